# Optimizing an MI355X kernel written in HIP

```python
import jax, jax.numpy as jnp
from jax import lax
import numpy as np

D_MODEL = 2048
BATCH = 2
SEQ = 4096
DEPTH = 1

EPS = 1e-6
M_WIDTH = D_MODEL // 2
A_WIDTH = D_MODEL - M_WIDTH
MIX_WIDTH = M_WIDTH + A_WIDTH
M_HEADS = 4
M_HEAD_DIM = M_WIDTH // M_HEADS
CONV_W = 4
CHUNK = 64
A_HEADS = 8
A_HEAD_DIM = A_WIDTH // A_HEADS
DILATED = ((128, 1), (512, 4), (2048, 16))
SEG_PAD = 2048
ROPE_THETA = 10000.0
IN_COLS = 3 * M_WIDTH + 2 * M_HEADS + 3 * A_WIDTH
IN_SPLITS = (M_WIDTH, 2 * M_WIDTH, 3 * M_WIDTH, 3 * M_WIDTH + M_HEADS, 3 * M_WIDTH + 2 * M_HEADS,
             3 * M_WIDTH + 2 * M_HEADS + A_WIDTH, 3 * M_WIDTH + 2 * M_HEADS + 2 * A_WIDTH)
N_MEM = 256
X_HEADS = 4
X_HEAD_DIM = D_MODEL // X_HEADS
PEER_HEADS = 8
N_KEYS = 128
N_EXPERTS = N_KEYS * N_KEYS
PK_DIM = 256
PK_TOPK = 16
PEER_BLOCK = 128

kernel_name = "hybrid_mlstm_dilated_peer_block"


def rmsnorm(x, g):
    xf = x.astype(jnp.float32)
    y = xf * lax.rsqrt(jnp.mean(xf * xf, axis=-1, keepdims=True) + EPS)
    return (y * g.astype(jnp.float32)).astype(x.dtype)


def heads(t, n_heads):
    b, s, _ = t.shape
    return t.reshape(b, s, n_heads, -1).transpose(0, 2, 1, 3)


def rope(x, pos):
    half = x.shape[-1] // 2
    inv = ROPE_THETA ** (-jnp.arange(half, dtype=jnp.float32) / half)
    ang = pos.astype(jnp.float32)[:, None] * inv[None, :]
    cos, sin = jnp.cos(ang), jnp.sin(ang)
    x1, x2 = x[..., :half].astype(jnp.float32), x[..., half:].astype(jnp.float32)
    out = jnp.concatenate([x1 * cos - x2 * sin, x2 * cos + x1 * sin], axis=-1)
    return out.astype(x.dtype)


def causal_conv(x, w, b):
    y = lax.conv_general_dilated(x, w[:, None, :], window_strides=(1,), padding=[(CONV_W - 1, 0)],
                                 dimension_numbers=('NWC', 'WIO', 'NWC'), feature_group_count=x.shape[-1])
    return y + b


def mlstm_chunkwise(q, k, v, i_pre, f_pre):
    out_dtype = q.dtype
    B, H, S, Dh = q.shape
    nc = S // CHUNK
    q = q.astype(jnp.float32).reshape(B, H, nc, CHUNK, Dh)
    k = k.astype(jnp.float32).reshape(B, H, nc, CHUNK, Dh) * (Dh ** -0.5)
    v = v.astype(jnp.float32).reshape(B, H, nc, CHUNK, Dh)
    logi = i_pre.astype(jnp.float32).reshape(B, H, nc, CHUNK)
    logf = jax.nn.log_sigmoid(f_pre.astype(jnp.float32)).reshape(B, H, nc, CHUNK)
    b = jnp.cumsum(logf, axis=-1)
    g = b[..., -1]
    a = logi + g[..., None] - b

    def step(carry, inp):
        C, n, m = carry
        k_c, v_c, a_c, g_c = inp
        m_new = jnp.maximum(g_c + m, jnp.max(a_c, axis=-1))
        decay = jnp.exp(g_c + m - m_new)
        w = jnp.exp(a_c - m_new[..., None])
        C_new = decay[..., None, None] * C + jnp.einsum('bhl,bhld,bhle->bhde', w, k_c, v_c)
        n_new = decay[..., None] * n + jnp.einsum('bhl,bhld->bhd', w, k_c)
        return (C_new, n_new, m_new), (C, n, m)

    init = (jnp.zeros((B, H, Dh, Dh), jnp.float32), jnp.zeros((B, H, Dh), jnp.float32),
            jnp.zeros((B, H), jnp.float32))
    xs = (jnp.moveaxis(k, 2, 0), jnp.moveaxis(v, 2, 0), jnp.moveaxis(a, 2, 0), jnp.moveaxis(g, 2, 0))
    _, (C_prev, n_prev, m_prev) = lax.scan(step, init, xs)
    C_prev = jnp.moveaxis(C_prev, 0, 2)
    n_prev = jnp.moveaxis(n_prev, 0, 2)
    m_prev = jnp.moveaxis(m_prev, 0, 2)

    causal = jnp.tril(jnp.ones((CHUNK, CHUNK), dtype=bool))
    D = jnp.where(causal, b[..., :, None] - b[..., None, :] + logi[..., None, :], -jnp.inf)
    m_inter = b + m_prev[..., None]
    m_t = jnp.maximum(m_inter, jnp.max(D, axis=-1))
    s = jnp.einsum('bhcld,bhcsd->bhcls', q, k) * jnp.exp(D - m_t[..., None])
    inter = jnp.exp(m_inter - m_t)
    num = jnp.einsum('bhcls,bhcse->bhcle', s, v) + inter[..., None] * jnp.einsum('bhcld,bhcde->bhcle', q, C_prev)
    den = jnp.sum(s, axis=-1) + inter * jnp.einsum('bhcld,bhcd->bhcl', q, n_prev)
    h = num / jnp.maximum(jnp.abs(den), jnp.exp(-m_t))[..., None]
    return h.reshape(B, H, S, Dh).astype(out_dtype)


def dilated_branch(q, k, v, window, dil):
    B, H, Sp, Dh = q.shape
    blk = window // dil
    M = Sp // dil
    nb = M // blk

    def to_stream(t):
        return t.reshape(B, H, M, dil, Dh).transpose(0, 1, 3, 2, 4).reshape(B, H, dil, nb, blk, Dh)

    def from_stream(t):
        rest = t.shape[5:]
        return t.reshape((B, H, dil, M) + rest).swapaxes(2, 3).reshape((B, H, Sp) + rest)

    def with_prev(t):
        prev = jnp.pad(t, ((0, 0), (0, 0), (0, 0), (1, 0), (0, 0), (0, 0)))[:, :, :, :-1]
        return jnp.concatenate([prev, t], axis=-2)

    qs = to_stream(q)
    kw = with_prev(to_stream(k))
    vw = with_prev(to_stream(v))
    scores = jnp.einsum('bhrnqd,bhrnkd->bhrnqk', qs, kw).astype(jnp.float32) * (Dh ** -0.5)
    qi = jnp.arange(blk)[:, None]
    kj = jnp.arange(2 * blk)[None, :]
    dist = qi + blk - kj
    band = (dist >= 0) & (dist <= blk)
    valid = band[None] & ((jnp.arange(nb)[:, None, None] > 0) | (kj >= blk)[None])
    scores = jnp.where(valid, scores, -jnp.inf)
    m = jnp.max(scores, axis=-1)
    p = jnp.exp(scores - m[..., None])
    s = jnp.sum(p, axis=-1)
    o = jnp.einsum('bhrnqk,bhrnkd->bhrnqd', p.astype(v.dtype), vw).astype(jnp.float32) / s[..., None]
    return from_stream(o), from_stream(m), from_stream(s)


def dilated_mixture(q, k, v):
    B, H, S, Dh = q.shape
    Sp = -(-S // SEG_PAD) * SEG_PAD
    pad = ((0, 0), (0, 0), (0, Sp - S), (0, 0))
    q, k, v = jnp.pad(q, pad), jnp.pad(k, pad), jnp.pad(v, pad)
    outs, maxes, sums = [], [], []
    for window, dil in DILATED:
        o, m, s = dilated_branch(q, k, v, window, dil)
        outs.append(o)
        maxes.append(m)
        sums.append(s)
    o_all, m_all, s_all = jnp.stack(outs), jnp.stack(maxes), jnp.stack(sums)
    w = s_all * jnp.exp(m_all - jnp.max(m_all, axis=0, keepdims=True))
    out = jnp.sum(w[..., None] * o_all, axis=0) / jnp.sum(w, axis=0)[..., None]
    return out[:, :, :S].astype(q.dtype)


def memory_cross_attention(h, mn, w_xq, w_xk, w_xv, w_xo):
    B, S, D = h.shape
    q = (h @ w_xq).reshape(B, S, X_HEADS, X_HEAD_DIM)
    km = (mn @ w_xk).reshape(B, N_MEM, X_HEADS, X_HEAD_DIM)
    vm = (mn @ w_xv).reshape(B, N_MEM, X_HEADS, X_HEAD_DIM)
    sc = jnp.einsum('bshd,bmhd->bhsm', q, km).astype(jnp.float32) * (X_HEAD_DIM ** -0.5)
    p = jax.nn.softmax(sc, axis=-1).astype(h.dtype)
    o = jnp.einsum('bhsm,bmhd->bshd', p, vm).reshape(B, S, D)
    return o @ w_xo


def peer(h, w_pq, sub_keys, u_tab, v_tab):
    B, S, D = h.shape
    T = B * S
    xt = h.reshape(T, D)
    q = (xt @ w_pq).reshape(T, PEER_HEADS, 2, PK_DIM // 2)
    s_half = jnp.einsum('thpc,hpkc->thpk', q, sub_keys).astype(jnp.float32)
    top_s, top_i = lax.top_k(s_half, PK_TOPK)
    cand_s = top_s[:, :, 0, :, None] + top_s[:, :, 1, None, :]
    cand_i = top_i[:, :, 0, :, None] * N_KEYS + top_i[:, :, 1, None, :]
    best_s, best_pos = lax.top_k(cand_s.reshape(T, PEER_HEADS, PK_TOPK * PK_TOPK), PK_TOPK)
    ids = jnp.take_along_axis(cand_i.reshape(T, PEER_HEADS, PK_TOPK * PK_TOPK), best_pos, axis=-1)
    gate = jax.nn.softmax(best_s, axis=-1)
    nblk = T // PEER_BLOCK

    def block(args):
        xb, idb, gb = args
        u = u_tab[idb]
        act = jax.nn.gelu(jnp.einsum('td,thkd->thk', xb, u).astype(jnp.float32), approximate=False)
        coef = (gb * act).astype(xb.dtype)
        return jnp.einsum('thk,thkd->td', coef, v_tab[idb])

    out = lax.map(block, (xt.reshape(nblk, PEER_BLOCK, D),
                          ids.reshape(nblk, PEER_BLOCK, PEER_HEADS, PK_TOPK),
                          gate.reshape(nblk, PEER_BLOCK, PEER_HEADS, PK_TOPK)))
    return out.reshape(B, S, D)


def setup_inputs(seed: int = 0) -> dict:
    key = jax.random.key(seed)
    ks = jax.random.split(key, 26)
    L = DEPTH

    def nrm(k, shape, scale):
        return jax.random.normal(k, shape, jnp.float32) * scale

    def gain(k, shape):
        return 1.0 + 0.02 * jax.random.normal(k, shape, jnp.float32)

    return {
        "x": nrm(ks[0], (BATCH, SEQ, D_MODEL), 1.0),
        "mem": nrm(ks[1], (BATCH, N_MEM, D_MODEL), 1.0),
        "g_mix": gain(ks[2], (L, D_MODEL)),
        "w_in": nrm(ks[3], (L, D_MODEL, IN_COLS), D_MODEL ** -0.5),
        "conv_w": nrm(ks[4], (L, CONV_W, M_WIDTH), CONV_W ** -0.5),
        "conv_b": nrm(ks[5], (L, M_WIDTH), 0.02),
        "w_mq": nrm(ks[6], (L, M_HEADS, M_HEAD_DIM, M_HEAD_DIM), M_HEAD_DIM ** -0.5),
        "w_mk": nrm(ks[7], (L, M_HEADS, M_HEAD_DIM, M_HEAD_DIM), M_HEAD_DIM ** -0.5),
        "b_mi": nrm(ks[8], (L, M_HEADS), 0.1),
        "b_mf": jnp.linspace(3.0, 6.0, M_HEADS, dtype=jnp.float32)[None, :] + nrm(ks[9], (L, M_HEADS), 0.1),
        "g_mhead": gain(ks[10], (L, M_HEADS, M_HEAD_DIM)),
        "g_ahead": gain(ks[11], (L, A_HEADS, A_HEAD_DIM)),
        "w_out": nrm(ks[12], (L, MIX_WIDTH, D_MODEL), MIX_WIDTH ** -0.5),
        "g_cross": gain(ks[13], (L, D_MODEL)),
        "g_mem": gain(ks[14], (L, D_MODEL)),
        "w_xq": nrm(ks[15], (L, D_MODEL, D_MODEL), D_MODEL ** -0.5),
        "w_xk": nrm(ks[16], (L, D_MODEL, D_MODEL), D_MODEL ** -0.5),
        "w_xv": nrm(ks[17], (L, D_MODEL, D_MODEL), D_MODEL ** -0.5),
        "w_xo": nrm(ks[18], (L, D_MODEL, D_MODEL), D_MODEL ** -0.5),
        "g_ffn": gain(ks[19], (L, D_MODEL)),
        "w_pq": nrm(ks[20], (L, D_MODEL, PEER_HEADS * PK_DIM), D_MODEL ** -0.5),
        "sub_keys": nrm(ks[21], (L, PEER_HEADS, 2, N_KEYS, PK_DIM // 2), (PK_DIM // 2) ** -0.5),
        "u_tab": nrm(ks[22], (L, N_EXPERTS, D_MODEL), D_MODEL ** -0.5),
        "v_tab": nrm(ks[23], (L, N_EXPERTS, D_MODEL), PEER_HEADS ** -0.5),
        "g_final": gain(ks[24], (D_MODEL,)),
    }


def reference(x, mem, g_mix, w_in, conv_w, conv_b, w_mq, w_mk, b_mi, b_mf, g_mhead, g_ahead, w_out,
              g_cross, g_mem, w_xq, w_xk, w_xv, w_xo, g_ffn, w_pq, sub_keys, u_tab, v_tab, g_final):
    B, S, _ = x.shape
    pos = jnp.arange(S)
    for l in range(DEPTH):
        h = rmsnorm(x, g_mix[l])
        proj = h @ w_in[l]
        m_in, m_v, m_o, m_i, m_f, a_q, a_k, a_v = jnp.split(proj, IN_SPLITS, axis=-1)
        c = jax.nn.silu(causal_conv(m_in, conv_w[l], conv_b[l])).reshape(B, S, M_HEADS, M_HEAD_DIM)
        mq = jnp.einsum('bshd,hde->bhse', c, w_mq[l])
        mk = jnp.einsum('bshd,hde->bhse', c, w_mk[l])
        mv = heads(m_v, M_HEADS)
        hm = mlstm_chunkwise(mq, mk, mv, (m_i + b_mi[l]).transpose(0, 2, 1), (m_f + b_mf[l]).transpose(0, 2, 1))
        hm = rmsnorm(hm.transpose(0, 2, 1, 3), g_mhead[l]).reshape(B, S, M_WIDTH) * jax.nn.sigmoid(m_o)
        qa = rope(heads(a_q, A_HEADS), pos)
        ka = rope(heads(a_k, A_HEADS), pos)
        va = heads(a_v, A_HEADS)
        ha = dilated_mixture(qa, ka, va)
        ha = rmsnorm(ha.transpose(0, 2, 1, 3), g_ahead[l]).reshape(B, S, A_WIDTH)
        x = x + jnp.concatenate([hm, ha], axis=-1) @ w_out[l]
        x = x + memory_cross_attention(rmsnorm(x, g_cross[l]), rmsnorm(mem, g_mem[l]),
                                       w_xq[l], w_xk[l], w_xv[l], w_xo[l])
        x = x + peer(rmsnorm(x, g_ffn[l]), w_pq[l], sub_keys[l], u_tab[l], v_tab[l])
    return rmsnorm(x, g_final)
```

```cpp
#include <hip/hip_runtime.h>
#include <stdint.h>
#include <math.h>

namespace {
constexpr int D = 2048, NB = 2, S = 4096, T = NB * S;
constexpr int INC = 6152;
constexpr int C_MIN = 0, C_MV = 1024, C_MO = 2048, C_MI = 3072, C_MF = 3076, C_AQ = 3080, C_AK = 4104, C_AV = 5128;
constexpr float EPS = 1e-6f;

__device__ __forceinline__ float wave_sum(float v) {
#pragma unroll
    for (int o = 32; o >= 1; o >>= 1) v += __shfl_xor(v, o);
    return v;
}
__device__ __forceinline__ float wave_max(float v) {
#pragma unroll
    for (int o = 32; o >= 1; o >>= 1) v = fmaxf(v, __shfl_xor(v, o));
    return v;
}

__global__ void __launch_bounds__(256) k_rmsnorm(const float* __restrict__ in, const float* __restrict__ g, float* __restrict__ out) {
    __shared__ float red[4];
    const int row = blockIdx.x, t = threadIdx.x;
    const float4* p = (const float4*)(in + (size_t)row * D);
    float4 a = p[t], b = p[t + 256];
    float s = a.x * a.x + a.y * a.y + a.z * a.z + a.w * a.w + b.x * b.x + b.y * b.y + b.z * b.z + b.w * b.w;
    s = wave_sum(s);
    if ((t & 63) == 0) red[t >> 6] = s;
    __syncthreads();
    const float tot = red[0] + red[1] + red[2] + red[3];
    const float r = rsqrtf(tot * (1.0f / D) + EPS);
    const float4* gp = (const float4*)g;
    float4 ga = gp[t], gb = gp[t + 256];
    float4* o = (float4*)(out + (size_t)row * D);
    o[t] = make_float4(a.x * r * ga.x, a.y * r * ga.y, a.z * r * ga.z, a.w * r * ga.w);
    o[t + 256] = make_float4(b.x * r * gb.x, b.y * r * gb.y, b.z * r * gb.z, b.w * r * gb.w);
}

struct GemmP {
    const float* A; int lda; long sA;
    const float* W; int ldw; long sW;
    float* C; int ldc; long sC;
    const float* R; int ldr;
    int M, N, K;
};
__global__ void __launch_bounds__(256) k_gemm(GemmP p) {
    __shared__ float As[16][128 + 4];
    __shared__ float Bs[16][128 + 4];
    const int tid = threadIdx.x, tx = tid & 15, ty = tid >> 4;
    const int m0 = blockIdx.y * 128, n0 = blockIdx.x * 128;
    const float* A = p.A + (size_t)blockIdx.z * p.sA;
    const float* W = p.W + (size_t)blockIdx.z * p.sW;
    float* C = p.C + (size_t)blockIdx.z * p.sC;
    float acc[8][8];
#pragma unroll
    for (int i = 0; i < 8; ++i)
#pragma unroll
        for (int j = 0; j < 8; ++j) acc[i][j] = 0.f;
    for (int k0 = 0; k0 < p.K; k0 += 16) {
#pragma unroll
        for (int r = 0; r < 2; ++r) {
            const int idx = tid + r * 256;
            const int row = idx >> 2, kq = idx & 3;
            const float4 v = *(const float4*)(A + (size_t)(m0 + row) * p.lda + k0 + kq * 4);
            As[kq * 4 + 0][row] = v.x; As[kq * 4 + 1][row] = v.y; As[kq * 4 + 2][row] = v.z; As[kq * 4 + 3][row] = v.w;
        }
#pragma unroll
        for (int r = 0; r < 2; ++r) {
            const int idx = tid + r * 256;
            const int kr = idx >> 5, c4 = idx & 31;
            const int col = n0 + c4 * 4;
            float4 v = make_float4(0.f, 0.f, 0.f, 0.f);
            if (col < p.N) v = *(const float4*)(W + (size_t)(k0 + kr) * p.ldw + col);
            *(float4*)&Bs[kr][c4 * 4] = v;
        }
        __syncthreads();
#pragma unroll
        for (int k = 0; k < 16; ++k) {
            float a[8], b[8];
            const float4 a0 = *(const float4*)&As[k][ty * 8], a1 = *(const float4*)&As[k][ty * 8 + 4];
            const float4 b0 = *(const float4*)&Bs[k][tx * 8], b1 = *(const float4*)&Bs[k][tx * 8 + 4];
            a[0] = a0.x; a[1] = a0.y; a[2] = a0.z; a[3] = a0.w; a[4] = a1.x; a[5] = a1.y; a[6] = a1.z; a[7] = a1.w;
            b[0] = b0.x; b[1] = b0.y; b[2] = b0.z; b[3] = b0.w; b[4] = b1.x; b[5] = b1.y; b[6] = b1.z; b[7] = b1.w;
#pragma unroll
            for (int i = 0; i < 8; ++i)
#pragma unroll
                for (int j = 0; j < 8; ++j) acc[i][j] = fmaf(a[i], b[j], acc[i][j]);
        }
        __syncthreads();
    }
#pragma unroll
    for (int i = 0; i < 8; ++i) {
        const int row = m0 + ty * 8 + i;
#pragma unroll
        for (int jq = 0; jq < 2; ++jq) {
            const int col = n0 + tx * 8 + jq * 4;
            if (col < p.N) {
                float4 v = make_float4(acc[i][jq * 4 + 0], acc[i][jq * 4 + 1], acc[i][jq * 4 + 2], acc[i][jq * 4 + 3]);
                if (p.R) {
                    const float4 r = *(const float4*)(p.R + (size_t)row * p.ldr + col);
                    v.x += r.x; v.y += r.y; v.z += r.z; v.w += r.w;
                }
                *(float4*)(C + (size_t)row * p.ldc + col) = v;
            }
        }
    }
}

__global__ void __launch_bounds__(256) k_conv_silu(const float* __restrict__ proj, const float* __restrict__ cw, const float* __restrict__ cb, float* __restrict__ c) {
    const int t = blockIdx.x, s = t % S;
    for (int ch = threadIdx.x; ch < 1024; ch += 256) {
        float y = cb[ch];
#pragma unroll
        for (int j = 0; j < 4; ++j) {
            const int ss = s - 3 + j;
            if (ss >= 0) y = fmaf(cw[j * 1024 + ch], proj[(size_t)(t - 3 + j) * INC + C_MIN + ch], y);
        }
        c[(size_t)t * 1024 + ch] = y / (1.0f + expf(-y));
    }
}

__device__ __forceinline__ float log_sigmoid(float x) { return fminf(x, 0.f) - log1pf(expf(-fabsf(x))); }

__global__ void __launch_bounds__(256) k_mlstm(const float* __restrict__ mq, const float* __restrict__ mk, const float* __restrict__ proj,
                                               const float* __restrict__ b_mi, const float* __restrict__ b_mf, float* __restrict__ hraw) {
    const int lane = threadIdx.x & 63, w = threadIdx.x >> 6;
    const int gid = blockIdx.x * 4 + w;
    const int e = gid & 255, h = (gid >> 8) & 3, b = gid >> 10;
    const float bi = b_mi[h], bf = b_mf[h];
    float C0 = 0.f, C1 = 0.f, C2 = 0.f, C3 = 0.f, n0 = 0.f, n1 = 0.f, n2 = 0.f, n3 = 0.f, m = 0.f;
    const size_t tb = (size_t)b * S;
    const float* qp = mq + tb * 1024 + h * 256 + lane * 4;
    const float* kp = mk + tb * 1024 + h * 256 + lane * 4;
    const float* pp = proj + tb * INC;
    float4 qn = *(const float4*)qp, kn = *(const float4*)kp;
    float vn = pp[C_MV + h * 256 + e], in_ = pp[C_MI + h], fn = pp[C_MF + h];
    for (int s = 0; s < S; ++s) {
        const float4 q = qn, k = kn; const float v = vn, ipre = in_ + bi, fpre = fn + bf;
        if (s + 1 < S) {
            qn = *(const float4*)(qp + (size_t)(s + 1) * 1024);
            kn = *(const float4*)(kp + (size_t)(s + 1) * 1024);
            const float* pr = pp + (size_t)(s + 1) * INC;
            vn = pr[C_MV + h * 256 + e]; in_ = pr[C_MI + h]; fn = pr[C_MF + h];
        }
        const float logf = log_sigmoid(fpre);
        const float mnew = fmaxf(logf + m, ipre);
        const float fd = expf(logf + m - mnew), ig = expf(ipre - mnew);
        m = mnew;
        const float sc = ig * 0.0625f;
        C0 = fd * C0 + sc * k.x * v; C1 = fd * C1 + sc * k.y * v; C2 = fd * C2 + sc * k.z * v; C3 = fd * C3 + sc * k.w * v;
        n0 = fd * n0 + sc * k.x; n1 = fd * n1 + sc * k.y; n2 = fd * n2 + sc * k.z; n3 = fd * n3 + sc * k.w;
        float num = q.x * C0 + q.y * C1 + q.z * C2 + q.w * C3;
        float den = q.x * n0 + q.y * n1 + q.z * n2 + q.w * n3;
        num = wave_sum(num); den = wave_sum(den);
        if (lane == 0) hraw[(tb + s) * 1024 + h * 256 + e] = num / fmaxf(fabsf(den), expf(-mnew));
    }
}

__global__ void __launch_bounds__(256) k_mhead_norm(const float* __restrict__ hraw, const float* __restrict__ proj, const float* __restrict__ g, float* __restrict__ mix) {
    const int t = blockIdx.x, h = threadIdx.x >> 6, lane = threadIdx.x & 63;
    const float4 v = *(const float4*)(hraw + (size_t)t * 1024 + h * 256 + lane * 4);
    float s = v.x * v.x + v.y * v.y + v.z * v.z + v.w * v.w;
    s = wave_sum(s);
    const float r = rsqrtf(s * (1.0f / 256.0f) + EPS);
    const float4 gg = *(const float4*)(g + h * 256 + lane * 4);
    const float* mo = proj + (size_t)t * INC + C_MO + h * 256 + lane * 4;
    float4 o;
    o.x = v.x * r * gg.x / (1.0f + expf(-mo[0]));
    o.y = v.y * r * gg.y / (1.0f + expf(-mo[1]));
    o.z = v.z * r * gg.z / (1.0f + expf(-mo[2]));
    o.w = v.w * r * gg.w / (1.0f + expf(-mo[3]));
    *(float4*)(mix + (size_t)t * D + h * 256 + lane * 4) = o;
}

__global__ void __launch_bounds__(256) k_rope(float* __restrict__ proj) {
    const int t = blockIdx.x, s = t % S;
    for (int idx = threadIdx.x; idx < 2 * 8 * 64; idx += 256) {
        const int i = idx & 63, hd = (idx >> 6) & 7, qk = idx >> 9;
        const float inv = (float)pow(10000.0, -(double)i / 64.0);
        const float ang = (float)s * inv;
        const float cs = (float)cos((double)ang), sn = (float)sin((double)ang);
        float* p = proj + (size_t)t * INC + (qk ? C_AK : C_AQ) + hd * 128;
        const float x1 = p[i], x2 = p[64 + i];
        p[i] = x1 * cs - x2 * sn;
        p[64 + i] = x2 * cs + x1 * sn;
    }
}

__global__ void __launch_bounds__(256) k_dilated(const float* __restrict__ proj, const float* __restrict__ g_ahead, float* __restrict__ mix) {
    __shared__ float qs[4][128];
    __shared__ float ps[4][3 * 192];
    const int lane = threadIdx.x & 63, w = threadIdx.x >> 6;
    const int gid = blockIdx.x * 4 + w;
    const int s = gid % S, hd = (gid / S) & 7, b = gid / (S * 8);
    const size_t t = (size_t)b * S + s;
    const float* qrow = proj + t * INC + C_AQ + hd * 128;
    qs[w][lane] = qrow[lane]; qs[w][lane + 64] = qrow[lane + 64];
    __syncthreads();
    const float scale = 0.08838834764831845f;
    float mloc = -INFINITY;
    for (int br = 0; br < 3; ++br) {
        const int dil = br == 0 ? 1 : (br == 1 ? 4 : 16);
        for (int jj = 0; jj < 192; jj += 64) {
            const int j = jj + lane;
            float sc = -INFINITY;
            if (j <= 128 && s - j * dil >= 0) {
                const float* krow = proj + (t - (size_t)j * dil) * INC + C_AK + hd * 128;
                float d = 0.f;
#pragma unroll 8
                for (int c = 0; c < 128; c += 4) {
                    const float4 kv = *(const float4*)(krow + c);
                    d = fmaf(qs[w][c], kv.x, d); d = fmaf(qs[w][c + 1], kv.y, d); d = fmaf(qs[w][c + 2], kv.z, d); d = fmaf(qs[w][c + 3], kv.w, d);
                }
                sc = d * scale;
            }
            ps[w][br * 192 + j] = sc;
            mloc = fmaxf(mloc, sc);
        }
    }
    const float mx = wave_max(mloc);
    __syncthreads();
    float lsum = 0.f;
    for (int i = lane; i < 3 * 192; i += 64) {
        const float sc = ps[w][i];
        const float pv = (sc == -INFINITY) ? 0.f : expf(sc - mx);
        ps[w][i] = pv; lsum += pv;
    }
    const float tot = wave_sum(lsum);
    __syncthreads();
    float o0 = 0.f, o1 = 0.f;
    for (int br = 0; br < 3; ++br) {
        const int dil = br == 0 ? 1 : (br == 1 ? 4 : 16);
        for (int j = 0; j <= 128; ++j) {
            if (s - j * dil < 0) break;
            const float pv = ps[w][br * 192 + j];
            const float* vrow = proj + (t - (size_t)j * dil) * INC + C_AV + hd * 128;
            o0 = fmaf(pv, vrow[lane], o0); o1 = fmaf(pv, vrow[lane + 64], o1);
        }
    }
    o0 /= tot; o1 /= tot;
    float ss = wave_sum(o0 * o0 + o1 * o1);
    const float r = rsqrtf(ss * (1.0f / 128.0f) + EPS);
    float* orow = mix + t * D + 1024 + hd * 128;
    orow[lane] = o0 * r * g_ahead[hd * 128 + lane];
    orow[lane + 64] = o1 * r * g_ahead[hd * 128 + lane + 64];
}

__global__ void __launch_bounds__(256) k_cross(const float* __restrict__ q, const float* __restrict__ km, const float* __restrict__ vm, float* __restrict__ o) {
    __shared__ float qs[4][512];
    __shared__ float ps[4][256];
    const int lane = threadIdx.x & 63, w = threadIdx.x >> 6;
    const int t = blockIdx.x, hd = w, b = t / S;
    const float* qrow = q + (size_t)t * D + hd * 512;
    for (int i = lane; i < 512; i += 64) qs[w][i] = qrow[i];
    __syncthreads();
    const float scale = 0.04419417382415922f;
    float sc[4]; float mloc = -INFINITY;
#pragma unroll
    for (int r = 0; r < 4; ++r) {
        const int mi = lane + 64 * r;
        const float* krow = km + ((size_t)b * 256 + mi) * D + hd * 512;
        float d = 0.f;
#pragma unroll 8
        for (int c = 0; c < 512; c += 4) {
            const float4 kv = *(const float4*)(krow + c);
            d = fmaf(qs[w][c], kv.x, d); d = fmaf(qs[w][c + 1], kv.y, d); d = fmaf(qs[w][c + 2], kv.z, d); d = fmaf(qs[w][c + 3], kv.w, d);
        }
        sc[r] = d * scale; mloc = fmaxf(mloc, sc[r]);
    }
    const float mx = wave_max(mloc);
    float lsum = 0.f;
#pragma unroll
    for (int r = 0; r < 4; ++r) { const float pv = expf(sc[r] - mx); ps[w][lane + 64 * r] = pv; lsum += pv; }
    const float tot = wave_sum(lsum);
    __syncthreads();
    float acc[8];
#pragma unroll
    for (int i = 0; i < 8; ++i) acc[i] = 0.f;
    for (int mi = 0; mi < 256; ++mi) {
        const float pv = ps[w][mi];
        const float* vrow = vm + ((size_t)b * 256 + mi) * D + hd * 512;
#pragma unroll
        for (int i = 0; i < 8; ++i) acc[i] = fmaf(pv, vrow[lane + 64 * i], acc[i]);
    }
    float* orow = o + (size_t)t * D + hd * 512;
#pragma unroll
    for (int i = 0; i < 8; ++i) orow[lane + 64 * i] = acc[i] / tot;
}

__device__ __forceinline__ void wave_argmax(float& best, int& bidx) {
#pragma unroll
    for (int o = 32; o >= 1; o >>= 1) {
        const float ob = __shfl_xor(best, o); const int oi = __shfl_xor(bidx, o);
        if (ob > best || (ob == best && oi < bidx)) { best = ob; bidx = oi; }
    }
}
__global__ void __launch_bounds__(256) k_peer_topk(const float* __restrict__ qp, const float* __restrict__ sub_keys, int* __restrict__ ids, float* __restrict__ gates) {
    __shared__ float qs[4][256];
    const int lane = threadIdx.x & 63, w = threadIdx.x >> 6;
    const int gid = blockIdx.x * 4 + w;
    const int hd = gid & 7, t = gid >> 3;
    const float* qrow = qp + (size_t)t * D + hd * 256;
    for (int i = lane; i < 256; i += 64) qs[w][i] = qrow[i];
    __syncthreads();
    float tops[2]; int topi[2];
#pragma unroll
    for (int p = 0; p < 2; ++p) {
        float v0, v1;
        {
            const float* k0 = sub_keys + ((size_t)(hd * 2 + p) * 128 + lane) * 128;
            const float* k1 = k0 + 64 * 128;
            float d0 = 0.f, d1 = 0.f;
#pragma unroll 8
            for (int c = 0; c < 128; c += 4) {
                const float4 a = *(const float4*)(k0 + c), bb = *(const float4*)(k1 + c);
                const float q0 = qs[w][p * 128 + c], q1 = qs[w][p * 128 + c + 1], q2 = qs[w][p * 128 + c + 2], q3 = qs[w][p * 128 + c + 3];
                d0 = fmaf(q0, a.x, d0); d0 = fmaf(q1, a.y, d0); d0 = fmaf(q2, a.z, d0); d0 = fmaf(q3, a.w, d0);
                d1 = fmaf(q0, bb.x, d1); d1 = fmaf(q1, bb.y, d1); d1 = fmaf(q2, bb.z, d1); d1 = fmaf(q3, bb.w, d1);
            }
            v0 = d0; v1 = d1;
        }
        float ts = 0.f; int ti = 0;
        for (int it = 0; it < 16; ++it) {
            float best; int bidx;
            if (v0 >= v1) { best = v0; bidx = lane; } else { best = v1; bidx = lane + 64; }
            wave_argmax(best, bidx);
            if (lane == it) { ts = best; ti = bidx; }
            if (bidx == lane) v0 = -INFINITY;
            if (bidx == lane + 64) v1 = -INFINITY;
        }
        tops[p] = ts; topi[p] = ti;
    }
    float cv[4]; int ci[4];
#pragma unroll
    for (int r = 0; r < 4; ++r) {
        const int c = lane * 4 + r, i = c >> 4, j = c & 15;
        const float s0 = __shfl(tops[0], i), s1 = __shfl(tops[1], j);
        const int i0 = __shfl(topi[0], i), i1 = __shfl(topi[1], j);
        cv[r] = s0 + s1; ci[r] = i0 * 128 + i1;
    }
    float bs = 0.f; int bid = 0;
    for (int it = 0; it < 16; ++it) {
        float best = cv[0]; int bidx = lane * 4;
#pragma unroll
        for (int r = 1; r < 4; ++r) if (cv[r] > best) { best = cv[r]; bidx = lane * 4 + r; }
        wave_argmax(best, bidx);
        const int owner = bidx >> 2, rr = bidx & 3;
        int myid = ci[0];
        if (rr == 1) myid = ci[1]; else if (rr == 2) myid = ci[2]; else if (rr == 3) myid = ci[3];
        const int eid = __shfl(myid, owner);
        if (lane == it) { bs = best; bid = eid; }
        if (owner == lane) {
#pragma unroll
            for (int r = 0; r < 4; ++r) if (rr == r) cv[r] = -INFINITY;
        }
    }
    float v = lane < 16 ? bs : -INFINITY;
    const float mx = wave_max(v);
    const float ev = lane < 16 ? expf(bs - mx) : 0.f;
    const float tot = wave_sum(ev);
    if (lane < 16) {
        ids[(size_t)t * 128 + hd * 16 + lane] = bid;
        gates[(size_t)t * 128 + hd * 16 + lane] = ev / tot;
    }
}

__global__ void __launch_bounds__(256) k_peer_out(const float* __restrict__ h3, const float* __restrict__ x2, const int* __restrict__ ids, const float* __restrict__ gates,
                                                  const float* __restrict__ u_tab, const float* __restrict__ v_tab, const float* __restrict__ g_final, float* __restrict__ out) {
    __shared__ float part[4][2048];
    __shared__ float red[4];
    const int lane = threadIdx.x & 63, w = threadIdx.x >> 6, t = blockIdx.x;
    float4 xr[8], acc[8];
    const float* hrow = h3 + (size_t)t * D;
#pragma unroll
    for (int i = 0; i < 8; ++i) { xr[i] = *(const float4*)(hrow + i * 256 + lane * 4); acc[i] = make_float4(0.f, 0.f, 0.f, 0.f); }
    for (int j = 0; j < 32; ++j) {
        const int slot = w * 32 + j;
        const int e = ids[(size_t)t * 128 + slot];
        const float gt = gates[(size_t)t * 128 + slot];
        const float* ur = u_tab + (size_t)e * D;
        const float* vr = v_tab + (size_t)e * D;
        float d = 0.f;
#pragma unroll
        for (int i = 0; i < 8; ++i) {
            const float4 u = *(const float4*)(ur + i * 256 + lane * 4);
            d = fmaf(xr[i].x, u.x, d); d = fmaf(xr[i].y, u.y, d); d = fmaf(xr[i].z, u.z, d); d = fmaf(xr[i].w, u.w, d);
        }
        d = wave_sum(d);
        const float act = 0.5f * d * (1.0f + erff(d * 0.7071067811865476f));
        const float cf = gt * act;
#pragma unroll
        for (int i = 0; i < 8; ++i) {
            const float4 v = *(const float4*)(vr + i * 256 + lane * 4);
            acc[i].x = fmaf(cf, v.x, acc[i].x); acc[i].y = fmaf(cf, v.y, acc[i].y); acc[i].z = fmaf(cf, v.z, acc[i].z); acc[i].w = fmaf(cf, v.w, acc[i].w);
        }
    }
#pragma unroll
    for (int i = 0; i < 8; ++i) *(float4*)&part[w][i * 256 + lane * 4] = acc[i];
    __syncthreads();
    const int tid = threadIdx.x;
    float4 r0, r1;
    {
        const float4 a = *(const float4*)&part[0][tid * 4], b = *(const float4*)&part[1][tid * 4], c = *(const float4*)&part[2][tid * 4], d = *(const float4*)&part[3][tid * 4];
        const float4 x = *(const float4*)(x2 + (size_t)t * D + tid * 4);
        r0 = make_float4(x.x + a.x + b.x + c.x + d.x, x.y + a.y + b.y + c.y + d.y, x.z + a.z + b.z + c.z + d.z, x.w + a.w + b.w + c.w + d.w);
    }
    {
        const float4 a = *(const float4*)&part[0][1024 + tid * 4], b = *(const float4*)&part[1][1024 + tid * 4], c = *(const float4*)&part[2][1024 + tid * 4], d = *(const float4*)&part[3][1024 + tid * 4];
        const float4 x = *(const float4*)(x2 + (size_t)t * D + 1024 + tid * 4);
        r1 = make_float4(x.x + a.x + b.x + c.x + d.x, x.y + a.y + b.y + c.y + d.y, x.z + a.z + b.z + c.z + d.z, x.w + a.w + b.w + c.w + d.w);
    }
    float s = r0.x * r0.x + r0.y * r0.y + r0.z * r0.z + r0.w * r0.w + r1.x * r1.x + r1.y * r1.y + r1.z * r1.z + r1.w * r1.w;
    s = wave_sum(s);
    if (lane == 0) red[w] = s;
    __syncthreads();
    const float tot = red[0] + red[1] + red[2] + red[3];
    const float r = rsqrtf(tot * (1.0f / D) + EPS);
    const float4 g0 = *(const float4*)(g_final + tid * 4), g1 = *(const float4*)(g_final + 1024 + tid * 4);
    *(float4*)(out + (size_t)t * D + tid * 4) = make_float4(r0.x * r * g0.x, r0.y * r * g0.y, r0.z * r * g0.z, r0.w * r * g0.w);
    *(float4*)(out + (size_t)t * D + 1024 + tid * 4) = make_float4(r1.x * r * g1.x, r1.y * r * g1.y, r1.z * r * g1.z, r1.w * r * g1.w);
}

void gemm(hipStream_t st, const float* A, int lda, long sA, const float* W, int ldw, long sW, float* C, int ldc, long sC, const float* R, int ldr, int M, int N, int K, int batch) {
    GemmP p{};
    p.A = A; p.lda = lda; p.sA = sA; p.W = W; p.ldw = ldw; p.sW = sW; p.C = C; p.ldc = ldc; p.sC = sC; p.R = R; p.ldr = ldr; p.M = M; p.N = N; p.K = K;
    dim3 grid((N + 127) / 128, M / 128, batch);
    k_gemm<<<grid, 256, 0, st>>>(p);
}
}

extern "C" void kernel_launch(void* const* d_in, const int* in_sizes, int n_in, void* d_out, int out_size, void* d_ws, size_t ws_size, hipStream_t stream) {
    const float* x = (const float*)d_in[0];
    const float* mem = (const float*)d_in[1];
    const float* g_mix = (const float*)d_in[2];
    const float* w_in = (const float*)d_in[3];
    const float* conv_w = (const float*)d_in[4];
    const float* conv_b = (const float*)d_in[5];
    const float* w_mq = (const float*)d_in[6];
    const float* w_mk = (const float*)d_in[7];
    const float* b_mi = (const float*)d_in[8];
    const float* b_mf = (const float*)d_in[9];
    const float* g_mhead = (const float*)d_in[10];
    const float* g_ahead = (const float*)d_in[11];
    const float* w_out = (const float*)d_in[12];
    const float* g_cross = (const float*)d_in[13];
    const float* g_mem = (const float*)d_in[14];
    const float* w_xq = (const float*)d_in[15];
    const float* w_xk = (const float*)d_in[16];
    const float* w_xv = (const float*)d_in[17];
    const float* w_xo = (const float*)d_in[18];
    const float* g_ffn = (const float*)d_in[19];
    const float* w_pq = (const float*)d_in[20];
    const float* sub_keys = (const float*)d_in[21];
    const float* u_tab = (const float*)d_in[22];
    const float* v_tab = (const float*)d_in[23];
    const float* g_final = (const float*)d_in[24];
    float* out = (float*)d_out;

    float* ws = (float*)d_ws;
    const size_t TD = (size_t)T * D;
    float* proj = ws;
    float* hbuf = proj + (size_t)T * INC;
    float* cbuf = hbuf + TD;
    float* mq = cbuf + (size_t)T * 1024;
    float* mk = mq + (size_t)T * 1024;
    float* mix = mk + (size_t)T * 1024;
    float* hraw = hbuf;
    float* x1 = proj;
    float* x2 = proj + TD;
    float* mn = proj + 2 * TD;
    float* km = mn + (size_t)512 * D;
    float* vm = km + (size_t)512 * D;
    float* gates = vm + (size_t)512 * D;
    int* ids = (int*)(gates + (size_t)T * 128);
    float* qx = cbuf;
    float* obuf = mix;

    k_rmsnorm<<<T, 256, 0, stream>>>(x, g_mix, hbuf);
    gemm(stream, hbuf, D, 0, w_in, INC, 0, proj, INC, 0, nullptr, 0, T, INC, D, 1);
    k_conv_silu<<<T, 256, 0, stream>>>(proj, conv_w, conv_b, cbuf);
    gemm(stream, cbuf, 1024, 256, w_mq, 256, 65536, mq, 1024, 256, nullptr, 0, T, 256, 256, 4);
    gemm(stream, cbuf, 1024, 256, w_mk, 256, 65536, mk, 1024, 256, nullptr, 0, T, 256, 256, 4);
    k_mlstm<<<(NB * 4 * 256) / 4, 256, 0, stream>>>(mq, mk, proj, b_mi, b_mf, hraw);
    k_mhead_norm<<<T, 256, 0, stream>>>(hraw, proj, g_mhead, mix);
    k_rope<<<T, 256, 0, stream>>>(proj);
    k_dilated<<<(NB * 8 * S) / 4, 256, 0, stream>>>(proj, g_ahead, mix);
    gemm(stream, mix, D, 0, w_out, D, 0, x1, D, 0, x, D, T, D, D, 1);
    k_rmsnorm<<<T, 256, 0, stream>>>(x1, g_cross, hbuf);
    k_rmsnorm<<<512, 256, 0, stream>>>(mem, g_mem, mn);
    gemm(stream, hbuf, D, 0, w_xq, D, 0, qx, D, 0, nullptr, 0, T, D, D, 1);
    gemm(stream, mn, D, 0, w_xk, D, 0, km, D, 0, nullptr, 0, 512, D, D, 1);
    gemm(stream, mn, D, 0, w_xv, D, 0, vm, D, 0, nullptr, 0, 512, D, D, 1);
    k_cross<<<T, 256, 0, stream>>>(qx, km, vm, obuf);
    gemm(stream, obuf, D, 0, w_xo, D, 0, x2, D, 0, x1, D, T, D, D, 1);
    k_rmsnorm<<<T, 256, 0, stream>>>(x2, g_ffn, hbuf);
    gemm(stream, hbuf, D, 0, w_pq, D, 0, qx, D, 0, nullptr, 0, T, D, D, 1);
    k_peer_topk<<<(T * 8) / 4, 256, 0, stream>>>(qx, sub_keys, ids, gates);
    k_peer_out<<<T, 256, 0, stream>>>(hbuf, x2, ids, gates, u_tab, v_tab, g_final, out);
}
```

```cpp
#include <hip/hip_runtime.h>
#include <stdint.h>
#include <math.h>
#include <cstdio>

namespace {
constexpr int D = 2048, NB = 2, S = 4096, T = NB * S;
constexpr int INC = 6152;
constexpr int C_MIN = 0, C_MV = 1024, C_MO = 2048, C_MI = 3072, C_MF = 3076, C_AQ = 3080, C_AK = 4104, C_AV = 5128;
constexpr float EPS = 1e-6f;
constexpr int NTHR = 512;
constexpr int HALF_SM_FLOATS = 8704;
constexpr int SMEM_BYTES = 2 * HALF_SM_FLOATS * 4 + 64;

#define XB_TMO      128
#define XB_XCNT(j)  (256  + 64 * (j))
#define XB_XSUB(j)  (1280 + 64 * (j))
#define XB_XGEN(j)  (2304 + 64 * (j))
#define XB_TOP      3328
#define XB_TOPGEN   3392
#define XCD_BAR_WORDS 3456
#define XB_SPIN_CAP (1u << 22)
#define LAS __attribute__((address_space(3)))

__device__ __forceinline__ unsigned xb_ld(unsigned* p)              { return __hip_atomic_load(p, __ATOMIC_RELAXED, __HIP_MEMORY_SCOPE_AGENT); }
__device__ __forceinline__ unsigned xb_add(unsigned* p, unsigned v) { return __hip_atomic_fetch_add(p, v, __ATOMIC_RELAXED, __HIP_MEMORY_SCOPE_AGENT); }
__device__ __forceinline__ unsigned xb_xcc_id() { return (unsigned)__builtin_amdgcn_s_getreg((3 << 11) | 20) & 0xFu; }
#define XB_SPIN(cond, bar) do { unsigned _sp = 0; while (cond) { __builtin_amdgcn_s_sleep(1); \
    if ((++_sp & 255u) == 0u) { if (xb_ld(&(bar)[XB_TMO])) break; if (_sp > XB_SPIN_CAP) { atomicAdd(&(bar)[XB_TMO], 1u); break; } } } } while (0)

struct XcdBarrier { unsigned* bar; unsigned x; volatile LAS unsigned* st; };

__device__ __forceinline__ XcdBarrier xcd_barrier_post(unsigned* bar, volatile LAS unsigned* st) {
    XcdBarrier b; b.bar = bar; b.x = xb_xcc_id(); b.st = st;
    if (threadIdx.x == 0) (void)xb_add(&bar[XB_XCNT(b.x)], 1u);
    return b;
}
__device__ __forceinline__ void xcd_barrier_complete(unsigned* bar, unsigned x, unsigned& nloc, unsigned& nx) {
    const unsigned G = gridDim.x * gridDim.y * gridDim.z;
    unsigned sum, cnt, mine, sp = 0u;
    for (;;) {
        sum = 0u; cnt = 0u; mine = 0u;
#pragma unroll
        for (unsigned j = 0; j < 16; ++j) { const unsigned c = xb_ld(&bar[XB_XCNT(j)]); sum += c; cnt += (c > 0u) ? 1u : 0u; mine = (j == x) ? c : mine; }
        if (sum == G) break;
        __builtin_amdgcn_s_sleep(1);
        if ((++sp & 255u) == 0u) { if (xb_ld(&bar[XB_TMO])) break; if (sp > XB_SPIN_CAP) { atomicAdd(&bar[XB_TMO], 1u); break; } }
    }
    nloc = mine > 0u ? mine : 1u; nx = cnt > 0u ? cnt : 1u;
}
__device__ __forceinline__ void xcd_barrier(const XcdBarrier& b) {
    asm volatile("s_waitcnt vmcnt(0)" ::: "memory");
    __syncthreads();
    if (threadIdx.x == 0) {
        unsigned* bar = b.bar;
        __builtin_amdgcn_s_waitcnt(0);
        unsigned nloc = b.st[0], nx = b.st[1];
        if (nloc == 0u) { xcd_barrier_complete(bar, b.x, nloc, nx); b.st[0] = nloc; b.st[1] = nx; }
        const unsigned old = xb_add(&bar[XB_XSUB(b.x)], 1u);
        const unsigned gen = old / nloc;
        if (old + 1u == (gen + 1u) * nloc) {
            __builtin_amdgcn_fence(__ATOMIC_RELEASE, "agent");
            asm volatile("s_waitcnt vmcnt(0)" ::: "memory");
            const unsigned og = xb_add(&bar[XB_TOP], 1u);
            const unsigned tg = og / nx;
            if (og + 1u == (tg + 1u) * nx) xb_add(&bar[XB_TOPGEN], 1u);
            else XB_SPIN(xb_ld(&bar[XB_TOPGEN]) == tg, bar);
            __builtin_amdgcn_fence(__ATOMIC_ACQUIRE, "agent");
            xb_add(&bar[XB_XGEN(b.x)], 1u);
            asm volatile("s_waitcnt vmcnt(0)" ::: "memory");
        } else {
            XB_SPIN(xb_ld(&bar[XB_XGEN(b.x)]) == gen, bar);
            __builtin_amdgcn_fence(__ATOMIC_ACQUIRE, "agent");
            asm volatile("s_waitcnt vmcnt(0)" ::: "memory");
        }
    }
    __syncthreads();
}

__device__ __forceinline__ float wave_sum(float v) {
#pragma unroll
    for (int o = 32; o >= 1; o >>= 1) v += __shfl_xor(v, o);
    return v;
}
__device__ __forceinline__ float wave_max(float v) {
#pragma unroll
    for (int o = 32; o >= 1; o >>= 1) v = fmaxf(v, __shfl_xor(v, o));
    return v;
}
__device__ __forceinline__ float log_sigmoid(float x) { return fminf(x, 0.f) - log1pf(expf(-fabsf(x))); }


__device__ __forceinline__ void d_rmsnorm(int vb, int t, float* sm, const float* __restrict__ in, const float* __restrict__ g, float* __restrict__ out) {
    float* red = sm;
    const int row = vb;
    const float4* p = (const float4*)(in + (size_t)row * D);
    float4 a = p[t], b = p[t + 256];
    float s = a.x * a.x + a.y * a.y + a.z * a.z + a.w * a.w + b.x * b.x + b.y * b.y + b.z * b.z + b.w * b.w;
    s = wave_sum(s);
    __syncthreads();
    if ((t & 63) == 0) red[t >> 6] = s;
    __syncthreads();
    const float tot = red[0] + red[1] + red[2] + red[3];
    const float r = rsqrtf(tot * (1.0f / D) + EPS);
    const float4* gp = (const float4*)g;
    float4 ga = gp[t], gb = gp[t + 256];
    float4* o = (float4*)(out + (size_t)row * D);
    o[t] = make_float4(a.x * r * ga.x, a.y * r * ga.y, a.z * r * ga.z, a.w * r * ga.w);
    o[t + 256] = make_float4(b.x * r * gb.x, b.y * r * gb.y, b.z * r * gb.z, b.w * r * gb.w);
}

struct GemmP {
    const float* A; int lda; long sA;
    const float* W; int ldw; long sW;
    float* C; int ldc; long sC;
    const float* R; int ldr;
    int M, N, K, batch;
};
__device__ __forceinline__ int gemm_nvb(const GemmP& p) { return ((p.N + 127) / 128) * (p.M / 128) * p.batch; }
__device__ __forceinline__ void d_gemm(int vb, int tid, float* sm, const GemmP& p) {
    float (*As)[132] = (float (*)[132])sm;
    float (*Bs)[132] = (float (*)[132])(sm + 16 * 132);
    const int nbx = (p.N + 127) / 128, nby = p.M / 128;
    const int bx = vb % nbx, by = (vb / nbx) % nby, bz = vb / (nbx * nby);
    const int tx = tid & 15, ty = tid >> 4;
    const int m0 = by * 128, n0 = bx * 128;
    const float* A = p.A + (size_t)bz * p.sA;
    const float* W = p.W + (size_t)bz * p.sW;
    float* C = p.C + (size_t)bz * p.sC;
    float acc[8][8];
#pragma unroll
    for (int i = 0; i < 8; ++i)
#pragma unroll
        for (int j = 0; j < 8; ++j) acc[i][j] = 0.f;
    for (int k0 = 0; k0 < p.K; k0 += 16) {
        __syncthreads();
#pragma unroll
        for (int r = 0; r < 2; ++r) {
            const int idx = tid + r * 256;
            const int row = idx >> 2, kq = idx & 3;
            const float4 v = *(const float4*)(A + (size_t)(m0 + row) * p.lda + k0 + kq * 4);
            As[kq * 4 + 0][row] = v.x; As[kq * 4 + 1][row] = v.y; As[kq * 4 + 2][row] = v.z; As[kq * 4 + 3][row] = v.w;
        }
#pragma unroll
        for (int r = 0; r < 2; ++r) {
            const int idx = tid + r * 256;
            const int kr = idx >> 5, c4 = idx & 31;
            const int col = n0 + c4 * 4;
            float4 v = make_float4(0.f, 0.f, 0.f, 0.f);
            if (col < p.N) v = *(const float4*)(W + (size_t)(k0 + kr) * p.ldw + col);
            *(float4*)&Bs[kr][c4 * 4] = v;
        }
        __syncthreads();
#pragma unroll 2
        for (int k = 0; k < 16; ++k) {
            float a[8], b[8];
            const float4 a0 = *(const float4*)&As[k][ty * 8], a1 = *(const float4*)&As[k][ty * 8 + 4];
            const float4 b0 = *(const float4*)&Bs[k][tx * 8], b1 = *(const float4*)&Bs[k][tx * 8 + 4];
            a[0] = a0.x; a[1] = a0.y; a[2] = a0.z; a[3] = a0.w; a[4] = a1.x; a[5] = a1.y; a[6] = a1.z; a[7] = a1.w;
            b[0] = b0.x; b[1] = b0.y; b[2] = b0.z; b[3] = b0.w; b[4] = b1.x; b[5] = b1.y; b[6] = b1.z; b[7] = b1.w;
#pragma unroll
            for (int i = 0; i < 8; ++i)
#pragma unroll
                for (int j = 0; j < 8; ++j) acc[i][j] = fmaf(a[i], b[j], acc[i][j]);
        }
    }
#pragma unroll
    for (int i = 0; i < 8; ++i) {
        const int row = m0 + ty * 8 + i;
#pragma unroll
        for (int jq = 0; jq < 2; ++jq) {
            const int col = n0 + tx * 8 + jq * 4;
            if (col < p.N) {
                float4 v = make_float4(acc[i][jq * 4 + 0], acc[i][jq * 4 + 1], acc[i][jq * 4 + 2], acc[i][jq * 4 + 3]);
                if (p.R) {
                    const float4 r = *(const float4*)(p.R + (size_t)row * p.ldr + col);
                    v.x += r.x; v.y += r.y; v.z += r.z; v.w += r.w;
                }
                *(float4*)(C + (size_t)row * p.ldc + col) = v;
            }
        }
    }
}

__device__ __forceinline__ void d_conv_silu(int vb, int tid, const float* __restrict__ proj, const float* __restrict__ cw, const float* __restrict__ cb, float* __restrict__ c) {
    const int t = vb, s = t % S;
    for (int ch = tid; ch < 1024; ch += 256) {
        float y = cb[ch];
#pragma unroll
        for (int j = 0; j < 4; ++j) {
            const int ss = s - 3 + j;
            if (ss >= 0) y = fmaf(cw[j * 1024 + ch], proj[(size_t)(t - 3 + j) * INC + C_MIN + ch], y);
        }
        c[(size_t)t * 1024 + ch] = y / (1.0f + expf(-y));
    }
}

__device__ __forceinline__ void d_mlstm(int vb, int tid, const float* __restrict__ mq, const float* __restrict__ mk, const float* __restrict__ proj,
                                        const float* __restrict__ b_mi, const float* __restrict__ b_mf, float* __restrict__ hraw) {
    const int lane = tid & 63, w = tid >> 6;
    const int gid = vb * 4 + w;
    const int e = gid & 255, h = (gid >> 8) & 3, b = gid >> 10;
    const float bi = b_mi[h], bf = b_mf[h];
    float C0 = 0.f, C1 = 0.f, C2 = 0.f, C3 = 0.f, n0 = 0.f, n1 = 0.f, n2 = 0.f, n3 = 0.f, m = 0.f;
    const size_t tb = (size_t)b * S;
    const float* qp = mq + tb * 1024 + h * 256 + lane * 4;
    const float* kp = mk + tb * 1024 + h * 256 + lane * 4;
    const float* pp = proj + tb * INC;
    float4 qn = *(const float4*)qp, kn = *(const float4*)kp;
    float vn = pp[C_MV + h * 256 + e], in_ = pp[C_MI + h], fn = pp[C_MF + h];
    for (int s = 0; s < S; ++s) {
        const float4 q = qn, k = kn; const float v = vn, ipre = in_ + bi, fpre = fn + bf;
        if (s + 1 < S) {
            qn = *(const float4*)(qp + (size_t)(s + 1) * 1024);
            kn = *(const float4*)(kp + (size_t)(s + 1) * 1024);
            const float* pr = pp + (size_t)(s + 1) * INC;
            vn = pr[C_MV + h * 256 + e]; in_ = pr[C_MI + h]; fn = pr[C_MF + h];
        }
        const float logf = log_sigmoid(fpre);
        const float mnew = fmaxf(logf + m, ipre);
        const float fd = expf(logf + m - mnew), ig = expf(ipre - mnew);
        m = mnew;
        const float sc = ig * 0.0625f;
        C0 = fd * C0 + sc * k.x * v; C1 = fd * C1 + sc * k.y * v; C2 = fd * C2 + sc * k.z * v; C3 = fd * C3 + sc * k.w * v;
        n0 = fd * n0 + sc * k.x; n1 = fd * n1 + sc * k.y; n2 = fd * n2 + sc * k.z; n3 = fd * n3 + sc * k.w;
        float num = q.x * C0 + q.y * C1 + q.z * C2 + q.w * C3;
        float den = q.x * n0 + q.y * n1 + q.z * n2 + q.w * n3;
        num = wave_sum(num); den = wave_sum(den);
        if (lane == 0) hraw[(tb + s) * 1024 + h * 256 + e] = num / fmaxf(fabsf(den), expf(-mnew));
    }
}

__device__ __forceinline__ void d_mhead_norm(int vb, int tid, const float* __restrict__ hraw, const float* __restrict__ proj, const float* __restrict__ g, float* __restrict__ mix) {
    const int t = vb, h = tid >> 6, lane = tid & 63;
    const float4 v = *(const float4*)(hraw + (size_t)t * 1024 + h * 256 + lane * 4);
    float s = v.x * v.x + v.y * v.y + v.z * v.z + v.w * v.w;
    s = wave_sum(s);
    const float r = rsqrtf(s * (1.0f / 256.0f) + EPS);
    const float4 gg = *(const float4*)(g + h * 256 + lane * 4);
    const float* mo = proj + (size_t)t * INC + C_MO + h * 256 + lane * 4;
    float4 o;
    o.x = v.x * r * gg.x / (1.0f + expf(-mo[0]));
    o.y = v.y * r * gg.y / (1.0f + expf(-mo[1]));
    o.z = v.z * r * gg.z / (1.0f + expf(-mo[2]));
    o.w = v.w * r * gg.w / (1.0f + expf(-mo[3]));
    *(float4*)(mix + (size_t)t * D + h * 256 + lane * 4) = o;
}

__device__ __forceinline__ void d_rope(int vb, int tid, float* __restrict__ proj) {
    const int t = vb, s = t % S;
    for (int idx = tid; idx < 2 * 8 * 64; idx += 256) {
        const int i = idx & 63, hd = (idx >> 6) & 7, qk = idx >> 9;
        const float inv = exp2f(-(float)i * 0.20762050593046014f);
        const float ang = (float)s * inv;
        float sn, cs; sincosf(ang, &sn, &cs);
        float* p = proj + (size_t)t * INC + (qk ? C_AK : C_AQ) + hd * 128;
        const float x1 = p[i], x2 = p[64 + i];
        p[i] = x1 * cs - x2 * sn;
        p[64 + i] = x2 * cs + x1 * sn;
    }
}

__device__ __forceinline__ void d_dilated(int vb, int tid, float* sm, const float* __restrict__ proj, const float* __restrict__ g_ahead, float* __restrict__ mix) {
    float (*qs)[128] = (float (*)[128])sm;
    float (*ps)[576] = (float (*)[576])(sm + 512);
    const int lane = tid & 63, w = tid >> 6;
    const int gid = vb * 4 + w;
    const int s = gid % S, hd = (gid / S) & 7, b = gid / (S * 8);
    const size_t t = (size_t)b * S + s;
    const float* qrow = proj + t * INC + C_AQ + hd * 128;
    __syncthreads();
    qs[w][lane] = qrow[lane]; qs[w][lane + 64] = qrow[lane + 64];
    __syncthreads();
    const float scale = 0.08838834764831845f;
    float mloc = -INFINITY;
    for (int br = 0; br < 3; ++br) {
        const int dil = br == 0 ? 1 : (br == 1 ? 4 : 16);
        for (int jj = 0; jj < 192; jj += 64) {
            const int j = jj + lane;
            float sc = -INFINITY;
            if (j <= 128 && s - j * dil >= 0) {
                const float* krow = proj + (t - (size_t)j * dil) * INC + C_AK + hd * 128;
                float d = 0.f;
#pragma unroll 8
                for (int c = 0; c < 128; c += 4) {
                    const float4 kv = *(const float4*)(krow + c);
                    d = fmaf(qs[w][c], kv.x, d); d = fmaf(qs[w][c + 1], kv.y, d); d = fmaf(qs[w][c + 2], kv.z, d); d = fmaf(qs[w][c + 3], kv.w, d);
                }
                sc = d * scale;
            }
            ps[w][br * 192 + j] = sc;
            mloc = fmaxf(mloc, sc);
        }
    }
    const float mx = wave_max(mloc);
    __syncthreads();
    float lsum = 0.f;
    for (int i = lane; i < 3 * 192; i += 64) {
        const float sc = ps[w][i];
        const float pv = (sc == -INFINITY) ? 0.f : expf(sc - mx);
        ps[w][i] = pv; lsum += pv;
    }
    const float tot = wave_sum(lsum);
    __syncthreads();
    float o0 = 0.f, o1 = 0.f;
    for (int br = 0; br < 3; ++br) {
        const int dil = br == 0 ? 1 : (br == 1 ? 4 : 16);
        for (int j = 0; j <= 128; ++j) {
            if (s - j * dil < 0) break;
            const float pv = ps[w][br * 192 + j];
            const float* vrow = proj + (t - (size_t)j * dil) * INC + C_AV + hd * 128;
            o0 = fmaf(pv, vrow[lane], o0); o1 = fmaf(pv, vrow[lane + 64], o1);
        }
    }
    o0 /= tot; o1 /= tot;
    float ss = wave_sum(o0 * o0 + o1 * o1);
    const float r = rsqrtf(ss * (1.0f / 128.0f) + EPS);
    float* orow = mix + t * D + 1024 + hd * 128;
    orow[lane] = o0 * r * g_ahead[hd * 128 + lane];
    orow[lane + 64] = o1 * r * g_ahead[hd * 128 + lane + 64];
}

__device__ __forceinline__ void d_cross(int vb, int tid, float* sm, const float* __restrict__ q, const float* __restrict__ km, const float* __restrict__ vm, float* __restrict__ o) {
    float (*qs)[512] = (float (*)[512])sm;
    float (*ps)[256] = (float (*)[256])(sm + 2048);
    const int lane = tid & 63, w = tid >> 6;
    const int t = vb, hd = w, b = t / S;
    const float* qrow = q + (size_t)t * D + hd * 512;
    __syncthreads();
    for (int i = lane; i < 512; i += 64) qs[w][i] = qrow[i];
    __syncthreads();
    const float scale = 0.04419417382415922f;
    float sc[4]; float mloc = -INFINITY;
#pragma unroll
    for (int r = 0; r < 4; ++r) {
        const int mi = lane + 64 * r;
        const float* krow = km + ((size_t)b * 256 + mi) * D + hd * 512;
        float d = 0.f;
#pragma unroll 8
        for (int c = 0; c < 512; c += 4) {
            const float4 kv = *(const float4*)(krow + c);
            d = fmaf(qs[w][c], kv.x, d); d = fmaf(qs[w][c + 1], kv.y, d); d = fmaf(qs[w][c + 2], kv.z, d); d = fmaf(qs[w][c + 3], kv.w, d);
        }
        sc[r] = d * scale; mloc = fmaxf(mloc, sc[r]);
    }
    const float mx = wave_max(mloc);
    float lsum = 0.f;
#pragma unroll
    for (int r = 0; r < 4; ++r) { const float pv = expf(sc[r] - mx); ps[w][lane + 64 * r] = pv; lsum += pv; }
    const float tot = wave_sum(lsum);
    __syncthreads();
    float acc[8];
#pragma unroll
    for (int i = 0; i < 8; ++i) acc[i] = 0.f;
    for (int mi = 0; mi < 256; ++mi) {
        const float pv = ps[w][mi];
        const float* vrow = vm + ((size_t)b * 256 + mi) * D + hd * 512;
#pragma unroll
        for (int i = 0; i < 8; ++i) acc[i] = fmaf(pv, vrow[lane + 64 * i], acc[i]);
    }
    float* orow = o + (size_t)t * D + hd * 512;
#pragma unroll
    for (int i = 0; i < 8; ++i) orow[lane + 64 * i] = acc[i] / tot;
}

__device__ __forceinline__ void wave_argmax(float& best, int& bidx) {
#pragma unroll
    for (int o = 32; o >= 1; o >>= 1) {
        const float ob = __shfl_xor(best, o); const int oi = __shfl_xor(bidx, o);
        if (ob > best || (ob == best && oi < bidx)) { best = ob; bidx = oi; }
    }
}
__device__ __forceinline__ void d_peer_topk(int vb, int tid, float* sm, const float* __restrict__ qp, const float* __restrict__ sub_keys, int* __restrict__ ids, float* __restrict__ gates) {
    float (*qs)[256] = (float (*)[256])sm;
    const int lane = tid & 63, w = tid >> 6;
    const int gid = vb * 4 + w;
    const int hd = gid & 7, t = gid >> 3;
    const float* qrow = qp + (size_t)t * D + hd * 256;
    __syncthreads();
    for (int i = lane; i < 256; i += 64) qs[w][i] = qrow[i];
    __syncthreads();
    float tops[2]; int topi[2];
#pragma unroll
    for (int p = 0; p < 2; ++p) {
        float v0, v1;
        {
            const float* k0 = sub_keys + ((size_t)(hd * 2 + p) * 128 + lane) * 128;
            const float* k1 = k0 + 64 * 128;
            float d0 = 0.f, d1 = 0.f;
#pragma unroll 8
            for (int c = 0; c < 128; c += 4) {
                const float4 a = *(const float4*)(k0 + c), bb = *(const float4*)(k1 + c);
                const float q0 = qs[w][p * 128 + c], q1 = qs[w][p * 128 + c + 1], q2 = qs[w][p * 128 + c + 2], q3 = qs[w][p * 128 + c + 3];
                d0 = fmaf(q0, a.x, d0); d0 = fmaf(q1, a.y, d0); d0 = fmaf(q2, a.z, d0); d0 = fmaf(q3, a.w, d0);
                d1 = fmaf(q0, bb.x, d1); d1 = fmaf(q1, bb.y, d1); d1 = fmaf(q2, bb.z, d1); d1 = fmaf(q3, bb.w, d1);
            }
            v0 = d0; v1 = d1;
        }
        float ts = 0.f; int ti = 0;
        for (int it = 0; it < 16; ++it) {
            float best; int bidx;
            if (v0 >= v1) { best = v0; bidx = lane; } else { best = v1; bidx = lane + 64; }
            wave_argmax(best, bidx);
            if (lane == it) { ts = best; ti = bidx; }
            if (bidx == lane) v0 = -INFINITY;
            if (bidx == lane + 64) v1 = -INFINITY;
        }
        tops[p] = ts; topi[p] = ti;
    }
    float cv[4]; int ci[4];
#pragma unroll
    for (int r = 0; r < 4; ++r) {
        const int c = lane * 4 + r, i = c >> 4, j = c & 15;
        const float s0 = __shfl(tops[0], i), s1 = __shfl(tops[1], j);
        const int i0 = __shfl(topi[0], i), i1 = __shfl(topi[1], j);
        cv[r] = s0 + s1; ci[r] = i0 * 128 + i1;
    }
    float bs = 0.f; int bid = 0;
    for (int it = 0; it < 16; ++it) {
        float best = cv[0]; int bidx = lane * 4;
#pragma unroll
        for (int r = 1; r < 4; ++r) if (cv[r] > best) { best = cv[r]; bidx = lane * 4 + r; }
        wave_argmax(best, bidx);
        const int owner = bidx >> 2, rr = bidx & 3;
        int myid = ci[0];
        if (rr == 1) myid = ci[1]; else if (rr == 2) myid = ci[2]; else if (rr == 3) myid = ci[3];
        const int eid = __shfl(myid, owner);
        if (lane == it) { bs = best; bid = eid; }
        if (owner == lane) {
#pragma unroll
            for (int r = 0; r < 4; ++r) if (rr == r) cv[r] = -INFINITY;
        }
    }
    float v = lane < 16 ? bs : -INFINITY;
    const float mx = wave_max(v);
    const float ev = lane < 16 ? expf(bs - mx) : 0.f;
    const float tot = wave_sum(ev);
    if (lane < 16) {
        ids[(size_t)t * 128 + hd * 16 + lane] = bid;
        gates[(size_t)t * 128 + hd * 16 + lane] = ev / tot;
    }
}

__device__ __forceinline__ void d_peer_out(int vb, int tid, float* sm, const float* __restrict__ h3, const float* __restrict__ x2, const int* __restrict__ ids, const float* __restrict__ gates,
                                           const float* __restrict__ u_tab, const float* __restrict__ v_tab, const float* __restrict__ g_final, float* __restrict__ out) {
    float (*part)[2048] = (float (*)[2048])sm;
    float* red = sm + 4 * 2048;
    const int lane = tid & 63, w = tid >> 6, t = vb;
    float4 xr[8], acc[8];
    const float* hrow = h3 + (size_t)t * D;
#pragma unroll
    for (int i = 0; i < 8; ++i) { xr[i] = *(const float4*)(hrow + i * 256 + lane * 4); acc[i] = make_float4(0.f, 0.f, 0.f, 0.f); }
    for (int j = 0; j < 32; ++j) {
        const int slot = w * 32 + j;
        const int e = ids[(size_t)t * 128 + slot];
        const float gt = gates[(size_t)t * 128 + slot];
        const float* ur = u_tab + (size_t)e * D;
        const float* vr = v_tab + (size_t)e * D;
        float d = 0.f;
#pragma unroll
        for (int i = 0; i < 8; ++i) {
            const float4 u = *(const float4*)(ur + i * 256 + lane * 4);
            d = fmaf(xr[i].x, u.x, d); d = fmaf(xr[i].y, u.y, d); d = fmaf(xr[i].z, u.z, d); d = fmaf(xr[i].w, u.w, d);
        }
        d = wave_sum(d);
        const float act = 0.5f * d * (1.0f + erff(d * 0.7071067811865476f));
        const float cf = gt * act;
#pragma unroll
        for (int i = 0; i < 8; ++i) {
            const float4 v = *(const float4*)(vr + i * 256 + lane * 4);
            acc[i].x = fmaf(cf, v.x, acc[i].x); acc[i].y = fmaf(cf, v.y, acc[i].y); acc[i].z = fmaf(cf, v.z, acc[i].z); acc[i].w = fmaf(cf, v.w, acc[i].w);
        }
    }
    __syncthreads();
#pragma unroll
    for (int i = 0; i < 8; ++i) *(float4*)&part[w][i * 256 + lane * 4] = acc[i];
    __syncthreads();
    float4 r0, r1;
    {
        const float4 a = *(const float4*)&part[0][tid * 4], b = *(const float4*)&part[1][tid * 4], c = *(const float4*)&part[2][tid * 4], d = *(const float4*)&part[3][tid * 4];
        const float4 x = *(const float4*)(x2 + (size_t)t * D + tid * 4);
        r0 = make_float4(x.x + a.x + b.x + c.x + d.x, x.y + a.y + b.y + c.y + d.y, x.z + a.z + b.z + c.z + d.z, x.w + a.w + b.w + c.w + d.w);
    }
    {
        const float4 a = *(const float4*)&part[0][1024 + tid * 4], b = *(const float4*)&part[1][1024 + tid * 4], c = *(const float4*)&part[2][1024 + tid * 4], d = *(const float4*)&part[3][1024 + tid * 4];
        const float4 x = *(const float4*)(x2 + (size_t)t * D + 1024 + tid * 4);
        r1 = make_float4(x.x + a.x + b.x + c.x + d.x, x.y + a.y + b.y + c.y + d.y, x.z + a.z + b.z + c.z + d.z, x.w + a.w + b.w + c.w + d.w);
    }
    float s = r0.x * r0.x + r0.y * r0.y + r0.z * r0.z + r0.w * r0.w + r1.x * r1.x + r1.y * r1.y + r1.z * r1.z + r1.w * r1.w;
    s = wave_sum(s);
    if (lane == 0) red[w] = s;
    __syncthreads();
    const float tot = red[0] + red[1] + red[2] + red[3];
    const float r = rsqrtf(tot * (1.0f / D) + EPS);
    const float4 g0 = *(const float4*)(g_final + tid * 4), g1 = *(const float4*)(g_final + 1024 + tid * 4);
    *(float4*)(out + (size_t)t * D + tid * 4) = make_float4(r0.x * r * g0.x, r0.y * r * g0.y, r0.z * r * g0.z, r0.w * r * g0.w);
    *(float4*)(out + (size_t)t * D + 1024 + tid * 4) = make_float4(r1.x * r * g1.x, r1.y * r * g1.y, r1.z * r * g1.z, r1.w * r * g1.w);
}

struct Params {
    const float *x, *mem, *g_mix, *w_in, *conv_w, *conv_b, *w_mq, *w_mk, *b_mi, *b_mf, *g_mhead, *g_ahead, *w_out, *g_cross, *g_mem,
                *w_xq, *w_xk, *w_xv, *w_xo, *g_ffn, *w_pq, *sub_keys, *u_tab, *v_tab, *g_final;
    float* out;
    unsigned* bar;
    float* ws;
};

__device__ __forceinline__ GemmP mk_gemm(const float* A, int lda, long sA, const float* W, int ldw, long sW, float* C, int ldc, long sC, const float* R, int ldr, int M, int N, int K, int batch) {
    GemmP p; p.A = A; p.lda = lda; p.sA = sA; p.W = W; p.ldw = ldw; p.sW = sW; p.C = C; p.ldc = ldc; p.sC = sC; p.R = R; p.ldr = ldr; p.M = M; p.N = N; p.K = K; p.batch = batch;
    return p;
}

#define PHASE_LOOP(nvb) for (int base_ = blockIdx.x * 2; base_ < (nvb); base_ += gridDim.x * 2)
#define VB (base_ + half)

__global__ void __launch_bounds__(NTHR) mega(Params P) {
    extern __shared__ __attribute__((aligned(16))) unsigned char smem_raw[];
    float* smf = (float*)smem_raw;
    const int half = threadIdx.x >> 8, tid = threadIdx.x & 255;
    float* sm = smf + half * HALF_SM_FLOATS;
    volatile LAS unsigned* st = (volatile LAS unsigned*)(LAS unsigned char*)(smem_raw + 2 * HALF_SM_FLOATS * 4);
    if (threadIdx.x == 0) { st[0] = 0u; st[1] = 0u; st[2] = 0u; st[3] = 0u; }
    __syncthreads();
    XcdBarrier xb = xcd_barrier_post(P.bar, st);

    float* ws = P.ws;
    const size_t TD = (size_t)T * D;
    float* proj = ws;
    float* hbuf = proj + (size_t)T * INC;
    float* cbuf = hbuf + TD;
    float* mq = cbuf + (size_t)T * 1024;
    float* mk = mq + (size_t)T * 1024;
    float* mix = mk + (size_t)T * 1024;
    float* hraw = hbuf;
    float* x1 = proj;
    float* x2 = proj + TD;
    float* mn = proj + 2 * TD;
    float* km = mn + (size_t)512 * D;
    float* vm = km + (size_t)512 * D;
    float* gates = vm + (size_t)512 * D;
    int* ids = (int*)(gates + (size_t)T * 128);
    float* qx = cbuf;
    float* obuf = mix;

#pragma nounroll
    for (int ph = 0; ph < 15; ++ph) {
        int j0 = 0, j1 = 0;
        switch (ph) {
            case 1: j0 = 0; j1 = 1; break;
            case 3: j0 = 1; j1 = 3; break;
            case 6: j0 = 3; j1 = 4; break;
            case 8: j0 = 4; j1 = 7; break;
            case 10: j0 = 7; j1 = 8; break;
            case 12: j0 = 8; j1 = 9; break;
            default: break;
        }
#pragma nounroll
        for (int j = j0; j < j1; ++j) {
            GemmP g;
            switch (j) {
                case 0: g = mk_gemm(hbuf, D, 0, P.w_in, INC, 0, proj, INC, 0, nullptr, 0, T, INC, D, 1); break;
                case 1: g = mk_gemm(cbuf, 1024, 256, P.w_mq, 256, 65536, mq, 1024, 256, nullptr, 0, T, 256, 256, 4); break;
                case 2: g = mk_gemm(cbuf, 1024, 256, P.w_mk, 256, 65536, mk, 1024, 256, nullptr, 0, T, 256, 256, 4); break;
                case 3: g = mk_gemm(mix, D, 0, P.w_out, D, 0, x1, D, 0, P.x, D, T, D, D, 1); break;
                case 4: g = mk_gemm(hbuf, D, 0, P.w_xq, D, 0, qx, D, 0, nullptr, 0, T, D, D, 1); break;
                case 5: g = mk_gemm(mn, D, 0, P.w_xk, D, 0, km, D, 0, nullptr, 0, 512, D, D, 1); break;
                case 6: g = mk_gemm(mn, D, 0, P.w_xv, D, 0, vm, D, 0, nullptr, 0, 512, D, D, 1); break;
                case 7: g = mk_gemm(obuf, D, 0, P.w_xo, D, 0, x2, D, 0, x1, D, T, D, D, 1); break;
                default: g = mk_gemm(hbuf, D, 0, P.w_pq, D, 0, qx, D, 0, nullptr, 0, T, D, D, 1); break;
            }
            const int nvb = gemm_nvb(g);
#pragma nounroll
            PHASE_LOOP(nvb) d_gemm(VB, tid, sm, g);
        }
        {
            const float* rin = nullptr; const float* rg = nullptr; float* rout = nullptr; int rows = 0, nj = 0;
            if (ph == 0) { nj = 1; } else if (ph == 7) { nj = 2; } else if (ph == 11) { nj = 1; }
#pragma nounroll
            for (int j = 0; j < nj; ++j) {
                if (ph == 0) { rin = P.x; rg = P.g_mix; rout = hbuf; rows = T; }
                else if (ph == 7 && j == 0) { rin = x1; rg = P.g_cross; rout = hbuf; rows = T; }
                else if (ph == 7) { rin = P.mem; rg = P.g_mem; rout = mn; rows = 512; }
                else { rin = x2; rg = P.g_ffn; rout = hbuf; rows = T; }
#pragma nounroll
                PHASE_LOOP(rows) d_rmsnorm(VB, tid, sm, rin, rg, rout);
            }
        }
        if (ph == 2) {
#pragma nounroll
            PHASE_LOOP(T) d_conv_silu(VB, tid, proj, P.conv_w, P.conv_b, cbuf);
#pragma nounroll
            PHASE_LOOP(T) d_rope(VB, tid, proj);
        } else if (ph == 3) {
#pragma nounroll
            PHASE_LOOP(NB * 8 * S / 4) d_dilated(VB, tid, sm, proj, P.g_ahead, mix);
        } else if (ph == 4) {
#pragma nounroll
            PHASE_LOOP(NB * 4 * 256 / 4) d_mlstm(VB, tid, mq, mk, proj, P.b_mi, P.b_mf, hraw);
        } else if (ph == 5) {
#pragma nounroll
            PHASE_LOOP(T) d_mhead_norm(VB, tid, hraw, proj, P.g_mhead, mix);
        } else if (ph == 9) {
#pragma nounroll
            PHASE_LOOP(T) d_cross(VB, tid, sm, qx, km, vm, obuf);
        } else if (ph == 13) {
#pragma nounroll
            PHASE_LOOP(T * 8 / 4) d_peer_topk(VB, tid, sm, qx, P.sub_keys, ids, gates);
        } else if (ph == 14) {
#pragma nounroll
            PHASE_LOOP(T) d_peer_out(VB, tid, sm, hbuf, x2, ids, gates, P.u_tab, P.v_tab, P.g_final, P.out);
        }
        if (ph < 14) xcd_barrier(xb);
    }
}
}

extern "C" void kernel_launch(void* const* d_in, const int* in_sizes, int n_in, void* d_out, int out_size, void* d_ws, size_t ws_size, hipStream_t stream) {
    static int grid_blocks = 0;
    if (!grid_blocks) {
        int dev = 0, cus = 0, per_cu = 0;
        hipGetDevice(&dev);
        hipDeviceGetAttribute(&cus, hipDeviceAttributeMultiprocessorCount, dev);
        hipFuncSetAttribute((const void*)mega, hipFuncAttributeMaxDynamicSharedMemorySize, SMEM_BYTES);
        hipOccupancyMaxActiveBlocksPerMultiprocessor(&per_cu, mega, NTHR, SMEM_BYTES);
        if (per_cu > 1) per_cu = 1;
        if (per_cu < 1) per_cu = 1;
        grid_blocks = cus * per_cu;
    }
    Params P{};
    const float** pp = (const float**)&P;
    for (int i = 0; i < 25; ++i) pp[i] = (const float*)d_in[i];
    P.out = (float*)d_out;
    P.bar = (unsigned*)d_ws;
    P.ws = (float*)((char*)d_ws + 16384);
    hipMemsetAsync(d_ws, 0, 16384, stream);
    void* args[] = {&P};
    hipError_t e = hipLaunchCooperativeKernel((const void*)mega, dim3(grid_blocks), dim3(NTHR), args, SMEM_BYTES, stream);
    if (e != hipSuccess) fprintf(stderr, "cooperative launch failed: %s (grid %d)\n", hipGetErrorString(e), grid_blocks);
}
```

```cpp
#include <hip/hip_runtime.h>
#include <stdint.h>
#include <math.h>
#include <cstdio>

#define LAS_ __attribute__((address_space(3)))
namespace {
constexpr int D = 2048, NB = 2, S = 4096, T = NB * S;
constexpr int INC = 6152;
constexpr int C_MIN = 0, C_MV = 1024, C_MO = 2048, C_MI = 3072, C_MF = 3076, C_AQ = 3080, C_AK = 4104, C_AV = 5128;
constexpr float EPS = 1e-6f;
constexpr int NTHR = 512;
constexpr int HALF_SM_FLOATS = 8704;
constexpr int GEMM_LDS = 131072;
constexpr int SMEM_BYTES = GEMM_LDS + 64 + 256;
typedef unsigned short bf16_t;
__device__ __forceinline__ unsigned f2bf(float f) { unsigned u = __float_as_uint(f); u += 0x7FFFu + ((u >> 16) & 1u); return u >> 16; }
__device__ __forceinline__ unsigned pk2(float lo, float hi) { return f2bf(lo) | (f2bf(hi) << 16); }
__device__ __forceinline__ float bf2f(unsigned short b) { return __uint_as_float(((unsigned)b) << 16); }
extern __shared__ __attribute__((aligned(16))) unsigned char smem_raw[];
enum { I_X = 0, I_MEM, I_GMIX, I_WIN, I_CONVW, I_CONVB, I_WMQ, I_WMK, I_BMI, I_BMF, I_GMHEAD, I_GAHEAD, I_WOUT, I_GCROSS, I_GMEM,
       I_WXQ, I_WXK, I_WXV, I_WXO, I_GFFN, I_WPQ, I_SUBK, I_UTAB, I_VTAB, I_GFINAL, I_OUT, I_BAR, I_WS, I_NPTR };
__device__ __forceinline__ unsigned long long ldp_raw(int i) {
    const LAS_ unsigned long long* tab = (const LAS_ unsigned long long*)(LAS_ unsigned char*)(smem_raw + GEMM_LDS + 64);
    const unsigned long long v = tab[i];
    const unsigned lo = __builtin_amdgcn_readfirstlane((unsigned)v), hi = __builtin_amdgcn_readfirstlane((unsigned)(v >> 32));
    return ((unsigned long long)hi << 32) | lo;
}
#define PF(i) ((const float*)ldp_raw(i))

#define XB_TMO      128
#define XB_XCNT(j)  (256  + 64 * (j))
#define XB_XSUB(j)  (1280 + 64 * (j))
#define XB_XGEN(j)  (2304 + 64 * (j))
#define XB_TOP      3328
#define XB_TOPGEN   3392
#define XCD_BAR_WORDS 3456
#define XB_SPIN_CAP (1u << 22)
#define LAS __attribute__((address_space(3)))

__device__ __forceinline__ unsigned xb_ld(unsigned* p)              { return __hip_atomic_load(p, __ATOMIC_RELAXED, __HIP_MEMORY_SCOPE_AGENT); }
__device__ __forceinline__ unsigned xb_add(unsigned* p, unsigned v) { return __hip_atomic_fetch_add(p, v, __ATOMIC_RELAXED, __HIP_MEMORY_SCOPE_AGENT); }
__device__ __forceinline__ unsigned xb_xcc_id() { return (unsigned)__builtin_amdgcn_s_getreg((3 << 11) | 20) & 0xFu; }
#define XB_SPIN(cond, bar) do { unsigned _sp = 0; while (cond) { __builtin_amdgcn_s_sleep(1); \
    if ((++_sp & 255u) == 0u) { if (xb_ld(&(bar)[XB_TMO])) break; if (_sp > XB_SPIN_CAP) { atomicAdd(&(bar)[XB_TMO], 1u); break; } } } } while (0)

struct XcdBarrier { unsigned* bar; unsigned x; volatile LAS unsigned* st; };

__device__ __forceinline__ XcdBarrier xcd_barrier_post(unsigned* bar, volatile LAS unsigned* st) {
    XcdBarrier b; b.bar = bar; b.x = xb_xcc_id(); b.st = st;
    if (threadIdx.x == 0) (void)xb_add(&bar[XB_XCNT(b.x)], 1u);
    return b;
}
__device__ __forceinline__ void xcd_barrier_complete(unsigned* bar, unsigned x, unsigned& nloc, unsigned& nx) {
    const unsigned G = gridDim.x * gridDim.y * gridDim.z;
    unsigned sum, cnt, mine, sp = 0u;
    for (;;) {
        sum = 0u; cnt = 0u; mine = 0u;
#pragma unroll
        for (unsigned j = 0; j < 16; ++j) { const unsigned c = xb_ld(&bar[XB_XCNT(j)]); sum += c; cnt += (c > 0u) ? 1u : 0u; mine = (j == x) ? c : mine; }
        if (sum == G) break;
        __builtin_amdgcn_s_sleep(1);
        if ((++sp & 255u) == 0u) { if (xb_ld(&bar[XB_TMO])) break; if (sp > XB_SPIN_CAP) { atomicAdd(&bar[XB_TMO], 1u); break; } }
    }
    nloc = mine > 0u ? mine : 1u; nx = cnt > 0u ? cnt : 1u;
}
__device__ __forceinline__ void xcd_barrier(const XcdBarrier& b) {
    asm volatile("s_waitcnt vmcnt(0)" ::: "memory");
    __syncthreads();
    if (threadIdx.x == 0) {
        unsigned* bar = b.bar;
        __builtin_amdgcn_s_waitcnt(0);
        unsigned nloc = b.st[0], nx = b.st[1];
        if (nloc == 0u) { xcd_barrier_complete(bar, b.x, nloc, nx); b.st[0] = nloc; b.st[1] = nx; }
        const unsigned old = xb_add(&bar[XB_XSUB(b.x)], 1u);
        const unsigned gen = old / nloc;
        if (old + 1u == (gen + 1u) * nloc) {
            __builtin_amdgcn_fence(__ATOMIC_RELEASE, "agent");
            asm volatile("s_waitcnt vmcnt(0)" ::: "memory");
            const unsigned og = xb_add(&bar[XB_TOP], 1u);
            const unsigned tg = og / nx;
            if (og + 1u == (tg + 1u) * nx) xb_add(&bar[XB_TOPGEN], 1u);
            else XB_SPIN(xb_ld(&bar[XB_TOPGEN]) == tg, bar);
            __builtin_amdgcn_fence(__ATOMIC_ACQUIRE, "agent");
            xb_add(&bar[XB_XGEN(b.x)], 1u);
            asm volatile("s_waitcnt vmcnt(0)" ::: "memory");
        } else {
            XB_SPIN(xb_ld(&bar[XB_XGEN(b.x)]) == gen, bar);
            __builtin_amdgcn_fence(__ATOMIC_ACQUIRE, "agent");
            asm volatile("s_waitcnt vmcnt(0)" ::: "memory");
        }
    }
    __syncthreads();
}

__device__ __forceinline__ float wave_sum(float v) {
#pragma unroll
    for (int o = 32; o >= 1; o >>= 1) v += __shfl_xor(v, o);
    return v;
}
__device__ __forceinline__ float wave_max(float v) {
#pragma unroll
    for (int o = 32; o >= 1; o >>= 1) v = fmaxf(v, __shfl_xor(v, o));
    return v;
}
__device__ __forceinline__ float log_sigmoid(float x) { return fminf(x, 0.f) - log1pf(expf(-fabsf(x))); }


__device__ __forceinline__ void d_rmsnorm(int vb, int t, float* sm, const float* __restrict__ in, const float* __restrict__ g, bf16_t* __restrict__ out,
                                          const float* __restrict__ w_in, float* __restrict__ gpre) {
    float* red = sm;
    const int row = vb;
    const float4* p = (const float4*)(in + (size_t)row * D);
    float4 a = p[t], b = p[t + 256];
    float s = a.x * a.x + a.y * a.y + a.z * a.z + a.w * a.w + b.x * b.x + b.y * b.y + b.z * b.z + b.w * b.w;
    s = wave_sum(s);
    __syncthreads();
    if ((t & 63) == 0) red[t >> 6] = s;
    __syncthreads();
    const float tot = red[0] + red[1] + red[2] + red[3];
    const float r = rsqrtf(tot * (1.0f / D) + EPS);
    const float4* gp = (const float4*)g;
    float4 ga = gp[t], gb = gp[t + 256];
    float hv[8] = {a.x * r * ga.x, a.y * r * ga.y, a.z * r * ga.z, a.w * r * ga.w, b.x * r * gb.x, b.y * r * gb.y, b.z * r * gb.z, b.w * r * gb.w};
    uint2 o0, o1;
    o0.x = pk2(hv[0], hv[1]); o0.y = pk2(hv[2], hv[3]); o1.x = pk2(hv[4], hv[5]); o1.y = pk2(hv[6], hv[7]);
    *(uint2*)(out + (size_t)row * D + t * 4) = o0;
    *(uint2*)(out + (size_t)row * D + 1024 + t * 4) = o1;
    if (gpre) {
        float gs[8];
#pragma unroll
        for (int c = 0; c < 8; ++c) gs[c] = 0.f;
#pragma unroll
        for (int j = 0; j < 8; ++j) {
            const int k = (j < 4) ? (t * 4 + j) : (1024 + t * 4 + (j - 4));
            const float4 w0 = *(const float4*)(w_in + (size_t)k * INC + C_MI), w1 = *(const float4*)(w_in + (size_t)k * INC + C_MI + 4);
            gs[0] = fmaf(hv[j], w0.x, gs[0]); gs[1] = fmaf(hv[j], w0.y, gs[1]); gs[2] = fmaf(hv[j], w0.z, gs[2]); gs[3] = fmaf(hv[j], w0.w, gs[3]);
            gs[4] = fmaf(hv[j], w1.x, gs[4]); gs[5] = fmaf(hv[j], w1.y, gs[5]); gs[6] = fmaf(hv[j], w1.z, gs[6]); gs[7] = fmaf(hv[j], w1.w, gs[7]);
        }
#pragma unroll
        for (int c = 0; c < 8; ++c) gs[c] = wave_sum(gs[c]);
        __syncthreads();
        if ((t & 63) == 0) {
#pragma unroll
            for (int c = 0; c < 8; ++c) red[8 + (t >> 6) * 8 + c] = gs[c];
        }
        __syncthreads();
        if (t < 8) gpre[(size_t)row * 8 + t] = red[8 + t] + red[16 + t] + red[24 + t] + red[32 + t];
    }
}

namespace pg8 {
typedef short bf16x8 __attribute__((ext_vector_type(8)));
typedef float f32x4 __attribute__((ext_vector_type(4)));
constexpr int BM = 256, BK = 64, HALF = 128, HTB = HALF * BK * 2, NXCD = 8, WGM = 8;
__device__ __forceinline__ int lds_byte(int r, int c) { const int st = (r >> 4) * 2 + (c >> 5), rr = r & 15, cc = c & 31, ob = rr * 64 + cc * 2; return st * 1024 + (ob ^ (((ob >> 9) & 1) << 5)); }
__device__ __forceinline__ void stage_rc(int b, int& R, int& C) { const int st = b / 1024, sb = b % 1024, swz = sb ^ (((sb >> 9) & 1) << 5); R = (st >> 1) * 16 + swz / 64; C = (st & 1) * 32 + (swz % 64) / 2; }
struct Unit { int pm, pn; };
struct GJob {
    const bf16_t* A; const bf16_t* Bt;
    int lda, ldb, K, nM, nN;
    int a_pn_mask, a_pn_step;
    float* C; int ldc; const float* R; int ldr;
    int mode;
};
__device__ __forceinline__ bool unit_next(const GJob& g, int i, Unit& u) {
    const int nwg = g.nM * g.nN;
    const long L = (long)i * gridDim.x + blockIdx.x; if (L >= nwg) return false;
    int wgid = (int)L; { const int q = nwg / NXCD, r = nwg % NXCD, xcd = wgid % NXCD, off = wgid / NXCD; wgid = (xcd < r ? xcd * (q + 1) : r * (q + 1) + (xcd - r) * q) + off; }
    const int nig = WGM * g.nN, gid = wgid / nig, fm = gid * WGM, gsz = (g.nM - fm) < WGM ? (g.nM - fm) : WGM;
    u.pm = fm + ((wgid % nig) % gsz); u.pn = (wgid % nig) / gsz; return true;
}
__device__ __forceinline__ void epilogue(const GJob& g, const f32x4 (&acc)[2][2][4][2], const Unit& u, int wr, int wc, int fr, int fq) {
    float* C = g.C; int ccol = u.pn * BM;
    if (g.mode == 1) { if (u.pn >= 12) ccol += 8; }
    else if (g.mode == 2) { C += (size_t)(u.pn >> 2) * ((size_t)T * 1024); ccol = (u.pn & 3) * 256; }
    const int row0 = u.pm * BM + wr * 64 + fr, col0 = ccol + wc * 32 + 4 * fq;
#pragma unroll
    for (int ai = 0; ai < 2; ++ai)
#pragma unroll
        for (int m = 0; m < 4; ++m) {
            const int row = row0 + ai * HALF + m * 16;
            float* rowp = C + (size_t)row * g.ldc + col0;
            const float* rp = g.R ? g.R + (size_t)row * g.ldr + col0 : nullptr;
#pragma unroll
            for (int bj = 0; bj < 2; ++bj)
#pragma unroll
                for (int n = 0; n < 2; ++n) {
                    f32x4 v = acc[ai][bj][m][n];
                    if (rp) v = v + *(const f32x4*)(rp + bj * HALF + n * 16);
                    *(f32x4*)(rowp + bj * HALF + n * 16) = v;
                }
        }
}
__device__ __forceinline__ void gemm_phase(LAS unsigned char* lds, const GJob& g) {
    const int tid = threadIdx.x, wid = __builtin_amdgcn_readfirstlane(tid >> 6), lane = tid & 63, wr = wid >> 2, wc = wid & 3, fr = lane & 15, fq = lane >> 4;
    const int K = g.K, nt = K / BK;
    unsigned voffA[2], voffB[2];
#pragma unroll
    for (int i = 0; i < 2; ++i) { int R, C; stage_rc(tid * 16 + i * 8192, R, C);
        voffA[i] = (unsigned)(R * g.lda + C) * 2u; voffB[i] = (unsigned)(R * g.ldb + C) * 2u; }
    const size_t kstep = (size_t)(BK * 2);
    const size_t hstepA = (size_t)HALF * g.lda * 2, hstepB = (size_t)HALF * g.ldb * 2;
    const unsigned ldsw = (unsigned)wid * 1024u;
    const int aoff = lds_byte(wr * 64 + fr, fq * 8), boff = lds_byte(wc * 32 + fr, fq * 8);
#define PG8_SA(b, h) (((b) * 2 + (h)) * HTB)
#define PG8_SB(b, h) ((4 + (b) * 2 + (h)) * HTB)
#define PG8_STAGE(bufoff, gbase, voff) do { _Pragma("unroll") for (int _i = 0; _i < 2; ++_i) \
        __builtin_amdgcn_global_load_lds((const unsigned*)((const char*)(gbase) + (voff)[_i]), (LAS unsigned*)(lds + (bufoff) + ldsw + _i * 8192), 16, 0, 0); } while (0)
#define PG8_LDA(dst, b, h) do { _Pragma("unroll") for (int m = 0; m < 4; ++m) _Pragma("unroll") for (int k = 0; k < 2; ++k) dst[m][k] = *(const LAS bf16x8*)(lds + PG8_SA(b, h) + aoff + m * 2048 + k * 1024); } while (0)
#define PG8_LDB(dst, b, h) do { _Pragma("unroll") for (int n = 0; n < 2; ++n) _Pragma("unroll") for (int k = 0; k < 2; ++k) dst[n][k] = *(const LAS bf16x8*)(lds + PG8_SB(b, h) + boff + n * 2048 + k * 1024); } while (0)
#define PG8_MMA(ai, bj, At, Bt) do { __builtin_amdgcn_s_setprio(1); _Pragma("unroll") for (int m = 0; m < 4; ++m) _Pragma("unroll") for (int n = 0; n < 2; ++n) _Pragma("unroll") for (int k = 0; k < 2; ++k) \
        acc[ai][bj][m][n] = __builtin_amdgcn_mfma_f32_16x16x32_bf16(Bt[n][k], At[m][k], acc[ai][bj][m][n], 0, 0, 0); __builtin_amdgcn_s_setprio(0); } while (0)
#define PG8_WAIT_V(n) asm volatile("s_waitcnt vmcnt(" #n ")" ::: "memory")
#define PG8_WAIT_L(n) asm volatile("s_waitcnt lgkmcnt(" #n ")" ::: "memory")
#define PG8_BAR __builtin_amdgcn_s_barrier()
#define PG8_SCHED __builtin_amdgcn_sched_barrier(0)
#define PG8_ABASE(u) ((const char*)g.A + ((size_t)(u).pm * BM * g.lda + (size_t)((u).pn & g.a_pn_mask) * g.a_pn_step) * 2)
#define PG8_BBASE(u) ((const char*)g.Bt + (size_t)(u).pn * BM * g.ldb * 2)
    Unit cur, nxt; int ui = 0;
    if (!unit_next(g, 0, cur)) return;
    f32x4 acc[2][2][4][2];
#pragma unroll
    for (int a = 0; a < 2; ++a)
#pragma unroll
        for (int b = 0; b < 2; ++b)
#pragma unroll
            for (int m = 0; m < 4; ++m)
#pragma unroll
                for (int n = 0; n < 2; ++n) acc[a][b][m][n] = (f32x4){0.f, 0.f, 0.f, 0.f};
    bf16x8 At[4][2], B0[2][2], B1[2][2];
    const char* cA = PG8_ABASE(cur); const char* cB = PG8_BBASE(cur);
    PG8_STAGE(PG8_SB(0, 0), cB, voffB); PG8_STAGE(PG8_SA(0, 0), cA, voffA); PG8_STAGE(PG8_SB(0, 1), cB + hstepB, voffB); PG8_STAGE(PG8_SA(0, 1), cA + hstepA, voffA);
    if (wr == 1) PG8_BAR;
    PG8_WAIT_V(4); PG8_BAR;
    PG8_STAGE(PG8_SB(1, 0), cB + kstep, voffB); PG8_STAGE(PG8_SA(1, 0), cA + kstep, voffA); PG8_STAGE(PG8_SB(1, 1), cB + hstepB + kstep, voffB);
    PG8_WAIT_V(6); PG8_BAR;
    for (;;) {
        const bool has_next = unit_next(g, ui + 1, nxt);
        const char* nA = has_next ? PG8_ABASE(nxt) : cA; const char* nB = has_next ? PG8_BBASE(nxt) : cB;
        for (int t = 0; t < nt; t += 2) {
            const bool last = (t == nt - 2);
            const char* a1 = cA + (size_t)(t + 1) * kstep;
            const char* a2 = last ? nA : cA + (size_t)(t + 2) * kstep; const char* b2 = last ? nB : cB + (size_t)(t + 2) * kstep;
            const char* a3 = a2 + kstep; const char* b3 = b2 + kstep;
            PG8_LDB(B0, 0, 0); PG8_SCHED; PG8_LDA(At, 0, 0); PG8_STAGE(PG8_SA(1, 1), a1 + hstepA, voffA);
            PG8_WAIT_L(8); PG8_BAR; PG8_WAIT_L(0); PG8_MMA(0, 0, At, B0); PG8_BAR; PG8_SCHED;
            PG8_LDB(B1, 0, 1); PG8_STAGE(PG8_SB(0, 0), b2, voffB);
            PG8_BAR; PG8_WAIT_L(0); PG8_MMA(0, 1, At, B1); PG8_BAR;
            PG8_LDA(At, 0, 1); PG8_STAGE(PG8_SA(0, 0), a2, voffA);
            PG8_BAR; PG8_WAIT_L(0); PG8_MMA(1, 0, At, B0); PG8_BAR; PG8_SCHED;
            PG8_STAGE(PG8_SB(0, 1), b2 + hstepB, voffB);
            PG8_WAIT_V(6); PG8_BAR; PG8_MMA(1, 1, At, B1); PG8_BAR;
            PG8_LDB(B0, 1, 0); PG8_SCHED; PG8_LDA(At, 1, 0); PG8_STAGE(PG8_SA(0, 1), a2 + hstepA, voffA);
            PG8_WAIT_L(8); PG8_BAR; PG8_WAIT_L(0); PG8_MMA(0, 0, At, B0); PG8_BAR; PG8_SCHED;
            PG8_LDB(B1, 1, 1); PG8_STAGE(PG8_SB(1, 0), b3, voffB);
            PG8_BAR; PG8_WAIT_L(0); PG8_MMA(0, 1, At, B1); PG8_BAR;
            PG8_LDA(At, 1, 1); PG8_STAGE(PG8_SA(1, 0), a3, voffA);
            PG8_BAR; PG8_WAIT_L(0); PG8_MMA(1, 0, At, B0); PG8_BAR; PG8_SCHED;
            PG8_STAGE(PG8_SB(1, 1), b3 + hstepB, voffB);
            PG8_WAIT_V(6); PG8_BAR; PG8_MMA(1, 1, At, B1); PG8_BAR;
        }
        epilogue(g, acc, cur, wr, wc, fr, fq);
        if (!has_next) break;
#pragma unroll
        for (int a = 0; a < 2; ++a)
#pragma unroll
            for (int b = 0; b < 2; ++b)
#pragma unroll
                for (int m = 0; m < 4; ++m)
#pragma unroll
                    for (int n = 0; n < 2; ++n) acc[a][b][m][n] = (f32x4){0.f, 0.f, 0.f, 0.f};
        cur = nxt; cA = nA; cB = nB; ++ui;
    }
    PG8_WAIT_V(0);
    if (wr == 0) PG8_BAR;
    PG8_BAR;
#undef PG8_SA
#undef PG8_SB
#undef PG8_STAGE
#undef PG8_LDA
#undef PG8_LDB
#undef PG8_MMA
#undef PG8_WAIT_V
#undef PG8_WAIT_L
#undef PG8_BAR
#undef PG8_SCHED
#undef PG8_ABASE
#undef PG8_BBASE
}
}

__device__ __forceinline__ void p0_transpose_item(const float* W, int ldw, int K, int csrc0, bf16_t* WT, int row0, LAS float* scr, int kb, int lane) {
    const int k0 = 64 * kb;
#pragma unroll 8
    for (int i = 0; i < 32; ++i) { const int kk = 2 * i + (lane >> 5); scr[kk * 33 + (lane & 31)] = W[(size_t)(k0 + kk) * ldw + csrc0 + (lane & 31)]; }
    asm volatile("s_waitcnt lgkmcnt(0)" ::: "memory");
    const int c = lane & 7;
#pragma unroll
    for (int j = 0; j < 4; ++j) { const int n = (lane >> 3) + 8 * j; const LAS float* s = scr + (8 * c) * 33 + n;
        uint4 o; o.x = pk2(s[0 * 33], s[1 * 33]); o.y = pk2(s[2 * 33], s[3 * 33]); o.z = pk2(s[4 * 33], s[5 * 33]); o.w = pk2(s[6 * 33], s[7 * 33]);
        *(uint4*)(WT + (size_t)(row0 + n) * K + k0 + 8 * c) = o; }
    asm volatile("s_waitcnt lgkmcnt(0)" ::: "memory");
}

__device__ __forceinline__ void d_conv_silu(int vb, int tid, const float* __restrict__ proj, const float* __restrict__ cw, const float* __restrict__ cb, bf16_t* __restrict__ c) {
    const int t = vb, s = t % S;
    for (int ch = tid; ch < 1024; ch += 256) {
        float y = cb[ch];
#pragma unroll
        for (int j = 0; j < 4; ++j) {
            const int ss = s - 3 + j;
            if (ss >= 0) y = fmaf(cw[j * 1024 + ch], proj[(size_t)(t - 3 + j) * INC + C_MIN + ch], y);
        }
        c[(size_t)t * 1024 + ch] = (bf16_t)f2bf(y / (1.0f + expf(-y)));
    }
}

__device__ __forceinline__ void d_mlstm(int vb, int tid, const float* __restrict__ mq, const float* __restrict__ mk, const float* __restrict__ proj,
                                        const float* __restrict__ gpre, const float* __restrict__ b_mi, const float* __restrict__ b_mf, float* __restrict__ hraw) {
    const int lane = tid & 63, w = tid >> 6;
    const int gid = vb * 4 + w;
    const int e = gid & 255, h = (gid >> 8) & 3, b = gid >> 10;
    const float bi = b_mi[h], bf = b_mf[h];
    float C0 = 0.f, C1 = 0.f, C2 = 0.f, C3 = 0.f, n0 = 0.f, n1 = 0.f, n2 = 0.f, n3 = 0.f, m = 0.f;
    const size_t tb = (size_t)b * S;
    const float* qp = mq + tb * 1024 + h * 256 + lane * 4;
    const float* kp = mk + tb * 1024 + h * 256 + lane * 4;
    const float* pp = proj + tb * INC;
    float4 qn = *(const float4*)qp, kn = *(const float4*)kp;
    const float* gp = gpre + tb * 8;
    float vn = pp[C_MV + h * 256 + e], in_ = gp[h], fn = gp[4 + h];
    for (int s = 0; s < S; ++s) {
        const float4 q = qn, k = kn; const float v = vn, ipre = in_ + bi, fpre = fn + bf;
        if (s + 1 < S) {
            qn = *(const float4*)(qp + (size_t)(s + 1) * 1024);
            kn = *(const float4*)(kp + (size_t)(s + 1) * 1024);
            const float* pr = pp + (size_t)(s + 1) * INC;
            vn = pr[C_MV + h * 256 + e]; in_ = gp[(size_t)(s + 1) * 8 + h]; fn = gp[(size_t)(s + 1) * 8 + 4 + h];
        }
        const float logf = log_sigmoid(fpre);
        const float mnew = fmaxf(logf + m, ipre);
        const float fd = expf(logf + m - mnew), ig = expf(ipre - mnew);
        m = mnew;
        const float sc = ig * 0.0625f;
        C0 = fd * C0 + sc * k.x * v; C1 = fd * C1 + sc * k.y * v; C2 = fd * C2 + sc * k.z * v; C3 = fd * C3 + sc * k.w * v;
        n0 = fd * n0 + sc * k.x; n1 = fd * n1 + sc * k.y; n2 = fd * n2 + sc * k.z; n3 = fd * n3 + sc * k.w;
        float num = q.x * C0 + q.y * C1 + q.z * C2 + q.w * C3;
        float den = q.x * n0 + q.y * n1 + q.z * n2 + q.w * n3;
        num = wave_sum(num); den = wave_sum(den);
        if (lane == 0) hraw[(tb + s) * 1024 + h * 256 + e] = num / fmaxf(fabsf(den), expf(-mnew));
    }
}

__device__ __forceinline__ void d_mhead_norm(int vb, int tid, const float* __restrict__ hraw, const float* __restrict__ proj, const float* __restrict__ g, bf16_t* __restrict__ mix) {
    const int t = vb, h = tid >> 6, lane = tid & 63;
    const float4 v = *(const float4*)(hraw + (size_t)t * 1024 + h * 256 + lane * 4);
    float s = v.x * v.x + v.y * v.y + v.z * v.z + v.w * v.w;
    s = wave_sum(s);
    const float r = rsqrtf(s * (1.0f / 256.0f) + EPS);
    const float4 gg = *(const float4*)(g + h * 256 + lane * 4);
    const float* mo = proj + (size_t)t * INC + C_MO + h * 256 + lane * 4;
    float4 o;
    o.x = v.x * r * gg.x / (1.0f + expf(-mo[0]));
    o.y = v.y * r * gg.y / (1.0f + expf(-mo[1]));
    o.z = v.z * r * gg.z / (1.0f + expf(-mo[2]));
    o.w = v.w * r * gg.w / (1.0f + expf(-mo[3]));
    uint2 ob; ob.x = pk2(o.x, o.y); ob.y = pk2(o.z, o.w);
    *(uint2*)(mix + (size_t)t * D + h * 256 + lane * 4) = ob;
}

__device__ __forceinline__ void d_rope(int vb, int tid, float* __restrict__ proj) {
    const int t = vb, s = t % S;
    for (int idx = tid; idx < 2 * 8 * 64; idx += 256) {
        const int i = idx & 63, hd = (idx >> 6) & 7, qk = idx >> 9;
        const float inv = exp2f(-(float)i * 0.20762050593046014f);
        const float ang = (float)s * inv;
        float sn, cs; sincosf(ang, &sn, &cs);
        float* p = proj + (size_t)t * INC + (qk ? C_AK : C_AQ) + hd * 128;
        const float x1 = p[i], x2 = p[64 + i];
        p[i] = x1 * cs - x2 * sn;
        p[64 + i] = x2 * cs + x1 * sn;
    }
}

__device__ __forceinline__ void d_dilated(int vb, int tid, float* sm, const float* __restrict__ proj, const float* __restrict__ g_ahead, bf16_t* __restrict__ mix) {
    float (*qs)[128] = (float (*)[128])sm;
    float (*ps)[576] = (float (*)[576])(sm + 512);
    const int lane = tid & 63, w = tid >> 6;
    const int gid = vb * 4 + w;
    const int s = gid % S, hd = (gid / S) & 7, b = gid / (S * 8);
    const size_t t = (size_t)b * S + s;
    const float* qrow = proj + t * INC + C_AQ + hd * 128;
    __syncthreads();
    qs[w][lane] = qrow[lane]; qs[w][lane + 64] = qrow[lane + 64];
    __syncthreads();
    const float scale = 0.08838834764831845f;
    float mloc = -INFINITY;
    for (int br = 0; br < 3; ++br) {
        const int dil = br == 0 ? 1 : (br == 1 ? 4 : 16);
        for (int jj = 0; jj < 192; jj += 64) {
            const int j = jj + lane;
            float sc = -INFINITY;
            if (j <= 128 && s - j * dil >= 0) {
                const float* krow = proj + (t - (size_t)j * dil) * INC + C_AK + hd * 128;
                float d = 0.f;
#pragma unroll 8
                for (int c = 0; c < 128; c += 4) {
                    const float4 kv = *(const float4*)(krow + c);
                    d = fmaf(qs[w][c], kv.x, d); d = fmaf(qs[w][c + 1], kv.y, d); d = fmaf(qs[w][c + 2], kv.z, d); d = fmaf(qs[w][c + 3], kv.w, d);
                }
                sc = d * scale;
            }
            ps[w][br * 192 + j] = sc;
            mloc = fmaxf(mloc, sc);
        }
    }
    const float mx = wave_max(mloc);
    __syncthreads();
    float lsum = 0.f;
    for (int i = lane; i < 3 * 192; i += 64) {
        const float sc = ps[w][i];
        const float pv = (sc == -INFINITY) ? 0.f : expf(sc - mx);
        ps[w][i] = pv; lsum += pv;
    }
    const float tot = wave_sum(lsum);
    __syncthreads();
    float o0 = 0.f, o1 = 0.f;
    for (int br = 0; br < 3; ++br) {
        const int dil = br == 0 ? 1 : (br == 1 ? 4 : 16);
        for (int j = 0; j <= 128; ++j) {
            if (s - j * dil < 0) break;
            const float pv = ps[w][br * 192 + j];
            const float* vrow = proj + (t - (size_t)j * dil) * INC + C_AV + hd * 128;
            o0 = fmaf(pv, vrow[lane], o0); o1 = fmaf(pv, vrow[lane + 64], o1);
        }
    }
    o0 /= tot; o1 /= tot;
    float ss = wave_sum(o0 * o0 + o1 * o1);
    const float r = rsqrtf(ss * (1.0f / 128.0f) + EPS);
    bf16_t* orow = mix + t * D + 1024 + hd * 128;
    orow[lane] = (bf16_t)f2bf(o0 * r * g_ahead[hd * 128 + lane]);
    orow[lane + 64] = (bf16_t)f2bf(o1 * r * g_ahead[hd * 128 + lane + 64]);
}

__device__ __forceinline__ void d_cross(int vb, int tid, float* sm, const float* __restrict__ q, const float* __restrict__ km, const float* __restrict__ vm, bf16_t* __restrict__ o) {
    float (*qs)[512] = (float (*)[512])sm;
    float (*ps)[256] = (float (*)[256])(sm + 2048);
    const int lane = tid & 63, w = tid >> 6;
    const int t = vb, hd = w, b = t / S;
    const float* qrow = q + (size_t)t * D + hd * 512;
    __syncthreads();
    for (int i = lane; i < 512; i += 64) qs[w][i] = qrow[i];
    __syncthreads();
    const float scale = 0.04419417382415922f;
    float sc[4]; float mloc = -INFINITY;
#pragma unroll
    for (int r = 0; r < 4; ++r) {
        const int mi = lane + 64 * r;
        const float* krow = km + ((size_t)b * 256 + mi) * D + hd * 512;
        float d = 0.f;
#pragma unroll 8
        for (int c = 0; c < 512; c += 4) {
            const float4 kv = *(const float4*)(krow + c);
            d = fmaf(qs[w][c], kv.x, d); d = fmaf(qs[w][c + 1], kv.y, d); d = fmaf(qs[w][c + 2], kv.z, d); d = fmaf(qs[w][c + 3], kv.w, d);
        }
        sc[r] = d * scale; mloc = fmaxf(mloc, sc[r]);
    }
    const float mx = wave_max(mloc);
    float lsum = 0.f;
#pragma unroll
    for (int r = 0; r < 4; ++r) { const float pv = expf(sc[r] - mx); ps[w][lane + 64 * r] = pv; lsum += pv; }
    const float tot = wave_sum(lsum);
    __syncthreads();
    float acc[8];
#pragma unroll
    for (int i = 0; i < 8; ++i) acc[i] = 0.f;
    for (int mi = 0; mi < 256; ++mi) {
        const float pv = ps[w][mi];
        const float* vrow = vm + ((size_t)b * 256 + mi) * D + hd * 512;
#pragma unroll
        for (int i = 0; i < 8; ++i) acc[i] = fmaf(pv, vrow[lane + 64 * i], acc[i]);
    }
    bf16_t* orow = o + (size_t)t * D + hd * 512;
#pragma unroll
    for (int i = 0; i < 8; ++i) orow[lane + 64 * i] = (bf16_t)f2bf(acc[i] / tot);
}

__device__ __forceinline__ void wave_argmax(float& best, int& bidx) {
#pragma unroll
    for (int o = 32; o >= 1; o >>= 1) {
        const float ob = __shfl_xor(best, o); const int oi = __shfl_xor(bidx, o);
        if (ob > best || (ob == best && oi < bidx)) { best = ob; bidx = oi; }
    }
}
__device__ __forceinline__ void d_peer_topk(int vb, int tid, float* sm, const float* __restrict__ qp, const float* __restrict__ sub_keys, int* __restrict__ ids, float* __restrict__ gates) {
    float (*qs)[256] = (float (*)[256])sm;
    const int lane = tid & 63, w = tid >> 6;
    const int gid = vb * 4 + w;
    const int hd = gid & 7, t = gid >> 3;
    const float* qrow = qp + (size_t)t * D + hd * 256;
    __syncthreads();
    for (int i = lane; i < 256; i += 64) qs[w][i] = qrow[i];
    __syncthreads();
    float tops[2]; int topi[2];
#pragma unroll
    for (int p = 0; p < 2; ++p) {
        float v0, v1;
        {
            const float* k0 = sub_keys + ((size_t)(hd * 2 + p) * 128 + lane) * 128;
            const float* k1 = k0 + 64 * 128;
            float d0 = 0.f, d1 = 0.f;
#pragma unroll 8
            for (int c = 0; c < 128; c += 4) {
                const float4 a = *(const float4*)(k0 + c), bb = *(const float4*)(k1 + c);
                const float q0 = qs[w][p * 128 + c], q1 = qs[w][p * 128 + c + 1], q2 = qs[w][p * 128 + c + 2], q3 = qs[w][p * 128 + c + 3];
                d0 = fmaf(q0, a.x, d0); d0 = fmaf(q1, a.y, d0); d0 = fmaf(q2, a.z, d0); d0 = fmaf(q3, a.w, d0);
                d1 = fmaf(q0, bb.x, d1); d1 = fmaf(q1, bb.y, d1); d1 = fmaf(q2, bb.z, d1); d1 = fmaf(q3, bb.w, d1);
            }
            v0 = d0; v1 = d1;
        }
        float ts = 0.f; int ti = 0;
        for (int it = 0; it < 16; ++it) {
            float best; int bidx;
            if (v0 >= v1) { best = v0; bidx = lane; } else { best = v1; bidx = lane + 64; }
            wave_argmax(best, bidx);
            if (lane == it) { ts = best; ti = bidx; }
            if (bidx == lane) v0 = -INFINITY;
            if (bidx == lane + 64) v1 = -INFINITY;
        }
        tops[p] = ts; topi[p] = ti;
    }
    float cv[4]; int ci[4];
#pragma unroll
    for (int r = 0; r < 4; ++r) {
        const int c = lane * 4 + r, i = c >> 4, j = c & 15;
        const float s0 = __shfl(tops[0], i), s1 = __shfl(tops[1], j);
        const int i0 = __shfl(topi[0], i), i1 = __shfl(topi[1], j);
        cv[r] = s0 + s1; ci[r] = i0 * 128 + i1;
    }
    float bs = 0.f; int bid = 0;
    for (int it = 0; it < 16; ++it) {
        float best = cv[0]; int bidx = lane * 4;
#pragma unroll
        for (int r = 1; r < 4; ++r) if (cv[r] > best) { best = cv[r]; bidx = lane * 4 + r; }
        wave_argmax(best, bidx);
        const int owner = bidx >> 2, rr = bidx & 3;
        int myid = ci[0];
        if (rr == 1) myid = ci[1]; else if (rr == 2) myid = ci[2]; else if (rr == 3) myid = ci[3];
        const int eid = __shfl(myid, owner);
        if (lane == it) { bs = best; bid = eid; }
        if (owner == lane) {
#pragma unroll
            for (int r = 0; r < 4; ++r) if (rr == r) cv[r] = -INFINITY;
        }
    }
    float v = lane < 16 ? bs : -INFINITY;
    const float mx = wave_max(v);
    const float ev = lane < 16 ? expf(bs - mx) : 0.f;
    const float tot = wave_sum(ev);
    if (lane < 16) {
        ids[(size_t)t * 128 + hd * 16 + lane] = bid;
        gates[(size_t)t * 128 + hd * 16 + lane] = ev / tot;
    }
}

__device__ __forceinline__ void d_peer_out(int vb, int tid, float* sm, const bf16_t* __restrict__ h3, const float* __restrict__ x2, const int* __restrict__ ids, const float* __restrict__ gates,
                                           const float* __restrict__ u_tab, const float* __restrict__ v_tab, const float* __restrict__ g_final, float* __restrict__ out) {
    float (*part)[2048] = (float (*)[2048])sm;
    float* red = sm + 4 * 2048;
    const int lane = tid & 63, w = tid >> 6, t = vb;
    float4 xr[8], acc[8];
    const bf16_t* hrow = h3 + (size_t)t * D;
#pragma unroll
    for (int i = 0; i < 8; ++i) { const ushort4 hv = *(const ushort4*)(hrow + i * 256 + lane * 4);
        xr[i] = make_float4(bf2f(hv.x), bf2f(hv.y), bf2f(hv.z), bf2f(hv.w)); acc[i] = make_float4(0.f, 0.f, 0.f, 0.f); }
    for (int j = 0; j < 32; ++j) {
        const int slot = w * 32 + j;
        const int e = ids[(size_t)t * 128 + slot];
        const float gt = gates[(size_t)t * 128 + slot];
        const float* ur = u_tab + (size_t)e * D;
        const float* vr = v_tab + (size_t)e * D;
        float d = 0.f;
#pragma unroll
        for (int i = 0; i < 8; ++i) {
            const float4 u = *(const float4*)(ur + i * 256 + lane * 4);
            d = fmaf(xr[i].x, u.x, d); d = fmaf(xr[i].y, u.y, d); d = fmaf(xr[i].z, u.z, d); d = fmaf(xr[i].w, u.w, d);
        }
        d = wave_sum(d);
        const float act = 0.5f * d * (1.0f + erff(d * 0.7071067811865476f));
        const float cf = gt * act;
#pragma unroll
        for (int i = 0; i < 8; ++i) {
            const float4 v = *(const float4*)(vr + i * 256 + lane * 4);
            acc[i].x = fmaf(cf, v.x, acc[i].x); acc[i].y = fmaf(cf, v.y, acc[i].y); acc[i].z = fmaf(cf, v.z, acc[i].z); acc[i].w = fmaf(cf, v.w, acc[i].w);
        }
    }
    __syncthreads();
#pragma unroll
    for (int i = 0; i < 8; ++i) *(float4*)&part[w][i * 256 + lane * 4] = acc[i];
    __syncthreads();
    float4 r0, r1;
    {
        const float4 a = *(const float4*)&part[0][tid * 4], b = *(const float4*)&part[1][tid * 4], c = *(const float4*)&part[2][tid * 4], d = *(const float4*)&part[3][tid * 4];
        const float4 x = *(const float4*)(x2 + (size_t)t * D + tid * 4);
        r0 = make_float4(x.x + a.x + b.x + c.x + d.x, x.y + a.y + b.y + c.y + d.y, x.z + a.z + b.z + c.z + d.z, x.w + a.w + b.w + c.w + d.w);
    }
    {
        const float4 a = *(const float4*)&part[0][1024 + tid * 4], b = *(const float4*)&part[1][1024 + tid * 4], c = *(const float4*)&part[2][1024 + tid * 4], d = *(const float4*)&part[3][1024 + tid * 4];
        const float4 x = *(const float4*)(x2 + (size_t)t * D + 1024 + tid * 4);
        r1 = make_float4(x.x + a.x + b.x + c.x + d.x, x.y + a.y + b.y + c.y + d.y, x.z + a.z + b.z + c.z + d.z, x.w + a.w + b.w + c.w + d.w);
    }
    float s = r0.x * r0.x + r0.y * r0.y + r0.z * r0.z + r0.w * r0.w + r1.x * r1.x + r1.y * r1.y + r1.z * r1.z + r1.w * r1.w;
    s = wave_sum(s);
    if (lane == 0) red[w] = s;
    __syncthreads();
    const float tot = red[0] + red[1] + red[2] + red[3];
    const float r = rsqrtf(tot * (1.0f / D) + EPS);
    const float4 g0 = *(const float4*)(g_final + tid * 4), g1 = *(const float4*)(g_final + 1024 + tid * 4);
    *(float4*)(out + (size_t)t * D + tid * 4) = make_float4(r0.x * r * g0.x, r0.y * r * g0.y, r0.z * r * g0.z, r0.w * r * g0.w);
    *(float4*)(out + (size_t)t * D + 1024 + tid * 4) = make_float4(r1.x * r * g1.x, r1.y * r * g1.y, r1.z * r * g1.z, r1.w * r * g1.w);
}

struct Params {
    const float *x, *mem, *g_mix, *w_in, *conv_w, *conv_b, *w_mq, *w_mk, *b_mi, *b_mf, *g_mhead, *g_ahead, *w_out, *g_cross, *g_mem,
                *w_xq, *w_xk, *w_xv, *w_xo, *g_ffn, *w_pq, *sub_keys, *u_tab, *v_tab, *g_final;
    float* out;
    unsigned* bar;
    float* ws;
};

#define PHASE_LOOP(nvb) for (int base_ = blockIdx.x * 2; base_ < (nvb); base_ += gridDim.x * 2)
#define VB (base_ + half)

__global__ void __launch_bounds__(NTHR) mega(Params P) {
    volatile LAS unsigned* st = (volatile LAS unsigned*)(LAS unsigned char*)(smem_raw + GEMM_LDS);
    if (threadIdx.x == 0) { st[0] = 0u; st[1] = 0u; st[2] = 0u; st[3] = 0u; }
    if (threadIdx.x < I_NPTR) ((LAS unsigned long long*)(LAS unsigned char*)(smem_raw + GEMM_LDS + 64))[threadIdx.x] = ((const unsigned long long*)&P)[threadIdx.x];
    __syncthreads();
    XcdBarrier xb = xcd_barrier_post((unsigned*)ldp_raw(I_BAR), st);

#pragma nounroll
    for (int ph = 0; ph < 15; ++ph) {
        int tidx = threadIdx.x; asm volatile("" : "+v"(tidx));
        const int half = tidx >> 8, tid = tidx & 255;
        float* sm = (float*)smem_raw + half * HALF_SM_FLOATS;
        char* wsb = (char*)ldp_raw(I_WS);
        const size_t TD = (size_t)T * D;
        constexpr size_t O_HB = (size_t)T * INC * 4, O_CBUF = O_HB + (size_t)T * D * 2, O_MQ = O_CBUF + (size_t)T * 1024 * 2, O_MK = O_MQ + (size_t)T * 1024 * 4,
                         O_MIXB = O_MK + (size_t)T * 1024 * 4, O_WIN = O_MIXB + (size_t)T * D * 2, O_WOUT = O_WIN + (size_t)6144 * D * 2, O_WXQ = O_WOUT + (size_t)D * D * 2,
                         O_WXK = O_WXQ + (size_t)D * D * 2, O_WXV = O_WXK + (size_t)D * D * 2, O_WXO = O_WXV + (size_t)D * D * 2, O_WPQ = O_WXO + (size_t)D * D * 2,
                         O_WQK = O_WPQ + (size_t)D * D * 2, O_GPRE = O_WQK + (size_t)8 * 256 * 256 * 2, O_END = O_GPRE + (size_t)T * 8 * 4;
#define W_PROJ  ((float*)wsb)
#define W_HB    ((bf16_t*)(wsb + O_HB))
#define W_CBUF  ((bf16_t*)(wsb + O_CBUF))
#define W_MQ    ((float*)(wsb + O_MQ))
#define W_MK    ((float*)(wsb + O_MK))
#define W_MIXB  ((bf16_t*)(wsb + O_MIXB))
#define W_GPRE  ((float*)(wsb + O_GPRE))
#define W_HRAW  ((float*)(wsb + O_HB))
#define W_X1    ((float*)wsb)
#define W_X2    ((float*)wsb + TD)
#define W_MN    ((bf16_t*)((float*)wsb + 2 * TD))
#define W_KM    ((float*)wsb + 2 * TD + (size_t)512 * D)
#define W_VM    ((float*)wsb + 2 * TD + (size_t)1024 * D)
#define W_GATES ((float*)wsb + 2 * TD + (size_t)1536 * D)
#define W_IDS   ((int*)((float*)wsb + 2 * TD + (size_t)1536 * D + (size_t)T * 128))
#define W_QX    ((float*)(wsb + O_CBUF))
        if (ph == 0) {
            LAS float* scr = (LAS float*)(LAS unsigned char*)(smem_raw) + (tidx >> 6) * (64 * 33);
            const int lane = tidx & 63;
            const int gw = blockIdx.x * 8 + (tidx >> 6), NGW = gridDim.x * 8;
            constexpr int I_IN = 32 * 192, I_SQ = 32 * 64, I_QK = 8 * 4 * 8;
            constexpr int NITEMS = I_IN + 6 * I_SQ + I_QK;
#pragma nounroll
            for (int it = gw; it < NITEMS; it += NGW) {
                const float* W; int ldw, K, csrc0, row0, kb; bf16_t* WT;
                int r = it;
                if (r < I_IN) { const int nb = r % 192; kb = r / 192; W = PF(I_WIN); ldw = INC; K = D; csrc0 = nb * 32 + (nb >= 96 ? 8 : 0); WT = (bf16_t*)(wsb + O_WIN); row0 = nb * 32; }
                else if ((r -= I_IN) < 6 * I_SQ) {
                    const int wsel = r / I_SQ; r -= wsel * I_SQ; const int nb = r % 64; kb = r / 64; ldw = D; K = D; csrc0 = nb * 32; row0 = nb * 32;
                    W = PF(wsel == 0 ? I_WOUT : wsel == 1 ? I_WXQ : wsel == 2 ? I_WXK : wsel == 3 ? I_WXV : wsel == 4 ? I_WXO : I_WPQ);
                    WT = (bf16_t*)(wsb + O_WOUT + (size_t)wsel * ((size_t)D * D * 2));
                } else {
                    r -= 6 * I_SQ; const int hq = r / 32; r -= hq * 32; const int nb = r % 8; kb = r / 8;
                    W = PF(hq < 4 ? I_WMQ : I_WMK) + (size_t)(hq & 3) * 65536; ldw = 256; K = 256; csrc0 = nb * 32; WT = (bf16_t*)(wsb + O_WQK); row0 = hq * 256 + nb * 32;
                }
                p0_transpose_item(W, ldw, K, csrc0, WT, row0, scr, kb, lane);
            }
            __syncthreads();
        }
        int j0 = 0, j1 = 0;
        switch (ph) {
            case 1: j0 = 0; j1 = 1; break;
            case 3: j0 = 1; j1 = 2; break;
            case 6: j0 = 2; j1 = 3; break;
            case 8: j0 = 3; j1 = 6; break;
            case 10: j0 = 6; j1 = 7; break;
            case 12: j0 = 7; j1 = 8; break;
            default: break;
        }
#pragma nounroll
        for (int j = j0; j < j1; ++j) {
            pg8::GJob g;
            g.lda = D; g.ldb = D; g.K = D; g.nM = 32; g.nN = 8; g.a_pn_mask = 0; g.a_pn_step = 0; g.ldc = D; g.R = nullptr; g.ldr = D; g.mode = 0;
            switch (j) {
                case 0: g.A = W_HB; g.Bt = (bf16_t*)(wsb + O_WIN); g.nN = 24; g.C = W_PROJ; g.ldc = INC; g.mode = 1; break;
                case 1: g.A = W_CBUF; g.lda = 1024; g.Bt = (bf16_t*)(wsb + O_WQK); g.ldb = 256; g.K = 256; g.a_pn_mask = 3; g.a_pn_step = 256; g.C = W_MQ; g.ldc = 1024; g.mode = 2; break;
                case 2: g.A = W_MIXB; g.Bt = (bf16_t*)(wsb + O_WOUT); g.C = W_X1; g.R = PF(I_X); break;
                case 3: g.A = W_HB; g.Bt = (bf16_t*)(wsb + O_WXQ); g.C = W_QX; break;
                case 4: g.A = W_MN; g.Bt = (bf16_t*)(wsb + O_WXK); g.nM = 2; g.C = W_KM; break;
                case 5: g.A = W_MN; g.Bt = (bf16_t*)(wsb + O_WXV); g.nM = 2; g.C = W_VM; break;
                case 6: g.A = W_MIXB; g.Bt = (bf16_t*)(wsb + O_WXO); g.C = W_X2; g.R = W_X1; break;
                default: g.A = W_HB; g.Bt = (bf16_t*)(wsb + O_WPQ); g.C = W_QX; break;
            }
            pg8::gemm_phase((LAS unsigned char*)smem_raw, g);
            __syncthreads();
        }
        {
            int nj = 0;
            if (ph == 0) { nj = 1; } else if (ph == 7) { nj = 2; } else if (ph == 11) { nj = 1; }
#pragma nounroll
            for (int j = 0; j < nj; ++j) {
                const float* rin; const float* rg; bf16_t* rout; int rows; float* gp = nullptr;
                if (ph == 0) { rin = PF(I_X); rg = PF(I_GMIX); rout = W_HB; rows = T; gp = W_GPRE; }
                else if (ph == 7 && j == 0) { rin = W_X1; rg = PF(I_GCROSS); rout = W_HB; rows = T; }
                else if (ph == 7) { rin = PF(I_MEM); rg = PF(I_GMEM); rout = W_MN; rows = 512; }
                else { rin = W_X2; rg = PF(I_GFFN); rout = W_HB; rows = T; }
                const float* win = PF(I_WIN);
#pragma nounroll
                PHASE_LOOP(rows) d_rmsnorm(VB, tid, sm, rin, rg, rout, win, gp);
            }
        }
        if (ph == 2) {
            const float* cw = PF(I_CONVW); const float* cb = PF(I_CONVB);
#pragma nounroll
            PHASE_LOOP(T) d_conv_silu(VB, tid, W_PROJ, cw, cb, W_CBUF);
#pragma nounroll
            PHASE_LOOP(T) d_rope(VB, tid, W_PROJ);
        } else if (ph == 3) {
            const float* ga = PF(I_GAHEAD);
#pragma nounroll
            PHASE_LOOP(NB * 8 * S / 4) d_dilated(VB, tid, sm, W_PROJ, ga, W_MIXB);
        } else if (ph == 4) {
            const float* bmi = PF(I_BMI); const float* bmf = PF(I_BMF);
#pragma nounroll
            PHASE_LOOP(NB * 4 * 256 / 4) d_mlstm(VB, tid, W_MQ, W_MK, W_PROJ, W_GPRE, bmi, bmf, W_HRAW);
        } else if (ph == 5) {
            const float* gm = PF(I_GMHEAD);
#pragma nounroll
            PHASE_LOOP(T) d_mhead_norm(VB, tid, W_HRAW, W_PROJ, gm, W_MIXB);
        } else if (ph == 9) {
#pragma nounroll
            PHASE_LOOP(T) d_cross(VB, tid, sm, W_QX, W_KM, W_VM, W_MIXB);
        } else if (ph == 13) {
            const float* sk = PF(I_SUBK);
#pragma nounroll
            PHASE_LOOP(T * 8 / 4) d_peer_topk(VB, tid, sm, W_QX, sk, W_IDS, W_GATES);
        } else if (ph == 14) {
            const float* ut = PF(I_UTAB); const float* vt = PF(I_VTAB); const float* gf = PF(I_GFINAL); float* outp = (float*)ldp_raw(I_OUT);
#pragma nounroll
            PHASE_LOOP(T) d_peer_out(VB, tid, sm, W_HB, W_X2, W_IDS, W_GATES, ut, vt, gf, outp);
        }
        if (ph < 14) xcd_barrier(xb);
    }
}
}

extern "C" void kernel_launch(void* const* d_in, const int* in_sizes, int n_in, void* d_out, int out_size, void* d_ws, size_t ws_size, hipStream_t stream) {
    static int grid_blocks = 0;
    if (!grid_blocks) {
        int dev = 0, cus = 0, per_cu = 0;
        hipGetDevice(&dev);
        hipDeviceGetAttribute(&cus, hipDeviceAttributeMultiprocessorCount, dev);
        hipFuncSetAttribute((const void*)mega, hipFuncAttributeMaxDynamicSharedMemorySize, SMEM_BYTES);
        hipOccupancyMaxActiveBlocksPerMultiprocessor(&per_cu, mega, NTHR, SMEM_BYTES);
        if (per_cu > 1) per_cu = 1;
        if (per_cu < 1) per_cu = 1;
        grid_blocks = cus * per_cu;
    }
    Params P{};
    const float** pp = (const float**)&P;
    for (int i = 0; i < 25; ++i) pp[i] = (const float*)d_in[i];
    P.out = (float*)d_out;
    P.bar = (unsigned*)d_ws;
    P.ws = (float*)((char*)d_ws + 16384);
    hipMemsetAsync(d_ws, 0, 16384, stream);
    void* args[] = {&P};
    hipError_t e = hipLaunchCooperativeKernel((const void*)mega, dim3(grid_blocks), dim3(NTHR), args, SMEM_BYTES, stream);
    if (e != hipSuccess) fprintf(stderr, "cooperative launch failed: %s (grid %d)\n", hipGetErrorString(e), grid_blocks);
}
```

```cpp
#include <hip/hip_runtime.h>
#include <stdint.h>
#include <math.h>
#include <cstdio>

#define LAS_ __attribute__((address_space(3)))
namespace {
constexpr int D = 2048, NB = 2, S = 4096, T = NB * S;
constexpr int INC = 6152;
constexpr int C_MIN = 0, C_MV = 1024, C_MO = 2048, C_MI = 3072, C_MF = 3076, C_AQ = 3080, C_AK = 4104, C_AV = 5128;
constexpr float EPS = 1e-6f;
constexpr size_t P6S = (size_t)8192 * 1024;
constexpr int NTHR = 512;
constexpr int HALF_SM_FLOATS = 8704;
constexpr int GEMM_LDS = 131072;
constexpr int SMEM_BYTES = GEMM_LDS + 1024 + 8192;
typedef unsigned short bf16_t;
__device__ __forceinline__ unsigned f2bf(float f) { unsigned u = __float_as_uint(f); u += 0x7FFFu + ((u >> 16) & 1u); return u >> 16; }
__device__ __forceinline__ unsigned pk2(float lo, float hi) { return f2bf(lo) | (f2bf(hi) << 16); }
__device__ __forceinline__ float bf2f(unsigned short b) { return __uint_as_float(((unsigned)b) << 16); }
extern __shared__ __attribute__((aligned(16))) unsigned char smem_raw[];
enum { I_X = 0, I_MEM, I_GMIX, I_WIN, I_CONVW, I_CONVB, I_WMQ, I_WMK, I_BMI, I_BMF, I_GMHEAD, I_GAHEAD, I_WOUT, I_GCROSS, I_GMEM,
       I_WXQ, I_WXK, I_WXV, I_WXO, I_GFFN, I_WPQ, I_SUBK, I_UTAB, I_VTAB, I_GFINAL, I_OUT, I_BAR, I_WS, I_NPTR };
__device__ __forceinline__ unsigned long long ldp_raw(int i) {
    const LAS_ unsigned long long* tab = (const LAS_ unsigned long long*)(LAS_ unsigned char*)(smem_raw + GEMM_LDS + 64);
    const unsigned long long v = tab[i];
    const unsigned lo = __builtin_amdgcn_readfirstlane((unsigned)v), hi = __builtin_amdgcn_readfirstlane((unsigned)(v >> 32));
    return ((unsigned long long)hi << 32) | lo;
}
#define PF(i) ((const float*)ldp_raw(i))

#define XB_TMO      128
#define XB_XCNT(j)  (256  + 64 * (j))
#define XB_XSUB(j)  (1280 + 64 * (j))
#define XB_XGEN(j)  (2304 + 64 * (j))
#define XB_TOP      3328
#define XB_TOPGEN   3392
#define XCD_BAR_WORDS 3456
#define XB_SPIN_CAP (1u << 22)
#define LAS __attribute__((address_space(3)))

__device__ __forceinline__ unsigned xb_ld(unsigned* p)              { return __hip_atomic_load(p, __ATOMIC_RELAXED, __HIP_MEMORY_SCOPE_AGENT); }
__device__ __forceinline__ unsigned xb_add(unsigned* p, unsigned v) { return __hip_atomic_fetch_add(p, v, __ATOMIC_RELAXED, __HIP_MEMORY_SCOPE_AGENT); }
__device__ __forceinline__ unsigned xb_xcc_id() { return (unsigned)__builtin_amdgcn_s_getreg((3 << 11) | 20) & 0xFu; }
#define XB_SPIN(cond, bar) do { unsigned _sp = 0; while (cond) { __builtin_amdgcn_s_sleep(1); \
    if ((++_sp & 255u) == 0u) { if (xb_ld(&(bar)[XB_TMO])) break; if (_sp > XB_SPIN_CAP) { atomicAdd(&(bar)[XB_TMO], 1u); break; } } } } while (0)

struct XcdBarrier { unsigned* bar; unsigned x; volatile LAS unsigned* st; };

__device__ __forceinline__ XcdBarrier xcd_barrier_post(unsigned* bar, volatile LAS unsigned* st) {
    XcdBarrier b; b.bar = bar; b.x = xb_xcc_id(); b.st = st;
    if (threadIdx.x == 0) (void)xb_add(&bar[XB_XCNT(b.x)], 1u);
    return b;
}
__device__ __forceinline__ void xcd_barrier_complete(unsigned* bar, unsigned x, unsigned& nloc, unsigned& nx) {
    const unsigned G = gridDim.x * gridDim.y * gridDim.z;
    unsigned sum, cnt, mine, sp = 0u;
    for (;;) {
        sum = 0u; cnt = 0u; mine = 0u;
#pragma unroll
        for (unsigned j = 0; j < 16; ++j) { const unsigned c = xb_ld(&bar[XB_XCNT(j)]); sum += c; cnt += (c > 0u) ? 1u : 0u; mine = (j == x) ? c : mine; }
        if (sum == G) break;
        __builtin_amdgcn_s_sleep(1);
        if ((++sp & 255u) == 0u) { if (xb_ld(&bar[XB_TMO])) break; if (sp > XB_SPIN_CAP) { atomicAdd(&bar[XB_TMO], 1u); break; } }
    }
    nloc = mine > 0u ? mine : 1u; nx = cnt > 0u ? cnt : 1u;
}
__device__ __forceinline__ void xcd_barrier(const XcdBarrier& b) {
    asm volatile("s_waitcnt vmcnt(0)" ::: "memory");
    __syncthreads();
    if (threadIdx.x == 0) {
        unsigned* bar = b.bar;
        __builtin_amdgcn_s_waitcnt(0);
        unsigned nloc = b.st[0], nx = b.st[1];
        if (nloc == 0u) { xcd_barrier_complete(bar, b.x, nloc, nx); b.st[0] = nloc; b.st[1] = nx; }
        const unsigned old = xb_add(&bar[XB_XSUB(b.x)], 1u);
        const unsigned gen = old / nloc;
        if (old + 1u == (gen + 1u) * nloc) {
            __builtin_amdgcn_fence(__ATOMIC_RELEASE, "agent");
            asm volatile("s_waitcnt vmcnt(0)" ::: "memory");
            const unsigned og = xb_add(&bar[XB_TOP], 1u);
            const unsigned tg = og / nx;
            if (og + 1u == (tg + 1u) * nx) xb_add(&bar[XB_TOPGEN], 1u);
            else XB_SPIN(xb_ld(&bar[XB_TOPGEN]) == tg, bar);
            __builtin_amdgcn_fence(__ATOMIC_ACQUIRE, "agent");
            xb_add(&bar[XB_XGEN(b.x)], 1u);
            asm volatile("s_waitcnt vmcnt(0)" ::: "memory");
        } else {
            XB_SPIN(xb_ld(&bar[XB_XGEN(b.x)]) == gen, bar);
            __builtin_amdgcn_fence(__ATOMIC_ACQUIRE, "agent");
            asm volatile("s_waitcnt vmcnt(0)" ::: "memory");
        }
    }
    __syncthreads();
}

__device__ __forceinline__ float wave_sum(float v) {
#pragma unroll
    for (int o = 32; o >= 1; o >>= 1) v += __shfl_xor(v, o);
    return v;
}
__device__ __forceinline__ float wave_max(float v) {
#pragma unroll
    for (int o = 32; o >= 1; o >>= 1) v = fmaxf(v, __shfl_xor(v, o));
    return v;
}
__device__ __forceinline__ float log_sigmoid(float x) { return fminf(x, 0.f) - log1pf(expf(-fabsf(x))); }


__device__ __forceinline__ void d_rmsnorm(int vb, int t, float* sm, const float* __restrict__ in, const float* __restrict__ g, bf16_t* __restrict__ out,
                                          const float* __restrict__ w_in, float* __restrict__ gpre) {
    float* red = sm;
    const int row = vb;
    const float4* p = (const float4*)(in + (size_t)row * D);
    float4 a = p[t], b = p[t + 256];
    float s = a.x * a.x + a.y * a.y + a.z * a.z + a.w * a.w + b.x * b.x + b.y * b.y + b.z * b.z + b.w * b.w;
    s = wave_sum(s);
    __syncthreads();
    if ((t & 63) == 0) red[t >> 6] = s;
    __syncthreads();
    const float tot = red[0] + red[1] + red[2] + red[3];
    const float r = rsqrtf(tot * (1.0f / D) + EPS);
    const float4* gp = (const float4*)g;
    float4 ga = gp[t], gb = gp[t + 256];
    float hv[8] = {a.x * r * ga.x, a.y * r * ga.y, a.z * r * ga.z, a.w * r * ga.w, b.x * r * gb.x, b.y * r * gb.y, b.z * r * gb.z, b.w * r * gb.w};
    uint2 o0, o1;
    o0.x = pk2(hv[0], hv[1]); o0.y = pk2(hv[2], hv[3]); o1.x = pk2(hv[4], hv[5]); o1.y = pk2(hv[6], hv[7]);
    *(uint2*)(out + (size_t)row * D + t * 4) = o0;
    *(uint2*)(out + (size_t)row * D + 1024 + t * 4) = o1;
    if (gpre) {
        float gs[8];
#pragma unroll
        for (int c = 0; c < 8; ++c) gs[c] = 0.f;
#pragma unroll
        for (int j = 0; j < 8; ++j) {
            const int k = (j < 4) ? (t * 4 + j) : (1024 + t * 4 + (j - 4));
            const float4 w0 = *(const float4*)(w_in + (size_t)k * INC + C_MI), w1 = *(const float4*)(w_in + (size_t)k * INC + C_MI + 4);
            gs[0] = fmaf(hv[j], w0.x, gs[0]); gs[1] = fmaf(hv[j], w0.y, gs[1]); gs[2] = fmaf(hv[j], w0.z, gs[2]); gs[3] = fmaf(hv[j], w0.w, gs[3]);
            gs[4] = fmaf(hv[j], w1.x, gs[4]); gs[5] = fmaf(hv[j], w1.y, gs[5]); gs[6] = fmaf(hv[j], w1.z, gs[6]); gs[7] = fmaf(hv[j], w1.w, gs[7]);
        }
#pragma unroll
        for (int c = 0; c < 8; ++c) gs[c] = wave_sum(gs[c]);
        __syncthreads();
        if ((t & 63) == 0) {
#pragma unroll
            for (int c = 0; c < 8; ++c) red[8 + (t >> 6) * 8 + c] = gs[c];
        }
        __syncthreads();
        if (t < 8) gpre[(size_t)row * 8 + t] = red[8 + t] + red[16 + t] + red[24 + t] + red[32 + t];
    }
}

namespace pg8 {
typedef short bf16x8 __attribute__((ext_vector_type(8)));
typedef float f32x4 __attribute__((ext_vector_type(4)));
constexpr int BM = 256, BK = 64, HALF = 128, HTB = HALF * BK * 2, NXCD = 8, WGM = 8;
__device__ __forceinline__ int lds_byte(int r, int c) { const int st = (r >> 4) * 2 + (c >> 5), rr = r & 15, cc = c & 31, ob = rr * 64 + cc * 2; return st * 1024 + (ob ^ (((ob >> 9) & 1) << 5)); }
__device__ __forceinline__ void stage_rc(int b, int& R, int& C) { const int st = b / 1024, sb = b % 1024, swz = sb ^ (((sb >> 9) & 1) << 5); R = (st >> 1) * 16 + swz / 64; C = (st & 1) * 32 + (swz % 64) / 2; }
struct Unit { int pm, pn; };
struct GJob {
    const bf16_t* A; const bf16_t* Bt;
    int lda, ldb, K, nM, nN;
    int a_pn_shift, a_pn_mask, a_pn_step;
    int b_pm_shift, b_pm_step, b_pn_step;
    float escale;
    float* C; int ldc; const float* R; int ldr;
    int mode;
};
__device__ __forceinline__ bool unit_next(const GJob& g, int i, Unit& u) {
    const int nwg = g.nM * g.nN;
    const long L = (long)i * gridDim.x + blockIdx.x; if (L >= nwg) return false;
    int wgid = (int)L; { const int q = nwg / NXCD, r = nwg % NXCD, xcd = wgid % NXCD, off = wgid / NXCD; wgid = (xcd < r ? xcd * (q + 1) : r * (q + 1) + (xcd - r) * q) + off; }
    const int nig = WGM * g.nN, gid = wgid / nig, fm = gid * WGM, gsz = (g.nM - fm) < WGM ? (g.nM - fm) : WGM;
    u.pm = fm + ((wgid % nig) % gsz); u.pn = (wgid % nig) / gsz; return true;
}
template <int MODE> __device__ __forceinline__ void epilogue(const GJob& g, f32x4 (&acc)[2][2][4][2], const Unit& u, int wr, int wc, int fr, int fq, LAS unsigned char* xlds) {
    const int row0 = u.pm * BM + wr * 64 + fr;
    if constexpr (MODE == 0) {
        const int col0 = u.pn * BM + wc * 32 + 4 * fq;
#pragma unroll
        for (int ai = 0; ai < 2; ++ai)
#pragma unroll
            for (int m = 0; m < 4; ++m) {
                const int row = row0 + ai * HALF + m * 16;
                float* rowp = g.C + (size_t)row * g.ldc + col0;
                const float* rp = g.R ? g.R + (size_t)row * g.ldr + col0 : nullptr;
#pragma unroll
                for (int bj = 0; bj < 2; ++bj)
#pragma unroll
                    for (int n = 0; n < 2; ++n) {
                        f32x4 v = acc[ai][bj][m][n];
                        if (rp) v = v + *(const f32x4*)(rp + bj * HALF + n * 16);
                        *(f32x4*)(rowp + bj * HALF + n * 16) = v;
                    }
            }
    } else if constexpr (MODE == 5) {
        LAS float* X0 = (LAS float*)xlds + wr * 512;
        LAS float* X1 = (LAS float*)xlds + 1024 + wr * 512;
#pragma unroll
        for (int ai = 0; ai < 2; ++ai)
#pragma unroll
            for (int m = 0; m < 4; ++m) {
                float v = -INFINITY;
#pragma unroll
                for (int bj = 0; bj < 2; ++bj)
#pragma unroll
                    for (int n = 0; n < 2; ++n) { const f32x4 a = acc[ai][bj][m][n]; v = fmaxf(v, fmaxf(fmaxf(a[0], a[1]), fmaxf(a[2], a[3]))); }
                v = fmaxf(v, __shfl_xor(v, 16)); v = fmaxf(v, __shfl_xor(v, 32));
                if (fq == 0) X0[(ai * 64 + m * 16 + fr) * 4 + wc] = v;
            }
        asm volatile("s_waitcnt lgkmcnt(0)" ::: "memory"); __builtin_amdgcn_s_barrier(); asm volatile("" ::: "memory");
#pragma unroll
        for (int ai = 0; ai < 2; ++ai)
#pragma unroll
            for (int m = 0; m < 4; ++m) {
                const f32x4 p4 = *(const LAS f32x4*)(X0 + (ai * 64 + m * 16 + fr) * 4);
                const float mxr = fmaxf(fmaxf(p4[0], p4[1]), fmaxf(p4[2], p4[3])) * g.escale;
                float s = 0.f;
#pragma unroll
                for (int bj = 0; bj < 2; ++bj)
#pragma unroll
                    for (int n = 0; n < 2; ++n) { f32x4 a = acc[ai][bj][m][n];
                        a[0] = __builtin_amdgcn_exp2f(a[0] * g.escale - mxr); a[1] = __builtin_amdgcn_exp2f(a[1] * g.escale - mxr); a[2] = __builtin_amdgcn_exp2f(a[2] * g.escale - mxr); a[3] = __builtin_amdgcn_exp2f(a[3] * g.escale - mxr);
                        acc[ai][bj][m][n] = a; s += (a[0] + a[1]) + (a[2] + a[3]); }
                s += __shfl_xor(s, 16); s += __shfl_xor(s, 32);
                if (fq == 0) X1[(ai * 64 + m * 16 + fr) * 4 + wc] = s;
            }
        asm volatile("s_waitcnt lgkmcnt(0)" ::: "memory"); __builtin_amdgcn_s_barrier(); asm volatile("" ::: "memory");
        bf16_t* Cb = (bf16_t*)g.C;
        const int col0 = u.pn * BM + wc * 32 + 4 * fq;
#pragma unroll
        for (int ai = 0; ai < 2; ++ai)
#pragma unroll
            for (int m = 0; m < 4; ++m) {
                const f32x4 p4 = *(const LAS f32x4*)(X1 + (ai * 64 + m * 16 + fr) * 4);
                const float inv = 1.0f / ((p4[0] + p4[1]) + (p4[2] + p4[3]));
                bf16_t* rowp = Cb + (size_t)(row0 + ai * HALF + m * 16) * g.ldc + col0;
#pragma unroll
                for (int bj = 0; bj < 2; ++bj)
#pragma unroll
                    for (int n = 0; n < 2; ++n) {
                        const f32x4 a = acc[ai][bj][m][n];
                        uint2 o; o.x = pk2(a[0] * inv, a[1] * inv); o.y = pk2(a[2] * inv, a[3] * inv);
                        *(uint2*)(rowp + bj * HALF + n * 16) = o;
                    }
            }
    } else {
        bf16_t* Cb = (bf16_t*)g.C; int ccol = u.pn * BM;
        if constexpr (MODE == 4) { Cb += (size_t)(u.pn >> 2) * P6S; ccol = (u.pn & 3) * 256; }
        const int col0 = ccol + wc * 32 + 4 * fq;
#pragma unroll
        for (int ai = 0; ai < 2; ++ai)
#pragma unroll
            for (int m = 0; m < 4; ++m) {
                bf16_t* rowp = Cb + (size_t)(row0 + ai * HALF + m * 16) * g.ldc + col0;
#pragma unroll
                for (int bj = 0; bj < 2; ++bj)
#pragma unroll
                    for (int n = 0; n < 2; ++n) {
                        const f32x4 v = acc[ai][bj][m][n];
                        uint2 o; o.x = pk2(v[0], v[1]); o.y = pk2(v[2], v[3]);
                        *(uint2*)(rowp + bj * HALF + n * 16) = o;
                    }
            }
    }
}
template <int MODE> __device__ __forceinline__ void gemm_phase(LAS unsigned char* lds, const GJob& g, int tid) {
    const int wid = __builtin_amdgcn_readfirstlane(tid >> 6), lane = tid & 63, wr = wid >> 2, wc = wid & 3, fr = lane & 15, fq = lane >> 4;
    const int K = g.K, nt = K / BK;
    unsigned voffA[2], voffB[2];
#pragma unroll
    for (int i = 0; i < 2; ++i) { int R, C; stage_rc(tid * 16 + i * 8192, R, C);
        voffA[i] = (unsigned)(R * g.lda + C) * 2u; voffB[i] = (unsigned)(R * g.ldb + C) * 2u; }
    const size_t kstep = (size_t)(BK * 2);
    const size_t hstepA = (size_t)HALF * g.lda * 2, hstepB = (size_t)HALF * g.ldb * 2;
    const unsigned ldsw = (unsigned)wid * 1024u;
    const int aoff = lds_byte(wr * 64 + fr, fq * 8), boff = lds_byte(wc * 32 + fr, fq * 8);
#define PG8_SA(b, h) (((b) * 2 + (h)) * HTB)
#define PG8_SB(b, h) ((4 + (b) * 2 + (h)) * HTB)
#define PG8_STAGE(bufoff, gbase, voff) do { _Pragma("unroll") for (int _i = 0; _i < 2; ++_i) \
        __builtin_amdgcn_global_load_lds((const unsigned*)((const char*)(gbase) + (voff)[_i]), (LAS unsigned*)(lds + (bufoff) + ldsw + _i * 8192), 16, 0, 0); } while (0)
#define PG8_LDA(dst, b, h) do { _Pragma("unroll") for (int m = 0; m < 4; ++m) _Pragma("unroll") for (int k = 0; k < 2; ++k) dst[m][k] = *(const LAS bf16x8*)(lds + PG8_SA(b, h) + aoff + m * 2048 + k * 1024); } while (0)
#define PG8_LDB(dst, b, h) do { _Pragma("unroll") for (int n = 0; n < 2; ++n) _Pragma("unroll") for (int k = 0; k < 2; ++k) dst[n][k] = *(const LAS bf16x8*)(lds + PG8_SB(b, h) + boff + n * 2048 + k * 1024); } while (0)
#define PG8_MMA(ai, bj, At, Bt) do { __builtin_amdgcn_s_setprio(1); _Pragma("unroll") for (int m = 0; m < 4; ++m) _Pragma("unroll") for (int n = 0; n < 2; ++n) _Pragma("unroll") for (int k = 0; k < 2; ++k) \
        acc[ai][bj][m][n] = __builtin_amdgcn_mfma_f32_16x16x32_bf16(Bt[n][k], At[m][k], acc[ai][bj][m][n], 0, 0, 0); __builtin_amdgcn_s_setprio(0); } while (0)
#define PG8_WAIT_V(n) asm volatile("s_waitcnt vmcnt(" #n ")" ::: "memory")
#define PG8_WAIT_L(n) asm volatile("s_waitcnt lgkmcnt(" #n ")" ::: "memory")
#define PG8_BAR __builtin_amdgcn_s_barrier()
#define PG8_SCHED __builtin_amdgcn_sched_barrier(0)
#define PG8_ABASE(u) ((const char*)g.A + ((size_t)(u).pm * BM * g.lda + (size_t)(((u).pn >> g.a_pn_shift) & g.a_pn_mask) * g.a_pn_step) * 2)
#define PG8_BBASE(u) ((const char*)g.Bt + ((size_t)(u).pn * g.b_pn_step + (size_t)((u).pm >> g.b_pm_shift) * g.b_pm_step) * 2)
    Unit cur, nxt; int ui = 0;
    if (!unit_next(g, 0, cur)) return;
    f32x4 acc[2][2][4][2];
#pragma unroll
    for (int a = 0; a < 2; ++a)
#pragma unroll
        for (int b = 0; b < 2; ++b)
#pragma unroll
            for (int m = 0; m < 4; ++m)
#pragma unroll
                for (int n = 0; n < 2; ++n) acc[a][b][m][n] = (f32x4){0.f, 0.f, 0.f, 0.f};
    bf16x8 At[4][2], B0[2][2], B1[2][2];
    const char* cA = PG8_ABASE(cur); const char* cB = PG8_BBASE(cur);
    PG8_STAGE(PG8_SB(0, 0), cB, voffB); PG8_STAGE(PG8_SA(0, 0), cA, voffA); PG8_STAGE(PG8_SB(0, 1), cB + hstepB, voffB); PG8_STAGE(PG8_SA(0, 1), cA + hstepA, voffA);
    if (wr == 1) PG8_BAR;
    PG8_WAIT_V(4); PG8_BAR;
    PG8_STAGE(PG8_SB(1, 0), cB + kstep, voffB); PG8_STAGE(PG8_SA(1, 0), cA + kstep, voffA); PG8_STAGE(PG8_SB(1, 1), cB + hstepB + kstep, voffB);
    PG8_WAIT_V(6); PG8_BAR;
    for (;;) {
        const bool has_next = unit_next(g, ui + 1, nxt);
        const char* nA = has_next ? PG8_ABASE(nxt) : cA; const char* nB = has_next ? PG8_BBASE(nxt) : cB;
        for (int t = 0; t < nt; t += 2) {
            const bool last = (t == nt - 2);
            const char* a1 = cA + (size_t)(t + 1) * kstep;
            const char* a2 = last ? nA : cA + (size_t)(t + 2) * kstep; const char* b2 = last ? nB : cB + (size_t)(t + 2) * kstep;
            const char* a3 = a2 + kstep; const char* b3 = b2 + kstep;
            PG8_LDB(B0, 0, 0); PG8_SCHED; PG8_LDA(At, 0, 0); PG8_STAGE(PG8_SA(1, 1), a1 + hstepA, voffA);
            PG8_WAIT_L(8); PG8_BAR; PG8_WAIT_L(0); PG8_MMA(0, 0, At, B0); PG8_BAR; PG8_SCHED;
            PG8_LDB(B1, 0, 1); PG8_STAGE(PG8_SB(0, 0), b2, voffB);
            PG8_BAR; PG8_WAIT_L(0); PG8_MMA(0, 1, At, B1); PG8_BAR;
            PG8_LDA(At, 0, 1); PG8_STAGE(PG8_SA(0, 0), a2, voffA);
            PG8_BAR; PG8_WAIT_L(0); PG8_MMA(1, 0, At, B0); PG8_BAR; PG8_SCHED;
            PG8_STAGE(PG8_SB(0, 1), b2 + hstepB, voffB);
            PG8_WAIT_V(6); PG8_BAR; PG8_MMA(1, 1, At, B1); PG8_BAR;
            PG8_LDB(B0, 1, 0); PG8_SCHED; PG8_LDA(At, 1, 0); PG8_STAGE(PG8_SA(0, 1), a2 + hstepA, voffA);
            PG8_WAIT_L(8); PG8_BAR; PG8_WAIT_L(0); PG8_MMA(0, 0, At, B0); PG8_BAR; PG8_SCHED;
            PG8_LDB(B1, 1, 1); PG8_STAGE(PG8_SB(1, 0), b3, voffB);
            PG8_BAR; PG8_WAIT_L(0); PG8_MMA(0, 1, At, B1); PG8_BAR;
            PG8_LDA(At, 1, 1); PG8_STAGE(PG8_SA(1, 0), a3, voffA);
            PG8_BAR; PG8_WAIT_L(0); PG8_MMA(1, 0, At, B0); PG8_BAR; PG8_SCHED;
            PG8_STAGE(PG8_SB(1, 1), b3 + hstepB, voffB);
            PG8_WAIT_V(6); PG8_BAR; PG8_MMA(1, 1, At, B1); PG8_BAR;
        }
        epilogue<MODE>(g, acc, cur, wr, wc, fr, fq, lds + GEMM_LDS + 1024);
        if (!has_next) break;
#pragma unroll
        for (int a = 0; a < 2; ++a)
#pragma unroll
            for (int b = 0; b < 2; ++b)
#pragma unroll
                for (int m = 0; m < 4; ++m)
#pragma unroll
                    for (int n = 0; n < 2; ++n) acc[a][b][m][n] = (f32x4){0.f, 0.f, 0.f, 0.f};
        cur = nxt; cA = nA; cB = nB; ++ui;
    }
    PG8_WAIT_V(0);
    if (wr == 0) PG8_BAR;
    PG8_BAR;
#undef PG8_SA
#undef PG8_SB
#undef PG8_STAGE
#undef PG8_LDA
#undef PG8_LDB
#undef PG8_MMA
#undef PG8_WAIT_V
#undef PG8_WAIT_L
#undef PG8_BAR
#undef PG8_SCHED
#undef PG8_ABASE
#undef PG8_BBASE
}
}

__device__ __forceinline__ void p0_transpose_item(const float* W, int ldw, int K, int csrc0, bf16_t* WT, int row0, LAS float* scr, int kb, int lane) {
    const int k0 = 64 * kb;
#pragma unroll 8
    for (int i = 0; i < 32; ++i) { const int kk = 2 * i + (lane >> 5); scr[kk * 33 + (lane & 31)] = W[(size_t)(k0 + kk) * ldw + csrc0 + (lane & 31)]; }
    asm volatile("s_waitcnt lgkmcnt(0)" ::: "memory");
    const int c = lane & 7;
#pragma unroll
    for (int j = 0; j < 4; ++j) { const int n = (lane >> 3) + 8 * j; const LAS float* s = scr + (8 * c) * 33 + n;
        uint4 o; o.x = pk2(s[0 * 33], s[1 * 33]); o.y = pk2(s[2 * 33], s[3 * 33]); o.z = pk2(s[4 * 33], s[5 * 33]); o.w = pk2(s[6 * 33], s[7 * 33]);
        *(uint4*)(WT + (size_t)(row0 + n) * K + k0 + 8 * c) = o; }
    asm volatile("s_waitcnt lgkmcnt(0)" ::: "memory");
}

__device__ __forceinline__ void d_conv_silu(int vb, int tid, const bf16_t* __restrict__ p6, const float* __restrict__ cw, const float* __restrict__ cb, bf16_t* __restrict__ c) {
    const int t = vb, s = t % S;
    for (int ch = tid; ch < 1024; ch += 256) {
        float y = cb[ch];
#pragma unroll
        for (int j = 0; j < 4; ++j) {
            const int ss = s - 3 + j;
            if (ss >= 0) y = fmaf(cw[j * 1024 + ch], bf2f(p6[(size_t)(t - 3 + j) * 1024 + ch]), y);
        }
        c[(size_t)t * 1024 + ch] = (bf16_t)f2bf(y / (1.0f + expf(-y)));
    }
}

__device__ __forceinline__ void d_mlstm(int vb, int tid, const bf16_t* __restrict__ mq, const bf16_t* __restrict__ mk, const bf16_t* __restrict__ p6,
                                        const float* __restrict__ gpre, const float* __restrict__ b_mi, const float* __restrict__ b_mf, float* __restrict__ hraw) {
    const int lane = tid & 63, w = tid >> 6;
    const int gid = vb * 4 + w;
    const int e = gid & 255, h = (gid >> 8) & 3, b = gid >> 10;
    const float bi = b_mi[h], bf = b_mf[h];
    float C0 = 0.f, C1 = 0.f, C2 = 0.f, C3 = 0.f, n0 = 0.f, n1 = 0.f, n2 = 0.f, n3 = 0.f, m = 0.f;
    const size_t tb = (size_t)b * S;
    const bf16_t* qp = mq + tb * 1024 + h * 256 + lane * 4;
    const bf16_t* kp = mk + tb * 1024 + h * 256 + lane * 4;
    const bf16_t* pp = p6 + P6S + tb * 1024 + h * 256 + e;
    ushort4 qn = *(const ushort4*)qp, kn = *(const ushort4*)kp;
    const float* gp = gpre + tb * 8;
    float vn = bf2f(pp[0]), in_ = gp[h], fn = gp[4 + h];
    for (int s = 0; s < S; ++s) {
        const float4 q = make_float4(bf2f(qn.x), bf2f(qn.y), bf2f(qn.z), bf2f(qn.w)), k = make_float4(bf2f(kn.x), bf2f(kn.y), bf2f(kn.z), bf2f(kn.w)); const float v = vn, ipre = in_ + bi, fpre = fn + bf;
        if (s + 1 < S) {
            qn = *(const ushort4*)(qp + (size_t)(s + 1) * 1024);
            kn = *(const ushort4*)(kp + (size_t)(s + 1) * 1024);
            vn = bf2f(pp[(size_t)(s + 1) * 1024]); in_ = gp[(size_t)(s + 1) * 8 + h]; fn = gp[(size_t)(s + 1) * 8 + 4 + h];
        }
        const float logf = log_sigmoid(fpre);
        const float mnew = fmaxf(logf + m, ipre);
        const float fd = expf(logf + m - mnew), ig = expf(ipre - mnew);
        m = mnew;
        const float sc = ig * 0.0625f;
        C0 = fd * C0 + sc * k.x * v; C1 = fd * C1 + sc * k.y * v; C2 = fd * C2 + sc * k.z * v; C3 = fd * C3 + sc * k.w * v;
        n0 = fd * n0 + sc * k.x; n1 = fd * n1 + sc * k.y; n2 = fd * n2 + sc * k.z; n3 = fd * n3 + sc * k.w;
        float num = q.x * C0 + q.y * C1 + q.z * C2 + q.w * C3;
        float den = q.x * n0 + q.y * n1 + q.z * n2 + q.w * n3;
        num = wave_sum(num); den = wave_sum(den);
        if (lane == 0) hraw[(tb + s) * 1024 + h * 256 + e] = num / fmaxf(fabsf(den), expf(-mnew));
    }
}

__device__ __forceinline__ void d_mhead_norm(int vb, int tid, const float* __restrict__ hraw, const bf16_t* __restrict__ p6, const float* __restrict__ g, bf16_t* __restrict__ mix) {
    const int t = vb, h = tid >> 6, lane = tid & 63;
    const float4 v = *(const float4*)(hraw + (size_t)t * 1024 + h * 256 + lane * 4);
    float s = v.x * v.x + v.y * v.y + v.z * v.z + v.w * v.w;
    s = wave_sum(s);
    const float r = rsqrtf(s * (1.0f / 256.0f) + EPS);
    const float4 gg = *(const float4*)(g + h * 256 + lane * 4);
    const ushort4 mo = *(const ushort4*)(p6 + 2 * P6S + (size_t)t * 1024 + h * 256 + lane * 4);
    float4 o;
    o.x = v.x * r * gg.x / (1.0f + expf(-bf2f(mo.x)));
    o.y = v.y * r * gg.y / (1.0f + expf(-bf2f(mo.y)));
    o.z = v.z * r * gg.z / (1.0f + expf(-bf2f(mo.z)));
    o.w = v.w * r * gg.w / (1.0f + expf(-bf2f(mo.w)));
    uint2 ob; ob.x = pk2(o.x, o.y); ob.y = pk2(o.z, o.w);
    *(uint2*)(mix + (size_t)t * D + h * 256 + lane * 4) = ob;
}

__device__ __forceinline__ void d_rope(int vb, int tid, bf16_t* __restrict__ p6) {
    const int t = vb, s = t % S;
    for (int idx = tid; idx < 2 * 8 * 64; idx += 256) {
        const int i = idx & 63, hd = (idx >> 6) & 7, qk = idx >> 9;
        const float inv = exp2f(-(float)i * 0.20762050593046014f);
        const float ang = (float)s * inv;
        float sn, cs; sincosf(ang, &sn, &cs);
        bf16_t* p = p6 + (size_t)(3 + qk) * P6S + (size_t)t * 1024 + hd * 128;
        const float x1 = bf2f(p[i]), x2 = bf2f(p[64 + i]);
        p[i] = (bf16_t)f2bf(x1 * cs - x2 * sn);
        p[64 + i] = (bf16_t)f2bf(x2 * cs + x1 * sn);
    }
}

__device__ __forceinline__ void d_dilated(int vb, int tid, float* sm, const bf16_t* __restrict__ p6, const float* __restrict__ g_ahead, bf16_t* __restrict__ mix) {
    float (*qs)[128] = (float (*)[128])sm;
    float (*ps)[576] = (float (*)[576])(sm + 512);
    const int lane = tid & 63, w = tid >> 6;
    const int gid = vb * 4 + w;
    const int s = gid % S, hd = (gid / S) & 7, b = gid / (S * 8);
    const size_t t = (size_t)b * S + s;
    const bf16_t* qrow = p6 + 3 * P6S + t * 1024 + hd * 128;
    __syncthreads();
    qs[w][lane] = bf2f(qrow[lane]); qs[w][lane + 64] = bf2f(qrow[lane + 64]);
    __syncthreads();
    const float scale = 0.08838834764831845f;
    float mloc = -INFINITY;
    for (int br = 0; br < 3; ++br) {
        const int dil = br == 0 ? 1 : (br == 1 ? 4 : 16);
        for (int jj = 0; jj < 192; jj += 64) {
            const int j = jj + lane;
            float sc = -INFINITY;
            if (j <= 128 && s - j * dil >= 0) {
                const bf16_t* krow = p6 + 4 * P6S + (t - (size_t)j * dil) * 1024 + hd * 128;
                float d = 0.f;
#pragma unroll 8
                for (int c = 0; c < 128; c += 4) {
                    const ushort4 kv = *(const ushort4*)(krow + c);
                    d = fmaf(qs[w][c], bf2f(kv.x), d); d = fmaf(qs[w][c + 1], bf2f(kv.y), d); d = fmaf(qs[w][c + 2], bf2f(kv.z), d); d = fmaf(qs[w][c + 3], bf2f(kv.w), d);
                }
                sc = d * scale;
            }
            ps[w][br * 192 + j] = sc;
            mloc = fmaxf(mloc, sc);
        }
    }
    const float mx = wave_max(mloc);
    __syncthreads();
    float lsum = 0.f;
    for (int i = lane; i < 3 * 192; i += 64) {
        const float sc = ps[w][i];
        const float pv = (sc == -INFINITY) ? 0.f : expf(sc - mx);
        ps[w][i] = pv; lsum += pv;
    }
    const float tot = wave_sum(lsum);
    __syncthreads();
    float o0 = 0.f, o1 = 0.f;
    for (int br = 0; br < 3; ++br) {
        const int dil = br == 0 ? 1 : (br == 1 ? 4 : 16);
        for (int j = 0; j <= 128; ++j) {
            if (s - j * dil < 0) break;
            const float pv = ps[w][br * 192 + j];
            const bf16_t* vrow = p6 + 5 * P6S + (t - (size_t)j * dil) * 1024 + hd * 128;
            o0 = fmaf(pv, bf2f(vrow[lane]), o0); o1 = fmaf(pv, bf2f(vrow[lane + 64]), o1);
        }
    }
    o0 /= tot; o1 /= tot;
    float ss = wave_sum(o0 * o0 + o1 * o1);
    const float r = rsqrtf(ss * (1.0f / 128.0f) + EPS);
    bf16_t* orow = mix + t * D + 1024 + hd * 128;
    orow[lane] = (bf16_t)f2bf(o0 * r * g_ahead[hd * 128 + lane]);
    orow[lane + 64] = (bf16_t)f2bf(o1 * r * g_ahead[hd * 128 + lane + 64]);
}

__device__ __forceinline__ void d_cross(int vb, int tid, float* sm, const bf16_t* __restrict__ q, const float* __restrict__ km, const float* __restrict__ vm, bf16_t* __restrict__ o) {
    float (*qs)[512] = (float (*)[512])sm;
    float (*ps)[256] = (float (*)[256])(sm + 2048);
    const int lane = tid & 63, w = tid >> 6;
    const int t = vb, hd = w, b = t / S;
    const bf16_t* qrow = q + (size_t)t * D + hd * 512;
    __syncthreads();
    for (int i = lane; i < 512; i += 64) qs[w][i] = bf2f(qrow[i]);
    __syncthreads();
    const float scale = 0.04419417382415922f;
    float sc[4]; float mloc = -INFINITY;
#pragma unroll
    for (int r = 0; r < 4; ++r) {
        const int mi = lane + 64 * r;
        const float* krow = km + ((size_t)b * 256 + mi) * D + hd * 512;
        float d = 0.f;
#pragma unroll 8
        for (int c = 0; c < 512; c += 4) {
            const float4 kv = *(const float4*)(krow + c);
            d = fmaf(qs[w][c], kv.x, d); d = fmaf(qs[w][c + 1], kv.y, d); d = fmaf(qs[w][c + 2], kv.z, d); d = fmaf(qs[w][c + 3], kv.w, d);
        }
        sc[r] = d * scale; mloc = fmaxf(mloc, sc[r]);
    }
    const float mx = wave_max(mloc);
    float lsum = 0.f;
#pragma unroll
    for (int r = 0; r < 4; ++r) { const float pv = expf(sc[r] - mx); ps[w][lane + 64 * r] = pv; lsum += pv; }
    const float tot = wave_sum(lsum);
    __syncthreads();
    float acc[8];
#pragma unroll
    for (int i = 0; i < 8; ++i) acc[i] = 0.f;
    for (int mi = 0; mi < 256; ++mi) {
        const float pv = ps[w][mi];
        const float* vrow = vm + ((size_t)b * 256 + mi) * D + hd * 512;
#pragma unroll
        for (int i = 0; i < 8; ++i) acc[i] = fmaf(pv, vrow[lane + 64 * i], acc[i]);
    }
    bf16_t* orow = o + (size_t)t * D + hd * 512;
#pragma unroll
    for (int i = 0; i < 8; ++i) orow[lane + 64 * i] = (bf16_t)f2bf(acc[i] / tot);
}

__device__ __forceinline__ void wave_argmax(float& best, int& bidx) {
#pragma unroll
    for (int o = 32; o >= 1; o >>= 1) {
        const float ob = __shfl_xor(best, o); const int oi = __shfl_xor(bidx, o);
        if (ob > best || (ob == best && oi < bidx)) { best = ob; bidx = oi; }
    }
}
__device__ __forceinline__ void d_peer_topk(int vb, int tid, float* sm, const bf16_t* __restrict__ qp, const float* __restrict__ sub_keys, int* __restrict__ ids, float* __restrict__ gates) {
    float (*qs)[256] = (float (*)[256])sm;
    const int lane = tid & 63, w = tid >> 6;
    const int gid = vb * 4 + w;
    const int hd = gid & 7, t = gid >> 3;
    const bf16_t* qrow = qp + (size_t)t * D + hd * 256;
    __syncthreads();
    for (int i = lane; i < 256; i += 64) qs[w][i] = bf2f(qrow[i]);
    __syncthreads();
    float tops[2]; int topi[2];
#pragma unroll
    for (int p = 0; p < 2; ++p) {
        float v0, v1;
        {
            const float* k0 = sub_keys + ((size_t)(hd * 2 + p) * 128 + lane) * 128;
            const float* k1 = k0 + 64 * 128;
            float d0 = 0.f, d1 = 0.f;
#pragma unroll 8
            for (int c = 0; c < 128; c += 4) {
                const float4 a = *(const float4*)(k0 + c), bb = *(const float4*)(k1 + c);
                const float q0 = qs[w][p * 128 + c], q1 = qs[w][p * 128 + c + 1], q2 = qs[w][p * 128 + c + 2], q3 = qs[w][p * 128 + c + 3];
                d0 = fmaf(q0, a.x, d0); d0 = fmaf(q1, a.y, d0); d0 = fmaf(q2, a.z, d0); d0 = fmaf(q3, a.w, d0);
                d1 = fmaf(q0, bb.x, d1); d1 = fmaf(q1, bb.y, d1); d1 = fmaf(q2, bb.z, d1); d1 = fmaf(q3, bb.w, d1);
            }
            v0 = d0; v1 = d1;
        }
        float ts = 0.f; int ti = 0;
        for (int it = 0; it < 16; ++it) {
            float best; int bidx;
            if (v0 >= v1) { best = v0; bidx = lane; } else { best = v1; bidx = lane + 64; }
            wave_argmax(best, bidx);
            if (lane == it) { ts = best; ti = bidx; }
            if (bidx == lane) v0 = -INFINITY;
            if (bidx == lane + 64) v1 = -INFINITY;
        }
        tops[p] = ts; topi[p] = ti;
    }
    float cv[4]; int ci[4];
#pragma unroll
    for (int r = 0; r < 4; ++r) {
        const int c = lane * 4 + r, i = c >> 4, j = c & 15;
        const float s0 = __shfl(tops[0], i), s1 = __shfl(tops[1], j);
        const int i0 = __shfl(topi[0], i), i1 = __shfl(topi[1], j);
        cv[r] = s0 + s1; ci[r] = i0 * 128 + i1;
    }
    float bs = 0.f; int bid = 0;
    for (int it = 0; it < 16; ++it) {
        float best = cv[0]; int bidx = lane * 4;
#pragma unroll
        for (int r = 1; r < 4; ++r) if (cv[r] > best) { best = cv[r]; bidx = lane * 4 + r; }
        wave_argmax(best, bidx);
        const int owner = bidx >> 2, rr = bidx & 3;
        int myid = ci[0];
        if (rr == 1) myid = ci[1]; else if (rr == 2) myid = ci[2]; else if (rr == 3) myid = ci[3];
        const int eid = __shfl(myid, owner);
        if (lane == it) { bs = best; bid = eid; }
        if (owner == lane) {
#pragma unroll
            for (int r = 0; r < 4; ++r) if (rr == r) cv[r] = -INFINITY;
        }
    }
    float v = lane < 16 ? bs : -INFINITY;
    const float mx = wave_max(v);
    const float ev = lane < 16 ? expf(bs - mx) : 0.f;
    const float tot = wave_sum(ev);
    if (lane < 16) {
        ids[(size_t)t * 128 + hd * 16 + lane] = bid;
        gates[(size_t)t * 128 + hd * 16 + lane] = ev / tot;
    }
}

__device__ __forceinline__ void d_peer_out(int vb, int tid, float* sm, const bf16_t* __restrict__ h3, const float* __restrict__ x2, const int* __restrict__ ids, const float* __restrict__ gates,
                                           const bf16_t* __restrict__ u_tab, const bf16_t* __restrict__ v_tab, const float* __restrict__ g_final, float* __restrict__ out) {
    float (*part)[2048] = (float (*)[2048])sm;
    float* red = sm + 4 * 2048;
    const int lane = tid & 63, w = tid >> 6, t = vb;
    float4 xr[8], acc[8];
    const bf16_t* hrow = h3 + (size_t)t * D;
#pragma unroll
    for (int i = 0; i < 8; ++i) { const ushort4 hv = *(const ushort4*)(hrow + i * 256 + lane * 4);
        xr[i] = make_float4(bf2f(hv.x), bf2f(hv.y), bf2f(hv.z), bf2f(hv.w)); acc[i] = make_float4(0.f, 0.f, 0.f, 0.f); }
    for (int j = 0; j < 32; ++j) {
        const int slot = w * 32 + j;
        const int e = ids[(size_t)t * 128 + slot];
        const float gt = gates[(size_t)t * 128 + slot];
        const bf16_t* ur = u_tab + (size_t)e * D;
        const bf16_t* vr = v_tab + (size_t)e * D;
        float d = 0.f;
#pragma unroll
        for (int i = 0; i < 8; ++i) {
            const ushort4 u = *(const ushort4*)(ur + i * 256 + lane * 4);
            d = fmaf(xr[i].x, bf2f(u.x), d); d = fmaf(xr[i].y, bf2f(u.y), d); d = fmaf(xr[i].z, bf2f(u.z), d); d = fmaf(xr[i].w, bf2f(u.w), d);
        }
        d = wave_sum(d);
        const float act = 0.5f * d * (1.0f + erff(d * 0.7071067811865476f));
        const float cf = gt * act;
#pragma unroll
        for (int i = 0; i < 8; ++i) {
            const ushort4 v = *(const ushort4*)(vr + i * 256 + lane * 4);
            acc[i].x = fmaf(cf, bf2f(v.x), acc[i].x); acc[i].y = fmaf(cf, bf2f(v.y), acc[i].y); acc[i].z = fmaf(cf, bf2f(v.z), acc[i].z); acc[i].w = fmaf(cf, bf2f(v.w), acc[i].w);
        }
    }
    __syncthreads();
#pragma unroll
    for (int i = 0; i < 8; ++i) *(float4*)&part[w][i * 256 + lane * 4] = acc[i];
    __syncthreads();
    float4 r0, r1;
    {
        const float4 a = *(const float4*)&part[0][tid * 4], b = *(const float4*)&part[1][tid * 4], c = *(const float4*)&part[2][tid * 4], d = *(const float4*)&part[3][tid * 4];
        const float4 x = *(const float4*)(x2 + (size_t)t * D + tid * 4);
        r0 = make_float4(x.x + a.x + b.x + c.x + d.x, x.y + a.y + b.y + c.y + d.y, x.z + a.z + b.z + c.z + d.z, x.w + a.w + b.w + c.w + d.w);
    }
    {
        const float4 a = *(const float4*)&part[0][1024 + tid * 4], b = *(const float4*)&part[1][1024 + tid * 4], c = *(const float4*)&part[2][1024 + tid * 4], d = *(const float4*)&part[3][1024 + tid * 4];
        const float4 x = *(const float4*)(x2 + (size_t)t * D + 1024 + tid * 4);
        r1 = make_float4(x.x + a.x + b.x + c.x + d.x, x.y + a.y + b.y + c.y + d.y, x.z + a.z + b.z + c.z + d.z, x.w + a.w + b.w + c.w + d.w);
    }
    float s = r0.x * r0.x + r0.y * r0.y + r0.z * r0.z + r0.w * r0.w + r1.x * r1.x + r1.y * r1.y + r1.z * r1.z + r1.w * r1.w;
    s = wave_sum(s);
    if (lane == 0) red[w] = s;
    __syncthreads();
    const float tot = red[0] + red[1] + red[2] + red[3];
    const float r = rsqrtf(tot * (1.0f / D) + EPS);
    const float4 g0 = *(const float4*)(g_final + tid * 4), g1 = *(const float4*)(g_final + 1024 + tid * 4);
    *(float4*)(out + (size_t)t * D + tid * 4) = make_float4(r0.x * r * g0.x, r0.y * r * g0.y, r0.z * r * g0.z, r0.w * r * g0.w);
    *(float4*)(out + (size_t)t * D + 1024 + tid * 4) = make_float4(r1.x * r * g1.x, r1.y * r * g1.y, r1.z * r * g1.z, r1.w * r * g1.w);
}

struct Params {
    const float *x, *mem, *g_mix, *w_in, *conv_w, *conv_b, *w_mq, *w_mk, *b_mi, *b_mf, *g_mhead, *g_ahead, *w_out, *g_cross, *g_mem,
                *w_xq, *w_xk, *w_xv, *w_xo, *g_ffn, *w_pq, *sub_keys, *u_tab, *v_tab, *g_final;
    float* out;
    unsigned* bar;
    float* ws;
};

#define PHASE_LOOP(nvb) for (int base_ = blockIdx.x * 2; base_ < (nvb); base_ += gridDim.x * 2)
#define VB (base_ + half)

__global__ void __launch_bounds__(NTHR) mega(Params P) {
    volatile LAS unsigned* st = (volatile LAS unsigned*)(LAS unsigned char*)(smem_raw + GEMM_LDS);
    if (threadIdx.x == 0) { st[0] = 0u; st[1] = 0u; st[2] = 0u; st[3] = 0u; }
    if (threadIdx.x < I_NPTR) ((LAS unsigned long long*)(LAS unsigned char*)(smem_raw + GEMM_LDS + 64))[threadIdx.x] = ((const unsigned long long*)&P)[threadIdx.x];
    __syncthreads();
    XcdBarrier xb = xcd_barrier_post((unsigned*)ldp_raw(I_BAR), st);

    constexpr size_t TD = (size_t)T * D;
    constexpr size_t O_HB = 6 * P6S * 2, O_CBUF = O_HB + (size_t)T * D * 2, O_MQ = O_CBUF + (size_t)T * 1024 * 2, O_MK = O_MQ + (size_t)T * 1024 * 2,
                     O_MIXB = O_MK + (size_t)T * 1024 * 2, O_WIN = O_MIXB + (size_t)T * D * 2, O_WOUT = O_WIN + (size_t)6144 * D * 2, O_WXQ = O_WOUT + (size_t)D * D * 2,
                     O_WXK = O_WXQ + (size_t)D * D * 2, O_WXV = O_WXK + (size_t)D * D * 2, O_WXO = O_WXV + (size_t)D * D * 2, O_WPQ = O_WXO + (size_t)D * D * 2,
                     O_WQK = O_WPQ + (size_t)D * D * 2, O_GPRE = O_WQK + (size_t)8 * 256 * 256 * 2, O_UT = O_GPRE + (size_t)T * 8 * 4, O_VT = O_UT + (size_t)16384 * D * 2,
                     O_END = O_VT + (size_t)16384 * D * 2;
    static_assert(O_END + 16384 <= (size_t)536870912, "workspace overflow");
#define W_P6    ((bf16_t*)wsb)
#define W_HB    ((bf16_t*)(wsb + O_HB))
#define W_CBUF  ((bf16_t*)(wsb + O_CBUF))
#define W_MQ    ((bf16_t*)(wsb + O_MQ))
#define W_MK    ((bf16_t*)(wsb + O_MK))
#define W_MIXB  ((bf16_t*)(wsb + O_MIXB))
#define W_GPRE  ((float*)(wsb + O_GPRE))
#define W_HRAW  ((float*)(wsb + O_HB))
#define W_XR    ((float*)wsb)
#define W_MN    ((bf16_t*)((float*)wsb + TD))
#define W_KM    ((bf16_t*)((float*)wsb + TD + (size_t)256 * D))
#define W_VMT   ((bf16_t*)((float*)wsb + TD + (size_t)768 * D))
#define W_PX    ((bf16_t*)(wsb + O_MK))
#define W_GATES ((float*)wsb + TD + (size_t)1280 * D)
#define W_IDS   ((int*)((float*)wsb + TD + (size_t)1280 * D + (size_t)T * 128))
#define W_QX    ((bf16_t*)(wsb + O_CBUF))
#define W_UT    ((bf16_t*)(wsb + O_UT))
#define W_VT    ((bf16_t*)(wsb + O_VT))
#define PH_BEGIN() int tidx = threadIdx.x; asm volatile("" : "+v"(tidx)); const int half = tidx >> 8, tid = tidx & 255; float* sm = (float*)smem_raw + half * HALF_SM_FLOATS; \
                   char* wsb = (char*)ldp_raw(I_WS); (void)half; (void)tid; (void)sm; (void)wsb
#define GJOB_DEFAULT(g) pg8::GJob g; g.lda = D; g.ldb = D; g.K = D; g.nM = 32; g.nN = 8; g.a_pn_shift = 0; g.a_pn_mask = 0; g.a_pn_step = 0; g.b_pm_shift = 0; g.b_pm_step = 0; g.b_pn_step = 256 * D; \
                        g.ldc = D; g.R = nullptr; g.ldr = D; g.mode = 0; g.escale = 1.0f
#define GEMM_LDSP ((LAS unsigned char*)smem_raw)

    {
        PH_BEGIN();
        {
            LAS float* scr = (LAS float*)(LAS unsigned char*)(smem_raw) + (tidx >> 6) * (64 * 33);
            const int lane = tidx & 63;
            const int gw = blockIdx.x * 8 + (tidx >> 6), NGW = gridDim.x * 8;
            constexpr int I_IN = 32 * 192, I_SQ = 32 * 64, I_QK = 8 * 4 * 8;
            constexpr int NITEMS = I_IN + 6 * I_SQ + I_QK;
#pragma nounroll
            for (int it = gw; it < NITEMS; it += NGW) {
                const float* W; int ldw, K, csrc0, row0, kb; bf16_t* WT;
                int r = it;
                if (r < I_IN) { const int nb = r % 192; kb = r / 192; W = PF(I_WIN); ldw = INC; K = D; csrc0 = nb * 32 + (nb >= 96 ? 8 : 0); WT = (bf16_t*)(wsb + O_WIN); row0 = nb * 32; }
                else if ((r -= I_IN) < 6 * I_SQ) {
                    const int wsel = r / I_SQ; r -= wsel * I_SQ; const int nb = r % 64; kb = r / 64; ldw = D; K = D; csrc0 = nb * 32; row0 = nb * 32;
                    W = PF(wsel == 0 ? I_WOUT : wsel == 1 ? I_WXQ : wsel == 2 ? I_WXK : wsel == 3 ? I_WXV : wsel == 4 ? I_WXO : I_WPQ);
                    WT = (bf16_t*)(wsb + O_WOUT + (size_t)wsel * ((size_t)D * D * 2));
                } else {
                    r -= 6 * I_SQ; const int hq = r / 32; r -= hq * 32; const int nb = r % 8; kb = r / 8;
                    W = PF(hq < 4 ? I_WMQ : I_WMK) + (size_t)(hq & 3) * 65536; ldw = 256; K = 256; csrc0 = nb * 32; WT = (bf16_t*)(wsb + O_WQK); row0 = hq * 256 + nb * 32;
                }
                p0_transpose_item(W, ldw, K, csrc0, WT, row0, scr, kb, lane);
            }
            {
                const float* ut = PF(I_UTAB); const float* vt = PF(I_VTAB);
                const size_t n8 = (size_t)16384 * D / 8, nth = (size_t)gridDim.x * NTHR;
#pragma nounroll
                for (size_t i = (size_t)blockIdx.x * NTHR + tidx; i < 2 * n8; i += nth) {
                    const bool second = i >= n8; const size_t k = second ? i - n8 : i;
                    const float4* sp = (const float4*)((second ? vt : ut) + k * 8);
                    const float4 a = sp[0], b = sp[1];
                    uint4 o; o.x = pk2(a.x, a.y); o.y = pk2(a.z, a.w); o.z = pk2(b.x, b.y); o.w = pk2(b.z, b.w);
                    *(uint4*)((second ? W_VT : W_UT) + k * 8) = o;
                }
            }
            __syncthreads();
        }
        { const float* rin = PF(I_X); const float* rg = PF(I_GMIX); const float* win = PF(I_WIN);
#pragma nounroll
          PHASE_LOOP(T) d_rmsnorm(VB, tid, sm, rin, rg, W_HB, win, W_GPRE); }
    }
    xcd_barrier(xb);
    {
        PH_BEGIN();
        GJOB_DEFAULT(g); g.A = W_HB; g.Bt = (bf16_t*)(wsb + O_WIN); g.nN = 24; g.C = (float*)W_P6; g.ldc = 1024;
        pg8::gemm_phase<4>(GEMM_LDSP, g, tidx);
    }
    xcd_barrier(xb);
    {
        PH_BEGIN();
        const float* cw = PF(I_CONVW); const float* cb = PF(I_CONVB);
#pragma nounroll
        PHASE_LOOP(T) d_conv_silu(VB, tid, W_P6, cw, cb, W_CBUF);
#pragma nounroll
        PHASE_LOOP(T) d_rope(VB, tid, W_P6);
    }
    xcd_barrier(xb);
    {
        PH_BEGIN();
        {
            GJOB_DEFAULT(g); g.A = W_CBUF; g.lda = 1024; g.Bt = (bf16_t*)(wsb + O_WQK); g.ldb = 256; g.b_pn_step = 256 * 256; g.K = 256; g.a_pn_mask = 3; g.a_pn_step = 256; g.C = (float*)W_MQ; g.ldc = 1024;
            pg8::gemm_phase<4>(GEMM_LDSP, g, tidx);
            __syncthreads();
        }
        const float* ga = PF(I_GAHEAD);
#pragma nounroll
        PHASE_LOOP(NB * 8 * S / 4) d_dilated(VB, tid, sm, W_P6, ga, W_MIXB);
    }
    xcd_barrier(xb);
    {
        PH_BEGIN();
        const float* bmi = PF(I_BMI); const float* bmf = PF(I_BMF);
#pragma nounroll
        PHASE_LOOP(NB * 4 * 256 / 4) d_mlstm(VB, tid, W_MQ, W_MK, W_P6, W_GPRE, bmi, bmf, W_HRAW);
    }
    xcd_barrier(xb);
    {
        PH_BEGIN();
        const float* gm = PF(I_GMHEAD);
#pragma nounroll
        PHASE_LOOP(T) d_mhead_norm(VB, tid, W_HRAW, W_P6, gm, W_MIXB);
    }
    xcd_barrier(xb);
    {
        PH_BEGIN();
        GJOB_DEFAULT(g); g.A = W_MIXB; g.Bt = (bf16_t*)(wsb + O_WOUT); g.C = W_XR; g.R = PF(I_X);
        pg8::gemm_phase<0>(GEMM_LDSP, g, tidx);
    }
    xcd_barrier(xb);
    {
        PH_BEGIN();
        { const float* rg = PF(I_GCROSS); const float* win = PF(I_WIN);
#pragma nounroll
          PHASE_LOOP(T) d_rmsnorm(VB, tid, sm, W_XR, rg, W_HB, win, nullptr); }
        { const float* rin = PF(I_MEM); const float* rg = PF(I_GMEM); const float* win = PF(I_WIN);
#pragma nounroll
          PHASE_LOOP(512) d_rmsnorm(VB, tid, sm, rin, rg, W_MN, win, nullptr); }
    }
    xcd_barrier(xb);
    {
        PH_BEGIN();
        { GJOB_DEFAULT(g); g.A = W_HB; g.Bt = (bf16_t*)(wsb + O_WXQ); g.C = (float*)W_QX; pg8::gemm_phase<3>(GEMM_LDSP, g, tidx); __syncthreads(); }
        { GJOB_DEFAULT(g); g.A = W_MN; g.Bt = (bf16_t*)(wsb + O_WXK); g.nM = 2; g.C = (float*)W_KM; pg8::gemm_phase<3>(GEMM_LDSP, g, tidx); __syncthreads(); }
        { GJOB_DEFAULT(g); g.A = (bf16_t*)(wsb + O_WXV); g.Bt = W_MN; g.nM = 8; g.nN = 2; g.C = (float*)W_VMT; g.ldc = 512; pg8::gemm_phase<3>(GEMM_LDSP, g, tidx); }
    }
    xcd_barrier(xb);
    {
        PH_BEGIN();
        GJOB_DEFAULT(g); g.A = W_QX; g.K = 512; g.a_pn_mask = 3; g.a_pn_step = 512; g.Bt = W_KM; g.b_pn_step = 512; g.b_pm_shift = 4; g.b_pm_step = 256 * D; g.nN = 4;
        g.C = (float*)W_PX; g.ldc = 1024; g.escale = 0.04419417382415922f * 1.4426950408889634f;
        pg8::gemm_phase<5>(GEMM_LDSP, g, tidx);
    }
    xcd_barrier(xb);
    {
        PH_BEGIN();
        GJOB_DEFAULT(g); g.A = W_PX; g.lda = 1024; g.K = 256; g.a_pn_shift = 1; g.a_pn_mask = 3; g.a_pn_step = 256; g.Bt = W_VMT; g.ldb = 512; g.b_pn_step = 256 * 512; g.b_pm_shift = 4; g.b_pm_step = 256;
        g.C = (float*)W_MIXB;
        pg8::gemm_phase<3>(GEMM_LDSP, g, tidx);
    }
    xcd_barrier(xb);
    {
        PH_BEGIN();
        GJOB_DEFAULT(g); g.A = W_MIXB; g.Bt = (bf16_t*)(wsb + O_WXO); g.C = W_XR; g.R = W_XR;
        pg8::gemm_phase<0>(GEMM_LDSP, g, tidx);
    }
    xcd_barrier(xb);
    {
        PH_BEGIN();
        const float* rg = PF(I_GFFN); const float* win = PF(I_WIN);
#pragma nounroll
        PHASE_LOOP(T) d_rmsnorm(VB, tid, sm, W_XR, rg, W_HB, win, nullptr);
    }
    xcd_barrier(xb);
    {
        PH_BEGIN();
        GJOB_DEFAULT(g); g.A = W_HB; g.Bt = (bf16_t*)(wsb + O_WPQ); g.C = (float*)W_QX;
        pg8::gemm_phase<3>(GEMM_LDSP, g, tidx);
    }
    xcd_barrier(xb);
    {
        PH_BEGIN();
        const float* sk = PF(I_SUBK);
#pragma nounroll
        PHASE_LOOP(T * 8 / 4) d_peer_topk(VB, tid, sm, W_QX, sk, W_IDS, W_GATES);
    }
    xcd_barrier(xb);
    {
        PH_BEGIN();
        const float* gf = PF(I_GFINAL); float* outp = (float*)ldp_raw(I_OUT);
#pragma nounroll
        PHASE_LOOP(T) d_peer_out(VB, tid, sm, W_HB, W_XR, W_IDS, W_GATES, W_UT, W_VT, gf, outp);
    }
}
}

extern "C" void kernel_launch(void* const* d_in, const int* in_sizes, int n_in, void* d_out, int out_size, void* d_ws, size_t ws_size, hipStream_t stream) {
    static int grid_blocks = 0;
    if (!grid_blocks) {
        int dev = 0, cus = 0, per_cu = 0;
        hipGetDevice(&dev);
        hipDeviceGetAttribute(&cus, hipDeviceAttributeMultiprocessorCount, dev);
        hipFuncSetAttribute((const void*)mega, hipFuncAttributeMaxDynamicSharedMemorySize, SMEM_BYTES);
        hipOccupancyMaxActiveBlocksPerMultiprocessor(&per_cu, mega, NTHR, SMEM_BYTES);
        if (per_cu > 1) per_cu = 1;
        if (per_cu < 1) per_cu = 1;
        grid_blocks = cus * per_cu;
    }
    Params P{};
    const float** pp = (const float**)&P;
    for (int i = 0; i < 25; ++i) pp[i] = (const float*)d_in[i];
    P.out = (float*)d_out;
    P.bar = (unsigned*)d_ws;
    P.ws = (float*)((char*)d_ws + 16384);
    hipMemsetAsync(d_ws, 0, 16384, stream);
    void* args[] = {&P};
    hipError_t e = hipLaunchCooperativeKernel((const void*)mega, dim3(grid_blocks), dim3(NTHR), args, SMEM_BYTES, stream);
    if (e != hipSuccess) fprintf(stderr, "cooperative launch failed: %s (grid %d)\n", hipGetErrorString(e), grid_blocks);
}
```

```cpp
#include <hip/hip_runtime.h>
#include <stdint.h>
#include <math.h>
#include <cstdio>

#define LAS_ __attribute__((address_space(3)))
namespace {
constexpr int D = 2048, NB = 2, S = 4096, T = NB * S;
constexpr int INC = 6152;
constexpr int C_MIN = 0, C_MV = 1024, C_MO = 2048, C_MI = 3072, C_MF = 3076, C_AQ = 3080, C_AK = 4104, C_AV = 5128;
constexpr float EPS = 1e-6f;
constexpr size_t P6S = (size_t)8192 * 1024;
constexpr int NTHR = 512;
constexpr int HALF_SM_FLOATS = 8704;
constexpr int GEMM_LDS = 131072;
constexpr int SMEM_BYTES = GEMM_LDS + 1024 + 8192;
typedef unsigned short bf16_t;
__device__ __forceinline__ unsigned f2bf(float f) { unsigned u = __float_as_uint(f); u += 0x7FFFu + ((u >> 16) & 1u); return u >> 16; }
__device__ __forceinline__ unsigned pk2(float lo, float hi) { return f2bf(lo) | (f2bf(hi) << 16); }
__device__ __forceinline__ float bf2f(unsigned short b) { return __uint_as_float(((unsigned)b) << 16); }
extern __shared__ __attribute__((aligned(16))) unsigned char smem_raw[];
enum { I_X = 0, I_MEM, I_GMIX, I_WIN, I_CONVW, I_CONVB, I_WMQ, I_WMK, I_BMI, I_BMF, I_GMHEAD, I_GAHEAD, I_WOUT, I_GCROSS, I_GMEM,
       I_WXQ, I_WXK, I_WXV, I_WXO, I_GFFN, I_WPQ, I_SUBK, I_UTAB, I_VTAB, I_GFINAL, I_OUT, I_BAR, I_WS, I_NPTR };
__device__ __forceinline__ unsigned long long ldp_raw(int i) {
    const LAS_ unsigned long long* tab = (const LAS_ unsigned long long*)(LAS_ unsigned char*)(smem_raw + GEMM_LDS + 64);
    const unsigned long long v = tab[i];
    const unsigned lo = __builtin_amdgcn_readfirstlane((unsigned)v), hi = __builtin_amdgcn_readfirstlane((unsigned)(v >> 32));
    return ((unsigned long long)hi << 32) | lo;
}
#define PF(i) ((const float*)ldp_raw(i))

#define XB_TMO      128
#define XB_XCNT(j)  (256  + 64 * (j))
#define XB_XSUB(j)  (1280 + 64 * (j))
#define XB_XGEN(j)  (2304 + 64 * (j))
#define XB_TOP      3328
#define XB_TOPGEN   3392
#define XCD_BAR_WORDS 3456
#define XB_SPIN_CAP (1u << 22)
#define LAS __attribute__((address_space(3)))

__device__ __forceinline__ unsigned xb_ld(unsigned* p)              { return __hip_atomic_load(p, __ATOMIC_RELAXED, __HIP_MEMORY_SCOPE_AGENT); }
__device__ __forceinline__ unsigned xb_add(unsigned* p, unsigned v) { return __hip_atomic_fetch_add(p, v, __ATOMIC_RELAXED, __HIP_MEMORY_SCOPE_AGENT); }
__device__ __forceinline__ unsigned xb_xcc_id() { return (unsigned)__builtin_amdgcn_s_getreg((3 << 11) | 20) & 0xFu; }
#define XB_SPIN(cond, bar) do { unsigned _sp = 0; while (cond) { __builtin_amdgcn_s_sleep(1); \
    if ((++_sp & 255u) == 0u) { if (xb_ld(&(bar)[XB_TMO])) break; if (_sp > XB_SPIN_CAP) { atomicAdd(&(bar)[XB_TMO], 1u); break; } } } } while (0)

struct XcdBarrier { unsigned* bar; unsigned x; volatile LAS unsigned* st; };

__device__ __forceinline__ XcdBarrier xcd_barrier_post(unsigned* bar, volatile LAS unsigned* st) {
    XcdBarrier b; b.bar = bar; b.x = xb_xcc_id(); b.st = st;
    if (threadIdx.x == 0) (void)xb_add(&bar[XB_XCNT(b.x)], 1u);
    return b;
}
__device__ __forceinline__ void xcd_barrier_complete(unsigned* bar, unsigned x, unsigned& nloc, unsigned& nx) {
    const unsigned G = gridDim.x * gridDim.y * gridDim.z;
    unsigned sum, cnt, mine, sp = 0u;
    for (;;) {
        sum = 0u; cnt = 0u; mine = 0u;
#pragma unroll
        for (unsigned j = 0; j < 16; ++j) { const unsigned c = xb_ld(&bar[XB_XCNT(j)]); sum += c; cnt += (c > 0u) ? 1u : 0u; mine = (j == x) ? c : mine; }
        if (sum == G) break;
        __builtin_amdgcn_s_sleep(1);
        if ((++sp & 255u) == 0u) { if (xb_ld(&bar[XB_TMO])) break; if (sp > XB_SPIN_CAP) { atomicAdd(&bar[XB_TMO], 1u); break; } }
    }
    nloc = mine > 0u ? mine : 1u; nx = cnt > 0u ? cnt : 1u;
}
__device__ __forceinline__ void xcd_barrier(const XcdBarrier& b) {
    asm volatile("s_waitcnt vmcnt(0)" ::: "memory");
    __syncthreads();
    if (threadIdx.x == 0) {
        unsigned* bar = b.bar;
        __builtin_amdgcn_s_waitcnt(0);
        unsigned nloc = b.st[0], nx = b.st[1];
        if (nloc == 0u) { xcd_barrier_complete(bar, b.x, nloc, nx); b.st[0] = nloc; b.st[1] = nx; }
        const unsigned old = xb_add(&bar[XB_XSUB(b.x)], 1u);
        const unsigned gen = old / nloc;
        if (old + 1u == (gen + 1u) * nloc) {
            __builtin_amdgcn_fence(__ATOMIC_RELEASE, "agent");
            asm volatile("s_waitcnt vmcnt(0)" ::: "memory");
            const unsigned og = xb_add(&bar[XB_TOP], 1u);
            const unsigned tg = og / nx;
            if (og + 1u == (tg + 1u) * nx) xb_add(&bar[XB_TOPGEN], 1u);
            else XB_SPIN(xb_ld(&bar[XB_TOPGEN]) == tg, bar);
            __builtin_amdgcn_fence(__ATOMIC_ACQUIRE, "agent");
            xb_add(&bar[XB_XGEN(b.x)], 1u);
            asm volatile("s_waitcnt vmcnt(0)" ::: "memory");
        } else {
            XB_SPIN(xb_ld(&bar[XB_XGEN(b.x)]) == gen, bar);
            __builtin_amdgcn_fence(__ATOMIC_ACQUIRE, "agent");
            asm volatile("s_waitcnt vmcnt(0)" ::: "memory");
        }
    }
    __syncthreads();
}

__device__ __forceinline__ float wave_sum(float v) {
#pragma unroll
    for (int o = 32; o >= 1; o >>= 1) v += __shfl_xor(v, o);
    return v;
}
__device__ __forceinline__ float wave_max(float v) {
#pragma unroll
    for (int o = 32; o >= 1; o >>= 1) v = fmaxf(v, __shfl_xor(v, o));
    return v;
}
__device__ __forceinline__ float log_sigmoid(float x) { return fminf(x, 0.f) - log1pf(expf(-fabsf(x))); }


__device__ __forceinline__ void d_rmsnorm(int vb, int t, float* sm, const float* __restrict__ in, const float* __restrict__ g, bf16_t* __restrict__ out,
                                          const float* __restrict__ w_in, float* __restrict__ gpre) {
    float* red = sm;
    const int row = vb;
    const float4* p = (const float4*)(in + (size_t)row * D);
    float4 a = p[t], b = p[t + 256];
    float s = a.x * a.x + a.y * a.y + a.z * a.z + a.w * a.w + b.x * b.x + b.y * b.y + b.z * b.z + b.w * b.w;
    s = wave_sum(s);
    __syncthreads();
    if ((t & 63) == 0) red[t >> 6] = s;
    __syncthreads();
    const float tot = red[0] + red[1] + red[2] + red[3];
    const float r = rsqrtf(tot * (1.0f / D) + EPS);
    const float4* gp = (const float4*)g;
    float4 ga = gp[t], gb = gp[t + 256];
    float hv[8] = {a.x * r * ga.x, a.y * r * ga.y, a.z * r * ga.z, a.w * r * ga.w, b.x * r * gb.x, b.y * r * gb.y, b.z * r * gb.z, b.w * r * gb.w};
    uint2 o0, o1;
    o0.x = pk2(hv[0], hv[1]); o0.y = pk2(hv[2], hv[3]); o1.x = pk2(hv[4], hv[5]); o1.y = pk2(hv[6], hv[7]);
    *(uint2*)(out + (size_t)row * D + t * 4) = o0;
    *(uint2*)(out + (size_t)row * D + 1024 + t * 4) = o1;
    if (gpre) {
        float gs[8];
#pragma unroll
        for (int c = 0; c < 8; ++c) gs[c] = 0.f;
#pragma unroll
        for (int j = 0; j < 8; ++j) {
            const int k = (j < 4) ? (t * 4 + j) : (1024 + t * 4 + (j - 4));
            const float4 w0 = *(const float4*)(w_in + (size_t)k * INC + C_MI), w1 = *(const float4*)(w_in + (size_t)k * INC + C_MI + 4);
            gs[0] = fmaf(hv[j], w0.x, gs[0]); gs[1] = fmaf(hv[j], w0.y, gs[1]); gs[2] = fmaf(hv[j], w0.z, gs[2]); gs[3] = fmaf(hv[j], w0.w, gs[3]);
            gs[4] = fmaf(hv[j], w1.x, gs[4]); gs[5] = fmaf(hv[j], w1.y, gs[5]); gs[6] = fmaf(hv[j], w1.z, gs[6]); gs[7] = fmaf(hv[j], w1.w, gs[7]);
        }
#pragma unroll
        for (int c = 0; c < 8; ++c) gs[c] = wave_sum(gs[c]);
        __syncthreads();
        if ((t & 63) == 0) {
#pragma unroll
            for (int c = 0; c < 8; ++c) red[8 + (t >> 6) * 8 + c] = gs[c];
        }
        __syncthreads();
        if (t < 8) gpre[(size_t)row * 8 + t] = red[8 + t] + red[16 + t] + red[24 + t] + red[32 + t];
    }
}

namespace pg8 {
typedef short bf16x8 __attribute__((ext_vector_type(8)));
typedef float f32x4 __attribute__((ext_vector_type(4)));
constexpr int BM = 256, BK = 64, HALF = 128, HTB = HALF * BK * 2, NXCD = 8, WGM = 8;
__device__ __forceinline__ int lds_byte(int r, int c) { const int st = (r >> 4) * 2 + (c >> 5), rr = r & 15, cc = c & 31, ob = rr * 64 + cc * 2; return st * 1024 + (ob ^ (((ob >> 9) & 1) << 5)); }
__device__ __forceinline__ void stage_rc(int b, int& R, int& C) { const int st = b / 1024, sb = b % 1024, swz = sb ^ (((sb >> 9) & 1) << 5); R = (st >> 1) * 16 + swz / 64; C = (st & 1) * 32 + (swz % 64) / 2; }
struct Unit { int pm, pn; };
struct GJob {
    const bf16_t* A; const bf16_t* Bt;
    int lda, ldb, K, nM, nN;
    int a_pn_shift, a_pn_mask, a_pn_step;
    int b_pm_shift, b_pm_step, b_pn_step;
    int a_pm_step;
    float escale;
    const float* gs; float* denp; const float* qn; const float* gvec; const bf16_t* mo;
    float* C; int ldc; const float* R; int ldr;
    int mode;
};
__device__ __forceinline__ bool unit_next(const GJob& g, int i, Unit& u) {
    const int nwg = g.nM * g.nN;
    const long L = (long)i * gridDim.x + blockIdx.x; if (L >= nwg) return false;
    int wgid = (int)L; { const int q = nwg / NXCD, r = nwg % NXCD, xcd = wgid % NXCD, off = wgid / NXCD; wgid = (xcd < r ? xcd * (q + 1) : r * (q + 1) + (xcd - r) * q) + off; }
    const int nig = WGM * g.nN, gid = wgid / nig, fm = gid * WGM, gsz = (g.nM - fm) < WGM ? (g.nM - fm) : WGM;
    u.pm = fm + ((wgid % nig) % gsz); u.pn = (wgid % nig) / gsz; return true;
}
template <int MODE> __device__ __forceinline__ void epilogue(const GJob& g, f32x4 (&acc)[2][2][4][2], const Unit& u, int wr, int wc, int fr, int fq, LAS unsigned char* xlds) {
    const int row0 = u.pm * BM + wr * 64 + fr;
    if constexpr (MODE == 0) {
        const int col0 = u.pn * BM + wc * 32 + 4 * fq;
#pragma unroll
        for (int ai = 0; ai < 2; ++ai)
#pragma unroll
            for (int m = 0; m < 4; ++m) {
                const int row = row0 + ai * HALF + m * 16;
                float* rowp = g.C + (size_t)row * g.ldc + col0;
                const float* rp = g.R ? g.R + (size_t)row * g.ldr + col0 : nullptr;
#pragma unroll
                for (int bj = 0; bj < 2; ++bj)
#pragma unroll
                    for (int n = 0; n < 2; ++n) {
                        f32x4 v = acc[ai][bj][m][n];
                        if (rp) v = v + *(const f32x4*)(rp + bj * HALF + n * 16);
                        *(f32x4*)(rowp + bj * HALF + n * 16) = v;
                    }
            }
    } else if constexpr (MODE == 6) {
        const int h = u.pn; const size_t t0 = (size_t)u.pm * BM;
        bf16_t* Cb = (bf16_t*)g.C;
#pragma unroll
        for (int ai = 0; ai < 2; ++ai)
#pragma unroll
            for (int m = 0; m < 4; ++m) {
                const int l = ai * HALF + wr * 64 + m * 16 + fr;
                const float M2 = g.gs[((t0 + l) * 4 + h) * 8 + 1];
                bf16_t* rowp = Cb + (t0 + l) * 2048 + h * 512 + wc * 32 + 4 * fq;
                float rs = 0.f;
#pragma unroll
                for (int bj = 0; bj < 2; ++bj)
#pragma unroll
                    for (int n = 0; n < 2; ++n) {
                        const f32x4 a = acc[ai][bj][m][n];
                        const int s0 = bj * HALF + wc * 32 + n * 16 + 4 * fq;
                        float p[4];
#pragma unroll
                        for (int r = 0; r < 4; ++r) { const float u2 = g.gs[((t0 + s0 + r) * 4 + h) * 8 + 0]; p[r] = (s0 + r <= l) ? a[r] * __builtin_amdgcn_exp2f(u2 - M2) : 0.f; rs += p[r]; }
                        uint2 o; o.x = pk2(p[0], p[1]); o.y = pk2(p[2], p[3]);
                        *(uint2*)(rowp + bj * HALF + n * 16) = o;
                    }
                rs += __shfl_xor(rs, 16); rs += __shfl_xor(rs, 32);
                if (fq == 0) g.denp[((t0 + l) * 4 + h) * 4 + wc] = rs;
            }
    } else if constexpr (MODE == 7) {
        float* Ct = g.C + (size_t)(u.pm * 4 + u.pn) * 65536;
        const int col0 = wc * 32 + 4 * fq;
#pragma unroll
        for (int ai = 0; ai < 2; ++ai)
#pragma unroll
            for (int m = 0; m < 4; ++m) {
                float* rowp = Ct + (size_t)(ai * HALF + wr * 64 + m * 16 + fr) * 256 + col0;
#pragma unroll
                for (int bj = 0; bj < 2; ++bj)
#pragma unroll
                    for (int n = 0; n < 2; ++n) *(f32x4*)(rowp + bj * HALF + n * 16) = acc[ai][bj][m][n];
            }
    } else if constexpr (MODE == 8) {
        const int h = u.pn; const size_t t0 = (size_t)u.pm * BM;
        LAS float* X0 = (LAS float*)xlds + wr * 512;
#pragma unroll
        for (int ai = 0; ai < 2; ++ai)
#pragma unroll
            for (int m = 0; m < 4; ++m) {
                const size_t th = (t0 + ai * HALF + wr * 64 + m * 16 + fr) * 4 + h;
                const f32x4 dp = *(const f32x4*)(g.denp + th * 4);
                const float den = (dp[0] + dp[1]) + (dp[2] + dp[3]) + g.gs[th * 8 + 3] * g.qn[th];
                const float rden = 1.0f / fmaxf(fabsf(den), g.gs[th * 8 + 4]);
                float ss = 0.f;
#pragma unroll
                for (int bj = 0; bj < 2; ++bj)
#pragma unroll
                    for (int n = 0; n < 2; ++n) { f32x4 a = acc[ai][bj][m][n] * rden; acc[ai][bj][m][n] = a; ss += (a[0] * a[0] + a[1] * a[1]) + (a[2] * a[2] + a[3] * a[3]); }
                ss += __shfl_xor(ss, 16); ss += __shfl_xor(ss, 32);
                if (fq == 0) X0[(ai * 64 + m * 16 + fr) * 4 + wc] = ss;
            }
        asm volatile("s_waitcnt lgkmcnt(0)" ::: "memory"); __builtin_amdgcn_s_barrier(); asm volatile("" ::: "memory");
        bf16_t* Cb = (bf16_t*)g.C;
        const int col0 = wc * 32 + 4 * fq;
#pragma unroll
        for (int ai = 0; ai < 2; ++ai)
#pragma unroll
            for (int m = 0; m < 4; ++m) {
                const f32x4 p4 = *(const LAS f32x4*)(X0 + (ai * 64 + m * 16 + fr) * 4);
                const float rsn = rsqrtf(((p4[0] + p4[1]) + (p4[2] + p4[3])) * (1.0f / 256.0f) + EPS);
                const size_t t = t0 + ai * HALF + wr * 64 + m * 16 + fr;
                bf16_t* rowp = Cb + t * 2048 + h * 256 + col0;
                const bf16_t* mop = g.mo + t * 1024 + h * 256 + col0;
#pragma unroll
                for (int bj = 0; bj < 2; ++bj)
#pragma unroll
                    for (int n = 0; n < 2; ++n) {
                        const f32x4 a = acc[ai][bj][m][n];
                        const ushort4 mo4 = *(const ushort4*)(mop + bj * HALF + n * 16);
                        const f32x4 gv = *(const f32x4*)(g.gvec + h * 256 + col0 + bj * HALF + n * 16);
                        const float o0 = a[0] * rsn * gv[0] / (1.0f + __expf(-bf2f(mo4.x)));
                        const float o1 = a[1] * rsn * gv[1] / (1.0f + __expf(-bf2f(mo4.y)));
                        const float o2 = a[2] * rsn * gv[2] / (1.0f + __expf(-bf2f(mo4.z)));
                        const float o3 = a[3] * rsn * gv[3] / (1.0f + __expf(-bf2f(mo4.w)));
                        uint2 o; o.x = pk2(o0, o1); o.y = pk2(o2, o3);
                        *(uint2*)(rowp + bj * HALF + n * 16) = o;
                    }
            }
    } else if constexpr (MODE == 5) {
        LAS float* X0 = (LAS float*)xlds + wr * 512;
        LAS float* X1 = (LAS float*)xlds + 1024 + wr * 512;
#pragma unroll
        for (int ai = 0; ai < 2; ++ai)
#pragma unroll
            for (int m = 0; m < 4; ++m) {
                float v = -INFINITY;
#pragma unroll
                for (int bj = 0; bj < 2; ++bj)
#pragma unroll
                    for (int n = 0; n < 2; ++n) { const f32x4 a = acc[ai][bj][m][n]; v = fmaxf(v, fmaxf(fmaxf(a[0], a[1]), fmaxf(a[2], a[3]))); }
                v = fmaxf(v, __shfl_xor(v, 16)); v = fmaxf(v, __shfl_xor(v, 32));
                if (fq == 0) X0[(ai * 64 + m * 16 + fr) * 4 + wc] = v;
            }
        asm volatile("s_waitcnt lgkmcnt(0)" ::: "memory"); __builtin_amdgcn_s_barrier(); asm volatile("" ::: "memory");
#pragma unroll
        for (int ai = 0; ai < 2; ++ai)
#pragma unroll
            for (int m = 0; m < 4; ++m) {
                const f32x4 p4 = *(const LAS f32x4*)(X0 + (ai * 64 + m * 16 + fr) * 4);
                const float mxr = fmaxf(fmaxf(p4[0], p4[1]), fmaxf(p4[2], p4[3])) * g.escale;
                float s = 0.f;
#pragma unroll
                for (int bj = 0; bj < 2; ++bj)
#pragma unroll
                    for (int n = 0; n < 2; ++n) { f32x4 a = acc[ai][bj][m][n];
                        a[0] = __builtin_amdgcn_exp2f(a[0] * g.escale - mxr); a[1] = __builtin_amdgcn_exp2f(a[1] * g.escale - mxr); a[2] = __builtin_amdgcn_exp2f(a[2] * g.escale - mxr); a[3] = __builtin_amdgcn_exp2f(a[3] * g.escale - mxr);
                        acc[ai][bj][m][n] = a; s += (a[0] + a[1]) + (a[2] + a[3]); }
                s += __shfl_xor(s, 16); s += __shfl_xor(s, 32);
                if (fq == 0) X1[(ai * 64 + m * 16 + fr) * 4 + wc] = s;
            }
        asm volatile("s_waitcnt lgkmcnt(0)" ::: "memory"); __builtin_amdgcn_s_barrier(); asm volatile("" ::: "memory");
        bf16_t* Cb = (bf16_t*)g.C;
        const int col0 = u.pn * BM + wc * 32 + 4 * fq;
#pragma unroll
        for (int ai = 0; ai < 2; ++ai)
#pragma unroll
            for (int m = 0; m < 4; ++m) {
                const f32x4 p4 = *(const LAS f32x4*)(X1 + (ai * 64 + m * 16 + fr) * 4);
                const float inv = 1.0f / ((p4[0] + p4[1]) + (p4[2] + p4[3]));
                bf16_t* rowp = Cb + (size_t)(row0 + ai * HALF + m * 16) * g.ldc + col0;
#pragma unroll
                for (int bj = 0; bj < 2; ++bj)
#pragma unroll
                    for (int n = 0; n < 2; ++n) {
                        const f32x4 a = acc[ai][bj][m][n];
                        uint2 o; o.x = pk2(a[0] * inv, a[1] * inv); o.y = pk2(a[2] * inv, a[3] * inv);
                        *(uint2*)(rowp + bj * HALF + n * 16) = o;
                    }
            }
    } else {
        bf16_t* Cb = (bf16_t*)g.C; int ccol = u.pn * BM;
        if constexpr (MODE == 4) { Cb += (size_t)(u.pn >> 2) * P6S; ccol = (u.pn & 3) * 256; }
        const int col0 = ccol + wc * 32 + 4 * fq;
#pragma unroll
        for (int ai = 0; ai < 2; ++ai)
#pragma unroll
            for (int m = 0; m < 4; ++m) {
                bf16_t* rowp = Cb + (size_t)(row0 + ai * HALF + m * 16) * g.ldc + col0;
#pragma unroll
                for (int bj = 0; bj < 2; ++bj)
#pragma unroll
                    for (int n = 0; n < 2; ++n) {
                        const f32x4 v = acc[ai][bj][m][n];
                        uint2 o; o.x = pk2(v[0], v[1]); o.y = pk2(v[2], v[3]);
                        *(uint2*)(rowp + bj * HALF + n * 16) = o;
                    }
            }
    }
}
template <int MODE> __device__ __forceinline__ void gemm_phase(LAS unsigned char* lds, const GJob& g, int tid) {
    const int wid = __builtin_amdgcn_readfirstlane(tid >> 6), lane = tid & 63, wr = wid >> 2, wc = wid & 3, fr = lane & 15, fq = lane >> 4;
    const int K = g.K, nt = K / BK;
    unsigned voffA[2], voffB[2];
#pragma unroll
    for (int i = 0; i < 2; ++i) { int R, C; stage_rc(tid * 16 + i * 8192, R, C);
        voffA[i] = (unsigned)(R * g.lda + C) * 2u; voffB[i] = (unsigned)(R * g.ldb + C) * 2u; }
    const size_t kstep = (size_t)(BK * 2);
    const size_t hstepA = (size_t)HALF * g.lda * 2, hstepB = (size_t)HALF * g.ldb * 2;
    const unsigned ldsw = (unsigned)wid * 1024u;
    const int aoff = lds_byte(wr * 64 + fr, fq * 8), boff = lds_byte(wc * 32 + fr, fq * 8);
#define PG8_SA(b, h) (((b) * 2 + (h)) * HTB)
#define PG8_SB(b, h) ((4 + (b) * 2 + (h)) * HTB)
#define PG8_STAGE(bufoff, gbase, voff) do { _Pragma("unroll") for (int _i = 0; _i < 2; ++_i) \
        __builtin_amdgcn_global_load_lds((const unsigned*)((const char*)(gbase) + (voff)[_i]), (LAS unsigned*)(lds + (bufoff) + ldsw + _i * 8192), 16, 0, 0); } while (0)
#define PG8_LDA(dst, b, h) do { _Pragma("unroll") for (int m = 0; m < 4; ++m) _Pragma("unroll") for (int k = 0; k < 2; ++k) dst[m][k] = *(const LAS bf16x8*)(lds + PG8_SA(b, h) + aoff + m * 2048 + k * 1024); } while (0)
#define PG8_LDB(dst, b, h) do { _Pragma("unroll") for (int n = 0; n < 2; ++n) _Pragma("unroll") for (int k = 0; k < 2; ++k) dst[n][k] = *(const LAS bf16x8*)(lds + PG8_SB(b, h) + boff + n * 2048 + k * 1024); } while (0)
#define PG8_MMA(ai, bj, At, Bt) do { __builtin_amdgcn_s_setprio(1); _Pragma("unroll") for (int m = 0; m < 4; ++m) _Pragma("unroll") for (int n = 0; n < 2; ++n) _Pragma("unroll") for (int k = 0; k < 2; ++k) \
        acc[ai][bj][m][n] = __builtin_amdgcn_mfma_f32_16x16x32_bf16(Bt[n][k], At[m][k], acc[ai][bj][m][n], 0, 0, 0); __builtin_amdgcn_s_setprio(0); } while (0)
#define PG8_WAIT_V(n) asm volatile("s_waitcnt vmcnt(" #n ")" ::: "memory")
#define PG8_WAIT_L(n) asm volatile("s_waitcnt lgkmcnt(" #n ")" ::: "memory")
#define PG8_BAR __builtin_amdgcn_s_barrier()
#define PG8_SCHED __builtin_amdgcn_sched_barrier(0)
#define PG8_ABASE(u) ((const char*)g.A + ((size_t)(u).pm * g.a_pm_step + (size_t)(((u).pn >> g.a_pn_shift) & g.a_pn_mask) * g.a_pn_step) * 2)
#define PG8_BBASE(u) ((const char*)g.Bt + ((size_t)(u).pn * g.b_pn_step + (size_t)((u).pm >> g.b_pm_shift) * g.b_pm_step) * 2)
    Unit cur, nxt; int ui = 0;
    if (!unit_next(g, 0, cur)) return;
    f32x4 acc[2][2][4][2];
#pragma unroll
    for (int a = 0; a < 2; ++a)
#pragma unroll
        for (int b = 0; b < 2; ++b)
#pragma unroll
            for (int m = 0; m < 4; ++m)
#pragma unroll
                for (int n = 0; n < 2; ++n) acc[a][b][m][n] = (f32x4){0.f, 0.f, 0.f, 0.f};
    bf16x8 At[4][2], B0[2][2], B1[2][2];
    const char* cA = PG8_ABASE(cur); const char* cB = PG8_BBASE(cur);
    PG8_STAGE(PG8_SB(0, 0), cB, voffB); PG8_STAGE(PG8_SA(0, 0), cA, voffA); PG8_STAGE(PG8_SB(0, 1), cB + hstepB, voffB); PG8_STAGE(PG8_SA(0, 1), cA + hstepA, voffA);
    if (wr == 1) PG8_BAR;
    PG8_WAIT_V(4); PG8_BAR;
    PG8_STAGE(PG8_SB(1, 0), cB + kstep, voffB); PG8_STAGE(PG8_SA(1, 0), cA + kstep, voffA); PG8_STAGE(PG8_SB(1, 1), cB + hstepB + kstep, voffB);
    PG8_WAIT_V(6); PG8_BAR;
    for (;;) {
        const bool has_next = unit_next(g, ui + 1, nxt);
        const char* nA = has_next ? PG8_ABASE(nxt) : cA; const char* nB = has_next ? PG8_BBASE(nxt) : cB;
        for (int t = 0; t < nt; t += 2) {
            const bool last = (t == nt - 2);
            const char* a1 = cA + (size_t)(t + 1) * kstep;
            const char* a2 = last ? nA : cA + (size_t)(t + 2) * kstep; const char* b2 = last ? nB : cB + (size_t)(t + 2) * kstep;
            const char* a3 = a2 + kstep; const char* b3 = b2 + kstep;
            PG8_LDB(B0, 0, 0); PG8_SCHED; PG8_LDA(At, 0, 0); PG8_STAGE(PG8_SA(1, 1), a1 + hstepA, voffA);
            PG8_WAIT_L(8); PG8_BAR; PG8_WAIT_L(0); PG8_MMA(0, 0, At, B0); PG8_BAR; PG8_SCHED;
            PG8_LDB(B1, 0, 1); PG8_STAGE(PG8_SB(0, 0), b2, voffB);
            PG8_BAR; PG8_WAIT_L(0); PG8_MMA(0, 1, At, B1); PG8_BAR;
            PG8_LDA(At, 0, 1); PG8_STAGE(PG8_SA(0, 0), a2, voffA);
            PG8_BAR; PG8_WAIT_L(0); PG8_MMA(1, 0, At, B0); PG8_BAR; PG8_SCHED;
            PG8_STAGE(PG8_SB(0, 1), b2 + hstepB, voffB);
            PG8_WAIT_V(6); PG8_BAR; PG8_MMA(1, 1, At, B1); PG8_BAR;
            PG8_LDB(B0, 1, 0); PG8_SCHED; PG8_LDA(At, 1, 0); PG8_STAGE(PG8_SA(0, 1), a2 + hstepA, voffA);
            PG8_WAIT_L(8); PG8_BAR; PG8_WAIT_L(0); PG8_MMA(0, 0, At, B0); PG8_BAR; PG8_SCHED;
            PG8_LDB(B1, 1, 1); PG8_STAGE(PG8_SB(1, 0), b3, voffB);
            PG8_BAR; PG8_WAIT_L(0); PG8_MMA(0, 1, At, B1); PG8_BAR;
            PG8_LDA(At, 1, 1); PG8_STAGE(PG8_SA(1, 0), a3, voffA);
            PG8_BAR; PG8_WAIT_L(0); PG8_MMA(1, 0, At, B0); PG8_BAR; PG8_SCHED;
            PG8_STAGE(PG8_SB(1, 1), b3 + hstepB, voffB);
            PG8_WAIT_V(6); PG8_BAR; PG8_MMA(1, 1, At, B1); PG8_BAR;
        }
        epilogue<MODE>(g, acc, cur, wr, wc, fr, fq, lds + GEMM_LDS + 1024);
        if (!has_next) break;
#pragma unroll
        for (int a = 0; a < 2; ++a)
#pragma unroll
            for (int b = 0; b < 2; ++b)
#pragma unroll
                for (int m = 0; m < 4; ++m)
#pragma unroll
                    for (int n = 0; n < 2; ++n) acc[a][b][m][n] = (f32x4){0.f, 0.f, 0.f, 0.f};
        cur = nxt; cA = nA; cB = nB; ++ui;
    }
    PG8_WAIT_V(0);
    if (wr == 0) PG8_BAR;
    PG8_BAR;
#undef PG8_SA
#undef PG8_SB
#undef PG8_STAGE
#undef PG8_LDA
#undef PG8_LDB
#undef PG8_MMA
#undef PG8_WAIT_V
#undef PG8_WAIT_L
#undef PG8_BAR
#undef PG8_SCHED
#undef PG8_ABASE
#undef PG8_BBASE
}
}

__device__ __forceinline__ void p0_transpose_item(const float* W, int ldw, int K, int csrc0, bf16_t* WT, int row0, LAS float* scr, int kb, int lane, float wscale) {
    const int k0 = 64 * kb;
#pragma unroll 8
    for (int i = 0; i < 32; ++i) { const int kk = 2 * i + (lane >> 5); scr[kk * 33 + (lane & 31)] = W[(size_t)(k0 + kk) * ldw + csrc0 + (lane & 31)] * wscale; }
    asm volatile("s_waitcnt lgkmcnt(0)" ::: "memory");
    const int c = lane & 7;
#pragma unroll
    for (int j = 0; j < 4; ++j) { const int n = (lane >> 3) + 8 * j; const LAS float* s = scr + (8 * c) * 33 + n;
        uint4 o; o.x = pk2(s[0 * 33], s[1 * 33]); o.y = pk2(s[2 * 33], s[3 * 33]); o.z = pk2(s[4 * 33], s[5 * 33]); o.w = pk2(s[6 * 33], s[7 * 33]);
        *(uint4*)(WT + (size_t)(row0 + n) * K + k0 + 8 * c) = o; }
    asm volatile("s_waitcnt lgkmcnt(0)" ::: "memory");
}

__device__ __forceinline__ void d_conv_silu(int vb, int tid, const bf16_t* __restrict__ p6, const float* __restrict__ cw, const float* __restrict__ cb, bf16_t* __restrict__ c) {
    const int t = vb, s = t % S;
    for (int ch = tid; ch < 1024; ch += 256) {
        float y = cb[ch];
#pragma unroll
        for (int j = 0; j < 4; ++j) {
            const int ss = s - 3 + j;
            if (ss >= 0) y = fmaf(cw[j * 1024 + ch], bf2f(p6[(size_t)(t - 3 + j) * 1024 + ch]), y);
        }
        c[(size_t)t * 1024 + ch] = (bf16_t)f2bf(y / (1.0f + expf(-y)));
    }
}

__device__ __forceinline__ void d_mlstm(int vb, int tid, const bf16_t* __restrict__ mq, const bf16_t* __restrict__ mk, const bf16_t* __restrict__ p6,
                                        const float* __restrict__ gpre, const float* __restrict__ b_mi, const float* __restrict__ b_mf, float* __restrict__ hraw) {
    const int lane = tid & 63, w = tid >> 6;
    const int gid = vb * 4 + w;
    const int e = gid & 255, h = (gid >> 8) & 3, b = gid >> 10;
    const float bi = b_mi[h], bf = b_mf[h];
    float C0 = 0.f, C1 = 0.f, C2 = 0.f, C3 = 0.f, n0 = 0.f, n1 = 0.f, n2 = 0.f, n3 = 0.f, m = 0.f;
    const size_t tb = (size_t)b * S;
    const bf16_t* qp = mq + tb * 1024 + h * 256 + lane * 4;
    const bf16_t* kp = mk + tb * 1024 + h * 256 + lane * 4;
    const bf16_t* pp = p6 + P6S + tb * 1024 + h * 256 + e;
    ushort4 qn = *(const ushort4*)qp, kn = *(const ushort4*)kp;
    const float* gp = gpre + tb * 8;
    float vn = bf2f(pp[0]), in_ = gp[h], fn = gp[4 + h];
    for (int s = 0; s < S; ++s) {
        const float4 q = make_float4(bf2f(qn.x), bf2f(qn.y), bf2f(qn.z), bf2f(qn.w)), k = make_float4(bf2f(kn.x), bf2f(kn.y), bf2f(kn.z), bf2f(kn.w)); const float v = vn, ipre = in_ + bi, fpre = fn + bf;
        if (s + 1 < S) {
            qn = *(const ushort4*)(qp + (size_t)(s + 1) * 1024);
            kn = *(const ushort4*)(kp + (size_t)(s + 1) * 1024);
            vn = bf2f(pp[(size_t)(s + 1) * 1024]); in_ = gp[(size_t)(s + 1) * 8 + h]; fn = gp[(size_t)(s + 1) * 8 + 4 + h];
        }
        const float logf = log_sigmoid(fpre);
        const float mnew = fmaxf(logf + m, ipre);
        const float fd = expf(logf + m - mnew), ig = expf(ipre - mnew);
        m = mnew;
        const float sc = ig * 0.0625f;
        C0 = fd * C0 + sc * k.x * v; C1 = fd * C1 + sc * k.y * v; C2 = fd * C2 + sc * k.z * v; C3 = fd * C3 + sc * k.w * v;
        n0 = fd * n0 + sc * k.x; n1 = fd * n1 + sc * k.y; n2 = fd * n2 + sc * k.z; n3 = fd * n3 + sc * k.w;
        float num = q.x * C0 + q.y * C1 + q.z * C2 + q.w * C3;
        float den = q.x * n0 + q.y * n1 + q.z * n2 + q.w * n3;
        num = wave_sum(num); den = wave_sum(den);
        if (lane == 0) hraw[(tb + s) * 1024 + h * 256 + e] = num / fmaxf(fabsf(den), expf(-mnew));
    }
}

__device__ __forceinline__ void d_mhead_norm(int vb, int tid, const float* __restrict__ hraw, const bf16_t* __restrict__ p6, const float* __restrict__ g, bf16_t* __restrict__ mix) {
    const int t = vb, h = tid >> 6, lane = tid & 63;
    const float4 v = *(const float4*)(hraw + (size_t)t * 1024 + h * 256 + lane * 4);
    float s = v.x * v.x + v.y * v.y + v.z * v.z + v.w * v.w;
    s = wave_sum(s);
    const float r = rsqrtf(s * (1.0f / 256.0f) + EPS);
    const float4 gg = *(const float4*)(g + h * 256 + lane * 4);
    const ushort4 mo = *(const ushort4*)(p6 + 2 * P6S + (size_t)t * 1024 + h * 256 + lane * 4);
    float4 o;
    o.x = v.x * r * gg.x / (1.0f + expf(-bf2f(mo.x)));
    o.y = v.y * r * gg.y / (1.0f + expf(-bf2f(mo.y)));
    o.z = v.z * r * gg.z / (1.0f + expf(-bf2f(mo.z)));
    o.w = v.w * r * gg.w / (1.0f + expf(-bf2f(mo.w)));
    uint2 ob; ob.x = pk2(o.x, o.y); ob.y = pk2(o.z, o.w);
    *(uint2*)(mix + (size_t)t * D + h * 256 + lane * 4) = ob;
}

__device__ __forceinline__ void d_rope(int vb, int tid, bf16_t* __restrict__ p6) {
    const int t = vb, s = t % S;
    for (int idx = tid; idx < 2 * 8 * 64; idx += 256) {
        const int i = idx & 63, hd = (idx >> 6) & 7, qk = idx >> 9;
        const float inv = exp2f(-(float)i * 0.20762050593046014f);
        const float ang = (float)s * inv;
        float sn, cs; sincosf(ang, &sn, &cs);
        bf16_t* p = p6 + (size_t)(3 + qk) * P6S + (size_t)t * 1024 + hd * 128;
        const float x1 = bf2f(p[i]), x2 = bf2f(p[64 + i]);
        p[i] = (bf16_t)f2bf(x1 * cs - x2 * sn);
        p[64 + i] = (bf16_t)f2bf(x2 * cs + x1 * sn);
    }
}

__device__ __forceinline__ void d_dilated(int vb, int tid, float* sm, const bf16_t* __restrict__ p6, const float* __restrict__ g_ahead, bf16_t* __restrict__ mix) {
    float (*qs)[128] = (float (*)[128])sm;
    float (*ps)[576] = (float (*)[576])(sm + 512);
    const int lane = tid & 63, w = tid >> 6;
    const int gid = vb * 4 + w;
    const int s = gid % S, hd = (gid / S) & 7, b = gid / (S * 8);
    const size_t t = (size_t)b * S + s;
    const bf16_t* qrow = p6 + 3 * P6S + t * 1024 + hd * 128;
    __syncthreads();
    qs[w][lane] = bf2f(qrow[lane]); qs[w][lane + 64] = bf2f(qrow[lane + 64]);
    __syncthreads();
    const float scale = 0.08838834764831845f;
    float mloc = -INFINITY;
    for (int br = 0; br < 3; ++br) {
        const int dil = br == 0 ? 1 : (br == 1 ? 4 : 16);
        for (int jj = 0; jj < 192; jj += 64) {
            const int j = jj + lane;
            float sc = -INFINITY;
            if (j <= 128 && s - j * dil >= 0) {
                const bf16_t* krow = p6 + 4 * P6S + (t - (size_t)j * dil) * 1024 + hd * 128;
                float d = 0.f;
#pragma unroll 8
                for (int c = 0; c < 128; c += 4) {
                    const ushort4 kv = *(const ushort4*)(krow + c);
                    d = fmaf(qs[w][c], bf2f(kv.x), d); d = fmaf(qs[w][c + 1], bf2f(kv.y), d); d = fmaf(qs[w][c + 2], bf2f(kv.z), d); d = fmaf(qs[w][c + 3], bf2f(kv.w), d);
                }
                sc = d * scale;
            }
            ps[w][br * 192 + j] = sc;
            mloc = fmaxf(mloc, sc);
        }
    }
    const float mx = wave_max(mloc);
    __syncthreads();
    float lsum = 0.f;
    for (int i = lane; i < 3 * 192; i += 64) {
        const float sc = ps[w][i];
        const float pv = (sc == -INFINITY) ? 0.f : expf(sc - mx);
        ps[w][i] = pv; lsum += pv;
    }
    const float tot = wave_sum(lsum);
    __syncthreads();
    float o0 = 0.f, o1 = 0.f;
    for (int br = 0; br < 3; ++br) {
        const int dil = br == 0 ? 1 : (br == 1 ? 4 : 16);
        for (int j = 0; j <= 128; ++j) {
            if (s - j * dil < 0) break;
            const float pv = ps[w][br * 192 + j];
            const bf16_t* vrow = p6 + 5 * P6S + (t - (size_t)j * dil) * 1024 + hd * 128;
            o0 = fmaf(pv, bf2f(vrow[lane]), o0); o1 = fmaf(pv, bf2f(vrow[lane + 64]), o1);
        }
    }
    o0 /= tot; o1 /= tot;
    float ss = wave_sum(o0 * o0 + o1 * o1);
    const float r = rsqrtf(ss * (1.0f / 128.0f) + EPS);
    bf16_t* orow = mix + t * D + 1024 + hd * 128;
    orow[lane] = (bf16_t)f2bf(o0 * r * g_ahead[hd * 128 + lane]);
    orow[lane + 64] = (bf16_t)f2bf(o1 * r * g_ahead[hd * 128 + lane + 64]);
}

__device__ __forceinline__ void d_cross(int vb, int tid, float* sm, const bf16_t* __restrict__ q, const float* __restrict__ km, const float* __restrict__ vm, bf16_t* __restrict__ o) {
    float (*qs)[512] = (float (*)[512])sm;
    float (*ps)[256] = (float (*)[256])(sm + 2048);
    const int lane = tid & 63, w = tid >> 6;
    const int t = vb, hd = w, b = t / S;
    const bf16_t* qrow = q + (size_t)t * D + hd * 512;
    __syncthreads();
    for (int i = lane; i < 512; i += 64) qs[w][i] = bf2f(qrow[i]);
    __syncthreads();
    const float scale = 0.04419417382415922f;
    float sc[4]; float mloc = -INFINITY;
#pragma unroll
    for (int r = 0; r < 4; ++r) {
        const int mi = lane + 64 * r;
        const float* krow = km + ((size_t)b * 256 + mi) * D + hd * 512;
        float d = 0.f;
#pragma unroll 8
        for (int c = 0; c < 512; c += 4) {
            const float4 kv = *(const float4*)(krow + c);
            d = fmaf(qs[w][c], kv.x, d); d = fmaf(qs[w][c + 1], kv.y, d); d = fmaf(qs[w][c + 2], kv.z, d); d = fmaf(qs[w][c + 3], kv.w, d);
        }
        sc[r] = d * scale; mloc = fmaxf(mloc, sc[r]);
    }
    const float mx = wave_max(mloc);
    float lsum = 0.f;
#pragma unroll
    for (int r = 0; r < 4; ++r) { const float pv = expf(sc[r] - mx); ps[w][lane + 64 * r] = pv; lsum += pv; }
    const float tot = wave_sum(lsum);
    __syncthreads();
    float acc[8];
#pragma unroll
    for (int i = 0; i < 8; ++i) acc[i] = 0.f;
    for (int mi = 0; mi < 256; ++mi) {
        const float pv = ps[w][mi];
        const float* vrow = vm + ((size_t)b * 256 + mi) * D + hd * 512;
#pragma unroll
        for (int i = 0; i < 8; ++i) acc[i] = fmaf(pv, vrow[lane + 64 * i], acc[i]);
    }
    bf16_t* orow = o + (size_t)t * D + hd * 512;
#pragma unroll
    for (int i = 0; i < 8; ++i) orow[lane + 64 * i] = (bf16_t)f2bf(acc[i] / tot);
}

__device__ __forceinline__ void wave_argmax(float& best, int& bidx) {
#pragma unroll
    for (int o = 32; o >= 1; o >>= 1) {
        const float ob = __shfl_xor(best, o); const int oi = __shfl_xor(bidx, o);
        if (ob > best || (ob == best && oi < bidx)) { best = ob; bidx = oi; }
    }
}
__device__ __forceinline__ void d_peer_topk(int vb, int tid, float* sm, const bf16_t* __restrict__ qp, const float* __restrict__ sub_keys, int* __restrict__ ids, float* __restrict__ gates) {
    float (*qs)[256] = (float (*)[256])sm;
    const int lane = tid & 63, w = tid >> 6;
    const int gid = vb * 4 + w;
    const int hd = gid & 7, t = gid >> 3;
    const bf16_t* qrow = qp + (size_t)t * D + hd * 256;
    __syncthreads();
    for (int i = lane; i < 256; i += 64) qs[w][i] = bf2f(qrow[i]);
    __syncthreads();
    float tops[2]; int topi[2];
#pragma unroll
    for (int p = 0; p < 2; ++p) {
        float v0, v1;
        {
            const float* k0 = sub_keys + ((size_t)(hd * 2 + p) * 128 + lane) * 128;
            const float* k1 = k0 + 64 * 128;
            float d0 = 0.f, d1 = 0.f;
#pragma unroll 8
            for (int c = 0; c < 128; c += 4) {
                const float4 a = *(const float4*)(k0 + c), bb = *(const float4*)(k1 + c);
                const float q0 = qs[w][p * 128 + c], q1 = qs[w][p * 128 + c + 1], q2 = qs[w][p * 128 + c + 2], q3 = qs[w][p * 128 + c + 3];
                d0 = fmaf(q0, a.x, d0); d0 = fmaf(q1, a.y, d0); d0 = fmaf(q2, a.z, d0); d0 = fmaf(q3, a.w, d0);
                d1 = fmaf(q0, bb.x, d1); d1 = fmaf(q1, bb.y, d1); d1 = fmaf(q2, bb.z, d1); d1 = fmaf(q3, bb.w, d1);
            }
            v0 = d0; v1 = d1;
        }
        float ts = 0.f; int ti = 0;
        for (int it = 0; it < 16; ++it) {
            float best; int bidx;
            if (v0 >= v1) { best = v0; bidx = lane; } else { best = v1; bidx = lane + 64; }
            wave_argmax(best, bidx);
            if (lane == it) { ts = best; ti = bidx; }
            if (bidx == lane) v0 = -INFINITY;
            if (bidx == lane + 64) v1 = -INFINITY;
        }
        tops[p] = ts; topi[p] = ti;
    }
    float cv[4]; int ci[4];
#pragma unroll
    for (int r = 0; r < 4; ++r) {
        const int c = lane * 4 + r, i = c >> 4, j = c & 15;
        const float s0 = __shfl(tops[0], i), s1 = __shfl(tops[1], j);
        const int i0 = __shfl(topi[0], i), i1 = __shfl(topi[1], j);
        cv[r] = s0 + s1; ci[r] = i0 * 128 + i1;
    }
    float bs = 0.f; int bid = 0;
    for (int it = 0; it < 16; ++it) {
        float best = cv[0]; int bidx = lane * 4;
#pragma unroll
        for (int r = 1; r < 4; ++r) if (cv[r] > best) { best = cv[r]; bidx = lane * 4 + r; }
        wave_argmax(best, bidx);
        const int owner = bidx >> 2, rr = bidx & 3;
        int myid = ci[0];
        if (rr == 1) myid = ci[1]; else if (rr == 2) myid = ci[2]; else if (rr == 3) myid = ci[3];
        const int eid = __shfl(myid, owner);
        if (lane == it) { bs = best; bid = eid; }
        if (owner == lane) {
#pragma unroll
            for (int r = 0; r < 4; ++r) if (rr == r) cv[r] = -INFINITY;
        }
    }
    float v = lane < 16 ? bs : -INFINITY;
    const float mx = wave_max(v);
    const float ev = lane < 16 ? expf(bs - mx) : 0.f;
    const float tot = wave_sum(ev);
    if (lane < 16) {
        ids[(size_t)t * 128 + hd * 16 + lane] = bid;
        gates[(size_t)t * 128 + hd * 16 + lane] = ev / tot;
    }
}

__device__ __forceinline__ void d_peer_out(int vb, int tid, float* sm, const bf16_t* __restrict__ h3, const float* __restrict__ x2, const int* __restrict__ ids, const float* __restrict__ gates,
                                           const bf16_t* __restrict__ u_tab, const bf16_t* __restrict__ v_tab, const float* __restrict__ g_final, float* __restrict__ out) {
    float (*part)[2048] = (float (*)[2048])sm;
    float* red = sm + 4 * 2048;
    const int lane = tid & 63, w = tid >> 6, t = vb;
    float4 xr[8], acc[8];
    const bf16_t* hrow = h3 + (size_t)t * D;
#pragma unroll
    for (int i = 0; i < 8; ++i) { const ushort4 hv = *(const ushort4*)(hrow + i * 256 + lane * 4);
        xr[i] = make_float4(bf2f(hv.x), bf2f(hv.y), bf2f(hv.z), bf2f(hv.w)); acc[i] = make_float4(0.f, 0.f, 0.f, 0.f); }
    for (int j = 0; j < 32; ++j) {
        const int slot = w * 32 + j;
        const int e = ids[(size_t)t * 128 + slot];
        const float gt = gates[(size_t)t * 128 + slot];
        const bf16_t* ur = u_tab + (size_t)e * D;
        const bf16_t* vr = v_tab + (size_t)e * D;
        float d = 0.f;
#pragma unroll
        for (int i = 0; i < 8; ++i) {
            const ushort4 u = *(const ushort4*)(ur + i * 256 + lane * 4);
            d = fmaf(xr[i].x, bf2f(u.x), d); d = fmaf(xr[i].y, bf2f(u.y), d); d = fmaf(xr[i].z, bf2f(u.z), d); d = fmaf(xr[i].w, bf2f(u.w), d);
        }
        d = wave_sum(d);
        const float act = 0.5f * d * (1.0f + erff(d * 0.7071067811865476f));
        const float cf = gt * act;
#pragma unroll
        for (int i = 0; i < 8; ++i) {
            const ushort4 v = *(const ushort4*)(vr + i * 256 + lane * 4);
            acc[i].x = fmaf(cf, bf2f(v.x), acc[i].x); acc[i].y = fmaf(cf, bf2f(v.y), acc[i].y); acc[i].z = fmaf(cf, bf2f(v.z), acc[i].z); acc[i].w = fmaf(cf, bf2f(v.w), acc[i].w);
        }
    }
    __syncthreads();
#pragma unroll
    for (int i = 0; i < 8; ++i) *(float4*)&part[w][i * 256 + lane * 4] = acc[i];
    __syncthreads();
    float4 r0, r1;
    {
        const float4 a = *(const float4*)&part[0][tid * 4], b = *(const float4*)&part[1][tid * 4], c = *(const float4*)&part[2][tid * 4], d = *(const float4*)&part[3][tid * 4];
        const float4 x = *(const float4*)(x2 + (size_t)t * D + tid * 4);
        r0 = make_float4(x.x + a.x + b.x + c.x + d.x, x.y + a.y + b.y + c.y + d.y, x.z + a.z + b.z + c.z + d.z, x.w + a.w + b.w + c.w + d.w);
    }
    {
        const float4 a = *(const float4*)&part[0][1024 + tid * 4], b = *(const float4*)&part[1][1024 + tid * 4], c = *(const float4*)&part[2][1024 + tid * 4], d = *(const float4*)&part[3][1024 + tid * 4];
        const float4 x = *(const float4*)(x2 + (size_t)t * D + 1024 + tid * 4);
        r1 = make_float4(x.x + a.x + b.x + c.x + d.x, x.y + a.y + b.y + c.y + d.y, x.z + a.z + b.z + c.z + d.z, x.w + a.w + b.w + c.w + d.w);
    }
    float s = r0.x * r0.x + r0.y * r0.y + r0.z * r0.z + r0.w * r0.w + r1.x * r1.x + r1.y * r1.y + r1.z * r1.z + r1.w * r1.w;
    s = wave_sum(s);
    if (lane == 0) red[w] = s;
    __syncthreads();
    const float tot = red[0] + red[1] + red[2] + red[3];
    const float r = rsqrtf(tot * (1.0f / D) + EPS);
    const float4 g0 = *(const float4*)(g_final + tid * 4), g1 = *(const float4*)(g_final + 1024 + tid * 4);
    *(float4*)(out + (size_t)t * D + tid * 4) = make_float4(r0.x * r * g0.x, r0.y * r * g0.y, r0.z * r * g0.z, r0.w * r * g0.w);
    *(float4*)(out + (size_t)t * D + 1024 + tid * 4) = make_float4(r1.x * r * g1.x, r1.y * r * g1.y, r1.z * r * g1.z, r1.w * r * g1.w);
}


__device__ __forceinline__ float wave_incl_scan_add(float v, int lane) {
#pragma unroll
    for (int o = 1; o < 64; o <<= 1) { const float t = __shfl_up(v, o); if (lane >= o) v += t; }
    return v;
}
__device__ __forceinline__ float wave_incl_scan_max(float v, int lane) {
#pragma unroll
    for (int o = 1; o < 64; o <<= 1) { const float t = __shfl_up(v, o); if (lane >= o) v = fmaxf(v, t); }
    return v;
}
__device__ __forceinline__ void mlstm_gates_wave(int b, int h, int lane, const float* __restrict__ gpre, const float* __restrict__ b_mi, const float* __restrict__ b_mf,
                                                 float* __restrict__ gs, float* __restrict__ decay) {
    const float bi = b_mi[h], bf = b_mf[h];
    float mprev = 0.f;
    for (int c = 0; c < 16; ++c) {
        const size_t t0 = (size_t)b * S + c * 256 + lane * 4;
        float logi[4], lf[4], bb[4];
#pragma unroll
        for (int j = 0; j < 4; ++j) { logi[j] = gpre[(t0 + j) * 8 + h] + bi; lf[j] = log_sigmoid(gpre[(t0 + j) * 8 + 4 + h] + bf); }
        bb[0] = lf[0]; bb[1] = bb[0] + lf[1]; bb[2] = bb[1] + lf[2]; bb[3] = bb[2] + lf[3];
        const float incl = wave_incl_scan_add(bb[3], lane);
        const float excl = incl - bb[3];
#pragma unroll
        for (int j = 0; j < 4; ++j) bb[j] += excl;
        const float g = __shfl(incl, 63);
        float amax = -INFINITY, uu[4], cm[4];
#pragma unroll
        for (int j = 0; j < 4; ++j) { amax = fmaxf(amax, logi[j] + g - bb[j]); uu[j] = logi[j] - bb[j]; }
        amax = wave_max(amax);
        const float mnew = fmaxf(g + mprev, amax);
        cm[0] = uu[0]; cm[1] = fmaxf(cm[0], uu[1]); cm[2] = fmaxf(cm[1], uu[2]); cm[3] = fmaxf(cm[2], uu[3]);
        const float cincl = wave_incl_scan_max(cm[3], lane);
        float cexcl = __shfl_up(cincl, 1); if (lane == 0) cexcl = -INFINITY;
#pragma unroll
        for (int j = 0; j < 4; ++j) {
            const float M = fmaxf(mprev, fmaxf(cexcl, cm[j]));
            float* o = gs + ((t0 + j) * 4 + h) * 8;
            o[0] = uu[j] * 1.4426950408889634f; o[1] = M * 1.4426950408889634f; o[2] = expf(logi[j] + g - bb[j] - mnew); o[3] = expf(mprev - M); o[4] = expf(-(bb[j] + M));
        }
        if (lane == 0) decay[(b * 16 + c) * 4 + h] = expf(g + mprev - mnew);
        mprev = mnew;
    }
}
__device__ __forceinline__ void transpose_tile64(int tid, float* sm, const bf16_t* __restrict__ src, int src_ld, bf16_t* __restrict__ dst, int dst_ld, const float* __restrict__ scale, int sstride) {
    unsigned short (*tl)[66] = (unsigned short (*)[66])sm;
    __syncthreads();
#pragma unroll
    for (int i = 0; i < 2; ++i) {
        const int ch = tid + i * 256, r = ch >> 3, c8 = (ch & 7) * 8;
        const uint4 v = *(const uint4*)(src + (size_t)r * src_ld + c8);
        const float sc = scale ? scale[(size_t)r * sstride] : 1.0f;
        const unsigned w[4] = {v.x, v.y, v.z, v.w};
#pragma unroll
        for (int k = 0; k < 4; ++k) {
            tl[r][c8 + 2 * k] = (unsigned short)f2bf(bf2f((unsigned short)(w[k] & 0xFFFFu)) * sc);
            tl[r][c8 + 2 * k + 1] = (unsigned short)f2bf(bf2f((unsigned short)(w[k] >> 16)) * sc);
        }
    }
    __syncthreads();
#pragma unroll
    for (int i = 0; i < 2; ++i) {
        const int ch = tid + i * 256, c = ch >> 3, r8 = (ch & 7) * 8;
        uint4 o;
        o.x = (unsigned)tl[r8 + 0][c] | ((unsigned)tl[r8 + 1][c] << 16); o.y = (unsigned)tl[r8 + 2][c] | ((unsigned)tl[r8 + 3][c] << 16);
        o.z = (unsigned)tl[r8 + 4][c] | ((unsigned)tl[r8 + 5][c] << 16); o.w = (unsigned)tl[r8 + 6][c] | ((unsigned)tl[r8 + 7][c] << 16);
        *(uint4*)(dst + (size_t)c * dst_ld + r8) = o;
    }
}

struct Params {
    const float *x, *mem, *g_mix, *w_in, *conv_w, *conv_b, *w_mq, *w_mk, *b_mi, *b_mf, *g_mhead, *g_ahead, *w_out, *g_cross, *g_mem,
                *w_xq, *w_xk, *w_xv, *w_xo, *g_ffn, *w_pq, *sub_keys, *u_tab, *v_tab, *g_final;
    float* out;
    unsigned* bar;
    float* ws;
};

#define PHASE_LOOP(nvb) for (int base_ = blockIdx.x * 2; base_ < (nvb); base_ += gridDim.x * 2)
#define VB (base_ + half)

__global__ void __launch_bounds__(NTHR) mega(Params P) {
    volatile LAS unsigned* st = (volatile LAS unsigned*)(LAS unsigned char*)(smem_raw + GEMM_LDS);
    if (threadIdx.x == 0) { st[0] = 0u; st[1] = 0u; st[2] = 0u; st[3] = 0u; }
    if (threadIdx.x < I_NPTR) ((LAS unsigned long long*)(LAS unsigned char*)(smem_raw + GEMM_LDS + 64))[threadIdx.x] = ((const unsigned long long*)&P)[threadIdx.x];
    __syncthreads();
    XcdBarrier xb = xcd_barrier_post((unsigned*)ldp_raw(I_BAR), st);

    constexpr size_t TD = (size_t)T * D;
    constexpr size_t O_HB = 6 * P6S * 2, O_CBUF = O_HB + (size_t)T * D * 2, O_MQ = O_CBUF + (size_t)T * 1024 * 2, O_MK = O_MQ + (size_t)T * 1024 * 2,
                     O_MIXB = O_MK + (size_t)T * 1024 * 2, O_WIN = O_MIXB + (size_t)T * D * 2, O_WOUT = O_WIN + (size_t)6144 * D * 2, O_WXQ = O_WOUT + (size_t)D * D * 2,
                     O_WXK = O_WXQ + (size_t)D * D * 2, O_WXV = O_WXK + (size_t)D * D * 2, O_WXO = O_WXV + (size_t)D * D * 2, O_WPQ = O_WXO + (size_t)D * D * 2,
                     O_WQK = O_WPQ + (size_t)D * D * 2, O_GPRE = O_WQK + (size_t)8 * 256 * 256 * 2, O_UT = O_GPRE + (size_t)T * 8 * 4, O_VT = O_UT + (size_t)16384 * D * 2,
                     O_BH = O_VT + (size_t)16384 * D * 2, O_GS = O_BH + (size_t)128 * 256 * 512 * 2, O_DENP = O_GS + (size_t)T * 4 * 8 * 4, O_QN = O_DENP + (size_t)T * 4 * 4 * 4,
                     O_DN = O_QN + (size_t)T * 4 * 4, O_DECAY = O_DN + (size_t)128 * 256 * 4, O_END = O_DECAY + 4096;
    static_assert(O_END + 16384 <= (size_t)536870912, "workspace overflow");
#define W_P6    ((bf16_t*)wsb)
#define W_HB    ((bf16_t*)(wsb + O_HB))
#define W_CBUF  ((bf16_t*)(wsb + O_CBUF))
#define W_MQ    ((bf16_t*)(wsb + O_MQ))
#define W_MK    ((bf16_t*)(wsb + O_MK))
#define W_MIXB  ((bf16_t*)(wsb + O_MIXB))
#define W_GPRE  ((float*)(wsb + O_GPRE))
#define W_HRAW  ((float*)(wsb + O_HB))
#define W_XR    ((float*)wsb)
#define W_MN    ((bf16_t*)((float*)wsb + TD))
#define W_KM    ((bf16_t*)((float*)wsb + TD + (size_t)256 * D))
#define W_VMT   ((bf16_t*)((float*)wsb + TD + (size_t)768 * D))
#define W_PX    ((bf16_t*)(wsb + O_MK))
#define W_GATES ((float*)wsb + TD + (size_t)1280 * D)
#define W_IDS   ((int*)((float*)wsb + TD + (size_t)1280 * D + (size_t)T * 128))
#define W_QX    ((bf16_t*)(wsb + O_CBUF))
#define W_BH    ((bf16_t*)(wsb + O_BH))
#define W_GS    ((float*)(wsb + O_GS))
#define W_DENP  ((float*)(wsb + O_DENP))
#define W_QN    ((float*)(wsb + O_QN))
#define W_DN    ((float*)(wsb + O_DN))
#define W_DECAY ((float*)(wsb + O_DECAY))
#define W_PQ    ((bf16_t*)(wsb + O_HB))
#define W_KWT   ((bf16_t*)(wsb + O_CBUF))
#define W_DC    ((float*)(wsb + 3 * P6S * 2))
#define W_UT    ((bf16_t*)(wsb + O_UT))
#define W_VT    ((bf16_t*)(wsb + O_VT))
#define PH_BEGIN() int tidx = threadIdx.x; asm volatile("" : "+v"(tidx)); const int half = tidx >> 8, tid = tidx & 255; float* sm = (float*)smem_raw + half * HALF_SM_FLOATS; \
                   char* wsb = (char*)ldp_raw(I_WS); (void)half; (void)tid; (void)sm; (void)wsb
#define GJOB_DEFAULT(g) pg8::GJob g; g.lda = D; g.ldb = D; g.K = D; g.nM = 32; g.nN = 8; g.a_pm_step = 256 * D; g.a_pn_shift = 0; g.a_pn_mask = 0; g.a_pn_step = 0; g.b_pm_shift = 0; g.b_pm_step = 0; g.b_pn_step = 256 * D; \
                        g.ldc = D; g.R = nullptr; g.ldr = D; g.mode = 0; g.escale = 1.0f; g.gs = nullptr; g.denp = nullptr; g.qn = nullptr; g.gvec = nullptr; g.mo = nullptr
#define GEMM_LDSP ((LAS unsigned char*)smem_raw)

    {
        PH_BEGIN();
        {
            LAS float* scr = (LAS float*)(LAS unsigned char*)(smem_raw) + (tidx >> 6) * (64 * 33);
            const int lane = tidx & 63;
            const int gw = blockIdx.x * 8 + (tidx >> 6), NGW = gridDim.x * 8;
            constexpr int I_IN = 32 * 192, I_SQ = 32 * 64, I_QK = 8 * 4 * 8;
            constexpr int NITEMS = I_IN + 6 * I_SQ + I_QK;
#pragma nounroll
            for (int it = gw; it < NITEMS; it += NGW) {
                const float* W; int ldw, K, csrc0, row0, kb; bf16_t* WT; float wscale = 1.0f;
                int r = it;
                if (r < I_IN) { const int nb = r % 192; kb = r / 192; W = PF(I_WIN); ldw = INC; K = D; csrc0 = nb * 32 + (nb >= 96 ? 8 : 0); WT = (bf16_t*)(wsb + O_WIN); row0 = nb * 32; }
                else if ((r -= I_IN) < 6 * I_SQ) {
                    const int wsel = r / I_SQ; r -= wsel * I_SQ; const int nb = r % 64; kb = r / 64; ldw = D; K = D; csrc0 = nb * 32; row0 = nb * 32;
                    W = PF(wsel == 0 ? I_WOUT : wsel == 1 ? I_WXQ : wsel == 2 ? I_WXK : wsel == 3 ? I_WXV : wsel == 4 ? I_WXO : I_WPQ);
                    WT = (bf16_t*)(wsb + O_WOUT + (size_t)wsel * ((size_t)D * D * 2));
                } else {
                    r -= 6 * I_SQ; const int hq = r / 32; r -= hq * 32; const int nb = r % 8; kb = r / 8;
                    W = PF(hq < 4 ? I_WMQ : I_WMK) + (size_t)(hq & 3) * 65536; ldw = 256; K = 256; csrc0 = nb * 32; WT = (bf16_t*)(wsb + O_WQK); row0 = hq * 256 + nb * 32;
                    if (hq >= 4) wscale = 0.0625f;
                }
                p0_transpose_item(W, ldw, K, csrc0, WT, row0, scr, kb, lane, wscale);
            }
            {
                const float* ut = PF(I_UTAB); const float* vt = PF(I_VTAB);
                const size_t n8 = (size_t)16384 * D / 8, nth = (size_t)gridDim.x * NTHR;
#pragma nounroll
                for (size_t i = (size_t)blockIdx.x * NTHR + tidx; i < 2 * n8; i += nth) {
                    const bool second = i >= n8; const size_t k = second ? i - n8 : i;
                    const float4* sp = (const float4*)((second ? vt : ut) + k * 8);
                    const float4 a = sp[0], b = sp[1];
                    uint4 o; o.x = pk2(a.x, a.y); o.y = pk2(a.z, a.w); o.z = pk2(b.x, b.y); o.w = pk2(b.z, b.w);
                    *(uint4*)((second ? W_VT : W_UT) + k * 8) = o;
                }
            }
            __syncthreads();
        }
        { const float* rin = PF(I_X); const float* rg = PF(I_GMIX); const float* win = PF(I_WIN);
#pragma nounroll
          PHASE_LOOP(T) d_rmsnorm(VB, tid, sm, rin, rg, W_HB, win, W_GPRE); }
    }
    xcd_barrier(xb);
    {
        PH_BEGIN();
        GJOB_DEFAULT(g); g.A = W_HB; g.Bt = (bf16_t*)(wsb + O_WIN); g.nN = 24; g.C = (float*)W_P6; g.ldc = 1024;
        pg8::gemm_phase<4>(GEMM_LDSP, g, tidx);
    }
    xcd_barrier(xb);
    {
        PH_BEGIN();
        const float* cw = PF(I_CONVW); const float* cb = PF(I_CONVB);
#pragma nounroll
        PHASE_LOOP(T) d_conv_silu(VB, tid, W_P6, cw, cb, W_CBUF);
#pragma nounroll
        PHASE_LOOP(T) d_rope(VB, tid, W_P6);
        if (blockIdx.x < 8 && tidx < 64) mlstm_gates_wave(blockIdx.x >> 2, blockIdx.x & 3, tidx, W_GPRE, PF(I_BMI), PF(I_BMF), W_GS, W_DECAY);
#pragma nounroll
        PHASE_LOOP(2048) { const int it = VB, lt = it & 3, et = (it >> 2) & 3, h = (it >> 4) & 3, cg = it >> 6;
            transpose_tile64(tid, sm, W_P6 + P6S + (size_t)(cg * 256 + lt * 64) * 1024 + h * 256 + et * 64, 1024, W_BH + ((size_t)(cg * 4 + h) * 256 + et * 64) * 512 + lt * 64, 512, nullptr, 0); }
    }
    xcd_barrier(xb);
    {
        PH_BEGIN();
        {
            GJOB_DEFAULT(g); g.A = W_CBUF; g.lda = 1024; g.a_pm_step = 256 * 1024; g.Bt = (bf16_t*)(wsb + O_WQK); g.ldb = 256; g.b_pn_step = 256 * 256; g.K = 256; g.a_pn_mask = 3; g.a_pn_step = 256; g.C = (float*)W_MQ; g.ldc = 1024;
            pg8::gemm_phase<4>(GEMM_LDSP, g, tidx);
            __syncthreads();
        }
        const float* ga = PF(I_GAHEAD);
#pragma nounroll
        PHASE_LOOP(NB * 8 * S / 4) d_dilated(VB, tid, sm, W_P6, ga, W_MIXB);
    }
    xcd_barrier(xb);
    {
        PH_BEGIN();
#pragma nounroll
        PHASE_LOOP(2048) { const int it = VB, lt = it & 3, dt = (it >> 2) & 3, h = (it >> 4) & 3, cg = it >> 6;
            transpose_tile64(tid, sm, W_MK + (size_t)(cg * 256 + lt * 64) * 1024 + h * 256 + dt * 64, 1024, W_KWT + ((size_t)(cg * 4 + h) * 256 + dt * 64) * 256 + lt * 64, 256,
                             W_GS + ((size_t)(cg * 256 + lt * 64) * 4 + h) * 8 + 2, 32); }
        {
            const size_t nth = (size_t)gridDim.x * NTHR;
#pragma nounroll
            for (size_t i = (size_t)blockIdx.x * NTHR + tidx; i < (size_t)T * 128; i += nth) {
                const size_t t = i >> 7; const int c8 = (int)(i & 127) * 8, h = c8 >> 8, d = c8 & 255;
                const float sc = W_GS[(t * 4 + h) * 8 + 3];
                const uint4 v = *(const uint4*)(W_MQ + t * 1024 + c8);
                uint4 o;
                o.x = pk2(bf2f((unsigned short)(v.x & 0xFFFFu)) * sc, bf2f((unsigned short)(v.x >> 16)) * sc); o.y = pk2(bf2f((unsigned short)(v.y & 0xFFFFu)) * sc, bf2f((unsigned short)(v.y >> 16)) * sc);
                o.z = pk2(bf2f((unsigned short)(v.z & 0xFFFFu)) * sc, bf2f((unsigned short)(v.z >> 16)) * sc); o.w = pk2(bf2f((unsigned short)(v.w & 0xFFFFu)) * sc, bf2f((unsigned short)(v.w >> 16)) * sc);
                *(uint4*)(W_PQ + t * 2048 + h * 512 + 256 + d) = o;
            }
        }
#pragma nounroll
        PHASE_LOOP(128) { const int cgh = VB, cg = cgh >> 2, h = cgh & 3;
            float a = 0.f;
            for (int l = 0; l < 256; ++l) { const size_t t = (size_t)cg * 256 + l; a = fmaf(W_GS[(t * 4 + h) * 8 + 2], bf2f(W_MK[t * 1024 + h * 256 + tid]), a); }
            W_DN[(size_t)cgh * 256 + tid] = a; }
        __syncthreads();
        {
            GJOB_DEFAULT(g); g.A = W_MQ; g.lda = 1024; g.a_pm_step = 256 * 1024; g.a_pn_mask = 3; g.a_pn_step = 256; g.K = 256; g.nN = 4;
            g.Bt = W_MK; g.ldb = 1024; g.b_pn_step = 256; g.b_pm_step = 256 * 1024; g.C = (float*)W_PQ; g.gs = W_GS; g.denp = W_DENP;
            pg8::gemm_phase<6>(GEMM_LDSP, g, tidx);
        }
    }
    xcd_barrier(xb);
    {
        PH_BEGIN();
        GJOB_DEFAULT(g); g.A = W_BH; g.lda = 512; g.a_pm_step = 4 * 256 * 512; g.a_pn_mask = 3; g.a_pn_step = 256 * 512; g.K = 256; g.nN = 4;
        g.Bt = W_KWT; g.ldb = 256; g.b_pn_step = 65536; g.b_pm_step = 4 * 65536; g.C = W_DC;
        pg8::gemm_phase<7>(GEMM_LDSP, g, tidx);
    }
    xcd_barrier(xb);
    {
        PH_BEGIN();
        {
#pragma nounroll
            for (int gid = blockIdx.x * NTHR + tidx; gid < 131072; gid += gridDim.x * NTHR) {
                const int bh = gid >> 14, b = bh >> 2, h = bh & 3, e = (gid >> 6) & 255, d = (gid & 63) * 4;
                float4 C = make_float4(0.f, 0.f, 0.f, 0.f);
#pragma unroll 4
                for (int c = 0; c < 16; ++c) {
                    const int cgh = (b * 16 + c) * 4 + h;
                    uint2 o; o.x = pk2(C.x, C.y); o.y = pk2(C.z, C.w);
                    *(uint2*)(W_BH + ((size_t)cgh * 256 + e) * 512 + 256 + d) = o;
                    const float dec = W_DECAY[cgh];
                    const float4 dc = *(const float4*)(W_DC + ((size_t)cgh * 256 + e) * 256 + d);
                    C.x = fmaf(dec, C.x, dc.x); C.y = fmaf(dec, C.y, dc.y); C.z = fmaf(dec, C.z, dc.z); C.w = fmaf(dec, C.w, dc.w);
                }
            }
        }
#pragma nounroll
        PHASE_LOOP(128) { const int cgh = VB, cg = cgh >> 2, h = cgh & 3, b = cg >> 4, c = cg & 15;
            float n = 0.f;
            for (int cc = 0; cc < c; ++cc) { const int j = (b * 16 + cc) * 4 + h; n = fmaf(W_DECAY[j], n, W_DN[(size_t)j * 256 + tid]); }
            __syncthreads();
            sm[tid] = n;
            __syncthreads();
            const int lane = tid & 63, w = tid >> 6;
            const float4 nv = *(const float4*)(sm + lane * 4);
            for (int i = 0; i < 64; ++i) {
                const size_t t = (size_t)cg * 256 + w * 64 + i;
                const ushort4 q4 = *(const ushort4*)(W_MQ + t * 1024 + h * 256 + lane * 4);
                float s = bf2f(q4.x) * nv.x + bf2f(q4.y) * nv.y + bf2f(q4.z) * nv.z + bf2f(q4.w) * nv.w;
                s = wave_sum(s);
                if (lane == 0) W_QN[t * 4 + h] = s;
            }
        }
    }
    xcd_barrier(xb);
    {
        PH_BEGIN();
        GJOB_DEFAULT(g); g.A = W_PQ; g.a_pn_mask = 3; g.a_pn_step = 512; g.K = 512; g.nN = 4;
        g.Bt = W_BH; g.ldb = 512; g.b_pn_step = 256 * 512; g.b_pm_step = 4 * 256 * 512; g.C = (float*)W_MIXB;
        g.gs = W_GS; g.denp = W_DENP; g.qn = W_QN; g.gvec = PF(I_GMHEAD); g.mo = W_P6 + 2 * P6S;
        pg8::gemm_phase<8>(GEMM_LDSP, g, tidx);
    }
    xcd_barrier(xb);
    {
        PH_BEGIN();
        GJOB_DEFAULT(g); g.A = W_MIXB; g.Bt = (bf16_t*)(wsb + O_WOUT); g.C = W_XR; g.R = PF(I_X);
        pg8::gemm_phase<0>(GEMM_LDSP, g, tidx);
    }
    xcd_barrier(xb);
    {
        PH_BEGIN();
        { const float* rg = PF(I_GCROSS); const float* win = PF(I_WIN);
#pragma nounroll
          PHASE_LOOP(T) d_rmsnorm(VB, tid, sm, W_XR, rg, W_HB, win, nullptr); }
        { const float* rin = PF(I_MEM); const float* rg = PF(I_GMEM); const float* win = PF(I_WIN);
#pragma nounroll
          PHASE_LOOP(512) d_rmsnorm(VB, tid, sm, rin, rg, W_MN, win, nullptr); }
    }
    xcd_barrier(xb);
    {
        PH_BEGIN();
        { GJOB_DEFAULT(g); g.A = W_HB; g.Bt = (bf16_t*)(wsb + O_WXQ); g.C = (float*)W_QX; pg8::gemm_phase<3>(GEMM_LDSP, g, tidx); __syncthreads(); }
        { GJOB_DEFAULT(g); g.A = W_MN; g.Bt = (bf16_t*)(wsb + O_WXK); g.nM = 2; g.C = (float*)W_KM; pg8::gemm_phase<3>(GEMM_LDSP, g, tidx); __syncthreads(); }
        { GJOB_DEFAULT(g); g.A = (bf16_t*)(wsb + O_WXV); g.Bt = W_MN; g.nM = 8; g.nN = 2; g.C = (float*)W_VMT; g.ldc = 512; pg8::gemm_phase<3>(GEMM_LDSP, g, tidx); }
    }
    xcd_barrier(xb);
    {
        PH_BEGIN();
        GJOB_DEFAULT(g); g.A = W_QX; g.K = 512; g.a_pn_mask = 3; g.a_pn_step = 512; g.Bt = W_KM; g.b_pn_step = 512; g.b_pm_shift = 4; g.b_pm_step = 256 * D; g.nN = 4;
        g.C = (float*)W_PX; g.ldc = 1024; g.escale = 0.04419417382415922f * 1.4426950408889634f;
        pg8::gemm_phase<5>(GEMM_LDSP, g, tidx);
    }
    xcd_barrier(xb);
    {
        PH_BEGIN();
        GJOB_DEFAULT(g); g.A = W_PX; g.lda = 1024; g.a_pm_step = 256 * 1024; g.K = 256; g.a_pn_shift = 1; g.a_pn_mask = 3; g.a_pn_step = 256; g.Bt = W_VMT; g.ldb = 512; g.b_pn_step = 256 * 512; g.b_pm_shift = 4; g.b_pm_step = 256;
        g.C = (float*)W_MIXB;
        pg8::gemm_phase<3>(GEMM_LDSP, g, tidx);
    }
    xcd_barrier(xb);
    {
        PH_BEGIN();
        GJOB_DEFAULT(g); g.A = W_MIXB; g.Bt = (bf16_t*)(wsb + O_WXO); g.C = W_XR; g.R = W_XR;
        pg8::gemm_phase<0>(GEMM_LDSP, g, tidx);
    }
    xcd_barrier(xb);
    {
        PH_BEGIN();
        const float* rg = PF(I_GFFN); const float* win = PF(I_WIN);
#pragma nounroll
        PHASE_LOOP(T) d_rmsnorm(VB, tid, sm, W_XR, rg, W_HB, win, nullptr);
    }
    xcd_barrier(xb);
    {
        PH_BEGIN();
        GJOB_DEFAULT(g); g.A = W_HB; g.Bt = (bf16_t*)(wsb + O_WPQ); g.C = (float*)W_QX;
        pg8::gemm_phase<3>(GEMM_LDSP, g, tidx);
    }
    xcd_barrier(xb);
    {
        PH_BEGIN();
        const float* sk = PF(I_SUBK);
#pragma nounroll
        PHASE_LOOP(T * 8 / 4) d_peer_topk(VB, tid, sm, W_QX, sk, W_IDS, W_GATES);
    }
    xcd_barrier(xb);
    {
        PH_BEGIN();
        const float* gf = PF(I_GFINAL); float* outp = (float*)ldp_raw(I_OUT);
#pragma nounroll
        PHASE_LOOP(T) d_peer_out(VB, tid, sm, W_HB, W_XR, W_IDS, W_GATES, W_UT, W_VT, gf, outp);
    }
}
}

extern "C" void kernel_launch(void* const* d_in, const int* in_sizes, int n_in, void* d_out, int out_size, void* d_ws, size_t ws_size, hipStream_t stream) {
    static int grid_blocks = 0;
    if (!grid_blocks) {
        int dev = 0, cus = 0, per_cu = 0;
        hipGetDevice(&dev);
        hipDeviceGetAttribute(&cus, hipDeviceAttributeMultiprocessorCount, dev);
        hipFuncSetAttribute((const void*)mega, hipFuncAttributeMaxDynamicSharedMemorySize, SMEM_BYTES);
        hipOccupancyMaxActiveBlocksPerMultiprocessor(&per_cu, mega, NTHR, SMEM_BYTES);
        if (per_cu > 1) per_cu = 1;
        if (per_cu < 1) per_cu = 1;
        grid_blocks = cus * per_cu;
    }
    Params P{};
    const float** pp = (const float**)&P;
    for (int i = 0; i < 25; ++i) pp[i] = (const float*)d_in[i];
    P.out = (float*)d_out;
    P.bar = (unsigned*)d_ws;
    P.ws = (float*)((char*)d_ws + 16384);
    hipMemsetAsync(d_ws, 0, 16384, stream);
    void* args[] = {&P};
    hipError_t e = hipLaunchCooperativeKernel((const void*)mega, dim3(grid_blocks), dim3(NTHR), args, SMEM_BYTES, stream);
    if (e != hipSuccess) fprintf(stderr, "cooperative launch failed: %s (grid %d)\n", hipGetErrorString(e), grid_blocks);
}
```

```cpp
#include <hip/hip_runtime.h>
#include <stdint.h>
#include <math.h>
#include <cstdio>

#define LAS_ __attribute__((address_space(3)))
namespace {
constexpr int D = 2048, NB = 2, S = 4096, T = NB * S;
constexpr int INC = 6152;
constexpr int C_MIN = 0, C_MV = 1024, C_MO = 2048, C_MI = 3072, C_MF = 3076, C_AQ = 3080, C_AK = 4104, C_AV = 5128;
constexpr float EPS = 1e-6f;
constexpr size_t P6S = (size_t)8192 * 1024;
constexpr int NTHR = 512;
constexpr int HALF_SM_FLOATS = 8704;
constexpr int GEMM_LDS = 131072;
constexpr int SMEM_BYTES = GEMM_LDS + 1024 + 8192;
typedef unsigned short bf16_t;
__device__ __forceinline__ unsigned f2bf(float f) { unsigned u = __float_as_uint(f); u += 0x7FFFu + ((u >> 16) & 1u); return u >> 16; }
__device__ __forceinline__ unsigned pk2(float lo, float hi) { return f2bf(lo) | (f2bf(hi) << 16); }
__device__ __forceinline__ float bf2f(unsigned short b) { return __uint_as_float(((unsigned)b) << 16); }
extern __shared__ __attribute__((aligned(16))) unsigned char smem_raw[];
enum { I_X = 0, I_MEM, I_GMIX, I_WIN, I_CONVW, I_CONVB, I_WMQ, I_WMK, I_BMI, I_BMF, I_GMHEAD, I_GAHEAD, I_WOUT, I_GCROSS, I_GMEM,
       I_WXQ, I_WXK, I_WXV, I_WXO, I_GFFN, I_WPQ, I_SUBK, I_UTAB, I_VTAB, I_GFINAL, I_OUT, I_BAR, I_WS, I_NPTR };
__device__ __forceinline__ unsigned long long ldp_raw(int i) {
    const LAS_ unsigned long long* tab = (const LAS_ unsigned long long*)(LAS_ unsigned char*)(smem_raw + GEMM_LDS + 64);
    const unsigned long long v = tab[i];
    const unsigned lo = __builtin_amdgcn_readfirstlane((unsigned)v), hi = __builtin_amdgcn_readfirstlane((unsigned)(v >> 32));
    return ((unsigned long long)hi << 32) | lo;
}
#define PF(i) ((const float*)ldp_raw(i))

#define XB_TMO      128
#define XB_XCNT(j)  (256  + 64 * (j))
#define XB_XSUB(j)  (1280 + 64 * (j))
#define XB_XGEN(j)  (2304 + 64 * (j))
#define XB_TOP      3328
#define XB_TOPGEN   3392
#define XCD_BAR_WORDS 3456
#define XB_SPIN_CAP (1u << 22)
#define LAS __attribute__((address_space(3)))

__device__ __forceinline__ unsigned xb_ld(unsigned* p)              { return __hip_atomic_load(p, __ATOMIC_RELAXED, __HIP_MEMORY_SCOPE_AGENT); }
__device__ __forceinline__ unsigned xb_add(unsigned* p, unsigned v) { return __hip_atomic_fetch_add(p, v, __ATOMIC_RELAXED, __HIP_MEMORY_SCOPE_AGENT); }
__device__ __forceinline__ unsigned xb_xcc_id() { return (unsigned)__builtin_amdgcn_s_getreg((3 << 11) | 20) & 0xFu; }
#define XB_SPIN(cond, bar) do { unsigned _sp = 0; while (cond) { __builtin_amdgcn_s_sleep(1); \
    if ((++_sp & 255u) == 0u) { if (xb_ld(&(bar)[XB_TMO])) break; if (_sp > XB_SPIN_CAP) { atomicAdd(&(bar)[XB_TMO], 1u); break; } } } } while (0)

struct XcdBarrier { unsigned* bar; unsigned x; volatile LAS unsigned* st; };

__device__ __forceinline__ XcdBarrier xcd_barrier_post(unsigned* bar, volatile LAS unsigned* st) {
    XcdBarrier b; b.bar = bar; b.x = xb_xcc_id(); b.st = st;
    if (threadIdx.x == 0) (void)xb_add(&bar[XB_XCNT(b.x)], 1u);
    return b;
}
__device__ __forceinline__ void xcd_barrier_complete(unsigned* bar, unsigned x, unsigned& nloc, unsigned& nx) {
    const unsigned G = gridDim.x * gridDim.y * gridDim.z;
    unsigned sum, cnt, mine, sp = 0u;
    for (;;) {
        sum = 0u; cnt = 0u; mine = 0u;
#pragma unroll
        for (unsigned j = 0; j < 16; ++j) { const unsigned c = xb_ld(&bar[XB_XCNT(j)]); sum += c; cnt += (c > 0u) ? 1u : 0u; mine = (j == x) ? c : mine; }
        if (sum == G) break;
        __builtin_amdgcn_s_sleep(1);
        if ((++sp & 255u) == 0u) { if (xb_ld(&bar[XB_TMO])) break; if (sp > XB_SPIN_CAP) { atomicAdd(&bar[XB_TMO], 1u); break; } }
    }
    nloc = mine > 0u ? mine : 1u; nx = cnt > 0u ? cnt : 1u;
}
__device__ __forceinline__ void xcd_barrier(const XcdBarrier& b) {
    asm volatile("s_waitcnt vmcnt(0)" ::: "memory");
    __syncthreads();
    if (threadIdx.x == 0) {
        unsigned* bar = b.bar;
        __builtin_amdgcn_s_waitcnt(0);
        unsigned nloc = b.st[0], nx = b.st[1];
        if (nloc == 0u) { xcd_barrier_complete(bar, b.x, nloc, nx); b.st[0] = nloc; b.st[1] = nx; }
        const unsigned old = xb_add(&bar[XB_XSUB(b.x)], 1u);
        const unsigned gen = old / nloc;
        if (old + 1u == (gen + 1u) * nloc) {
            __builtin_amdgcn_fence(__ATOMIC_RELEASE, "agent");
            asm volatile("s_waitcnt vmcnt(0)" ::: "memory");
            const unsigned og = xb_add(&bar[XB_TOP], 1u);
            const unsigned tg = og / nx;
            if (og + 1u == (tg + 1u) * nx) xb_add(&bar[XB_TOPGEN], 1u);
            else XB_SPIN(xb_ld(&bar[XB_TOPGEN]) == tg, bar);
            __builtin_amdgcn_fence(__ATOMIC_ACQUIRE, "agent");
            xb_add(&bar[XB_XGEN(b.x)], 1u);
            asm volatile("s_waitcnt vmcnt(0)" ::: "memory");
        } else {
            XB_SPIN(xb_ld(&bar[XB_XGEN(b.x)]) == gen, bar);
            __builtin_amdgcn_fence(__ATOMIC_ACQUIRE, "agent");
            asm volatile("s_waitcnt vmcnt(0)" ::: "memory");
        }
    }
    __syncthreads();
}

__device__ __forceinline__ float wave_sum(float v) {
#pragma unroll
    for (int o = 32; o >= 1; o >>= 1) v += __shfl_xor(v, o);
    return v;
}
__device__ __forceinline__ float wave_max(float v) {
#pragma unroll
    for (int o = 32; o >= 1; o >>= 1) v = fmaxf(v, __shfl_xor(v, o));
    return v;
}
__device__ __forceinline__ float log_sigmoid(float x) { return fminf(x, 0.f) - log1pf(expf(-fabsf(x))); }


__device__ __forceinline__ void d_rmsnorm(int vb, int t, float* sm, const float* __restrict__ in, const float* __restrict__ g, bf16_t* __restrict__ out,
                                          const float* __restrict__ w_in, float* __restrict__ gpre) {
    float* red = sm;
    const int row = vb;
    const float4* p = (const float4*)(in + (size_t)row * D);
    float4 a = p[t], b = p[t + 256];
    float s = a.x * a.x + a.y * a.y + a.z * a.z + a.w * a.w + b.x * b.x + b.y * b.y + b.z * b.z + b.w * b.w;
    s = wave_sum(s);
    __syncthreads();
    if ((t & 63) == 0) red[t >> 6] = s;
    __syncthreads();
    const float tot = red[0] + red[1] + red[2] + red[3];
    const float r = rsqrtf(tot * (1.0f / D) + EPS);
    const float4* gp = (const float4*)g;
    float4 ga = gp[t], gb = gp[t + 256];
    float hv[8] = {a.x * r * ga.x, a.y * r * ga.y, a.z * r * ga.z, a.w * r * ga.w, b.x * r * gb.x, b.y * r * gb.y, b.z * r * gb.z, b.w * r * gb.w};
    uint2 o0, o1;
    o0.x = pk2(hv[0], hv[1]); o0.y = pk2(hv[2], hv[3]); o1.x = pk2(hv[4], hv[5]); o1.y = pk2(hv[6], hv[7]);
    *(uint2*)(out + (size_t)row * D + t * 4) = o0;
    *(uint2*)(out + (size_t)row * D + 1024 + t * 4) = o1;
    if (gpre) {
        float gs[8];
#pragma unroll
        for (int c = 0; c < 8; ++c) gs[c] = 0.f;
#pragma unroll
        for (int j = 0; j < 8; ++j) {
            const int k = (j < 4) ? (t * 4 + j) : (1024 + t * 4 + (j - 4));
            const float4 w0 = *(const float4*)(w_in + (size_t)k * INC + C_MI), w1 = *(const float4*)(w_in + (size_t)k * INC + C_MI + 4);
            gs[0] = fmaf(hv[j], w0.x, gs[0]); gs[1] = fmaf(hv[j], w0.y, gs[1]); gs[2] = fmaf(hv[j], w0.z, gs[2]); gs[3] = fmaf(hv[j], w0.w, gs[3]);
            gs[4] = fmaf(hv[j], w1.x, gs[4]); gs[5] = fmaf(hv[j], w1.y, gs[5]); gs[6] = fmaf(hv[j], w1.z, gs[6]); gs[7] = fmaf(hv[j], w1.w, gs[7]);
        }
#pragma unroll
        for (int c = 0; c < 8; ++c) gs[c] = wave_sum(gs[c]);
        __syncthreads();
        if ((t & 63) == 0) {
#pragma unroll
            for (int c = 0; c < 8; ++c) red[8 + (t >> 6) * 8 + c] = gs[c];
        }
        __syncthreads();
        if (t < 8) gpre[(size_t)row * 8 + t] = red[8 + t] + red[16 + t] + red[24 + t] + red[32 + t];
    }
}

namespace pg8 {
typedef short bf16x8 __attribute__((ext_vector_type(8)));
typedef float f32x4 __attribute__((ext_vector_type(4)));
constexpr int BM = 256, BK = 64, HALF = 128, HTB = HALF * BK * 2, NXCD = 8, WGM = 8;
__device__ __forceinline__ int lds_byte(int r, int c) { const int st = (r >> 4) * 2 + (c >> 5), rr = r & 15, cc = c & 31, ob = rr * 64 + cc * 2; return st * 1024 + (ob ^ (((ob >> 9) & 1) << 5)); }
__device__ __forceinline__ void stage_rc(int b, int& R, int& C) { const int st = b / 1024, sb = b % 1024, swz = sb ^ (((sb >> 9) & 1) << 5); R = (st >> 1) * 16 + swz / 64; C = (st & 1) * 32 + (swz % 64) / 2; }
struct Unit { int pm, pn; };
struct GJob {
    const bf16_t* A; const bf16_t* Bt;
    int lda, ldb, K, nM, nN;
    int a_pn_shift, a_pn_mask, a_pn_step;
    int b_pm_shift, b_pm_step, b_pn_step;
    int a_pm_step;
    float escale;
    const float* gs; float* denp; const float* qn; const float* gvec; const bf16_t* mo;
    float* C; int ldc; const float* R; int ldr;
    int mode;
};
__device__ __forceinline__ bool unit_next(const GJob& g, int i, Unit& u) {
    const int nwg = g.nM * g.nN;
    const long L = (long)i * gridDim.x + blockIdx.x; if (L >= nwg) return false;
    int wgid = (int)L; { const int q = nwg / NXCD, r = nwg % NXCD, xcd = wgid % NXCD, off = wgid / NXCD; wgid = (xcd < r ? xcd * (q + 1) : r * (q + 1) + (xcd - r) * q) + off; }
    const int nig = WGM * g.nN, gid = wgid / nig, fm = gid * WGM, gsz = (g.nM - fm) < WGM ? (g.nM - fm) : WGM;
    u.pm = fm + ((wgid % nig) % gsz); u.pn = (wgid % nig) / gsz; return true;
}
template <int MODE> __device__ __forceinline__ void epilogue(const GJob& g, f32x4 (&acc)[2][2][4][2], const Unit& u, int wr, int wc, int fr, int fq, LAS unsigned char* xlds) {
    const int row0 = u.pm * BM + wr * 64 + fr;
    if constexpr (MODE == 0) {
        const int col0 = u.pn * BM + wc * 32 + 4 * fq;
#pragma unroll
        for (int ai = 0; ai < 2; ++ai)
#pragma unroll
            for (int m = 0; m < 4; ++m) {
                const int row = row0 + ai * HALF + m * 16;
                float* rowp = g.C + (size_t)row * g.ldc + col0;
                const float* rp = g.R ? g.R + (size_t)row * g.ldr + col0 : nullptr;
#pragma unroll
                for (int bj = 0; bj < 2; ++bj)
#pragma unroll
                    for (int n = 0; n < 2; ++n) {
                        f32x4 v = acc[ai][bj][m][n];
                        if (rp) v = v + *(const f32x4*)(rp + bj * HALF + n * 16);
                        *(f32x4*)(rowp + bj * HALF + n * 16) = v;
                    }
            }
    } else if constexpr (MODE == 6) {
        const int h = u.pn; const size_t t0 = (size_t)u.pm * BM;
        bf16_t* Cb = (bf16_t*)g.C;
#pragma unroll
        for (int ai = 0; ai < 2; ++ai)
#pragma unroll
            for (int m = 0; m < 4; ++m) {
                const int l = ai * HALF + wr * 64 + m * 16 + fr;
                const float M2 = g.gs[((t0 + l) * 4 + h) * 8 + 1];
                bf16_t* rowp = Cb + (t0 + l) * 2048 + h * 512 + wc * 32 + 4 * fq;
                float rs = 0.f;
#pragma unroll
                for (int bj = 0; bj < 2; ++bj)
#pragma unroll
                    for (int n = 0; n < 2; ++n) {
                        const f32x4 a = acc[ai][bj][m][n];
                        const int s0 = bj * HALF + wc * 32 + n * 16 + 4 * fq;
                        float p[4];
#pragma unroll
                        for (int r = 0; r < 4; ++r) { const float u2 = g.gs[((t0 + s0 + r) * 4 + h) * 8 + 0]; p[r] = (s0 + r <= l) ? a[r] * __builtin_amdgcn_exp2f(u2 - M2) : 0.f; rs += p[r]; }
                        uint2 o; o.x = pk2(p[0], p[1]); o.y = pk2(p[2], p[3]);
                        *(uint2*)(rowp + bj * HALF + n * 16) = o;
                    }
                rs += __shfl_xor(rs, 16); rs += __shfl_xor(rs, 32);
                if (fq == 0) g.denp[((t0 + l) * 4 + h) * 4 + wc] = rs;
            }
    } else if constexpr (MODE == 7) {
        float* Ct = g.C + (size_t)(u.pm * 4 + u.pn) * 65536;
        const int col0 = wc * 32 + 4 * fq;
#pragma unroll
        for (int ai = 0; ai < 2; ++ai)
#pragma unroll
            for (int m = 0; m < 4; ++m) {
                float* rowp = Ct + (size_t)(ai * HALF + wr * 64 + m * 16 + fr) * 256 + col0;
#pragma unroll
                for (int bj = 0; bj < 2; ++bj)
#pragma unroll
                    for (int n = 0; n < 2; ++n) *(f32x4*)(rowp + bj * HALF + n * 16) = acc[ai][bj][m][n];
            }
    } else if constexpr (MODE == 8) {
        const int h = u.pn; const size_t t0 = (size_t)u.pm * BM;
        LAS float* X0 = (LAS float*)xlds + wr * 512;
#pragma unroll
        for (int ai = 0; ai < 2; ++ai)
#pragma unroll
            for (int m = 0; m < 4; ++m) {
                const size_t th = (t0 + ai * HALF + wr * 64 + m * 16 + fr) * 4 + h;
                const f32x4 dp = *(const f32x4*)(g.denp + th * 4);
                const float den = (dp[0] + dp[1]) + (dp[2] + dp[3]) + g.gs[th * 8 + 3] * g.qn[th];
                const float rden = 1.0f / fmaxf(fabsf(den), g.gs[th * 8 + 4]);
                float ss = 0.f;
#pragma unroll
                for (int bj = 0; bj < 2; ++bj)
#pragma unroll
                    for (int n = 0; n < 2; ++n) { f32x4 a = acc[ai][bj][m][n] * rden; acc[ai][bj][m][n] = a; ss += (a[0] * a[0] + a[1] * a[1]) + (a[2] * a[2] + a[3] * a[3]); }
                ss += __shfl_xor(ss, 16); ss += __shfl_xor(ss, 32);
                if (fq == 0) X0[(ai * 64 + m * 16 + fr) * 4 + wc] = ss;
            }
        asm volatile("s_waitcnt lgkmcnt(0)" ::: "memory"); __builtin_amdgcn_s_barrier(); asm volatile("" ::: "memory");
        bf16_t* Cb = (bf16_t*)g.C;
        const int col0 = wc * 32 + 4 * fq;
#pragma unroll
        for (int ai = 0; ai < 2; ++ai)
#pragma unroll
            for (int m = 0; m < 4; ++m) {
                const f32x4 p4 = *(const LAS f32x4*)(X0 + (ai * 64 + m * 16 + fr) * 4);
                const float rsn = rsqrtf(((p4[0] + p4[1]) + (p4[2] + p4[3])) * (1.0f / 256.0f) + EPS);
                const size_t t = t0 + ai * HALF + wr * 64 + m * 16 + fr;
                bf16_t* rowp = Cb + t * 2048 + h * 256 + col0;
                const bf16_t* mop = g.mo + t * 1024 + h * 256 + col0;
#pragma unroll
                for (int bj = 0; bj < 2; ++bj)
#pragma unroll
                    for (int n = 0; n < 2; ++n) {
                        const f32x4 a = acc[ai][bj][m][n];
                        const ushort4 mo4 = *(const ushort4*)(mop + bj * HALF + n * 16);
                        const f32x4 gv = *(const f32x4*)(g.gvec + h * 256 + col0 + bj * HALF + n * 16);
                        const float o0 = a[0] * rsn * gv[0] / (1.0f + __expf(-bf2f(mo4.x)));
                        const float o1 = a[1] * rsn * gv[1] / (1.0f + __expf(-bf2f(mo4.y)));
                        const float o2 = a[2] * rsn * gv[2] / (1.0f + __expf(-bf2f(mo4.z)));
                        const float o3 = a[3] * rsn * gv[3] / (1.0f + __expf(-bf2f(mo4.w)));
                        uint2 o; o.x = pk2(o0, o1); o.y = pk2(o2, o3);
                        *(uint2*)(rowp + bj * HALF + n * 16) = o;
                    }
            }
    } else if constexpr (MODE == 5) {
        LAS float* X0 = (LAS float*)xlds + wr * 512;
        LAS float* X1 = (LAS float*)xlds + 1024 + wr * 512;
#pragma unroll
        for (int ai = 0; ai < 2; ++ai)
#pragma unroll
            for (int m = 0; m < 4; ++m) {
                float v = -INFINITY;
#pragma unroll
                for (int bj = 0; bj < 2; ++bj)
#pragma unroll
                    for (int n = 0; n < 2; ++n) { const f32x4 a = acc[ai][bj][m][n]; v = fmaxf(v, fmaxf(fmaxf(a[0], a[1]), fmaxf(a[2], a[3]))); }
                v = fmaxf(v, __shfl_xor(v, 16)); v = fmaxf(v, __shfl_xor(v, 32));
                if (fq == 0) X0[(ai * 64 + m * 16 + fr) * 4 + wc] = v;
            }
        asm volatile("s_waitcnt lgkmcnt(0)" ::: "memory"); __builtin_amdgcn_s_barrier(); asm volatile("" ::: "memory");
#pragma unroll
        for (int ai = 0; ai < 2; ++ai)
#pragma unroll
            for (int m = 0; m < 4; ++m) {
                const f32x4 p4 = *(const LAS f32x4*)(X0 + (ai * 64 + m * 16 + fr) * 4);
                const float mxr = fmaxf(fmaxf(p4[0], p4[1]), fmaxf(p4[2], p4[3])) * g.escale;
                float s = 0.f;
#pragma unroll
                for (int bj = 0; bj < 2; ++bj)
#pragma unroll
                    for (int n = 0; n < 2; ++n) { f32x4 a = acc[ai][bj][m][n];
                        a[0] = __builtin_amdgcn_exp2f(a[0] * g.escale - mxr); a[1] = __builtin_amdgcn_exp2f(a[1] * g.escale - mxr); a[2] = __builtin_amdgcn_exp2f(a[2] * g.escale - mxr); a[3] = __builtin_amdgcn_exp2f(a[3] * g.escale - mxr);
                        acc[ai][bj][m][n] = a; s += (a[0] + a[1]) + (a[2] + a[3]); }
                s += __shfl_xor(s, 16); s += __shfl_xor(s, 32);
                if (fq == 0) X1[(ai * 64 + m * 16 + fr) * 4 + wc] = s;
            }
        asm volatile("s_waitcnt lgkmcnt(0)" ::: "memory"); __builtin_amdgcn_s_barrier(); asm volatile("" ::: "memory");
        bf16_t* Cb = (bf16_t*)g.C;
        const int col0 = u.pn * BM + wc * 32 + 4 * fq;
#pragma unroll
        for (int ai = 0; ai < 2; ++ai)
#pragma unroll
            for (int m = 0; m < 4; ++m) {
                const f32x4 p4 = *(const LAS f32x4*)(X1 + (ai * 64 + m * 16 + fr) * 4);
                const float inv = 1.0f / ((p4[0] + p4[1]) + (p4[2] + p4[3]));
                bf16_t* rowp = Cb + (size_t)(row0 + ai * HALF + m * 16) * g.ldc + col0;
#pragma unroll
                for (int bj = 0; bj < 2; ++bj)
#pragma unroll
                    for (int n = 0; n < 2; ++n) {
                        const f32x4 a = acc[ai][bj][m][n];
                        uint2 o; o.x = pk2(a[0] * inv, a[1] * inv); o.y = pk2(a[2] * inv, a[3] * inv);
                        *(uint2*)(rowp + bj * HALF + n * 16) = o;
                    }
            }
    } else {
        bf16_t* Cb = (bf16_t*)g.C; int ccol = u.pn * BM;
        if constexpr (MODE == 4) { Cb += (size_t)(u.pn >> 2) * P6S; ccol = (u.pn & 3) * 256; }
        const int col0 = ccol + wc * 32 + 4 * fq;
#pragma unroll
        for (int ai = 0; ai < 2; ++ai)
#pragma unroll
            for (int m = 0; m < 4; ++m) {
                bf16_t* rowp = Cb + (size_t)(row0 + ai * HALF + m * 16) * g.ldc + col0;
#pragma unroll
                for (int bj = 0; bj < 2; ++bj)
#pragma unroll
                    for (int n = 0; n < 2; ++n) {
                        const f32x4 v = acc[ai][bj][m][n];
                        uint2 o; o.x = pk2(v[0], v[1]); o.y = pk2(v[2], v[3]);
                        *(uint2*)(rowp + bj * HALF + n * 16) = o;
                    }
            }
    }
}
template <int MODE> __device__ __forceinline__ void gemm_phase(LAS unsigned char* lds, const GJob& g, int tid) {
    const int wid = __builtin_amdgcn_readfirstlane(tid >> 6), lane = tid & 63, wr = wid >> 2, wc = wid & 3, fr = lane & 15, fq = lane >> 4;
    const int K = g.K, nt = K / BK;
    unsigned voffA[2], voffB[2];
#pragma unroll
    for (int i = 0; i < 2; ++i) { int R, C; stage_rc(tid * 16 + i * 8192, R, C);
        voffA[i] = (unsigned)(R * g.lda + C) * 2u; voffB[i] = (unsigned)(R * g.ldb + C) * 2u; }
    const size_t kstep = (size_t)(BK * 2);
    const size_t hstepA = (size_t)HALF * g.lda * 2, hstepB = (size_t)HALF * g.ldb * 2;
    const unsigned ldsw = (unsigned)wid * 1024u;
    const int aoff = lds_byte(wr * 64 + fr, fq * 8), boff = lds_byte(wc * 32 + fr, fq * 8);
#define PG8_SA(b, h) (((b) * 2 + (h)) * HTB)
#define PG8_SB(b, h) ((4 + (b) * 2 + (h)) * HTB)
#define PG8_STAGE(bufoff, gbase, voff) do { _Pragma("unroll") for (int _i = 0; _i < 2; ++_i) \
        __builtin_amdgcn_global_load_lds((const unsigned*)((const char*)(gbase) + (voff)[_i]), (LAS unsigned*)(lds + (bufoff) + ldsw + _i * 8192), 16, 0, 0); } while (0)
#define PG8_LDA(dst, b, h) do { _Pragma("unroll") for (int m = 0; m < 4; ++m) _Pragma("unroll") for (int k = 0; k < 2; ++k) dst[m][k] = *(const LAS bf16x8*)(lds + PG8_SA(b, h) + aoff + m * 2048 + k * 1024); } while (0)
#define PG8_LDB(dst, b, h) do { _Pragma("unroll") for (int n = 0; n < 2; ++n) _Pragma("unroll") for (int k = 0; k < 2; ++k) dst[n][k] = *(const LAS bf16x8*)(lds + PG8_SB(b, h) + boff + n * 2048 + k * 1024); } while (0)
#define PG8_MMA(ai, bj, At, Bt) do { __builtin_amdgcn_s_setprio(1); _Pragma("unroll") for (int m = 0; m < 4; ++m) _Pragma("unroll") for (int n = 0; n < 2; ++n) _Pragma("unroll") for (int k = 0; k < 2; ++k) \
        acc[ai][bj][m][n] = __builtin_amdgcn_mfma_f32_16x16x32_bf16(Bt[n][k], At[m][k], acc[ai][bj][m][n], 0, 0, 0); __builtin_amdgcn_s_setprio(0); } while (0)
#define PG8_WAIT_V(n) asm volatile("s_waitcnt vmcnt(" #n ")" ::: "memory")
#define PG8_WAIT_L(n) asm volatile("s_waitcnt lgkmcnt(" #n ")" ::: "memory")
#define PG8_BAR __builtin_amdgcn_s_barrier()
#define PG8_SCHED __builtin_amdgcn_sched_barrier(0)
#define PG8_ABASE(u) ((const char*)g.A + ((size_t)(u).pm * g.a_pm_step + (size_t)(((u).pn >> g.a_pn_shift) & g.a_pn_mask) * g.a_pn_step) * 2)
#define PG8_BBASE(u) ((const char*)g.Bt + ((size_t)(u).pn * g.b_pn_step + (size_t)((u).pm >> g.b_pm_shift) * g.b_pm_step) * 2)
    Unit cur, nxt; int ui = 0;
    if (!unit_next(g, 0, cur)) return;
    f32x4 acc[2][2][4][2];
#pragma unroll
    for (int a = 0; a < 2; ++a)
#pragma unroll
        for (int b = 0; b < 2; ++b)
#pragma unroll
            for (int m = 0; m < 4; ++m)
#pragma unroll
                for (int n = 0; n < 2; ++n) acc[a][b][m][n] = (f32x4){0.f, 0.f, 0.f, 0.f};
    bf16x8 At[4][2], B0[2][2], B1[2][2];
    const char* cA = PG8_ABASE(cur); const char* cB = PG8_BBASE(cur);
    PG8_STAGE(PG8_SB(0, 0), cB, voffB); PG8_STAGE(PG8_SA(0, 0), cA, voffA); PG8_STAGE(PG8_SB(0, 1), cB + hstepB, voffB); PG8_STAGE(PG8_SA(0, 1), cA + hstepA, voffA);
    if (wr == 1) PG8_BAR;
    PG8_WAIT_V(4); PG8_BAR;
    PG8_STAGE(PG8_SB(1, 0), cB + kstep, voffB); PG8_STAGE(PG8_SA(1, 0), cA + kstep, voffA); PG8_STAGE(PG8_SB(1, 1), cB + hstepB + kstep, voffB);
    PG8_WAIT_V(6); PG8_BAR;
    for (;;) {
        const bool has_next = unit_next(g, ui + 1, nxt);
        const char* nA = has_next ? PG8_ABASE(nxt) : cA; const char* nB = has_next ? PG8_BBASE(nxt) : cB;
        for (int t = 0; t < nt; t += 2) {
            const bool last = (t == nt - 2);
            const char* a1 = cA + (size_t)(t + 1) * kstep;
            const char* a2 = last ? nA : cA + (size_t)(t + 2) * kstep; const char* b2 = last ? nB : cB + (size_t)(t + 2) * kstep;
            const char* a3 = a2 + kstep; const char* b3 = b2 + kstep;
            PG8_LDB(B0, 0, 0); PG8_SCHED; PG8_LDA(At, 0, 0); PG8_STAGE(PG8_SA(1, 1), a1 + hstepA, voffA);
            PG8_WAIT_L(8); PG8_BAR; PG8_WAIT_L(0); PG8_MMA(0, 0, At, B0); PG8_BAR; PG8_SCHED;
            PG8_LDB(B1, 0, 1); PG8_STAGE(PG8_SB(0, 0), b2, voffB);
            PG8_BAR; PG8_WAIT_L(0); PG8_MMA(0, 1, At, B1); PG8_BAR;
            PG8_LDA(At, 0, 1); PG8_STAGE(PG8_SA(0, 0), a2, voffA);
            PG8_BAR; PG8_WAIT_L(0); PG8_MMA(1, 0, At, B0); PG8_BAR; PG8_SCHED;
            PG8_STAGE(PG8_SB(0, 1), b2 + hstepB, voffB);
            PG8_WAIT_V(6); PG8_BAR; PG8_MMA(1, 1, At, B1); PG8_BAR;
            PG8_LDB(B0, 1, 0); PG8_SCHED; PG8_LDA(At, 1, 0); PG8_STAGE(PG8_SA(0, 1), a2 + hstepA, voffA);
            PG8_WAIT_L(8); PG8_BAR; PG8_WAIT_L(0); PG8_MMA(0, 0, At, B0); PG8_BAR; PG8_SCHED;
            PG8_LDB(B1, 1, 1); PG8_STAGE(PG8_SB(1, 0), b3, voffB);
            PG8_BAR; PG8_WAIT_L(0); PG8_MMA(0, 1, At, B1); PG8_BAR;
            PG8_LDA(At, 1, 1); PG8_STAGE(PG8_SA(1, 0), a3, voffA);
            PG8_BAR; PG8_WAIT_L(0); PG8_MMA(1, 0, At, B0); PG8_BAR; PG8_SCHED;
            PG8_STAGE(PG8_SB(1, 1), b3 + hstepB, voffB);
            PG8_WAIT_V(6); PG8_BAR; PG8_MMA(1, 1, At, B1); PG8_BAR;
        }
        epilogue<MODE>(g, acc, cur, wr, wc, fr, fq, lds + GEMM_LDS + 1024);
        if (!has_next) break;
#pragma unroll
        for (int a = 0; a < 2; ++a)
#pragma unroll
            for (int b = 0; b < 2; ++b)
#pragma unroll
                for (int m = 0; m < 4; ++m)
#pragma unroll
                    for (int n = 0; n < 2; ++n) acc[a][b][m][n] = (f32x4){0.f, 0.f, 0.f, 0.f};
        cur = nxt; cA = nA; cB = nB; ++ui;
    }
    PG8_WAIT_V(0);
    if (wr == 0) PG8_BAR;
    PG8_BAR;
#undef PG8_SA
#undef PG8_SB
#undef PG8_STAGE
#undef PG8_LDA
#undef PG8_LDB
#undef PG8_MMA
#undef PG8_WAIT_V
#undef PG8_WAIT_L
#undef PG8_BAR
#undef PG8_SCHED
#undef PG8_ABASE
#undef PG8_BBASE
}
}

__device__ __forceinline__ void p0_transpose_item(const float* W, int ldw, int K, int csrc0, bf16_t* WT, int row0, LAS float* scr, int kb, int lane, float wscale) {
    const int k0 = 64 * kb;
#pragma unroll 8
    for (int i = 0; i < 32; ++i) { const int kk = 2 * i + (lane >> 5); scr[kk * 33 + (lane & 31)] = W[(size_t)(k0 + kk) * ldw + csrc0 + (lane & 31)] * wscale; }
    asm volatile("s_waitcnt lgkmcnt(0)" ::: "memory");
    const int c = lane & 7;
#pragma unroll
    for (int j = 0; j < 4; ++j) { const int n = (lane >> 3) + 8 * j; const LAS float* s = scr + (8 * c) * 33 + n;
        uint4 o; o.x = pk2(s[0 * 33], s[1 * 33]); o.y = pk2(s[2 * 33], s[3 * 33]); o.z = pk2(s[4 * 33], s[5 * 33]); o.w = pk2(s[6 * 33], s[7 * 33]);
        *(uint4*)(WT + (size_t)(row0 + n) * K + k0 + 8 * c) = o; }
    asm volatile("s_waitcnt lgkmcnt(0)" ::: "memory");
}

__device__ __forceinline__ void d_conv_silu(int vb, int tid, const bf16_t* __restrict__ p6, const float* __restrict__ cw, const float* __restrict__ cb, bf16_t* __restrict__ c) {
    const int t = vb, s = t % S;
    for (int ch = tid; ch < 1024; ch += 256) {
        float y = cb[ch];
#pragma unroll
        for (int j = 0; j < 4; ++j) {
            const int ss = s - 3 + j;
            if (ss >= 0) y = fmaf(cw[j * 1024 + ch], bf2f(p6[(size_t)(t - 3 + j) * 1024 + ch]), y);
        }
        c[(size_t)t * 1024 + ch] = (bf16_t)f2bf(y / (1.0f + expf(-y)));
    }
}

__device__ __forceinline__ void d_mlstm(int vb, int tid, const bf16_t* __restrict__ mq, const bf16_t* __restrict__ mk, const bf16_t* __restrict__ p6,
                                        const float* __restrict__ gpre, const float* __restrict__ b_mi, const float* __restrict__ b_mf, float* __restrict__ hraw) {
    const int lane = tid & 63, w = tid >> 6;
    const int gid = vb * 4 + w;
    const int e = gid & 255, h = (gid >> 8) & 3, b = gid >> 10;
    const float bi = b_mi[h], bf = b_mf[h];
    float C0 = 0.f, C1 = 0.f, C2 = 0.f, C3 = 0.f, n0 = 0.f, n1 = 0.f, n2 = 0.f, n3 = 0.f, m = 0.f;
    const size_t tb = (size_t)b * S;
    const bf16_t* qp = mq + tb * 1024 + h * 256 + lane * 4;
    const bf16_t* kp = mk + tb * 1024 + h * 256 + lane * 4;
    const bf16_t* pp = p6 + P6S + tb * 1024 + h * 256 + e;
    ushort4 qn = *(const ushort4*)qp, kn = *(const ushort4*)kp;
    const float* gp = gpre + tb * 8;
    float vn = bf2f(pp[0]), in_ = gp[h], fn = gp[4 + h];
    for (int s = 0; s < S; ++s) {
        const float4 q = make_float4(bf2f(qn.x), bf2f(qn.y), bf2f(qn.z), bf2f(qn.w)), k = make_float4(bf2f(kn.x), bf2f(kn.y), bf2f(kn.z), bf2f(kn.w)); const float v = vn, ipre = in_ + bi, fpre = fn + bf;
        if (s + 1 < S) {
            qn = *(const ushort4*)(qp + (size_t)(s + 1) * 1024);
            kn = *(const ushort4*)(kp + (size_t)(s + 1) * 1024);
            vn = bf2f(pp[(size_t)(s + 1) * 1024]); in_ = gp[(size_t)(s + 1) * 8 + h]; fn = gp[(size_t)(s + 1) * 8 + 4 + h];
        }
        const float logf = log_sigmoid(fpre);
        const float mnew = fmaxf(logf + m, ipre);
        const float fd = expf(logf + m - mnew), ig = expf(ipre - mnew);
        m = mnew;
        const float sc = ig * 0.0625f;
        C0 = fd * C0 + sc * k.x * v; C1 = fd * C1 + sc * k.y * v; C2 = fd * C2 + sc * k.z * v; C3 = fd * C3 + sc * k.w * v;
        n0 = fd * n0 + sc * k.x; n1 = fd * n1 + sc * k.y; n2 = fd * n2 + sc * k.z; n3 = fd * n3 + sc * k.w;
        float num = q.x * C0 + q.y * C1 + q.z * C2 + q.w * C3;
        float den = q.x * n0 + q.y * n1 + q.z * n2 + q.w * n3;
        num = wave_sum(num); den = wave_sum(den);
        if (lane == 0) hraw[(tb + s) * 1024 + h * 256 + e] = num / fmaxf(fabsf(den), expf(-mnew));
    }
}

__device__ __forceinline__ void d_mhead_norm(int vb, int tid, const float* __restrict__ hraw, const bf16_t* __restrict__ p6, const float* __restrict__ g, bf16_t* __restrict__ mix) {
    const int t = vb, h = tid >> 6, lane = tid & 63;
    const float4 v = *(const float4*)(hraw + (size_t)t * 1024 + h * 256 + lane * 4);
    float s = v.x * v.x + v.y * v.y + v.z * v.z + v.w * v.w;
    s = wave_sum(s);
    const float r = rsqrtf(s * (1.0f / 256.0f) + EPS);
    const float4 gg = *(const float4*)(g + h * 256 + lane * 4);
    const ushort4 mo = *(const ushort4*)(p6 + 2 * P6S + (size_t)t * 1024 + h * 256 + lane * 4);
    float4 o;
    o.x = v.x * r * gg.x / (1.0f + expf(-bf2f(mo.x)));
    o.y = v.y * r * gg.y / (1.0f + expf(-bf2f(mo.y)));
    o.z = v.z * r * gg.z / (1.0f + expf(-bf2f(mo.z)));
    o.w = v.w * r * gg.w / (1.0f + expf(-bf2f(mo.w)));
    uint2 ob; ob.x = pk2(o.x, o.y); ob.y = pk2(o.z, o.w);
    *(uint2*)(mix + (size_t)t * D + h * 256 + lane * 4) = ob;
}

__device__ __forceinline__ void d_rope(int vb, int tid, bf16_t* __restrict__ p6) {
    const int t = vb, s = t % S;
    for (int idx = tid; idx < 2 * 8 * 64; idx += 256) {
        const int i = idx & 63, hd = (idx >> 6) & 7, qk = idx >> 9;
        const float inv = exp2f(-(float)i * 0.20762050593046014f);
        const float ang = (float)s * inv;
        float sn, cs; sincosf(ang, &sn, &cs);
        bf16_t* p = p6 + (size_t)(3 + qk) * P6S + (size_t)t * 1024 + hd * 128;
        const float x1 = bf2f(p[i]), x2 = bf2f(p[64 + i]);
        p[i] = (bf16_t)f2bf(x1 * cs - x2 * sn);
        p[64 + i] = (bf16_t)f2bf(x2 * cs + x1 * sn);
    }
}

__device__ __forceinline__ void d_dilated(int vb, int tid, float* sm, const bf16_t* __restrict__ p6, const float* __restrict__ g_ahead, bf16_t* __restrict__ mix) {
    float (*qs)[128] = (float (*)[128])sm;
    float (*ps)[576] = (float (*)[576])(sm + 512);
    const int lane = tid & 63, w = tid >> 6;
    const int gid = vb * 4 + w;
    const int s = gid % S, hd = (gid / S) & 7, b = gid / (S * 8);
    const size_t t = (size_t)b * S + s;
    const bf16_t* qrow = p6 + 3 * P6S + t * 1024 + hd * 128;
    __syncthreads();
    qs[w][lane] = bf2f(qrow[lane]); qs[w][lane + 64] = bf2f(qrow[lane + 64]);
    __syncthreads();
    const float scale = 0.08838834764831845f;
    float mloc = -INFINITY;
    for (int br = 0; br < 3; ++br) {
        const int dil = br == 0 ? 1 : (br == 1 ? 4 : 16);
        for (int jj = 0; jj < 192; jj += 64) {
            const int j = jj + lane;
            float sc = -INFINITY;
            if (j <= 128 && s - j * dil >= 0) {
                const bf16_t* krow = p6 + 4 * P6S + (t - (size_t)j * dil) * 1024 + hd * 128;
                float d = 0.f;
#pragma unroll 8
                for (int c = 0; c < 128; c += 4) {
                    const ushort4 kv = *(const ushort4*)(krow + c);
                    d = fmaf(qs[w][c], bf2f(kv.x), d); d = fmaf(qs[w][c + 1], bf2f(kv.y), d); d = fmaf(qs[w][c + 2], bf2f(kv.z), d); d = fmaf(qs[w][c + 3], bf2f(kv.w), d);
                }
                sc = d * scale;
            }
            ps[w][br * 192 + j] = sc;
            mloc = fmaxf(mloc, sc);
        }
    }
    const float mx = wave_max(mloc);
    __syncthreads();
    float lsum = 0.f;
    for (int i = lane; i < 3 * 192; i += 64) {
        const float sc = ps[w][i];
        const float pv = (sc == -INFINITY) ? 0.f : expf(sc - mx);
        ps[w][i] = pv; lsum += pv;
    }
    const float tot = wave_sum(lsum);
    __syncthreads();
    float o0 = 0.f, o1 = 0.f;
    for (int br = 0; br < 3; ++br) {
        const int dil = br == 0 ? 1 : (br == 1 ? 4 : 16);
        for (int j = 0; j <= 128; ++j) {
            if (s - j * dil < 0) break;
            const float pv = ps[w][br * 192 + j];
            const bf16_t* vrow = p6 + 5 * P6S + (t - (size_t)j * dil) * 1024 + hd * 128;
            o0 = fmaf(pv, bf2f(vrow[lane]), o0); o1 = fmaf(pv, bf2f(vrow[lane + 64]), o1);
        }
    }
    o0 /= tot; o1 /= tot;
    float ss = wave_sum(o0 * o0 + o1 * o1);
    const float r = rsqrtf(ss * (1.0f / 128.0f) + EPS);
    bf16_t* orow = mix + t * D + 1024 + hd * 128;
    orow[lane] = (bf16_t)f2bf(o0 * r * g_ahead[hd * 128 + lane]);
    orow[lane + 64] = (bf16_t)f2bf(o1 * r * g_ahead[hd * 128 + lane + 64]);
}

__device__ __forceinline__ void d_cross(int vb, int tid, float* sm, const bf16_t* __restrict__ q, const float* __restrict__ km, const float* __restrict__ vm, bf16_t* __restrict__ o) {
    float (*qs)[512] = (float (*)[512])sm;
    float (*ps)[256] = (float (*)[256])(sm + 2048);
    const int lane = tid & 63, w = tid >> 6;
    const int t = vb, hd = w, b = t / S;
    const bf16_t* qrow = q + (size_t)t * D + hd * 512;
    __syncthreads();
    for (int i = lane; i < 512; i += 64) qs[w][i] = bf2f(qrow[i]);
    __syncthreads();
    const float scale = 0.04419417382415922f;
    float sc[4]; float mloc = -INFINITY;
#pragma unroll
    for (int r = 0; r < 4; ++r) {
        const int mi = lane + 64 * r;
        const float* krow = km + ((size_t)b * 256 + mi) * D + hd * 512;
        float d = 0.f;
#pragma unroll 8
        for (int c = 0; c < 512; c += 4) {
            const float4 kv = *(const float4*)(krow + c);
            d = fmaf(qs[w][c], kv.x, d); d = fmaf(qs[w][c + 1], kv.y, d); d = fmaf(qs[w][c + 2], kv.z, d); d = fmaf(qs[w][c + 3], kv.w, d);
        }
        sc[r] = d * scale; mloc = fmaxf(mloc, sc[r]);
    }
    const float mx = wave_max(mloc);
    float lsum = 0.f;
#pragma unroll
    for (int r = 0; r < 4; ++r) { const float pv = expf(sc[r] - mx); ps[w][lane + 64 * r] = pv; lsum += pv; }
    const float tot = wave_sum(lsum);
    __syncthreads();
    float acc[8];
#pragma unroll
    for (int i = 0; i < 8; ++i) acc[i] = 0.f;
    for (int mi = 0; mi < 256; ++mi) {
        const float pv = ps[w][mi];
        const float* vrow = vm + ((size_t)b * 256 + mi) * D + hd * 512;
#pragma unroll
        for (int i = 0; i < 8; ++i) acc[i] = fmaf(pv, vrow[lane + 64 * i], acc[i]);
    }
    bf16_t* orow = o + (size_t)t * D + hd * 512;
#pragma unroll
    for (int i = 0; i < 8; ++i) orow[lane + 64 * i] = (bf16_t)f2bf(acc[i] / tot);
}

__device__ __forceinline__ void wave_argmax(float& best, int& bidx) {
#pragma unroll
    for (int o = 32; o >= 1; o >>= 1) {
        const float ob = __shfl_xor(best, o); const int oi = __shfl_xor(bidx, o);
        if (ob > best || (ob == best && oi < bidx)) { best = ob; bidx = oi; }
    }
}
__device__ __forceinline__ void d_peer_topk(int vb, int tid, float* sm, const bf16_t* __restrict__ qp, const float* __restrict__ sub_keys, int* __restrict__ ids, float* __restrict__ gates) {
    float (*qs)[256] = (float (*)[256])sm;
    const int lane = tid & 63, w = tid >> 6;
    const int gid = vb * 4 + w;
    const int hd = gid & 7, t = gid >> 3;
    const bf16_t* qrow = qp + (size_t)t * D + hd * 256;
    __syncthreads();
    for (int i = lane; i < 256; i += 64) qs[w][i] = bf2f(qrow[i]);
    __syncthreads();
    float tops[2]; int topi[2];
#pragma unroll
    for (int p = 0; p < 2; ++p) {
        float v0, v1;
        {
            const float* k0 = sub_keys + ((size_t)(hd * 2 + p) * 128 + lane) * 128;
            const float* k1 = k0 + 64 * 128;
            float d0 = 0.f, d1 = 0.f;
#pragma unroll 8
            for (int c = 0; c < 128; c += 4) {
                const float4 a = *(const float4*)(k0 + c), bb = *(const float4*)(k1 + c);
                const float q0 = qs[w][p * 128 + c], q1 = qs[w][p * 128 + c + 1], q2 = qs[w][p * 128 + c + 2], q3 = qs[w][p * 128 + c + 3];
                d0 = fmaf(q0, a.x, d0); d0 = fmaf(q1, a.y, d0); d0 = fmaf(q2, a.z, d0); d0 = fmaf(q3, a.w, d0);
                d1 = fmaf(q0, bb.x, d1); d1 = fmaf(q1, bb.y, d1); d1 = fmaf(q2, bb.z, d1); d1 = fmaf(q3, bb.w, d1);
            }
            v0 = d0; v1 = d1;
        }
        float ts = 0.f; int ti = 0;
        for (int it = 0; it < 16; ++it) {
            float best; int bidx;
            if (v0 >= v1) { best = v0; bidx = lane; } else { best = v1; bidx = lane + 64; }
            wave_argmax(best, bidx);
            if (lane == it) { ts = best; ti = bidx; }
            if (bidx == lane) v0 = -INFINITY;
            if (bidx == lane + 64) v1 = -INFINITY;
        }
        tops[p] = ts; topi[p] = ti;
    }
    float cv[4]; int ci[4];
#pragma unroll
    for (int r = 0; r < 4; ++r) {
        const int c = lane * 4 + r, i = c >> 4, j = c & 15;
        const float s0 = __shfl(tops[0], i), s1 = __shfl(tops[1], j);
        const int i0 = __shfl(topi[0], i), i1 = __shfl(topi[1], j);
        cv[r] = s0 + s1; ci[r] = i0 * 128 + i1;
    }
    float bs = 0.f; int bid = 0;
    for (int it = 0; it < 16; ++it) {
        float best = cv[0]; int bidx = lane * 4;
#pragma unroll
        for (int r = 1; r < 4; ++r) if (cv[r] > best) { best = cv[r]; bidx = lane * 4 + r; }
        wave_argmax(best, bidx);
        const int owner = bidx >> 2, rr = bidx & 3;
        int myid = ci[0];
        if (rr == 1) myid = ci[1]; else if (rr == 2) myid = ci[2]; else if (rr == 3) myid = ci[3];
        const int eid = __shfl(myid, owner);
        if (lane == it) { bs = best; bid = eid; }
        if (owner == lane) {
#pragma unroll
            for (int r = 0; r < 4; ++r) if (rr == r) cv[r] = -INFINITY;
        }
    }
    float v = lane < 16 ? bs : -INFINITY;
    const float mx = wave_max(v);
    const float ev = lane < 16 ? expf(bs - mx) : 0.f;
    const float tot = wave_sum(ev);
    if (lane < 16) {
        ids[(size_t)t * 128 + hd * 16 + lane] = bid;
        gates[(size_t)t * 128 + hd * 16 + lane] = ev / tot;
    }
}

__device__ __forceinline__ void d_peer_out(int vb, int tid, float* sm, const bf16_t* __restrict__ h3, const float* __restrict__ x2, const int* __restrict__ ids, const float* __restrict__ gates,
                                           const bf16_t* __restrict__ u_tab, const bf16_t* __restrict__ v_tab, const float* __restrict__ g_final, float* __restrict__ out) {
    float (*part)[2048] = (float (*)[2048])sm;
    float* red = sm + 4 * 2048;
    const int lane = tid & 63, w = tid >> 6, t = vb;
    float4 xr[8], acc[8];
    const bf16_t* hrow = h3 + (size_t)t * D;
#pragma unroll
    for (int i = 0; i < 8; ++i) { const ushort4 hv = *(const ushort4*)(hrow + i * 256 + lane * 4);
        xr[i] = make_float4(bf2f(hv.x), bf2f(hv.y), bf2f(hv.z), bf2f(hv.w)); acc[i] = make_float4(0.f, 0.f, 0.f, 0.f); }
    for (int j = 0; j < 32; ++j) {
        const int slot = w * 32 + j;
        const int e = ids[(size_t)t * 128 + slot];
        const float gt = gates[(size_t)t * 128 + slot];
        const bf16_t* ur = u_tab + (size_t)e * D;
        const bf16_t* vr = v_tab + (size_t)e * D;
        float d = 0.f;
#pragma unroll
        for (int i = 0; i < 8; ++i) {
            const ushort4 u = *(const ushort4*)(ur + i * 256 + lane * 4);
            d = fmaf(xr[i].x, bf2f(u.x), d); d = fmaf(xr[i].y, bf2f(u.y), d); d = fmaf(xr[i].z, bf2f(u.z), d); d = fmaf(xr[i].w, bf2f(u.w), d);
        }
        d = wave_sum(d);
        const float act = 0.5f * d * (1.0f + erff(d * 0.7071067811865476f));
        const float cf = gt * act;
#pragma unroll
        for (int i = 0; i < 8; ++i) {
            const ushort4 v = *(const ushort4*)(vr + i * 256 + lane * 4);
            acc[i].x = fmaf(cf, bf2f(v.x), acc[i].x); acc[i].y = fmaf(cf, bf2f(v.y), acc[i].y); acc[i].z = fmaf(cf, bf2f(v.z), acc[i].z); acc[i].w = fmaf(cf, bf2f(v.w), acc[i].w);
        }
    }
    __syncthreads();
#pragma unroll
    for (int i = 0; i < 8; ++i) *(float4*)&part[w][i * 256 + lane * 4] = acc[i];
    __syncthreads();
    float4 r0, r1;
    {
        const float4 a = *(const float4*)&part[0][tid * 4], b = *(const float4*)&part[1][tid * 4], c = *(const float4*)&part[2][tid * 4], d = *(const float4*)&part[3][tid * 4];
        const float4 x = *(const float4*)(x2 + (size_t)t * D + tid * 4);
        r0 = make_float4(x.x + a.x + b.x + c.x + d.x, x.y + a.y + b.y + c.y + d.y, x.z + a.z + b.z + c.z + d.z, x.w + a.w + b.w + c.w + d.w);
    }
    {
        const float4 a = *(const float4*)&part[0][1024 + tid * 4], b = *(const float4*)&part[1][1024 + tid * 4], c = *(const float4*)&part[2][1024 + tid * 4], d = *(const float4*)&part[3][1024 + tid * 4];
        const float4 x = *(const float4*)(x2 + (size_t)t * D + 1024 + tid * 4);
        r1 = make_float4(x.x + a.x + b.x + c.x + d.x, x.y + a.y + b.y + c.y + d.y, x.z + a.z + b.z + c.z + d.z, x.w + a.w + b.w + c.w + d.w);
    }
    float s = r0.x * r0.x + r0.y * r0.y + r0.z * r0.z + r0.w * r0.w + r1.x * r1.x + r1.y * r1.y + r1.z * r1.z + r1.w * r1.w;
    s = wave_sum(s);
    if (lane == 0) red[w] = s;
    __syncthreads();
    const float tot = red[0] + red[1] + red[2] + red[3];
    const float r = rsqrtf(tot * (1.0f / D) + EPS);
    const float4 g0 = *(const float4*)(g_final + tid * 4), g1 = *(const float4*)(g_final + 1024 + tid * 4);
    *(float4*)(out + (size_t)t * D + tid * 4) = make_float4(r0.x * r * g0.x, r0.y * r * g0.y, r0.z * r * g0.z, r0.w * r * g0.w);
    *(float4*)(out + (size_t)t * D + 1024 + tid * 4) = make_float4(r1.x * r * g1.x, r1.y * r * g1.y, r1.z * r * g1.z, r1.w * r * g1.w);
}


__device__ __forceinline__ float wave_incl_scan_add(float v, int lane) {
#pragma unroll
    for (int o = 1; o < 64; o <<= 1) { const float t = __shfl_up(v, o); if (lane >= o) v += t; }
    return v;
}
__device__ __forceinline__ float wave_incl_scan_max(float v, int lane) {
#pragma unroll
    for (int o = 1; o < 64; o <<= 1) { const float t = __shfl_up(v, o); if (lane >= o) v = fmaxf(v, t); }
    return v;
}
__device__ __forceinline__ void mlstm_gates_wave(int b, int h, int lane, const float* __restrict__ gpre, const float* __restrict__ b_mi, const float* __restrict__ b_mf,
                                                 float* __restrict__ gs, float* __restrict__ decay) {
    const float bi = b_mi[h], bf = b_mf[h];
    float mprev = 0.f;
    for (int c = 0; c < 16; ++c) {
        const size_t t0 = (size_t)b * S + c * 256 + lane * 4;
        float logi[4], lf[4], bb[4];
#pragma unroll
        for (int j = 0; j < 4; ++j) { logi[j] = gpre[(t0 + j) * 8 + h] + bi; lf[j] = log_sigmoid(gpre[(t0 + j) * 8 + 4 + h] + bf); }
        bb[0] = lf[0]; bb[1] = bb[0] + lf[1]; bb[2] = bb[1] + lf[2]; bb[3] = bb[2] + lf[3];
        const float incl = wave_incl_scan_add(bb[3], lane);
        const float excl = incl - bb[3];
#pragma unroll
        for (int j = 0; j < 4; ++j) bb[j] += excl;
        const float g = __shfl(incl, 63);
        float amax = -INFINITY, uu[4], cm[4];
#pragma unroll
        for (int j = 0; j < 4; ++j) { amax = fmaxf(amax, logi[j] + g - bb[j]); uu[j] = logi[j] - bb[j]; }
        amax = wave_max(amax);
        const float mnew = fmaxf(g + mprev, amax);
        cm[0] = uu[0]; cm[1] = fmaxf(cm[0], uu[1]); cm[2] = fmaxf(cm[1], uu[2]); cm[3] = fmaxf(cm[2], uu[3]);
        const float cincl = wave_incl_scan_max(cm[3], lane);
        float cexcl = __shfl_up(cincl, 1); if (lane == 0) cexcl = -INFINITY;
#pragma unroll
        for (int j = 0; j < 4; ++j) {
            const float M = fmaxf(mprev, fmaxf(cexcl, cm[j]));
            float* o = gs + ((t0 + j) * 4 + h) * 8;
            o[0] = uu[j] * 1.4426950408889634f; o[1] = M * 1.4426950408889634f; o[2] = expf(logi[j] + g - bb[j] - mnew); o[3] = expf(mprev - M); o[4] = expf(-(bb[j] + M));
        }
        if (lane == 0) decay[(b * 16 + c) * 4 + h] = expf(g + mprev - mnew);
        mprev = mnew;
    }
}
__device__ __forceinline__ void transpose_tile64(int tid, float* sm, const bf16_t* __restrict__ src, int src_ld, bf16_t* __restrict__ dst, int dst_ld, const float* __restrict__ scale, int sstride) {
    unsigned short (*tl)[66] = (unsigned short (*)[66])sm;
    __syncthreads();
#pragma unroll
    for (int i = 0; i < 2; ++i) {
        const int ch = tid + i * 256, r = ch >> 3, c8 = (ch & 7) * 8;
        const uint4 v = *(const uint4*)(src + (size_t)r * src_ld + c8);
        const float sc = scale ? scale[(size_t)r * sstride] : 1.0f;
        const unsigned w[4] = {v.x, v.y, v.z, v.w};
#pragma unroll
        for (int k = 0; k < 4; ++k) {
            tl[r][c8 + 2 * k] = (unsigned short)f2bf(bf2f((unsigned short)(w[k] & 0xFFFFu)) * sc);
            tl[r][c8 + 2 * k + 1] = (unsigned short)f2bf(bf2f((unsigned short)(w[k] >> 16)) * sc);
        }
    }
    __syncthreads();
#pragma unroll
    for (int i = 0; i < 2; ++i) {
        const int ch = tid + i * 256, c = ch >> 3, r8 = (ch & 7) * 8;
        uint4 o;
        o.x = (unsigned)tl[r8 + 0][c] | ((unsigned)tl[r8 + 1][c] << 16); o.y = (unsigned)tl[r8 + 2][c] | ((unsigned)tl[r8 + 3][c] << 16);
        o.z = (unsigned)tl[r8 + 4][c] | ((unsigned)tl[r8 + 5][c] << 16); o.w = (unsigned)tl[r8 + 6][c] | ((unsigned)tl[r8 + 7][c] << 16);
        *(uint4*)(dst + (size_t)c * dst_ld + r8) = o;
    }
}

typedef short bf16x8_t __attribute__((ext_vector_type(8)));
typedef short bf16x4_t __attribute__((ext_vector_type(4)));
typedef float f32x4_t __attribute__((ext_vector_type(4)));
__device__ __forceinline__ void dilated_wave_tile(int qt, int lane, const bf16_t* __restrict__ AQ, const bf16_t* __restrict__ AK, const bf16_t* __restrict__ VT,
                                                  const float* __restrict__ g_ahead, bf16_t* __restrict__ mix) {
    const int r = qt & 15, blk = (qt >> 4) & 15, hd = (qt >> 8) & 7, b = qt >> 11;
    const int j = lane & 15, g = lane >> 4;
    const int t0 = blk * 256;
    const int sq = t0 + r + 16 * j;
    bf16x8_t qf[4];
    {
        const bf16_t* qrow = AQ + ((size_t)b * S + sq) * 1024 + hd * 128 + 8 * g;
#pragma unroll
        for (int ks = 0; ks < 4; ++ks) qf[ks] = *(const bf16x8_t*)(qrow + 32 * ks);
    }
    const float sc = 0.08838834764831845f * 1.4426950408889634f;
    float m_run = -1e30f, l_run = 0.f;
    f32x4_t o[8];
#pragma unroll
    for (int dt = 0; dt < 8; ++dt) o[dt] = (f32x4_t){0.f, 0.f, 0.f, 0.f};
#pragma nounroll
    for (int br = 0; br < 3; ++br) {
        const int ld = 2 * br, d = 1 << ld;
        const int rho = r & (d - 1);
        const int qj = (sq - rho) >> ld;
        const int q_lo = ((t0 + r - rho) >> ld) - 128, q_hi = (t0 + r + 240 - rho) >> ld;
        const int tile_lo = q_lo < 0 ? 0 : (q_lo >> 4), tile_hi = q_hi >> 4, tile_max = (256 >> ld) - 1;
        const bf16_t* vtb = VT + (size_t)br * ((size_t)1024 * 8192) + (size_t)(hd * 128 + j) * 8192 + (size_t)b * 4096 + (size_t)rho * (4096 >> ld) + 4 * g;
#pragma nounroll
        for (int tp = tile_lo; tp <= tile_hi; tp += 2) {
            f32x4_t su[2];
#pragma unroll
            for (int u = 0; u < 2; ++u) {
                int tl = tp + u; if (tl > tile_max) tl = tile_max;
                const int pos = rho + ((16 * tl + j) << ld);
                const bf16_t* krow = AK + ((size_t)b * S + pos) * 1024 + hd * 128 + 8 * g;
                f32x4_t a = (f32x4_t){0.f, 0.f, 0.f, 0.f};
#pragma unroll
                for (int ks = 0; ks < 4; ++ks) a = __builtin_amdgcn_mfma_f32_16x16x32_bf16(*(const bf16x8_t*)(krow + 32 * ks), qf[ks], a, 0, 0, 0);
                su[u] = a;
            }
            float p[2][4]; float mx = -1e30f;
#pragma unroll
            for (int u = 0; u < 2; ++u)
#pragma unroll
                for (int e = 0; e < 4; ++e) {
                    const int n = qj - (16 * (tp + u) + 4 * g + e);
                    const bool valid = (n >= 0) && (n <= 128);
                    p[u][e] = valid ? su[u][e] * sc : -1e30f;
                    mx = fmaxf(mx, p[u][e]);
                }
            mx = fmaxf(mx, __shfl_xor(mx, 16)); mx = fmaxf(mx, __shfl_xor(mx, 32));
            const float m_new = fmaxf(m_run, mx);
            const float alpha = __builtin_amdgcn_exp2f(m_run - m_new);
            m_run = m_new;
            float ps = 0.f;
#pragma unroll
            for (int u = 0; u < 2; ++u)
#pragma unroll
                for (int e = 0; e < 4; ++e) { p[u][e] = (p[u][e] > -1e29f) ? __builtin_amdgcn_exp2f(p[u][e] - m_new) : 0.f; ps += p[u][e]; }
            l_run = l_run * alpha + ps;
            bf16x8_t pb;
            {
                const unsigned w0 = pk2(p[0][0], p[0][1]), w1 = pk2(p[0][2], p[0][3]), w2 = pk2(p[1][0], p[1][1]), w3 = pk2(p[1][2], p[1][3]);
                pb[0] = (short)(w0 & 0xFFFF); pb[1] = (short)(w0 >> 16); pb[2] = (short)(w1 & 0xFFFF); pb[3] = (short)(w1 >> 16);
                pb[4] = (short)(w2 & 0xFFFF); pb[5] = (short)(w2 >> 16); pb[6] = (short)(w3 & 0xFFFF); pb[7] = (short)(w3 >> 16);
            }
            int tl0 = tp, tl1 = tp + 1; if (tl0 > tile_max) tl0 = tile_max; if (tl1 > tile_max) tl1 = tile_max;
#pragma unroll
            for (int dt = 0; dt < 8; ++dt) {
                const bf16_t* vrow = vtb + (size_t)dt * (16 * 8192);
                const bf16x4_t v0 = *(const bf16x4_t*)(vrow + 16 * tl0), v1 = *(const bf16x4_t*)(vrow + 16 * tl1);
                bf16x8_t va; va[0] = v0[0]; va[1] = v0[1]; va[2] = v0[2]; va[3] = v0[3]; va[4] = v1[0]; va[5] = v1[1]; va[6] = v1[2]; va[7] = v1[3];
                f32x4_t oo = o[dt]; oo = oo * alpha;
                o[dt] = __builtin_amdgcn_mfma_f32_16x16x32_bf16(va, pb, oo, 0, 0, 0);
            }
        }
    }
    float lt = l_run; lt += __shfl_xor(lt, 16); lt += __shfl_xor(lt, 32);
    const float inv = 1.0f / lt;
    float ss = 0.f;
#pragma unroll
    for (int dt = 0; dt < 8; ++dt) { o[dt] = o[dt] * inv; ss += (o[dt][0] * o[dt][0] + o[dt][1] * o[dt][1]) + (o[dt][2] * o[dt][2] + o[dt][3] * o[dt][3]); }
    ss += __shfl_xor(ss, 16); ss += __shfl_xor(ss, 32);
    const float rn = rsqrtf(ss * (1.0f / 128.0f) + EPS);
    bf16_t* orow = mix + ((size_t)b * S + sq) * D + 1024 + hd * 128 + 4 * g;
#pragma unroll
    for (int dt = 0; dt < 8; ++dt) {
        const f32x4_t gv = *(const f32x4_t*)(g_ahead + hd * 128 + 16 * dt + 4 * g);
        uint2 w; w.x = pk2(o[dt][0] * rn * gv[0], o[dt][1] * rn * gv[1]); w.y = pk2(o[dt][2] * rn * gv[2], o[dt][3] * rn * gv[3]);
        *(uint2*)(orow + 16 * dt) = w;
    }
}

struct Params {
    const float *x, *mem, *g_mix, *w_in, *conv_w, *conv_b, *w_mq, *w_mk, *b_mi, *b_mf, *g_mhead, *g_ahead, *w_out, *g_cross, *g_mem,
                *w_xq, *w_xk, *w_xv, *w_xo, *g_ffn, *w_pq, *sub_keys, *u_tab, *v_tab, *g_final;
    float* out;
    unsigned* bar;
    float* ws;
};

#define PHASE_LOOP(nvb) for (int base_ = blockIdx.x * 2; base_ < (nvb); base_ += gridDim.x * 2)
#define VB (base_ + half)

__global__ void __launch_bounds__(NTHR) mega(Params P) {
    volatile LAS unsigned* st = (volatile LAS unsigned*)(LAS unsigned char*)(smem_raw + GEMM_LDS);
    if (threadIdx.x == 0) { st[0] = 0u; st[1] = 0u; st[2] = 0u; st[3] = 0u; }
    if (threadIdx.x < I_NPTR) ((LAS unsigned long long*)(LAS unsigned char*)(smem_raw + GEMM_LDS + 64))[threadIdx.x] = ((const unsigned long long*)&P)[threadIdx.x];
    __syncthreads();
    XcdBarrier xb = xcd_barrier_post((unsigned*)ldp_raw(I_BAR), st);

    constexpr size_t TD = (size_t)T * D;
    constexpr size_t O_HB = 6 * P6S * 2, O_CBUF = O_HB + (size_t)T * D * 2, O_MQ = O_CBUF + (size_t)T * 1024 * 2, O_MK = O_MQ + (size_t)T * 1024 * 2,
                     O_MIXB = O_MK + (size_t)T * 1024 * 2, O_WIN = O_MIXB + (size_t)T * D * 2, O_WOUT = O_WIN + (size_t)6144 * D * 2, O_WXQ = O_WOUT + (size_t)D * D * 2,
                     O_WXK = O_WXQ + (size_t)D * D * 2, O_WXV = O_WXK + (size_t)D * D * 2, O_WXO = O_WXV + (size_t)D * D * 2, O_WPQ = O_WXO + (size_t)D * D * 2,
                     O_WQK = O_WPQ + (size_t)D * D * 2, O_GPRE = O_WQK + (size_t)8 * 256 * 256 * 2, O_UT = O_GPRE + (size_t)T * 8 * 4, O_VT = O_UT + (size_t)16384 * D * 2,
                     O_BH = O_VT + (size_t)16384 * D * 2, O_GS = O_BH + (size_t)128 * 256 * 512 * 2, O_DENP = O_GS + (size_t)T * 4 * 8 * 4, O_QN = O_DENP + (size_t)T * 4 * 4 * 4,
                     O_DN = O_QN + (size_t)T * 4 * 4, O_DECAY = O_DN + (size_t)128 * 256 * 4, O_VT3 = O_DECAY + 4096, O_END = O_VT3 + (size_t)3 * 1024 * 8192 * 2;
    static_assert(O_END + 16384 <= (size_t)536870912, "workspace overflow");
#define W_P6    ((bf16_t*)wsb)
#define W_HB    ((bf16_t*)(wsb + O_HB))
#define W_CBUF  ((bf16_t*)(wsb + O_CBUF))
#define W_MQ    ((bf16_t*)(wsb + O_MQ))
#define W_MK    ((bf16_t*)(wsb + O_MK))
#define W_MIXB  ((bf16_t*)(wsb + O_MIXB))
#define W_GPRE  ((float*)(wsb + O_GPRE))
#define W_HRAW  ((float*)(wsb + O_HB))
#define W_XR    ((float*)wsb)
#define W_MN    ((bf16_t*)((float*)wsb + TD))
#define W_KM    ((bf16_t*)((float*)wsb + TD + (size_t)256 * D))
#define W_VMT   ((bf16_t*)((float*)wsb + TD + (size_t)768 * D))
#define W_PX    ((bf16_t*)(wsb + O_MK))
#define W_GATES ((float*)wsb + TD + (size_t)1280 * D)
#define W_IDS   ((int*)((float*)wsb + TD + (size_t)1280 * D + (size_t)T * 128))
#define W_QX    ((bf16_t*)(wsb + O_CBUF))
#define W_BH    ((bf16_t*)(wsb + O_BH))
#define W_VT3   ((bf16_t*)(wsb + O_VT3))
#define W_GS    ((float*)(wsb + O_GS))
#define W_DENP  ((float*)(wsb + O_DENP))
#define W_QN    ((float*)(wsb + O_QN))
#define W_DN    ((float*)(wsb + O_DN))
#define W_DECAY ((float*)(wsb + O_DECAY))
#define W_PQ    ((bf16_t*)(wsb + O_HB))
#define W_KWT   ((bf16_t*)(wsb + O_CBUF))
#define W_DC    ((float*)(wsb + 3 * P6S * 2))
#define W_UT    ((bf16_t*)(wsb + O_UT))
#define W_VT    ((bf16_t*)(wsb + O_VT))
#define PH_BEGIN() int tidx = threadIdx.x; asm volatile("" : "+v"(tidx)); const int half = tidx >> 8, tid = tidx & 255; float* sm = (float*)smem_raw + half * HALF_SM_FLOATS; \
                   char* wsb = (char*)ldp_raw(I_WS); (void)half; (void)tid; (void)sm; (void)wsb
#define GJOB_DEFAULT(g) pg8::GJob g; g.lda = D; g.ldb = D; g.K = D; g.nM = 32; g.nN = 8; g.a_pm_step = 256 * D; g.a_pn_shift = 0; g.a_pn_mask = 0; g.a_pn_step = 0; g.b_pm_shift = 0; g.b_pm_step = 0; g.b_pn_step = 256 * D; \
                        g.ldc = D; g.R = nullptr; g.ldr = D; g.mode = 0; g.escale = 1.0f; g.gs = nullptr; g.denp = nullptr; g.qn = nullptr; g.gvec = nullptr; g.mo = nullptr
#define GEMM_LDSP ((LAS unsigned char*)smem_raw)

    {
        PH_BEGIN();
        {
            LAS float* scr = (LAS float*)(LAS unsigned char*)(smem_raw) + (tidx >> 6) * (64 * 33);
            const int lane = tidx & 63;
            const int gw = blockIdx.x * 8 + (tidx >> 6), NGW = gridDim.x * 8;
            constexpr int I_IN = 32 * 192, I_SQ = 32 * 64, I_QK = 8 * 4 * 8;
            constexpr int NITEMS = I_IN + 6 * I_SQ + I_QK;
#pragma nounroll
            for (int it = gw; it < NITEMS; it += NGW) {
                const float* W; int ldw, K, csrc0, row0, kb; bf16_t* WT; float wscale = 1.0f;
                int r = it;
                if (r < I_IN) { const int nb = r % 192; kb = r / 192; W = PF(I_WIN); ldw = INC; K = D; csrc0 = nb * 32 + (nb >= 96 ? 8 : 0); WT = (bf16_t*)(wsb + O_WIN); row0 = nb * 32; }
                else if ((r -= I_IN) < 6 * I_SQ) {
                    const int wsel = r / I_SQ; r -= wsel * I_SQ; const int nb = r % 64; kb = r / 64; ldw = D; K = D; csrc0 = nb * 32; row0 = nb * 32;
                    W = PF(wsel == 0 ? I_WOUT : wsel == 1 ? I_WXQ : wsel == 2 ? I_WXK : wsel == 3 ? I_WXV : wsel == 4 ? I_WXO : I_WPQ);
                    WT = (bf16_t*)(wsb + O_WOUT + (size_t)wsel * ((size_t)D * D * 2));
                } else {
                    r -= 6 * I_SQ; const int hq = r / 32; r -= hq * 32; const int nb = r % 8; kb = r / 8;
                    W = PF(hq < 4 ? I_WMQ : I_WMK) + (size_t)(hq & 3) * 65536; ldw = 256; K = 256; csrc0 = nb * 32; WT = (bf16_t*)(wsb + O_WQK); row0 = hq * 256 + nb * 32;
                    if (hq >= 4) wscale = 0.0625f;
                }
                p0_transpose_item(W, ldw, K, csrc0, WT, row0, scr, kb, lane, wscale);
            }
            {
                const float* ut = PF(I_UTAB); const float* vt = PF(I_VTAB);
                const size_t n8 = (size_t)16384 * D / 8, nth = (size_t)gridDim.x * NTHR;
#pragma nounroll
                for (size_t i = (size_t)blockIdx.x * NTHR + tidx; i < 2 * n8; i += nth) {
                    const bool second = i >= n8; const size_t k = second ? i - n8 : i;
                    const float4* sp = (const float4*)((second ? vt : ut) + k * 8);
                    const float4 a = sp[0], b = sp[1];
                    uint4 o; o.x = pk2(a.x, a.y); o.y = pk2(a.z, a.w); o.z = pk2(b.x, b.y); o.w = pk2(b.z, b.w);
                    *(uint4*)((second ? W_VT : W_UT) + k * 8) = o;
                }
            }
            __syncthreads();
        }
        { const float* rin = PF(I_X); const float* rg = PF(I_GMIX); const float* win = PF(I_WIN);
#pragma nounroll
          PHASE_LOOP(T) d_rmsnorm(VB, tid, sm, rin, rg, W_HB, win, W_GPRE); }
    }
    xcd_barrier(xb);
    {
        PH_BEGIN();
        GJOB_DEFAULT(g); g.A = W_HB; g.Bt = (bf16_t*)(wsb + O_WIN); g.nN = 24; g.C = (float*)W_P6; g.ldc = 1024;
        pg8::gemm_phase<4>(GEMM_LDSP, g, tidx);
    }
    xcd_barrier(xb);
    {
        PH_BEGIN();
        const float* cw = PF(I_CONVW); const float* cb = PF(I_CONVB);
#pragma nounroll
        PHASE_LOOP(T) d_conv_silu(VB, tid, W_P6, cw, cb, W_CBUF);
#pragma nounroll
        PHASE_LOOP(T) d_rope(VB, tid, W_P6);
        if (blockIdx.x < 8 && tidx < 64) mlstm_gates_wave(blockIdx.x >> 2, blockIdx.x & 3, tidx, W_GPRE, PF(I_BMI), PF(I_BMF), W_GS, W_DECAY);
#pragma nounroll
        PHASE_LOOP(2048) { const int it = VB, lt = it & 3, et = (it >> 2) & 3, h = (it >> 4) & 3, cg = it >> 6;
            transpose_tile64(tid, sm, W_P6 + P6S + (size_t)(cg * 256 + lt * 64) * 1024 + h * 256 + et * 64, 1024, W_BH + ((size_t)(cg * 4 + h) * 256 + et * 64) * 512 + lt * 64, 512, nullptr, 0); }
#pragma nounroll
        PHASE_LOOP(6144) { const int br = VB >> 11, it = VB & 2047, ld = 2 * br, dimt = it & 15, rest = it >> 4, b = rest >> 6, x = rest & 63, rho = x >> (6 - ld), qt = x & ((64 >> ld) - 1);
            transpose_tile64(tid, sm, W_P6 + 5 * P6S + ((size_t)b * S + rho + ((size_t)(64 * qt) << ld)) * 1024 + dimt * 64, 1024 << ld,
                             W_VT3 + (size_t)br * ((size_t)1024 * 8192) + (size_t)(dimt * 64) * 8192 + (size_t)b * 4096 + (size_t)rho * (4096 >> ld) + qt * 64, 8192, nullptr, 0); }
    }
    xcd_barrier(xb);
    {
        PH_BEGIN();
        {
            GJOB_DEFAULT(g); g.A = W_CBUF; g.lda = 1024; g.a_pm_step = 256 * 1024; g.Bt = (bf16_t*)(wsb + O_WQK); g.ldb = 256; g.b_pn_step = 256 * 256; g.K = 256; g.a_pn_mask = 3; g.a_pn_step = 256; g.C = (float*)W_MQ; g.ldc = 1024;
            pg8::gemm_phase<4>(GEMM_LDSP, g, tidx);
            __syncthreads();
        }
        const float* ga = PF(I_GAHEAD);
#pragma nounroll
        for (int qt = blockIdx.x * 8 + (tidx >> 6); qt < 4096; qt += gridDim.x * 8) dilated_wave_tile(qt, tidx & 63, W_P6 + 3 * P6S, W_P6 + 4 * P6S, W_VT3, ga, W_MIXB);
    }
    xcd_barrier(xb);
    {
        PH_BEGIN();
#pragma nounroll
        PHASE_LOOP(2048) { const int it = VB, lt = it & 3, dt = (it >> 2) & 3, h = (it >> 4) & 3, cg = it >> 6;
            transpose_tile64(tid, sm, W_MK + (size_t)(cg * 256 + lt * 64) * 1024 + h * 256 + dt * 64, 1024, W_KWT + ((size_t)(cg * 4 + h) * 256 + dt * 64) * 256 + lt * 64, 256,
                             W_GS + ((size_t)(cg * 256 + lt * 64) * 4 + h) * 8 + 2, 32); }
        {
            const size_t nth = (size_t)gridDim.x * NTHR;
#pragma nounroll
            for (size_t i = (size_t)blockIdx.x * NTHR + tidx; i < (size_t)T * 128; i += nth) {
                const size_t t = i >> 7; const int c8 = (int)(i & 127) * 8, h = c8 >> 8, d = c8 & 255;
                const float sc = W_GS[(t * 4 + h) * 8 + 3];
                const uint4 v = *(const uint4*)(W_MQ + t * 1024 + c8);
                uint4 o;
                o.x = pk2(bf2f((unsigned short)(v.x & 0xFFFFu)) * sc, bf2f((unsigned short)(v.x >> 16)) * sc); o.y = pk2(bf2f((unsigned short)(v.y & 0xFFFFu)) * sc, bf2f((unsigned short)(v.y >> 16)) * sc);
                o.z = pk2(bf2f((unsigned short)(v.z & 0xFFFFu)) * sc, bf2f((unsigned short)(v.z >> 16)) * sc); o.w = pk2(bf2f((unsigned short)(v.w & 0xFFFFu)) * sc, bf2f((unsigned short)(v.w >> 16)) * sc);
                *(uint4*)(W_PQ + t * 2048 + h * 512 + 256 + d) = o;
            }
        }
#pragma nounroll
        PHASE_LOOP(128) { const int cgh = VB, cg = cgh >> 2, h = cgh & 3;
            float a = 0.f;
            for (int l = 0; l < 256; ++l) { const size_t t = (size_t)cg * 256 + l; a = fmaf(W_GS[(t * 4 + h) * 8 + 2], bf2f(W_MK[t * 1024 + h * 256 + tid]), a); }
            W_DN[(size_t)cgh * 256 + tid] = a; }
        __syncthreads();
        {
            GJOB_DEFAULT(g); g.A = W_MQ; g.lda = 1024; g.a_pm_step = 256 * 1024; g.a_pn_mask = 3; g.a_pn_step = 256; g.K = 256; g.nN = 4;
            g.Bt = W_MK; g.ldb = 1024; g.b_pn_step = 256; g.b_pm_step = 256 * 1024; g.C = (float*)W_PQ; g.gs = W_GS; g.denp = W_DENP;
            pg8::gemm_phase<6>(GEMM_LDSP, g, tidx);
        }
    }
    xcd_barrier(xb);
    {
        PH_BEGIN();
        GJOB_DEFAULT(g); g.A = W_BH; g.lda = 512; g.a_pm_step = 4 * 256 * 512; g.a_pn_mask = 3; g.a_pn_step = 256 * 512; g.K = 256; g.nN = 4;
        g.Bt = W_KWT; g.ldb = 256; g.b_pn_step = 65536; g.b_pm_step = 4 * 65536; g.C = W_DC;
        pg8::gemm_phase<7>(GEMM_LDSP, g, tidx);
    }
    xcd_barrier(xb);
    {
        PH_BEGIN();
        {
#pragma nounroll
            for (int gid = blockIdx.x * NTHR + tidx; gid < 131072; gid += gridDim.x * NTHR) {
                const int bh = gid >> 14, b = bh >> 2, h = bh & 3, e = (gid >> 6) & 255, d = (gid & 63) * 4;
                float4 C = make_float4(0.f, 0.f, 0.f, 0.f);
#pragma unroll 4
                for (int c = 0; c < 16; ++c) {
                    const int cgh = (b * 16 + c) * 4 + h;
                    uint2 o; o.x = pk2(C.x, C.y); o.y = pk2(C.z, C.w);
                    *(uint2*)(W_BH + ((size_t)cgh * 256 + e) * 512 + 256 + d) = o;
                    const float dec = W_DECAY[cgh];
                    const float4 dc = *(const float4*)(W_DC + ((size_t)cgh * 256 + e) * 256 + d);
                    C.x = fmaf(dec, C.x, dc.x); C.y = fmaf(dec, C.y, dc.y); C.z = fmaf(dec, C.z, dc.z); C.w = fmaf(dec, C.w, dc.w);
                }
            }
        }
#pragma nounroll
        PHASE_LOOP(128) { const int cgh = VB, cg = cgh >> 2, h = cgh & 3, b = cg >> 4, c = cg & 15;
            float n = 0.f;
            for (int cc = 0; cc < c; ++cc) { const int j = (b * 16 + cc) * 4 + h; n = fmaf(W_DECAY[j], n, W_DN[(size_t)j * 256 + tid]); }
            __syncthreads();
            sm[tid] = n;
            __syncthreads();
            const int lane = tid & 63, w = tid >> 6;
            const float4 nv = *(const float4*)(sm + lane * 4);
            for (int i = 0; i < 64; ++i) {
                const size_t t = (size_t)cg * 256 + w * 64 + i;
                const ushort4 q4 = *(const ushort4*)(W_MQ + t * 1024 + h * 256 + lane * 4);
                float s = bf2f(q4.x) * nv.x + bf2f(q4.y) * nv.y + bf2f(q4.z) * nv.z + bf2f(q4.w) * nv.w;
                s = wave_sum(s);
                if (lane == 0) W_QN[t * 4 + h] = s;
            }
        }
    }
    xcd_barrier(xb);
    {
        PH_BEGIN();
        GJOB_DEFAULT(g); g.A = W_PQ; g.a_pn_mask = 3; g.a_pn_step = 512; g.K = 512; g.nN = 4;
        g.Bt = W_BH; g.ldb = 512; g.b_pn_step = 256 * 512; g.b_pm_step = 4 * 256 * 512; g.C = (float*)W_MIXB;
        g.gs = W_GS; g.denp = W_DENP; g.qn = W_QN; g.gvec = PF(I_GMHEAD); g.mo = W_P6 + 2 * P6S;
        pg8::gemm_phase<8>(GEMM_LDSP, g, tidx);
    }
    xcd_barrier(xb);
    {
        PH_BEGIN();
        GJOB_DEFAULT(g); g.A = W_MIXB; g.Bt = (bf16_t*)(wsb + O_WOUT); g.C = W_XR; g.R = PF(I_X);
        pg8::gemm_phase<0>(GEMM_LDSP, g, tidx);
    }
    xcd_barrier(xb);
    {
        PH_BEGIN();
        { const float* rg = PF(I_GCROSS); const float* win = PF(I_WIN);
#pragma nounroll
          PHASE_LOOP(T) d_rmsnorm(VB, tid, sm, W_XR, rg, W_HB, win, nullptr); }
        { const float* rin = PF(I_MEM); const float* rg = PF(I_GMEM); const float* win = PF(I_WIN);
#pragma nounroll
          PHASE_LOOP(512) d_rmsnorm(VB, tid, sm, rin, rg, W_MN, win, nullptr); }
    }
    xcd_barrier(xb);
    {
        PH_BEGIN();
        { GJOB_DEFAULT(g); g.A = W_HB; g.Bt = (bf16_t*)(wsb + O_WXQ); g.C = (float*)W_QX; pg8::gemm_phase<3>(GEMM_LDSP, g, tidx); __syncthreads(); }
        { GJOB_DEFAULT(g); g.A = W_MN; g.Bt = (bf16_t*)(wsb + O_WXK); g.nM = 2; g.C = (float*)W_KM; pg8::gemm_phase<3>(GEMM_LDSP, g, tidx); __syncthreads(); }
        { GJOB_DEFAULT(g); g.A = (bf16_t*)(wsb + O_WXV); g.Bt = W_MN; g.nM = 8; g.nN = 2; g.C = (float*)W_VMT; g.ldc = 512; pg8::gemm_phase<3>(GEMM_LDSP, g, tidx); }
    }
    xcd_barrier(xb);
    {
        PH_BEGIN();
        GJOB_DEFAULT(g); g.A = W_QX; g.K = 512; g.a_pn_mask = 3; g.a_pn_step = 512; g.Bt = W_KM; g.b_pn_step = 512; g.b_pm_shift = 4; g.b_pm_step = 256 * D; g.nN = 4;
        g.C = (float*)W_PX; g.ldc = 1024; g.escale = 0.04419417382415922f * 1.4426950408889634f;
        pg8::gemm_phase<5>(GEMM_LDSP, g, tidx);
    }
    xcd_barrier(xb);
    {
        PH_BEGIN();
        GJOB_DEFAULT(g); g.A = W_PX; g.lda = 1024; g.a_pm_step = 256 * 1024; g.K = 256; g.a_pn_shift = 1; g.a_pn_mask = 3; g.a_pn_step = 256; g.Bt = W_VMT; g.ldb = 512; g.b_pn_step = 256 * 512; g.b_pm_shift = 4; g.b_pm_step = 256;
        g.C = (float*)W_MIXB;
        pg8::gemm_phase<3>(GEMM_LDSP, g, tidx);
    }
    xcd_barrier(xb);
    {
        PH_BEGIN();
        GJOB_DEFAULT(g); g.A = W_MIXB; g.Bt = (bf16_t*)(wsb + O_WXO); g.C = W_XR; g.R = W_XR;
        pg8::gemm_phase<0>(GEMM_LDSP, g, tidx);
    }
    xcd_barrier(xb);
    {
        PH_BEGIN();
        const float* rg = PF(I_GFFN); const float* win = PF(I_WIN);
#pragma nounroll
        PHASE_LOOP(T) d_rmsnorm(VB, tid, sm, W_XR, rg, W_HB, win, nullptr);
    }
    xcd_barrier(xb);
    {
        PH_BEGIN();
        GJOB_DEFAULT(g); g.A = W_HB; g.Bt = (bf16_t*)(wsb + O_WPQ); g.C = (float*)W_QX;
        pg8::gemm_phase<3>(GEMM_LDSP, g, tidx);
    }
    xcd_barrier(xb);
    {
        PH_BEGIN();
        const float* sk = PF(I_SUBK);
#pragma nounroll
        PHASE_LOOP(T * 8 / 4) d_peer_topk(VB, tid, sm, W_QX, sk, W_IDS, W_GATES);
    }
    xcd_barrier(xb);
    {
        PH_BEGIN();
        const float* gf = PF(I_GFINAL); float* outp = (float*)ldp_raw(I_OUT);
#pragma nounroll
        PHASE_LOOP(T) d_peer_out(VB, tid, sm, W_HB, W_XR, W_IDS, W_GATES, W_UT, W_VT, gf, outp);
    }
}
}

extern "C" void kernel_launch(void* const* d_in, const int* in_sizes, int n_in, void* d_out, int out_size, void* d_ws, size_t ws_size, hipStream_t stream) {
    static int grid_blocks = 0;
    if (!grid_blocks) {
        int dev = 0, cus = 0, per_cu = 0;
        hipGetDevice(&dev);
        hipDeviceGetAttribute(&cus, hipDeviceAttributeMultiprocessorCount, dev);
        hipFuncSetAttribute((const void*)mega, hipFuncAttributeMaxDynamicSharedMemorySize, SMEM_BYTES);
        hipOccupancyMaxActiveBlocksPerMultiprocessor(&per_cu, mega, NTHR, SMEM_BYTES);
        if (per_cu > 1) per_cu = 1;
        if (per_cu < 1) per_cu = 1;
        grid_blocks = cus * per_cu;
    }
    Params P{};
    const float** pp = (const float**)&P;
    for (int i = 0; i < 25; ++i) pp[i] = (const float*)d_in[i];
    P.out = (float*)d_out;
    P.bar = (unsigned*)d_ws;
    P.ws = (float*)((char*)d_ws + 16384);
    hipMemsetAsync(d_ws, 0, 16384, stream);
    void* args[] = {&P};
    hipError_t e = hipLaunchCooperativeKernel((const void*)mega, dim3(grid_blocks), dim3(NTHR), args, SMEM_BYTES, stream);
    if (e != hipSuccess) fprintf(stderr, "cooperative launch failed: %s (grid %d)\n", hipGetErrorString(e), grid_blocks);
}
```

```cpp
#include <hip/hip_runtime.h>
#include <stdint.h>
#include <math.h>
#include <cstdio>

#define LAS_ __attribute__((address_space(3)))
namespace {
constexpr int D = 2048, NB = 2, S = 4096, T = NB * S;
constexpr int INC = 6152;
constexpr int C_MIN = 0, C_MV = 1024, C_MO = 2048, C_MI = 3072, C_MF = 3076, C_AQ = 3080, C_AK = 4104, C_AV = 5128;
constexpr float EPS = 1e-6f;
constexpr size_t P6S = (size_t)8192 * 1024;
constexpr int NTHR = 512;
constexpr int HALF_SM_FLOATS = 8704;
constexpr int GEMM_LDS = 131072;
constexpr int SMEM_BYTES = GEMM_LDS + 1024 + 8192;
typedef unsigned short bf16_t;
__device__ __forceinline__ unsigned f2bf(float f) { unsigned u = __float_as_uint(f); u += 0x7FFFu + ((u >> 16) & 1u); return u >> 16; }
__device__ __forceinline__ unsigned pk2(float lo, float hi) { return f2bf(lo) | (f2bf(hi) << 16); }
__device__ __forceinline__ float bf2f(unsigned short b) { return __uint_as_float(((unsigned)b) << 16); }
extern __shared__ __attribute__((aligned(16))) unsigned char smem_raw[];
enum { I_X = 0, I_MEM, I_GMIX, I_WIN, I_CONVW, I_CONVB, I_WMQ, I_WMK, I_BMI, I_BMF, I_GMHEAD, I_GAHEAD, I_WOUT, I_GCROSS, I_GMEM,
       I_WXQ, I_WXK, I_WXV, I_WXO, I_GFFN, I_WPQ, I_SUBK, I_UTAB, I_VTAB, I_GFINAL, I_OUT, I_BAR, I_WS, I_NPTR };
__device__ __forceinline__ unsigned long long ldp_raw(int i) {
    const LAS_ unsigned long long* tab = (const LAS_ unsigned long long*)(LAS_ unsigned char*)(smem_raw + GEMM_LDS + 64);
    const unsigned long long v = tab[i];
    const unsigned lo = __builtin_amdgcn_readfirstlane((unsigned)v), hi = __builtin_amdgcn_readfirstlane((unsigned)(v >> 32));
    return ((unsigned long long)hi << 32) | lo;
}
#define PF(i) ((const float*)ldp_raw(i))

#define XB_TMO      128
#define XB_XCNT(j)  (256  + 64 * (j))
#define XB_XSUB(j)  (1280 + 64 * (j))
#define XB_XGEN(j)  (2304 + 64 * (j))
#define XB_TOP      3328
#define XB_TOPGEN   3392
#define XCD_BAR_WORDS 3456
#define XB_SPIN_CAP (1u << 22)
#define LAS __attribute__((address_space(3)))

__device__ __forceinline__ unsigned xb_ld(unsigned* p)              { return __hip_atomic_load(p, __ATOMIC_RELAXED, __HIP_MEMORY_SCOPE_AGENT); }
__device__ __forceinline__ unsigned xb_add(unsigned* p, unsigned v) { return __hip_atomic_fetch_add(p, v, __ATOMIC_RELAXED, __HIP_MEMORY_SCOPE_AGENT); }
__device__ __forceinline__ unsigned xb_xcc_id() { return (unsigned)__builtin_amdgcn_s_getreg((3 << 11) | 20) & 0xFu; }
#define XB_SPIN(cond, bar) do { unsigned _sp = 0; while (cond) { __builtin_amdgcn_s_sleep(1); \
    if ((++_sp & 255u) == 0u) { if (xb_ld(&(bar)[XB_TMO])) break; if (_sp > XB_SPIN_CAP) { atomicAdd(&(bar)[XB_TMO], 1u); break; } } } } while (0)

struct XcdBarrier { unsigned* bar; unsigned x; volatile LAS unsigned* st; };

__device__ __forceinline__ XcdBarrier xcd_barrier_post(unsigned* bar, volatile LAS unsigned* st) {
    XcdBarrier b; b.bar = bar; b.x = xb_xcc_id(); b.st = st;
    if (threadIdx.x == 0) (void)xb_add(&bar[XB_XCNT(b.x)], 1u);
    return b;
}
__device__ __forceinline__ void xcd_barrier_complete(unsigned* bar, unsigned x, unsigned& nloc, unsigned& nx) {
    const unsigned G = gridDim.x * gridDim.y * gridDim.z;
    unsigned sum, cnt, mine, sp = 0u;
    for (;;) {
        sum = 0u; cnt = 0u; mine = 0u;
#pragma unroll
        for (unsigned j = 0; j < 16; ++j) { const unsigned c = xb_ld(&bar[XB_XCNT(j)]); sum += c; cnt += (c > 0u) ? 1u : 0u; mine = (j == x) ? c : mine; }
        if (sum == G) break;
        __builtin_amdgcn_s_sleep(1);
        if ((++sp & 255u) == 0u) { if (xb_ld(&bar[XB_TMO])) break; if (sp > XB_SPIN_CAP) { atomicAdd(&bar[XB_TMO], 1u); break; } }
    }
    nloc = mine > 0u ? mine : 1u; nx = cnt > 0u ? cnt : 1u;
}
__device__ __forceinline__ void xcd_barrier(const XcdBarrier& b) {
    asm volatile("s_waitcnt vmcnt(0)" ::: "memory");
    __syncthreads();
    if (threadIdx.x == 0) {
        unsigned* bar = b.bar;
        __builtin_amdgcn_s_waitcnt(0);
        unsigned nloc = b.st[0], nx = b.st[1];
        if (nloc == 0u) { xcd_barrier_complete(bar, b.x, nloc, nx); b.st[0] = nloc; b.st[1] = nx; }
        const unsigned old = xb_add(&bar[XB_XSUB(b.x)], 1u);
        const unsigned gen = old / nloc;
        if (old + 1u == (gen + 1u) * nloc) {
            __builtin_amdgcn_fence(__ATOMIC_RELEASE, "agent");
            asm volatile("s_waitcnt vmcnt(0)" ::: "memory");
            const unsigned og = xb_add(&bar[XB_TOP], 1u);
            const unsigned tg = og / nx;
            if (og + 1u == (tg + 1u) * nx) xb_add(&bar[XB_TOPGEN], 1u);
            else XB_SPIN(xb_ld(&bar[XB_TOPGEN]) == tg, bar);
            __builtin_amdgcn_fence(__ATOMIC_ACQUIRE, "agent");
            xb_add(&bar[XB_XGEN(b.x)], 1u);
            asm volatile("s_waitcnt vmcnt(0)" ::: "memory");
        } else {
            XB_SPIN(xb_ld(&bar[XB_XGEN(b.x)]) == gen, bar);
            __builtin_amdgcn_fence(__ATOMIC_ACQUIRE, "agent");
            asm volatile("s_waitcnt vmcnt(0)" ::: "memory");
        }
    }
    __syncthreads();
}

__device__ __forceinline__ float wave_sum(float v) {
#pragma unroll
    for (int o = 32; o >= 1; o >>= 1) v += __shfl_xor(v, o);
    return v;
}
__device__ __forceinline__ float wave_max(float v) {
#pragma unroll
    for (int o = 32; o >= 1; o >>= 1) v = fmaxf(v, __shfl_xor(v, o));
    return v;
}
__device__ __forceinline__ float log_sigmoid(float x) { return fminf(x, 0.f) - log1pf(expf(-fabsf(x))); }


__device__ __forceinline__ void d_rmsnorm(int vb, int t, float* sm, const float* __restrict__ in, const float* __restrict__ g, bf16_t* __restrict__ out,
                                          const float* __restrict__ w_in, float* __restrict__ gpre) {
    float* red = sm;
    const int row = vb;
    const float4* p = (const float4*)(in + (size_t)row * D);
    float4 a = p[t], b = p[t + 256];
    float s = a.x * a.x + a.y * a.y + a.z * a.z + a.w * a.w + b.x * b.x + b.y * b.y + b.z * b.z + b.w * b.w;
    s = wave_sum(s);
    __syncthreads();
    if ((t & 63) == 0) red[t >> 6] = s;
    __syncthreads();
    const float tot = red[0] + red[1] + red[2] + red[3];
    const float r = rsqrtf(tot * (1.0f / D) + EPS);
    const float4* gp = (const float4*)g;
    float4 ga = gp[t], gb = gp[t + 256];
    float hv[8] = {a.x * r * ga.x, a.y * r * ga.y, a.z * r * ga.z, a.w * r * ga.w, b.x * r * gb.x, b.y * r * gb.y, b.z * r * gb.z, b.w * r * gb.w};
    uint2 o0, o1;
    o0.x = pk2(hv[0], hv[1]); o0.y = pk2(hv[2], hv[3]); o1.x = pk2(hv[4], hv[5]); o1.y = pk2(hv[6], hv[7]);
    *(uint2*)(out + (size_t)row * D + t * 4) = o0;
    *(uint2*)(out + (size_t)row * D + 1024 + t * 4) = o1;
    if (gpre) {
        float gs[8];
#pragma unroll
        for (int c = 0; c < 8; ++c) gs[c] = 0.f;
#pragma unroll
        for (int j = 0; j < 8; ++j) {
            const int k = (j < 4) ? (t * 4 + j) : (1024 + t * 4 + (j - 4));
            const float4 w0 = *(const float4*)(w_in + (size_t)k * INC + C_MI), w1 = *(const float4*)(w_in + (size_t)k * INC + C_MI + 4);
            gs[0] = fmaf(hv[j], w0.x, gs[0]); gs[1] = fmaf(hv[j], w0.y, gs[1]); gs[2] = fmaf(hv[j], w0.z, gs[2]); gs[3] = fmaf(hv[j], w0.w, gs[3]);
            gs[4] = fmaf(hv[j], w1.x, gs[4]); gs[5] = fmaf(hv[j], w1.y, gs[5]); gs[6] = fmaf(hv[j], w1.z, gs[6]); gs[7] = fmaf(hv[j], w1.w, gs[7]);
        }
#pragma unroll
        for (int c = 0; c < 8; ++c) gs[c] = wave_sum(gs[c]);
        __syncthreads();
        if ((t & 63) == 0) {
#pragma unroll
            for (int c = 0; c < 8; ++c) red[8 + (t >> 6) * 8 + c] = gs[c];
        }
        __syncthreads();
        if (t < 8) gpre[(size_t)row * 8 + t] = red[8 + t] + red[16 + t] + red[24 + t] + red[32 + t];
    }
}

namespace pg8 {
typedef short bf16x8 __attribute__((ext_vector_type(8)));
typedef float f32x4 __attribute__((ext_vector_type(4)));
constexpr int BM = 256, BK = 64, HALF = 128, HTB = HALF * BK * 2, NXCD = 8, WGM = 8;
__device__ __forceinline__ int lds_byte(int r, int c) { const int st = (r >> 4) * 2 + (c >> 5), rr = r & 15, cc = c & 31, ob = rr * 64 + cc * 2; return st * 1024 + (ob ^ (((ob >> 9) & 1) << 5)); }
__device__ __forceinline__ void stage_rc(int b, int& R, int& C) { const int st = b / 1024, sb = b % 1024, swz = sb ^ (((sb >> 9) & 1) << 5); R = (st >> 1) * 16 + swz / 64; C = (st & 1) * 32 + (swz % 64) / 2; }
struct Unit { int pm, pn; };
struct GJob {
    const bf16_t* A; const bf16_t* Bt;
    int lda, ldb, K, nM, nN;
    int a_pn_shift, a_pn_mask, a_pn_step;
    int b_pm_shift, b_pm_step, b_pn_step;
    int a_pm_step;
    float escale;
    const float* gs; float* denp; const float* qn; const float* gvec; const bf16_t* mo;
    float* C; int ldc; const float* R; int ldr;
    int mode;
};
__device__ __forceinline__ bool unit_next(const GJob& g, int i, Unit& u) {
    const int nwg = g.nM * g.nN;
    const long L = (long)i * gridDim.x + blockIdx.x; if (L >= nwg) return false;
    int wgid = (int)L; { const int q = nwg / NXCD, r = nwg % NXCD, xcd = wgid % NXCD, off = wgid / NXCD; wgid = (xcd < r ? xcd * (q + 1) : r * (q + 1) + (xcd - r) * q) + off; }
    const int nig = WGM * g.nN, gid = wgid / nig, fm = gid * WGM, gsz = (g.nM - fm) < WGM ? (g.nM - fm) : WGM;
    u.pm = fm + ((wgid % nig) % gsz); u.pn = (wgid % nig) / gsz; return true;
}
template <int MODE> __device__ __forceinline__ void epilogue(const GJob& g, f32x4 (&acc)[2][2][4][2], const Unit& u, int wr, int wc, int fr, int fq, LAS unsigned char* xlds) {
    const int row0 = u.pm * BM + wr * 64 + fr;
    if constexpr (MODE == 0) {
        const int col0 = u.pn * BM + wc * 32 + 4 * fq;
#pragma unroll
        for (int ai = 0; ai < 2; ++ai)
#pragma unroll
            for (int m = 0; m < 4; ++m) {
                const int row = row0 + ai * HALF + m * 16;
                float* rowp = g.C + (size_t)row * g.ldc + col0;
                const float* rp = g.R ? g.R + (size_t)row * g.ldr + col0 : nullptr;
#pragma unroll
                for (int bj = 0; bj < 2; ++bj)
#pragma unroll
                    for (int n = 0; n < 2; ++n) {
                        f32x4 v = acc[ai][bj][m][n];
                        if (rp) v = v + *(const f32x4*)(rp + bj * HALF + n * 16);
                        *(f32x4*)(rowp + bj * HALF + n * 16) = v;
                    }
            }
    } else if constexpr (MODE == 6) {
        const int h = u.pn; const size_t t0 = (size_t)u.pm * BM;
        bf16_t* Cb = (bf16_t*)g.C;
#pragma unroll
        for (int ai = 0; ai < 2; ++ai)
#pragma unroll
            for (int m = 0; m < 4; ++m) {
                const int l = ai * HALF + wr * 64 + m * 16 + fr;
                const float M2 = g.gs[((t0 + l) * 4 + h) * 8 + 1];
                bf16_t* rowp = Cb + (t0 + l) * 2048 + h * 512 + wc * 32 + 4 * fq;
                float rs = 0.f;
#pragma unroll
                for (int bj = 0; bj < 2; ++bj)
#pragma unroll
                    for (int n = 0; n < 2; ++n) {
                        const f32x4 a = acc[ai][bj][m][n];
                        const int s0 = bj * HALF + wc * 32 + n * 16 + 4 * fq;
                        float p[4];
#pragma unroll
                        for (int r = 0; r < 4; ++r) { const float u2 = g.gs[((t0 + s0 + r) * 4 + h) * 8 + 0]; p[r] = (s0 + r <= l) ? a[r] * __builtin_amdgcn_exp2f(u2 - M2) : 0.f; rs += p[r]; }
                        uint2 o; o.x = pk2(p[0], p[1]); o.y = pk2(p[2], p[3]);
                        *(uint2*)(rowp + bj * HALF + n * 16) = o;
                    }
                rs += __shfl_xor(rs, 16); rs += __shfl_xor(rs, 32);
                if (fq == 0) g.denp[((t0 + l) * 4 + h) * 4 + wc] = rs;
            }
    } else if constexpr (MODE == 7) {
        float* Ct = g.C + (size_t)(u.pm * 4 + u.pn) * 65536;
        const int col0 = wc * 32 + 4 * fq;
#pragma unroll
        for (int ai = 0; ai < 2; ++ai)
#pragma unroll
            for (int m = 0; m < 4; ++m) {
                float* rowp = Ct + (size_t)(ai * HALF + wr * 64 + m * 16 + fr) * 256 + col0;
#pragma unroll
                for (int bj = 0; bj < 2; ++bj)
#pragma unroll
                    for (int n = 0; n < 2; ++n) *(f32x4*)(rowp + bj * HALF + n * 16) = acc[ai][bj][m][n];
            }
    } else if constexpr (MODE == 8) {
        const int h = u.pn; const size_t t0 = (size_t)u.pm * BM;
        LAS float* X0 = (LAS float*)xlds + wr * 512;
#pragma unroll
        for (int ai = 0; ai < 2; ++ai)
#pragma unroll
            for (int m = 0; m < 4; ++m) {
                const size_t th = (t0 + ai * HALF + wr * 64 + m * 16 + fr) * 4 + h;
                const f32x4 dp = *(const f32x4*)(g.denp + th * 4);
                const float den = (dp[0] + dp[1]) + (dp[2] + dp[3]) + g.gs[th * 8 + 3] * g.qn[th];
                const float rden = 1.0f / fmaxf(fabsf(den), g.gs[th * 8 + 4]);
                float ss = 0.f;
#pragma unroll
                for (int bj = 0; bj < 2; ++bj)
#pragma unroll
                    for (int n = 0; n < 2; ++n) { f32x4 a = acc[ai][bj][m][n] * rden; acc[ai][bj][m][n] = a; ss += (a[0] * a[0] + a[1] * a[1]) + (a[2] * a[2] + a[3] * a[3]); }
                ss += __shfl_xor(ss, 16); ss += __shfl_xor(ss, 32);
                if (fq == 0) X0[(ai * 64 + m * 16 + fr) * 4 + wc] = ss;
            }
        asm volatile("s_waitcnt lgkmcnt(0)" ::: "memory"); __builtin_amdgcn_s_barrier(); asm volatile("" ::: "memory");
        bf16_t* Cb = (bf16_t*)g.C;
        const int col0 = wc * 32 + 4 * fq;
#pragma unroll
        for (int ai = 0; ai < 2; ++ai)
#pragma unroll
            for (int m = 0; m < 4; ++m) {
                const f32x4 p4 = *(const LAS f32x4*)(X0 + (ai * 64 + m * 16 + fr) * 4);
                const float rsn = rsqrtf(((p4[0] + p4[1]) + (p4[2] + p4[3])) * (1.0f / 256.0f) + EPS);
                const size_t t = t0 + ai * HALF + wr * 64 + m * 16 + fr;
                bf16_t* rowp = Cb + t * 2048 + h * 256 + col0;
                const bf16_t* mop = g.mo + t * 1024 + h * 256 + col0;
#pragma unroll
                for (int bj = 0; bj < 2; ++bj)
#pragma unroll
                    for (int n = 0; n < 2; ++n) {
                        const f32x4 a = acc[ai][bj][m][n];
                        const ushort4 mo4 = *(const ushort4*)(mop + bj * HALF + n * 16);
                        const f32x4 gv = *(const f32x4*)(g.gvec + h * 256 + col0 + bj * HALF + n * 16);
                        const float o0 = a[0] * rsn * gv[0] / (1.0f + __expf(-bf2f(mo4.x)));
                        const float o1 = a[1] * rsn * gv[1] / (1.0f + __expf(-bf2f(mo4.y)));
                        const float o2 = a[2] * rsn * gv[2] / (1.0f + __expf(-bf2f(mo4.z)));
                        const float o3 = a[3] * rsn * gv[3] / (1.0f + __expf(-bf2f(mo4.w)));
                        uint2 o; o.x = pk2(o0, o1); o.y = pk2(o2, o3);
                        *(uint2*)(rowp + bj * HALF + n * 16) = o;
                    }
            }
    } else if constexpr (MODE == 5) {
        LAS float* X0 = (LAS float*)xlds + wr * 512;
        LAS float* X1 = (LAS float*)xlds + 1024 + wr * 512;
#pragma unroll
        for (int ai = 0; ai < 2; ++ai)
#pragma unroll
            for (int m = 0; m < 4; ++m) {
                float v = -INFINITY;
#pragma unroll
                for (int bj = 0; bj < 2; ++bj)
#pragma unroll
                    for (int n = 0; n < 2; ++n) { const f32x4 a = acc[ai][bj][m][n]; v = fmaxf(v, fmaxf(fmaxf(a[0], a[1]), fmaxf(a[2], a[3]))); }
                v = fmaxf(v, __shfl_xor(v, 16)); v = fmaxf(v, __shfl_xor(v, 32));
                if (fq == 0) X0[(ai * 64 + m * 16 + fr) * 4 + wc] = v;
            }
        asm volatile("s_waitcnt lgkmcnt(0)" ::: "memory"); __builtin_amdgcn_s_barrier(); asm volatile("" ::: "memory");
#pragma unroll
        for (int ai = 0; ai < 2; ++ai)
#pragma unroll
            for (int m = 0; m < 4; ++m) {
                const f32x4 p4 = *(const LAS f32x4*)(X0 + (ai * 64 + m * 16 + fr) * 4);
                const float mxr = fmaxf(fmaxf(p4[0], p4[1]), fmaxf(p4[2], p4[3])) * g.escale;
                float s = 0.f;
#pragma unroll
                for (int bj = 0; bj < 2; ++bj)
#pragma unroll
                    for (int n = 0; n < 2; ++n) { f32x4 a = acc[ai][bj][m][n];
                        a[0] = __builtin_amdgcn_exp2f(a[0] * g.escale - mxr); a[1] = __builtin_amdgcn_exp2f(a[1] * g.escale - mxr); a[2] = __builtin_amdgcn_exp2f(a[2] * g.escale - mxr); a[3] = __builtin_amdgcn_exp2f(a[3] * g.escale - mxr);
                        acc[ai][bj][m][n] = a; s += (a[0] + a[1]) + (a[2] + a[3]); }
                s += __shfl_xor(s, 16); s += __shfl_xor(s, 32);
                if (fq == 0) X1[(ai * 64 + m * 16 + fr) * 4 + wc] = s;
            }
        asm volatile("s_waitcnt lgkmcnt(0)" ::: "memory"); __builtin_amdgcn_s_barrier(); asm volatile("" ::: "memory");
        bf16_t* Cb = (bf16_t*)g.C;
        const int col0 = u.pn * BM + wc * 32 + 4 * fq;
#pragma unroll
        for (int ai = 0; ai < 2; ++ai)
#pragma unroll
            for (int m = 0; m < 4; ++m) {
                const f32x4 p4 = *(const LAS f32x4*)(X1 + (ai * 64 + m * 16 + fr) * 4);
                const float inv = 1.0f / ((p4[0] + p4[1]) + (p4[2] + p4[3]));
                bf16_t* rowp = Cb + (size_t)(row0 + ai * HALF + m * 16) * g.ldc + col0;
#pragma unroll
                for (int bj = 0; bj < 2; ++bj)
#pragma unroll
                    for (int n = 0; n < 2; ++n) {
                        const f32x4 a = acc[ai][bj][m][n];
                        uint2 o; o.x = pk2(a[0] * inv, a[1] * inv); o.y = pk2(a[2] * inv, a[3] * inv);
                        *(uint2*)(rowp + bj * HALF + n * 16) = o;
                    }
            }
    } else {
        bf16_t* Cb = (bf16_t*)g.C; int ccol = u.pn * BM;
        if constexpr (MODE == 4) { Cb += (size_t)(u.pn >> 2) * P6S; ccol = (u.pn & 3) * 256; }
        const int col0 = ccol + wc * 32 + 4 * fq;
#pragma unroll
        for (int ai = 0; ai < 2; ++ai)
#pragma unroll
            for (int m = 0; m < 4; ++m) {
                bf16_t* rowp = Cb + (size_t)(row0 + ai * HALF + m * 16) * g.ldc + col0;
#pragma unroll
                for (int bj = 0; bj < 2; ++bj)
#pragma unroll
                    for (int n = 0; n < 2; ++n) {
                        const f32x4 v = acc[ai][bj][m][n];
                        uint2 o; o.x = pk2(v[0], v[1]); o.y = pk2(v[2], v[3]);
                        *(uint2*)(rowp + bj * HALF + n * 16) = o;
                    }
            }
    }
}
template <int MODE> __device__ __forceinline__ void gemm_phase(LAS unsigned char* lds, const GJob& g, int tid) {
    const int wid = __builtin_amdgcn_readfirstlane(tid >> 6), lane = tid & 63, wr = wid >> 2, wc = wid & 3, fr = lane & 15, fq = lane >> 4;
    const int K = g.K, nt = K / BK;
    unsigned voffA[2], voffB[2];
#pragma unroll
    for (int i = 0; i < 2; ++i) { int R, C; stage_rc(tid * 16 + i * 8192, R, C);
        voffA[i] = (unsigned)(R * g.lda + C) * 2u; voffB[i] = (unsigned)(R * g.ldb + C) * 2u; }
    const size_t kstep = (size_t)(BK * 2);
    const size_t hstepA = (size_t)HALF * g.lda * 2, hstepB = (size_t)HALF * g.ldb * 2;
    const unsigned ldsw = (unsigned)wid * 1024u;
    const int aoff = lds_byte(wr * 64 + fr, fq * 8), boff = lds_byte(wc * 32 + fr, fq * 8);
#define PG8_SA(b, h) (((b) * 2 + (h)) * HTB)
#define PG8_SB(b, h) ((4 + (b) * 2 + (h)) * HTB)
#define PG8_STAGE(bufoff, gbase, voff) do { _Pragma("unroll") for (int _i = 0; _i < 2; ++_i) \
        __builtin_amdgcn_global_load_lds((const unsigned*)((const char*)(gbase) + (voff)[_i]), (LAS unsigned*)(lds + (bufoff) + ldsw + _i * 8192), 16, 0, 0); } while (0)
#define PG8_LDA(dst, b, h) do { _Pragma("unroll") for (int m = 0; m < 4; ++m) _Pragma("unroll") for (int k = 0; k < 2; ++k) dst[m][k] = *(const LAS bf16x8*)(lds + PG8_SA(b, h) + aoff + m * 2048 + k * 1024); } while (0)
#define PG8_LDB(dst, b, h) do { _Pragma("unroll") for (int n = 0; n < 2; ++n) _Pragma("unroll") for (int k = 0; k < 2; ++k) dst[n][k] = *(const LAS bf16x8*)(lds + PG8_SB(b, h) + boff + n * 2048 + k * 1024); } while (0)
#define PG8_MMA(ai, bj, At, Bt) do { __builtin_amdgcn_s_setprio(1); _Pragma("unroll") for (int m = 0; m < 4; ++m) _Pragma("unroll") for (int n = 0; n < 2; ++n) _Pragma("unroll") for (int k = 0; k < 2; ++k) \
        acc[ai][bj][m][n] = __builtin_amdgcn_mfma_f32_16x16x32_bf16(Bt[n][k], At[m][k], acc[ai][bj][m][n], 0, 0, 0); __builtin_amdgcn_s_setprio(0); } while (0)
#define PG8_WAIT_V(n) asm volatile("s_waitcnt vmcnt(" #n ")" ::: "memory")
#define PG8_WAIT_L(n) asm volatile("s_waitcnt lgkmcnt(" #n ")" ::: "memory")
#define PG8_BAR __builtin_amdgcn_s_barrier()
#define PG8_SCHED __builtin_amdgcn_sched_barrier(0)
#define PG8_ABASE(u) ((const char*)g.A + ((size_t)(u).pm * g.a_pm_step + (size_t)(((u).pn >> g.a_pn_shift) & g.a_pn_mask) * g.a_pn_step) * 2)
#define PG8_BBASE(u) ((const char*)g.Bt + ((size_t)(u).pn * g.b_pn_step + (size_t)((u).pm >> g.b_pm_shift) * g.b_pm_step) * 2)
    Unit cur, nxt; int ui = 0;
    if (!unit_next(g, 0, cur)) return;
    f32x4 acc[2][2][4][2];
#pragma unroll
    for (int a = 0; a < 2; ++a)
#pragma unroll
        for (int b = 0; b < 2; ++b)
#pragma unroll
            for (int m = 0; m < 4; ++m)
#pragma unroll
                for (int n = 0; n < 2; ++n) acc[a][b][m][n] = (f32x4){0.f, 0.f, 0.f, 0.f};
    bf16x8 At[4][2], B0[2][2], B1[2][2];
    const char* cA = PG8_ABASE(cur); const char* cB = PG8_BBASE(cur);
    PG8_STAGE(PG8_SB(0, 0), cB, voffB); PG8_STAGE(PG8_SA(0, 0), cA, voffA); PG8_STAGE(PG8_SB(0, 1), cB + hstepB, voffB); PG8_STAGE(PG8_SA(0, 1), cA + hstepA, voffA);
    if (wr == 1) PG8_BAR;
    PG8_WAIT_V(4); PG8_BAR;
    PG8_STAGE(PG8_SB(1, 0), cB + kstep, voffB); PG8_STAGE(PG8_SA(1, 0), cA + kstep, voffA); PG8_STAGE(PG8_SB(1, 1), cB + hstepB + kstep, voffB);
    PG8_WAIT_V(6); PG8_BAR;
    for (;;) {
        const bool has_next = unit_next(g, ui + 1, nxt);
        const char* nA = has_next ? PG8_ABASE(nxt) : cA; const char* nB = has_next ? PG8_BBASE(nxt) : cB;
        for (int t = 0; t < nt; t += 2) {
            const bool last = (t == nt - 2);
            const char* a1 = cA + (size_t)(t + 1) * kstep;
            const char* a2 = last ? nA : cA + (size_t)(t + 2) * kstep; const char* b2 = last ? nB : cB + (size_t)(t + 2) * kstep;
            const char* a3 = a2 + kstep; const char* b3 = b2 + kstep;
            PG8_LDB(B0, 0, 0); PG8_SCHED; PG8_LDA(At, 0, 0); PG8_STAGE(PG8_SA(1, 1), a1 + hstepA, voffA);
            PG8_WAIT_L(8); PG8_BAR; PG8_WAIT_L(0); PG8_MMA(0, 0, At, B0); PG8_BAR; PG8_SCHED;
            PG8_LDB(B1, 0, 1); PG8_STAGE(PG8_SB(0, 0), b2, voffB);
            PG8_BAR; PG8_WAIT_L(0); PG8_MMA(0, 1, At, B1); PG8_BAR;
            PG8_LDA(At, 0, 1); PG8_STAGE(PG8_SA(0, 0), a2, voffA);
            PG8_BAR; PG8_WAIT_L(0); PG8_MMA(1, 0, At, B0); PG8_BAR; PG8_SCHED;
            PG8_STAGE(PG8_SB(0, 1), b2 + hstepB, voffB);
            PG8_WAIT_V(6); PG8_BAR; PG8_MMA(1, 1, At, B1); PG8_BAR;
            PG8_LDB(B0, 1, 0); PG8_SCHED; PG8_LDA(At, 1, 0); PG8_STAGE(PG8_SA(0, 1), a2 + hstepA, voffA);
            PG8_WAIT_L(8); PG8_BAR; PG8_WAIT_L(0); PG8_MMA(0, 0, At, B0); PG8_BAR; PG8_SCHED;
            PG8_LDB(B1, 1, 1); PG8_STAGE(PG8_SB(1, 0), b3, voffB);
            PG8_BAR; PG8_WAIT_L(0); PG8_MMA(0, 1, At, B1); PG8_BAR;
            PG8_LDA(At, 1, 1); PG8_STAGE(PG8_SA(1, 0), a3, voffA);
            PG8_BAR; PG8_WAIT_L(0); PG8_MMA(1, 0, At, B0); PG8_BAR; PG8_SCHED;
            PG8_STAGE(PG8_SB(1, 1), b3 + hstepB, voffB);
            PG8_WAIT_V(6); PG8_BAR; PG8_MMA(1, 1, At, B1); PG8_BAR;
        }
        epilogue<MODE>(g, acc, cur, wr, wc, fr, fq, lds + GEMM_LDS + 1024);
        if (!has_next) break;
#pragma unroll
        for (int a = 0; a < 2; ++a)
#pragma unroll
            for (int b = 0; b < 2; ++b)
#pragma unroll
                for (int m = 0; m < 4; ++m)
#pragma unroll
                    for (int n = 0; n < 2; ++n) acc[a][b][m][n] = (f32x4){0.f, 0.f, 0.f, 0.f};
        cur = nxt; cA = nA; cB = nB; ++ui;
    }
    PG8_WAIT_V(0);
    if (wr == 0) PG8_BAR;
    PG8_BAR;
#undef PG8_SA
#undef PG8_SB
#undef PG8_STAGE
#undef PG8_LDA
#undef PG8_LDB
#undef PG8_MMA
#undef PG8_WAIT_V
#undef PG8_WAIT_L
#undef PG8_BAR
#undef PG8_SCHED
#undef PG8_ABASE
#undef PG8_BBASE
}
}

__device__ __forceinline__ void p0_transpose_item(const float* W, int ldw, int K, int csrc0, bf16_t* WT, int row0, LAS float* scr, int kb, int lane, float wscale) {
    const int k0 = 64 * kb;
#pragma unroll 8
    for (int i = 0; i < 32; ++i) { const int kk = 2 * i + (lane >> 5); scr[kk * 33 + (lane & 31)] = W[(size_t)(k0 + kk) * ldw + csrc0 + (lane & 31)] * wscale; }
    asm volatile("s_waitcnt lgkmcnt(0)" ::: "memory");
    const int c = lane & 7;
#pragma unroll
    for (int j = 0; j < 4; ++j) { const int n = (lane >> 3) + 8 * j; const LAS float* s = scr + (8 * c) * 33 + n;
        uint4 o; o.x = pk2(s[0 * 33], s[1 * 33]); o.y = pk2(s[2 * 33], s[3 * 33]); o.z = pk2(s[4 * 33], s[5 * 33]); o.w = pk2(s[6 * 33], s[7 * 33]);
        *(uint4*)(WT + (size_t)(row0 + n) * K + k0 + 8 * c) = o; }
    asm volatile("s_waitcnt lgkmcnt(0)" ::: "memory");
}

__device__ __forceinline__ void d_conv_silu(int vb, int tid, const bf16_t* __restrict__ p6, const float* __restrict__ cw, const float* __restrict__ cb, bf16_t* __restrict__ c) {
    const int t = vb, s = t % S;
    for (int ch = tid; ch < 1024; ch += 256) {
        float y = cb[ch];
#pragma unroll
        for (int j = 0; j < 4; ++j) {
            const int ss = s - 3 + j;
            if (ss >= 0) y = fmaf(cw[j * 1024 + ch], bf2f(p6[(size_t)(t - 3 + j) * 1024 + ch]), y);
        }
        c[(size_t)t * 1024 + ch] = (bf16_t)f2bf(y / (1.0f + expf(-y)));
    }
}

__device__ __forceinline__ void d_mlstm(int vb, int tid, const bf16_t* __restrict__ mq, const bf16_t* __restrict__ mk, const bf16_t* __restrict__ p6,
                                        const float* __restrict__ gpre, const float* __restrict__ b_mi, const float* __restrict__ b_mf, float* __restrict__ hraw) {
    const int lane = tid & 63, w = tid >> 6;
    const int gid = vb * 4 + w;
    const int e = gid & 255, h = (gid >> 8) & 3, b = gid >> 10;
    const float bi = b_mi[h], bf = b_mf[h];
    float C0 = 0.f, C1 = 0.f, C2 = 0.f, C3 = 0.f, n0 = 0.f, n1 = 0.f, n2 = 0.f, n3 = 0.f, m = 0.f;
    const size_t tb = (size_t)b * S;
    const bf16_t* qp = mq + tb * 1024 + h * 256 + lane * 4;
    const bf16_t* kp = mk + tb * 1024 + h * 256 + lane * 4;
    const bf16_t* pp = p6 + P6S + tb * 1024 + h * 256 + e;
    ushort4 qn = *(const ushort4*)qp, kn = *(const ushort4*)kp;
    const float* gp = gpre + tb * 8;
    float vn = bf2f(pp[0]), in_ = gp[h], fn = gp[4 + h];
    for (int s = 0; s < S; ++s) {
        const float4 q = make_float4(bf2f(qn.x), bf2f(qn.y), bf2f(qn.z), bf2f(qn.w)), k = make_float4(bf2f(kn.x), bf2f(kn.y), bf2f(kn.z), bf2f(kn.w)); const float v = vn, ipre = in_ + bi, fpre = fn + bf;
        if (s + 1 < S) {
            qn = *(const ushort4*)(qp + (size_t)(s + 1) * 1024);
            kn = *(const ushort4*)(kp + (size_t)(s + 1) * 1024);
            vn = bf2f(pp[(size_t)(s + 1) * 1024]); in_ = gp[(size_t)(s + 1) * 8 + h]; fn = gp[(size_t)(s + 1) * 8 + 4 + h];
        }
        const float logf = log_sigmoid(fpre);
        const float mnew = fmaxf(logf + m, ipre);
        const float fd = expf(logf + m - mnew), ig = expf(ipre - mnew);
        m = mnew;
        const float sc = ig * 0.0625f;
        C0 = fd * C0 + sc * k.x * v; C1 = fd * C1 + sc * k.y * v; C2 = fd * C2 + sc * k.z * v; C3 = fd * C3 + sc * k.w * v;
        n0 = fd * n0 + sc * k.x; n1 = fd * n1 + sc * k.y; n2 = fd * n2 + sc * k.z; n3 = fd * n3 + sc * k.w;
        float num = q.x * C0 + q.y * C1 + q.z * C2 + q.w * C3;
        float den = q.x * n0 + q.y * n1 + q.z * n2 + q.w * n3;
        num = wave_sum(num); den = wave_sum(den);
        if (lane == 0) hraw[(tb + s) * 1024 + h * 256 + e] = num / fmaxf(fabsf(den), expf(-mnew));
    }
}

__device__ __forceinline__ void d_mhead_norm(int vb, int tid, const float* __restrict__ hraw, const bf16_t* __restrict__ p6, const float* __restrict__ g, bf16_t* __restrict__ mix) {
    const int t = vb, h = tid >> 6, lane = tid & 63;
    const float4 v = *(const float4*)(hraw + (size_t)t * 1024 + h * 256 + lane * 4);
    float s = v.x * v.x + v.y * v.y + v.z * v.z + v.w * v.w;
    s = wave_sum(s);
    const float r = rsqrtf(s * (1.0f / 256.0f) + EPS);
    const float4 gg = *(const float4*)(g + h * 256 + lane * 4);
    const ushort4 mo = *(const ushort4*)(p6 + 2 * P6S + (size_t)t * 1024 + h * 256 + lane * 4);
    float4 o;
    o.x = v.x * r * gg.x / (1.0f + expf(-bf2f(mo.x)));
    o.y = v.y * r * gg.y / (1.0f + expf(-bf2f(mo.y)));
    o.z = v.z * r * gg.z / (1.0f + expf(-bf2f(mo.z)));
    o.w = v.w * r * gg.w / (1.0f + expf(-bf2f(mo.w)));
    uint2 ob; ob.x = pk2(o.x, o.y); ob.y = pk2(o.z, o.w);
    *(uint2*)(mix + (size_t)t * D + h * 256 + lane * 4) = ob;
}

__device__ __forceinline__ void d_rope(int vb, int tid, bf16_t* __restrict__ p6) {
    const int t = vb, s = t % S;
    for (int idx = tid; idx < 2 * 8 * 64; idx += 256) {
        const int i = idx & 63, hd = (idx >> 6) & 7, qk = idx >> 9;
        const float inv = exp2f(-(float)i * 0.20762050593046014f);
        const float ang = (float)s * inv;
        float sn, cs; sincosf(ang, &sn, &cs);
        bf16_t* p = p6 + (size_t)(3 + qk) * P6S + (size_t)t * 1024 + hd * 128;
        const float x1 = bf2f(p[i]), x2 = bf2f(p[64 + i]);
        p[i] = (bf16_t)f2bf(x1 * cs - x2 * sn);
        p[64 + i] = (bf16_t)f2bf(x2 * cs + x1 * sn);
    }
}

__device__ __forceinline__ void d_dilated(int vb, int tid, float* sm, const bf16_t* __restrict__ p6, const float* __restrict__ g_ahead, bf16_t* __restrict__ mix) {
    float (*qs)[128] = (float (*)[128])sm;
    float (*ps)[576] = (float (*)[576])(sm + 512);
    const int lane = tid & 63, w = tid >> 6;
    const int gid = vb * 4 + w;
    const int s = gid % S, hd = (gid / S) & 7, b = gid / (S * 8);
    const size_t t = (size_t)b * S + s;
    const bf16_t* qrow = p6 + 3 * P6S + t * 1024 + hd * 128;
    __syncthreads();
    qs[w][lane] = bf2f(qrow[lane]); qs[w][lane + 64] = bf2f(qrow[lane + 64]);
    __syncthreads();
    const float scale = 0.08838834764831845f;
    float mloc = -INFINITY;
    for (int br = 0; br < 3; ++br) {
        const int dil = br == 0 ? 1 : (br == 1 ? 4 : 16);
        for (int jj = 0; jj < 192; jj += 64) {
            const int j = jj + lane;
            float sc = -INFINITY;
            if (j <= 128 && s - j * dil >= 0) {
                const bf16_t* krow = p6 + 4 * P6S + (t - (size_t)j * dil) * 1024 + hd * 128;
                float d = 0.f;
#pragma unroll 8
                for (int c = 0; c < 128; c += 4) {
                    const ushort4 kv = *(const ushort4*)(krow + c);
                    d = fmaf(qs[w][c], bf2f(kv.x), d); d = fmaf(qs[w][c + 1], bf2f(kv.y), d); d = fmaf(qs[w][c + 2], bf2f(kv.z), d); d = fmaf(qs[w][c + 3], bf2f(kv.w), d);
                }
                sc = d * scale;
            }
            ps[w][br * 192 + j] = sc;
            mloc = fmaxf(mloc, sc);
        }
    }
    const float mx = wave_max(mloc);
    __syncthreads();
    float lsum = 0.f;
    for (int i = lane; i < 3 * 192; i += 64) {
        const float sc = ps[w][i];
        const float pv = (sc == -INFINITY) ? 0.f : expf(sc - mx);
        ps[w][i] = pv; lsum += pv;
    }
    const float tot = wave_sum(lsum);
    __syncthreads();
    float o0 = 0.f, o1 = 0.f;
    for (int br = 0; br < 3; ++br) {
        const int dil = br == 0 ? 1 : (br == 1 ? 4 : 16);
        for (int j = 0; j <= 128; ++j) {
            if (s - j * dil < 0) break;
            const float pv = ps[w][br * 192 + j];
            const bf16_t* vrow = p6 + 5 * P6S + (t - (size_t)j * dil) * 1024 + hd * 128;
            o0 = fmaf(pv, bf2f(vrow[lane]), o0); o1 = fmaf(pv, bf2f(vrow[lane + 64]), o1);
        }
    }
    o0 /= tot; o1 /= tot;
    float ss = wave_sum(o0 * o0 + o1 * o1);
    const float r = rsqrtf(ss * (1.0f / 128.0f) + EPS);
    bf16_t* orow = mix + t * D + 1024 + hd * 128;
    orow[lane] = (bf16_t)f2bf(o0 * r * g_ahead[hd * 128 + lane]);
    orow[lane + 64] = (bf16_t)f2bf(o1 * r * g_ahead[hd * 128 + lane + 64]);
}

__device__ __forceinline__ void d_cross(int vb, int tid, float* sm, const bf16_t* __restrict__ q, const float* __restrict__ km, const float* __restrict__ vm, bf16_t* __restrict__ o) {
    float (*qs)[512] = (float (*)[512])sm;
    float (*ps)[256] = (float (*)[256])(sm + 2048);
    const int lane = tid & 63, w = tid >> 6;
    const int t = vb, hd = w, b = t / S;
    const bf16_t* qrow = q + (size_t)t * D + hd * 512;
    __syncthreads();
    for (int i = lane; i < 512; i += 64) qs[w][i] = bf2f(qrow[i]);
    __syncthreads();
    const float scale = 0.04419417382415922f;
    float sc[4]; float mloc = -INFINITY;
#pragma unroll
    for (int r = 0; r < 4; ++r) {
        const int mi = lane + 64 * r;
        const float* krow = km + ((size_t)b * 256 + mi) * D + hd * 512;
        float d = 0.f;
#pragma unroll 8
        for (int c = 0; c < 512; c += 4) {
            const float4 kv = *(const float4*)(krow + c);
            d = fmaf(qs[w][c], kv.x, d); d = fmaf(qs[w][c + 1], kv.y, d); d = fmaf(qs[w][c + 2], kv.z, d); d = fmaf(qs[w][c + 3], kv.w, d);
        }
        sc[r] = d * scale; mloc = fmaxf(mloc, sc[r]);
    }
    const float mx = wave_max(mloc);
    float lsum = 0.f;
#pragma unroll
    for (int r = 0; r < 4; ++r) { const float pv = expf(sc[r] - mx); ps[w][lane + 64 * r] = pv; lsum += pv; }
    const float tot = wave_sum(lsum);
    __syncthreads();
    float acc[8];
#pragma unroll
    for (int i = 0; i < 8; ++i) acc[i] = 0.f;
    for (int mi = 0; mi < 256; ++mi) {
        const float pv = ps[w][mi];
        const float* vrow = vm + ((size_t)b * 256 + mi) * D + hd * 512;
#pragma unroll
        for (int i = 0; i < 8; ++i) acc[i] = fmaf(pv, vrow[lane + 64 * i], acc[i]);
    }
    bf16_t* orow = o + (size_t)t * D + hd * 512;
#pragma unroll
    for (int i = 0; i < 8; ++i) orow[lane + 64 * i] = (bf16_t)f2bf(acc[i] / tot);
}

__device__ __forceinline__ void wave_argmax(float& best, int& bidx) {
#pragma unroll
    for (int o = 32; o >= 1; o >>= 1) {
        const float ob = __shfl_xor(best, o); const int oi = __shfl_xor(bidx, o);
        if (ob > best || (ob == best && oi < bidx)) { best = ob; bidx = oi; }
    }
}
__device__ __forceinline__ void d_peer_topk(int vb, int tid, float* sm, const bf16_t* __restrict__ qp, const float* __restrict__ sub_keys, int* __restrict__ ids, float* __restrict__ gates) {
    float (*qs)[256] = (float (*)[256])sm;
    const int lane = tid & 63, w = tid >> 6;
    const int gid = vb * 4 + w;
    const int hd = gid & 7, t = gid >> 3;
    const bf16_t* qrow = qp + (size_t)t * D + hd * 256;
    __syncthreads();
    for (int i = lane; i < 256; i += 64) qs[w][i] = bf2f(qrow[i]);
    __syncthreads();
    float tops[2]; int topi[2];
#pragma unroll
    for (int p = 0; p < 2; ++p) {
        float v0, v1;
        {
            const float* k0 = sub_keys + ((size_t)(hd * 2 + p) * 128 + lane) * 128;
            const float* k1 = k0 + 64 * 128;
            float d0 = 0.f, d1 = 0.f;
#pragma unroll 8
            for (int c = 0; c < 128; c += 4) {
                const float4 a = *(const float4*)(k0 + c), bb = *(const float4*)(k1 + c);
                const float q0 = qs[w][p * 128 + c], q1 = qs[w][p * 128 + c + 1], q2 = qs[w][p * 128 + c + 2], q3 = qs[w][p * 128 + c + 3];
                d0 = fmaf(q0, a.x, d0); d0 = fmaf(q1, a.y, d0); d0 = fmaf(q2, a.z, d0); d0 = fmaf(q3, a.w, d0);
                d1 = fmaf(q0, bb.x, d1); d1 = fmaf(q1, bb.y, d1); d1 = fmaf(q2, bb.z, d1); d1 = fmaf(q3, bb.w, d1);
            }
            v0 = d0; v1 = d1;
        }
        float ts = 0.f; int ti = 0;
        for (int it = 0; it < 16; ++it) {
            float best; int bidx;
            if (v0 >= v1) { best = v0; bidx = lane; } else { best = v1; bidx = lane + 64; }
            wave_argmax(best, bidx);
            if (lane == it) { ts = best; ti = bidx; }
            if (bidx == lane) v0 = -INFINITY;
            if (bidx == lane + 64) v1 = -INFINITY;
        }
        tops[p] = ts; topi[p] = ti;
    }
    float cv[4]; int ci[4];
#pragma unroll
    for (int r = 0; r < 4; ++r) {
        const int c = lane * 4 + r, i = c >> 4, j = c & 15;
        const float s0 = __shfl(tops[0], i), s1 = __shfl(tops[1], j);
        const int i0 = __shfl(topi[0], i), i1 = __shfl(topi[1], j);
        cv[r] = s0 + s1; ci[r] = i0 * 128 + i1;
    }
    float bs = 0.f; int bid = 0;
    for (int it = 0; it < 16; ++it) {
        float best = cv[0]; int bidx = lane * 4;
#pragma unroll
        for (int r = 1; r < 4; ++r) if (cv[r] > best) { best = cv[r]; bidx = lane * 4 + r; }
        wave_argmax(best, bidx);
        const int owner = bidx >> 2, rr = bidx & 3;
        int myid = ci[0];
        if (rr == 1) myid = ci[1]; else if (rr == 2) myid = ci[2]; else if (rr == 3) myid = ci[3];
        const int eid = __shfl(myid, owner);
        if (lane == it) { bs = best; bid = eid; }
        if (owner == lane) {
#pragma unroll
            for (int r = 0; r < 4; ++r) if (rr == r) cv[r] = -INFINITY;
        }
    }
    float v = lane < 16 ? bs : -INFINITY;
    const float mx = wave_max(v);
    const float ev = lane < 16 ? expf(bs - mx) : 0.f;
    const float tot = wave_sum(ev);
    if (lane < 16) {
        ids[(size_t)t * 128 + hd * 16 + lane] = bid;
        gates[(size_t)t * 128 + hd * 16 + lane] = ev / tot;
    }
}

__device__ __forceinline__ void d_peer_out(int vb, int tid, float* sm, const bf16_t* __restrict__ h3, const float* __restrict__ x2, const int* __restrict__ ids, const float* __restrict__ gates,
                                           const bf16_t* __restrict__ u_tab, const bf16_t* __restrict__ v_tab, const float* __restrict__ g_final, float* __restrict__ out) {
    float (*part)[2048] = (float (*)[2048])sm;
    float* red = sm + 4 * 2048;
    const int lane = tid & 63, w = tid >> 6, t = vb;
    float4 xr[8], acc[8];
    const bf16_t* hrow = h3 + (size_t)t * D;
#pragma unroll
    for (int i = 0; i < 8; ++i) { const ushort4 hv = *(const ushort4*)(hrow + i * 256 + lane * 4);
        xr[i] = make_float4(bf2f(hv.x), bf2f(hv.y), bf2f(hv.z), bf2f(hv.w)); acc[i] = make_float4(0.f, 0.f, 0.f, 0.f); }
    for (int j = 0; j < 32; ++j) {
        const int slot = w * 32 + j;
        const int e = ids[(size_t)t * 128 + slot];
        const float gt = gates[(size_t)t * 128 + slot];
        const bf16_t* ur = u_tab + (size_t)e * D;
        const bf16_t* vr = v_tab + (size_t)e * D;
        float d = 0.f;
#pragma unroll
        for (int i = 0; i < 8; ++i) {
            const ushort4 u = *(const ushort4*)(ur + i * 256 + lane * 4);
            d = fmaf(xr[i].x, bf2f(u.x), d); d = fmaf(xr[i].y, bf2f(u.y), d); d = fmaf(xr[i].z, bf2f(u.z), d); d = fmaf(xr[i].w, bf2f(u.w), d);
        }
        d = wave_sum(d);
        const float act = 0.5f * d * (1.0f + erff(d * 0.7071067811865476f));
        const float cf = gt * act;
#pragma unroll
        for (int i = 0; i < 8; ++i) {
            const ushort4 v = *(const ushort4*)(vr + i * 256 + lane * 4);
            acc[i].x = fmaf(cf, bf2f(v.x), acc[i].x); acc[i].y = fmaf(cf, bf2f(v.y), acc[i].y); acc[i].z = fmaf(cf, bf2f(v.z), acc[i].z); acc[i].w = fmaf(cf, bf2f(v.w), acc[i].w);
        }
    }
    __syncthreads();
#pragma unroll
    for (int i = 0; i < 8; ++i) *(float4*)&part[w][i * 256 + lane * 4] = acc[i];
    __syncthreads();
    float4 r0, r1;
    {
        const float4 a = *(const float4*)&part[0][tid * 4], b = *(const float4*)&part[1][tid * 4], c = *(const float4*)&part[2][tid * 4], d = *(const float4*)&part[3][tid * 4];
        const float4 x = *(const float4*)(x2 + (size_t)t * D + tid * 4);
        r0 = make_float4(x.x + a.x + b.x + c.x + d.x, x.y + a.y + b.y + c.y + d.y, x.z + a.z + b.z + c.z + d.z, x.w + a.w + b.w + c.w + d.w);
    }
    {
        const float4 a = *(const float4*)&part[0][1024 + tid * 4], b = *(const float4*)&part[1][1024 + tid * 4], c = *(const float4*)&part[2][1024 + tid * 4], d = *(const float4*)&part[3][1024 + tid * 4];
        const float4 x = *(const float4*)(x2 + (size_t)t * D + 1024 + tid * 4);
        r1 = make_float4(x.x + a.x + b.x + c.x + d.x, x.y + a.y + b.y + c.y + d.y, x.z + a.z + b.z + c.z + d.z, x.w + a.w + b.w + c.w + d.w);
    }
    float s = r0.x * r0.x + r0.y * r0.y + r0.z * r0.z + r0.w * r0.w + r1.x * r1.x + r1.y * r1.y + r1.z * r1.z + r1.w * r1.w;
    s = wave_sum(s);
    if (lane == 0) red[w] = s;
    __syncthreads();
    const float tot = red[0] + red[1] + red[2] + red[3];
    const float r = rsqrtf(tot * (1.0f / D) + EPS);
    const float4 g0 = *(const float4*)(g_final + tid * 4), g1 = *(const float4*)(g_final + 1024 + tid * 4);
    *(float4*)(out + (size_t)t * D + tid * 4) = make_float4(r0.x * r * g0.x, r0.y * r * g0.y, r0.z * r * g0.z, r0.w * r * g0.w);
    *(float4*)(out + (size_t)t * D + 1024 + tid * 4) = make_float4(r1.x * r * g1.x, r1.y * r * g1.y, r1.z * r * g1.z, r1.w * r * g1.w);
}


__device__ __forceinline__ float wave_incl_scan_add(float v, int lane) {
#pragma unroll
    for (int o = 1; o < 64; o <<= 1) { const float t = __shfl_up(v, o); if (lane >= o) v += t; }
    return v;
}
__device__ __forceinline__ float wave_incl_scan_max(float v, int lane) {
#pragma unroll
    for (int o = 1; o < 64; o <<= 1) { const float t = __shfl_up(v, o); if (lane >= o) v = fmaxf(v, t); }
    return v;
}
__device__ __forceinline__ void mlstm_gates_wave(int b, int h, int lane, const float* __restrict__ gpre, const float* __restrict__ b_mi, const float* __restrict__ b_mf,
                                                 float* __restrict__ gs, float* __restrict__ decay) {
    const float bi = b_mi[h], bf = b_mf[h];
    float mprev = 0.f;
    for (int c = 0; c < 16; ++c) {
        const size_t t0 = (size_t)b * S + c * 256 + lane * 4;
        float logi[4], lf[4], bb[4];
#pragma unroll
        for (int j = 0; j < 4; ++j) { logi[j] = gpre[(t0 + j) * 8 + h] + bi; lf[j] = log_sigmoid(gpre[(t0 + j) * 8 + 4 + h] + bf); }
        bb[0] = lf[0]; bb[1] = bb[0] + lf[1]; bb[2] = bb[1] + lf[2]; bb[3] = bb[2] + lf[3];
        const float incl = wave_incl_scan_add(bb[3], lane);
        const float excl = incl - bb[3];
#pragma unroll
        for (int j = 0; j < 4; ++j) bb[j] += excl;
        const float g = __shfl(incl, 63);
        float amax = -INFINITY, uu[4], cm[4];
#pragma unroll
        for (int j = 0; j < 4; ++j) { amax = fmaxf(amax, logi[j] + g - bb[j]); uu[j] = logi[j] - bb[j]; }
        amax = wave_max(amax);
        const float mnew = fmaxf(g + mprev, amax);
        cm[0] = uu[0]; cm[1] = fmaxf(cm[0], uu[1]); cm[2] = fmaxf(cm[1], uu[2]); cm[3] = fmaxf(cm[2], uu[3]);
        const float cincl = wave_incl_scan_max(cm[3], lane);
        float cexcl = __shfl_up(cincl, 1); if (lane == 0) cexcl = -INFINITY;
#pragma unroll
        for (int j = 0; j < 4; ++j) {
            const float M = fmaxf(mprev, fmaxf(cexcl, cm[j]));
            float* o = gs + ((t0 + j) * 4 + h) * 8;
            o[0] = uu[j] * 1.4426950408889634f; o[1] = M * 1.4426950408889634f; o[2] = expf(logi[j] + g - bb[j] - mnew); o[3] = expf(mprev - M); o[4] = expf(-(bb[j] + M));
        }
        if (lane == 0) decay[(b * 16 + c) * 4 + h] = expf(g + mprev - mnew);
        mprev = mnew;
    }
}
__device__ __forceinline__ void transpose_tile64(int tid, float* sm, const bf16_t* __restrict__ src, int src_ld, bf16_t* __restrict__ dst, int dst_ld, const float* __restrict__ scale, int sstride) {
    unsigned short (*tl)[66] = (unsigned short (*)[66])sm;
    __syncthreads();
#pragma unroll
    for (int i = 0; i < 2; ++i) {
        const int ch = tid + i * 256, r = ch >> 3, c8 = (ch & 7) * 8;
        const uint4 v = *(const uint4*)(src + (size_t)r * src_ld + c8);
        const float sc = scale ? scale[(size_t)r * sstride] : 1.0f;
        const unsigned w[4] = {v.x, v.y, v.z, v.w};
#pragma unroll
        for (int k = 0; k < 4; ++k) {
            tl[r][c8 + 2 * k] = (unsigned short)f2bf(bf2f((unsigned short)(w[k] & 0xFFFFu)) * sc);
            tl[r][c8 + 2 * k + 1] = (unsigned short)f2bf(bf2f((unsigned short)(w[k] >> 16)) * sc);
        }
    }
    __syncthreads();
#pragma unroll
    for (int i = 0; i < 2; ++i) {
        const int ch = tid + i * 256, c = ch >> 3, r8 = (ch & 7) * 8;
        uint4 o;
        o.x = (unsigned)tl[r8 + 0][c] | ((unsigned)tl[r8 + 1][c] << 16); o.y = (unsigned)tl[r8 + 2][c] | ((unsigned)tl[r8 + 3][c] << 16);
        o.z = (unsigned)tl[r8 + 4][c] | ((unsigned)tl[r8 + 5][c] << 16); o.w = (unsigned)tl[r8 + 6][c] | ((unsigned)tl[r8 + 7][c] << 16);
        *(uint4*)(dst + (size_t)c * dst_ld + r8) = o;
    }
}

typedef short bf16x8_t __attribute__((ext_vector_type(8)));
typedef short bf16x4_t __attribute__((ext_vector_type(4)));
typedef float f32x4_t __attribute__((ext_vector_type(4)));
__device__ __forceinline__ void dilated_wave_tile(int qt, int lane, const bf16_t* __restrict__ AQ, const bf16_t* __restrict__ AK, const bf16_t* __restrict__ VT,
                                                  const float* __restrict__ g_ahead, bf16_t* __restrict__ mix) {
    const int r = qt & 15, blk = (qt >> 4) & 15, hd = (qt >> 8) & 7, b = qt >> 11;
    const int j = lane & 15, g = lane >> 4;
    const int t0 = blk * 256;
    const int sq = t0 + r + 16 * j;
    bf16x8_t qf[4];
    {
        const bf16_t* qrow = AQ + ((size_t)b * S + sq) * 1024 + hd * 128 + 8 * g;
#pragma unroll
        for (int ks = 0; ks < 4; ++ks) qf[ks] = *(const bf16x8_t*)(qrow + 32 * ks);
    }
    const float sc = 0.08838834764831845f * 1.4426950408889634f;
    float m_run = -1e30f, l_run = 0.f;
    f32x4_t o[8];
#pragma unroll
    for (int dt = 0; dt < 8; ++dt) o[dt] = (f32x4_t){0.f, 0.f, 0.f, 0.f};
#pragma nounroll
    for (int br = 0; br < 3; ++br) {
        const int ld = 2 * br, d = 1 << ld;
        const int rho = r & (d - 1);
        const int qj = (sq - rho) >> ld;
        const int q_lo = ((t0 + r - rho) >> ld) - 128, q_hi = (t0 + r + 240 - rho) >> ld;
        const int tile_lo = q_lo < 0 ? 0 : (q_lo >> 4), tile_hi = q_hi >> 4, tile_max = (256 >> ld) - 1;
        const bf16_t* vtb = VT + (size_t)br * ((size_t)1024 * 8192) + (size_t)(hd * 128 + j) * 8192 + (size_t)b * 4096 + (size_t)rho * (4096 >> ld) + 4 * g;
#pragma nounroll
        for (int tp = tile_lo; tp <= tile_hi; tp += 2) {
            f32x4_t su[2];
#pragma unroll
            for (int u = 0; u < 2; ++u) {
                int tl = tp + u; if (tl > tile_max) tl = tile_max;
                const int pos = rho + ((16 * tl + j) << ld);
                const bf16_t* krow = AK + ((size_t)b * S + pos) * 1024 + hd * 128 + 8 * g;
                f32x4_t a = (f32x4_t){0.f, 0.f, 0.f, 0.f};
#pragma unroll
                for (int ks = 0; ks < 4; ++ks) a = __builtin_amdgcn_mfma_f32_16x16x32_bf16(*(const bf16x8_t*)(krow + 32 * ks), qf[ks], a, 0, 0, 0);
                su[u] = a;
            }
            float p[2][4]; float mx = -1e30f;
#pragma unroll
            for (int u = 0; u < 2; ++u)
#pragma unroll
                for (int e = 0; e < 4; ++e) {
                    const int n = qj - (16 * (tp + u) + 4 * g + e);
                    const bool valid = (n >= 0) && (n <= 128);
                    p[u][e] = valid ? su[u][e] * sc : -1e30f;
                    mx = fmaxf(mx, p[u][e]);
                }
            mx = fmaxf(mx, __shfl_xor(mx, 16)); mx = fmaxf(mx, __shfl_xor(mx, 32));
            const float m_new = fmaxf(m_run, mx);
            const float alpha = __builtin_amdgcn_exp2f(m_run - m_new);
            m_run = m_new;
            float ps = 0.f;
#pragma unroll
            for (int u = 0; u < 2; ++u)
#pragma unroll
                for (int e = 0; e < 4; ++e) { p[u][e] = (p[u][e] > -1e29f) ? __builtin_amdgcn_exp2f(p[u][e] - m_new) : 0.f; ps += p[u][e]; }
            l_run = l_run * alpha + ps;
            bf16x8_t pb;
            {
                const unsigned w0 = pk2(p[0][0], p[0][1]), w1 = pk2(p[0][2], p[0][3]), w2 = pk2(p[1][0], p[1][1]), w3 = pk2(p[1][2], p[1][3]);
                pb[0] = (short)(w0 & 0xFFFF); pb[1] = (short)(w0 >> 16); pb[2] = (short)(w1 & 0xFFFF); pb[3] = (short)(w1 >> 16);
                pb[4] = (short)(w2 & 0xFFFF); pb[5] = (short)(w2 >> 16); pb[6] = (short)(w3 & 0xFFFF); pb[7] = (short)(w3 >> 16);
            }
            int tl0 = tp, tl1 = tp + 1; if (tl0 > tile_max) tl0 = tile_max; if (tl1 > tile_max) tl1 = tile_max;
#pragma unroll
            for (int dt = 0; dt < 8; ++dt) {
                const bf16_t* vrow = vtb + (size_t)dt * (16 * 8192);
                const bf16x4_t v0 = *(const bf16x4_t*)(vrow + 16 * tl0), v1 = *(const bf16x4_t*)(vrow + 16 * tl1);
                bf16x8_t va; va[0] = v0[0]; va[1] = v0[1]; va[2] = v0[2]; va[3] = v0[3]; va[4] = v1[0]; va[5] = v1[1]; va[6] = v1[2]; va[7] = v1[3];
                f32x4_t oo = o[dt]; oo = oo * alpha;
                o[dt] = __builtin_amdgcn_mfma_f32_16x16x32_bf16(va, pb, oo, 0, 0, 0);
            }
        }
    }
    float lt = l_run; lt += __shfl_xor(lt, 16); lt += __shfl_xor(lt, 32);
    const float inv = 1.0f / lt;
    float ss = 0.f;
#pragma unroll
    for (int dt = 0; dt < 8; ++dt) { o[dt] = o[dt] * inv; ss += (o[dt][0] * o[dt][0] + o[dt][1] * o[dt][1]) + (o[dt][2] * o[dt][2] + o[dt][3] * o[dt][3]); }
    ss += __shfl_xor(ss, 16); ss += __shfl_xor(ss, 32);
    const float rn = rsqrtf(ss * (1.0f / 128.0f) + EPS);
    bf16_t* orow = mix + ((size_t)b * S + sq) * D + 1024 + hd * 128 + 4 * g;
#pragma unroll
    for (int dt = 0; dt < 8; ++dt) {
        const f32x4_t gv = *(const f32x4_t*)(g_ahead + hd * 128 + 16 * dt + 4 * g);
        uint2 w; w.x = pk2(o[dt][0] * rn * gv[0], o[dt][1] * rn * gv[1]); w.y = pk2(o[dt][2] * rn * gv[2], o[dt][3] * rn * gv[3]);
        *(uint2*)(orow + 16 * dt) = w;
    }
}

__device__ __forceinline__ unsigned ord_key(float s) { const unsigned u = __float_as_uint(s); return u ^ ((unsigned)((int)u >> 31) | 0x80000000u); }
__device__ __forceinline__ unsigned wave_max_u32(unsigned v) {
#pragma unroll
    for (int o = 32; o >= 1; o >>= 1) { const unsigned t = (unsigned)__shfl_xor((int)v, o); v = v > t ? v : t; }
    return v;
}
__device__ __forceinline__ void peer_topk_wave(int item, int lane, LAS float* wl, const bf16_t* __restrict__ qp, const bf16_t* __restrict__ skb, int* __restrict__ ids, float* __restrict__ gates) {
    const int hd = item & 7, tt = item >> 3, j = lane & 15, g = lane >> 4;
    const size_t t0 = (size_t)tt * 16;
    LAS float* sc = wl;
    LAS float* lst = wl + 2048;
#pragma unroll 1
    for (int p = 0; p < 2; ++p) {
        bf16x8_t qf[4];
        const bf16_t* qrow = qp + (t0 + j) * D + hd * 256 + p * 128 + 8 * g;
#pragma unroll
        for (int ks = 0; ks < 4; ++ks) qf[ks] = *(const bf16x8_t*)(qrow + 32 * ks);
        const bf16_t* kb = skb + ((size_t)(hd * 2 + p) * 128 + j) * 128 + 8 * g;
#pragma unroll
        for (int kt = 0; kt < 8; ++kt) {
            f32x4_t a = (f32x4_t){0.f, 0.f, 0.f, 0.f};
#pragma unroll
            for (int ks = 0; ks < 4; ++ks) a = __builtin_amdgcn_mfma_f32_16x16x32_bf16(*(const bf16x8_t*)(kb + (size_t)kt * (16 * 128) + 32 * ks), qf[ks], a, 0, 0, 0);
            *(LAS f32x4_t*)(sc + j * 128 + 16 * kt + 4 * g) = a;
        }
        asm volatile("s_waitcnt lgkmcnt(0)" ::: "memory");
#pragma unroll 1
        for (int tok = 0; tok < 16; ++tok) {
            const float s0 = sc[tok * 128 + lane], s1 = sc[tok * 128 + 64 + lane];
            unsigned k0 = (ord_key(s0) & ~127u) | (unsigned)(127 - lane), k1 = (ord_key(s1) & ~127u) | (unsigned)(63 - lane);
            unsigned sel = 0u;
#pragma unroll 4
            for (int it = 0; it < 16; ++it) {
                unsigned m = k0 > k1 ? k0 : k1;
                m = wave_max_u32(m);
                if (lane == it) sel = m;
                if (k0 == m) k0 = 0u;
                if (k1 == m) k1 = 0u;
            }
            if (lane < 16) {
                const int idx = 127 - (int)(sel & 127u);
                lst[((p * 16 + tok) * 16 + lane) * 2 + 0] = sc[tok * 128 + idx];
                lst[((p * 16 + tok) * 16 + lane) * 2 + 1] = __int_as_float(idx);
            }
        }
        asm volatile("s_waitcnt lgkmcnt(0)" ::: "memory");
    }
#pragma unroll 1
    for (int tok = 0; tok < 16; ++tok) {
        const int i = lane >> 2;
        const float sA = lst[((0 * 16 + tok) * 16 + i) * 2];
        unsigned kk[4];
#pragma unroll
        for (int r = 0; r < 4; ++r) {
            const int jb = (lane & 3) * 4 + r;
            const float sum = sA + lst[((1 * 16 + tok) * 16 + jb) * 2];
            kk[r] = (ord_key(sum) & ~255u) | (unsigned)(255 - (lane * 4 + r));
        }
        unsigned sel = 0u;
#pragma unroll 4
        for (int it = 0; it < 16; ++it) {
            unsigned m = kk[0] > kk[1] ? kk[0] : kk[1]; const unsigned m2 = kk[2] > kk[3] ? kk[2] : kk[3]; m = m > m2 ? m : m2;
            m = wave_max_u32(m);
            if (lane == it) sel = m;
#pragma unroll
            for (int r = 0; r < 4; ++r) if (kk[r] == m) kk[r] = 0u;
        }
        float bs = -INFINITY; int eid = 0;
        if (lane < 16) {
            const int c = 255 - (int)(sel & 255u), ia = c >> 4, ib = c & 15;
            bs = lst[((0 * 16 + tok) * 16 + ia) * 2] + lst[((1 * 16 + tok) * 16 + ib) * 2];
            eid = __float_as_int(lst[((0 * 16 + tok) * 16 + ia) * 2 + 1]) * 128 + __float_as_int(lst[((1 * 16 + tok) * 16 + ib) * 2 + 1]);
        }
        const float mx = wave_max(bs);
        const float ev = lane < 16 ? __expf(bs - mx) : 0.f;
        const float tot = wave_sum(ev);
        if (lane < 16) {
            ids[(t0 + tok) * 128 + hd * 16 + lane] = eid;
            gates[(t0 + tok) * 128 + hd * 16 + lane] = ev / tot;
        }
    }
}

struct Params {
    const float *x, *mem, *g_mix, *w_in, *conv_w, *conv_b, *w_mq, *w_mk, *b_mi, *b_mf, *g_mhead, *g_ahead, *w_out, *g_cross, *g_mem,
                *w_xq, *w_xk, *w_xv, *w_xo, *g_ffn, *w_pq, *sub_keys, *u_tab, *v_tab, *g_final;
    float* out;
    unsigned* bar;
    float* ws;
};

#define PHASE_LOOP(nvb) for (int base_ = blockIdx.x * 2; base_ < (nvb); base_ += gridDim.x * 2)
#define VB (base_ + half)

__global__ void __launch_bounds__(NTHR) mega(Params P) {
    volatile LAS unsigned* st = (volatile LAS unsigned*)(LAS unsigned char*)(smem_raw + GEMM_LDS);
    if (threadIdx.x == 0) { st[0] = 0u; st[1] = 0u; st[2] = 0u; st[3] = 0u; }
    if (threadIdx.x < I_NPTR) ((LAS unsigned long long*)(LAS unsigned char*)(smem_raw + GEMM_LDS + 64))[threadIdx.x] = ((const unsigned long long*)&P)[threadIdx.x];
    __syncthreads();
    XcdBarrier xb = xcd_barrier_post((unsigned*)ldp_raw(I_BAR), st);

    constexpr size_t TD = (size_t)T * D;
    constexpr size_t O_HB = 6 * P6S * 2, O_CBUF = O_HB + (size_t)T * D * 2, O_MQ = O_CBUF + (size_t)T * 1024 * 2, O_MK = O_MQ + (size_t)T * 1024 * 2,
                     O_MIXB = O_MK + (size_t)T * 1024 * 2, O_WIN = O_MIXB + (size_t)T * D * 2, O_WOUT = O_WIN + (size_t)6144 * D * 2, O_WXQ = O_WOUT + (size_t)D * D * 2,
                     O_WXK = O_WXQ + (size_t)D * D * 2, O_WXV = O_WXK + (size_t)D * D * 2, O_WXO = O_WXV + (size_t)D * D * 2, O_WPQ = O_WXO + (size_t)D * D * 2,
                     O_WQK = O_WPQ + (size_t)D * D * 2, O_GPRE = O_WQK + (size_t)8 * 256 * 256 * 2, O_UT = O_GPRE + (size_t)T * 8 * 4, O_VT = O_UT + (size_t)16384 * D * 2,
                     O_BH = O_VT + (size_t)16384 * D * 2, O_GS = O_BH + (size_t)128 * 256 * 512 * 2, O_DENP = O_GS + (size_t)T * 4 * 8 * 4, O_QN = O_DENP + (size_t)T * 4 * 4 * 4,
                     O_DN = O_QN + (size_t)T * 4 * 4, O_DECAY = O_DN + (size_t)128 * 256 * 4, O_VT3 = O_DECAY + 4096, O_SKB = O_VT3 + (size_t)3 * 1024 * 8192 * 2, O_END = O_SKB + (size_t)262144 * 2;
    static_assert(O_END + 16384 <= (size_t)536870912, "workspace overflow");
#define W_P6    ((bf16_t*)wsb)
#define W_HB    ((bf16_t*)(wsb + O_HB))
#define W_CBUF  ((bf16_t*)(wsb + O_CBUF))
#define W_MQ    ((bf16_t*)(wsb + O_MQ))
#define W_MK    ((bf16_t*)(wsb + O_MK))
#define W_MIXB  ((bf16_t*)(wsb + O_MIXB))
#define W_GPRE  ((float*)(wsb + O_GPRE))
#define W_HRAW  ((float*)(wsb + O_HB))
#define W_XR    ((float*)wsb)
#define W_MN    ((bf16_t*)((float*)wsb + TD))
#define W_KM    ((bf16_t*)((float*)wsb + TD + (size_t)256 * D))
#define W_VMT   ((bf16_t*)((float*)wsb + TD + (size_t)768 * D))
#define W_PX    ((bf16_t*)(wsb + O_MK))
#define W_GATES ((float*)wsb + TD + (size_t)1280 * D)
#define W_IDS   ((int*)((float*)wsb + TD + (size_t)1280 * D + (size_t)T * 128))
#define W_QX    ((bf16_t*)(wsb + O_CBUF))
#define W_BH    ((bf16_t*)(wsb + O_BH))
#define W_VT3   ((bf16_t*)(wsb + O_VT3))
#define W_SKB   ((bf16_t*)(wsb + O_SKB))
#define W_GS    ((float*)(wsb + O_GS))
#define W_DENP  ((float*)(wsb + O_DENP))
#define W_QN    ((float*)(wsb + O_QN))
#define W_DN    ((float*)(wsb + O_DN))
#define W_DECAY ((float*)(wsb + O_DECAY))
#define W_PQ    ((bf16_t*)(wsb + O_HB))
#define W_KWT   ((bf16_t*)(wsb + O_CBUF))
#define W_DC    ((float*)(wsb + 3 * P6S * 2))
#define W_UT    ((bf16_t*)(wsb + O_UT))
#define W_VT    ((bf16_t*)(wsb + O_VT))
#define PH_BEGIN() int tidx = threadIdx.x; asm volatile("" : "+v"(tidx)); const int half = tidx >> 8, tid = tidx & 255; float* sm = (float*)smem_raw + half * HALF_SM_FLOATS; \
                   char* wsb = (char*)ldp_raw(I_WS); (void)half; (void)tid; (void)sm; (void)wsb
#define GJOB_DEFAULT(g) pg8::GJob g; g.lda = D; g.ldb = D; g.K = D; g.nM = 32; g.nN = 8; g.a_pm_step = 256 * D; g.a_pn_shift = 0; g.a_pn_mask = 0; g.a_pn_step = 0; g.b_pm_shift = 0; g.b_pm_step = 0; g.b_pn_step = 256 * D; \
                        g.ldc = D; g.R = nullptr; g.ldr = D; g.mode = 0; g.escale = 1.0f; g.gs = nullptr; g.denp = nullptr; g.qn = nullptr; g.gvec = nullptr; g.mo = nullptr
#define GEMM_LDSP ((LAS unsigned char*)smem_raw)

    {
        PH_BEGIN();
        {
            LAS float* scr = (LAS float*)(LAS unsigned char*)(smem_raw) + (tidx >> 6) * (64 * 33);
            const int lane = tidx & 63;
            const int gw = blockIdx.x * 8 + (tidx >> 6), NGW = gridDim.x * 8;
            constexpr int I_IN = 32 * 192, I_SQ = 32 * 64, I_QK = 8 * 4 * 8;
            constexpr int NITEMS = I_IN + 6 * I_SQ + I_QK;
#pragma nounroll
            for (int it = gw; it < NITEMS; it += NGW) {
                const float* W; int ldw, K, csrc0, row0, kb; bf16_t* WT; float wscale = 1.0f;
                int r = it;
                if (r < I_IN) { const int nb = r % 192; kb = r / 192; W = PF(I_WIN); ldw = INC; K = D; csrc0 = nb * 32 + (nb >= 96 ? 8 : 0); WT = (bf16_t*)(wsb + O_WIN); row0 = nb * 32; }
                else if ((r -= I_IN) < 6 * I_SQ) {
                    const int wsel = r / I_SQ; r -= wsel * I_SQ; const int nb = r % 64; kb = r / 64; ldw = D; K = D; csrc0 = nb * 32; row0 = nb * 32;
                    W = PF(wsel == 0 ? I_WOUT : wsel == 1 ? I_WXQ : wsel == 2 ? I_WXK : wsel == 3 ? I_WXV : wsel == 4 ? I_WXO : I_WPQ);
                    WT = (bf16_t*)(wsb + O_WOUT + (size_t)wsel * ((size_t)D * D * 2));
                } else {
                    r -= 6 * I_SQ; const int hq = r / 32; r -= hq * 32; const int nb = r % 8; kb = r / 8;
                    W = PF(hq < 4 ? I_WMQ : I_WMK) + (size_t)(hq & 3) * 65536; ldw = 256; K = 256; csrc0 = nb * 32; WT = (bf16_t*)(wsb + O_WQK); row0 = hq * 256 + nb * 32;
                    if (hq >= 4) wscale = 0.0625f;
                }
                p0_transpose_item(W, ldw, K, csrc0, WT, row0, scr, kb, lane, wscale);
            }
            {
                const float* ut = PF(I_UTAB); const float* vt = PF(I_VTAB);
                const size_t n8 = (size_t)16384 * D / 8, nth = (size_t)gridDim.x * NTHR;
#pragma nounroll
                for (size_t i = (size_t)blockIdx.x * NTHR + tidx; i < 2 * n8; i += nth) {
                    const bool second = i >= n8; const size_t k = second ? i - n8 : i;
                    const float4* sp = (const float4*)((second ? vt : ut) + k * 8);
                    const float4 a = sp[0], b = sp[1];
                    uint4 o; o.x = pk2(a.x, a.y); o.y = pk2(a.z, a.w); o.z = pk2(b.x, b.y); o.w = pk2(b.z, b.w);
                    *(uint4*)((second ? W_VT : W_UT) + k * 8) = o;
                }
            }
            {
                const float* sk = PF(I_SUBK);
#pragma nounroll
                for (int i = blockIdx.x * NTHR + tidx; i < 262144 / 8; i += gridDim.x * NTHR) {
                    const float4 a = *(const float4*)(sk + (size_t)i * 8), b = *(const float4*)(sk + (size_t)i * 8 + 4);
                    uint4 o; o.x = pk2(a.x, a.y); o.y = pk2(a.z, a.w); o.z = pk2(b.x, b.y); o.w = pk2(b.z, b.w);
                    *(uint4*)(W_SKB + (size_t)i * 8) = o;
                }
            }
            __syncthreads();
        }
        { const float* rin = PF(I_X); const float* rg = PF(I_GMIX); const float* win = PF(I_WIN);
#pragma nounroll
          PHASE_LOOP(T) d_rmsnorm(VB, tid, sm, rin, rg, W_HB, win, W_GPRE); }
    }
    xcd_barrier(xb);
    {
        PH_BEGIN();
        GJOB_DEFAULT(g); g.A = W_HB; g.Bt = (bf16_t*)(wsb + O_WIN); g.nN = 24; g.C = (float*)W_P6; g.ldc = 1024;
        pg8::gemm_phase<4>(GEMM_LDSP, g, tidx);
    }
    xcd_barrier(xb);
    {
        PH_BEGIN();
        const float* cw = PF(I_CONVW); const float* cb = PF(I_CONVB);
#pragma nounroll
        PHASE_LOOP(T) d_conv_silu(VB, tid, W_P6, cw, cb, W_CBUF);
#pragma nounroll
        PHASE_LOOP(T) d_rope(VB, tid, W_P6);
        if (blockIdx.x < 8 && tidx < 64) mlstm_gates_wave(blockIdx.x >> 2, blockIdx.x & 3, tidx, W_GPRE, PF(I_BMI), PF(I_BMF), W_GS, W_DECAY);
#pragma nounroll
        PHASE_LOOP(2048) { const int it = VB, lt = it & 3, et = (it >> 2) & 3, h = (it >> 4) & 3, cg = it >> 6;
            transpose_tile64(tid, sm, W_P6 + P6S + (size_t)(cg * 256 + lt * 64) * 1024 + h * 256 + et * 64, 1024, W_BH + ((size_t)(cg * 4 + h) * 256 + et * 64) * 512 + lt * 64, 512, nullptr, 0); }
#pragma nounroll
        PHASE_LOOP(6144) { const int br = VB >> 11, it = VB & 2047, ld = 2 * br, dimt = it & 15, rest = it >> 4, b = rest >> 6, x = rest & 63, rho = x >> (6 - ld), qt = x & ((64 >> ld) - 1);
            transpose_tile64(tid, sm, W_P6 + 5 * P6S + ((size_t)b * S + rho + ((size_t)(64 * qt) << ld)) * 1024 + dimt * 64, 1024 << ld,
                             W_VT3 + (size_t)br * ((size_t)1024 * 8192) + (size_t)(dimt * 64) * 8192 + (size_t)b * 4096 + (size_t)rho * (4096 >> ld) + qt * 64, 8192, nullptr, 0); }
    }
    xcd_barrier(xb);
    {
        PH_BEGIN();
        {
            GJOB_DEFAULT(g); g.A = W_CBUF; g.lda = 1024; g.a_pm_step = 256 * 1024; g.Bt = (bf16_t*)(wsb + O_WQK); g.ldb = 256; g.b_pn_step = 256 * 256; g.K = 256; g.a_pn_mask = 3; g.a_pn_step = 256; g.C = (float*)W_MQ; g.ldc = 1024;
            pg8::gemm_phase<4>(GEMM_LDSP, g, tidx);
            __syncthreads();
        }
        const float* ga = PF(I_GAHEAD);
#pragma nounroll
        for (int qt = blockIdx.x * 8 + (tidx >> 6); qt < 4096; qt += gridDim.x * 8) dilated_wave_tile(qt, tidx & 63, W_P6 + 3 * P6S, W_P6 + 4 * P6S, W_VT3, ga, W_MIXB);
    }
    xcd_barrier(xb);
    {
        PH_BEGIN();
#pragma nounroll
        PHASE_LOOP(2048) { const int it = VB, lt = it & 3, dt = (it >> 2) & 3, h = (it >> 4) & 3, cg = it >> 6;
            transpose_tile64(tid, sm, W_MK + (size_t)(cg * 256 + lt * 64) * 1024 + h * 256 + dt * 64, 1024, W_KWT + ((size_t)(cg * 4 + h) * 256 + dt * 64) * 256 + lt * 64, 256,
                             W_GS + ((size_t)(cg * 256 + lt * 64) * 4 + h) * 8 + 2, 32); }
        {
            const size_t nth = (size_t)gridDim.x * NTHR;
#pragma nounroll
            for (size_t i = (size_t)blockIdx.x * NTHR + tidx; i < (size_t)T * 128; i += nth) {
                const size_t t = i >> 7; const int c8 = (int)(i & 127) * 8, h = c8 >> 8, d = c8 & 255;
                const float sc = W_GS[(t * 4 + h) * 8 + 3];
                const uint4 v = *(const uint4*)(W_MQ + t * 1024 + c8);
                uint4 o;
                o.x = pk2(bf2f((unsigned short)(v.x & 0xFFFFu)) * sc, bf2f((unsigned short)(v.x >> 16)) * sc); o.y = pk2(bf2f((unsigned short)(v.y & 0xFFFFu)) * sc, bf2f((unsigned short)(v.y >> 16)) * sc);
                o.z = pk2(bf2f((unsigned short)(v.z & 0xFFFFu)) * sc, bf2f((unsigned short)(v.z >> 16)) * sc); o.w = pk2(bf2f((unsigned short)(v.w & 0xFFFFu)) * sc, bf2f((unsigned short)(v.w >> 16)) * sc);
                *(uint4*)(W_PQ + t * 2048 + h * 512 + 256 + d) = o;
            }
        }
#pragma nounroll
        PHASE_LOOP(128) { const int cgh = VB, cg = cgh >> 2, h = cgh & 3;
            float a = 0.f;
            for (int l = 0; l < 256; ++l) { const size_t t = (size_t)cg * 256 + l; a = fmaf(W_GS[(t * 4 + h) * 8 + 2], bf2f(W_MK[t * 1024 + h * 256 + tid]), a); }
            W_DN[(size_t)cgh * 256 + tid] = a; }
        __syncthreads();
        {
            GJOB_DEFAULT(g); g.A = W_MQ; g.lda = 1024; g.a_pm_step = 256 * 1024; g.a_pn_mask = 3; g.a_pn_step = 256; g.K = 256; g.nN = 4;
            g.Bt = W_MK; g.ldb = 1024; g.b_pn_step = 256; g.b_pm_step = 256 * 1024; g.C = (float*)W_PQ; g.gs = W_GS; g.denp = W_DENP;
            pg8::gemm_phase<6>(GEMM_LDSP, g, tidx);
        }
    }
    xcd_barrier(xb);
    {
        PH_BEGIN();
        GJOB_DEFAULT(g); g.A = W_BH; g.lda = 512; g.a_pm_step = 4 * 256 * 512; g.a_pn_mask = 3; g.a_pn_step = 256 * 512; g.K = 256; g.nN = 4;
        g.Bt = W_KWT; g.ldb = 256; g.b_pn_step = 65536; g.b_pm_step = 4 * 65536; g.C = W_DC;
        pg8::gemm_phase<7>(GEMM_LDSP, g, tidx);
    }
    xcd_barrier(xb);
    {
        PH_BEGIN();
        {
#pragma nounroll
            for (int gid = blockIdx.x * NTHR + tidx; gid < 131072; gid += gridDim.x * NTHR) {
                const int bh = gid >> 14, b = bh >> 2, h = bh & 3, e = (gid >> 6) & 255, d = (gid & 63) * 4;
                float4 C = make_float4(0.f, 0.f, 0.f, 0.f);
#pragma unroll 4
                for (int c = 0; c < 16; ++c) {
                    const int cgh = (b * 16 + c) * 4 + h;
                    uint2 o; o.x = pk2(C.x, C.y); o.y = pk2(C.z, C.w);
                    *(uint2*)(W_BH + ((size_t)cgh * 256 + e) * 512 + 256 + d) = o;
                    const float dec = W_DECAY[cgh];
                    const float4 dc = *(const float4*)(W_DC + ((size_t)cgh * 256 + e) * 256 + d);
                    C.x = fmaf(dec, C.x, dc.x); C.y = fmaf(dec, C.y, dc.y); C.z = fmaf(dec, C.z, dc.z); C.w = fmaf(dec, C.w, dc.w);
                }
            }
        }
#pragma nounroll
        PHASE_LOOP(128) { const int cgh = VB, cg = cgh >> 2, h = cgh & 3, b = cg >> 4, c = cg & 15;
            float n = 0.f;
            for (int cc = 0; cc < c; ++cc) { const int j = (b * 16 + cc) * 4 + h; n = fmaf(W_DECAY[j], n, W_DN[(size_t)j * 256 + tid]); }
            __syncthreads();
            sm[tid] = n;
            __syncthreads();
            const int lane = tid & 63, w = tid >> 6;
            const float4 nv = *(const float4*)(sm + lane * 4);
            for (int i = 0; i < 64; ++i) {
                const size_t t = (size_t)cg * 256 + w * 64 + i;
                const ushort4 q4 = *(const ushort4*)(W_MQ + t * 1024 + h * 256 + lane * 4);
                float s = bf2f(q4.x) * nv.x + bf2f(q4.y) * nv.y + bf2f(q4.z) * nv.z + bf2f(q4.w) * nv.w;
                s = wave_sum(s);
                if (lane == 0) W_QN[t * 4 + h] = s;
            }
        }
    }
    xcd_barrier(xb);
    {
        PH_BEGIN();
        GJOB_DEFAULT(g); g.A = W_PQ; g.a_pn_mask = 3; g.a_pn_step = 512; g.K = 512; g.nN = 4;
        g.Bt = W_BH; g.ldb = 512; g.b_pn_step = 256 * 512; g.b_pm_step = 4 * 256 * 512; g.C = (float*)W_MIXB;
        g.gs = W_GS; g.denp = W_DENP; g.qn = W_QN; g.gvec = PF(I_GMHEAD); g.mo = W_P6 + 2 * P6S;
        pg8::gemm_phase<8>(GEMM_LDSP, g, tidx);
    }
    xcd_barrier(xb);
    {
        PH_BEGIN();
        GJOB_DEFAULT(g); g.A = W_MIXB; g.Bt = (bf16_t*)(wsb + O_WOUT); g.C = W_XR; g.R = PF(I_X);
        pg8::gemm_phase<0>(GEMM_LDSP, g, tidx);
    }
    xcd_barrier(xb);
    {
        PH_BEGIN();
        { const float* rg = PF(I_GCROSS); const float* win = PF(I_WIN);
#pragma nounroll
          PHASE_LOOP(T) d_rmsnorm(VB, tid, sm, W_XR, rg, W_HB, win, nullptr); }
        { const float* rin = PF(I_MEM); const float* rg = PF(I_GMEM); const float* win = PF(I_WIN);
#pragma nounroll
          PHASE_LOOP(512) d_rmsnorm(VB, tid, sm, rin, rg, W_MN, win, nullptr); }
    }
    xcd_barrier(xb);
    {
        PH_BEGIN();
        { GJOB_DEFAULT(g); g.A = W_HB; g.Bt = (bf16_t*)(wsb + O_WXQ); g.C = (float*)W_QX; pg8::gemm_phase<3>(GEMM_LDSP, g, tidx); __syncthreads(); }
        { GJOB_DEFAULT(g); g.A = W_MN; g.Bt = (bf16_t*)(wsb + O_WXK); g.nM = 2; g.C = (float*)W_KM; pg8::gemm_phase<3>(GEMM_LDSP, g, tidx); __syncthreads(); }
        { GJOB_DEFAULT(g); g.A = (bf16_t*)(wsb + O_WXV); g.Bt = W_MN; g.nM = 8; g.nN = 2; g.C = (float*)W_VMT; g.ldc = 512; pg8::gemm_phase<3>(GEMM_LDSP, g, tidx); }
    }
    xcd_barrier(xb);
    {
        PH_BEGIN();
        GJOB_DEFAULT(g); g.A = W_QX; g.K = 512; g.a_pn_mask = 3; g.a_pn_step = 512; g.Bt = W_KM; g.b_pn_step = 512; g.b_pm_shift = 4; g.b_pm_step = 256 * D; g.nN = 4;
        g.C = (float*)W_PX; g.ldc = 1024; g.escale = 0.04419417382415922f * 1.4426950408889634f;
        pg8::gemm_phase<5>(GEMM_LDSP, g, tidx);
    }
    xcd_barrier(xb);
    {
        PH_BEGIN();
        GJOB_DEFAULT(g); g.A = W_PX; g.lda = 1024; g.a_pm_step = 256 * 1024; g.K = 256; g.a_pn_shift = 1; g.a_pn_mask = 3; g.a_pn_step = 256; g.Bt = W_VMT; g.ldb = 512; g.b_pn_step = 256 * 512; g.b_pm_shift = 4; g.b_pm_step = 256;
        g.C = (float*)W_MIXB;
        pg8::gemm_phase<3>(GEMM_LDSP, g, tidx);
    }
    xcd_barrier(xb);
    {
        PH_BEGIN();
        GJOB_DEFAULT(g); g.A = W_MIXB; g.Bt = (bf16_t*)(wsb + O_WXO); g.C = W_XR; g.R = W_XR;
        pg8::gemm_phase<0>(GEMM_LDSP, g, tidx);
    }
    xcd_barrier(xb);
    {
        PH_BEGIN();
        const float* rg = PF(I_GFFN); const float* win = PF(I_WIN);
#pragma nounroll
        PHASE_LOOP(T) d_rmsnorm(VB, tid, sm, W_XR, rg, W_HB, win, nullptr);
    }
    xcd_barrier(xb);
    {
        PH_BEGIN();
        GJOB_DEFAULT(g); g.A = W_HB; g.Bt = (bf16_t*)(wsb + O_WPQ); g.C = (float*)W_QX;
        pg8::gemm_phase<3>(GEMM_LDSP, g, tidx);
    }
    xcd_barrier(xb);
    {
        PH_BEGIN();
        LAS float* wl = (LAS float*)(LAS unsigned char*)smem_raw + (tidx >> 6) * 3072;
#pragma nounroll
        for (int item = blockIdx.x * 8 + (tidx >> 6); item < 4096; item += gridDim.x * 8) peer_topk_wave(item, tidx & 63, wl, W_QX, W_SKB, W_IDS, W_GATES);
    }
    xcd_barrier(xb);
    {
        PH_BEGIN();
        const float* gf = PF(I_GFINAL); float* outp = (float*)ldp_raw(I_OUT);
#pragma nounroll
        PHASE_LOOP(T) d_peer_out(VB, tid, sm, W_HB, W_XR, W_IDS, W_GATES, W_UT, W_VT, gf, outp);
    }
}
}

extern "C" void kernel_launch(void* const* d_in, const int* in_sizes, int n_in, void* d_out, int out_size, void* d_ws, size_t ws_size, hipStream_t stream) {
    static int grid_blocks = 0;
    if (!grid_blocks) {
        int dev = 0, cus = 0, per_cu = 0;
        hipGetDevice(&dev);
        hipDeviceGetAttribute(&cus, hipDeviceAttributeMultiprocessorCount, dev);
        hipFuncSetAttribute((const void*)mega, hipFuncAttributeMaxDynamicSharedMemorySize, SMEM_BYTES);
        hipOccupancyMaxActiveBlocksPerMultiprocessor(&per_cu, mega, NTHR, SMEM_BYTES);
        if (per_cu > 1) per_cu = 1;
        if (per_cu < 1) per_cu = 1;
        grid_blocks = cus * per_cu;
    }
    Params P{};
    const float** pp = (const float**)&P;
    for (int i = 0; i < 25; ++i) pp[i] = (const float*)d_in[i];
    P.out = (float*)d_out;
    P.bar = (unsigned*)d_ws;
    P.ws = (float*)((char*)d_ws + 16384);
    hipMemsetAsync(d_ws, 0, 16384, stream);
    void* args[] = {&P};
    hipError_t e = hipLaunchCooperativeKernel((const void*)mega, dim3(grid_blocks), dim3(NTHR), args, SMEM_BYTES, stream);
    if (e != hipSuccess) fprintf(stderr, "cooperative launch failed: %s (grid %d)\n", hipGetErrorString(e), grid_blocks);
}
```

```cpp
#include <hip/hip_runtime.h>
#include <stdint.h>
#include <math.h>
#include <cstdio>

#define LAS_ __attribute__((address_space(3)))
namespace {
constexpr int D = 2048, NB = 2, S = 4096, T = NB * S;
constexpr int INC = 6152;
constexpr int C_MIN = 0, C_MV = 1024, C_MO = 2048, C_MI = 3072, C_MF = 3076, C_AQ = 3080, C_AK = 4104, C_AV = 5128;
constexpr float EPS = 1e-6f;
constexpr size_t P6S = (size_t)8192 * 1024;
constexpr int NTHR = 512;
constexpr int HALF_SM_FLOATS = 8704;
constexpr int GEMM_LDS = 131072;
constexpr int SMEM_BYTES = GEMM_LDS + 1024 + 8192;
typedef unsigned short bf16_t;
__device__ __forceinline__ unsigned f2bf(float f) { unsigned u = __float_as_uint(f); u += 0x7FFFu + ((u >> 16) & 1u); return u >> 16; }
__device__ __forceinline__ unsigned pk2(float lo, float hi) { return f2bf(lo) | (f2bf(hi) << 16); }
__device__ __forceinline__ float bf2f(unsigned short b) { return __uint_as_float(((unsigned)b) << 16); }
extern __shared__ __attribute__((aligned(16))) unsigned char smem_raw[];
enum { I_X = 0, I_MEM, I_GMIX, I_WIN, I_CONVW, I_CONVB, I_WMQ, I_WMK, I_BMI, I_BMF, I_GMHEAD, I_GAHEAD, I_WOUT, I_GCROSS, I_GMEM,
       I_WXQ, I_WXK, I_WXV, I_WXO, I_GFFN, I_WPQ, I_SUBK, I_UTAB, I_VTAB, I_GFINAL, I_OUT, I_BAR, I_WS, I_NPTR };
__device__ __forceinline__ unsigned long long ldp_raw(int i) {
    const LAS_ unsigned long long* tab = (const LAS_ unsigned long long*)(LAS_ unsigned char*)(smem_raw + GEMM_LDS + 64);
    const unsigned long long v = tab[i];
    const unsigned lo = __builtin_amdgcn_readfirstlane((unsigned)v), hi = __builtin_amdgcn_readfirstlane((unsigned)(v >> 32));
    return ((unsigned long long)hi << 32) | lo;
}
#define PF(i) ((const float*)ldp_raw(i))

#define XB_TMO      128
#define XB_XCNT(j)  (256  + 64 * (j))
#define XB_XSUB(j)  (1280 + 64 * (j))
#define XB_XGEN(j)  (2304 + 64 * (j))
#define XB_TOP      3328
#define XB_TOPGEN   3392
#define XCD_BAR_WORDS 3456
#define XB_SPIN_CAP (1u << 22)
#define LAS __attribute__((address_space(3)))

__device__ __forceinline__ unsigned xb_ld(unsigned* p)              { return __hip_atomic_load(p, __ATOMIC_RELAXED, __HIP_MEMORY_SCOPE_AGENT); }
__device__ __forceinline__ unsigned xb_add(unsigned* p, unsigned v) { return __hip_atomic_fetch_add(p, v, __ATOMIC_RELAXED, __HIP_MEMORY_SCOPE_AGENT); }
__device__ __forceinline__ unsigned xb_xcc_id() { return (unsigned)__builtin_amdgcn_s_getreg((3 << 11) | 20) & 0xFu; }
#define XB_SPIN(cond, bar) do { unsigned _sp = 0; while (cond) { __builtin_amdgcn_s_sleep(1); \
    if ((++_sp & 255u) == 0u) { if (xb_ld(&(bar)[XB_TMO])) break; if (_sp > XB_SPIN_CAP) { atomicAdd(&(bar)[XB_TMO], 1u); break; } } } } while (0)

struct XcdBarrier { unsigned* bar; unsigned x; volatile LAS unsigned* st; };

__device__ __forceinline__ XcdBarrier xcd_barrier_post(unsigned* bar, volatile LAS unsigned* st) {
    XcdBarrier b; b.bar = bar; b.x = xb_xcc_id(); b.st = st;
    if (threadIdx.x == 0) (void)xb_add(&bar[XB_XCNT(b.x)], 1u);
    return b;
}
__device__ __forceinline__ void xcd_barrier_complete(unsigned* bar, unsigned x, unsigned& nloc, unsigned& nx) {
    const unsigned G = gridDim.x * gridDim.y * gridDim.z;
    unsigned sum, cnt, mine, sp = 0u;
    for (;;) {
        sum = 0u; cnt = 0u; mine = 0u;
#pragma unroll
        for (unsigned j = 0; j < 16; ++j) { const unsigned c = xb_ld(&bar[XB_XCNT(j)]); sum += c; cnt += (c > 0u) ? 1u : 0u; mine = (j == x) ? c : mine; }
        if (sum == G) break;
        __builtin_amdgcn_s_sleep(1);
        if ((++sp & 255u) == 0u) { if (xb_ld(&bar[XB_TMO])) break; if (sp > XB_SPIN_CAP) { atomicAdd(&bar[XB_TMO], 1u); break; } }
    }
    nloc = mine > 0u ? mine : 1u; nx = cnt > 0u ? cnt : 1u;
}
__device__ __forceinline__ void xcd_barrier(const XcdBarrier& b) {
    asm volatile("s_waitcnt vmcnt(0)" ::: "memory");
    __syncthreads();
    if (threadIdx.x == 0) {
        unsigned* bar = b.bar;
        __builtin_amdgcn_s_waitcnt(0);
        unsigned nloc = b.st[0], nx = b.st[1];
        if (nloc == 0u) { xcd_barrier_complete(bar, b.x, nloc, nx); b.st[0] = nloc; b.st[1] = nx; }
        const unsigned old = xb_add(&bar[XB_XSUB(b.x)], 1u);
        const unsigned gen = old / nloc;
        if (old + 1u == (gen + 1u) * nloc) {
            __builtin_amdgcn_fence(__ATOMIC_RELEASE, "agent");
            asm volatile("s_waitcnt vmcnt(0)" ::: "memory");
            const unsigned og = xb_add(&bar[XB_TOP], 1u);
            const unsigned tg = og / nx;
            if (og + 1u == (tg + 1u) * nx) xb_add(&bar[XB_TOPGEN], 1u);
            else XB_SPIN(xb_ld(&bar[XB_TOPGEN]) == tg, bar);
            __builtin_amdgcn_fence(__ATOMIC_ACQUIRE, "agent");
            xb_add(&bar[XB_XGEN(b.x)], 1u);
            asm volatile("s_waitcnt vmcnt(0)" ::: "memory");
        } else {
            XB_SPIN(xb_ld(&bar[XB_XGEN(b.x)]) == gen, bar);
            __builtin_amdgcn_fence(__ATOMIC_ACQUIRE, "agent");
            asm volatile("s_waitcnt vmcnt(0)" ::: "memory");
        }
    }
    __syncthreads();
}

__device__ __forceinline__ float wave_sum(float v) {
#pragma unroll
    for (int o = 32; o >= 1; o >>= 1) v += __shfl_xor(v, o);
    return v;
}
__device__ __forceinline__ float wave_max(float v) {
#pragma unroll
    for (int o = 32; o >= 1; o >>= 1) v = fmaxf(v, __shfl_xor(v, o));
    return v;
}
__device__ __forceinline__ float log_sigmoid(float x) { return fminf(x, 0.f) - log1pf(expf(-fabsf(x))); }


__device__ __forceinline__ void d_rmsnorm(int vb, int t, float* sm, const float* __restrict__ in, const float* __restrict__ g, bf16_t* __restrict__ out,
                                          const float* __restrict__ w_in, float* __restrict__ gpre) {
    float* red = sm;
    const int row = vb;
    const float4* p = (const float4*)(in + (size_t)row * D);
    float4 a = p[t], b = p[t + 256];
    float s = a.x * a.x + a.y * a.y + a.z * a.z + a.w * a.w + b.x * b.x + b.y * b.y + b.z * b.z + b.w * b.w;
    s = wave_sum(s);
    __syncthreads();
    if ((t & 63) == 0) red[t >> 6] = s;
    __syncthreads();
    const float tot = red[0] + red[1] + red[2] + red[3];
    const float r = rsqrtf(tot * (1.0f / D) + EPS);
    const float4* gp = (const float4*)g;
    float4 ga = gp[t], gb = gp[t + 256];
    float hv[8] = {a.x * r * ga.x, a.y * r * ga.y, a.z * r * ga.z, a.w * r * ga.w, b.x * r * gb.x, b.y * r * gb.y, b.z * r * gb.z, b.w * r * gb.w};
    uint2 o0, o1;
    o0.x = pk2(hv[0], hv[1]); o0.y = pk2(hv[2], hv[3]); o1.x = pk2(hv[4], hv[5]); o1.y = pk2(hv[6], hv[7]);
    *(uint2*)(out + (size_t)row * D + t * 4) = o0;
    *(uint2*)(out + (size_t)row * D + 1024 + t * 4) = o1;
    if (gpre) {
        float gs[8];
#pragma unroll
        for (int c = 0; c < 8; ++c) gs[c] = 0.f;
#pragma unroll
        for (int j = 0; j < 8; ++j) {
            const int k = (j < 4) ? (t * 4 + j) : (1024 + t * 4 + (j - 4));
            const float4 w0 = *(const float4*)(w_in + (size_t)k * INC + C_MI), w1 = *(const float4*)(w_in + (size_t)k * INC + C_MI + 4);
            gs[0] = fmaf(hv[j], w0.x, gs[0]); gs[1] = fmaf(hv[j], w0.y, gs[1]); gs[2] = fmaf(hv[j], w0.z, gs[2]); gs[3] = fmaf(hv[j], w0.w, gs[3]);
            gs[4] = fmaf(hv[j], w1.x, gs[4]); gs[5] = fmaf(hv[j], w1.y, gs[5]); gs[6] = fmaf(hv[j], w1.z, gs[6]); gs[7] = fmaf(hv[j], w1.w, gs[7]);
        }
#pragma unroll
        for (int c = 0; c < 8; ++c) gs[c] = wave_sum(gs[c]);
        __syncthreads();
        if ((t & 63) == 0) {
#pragma unroll
            for (int c = 0; c < 8; ++c) red[8 + (t >> 6) * 8 + c] = gs[c];
        }
        __syncthreads();
        if (t < 8) gpre[(size_t)row * 8 + t] = red[8 + t] + red[16 + t] + red[24 + t] + red[32 + t];
    }
}

namespace pg8 {
typedef short bf16x8 __attribute__((ext_vector_type(8)));
typedef float f32x4 __attribute__((ext_vector_type(4)));
constexpr int BM = 256, BK = 64, HALF = 128, HTB = HALF * BK * 2, NXCD = 8, WGM = 8;
__device__ __forceinline__ int lds_byte(int r, int c) { const int st = (r >> 4) * 2 + (c >> 5), rr = r & 15, cc = c & 31, ob = rr * 64 + cc * 2; return st * 1024 + (ob ^ (((ob >> 9) & 1) << 5)); }
__device__ __forceinline__ void stage_rc(int b, int& R, int& C) { const int st = b / 1024, sb = b % 1024, swz = sb ^ (((sb >> 9) & 1) << 5); R = (st >> 1) * 16 + swz / 64; C = (st & 1) * 32 + (swz % 64) / 2; }
struct Unit { int pm, pn; };
struct GJob {
    const bf16_t* A; const bf16_t* Bt;
    int lda, ldb, K, nM, nN;
    int a_pn_shift, a_pn_mask, a_pn_step;
    int b_pm_shift, b_pm_step, b_pn_step;
    int a_pm_step;
    float escale;
    const float* gs; float* denp; const float* qn; const float* gvec; const bf16_t* mo;
    float* C; int ldc; const float* R; int ldr;
    int mode;
};
__device__ __forceinline__ bool unit_next(const GJob& g, int i, Unit& u) {
    const int nwg = g.nM * g.nN;
    const long L = (long)i * gridDim.x + blockIdx.x; if (L >= nwg) return false;
    int wgid = (int)L; { const int q = nwg / NXCD, r = nwg % NXCD, xcd = wgid % NXCD, off = wgid / NXCD; wgid = (xcd < r ? xcd * (q + 1) : r * (q + 1) + (xcd - r) * q) + off; }
    const int nig = WGM * g.nN, gid = wgid / nig, fm = gid * WGM, gsz = (g.nM - fm) < WGM ? (g.nM - fm) : WGM;
    u.pm = fm + ((wgid % nig) % gsz); u.pn = (wgid % nig) / gsz; return true;
}
template <int MODE> __device__ __forceinline__ void epilogue(const GJob& g, f32x4 (&acc)[2][2][4][2], const Unit& u, int wr, int wc, int fr, int fq, LAS unsigned char* xlds) {
    const int row0 = u.pm * BM + wr * 64 + fr;
    if constexpr (MODE == 0) {
        const int col0 = u.pn * BM + wc * 32 + 4 * fq;
#pragma unroll
        for (int ai = 0; ai < 2; ++ai)
#pragma unroll
            for (int m = 0; m < 4; ++m) {
                const int row = row0 + ai * HALF + m * 16;
                float* rowp = g.C + (size_t)row * g.ldc + col0;
                const float* rp = g.R ? g.R + (size_t)row * g.ldr + col0 : nullptr;
#pragma unroll
                for (int bj = 0; bj < 2; ++bj)
#pragma unroll
                    for (int n = 0; n < 2; ++n) {
                        f32x4 v = acc[ai][bj][m][n];
                        if (rp) v = v + *(const f32x4*)(rp + bj * HALF + n * 16);
                        *(f32x4*)(rowp + bj * HALF + n * 16) = v;
                    }
            }
    } else if constexpr (MODE == 6) {
        const int h = u.pn; const size_t t0 = (size_t)u.pm * BM;
        bf16_t* Cb = (bf16_t*)g.C;
#pragma unroll
        for (int ai = 0; ai < 2; ++ai)
#pragma unroll
            for (int m = 0; m < 4; ++m) {
                const int l = ai * HALF + wr * 64 + m * 16 + fr;
                const float M2 = g.gs[((t0 + l) * 4 + h) * 8 + 1];
                bf16_t* rowp = Cb + (t0 + l) * 2048 + h * 512 + wc * 32 + 4 * fq;
                float rs = 0.f;
#pragma unroll
                for (int bj = 0; bj < 2; ++bj)
#pragma unroll
                    for (int n = 0; n < 2; ++n) {
                        const f32x4 a = acc[ai][bj][m][n];
                        const int s0 = bj * HALF + wc * 32 + n * 16 + 4 * fq;
                        float p[4];
#pragma unroll
                        for (int r = 0; r < 4; ++r) { const float u2 = g.gs[((t0 + s0 + r) * 4 + h) * 8 + 0]; p[r] = (s0 + r <= l) ? a[r] * __builtin_amdgcn_exp2f(u2 - M2) : 0.f; rs += p[r]; }
                        uint2 o; o.x = pk2(p[0], p[1]); o.y = pk2(p[2], p[3]);
                        *(uint2*)(rowp + bj * HALF + n * 16) = o;
                    }
                rs += __shfl_xor(rs, 16); rs += __shfl_xor(rs, 32);
                if (fq == 0) g.denp[((t0 + l) * 4 + h) * 4 + wc] = rs;
            }
    } else if constexpr (MODE == 7) {
        float* Ct = g.C + (size_t)(u.pm * 4 + u.pn) * 65536;
        const int col0 = wc * 32 + 4 * fq;
#pragma unroll
        for (int ai = 0; ai < 2; ++ai)
#pragma unroll
            for (int m = 0; m < 4; ++m) {
                float* rowp = Ct + (size_t)(ai * HALF + wr * 64 + m * 16 + fr) * 256 + col0;
#pragma unroll
                for (int bj = 0; bj < 2; ++bj)
#pragma unroll
                    for (int n = 0; n < 2; ++n) *(f32x4*)(rowp + bj * HALF + n * 16) = acc[ai][bj][m][n];
            }
    } else if constexpr (MODE == 8) {
        const int h = u.pn; const size_t t0 = (size_t)u.pm * BM;
        LAS float* X0 = (LAS float*)xlds + wr * 512;
#pragma unroll
        for (int ai = 0; ai < 2; ++ai)
#pragma unroll
            for (int m = 0; m < 4; ++m) {
                const size_t th = (t0 + ai * HALF + wr * 64 + m * 16 + fr) * 4 + h;
                const f32x4 dp = *(const f32x4*)(g.denp + th * 4);
                const float den = (dp[0] + dp[1]) + (dp[2] + dp[3]) + g.gs[th * 8 + 3] * g.qn[th];
                const float rden = 1.0f / fmaxf(fabsf(den), g.gs[th * 8 + 4]);
                float ss = 0.f;
#pragma unroll
                for (int bj = 0; bj < 2; ++bj)
#pragma unroll
                    for (int n = 0; n < 2; ++n) { f32x4 a = acc[ai][bj][m][n] * rden; acc[ai][bj][m][n] = a; ss += (a[0] * a[0] + a[1] * a[1]) + (a[2] * a[2] + a[3] * a[3]); }
                ss += __shfl_xor(ss, 16); ss += __shfl_xor(ss, 32);
                if (fq == 0) X0[(ai * 64 + m * 16 + fr) * 4 + wc] = ss;
            }
        asm volatile("s_waitcnt lgkmcnt(0)" ::: "memory"); __builtin_amdgcn_s_barrier(); asm volatile("" ::: "memory");
        bf16_t* Cb = (bf16_t*)g.C;
        const int col0 = wc * 32 + 4 * fq;
#pragma unroll
        for (int ai = 0; ai < 2; ++ai)
#pragma unroll
            for (int m = 0; m < 4; ++m) {
                const f32x4 p4 = *(const LAS f32x4*)(X0 + (ai * 64 + m * 16 + fr) * 4);
                const float rsn = rsqrtf(((p4[0] + p4[1]) + (p4[2] + p4[3])) * (1.0f / 256.0f) + EPS);
                const size_t t = t0 + ai * HALF + wr * 64 + m * 16 + fr;
                bf16_t* rowp = Cb + t * 2048 + h * 256 + col0;
                const bf16_t* mop = g.mo + t * 1024 + h * 256 + col0;
#pragma unroll
                for (int bj = 0; bj < 2; ++bj)
#pragma unroll
                    for (int n = 0; n < 2; ++n) {
                        const f32x4 a = acc[ai][bj][m][n];
                        const ushort4 mo4 = *(const ushort4*)(mop + bj * HALF + n * 16);
                        const f32x4 gv = *(const f32x4*)(g.gvec + h * 256 + col0 + bj * HALF + n * 16);
                        const float o0 = a[0] * rsn * gv[0] / (1.0f + __expf(-bf2f(mo4.x)));
                        const float o1 = a[1] * rsn * gv[1] / (1.0f + __expf(-bf2f(mo4.y)));
                        const float o2 = a[2] * rsn * gv[2] / (1.0f + __expf(-bf2f(mo4.z)));
                        const float o3 = a[3] * rsn * gv[3] / (1.0f + __expf(-bf2f(mo4.w)));
                        uint2 o; o.x = pk2(o0, o1); o.y = pk2(o2, o3);
                        *(uint2*)(rowp + bj * HALF + n * 16) = o;
                    }
            }
    } else if constexpr (MODE == 5) {
        LAS float* X0 = (LAS float*)xlds + wr * 512;
        LAS float* X1 = (LAS float*)xlds + 1024 + wr * 512;
#pragma unroll
        for (int ai = 0; ai < 2; ++ai)
#pragma unroll
            for (int m = 0; m < 4; ++m) {
                float v = -INFINITY;
#pragma unroll
                for (int bj = 0; bj < 2; ++bj)
#pragma unroll
                    for (int n = 0; n < 2; ++n) { const f32x4 a = acc[ai][bj][m][n]; v = fmaxf(v, fmaxf(fmaxf(a[0], a[1]), fmaxf(a[2], a[3]))); }
                v = fmaxf(v, __shfl_xor(v, 16)); v = fmaxf(v, __shfl_xor(v, 32));
                if (fq == 0) X0[(ai * 64 + m * 16 + fr) * 4 + wc] = v;
            }
        asm volatile("s_waitcnt lgkmcnt(0)" ::: "memory"); __builtin_amdgcn_s_barrier(); asm volatile("" ::: "memory");
#pragma unroll
        for (int ai = 0; ai < 2; ++ai)
#pragma unroll
            for (int m = 0; m < 4; ++m) {
                const f32x4 p4 = *(const LAS f32x4*)(X0 + (ai * 64 + m * 16 + fr) * 4);
                const float mxr = fmaxf(fmaxf(p4[0], p4[1]), fmaxf(p4[2], p4[3])) * g.escale;
                float s = 0.f;
#pragma unroll
                for (int bj = 0; bj < 2; ++bj)
#pragma unroll
                    for (int n = 0; n < 2; ++n) { f32x4 a = acc[ai][bj][m][n];
                        a[0] = __builtin_amdgcn_exp2f(a[0] * g.escale - mxr); a[1] = __builtin_amdgcn_exp2f(a[1] * g.escale - mxr); a[2] = __builtin_amdgcn_exp2f(a[2] * g.escale - mxr); a[3] = __builtin_amdgcn_exp2f(a[3] * g.escale - mxr);
                        acc[ai][bj][m][n] = a; s += (a[0] + a[1]) + (a[2] + a[3]); }
                s += __shfl_xor(s, 16); s += __shfl_xor(s, 32);
                if (fq == 0) X1[(ai * 64 + m * 16 + fr) * 4 + wc] = s;
            }
        asm volatile("s_waitcnt lgkmcnt(0)" ::: "memory"); __builtin_amdgcn_s_barrier(); asm volatile("" ::: "memory");
        bf16_t* Cb = (bf16_t*)g.C;
        const int col0 = u.pn * BM + wc * 32 + 4 * fq;
#pragma unroll
        for (int ai = 0; ai < 2; ++ai)
#pragma unroll
            for (int m = 0; m < 4; ++m) {
                const f32x4 p4 = *(const LAS f32x4*)(X1 + (ai * 64 + m * 16 + fr) * 4);
                const float inv = 1.0f / ((p4[0] + p4[1]) + (p4[2] + p4[3]));
                bf16_t* rowp = Cb + (size_t)(row0 + ai * HALF + m * 16) * g.ldc + col0;
#pragma unroll
                for (int bj = 0; bj < 2; ++bj)
#pragma unroll
                    for (int n = 0; n < 2; ++n) {
                        const f32x4 a = acc[ai][bj][m][n];
                        uint2 o; o.x = pk2(a[0] * inv, a[1] * inv); o.y = pk2(a[2] * inv, a[3] * inv);
                        *(uint2*)(rowp + bj * HALF + n * 16) = o;
                    }
            }
    } else {
        bf16_t* Cb = (bf16_t*)g.C; int ccol = u.pn * BM;
        if constexpr (MODE == 4) { Cb += (size_t)(u.pn >> 2) * P6S; ccol = (u.pn & 3) * 256; }
        const int col0 = ccol + wc * 32 + 4 * fq;
#pragma unroll
        for (int ai = 0; ai < 2; ++ai)
#pragma unroll
            for (int m = 0; m < 4; ++m) {
                bf16_t* rowp = Cb + (size_t)(row0 + ai * HALF + m * 16) * g.ldc + col0;
#pragma unroll
                for (int bj = 0; bj < 2; ++bj)
#pragma unroll
                    for (int n = 0; n < 2; ++n) {
                        const f32x4 v = acc[ai][bj][m][n];
                        uint2 o; o.x = pk2(v[0], v[1]); o.y = pk2(v[2], v[3]);
                        *(uint2*)(rowp + bj * HALF + n * 16) = o;
                    }
            }
    }
}
template <int MODE> __device__ __forceinline__ void gemm_phase(LAS unsigned char* lds, const GJob& g, int tid) {
    const int wid = __builtin_amdgcn_readfirstlane(tid >> 6), lane = tid & 63, wr = wid >> 2, wc = wid & 3, fr = lane & 15, fq = lane >> 4;
    const int K = g.K, nt = K / BK;
    unsigned voffA[2], voffB[2];
#pragma unroll
    for (int i = 0; i < 2; ++i) { int R, C; stage_rc(tid * 16 + i * 8192, R, C);
        voffA[i] = (unsigned)(R * g.lda + C) * 2u; voffB[i] = (unsigned)(R * g.ldb + C) * 2u; }
    const size_t kstep = (size_t)(BK * 2);
    const size_t hstepA = (size_t)HALF * g.lda * 2, hstepB = (size_t)HALF * g.ldb * 2;
    const unsigned ldsw = (unsigned)wid * 1024u;
    const int aoff = lds_byte(wr * 64 + fr, fq * 8), boff = lds_byte(wc * 32 + fr, fq * 8);
#define PG8_SA(b, h) (((b) * 2 + (h)) * HTB)
#define PG8_SB(b, h) ((4 + (b) * 2 + (h)) * HTB)
#define PG8_STAGE(bufoff, gbase, voff) do { _Pragma("unroll") for (int _i = 0; _i < 2; ++_i) \
        __builtin_amdgcn_global_load_lds((const unsigned*)((const char*)(gbase) + (voff)[_i]), (LAS unsigned*)(lds + (bufoff) + ldsw + _i * 8192), 16, 0, 0); } while (0)
#define PG8_LDA(dst, b, h) do { _Pragma("unroll") for (int m = 0; m < 4; ++m) _Pragma("unroll") for (int k = 0; k < 2; ++k) dst[m][k] = *(const LAS bf16x8*)(lds + PG8_SA(b, h) + aoff + m * 2048 + k * 1024); } while (0)
#define PG8_LDB(dst, b, h) do { _Pragma("unroll") for (int n = 0; n < 2; ++n) _Pragma("unroll") for (int k = 0; k < 2; ++k) dst[n][k] = *(const LAS bf16x8*)(lds + PG8_SB(b, h) + boff + n * 2048 + k * 1024); } while (0)
#define PG8_MMA(ai, bj, At, Bt) do { __builtin_amdgcn_s_setprio(1); _Pragma("unroll") for (int m = 0; m < 4; ++m) _Pragma("unroll") for (int n = 0; n < 2; ++n) _Pragma("unroll") for (int k = 0; k < 2; ++k) \
        acc[ai][bj][m][n] = __builtin_amdgcn_mfma_f32_16x16x32_bf16(Bt[n][k], At[m][k], acc[ai][bj][m][n], 0, 0, 0); __builtin_amdgcn_s_setprio(0); } while (0)
#define PG8_WAIT_V(n) asm volatile("s_waitcnt vmcnt(" #n ")" ::: "memory")
#define PG8_WAIT_L(n) asm volatile("s_waitcnt lgkmcnt(" #n ")" ::: "memory")
#define PG8_BAR __builtin_amdgcn_s_barrier()
#define PG8_SCHED __builtin_amdgcn_sched_barrier(0)
#define PG8_ABASE(u) ((const char*)g.A + ((size_t)(u).pm * g.a_pm_step + (size_t)(((u).pn >> g.a_pn_shift) & g.a_pn_mask) * g.a_pn_step) * 2)
#define PG8_BBASE(u) ((const char*)g.Bt + ((size_t)(u).pn * g.b_pn_step + (size_t)((u).pm >> g.b_pm_shift) * g.b_pm_step) * 2)
    Unit cur, nxt; int ui = 0;
    if (!unit_next(g, 0, cur)) return;
    f32x4 acc[2][2][4][2];
#pragma unroll
    for (int a = 0; a < 2; ++a)
#pragma unroll
        for (int b = 0; b < 2; ++b)
#pragma unroll
            for (int m = 0; m < 4; ++m)
#pragma unroll
                for (int n = 0; n < 2; ++n) acc[a][b][m][n] = (f32x4){0.f, 0.f, 0.f, 0.f};
    bf16x8 At[4][2], B0[2][2], B1[2][2];
    const char* cA = PG8_ABASE(cur); const char* cB = PG8_BBASE(cur);
    PG8_STAGE(PG8_SB(0, 0), cB, voffB); PG8_STAGE(PG8_SA(0, 0), cA, voffA); PG8_STAGE(PG8_SB(0, 1), cB + hstepB, voffB); PG8_STAGE(PG8_SA(0, 1), cA + hstepA, voffA);
    if (wr == 1) PG8_BAR;
    PG8_WAIT_V(4); PG8_BAR;
    PG8_STAGE(PG8_SB(1, 0), cB + kstep, voffB); PG8_STAGE(PG8_SA(1, 0), cA + kstep, voffA); PG8_STAGE(PG8_SB(1, 1), cB + hstepB + kstep, voffB);
    PG8_WAIT_V(6); PG8_BAR;
    for (;;) {
        const bool has_next = unit_next(g, ui + 1, nxt);
        const char* nA = has_next ? PG8_ABASE(nxt) : cA; const char* nB = has_next ? PG8_BBASE(nxt) : cB;
        for (int t = 0; t < nt; t += 2) {
            const bool last = (t == nt - 2);
            const char* a1 = cA + (size_t)(t + 1) * kstep;
            const char* a2 = last ? nA : cA + (size_t)(t + 2) * kstep; const char* b2 = last ? nB : cB + (size_t)(t + 2) * kstep;
            const char* a3 = a2 + kstep; const char* b3 = b2 + kstep;
            PG8_LDB(B0, 0, 0); PG8_SCHED; PG8_LDA(At, 0, 0); PG8_STAGE(PG8_SA(1, 1), a1 + hstepA, voffA);
            PG8_WAIT_L(8); PG8_BAR; PG8_WAIT_L(0); PG8_MMA(0, 0, At, B0); PG8_BAR; PG8_SCHED;
            PG8_LDB(B1, 0, 1); PG8_STAGE(PG8_SB(0, 0), b2, voffB);
            PG8_BAR; PG8_WAIT_L(0); PG8_MMA(0, 1, At, B1); PG8_BAR;
            PG8_LDA(At, 0, 1); PG8_STAGE(PG8_SA(0, 0), a2, voffA);
            PG8_BAR; PG8_WAIT_L(0); PG8_MMA(1, 0, At, B0); PG8_BAR; PG8_SCHED;
            PG8_STAGE(PG8_SB(0, 1), b2 + hstepB, voffB);
            PG8_WAIT_V(6); PG8_BAR; PG8_MMA(1, 1, At, B1); PG8_BAR;
            PG8_LDB(B0, 1, 0); PG8_SCHED; PG8_LDA(At, 1, 0); PG8_STAGE(PG8_SA(0, 1), a2 + hstepA, voffA);
            PG8_WAIT_L(8); PG8_BAR; PG8_WAIT_L(0); PG8_MMA(0, 0, At, B0); PG8_BAR; PG8_SCHED;
            PG8_LDB(B1, 1, 1); PG8_STAGE(PG8_SB(1, 0), b3, voffB);
            PG8_BAR; PG8_WAIT_L(0); PG8_MMA(0, 1, At, B1); PG8_BAR;
            PG8_LDA(At, 1, 1); PG8_STAGE(PG8_SA(1, 0), a3, voffA);
            PG8_BAR; PG8_WAIT_L(0); PG8_MMA(1, 0, At, B0); PG8_BAR; PG8_SCHED;
            PG8_STAGE(PG8_SB(1, 1), b3 + hstepB, voffB);
            PG8_WAIT_V(6); PG8_BAR; PG8_MMA(1, 1, At, B1); PG8_BAR;
        }
        epilogue<MODE>(g, acc, cur, wr, wc, fr, fq, lds + GEMM_LDS + 1024);
        if (!has_next) break;
#pragma unroll
        for (int a = 0; a < 2; ++a)
#pragma unroll
            for (int b = 0; b < 2; ++b)
#pragma unroll
                for (int m = 0; m < 4; ++m)
#pragma unroll
                    for (int n = 0; n < 2; ++n) acc[a][b][m][n] = (f32x4){0.f, 0.f, 0.f, 0.f};
        cur = nxt; cA = nA; cB = nB; ++ui;
    }
    PG8_WAIT_V(0);
    if (wr == 0) PG8_BAR;
    PG8_BAR;
#undef PG8_SA
#undef PG8_SB
#undef PG8_STAGE
#undef PG8_LDA
#undef PG8_LDB
#undef PG8_MMA
#undef PG8_WAIT_V
#undef PG8_WAIT_L
#undef PG8_BAR
#undef PG8_SCHED
#undef PG8_ABASE
#undef PG8_BBASE
}
}

__device__ __forceinline__ void p0_transpose_item(const float* W, int ldw, int K, int csrc0, bf16_t* WT, int row0, LAS float* scr, int kb, int lane, float wscale) {
    const int k0 = 64 * kb;
#pragma unroll 8
    for (int i = 0; i < 32; ++i) { const int kk = 2 * i + (lane >> 5); scr[kk * 33 + (lane & 31)] = W[(size_t)(k0 + kk) * ldw + csrc0 + (lane & 31)] * wscale; }
    asm volatile("s_waitcnt lgkmcnt(0)" ::: "memory");
    const int c = lane & 7;
#pragma unroll
    for (int j = 0; j < 4; ++j) { const int n = (lane >> 3) + 8 * j; const LAS float* s = scr + (8 * c) * 33 + n;
        uint4 o; o.x = pk2(s[0 * 33], s[1 * 33]); o.y = pk2(s[2 * 33], s[3 * 33]); o.z = pk2(s[4 * 33], s[5 * 33]); o.w = pk2(s[6 * 33], s[7 * 33]);
        *(uint4*)(WT + (size_t)(row0 + n) * K + k0 + 8 * c) = o; }
    asm volatile("s_waitcnt lgkmcnt(0)" ::: "memory");
}

__device__ __forceinline__ void d_conv_silu(int vb, int tid, const bf16_t* __restrict__ p6, const float* __restrict__ cw, const float* __restrict__ cb, bf16_t* __restrict__ c) {
    const int t = vb, s = t % S;
    for (int ch = tid; ch < 1024; ch += 256) {
        float y = cb[ch];
#pragma unroll
        for (int j = 0; j < 4; ++j) {
            const int ss = s - 3 + j;
            if (ss >= 0) y = fmaf(cw[j * 1024 + ch], bf2f(p6[(size_t)(t - 3 + j) * 1024 + ch]), y);
        }
        c[(size_t)t * 1024 + ch] = (bf16_t)f2bf(y / (1.0f + expf(-y)));
    }
}

__device__ __forceinline__ void d_mlstm(int vb, int tid, const bf16_t* __restrict__ mq, const bf16_t* __restrict__ mk, const bf16_t* __restrict__ p6,
                                        const float* __restrict__ gpre, const float* __restrict__ b_mi, const float* __restrict__ b_mf, float* __restrict__ hraw) {
    const int lane = tid & 63, w = tid >> 6;
    const int gid = vb * 4 + w;
    const int e = gid & 255, h = (gid >> 8) & 3, b = gid >> 10;
    const float bi = b_mi[h], bf = b_mf[h];
    float C0 = 0.f, C1 = 0.f, C2 = 0.f, C3 = 0.f, n0 = 0.f, n1 = 0.f, n2 = 0.f, n3 = 0.f, m = 0.f;
    const size_t tb = (size_t)b * S;
    const bf16_t* qp = mq + tb * 1024 + h * 256 + lane * 4;
    const bf16_t* kp = mk + tb * 1024 + h * 256 + lane * 4;
    const bf16_t* pp = p6 + P6S + tb * 1024 + h * 256 + e;
    ushort4 qn = *(const ushort4*)qp, kn = *(const ushort4*)kp;
    const float* gp = gpre + tb * 8;
    float vn = bf2f(pp[0]), in_ = gp[h], fn = gp[4 + h];
    for (int s = 0; s < S; ++s) {
        const float4 q = make_float4(bf2f(qn.x), bf2f(qn.y), bf2f(qn.z), bf2f(qn.w)), k = make_float4(bf2f(kn.x), bf2f(kn.y), bf2f(kn.z), bf2f(kn.w)); const float v = vn, ipre = in_ + bi, fpre = fn + bf;
        if (s + 1 < S) {
            qn = *(const ushort4*)(qp + (size_t)(s + 1) * 1024);
            kn = *(const ushort4*)(kp + (size_t)(s + 1) * 1024);
            vn = bf2f(pp[(size_t)(s + 1) * 1024]); in_ = gp[(size_t)(s + 1) * 8 + h]; fn = gp[(size_t)(s + 1) * 8 + 4 + h];
        }
        const float logf = log_sigmoid(fpre);
        const float mnew = fmaxf(logf + m, ipre);
        const float fd = expf(logf + m - mnew), ig = expf(ipre - mnew);
        m = mnew;
        const float sc = ig * 0.0625f;
        C0 = fd * C0 + sc * k.x * v; C1 = fd * C1 + sc * k.y * v; C2 = fd * C2 + sc * k.z * v; C3 = fd * C3 + sc * k.w * v;
        n0 = fd * n0 + sc * k.x; n1 = fd * n1 + sc * k.y; n2 = fd * n2 + sc * k.z; n3 = fd * n3 + sc * k.w;
        float num = q.x * C0 + q.y * C1 + q.z * C2 + q.w * C3;
        float den = q.x * n0 + q.y * n1 + q.z * n2 + q.w * n3;
        num = wave_sum(num); den = wave_sum(den);
        if (lane == 0) hraw[(tb + s) * 1024 + h * 256 + e] = num / fmaxf(fabsf(den), expf(-mnew));
    }
}

__device__ __forceinline__ void d_mhead_norm(int vb, int tid, const float* __restrict__ hraw, const bf16_t* __restrict__ p6, const float* __restrict__ g, bf16_t* __restrict__ mix) {
    const int t = vb, h = tid >> 6, lane = tid & 63;
    const float4 v = *(const float4*)(hraw + (size_t)t * 1024 + h * 256 + lane * 4);
    float s = v.x * v.x + v.y * v.y + v.z * v.z + v.w * v.w;
    s = wave_sum(s);
    const float r = rsqrtf(s * (1.0f / 256.0f) + EPS);
    const float4 gg = *(const float4*)(g + h * 256 + lane * 4);
    const ushort4 mo = *(const ushort4*)(p6 + 2 * P6S + (size_t)t * 1024 + h * 256 + lane * 4);
    float4 o;
    o.x = v.x * r * gg.x / (1.0f + expf(-bf2f(mo.x)));
    o.y = v.y * r * gg.y / (1.0f + expf(-bf2f(mo.y)));
    o.z = v.z * r * gg.z / (1.0f + expf(-bf2f(mo.z)));
    o.w = v.w * r * gg.w / (1.0f + expf(-bf2f(mo.w)));
    uint2 ob; ob.x = pk2(o.x, o.y); ob.y = pk2(o.z, o.w);
    *(uint2*)(mix + (size_t)t * D + h * 256 + lane * 4) = ob;
}

__device__ __forceinline__ void d_rope(int vb, int tid, bf16_t* __restrict__ p6) {
    const int t = vb, s = t % S;
    for (int idx = tid; idx < 2 * 8 * 64; idx += 256) {
        const int i = idx & 63, hd = (idx >> 6) & 7, qk = idx >> 9;
        const float inv = exp2f(-(float)i * 0.20762050593046014f);
        const float ang = (float)s * inv;
        float sn, cs; sincosf(ang, &sn, &cs);
        bf16_t* p = p6 + (size_t)(3 + qk) * P6S + (size_t)t * 1024 + hd * 128;
        const float x1 = bf2f(p[i]), x2 = bf2f(p[64 + i]);
        p[i] = (bf16_t)f2bf(x1 * cs - x2 * sn);
        p[64 + i] = (bf16_t)f2bf(x2 * cs + x1 * sn);
    }
}

__device__ __forceinline__ void d_dilated(int vb, int tid, float* sm, const bf16_t* __restrict__ p6, const float* __restrict__ g_ahead, bf16_t* __restrict__ mix) {
    float (*qs)[128] = (float (*)[128])sm;
    float (*ps)[576] = (float (*)[576])(sm + 512);
    const int lane = tid & 63, w = tid >> 6;
    const int gid = vb * 4 + w;
    const int s = gid % S, hd = (gid / S) & 7, b = gid / (S * 8);
    const size_t t = (size_t)b * S + s;
    const bf16_t* qrow = p6 + 3 * P6S + t * 1024 + hd * 128;
    __syncthreads();
    qs[w][lane] = bf2f(qrow[lane]); qs[w][lane + 64] = bf2f(qrow[lane + 64]);
    __syncthreads();
    const float scale = 0.08838834764831845f;
    float mloc = -INFINITY;
    for (int br = 0; br < 3; ++br) {
        const int dil = br == 0 ? 1 : (br == 1 ? 4 : 16);
        for (int jj = 0; jj < 192; jj += 64) {
            const int j = jj + lane;
            float sc = -INFINITY;
            if (j <= 128 && s - j * dil >= 0) {
                const bf16_t* krow = p6 + 4 * P6S + (t - (size_t)j * dil) * 1024 + hd * 128;
                float d = 0.f;
#pragma unroll 8
                for (int c = 0; c < 128; c += 4) {
                    const ushort4 kv = *(const ushort4*)(krow + c);
                    d = fmaf(qs[w][c], bf2f(kv.x), d); d = fmaf(qs[w][c + 1], bf2f(kv.y), d); d = fmaf(qs[w][c + 2], bf2f(kv.z), d); d = fmaf(qs[w][c + 3], bf2f(kv.w), d);
                }
                sc = d * scale;
            }
            ps[w][br * 192 + j] = sc;
            mloc = fmaxf(mloc, sc);
        }
    }
    const float mx = wave_max(mloc);
    __syncthreads();
    float lsum = 0.f;
    for (int i = lane; i < 3 * 192; i += 64) {
        const float sc = ps[w][i];
        const float pv = (sc == -INFINITY) ? 0.f : expf(sc - mx);
        ps[w][i] = pv; lsum += pv;
    }
    const float tot = wave_sum(lsum);
    __syncthreads();
    float o0 = 0.f, o1 = 0.f;
    for (int br = 0; br < 3; ++br) {
        const int dil = br == 0 ? 1 : (br == 1 ? 4 : 16);
        for (int j = 0; j <= 128; ++j) {
            if (s - j * dil < 0) break;
            const float pv = ps[w][br * 192 + j];
            const bf16_t* vrow = p6 + 5 * P6S + (t - (size_t)j * dil) * 1024 + hd * 128;
            o0 = fmaf(pv, bf2f(vrow[lane]), o0); o1 = fmaf(pv, bf2f(vrow[lane + 64]), o1);
        }
    }
    o0 /= tot; o1 /= tot;
    float ss = wave_sum(o0 * o0 + o1 * o1);
    const float r = rsqrtf(ss * (1.0f / 128.0f) + EPS);
    bf16_t* orow = mix + t * D + 1024 + hd * 128;
    orow[lane] = (bf16_t)f2bf(o0 * r * g_ahead[hd * 128 + lane]);
    orow[lane + 64] = (bf16_t)f2bf(o1 * r * g_ahead[hd * 128 + lane + 64]);
}

__device__ __forceinline__ void d_cross(int vb, int tid, float* sm, const bf16_t* __restrict__ q, const float* __restrict__ km, const float* __restrict__ vm, bf16_t* __restrict__ o) {
    float (*qs)[512] = (float (*)[512])sm;
    float (*ps)[256] = (float (*)[256])(sm + 2048);
    const int lane = tid & 63, w = tid >> 6;
    const int t = vb, hd = w, b = t / S;
    const bf16_t* qrow = q + (size_t)t * D + hd * 512;
    __syncthreads();
    for (int i = lane; i < 512; i += 64) qs[w][i] = bf2f(qrow[i]);
    __syncthreads();
    const float scale = 0.04419417382415922f;
    float sc[4]; float mloc = -INFINITY;
#pragma unroll
    for (int r = 0; r < 4; ++r) {
        const int mi = lane + 64 * r;
        const float* krow = km + ((size_t)b * 256 + mi) * D + hd * 512;
        float d = 0.f;
#pragma unroll 8
        for (int c = 0; c < 512; c += 4) {
            const float4 kv = *(const float4*)(krow + c);
            d = fmaf(qs[w][c], kv.x, d); d = fmaf(qs[w][c + 1], kv.y, d); d = fmaf(qs[w][c + 2], kv.z, d); d = fmaf(qs[w][c + 3], kv.w, d);
        }
        sc[r] = d * scale; mloc = fmaxf(mloc, sc[r]);
    }
    const float mx = wave_max(mloc);
    float lsum = 0.f;
#pragma unroll
    for (int r = 0; r < 4; ++r) { const float pv = expf(sc[r] - mx); ps[w][lane + 64 * r] = pv; lsum += pv; }
    const float tot = wave_sum(lsum);
    __syncthreads();
    float acc[8];
#pragma unroll
    for (int i = 0; i < 8; ++i) acc[i] = 0.f;
    for (int mi = 0; mi < 256; ++mi) {
        const float pv = ps[w][mi];
        const float* vrow = vm + ((size_t)b * 256 + mi) * D + hd * 512;
#pragma unroll
        for (int i = 0; i < 8; ++i) acc[i] = fmaf(pv, vrow[lane + 64 * i], acc[i]);
    }
    bf16_t* orow = o + (size_t)t * D + hd * 512;
#pragma unroll
    for (int i = 0; i < 8; ++i) orow[lane + 64 * i] = (bf16_t)f2bf(acc[i] / tot);
}

__device__ __forceinline__ void wave_argmax(float& best, int& bidx) {
#pragma unroll
    for (int o = 32; o >= 1; o >>= 1) {
        const float ob = __shfl_xor(best, o); const int oi = __shfl_xor(bidx, o);
        if (ob > best || (ob == best && oi < bidx)) { best = ob; bidx = oi; }
    }
}
__device__ __forceinline__ void d_peer_topk(int vb, int tid, float* sm, const bf16_t* __restrict__ qp, const float* __restrict__ sub_keys, int* __restrict__ ids, float* __restrict__ gates) {
    float (*qs)[256] = (float (*)[256])sm;
    const int lane = tid & 63, w = tid >> 6;
    const int gid = vb * 4 + w;
    const int hd = gid & 7, t = gid >> 3;
    const bf16_t* qrow = qp + (size_t)t * D + hd * 256;
    __syncthreads();
    for (int i = lane; i < 256; i += 64) qs[w][i] = bf2f(qrow[i]);
    __syncthreads();
    float tops[2]; int topi[2];
#pragma unroll
    for (int p = 0; p < 2; ++p) {
        float v0, v1;
        {
            const float* k0 = sub_keys + ((size_t)(hd * 2 + p) * 128 + lane) * 128;
            const float* k1 = k0 + 64 * 128;
            float d0 = 0.f, d1 = 0.f;
#pragma unroll 8
            for (int c = 0; c < 128; c += 4) {
                const float4 a = *(const float4*)(k0 + c), bb = *(const float4*)(k1 + c);
                const float q0 = qs[w][p * 128 + c], q1 = qs[w][p * 128 + c + 1], q2 = qs[w][p * 128 + c + 2], q3 = qs[w][p * 128 + c + 3];
                d0 = fmaf(q0, a.x, d0); d0 = fmaf(q1, a.y, d0); d0 = fmaf(q2, a.z, d0); d0 = fmaf(q3, a.w, d0);
                d1 = fmaf(q0, bb.x, d1); d1 = fmaf(q1, bb.y, d1); d1 = fmaf(q2, bb.z, d1); d1 = fmaf(q3, bb.w, d1);
            }
            v0 = d0; v1 = d1;
        }
        float ts = 0.f; int ti = 0;
        for (int it = 0; it < 16; ++it) {
            float best; int bidx;
            if (v0 >= v1) { best = v0; bidx = lane; } else { best = v1; bidx = lane + 64; }
            wave_argmax(best, bidx);
            if (lane == it) { ts = best; ti = bidx; }
            if (bidx == lane) v0 = -INFINITY;
            if (bidx == lane + 64) v1 = -INFINITY;
        }
        tops[p] = ts; topi[p] = ti;
    }
    float cv[4]; int ci[4];
#pragma unroll
    for (int r = 0; r < 4; ++r) {
        const int c = lane * 4 + r, i = c >> 4, j = c & 15;
        const float s0 = __shfl(tops[0], i), s1 = __shfl(tops[1], j);
        const int i0 = __shfl(topi[0], i), i1 = __shfl(topi[1], j);
        cv[r] = s0 + s1; ci[r] = i0 * 128 + i1;
    }
    float bs = 0.f; int bid = 0;
    for (int it = 0; it < 16; ++it) {
        float best = cv[0]; int bidx = lane * 4;
#pragma unroll
        for (int r = 1; r < 4; ++r) if (cv[r] > best) { best = cv[r]; bidx = lane * 4 + r; }
        wave_argmax(best, bidx);
        const int owner = bidx >> 2, rr = bidx & 3;
        int myid = ci[0];
        if (rr == 1) myid = ci[1]; else if (rr == 2) myid = ci[2]; else if (rr == 3) myid = ci[3];
        const int eid = __shfl(myid, owner);
        if (lane == it) { bs = best; bid = eid; }
        if (owner == lane) {
#pragma unroll
            for (int r = 0; r < 4; ++r) if (rr == r) cv[r] = -INFINITY;
        }
    }
    float v = lane < 16 ? bs : -INFINITY;
    const float mx = wave_max(v);
    const float ev = lane < 16 ? expf(bs - mx) : 0.f;
    const float tot = wave_sum(ev);
    if (lane < 16) {
        ids[(size_t)t * 128 + hd * 16 + lane] = bid;
        gates[(size_t)t * 128 + hd * 16 + lane] = ev / tot;
    }
}

__device__ __forceinline__ void d_peer_out(int vb, int tid, float* sm, const bf16_t* __restrict__ h3, const float* __restrict__ x2, const int* __restrict__ ids, const float* __restrict__ gates,
                                           const bf16_t* __restrict__ u_tab, const bf16_t* __restrict__ v_tab, const float* __restrict__ g_final, float* __restrict__ out) {
    float (*part)[2048] = (float (*)[2048])sm;
    float* red = sm + 4 * 2048;
    const int lane = tid & 63, w = tid >> 6, t = vb;
    float4 xr[8], acc[8];
    const bf16_t* hrow = h3 + (size_t)t * D;
#pragma unroll
    for (int i = 0; i < 8; ++i) { const ushort4 hv = *(const ushort4*)(hrow + i * 256 + lane * 4);
        xr[i] = make_float4(bf2f(hv.x), bf2f(hv.y), bf2f(hv.z), bf2f(hv.w)); acc[i] = make_float4(0.f, 0.f, 0.f, 0.f); }
    for (int j = 0; j < 32; ++j) {
        const int slot = w * 32 + j;
        const int e = ids[(size_t)t * 128 + slot];
        const float gt = gates[(size_t)t * 128 + slot];
        const bf16_t* ur = u_tab + (size_t)e * D;
        const bf16_t* vr = v_tab + (size_t)e * D;
        float d = 0.f;
#pragma unroll
        for (int i = 0; i < 8; ++i) {
            const ushort4 u = *(const ushort4*)(ur + i * 256 + lane * 4);
            d = fmaf(xr[i].x, bf2f(u.x), d); d = fmaf(xr[i].y, bf2f(u.y), d); d = fmaf(xr[i].z, bf2f(u.z), d); d = fmaf(xr[i].w, bf2f(u.w), d);
        }
        d = wave_sum(d);
        const float act = 0.5f * d * (1.0f + erff(d * 0.7071067811865476f));
        const float cf = gt * act;
#pragma unroll
        for (int i = 0; i < 8; ++i) {
            const ushort4 v = *(const ushort4*)(vr + i * 256 + lane * 4);
            acc[i].x = fmaf(cf, bf2f(v.x), acc[i].x); acc[i].y = fmaf(cf, bf2f(v.y), acc[i].y); acc[i].z = fmaf(cf, bf2f(v.z), acc[i].z); acc[i].w = fmaf(cf, bf2f(v.w), acc[i].w);
        }
    }
    __syncthreads();
#pragma unroll
    for (int i = 0; i < 8; ++i) *(float4*)&part[w][i * 256 + lane * 4] = acc[i];
    __syncthreads();
    float4 r0, r1;
    {
        const float4 a = *(const float4*)&part[0][tid * 4], b = *(const float4*)&part[1][tid * 4], c = *(const float4*)&part[2][tid * 4], d = *(const float4*)&part[3][tid * 4];
        const float4 x = *(const float4*)(x2 + (size_t)t * D + tid * 4);
        r0 = make_float4(x.x + a.x + b.x + c.x + d.x, x.y + a.y + b.y + c.y + d.y, x.z + a.z + b.z + c.z + d.z, x.w + a.w + b.w + c.w + d.w);
    }
    {
        const float4 a = *(const float4*)&part[0][1024 + tid * 4], b = *(const float4*)&part[1][1024 + tid * 4], c = *(const float4*)&part[2][1024 + tid * 4], d = *(const float4*)&part[3][1024 + tid * 4];
        const float4 x = *(const float4*)(x2 + (size_t)t * D + 1024 + tid * 4);
        r1 = make_float4(x.x + a.x + b.x + c.x + d.x, x.y + a.y + b.y + c.y + d.y, x.z + a.z + b.z + c.z + d.z, x.w + a.w + b.w + c.w + d.w);
    }
    float s = r0.x * r0.x + r0.y * r0.y + r0.z * r0.z + r0.w * r0.w + r1.x * r1.x + r1.y * r1.y + r1.z * r1.z + r1.w * r1.w;
    s = wave_sum(s);
    if (lane == 0) red[w] = s;
    __syncthreads();
    const float tot = red[0] + red[1] + red[2] + red[3];
    const float r = rsqrtf(tot * (1.0f / D) + EPS);
    const float4 g0 = *(const float4*)(g_final + tid * 4), g1 = *(const float4*)(g_final + 1024 + tid * 4);
    *(float4*)(out + (size_t)t * D + tid * 4) = make_float4(r0.x * r * g0.x, r0.y * r * g0.y, r0.z * r * g0.z, r0.w * r * g0.w);
    *(float4*)(out + (size_t)t * D + 1024 + tid * 4) = make_float4(r1.x * r * g1.x, r1.y * r * g1.y, r1.z * r * g1.z, r1.w * r * g1.w);
}


__device__ __forceinline__ float wave_incl_scan_add(float v, int lane) {
#pragma unroll
    for (int o = 1; o < 64; o <<= 1) { const float t = __shfl_up(v, o); if (lane >= o) v += t; }
    return v;
}
__device__ __forceinline__ float wave_incl_scan_max(float v, int lane) {
#pragma unroll
    for (int o = 1; o < 64; o <<= 1) { const float t = __shfl_up(v, o); if (lane >= o) v = fmaxf(v, t); }
    return v;
}
__device__ __forceinline__ void mlstm_gates_wave(int b, int h, int lane, const float* __restrict__ gpre, const float* __restrict__ b_mi, const float* __restrict__ b_mf,
                                                 float* __restrict__ gs, float* __restrict__ decay) {
    const float bi = b_mi[h], bf = b_mf[h];
    float mprev = 0.f;
    for (int c = 0; c < 16; ++c) {
        const size_t t0 = (size_t)b * S + c * 256 + lane * 4;
        float logi[4], lf[4], bb[4];
#pragma unroll
        for (int j = 0; j < 4; ++j) { logi[j] = gpre[(t0 + j) * 8 + h] + bi; lf[j] = log_sigmoid(gpre[(t0 + j) * 8 + 4 + h] + bf); }
        bb[0] = lf[0]; bb[1] = bb[0] + lf[1]; bb[2] = bb[1] + lf[2]; bb[3] = bb[2] + lf[3];
        const float incl = wave_incl_scan_add(bb[3], lane);
        const float excl = incl - bb[3];
#pragma unroll
        for (int j = 0; j < 4; ++j) bb[j] += excl;
        const float g = __shfl(incl, 63);
        float amax = -INFINITY, uu[4], cm[4];
#pragma unroll
        for (int j = 0; j < 4; ++j) { amax = fmaxf(amax, logi[j] + g - bb[j]); uu[j] = logi[j] - bb[j]; }
        amax = wave_max(amax);
        const float mnew = fmaxf(g + mprev, amax);
        cm[0] = uu[0]; cm[1] = fmaxf(cm[0], uu[1]); cm[2] = fmaxf(cm[1], uu[2]); cm[3] = fmaxf(cm[2], uu[3]);
        const float cincl = wave_incl_scan_max(cm[3], lane);
        float cexcl = __shfl_up(cincl, 1); if (lane == 0) cexcl = -INFINITY;
#pragma unroll
        for (int j = 0; j < 4; ++j) {
            const float M = fmaxf(mprev, fmaxf(cexcl, cm[j]));
            float* o = gs + ((t0 + j) * 4 + h) * 8;
            o[0] = uu[j] * 1.4426950408889634f; o[1] = M * 1.4426950408889634f; o[2] = expf(logi[j] + g - bb[j] - mnew); o[3] = expf(mprev - M); o[4] = expf(-(bb[j] + M));
        }
        if (lane == 0) decay[(b * 16 + c) * 4 + h] = expf(g + mprev - mnew);
        mprev = mnew;
    }
}
__device__ __forceinline__ void transpose_tile64(int tid, float* sm, const bf16_t* __restrict__ src, int src_ld, bf16_t* __restrict__ dst, int dst_ld, const float* __restrict__ scale, int sstride) {
    unsigned short (*tl)[66] = (unsigned short (*)[66])sm;
    __syncthreads();
#pragma unroll
    for (int i = 0; i < 2; ++i) {
        const int ch = tid + i * 256, r = ch >> 3, c8 = (ch & 7) * 8;
        const uint4 v = *(const uint4*)(src + (size_t)r * src_ld + c8);
        const float sc = scale ? scale[(size_t)r * sstride] : 1.0f;
        const unsigned w[4] = {v.x, v.y, v.z, v.w};
#pragma unroll
        for (int k = 0; k < 4; ++k) {
            tl[r][c8 + 2 * k] = (unsigned short)f2bf(bf2f((unsigned short)(w[k] & 0xFFFFu)) * sc);
            tl[r][c8 + 2 * k + 1] = (unsigned short)f2bf(bf2f((unsigned short)(w[k] >> 16)) * sc);
        }
    }
    __syncthreads();
#pragma unroll
    for (int i = 0; i < 2; ++i) {
        const int ch = tid + i * 256, c = ch >> 3, r8 = (ch & 7) * 8;
        uint4 o;
        o.x = (unsigned)tl[r8 + 0][c] | ((unsigned)tl[r8 + 1][c] << 16); o.y = (unsigned)tl[r8 + 2][c] | ((unsigned)tl[r8 + 3][c] << 16);
        o.z = (unsigned)tl[r8 + 4][c] | ((unsigned)tl[r8 + 5][c] << 16); o.w = (unsigned)tl[r8 + 6][c] | ((unsigned)tl[r8 + 7][c] << 16);
        *(uint4*)(dst + (size_t)c * dst_ld + r8) = o;
    }
}

typedef short bf16x8_t __attribute__((ext_vector_type(8)));
typedef short bf16x4_t __attribute__((ext_vector_type(4)));
typedef float f32x4_t __attribute__((ext_vector_type(4)));
__device__ __forceinline__ void dilated_wave_tile(int qt, int lane, const bf16_t* __restrict__ AQ, const bf16_t* __restrict__ AK, const bf16_t* __restrict__ VT,
                                                  const float* __restrict__ g_ahead, bf16_t* __restrict__ mix) {
    const int r = qt & 15, blk = (qt >> 4) & 15, hd = (qt >> 8) & 7, b = qt >> 11;
    const int j = lane & 15, g = lane >> 4;
    const int t0 = blk * 256;
    const int sq = t0 + r + 16 * j;
    bf16x8_t qf[4];
    {
        const bf16_t* qrow = AQ + ((size_t)b * S + sq) * 1024 + hd * 128 + 8 * g;
#pragma unroll
        for (int ks = 0; ks < 4; ++ks) qf[ks] = *(const bf16x8_t*)(qrow + 32 * ks);
    }
    const float sc = 0.08838834764831845f * 1.4426950408889634f;
    float m_run = -1e30f, l_run = 0.f;
    f32x4_t o[8];
#pragma unroll
    for (int dt = 0; dt < 8; ++dt) o[dt] = (f32x4_t){0.f, 0.f, 0.f, 0.f};
#pragma nounroll
    for (int br = 0; br < 3; ++br) {
        const int ld = 2 * br, d = 1 << ld;
        const int rho = r & (d - 1);
        const int qj = (sq - rho) >> ld;
        const int q_lo = ((t0 + r - rho) >> ld) - 128, q_hi = (t0 + r + 240 - rho) >> ld;
        const int tile_lo = q_lo < 0 ? 0 : (q_lo >> 4), tile_hi = q_hi >> 4, tile_max = (256 >> ld) - 1;
        const bf16_t* vtb = VT + (size_t)br * ((size_t)1024 * 8192) + (size_t)(hd * 128 + j) * 8192 + (size_t)b * 4096 + (size_t)rho * (4096 >> ld) + 4 * g;
#pragma nounroll
        for (int tp = tile_lo; tp <= tile_hi; tp += 2) {
            f32x4_t su[2];
#pragma unroll
            for (int u = 0; u < 2; ++u) {
                int tl = tp + u; if (tl > tile_max) tl = tile_max;
                const int pos = rho + ((16 * tl + j) << ld);
                const bf16_t* krow = AK + ((size_t)b * S + pos) * 1024 + hd * 128 + 8 * g;
                f32x4_t a = (f32x4_t){0.f, 0.f, 0.f, 0.f};
#pragma unroll
                for (int ks = 0; ks < 4; ++ks) a = __builtin_amdgcn_mfma_f32_16x16x32_bf16(*(const bf16x8_t*)(krow + 32 * ks), qf[ks], a, 0, 0, 0);
                su[u] = a;
            }
            float p[2][4]; float mx = -1e30f;
#pragma unroll
            for (int u = 0; u < 2; ++u)
#pragma unroll
                for (int e = 0; e < 4; ++e) {
                    const int n = qj - (16 * (tp + u) + 4 * g + e);
                    const bool valid = (n >= 0) && (n <= 128);
                    p[u][e] = valid ? su[u][e] * sc : -1e30f;
                    mx = fmaxf(mx, p[u][e]);
                }
            mx = fmaxf(mx, __shfl_xor(mx, 16)); mx = fmaxf(mx, __shfl_xor(mx, 32));
            const float m_new = fmaxf(m_run, mx);
            const float alpha = __builtin_amdgcn_exp2f(m_run - m_new);
            m_run = m_new;
            float ps = 0.f;
#pragma unroll
            for (int u = 0; u < 2; ++u)
#pragma unroll
                for (int e = 0; e < 4; ++e) { p[u][e] = (p[u][e] > -1e29f) ? __builtin_amdgcn_exp2f(p[u][e] - m_new) : 0.f; ps += p[u][e]; }
            l_run = l_run * alpha + ps;
            bf16x8_t pb;
            {
                const unsigned w0 = pk2(p[0][0], p[0][1]), w1 = pk2(p[0][2], p[0][3]), w2 = pk2(p[1][0], p[1][1]), w3 = pk2(p[1][2], p[1][3]);
                pb[0] = (short)(w0 & 0xFFFF); pb[1] = (short)(w0 >> 16); pb[2] = (short)(w1 & 0xFFFF); pb[3] = (short)(w1 >> 16);
                pb[4] = (short)(w2 & 0xFFFF); pb[5] = (short)(w2 >> 16); pb[6] = (short)(w3 & 0xFFFF); pb[7] = (short)(w3 >> 16);
            }
            int tl0 = tp, tl1 = tp + 1; if (tl0 > tile_max) tl0 = tile_max; if (tl1 > tile_max) tl1 = tile_max;
#pragma unroll
            for (int dt = 0; dt < 8; ++dt) {
                const bf16_t* vrow = vtb + (size_t)dt * (16 * 8192);
                const bf16x4_t v0 = *(const bf16x4_t*)(vrow + 16 * tl0), v1 = *(const bf16x4_t*)(vrow + 16 * tl1);
                bf16x8_t va; va[0] = v0[0]; va[1] = v0[1]; va[2] = v0[2]; va[3] = v0[3]; va[4] = v1[0]; va[5] = v1[1]; va[6] = v1[2]; va[7] = v1[3];
                f32x4_t oo = o[dt]; oo = oo * alpha;
                o[dt] = __builtin_amdgcn_mfma_f32_16x16x32_bf16(va, pb, oo, 0, 0, 0);
            }
        }
    }
    float lt = l_run; lt += __shfl_xor(lt, 16); lt += __shfl_xor(lt, 32);
    const float inv = 1.0f / lt;
    float ss = 0.f;
#pragma unroll
    for (int dt = 0; dt < 8; ++dt) { o[dt] = o[dt] * inv; ss += (o[dt][0] * o[dt][0] + o[dt][1] * o[dt][1]) + (o[dt][2] * o[dt][2] + o[dt][3] * o[dt][3]); }
    ss += __shfl_xor(ss, 16); ss += __shfl_xor(ss, 32);
    const float rn = rsqrtf(ss * (1.0f / 128.0f) + EPS);
    bf16_t* orow = mix + ((size_t)b * S + sq) * D + 1024 + hd * 128 + 4 * g;
#pragma unroll
    for (int dt = 0; dt < 8; ++dt) {
        const f32x4_t gv = *(const f32x4_t*)(g_ahead + hd * 128 + 16 * dt + 4 * g);
        uint2 w; w.x = pk2(o[dt][0] * rn * gv[0], o[dt][1] * rn * gv[1]); w.y = pk2(o[dt][2] * rn * gv[2], o[dt][3] * rn * gv[3]);
        *(uint2*)(orow + 16 * dt) = w;
    }
}

__device__ __forceinline__ unsigned ord_key(float s) { const unsigned u = __float_as_uint(s); return u ^ ((unsigned)((int)u >> 31) | 0x80000000u); }
__device__ __forceinline__ unsigned wave_max_u32(unsigned v) {
#pragma unroll
    for (int o = 32; o >= 1; o >>= 1) { const unsigned t = (unsigned)__shfl_xor((int)v, o); v = v > t ? v : t; }
    return v;
}
__device__ __forceinline__ void peer_topk_wave(int item, int lane, LAS float* wl, const bf16_t* __restrict__ qp, const bf16_t* __restrict__ skb, int* __restrict__ ids, float* __restrict__ gates) {
    const int hd = item & 7, tt = item >> 3, j = lane & 15, g = lane >> 4;
    const size_t t0 = (size_t)tt * 16;
    LAS float* sc = wl;
    LAS float* lst = wl + 2048;
#pragma unroll 1
    for (int p = 0; p < 2; ++p) {
        bf16x8_t qf[4];
        const bf16_t* qrow = qp + (t0 + j) * D + hd * 256 + p * 128 + 8 * g;
#pragma unroll
        for (int ks = 0; ks < 4; ++ks) qf[ks] = *(const bf16x8_t*)(qrow + 32 * ks);
        const bf16_t* kb = skb + ((size_t)(hd * 2 + p) * 128 + j) * 128 + 8 * g;
#pragma unroll
        for (int kt = 0; kt < 8; ++kt) {
            f32x4_t a = (f32x4_t){0.f, 0.f, 0.f, 0.f};
#pragma unroll
            for (int ks = 0; ks < 4; ++ks) a = __builtin_amdgcn_mfma_f32_16x16x32_bf16(*(const bf16x8_t*)(kb + (size_t)kt * (16 * 128) + 32 * ks), qf[ks], a, 0, 0, 0);
            *(LAS f32x4_t*)(sc + j * 128 + 16 * kt + 4 * g) = a;
        }
        asm volatile("s_waitcnt lgkmcnt(0)" ::: "memory");
#pragma unroll 1
        for (int tok = 0; tok < 16; ++tok) {
            const float s0 = sc[tok * 128 + lane], s1 = sc[tok * 128 + 64 + lane];
            unsigned k0 = (ord_key(s0) & ~127u) | (unsigned)(127 - lane), k1 = (ord_key(s1) & ~127u) | (unsigned)(63 - lane);
            unsigned sel = 0u;
#pragma unroll 4
            for (int it = 0; it < 16; ++it) {
                unsigned m = k0 > k1 ? k0 : k1;
                m = wave_max_u32(m);
                if (lane == it) sel = m;
                if (k0 == m) k0 = 0u;
                if (k1 == m) k1 = 0u;
            }
            if (lane < 16) {
                const int idx = 127 - (int)(sel & 127u);
                lst[((p * 16 + tok) * 16 + lane) * 2 + 0] = sc[tok * 128 + idx];
                lst[((p * 16 + tok) * 16 + lane) * 2 + 1] = __int_as_float(idx);
            }
        }
        asm volatile("s_waitcnt lgkmcnt(0)" ::: "memory");
    }
#pragma unroll 1
    for (int tok = 0; tok < 16; ++tok) {
        const int i = lane >> 2;
        const float sA = lst[((0 * 16 + tok) * 16 + i) * 2];
        unsigned kk[4];
#pragma unroll
        for (int r = 0; r < 4; ++r) {
            const int jb = (lane & 3) * 4 + r;
            const float sum = sA + lst[((1 * 16 + tok) * 16 + jb) * 2];
            kk[r] = (ord_key(sum) & ~255u) | (unsigned)(255 - (lane * 4 + r));
        }
        unsigned sel = 0u;
#pragma unroll 4
        for (int it = 0; it < 16; ++it) {
            unsigned m = kk[0] > kk[1] ? kk[0] : kk[1]; const unsigned m2 = kk[2] > kk[3] ? kk[2] : kk[3]; m = m > m2 ? m : m2;
            m = wave_max_u32(m);
            if (lane == it) sel = m;
#pragma unroll
            for (int r = 0; r < 4; ++r) if (kk[r] == m) kk[r] = 0u;
        }
        float bs = -INFINITY; int eid = 0;
        if (lane < 16) {
            const int c = 255 - (int)(sel & 255u), ia = c >> 4, ib = c & 15;
            bs = lst[((0 * 16 + tok) * 16 + ia) * 2] + lst[((1 * 16 + tok) * 16 + ib) * 2];
            eid = __float_as_int(lst[((0 * 16 + tok) * 16 + ia) * 2 + 1]) * 128 + __float_as_int(lst[((1 * 16 + tok) * 16 + ib) * 2 + 1]);
        }
        const float mx = wave_max(bs);
        const float ev = lane < 16 ? __expf(bs - mx) : 0.f;
        const float tot = wave_sum(ev);
        if (lane < 16) {
            ids[(t0 + tok) * 128 + hd * 16 + lane] = eid;
            gates[(t0 + tok) * 128 + hd * 16 + lane] = ev / tot;
        }
    }
}

typedef float f32x2_t __attribute__((ext_vector_type(2)));
__device__ __forceinline__ void table_row_to_fp8(const float* __restrict__ srow, unsigned char* __restrict__ drow, float* __restrict__ rscale, int lane) {
    float4 f[8];
#pragma unroll
    for (int i = 0; i < 8; ++i) f[i] = *(const float4*)(srow + lane * 32 + i * 4);
    float am = 0.f;
#pragma unroll
    for (int i = 0; i < 8; ++i) am = fmaxf(am, fmaxf(fmaxf(fabsf(f[i].x), fabsf(f[i].y)), fmaxf(fabsf(f[i].z), fabsf(f[i].w))));
    am = wave_max(am);
    const float e = floorf(log2f(448.0f / fmaxf(am, 1e-30f)));
    const float s = exp2f(fminf(e, 100.0f));
    unsigned w[8];
#pragma unroll
    for (int i = 0; i < 8; ++i) {
        int t = 0;
        t = __builtin_amdgcn_cvt_pk_fp8_f32(f[i].x * s, f[i].y * s, t, false);
        t = __builtin_amdgcn_cvt_pk_fp8_f32(f[i].z * s, f[i].w * s, t, true);
        w[i] = (unsigned)t;
    }
    *(uint4*)(drow + lane * 32) = make_uint4(w[0], w[1], w[2], w[3]);
    *(uint4*)(drow + lane * 32 + 16) = make_uint4(w[4], w[5], w[6], w[7]);
    if (lane == 0) *rscale = 1.0f / s;
}
__device__ __forceinline__ float dot16_fp8(const uint4 q, const float* x) {
    float d = 0.f;
    const unsigned w[4] = {q.x, q.y, q.z, q.w};
#pragma unroll
    for (int k = 0; k < 4; ++k) {
        const f32x2_t lo = __builtin_amdgcn_cvt_pk_f32_fp8((int)w[k], false), hi = __builtin_amdgcn_cvt_pk_f32_fp8((int)w[k], true);
        d = fmaf(lo.x, x[4 * k], d); d = fmaf(lo.y, x[4 * k + 1], d); d = fmaf(hi.x, x[4 * k + 2], d); d = fmaf(hi.y, x[4 * k + 3], d);
    }
    return d;
}
__device__ __forceinline__ void axpy16_fp8(const uint4 q, float c, float* acc) {
    const unsigned w[4] = {q.x, q.y, q.z, q.w};
#pragma unroll
    for (int k = 0; k < 4; ++k) {
        const f32x2_t lo = __builtin_amdgcn_cvt_pk_f32_fp8((int)w[k], false), hi = __builtin_amdgcn_cvt_pk_f32_fp8((int)w[k], true);
        acc[4 * k] = fmaf(c, lo.x, acc[4 * k]); acc[4 * k + 1] = fmaf(c, lo.y, acc[4 * k + 1]); acc[4 * k + 2] = fmaf(c, hi.x, acc[4 * k + 2]); acc[4 * k + 3] = fmaf(c, hi.y, acc[4 * k + 3]);
    }
}
__device__ __forceinline__ void d_peer_out8(int vb, int tid, float* sm, const bf16_t* __restrict__ h3, const float* __restrict__ x2, const int* __restrict__ ids, const float* __restrict__ gates,
                                            const unsigned char* __restrict__ ut8, const unsigned char* __restrict__ vt8, const float* __restrict__ rsc, const float* __restrict__ g_final, float* __restrict__ out) {
    float (*part)[2048] = (float (*)[2048])sm;
    float* red = sm + 4 * 2048;
    const int lane = tid & 63, w = tid >> 6, t = vb;
    float x[32], acc[32];
    {
        const bf16_t* hrow = h3 + (size_t)t * D + lane * 16;
#pragma unroll
        for (int hh = 0; hh < 2; ++hh) {
            const uint4 a = *(const uint4*)(hrow + hh * 1024), b = *(const uint4*)(hrow + hh * 1024 + 8);
            const unsigned ww[8] = {a.x, a.y, a.z, a.w, b.x, b.y, b.z, b.w};
#pragma unroll
            for (int k = 0; k < 8; ++k) { x[hh * 16 + 2 * k] = __uint_as_float(ww[k] << 16); x[hh * 16 + 2 * k + 1] = __uint_as_float(ww[k] & 0xFFFF0000u); }
        }
#pragma unroll
        for (int i = 0; i < 32; ++i) acc[i] = 0.f;
    }
    const int myid = ids[(size_t)t * 128 + w * 32 + (lane & 31)];
    const float mygate = gates[(size_t)t * 128 + w * 32 + (lane & 31)];
#pragma unroll 1
    for (int j = 0; j < 32; j += 4) {
        int e[4]; uint4 uq[4][2], vq[4][2];
#pragma unroll
        for (int q = 0; q < 4; ++q) {
            e[q] = __builtin_amdgcn_readfirstlane(__shfl(myid, j + q));
            const unsigned char* ur = ut8 + (size_t)e[q] * 2048 + lane * 16;
            uq[q][0] = *(const uint4*)ur; uq[q][1] = *(const uint4*)(ur + 1024);
        }
#pragma unroll
        for (int q = 0; q < 4; ++q) {
            const unsigned char* vr = vt8 + (size_t)e[q] * 2048 + lane * 16;
            vq[q][0] = *(const uint4*)vr; vq[q][1] = *(const uint4*)(vr + 1024);
        }
        float d[4];
#pragma unroll
        for (int q = 0; q < 4; ++q) d[q] = dot16_fp8(uq[q][0], x) + dot16_fp8(uq[q][1], x + 16);
#pragma unroll
        for (int o = 32; o >= 1; o >>= 1) {
#pragma unroll
            for (int q = 0; q < 4; ++q) d[q] += __shfl_xor(d[q], o);
        }
#pragma unroll
        for (int q = 0; q < 4; ++q) {
            const float a = d[q] * rsc[e[q]];
            const float act = 0.5f * a * (1.0f + erff(a * 0.7071067811865476f));
            const float cf = __shfl(mygate, j + q) * act * rsc[16384 + e[q]];
            axpy16_fp8(vq[q][0], cf, acc); axpy16_fp8(vq[q][1], cf, acc + 16);
        }
    }
    __syncthreads();
#pragma unroll
    for (int hh = 0; hh < 2; ++hh)
#pragma unroll
        for (int k = 0; k < 4; ++k) *(float4*)&part[w][hh * 1024 + lane * 16 + 4 * k] = make_float4(acc[hh * 16 + 4 * k], acc[hh * 16 + 4 * k + 1], acc[hh * 16 + 4 * k + 2], acc[hh * 16 + 4 * k + 3]);
    __syncthreads();
    float4 r0, r1;
    {
        const float4 a = *(const float4*)&part[0][tid * 4], b = *(const float4*)&part[1][tid * 4], c = *(const float4*)&part[2][tid * 4], dd = *(const float4*)&part[3][tid * 4];
        const float4 xx = *(const float4*)(x2 + (size_t)t * D + tid * 4);
        r0 = make_float4(xx.x + a.x + b.x + c.x + dd.x, xx.y + a.y + b.y + c.y + dd.y, xx.z + a.z + b.z + c.z + dd.z, xx.w + a.w + b.w + c.w + dd.w);
    }
    {
        const float4 a = *(const float4*)&part[0][1024 + tid * 4], b = *(const float4*)&part[1][1024 + tid * 4], c = *(const float4*)&part[2][1024 + tid * 4], dd = *(const float4*)&part[3][1024 + tid * 4];
        const float4 xx = *(const float4*)(x2 + (size_t)t * D + 1024 + tid * 4);
        r1 = make_float4(xx.x + a.x + b.x + c.x + dd.x, xx.y + a.y + b.y + c.y + dd.y, xx.z + a.z + b.z + c.z + dd.z, xx.w + a.w + b.w + c.w + dd.w);
    }
    float s = r0.x * r0.x + r0.y * r0.y + r0.z * r0.z + r0.w * r0.w + r1.x * r1.x + r1.y * r1.y + r1.z * r1.z + r1.w * r1.w;
    s = wave_sum(s);
    if (lane == 0) red[w] = s;
    __syncthreads();
    const float tot = red[0] + red[1] + red[2] + red[3];
    const float r = rsqrtf(tot * (1.0f / D) + EPS);
    const float4 g0 = *(const float4*)(g_final + tid * 4), g1 = *(const float4*)(g_final + 1024 + tid * 4);
    *(float4*)(out + (size_t)t * D + tid * 4) = make_float4(r0.x * r * g0.x, r0.y * r * g0.y, r0.z * r * g0.z, r0.w * r * g0.w);
    *(float4*)(out + (size_t)t * D + 1024 + tid * 4) = make_float4(r1.x * r * g1.x, r1.y * r * g1.y, r1.z * r * g1.z, r1.w * r * g1.w);
}

struct Params {
    const float *x, *mem, *g_mix, *w_in, *conv_w, *conv_b, *w_mq, *w_mk, *b_mi, *b_mf, *g_mhead, *g_ahead, *w_out, *g_cross, *g_mem,
                *w_xq, *w_xk, *w_xv, *w_xo, *g_ffn, *w_pq, *sub_keys, *u_tab, *v_tab, *g_final;
    float* out;
    unsigned* bar;
    float* ws;
};

#define PHASE_LOOP(nvb) for (int base_ = blockIdx.x * 2; base_ < (nvb); base_ += gridDim.x * 2)
#define VB (base_ + half)

__global__ void __launch_bounds__(NTHR) mega(Params P) {
    volatile LAS unsigned* st = (volatile LAS unsigned*)(LAS unsigned char*)(smem_raw + GEMM_LDS);
    if (threadIdx.x == 0) { st[0] = 0u; st[1] = 0u; st[2] = 0u; st[3] = 0u; }
    if (threadIdx.x < I_NPTR) ((LAS unsigned long long*)(LAS unsigned char*)(smem_raw + GEMM_LDS + 64))[threadIdx.x] = ((const unsigned long long*)&P)[threadIdx.x];
    __syncthreads();
    XcdBarrier xb = xcd_barrier_post((unsigned*)ldp_raw(I_BAR), st);

    constexpr size_t TD = (size_t)T * D;
    constexpr size_t O_HB = 6 * P6S * 2, O_CBUF = O_HB + (size_t)T * D * 2, O_MQ = O_CBUF + (size_t)T * 1024 * 2, O_MK = O_MQ + (size_t)T * 1024 * 2,
                     O_MIXB = O_MK + (size_t)T * 1024 * 2, O_WIN = O_MIXB + (size_t)T * D * 2, O_WOUT = O_WIN + (size_t)6144 * D * 2, O_WXQ = O_WOUT + (size_t)D * D * 2,
                     O_WXK = O_WXQ + (size_t)D * D * 2, O_WXV = O_WXK + (size_t)D * D * 2, O_WXO = O_WXV + (size_t)D * D * 2, O_WPQ = O_WXO + (size_t)D * D * 2,
                     O_WQK = O_WPQ + (size_t)D * D * 2, O_GPRE = O_WQK + (size_t)8 * 256 * 256 * 2, O_UT = O_GPRE + (size_t)T * 8 * 4, O_VT = O_UT + (size_t)16384 * D, O_RSC = O_VT + (size_t)16384 * D,
                     O_BH = O_RSC + (size_t)32768 * 4, O_GS = O_BH + (size_t)128 * 256 * 512 * 2, O_DENP = O_GS + (size_t)T * 4 * 8 * 4, O_QN = O_DENP + (size_t)T * 4 * 4 * 4,
                     O_DN = O_QN + (size_t)T * 4 * 4, O_DECAY = O_DN + (size_t)128 * 256 * 4, O_VT3 = O_DECAY + 4096, O_SKB = O_VT3 + (size_t)3 * 1024 * 8192 * 2, O_END = O_SKB + (size_t)262144 * 2;
    static_assert(O_END + 16384 <= (size_t)536870912, "workspace overflow");
#define W_P6    ((bf16_t*)wsb)
#define W_HB    ((bf16_t*)(wsb + O_HB))
#define W_CBUF  ((bf16_t*)(wsb + O_CBUF))
#define W_MQ    ((bf16_t*)(wsb + O_MQ))
#define W_MK    ((bf16_t*)(wsb + O_MK))
#define W_MIXB  ((bf16_t*)(wsb + O_MIXB))
#define W_GPRE  ((float*)(wsb + O_GPRE))
#define W_HRAW  ((float*)(wsb + O_HB))
#define W_XR    ((float*)wsb)
#define W_MN    ((bf16_t*)((float*)wsb + TD))
#define W_KM    ((bf16_t*)((float*)wsb + TD + (size_t)256 * D))
#define W_VMT   ((bf16_t*)((float*)wsb + TD + (size_t)768 * D))
#define W_PX    ((bf16_t*)(wsb + O_MK))
#define W_GATES ((float*)wsb + TD + (size_t)1280 * D)
#define W_IDS   ((int*)((float*)wsb + TD + (size_t)1280 * D + (size_t)T * 128))
#define W_QX    ((bf16_t*)(wsb + O_CBUF))
#define W_BH    ((bf16_t*)(wsb + O_BH))
#define W_VT3   ((bf16_t*)(wsb + O_VT3))
#define W_SKB   ((bf16_t*)(wsb + O_SKB))
#define W_GS    ((float*)(wsb + O_GS))
#define W_DENP  ((float*)(wsb + O_DENP))
#define W_QN    ((float*)(wsb + O_QN))
#define W_DN    ((float*)(wsb + O_DN))
#define W_DECAY ((float*)(wsb + O_DECAY))
#define W_PQ    ((bf16_t*)(wsb + O_HB))
#define W_KWT   ((bf16_t*)(wsb + O_CBUF))
#define W_DC    ((float*)(wsb + 3 * P6S * 2))
#define W_UT    ((unsigned char*)(wsb + O_UT))
#define W_VT    ((unsigned char*)(wsb + O_VT))
#define W_RSC   ((float*)(wsb + O_RSC))
#define PH_BEGIN() int tidx = threadIdx.x; asm volatile("" : "+v"(tidx)); const int half = tidx >> 8, tid = tidx & 255; float* sm = (float*)smem_raw + half * HALF_SM_FLOATS; \
                   char* wsb = (char*)ldp_raw(I_WS); (void)half; (void)tid; (void)sm; (void)wsb
#define GJOB_DEFAULT(g) pg8::GJob g; g.lda = D; g.ldb = D; g.K = D; g.nM = 32; g.nN = 8; g.a_pm_step = 256 * D; g.a_pn_shift = 0; g.a_pn_mask = 0; g.a_pn_step = 0; g.b_pm_shift = 0; g.b_pm_step = 0; g.b_pn_step = 256 * D; \
                        g.ldc = D; g.R = nullptr; g.ldr = D; g.mode = 0; g.escale = 1.0f; g.gs = nullptr; g.denp = nullptr; g.qn = nullptr; g.gvec = nullptr; g.mo = nullptr
#define GEMM_LDSP ((LAS unsigned char*)smem_raw)

    {
        PH_BEGIN();
        {
            LAS float* scr = (LAS float*)(LAS unsigned char*)(smem_raw) + (tidx >> 6) * (64 * 33);
            const int lane = tidx & 63;
            const int gw = blockIdx.x * 8 + (tidx >> 6), NGW = gridDim.x * 8;
            constexpr int I_IN = 32 * 192, I_SQ = 32 * 64, I_QK = 8 * 4 * 8;
            constexpr int NITEMS = I_IN + 6 * I_SQ + I_QK;
#pragma nounroll
            for (int it = gw; it < NITEMS; it += NGW) {
                const float* W; int ldw, K, csrc0, row0, kb; bf16_t* WT; float wscale = 1.0f;
                int r = it;
                if (r < I_IN) { const int nb = r % 192; kb = r / 192; W = PF(I_WIN); ldw = INC; K = D; csrc0 = nb * 32 + (nb >= 96 ? 8 : 0); WT = (bf16_t*)(wsb + O_WIN); row0 = nb * 32; }
                else if ((r -= I_IN) < 6 * I_SQ) {
                    const int wsel = r / I_SQ; r -= wsel * I_SQ; const int nb = r % 64; kb = r / 64; ldw = D; K = D; csrc0 = nb * 32; row0 = nb * 32;
                    W = PF(wsel == 0 ? I_WOUT : wsel == 1 ? I_WXQ : wsel == 2 ? I_WXK : wsel == 3 ? I_WXV : wsel == 4 ? I_WXO : I_WPQ);
                    WT = (bf16_t*)(wsb + O_WOUT + (size_t)wsel * ((size_t)D * D * 2));
                } else {
                    r -= 6 * I_SQ; const int hq = r / 32; r -= hq * 32; const int nb = r % 8; kb = r / 8;
                    W = PF(hq < 4 ? I_WMQ : I_WMK) + (size_t)(hq & 3) * 65536; ldw = 256; K = 256; csrc0 = nb * 32; WT = (bf16_t*)(wsb + O_WQK); row0 = hq * 256 + nb * 32;
                    if (hq >= 4) wscale = 0.0625f;
                }
                p0_transpose_item(W, ldw, K, csrc0, WT, row0, scr, kb, lane, wscale);
            }
            {
                const float* ut = PF(I_UTAB); const float* vt = PF(I_VTAB);
#pragma nounroll
                for (int row = gw; row < 32768; row += NGW) {
                    const bool second = row >= 16384; const int rr = second ? row - 16384 : row;
                    table_row_to_fp8((second ? vt : ut) + (size_t)rr * D, (second ? W_VT : W_UT) + (size_t)rr * D, W_RSC + row, lane);
                }
            }
            {
                const float* sk = PF(I_SUBK);
#pragma nounroll
                for (int i = blockIdx.x * NTHR + tidx; i < 262144 / 8; i += gridDim.x * NTHR) {
                    const float4 a = *(const float4*)(sk + (size_t)i * 8), b = *(const float4*)(sk + (size_t)i * 8 + 4);
                    uint4 o; o.x = pk2(a.x, a.y); o.y = pk2(a.z, a.w); o.z = pk2(b.x, b.y); o.w = pk2(b.z, b.w);
                    *(uint4*)(W_SKB + (size_t)i * 8) = o;
                }
            }
            __syncthreads();
        }
        { const float* rin = PF(I_X); const float* rg = PF(I_GMIX); const float* win = PF(I_WIN);
#pragma nounroll
          PHASE_LOOP(T) d_rmsnorm(VB, tid, sm, rin, rg, W_HB, win, W_GPRE); }
    }
    xcd_barrier(xb);
    {
        PH_BEGIN();
        GJOB_DEFAULT(g); g.A = W_HB; g.Bt = (bf16_t*)(wsb + O_WIN); g.nN = 24; g.C = (float*)W_P6; g.ldc = 1024;
        pg8::gemm_phase<4>(GEMM_LDSP, g, tidx);
    }
    xcd_barrier(xb);
    {
        PH_BEGIN();
        const float* cw = PF(I_CONVW); const float* cb = PF(I_CONVB);
#pragma nounroll
        PHASE_LOOP(T) d_conv_silu(VB, tid, W_P6, cw, cb, W_CBUF);
#pragma nounroll
        PHASE_LOOP(T) d_rope(VB, tid, W_P6);
        if (blockIdx.x < 8 && tidx < 64) mlstm_gates_wave(blockIdx.x >> 2, blockIdx.x & 3, tidx, W_GPRE, PF(I_BMI), PF(I_BMF), W_GS, W_DECAY);
#pragma nounroll
        PHASE_LOOP(2048) { const int it = VB, lt = it & 3, et = (it >> 2) & 3, h = (it >> 4) & 3, cg = it >> 6;
            transpose_tile64(tid, sm, W_P6 + P6S + (size_t)(cg * 256 + lt * 64) * 1024 + h * 256 + et * 64, 1024, W_BH + ((size_t)(cg * 4 + h) * 256 + et * 64) * 512 + lt * 64, 512, nullptr, 0); }
#pragma nounroll
        PHASE_LOOP(6144) { const int br = VB >> 11, it = VB & 2047, ld = 2 * br, dimt = it & 15, rest = it >> 4, b = rest >> 6, x = rest & 63, rho = x >> (6 - ld), qt = x & ((64 >> ld) - 1);
            transpose_tile64(tid, sm, W_P6 + 5 * P6S + ((size_t)b * S + rho + ((size_t)(64 * qt) << ld)) * 1024 + dimt * 64, 1024 << ld,
                             W_VT3 + (size_t)br * ((size_t)1024 * 8192) + (size_t)(dimt * 64) * 8192 + (size_t)b * 4096 + (size_t)rho * (4096 >> ld) + qt * 64, 8192, nullptr, 0); }
    }
    xcd_barrier(xb);
    {
        PH_BEGIN();
        {
            GJOB_DEFAULT(g); g.A = W_CBUF; g.lda = 1024; g.a_pm_step = 256 * 1024; g.Bt = (bf16_t*)(wsb + O_WQK); g.ldb = 256; g.b_pn_step = 256 * 256; g.K = 256; g.a_pn_mask = 3; g.a_pn_step = 256; g.C = (float*)W_MQ; g.ldc = 1024;
            pg8::gemm_phase<4>(GEMM_LDSP, g, tidx);
            __syncthreads();
        }
        const float* ga = PF(I_GAHEAD);
#pragma nounroll
        for (int qt = blockIdx.x * 8 + (tidx >> 6); qt < 4096; qt += gridDim.x * 8) dilated_wave_tile(qt, tidx & 63, W_P6 + 3 * P6S, W_P6 + 4 * P6S, W_VT3, ga, W_MIXB);
    }
    xcd_barrier(xb);
    {
        PH_BEGIN();
#pragma nounroll
        PHASE_LOOP(2048) { const int it = VB, lt = it & 3, dt = (it >> 2) & 3, h = (it >> 4) & 3, cg = it >> 6;
            transpose_tile64(tid, sm, W_MK + (size_t)(cg * 256 + lt * 64) * 1024 + h * 256 + dt * 64, 1024, W_KWT + ((size_t)(cg * 4 + h) * 256 + dt * 64) * 256 + lt * 64, 256,
                             W_GS + ((size_t)(cg * 256 + lt * 64) * 4 + h) * 8 + 2, 32); }
        {
            const size_t nth = (size_t)gridDim.x * NTHR;
#pragma nounroll
            for (size_t i = (size_t)blockIdx.x * NTHR + tidx; i < (size_t)T * 128; i += nth) {
                const size_t t = i >> 7; const int c8 = (int)(i & 127) * 8, h = c8 >> 8, d = c8 & 255;
                const float sc = W_GS[(t * 4 + h) * 8 + 3];
                const uint4 v = *(const uint4*)(W_MQ + t * 1024 + c8);
                uint4 o;
                o.x = pk2(bf2f((unsigned short)(v.x & 0xFFFFu)) * sc, bf2f((unsigned short)(v.x >> 16)) * sc); o.y = pk2(bf2f((unsigned short)(v.y & 0xFFFFu)) * sc, bf2f((unsigned short)(v.y >> 16)) * sc);
                o.z = pk2(bf2f((unsigned short)(v.z & 0xFFFFu)) * sc, bf2f((unsigned short)(v.z >> 16)) * sc); o.w = pk2(bf2f((unsigned short)(v.w & 0xFFFFu)) * sc, bf2f((unsigned short)(v.w >> 16)) * sc);
                *(uint4*)(W_PQ + t * 2048 + h * 512 + 256 + d) = o;
            }
        }
#pragma nounroll
        PHASE_LOOP(128) { const int cgh = VB, cg = cgh >> 2, h = cgh & 3;
            float a = 0.f;
            for (int l = 0; l < 256; ++l) { const size_t t = (size_t)cg * 256 + l; a = fmaf(W_GS[(t * 4 + h) * 8 + 2], bf2f(W_MK[t * 1024 + h * 256 + tid]), a); }
            W_DN[(size_t)cgh * 256 + tid] = a; }
        __syncthreads();
        {
            GJOB_DEFAULT(g); g.A = W_MQ; g.lda = 1024; g.a_pm_step = 256 * 1024; g.a_pn_mask = 3; g.a_pn_step = 256; g.K = 256; g.nN = 4;
            g.Bt = W_MK; g.ldb = 1024; g.b_pn_step = 256; g.b_pm_step = 256 * 1024; g.C = (float*)W_PQ; g.gs = W_GS; g.denp = W_DENP;
            pg8::gemm_phase<6>(GEMM_LDSP, g, tidx);
        }
    }
    xcd_barrier(xb);
    {
        PH_BEGIN();
        GJOB_DEFAULT(g); g.A = W_BH; g.lda = 512; g.a_pm_step = 4 * 256 * 512; g.a_pn_mask = 3; g.a_pn_step = 256 * 512; g.K = 256; g.nN = 4;
        g.Bt = W_KWT; g.ldb = 256; g.b_pn_step = 65536; g.b_pm_step = 4 * 65536; g.C = W_DC;
        pg8::gemm_phase<7>(GEMM_LDSP, g, tidx);
    }
    xcd_barrier(xb);
    {
        PH_BEGIN();
        {
#pragma nounroll
            for (int gid = blockIdx.x * NTHR + tidx; gid < 131072; gid += gridDim.x * NTHR) {
                const int bh = gid >> 14, b = bh >> 2, h = bh & 3, e = (gid >> 6) & 255, d = (gid & 63) * 4;
                float4 C = make_float4(0.f, 0.f, 0.f, 0.f);
#pragma unroll 4
                for (int c = 0; c < 16; ++c) {
                    const int cgh = (b * 16 + c) * 4 + h;
                    uint2 o; o.x = pk2(C.x, C.y); o.y = pk2(C.z, C.w);
                    *(uint2*)(W_BH + ((size_t)cgh * 256 + e) * 512 + 256 + d) = o;
                    const float dec = W_DECAY[cgh];
                    const float4 dc = *(const float4*)(W_DC + ((size_t)cgh * 256 + e) * 256 + d);
                    C.x = fmaf(dec, C.x, dc.x); C.y = fmaf(dec, C.y, dc.y); C.z = fmaf(dec, C.z, dc.z); C.w = fmaf(dec, C.w, dc.w);
                }
            }
        }
#pragma nounroll
        PHASE_LOOP(128) { const int cgh = VB, cg = cgh >> 2, h = cgh & 3, b = cg >> 4, c = cg & 15;
            float n = 0.f;
            for (int cc = 0; cc < c; ++cc) { const int j = (b * 16 + cc) * 4 + h; n = fmaf(W_DECAY[j], n, W_DN[(size_t)j * 256 + tid]); }
            __syncthreads();
            sm[tid] = n;
            __syncthreads();
            const int lane = tid & 63, w = tid >> 6;
            const float4 nv = *(const float4*)(sm + lane * 4);
            for (int i = 0; i < 64; ++i) {
                const size_t t = (size_t)cg * 256 + w * 64 + i;
                const ushort4 q4 = *(const ushort4*)(W_MQ + t * 1024 + h * 256 + lane * 4);
                float s = bf2f(q4.x) * nv.x + bf2f(q4.y) * nv.y + bf2f(q4.z) * nv.z + bf2f(q4.w) * nv.w;
                s = wave_sum(s);
                if (lane == 0) W_QN[t * 4 + h] = s;
            }
        }
    }
    xcd_barrier(xb);
    {
        PH_BEGIN();
        GJOB_DEFAULT(g); g.A = W_PQ; g.a_pn_mask = 3; g.a_pn_step = 512; g.K = 512; g.nN = 4;
        g.Bt = W_BH; g.ldb = 512; g.b_pn_step = 256 * 512; g.b_pm_step = 4 * 256 * 512; g.C = (float*)W_MIXB;
        g.gs = W_GS; g.denp = W_DENP; g.qn = W_QN; g.gvec = PF(I_GMHEAD); g.mo = W_P6 + 2 * P6S;
        pg8::gemm_phase<8>(GEMM_LDSP, g, tidx);
    }
    xcd_barrier(xb);
    {
        PH_BEGIN();
        GJOB_DEFAULT(g); g.A = W_MIXB; g.Bt = (bf16_t*)(wsb + O_WOUT); g.C = W_XR; g.R = PF(I_X);
        pg8::gemm_phase<0>(GEMM_LDSP, g, tidx);
    }
    xcd_barrier(xb);
    {
        PH_BEGIN();
        { const float* rg = PF(I_GCROSS); const float* win = PF(I_WIN);
#pragma nounroll
          PHASE_LOOP(T) d_rmsnorm(VB, tid, sm, W_XR, rg, W_HB, win, nullptr); }
        { const float* rin = PF(I_MEM); const float* rg = PF(I_GMEM); const float* win = PF(I_WIN);
#pragma nounroll
          PHASE_LOOP(512) d_rmsnorm(VB, tid, sm, rin, rg, W_MN, win, nullptr); }
    }
    xcd_barrier(xb);
    {
        PH_BEGIN();
        { GJOB_DEFAULT(g); g.A = W_HB; g.Bt = (bf16_t*)(wsb + O_WXQ); g.C = (float*)W_QX; pg8::gemm_phase<3>(GEMM_LDSP, g, tidx); __syncthreads(); }
        { GJOB_DEFAULT(g); g.A = W_MN; g.Bt = (bf16_t*)(wsb + O_WXK); g.nM = 2; g.C = (float*)W_KM; pg8::gemm_phase<3>(GEMM_LDSP, g, tidx); __syncthreads(); }
        { GJOB_DEFAULT(g); g.A = (bf16_t*)(wsb + O_WXV); g.Bt = W_MN; g.nM = 8; g.nN = 2; g.C = (float*)W_VMT; g.ldc = 512; pg8::gemm_phase<3>(GEMM_LDSP, g, tidx); }
    }
    xcd_barrier(xb);
    {
        PH_BEGIN();
        GJOB_DEFAULT(g); g.A = W_QX; g.K = 512; g.a_pn_mask = 3; g.a_pn_step = 512; g.Bt = W_KM; g.b_pn_step = 512; g.b_pm_shift = 4; g.b_pm_step = 256 * D; g.nN = 4;
        g.C = (float*)W_PX; g.ldc = 1024; g.escale = 0.04419417382415922f * 1.4426950408889634f;
        pg8::gemm_phase<5>(GEMM_LDSP, g, tidx);
    }
    xcd_barrier(xb);
    {
        PH_BEGIN();
        GJOB_DEFAULT(g); g.A = W_PX; g.lda = 1024; g.a_pm_step = 256 * 1024; g.K = 256; g.a_pn_shift = 1; g.a_pn_mask = 3; g.a_pn_step = 256; g.Bt = W_VMT; g.ldb = 512; g.b_pn_step = 256 * 512; g.b_pm_shift = 4; g.b_pm_step = 256;
        g.C = (float*)W_MIXB;
        pg8::gemm_phase<3>(GEMM_LDSP, g, tidx);
    }
    xcd_barrier(xb);
    {
        PH_BEGIN();
        GJOB_DEFAULT(g); g.A = W_MIXB; g.Bt = (bf16_t*)(wsb + O_WXO); g.C = W_XR; g.R = W_XR;
        pg8::gemm_phase<0>(GEMM_LDSP, g, tidx);
    }
    xcd_barrier(xb);
    {
        PH_BEGIN();
        const float* rg = PF(I_GFFN); const float* win = PF(I_WIN);
#pragma nounroll
        PHASE_LOOP(T) d_rmsnorm(VB, tid, sm, W_XR, rg, W_HB, win, nullptr);
    }
    xcd_barrier(xb);
    {
        PH_BEGIN();
        GJOB_DEFAULT(g); g.A = W_HB; g.Bt = (bf16_t*)(wsb + O_WPQ); g.C = (float*)W_QX;
        pg8::gemm_phase<3>(GEMM_LDSP, g, tidx);
    }
    xcd_barrier(xb);
    {
        PH_BEGIN();
        LAS float* wl = (LAS float*)(LAS unsigned char*)smem_raw + (tidx >> 6) * 3072;
#pragma nounroll
        for (int item = blockIdx.x * 8 + (tidx >> 6); item < 4096; item += gridDim.x * 8) peer_topk_wave(item, tidx & 63, wl, W_QX, W_SKB, W_IDS, W_GATES);
    }
    xcd_barrier(xb);
    {
        PH_BEGIN();
        const float* gf = PF(I_GFINAL); float* outp = (float*)ldp_raw(I_OUT);
#pragma nounroll
        PHASE_LOOP(T) d_peer_out8(VB, tid, sm, W_HB, W_XR, W_IDS, W_GATES, W_UT, W_VT, W_RSC, gf, outp);
    }
}
}

extern "C" void kernel_launch(void* const* d_in, const int* in_sizes, int n_in, void* d_out, int out_size, void* d_ws, size_t ws_size, hipStream_t stream) {
    static int grid_blocks = 0;
    if (!grid_blocks) {
        int dev = 0, cus = 0, per_cu = 0;
        hipGetDevice(&dev);
        hipDeviceGetAttribute(&cus, hipDeviceAttributeMultiprocessorCount, dev);
        hipFuncSetAttribute((const void*)mega, hipFuncAttributeMaxDynamicSharedMemorySize, SMEM_BYTES);
        hipOccupancyMaxActiveBlocksPerMultiprocessor(&per_cu, mega, NTHR, SMEM_BYTES);
        if (per_cu > 1) per_cu = 1;
        if (per_cu < 1) per_cu = 1;
        grid_blocks = cus * per_cu;
    }
    Params P{};
    const float** pp = (const float**)&P;
    for (int i = 0; i < 25; ++i) pp[i] = (const float*)d_in[i];
    P.out = (float*)d_out;
    P.bar = (unsigned*)d_ws;
    P.ws = (float*)((char*)d_ws + 16384);
    hipMemsetAsync(d_ws, 0, 16384, stream);
    void* args[] = {&P};
    hipError_t e = hipLaunchCooperativeKernel((const void*)mega, dim3(grid_blocks), dim3(NTHR), args, SMEM_BYTES, stream);
    if (e != hipSuccess) fprintf(stderr, "cooperative launch failed: %s (grid %d)\n", hipGetErrorString(e), grid_blocks);
}
```

```cpp
#include <hip/hip_runtime.h>
#include <stdint.h>
#include <math.h>
#include <cstdio>

#define LAS_ __attribute__((address_space(3)))
namespace {
constexpr int D = 2048, NB = 2, S = 4096, T = NB * S;
constexpr int INC = 6152;
constexpr int C_MIN = 0, C_MV = 1024, C_MO = 2048, C_MI = 3072, C_MF = 3076, C_AQ = 3080, C_AK = 4104, C_AV = 5128;
constexpr float EPS = 1e-6f;
constexpr size_t P6S = (size_t)8192 * 1024;
constexpr int NTHR = 512;
constexpr int HALF_SM_FLOATS = 8704;
constexpr int GEMM_LDS = 131072;
constexpr int SMEM_BYTES = GEMM_LDS + 1024 + 8192;
typedef unsigned short bf16_t;
__device__ __forceinline__ unsigned f2bf(float f) { unsigned u = __float_as_uint(f); u += 0x7FFFu + ((u >> 16) & 1u); return u >> 16; }
__device__ __forceinline__ unsigned pk2(float lo, float hi) { return f2bf(lo) | (f2bf(hi) << 16); }
__device__ __forceinline__ float bf2f(unsigned short b) { return __uint_as_float(((unsigned)b) << 16); }
extern __shared__ __attribute__((aligned(16))) unsigned char smem_raw[];
enum { I_X = 0, I_MEM, I_GMIX, I_WIN, I_CONVW, I_CONVB, I_WMQ, I_WMK, I_BMI, I_BMF, I_GMHEAD, I_GAHEAD, I_WOUT, I_GCROSS, I_GMEM,
       I_WXQ, I_WXK, I_WXV, I_WXO, I_GFFN, I_WPQ, I_SUBK, I_UTAB, I_VTAB, I_GFINAL, I_OUT, I_BAR, I_WS, I_NPTR };
__device__ __forceinline__ unsigned long long ldp_raw(int i) {
    const LAS_ unsigned long long* tab = (const LAS_ unsigned long long*)(LAS_ unsigned char*)(smem_raw + GEMM_LDS + 64);
    const unsigned long long v = tab[i];
    const unsigned lo = __builtin_amdgcn_readfirstlane((unsigned)v), hi = __builtin_amdgcn_readfirstlane((unsigned)(v >> 32));
    return ((unsigned long long)hi << 32) | lo;
}
#define PF(i) ((const float*)ldp_raw(i))

#define XB_TMO      128
#define XB_XCNT(j)  (256  + 64 * (j))
#define XB_XSUB(j)  (1280 + 64 * (j))
#define XB_XGEN(j)  (2304 + 64 * (j))
#define XB_TOP      3328
#define XB_TOPGEN   3392
#define XCD_BAR_WORDS 3456
#define XB_SPIN_CAP (1u << 22)
#define LAS __attribute__((address_space(3)))

__device__ __forceinline__ unsigned xb_ld(unsigned* p)              { return __hip_atomic_load(p, __ATOMIC_RELAXED, __HIP_MEMORY_SCOPE_AGENT); }
__device__ __forceinline__ unsigned xb_add(unsigned* p, unsigned v) { return __hip_atomic_fetch_add(p, v, __ATOMIC_RELAXED, __HIP_MEMORY_SCOPE_AGENT); }
__device__ __forceinline__ unsigned xb_xcc_id() { return (unsigned)__builtin_amdgcn_s_getreg((3 << 11) | 20) & 0xFu; }
#define XB_SPIN(cond, bar) do { unsigned _sp = 0; while (cond) { __builtin_amdgcn_s_sleep(1); \
    if ((++_sp & 255u) == 0u) { if (xb_ld(&(bar)[XB_TMO])) break; if (_sp > XB_SPIN_CAP) { atomicAdd(&(bar)[XB_TMO], 1u); break; } } } } while (0)

struct XcdBarrier { unsigned* bar; unsigned x; volatile LAS unsigned* st; };

__device__ __forceinline__ XcdBarrier xcd_barrier_post(unsigned* bar, volatile LAS unsigned* st) {
    XcdBarrier b; b.bar = bar; b.x = xb_xcc_id(); b.st = st;
    if (threadIdx.x == 0) (void)xb_add(&bar[XB_XCNT(b.x)], 1u);
    return b;
}
__device__ __forceinline__ void xcd_barrier_complete(unsigned* bar, unsigned x, unsigned& nloc, unsigned& nx) {
    const unsigned G = gridDim.x * gridDim.y * gridDim.z;
    unsigned sum, cnt, mine, sp = 0u;
    for (;;) {
        sum = 0u; cnt = 0u; mine = 0u;
#pragma unroll
        for (unsigned j = 0; j < 16; ++j) { const unsigned c = xb_ld(&bar[XB_XCNT(j)]); sum += c; cnt += (c > 0u) ? 1u : 0u; mine = (j == x) ? c : mine; }
        if (sum == G) break;
        __builtin_amdgcn_s_sleep(1);
        if ((++sp & 255u) == 0u) { if (xb_ld(&bar[XB_TMO])) break; if (sp > XB_SPIN_CAP) { atomicAdd(&bar[XB_TMO], 1u); break; } }
    }
    nloc = mine > 0u ? mine : 1u; nx = cnt > 0u ? cnt : 1u;
}
__device__ __forceinline__ void xcd_barrier(const XcdBarrier& b) {
    asm volatile("s_waitcnt vmcnt(0)" ::: "memory");
    __syncthreads();
    if (threadIdx.x == 0) {
        unsigned* bar = b.bar;
        __builtin_amdgcn_s_waitcnt(0);
        unsigned nloc = b.st[0], nx = b.st[1];
        if (nloc == 0u) { xcd_barrier_complete(bar, b.x, nloc, nx); b.st[0] = nloc; b.st[1] = nx; }
        const unsigned old = xb_add(&bar[XB_XSUB(b.x)], 1u);
        const unsigned gen = old / nloc;
        if (old + 1u == (gen + 1u) * nloc) {
            __builtin_amdgcn_fence(__ATOMIC_RELEASE, "agent");
            asm volatile("s_waitcnt vmcnt(0)" ::: "memory");
            const unsigned og = xb_add(&bar[XB_TOP], 1u);
            const unsigned tg = og / nx;
            if (og + 1u == (tg + 1u) * nx) xb_add(&bar[XB_TOPGEN], 1u);
            else XB_SPIN(xb_ld(&bar[XB_TOPGEN]) == tg, bar);
            __builtin_amdgcn_fence(__ATOMIC_ACQUIRE, "agent");
            xb_add(&bar[XB_XGEN(b.x)], 1u);
            asm volatile("s_waitcnt vmcnt(0)" ::: "memory");
        } else {
            XB_SPIN(xb_ld(&bar[XB_XGEN(b.x)]) == gen, bar);
            __builtin_amdgcn_fence(__ATOMIC_ACQUIRE, "agent");
            asm volatile("s_waitcnt vmcnt(0)" ::: "memory");
        }
    }
    __syncthreads();
}

__device__ __forceinline__ float wave_sum(float v) {
#pragma unroll
    for (int o = 32; o >= 1; o >>= 1) v += __shfl_xor(v, o);
    return v;
}
__device__ __forceinline__ float wave_max(float v) {
#pragma unroll
    for (int o = 32; o >= 1; o >>= 1) v = fmaxf(v, __shfl_xor(v, o));
    return v;
}
__device__ __forceinline__ float log_sigmoid(float x) { return fminf(x, 0.f) - log1pf(expf(-fabsf(x))); }


__device__ __forceinline__ void d_rmsnorm(int vb, int t, float* sm, const float* __restrict__ in, const float* __restrict__ g, bf16_t* __restrict__ out,
                                          const float* __restrict__ w_in, float* __restrict__ gpre) {
    float* red = sm;
    const int row = vb;
    const float4* p = (const float4*)(in + (size_t)row * D);
    float4 a = p[t], b = p[t + 256];
    float s = a.x * a.x + a.y * a.y + a.z * a.z + a.w * a.w + b.x * b.x + b.y * b.y + b.z * b.z + b.w * b.w;
    s = wave_sum(s);
    __syncthreads();
    if ((t & 63) == 0) red[t >> 6] = s;
    __syncthreads();
    const float tot = red[0] + red[1] + red[2] + red[3];
    const float r = rsqrtf(tot * (1.0f / D) + EPS);
    const float4* gp = (const float4*)g;
    float4 ga = gp[t], gb = gp[t + 256];
    float hv[8] = {a.x * r * ga.x, a.y * r * ga.y, a.z * r * ga.z, a.w * r * ga.w, b.x * r * gb.x, b.y * r * gb.y, b.z * r * gb.z, b.w * r * gb.w};
    uint2 o0, o1;
    o0.x = pk2(hv[0], hv[1]); o0.y = pk2(hv[2], hv[3]); o1.x = pk2(hv[4], hv[5]); o1.y = pk2(hv[6], hv[7]);
    *(uint2*)(out + (size_t)row * D + t * 4) = o0;
    *(uint2*)(out + (size_t)row * D + 1024 + t * 4) = o1;
    if (gpre) {
        float gs[8];
#pragma unroll
        for (int c = 0; c < 8; ++c) gs[c] = 0.f;
#pragma unroll
        for (int j = 0; j < 8; ++j) {
            const int k = (j < 4) ? (t * 4 + j) : (1024 + t * 4 + (j - 4));
            const float4 w0 = *(const float4*)(w_in + (size_t)k * INC + C_MI), w1 = *(const float4*)(w_in + (size_t)k * INC + C_MI + 4);
            gs[0] = fmaf(hv[j], w0.x, gs[0]); gs[1] = fmaf(hv[j], w0.y, gs[1]); gs[2] = fmaf(hv[j], w0.z, gs[2]); gs[3] = fmaf(hv[j], w0.w, gs[3]);
            gs[4] = fmaf(hv[j], w1.x, gs[4]); gs[5] = fmaf(hv[j], w1.y, gs[5]); gs[6] = fmaf(hv[j], w1.z, gs[6]); gs[7] = fmaf(hv[j], w1.w, gs[7]);
        }
#pragma unroll
        for (int c = 0; c < 8; ++c) gs[c] = wave_sum(gs[c]);
        __syncthreads();
        if ((t & 63) == 0) {
#pragma unroll
            for (int c = 0; c < 8; ++c) red[8 + (t >> 6) * 8 + c] = gs[c];
        }
        __syncthreads();
        if (t < 8) gpre[(size_t)row * 8 + t] = red[8 + t] + red[16 + t] + red[24 + t] + red[32 + t];
    }
}

namespace pg8 {
typedef short bf16x8 __attribute__((ext_vector_type(8)));
typedef float f32x4 __attribute__((ext_vector_type(4)));
constexpr int BM = 256, BK = 64, HALF = 128, HTB = HALF * BK * 2, NXCD = 8, WGM = 8;
__device__ __forceinline__ int lds_byte(int r, int c) { const int st = (r >> 4) * 2 + (c >> 5), rr = r & 15, cc = c & 31, ob = rr * 64 + cc * 2; return st * 1024 + (ob ^ (((ob >> 9) & 1) << 5)); }
__device__ __forceinline__ void stage_rc(int b, int& R, int& C) { const int st = b / 1024, sb = b % 1024, swz = sb ^ (((sb >> 9) & 1) << 5); R = (st >> 1) * 16 + swz / 64; C = (st & 1) * 32 + (swz % 64) / 2; }
struct Unit { int pm, pn; };
struct GJob {
    const bf16_t* A; const bf16_t* Bt;
    int lda, ldb, K, nM, nN;
    int a_pn_shift, a_pn_mask, a_pn_step;
    int b_pm_shift, b_pm_step, b_pn_step;
    int a_pm_step;
    float escale;
    const float* gs; float* denp; const float* qn; const float* gvec; const bf16_t* mo;
    float* C; int ldc; const float* R; int ldr;
    int mode;
};
__device__ __forceinline__ bool unit_next(const GJob& g, int i, Unit& u) {
    const int nwg = g.nM * g.nN;
    const long L = (long)i * gridDim.x + blockIdx.x; if (L >= nwg) return false;
    int wgid = (int)L; { const int q = nwg / NXCD, r = nwg % NXCD, xcd = wgid % NXCD, off = wgid / NXCD; wgid = (xcd < r ? xcd * (q + 1) : r * (q + 1) + (xcd - r) * q) + off; }
    const int nig = WGM * g.nN, gid = wgid / nig, fm = gid * WGM, gsz = (g.nM - fm) < WGM ? (g.nM - fm) : WGM;
    u.pm = fm + ((wgid % nig) % gsz); u.pn = (wgid % nig) / gsz; return true;
}
template <int MODE> __device__ __forceinline__ void epilogue(const GJob& g, f32x4 (&acc)[2][2][4][2], const Unit& u, int wr, int wc, int fr, int fq, LAS unsigned char* xlds) {
    const int row0 = u.pm * BM + wr * 64 + fr;
    if constexpr (MODE == 0) {
        const int col0 = u.pn * BM + wc * 32 + 4 * fq;
#pragma unroll
        for (int ai = 0; ai < 2; ++ai)
#pragma unroll
            for (int m = 0; m < 4; ++m) {
                const int row = row0 + ai * HALF + m * 16;
                float* rowp = g.C + (size_t)row * g.ldc + col0;
                const float* rp = g.R ? g.R + (size_t)row * g.ldr + col0 : nullptr;
#pragma unroll
                for (int bj = 0; bj < 2; ++bj)
#pragma unroll
                    for (int n = 0; n < 2; ++n) {
                        f32x4 v = acc[ai][bj][m][n];
                        if (rp) v = v + *(const f32x4*)(rp + bj * HALF + n * 16);
                        *(f32x4*)(rowp + bj * HALF + n * 16) = v;
                    }
            }
    } else if constexpr (MODE == 6) {
        const int h = u.pn; const size_t t0 = (size_t)u.pm * BM;
        bf16_t* Cb = (bf16_t*)g.C;
#pragma unroll
        for (int ai = 0; ai < 2; ++ai)
#pragma unroll
            for (int m = 0; m < 4; ++m) {
                const int l = ai * HALF + wr * 64 + m * 16 + fr;
                const float M2 = g.gs[((t0 + l) * 4 + h) * 8 + 1];
                bf16_t* rowp = Cb + (t0 + l) * 2048 + h * 512 + wc * 32 + 4 * fq;
                float rs = 0.f;
#pragma unroll
                for (int bj = 0; bj < 2; ++bj)
#pragma unroll
                    for (int n = 0; n < 2; ++n) {
                        const f32x4 a = acc[ai][bj][m][n];
                        const int s0 = bj * HALF + wc * 32 + n * 16 + 4 * fq;
                        float p[4];
#pragma unroll
                        for (int r = 0; r < 4; ++r) { const float u2 = g.gs[((t0 + s0 + r) * 4 + h) * 8 + 0]; p[r] = (s0 + r <= l) ? a[r] * __builtin_amdgcn_exp2f(u2 - M2) : 0.f; rs += p[r]; }
                        uint2 o; o.x = pk2(p[0], p[1]); o.y = pk2(p[2], p[3]);
                        *(uint2*)(rowp + bj * HALF + n * 16) = o;
                    }
                rs += __shfl_xor(rs, 16); rs += __shfl_xor(rs, 32);
                if (fq == 0) g.denp[((t0 + l) * 4 + h) * 4 + wc] = rs;
            }
    } else if constexpr (MODE == 7) {
        float* Ct = g.C + (size_t)(u.pm * 4 + u.pn) * 65536;
        const int col0 = wc * 32 + 4 * fq;
#pragma unroll
        for (int ai = 0; ai < 2; ++ai)
#pragma unroll
            for (int m = 0; m < 4; ++m) {
                float* rowp = Ct + (size_t)(ai * HALF + wr * 64 + m * 16 + fr) * 256 + col0;
#pragma unroll
                for (int bj = 0; bj < 2; ++bj)
#pragma unroll
                    for (int n = 0; n < 2; ++n) *(f32x4*)(rowp + bj * HALF + n * 16) = acc[ai][bj][m][n];
            }
    } else if constexpr (MODE == 8) {
        const int h = u.pn; const size_t t0 = (size_t)u.pm * BM;
        LAS float* X0 = (LAS float*)xlds + wr * 512;
#pragma unroll
        for (int ai = 0; ai < 2; ++ai)
#pragma unroll
            for (int m = 0; m < 4; ++m) {
                const size_t th = (t0 + ai * HALF + wr * 64 + m * 16 + fr) * 4 + h;
                const f32x4 dp = *(const f32x4*)(g.denp + th * 4);
                const float den = (dp[0] + dp[1]) + (dp[2] + dp[3]) + g.gs[th * 8 + 3] * g.qn[th];
                const float rden = 1.0f / fmaxf(fabsf(den), g.gs[th * 8 + 4]);
                float ss = 0.f;
#pragma unroll
                for (int bj = 0; bj < 2; ++bj)
#pragma unroll
                    for (int n = 0; n < 2; ++n) { f32x4 a = acc[ai][bj][m][n] * rden; acc[ai][bj][m][n] = a; ss += (a[0] * a[0] + a[1] * a[1]) + (a[2] * a[2] + a[3] * a[3]); }
                ss += __shfl_xor(ss, 16); ss += __shfl_xor(ss, 32);
                if (fq == 0) X0[(ai * 64 + m * 16 + fr) * 4 + wc] = ss;
            }
        asm volatile("s_waitcnt lgkmcnt(0)" ::: "memory"); __builtin_amdgcn_s_barrier(); asm volatile("" ::: "memory");
        bf16_t* Cb = (bf16_t*)g.C;
        const int col0 = wc * 32 + 4 * fq;
#pragma unroll
        for (int ai = 0; ai < 2; ++ai)
#pragma unroll
            for (int m = 0; m < 4; ++m) {
                const f32x4 p4 = *(const LAS f32x4*)(X0 + (ai * 64 + m * 16 + fr) * 4);
                const float rsn = rsqrtf(((p4[0] + p4[1]) + (p4[2] + p4[3])) * (1.0f / 256.0f) + EPS);
                const size_t t = t0 + ai * HALF + wr * 64 + m * 16 + fr;
                bf16_t* rowp = Cb + t * 2048 + h * 256 + col0;
                const bf16_t* mop = g.mo + t * 1024 + h * 256 + col0;
#pragma unroll
                for (int bj = 0; bj < 2; ++bj)
#pragma unroll
                    for (int n = 0; n < 2; ++n) {
                        const f32x4 a = acc[ai][bj][m][n];
                        const ushort4 mo4 = *(const ushort4*)(mop + bj * HALF + n * 16);
                        const f32x4 gv = *(const f32x4*)(g.gvec + h * 256 + col0 + bj * HALF + n * 16);
                        const float o0 = a[0] * rsn * gv[0] / (1.0f + __expf(-bf2f(mo4.x)));
                        const float o1 = a[1] * rsn * gv[1] / (1.0f + __expf(-bf2f(mo4.y)));
                        const float o2 = a[2] * rsn * gv[2] / (1.0f + __expf(-bf2f(mo4.z)));
                        const float o3 = a[3] * rsn * gv[3] / (1.0f + __expf(-bf2f(mo4.w)));
                        uint2 o; o.x = pk2(o0, o1); o.y = pk2(o2, o3);
                        *(uint2*)(rowp + bj * HALF + n * 16) = o;
                    }
            }
    } else if constexpr (MODE == 5) {
        LAS float* X0 = (LAS float*)xlds + wr * 512;
        LAS float* X1 = (LAS float*)xlds + 1024 + wr * 512;
#pragma unroll
        for (int ai = 0; ai < 2; ++ai)
#pragma unroll
            for (int m = 0; m < 4; ++m) {
                float v = -INFINITY;
#pragma unroll
                for (int bj = 0; bj < 2; ++bj)
#pragma unroll
                    for (int n = 0; n < 2; ++n) { const f32x4 a = acc[ai][bj][m][n]; v = fmaxf(v, fmaxf(fmaxf(a[0], a[1]), fmaxf(a[2], a[3]))); }
                v = fmaxf(v, __shfl_xor(v, 16)); v = fmaxf(v, __shfl_xor(v, 32));
                if (fq == 0) X0[(ai * 64 + m * 16 + fr) * 4 + wc] = v;
            }
        asm volatile("s_waitcnt lgkmcnt(0)" ::: "memory"); __builtin_amdgcn_s_barrier(); asm volatile("" ::: "memory");
#pragma unroll
        for (int ai = 0; ai < 2; ++ai)
#pragma unroll
            for (int m = 0; m < 4; ++m) {
                const f32x4 p4 = *(const LAS f32x4*)(X0 + (ai * 64 + m * 16 + fr) * 4);
                const float mxr = fmaxf(fmaxf(p4[0], p4[1]), fmaxf(p4[2], p4[3])) * g.escale;
                float s = 0.f;
#pragma unroll
                for (int bj = 0; bj < 2; ++bj)
#pragma unroll
                    for (int n = 0; n < 2; ++n) { f32x4 a = acc[ai][bj][m][n];
                        a[0] = __builtin_amdgcn_exp2f(a[0] * g.escale - mxr); a[1] = __builtin_amdgcn_exp2f(a[1] * g.escale - mxr); a[2] = __builtin_amdgcn_exp2f(a[2] * g.escale - mxr); a[3] = __builtin_amdgcn_exp2f(a[3] * g.escale - mxr);
                        acc[ai][bj][m][n] = a; s += (a[0] + a[1]) + (a[2] + a[3]); }
                s += __shfl_xor(s, 16); s += __shfl_xor(s, 32);
                if (fq == 0) X1[(ai * 64 + m * 16 + fr) * 4 + wc] = s;
            }
        asm volatile("s_waitcnt lgkmcnt(0)" ::: "memory"); __builtin_amdgcn_s_barrier(); asm volatile("" ::: "memory");
        bf16_t* Cb = (bf16_t*)g.C;
        const int col0 = u.pn * BM + wc * 32 + 4 * fq;
#pragma unroll
        for (int ai = 0; ai < 2; ++ai)
#pragma unroll
            for (int m = 0; m < 4; ++m) {
                const f32x4 p4 = *(const LAS f32x4*)(X1 + (ai * 64 + m * 16 + fr) * 4);
                const float inv = 1.0f / ((p4[0] + p4[1]) + (p4[2] + p4[3]));
                bf16_t* rowp = Cb + (size_t)(row0 + ai * HALF + m * 16) * g.ldc + col0;
#pragma unroll
                for (int bj = 0; bj < 2; ++bj)
#pragma unroll
                    for (int n = 0; n < 2; ++n) {
                        const f32x4 a = acc[ai][bj][m][n];
                        uint2 o; o.x = pk2(a[0] * inv, a[1] * inv); o.y = pk2(a[2] * inv, a[3] * inv);
                        *(uint2*)(rowp + bj * HALF + n * 16) = o;
                    }
            }
    } else {
        bf16_t* Cb = (bf16_t*)g.C; int ccol = u.pn * BM;
        if constexpr (MODE == 4) { Cb += (size_t)(u.pn >> 2) * P6S; ccol = (u.pn & 3) * 256; }
        const int col0 = ccol + wc * 32 + 4 * fq;
#pragma unroll
        for (int ai = 0; ai < 2; ++ai)
#pragma unroll
            for (int m = 0; m < 4; ++m) {
                bf16_t* rowp = Cb + (size_t)(row0 + ai * HALF + m * 16) * g.ldc + col0;
#pragma unroll
                for (int bj = 0; bj < 2; ++bj)
#pragma unroll
                    for (int n = 0; n < 2; ++n) {
                        const f32x4 v = acc[ai][bj][m][n];
                        uint2 o; o.x = pk2(v[0], v[1]); o.y = pk2(v[2], v[3]);
                        *(uint2*)(rowp + bj * HALF + n * 16) = o;
                    }
            }
    }
}
template <int MODE> __device__ __forceinline__ void gemm_phase(LAS unsigned char* lds, const GJob& g, int tid) {
    const int wid = __builtin_amdgcn_readfirstlane(tid >> 6), lane = tid & 63, wr = wid >> 2, wc = wid & 3, fr = lane & 15, fq = lane >> 4;
    const int K = g.K, nt = K / BK;
    unsigned voffA[2], voffB[2];
#pragma unroll
    for (int i = 0; i < 2; ++i) { int R, C; stage_rc(tid * 16 + i * 8192, R, C);
        voffA[i] = (unsigned)(R * g.lda + C) * 2u; voffB[i] = (unsigned)(R * g.ldb + C) * 2u; }
    const size_t kstep = (size_t)(BK * 2);
    const size_t hstepA = (size_t)HALF * g.lda * 2, hstepB = (size_t)HALF * g.ldb * 2;
    const unsigned ldsw = (unsigned)wid * 1024u;
    const int aoff = lds_byte(wr * 64 + fr, fq * 8), boff = lds_byte(wc * 32 + fr, fq * 8);
#define PG8_SA(b, h) (((b) * 2 + (h)) * HTB)
#define PG8_SB(b, h) ((4 + (b) * 2 + (h)) * HTB)
#define PG8_STAGE(bufoff, gbase, voff) do { _Pragma("unroll") for (int _i = 0; _i < 2; ++_i) \
        __builtin_amdgcn_global_load_lds((const unsigned*)((const char*)(gbase) + (voff)[_i]), (LAS unsigned*)(lds + (bufoff) + ldsw + _i * 8192), 16, 0, 0); } while (0)
#define PG8_LDA(dst, b, h) do { _Pragma("unroll") for (int m = 0; m < 4; ++m) _Pragma("unroll") for (int k = 0; k < 2; ++k) dst[m][k] = *(const LAS bf16x8*)(lds + PG8_SA(b, h) + aoff + m * 2048 + k * 1024); } while (0)
#define PG8_LDB(dst, b, h) do { _Pragma("unroll") for (int n = 0; n < 2; ++n) _Pragma("unroll") for (int k = 0; k < 2; ++k) dst[n][k] = *(const LAS bf16x8*)(lds + PG8_SB(b, h) + boff + n * 2048 + k * 1024); } while (0)
#define PG8_MMA(ai, bj, At, Bt) do { __builtin_amdgcn_s_setprio(1); _Pragma("unroll") for (int m = 0; m < 4; ++m) _Pragma("unroll") for (int n = 0; n < 2; ++n) _Pragma("unroll") for (int k = 0; k < 2; ++k) \
        acc[ai][bj][m][n] = __builtin_amdgcn_mfma_f32_16x16x32_bf16(Bt[n][k], At[m][k], acc[ai][bj][m][n], 0, 0, 0); __builtin_amdgcn_s_setprio(0); } while (0)
#define PG8_WAIT_V(n) asm volatile("s_waitcnt vmcnt(" #n ")" ::: "memory")
#define PG8_WAIT_L(n) asm volatile("s_waitcnt lgkmcnt(" #n ")" ::: "memory")
#define PG8_BAR __builtin_amdgcn_s_barrier()
#define PG8_SCHED __builtin_amdgcn_sched_barrier(0)
#define PG8_ABASE(u) ((const char*)g.A + ((size_t)(u).pm * g.a_pm_step + (size_t)(((u).pn >> g.a_pn_shift) & g.a_pn_mask) * g.a_pn_step) * 2)
#define PG8_BBASE(u) ((const char*)g.Bt + ((size_t)(u).pn * g.b_pn_step + (size_t)((u).pm >> g.b_pm_shift) * g.b_pm_step) * 2)
    Unit cur, nxt; int ui = 0;
    if (!unit_next(g, 0, cur)) return;
    f32x4 acc[2][2][4][2];
#pragma unroll
    for (int a = 0; a < 2; ++a)
#pragma unroll
        for (int b = 0; b < 2; ++b)
#pragma unroll
            for (int m = 0; m < 4; ++m)
#pragma unroll
                for (int n = 0; n < 2; ++n) acc[a][b][m][n] = (f32x4){0.f, 0.f, 0.f, 0.f};
    bf16x8 At[4][2], B0[2][2], B1[2][2];
    const char* cA = PG8_ABASE(cur); const char* cB = PG8_BBASE(cur);
    PG8_STAGE(PG8_SB(0, 0), cB, voffB); PG8_STAGE(PG8_SA(0, 0), cA, voffA); PG8_STAGE(PG8_SB(0, 1), cB + hstepB, voffB); PG8_STAGE(PG8_SA(0, 1), cA + hstepA, voffA);
    if (wr == 1) PG8_BAR;
    PG8_WAIT_V(4); PG8_BAR;
    PG8_STAGE(PG8_SB(1, 0), cB + kstep, voffB); PG8_STAGE(PG8_SA(1, 0), cA + kstep, voffA); PG8_STAGE(PG8_SB(1, 1), cB + hstepB + kstep, voffB);
    PG8_WAIT_V(6); PG8_BAR;
    for (;;) {
        const bool has_next = unit_next(g, ui + 1, nxt);
        const char* nA = has_next ? PG8_ABASE(nxt) : cA; const char* nB = has_next ? PG8_BBASE(nxt) : cB;
        for (int t = 0; t < nt; t += 2) {
            const bool last = (t == nt - 2);
            const char* a1 = cA + (size_t)(t + 1) * kstep;
            const char* a2 = last ? nA : cA + (size_t)(t + 2) * kstep; const char* b2 = last ? nB : cB + (size_t)(t + 2) * kstep;
            const char* a3 = a2 + kstep; const char* b3 = b2 + kstep;
            PG8_LDB(B0, 0, 0); PG8_SCHED; PG8_LDA(At, 0, 0); PG8_STAGE(PG8_SA(1, 1), a1 + hstepA, voffA);
            PG8_WAIT_L(8); PG8_BAR; PG8_WAIT_L(0); PG8_MMA(0, 0, At, B0); PG8_BAR; PG8_SCHED;
            PG8_LDB(B1, 0, 1); PG8_STAGE(PG8_SB(0, 0), b2, voffB);
            PG8_BAR; PG8_WAIT_L(0); PG8_MMA(0, 1, At, B1); PG8_BAR;
            PG8_LDA(At, 0, 1); PG8_STAGE(PG8_SA(0, 0), a2, voffA);
            PG8_BAR; PG8_WAIT_L(0); PG8_MMA(1, 0, At, B0); PG8_BAR; PG8_SCHED;
            PG8_STAGE(PG8_SB(0, 1), b2 + hstepB, voffB);
            PG8_WAIT_V(6); PG8_BAR; PG8_MMA(1, 1, At, B1); PG8_BAR;
            PG8_LDB(B0, 1, 0); PG8_SCHED; PG8_LDA(At, 1, 0); PG8_STAGE(PG8_SA(0, 1), a2 + hstepA, voffA);
            PG8_WAIT_L(8); PG8_BAR; PG8_WAIT_L(0); PG8_MMA(0, 0, At, B0); PG8_BAR; PG8_SCHED;
            PG8_LDB(B1, 1, 1); PG8_STAGE(PG8_SB(1, 0), b3, voffB);
            PG8_BAR; PG8_WAIT_L(0); PG8_MMA(0, 1, At, B1); PG8_BAR;
            PG8_LDA(At, 1, 1); PG8_STAGE(PG8_SA(1, 0), a3, voffA);
            PG8_BAR; PG8_WAIT_L(0); PG8_MMA(1, 0, At, B0); PG8_BAR; PG8_SCHED;
            PG8_STAGE(PG8_SB(1, 1), b3 + hstepB, voffB);
            PG8_WAIT_V(6); PG8_BAR; PG8_MMA(1, 1, At, B1); PG8_BAR;
        }
        epilogue<MODE>(g, acc, cur, wr, wc, fr, fq, lds + GEMM_LDS + 1024);
        if (!has_next) break;
#pragma unroll
        for (int a = 0; a < 2; ++a)
#pragma unroll
            for (int b = 0; b < 2; ++b)
#pragma unroll
                for (int m = 0; m < 4; ++m)
#pragma unroll
                    for (int n = 0; n < 2; ++n) acc[a][b][m][n] = (f32x4){0.f, 0.f, 0.f, 0.f};
        cur = nxt; cA = nA; cB = nB; ++ui;
    }
    PG8_WAIT_V(0);
    if (wr == 0) PG8_BAR;
    PG8_BAR;
#undef PG8_SA
#undef PG8_SB
#undef PG8_STAGE
#undef PG8_LDA
#undef PG8_LDB
#undef PG8_MMA
#undef PG8_WAIT_V
#undef PG8_WAIT_L
#undef PG8_BAR
#undef PG8_SCHED
#undef PG8_ABASE
#undef PG8_BBASE
}
}

__device__ __forceinline__ void p0_transpose_item(const float* W, int ldw, int K, int csrc0, bf16_t* WT, int row0, LAS float* scr, int kb, int lane, float wscale) {
    const int k0 = 64 * kb;
#pragma unroll 8
    for (int i = 0; i < 32; ++i) { const int kk = 2 * i + (lane >> 5); scr[kk * 33 + (lane & 31)] = W[(size_t)(k0 + kk) * ldw + csrc0 + (lane & 31)] * wscale; }
    asm volatile("s_waitcnt lgkmcnt(0)" ::: "memory");
    const int c = lane & 7;
#pragma unroll
    for (int j = 0; j < 4; ++j) { const int n = (lane >> 3) + 8 * j; const LAS float* s = scr + (8 * c) * 33 + n;
        uint4 o; o.x = pk2(s[0 * 33], s[1 * 33]); o.y = pk2(s[2 * 33], s[3 * 33]); o.z = pk2(s[4 * 33], s[5 * 33]); o.w = pk2(s[6 * 33], s[7 * 33]);
        *(uint4*)(WT + (size_t)(row0 + n) * K + k0 + 8 * c) = o; }
    asm volatile("s_waitcnt lgkmcnt(0)" ::: "memory");
}

__device__ __forceinline__ void d_conv_silu(int vb, int tid, const bf16_t* __restrict__ p6, const float* __restrict__ cw, const float* __restrict__ cb, bf16_t* __restrict__ c) {
    const int t = vb, s = t % S;
    for (int ch = tid; ch < 1024; ch += 256) {
        float y = cb[ch];
#pragma unroll
        for (int j = 0; j < 4; ++j) {
            const int ss = s - 3 + j;
            if (ss >= 0) y = fmaf(cw[j * 1024 + ch], bf2f(p6[(size_t)(t - 3 + j) * 1024 + ch]), y);
        }
        c[(size_t)t * 1024 + ch] = (bf16_t)f2bf(y / (1.0f + expf(-y)));
    }
}

__device__ __forceinline__ void d_mlstm(int vb, int tid, const bf16_t* __restrict__ mq, const bf16_t* __restrict__ mk, const bf16_t* __restrict__ p6,
                                        const float* __restrict__ gpre, const float* __restrict__ b_mi, const float* __restrict__ b_mf, float* __restrict__ hraw) {
    const int lane = tid & 63, w = tid >> 6;
    const int gid = vb * 4 + w;
    const int e = gid & 255, h = (gid >> 8) & 3, b = gid >> 10;
    const float bi = b_mi[h], bf = b_mf[h];
    float C0 = 0.f, C1 = 0.f, C2 = 0.f, C3 = 0.f, n0 = 0.f, n1 = 0.f, n2 = 0.f, n3 = 0.f, m = 0.f;
    const size_t tb = (size_t)b * S;
    const bf16_t* qp = mq + tb * 1024 + h * 256 + lane * 4;
    const bf16_t* kp = mk + tb * 1024 + h * 256 + lane * 4;
    const bf16_t* pp = p6 + P6S + tb * 1024 + h * 256 + e;
    ushort4 qn = *(const ushort4*)qp, kn = *(const ushort4*)kp;
    const float* gp = gpre + tb * 8;
    float vn = bf2f(pp[0]), in_ = gp[h], fn = gp[4 + h];
    for (int s = 0; s < S; ++s) {
        const float4 q = make_float4(bf2f(qn.x), bf2f(qn.y), bf2f(qn.z), bf2f(qn.w)), k = make_float4(bf2f(kn.x), bf2f(kn.y), bf2f(kn.z), bf2f(kn.w)); const float v = vn, ipre = in_ + bi, fpre = fn + bf;
        if (s + 1 < S) {
            qn = *(const ushort4*)(qp + (size_t)(s + 1) * 1024);
            kn = *(const ushort4*)(kp + (size_t)(s + 1) * 1024);
            vn = bf2f(pp[(size_t)(s + 1) * 1024]); in_ = gp[(size_t)(s + 1) * 8 + h]; fn = gp[(size_t)(s + 1) * 8 + 4 + h];
        }
        const float logf = log_sigmoid(fpre);
        const float mnew = fmaxf(logf + m, ipre);
        const float fd = expf(logf + m - mnew), ig = expf(ipre - mnew);
        m = mnew;
        const float sc = ig * 0.0625f;
        C0 = fd * C0 + sc * k.x * v; C1 = fd * C1 + sc * k.y * v; C2 = fd * C2 + sc * k.z * v; C3 = fd * C3 + sc * k.w * v;
        n0 = fd * n0 + sc * k.x; n1 = fd * n1 + sc * k.y; n2 = fd * n2 + sc * k.z; n3 = fd * n3 + sc * k.w;
        float num = q.x * C0 + q.y * C1 + q.z * C2 + q.w * C3;
        float den = q.x * n0 + q.y * n1 + q.z * n2 + q.w * n3;
        num = wave_sum(num); den = wave_sum(den);
        if (lane == 0) hraw[(tb + s) * 1024 + h * 256 + e] = num / fmaxf(fabsf(den), expf(-mnew));
    }
}

__device__ __forceinline__ void d_mhead_norm(int vb, int tid, const float* __restrict__ hraw, const bf16_t* __restrict__ p6, const float* __restrict__ g, bf16_t* __restrict__ mix) {
    const int t = vb, h = tid >> 6, lane = tid & 63;
    const float4 v = *(const float4*)(hraw + (size_t)t * 1024 + h * 256 + lane * 4);
    float s = v.x * v.x + v.y * v.y + v.z * v.z + v.w * v.w;
    s = wave_sum(s);
    const float r = rsqrtf(s * (1.0f / 256.0f) + EPS);
    const float4 gg = *(const float4*)(g + h * 256 + lane * 4);
    const ushort4 mo = *(const ushort4*)(p6 + 2 * P6S + (size_t)t * 1024 + h * 256 + lane * 4);
    float4 o;
    o.x = v.x * r * gg.x / (1.0f + expf(-bf2f(mo.x)));
    o.y = v.y * r * gg.y / (1.0f + expf(-bf2f(mo.y)));
    o.z = v.z * r * gg.z / (1.0f + expf(-bf2f(mo.z)));
    o.w = v.w * r * gg.w / (1.0f + expf(-bf2f(mo.w)));
    uint2 ob; ob.x = pk2(o.x, o.y); ob.y = pk2(o.z, o.w);
    *(uint2*)(mix + (size_t)t * D + h * 256 + lane * 4) = ob;
}

__device__ __forceinline__ void d_rope(int vb, int tid, bf16_t* __restrict__ p6) {
    const int t = vb, s = t % S;
    for (int idx = tid; idx < 2 * 8 * 64; idx += 256) {
        const int i = idx & 63, hd = (idx >> 6) & 7, qk = idx >> 9;
        const float inv = exp2f(-(float)i * 0.20762050593046014f);
        const float ang = (float)s * inv;
        float sn, cs; sincosf(ang, &sn, &cs);
        bf16_t* p = p6 + (size_t)(3 + qk) * P6S + (size_t)t * 1024 + hd * 128;
        const float x1 = bf2f(p[i]), x2 = bf2f(p[64 + i]);
        p[i] = (bf16_t)f2bf(x1 * cs - x2 * sn);
        p[64 + i] = (bf16_t)f2bf(x2 * cs + x1 * sn);
    }
}

__device__ __forceinline__ void d_dilated(int vb, int tid, float* sm, const bf16_t* __restrict__ p6, const float* __restrict__ g_ahead, bf16_t* __restrict__ mix) {
    float (*qs)[128] = (float (*)[128])sm;
    float (*ps)[576] = (float (*)[576])(sm + 512);
    const int lane = tid & 63, w = tid >> 6;
    const int gid = vb * 4 + w;
    const int s = gid % S, hd = (gid / S) & 7, b = gid / (S * 8);
    const size_t t = (size_t)b * S + s;
    const bf16_t* qrow = p6 + 3 * P6S + t * 1024 + hd * 128;
    __syncthreads();
    qs[w][lane] = bf2f(qrow[lane]); qs[w][lane + 64] = bf2f(qrow[lane + 64]);
    __syncthreads();
    const float scale = 0.08838834764831845f;
    float mloc = -INFINITY;
    for (int br = 0; br < 3; ++br) {
        const int dil = br == 0 ? 1 : (br == 1 ? 4 : 16);
        for (int jj = 0; jj < 192; jj += 64) {
            const int j = jj + lane;
            float sc = -INFINITY;
            if (j <= 128 && s - j * dil >= 0) {
                const bf16_t* krow = p6 + 4 * P6S + (t - (size_t)j * dil) * 1024 + hd * 128;
                float d = 0.f;
#pragma unroll 8
                for (int c = 0; c < 128; c += 4) {
                    const ushort4 kv = *(const ushort4*)(krow + c);
                    d = fmaf(qs[w][c], bf2f(kv.x), d); d = fmaf(qs[w][c + 1], bf2f(kv.y), d); d = fmaf(qs[w][c + 2], bf2f(kv.z), d); d = fmaf(qs[w][c + 3], bf2f(kv.w), d);
                }
                sc = d * scale;
            }
            ps[w][br * 192 + j] = sc;
            mloc = fmaxf(mloc, sc);
        }
    }
    const float mx = wave_max(mloc);
    __syncthreads();
    float lsum = 0.f;
    for (int i = lane; i < 3 * 192; i += 64) {
        const float sc = ps[w][i];
        const float pv = (sc == -INFINITY) ? 0.f : expf(sc - mx);
        ps[w][i] = pv; lsum += pv;
    }
    const float tot = wave_sum(lsum);
    __syncthreads();
    float o0 = 0.f, o1 = 0.f;
    for (int br = 0; br < 3; ++br) {
        const int dil = br == 0 ? 1 : (br == 1 ? 4 : 16);
        for (int j = 0; j <= 128; ++j) {
            if (s - j * dil < 0) break;
            const float pv = ps[w][br * 192 + j];
            const bf16_t* vrow = p6 + 5 * P6S + (t - (size_t)j * dil) * 1024 + hd * 128;
            o0 = fmaf(pv, bf2f(vrow[lane]), o0); o1 = fmaf(pv, bf2f(vrow[lane + 64]), o1);
        }
    }
    o0 /= tot; o1 /= tot;
    float ss = wave_sum(o0 * o0 + o1 * o1);
    const float r = rsqrtf(ss * (1.0f / 128.0f) + EPS);
    bf16_t* orow = mix + t * D + 1024 + hd * 128;
    orow[lane] = (bf16_t)f2bf(o0 * r * g_ahead[hd * 128 + lane]);
    orow[lane + 64] = (bf16_t)f2bf(o1 * r * g_ahead[hd * 128 + lane + 64]);
}

__device__ __forceinline__ void d_cross(int vb, int tid, float* sm, const bf16_t* __restrict__ q, const float* __restrict__ km, const float* __restrict__ vm, bf16_t* __restrict__ o) {
    float (*qs)[512] = (float (*)[512])sm;
    float (*ps)[256] = (float (*)[256])(sm + 2048);
    const int lane = tid & 63, w = tid >> 6;
    const int t = vb, hd = w, b = t / S;
    const bf16_t* qrow = q + (size_t)t * D + hd * 512;
    __syncthreads();
    for (int i = lane; i < 512; i += 64) qs[w][i] = bf2f(qrow[i]);
    __syncthreads();
    const float scale = 0.04419417382415922f;
    float sc[4]; float mloc = -INFINITY;
#pragma unroll
    for (int r = 0; r < 4; ++r) {
        const int mi = lane + 64 * r;
        const float* krow = km + ((size_t)b * 256 + mi) * D + hd * 512;
        float d = 0.f;
#pragma unroll 8
        for (int c = 0; c < 512; c += 4) {
            const float4 kv = *(const float4*)(krow + c);
            d = fmaf(qs[w][c], kv.x, d); d = fmaf(qs[w][c + 1], kv.y, d); d = fmaf(qs[w][c + 2], kv.z, d); d = fmaf(qs[w][c + 3], kv.w, d);
        }
        sc[r] = d * scale; mloc = fmaxf(mloc, sc[r]);
    }
    const float mx = wave_max(mloc);
    float lsum = 0.f;
#pragma unroll
    for (int r = 0; r < 4; ++r) { const float pv = expf(sc[r] - mx); ps[w][lane + 64 * r] = pv; lsum += pv; }
    const float tot = wave_sum(lsum);
    __syncthreads();
    float acc[8];
#pragma unroll
    for (int i = 0; i < 8; ++i) acc[i] = 0.f;
    for (int mi = 0; mi < 256; ++mi) {
        const float pv = ps[w][mi];
        const float* vrow = vm + ((size_t)b * 256 + mi) * D + hd * 512;
#pragma unroll
        for (int i = 0; i < 8; ++i) acc[i] = fmaf(pv, vrow[lane + 64 * i], acc[i]);
    }
    bf16_t* orow = o + (size_t)t * D + hd * 512;
#pragma unroll
    for (int i = 0; i < 8; ++i) orow[lane + 64 * i] = (bf16_t)f2bf(acc[i] / tot);
}

__device__ __forceinline__ void wave_argmax(float& best, int& bidx) {
#pragma unroll
    for (int o = 32; o >= 1; o >>= 1) {
        const float ob = __shfl_xor(best, o); const int oi = __shfl_xor(bidx, o);
        if (ob > best || (ob == best && oi < bidx)) { best = ob; bidx = oi; }
    }
}
__device__ __forceinline__ void d_peer_topk(int vb, int tid, float* sm, const bf16_t* __restrict__ qp, const float* __restrict__ sub_keys, int* __restrict__ ids, float* __restrict__ gates) {
    float (*qs)[256] = (float (*)[256])sm;
    const int lane = tid & 63, w = tid >> 6;
    const int gid = vb * 4 + w;
    const int hd = gid & 7, t = gid >> 3;
    const bf16_t* qrow = qp + (size_t)t * D + hd * 256;
    __syncthreads();
    for (int i = lane; i < 256; i += 64) qs[w][i] = bf2f(qrow[i]);
    __syncthreads();
    float tops[2]; int topi[2];
#pragma unroll
    for (int p = 0; p < 2; ++p) {
        float v0, v1;
        {
            const float* k0 = sub_keys + ((size_t)(hd * 2 + p) * 128 + lane) * 128;
            const float* k1 = k0 + 64 * 128;
            float d0 = 0.f, d1 = 0.f;
#pragma unroll 8
            for (int c = 0; c < 128; c += 4) {
                const float4 a = *(const float4*)(k0 + c), bb = *(const float4*)(k1 + c);
                const float q0 = qs[w][p * 128 + c], q1 = qs[w][p * 128 + c + 1], q2 = qs[w][p * 128 + c + 2], q3 = qs[w][p * 128 + c + 3];
                d0 = fmaf(q0, a.x, d0); d0 = fmaf(q1, a.y, d0); d0 = fmaf(q2, a.z, d0); d0 = fmaf(q3, a.w, d0);
                d1 = fmaf(q0, bb.x, d1); d1 = fmaf(q1, bb.y, d1); d1 = fmaf(q2, bb.z, d1); d1 = fmaf(q3, bb.w, d1);
            }
            v0 = d0; v1 = d1;
        }
        float ts = 0.f; int ti = 0;
        for (int it = 0; it < 16; ++it) {
            float best; int bidx;
            if (v0 >= v1) { best = v0; bidx = lane; } else { best = v1; bidx = lane + 64; }
            wave_argmax(best, bidx);
            if (lane == it) { ts = best; ti = bidx; }
            if (bidx == lane) v0 = -INFINITY;
            if (bidx == lane + 64) v1 = -INFINITY;
        }
        tops[p] = ts; topi[p] = ti;
    }
    float cv[4]; int ci[4];
#pragma unroll
    for (int r = 0; r < 4; ++r) {
        const int c = lane * 4 + r, i = c >> 4, j = c & 15;
        const float s0 = __shfl(tops[0], i), s1 = __shfl(tops[1], j);
        const int i0 = __shfl(topi[0], i), i1 = __shfl(topi[1], j);
        cv[r] = s0 + s1; ci[r] = i0 * 128 + i1;
    }
    float bs = 0.f; int bid = 0;
    for (int it = 0; it < 16; ++it) {
        float best = cv[0]; int bidx = lane * 4;
#pragma unroll
        for (int r = 1; r < 4; ++r) if (cv[r] > best) { best = cv[r]; bidx = lane * 4 + r; }
        wave_argmax(best, bidx);
        const int owner = bidx >> 2, rr = bidx & 3;
        int myid = ci[0];
        if (rr == 1) myid = ci[1]; else if (rr == 2) myid = ci[2]; else if (rr == 3) myid = ci[3];
        const int eid = __shfl(myid, owner);
        if (lane == it) { bs = best; bid = eid; }
        if (owner == lane) {
#pragma unroll
            for (int r = 0; r < 4; ++r) if (rr == r) cv[r] = -INFINITY;
        }
    }
    float v = lane < 16 ? bs : -INFINITY;
    const float mx = wave_max(v);
    const float ev = lane < 16 ? expf(bs - mx) : 0.f;
    const float tot = wave_sum(ev);
    if (lane < 16) {
        ids[(size_t)t * 128 + hd * 16 + lane] = bid;
        gates[(size_t)t * 128 + hd * 16 + lane] = ev / tot;
    }
}

__device__ __forceinline__ void d_peer_out(int vb, int tid, float* sm, const bf16_t* __restrict__ h3, const float* __restrict__ x2, const int* __restrict__ ids, const float* __restrict__ gates,
                                           const bf16_t* __restrict__ u_tab, const bf16_t* __restrict__ v_tab, const float* __restrict__ g_final, float* __restrict__ out) {
    float (*part)[2048] = (float (*)[2048])sm;
    float* red = sm + 4 * 2048;
    const int lane = tid & 63, w = tid >> 6, t = vb;
    float4 xr[8], acc[8];
    const bf16_t* hrow = h3 + (size_t)t * D;
#pragma unroll
    for (int i = 0; i < 8; ++i) { const ushort4 hv = *(const ushort4*)(hrow + i * 256 + lane * 4);
        xr[i] = make_float4(bf2f(hv.x), bf2f(hv.y), bf2f(hv.z), bf2f(hv.w)); acc[i] = make_float4(0.f, 0.f, 0.f, 0.f); }
    for (int j = 0; j < 32; ++j) {
        const int slot = w * 32 + j;
        const int e = ids[(size_t)t * 128 + slot];
        const float gt = gates[(size_t)t * 128 + slot];
        const bf16_t* ur = u_tab + (size_t)e * D;
        const bf16_t* vr = v_tab + (size_t)e * D;
        float d = 0.f;
#pragma unroll
        for (int i = 0; i < 8; ++i) {
            const ushort4 u = *(const ushort4*)(ur + i * 256 + lane * 4);
            d = fmaf(xr[i].x, bf2f(u.x), d); d = fmaf(xr[i].y, bf2f(u.y), d); d = fmaf(xr[i].z, bf2f(u.z), d); d = fmaf(xr[i].w, bf2f(u.w), d);
        }
        d = wave_sum(d);
        const float act = 0.5f * d * (1.0f + erff(d * 0.7071067811865476f));
        const float cf = gt * act;
#pragma unroll
        for (int i = 0; i < 8; ++i) {
            const ushort4 v = *(const ushort4*)(vr + i * 256 + lane * 4);
            acc[i].x = fmaf(cf, bf2f(v.x), acc[i].x); acc[i].y = fmaf(cf, bf2f(v.y), acc[i].y); acc[i].z = fmaf(cf, bf2f(v.z), acc[i].z); acc[i].w = fmaf(cf, bf2f(v.w), acc[i].w);
        }
    }
    __syncthreads();
#pragma unroll
    for (int i = 0; i < 8; ++i) *(float4*)&part[w][i * 256 + lane * 4] = acc[i];
    __syncthreads();
    float4 r0, r1;
    {
        const float4 a = *(const float4*)&part[0][tid * 4], b = *(const float4*)&part[1][tid * 4], c = *(const float4*)&part[2][tid * 4], d = *(const float4*)&part[3][tid * 4];
        const float4 x = *(const float4*)(x2 + (size_t)t * D + tid * 4);
        r0 = make_float4(x.x + a.x + b.x + c.x + d.x, x.y + a.y + b.y + c.y + d.y, x.z + a.z + b.z + c.z + d.z, x.w + a.w + b.w + c.w + d.w);
    }
    {
        const float4 a = *(const float4*)&part[0][1024 + tid * 4], b = *(const float4*)&part[1][1024 + tid * 4], c = *(const float4*)&part[2][1024 + tid * 4], d = *(const float4*)&part[3][1024 + tid * 4];
        const float4 x = *(const float4*)(x2 + (size_t)t * D + 1024 + tid * 4);
        r1 = make_float4(x.x + a.x + b.x + c.x + d.x, x.y + a.y + b.y + c.y + d.y, x.z + a.z + b.z + c.z + d.z, x.w + a.w + b.w + c.w + d.w);
    }
    float s = r0.x * r0.x + r0.y * r0.y + r0.z * r0.z + r0.w * r0.w + r1.x * r1.x + r1.y * r1.y + r1.z * r1.z + r1.w * r1.w;
    s = wave_sum(s);
    if (lane == 0) red[w] = s;
    __syncthreads();
    const float tot = red[0] + red[1] + red[2] + red[3];
    const float r = rsqrtf(tot * (1.0f / D) + EPS);
    const float4 g0 = *(const float4*)(g_final + tid * 4), g1 = *(const float4*)(g_final + 1024 + tid * 4);
    *(float4*)(out + (size_t)t * D + tid * 4) = make_float4(r0.x * r * g0.x, r0.y * r * g0.y, r0.z * r * g0.z, r0.w * r * g0.w);
    *(float4*)(out + (size_t)t * D + 1024 + tid * 4) = make_float4(r1.x * r * g1.x, r1.y * r * g1.y, r1.z * r * g1.z, r1.w * r * g1.w);
}


__device__ __forceinline__ float wave_incl_scan_add(float v, int lane) {
#pragma unroll
    for (int o = 1; o < 64; o <<= 1) { const float t = __shfl_up(v, o); if (lane >= o) v += t; }
    return v;
}
__device__ __forceinline__ float wave_incl_scan_max(float v, int lane) {
#pragma unroll
    for (int o = 1; o < 64; o <<= 1) { const float t = __shfl_up(v, o); if (lane >= o) v = fmaxf(v, t); }
    return v;
}
__device__ __forceinline__ void mlstm_gates_wave(int b, int h, int lane, const float* __restrict__ gpre, const float* __restrict__ b_mi, const float* __restrict__ b_mf,
                                                 float* __restrict__ gs, float* __restrict__ decay) {
    const float bi = b_mi[h], bf = b_mf[h];
    float mprev = 0.f;
    for (int c = 0; c < 16; ++c) {
        const size_t t0 = (size_t)b * S + c * 256 + lane * 4;
        float logi[4], lf[4], bb[4];
#pragma unroll
        for (int j = 0; j < 4; ++j) { logi[j] = gpre[(t0 + j) * 8 + h] + bi; lf[j] = log_sigmoid(gpre[(t0 + j) * 8 + 4 + h] + bf); }
        bb[0] = lf[0]; bb[1] = bb[0] + lf[1]; bb[2] = bb[1] + lf[2]; bb[3] = bb[2] + lf[3];
        const float incl = wave_incl_scan_add(bb[3], lane);
        const float excl = incl - bb[3];
#pragma unroll
        for (int j = 0; j < 4; ++j) bb[j] += excl;
        const float g = __shfl(incl, 63);
        float amax = -INFINITY, uu[4], cm[4];
#pragma unroll
        for (int j = 0; j < 4; ++j) { amax = fmaxf(amax, logi[j] + g - bb[j]); uu[j] = logi[j] - bb[j]; }
        amax = wave_max(amax);
        const float mnew = fmaxf(g + mprev, amax);
        cm[0] = uu[0]; cm[1] = fmaxf(cm[0], uu[1]); cm[2] = fmaxf(cm[1], uu[2]); cm[3] = fmaxf(cm[2], uu[3]);
        const float cincl = wave_incl_scan_max(cm[3], lane);
        float cexcl = __shfl_up(cincl, 1); if (lane == 0) cexcl = -INFINITY;
#pragma unroll
        for (int j = 0; j < 4; ++j) {
            const float M = fmaxf(mprev, fmaxf(cexcl, cm[j]));
            float* o = gs + ((t0 + j) * 4 + h) * 8;
            o[0] = uu[j] * 1.4426950408889634f; o[1] = M * 1.4426950408889634f; o[2] = expf(logi[j] + g - bb[j] - mnew); o[3] = expf(mprev - M); o[4] = expf(-(bb[j] + M));
        }
        if (lane == 0) decay[(b * 16 + c) * 4 + h] = expf(g + mprev - mnew);
        mprev = mnew;
    }
}
__device__ __forceinline__ void transpose_tile64(int tid, float* sm, const bf16_t* __restrict__ src, int src_ld, bf16_t* __restrict__ dst, int dst_ld, const float* __restrict__ scale, int sstride) {
    unsigned short (*tl)[66] = (unsigned short (*)[66])sm;
    __syncthreads();
#pragma unroll
    for (int i = 0; i < 2; ++i) {
        const int ch = tid + i * 256, r = ch >> 3, c8 = (ch & 7) * 8;
        const uint4 v = *(const uint4*)(src + (size_t)r * src_ld + c8);
        const float sc = scale ? scale[(size_t)r * sstride] : 1.0f;
        const unsigned w[4] = {v.x, v.y, v.z, v.w};
#pragma unroll
        for (int k = 0; k < 4; ++k) {
            tl[r][c8 + 2 * k] = (unsigned short)f2bf(bf2f((unsigned short)(w[k] & 0xFFFFu)) * sc);
            tl[r][c8 + 2 * k + 1] = (unsigned short)f2bf(bf2f((unsigned short)(w[k] >> 16)) * sc);
        }
    }
    __syncthreads();
#pragma unroll
    for (int i = 0; i < 2; ++i) {
        const int ch = tid + i * 256, c = ch >> 3, r8 = (ch & 7) * 8;
        uint4 o;
        o.x = (unsigned)tl[r8 + 0][c] | ((unsigned)tl[r8 + 1][c] << 16); o.y = (unsigned)tl[r8 + 2][c] | ((unsigned)tl[r8 + 3][c] << 16);
        o.z = (unsigned)tl[r8 + 4][c] | ((unsigned)tl[r8 + 5][c] << 16); o.w = (unsigned)tl[r8 + 6][c] | ((unsigned)tl[r8 + 7][c] << 16);
        *(uint4*)(dst + (size_t)c * dst_ld + r8) = o;
    }
}

typedef short bf16x8_t __attribute__((ext_vector_type(8)));
typedef short bf16x4_t __attribute__((ext_vector_type(4)));
typedef float f32x4_t __attribute__((ext_vector_type(4)));
__device__ __forceinline__ void dilated_wave_tile(int qt, int lane, const bf16_t* __restrict__ AQ, const bf16_t* __restrict__ AK, const bf16_t* __restrict__ VT,
                                                  const float* __restrict__ g_ahead, bf16_t* __restrict__ mix) {
    const int r = qt & 15, blk = (qt >> 4) & 15, hd = (qt >> 8) & 7, b = qt >> 11;
    const int j = lane & 15, g = lane >> 4;
    const int t0 = blk * 256;
    const int sq = t0 + r + 16 * j;
    bf16x8_t qf[4];
    {
        const bf16_t* qrow = AQ + ((size_t)b * S + sq) * 1024 + hd * 128 + 8 * g;
#pragma unroll
        for (int ks = 0; ks < 4; ++ks) qf[ks] = *(const bf16x8_t*)(qrow + 32 * ks);
    }
    const float sc = 0.08838834764831845f * 1.4426950408889634f;
    float m_run = -1e30f, l_run = 0.f;
    f32x4_t o[8];
#pragma unroll
    for (int dt = 0; dt < 8; ++dt) o[dt] = (f32x4_t){0.f, 0.f, 0.f, 0.f};
#pragma nounroll
    for (int br = 0; br < 3; ++br) {
        const int ld = 2 * br, d = 1 << ld;
        const int rho = r & (d - 1);
        const int qj = (sq - rho) >> ld;
        const int q_lo = ((t0 + r - rho) >> ld) - 128, q_hi = (t0 + r + 240 - rho) >> ld;
        const int tile_lo = q_lo < 0 ? 0 : (q_lo >> 4), tile_hi = q_hi >> 4, tile_max = (256 >> ld) - 1;
        const bf16_t* vtb = VT + (size_t)br * ((size_t)1024 * 8192) + (size_t)(hd * 128 + j) * 8192 + (size_t)b * 4096 + (size_t)rho * (4096 >> ld) + 4 * g;
#pragma nounroll
        for (int tp = tile_lo; tp <= tile_hi; tp += 2) {
            f32x4_t su[2];
#pragma unroll
            for (int u = 0; u < 2; ++u) {
                int tl = tp + u; if (tl > tile_max) tl = tile_max;
                const int pos = rho + ((16 * tl + j) << ld);
                const bf16_t* krow = AK + ((size_t)b * S + pos) * 1024 + hd * 128 + 8 * g;
                f32x4_t a = (f32x4_t){0.f, 0.f, 0.f, 0.f};
#pragma unroll
                for (int ks = 0; ks < 4; ++ks) a = __builtin_amdgcn_mfma_f32_16x16x32_bf16(*(const bf16x8_t*)(krow + 32 * ks), qf[ks], a, 0, 0, 0);
                su[u] = a;
            }
            float p[2][4]; float mx = -1e30f;
#pragma unroll
            for (int u = 0; u < 2; ++u)
#pragma unroll
                for (int e = 0; e < 4; ++e) {
                    const int n = qj - (16 * (tp + u) + 4 * g + e);
                    const bool valid = (n >= 0) && (n <= 128);
                    p[u][e] = valid ? su[u][e] * sc : -1e30f;
                    mx = fmaxf(mx, p[u][e]);
                }
            mx = fmaxf(mx, __shfl_xor(mx, 16)); mx = fmaxf(mx, __shfl_xor(mx, 32));
            const float m_new = fmaxf(m_run, mx);
            const float alpha = __builtin_amdgcn_exp2f(m_run - m_new);
            m_run = m_new;
            float ps = 0.f;
#pragma unroll
            for (int u = 0; u < 2; ++u)
#pragma unroll
                for (int e = 0; e < 4; ++e) { p[u][e] = (p[u][e] > -1e29f) ? __builtin_amdgcn_exp2f(p[u][e] - m_new) : 0.f; ps += p[u][e]; }
            l_run = l_run * alpha + ps;
            bf16x8_t pb;
            {
                const unsigned w0 = pk2(p[0][0], p[0][1]), w1 = pk2(p[0][2], p[0][3]), w2 = pk2(p[1][0], p[1][1]), w3 = pk2(p[1][2], p[1][3]);
                pb[0] = (short)(w0 & 0xFFFF); pb[1] = (short)(w0 >> 16); pb[2] = (short)(w1 & 0xFFFF); pb[3] = (short)(w1 >> 16);
                pb[4] = (short)(w2 & 0xFFFF); pb[5] = (short)(w2 >> 16); pb[6] = (short)(w3 & 0xFFFF); pb[7] = (short)(w3 >> 16);
            }
            int tl0 = tp, tl1 = tp + 1; if (tl0 > tile_max) tl0 = tile_max; if (tl1 > tile_max) tl1 = tile_max;
#pragma unroll
            for (int dt = 0; dt < 8; ++dt) {
                const bf16_t* vrow = vtb + (size_t)dt * (16 * 8192);
                const bf16x4_t v0 = *(const bf16x4_t*)(vrow + 16 * tl0), v1 = *(const bf16x4_t*)(vrow + 16 * tl1);
                bf16x8_t va; va[0] = v0[0]; va[1] = v0[1]; va[2] = v0[2]; va[3] = v0[3]; va[4] = v1[0]; va[5] = v1[1]; va[6] = v1[2]; va[7] = v1[3];
                f32x4_t oo = o[dt]; oo = oo * alpha;
                o[dt] = __builtin_amdgcn_mfma_f32_16x16x32_bf16(va, pb, oo, 0, 0, 0);
            }
        }
    }
    float lt = l_run; lt += __shfl_xor(lt, 16); lt += __shfl_xor(lt, 32);
    const float inv = 1.0f / lt;
    float ss = 0.f;
#pragma unroll
    for (int dt = 0; dt < 8; ++dt) { o[dt] = o[dt] * inv; ss += (o[dt][0] * o[dt][0] + o[dt][1] * o[dt][1]) + (o[dt][2] * o[dt][2] + o[dt][3] * o[dt][3]); }
    ss += __shfl_xor(ss, 16); ss += __shfl_xor(ss, 32);
    const float rn = rsqrtf(ss * (1.0f / 128.0f) + EPS);
    bf16_t* orow = mix + ((size_t)b * S + sq) * D + 1024 + hd * 128 + 4 * g;
#pragma unroll
    for (int dt = 0; dt < 8; ++dt) {
        const f32x4_t gv = *(const f32x4_t*)(g_ahead + hd * 128 + 16 * dt + 4 * g);
        uint2 w; w.x = pk2(o[dt][0] * rn * gv[0], o[dt][1] * rn * gv[1]); w.y = pk2(o[dt][2] * rn * gv[2], o[dt][3] * rn * gv[3]);
        *(uint2*)(orow + 16 * dt) = w;
    }
}

__device__ __forceinline__ unsigned ord_key(float s) { const unsigned u = __float_as_uint(s); return u ^ ((unsigned)((int)u >> 31) | 0x80000000u); }
__device__ __forceinline__ unsigned wave_max_u32(unsigned v) {
    unsigned t;
    t = (unsigned)__builtin_amdgcn_update_dpp(0, (int)v, 0xB1, 0xF, 0xF, true); v = v > t ? v : t;
    t = (unsigned)__builtin_amdgcn_update_dpp(0, (int)v, 0x4E, 0xF, 0xF, true); v = v > t ? v : t;
    t = (unsigned)__builtin_amdgcn_update_dpp(0, (int)v, 0x141, 0xF, 0xF, true); v = v > t ? v : t;
    t = (unsigned)__builtin_amdgcn_update_dpp(0, (int)v, 0x140, 0xF, 0xF, true); v = v > t ? v : t;
    const unsigned a = (unsigned)__builtin_amdgcn_readlane((int)v, 0), b = (unsigned)__builtin_amdgcn_readlane((int)v, 16),
                   c = (unsigned)__builtin_amdgcn_readlane((int)v, 32), d = (unsigned)__builtin_amdgcn_readlane((int)v, 48);
    const unsigned ab = a > b ? a : b, cd = c > d ? c : d;
    return ab > cd ? ab : cd;
}
__device__ __forceinline__ void peer_topk_wave(int item, int lane, LAS float* wl, const bf16_t* __restrict__ qp, const bf16_t* __restrict__ skb, int* __restrict__ ids, float* __restrict__ gates) {
    const int hd = item & 7, tt = item >> 3, j = lane & 15, g = lane >> 4;
    const size_t t0 = (size_t)tt * 16;
    LAS float* sc = wl;
    LAS float* lst = wl + 2048;
#pragma unroll 1
    for (int p = 0; p < 2; ++p) {
        bf16x8_t qf[4];
        const bf16_t* qrow = qp + (t0 + j) * D + hd * 256 + p * 128 + 8 * g;
#pragma unroll
        for (int ks = 0; ks < 4; ++ks) qf[ks] = *(const bf16x8_t*)(qrow + 32 * ks);
        const bf16_t* kb = skb + ((size_t)(hd * 2 + p) * 128 + j) * 128 + 8 * g;
#pragma unroll
        for (int kt = 0; kt < 8; ++kt) {
            f32x4_t a = (f32x4_t){0.f, 0.f, 0.f, 0.f};
#pragma unroll
            for (int ks = 0; ks < 4; ++ks) a = __builtin_amdgcn_mfma_f32_16x16x32_bf16(*(const bf16x8_t*)(kb + (size_t)kt * (16 * 128) + 32 * ks), qf[ks], a, 0, 0, 0);
            *(LAS f32x4_t*)(sc + j * 128 + 16 * kt + 4 * g) = a;
        }
        asm volatile("s_waitcnt lgkmcnt(0)" ::: "memory");
#pragma unroll 1
        for (int tok = 0; tok < 16; ++tok) {
            const float s0 = sc[tok * 128 + lane], s1 = sc[tok * 128 + 64 + lane];
            unsigned k0 = (ord_key(s0) & ~127u) | (unsigned)(127 - lane), k1 = (ord_key(s1) & ~127u) | (unsigned)(63 - lane);
            unsigned sel = 0u;
#pragma unroll 4
            for (int it = 0; it < 16; ++it) {
                unsigned m = k0 > k1 ? k0 : k1;
                m = wave_max_u32(m);
                if (lane == it) sel = m;
                if (k0 == m) k0 = 0u;
                if (k1 == m) k1 = 0u;
            }
            if (lane < 16) {
                const int idx = 127 - (int)(sel & 127u);
                lst[((p * 16 + tok) * 16 + lane) * 2 + 0] = sc[tok * 128 + idx];
                lst[((p * 16 + tok) * 16 + lane) * 2 + 1] = __int_as_float(idx);
            }
        }
        asm volatile("s_waitcnt lgkmcnt(0)" ::: "memory");
    }
#pragma unroll 1
    for (int tok = 0; tok < 16; ++tok) {
        const int i = lane >> 2;
        const float sA = lst[((0 * 16 + tok) * 16 + i) * 2];
        unsigned kk[4];
#pragma unroll
        for (int r = 0; r < 4; ++r) {
            const int jb = (lane & 3) * 4 + r;
            const float sum = sA + lst[((1 * 16 + tok) * 16 + jb) * 2];
            kk[r] = (ord_key(sum) & ~255u) | (unsigned)(255 - (lane * 4 + r));
        }
        unsigned sel = 0u;
#pragma unroll 4
        for (int it = 0; it < 16; ++it) {
            unsigned m = kk[0] > kk[1] ? kk[0] : kk[1]; const unsigned m2 = kk[2] > kk[3] ? kk[2] : kk[3]; m = m > m2 ? m : m2;
            m = wave_max_u32(m);
            if (lane == it) sel = m;
#pragma unroll
            for (int r = 0; r < 4; ++r) if (kk[r] == m) kk[r] = 0u;
        }
        float bs = -INFINITY; int eid = 0;
        if (lane < 16) {
            const int c = 255 - (int)(sel & 255u), ia = c >> 4, ib = c & 15;
            bs = lst[((0 * 16 + tok) * 16 + ia) * 2] + lst[((1 * 16 + tok) * 16 + ib) * 2];
            eid = __float_as_int(lst[((0 * 16 + tok) * 16 + ia) * 2 + 1]) * 128 + __float_as_int(lst[((1 * 16 + tok) * 16 + ib) * 2 + 1]);
        }
        const float mx = wave_max(bs);
        const float ev = lane < 16 ? __expf(bs - mx) : 0.f;
        const float tot = wave_sum(ev);
        if (lane < 16) {
            ids[(t0 + tok) * 128 + hd * 16 + lane] = eid;
            gates[(t0 + tok) * 128 + hd * 16 + lane] = ev / tot;
        }
    }
}

typedef float f32x2_t __attribute__((ext_vector_type(2)));
__device__ __forceinline__ void table_row_to_fp8(const float* __restrict__ srow, unsigned char* __restrict__ drow, float* __restrict__ rscale, int lane) {
    float4 f[8];
#pragma unroll
    for (int i = 0; i < 8; ++i) f[i] = *(const float4*)(srow + lane * 32 + i * 4);
    float am = 0.f;
#pragma unroll
    for (int i = 0; i < 8; ++i) am = fmaxf(am, fmaxf(fmaxf(fabsf(f[i].x), fabsf(f[i].y)), fmaxf(fabsf(f[i].z), fabsf(f[i].w))));
    am = wave_max(am);
    const float e = floorf(log2f(448.0f / fmaxf(am, 1e-30f)));
    const float s = exp2f(fminf(e, 100.0f));
    unsigned w[8];
#pragma unroll
    for (int i = 0; i < 8; ++i) {
        int t = 0;
        t = __builtin_amdgcn_cvt_pk_fp8_f32(f[i].x * s, f[i].y * s, t, false);
        t = __builtin_amdgcn_cvt_pk_fp8_f32(f[i].z * s, f[i].w * s, t, true);
        w[i] = (unsigned)t;
    }
    *(uint4*)(drow + lane * 32) = make_uint4(w[0], w[1], w[2], w[3]);
    *(uint4*)(drow + lane * 32 + 16) = make_uint4(w[4], w[5], w[6], w[7]);
    if (lane == 0) *rscale = 1.0f / s;
}
__device__ __forceinline__ float dot16_fp8(const uint4 q, const float* x) {
    float d = 0.f;
    const unsigned w[4] = {q.x, q.y, q.z, q.w};
#pragma unroll
    for (int k = 0; k < 4; ++k) {
        const f32x2_t lo = __builtin_amdgcn_cvt_pk_f32_fp8((int)w[k], false), hi = __builtin_amdgcn_cvt_pk_f32_fp8((int)w[k], true);
        d = fmaf(lo.x, x[4 * k], d); d = fmaf(lo.y, x[4 * k + 1], d); d = fmaf(hi.x, x[4 * k + 2], d); d = fmaf(hi.y, x[4 * k + 3], d);
    }
    return d;
}
__device__ __forceinline__ void axpy16_fp8(const uint4 q, float c, float* acc) {
    const unsigned w[4] = {q.x, q.y, q.z, q.w};
#pragma unroll
    for (int k = 0; k < 4; ++k) {
        const f32x2_t lo = __builtin_amdgcn_cvt_pk_f32_fp8((int)w[k], false), hi = __builtin_amdgcn_cvt_pk_f32_fp8((int)w[k], true);
        acc[4 * k] = fmaf(c, lo.x, acc[4 * k]); acc[4 * k + 1] = fmaf(c, lo.y, acc[4 * k + 1]); acc[4 * k + 2] = fmaf(c, hi.x, acc[4 * k + 2]); acc[4 * k + 3] = fmaf(c, hi.y, acc[4 * k + 3]);
    }
}
__device__ __forceinline__ void d_peer_out8(int vb, int tid, float* sm, const bf16_t* __restrict__ h3, const float* __restrict__ x2, const int* __restrict__ ids, const float* __restrict__ gates,
                                            const unsigned char* __restrict__ ut8, const unsigned char* __restrict__ vt8, const float* __restrict__ rsc, const float* __restrict__ g_final, float* __restrict__ out) {
    float (*part)[2048] = (float (*)[2048])sm;
    float* red = sm + 4 * 2048;
    const int lane = tid & 63, w = tid >> 6, t = vb;
    float x[32], acc[32];
    {
        const bf16_t* hrow = h3 + (size_t)t * D + lane * 16;
#pragma unroll
        for (int hh = 0; hh < 2; ++hh) {
            const uint4 a = *(const uint4*)(hrow + hh * 1024), b = *(const uint4*)(hrow + hh * 1024 + 8);
            const unsigned ww[8] = {a.x, a.y, a.z, a.w, b.x, b.y, b.z, b.w};
#pragma unroll
            for (int k = 0; k < 8; ++k) { x[hh * 16 + 2 * k] = __uint_as_float(ww[k] << 16); x[hh * 16 + 2 * k + 1] = __uint_as_float(ww[k] & 0xFFFF0000u); }
        }
#pragma unroll
        for (int i = 0; i < 32; ++i) acc[i] = 0.f;
    }
    const int myid = ids[(size_t)t * 128 + w * 32 + (lane & 31)];
    const float mygate = gates[(size_t)t * 128 + w * 32 + (lane & 31)];
#pragma unroll 1
    for (int j = 0; j < 32; j += 4) {
        int e[4]; uint4 uq[4][2], vq[4][2];
#pragma unroll
        for (int q = 0; q < 4; ++q) {
            e[q] = __builtin_amdgcn_readfirstlane(__shfl(myid, j + q));
            const unsigned char* ur = ut8 + (size_t)e[q] * 2048 + lane * 16;
            uq[q][0] = *(const uint4*)ur; uq[q][1] = *(const uint4*)(ur + 1024);
        }
#pragma unroll
        for (int q = 0; q < 4; ++q) {
            const unsigned char* vr = vt8 + (size_t)e[q] * 2048 + lane * 16;
            vq[q][0] = *(const uint4*)vr; vq[q][1] = *(const uint4*)(vr + 1024);
        }
        float d[4];
#pragma unroll
        for (int q = 0; q < 4; ++q) d[q] = dot16_fp8(uq[q][0], x) + dot16_fp8(uq[q][1], x + 16);
#pragma unroll
        for (int o = 32; o >= 1; o >>= 1) {
#pragma unroll
            for (int q = 0; q < 4; ++q) d[q] += __shfl_xor(d[q], o);
        }
#pragma unroll
        for (int q = 0; q < 4; ++q) {
            const float a = d[q] * rsc[e[q]];
            const float act = 0.5f * a * (1.0f + erff(a * 0.7071067811865476f));
            const float cf = __shfl(mygate, j + q) * act * rsc[16384 + e[q]];
            axpy16_fp8(vq[q][0], cf, acc); axpy16_fp8(vq[q][1], cf, acc + 16);
        }
    }
    __syncthreads();
#pragma unroll
    for (int hh = 0; hh < 2; ++hh)
#pragma unroll
        for (int k = 0; k < 4; ++k) *(float4*)&part[w][hh * 1024 + lane * 16 + 4 * k] = make_float4(acc[hh * 16 + 4 * k], acc[hh * 16 + 4 * k + 1], acc[hh * 16 + 4 * k + 2], acc[hh * 16 + 4 * k + 3]);
    __syncthreads();
    float4 r0, r1;
    {
        const float4 a = *(const float4*)&part[0][tid * 4], b = *(const float4*)&part[1][tid * 4], c = *(const float4*)&part[2][tid * 4], dd = *(const float4*)&part[3][tid * 4];
        const float4 xx = *(const float4*)(x2 + (size_t)t * D + tid * 4);
        r0 = make_float4(xx.x + a.x + b.x + c.x + dd.x, xx.y + a.y + b.y + c.y + dd.y, xx.z + a.z + b.z + c.z + dd.z, xx.w + a.w + b.w + c.w + dd.w);
    }
    {
        const float4 a = *(const float4*)&part[0][1024 + tid * 4], b = *(const float4*)&part[1][1024 + tid * 4], c = *(const float4*)&part[2][1024 + tid * 4], dd = *(const float4*)&part[3][1024 + tid * 4];
        const float4 xx = *(const float4*)(x2 + (size_t)t * D + 1024 + tid * 4);
        r1 = make_float4(xx.x + a.x + b.x + c.x + dd.x, xx.y + a.y + b.y + c.y + dd.y, xx.z + a.z + b.z + c.z + dd.z, xx.w + a.w + b.w + c.w + dd.w);
    }
    float s = r0.x * r0.x + r0.y * r0.y + r0.z * r0.z + r0.w * r0.w + r1.x * r1.x + r1.y * r1.y + r1.z * r1.z + r1.w * r1.w;
    s = wave_sum(s);
    if (lane == 0) red[w] = s;
    __syncthreads();
    const float tot = red[0] + red[1] + red[2] + red[3];
    const float r = rsqrtf(tot * (1.0f / D) + EPS);
    const float4 g0 = *(const float4*)(g_final + tid * 4), g1 = *(const float4*)(g_final + 1024 + tid * 4);
    *(float4*)(out + (size_t)t * D + tid * 4) = make_float4(r0.x * r * g0.x, r0.y * r * g0.y, r0.z * r * g0.z, r0.w * r * g0.w);
    *(float4*)(out + (size_t)t * D + 1024 + tid * 4) = make_float4(r1.x * r * g1.x, r1.y * r * g1.y, r1.z * r * g1.z, r1.w * r * g1.w);
}

struct Params {
    const float *x, *mem, *g_mix, *w_in, *conv_w, *conv_b, *w_mq, *w_mk, *b_mi, *b_mf, *g_mhead, *g_ahead, *w_out, *g_cross, *g_mem,
                *w_xq, *w_xk, *w_xv, *w_xo, *g_ffn, *w_pq, *sub_keys, *u_tab, *v_tab, *g_final;
    float* out;
    unsigned* bar;
    float* ws;
};

#define PHASE_LOOP(nvb) for (int base_ = blockIdx.x * 2; base_ < (nvb); base_ += gridDim.x * 2)
#define VB (base_ + half)

__global__ void __launch_bounds__(NTHR) mega(Params P) {
    volatile LAS unsigned* st = (volatile LAS unsigned*)(LAS unsigned char*)(smem_raw + GEMM_LDS);
    if (threadIdx.x == 0) { st[0] = 0u; st[1] = 0u; st[2] = 0u; st[3] = 0u; }
    if (threadIdx.x < I_NPTR) ((LAS unsigned long long*)(LAS unsigned char*)(smem_raw + GEMM_LDS + 64))[threadIdx.x] = ((const unsigned long long*)&P)[threadIdx.x];
    __syncthreads();
    XcdBarrier xb = xcd_barrier_post((unsigned*)ldp_raw(I_BAR), st);

    constexpr size_t TD = (size_t)T * D;
    constexpr size_t O_HB = 6 * P6S * 2, O_CBUF = O_HB + (size_t)T * D * 2, O_MQ = O_CBUF + (size_t)T * 1024 * 2, O_MK = O_MQ + (size_t)T * 1024 * 2,
                     O_MIXB = O_MK + (size_t)T * 1024 * 2, O_WIN = O_MIXB + (size_t)T * D * 2, O_WOUT = O_WIN + (size_t)6144 * D * 2, O_WXQ = O_WOUT + (size_t)D * D * 2,
                     O_WXK = O_WXQ + (size_t)D * D * 2, O_WXV = O_WXK + (size_t)D * D * 2, O_WXO = O_WXV + (size_t)D * D * 2, O_WPQ = O_WXO + (size_t)D * D * 2,
                     O_WQK = O_WPQ + (size_t)D * D * 2, O_GPRE = O_WQK + (size_t)8 * 256 * 256 * 2, O_UT = O_GPRE + (size_t)T * 8 * 4, O_VT = O_UT + (size_t)16384 * D, O_RSC = O_VT + (size_t)16384 * D,
                     O_BH = O_RSC + (size_t)32768 * 4, O_GS = O_BH + (size_t)128 * 256 * 512 * 2, O_DENP = O_GS + (size_t)T * 4 * 8 * 4, O_QN = O_DENP + (size_t)T * 4 * 4 * 4,
                     O_DN = O_QN + (size_t)T * 4 * 4, O_DECAY = O_DN + (size_t)128 * 256 * 4, O_VT3 = O_DECAY + 4096, O_SKB = O_VT3 + (size_t)3 * 1024 * 8192 * 2, O_END = O_SKB + (size_t)262144 * 2;
    static_assert(O_END + 16384 <= (size_t)536870912, "workspace overflow");
#define W_P6    ((bf16_t*)wsb)
#define W_HB    ((bf16_t*)(wsb + O_HB))
#define W_CBUF  ((bf16_t*)(wsb + O_CBUF))
#define W_MQ    ((bf16_t*)(wsb + O_MQ))
#define W_MK    ((bf16_t*)(wsb + O_MK))
#define W_MIXB  ((bf16_t*)(wsb + O_MIXB))
#define W_GPRE  ((float*)(wsb + O_GPRE))
#define W_HRAW  ((float*)(wsb + O_HB))
#define W_XR    ((float*)wsb)
#define W_MN    ((bf16_t*)((float*)wsb + TD))
#define W_KM    ((bf16_t*)((float*)wsb + TD + (size_t)256 * D))
#define W_VMT   ((bf16_t*)((float*)wsb + TD + (size_t)768 * D))
#define W_PX    ((bf16_t*)(wsb + O_MK))
#define W_GATES ((float*)wsb + TD + (size_t)1280 * D)
#define W_IDS   ((int*)((float*)wsb + TD + (size_t)1280 * D + (size_t)T * 128))
#define W_QX    ((bf16_t*)(wsb + O_CBUF))
#define W_BH    ((bf16_t*)(wsb + O_BH))
#define W_VT3   ((bf16_t*)(wsb + O_VT3))
#define W_SKB   ((bf16_t*)(wsb + O_SKB))
#define W_GS    ((float*)(wsb + O_GS))
#define W_DENP  ((float*)(wsb + O_DENP))
#define W_QN    ((float*)(wsb + O_QN))
#define W_DN    ((float*)(wsb + O_DN))
#define W_DECAY ((float*)(wsb + O_DECAY))
#define W_PQ    ((bf16_t*)(wsb + O_HB))
#define W_KWT   ((bf16_t*)(wsb + O_CBUF))
#define W_DC    ((float*)(wsb + 3 * P6S * 2))
#define W_UT    ((unsigned char*)(wsb + O_UT))
#define W_VT    ((unsigned char*)(wsb + O_VT))
#define W_RSC   ((float*)(wsb + O_RSC))
#define PH_BEGIN() int tidx = threadIdx.x; asm volatile("" : "+v"(tidx)); const int half = tidx >> 8, tid = tidx & 255; float* sm = (float*)smem_raw + half * HALF_SM_FLOATS; \
                   char* wsb = (char*)ldp_raw(I_WS); (void)half; (void)tid; (void)sm; (void)wsb
#define GJOB_DEFAULT(g) pg8::GJob g; g.lda = D; g.ldb = D; g.K = D; g.nM = 32; g.nN = 8; g.a_pm_step = 256 * D; g.a_pn_shift = 0; g.a_pn_mask = 0; g.a_pn_step = 0; g.b_pm_shift = 0; g.b_pm_step = 0; g.b_pn_step = 256 * D; \
                        g.ldc = D; g.R = nullptr; g.ldr = D; g.mode = 0; g.escale = 1.0f; g.gs = nullptr; g.denp = nullptr; g.qn = nullptr; g.gvec = nullptr; g.mo = nullptr
#define GEMM_LDSP ((LAS unsigned char*)smem_raw)

    {
        PH_BEGIN();
        {
            LAS float* scr = (LAS float*)(LAS unsigned char*)(smem_raw) + (tidx >> 6) * (64 * 33);
            const int lane = tidx & 63;
            const int gw = blockIdx.x * 8 + (tidx >> 6), NGW = gridDim.x * 8;
            constexpr int I_IN = 32 * 192, I_SQ = 32 * 64, I_QK = 8 * 4 * 8;
            constexpr int NITEMS = I_IN + 6 * I_SQ + I_QK;
#pragma nounroll
            for (int it = gw; it < NITEMS; it += NGW) {
                const float* W; int ldw, K, csrc0, row0, kb; bf16_t* WT; float wscale = 1.0f;
                int r = it;
                if (r < I_IN) { const int nb = r % 192; kb = r / 192; W = PF(I_WIN); ldw = INC; K = D; csrc0 = nb * 32 + (nb >= 96 ? 8 : 0); WT = (bf16_t*)(wsb + O_WIN); row0 = nb * 32; }
                else if ((r -= I_IN) < 6 * I_SQ) {
                    const int wsel = r / I_SQ; r -= wsel * I_SQ; const int nb = r % 64; kb = r / 64; ldw = D; K = D; csrc0 = nb * 32; row0 = nb * 32;
                    W = PF(wsel == 0 ? I_WOUT : wsel == 1 ? I_WXQ : wsel == 2 ? I_WXK : wsel == 3 ? I_WXV : wsel == 4 ? I_WXO : I_WPQ);
                    WT = (bf16_t*)(wsb + O_WOUT + (size_t)wsel * ((size_t)D * D * 2));
                } else {
                    r -= 6 * I_SQ; const int hq = r / 32; r -= hq * 32; const int nb = r % 8; kb = r / 8;
                    W = PF(hq < 4 ? I_WMQ : I_WMK) + (size_t)(hq & 3) * 65536; ldw = 256; K = 256; csrc0 = nb * 32; WT = (bf16_t*)(wsb + O_WQK); row0 = hq * 256 + nb * 32;
                    if (hq >= 4) wscale = 0.0625f;
                }
                p0_transpose_item(W, ldw, K, csrc0, WT, row0, scr, kb, lane, wscale);
            }
            {
                const float* ut = PF(I_UTAB); const float* vt = PF(I_VTAB);
#pragma nounroll
                for (int row = gw; row < 32768; row += NGW) {
                    const bool second = row >= 16384; const int rr = second ? row - 16384 : row;
                    table_row_to_fp8((second ? vt : ut) + (size_t)rr * D, (second ? W_VT : W_UT) + (size_t)rr * D, W_RSC + row, lane);
                }
            }
            {
                const float* sk = PF(I_SUBK);
#pragma nounroll
                for (int i = blockIdx.x * NTHR + tidx; i < 262144 / 8; i += gridDim.x * NTHR) {
                    const float4 a = *(const float4*)(sk + (size_t)i * 8), b = *(const float4*)(sk + (size_t)i * 8 + 4);
                    uint4 o; o.x = pk2(a.x, a.y); o.y = pk2(a.z, a.w); o.z = pk2(b.x, b.y); o.w = pk2(b.z, b.w);
                    *(uint4*)(W_SKB + (size_t)i * 8) = o;
                }
            }
            __syncthreads();
        }
        { const float* rin = PF(I_X); const float* rg = PF(I_GMIX); const float* win = PF(I_WIN);
#pragma nounroll
          PHASE_LOOP(T) d_rmsnorm(VB, tid, sm, rin, rg, W_HB, win, W_GPRE); }
    }
    xcd_barrier(xb);
    {
        PH_BEGIN();
        GJOB_DEFAULT(g); g.A = W_HB; g.Bt = (bf16_t*)(wsb + O_WIN); g.nN = 24; g.C = (float*)W_P6; g.ldc = 1024;
        pg8::gemm_phase<4>(GEMM_LDSP, g, tidx);
    }
    xcd_barrier(xb);
    {
        PH_BEGIN();
        const float* cw = PF(I_CONVW); const float* cb = PF(I_CONVB);
#pragma nounroll
        PHASE_LOOP(T) d_conv_silu(VB, tid, W_P6, cw, cb, W_CBUF);
#pragma nounroll
        PHASE_LOOP(T) d_rope(VB, tid, W_P6);
        if (blockIdx.x < 8 && tidx < 64) mlstm_gates_wave(blockIdx.x >> 2, blockIdx.x & 3, tidx, W_GPRE, PF(I_BMI), PF(I_BMF), W_GS, W_DECAY);
#pragma nounroll
        PHASE_LOOP(2048) { const int it = VB, lt = it & 3, et = (it >> 2) & 3, h = (it >> 4) & 3, cg = it >> 6;
            transpose_tile64(tid, sm, W_P6 + P6S + (size_t)(cg * 256 + lt * 64) * 1024 + h * 256 + et * 64, 1024, W_BH + ((size_t)(cg * 4 + h) * 256 + et * 64) * 512 + lt * 64, 512, nullptr, 0); }
#pragma nounroll
        PHASE_LOOP(6144) { const int br = VB >> 11, it = VB & 2047, ld = 2 * br, dimt = it & 15, rest = it >> 4, b = rest >> 6, x = rest & 63, rho = x >> (6 - ld), qt = x & ((64 >> ld) - 1);
            transpose_tile64(tid, sm, W_P6 + 5 * P6S + ((size_t)b * S + rho + ((size_t)(64 * qt) << ld)) * 1024 + dimt * 64, 1024 << ld,
                             W_VT3 + (size_t)br * ((size_t)1024 * 8192) + (size_t)(dimt * 64) * 8192 + (size_t)b * 4096 + (size_t)rho * (4096 >> ld) + qt * 64, 8192, nullptr, 0); }
    }
    xcd_barrier(xb);
    {
        PH_BEGIN();
        {
            GJOB_DEFAULT(g); g.A = W_CBUF; g.lda = 1024; g.a_pm_step = 256 * 1024; g.Bt = (bf16_t*)(wsb + O_WQK); g.ldb = 256; g.b_pn_step = 256 * 256; g.K = 256; g.a_pn_mask = 3; g.a_pn_step = 256; g.C = (float*)W_MQ; g.ldc = 1024;
            pg8::gemm_phase<4>(GEMM_LDSP, g, tidx);
            __syncthreads();
        }
        const float* ga = PF(I_GAHEAD);
#pragma nounroll
        for (int qt = blockIdx.x * 8 + (tidx >> 6); qt < 4096; qt += gridDim.x * 8) dilated_wave_tile(qt, tidx & 63, W_P6 + 3 * P6S, W_P6 + 4 * P6S, W_VT3, ga, W_MIXB);
    }
    xcd_barrier(xb);
    {
        PH_BEGIN();
#pragma nounroll
        PHASE_LOOP(2048) { const int it = VB, lt = it & 3, dt = (it >> 2) & 3, h = (it >> 4) & 3, cg = it >> 6;
            transpose_tile64(tid, sm, W_MK + (size_t)(cg * 256 + lt * 64) * 1024 + h * 256 + dt * 64, 1024, W_KWT + ((size_t)(cg * 4 + h) * 256 + dt * 64) * 256 + lt * 64, 256,
                             W_GS + ((size_t)(cg * 256 + lt * 64) * 4 + h) * 8 + 2, 32); }
        {
            const size_t nth = (size_t)gridDim.x * NTHR;
#pragma nounroll
            for (size_t i = (size_t)blockIdx.x * NTHR + tidx; i < (size_t)T * 128; i += nth) {
                const size_t t = i >> 7; const int c8 = (int)(i & 127) * 8, h = c8 >> 8, d = c8 & 255;
                const float sc = W_GS[(t * 4 + h) * 8 + 3];
                const uint4 v = *(const uint4*)(W_MQ + t * 1024 + c8);
                uint4 o;
                o.x = pk2(bf2f((unsigned short)(v.x & 0xFFFFu)) * sc, bf2f((unsigned short)(v.x >> 16)) * sc); o.y = pk2(bf2f((unsigned short)(v.y & 0xFFFFu)) * sc, bf2f((unsigned short)(v.y >> 16)) * sc);
                o.z = pk2(bf2f((unsigned short)(v.z & 0xFFFFu)) * sc, bf2f((unsigned short)(v.z >> 16)) * sc); o.w = pk2(bf2f((unsigned short)(v.w & 0xFFFFu)) * sc, bf2f((unsigned short)(v.w >> 16)) * sc);
                *(uint4*)(W_PQ + t * 2048 + h * 512 + 256 + d) = o;
            }
        }
#pragma nounroll
        PHASE_LOOP(128) { const int cgh = VB, cg = cgh >> 2, h = cgh & 3;
            float a = 0.f;
            for (int l = 0; l < 256; ++l) { const size_t t = (size_t)cg * 256 + l; a = fmaf(W_GS[(t * 4 + h) * 8 + 2], bf2f(W_MK[t * 1024 + h * 256 + tid]), a); }
            W_DN[(size_t)cgh * 256 + tid] = a; }
        __syncthreads();
        {
            GJOB_DEFAULT(g); g.A = W_MQ; g.lda = 1024; g.a_pm_step = 256 * 1024; g.a_pn_mask = 3; g.a_pn_step = 256; g.K = 256; g.nN = 4;
            g.Bt = W_MK; g.ldb = 1024; g.b_pn_step = 256; g.b_pm_step = 256 * 1024; g.C = (float*)W_PQ; g.gs = W_GS; g.denp = W_DENP;
            pg8::gemm_phase<6>(GEMM_LDSP, g, tidx);
        }
    }
    xcd_barrier(xb);
    {
        PH_BEGIN();
        GJOB_DEFAULT(g); g.A = W_BH; g.lda = 512; g.a_pm_step = 4 * 256 * 512; g.a_pn_mask = 3; g.a_pn_step = 256 * 512; g.K = 256; g.nN = 4;
        g.Bt = W_KWT; g.ldb = 256; g.b_pn_step = 65536; g.b_pm_step = 4 * 65536; g.C = W_DC;
        pg8::gemm_phase<7>(GEMM_LDSP, g, tidx);
    }
    xcd_barrier(xb);
    {
        PH_BEGIN();
        {
#pragma nounroll
            for (int gid = blockIdx.x * NTHR + tidx; gid < 131072; gid += gridDim.x * NTHR) {
                const int bh = gid >> 14, b = bh >> 2, h = bh & 3, e = (gid >> 6) & 255, d = (gid & 63) * 4;
                float4 C = make_float4(0.f, 0.f, 0.f, 0.f);
#pragma unroll 4
                for (int c = 0; c < 16; ++c) {
                    const int cgh = (b * 16 + c) * 4 + h;
                    uint2 o; o.x = pk2(C.x, C.y); o.y = pk2(C.z, C.w);
                    *(uint2*)(W_BH + ((size_t)cgh * 256 + e) * 512 + 256 + d) = o;
                    const float dec = W_DECAY[cgh];
                    const float4 dc = *(const float4*)(W_DC + ((size_t)cgh * 256 + e) * 256 + d);
                    C.x = fmaf(dec, C.x, dc.x); C.y = fmaf(dec, C.y, dc.y); C.z = fmaf(dec, C.z, dc.z); C.w = fmaf(dec, C.w, dc.w);
                }
            }
        }
#pragma nounroll
        PHASE_LOOP(128) { const int cgh = VB, cg = cgh >> 2, h = cgh & 3, b = cg >> 4, c = cg & 15;
            float n = 0.f;
            for (int cc = 0; cc < c; ++cc) { const int j = (b * 16 + cc) * 4 + h; n = fmaf(W_DECAY[j], n, W_DN[(size_t)j * 256 + tid]); }
            __syncthreads();
            sm[tid] = n;
            __syncthreads();
            const int lane = tid & 63, w = tid >> 6;
            const float4 nv = *(const float4*)(sm + lane * 4);
            for (int i = 0; i < 64; ++i) {
                const size_t t = (size_t)cg * 256 + w * 64 + i;
                const ushort4 q4 = *(const ushort4*)(W_MQ + t * 1024 + h * 256 + lane * 4);
                float s = bf2f(q4.x) * nv.x + bf2f(q4.y) * nv.y + bf2f(q4.z) * nv.z + bf2f(q4.w) * nv.w;
                s = wave_sum(s);
                if (lane == 0) W_QN[t * 4 + h] = s;
            }
        }
    }
    xcd_barrier(xb);
    {
        PH_BEGIN();
        GJOB_DEFAULT(g); g.A = W_PQ; g.a_pn_mask = 3; g.a_pn_step = 512; g.K = 512; g.nN = 4;
        g.Bt = W_BH; g.ldb = 512; g.b_pn_step = 256 * 512; g.b_pm_step = 4 * 256 * 512; g.C = (float*)W_MIXB;
        g.gs = W_GS; g.denp = W_DENP; g.qn = W_QN; g.gvec = PF(I_GMHEAD); g.mo = W_P6 + 2 * P6S;
        pg8::gemm_phase<8>(GEMM_LDSP, g, tidx);
    }
    xcd_barrier(xb);
    {
        PH_BEGIN();
        GJOB_DEFAULT(g); g.A = W_MIXB; g.Bt = (bf16_t*)(wsb + O_WOUT); g.C = W_XR; g.R = PF(I_X);
        pg8::gemm_phase<0>(GEMM_LDSP, g, tidx);
    }
    xcd_barrier(xb);
    {
        PH_BEGIN();
        { const float* rg = PF(I_GCROSS); const float* win = PF(I_WIN);
#pragma nounroll
          PHASE_LOOP(T) d_rmsnorm(VB, tid, sm, W_XR, rg, W_HB, win, nullptr); }
        { const float* rin = PF(I_MEM); const float* rg = PF(I_GMEM); const float* win = PF(I_WIN);
#pragma nounroll
          PHASE_LOOP(512) d_rmsnorm(VB, tid, sm, rin, rg, W_MN, win, nullptr); }
    }
    xcd_barrier(xb);
    {
        PH_BEGIN();
        { GJOB_DEFAULT(g); g.A = W_HB; g.Bt = (bf16_t*)(wsb + O_WXQ); g.C = (float*)W_QX; pg8::gemm_phase<3>(GEMM_LDSP, g, tidx); __syncthreads(); }
        { GJOB_DEFAULT(g); g.A = W_MN; g.Bt = (bf16_t*)(wsb + O_WXK); g.nM = 2; g.C = (float*)W_KM; pg8::gemm_phase<3>(GEMM_LDSP, g, tidx); __syncthreads(); }
        { GJOB_DEFAULT(g); g.A = (bf16_t*)(wsb + O_WXV); g.Bt = W_MN; g.nM = 8; g.nN = 2; g.C = (float*)W_VMT; g.ldc = 512; pg8::gemm_phase<3>(GEMM_LDSP, g, tidx); }
    }
    xcd_barrier(xb);
    {
        PH_BEGIN();
        GJOB_DEFAULT(g); g.A = W_QX; g.K = 512; g.a_pn_mask = 3; g.a_pn_step = 512; g.Bt = W_KM; g.b_pn_step = 512; g.b_pm_shift = 4; g.b_pm_step = 256 * D; g.nN = 4;
        g.C = (float*)W_PX; g.ldc = 1024; g.escale = 0.04419417382415922f * 1.4426950408889634f;
        pg8::gemm_phase<5>(GEMM_LDSP, g, tidx);
    }
    xcd_barrier(xb);
    {
        PH_BEGIN();
        GJOB_DEFAULT(g); g.A = W_PX; g.lda = 1024; g.a_pm_step = 256 * 1024; g.K = 256; g.a_pn_shift = 1; g.a_pn_mask = 3; g.a_pn_step = 256; g.Bt = W_VMT; g.ldb = 512; g.b_pn_step = 256 * 512; g.b_pm_shift = 4; g.b_pm_step = 256;
        g.C = (float*)W_MIXB;
        pg8::gemm_phase<3>(GEMM_LDSP, g, tidx);
    }
    xcd_barrier(xb);
    {
        PH_BEGIN();
        GJOB_DEFAULT(g); g.A = W_MIXB; g.Bt = (bf16_t*)(wsb + O_WXO); g.C = W_XR; g.R = W_XR;
        pg8::gemm_phase<0>(GEMM_LDSP, g, tidx);
    }
    xcd_barrier(xb);
    {
        PH_BEGIN();
        const float* rg = PF(I_GFFN); const float* win = PF(I_WIN);
#pragma nounroll
        PHASE_LOOP(T) d_rmsnorm(VB, tid, sm, W_XR, rg, W_HB, win, nullptr);
    }
    xcd_barrier(xb);
    {
        PH_BEGIN();
        GJOB_DEFAULT(g); g.A = W_HB; g.Bt = (bf16_t*)(wsb + O_WPQ); g.C = (float*)W_QX;
        pg8::gemm_phase<3>(GEMM_LDSP, g, tidx);
    }
    xcd_barrier(xb);
    {
        PH_BEGIN();
        LAS float* wl = (LAS float*)(LAS unsigned char*)smem_raw + (tidx >> 6) * 3072;
#pragma nounroll
        for (int item = blockIdx.x * 8 + (tidx >> 6); item < 4096; item += gridDim.x * 8) peer_topk_wave(item, tidx & 63, wl, W_QX, W_SKB, W_IDS, W_GATES);
    }
    xcd_barrier(xb);
    {
        PH_BEGIN();
        const float* gf = PF(I_GFINAL); float* outp = (float*)ldp_raw(I_OUT);
#pragma nounroll
        PHASE_LOOP(T) d_peer_out8(VB, tid, sm, W_HB, W_XR, W_IDS, W_GATES, W_UT, W_VT, W_RSC, gf, outp);
    }
}
}

extern "C" void kernel_launch(void* const* d_in, const int* in_sizes, int n_in, void* d_out, int out_size, void* d_ws, size_t ws_size, hipStream_t stream) {
    static int grid_blocks = 0;
    if (!grid_blocks) {
        int dev = 0, cus = 0, per_cu = 0;
        hipGetDevice(&dev);
        hipDeviceGetAttribute(&cus, hipDeviceAttributeMultiprocessorCount, dev);
        hipFuncSetAttribute((const void*)mega, hipFuncAttributeMaxDynamicSharedMemorySize, SMEM_BYTES);
        hipOccupancyMaxActiveBlocksPerMultiprocessor(&per_cu, mega, NTHR, SMEM_BYTES);
        if (per_cu > 1) per_cu = 1;
        if (per_cu < 1) per_cu = 1;
        grid_blocks = cus * per_cu;
    }
    Params P{};
    const float** pp = (const float**)&P;
    for (int i = 0; i < 25; ++i) pp[i] = (const float*)d_in[i];
    P.out = (float*)d_out;
    P.bar = (unsigned*)d_ws;
    P.ws = (float*)((char*)d_ws + 16384);
    hipMemsetAsync(d_ws, 0, 16384, stream);
    void* args[] = {&P};
    hipError_t e = hipLaunchCooperativeKernel((const void*)mega, dim3(grid_blocks), dim3(NTHR), args, SMEM_BYTES, stream);
    if (e != hipSuccess) fprintf(stderr, "cooperative launch failed: %s (grid %d)\n", hipGetErrorString(e), grid_blocks);
}
```

```cpp
#include <hip/hip_runtime.h>
#include <stdint.h>
#include <math.h>
#include <cstdio>

#define LAS_ __attribute__((address_space(3)))
namespace {
constexpr int D = 2048, NB = 2, S = 4096, T = NB * S;
constexpr int INC = 6152;
constexpr int C_MIN = 0, C_MV = 1024, C_MO = 2048, C_MI = 3072, C_MF = 3076, C_AQ = 3080, C_AK = 4104, C_AV = 5128;
constexpr float EPS = 1e-6f;
constexpr size_t P6S = (size_t)8192 * 1024;
constexpr int NTHR = 512;
constexpr int HALF_SM_FLOATS = 8704;
constexpr int GEMM_LDS = 131072;
constexpr int SMEM_BYTES = GEMM_LDS + 1024 + 8192;
typedef unsigned short bf16_t;
__device__ __forceinline__ unsigned f2bf(float f) { unsigned u = __float_as_uint(f); u += 0x7FFFu + ((u >> 16) & 1u); return u >> 16; }
__device__ __forceinline__ unsigned pk2(float lo, float hi) { return f2bf(lo) | (f2bf(hi) << 16); }
__device__ __forceinline__ float bf2f(unsigned short b) { return __uint_as_float(((unsigned)b) << 16); }
extern __shared__ __attribute__((aligned(16))) unsigned char smem_raw[];
enum { I_X = 0, I_MEM, I_GMIX, I_WIN, I_CONVW, I_CONVB, I_WMQ, I_WMK, I_BMI, I_BMF, I_GMHEAD, I_GAHEAD, I_WOUT, I_GCROSS, I_GMEM,
       I_WXQ, I_WXK, I_WXV, I_WXO, I_GFFN, I_WPQ, I_SUBK, I_UTAB, I_VTAB, I_GFINAL, I_OUT, I_BAR, I_WS, I_NPTR };
__device__ __forceinline__ unsigned long long ldp_raw(int i) {
    const LAS_ unsigned long long* tab = (const LAS_ unsigned long long*)(LAS_ unsigned char*)(smem_raw + GEMM_LDS + 64);
    const unsigned long long v = tab[i];
    const unsigned lo = __builtin_amdgcn_readfirstlane((unsigned)v), hi = __builtin_amdgcn_readfirstlane((unsigned)(v >> 32));
    return ((unsigned long long)hi << 32) | lo;
}
#define PF(i) ((const float*)ldp_raw(i))

#define XB_TMO      128
#define XB_XCNT(j)  (256  + 64 * (j))
#define XB_XSUB(j)  (1280 + 64 * (j))
#define XB_XGEN(j)  (2304 + 64 * (j))
#define XB_TOP      3328
#define XB_TOPGEN   3392
#define XCD_BAR_WORDS 3456
#define XB_SPIN_CAP (1u << 22)
#define LAS __attribute__((address_space(3)))

__device__ __forceinline__ unsigned xb_ld(unsigned* p)              { return __hip_atomic_load(p, __ATOMIC_RELAXED, __HIP_MEMORY_SCOPE_AGENT); }
__device__ __forceinline__ unsigned xb_add(unsigned* p, unsigned v) { return __hip_atomic_fetch_add(p, v, __ATOMIC_RELAXED, __HIP_MEMORY_SCOPE_AGENT); }
__device__ __forceinline__ unsigned xb_xcc_id() { return (unsigned)__builtin_amdgcn_s_getreg((3 << 11) | 20) & 0xFu; }
#define XB_SPIN(cond, bar) do { unsigned _sp = 0; while (cond) { __builtin_amdgcn_s_sleep(1); \
    if ((++_sp & 255u) == 0u) { if (xb_ld(&(bar)[XB_TMO])) break; if (_sp > XB_SPIN_CAP) { atomicAdd(&(bar)[XB_TMO], 1u); break; } } } } while (0)

struct XcdBarrier { unsigned* bar; unsigned x; volatile LAS unsigned* st; };

__device__ __forceinline__ XcdBarrier xcd_barrier_post(unsigned* bar, volatile LAS unsigned* st) {
    XcdBarrier b; b.bar = bar; b.x = xb_xcc_id(); b.st = st;
    if (threadIdx.x == 0) (void)xb_add(&bar[XB_XCNT(b.x)], 1u);
    return b;
}
__device__ __forceinline__ void xcd_barrier_complete(unsigned* bar, unsigned x, unsigned& nloc, unsigned& nx) {
    const unsigned G = gridDim.x * gridDim.y * gridDim.z;
    unsigned sum, cnt, mine, sp = 0u;
    for (;;) {
        sum = 0u; cnt = 0u; mine = 0u;
#pragma unroll
        for (unsigned j = 0; j < 16; ++j) { const unsigned c = xb_ld(&bar[XB_XCNT(j)]); sum += c; cnt += (c > 0u) ? 1u : 0u; mine = (j == x) ? c : mine; }
        if (sum == G) break;
        __builtin_amdgcn_s_sleep(1);
        if ((++sp & 255u) == 0u) { if (xb_ld(&bar[XB_TMO])) break; if (sp > XB_SPIN_CAP) { atomicAdd(&bar[XB_TMO], 1u); break; } }
    }
    nloc = mine > 0u ? mine : 1u; nx = cnt > 0u ? cnt : 1u;
}
__device__ __forceinline__ void xcd_barrier(const XcdBarrier& b) {
    asm volatile("s_waitcnt vmcnt(0)" ::: "memory");
    __syncthreads();
    if (threadIdx.x == 0) {
        unsigned* bar = b.bar;
        __builtin_amdgcn_s_waitcnt(0);
        unsigned nloc = b.st[0], nx = b.st[1];
        if (nloc == 0u) { xcd_barrier_complete(bar, b.x, nloc, nx); b.st[0] = nloc; b.st[1] = nx; }
        const unsigned old = xb_add(&bar[XB_XSUB(b.x)], 1u);
        const unsigned gen = old / nloc;
        if (old + 1u == (gen + 1u) * nloc) {
            __builtin_amdgcn_fence(__ATOMIC_RELEASE, "agent");
            asm volatile("s_waitcnt vmcnt(0)" ::: "memory");
            const unsigned og = xb_add(&bar[XB_TOP], 1u);
            const unsigned tg = og / nx;
            if (og + 1u == (tg + 1u) * nx) xb_add(&bar[XB_TOPGEN], 1u);
            else XB_SPIN(xb_ld(&bar[XB_TOPGEN]) == tg, bar);
            __builtin_amdgcn_fence(__ATOMIC_ACQUIRE, "agent");
            xb_add(&bar[XB_XGEN(b.x)], 1u);
            asm volatile("s_waitcnt vmcnt(0)" ::: "memory");
        } else {
            XB_SPIN(xb_ld(&bar[XB_XGEN(b.x)]) == gen, bar);
            __builtin_amdgcn_fence(__ATOMIC_ACQUIRE, "agent");
            asm volatile("s_waitcnt vmcnt(0)" ::: "memory");
        }
    }
    __syncthreads();
}

__device__ __forceinline__ float wave_sum(float v) {
#pragma unroll
    for (int o = 32; o >= 1; o >>= 1) v += __shfl_xor(v, o);
    return v;
}
__device__ __forceinline__ float wave_max(float v) {
#pragma unroll
    for (int o = 32; o >= 1; o >>= 1) v = fmaxf(v, __shfl_xor(v, o));
    return v;
}
__device__ __forceinline__ float log_sigmoid(float x) { return fminf(x, 0.f) - log1pf(expf(-fabsf(x))); }


__device__ __forceinline__ void d_rmsnorm(int vb, int t, float* sm, const float* __restrict__ in, const float* __restrict__ g, bf16_t* __restrict__ out,
                                          const float* __restrict__ w_in, float* __restrict__ gpre) {
    float* red = sm;
    const int row = vb;
    const float4* p = (const float4*)(in + (size_t)row * D);
    float4 a = p[t], b = p[t + 256];
    float s = a.x * a.x + a.y * a.y + a.z * a.z + a.w * a.w + b.x * b.x + b.y * b.y + b.z * b.z + b.w * b.w;
    s = wave_sum(s);
    __syncthreads();
    if ((t & 63) == 0) red[t >> 6] = s;
    __syncthreads();
    const float tot = red[0] + red[1] + red[2] + red[3];
    const float r = rsqrtf(tot * (1.0f / D) + EPS);
    const float4* gp = (const float4*)g;
    float4 ga = gp[t], gb = gp[t + 256];
    float hv[8] = {a.x * r * ga.x, a.y * r * ga.y, a.z * r * ga.z, a.w * r * ga.w, b.x * r * gb.x, b.y * r * gb.y, b.z * r * gb.z, b.w * r * gb.w};
    uint2 o0, o1;
    o0.x = pk2(hv[0], hv[1]); o0.y = pk2(hv[2], hv[3]); o1.x = pk2(hv[4], hv[5]); o1.y = pk2(hv[6], hv[7]);
    *(uint2*)(out + (size_t)row * D + t * 4) = o0;
    *(uint2*)(out + (size_t)row * D + 1024 + t * 4) = o1;
    if (gpre) {
        float gs[8];
#pragma unroll
        for (int c = 0; c < 8; ++c) gs[c] = 0.f;
#pragma unroll
        for (int j = 0; j < 8; ++j) {
            const int k = (j < 4) ? (t * 4 + j) : (1024 + t * 4 + (j - 4));
            const float4 w0 = *(const float4*)(w_in + (size_t)k * INC + C_MI), w1 = *(const float4*)(w_in + (size_t)k * INC + C_MI + 4);
            gs[0] = fmaf(hv[j], w0.x, gs[0]); gs[1] = fmaf(hv[j], w0.y, gs[1]); gs[2] = fmaf(hv[j], w0.z, gs[2]); gs[3] = fmaf(hv[j], w0.w, gs[3]);
            gs[4] = fmaf(hv[j], w1.x, gs[4]); gs[5] = fmaf(hv[j], w1.y, gs[5]); gs[6] = fmaf(hv[j], w1.z, gs[6]); gs[7] = fmaf(hv[j], w1.w, gs[7]);
        }
#pragma unroll
        for (int c = 0; c < 8; ++c) gs[c] = wave_sum(gs[c]);
        __syncthreads();
        if ((t & 63) == 0) {
#pragma unroll
            for (int c = 0; c < 8; ++c) red[8 + (t >> 6) * 8 + c] = gs[c];
        }
        __syncthreads();
        if (t < 8) gpre[(size_t)row * 8 + t] = red[8 + t] + red[16 + t] + red[24 + t] + red[32 + t];
    }
}

namespace pg8 {
typedef short bf16x8 __attribute__((ext_vector_type(8)));
typedef float f32x4 __attribute__((ext_vector_type(4)));
constexpr int BM = 256, BK = 64, HALF = 128, HTB = HALF * BK * 2, NXCD = 8, WGM = 8;
__device__ __forceinline__ int lds_byte(int r, int c) { const int st = (r >> 4) * 2 + (c >> 5), rr = r & 15, cc = c & 31, ob = rr * 64 + cc * 2; return st * 1024 + (ob ^ (((ob >> 9) & 1) << 5)); }
__device__ __forceinline__ void stage_rc(int b, int& R, int& C) { const int st = b / 1024, sb = b % 1024, swz = sb ^ (((sb >> 9) & 1) << 5); R = (st >> 1) * 16 + swz / 64; C = (st & 1) * 32 + (swz % 64) / 2; }
struct Unit { int pm, pn; };
struct GJob {
    const bf16_t* A; const bf16_t* Bt;
    int lda, ldb, K, nM, nN;
    int a_pn_shift, a_pn_mask, a_pn_step;
    int b_pm_shift, b_pm_step, b_pn_step;
    int a_pm_step;
    float escale;
    const float* gs; float* denp; const float* qn; const float* gvec; const bf16_t* mo;
    float* C; int ldc; const float* R; int ldr;
    int mode;
};
__device__ __forceinline__ bool unit_next(const GJob& g, int i, Unit& u) {
    const int nwg = g.nM * g.nN;
    const long L = (long)i * gridDim.x + blockIdx.x; if (L >= nwg) return false;
    int wgid = (int)L; { const int q = nwg / NXCD, r = nwg % NXCD, xcd = wgid % NXCD, off = wgid / NXCD; wgid = (xcd < r ? xcd * (q + 1) : r * (q + 1) + (xcd - r) * q) + off; }
    const int nig = WGM * g.nN, gid = wgid / nig, fm = gid * WGM, gsz = (g.nM - fm) < WGM ? (g.nM - fm) : WGM;
    u.pm = fm + ((wgid % nig) % gsz); u.pn = (wgid % nig) / gsz; return true;
}
template <int MODE> __device__ __forceinline__ void epilogue(const GJob& g, f32x4 (&acc)[2][2][4][2], const Unit& u, int wr, int wc, int fr, int fq, LAS unsigned char* xlds) {
    const int row0 = u.pm * BM + wr * 64 + fr;
    if constexpr (MODE == 0) {
        const int col0 = u.pn * BM + wc * 32 + 4 * fq;
#pragma unroll
        for (int ai = 0; ai < 2; ++ai)
#pragma unroll
            for (int m = 0; m < 4; ++m) {
                const int row = row0 + ai * HALF + m * 16;
                float* rowp = g.C + (size_t)row * g.ldc + col0;
                const float* rp = g.R ? g.R + (size_t)row * g.ldr + col0 : nullptr;
#pragma unroll
                for (int bj = 0; bj < 2; ++bj)
#pragma unroll
                    for (int n = 0; n < 2; ++n) {
                        f32x4 v = acc[ai][bj][m][n];
                        if (rp) v = v + *(const f32x4*)(rp + bj * HALF + n * 16);
                        *(f32x4*)(rowp + bj * HALF + n * 16) = v;
                    }
            }
    } else if constexpr (MODE == 6) {
        const int h = u.pn; const size_t t0 = (size_t)u.pm * BM;
        bf16_t* Cb = (bf16_t*)g.C;
#pragma unroll
        for (int ai = 0; ai < 2; ++ai)
#pragma unroll
            for (int m = 0; m < 4; ++m) {
                const int l = ai * HALF + wr * 64 + m * 16 + fr;
                const float M2 = g.gs[((t0 + l) * 4 + h) * 8 + 1];
                bf16_t* rowp = Cb + (t0 + l) * 2048 + h * 512 + wc * 32 + 4 * fq;
                float rs = 0.f;
#pragma unroll
                for (int bj = 0; bj < 2; ++bj)
#pragma unroll
                    for (int n = 0; n < 2; ++n) {
                        const f32x4 a = acc[ai][bj][m][n];
                        const int s0 = bj * HALF + wc * 32 + n * 16 + 4 * fq;
                        float p[4];
#pragma unroll
                        for (int r = 0; r < 4; ++r) { const float u2 = g.gs[((t0 + s0 + r) * 4 + h) * 8 + 0]; p[r] = (s0 + r <= l) ? a[r] * __builtin_amdgcn_exp2f(u2 - M2) : 0.f; rs += p[r]; }
                        uint2 o; o.x = pk2(p[0], p[1]); o.y = pk2(p[2], p[3]);
                        *(uint2*)(rowp + bj * HALF + n * 16) = o;
                    }
                rs += __shfl_xor(rs, 16); rs += __shfl_xor(rs, 32);
                if (fq == 0) g.denp[((t0 + l) * 4 + h) * 4 + wc] = rs;
            }
    } else if constexpr (MODE == 7) {
        float* Ct = g.C + (size_t)(u.pm * 4 + u.pn) * 65536;
        const int col0 = wc * 32 + 4 * fq;
#pragma unroll
        for (int ai = 0; ai < 2; ++ai)
#pragma unroll
            for (int m = 0; m < 4; ++m) {
                float* rowp = Ct + (size_t)(ai * HALF + wr * 64 + m * 16 + fr) * 256 + col0;
#pragma unroll
                for (int bj = 0; bj < 2; ++bj)
#pragma unroll
                    for (int n = 0; n < 2; ++n) *(f32x4*)(rowp + bj * HALF + n * 16) = acc[ai][bj][m][n];
            }
    } else if constexpr (MODE == 8) {
        const int h = u.pn; const size_t t0 = (size_t)u.pm * BM;
        LAS float* X0 = (LAS float*)xlds + wr * 512;
#pragma unroll
        for (int ai = 0; ai < 2; ++ai)
#pragma unroll
            for (int m = 0; m < 4; ++m) {
                const size_t th = (t0 + ai * HALF + wr * 64 + m * 16 + fr) * 4 + h;
                const f32x4 dp = *(const f32x4*)(g.denp + th * 4);
                const float den = (dp[0] + dp[1]) + (dp[2] + dp[3]) + g.gs[th * 8 + 3] * g.qn[th];
                const float rden = 1.0f / fmaxf(fabsf(den), g.gs[th * 8 + 4]);
                float ss = 0.f;
#pragma unroll
                for (int bj = 0; bj < 2; ++bj)
#pragma unroll
                    for (int n = 0; n < 2; ++n) { f32x4 a = acc[ai][bj][m][n] * rden; acc[ai][bj][m][n] = a; ss += (a[0] * a[0] + a[1] * a[1]) + (a[2] * a[2] + a[3] * a[3]); }
                ss += __shfl_xor(ss, 16); ss += __shfl_xor(ss, 32);
                if (fq == 0) X0[(ai * 64 + m * 16 + fr) * 4 + wc] = ss;
            }
        asm volatile("s_waitcnt lgkmcnt(0)" ::: "memory"); __builtin_amdgcn_s_barrier(); asm volatile("" ::: "memory");
        bf16_t* Cb = (bf16_t*)g.C;
        const int col0 = wc * 32 + 4 * fq;
#pragma unroll
        for (int ai = 0; ai < 2; ++ai)
#pragma unroll
            for (int m = 0; m < 4; ++m) {
                const f32x4 p4 = *(const LAS f32x4*)(X0 + (ai * 64 + m * 16 + fr) * 4);
                const float rsn = rsqrtf(((p4[0] + p4[1]) + (p4[2] + p4[3])) * (1.0f / 256.0f) + EPS);
                const size_t t = t0 + ai * HALF + wr * 64 + m * 16 + fr;
                bf16_t* rowp = Cb + t * 2048 + h * 256 + col0;
                const bf16_t* mop = g.mo + t * 1024 + h * 256 + col0;
#pragma unroll
                for (int bj = 0; bj < 2; ++bj)
#pragma unroll
                    for (int n = 0; n < 2; ++n) {
                        const f32x4 a = acc[ai][bj][m][n];
                        const ushort4 mo4 = *(const ushort4*)(mop + bj * HALF + n * 16);
                        const f32x4 gv = *(const f32x4*)(g.gvec + h * 256 + col0 + bj * HALF + n * 16);
                        const float o0 = a[0] * rsn * gv[0] / (1.0f + __expf(-bf2f(mo4.x)));
                        const float o1 = a[1] * rsn * gv[1] / (1.0f + __expf(-bf2f(mo4.y)));
                        const float o2 = a[2] * rsn * gv[2] / (1.0f + __expf(-bf2f(mo4.z)));
                        const float o3 = a[3] * rsn * gv[3] / (1.0f + __expf(-bf2f(mo4.w)));
                        uint2 o; o.x = pk2(o0, o1); o.y = pk2(o2, o3);
                        *(uint2*)(rowp + bj * HALF + n * 16) = o;
                    }
            }
    } else if constexpr (MODE == 5) {
        LAS float* X0 = (LAS float*)xlds + wr * 512;
        LAS float* X1 = (LAS float*)xlds + 1024 + wr * 512;
#pragma unroll
        for (int ai = 0; ai < 2; ++ai)
#pragma unroll
            for (int m = 0; m < 4; ++m) {
                float v = -INFINITY;
#pragma unroll
                for (int bj = 0; bj < 2; ++bj)
#pragma unroll
                    for (int n = 0; n < 2; ++n) { const f32x4 a = acc[ai][bj][m][n]; v = fmaxf(v, fmaxf(fmaxf(a[0], a[1]), fmaxf(a[2], a[3]))); }
                v = fmaxf(v, __shfl_xor(v, 16)); v = fmaxf(v, __shfl_xor(v, 32));
                if (fq == 0) X0[(ai * 64 + m * 16 + fr) * 4 + wc] = v;
            }
        asm volatile("s_waitcnt lgkmcnt(0)" ::: "memory"); __builtin_amdgcn_s_barrier(); asm volatile("" ::: "memory");
#pragma unroll
        for (int ai = 0; ai < 2; ++ai)
#pragma unroll
            for (int m = 0; m < 4; ++m) {
                const f32x4 p4 = *(const LAS f32x4*)(X0 + (ai * 64 + m * 16 + fr) * 4);
                const float mxr = fmaxf(fmaxf(p4[0], p4[1]), fmaxf(p4[2], p4[3])) * g.escale;
                float s = 0.f;
#pragma unroll
                for (int bj = 0; bj < 2; ++bj)
#pragma unroll
                    for (int n = 0; n < 2; ++n) { f32x4 a = acc[ai][bj][m][n];
                        a[0] = __builtin_amdgcn_exp2f(a[0] * g.escale - mxr); a[1] = __builtin_amdgcn_exp2f(a[1] * g.escale - mxr); a[2] = __builtin_amdgcn_exp2f(a[2] * g.escale - mxr); a[3] = __builtin_amdgcn_exp2f(a[3] * g.escale - mxr);
                        acc[ai][bj][m][n] = a; s += (a[0] + a[1]) + (a[2] + a[3]); }
                s += __shfl_xor(s, 16); s += __shfl_xor(s, 32);
                if (fq == 0) X1[(ai * 64 + m * 16 + fr) * 4 + wc] = s;
            }
        asm volatile("s_waitcnt lgkmcnt(0)" ::: "memory"); __builtin_amdgcn_s_barrier(); asm volatile("" ::: "memory");
        bf16_t* Cb = (bf16_t*)g.C;
        const int col0 = u.pn * BM + wc * 32 + 4 * fq;
#pragma unroll
        for (int ai = 0; ai < 2; ++ai)
#pragma unroll
            for (int m = 0; m < 4; ++m) {
                const f32x4 p4 = *(const LAS f32x4*)(X1 + (ai * 64 + m * 16 + fr) * 4);
                const float inv = 1.0f / ((p4[0] + p4[1]) + (p4[2] + p4[3]));
                bf16_t* rowp = Cb + (size_t)(row0 + ai * HALF + m * 16) * g.ldc + col0;
#pragma unroll
                for (int bj = 0; bj < 2; ++bj)
#pragma unroll
                    for (int n = 0; n < 2; ++n) {
                        const f32x4 a = acc[ai][bj][m][n];
                        uint2 o; o.x = pk2(a[0] * inv, a[1] * inv); o.y = pk2(a[2] * inv, a[3] * inv);
                        *(uint2*)(rowp + bj * HALF + n * 16) = o;
                    }
            }
    } else {
        bf16_t* Cb = (bf16_t*)g.C; int ccol = u.pn * BM;
        if constexpr (MODE == 4) { Cb += (size_t)(u.pn >> 2) * P6S; ccol = (u.pn & 3) * 256; }
        const int col0 = ccol + wc * 32 + 4 * fq;
#pragma unroll
        for (int ai = 0; ai < 2; ++ai)
#pragma unroll
            for (int m = 0; m < 4; ++m) {
                bf16_t* rowp = Cb + (size_t)(row0 + ai * HALF + m * 16) * g.ldc + col0;
#pragma unroll
                for (int bj = 0; bj < 2; ++bj)
#pragma unroll
                    for (int n = 0; n < 2; ++n) {
                        const f32x4 v = acc[ai][bj][m][n];
                        uint2 o; o.x = pk2(v[0], v[1]); o.y = pk2(v[2], v[3]);
                        *(uint2*)(rowp + bj * HALF + n * 16) = o;
                    }
            }
    }
}
template <int MODE> __device__ __forceinline__ void gemm_phase(LAS unsigned char* lds, const GJob& g, int tid) {
    const int wid = __builtin_amdgcn_readfirstlane(tid >> 6), lane = tid & 63, wr = wid >> 2, wc = wid & 3, fr = lane & 15, fq = lane >> 4;
    const int K = g.K, nt = K / BK;
    unsigned voffA[2], voffB[2];
#pragma unroll
    for (int i = 0; i < 2; ++i) { int R, C; stage_rc(tid * 16 + i * 8192, R, C);
        voffA[i] = (unsigned)(R * g.lda + C) * 2u; voffB[i] = (unsigned)(R * g.ldb + C) * 2u; }
    const size_t kstep = (size_t)(BK * 2);
    const size_t hstepA = (size_t)HALF * g.lda * 2, hstepB = (size_t)HALF * g.ldb * 2;
    const unsigned ldsw = (unsigned)wid * 1024u;
    const int aoff = lds_byte(wr * 64 + fr, fq * 8), boff = lds_byte(wc * 32 + fr, fq * 8);
#define PG8_SA(b, h) (((b) * 2 + (h)) * HTB)
#define PG8_SB(b, h) ((4 + (b) * 2 + (h)) * HTB)
#define PG8_STAGE(bufoff, gbase, voff) do { _Pragma("unroll") for (int _i = 0; _i < 2; ++_i) \
        __builtin_amdgcn_global_load_lds((const unsigned*)((const char*)(gbase) + (voff)[_i]), (LAS unsigned*)(lds + (bufoff) + ldsw + _i * 8192), 16, 0, 0); } while (0)
#define PG8_LDA(dst, b, h) do { _Pragma("unroll") for (int m = 0; m < 4; ++m) _Pragma("unroll") for (int k = 0; k < 2; ++k) dst[m][k] = *(const LAS bf16x8*)(lds + PG8_SA(b, h) + aoff + m * 2048 + k * 1024); } while (0)
#define PG8_LDB(dst, b, h) do { _Pragma("unroll") for (int n = 0; n < 2; ++n) _Pragma("unroll") for (int k = 0; k < 2; ++k) dst[n][k] = *(const LAS bf16x8*)(lds + PG8_SB(b, h) + boff + n * 2048 + k * 1024); } while (0)
#define PG8_MMA(ai, bj, At, Bt) do { __builtin_amdgcn_s_setprio(1); _Pragma("unroll") for (int m = 0; m < 4; ++m) _Pragma("unroll") for (int n = 0; n < 2; ++n) _Pragma("unroll") for (int k = 0; k < 2; ++k) \
        acc[ai][bj][m][n] = __builtin_amdgcn_mfma_f32_16x16x32_bf16(Bt[n][k], At[m][k], acc[ai][bj][m][n], 0, 0, 0); __builtin_amdgcn_s_setprio(0); } while (0)
#define PG8_WAIT_V(n) asm volatile("s_waitcnt vmcnt(" #n ")" ::: "memory")
#define PG8_WAIT_L(n) asm volatile("s_waitcnt lgkmcnt(" #n ")" ::: "memory")
#define PG8_BAR __builtin_amdgcn_s_barrier()
#define PG8_SCHED __builtin_amdgcn_sched_barrier(0)
#define PG8_ABASE(u) ((const char*)g.A + ((size_t)(u).pm * g.a_pm_step + (size_t)(((u).pn >> g.a_pn_shift) & g.a_pn_mask) * g.a_pn_step) * 2)
#define PG8_BBASE(u) ((const char*)g.Bt + ((size_t)(u).pn * g.b_pn_step + (size_t)((u).pm >> g.b_pm_shift) * g.b_pm_step) * 2)
    Unit cur, nxt; int ui = 0;
    if (!unit_next(g, 0, cur)) return;
    f32x4 acc[2][2][4][2];
#pragma unroll
    for (int a = 0; a < 2; ++a)
#pragma unroll
        for (int b = 0; b < 2; ++b)
#pragma unroll
            for (int m = 0; m < 4; ++m)
#pragma unroll
                for (int n = 0; n < 2; ++n) acc[a][b][m][n] = (f32x4){0.f, 0.f, 0.f, 0.f};
    bf16x8 At[4][2], B0[2][2], B1[2][2];
    const char* cA = PG8_ABASE(cur); const char* cB = PG8_BBASE(cur);
    PG8_STAGE(PG8_SB(0, 0), cB, voffB); PG8_STAGE(PG8_SA(0, 0), cA, voffA); PG8_STAGE(PG8_SB(0, 1), cB + hstepB, voffB); PG8_STAGE(PG8_SA(0, 1), cA + hstepA, voffA);
    if (wr == 1) PG8_BAR;
    PG8_WAIT_V(4); PG8_BAR;
    PG8_STAGE(PG8_SB(1, 0), cB + kstep, voffB); PG8_STAGE(PG8_SA(1, 0), cA + kstep, voffA); PG8_STAGE(PG8_SB(1, 1), cB + hstepB + kstep, voffB);
    PG8_WAIT_V(6); PG8_BAR;
    for (;;) {
        const bool has_next = unit_next(g, ui + 1, nxt);
        const char* nA = has_next ? PG8_ABASE(nxt) : cA; const char* nB = has_next ? PG8_BBASE(nxt) : cB;
        for (int t = 0; t < nt; t += 2) {
            const bool last = (t == nt - 2);
            const char* a1 = cA + (size_t)(t + 1) * kstep;
            const char* a2 = last ? nA : cA + (size_t)(t + 2) * kstep; const char* b2 = last ? nB : cB + (size_t)(t + 2) * kstep;
            const char* a3 = a2 + kstep; const char* b3 = b2 + kstep;
            PG8_LDB(B0, 0, 0); PG8_SCHED; PG8_LDA(At, 0, 0); PG8_STAGE(PG8_SA(1, 1), a1 + hstepA, voffA);
            PG8_WAIT_L(8); PG8_BAR; PG8_WAIT_L(0); PG8_MMA(0, 0, At, B0); PG8_BAR; PG8_SCHED;
            PG8_LDB(B1, 0, 1); PG8_STAGE(PG8_SB(0, 0), b2, voffB);
            PG8_BAR; PG8_WAIT_L(0); PG8_MMA(0, 1, At, B1); PG8_BAR;
            PG8_LDA(At, 0, 1); PG8_STAGE(PG8_SA(0, 0), a2, voffA);
            PG8_BAR; PG8_WAIT_L(0); PG8_MMA(1, 0, At, B0); PG8_BAR; PG8_SCHED;
            PG8_STAGE(PG8_SB(0, 1), b2 + hstepB, voffB);
            PG8_WAIT_V(6); PG8_BAR; PG8_MMA(1, 1, At, B1); PG8_BAR;
            PG8_LDB(B0, 1, 0); PG8_SCHED; PG8_LDA(At, 1, 0); PG8_STAGE(PG8_SA(0, 1), a2 + hstepA, voffA);
            PG8_WAIT_L(8); PG8_BAR; PG8_WAIT_L(0); PG8_MMA(0, 0, At, B0); PG8_BAR; PG8_SCHED;
            PG8_LDB(B1, 1, 1); PG8_STAGE(PG8_SB(1, 0), b3, voffB);
            PG8_BAR; PG8_WAIT_L(0); PG8_MMA(0, 1, At, B1); PG8_BAR;
            PG8_LDA(At, 1, 1); PG8_STAGE(PG8_SA(1, 0), a3, voffA);
            PG8_BAR; PG8_WAIT_L(0); PG8_MMA(1, 0, At, B0); PG8_BAR; PG8_SCHED;
            PG8_STAGE(PG8_SB(1, 1), b3 + hstepB, voffB);
            PG8_WAIT_V(6); PG8_BAR; PG8_MMA(1, 1, At, B1); PG8_BAR;
        }
        epilogue<MODE>(g, acc, cur, wr, wc, fr, fq, lds + GEMM_LDS + 1024);
        if (!has_next) break;
#pragma unroll
        for (int a = 0; a < 2; ++a)
#pragma unroll
            for (int b = 0; b < 2; ++b)
#pragma unroll
                for (int m = 0; m < 4; ++m)
#pragma unroll
                    for (int n = 0; n < 2; ++n) acc[a][b][m][n] = (f32x4){0.f, 0.f, 0.f, 0.f};
        cur = nxt; cA = nA; cB = nB; ++ui;
    }
    PG8_WAIT_V(0);
    if (wr == 0) PG8_BAR;
    PG8_BAR;
#undef PG8_SA
#undef PG8_SB
#undef PG8_STAGE
#undef PG8_LDA
#undef PG8_LDB
#undef PG8_MMA
#undef PG8_WAIT_V
#undef PG8_WAIT_L
#undef PG8_BAR
#undef PG8_SCHED
#undef PG8_ABASE
#undef PG8_BBASE
}
}

__device__ __forceinline__ void p0_transpose_item(const float* W, int ldw, int K, int csrc0, bf16_t* WT, int row0, LAS float* scr, int kb, int lane, float wscale) {
    const int k0 = 64 * kb;
#pragma unroll
    for (int i = 0; i < 8; ++i) { const int kk = 8 * i + (lane >> 3), n4 = (lane & 7) * 4;
        const float4 v = *(const float4*)(W + (size_t)(k0 + kk) * ldw + csrc0 + n4);
        scr[kk * 33 + n4] = v.x * wscale; scr[kk * 33 + n4 + 1] = v.y * wscale; scr[kk * 33 + n4 + 2] = v.z * wscale; scr[kk * 33 + n4 + 3] = v.w * wscale; }
    asm volatile("s_waitcnt lgkmcnt(0)" ::: "memory");
    const int c = lane & 7;
#pragma unroll
    for (int j = 0; j < 4; ++j) { const int n = (lane >> 3) + 8 * j; const LAS float* s = scr + (8 * c) * 33 + n;
        uint4 o; o.x = pk2(s[0 * 33], s[1 * 33]); o.y = pk2(s[2 * 33], s[3 * 33]); o.z = pk2(s[4 * 33], s[5 * 33]); o.w = pk2(s[6 * 33], s[7 * 33]);
        *(uint4*)(WT + (size_t)(row0 + n) * K + k0 + 8 * c) = o; }
    asm volatile("s_waitcnt lgkmcnt(0)" ::: "memory");
}

__device__ __forceinline__ void d_conv_silu(int vb, int tid, const bf16_t* __restrict__ p6, const float* __restrict__ cw, const float* __restrict__ cb, bf16_t* __restrict__ c) {
    const int t = vb, s = t % S;
    for (int ch = tid; ch < 1024; ch += 256) {
        float y = cb[ch];
#pragma unroll
        for (int j = 0; j < 4; ++j) {
            const int ss = s - 3 + j;
            if (ss >= 0) y = fmaf(cw[j * 1024 + ch], bf2f(p6[(size_t)(t - 3 + j) * 1024 + ch]), y);
        }
        c[(size_t)t * 1024 + ch] = (bf16_t)f2bf(y / (1.0f + expf(-y)));
    }
}

__device__ __forceinline__ void d_mlstm(int vb, int tid, const bf16_t* __restrict__ mq, const bf16_t* __restrict__ mk, const bf16_t* __restrict__ p6,
                                        const float* __restrict__ gpre, const float* __restrict__ b_mi, const float* __restrict__ b_mf, float* __restrict__ hraw) {
    const int lane = tid & 63, w = tid >> 6;
    const int gid = vb * 4 + w;
    const int e = gid & 255, h = (gid >> 8) & 3, b = gid >> 10;
    const float bi = b_mi[h], bf = b_mf[h];
    float C0 = 0.f, C1 = 0.f, C2 = 0.f, C3 = 0.f, n0 = 0.f, n1 = 0.f, n2 = 0.f, n3 = 0.f, m = 0.f;
    const size_t tb = (size_t)b * S;
    const bf16_t* qp = mq + tb * 1024 + h * 256 + lane * 4;
    const bf16_t* kp = mk + tb * 1024 + h * 256 + lane * 4;
    const bf16_t* pp = p6 + P6S + tb * 1024 + h * 256 + e;
    ushort4 qn = *(const ushort4*)qp, kn = *(const ushort4*)kp;
    const float* gp = gpre + tb * 8;
    float vn = bf2f(pp[0]), in_ = gp[h], fn = gp[4 + h];
    for (int s = 0; s < S; ++s) {
        const float4 q = make_float4(bf2f(qn.x), bf2f(qn.y), bf2f(qn.z), bf2f(qn.w)), k = make_float4(bf2f(kn.x), bf2f(kn.y), bf2f(kn.z), bf2f(kn.w)); const float v = vn, ipre = in_ + bi, fpre = fn + bf;
        if (s + 1 < S) {
            qn = *(const ushort4*)(qp + (size_t)(s + 1) * 1024);
            kn = *(const ushort4*)(kp + (size_t)(s + 1) * 1024);
            vn = bf2f(pp[(size_t)(s + 1) * 1024]); in_ = gp[(size_t)(s + 1) * 8 + h]; fn = gp[(size_t)(s + 1) * 8 + 4 + h];
        }
        const float logf = log_sigmoid(fpre);
        const float mnew = fmaxf(logf + m, ipre);
        const float fd = expf(logf + m - mnew), ig = expf(ipre - mnew);
        m = mnew;
        const float sc = ig * 0.0625f;
        C0 = fd * C0 + sc * k.x * v; C1 = fd * C1 + sc * k.y * v; C2 = fd * C2 + sc * k.z * v; C3 = fd * C3 + sc * k.w * v;
        n0 = fd * n0 + sc * k.x; n1 = fd * n1 + sc * k.y; n2 = fd * n2 + sc * k.z; n3 = fd * n3 + sc * k.w;
        float num = q.x * C0 + q.y * C1 + q.z * C2 + q.w * C3;
        float den = q.x * n0 + q.y * n1 + q.z * n2 + q.w * n3;
        num = wave_sum(num); den = wave_sum(den);
        if (lane == 0) hraw[(tb + s) * 1024 + h * 256 + e] = num / fmaxf(fabsf(den), expf(-mnew));
    }
}

__device__ __forceinline__ void d_mhead_norm(int vb, int tid, const float* __restrict__ hraw, const bf16_t* __restrict__ p6, const float* __restrict__ g, bf16_t* __restrict__ mix) {
    const int t = vb, h = tid >> 6, lane = tid & 63;
    const float4 v = *(const float4*)(hraw + (size_t)t * 1024 + h * 256 + lane * 4);
    float s = v.x * v.x + v.y * v.y + v.z * v.z + v.w * v.w;
    s = wave_sum(s);
    const float r = rsqrtf(s * (1.0f / 256.0f) + EPS);
    const float4 gg = *(const float4*)(g + h * 256 + lane * 4);
    const ushort4 mo = *(const ushort4*)(p6 + 2 * P6S + (size_t)t * 1024 + h * 256 + lane * 4);
    float4 o;
    o.x = v.x * r * gg.x / (1.0f + expf(-bf2f(mo.x)));
    o.y = v.y * r * gg.y / (1.0f + expf(-bf2f(mo.y)));
    o.z = v.z * r * gg.z / (1.0f + expf(-bf2f(mo.z)));
    o.w = v.w * r * gg.w / (1.0f + expf(-bf2f(mo.w)));
    uint2 ob; ob.x = pk2(o.x, o.y); ob.y = pk2(o.z, o.w);
    *(uint2*)(mix + (size_t)t * D + h * 256 + lane * 4) = ob;
}

__device__ __forceinline__ void d_rope(int vb, int tid, bf16_t* __restrict__ p6) {
    const int t = vb, s = t % S;
    for (int idx = tid; idx < 2 * 8 * 64; idx += 256) {
        const int i = idx & 63, hd = (idx >> 6) & 7, qk = idx >> 9;
        const float inv = exp2f(-(float)i * 0.20762050593046014f);
        const float ang = (float)s * inv;
        float sn, cs; sincosf(ang, &sn, &cs);
        bf16_t* p = p6 + (size_t)(3 + qk) * P6S + (size_t)t * 1024 + hd * 128;
        const float x1 = bf2f(p[i]), x2 = bf2f(p[64 + i]);
        p[i] = (bf16_t)f2bf(x1 * cs - x2 * sn);
        p[64 + i] = (bf16_t)f2bf(x2 * cs + x1 * sn);
    }
}

__device__ __forceinline__ void d_dilated(int vb, int tid, float* sm, const bf16_t* __restrict__ p6, const float* __restrict__ g_ahead, bf16_t* __restrict__ mix) {
    float (*qs)[128] = (float (*)[128])sm;
    float (*ps)[576] = (float (*)[576])(sm + 512);
    const int lane = tid & 63, w = tid >> 6;
    const int gid = vb * 4 + w;
    const int s = gid % S, hd = (gid / S) & 7, b = gid / (S * 8);
    const size_t t = (size_t)b * S + s;
    const bf16_t* qrow = p6 + 3 * P6S + t * 1024 + hd * 128;
    __syncthreads();
    qs[w][lane] = bf2f(qrow[lane]); qs[w][lane + 64] = bf2f(qrow[lane + 64]);
    __syncthreads();
    const float scale = 0.08838834764831845f;
    float mloc = -INFINITY;
    for (int br = 0; br < 3; ++br) {
        const int dil = br == 0 ? 1 : (br == 1 ? 4 : 16);
        for (int jj = 0; jj < 192; jj += 64) {
            const int j = jj + lane;
            float sc = -INFINITY;
            if (j <= 128 && s - j * dil >= 0) {
                const bf16_t* krow = p6 + 4 * P6S + (t - (size_t)j * dil) * 1024 + hd * 128;
                float d = 0.f;
#pragma unroll 8
                for (int c = 0; c < 128; c += 4) {
                    const ushort4 kv = *(const ushort4*)(krow + c);
                    d = fmaf(qs[w][c], bf2f(kv.x), d); d = fmaf(qs[w][c + 1], bf2f(kv.y), d); d = fmaf(qs[w][c + 2], bf2f(kv.z), d); d = fmaf(qs[w][c + 3], bf2f(kv.w), d);
                }
                sc = d * scale;
            }
            ps[w][br * 192 + j] = sc;
            mloc = fmaxf(mloc, sc);
        }
    }
    const float mx = wave_max(mloc);
    __syncthreads();
    float lsum = 0.f;
    for (int i = lane; i < 3 * 192; i += 64) {
        const float sc = ps[w][i];
        const float pv = (sc == -INFINITY) ? 0.f : expf(sc - mx);
        ps[w][i] = pv; lsum += pv;
    }
    const float tot = wave_sum(lsum);
    __syncthreads();
    float o0 = 0.f, o1 = 0.f;
    for (int br = 0; br < 3; ++br) {
        const int dil = br == 0 ? 1 : (br == 1 ? 4 : 16);
        for (int j = 0; j <= 128; ++j) {
            if (s - j * dil < 0) break;
            const float pv = ps[w][br * 192 + j];
            const bf16_t* vrow = p6 + 5 * P6S + (t - (size_t)j * dil) * 1024 + hd * 128;
            o0 = fmaf(pv, bf2f(vrow[lane]), o0); o1 = fmaf(pv, bf2f(vrow[lane + 64]), o1);
        }
    }
    o0 /= tot; o1 /= tot;
    float ss = wave_sum(o0 * o0 + o1 * o1);
    const float r = rsqrtf(ss * (1.0f / 128.0f) + EPS);
    bf16_t* orow = mix + t * D + 1024 + hd * 128;
    orow[lane] = (bf16_t)f2bf(o0 * r * g_ahead[hd * 128 + lane]);
    orow[lane + 64] = (bf16_t)f2bf(o1 * r * g_ahead[hd * 128 + lane + 64]);
}

__device__ __forceinline__ void d_cross(int vb, int tid, float* sm, const bf16_t* __restrict__ q, const float* __restrict__ km, const float* __restrict__ vm, bf16_t* __restrict__ o) {
    float (*qs)[512] = (float (*)[512])sm;
    float (*ps)[256] = (float (*)[256])(sm + 2048);
    const int lane = tid & 63, w = tid >> 6;
    const int t = vb, hd = w, b = t / S;
    const bf16_t* qrow = q + (size_t)t * D + hd * 512;
    __syncthreads();
    for (int i = lane; i < 512; i += 64) qs[w][i] = bf2f(qrow[i]);
    __syncthreads();
    const float scale = 0.04419417382415922f;
    float sc[4]; float mloc = -INFINITY;
#pragma unroll
    for (int r = 0; r < 4; ++r) {
        const int mi = lane + 64 * r;
        const float* krow = km + ((size_t)b * 256 + mi) * D + hd * 512;
        float d = 0.f;
#pragma unroll 8
        for (int c = 0; c < 512; c += 4) {
            const float4 kv = *(const float4*)(krow + c);
            d = fmaf(qs[w][c], kv.x, d); d = fmaf(qs[w][c + 1], kv.y, d); d = fmaf(qs[w][c + 2], kv.z, d); d = fmaf(qs[w][c + 3], kv.w, d);
        }
        sc[r] = d * scale; mloc = fmaxf(mloc, sc[r]);
    }
    const float mx = wave_max(mloc);
    float lsum = 0.f;
#pragma unroll
    for (int r = 0; r < 4; ++r) { const float pv = expf(sc[r] - mx); ps[w][lane + 64 * r] = pv; lsum += pv; }
    const float tot = wave_sum(lsum);
    __syncthreads();
    float acc[8];
#pragma unroll
    for (int i = 0; i < 8; ++i) acc[i] = 0.f;
    for (int mi = 0; mi < 256; ++mi) {
        const float pv = ps[w][mi];
        const float* vrow = vm + ((size_t)b * 256 + mi) * D + hd * 512;
#pragma unroll
        for (int i = 0; i < 8; ++i) acc[i] = fmaf(pv, vrow[lane + 64 * i], acc[i]);
    }
    bf16_t* orow = o + (size_t)t * D + hd * 512;
#pragma unroll
    for (int i = 0; i < 8; ++i) orow[lane + 64 * i] = (bf16_t)f2bf(acc[i] / tot);
}

__device__ __forceinline__ void wave_argmax(float& best, int& bidx) {
#pragma unroll
    for (int o = 32; o >= 1; o >>= 1) {
        const float ob = __shfl_xor(best, o); const int oi = __shfl_xor(bidx, o);
        if (ob > best || (ob == best && oi < bidx)) { best = ob; bidx = oi; }
    }
}
__device__ __forceinline__ void d_peer_topk(int vb, int tid, float* sm, const bf16_t* __restrict__ qp, const float* __restrict__ sub_keys, int* __restrict__ ids, float* __restrict__ gates) {
    float (*qs)[256] = (float (*)[256])sm;
    const int lane = tid & 63, w = tid >> 6;
    const int gid = vb * 4 + w;
    const int hd = gid & 7, t = gid >> 3;
    const bf16_t* qrow = qp + (size_t)t * D + hd * 256;
    __syncthreads();
    for (int i = lane; i < 256; i += 64) qs[w][i] = bf2f(qrow[i]);
    __syncthreads();
    float tops[2]; int topi[2];
#pragma unroll
    for (int p = 0; p < 2; ++p) {
        float v0, v1;
        {
            const float* k0 = sub_keys + ((size_t)(hd * 2 + p) * 128 + lane) * 128;
            const float* k1 = k0 + 64 * 128;
            float d0 = 0.f, d1 = 0.f;
#pragma unroll 8
            for (int c = 0; c < 128; c += 4) {
                const float4 a = *(const float4*)(k0 + c), bb = *(const float4*)(k1 + c);
                const float q0 = qs[w][p * 128 + c], q1 = qs[w][p * 128 + c + 1], q2 = qs[w][p * 128 + c + 2], q3 = qs[w][p * 128 + c + 3];
                d0 = fmaf(q0, a.x, d0); d0 = fmaf(q1, a.y, d0); d0 = fmaf(q2, a.z, d0); d0 = fmaf(q3, a.w, d0);
                d1 = fmaf(q0, bb.x, d1); d1 = fmaf(q1, bb.y, d1); d1 = fmaf(q2, bb.z, d1); d1 = fmaf(q3, bb.w, d1);
            }
            v0 = d0; v1 = d1;
        }
        float ts = 0.f; int ti = 0;
        for (int it = 0; it < 16; ++it) {
            float best; int bidx;
            if (v0 >= v1) { best = v0; bidx = lane; } else { best = v1; bidx = lane + 64; }
            wave_argmax(best, bidx);
            if (lane == it) { ts = best; ti = bidx; }
            if (bidx == lane) v0 = -INFINITY;
            if (bidx == lane + 64) v1 = -INFINITY;
        }
        tops[p] = ts; topi[p] = ti;
    }
    float cv[4]; int ci[4];
#pragma unroll
    for (int r = 0; r < 4; ++r) {
        const int c = lane * 4 + r, i = c >> 4, j = c & 15;
        const float s0 = __shfl(tops[0], i), s1 = __shfl(tops[1], j);
        const int i0 = __shfl(topi[0], i), i1 = __shfl(topi[1], j);
        cv[r] = s0 + s1; ci[r] = i0 * 128 + i1;
    }
    float bs = 0.f; int bid = 0;
    for (int it = 0; it < 16; ++it) {
        float best = cv[0]; int bidx = lane * 4;
#pragma unroll
        for (int r = 1; r < 4; ++r) if (cv[r] > best) { best = cv[r]; bidx = lane * 4 + r; }
        wave_argmax(best, bidx);
        const int owner = bidx >> 2, rr = bidx & 3;
        int myid = ci[0];
        if (rr == 1) myid = ci[1]; else if (rr == 2) myid = ci[2]; else if (rr == 3) myid = ci[3];
        const int eid = __shfl(myid, owner);
        if (lane == it) { bs = best; bid = eid; }
        if (owner == lane) {
#pragma unroll
            for (int r = 0; r < 4; ++r) if (rr == r) cv[r] = -INFINITY;
        }
    }
    float v = lane < 16 ? bs : -INFINITY;
    const float mx = wave_max(v);
    const float ev = lane < 16 ? expf(bs - mx) : 0.f;
    const float tot = wave_sum(ev);
    if (lane < 16) {
        ids[(size_t)t * 128 + hd * 16 + lane] = bid;
        gates[(size_t)t * 128 + hd * 16 + lane] = ev / tot;
    }
}

__device__ __forceinline__ void d_peer_out(int vb, int tid, float* sm, const bf16_t* __restrict__ h3, const float* __restrict__ x2, const int* __restrict__ ids, const float* __restrict__ gates,
                                           const bf16_t* __restrict__ u_tab, const bf16_t* __restrict__ v_tab, const float* __restrict__ g_final, float* __restrict__ out) {
    float (*part)[2048] = (float (*)[2048])sm;
    float* red = sm + 4 * 2048;
    const int lane = tid & 63, w = tid >> 6, t = vb;
    float4 xr[8], acc[8];
    const bf16_t* hrow = h3 + (size_t)t * D;
#pragma unroll
    for (int i = 0; i < 8; ++i) { const ushort4 hv = *(const ushort4*)(hrow + i * 256 + lane * 4);
        xr[i] = make_float4(bf2f(hv.x), bf2f(hv.y), bf2f(hv.z), bf2f(hv.w)); acc[i] = make_float4(0.f, 0.f, 0.f, 0.f); }
    for (int j = 0; j < 32; ++j) {
        const int slot = w * 32 + j;
        const int e = ids[(size_t)t * 128 + slot];
        const float gt = gates[(size_t)t * 128 + slot];
        const bf16_t* ur = u_tab + (size_t)e * D;
        const bf16_t* vr = v_tab + (size_t)e * D;
        float d = 0.f;
#pragma unroll
        for (int i = 0; i < 8; ++i) {
            const ushort4 u = *(const ushort4*)(ur + i * 256 + lane * 4);
            d = fmaf(xr[i].x, bf2f(u.x), d); d = fmaf(xr[i].y, bf2f(u.y), d); d = fmaf(xr[i].z, bf2f(u.z), d); d = fmaf(xr[i].w, bf2f(u.w), d);
        }
        d = wave_sum(d);
        const float act = 0.5f * d * (1.0f + erff(d * 0.7071067811865476f));
        const float cf = gt * act;
#pragma unroll
        for (int i = 0; i < 8; ++i) {
            const ushort4 v = *(const ushort4*)(vr + i * 256 + lane * 4);
            acc[i].x = fmaf(cf, bf2f(v.x), acc[i].x); acc[i].y = fmaf(cf, bf2f(v.y), acc[i].y); acc[i].z = fmaf(cf, bf2f(v.z), acc[i].z); acc[i].w = fmaf(cf, bf2f(v.w), acc[i].w);
        }
    }
    __syncthreads();
#pragma unroll
    for (int i = 0; i < 8; ++i) *(float4*)&part[w][i * 256 + lane * 4] = acc[i];
    __syncthreads();
    float4 r0, r1;
    {
        const float4 a = *(const float4*)&part[0][tid * 4], b = *(const float4*)&part[1][tid * 4], c = *(const float4*)&part[2][tid * 4], d = *(const float4*)&part[3][tid * 4];
        const float4 x = *(const float4*)(x2 + (size_t)t * D + tid * 4);
        r0 = make_float4(x.x + a.x + b.x + c.x + d.x, x.y + a.y + b.y + c.y + d.y, x.z + a.z + b.z + c.z + d.z, x.w + a.w + b.w + c.w + d.w);
    }
    {
        const float4 a = *(const float4*)&part[0][1024 + tid * 4], b = *(const float4*)&part[1][1024 + tid * 4], c = *(const float4*)&part[2][1024 + tid * 4], d = *(const float4*)&part[3][1024 + tid * 4];
        const float4 x = *(const float4*)(x2 + (size_t)t * D + 1024 + tid * 4);
        r1 = make_float4(x.x + a.x + b.x + c.x + d.x, x.y + a.y + b.y + c.y + d.y, x.z + a.z + b.z + c.z + d.z, x.w + a.w + b.w + c.w + d.w);
    }
    float s = r0.x * r0.x + r0.y * r0.y + r0.z * r0.z + r0.w * r0.w + r1.x * r1.x + r1.y * r1.y + r1.z * r1.z + r1.w * r1.w;
    s = wave_sum(s);
    if (lane == 0) red[w] = s;
    __syncthreads();
    const float tot = red[0] + red[1] + red[2] + red[3];
    const float r = rsqrtf(tot * (1.0f / D) + EPS);
    const float4 g0 = *(const float4*)(g_final + tid * 4), g1 = *(const float4*)(g_final + 1024 + tid * 4);
    *(float4*)(out + (size_t)t * D + tid * 4) = make_float4(r0.x * r * g0.x, r0.y * r * g0.y, r0.z * r * g0.z, r0.w * r * g0.w);
    *(float4*)(out + (size_t)t * D + 1024 + tid * 4) = make_float4(r1.x * r * g1.x, r1.y * r * g1.y, r1.z * r * g1.z, r1.w * r * g1.w);
}


__device__ __forceinline__ float wave_incl_scan_add(float v, int lane) {
#pragma unroll
    for (int o = 1; o < 64; o <<= 1) { const float t = __shfl_up(v, o); if (lane >= o) v += t; }
    return v;
}
__device__ __forceinline__ float wave_incl_scan_max(float v, int lane) {
#pragma unroll
    for (int o = 1; o < 64; o <<= 1) { const float t = __shfl_up(v, o); if (lane >= o) v = fmaxf(v, t); }
    return v;
}
__device__ __forceinline__ void mlstm_gates_wave(int b, int h, int lane, const float* __restrict__ gpre, const float* __restrict__ b_mi, const float* __restrict__ b_mf,
                                                 float* __restrict__ gs, float* __restrict__ decay) {
    const float bi = b_mi[h], bf = b_mf[h];
    float mprev = 0.f;
    for (int c = 0; c < 16; ++c) {
        const size_t t0 = (size_t)b * S + c * 256 + lane * 4;
        float logi[4], lf[4], bb[4];
#pragma unroll
        for (int j = 0; j < 4; ++j) { logi[j] = gpre[(t0 + j) * 8 + h] + bi; lf[j] = log_sigmoid(gpre[(t0 + j) * 8 + 4 + h] + bf); }
        bb[0] = lf[0]; bb[1] = bb[0] + lf[1]; bb[2] = bb[1] + lf[2]; bb[3] = bb[2] + lf[3];
        const float incl = wave_incl_scan_add(bb[3], lane);
        const float excl = incl - bb[3];
#pragma unroll
        for (int j = 0; j < 4; ++j) bb[j] += excl;
        const float g = __shfl(incl, 63);
        float amax = -INFINITY, uu[4], cm[4];
#pragma unroll
        for (int j = 0; j < 4; ++j) { amax = fmaxf(amax, logi[j] + g - bb[j]); uu[j] = logi[j] - bb[j]; }
        amax = wave_max(amax);
        const float mnew = fmaxf(g + mprev, amax);
        cm[0] = uu[0]; cm[1] = fmaxf(cm[0], uu[1]); cm[2] = fmaxf(cm[1], uu[2]); cm[3] = fmaxf(cm[2], uu[3]);
        const float cincl = wave_incl_scan_max(cm[3], lane);
        float cexcl = __shfl_up(cincl, 1); if (lane == 0) cexcl = -INFINITY;
#pragma unroll
        for (int j = 0; j < 4; ++j) {
            const float M = fmaxf(mprev, fmaxf(cexcl, cm[j]));
            float* o = gs + ((t0 + j) * 4 + h) * 8;
            o[0] = uu[j] * 1.4426950408889634f; o[1] = M * 1.4426950408889634f; o[2] = expf(logi[j] + g - bb[j] - mnew); o[3] = expf(mprev - M); o[4] = expf(-(bb[j] + M));
        }
        if (lane == 0) decay[(b * 16 + c) * 4 + h] = expf(g + mprev - mnew);
        mprev = mnew;
    }
}
__device__ __forceinline__ void transpose_tile64(int tid, float* sm, const bf16_t* __restrict__ src, int src_ld, bf16_t* __restrict__ dst, int dst_ld, const float* __restrict__ scale, int sstride) {
    unsigned short (*tl)[66] = (unsigned short (*)[66])sm;
    __syncthreads();
#pragma unroll
    for (int i = 0; i < 2; ++i) {
        const int ch = tid + i * 256, r = ch >> 3, c8 = (ch & 7) * 8;
        const uint4 v = *(const uint4*)(src + (size_t)r * src_ld + c8);
        const float sc = scale ? scale[(size_t)r * sstride] : 1.0f;
        const unsigned w[4] = {v.x, v.y, v.z, v.w};
#pragma unroll
        for (int k = 0; k < 4; ++k) {
            tl[r][c8 + 2 * k] = (unsigned short)f2bf(bf2f((unsigned short)(w[k] & 0xFFFFu)) * sc);
            tl[r][c8 + 2 * k + 1] = (unsigned short)f2bf(bf2f((unsigned short)(w[k] >> 16)) * sc);
        }
    }
    __syncthreads();
#pragma unroll
    for (int i = 0; i < 2; ++i) {
        const int ch = tid + i * 256, c = ch >> 3, r8 = (ch & 7) * 8;
        uint4 o;
        o.x = (unsigned)tl[r8 + 0][c] | ((unsigned)tl[r8 + 1][c] << 16); o.y = (unsigned)tl[r8 + 2][c] | ((unsigned)tl[r8 + 3][c] << 16);
        o.z = (unsigned)tl[r8 + 4][c] | ((unsigned)tl[r8 + 5][c] << 16); o.w = (unsigned)tl[r8 + 6][c] | ((unsigned)tl[r8 + 7][c] << 16);
        *(uint4*)(dst + (size_t)c * dst_ld + r8) = o;
    }
}

__device__ __forceinline__ void rope_table_fill(float2* __restrict__ cs, int gtid, int nth) {
    for (int idx = gtid; idx < 4096 * 64; idx += nth) {
        const int i = idx & 63, s = idx >> 6;
        const float inv = exp2f(-(float)i * 0.20762050593046014f);
        const float ang = (float)s * inv;
        float sn, c; sincosf(ang, &sn, &c);
        cs[idx] = make_float2(c, sn);
    }
}
__device__ __forceinline__ void rope_q_pass(bf16_t* __restrict__ aq, const float2* __restrict__ cs, size_t gtid, size_t nth) {
    for (size_t idx = gtid; idx < (size_t)T * 8 * 8; idx += nth) {
        const int c8 = (int)(idx & 7), hd = (int)((idx >> 3) & 7); const size_t t = idx >> 6; const int s = (int)(t & (S - 1));
        bf16_t* p = aq + t * 1024 + hd * 128 + c8 * 8;
        const uint4 a = *(const uint4*)p, b = *(const uint4*)(p + 64);
        const unsigned aw[4] = {a.x, a.y, a.z, a.w}, bw[4] = {b.x, b.y, b.z, b.w};
        unsigned ao[4], bo[4];
#pragma unroll
        for (int k = 0; k < 4; ++k) {
            const float4 cc = *(const float4*)(cs + (size_t)s * 64 + c8 * 8 + 2 * k);
            const float x10 = __uint_as_float(aw[k] << 16), x11 = __uint_as_float(aw[k] & 0xFFFF0000u), x20 = __uint_as_float(bw[k] << 16), x21 = __uint_as_float(bw[k] & 0xFFFF0000u);
            ao[k] = pk2(x10 * cc.x - x20 * cc.y, x11 * cc.z - x21 * cc.w);
            bo[k] = pk2(x20 * cc.x + x10 * cc.y, x21 * cc.z + x11 * cc.w);
        }
        *(uint4*)p = make_uint4(ao[0], ao[1], ao[2], ao[3]); *(uint4*)(p + 64) = make_uint4(bo[0], bo[1], bo[2], bo[3]);
    }
}
__device__ __forceinline__ void dil_tile_prep(int item, int lane, LAS unsigned short* wl, const bf16_t* __restrict__ ak, const bf16_t* __restrict__ av, const float2* __restrict__ cs,
                                              bf16_t* __restrict__ KB, bf16_t* __restrict__ VB) {
    const int TT = item & 255, hd = (item >> 8) & 7, b = (item >> 11) & 1, br = item >> 12;
    const int ld = 2 * br, tpr = 256 >> ld, rho = TT / tpr, tile = TT - rho * tpr;
    const int i = lane & 15, c = lane >> 4;
    const int s = rho + ((16 * tile + i) << ld);
    const size_t trow = (size_t)b * S + s;
    bf16_t* kdst = KB + (size_t)item * 2048;
    bf16_t* vdst = VB + (size_t)item * 2048;
    {
        const bf16_t* kr = ak + trow * 1024 + hd * 128 + 16 * c;
        const uint4 a0 = *(const uint4*)kr, a1 = *(const uint4*)(kr + 8), b0 = *(const uint4*)(kr + 64), b1 = *(const uint4*)(kr + 72);
        const unsigned aw[8] = {a0.x, a0.y, a0.z, a0.w, a1.x, a1.y, a1.z, a1.w}, bw[8] = {b0.x, b0.y, b0.z, b0.w, b1.x, b1.y, b1.z, b1.w};
        unsigned ao[8], bo[8];
#pragma unroll
        for (int k = 0; k < 8; ++k) {
            const float4 cc = *(const float4*)(cs + (size_t)s * 64 + 16 * c + 2 * k);
            const float x10 = __uint_as_float(aw[k] << 16), x11 = __uint_as_float(aw[k] & 0xFFFF0000u), x20 = __uint_as_float(bw[k] << 16), x21 = __uint_as_float(bw[k] & 0xFFFF0000u);
            ao[k] = pk2(x10 * cc.x - x20 * cc.y, x11 * cc.z - x21 * cc.w);
            bo[k] = pk2(x20 * cc.x + x10 * cc.y, x21 * cc.z + x11 * cc.w);
        }
        bf16_t* d0 = kdst + (c >> 1) * 512 + i * 32 + (c & 1) * 16;
        *(uint4*)d0 = make_uint4(ao[0], ao[1], ao[2], ao[3]); *(uint4*)(d0 + 8) = make_uint4(ao[4], ao[5], ao[6], ao[7]);
        bf16_t* d1 = d0 + 1024;
        *(uint4*)d1 = make_uint4(bo[0], bo[1], bo[2], bo[3]); *(uint4*)(d1 + 8) = make_uint4(bo[4], bo[5], bo[6], bo[7]);
    }
    {
        const bf16_t* vr = av + trow * 1024 + hd * 128 + 32 * c;
        const uint4 v0 = *(const uint4*)vr, v1 = *(const uint4*)(vr + 8), v2 = *(const uint4*)(vr + 16), v3 = *(const uint4*)(vr + 24);
        LAS unsigned short* wr = wl + i * 136 + 32 * c;
        typedef unsigned u32x4_t __attribute__((ext_vector_type(4)));
        *(LAS u32x4_t*)wr = (u32x4_t){v0.x, v0.y, v0.z, v0.w}; *(LAS u32x4_t*)(wr + 8) = (u32x4_t){v1.x, v1.y, v1.z, v1.w};
        *(LAS u32x4_t*)(wr + 16) = (u32x4_t){v2.x, v2.y, v2.z, v2.w}; *(LAS u32x4_t*)(wr + 24) = (u32x4_t){v3.x, v3.y, v3.z, v3.w};
        asm volatile("s_waitcnt lgkmcnt(0)" ::: "memory");
        unsigned o[16];
#pragma unroll
        for (int k = 0; k < 8; ++k) {
            const unsigned p0 = *(const LAS unsigned*)(wl + (2 * k) * 136 + 2 * lane), p1 = *(const LAS unsigned*)(wl + (2 * k + 1) * 136 + 2 * lane);
            o[k] = (p0 & 0xFFFFu) | (p1 << 16);
            o[8 + k] = (p0 >> 16) | (p1 & 0xFFFF0000u);
        }
        bf16_t* d = vdst + (2 * lane) * 16;
        *(uint4*)d = make_uint4(o[0], o[1], o[2], o[3]); *(uint4*)(d + 8) = make_uint4(o[4], o[5], o[6], o[7]);
        *(uint4*)(d + 16) = make_uint4(o[8], o[9], o[10], o[11]); *(uint4*)(d + 24) = make_uint4(o[12], o[13], o[14], o[15]);
        asm volatile("s_waitcnt lgkmcnt(0)" ::: "memory");
    }
}

typedef short bf16x8_t __attribute__((ext_vector_type(8)));
typedef short bf16x4_t __attribute__((ext_vector_type(4)));
typedef float f32x4_t __attribute__((ext_vector_type(4)));
__device__ __forceinline__ void dilated_wave_tile(int qt, int lane, const bf16_t* __restrict__ AQ, const bf16_t* __restrict__ KB, const bf16_t* __restrict__ VB,
                                                  const float* __restrict__ g_ahead, bf16_t* __restrict__ mix) {
    const int r = qt & 15, blk = (qt >> 4) & 15, hd = (qt >> 8) & 7, b = qt >> 11;
    const int j = lane & 15, g = lane >> 4;
    const int t0 = blk * 256;
    const int sq = t0 + r + 16 * j;
    bf16x8_t qf[4];
    {
        const bf16_t* qrow = AQ + ((size_t)b * S + sq) * 1024 + hd * 128 + 8 * g;
#pragma unroll
        for (int ks = 0; ks < 4; ++ks) qf[ks] = *(const bf16x8_t*)(qrow + 32 * ks);
    }
    const float sc = 0.08838834764831845f * 1.4426950408889634f;
    float m_run = -1e30f, l_run = 0.f;
    f32x4_t o[8];
#pragma unroll
    for (int dt = 0; dt < 8; ++dt) o[dt] = (f32x4_t){0.f, 0.f, 0.f, 0.f};
#pragma nounroll
    for (int br = 0; br < 3; ++br) {
        const int ld = 2 * br, d = 1 << ld;
        const int rho = r & (d - 1);
        const int qj = (sq - rho) >> ld;
        const int q_lo = ((t0 + r - rho) >> ld) - 128, q_hi = (t0 + r + 240 - rho) >> ld;
        const int tile_lo = q_lo < 0 ? 0 : (q_lo >> 4), tile_hi = q_hi >> 4, tile_max = (256 >> ld) - 1;
        const size_t tbase = ((size_t)((br * 2 + b) * 8 + hd) * 256 + (size_t)rho * (256 >> ld)) * 2048;
        const bf16_t* kbb = KB + tbase + j * 32 + 8 * g;
        const bf16_t* vbb = VB + tbase + j * 16 + 4 * g;
#pragma nounroll
        for (int tp = tile_lo; tp <= tile_hi; tp += 2) {
            f32x4_t su[2];
#pragma unroll
            for (int u = 0; u < 2; ++u) {
                int tl = tp + u; if (tl > tile_max) tl = tile_max;
                const bf16_t* krow = kbb + (size_t)tl * 2048;
                f32x4_t a = (f32x4_t){0.f, 0.f, 0.f, 0.f};
#pragma unroll
                for (int ks = 0; ks < 4; ++ks) a = __builtin_amdgcn_mfma_f32_16x16x32_bf16(*(const bf16x8_t*)(krow + 512 * ks), qf[ks], a, 0, 0, 0);
                su[u] = a;
            }
            float p[2][4]; float mx = -1e30f;
#pragma unroll
            for (int u = 0; u < 2; ++u)
#pragma unroll
                for (int e = 0; e < 4; ++e) {
                    const int n = qj - (16 * (tp + u) + 4 * g + e);
                    const bool valid = (n >= 0) && (n <= 128);
                    p[u][e] = valid ? su[u][e] * sc : -1e30f;
                    mx = fmaxf(mx, p[u][e]);
                }
            mx = fmaxf(mx, __shfl_xor(mx, 16)); mx = fmaxf(mx, __shfl_xor(mx, 32));
            const float m_new = fmaxf(m_run, mx);
            const float alpha = __builtin_amdgcn_exp2f(m_run - m_new);
            m_run = m_new;
            float ps = 0.f;
#pragma unroll
            for (int u = 0; u < 2; ++u)
#pragma unroll
                for (int e = 0; e < 4; ++e) { p[u][e] = (p[u][e] > -1e29f) ? __builtin_amdgcn_exp2f(p[u][e] - m_new) : 0.f; ps += p[u][e]; }
            l_run = l_run * alpha + ps;
            bf16x8_t pb;
            {
                const unsigned w0 = pk2(p[0][0], p[0][1]), w1 = pk2(p[0][2], p[0][3]), w2 = pk2(p[1][0], p[1][1]), w3 = pk2(p[1][2], p[1][3]);
                pb[0] = (short)(w0 & 0xFFFF); pb[1] = (short)(w0 >> 16); pb[2] = (short)(w1 & 0xFFFF); pb[3] = (short)(w1 >> 16);
                pb[4] = (short)(w2 & 0xFFFF); pb[5] = (short)(w2 >> 16); pb[6] = (short)(w3 & 0xFFFF); pb[7] = (short)(w3 >> 16);
            }
            int tl0 = tp, tl1 = tp + 1; if (tl0 > tile_max) tl0 = tile_max; if (tl1 > tile_max) tl1 = tile_max;
#pragma unroll
            for (int dt = 0; dt < 8; ++dt) {
                const bf16_t* vrow = vbb + dt * 256;
                const bf16x4_t v0 = *(const bf16x4_t*)(vrow + (size_t)tl0 * 2048), v1 = *(const bf16x4_t*)(vrow + (size_t)tl1 * 2048);
                bf16x8_t va; va[0] = v0[0]; va[1] = v0[1]; va[2] = v0[2]; va[3] = v0[3]; va[4] = v1[0]; va[5] = v1[1]; va[6] = v1[2]; va[7] = v1[3];
                f32x4_t oo = o[dt]; oo = oo * alpha;
                o[dt] = __builtin_amdgcn_mfma_f32_16x16x32_bf16(va, pb, oo, 0, 0, 0);
            }
        }
    }
    float lt = l_run; lt += __shfl_xor(lt, 16); lt += __shfl_xor(lt, 32);
    const float inv = 1.0f / lt;
    float ss = 0.f;
#pragma unroll
    for (int dt = 0; dt < 8; ++dt) { o[dt] = o[dt] * inv; ss += (o[dt][0] * o[dt][0] + o[dt][1] * o[dt][1]) + (o[dt][2] * o[dt][2] + o[dt][3] * o[dt][3]); }
    ss += __shfl_xor(ss, 16); ss += __shfl_xor(ss, 32);
    const float rn = rsqrtf(ss * (1.0f / 128.0f) + EPS);
    bf16_t* orow = mix + ((size_t)b * S + sq) * D + 1024 + hd * 128 + 4 * g;
#pragma unroll
    for (int dt = 0; dt < 8; ++dt) {
        const f32x4_t gv = *(const f32x4_t*)(g_ahead + hd * 128 + 16 * dt + 4 * g);
        uint2 w; w.x = pk2(o[dt][0] * rn * gv[0], o[dt][1] * rn * gv[1]); w.y = pk2(o[dt][2] * rn * gv[2], o[dt][3] * rn * gv[3]);
        *(uint2*)(orow + 16 * dt) = w;
    }
}

__device__ __forceinline__ unsigned ord_key(float s) { const unsigned u = __float_as_uint(s); return u ^ ((unsigned)((int)u >> 31) | 0x80000000u); }
__device__ __forceinline__ unsigned wave_max_u32(unsigned v) {
    unsigned t;
    t = (unsigned)__builtin_amdgcn_update_dpp(0, (int)v, 0xB1, 0xF, 0xF, true); v = v > t ? v : t;
    t = (unsigned)__builtin_amdgcn_update_dpp(0, (int)v, 0x4E, 0xF, 0xF, true); v = v > t ? v : t;
    t = (unsigned)__builtin_amdgcn_update_dpp(0, (int)v, 0x141, 0xF, 0xF, true); v = v > t ? v : t;
    t = (unsigned)__builtin_amdgcn_update_dpp(0, (int)v, 0x140, 0xF, 0xF, true); v = v > t ? v : t;
    const unsigned a = (unsigned)__builtin_amdgcn_readlane((int)v, 0), b = (unsigned)__builtin_amdgcn_readlane((int)v, 16),
                   c = (unsigned)__builtin_amdgcn_readlane((int)v, 32), d = (unsigned)__builtin_amdgcn_readlane((int)v, 48);
    const unsigned ab = a > b ? a : b, cd = c > d ? c : d;
    return ab > cd ? ab : cd;
}
__device__ __forceinline__ void peer_topk_wave(int item, int lane, LAS float* wl, const bf16_t* __restrict__ qp, const bf16_t* __restrict__ skb, int* __restrict__ ids, float* __restrict__ gates) {
    const int hd = item & 7, tt = item >> 3, j = lane & 15, g = lane >> 4;
    const size_t t0 = (size_t)tt * 16;
    LAS float* sc = wl;
    LAS float* lst = wl + 2048;
#pragma unroll 1
    for (int p = 0; p < 2; ++p) {
        bf16x8_t qf[4];
        const bf16_t* qrow = qp + (t0 + j) * D + hd * 256 + p * 128 + 8 * g;
#pragma unroll
        for (int ks = 0; ks < 4; ++ks) qf[ks] = *(const bf16x8_t*)(qrow + 32 * ks);
        const bf16_t* kb = skb + ((size_t)(hd * 2 + p) * 128 + j) * 128 + 8 * g;
#pragma unroll
        for (int kt = 0; kt < 8; ++kt) {
            f32x4_t a = (f32x4_t){0.f, 0.f, 0.f, 0.f};
#pragma unroll
            for (int ks = 0; ks < 4; ++ks) a = __builtin_amdgcn_mfma_f32_16x16x32_bf16(*(const bf16x8_t*)(kb + (size_t)kt * (16 * 128) + 32 * ks), qf[ks], a, 0, 0, 0);
            *(LAS f32x4_t*)(sc + j * 128 + 16 * kt + 4 * g) = a;
        }
        asm volatile("s_waitcnt lgkmcnt(0)" ::: "memory");
#pragma unroll 1
        for (int tok = 0; tok < 16; ++tok) {
            const float s0 = sc[tok * 128 + lane], s1 = sc[tok * 128 + 64 + lane];
            unsigned k0 = (ord_key(s0) & ~127u) | (unsigned)(127 - lane), k1 = (ord_key(s1) & ~127u) | (unsigned)(63 - lane);
            unsigned sel = 0u;
#pragma unroll 4
            for (int it = 0; it < 16; ++it) {
                unsigned m = k0 > k1 ? k0 : k1;
                m = wave_max_u32(m);
                if (lane == it) sel = m;
                if (k0 == m) k0 = 0u;
                if (k1 == m) k1 = 0u;
            }
            if (lane < 16) {
                const int idx = 127 - (int)(sel & 127u);
                lst[((p * 16 + tok) * 16 + lane) * 2 + 0] = sc[tok * 128 + idx];
                lst[((p * 16 + tok) * 16 + lane) * 2 + 1] = __int_as_float(idx);
            }
        }
        asm volatile("s_waitcnt lgkmcnt(0)" ::: "memory");
    }
#pragma unroll 1
    for (int tok = 0; tok < 16; ++tok) {
        const int i = lane >> 2;
        const float sA = lst[((0 * 16 + tok) * 16 + i) * 2];
        unsigned kk[4];
#pragma unroll
        for (int r = 0; r < 4; ++r) {
            const int jb = (lane & 3) * 4 + r;
            const float sum = sA + lst[((1 * 16 + tok) * 16 + jb) * 2];
            kk[r] = (ord_key(sum) & ~255u) | (unsigned)(255 - (lane * 4 + r));
        }
        unsigned sel = 0u;
#pragma unroll 4
        for (int it = 0; it < 16; ++it) {
            unsigned m = kk[0] > kk[1] ? kk[0] : kk[1]; const unsigned m2 = kk[2] > kk[3] ? kk[2] : kk[3]; m = m > m2 ? m : m2;
            m = wave_max_u32(m);
            if (lane == it) sel = m;
#pragma unroll
            for (int r = 0; r < 4; ++r) if (kk[r] == m) kk[r] = 0u;
        }
        float bs = -INFINITY; int eid = 0;
        if (lane < 16) {
            const int c = 255 - (int)(sel & 255u), ia = c >> 4, ib = c & 15;
            bs = lst[((0 * 16 + tok) * 16 + ia) * 2] + lst[((1 * 16 + tok) * 16 + ib) * 2];
            eid = __float_as_int(lst[((0 * 16 + tok) * 16 + ia) * 2 + 1]) * 128 + __float_as_int(lst[((1 * 16 + tok) * 16 + ib) * 2 + 1]);
        }
        const float mx = wave_max(bs);
        const float ev = lane < 16 ? __expf(bs - mx) : 0.f;
        const float tot = wave_sum(ev);
        if (lane < 16) {
            ids[(t0 + tok) * 128 + hd * 16 + lane] = eid;
            gates[(t0 + tok) * 128 + hd * 16 + lane] = ev / tot;
        }
    }
}

typedef float f32x2_t __attribute__((ext_vector_type(2)));
__device__ __forceinline__ void table_row_to_fp8(const float* __restrict__ srow, unsigned char* __restrict__ drow, float* __restrict__ rscale, int lane) {
    float4 f[8];
#pragma unroll
    for (int i = 0; i < 8; ++i) f[i] = *(const float4*)(srow + i * 256 + lane * 4);
    float am = 0.f;
#pragma unroll
    for (int i = 0; i < 8; ++i) am = fmaxf(am, fmaxf(fmaxf(fabsf(f[i].x), fabsf(f[i].y)), fmaxf(fabsf(f[i].z), fabsf(f[i].w))));
    am = wave_max(am);
    const float e = floorf(log2f(448.0f / fmaxf(am, 1e-30f)));
    const float s = exp2f(fminf(e, 100.0f));
    unsigned w[8];
#pragma unroll
    for (int i = 0; i < 8; ++i) {
        int t = 0;
        t = __builtin_amdgcn_cvt_pk_fp8_f32(f[i].x * s, f[i].y * s, t, false);
        t = __builtin_amdgcn_cvt_pk_fp8_f32(f[i].z * s, f[i].w * s, t, true);
        w[i] = (unsigned)t;
    }
#pragma unroll
    for (int i = 0; i < 8; ++i) *(unsigned*)(drow + i * 256 + lane * 4) = w[i];
    if (lane == 0) *rscale = 1.0f / s;
}
__device__ __forceinline__ float dot16_fp8(const uint4 q, const float* x) {
    float d = 0.f;
    const unsigned w[4] = {q.x, q.y, q.z, q.w};
#pragma unroll
    for (int k = 0; k < 4; ++k) {
        const f32x2_t lo = __builtin_amdgcn_cvt_pk_f32_fp8((int)w[k], false), hi = __builtin_amdgcn_cvt_pk_f32_fp8((int)w[k], true);
        d = fmaf(lo.x, x[4 * k], d); d = fmaf(lo.y, x[4 * k + 1], d); d = fmaf(hi.x, x[4 * k + 2], d); d = fmaf(hi.y, x[4 * k + 3], d);
    }
    return d;
}
__device__ __forceinline__ void axpy16_fp8(const uint4 q, float c, float* acc) {
    const unsigned w[4] = {q.x, q.y, q.z, q.w};
#pragma unroll
    for (int k = 0; k < 4; ++k) {
        const f32x2_t lo = __builtin_amdgcn_cvt_pk_f32_fp8((int)w[k], false), hi = __builtin_amdgcn_cvt_pk_f32_fp8((int)w[k], true);
        acc[4 * k] = fmaf(c, lo.x, acc[4 * k]); acc[4 * k + 1] = fmaf(c, lo.y, acc[4 * k + 1]); acc[4 * k + 2] = fmaf(c, hi.x, acc[4 * k + 2]); acc[4 * k + 3] = fmaf(c, hi.y, acc[4 * k + 3]);
    }
}
__device__ __forceinline__ void d_peer_out8(int vb, int tid, float* sm, const bf16_t* __restrict__ h3, const float* __restrict__ x2, const int* __restrict__ ids, const float* __restrict__ gates,
                                            const unsigned char* __restrict__ ut8, const unsigned char* __restrict__ vt8, const float* __restrict__ rsc, const float* __restrict__ g_final, float* __restrict__ out) {
    float (*part)[2048] = (float (*)[2048])sm;
    float* red = sm + 4 * 2048;
    const int lane = tid & 63, w = tid >> 6, t = vb;
    float x[32], acc[32];
    {
        const bf16_t* hrow = h3 + (size_t)t * D + lane * 16;
#pragma unroll
        for (int hh = 0; hh < 2; ++hh) {
            const uint4 a = *(const uint4*)(hrow + hh * 1024), b = *(const uint4*)(hrow + hh * 1024 + 8);
            const unsigned ww[8] = {a.x, a.y, a.z, a.w, b.x, b.y, b.z, b.w};
#pragma unroll
            for (int k = 0; k < 8; ++k) { x[hh * 16 + 2 * k] = __uint_as_float(ww[k] << 16); x[hh * 16 + 2 * k + 1] = __uint_as_float(ww[k] & 0xFFFF0000u); }
        }
#pragma unroll
        for (int i = 0; i < 32; ++i) acc[i] = 0.f;
    }
    const int myid = ids[(size_t)t * 128 + w * 32 + (lane & 31)];
    const float mygate = gates[(size_t)t * 128 + w * 32 + (lane & 31)];
#pragma unroll 1
    for (int j = 0; j < 32; j += 4) {
        int e[4]; uint4 uq[4][2], vq[4][2];
#pragma unroll
        for (int q = 0; q < 4; ++q) {
            e[q] = __builtin_amdgcn_readfirstlane(__shfl(myid, j + q));
            const unsigned char* ur = ut8 + (size_t)e[q] * 2048 + lane * 16;
            uq[q][0] = *(const uint4*)ur; uq[q][1] = *(const uint4*)(ur + 1024);
        }
#pragma unroll
        for (int q = 0; q < 4; ++q) {
            const unsigned char* vr = vt8 + (size_t)e[q] * 2048 + lane * 16;
            vq[q][0] = *(const uint4*)vr; vq[q][1] = *(const uint4*)(vr + 1024);
        }
        float d[4];
#pragma unroll
        for (int q = 0; q < 4; ++q) d[q] = dot16_fp8(uq[q][0], x) + dot16_fp8(uq[q][1], x + 16);
#pragma unroll
        for (int o = 32; o >= 1; o >>= 1) {
#pragma unroll
            for (int q = 0; q < 4; ++q) d[q] += __shfl_xor(d[q], o);
        }
#pragma unroll
        for (int q = 0; q < 4; ++q) {
            const float a = d[q] * rsc[e[q]];
            const float act = 0.5f * a * (1.0f + erff(a * 0.7071067811865476f));
            const float cf = __shfl(mygate, j + q) * act * rsc[16384 + e[q]];
            axpy16_fp8(vq[q][0], cf, acc); axpy16_fp8(vq[q][1], cf, acc + 16);
        }
    }
    __syncthreads();
#pragma unroll
    for (int hh = 0; hh < 2; ++hh)
#pragma unroll
        for (int k = 0; k < 4; ++k) *(float4*)&part[w][hh * 1024 + lane * 16 + 4 * k] = make_float4(acc[hh * 16 + 4 * k], acc[hh * 16 + 4 * k + 1], acc[hh * 16 + 4 * k + 2], acc[hh * 16 + 4 * k + 3]);
    __syncthreads();
    float4 r0, r1;
    {
        const float4 a = *(const float4*)&part[0][tid * 4], b = *(const float4*)&part[1][tid * 4], c = *(const float4*)&part[2][tid * 4], dd = *(const float4*)&part[3][tid * 4];
        const float4 xx = *(const float4*)(x2 + (size_t)t * D + tid * 4);
        r0 = make_float4(xx.x + a.x + b.x + c.x + dd.x, xx.y + a.y + b.y + c.y + dd.y, xx.z + a.z + b.z + c.z + dd.z, xx.w + a.w + b.w + c.w + dd.w);
    }
    {
        const float4 a = *(const float4*)&part[0][1024 + tid * 4], b = *(const float4*)&part[1][1024 + tid * 4], c = *(const float4*)&part[2][1024 + tid * 4], dd = *(const float4*)&part[3][1024 + tid * 4];
        const float4 xx = *(const float4*)(x2 + (size_t)t * D + 1024 + tid * 4);
        r1 = make_float4(xx.x + a.x + b.x + c.x + dd.x, xx.y + a.y + b.y + c.y + dd.y, xx.z + a.z + b.z + c.z + dd.z, xx.w + a.w + b.w + c.w + dd.w);
    }
    float s = r0.x * r0.x + r0.y * r0.y + r0.z * r0.z + r0.w * r0.w + r1.x * r1.x + r1.y * r1.y + r1.z * r1.z + r1.w * r1.w;
    s = wave_sum(s);
    if (lane == 0) red[w] = s;
    __syncthreads();
    const float tot = red[0] + red[1] + red[2] + red[3];
    const float r = rsqrtf(tot * (1.0f / D) + EPS);
    const float4 g0 = *(const float4*)(g_final + tid * 4), g1 = *(const float4*)(g_final + 1024 + tid * 4);
    *(float4*)(out + (size_t)t * D + tid * 4) = make_float4(r0.x * r * g0.x, r0.y * r * g0.y, r0.z * r * g0.z, r0.w * r * g0.w);
    *(float4*)(out + (size_t)t * D + 1024 + tid * 4) = make_float4(r1.x * r * g1.x, r1.y * r * g1.y, r1.z * r * g1.z, r1.w * r * g1.w);
}

struct Params {
    const float *x, *mem, *g_mix, *w_in, *conv_w, *conv_b, *w_mq, *w_mk, *b_mi, *b_mf, *g_mhead, *g_ahead, *w_out, *g_cross, *g_mem,
                *w_xq, *w_xk, *w_xv, *w_xo, *g_ffn, *w_pq, *sub_keys, *u_tab, *v_tab, *g_final;
    float* out;
    unsigned* bar;
    float* ws;
};

#define PHASE_LOOP(nvb) for (int base_ = blockIdx.x * 2; base_ < (nvb); base_ += gridDim.x * 2)
#define VB (base_ + half)

__global__ void __launch_bounds__(NTHR) mega(Params P) {
    volatile LAS unsigned* st = (volatile LAS unsigned*)(LAS unsigned char*)(smem_raw + GEMM_LDS);
    if (threadIdx.x == 0) { st[0] = 0u; st[1] = 0u; st[2] = 0u; st[3] = 0u; }
    if (threadIdx.x < I_NPTR) ((LAS unsigned long long*)(LAS unsigned char*)(smem_raw + GEMM_LDS + 64))[threadIdx.x] = ((const unsigned long long*)&P)[threadIdx.x];
    __syncthreads();
    XcdBarrier xb = xcd_barrier_post((unsigned*)ldp_raw(I_BAR), st);

    constexpr size_t TD = (size_t)T * D;
    constexpr size_t O_HB = 6 * P6S * 2, O_CBUF = O_HB + (size_t)T * D * 2, O_MQ = O_CBUF + (size_t)T * 1024 * 2, O_MK = O_MQ + (size_t)T * 1024 * 2,
                     O_MIXB = O_MK + (size_t)T * 1024 * 2, O_WIN = O_MIXB + (size_t)T * D * 2, O_WOUT = O_WIN + (size_t)6144 * D * 2, O_WXQ = O_WOUT + (size_t)D * D * 2,
                     O_WXK = O_WXQ + (size_t)D * D * 2, O_WXV = O_WXK + (size_t)D * D * 2, O_WXO = O_WXV + (size_t)D * D * 2, O_WPQ = O_WXO + (size_t)D * D * 2,
                     O_WQK = O_WPQ + (size_t)D * D * 2, O_GPRE = O_WQK + (size_t)8 * 256 * 256 * 2, O_UT = O_GPRE + (size_t)T * 8 * 4, O_VT = O_UT + (size_t)16384 * D, O_RSC = O_VT + (size_t)16384 * D,
                     O_BH = O_RSC + (size_t)32768 * 4, O_GS = O_BH + (size_t)128 * 256 * 512 * 2, O_DENP = O_GS + (size_t)T * 4 * 8 * 4, O_QN = O_DENP + (size_t)T * 4 * 4 * 4,
                     O_DN = O_QN + (size_t)T * 4 * 4, O_DECAY = O_DN + (size_t)128 * 256 * 4, O_KB = O_DECAY + 4096, O_VB = O_KB + (size_t)12288 * 2048 * 2, O_CS = O_VB + (size_t)12288 * 2048 * 2, O_SKB = O_CS + (size_t)4096 * 64 * 8, O_END = O_SKB + (size_t)262144 * 2;
    static_assert(O_END + 16384 <= (size_t)536870912, "workspace overflow");
#define W_P6    ((bf16_t*)wsb)
#define W_HB    ((bf16_t*)(wsb + O_HB))
#define W_CBUF  ((bf16_t*)(wsb + O_CBUF))
#define W_MQ    ((bf16_t*)(wsb + O_MQ))
#define W_MK    ((bf16_t*)(wsb + O_MK))
#define W_MIXB  ((bf16_t*)(wsb + O_MIXB))
#define W_GPRE  ((float*)(wsb + O_GPRE))
#define W_HRAW  ((float*)(wsb + O_HB))
#define W_XR    ((float*)wsb)
#define W_MN    ((bf16_t*)((float*)wsb + TD))
#define W_KM    ((bf16_t*)((float*)wsb + TD + (size_t)256 * D))
#define W_VMT   ((bf16_t*)((float*)wsb + TD + (size_t)768 * D))
#define W_PX    ((bf16_t*)(wsb + O_MK))
#define W_GATES ((float*)wsb + TD + (size_t)1280 * D)
#define W_IDS   ((int*)((float*)wsb + TD + (size_t)1280 * D + (size_t)T * 128))
#define W_QX    ((bf16_t*)(wsb + O_CBUF))
#define W_BH    ((bf16_t*)(wsb + O_BH))
#define W_KB    ((bf16_t*)(wsb + O_KB))
#define W_VB    ((bf16_t*)(wsb + O_VB))
#define W_CS    ((float2*)(wsb + O_CS))
#define W_SKB   ((bf16_t*)(wsb + O_SKB))
#define W_GS    ((float*)(wsb + O_GS))
#define W_DENP  ((float*)(wsb + O_DENP))
#define W_QN    ((float*)(wsb + O_QN))
#define W_DN    ((float*)(wsb + O_DN))
#define W_DECAY ((float*)(wsb + O_DECAY))
#define W_PQ    ((bf16_t*)(wsb + O_HB))
#define W_KWT   ((bf16_t*)(wsb + O_CBUF))
#define W_DC    ((float*)(wsb + 3 * P6S * 2))
#define W_UT    ((unsigned char*)(wsb + O_UT))
#define W_VT    ((unsigned char*)(wsb + O_VT))
#define W_RSC   ((float*)(wsb + O_RSC))
#define PH_BEGIN() int tidx = threadIdx.x; asm volatile("" : "+v"(tidx)); const int half = tidx >> 8, tid = tidx & 255; float* sm = (float*)smem_raw + half * HALF_SM_FLOATS; \
                   char* wsb = (char*)ldp_raw(I_WS); (void)half; (void)tid; (void)sm; (void)wsb
#define GJOB_DEFAULT(g) pg8::GJob g; g.lda = D; g.ldb = D; g.K = D; g.nM = 32; g.nN = 8; g.a_pm_step = 256 * D; g.a_pn_shift = 0; g.a_pn_mask = 0; g.a_pn_step = 0; g.b_pm_shift = 0; g.b_pm_step = 0; g.b_pn_step = 256 * D; \
                        g.ldc = D; g.R = nullptr; g.ldr = D; g.mode = 0; g.escale = 1.0f; g.gs = nullptr; g.denp = nullptr; g.qn = nullptr; g.gvec = nullptr; g.mo = nullptr
#define GEMM_LDSP ((LAS unsigned char*)smem_raw)

    {
        PH_BEGIN();
        {
            LAS float* scr = (LAS float*)(LAS unsigned char*)(smem_raw) + (tidx >> 6) * (64 * 33);
            const int lane = tidx & 63;
            const int gw = blockIdx.x * 8 + (tidx >> 6), NGW = gridDim.x * 8;
            constexpr int I_IN = 32 * 192, I_SQ = 32 * 64, I_QK = 8 * 4 * 8;
            constexpr int NITEMS = I_IN + 6 * I_SQ + I_QK;
#pragma nounroll
            for (int it = gw; it < NITEMS; it += NGW) {
                const float* W; int ldw, K, csrc0, row0, kb; bf16_t* WT; float wscale = 1.0f;
                int r = it;
                if (r < I_IN) { const int nb = r % 192; kb = r / 192; W = PF(I_WIN); ldw = INC; K = D; csrc0 = nb * 32 + (nb >= 96 ? 8 : 0); WT = (bf16_t*)(wsb + O_WIN); row0 = nb * 32; }
                else if ((r -= I_IN) < 6 * I_SQ) {
                    const int wsel = r / I_SQ; r -= wsel * I_SQ; const int nb = r % 64; kb = r / 64; ldw = D; K = D; csrc0 = nb * 32; row0 = nb * 32;
                    W = PF(wsel == 0 ? I_WOUT : wsel == 1 ? I_WXQ : wsel == 2 ? I_WXK : wsel == 3 ? I_WXV : wsel == 4 ? I_WXO : I_WPQ);
                    WT = (bf16_t*)(wsb + O_WOUT + (size_t)wsel * ((size_t)D * D * 2));
                } else {
                    r -= 6 * I_SQ; const int hq = r / 32; r -= hq * 32; const int nb = r % 8; kb = r / 8;
                    W = PF(hq < 4 ? I_WMQ : I_WMK) + (size_t)(hq & 3) * 65536; ldw = 256; K = 256; csrc0 = nb * 32; WT = (bf16_t*)(wsb + O_WQK); row0 = hq * 256 + nb * 32;
                    if (hq >= 4) wscale = 0.0625f;
                }
                p0_transpose_item(W, ldw, K, csrc0, WT, row0, scr, kb, lane, wscale);
            }
            {
                const float* ut = PF(I_UTAB); const float* vt = PF(I_VTAB);
#pragma nounroll
                for (int row = gw; row < 32768; row += NGW) {
                    const bool second = row >= 16384; const int rr = second ? row - 16384 : row;
                    table_row_to_fp8((second ? vt : ut) + (size_t)rr * D, (second ? W_VT : W_UT) + (size_t)rr * D, W_RSC + row, lane);
                }
            }
            rope_table_fill(W_CS, blockIdx.x * NTHR + tidx, gridDim.x * NTHR);
            {
                const float* sk = PF(I_SUBK);
#pragma nounroll
                for (int i = blockIdx.x * NTHR + tidx; i < 262144 / 8; i += gridDim.x * NTHR) {
                    const float4 a = *(const float4*)(sk + (size_t)i * 8), b = *(const float4*)(sk + (size_t)i * 8 + 4);
                    uint4 o; o.x = pk2(a.x, a.y); o.y = pk2(a.z, a.w); o.z = pk2(b.x, b.y); o.w = pk2(b.z, b.w);
                    *(uint4*)(W_SKB + (size_t)i * 8) = o;
                }
            }
            __syncthreads();
        }
        { const float* rin = PF(I_X); const float* rg = PF(I_GMIX); const float* win = PF(I_WIN);
#pragma nounroll
          PHASE_LOOP(T) d_rmsnorm(VB, tid, sm, rin, rg, W_HB, win, W_GPRE); }
    }
    xcd_barrier(xb);
    {
        PH_BEGIN();
        GJOB_DEFAULT(g); g.A = W_HB; g.Bt = (bf16_t*)(wsb + O_WIN); g.nN = 24; g.C = (float*)W_P6; g.ldc = 1024;
        pg8::gemm_phase<4>(GEMM_LDSP, g, tidx);
    }
    xcd_barrier(xb);
    {
        PH_BEGIN();
        const float* cw = PF(I_CONVW); const float* cb = PF(I_CONVB);
#pragma nounroll
        PHASE_LOOP(T) d_conv_silu(VB, tid, W_P6, cw, cb, W_CBUF);
        rope_q_pass(W_P6 + 3 * P6S, W_CS, (size_t)blockIdx.x * NTHR + tidx, (size_t)gridDim.x * NTHR);
        {
            LAS unsigned short* wl = (LAS unsigned short*)(LAS unsigned char*)smem_raw + (tidx >> 6) * (16 * 136);
#pragma nounroll
            for (int item = blockIdx.x * 8 + (tidx >> 6); item < 12288; item += gridDim.x * 8) dil_tile_prep(item, tidx & 63, wl, W_P6 + 4 * P6S, W_P6 + 5 * P6S, W_CS, W_KB, W_VB);
            __syncthreads();
        }
        if (blockIdx.x < 8 && tidx < 64) mlstm_gates_wave(blockIdx.x >> 2, blockIdx.x & 3, tidx, W_GPRE, PF(I_BMI), PF(I_BMF), W_GS, W_DECAY);
#pragma nounroll
        PHASE_LOOP(2048) { const int it = VB, lt = it & 3, et = (it >> 2) & 3, h = (it >> 4) & 3, cg = it >> 6;
            transpose_tile64(tid, sm, W_P6 + P6S + (size_t)(cg * 256 + lt * 64) * 1024 + h * 256 + et * 64, 1024, W_BH + ((size_t)(cg * 4 + h) * 256 + et * 64) * 512 + lt * 64, 512, nullptr, 0); }
    }
    xcd_barrier(xb);
    {
        PH_BEGIN();
        {
            GJOB_DEFAULT(g); g.A = W_CBUF; g.lda = 1024; g.a_pm_step = 256 * 1024; g.Bt = (bf16_t*)(wsb + O_WQK); g.ldb = 256; g.b_pn_step = 256 * 256; g.K = 256; g.a_pn_mask = 3; g.a_pn_step = 256; g.C = (float*)W_MQ; g.ldc = 1024;
            pg8::gemm_phase<4>(GEMM_LDSP, g, tidx);
            __syncthreads();
        }
        const float* ga = PF(I_GAHEAD);
#pragma nounroll
        for (int qt = blockIdx.x * 8 + (tidx >> 6); qt < 4096; qt += gridDim.x * 8) dilated_wave_tile(qt, tidx & 63, W_P6 + 3 * P6S, W_KB, W_VB, ga, W_MIXB);
    }
    xcd_barrier(xb);
    {
        PH_BEGIN();
#pragma nounroll
        PHASE_LOOP(2048) { const int it = VB, lt = it & 3, dt = (it >> 2) & 3, h = (it >> 4) & 3, cg = it >> 6;
            transpose_tile64(tid, sm, W_MK + (size_t)(cg * 256 + lt * 64) * 1024 + h * 256 + dt * 64, 1024, W_KWT + ((size_t)(cg * 4 + h) * 256 + dt * 64) * 256 + lt * 64, 256,
                             W_GS + ((size_t)(cg * 256 + lt * 64) * 4 + h) * 8 + 2, 32); }
        {
            const size_t nth = (size_t)gridDim.x * NTHR;
#pragma nounroll
            for (size_t i = (size_t)blockIdx.x * NTHR + tidx; i < (size_t)T * 128; i += nth) {
                const size_t t = i >> 7; const int c8 = (int)(i & 127) * 8, h = c8 >> 8, d = c8 & 255;
                const float sc = W_GS[(t * 4 + h) * 8 + 3];
                const uint4 v = *(const uint4*)(W_MQ + t * 1024 + c8);
                uint4 o;
                o.x = pk2(bf2f((unsigned short)(v.x & 0xFFFFu)) * sc, bf2f((unsigned short)(v.x >> 16)) * sc); o.y = pk2(bf2f((unsigned short)(v.y & 0xFFFFu)) * sc, bf2f((unsigned short)(v.y >> 16)) * sc);
                o.z = pk2(bf2f((unsigned short)(v.z & 0xFFFFu)) * sc, bf2f((unsigned short)(v.z >> 16)) * sc); o.w = pk2(bf2f((unsigned short)(v.w & 0xFFFFu)) * sc, bf2f((unsigned short)(v.w >> 16)) * sc);
                *(uint4*)(W_PQ + t * 2048 + h * 512 + 256 + d) = o;
            }
        }
#pragma nounroll
        PHASE_LOOP(128) { const int cgh = VB, cg = cgh >> 2, h = cgh & 3;
            float a = 0.f;
            for (int l = 0; l < 256; ++l) { const size_t t = (size_t)cg * 256 + l; a = fmaf(W_GS[(t * 4 + h) * 8 + 2], bf2f(W_MK[t * 1024 + h * 256 + tid]), a); }
            W_DN[(size_t)cgh * 256 + tid] = a; }
        __syncthreads();
        {
            GJOB_DEFAULT(g); g.A = W_MQ; g.lda = 1024; g.a_pm_step = 256 * 1024; g.a_pn_mask = 3; g.a_pn_step = 256; g.K = 256; g.nN = 4;
            g.Bt = W_MK; g.ldb = 1024; g.b_pn_step = 256; g.b_pm_step = 256 * 1024; g.C = (float*)W_PQ; g.gs = W_GS; g.denp = W_DENP;
            pg8::gemm_phase<6>(GEMM_LDSP, g, tidx);
        }
    }
    xcd_barrier(xb);
    {
        PH_BEGIN();
        GJOB_DEFAULT(g); g.A = W_BH; g.lda = 512; g.a_pm_step = 4 * 256 * 512; g.a_pn_mask = 3; g.a_pn_step = 256 * 512; g.K = 256; g.nN = 4;
        g.Bt = W_KWT; g.ldb = 256; g.b_pn_step = 65536; g.b_pm_step = 4 * 65536; g.C = W_DC;
        pg8::gemm_phase<7>(GEMM_LDSP, g, tidx);
    }
    xcd_barrier(xb);
    {
        PH_BEGIN();
        {
#pragma nounroll
            for (int gid = blockIdx.x * NTHR + tidx; gid < 131072; gid += gridDim.x * NTHR) {
                const int bh = gid >> 14, b = bh >> 2, h = bh & 3, e = (gid >> 6) & 255, d = (gid & 63) * 4;
                float4 C = make_float4(0.f, 0.f, 0.f, 0.f);
#pragma unroll 4
                for (int c = 0; c < 16; ++c) {
                    const int cgh = (b * 16 + c) * 4 + h;
                    uint2 o; o.x = pk2(C.x, C.y); o.y = pk2(C.z, C.w);
                    *(uint2*)(W_BH + ((size_t)cgh * 256 + e) * 512 + 256 + d) = o;
                    const float dec = W_DECAY[cgh];
                    const float4 dc = *(const float4*)(W_DC + ((size_t)cgh * 256 + e) * 256 + d);
                    C.x = fmaf(dec, C.x, dc.x); C.y = fmaf(dec, C.y, dc.y); C.z = fmaf(dec, C.z, dc.z); C.w = fmaf(dec, C.w, dc.w);
                }
            }
        }
#pragma nounroll
        PHASE_LOOP(128) { const int cgh = VB, cg = cgh >> 2, h = cgh & 3, b = cg >> 4, c = cg & 15;
            float n = 0.f;
            for (int cc = 0; cc < c; ++cc) { const int j = (b * 16 + cc) * 4 + h; n = fmaf(W_DECAY[j], n, W_DN[(size_t)j * 256 + tid]); }
            __syncthreads();
            sm[tid] = n;
            __syncthreads();
            const int lane = tid & 63, w = tid >> 6;
            const float4 nv = *(const float4*)(sm + lane * 4);
            for (int i = 0; i < 64; ++i) {
                const size_t t = (size_t)cg * 256 + w * 64 + i;
                const ushort4 q4 = *(const ushort4*)(W_MQ + t * 1024 + h * 256 + lane * 4);
                float s = bf2f(q4.x) * nv.x + bf2f(q4.y) * nv.y + bf2f(q4.z) * nv.z + bf2f(q4.w) * nv.w;
                s = wave_sum(s);
                if (lane == 0) W_QN[t * 4 + h] = s;
            }
        }
    }
    xcd_barrier(xb);
    {
        PH_BEGIN();
        GJOB_DEFAULT(g); g.A = W_PQ; g.a_pn_mask = 3; g.a_pn_step = 512; g.K = 512; g.nN = 4;
        g.Bt = W_BH; g.ldb = 512; g.b_pn_step = 256 * 512; g.b_pm_step = 4 * 256 * 512; g.C = (float*)W_MIXB;
        g.gs = W_GS; g.denp = W_DENP; g.qn = W_QN; g.gvec = PF(I_GMHEAD); g.mo = W_P6 + 2 * P6S;
        pg8::gemm_phase<8>(GEMM_LDSP, g, tidx);
    }
    xcd_barrier(xb);
    {
        PH_BEGIN();
        GJOB_DEFAULT(g); g.A = W_MIXB; g.Bt = (bf16_t*)(wsb + O_WOUT); g.C = W_XR; g.R = PF(I_X);
        pg8::gemm_phase<0>(GEMM_LDSP, g, tidx);
    }
    xcd_barrier(xb);
    {
        PH_BEGIN();
        { const float* rg = PF(I_GCROSS); const float* win = PF(I_WIN);
#pragma nounroll
          PHASE_LOOP(T) d_rmsnorm(VB, tid, sm, W_XR, rg, W_HB, win, nullptr); }
        { const float* rin = PF(I_MEM); const float* rg = PF(I_GMEM); const float* win = PF(I_WIN);
#pragma nounroll
          PHASE_LOOP(512) d_rmsnorm(VB, tid, sm, rin, rg, W_MN, win, nullptr); }
    }
    xcd_barrier(xb);
    {
        PH_BEGIN();
        { GJOB_DEFAULT(g); g.A = W_HB; g.Bt = (bf16_t*)(wsb + O_WXQ); g.C = (float*)W_QX; pg8::gemm_phase<3>(GEMM_LDSP, g, tidx); __syncthreads(); }
        { GJOB_DEFAULT(g); g.A = W_MN; g.Bt = (bf16_t*)(wsb + O_WXK); g.nM = 2; g.C = (float*)W_KM; pg8::gemm_phase<3>(GEMM_LDSP, g, tidx); __syncthreads(); }
        { GJOB_DEFAULT(g); g.A = (bf16_t*)(wsb + O_WXV); g.Bt = W_MN; g.nM = 8; g.nN = 2; g.C = (float*)W_VMT; g.ldc = 512; pg8::gemm_phase<3>(GEMM_LDSP, g, tidx); }
    }
    xcd_barrier(xb);
    {
        PH_BEGIN();
        GJOB_DEFAULT(g); g.A = W_QX; g.K = 512; g.a_pn_mask = 3; g.a_pn_step = 512; g.Bt = W_KM; g.b_pn_step = 512; g.b_pm_shift = 4; g.b_pm_step = 256 * D; g.nN = 4;
        g.C = (float*)W_PX; g.ldc = 1024; g.escale = 0.04419417382415922f * 1.4426950408889634f;
        pg8::gemm_phase<5>(GEMM_LDSP, g, tidx);
    }
    xcd_barrier(xb);
    {
        PH_BEGIN();
        GJOB_DEFAULT(g); g.A = W_PX; g.lda = 1024; g.a_pm_step = 256 * 1024; g.K = 256; g.a_pn_shift = 1; g.a_pn_mask = 3; g.a_pn_step = 256; g.Bt = W_VMT; g.ldb = 512; g.b_pn_step = 256 * 512; g.b_pm_shift = 4; g.b_pm_step = 256;
        g.C = (float*)W_MIXB;
        pg8::gemm_phase<3>(GEMM_LDSP, g, tidx);
    }
    xcd_barrier(xb);
    {
        PH_BEGIN();
        GJOB_DEFAULT(g); g.A = W_MIXB; g.Bt = (bf16_t*)(wsb + O_WXO); g.C = W_XR; g.R = W_XR;
        pg8::gemm_phase<0>(GEMM_LDSP, g, tidx);
    }
    xcd_barrier(xb);
    {
        PH_BEGIN();
        const float* rg = PF(I_GFFN); const float* win = PF(I_WIN);
#pragma nounroll
        PHASE_LOOP(T) d_rmsnorm(VB, tid, sm, W_XR, rg, W_HB, win, nullptr);
    }
    xcd_barrier(xb);
    {
        PH_BEGIN();
        GJOB_DEFAULT(g); g.A = W_HB; g.Bt = (bf16_t*)(wsb + O_WPQ); g.C = (float*)W_QX;
        pg8::gemm_phase<3>(GEMM_LDSP, g, tidx);
    }
    xcd_barrier(xb);
    {
        PH_BEGIN();
        LAS float* wl = (LAS float*)(LAS unsigned char*)smem_raw + (tidx >> 6) * 3072;
#pragma nounroll
        for (int item = blockIdx.x * 8 + (tidx >> 6); item < 4096; item += gridDim.x * 8) peer_topk_wave(item, tidx & 63, wl, W_QX, W_SKB, W_IDS, W_GATES);
    }
    xcd_barrier(xb);
    {
        PH_BEGIN();
        const float* gf = PF(I_GFINAL); float* outp = (float*)ldp_raw(I_OUT);
#pragma nounroll
        PHASE_LOOP(T) d_peer_out8(VB, tid, sm, W_HB, W_XR, W_IDS, W_GATES, W_UT, W_VT, W_RSC, gf, outp);
    }
}
}

extern "C" void kernel_launch(void* const* d_in, const int* in_sizes, int n_in, void* d_out, int out_size, void* d_ws, size_t ws_size, hipStream_t stream) {
    static int grid_blocks = 0;
    if (!grid_blocks) {
        int dev = 0, cus = 0, per_cu = 0;
        hipGetDevice(&dev);
        hipDeviceGetAttribute(&cus, hipDeviceAttributeMultiprocessorCount, dev);
        hipFuncSetAttribute((const void*)mega, hipFuncAttributeMaxDynamicSharedMemorySize, SMEM_BYTES);
        hipOccupancyMaxActiveBlocksPerMultiprocessor(&per_cu, mega, NTHR, SMEM_BYTES);
        if (per_cu > 1) per_cu = 1;
        if (per_cu < 1) per_cu = 1;
        grid_blocks = cus * per_cu;
    }
    Params P{};
    const float** pp = (const float**)&P;
    for (int i = 0; i < 25; ++i) pp[i] = (const float*)d_in[i];
    P.out = (float*)d_out;
    P.bar = (unsigned*)d_ws;
    P.ws = (float*)((char*)d_ws + 16384);
    hipMemsetAsync(d_ws, 0, 16384, stream);
    void* args[] = {&P};
    hipError_t e = hipLaunchCooperativeKernel((const void*)mega, dim3(grid_blocks), dim3(NTHR), args, SMEM_BYTES, stream);
    if (e != hipSuccess) fprintf(stderr, "cooperative launch failed: %s (grid %d)\n", hipGetErrorString(e), grid_blocks);
}
```

```cpp
#include <hip/hip_runtime.h>
#include <stdint.h>
#include <math.h>
#include <cstdio>

#define LAS_ __attribute__((address_space(3)))
namespace {
constexpr int D = 2048, NB = 2, S = 4096, T = NB * S;
constexpr int INC = 6152;
constexpr int C_MIN = 0, C_MV = 1024, C_MO = 2048, C_MI = 3072, C_MF = 3076, C_AQ = 3080, C_AK = 4104, C_AV = 5128;
constexpr float EPS = 1e-6f;
constexpr size_t P6S = (size_t)8192 * 1024;
constexpr int NTHR = 512;
constexpr int HALF_SM_FLOATS = 8704;
constexpr int GEMM_LDS = 131072;
constexpr int SMEM_BYTES = GEMM_LDS + 1024 + 8192 + 1024;
typedef unsigned short bf16_t;
__device__ __forceinline__ unsigned f2bf(float f) { unsigned u = __float_as_uint(f); u += 0x7FFFu + ((u >> 16) & 1u); return u >> 16; }
__device__ __forceinline__ unsigned pk2(float lo, float hi) { return f2bf(lo) | (f2bf(hi) << 16); }
__device__ __forceinline__ float bf2f(unsigned short b) { return __uint_as_float(((unsigned)b) << 16); }
extern __shared__ __attribute__((aligned(16))) unsigned char smem_raw[];
enum { I_X = 0, I_MEM, I_GMIX, I_WIN, I_CONVW, I_CONVB, I_WMQ, I_WMK, I_BMI, I_BMF, I_GMHEAD, I_GAHEAD, I_WOUT, I_GCROSS, I_GMEM,
       I_WXQ, I_WXK, I_WXV, I_WXO, I_GFFN, I_WPQ, I_SUBK, I_UTAB, I_VTAB, I_GFINAL, I_OUT, I_BAR, I_WS, I_NPTR };
__device__ __forceinline__ unsigned long long ldp_raw(int i) {
    const LAS_ unsigned long long* tab = (const LAS_ unsigned long long*)(LAS_ unsigned char*)(smem_raw + GEMM_LDS + 64);
    const unsigned long long v = tab[i];
    const unsigned lo = __builtin_amdgcn_readfirstlane((unsigned)v), hi = __builtin_amdgcn_readfirstlane((unsigned)(v >> 32));
    return ((unsigned long long)hi << 32) | lo;
}
#define PF(i) ((const float*)ldp_raw(i))

#define XB_TMO      128
#define XB_XCNT(j)  (256  + 64 * (j))
#define XB_XSUB(j)  (1280 + 64 * (j))
#define XB_XGEN(j)  (2304 + 64 * (j))
#define XB_TOP      3328
#define XB_TOPGEN   3392
#define XCD_BAR_WORDS 3456
#define XB_SPIN_CAP (1u << 22)
#define LAS __attribute__((address_space(3)))

__device__ __forceinline__ unsigned xb_ld(unsigned* p)              { return __hip_atomic_load(p, __ATOMIC_RELAXED, __HIP_MEMORY_SCOPE_AGENT); }
__device__ __forceinline__ unsigned xb_add(unsigned* p, unsigned v) { return __hip_atomic_fetch_add(p, v, __ATOMIC_RELAXED, __HIP_MEMORY_SCOPE_AGENT); }
__device__ __forceinline__ unsigned xb_xcc_id() { return (unsigned)__builtin_amdgcn_s_getreg((3 << 11) | 20) & 0xFu; }
#define XB_SPIN(cond, bar) do { unsigned _sp = 0; while (cond) { __builtin_amdgcn_s_sleep(1); \
    if ((++_sp & 255u) == 0u) { if (xb_ld(&(bar)[XB_TMO])) break; if (_sp > XB_SPIN_CAP) { atomicAdd(&(bar)[XB_TMO], 1u); break; } } } } while (0)

struct XcdBarrier { unsigned* bar; unsigned x; volatile LAS unsigned* st; };

__device__ __forceinline__ XcdBarrier xcd_barrier_post(unsigned* bar, volatile LAS unsigned* st) {
    XcdBarrier b; b.bar = bar; b.x = xb_xcc_id(); b.st = st;
    if (threadIdx.x == 0) (void)xb_add(&bar[XB_XCNT(b.x)], 1u);
    return b;
}
__device__ __forceinline__ void xcd_barrier_complete(unsigned* bar, unsigned x, unsigned& nloc, unsigned& nx) {
    const unsigned G = gridDim.x * gridDim.y * gridDim.z;
    unsigned sum, cnt, mine, sp = 0u;
    for (;;) {
        sum = 0u; cnt = 0u; mine = 0u;
#pragma unroll
        for (unsigned j = 0; j < 16; ++j) { const unsigned c = xb_ld(&bar[XB_XCNT(j)]); sum += c; cnt += (c > 0u) ? 1u : 0u; mine = (j == x) ? c : mine; }
        if (sum == G) break;
        __builtin_amdgcn_s_sleep(1);
        if ((++sp & 255u) == 0u) { if (xb_ld(&bar[XB_TMO])) break; if (sp > XB_SPIN_CAP) { atomicAdd(&bar[XB_TMO], 1u); break; } }
    }
    nloc = mine > 0u ? mine : 1u; nx = cnt > 0u ? cnt : 1u;
}
__device__ __forceinline__ void xcd_barrier(const XcdBarrier& b) {
    asm volatile("s_waitcnt vmcnt(0)" ::: "memory");
    __syncthreads();
    if (threadIdx.x == 0) {
        unsigned* bar = b.bar;
        __builtin_amdgcn_s_waitcnt(0);
        unsigned nloc = b.st[0], nx = b.st[1];
        if (nloc == 0u) { xcd_barrier_complete(bar, b.x, nloc, nx); b.st[0] = nloc; b.st[1] = nx; }
        const unsigned old = xb_add(&bar[XB_XSUB(b.x)], 1u);
        const unsigned gen = old / nloc;
        if (old + 1u == (gen + 1u) * nloc) {
            __builtin_amdgcn_fence(__ATOMIC_RELEASE, "agent");
            asm volatile("s_waitcnt vmcnt(0)" ::: "memory");
            const unsigned og = xb_add(&bar[XB_TOP], 1u);
            const unsigned tg = og / nx;
            if (og + 1u == (tg + 1u) * nx) xb_add(&bar[XB_TOPGEN], 1u);
            else XB_SPIN(xb_ld(&bar[XB_TOPGEN]) == tg, bar);
            __builtin_amdgcn_fence(__ATOMIC_ACQUIRE, "agent");
            xb_add(&bar[XB_XGEN(b.x)], 1u);
            asm volatile("s_waitcnt vmcnt(0)" ::: "memory");
        } else {
            XB_SPIN(xb_ld(&bar[XB_XGEN(b.x)]) == gen, bar);
            __builtin_amdgcn_fence(__ATOMIC_ACQUIRE, "agent");
            asm volatile("s_waitcnt vmcnt(0)" ::: "memory");
        }
    }
    __syncthreads();
}

__device__ __forceinline__ float wave_sum(float v) {
#pragma unroll
    for (int o = 32; o >= 1; o >>= 1) v += __shfl_xor(v, o);
    return v;
}
__device__ __forceinline__ float wave_max(float v) {
#pragma unroll
    for (int o = 32; o >= 1; o >>= 1) v = fmaxf(v, __shfl_xor(v, o));
    return v;
}
__device__ __forceinline__ float log_sigmoid(float x) { return fminf(x, 0.f) - log1pf(expf(-fabsf(x))); }


__device__ __forceinline__ void d_rmsnorm(int vb, int t, float* sm, const float* __restrict__ in, const float* __restrict__ g, bf16_t* __restrict__ out,
                                          const float* gwl  , float* __restrict__ gpre) {
    float* red = sm;
    const int row = vb;
    const float4* p = (const float4*)(in + (size_t)row * D);
    float4 a = p[t], b = p[t + 256];
    float s = a.x * a.x + a.y * a.y + a.z * a.z + a.w * a.w + b.x * b.x + b.y * b.y + b.z * b.z + b.w * b.w;
    s = wave_sum(s);
    __syncthreads();
    if ((t & 63) == 0) red[t >> 6] = s;
    __syncthreads();
    const float tot = red[0] + red[1] + red[2] + red[3];
    const float r = rsqrtf(tot * (1.0f / D) + EPS);
    const float4* gp = (const float4*)g;
    float4 ga = gp[t], gb = gp[t + 256];
    float hv[8] = {a.x * r * ga.x, a.y * r * ga.y, a.z * r * ga.z, a.w * r * ga.w, b.x * r * gb.x, b.y * r * gb.y, b.z * r * gb.z, b.w * r * gb.w};
    uint2 o0, o1;
    o0.x = pk2(hv[0], hv[1]); o0.y = pk2(hv[2], hv[3]); o1.x = pk2(hv[4], hv[5]); o1.y = pk2(hv[6], hv[7]);
    *(uint2*)(out + (size_t)row * D + t * 4) = o0;
    *(uint2*)(out + (size_t)row * D + 1024 + t * 4) = o1;
    if (gpre) {
        float gs[8];
#pragma unroll
        for (int c = 0; c < 8; ++c) gs[c] = 0.f;
#pragma unroll
        for (int j = 0; j < 8; ++j) {
            const int k = (j < 4) ? (t * 4 + j) : (1024 + t * 4 + (j - 4));
            const float4 w0 = *(const float4*)(gwl + k * 8), w1 = *(const float4*)(gwl + k * 8 + 4);
            gs[0] = fmaf(hv[j], w0.x, gs[0]); gs[1] = fmaf(hv[j], w0.y, gs[1]); gs[2] = fmaf(hv[j], w0.z, gs[2]); gs[3] = fmaf(hv[j], w0.w, gs[3]);
            gs[4] = fmaf(hv[j], w1.x, gs[4]); gs[5] = fmaf(hv[j], w1.y, gs[5]); gs[6] = fmaf(hv[j], w1.z, gs[6]); gs[7] = fmaf(hv[j], w1.w, gs[7]);
        }
#pragma unroll
        for (int c = 0; c < 8; ++c) gs[c] = wave_sum(gs[c]);
        __syncthreads();
        if ((t & 63) == 0) {
#pragma unroll
            for (int c = 0; c < 8; ++c) red[8 + (t >> 6) * 8 + c] = gs[c];
        }
        __syncthreads();
        if (t < 8) gpre[(size_t)row * 8 + t] = red[8 + t] + red[16 + t] + red[24 + t] + red[32 + t];
    }
}

namespace pg8 {
typedef short bf16x8 __attribute__((ext_vector_type(8)));
typedef float f32x4 __attribute__((ext_vector_type(4)));
constexpr int BM = 256, BK = 64, HALF = 128, HTB = HALF * BK * 2, NXCD = 8, WGM = 8;
__device__ __forceinline__ int lds_byte(int r, int c) { const int st = (r >> 4) * 2 + (c >> 5), rr = r & 15, cc = c & 31, ob = rr * 64 + cc * 2; return st * 1024 + (ob ^ (((ob >> 9) & 1) << 5)); }
__device__ __forceinline__ void stage_rc(int b, int& R, int& C) { const int st = b / 1024, sb = b % 1024, swz = sb ^ (((sb >> 9) & 1) << 5); R = (st >> 1) * 16 + swz / 64; C = (st & 1) * 32 + (swz % 64) / 2; }
struct Unit { int pm, pn; };
struct GJob {
    const bf16_t* A; const bf16_t* Bt;
    int lda, ldb, K, nM, nN;
    int a_pn_shift, a_pn_mask, a_pn_step;
    int b_pm_shift, b_pm_step, b_pn_step;
    int a_pm_step;
    float escale;
    const float* gs; float* denp; const float* qn; const float* gvec; const bf16_t* mo;
    bf16_t* C2; float* rssp; const float* rstd;
    float* C; int ldc; const float* R; int ldr;
    int mode;
};
__device__ __forceinline__ bool unit_next(const GJob& g, int i, Unit& u) {
    const int nwg = g.nM * g.nN;
    const long L = (long)i * gridDim.x + blockIdx.x; if (L >= nwg) return false;
    int wgid = (int)L; { const int q = nwg / NXCD, r = nwg % NXCD, xcd = wgid % NXCD, off = wgid / NXCD; wgid = (xcd < r ? xcd * (q + 1) : r * (q + 1) + (xcd - r) * q) + off; }
    const int nig = WGM * g.nN, gid = wgid / nig, fm = gid * WGM, gsz = (g.nM - fm) < WGM ? (g.nM - fm) : WGM;
    u.pm = fm + ((wgid % nig) % gsz); u.pn = (wgid % nig) / gsz; return true;
}
template <int MODE> __device__ __forceinline__ void epilogue(const GJob& g, f32x4 (&acc)[2][2][4][2], const Unit& u, int wr, int wc, int fr, int fq, LAS unsigned char* xlds) {
    const int row0 = u.pm * BM + wr * 64 + fr;
    if constexpr (MODE == 0) {
        const int col0 = u.pn * BM + wc * 32 + 4 * fq;
#pragma unroll
        for (int ai = 0; ai < 2; ++ai)
#pragma unroll
            for (int m = 0; m < 4; ++m) {
                const int row = row0 + ai * HALF + m * 16;
                float* rowp = g.C + (size_t)row * g.ldc + col0;
                const float* rp = g.R ? g.R + (size_t)row * g.ldr + col0 : nullptr;
#pragma unroll
                for (int bj = 0; bj < 2; ++bj)
#pragma unroll
                    for (int n = 0; n < 2; ++n) {
                        f32x4 v = acc[ai][bj][m][n];
                        if (rp) v = v + *(const f32x4*)(rp + bj * HALF + n * 16);
                        *(f32x4*)(rowp + bj * HALF + n * 16) = v;
                    }
            }
    } else if constexpr (MODE == 10) {
        const int col0 = u.pn * BM + wc * 32 + 4 * fq;
#pragma unroll
        for (int ai = 0; ai < 2; ++ai)
#pragma unroll
            for (int m = 0; m < 4; ++m) {
                const int row = row0 + ai * HALF + m * 16;
                float* rowp = g.C + (size_t)row * g.ldc + col0;
                const float* rp = g.R + (size_t)row * g.ldr + col0;
                bf16_t* r2 = g.C2 + (size_t)row * D + col0;
                float ss = 0.f;
#pragma unroll
                for (int bj = 0; bj < 2; ++bj)
#pragma unroll
                    for (int n = 0; n < 2; ++n) {
                        const f32x4 v = acc[ai][bj][m][n] + *(const f32x4*)(rp + bj * HALF + n * 16);
                        *(f32x4*)(rowp + bj * HALF + n * 16) = v;
                        const f32x4 gv = *(const f32x4*)(g.gvec + col0 + bj * HALF + n * 16);
                        uint2 o; o.x = pk2(v[0] * gv[0], v[1] * gv[1]); o.y = pk2(v[2] * gv[2], v[3] * gv[3]);
                        *(uint2*)(r2 + bj * HALF + n * 16) = o;
                        ss += (v[0] * v[0] + v[1] * v[1]) + (v[2] * v[2] + v[3] * v[3]);
                    }
                ss += __shfl_xor(ss, 16); ss += __shfl_xor(ss, 32);
                if (fq == 0) g.rssp[(size_t)row * 32 + u.pn * 4 + wc] = ss;
            }
    } else if constexpr (MODE == 11) {
        bf16_t* Cb = (bf16_t*)g.C;
        const int col0 = u.pn * BM + wc * 32 + 4 * fq;
#pragma unroll
        for (int ai = 0; ai < 2; ++ai)
#pragma unroll
            for (int m = 0; m < 4; ++m) {
                const int row = row0 + ai * HALF + m * 16;
                const float rs = ((const LAS float*)(xlds + 8192))[row - u.pm * BM];
                bf16_t* rowp = Cb + (size_t)row * g.ldc + col0;
#pragma unroll
                for (int bj = 0; bj < 2; ++bj)
#pragma unroll
                    for (int n = 0; n < 2; ++n) {
                        const f32x4 v = acc[ai][bj][m][n] * rs;
                        uint2 o; o.x = pk2(v[0], v[1]); o.y = pk2(v[2], v[3]);
                        *(uint2*)(rowp + bj * HALF + n * 16) = o;
                    }
            }
    } else if constexpr (MODE == 6) {
        const int h = u.pn; const size_t t0 = (size_t)u.pm * BM;
        bf16_t* Cb = (bf16_t*)g.C;
#pragma unroll
        for (int ai = 0; ai < 2; ++ai)
#pragma unroll
            for (int m = 0; m < 4; ++m) {
                const int l = ai * HALF + wr * 64 + m * 16 + fr;
                const float M2 = g.gs[((t0 + l) * 4 + h) * 8 + 1];
                bf16_t* rowp = Cb + (t0 + l) * 2048 + h * 512 + wc * 32 + 4 * fq;
                float rs = 0.f;
#pragma unroll
                for (int bj = 0; bj < 2; ++bj)
#pragma unroll
                    for (int n = 0; n < 2; ++n) {
                        const f32x4 a = acc[ai][bj][m][n];
                        const int s0 = bj * HALF + wc * 32 + n * 16 + 4 * fq;
                        float p[4];
#pragma unroll
                        for (int r = 0; r < 4; ++r) { const float u2 = g.gs[((t0 + s0 + r) * 4 + h) * 8 + 0]; p[r] = (s0 + r <= l) ? a[r] * __builtin_amdgcn_exp2f(u2 - M2) : 0.f; rs += p[r]; }
                        uint2 o; o.x = pk2(p[0], p[1]); o.y = pk2(p[2], p[3]);
                        *(uint2*)(rowp + bj * HALF + n * 16) = o;
                    }
                rs += __shfl_xor(rs, 16); rs += __shfl_xor(rs, 32);
                if (fq == 0) g.denp[((t0 + l) * 4 + h) * 4 + wc] = rs;
            }
    } else if constexpr (MODE == 7) {
        float* Ct = g.C + (size_t)(u.pm * 4 + u.pn) * 65536;
        const int col0 = wc * 32 + 4 * fq;
#pragma unroll
        for (int ai = 0; ai < 2; ++ai)
#pragma unroll
            for (int m = 0; m < 4; ++m) {
                float* rowp = Ct + (size_t)(ai * HALF + wr * 64 + m * 16 + fr) * 256 + col0;
#pragma unroll
                for (int bj = 0; bj < 2; ++bj)
#pragma unroll
                    for (int n = 0; n < 2; ++n) *(f32x4*)(rowp + bj * HALF + n * 16) = acc[ai][bj][m][n];
            }
    } else if constexpr (MODE == 8) {
        const int h = u.pn; const size_t t0 = (size_t)u.pm * BM;
        LAS float* X0 = (LAS float*)xlds + wr * 512;
#pragma unroll
        for (int ai = 0; ai < 2; ++ai)
#pragma unroll
            for (int m = 0; m < 4; ++m) {
                const size_t th = (t0 + ai * HALF + wr * 64 + m * 16 + fr) * 4 + h;
                const f32x4 dp = *(const f32x4*)(g.denp + th * 4);
                const float den = (dp[0] + dp[1]) + (dp[2] + dp[3]) + g.gs[th * 8 + 3] * g.qn[th];
                const float rden = 1.0f / fmaxf(fabsf(den), g.gs[th * 8 + 4]);
                float ss = 0.f;
#pragma unroll
                for (int bj = 0; bj < 2; ++bj)
#pragma unroll
                    for (int n = 0; n < 2; ++n) { f32x4 a = acc[ai][bj][m][n] * rden; acc[ai][bj][m][n] = a; ss += (a[0] * a[0] + a[1] * a[1]) + (a[2] * a[2] + a[3] * a[3]); }
                ss += __shfl_xor(ss, 16); ss += __shfl_xor(ss, 32);
                if (fq == 0) X0[(ai * 64 + m * 16 + fr) * 4 + wc] = ss;
            }
        asm volatile("s_waitcnt lgkmcnt(0)" ::: "memory"); __builtin_amdgcn_s_barrier(); asm volatile("" ::: "memory");
        bf16_t* Cb = (bf16_t*)g.C;
        const int col0 = wc * 32 + 4 * fq;
#pragma unroll
        for (int ai = 0; ai < 2; ++ai)
#pragma unroll
            for (int m = 0; m < 4; ++m) {
                const f32x4 p4 = *(const LAS f32x4*)(X0 + (ai * 64 + m * 16 + fr) * 4);
                const float rsn = rsqrtf(((p4[0] + p4[1]) + (p4[2] + p4[3])) * (1.0f / 256.0f) + EPS);
                const size_t t = t0 + ai * HALF + wr * 64 + m * 16 + fr;
                bf16_t* rowp = Cb + t * 2048 + h * 256 + col0;
                const bf16_t* mop = g.mo + t * 1024 + h * 256 + col0;
#pragma unroll
                for (int bj = 0; bj < 2; ++bj)
#pragma unroll
                    for (int n = 0; n < 2; ++n) {
                        const f32x4 a = acc[ai][bj][m][n];
                        const ushort4 mo4 = *(const ushort4*)(mop + bj * HALF + n * 16);
                        const f32x4 gv = *(const f32x4*)(g.gvec + h * 256 + col0 + bj * HALF + n * 16);
                        const float o0 = a[0] * rsn * gv[0] / (1.0f + __expf(-bf2f(mo4.x)));
                        const float o1 = a[1] * rsn * gv[1] / (1.0f + __expf(-bf2f(mo4.y)));
                        const float o2 = a[2] * rsn * gv[2] / (1.0f + __expf(-bf2f(mo4.z)));
                        const float o3 = a[3] * rsn * gv[3] / (1.0f + __expf(-bf2f(mo4.w)));
                        uint2 o; o.x = pk2(o0, o1); o.y = pk2(o2, o3);
                        *(uint2*)(rowp + bj * HALF + n * 16) = o;
                    }
            }
    } else if constexpr (MODE == 5) {
        LAS float* X0 = (LAS float*)xlds + wr * 512;
        LAS float* X1 = (LAS float*)xlds + 1024 + wr * 512;
#pragma unroll
        for (int ai = 0; ai < 2; ++ai)
#pragma unroll
            for (int m = 0; m < 4; ++m) {
                float v = -INFINITY;
#pragma unroll
                for (int bj = 0; bj < 2; ++bj)
#pragma unroll
                    for (int n = 0; n < 2; ++n) { const f32x4 a = acc[ai][bj][m][n]; v = fmaxf(v, fmaxf(fmaxf(a[0], a[1]), fmaxf(a[2], a[3]))); }
                v = fmaxf(v, __shfl_xor(v, 16)); v = fmaxf(v, __shfl_xor(v, 32));
                if (fq == 0) X0[(ai * 64 + m * 16 + fr) * 4 + wc] = v;
            }
        asm volatile("s_waitcnt lgkmcnt(0)" ::: "memory"); __builtin_amdgcn_s_barrier(); asm volatile("" ::: "memory");
#pragma unroll
        for (int ai = 0; ai < 2; ++ai)
#pragma unroll
            for (int m = 0; m < 4; ++m) {
                const f32x4 p4 = *(const LAS f32x4*)(X0 + (ai * 64 + m * 16 + fr) * 4);
                const float mxr = fmaxf(fmaxf(p4[0], p4[1]), fmaxf(p4[2], p4[3])) * g.escale;
                float s = 0.f;
#pragma unroll
                for (int bj = 0; bj < 2; ++bj)
#pragma unroll
                    for (int n = 0; n < 2; ++n) { f32x4 a = acc[ai][bj][m][n];
                        a[0] = __builtin_amdgcn_exp2f(a[0] * g.escale - mxr); a[1] = __builtin_amdgcn_exp2f(a[1] * g.escale - mxr); a[2] = __builtin_amdgcn_exp2f(a[2] * g.escale - mxr); a[3] = __builtin_amdgcn_exp2f(a[3] * g.escale - mxr);
                        acc[ai][bj][m][n] = a; s += (a[0] + a[1]) + (a[2] + a[3]); }
                s += __shfl_xor(s, 16); s += __shfl_xor(s, 32);
                if (fq == 0) X1[(ai * 64 + m * 16 + fr) * 4 + wc] = s;
            }
        asm volatile("s_waitcnt lgkmcnt(0)" ::: "memory"); __builtin_amdgcn_s_barrier(); asm volatile("" ::: "memory");
        bf16_t* Cb = (bf16_t*)g.C;
        const int col0 = u.pn * BM + wc * 32 + 4 * fq;
#pragma unroll
        for (int ai = 0; ai < 2; ++ai)
#pragma unroll
            for (int m = 0; m < 4; ++m) {
                const f32x4 p4 = *(const LAS f32x4*)(X1 + (ai * 64 + m * 16 + fr) * 4);
                const float inv = 1.0f / ((p4[0] + p4[1]) + (p4[2] + p4[3]));
                bf16_t* rowp = Cb + (size_t)(row0 + ai * HALF + m * 16) * g.ldc + col0;
#pragma unroll
                for (int bj = 0; bj < 2; ++bj)
#pragma unroll
                    for (int n = 0; n < 2; ++n) {
                        const f32x4 a = acc[ai][bj][m][n];
                        uint2 o; o.x = pk2(a[0] * inv, a[1] * inv); o.y = pk2(a[2] * inv, a[3] * inv);
                        *(uint2*)(rowp + bj * HALF + n * 16) = o;
                    }
            }
    } else {
        bf16_t* Cb = (bf16_t*)g.C; int ccol = u.pn * BM;
        if constexpr (MODE == 4) { Cb += (size_t)(u.pn >> 2) * P6S; ccol = (u.pn & 3) * 256; }
        const int col0 = ccol + wc * 32 + 4 * fq;
#pragma unroll
        for (int ai = 0; ai < 2; ++ai)
#pragma unroll
            for (int m = 0; m < 4; ++m) {
                bf16_t* rowp = Cb + (size_t)(row0 + ai * HALF + m * 16) * g.ldc + col0;
#pragma unroll
                for (int bj = 0; bj < 2; ++bj)
#pragma unroll
                    for (int n = 0; n < 2; ++n) {
                        const f32x4 v = acc[ai][bj][m][n];
                        uint2 o; o.x = pk2(v[0], v[1]); o.y = pk2(v[2], v[3]);
                        *(uint2*)(rowp + bj * HALF + n * 16) = o;
                    }
            }
    }
}
template <int MODE> __device__ __forceinline__ void gemm_phase(LAS unsigned char* lds, const GJob& g, int tid) {
    const int wid = __builtin_amdgcn_readfirstlane(tid >> 6), lane = tid & 63, wr = wid >> 2, wc = wid & 3, fr = lane & 15, fq = lane >> 4;
    const int K = g.K, nt = K / BK;
    unsigned voffA[2], voffB[2];
#pragma unroll
    for (int i = 0; i < 2; ++i) { int R, C; stage_rc(tid * 16 + i * 8192, R, C);
        voffA[i] = (unsigned)(R * g.lda + C) * 2u; voffB[i] = (unsigned)(R * g.ldb + C) * 2u; }
    const size_t kstep = (size_t)(BK * 2);
    const size_t hstepA = (size_t)HALF * g.lda * 2, hstepB = (size_t)HALF * g.ldb * 2;
    const unsigned ldsw = (unsigned)wid * 1024u;
    const int aoff = lds_byte(wr * 64 + fr, fq * 8), boff = lds_byte(wc * 32 + fr, fq * 8);
#define PG8_SA(b, h) (((b) * 2 + (h)) * HTB)
#define PG8_SB(b, h) ((4 + (b) * 2 + (h)) * HTB)
#define PG8_STAGE(bufoff, gbase, voff) do { _Pragma("unroll") for (int _i = 0; _i < 2; ++_i) \
        __builtin_amdgcn_global_load_lds((const unsigned*)((const char*)(gbase) + (voff)[_i]), (LAS unsigned*)(lds + (bufoff) + ldsw + _i * 8192), 16, 0, 0); } while (0)
#define PG8_LDA(dst, b, h) do { _Pragma("unroll") for (int m = 0; m < 4; ++m) _Pragma("unroll") for (int k = 0; k < 2; ++k) dst[m][k] = *(const LAS bf16x8*)(lds + PG8_SA(b, h) + aoff + m * 2048 + k * 1024); } while (0)
#define PG8_LDB(dst, b, h) do { _Pragma("unroll") for (int n = 0; n < 2; ++n) _Pragma("unroll") for (int k = 0; k < 2; ++k) dst[n][k] = *(const LAS bf16x8*)(lds + PG8_SB(b, h) + boff + n * 2048 + k * 1024); } while (0)
#define PG8_MMA(ai, bj, At, Bt) do { __builtin_amdgcn_s_setprio(1); _Pragma("unroll") for (int m = 0; m < 4; ++m) _Pragma("unroll") for (int n = 0; n < 2; ++n) _Pragma("unroll") for (int k = 0; k < 2; ++k) \
        acc[ai][bj][m][n] = __builtin_amdgcn_mfma_f32_16x16x32_bf16(Bt[n][k], At[m][k], acc[ai][bj][m][n], 0, 0, 0); __builtin_amdgcn_s_setprio(0); } while (0)
#define PG8_WAIT_V(n) asm volatile("s_waitcnt vmcnt(" #n ")" ::: "memory")
#define PG8_WAIT_L(n) asm volatile("s_waitcnt lgkmcnt(" #n ")" ::: "memory")
#define PG8_BAR __builtin_amdgcn_s_barrier()
#define PG8_SCHED __builtin_amdgcn_sched_barrier(0)
#define PG8_ABASE(u) ((const char*)g.A + ((size_t)(u).pm * g.a_pm_step + (size_t)(((u).pn >> g.a_pn_shift) & g.a_pn_mask) * g.a_pn_step) * 2)
#define PG8_BBASE(u) ((const char*)g.Bt + ((size_t)(u).pn * g.b_pn_step + (size_t)((u).pm >> g.b_pm_shift) * g.b_pm_step) * 2)
    Unit cur, nxt; int ui = 0;
    if (!unit_next(g, 0, cur)) return;
    f32x4 acc[2][2][4][2];
#pragma unroll
    for (int a = 0; a < 2; ++a)
#pragma unroll
        for (int b = 0; b < 2; ++b)
#pragma unroll
            for (int m = 0; m < 4; ++m)
#pragma unroll
                for (int n = 0; n < 2; ++n) acc[a][b][m][n] = (f32x4){0.f, 0.f, 0.f, 0.f};
    bf16x8 At[4][2], B0[2][2], B1[2][2];
    const char* cA = PG8_ABASE(cur); const char* cB = PG8_BBASE(cur);
    PG8_STAGE(PG8_SB(0, 0), cB, voffB); PG8_STAGE(PG8_SA(0, 0), cA, voffA); PG8_STAGE(PG8_SB(0, 1), cB + hstepB, voffB); PG8_STAGE(PG8_SA(0, 1), cA + hstepA, voffA);
    if (wr == 1) PG8_BAR;
    PG8_WAIT_V(4); PG8_BAR;
    PG8_STAGE(PG8_SB(1, 0), cB + kstep, voffB); PG8_STAGE(PG8_SA(1, 0), cA + kstep, voffA); PG8_STAGE(PG8_SB(1, 1), cB + hstepB + kstep, voffB);
    PG8_WAIT_V(6); PG8_BAR;
    for (;;) {
        const bool has_next = unit_next(g, ui + 1, nxt);
        const char* nA = has_next ? PG8_ABASE(nxt) : cA; const char* nB = has_next ? PG8_BBASE(nxt) : cB;
        for (int t = 0; t < nt; t += 2) {
            const bool last = (t == nt - 2);
            const char* a1 = cA + (size_t)(t + 1) * kstep;
            const char* a2 = last ? nA : cA + (size_t)(t + 2) * kstep; const char* b2 = last ? nB : cB + (size_t)(t + 2) * kstep;
            const char* a3 = a2 + kstep; const char* b3 = b2 + kstep;
            PG8_LDB(B0, 0, 0); PG8_SCHED; PG8_LDA(At, 0, 0); PG8_STAGE(PG8_SA(1, 1), a1 + hstepA, voffA);
            PG8_WAIT_L(8); PG8_BAR; PG8_WAIT_L(0); PG8_MMA(0, 0, At, B0); PG8_BAR; PG8_SCHED;
            PG8_LDB(B1, 0, 1); PG8_STAGE(PG8_SB(0, 0), b2, voffB);
            PG8_BAR; PG8_WAIT_L(0); PG8_MMA(0, 1, At, B1); PG8_BAR;
            PG8_LDA(At, 0, 1); PG8_STAGE(PG8_SA(0, 0), a2, voffA);
            PG8_BAR; PG8_WAIT_L(0); PG8_MMA(1, 0, At, B0); PG8_BAR; PG8_SCHED;
            PG8_STAGE(PG8_SB(0, 1), b2 + hstepB, voffB);
            PG8_WAIT_V(6); PG8_BAR; PG8_MMA(1, 1, At, B1); PG8_BAR;
            PG8_LDB(B0, 1, 0); PG8_SCHED; PG8_LDA(At, 1, 0); PG8_STAGE(PG8_SA(0, 1), a2 + hstepA, voffA);
            PG8_WAIT_L(8); PG8_BAR; PG8_WAIT_L(0); PG8_MMA(0, 0, At, B0); PG8_BAR; PG8_SCHED;
            PG8_LDB(B1, 1, 1); PG8_STAGE(PG8_SB(1, 0), b3, voffB);
            PG8_BAR; PG8_WAIT_L(0); PG8_MMA(0, 1, At, B1); PG8_BAR;
            PG8_LDA(At, 1, 1); PG8_STAGE(PG8_SA(1, 0), a3, voffA);
            PG8_BAR; PG8_WAIT_L(0); PG8_MMA(1, 0, At, B0); PG8_BAR; PG8_SCHED;
            PG8_STAGE(PG8_SB(1, 1), b3 + hstepB, voffB);
            PG8_WAIT_V(6); PG8_BAR; PG8_MMA(1, 1, At, B1); PG8_BAR;
        }
        epilogue<MODE>(g, acc, cur, wr, wc, fr, fq, lds + GEMM_LDS + 1024);
        if (!has_next) break;
#pragma unroll
        for (int a = 0; a < 2; ++a)
#pragma unroll
            for (int b = 0; b < 2; ++b)
#pragma unroll
                for (int m = 0; m < 4; ++m)
#pragma unroll
                    for (int n = 0; n < 2; ++n) acc[a][b][m][n] = (f32x4){0.f, 0.f, 0.f, 0.f};
        cur = nxt; cA = nA; cB = nB; ++ui;
    }
    PG8_WAIT_V(0);
    if (wr == 0) PG8_BAR;
    PG8_BAR;
#undef PG8_SA
#undef PG8_SB
#undef PG8_STAGE
#undef PG8_LDA
#undef PG8_LDB
#undef PG8_MMA
#undef PG8_WAIT_V
#undef PG8_WAIT_L
#undef PG8_BAR
#undef PG8_SCHED
#undef PG8_ABASE
#undef PG8_BBASE
}
}

__device__ __forceinline__ void p0_transpose_item(const float* W, int ldw, int K, int csrc0, bf16_t* WT, int row0, LAS float* scr, int kb, int lane, float wscale) {
    const int k0 = 64 * kb;
#pragma unroll
    for (int i = 0; i < 8; ++i) { const int kk = 8 * i + (lane >> 3), n4 = (lane & 7) * 4;
        const float4 v = *(const float4*)(W + (size_t)(k0 + kk) * ldw + csrc0 + n4);
        scr[kk * 33 + n4] = v.x * wscale; scr[kk * 33 + n4 + 1] = v.y * wscale; scr[kk * 33 + n4 + 2] = v.z * wscale; scr[kk * 33 + n4 + 3] = v.w * wscale; }
    asm volatile("s_waitcnt lgkmcnt(0)" ::: "memory");
    const int c = lane & 7;
#pragma unroll
    for (int j = 0; j < 4; ++j) { const int n = (lane >> 3) + 8 * j; const LAS float* s = scr + (8 * c) * 33 + n;
        uint4 o; o.x = pk2(s[0 * 33], s[1 * 33]); o.y = pk2(s[2 * 33], s[3 * 33]); o.z = pk2(s[4 * 33], s[5 * 33]); o.w = pk2(s[6 * 33], s[7 * 33]);
        *(uint4*)(WT + (size_t)(row0 + n) * K + k0 + 8 * c) = o; }
    asm volatile("s_waitcnt lgkmcnt(0)" ::: "memory");
}

__device__ __forceinline__ void d_conv_silu(int vb, int tid, const bf16_t* __restrict__ p6, const float* __restrict__ cw, const float* __restrict__ cb, bf16_t* __restrict__ c) {
    const int t = vb, s = t % S;
    for (int ch = tid; ch < 1024; ch += 256) {
        float y = cb[ch];
#pragma unroll
        for (int j = 0; j < 4; ++j) {
            const int ss = s - 3 + j;
            if (ss >= 0) y = fmaf(cw[j * 1024 + ch], bf2f(p6[(size_t)(t - 3 + j) * 1024 + ch]), y);
        }
        c[(size_t)t * 1024 + ch] = (bf16_t)f2bf(y / (1.0f + expf(-y)));
    }
}

__device__ __forceinline__ void d_mlstm(int vb, int tid, const bf16_t* __restrict__ mq, const bf16_t* __restrict__ mk, const bf16_t* __restrict__ p6,
                                        const float* __restrict__ gpre, const float* __restrict__ b_mi, const float* __restrict__ b_mf, float* __restrict__ hraw) {
    const int lane = tid & 63, w = tid >> 6;
    const int gid = vb * 4 + w;
    const int e = gid & 255, h = (gid >> 8) & 3, b = gid >> 10;
    const float bi = b_mi[h], bf = b_mf[h];
    float C0 = 0.f, C1 = 0.f, C2 = 0.f, C3 = 0.f, n0 = 0.f, n1 = 0.f, n2 = 0.f, n3 = 0.f, m = 0.f;
    const size_t tb = (size_t)b * S;
    const bf16_t* qp = mq + tb * 1024 + h * 256 + lane * 4;
    const bf16_t* kp = mk + tb * 1024 + h * 256 + lane * 4;
    const bf16_t* pp = p6 + P6S + tb * 1024 + h * 256 + e;
    ushort4 qn = *(const ushort4*)qp, kn = *(const ushort4*)kp;
    const float* gp = gpre + tb * 8;
    float vn = bf2f(pp[0]), in_ = gp[h], fn = gp[4 + h];
    for (int s = 0; s < S; ++s) {
        const float4 q = make_float4(bf2f(qn.x), bf2f(qn.y), bf2f(qn.z), bf2f(qn.w)), k = make_float4(bf2f(kn.x), bf2f(kn.y), bf2f(kn.z), bf2f(kn.w)); const float v = vn, ipre = in_ + bi, fpre = fn + bf;
        if (s + 1 < S) {
            qn = *(const ushort4*)(qp + (size_t)(s + 1) * 1024);
            kn = *(const ushort4*)(kp + (size_t)(s + 1) * 1024);
            vn = bf2f(pp[(size_t)(s + 1) * 1024]); in_ = gp[(size_t)(s + 1) * 8 + h]; fn = gp[(size_t)(s + 1) * 8 + 4 + h];
        }
        const float logf = log_sigmoid(fpre);
        const float mnew = fmaxf(logf + m, ipre);
        const float fd = expf(logf + m - mnew), ig = expf(ipre - mnew);
        m = mnew;
        const float sc = ig * 0.0625f;
        C0 = fd * C0 + sc * k.x * v; C1 = fd * C1 + sc * k.y * v; C2 = fd * C2 + sc * k.z * v; C3 = fd * C3 + sc * k.w * v;
        n0 = fd * n0 + sc * k.x; n1 = fd * n1 + sc * k.y; n2 = fd * n2 + sc * k.z; n3 = fd * n3 + sc * k.w;
        float num = q.x * C0 + q.y * C1 + q.z * C2 + q.w * C3;
        float den = q.x * n0 + q.y * n1 + q.z * n2 + q.w * n3;
        num = wave_sum(num); den = wave_sum(den);
        if (lane == 0) hraw[(tb + s) * 1024 + h * 256 + e] = num / fmaxf(fabsf(den), expf(-mnew));
    }
}

__device__ __forceinline__ void d_mhead_norm(int vb, int tid, const float* __restrict__ hraw, const bf16_t* __restrict__ p6, const float* __restrict__ g, bf16_t* __restrict__ mix) {
    const int t = vb, h = tid >> 6, lane = tid & 63;
    const float4 v = *(const float4*)(hraw + (size_t)t * 1024 + h * 256 + lane * 4);
    float s = v.x * v.x + v.y * v.y + v.z * v.z + v.w * v.w;
    s = wave_sum(s);
    const float r = rsqrtf(s * (1.0f / 256.0f) + EPS);
    const float4 gg = *(const float4*)(g + h * 256 + lane * 4);
    const ushort4 mo = *(const ushort4*)(p6 + 2 * P6S + (size_t)t * 1024 + h * 256 + lane * 4);
    float4 o;
    o.x = v.x * r * gg.x / (1.0f + expf(-bf2f(mo.x)));
    o.y = v.y * r * gg.y / (1.0f + expf(-bf2f(mo.y)));
    o.z = v.z * r * gg.z / (1.0f + expf(-bf2f(mo.z)));
    o.w = v.w * r * gg.w / (1.0f + expf(-bf2f(mo.w)));
    uint2 ob; ob.x = pk2(o.x, o.y); ob.y = pk2(o.z, o.w);
    *(uint2*)(mix + (size_t)t * D + h * 256 + lane * 4) = ob;
}

__device__ __forceinline__ void d_rope(int vb, int tid, bf16_t* __restrict__ p6) {
    const int t = vb, s = t % S;
    for (int idx = tid; idx < 2 * 8 * 64; idx += 256) {
        const int i = idx & 63, hd = (idx >> 6) & 7, qk = idx >> 9;
        const float inv = exp2f(-(float)i * 0.20762050593046014f);
        const float ang = (float)s * inv;
        float sn, cs; sincosf(ang, &sn, &cs);
        bf16_t* p = p6 + (size_t)(3 + qk) * P6S + (size_t)t * 1024 + hd * 128;
        const float x1 = bf2f(p[i]), x2 = bf2f(p[64 + i]);
        p[i] = (bf16_t)f2bf(x1 * cs - x2 * sn);
        p[64 + i] = (bf16_t)f2bf(x2 * cs + x1 * sn);
    }
}

__device__ __forceinline__ void d_dilated(int vb, int tid, float* sm, const bf16_t* __restrict__ p6, const float* __restrict__ g_ahead, bf16_t* __restrict__ mix) {
    float (*qs)[128] = (float (*)[128])sm;
    float (*ps)[576] = (float (*)[576])(sm + 512);
    const int lane = tid & 63, w = tid >> 6;
    const int gid = vb * 4 + w;
    const int s = gid % S, hd = (gid / S) & 7, b = gid / (S * 8);
    const size_t t = (size_t)b * S + s;
    const bf16_t* qrow = p6 + 3 * P6S + t * 1024 + hd * 128;
    __syncthreads();
    qs[w][lane] = bf2f(qrow[lane]); qs[w][lane + 64] = bf2f(qrow[lane + 64]);
    __syncthreads();
    const float scale = 0.08838834764831845f;
    float mloc = -INFINITY;
    for (int br = 0; br < 3; ++br) {
        const int dil = br == 0 ? 1 : (br == 1 ? 4 : 16);
        for (int jj = 0; jj < 192; jj += 64) {
            const int j = jj + lane;
            float sc = -INFINITY;
            if (j <= 128 && s - j * dil >= 0) {
                const bf16_t* krow = p6 + 4 * P6S + (t - (size_t)j * dil) * 1024 + hd * 128;
                float d = 0.f;
#pragma unroll 8
                for (int c = 0; c < 128; c += 4) {
                    const ushort4 kv = *(const ushort4*)(krow + c);
                    d = fmaf(qs[w][c], bf2f(kv.x), d); d = fmaf(qs[w][c + 1], bf2f(kv.y), d); d = fmaf(qs[w][c + 2], bf2f(kv.z), d); d = fmaf(qs[w][c + 3], bf2f(kv.w), d);
                }
                sc = d * scale;
            }
            ps[w][br * 192 + j] = sc;
            mloc = fmaxf(mloc, sc);
        }
    }
    const float mx = wave_max(mloc);
    __syncthreads();
    float lsum = 0.f;
    for (int i = lane; i < 3 * 192; i += 64) {
        const float sc = ps[w][i];
        const float pv = (sc == -INFINITY) ? 0.f : expf(sc - mx);
        ps[w][i] = pv; lsum += pv;
    }
    const float tot = wave_sum(lsum);
    __syncthreads();
    float o0 = 0.f, o1 = 0.f;
    for (int br = 0; br < 3; ++br) {
        const int dil = br == 0 ? 1 : (br == 1 ? 4 : 16);
        for (int j = 0; j <= 128; ++j) {
            if (s - j * dil < 0) break;
            const float pv = ps[w][br * 192 + j];
            const bf16_t* vrow = p6 + 5 * P6S + (t - (size_t)j * dil) * 1024 + hd * 128;
            o0 = fmaf(pv, bf2f(vrow[lane]), o0); o1 = fmaf(pv, bf2f(vrow[lane + 64]), o1);
        }
    }
    o0 /= tot; o1 /= tot;
    float ss = wave_sum(o0 * o0 + o1 * o1);
    const float r = rsqrtf(ss * (1.0f / 128.0f) + EPS);
    bf16_t* orow = mix + t * D + 1024 + hd * 128;
    orow[lane] = (bf16_t)f2bf(o0 * r * g_ahead[hd * 128 + lane]);
    orow[lane + 64] = (bf16_t)f2bf(o1 * r * g_ahead[hd * 128 + lane + 64]);
}

__device__ __forceinline__ void d_cross(int vb, int tid, float* sm, const bf16_t* __restrict__ q, const float* __restrict__ km, const float* __restrict__ vm, bf16_t* __restrict__ o) {
    float (*qs)[512] = (float (*)[512])sm;
    float (*ps)[256] = (float (*)[256])(sm + 2048);
    const int lane = tid & 63, w = tid >> 6;
    const int t = vb, hd = w, b = t / S;
    const bf16_t* qrow = q + (size_t)t * D + hd * 512;
    __syncthreads();
    for (int i = lane; i < 512; i += 64) qs[w][i] = bf2f(qrow[i]);
    __syncthreads();
    const float scale = 0.04419417382415922f;
    float sc[4]; float mloc = -INFINITY;
#pragma unroll
    for (int r = 0; r < 4; ++r) {
        const int mi = lane + 64 * r;
        const float* krow = km + ((size_t)b * 256 + mi) * D + hd * 512;
        float d = 0.f;
#pragma unroll 8
        for (int c = 0; c < 512; c += 4) {
            const float4 kv = *(const float4*)(krow + c);
            d = fmaf(qs[w][c], kv.x, d); d = fmaf(qs[w][c + 1], kv.y, d); d = fmaf(qs[w][c + 2], kv.z, d); d = fmaf(qs[w][c + 3], kv.w, d);
        }
        sc[r] = d * scale; mloc = fmaxf(mloc, sc[r]);
    }
    const float mx = wave_max(mloc);
    float lsum = 0.f;
#pragma unroll
    for (int r = 0; r < 4; ++r) { const float pv = expf(sc[r] - mx); ps[w][lane + 64 * r] = pv; lsum += pv; }
    const float tot = wave_sum(lsum);
    __syncthreads();
    float acc[8];
#pragma unroll
    for (int i = 0; i < 8; ++i) acc[i] = 0.f;
    for (int mi = 0; mi < 256; ++mi) {
        const float pv = ps[w][mi];
        const float* vrow = vm + ((size_t)b * 256 + mi) * D + hd * 512;
#pragma unroll
        for (int i = 0; i < 8; ++i) acc[i] = fmaf(pv, vrow[lane + 64 * i], acc[i]);
    }
    bf16_t* orow = o + (size_t)t * D + hd * 512;
#pragma unroll
    for (int i = 0; i < 8; ++i) orow[lane + 64 * i] = (bf16_t)f2bf(acc[i] / tot);
}

__device__ __forceinline__ void wave_argmax(float& best, int& bidx) {
#pragma unroll
    for (int o = 32; o >= 1; o >>= 1) {
        const float ob = __shfl_xor(best, o); const int oi = __shfl_xor(bidx, o);
        if (ob > best || (ob == best && oi < bidx)) { best = ob; bidx = oi; }
    }
}
__device__ __forceinline__ void d_peer_topk(int vb, int tid, float* sm, const bf16_t* __restrict__ qp, const float* __restrict__ sub_keys, int* __restrict__ ids, float* __restrict__ gates) {
    float (*qs)[256] = (float (*)[256])sm;
    const int lane = tid & 63, w = tid >> 6;
    const int gid = vb * 4 + w;
    const int hd = gid & 7, t = gid >> 3;
    const bf16_t* qrow = qp + (size_t)t * D + hd * 256;
    __syncthreads();
    for (int i = lane; i < 256; i += 64) qs[w][i] = bf2f(qrow[i]);
    __syncthreads();
    float tops[2]; int topi[2];
#pragma unroll
    for (int p = 0; p < 2; ++p) {
        float v0, v1;
        {
            const float* k0 = sub_keys + ((size_t)(hd * 2 + p) * 128 + lane) * 128;
            const float* k1 = k0 + 64 * 128;
            float d0 = 0.f, d1 = 0.f;
#pragma unroll 8
            for (int c = 0; c < 128; c += 4) {
                const float4 a = *(const float4*)(k0 + c), bb = *(const float4*)(k1 + c);
                const float q0 = qs[w][p * 128 + c], q1 = qs[w][p * 128 + c + 1], q2 = qs[w][p * 128 + c + 2], q3 = qs[w][p * 128 + c + 3];
                d0 = fmaf(q0, a.x, d0); d0 = fmaf(q1, a.y, d0); d0 = fmaf(q2, a.z, d0); d0 = fmaf(q3, a.w, d0);
                d1 = fmaf(q0, bb.x, d1); d1 = fmaf(q1, bb.y, d1); d1 = fmaf(q2, bb.z, d1); d1 = fmaf(q3, bb.w, d1);
            }
            v0 = d0; v1 = d1;
        }
        float ts = 0.f; int ti = 0;
        for (int it = 0; it < 16; ++it) {
            float best; int bidx;
            if (v0 >= v1) { best = v0; bidx = lane; } else { best = v1; bidx = lane + 64; }
            wave_argmax(best, bidx);
            if (lane == it) { ts = best; ti = bidx; }
            if (bidx == lane) v0 = -INFINITY;
            if (bidx == lane + 64) v1 = -INFINITY;
        }
        tops[p] = ts; topi[p] = ti;
    }
    float cv[4]; int ci[4];
#pragma unroll
    for (int r = 0; r < 4; ++r) {
        const int c = lane * 4 + r, i = c >> 4, j = c & 15;
        const float s0 = __shfl(tops[0], i), s1 = __shfl(tops[1], j);
        const int i0 = __shfl(topi[0], i), i1 = __shfl(topi[1], j);
        cv[r] = s0 + s1; ci[r] = i0 * 128 + i1;
    }
    float bs = 0.f; int bid = 0;
    for (int it = 0; it < 16; ++it) {
        float best = cv[0]; int bidx = lane * 4;
#pragma unroll
        for (int r = 1; r < 4; ++r) if (cv[r] > best) { best = cv[r]; bidx = lane * 4 + r; }
        wave_argmax(best, bidx);
        const int owner = bidx >> 2, rr = bidx & 3;
        int myid = ci[0];
        if (rr == 1) myid = ci[1]; else if (rr == 2) myid = ci[2]; else if (rr == 3) myid = ci[3];
        const int eid = __shfl(myid, owner);
        if (lane == it) { bs = best; bid = eid; }
        if (owner == lane) {
#pragma unroll
            for (int r = 0; r < 4; ++r) if (rr == r) cv[r] = -INFINITY;
        }
    }
    float v = lane < 16 ? bs : -INFINITY;
    const float mx = wave_max(v);
    const float ev = lane < 16 ? expf(bs - mx) : 0.f;
    const float tot = wave_sum(ev);
    if (lane < 16) {
        ids[(size_t)t * 128 + hd * 16 + lane] = bid;
        gates[(size_t)t * 128 + hd * 16 + lane] = ev / tot;
    }
}

__device__ __forceinline__ void d_peer_out(int vb, int tid, float* sm, const bf16_t* __restrict__ h3, const float* __restrict__ x2, const int* __restrict__ ids, const float* __restrict__ gates,
                                           const bf16_t* __restrict__ u_tab, const bf16_t* __restrict__ v_tab, const float* __restrict__ g_final, float* __restrict__ out) {
    float (*part)[2048] = (float (*)[2048])sm;
    float* red = sm + 4 * 2048;
    const int lane = tid & 63, w = tid >> 6, t = vb;
    float4 xr[8], acc[8];
    const bf16_t* hrow = h3 + (size_t)t * D;
#pragma unroll
    for (int i = 0; i < 8; ++i) { const ushort4 hv = *(const ushort4*)(hrow + i * 256 + lane * 4);
        xr[i] = make_float4(bf2f(hv.x), bf2f(hv.y), bf2f(hv.z), bf2f(hv.w)); acc[i] = make_float4(0.f, 0.f, 0.f, 0.f); }
    for (int j = 0; j < 32; ++j) {
        const int slot = w * 32 + j;
        const int e = ids[(size_t)t * 128 + slot];
        const float gt = gates[(size_t)t * 128 + slot];
        const bf16_t* ur = u_tab + (size_t)e * D;
        const bf16_t* vr = v_tab + (size_t)e * D;
        float d = 0.f;
#pragma unroll
        for (int i = 0; i < 8; ++i) {
            const ushort4 u = *(const ushort4*)(ur + i * 256 + lane * 4);
            d = fmaf(xr[i].x, bf2f(u.x), d); d = fmaf(xr[i].y, bf2f(u.y), d); d = fmaf(xr[i].z, bf2f(u.z), d); d = fmaf(xr[i].w, bf2f(u.w), d);
        }
        d = wave_sum(d);
        const float act = 0.5f * d * (1.0f + erff(d * 0.7071067811865476f));
        const float cf = gt * act;
#pragma unroll
        for (int i = 0; i < 8; ++i) {
            const ushort4 v = *(const ushort4*)(vr + i * 256 + lane * 4);
            acc[i].x = fmaf(cf, bf2f(v.x), acc[i].x); acc[i].y = fmaf(cf, bf2f(v.y), acc[i].y); acc[i].z = fmaf(cf, bf2f(v.z), acc[i].z); acc[i].w = fmaf(cf, bf2f(v.w), acc[i].w);
        }
    }
    __syncthreads();
#pragma unroll
    for (int i = 0; i < 8; ++i) *(float4*)&part[w][i * 256 + lane * 4] = acc[i];
    __syncthreads();
    float4 r0, r1;
    {
        const float4 a = *(const float4*)&part[0][tid * 4], b = *(const float4*)&part[1][tid * 4], c = *(const float4*)&part[2][tid * 4], d = *(const float4*)&part[3][tid * 4];
        const float4 x = *(const float4*)(x2 + (size_t)t * D + tid * 4);
        r0 = make_float4(x.x + a.x + b.x + c.x + d.x, x.y + a.y + b.y + c.y + d.y, x.z + a.z + b.z + c.z + d.z, x.w + a.w + b.w + c.w + d.w);
    }
    {
        const float4 a = *(const float4*)&part[0][1024 + tid * 4], b = *(const float4*)&part[1][1024 + tid * 4], c = *(const float4*)&part[2][1024 + tid * 4], d = *(const float4*)&part[3][1024 + tid * 4];
        const float4 x = *(const float4*)(x2 + (size_t)t * D + 1024 + tid * 4);
        r1 = make_float4(x.x + a.x + b.x + c.x + d.x, x.y + a.y + b.y + c.y + d.y, x.z + a.z + b.z + c.z + d.z, x.w + a.w + b.w + c.w + d.w);
    }
    float s = r0.x * r0.x + r0.y * r0.y + r0.z * r0.z + r0.w * r0.w + r1.x * r1.x + r1.y * r1.y + r1.z * r1.z + r1.w * r1.w;
    s = wave_sum(s);
    if (lane == 0) red[w] = s;
    __syncthreads();
    const float tot = red[0] + red[1] + red[2] + red[3];
    const float r = rsqrtf(tot * (1.0f / D) + EPS);
    const float4 g0 = *(const float4*)(g_final + tid * 4), g1 = *(const float4*)(g_final + 1024 + tid * 4);
    *(float4*)(out + (size_t)t * D + tid * 4) = make_float4(r0.x * r * g0.x, r0.y * r * g0.y, r0.z * r * g0.z, r0.w * r * g0.w);
    *(float4*)(out + (size_t)t * D + 1024 + tid * 4) = make_float4(r1.x * r * g1.x, r1.y * r * g1.y, r1.z * r * g1.z, r1.w * r * g1.w);
}


__device__ __forceinline__ float wave_incl_scan_add(float v, int lane) {
#pragma unroll
    for (int o = 1; o < 64; o <<= 1) { const float t = __shfl_up(v, o); if (lane >= o) v += t; }
    return v;
}
__device__ __forceinline__ float wave_incl_scan_max(float v, int lane) {
#pragma unroll
    for (int o = 1; o < 64; o <<= 1) { const float t = __shfl_up(v, o); if (lane >= o) v = fmaxf(v, t); }
    return v;
}
__device__ __forceinline__ void mlstm_gates_wave(int b, int h, int lane, const float* __restrict__ gpre, const float* __restrict__ b_mi, const float* __restrict__ b_mf,
                                                 float* __restrict__ gs, float* __restrict__ decay) {
    const float bi = b_mi[h], bf = b_mf[h];
    float mprev = 0.f;
    for (int c = 0; c < 16; ++c) {
        const size_t t0 = (size_t)b * S + c * 256 + lane * 4;
        float logi[4], lf[4], bb[4];
#pragma unroll
        for (int j = 0; j < 4; ++j) { logi[j] = gpre[(t0 + j) * 8 + h] + bi; lf[j] = log_sigmoid(gpre[(t0 + j) * 8 + 4 + h] + bf); }
        bb[0] = lf[0]; bb[1] = bb[0] + lf[1]; bb[2] = bb[1] + lf[2]; bb[3] = bb[2] + lf[3];
        const float incl = wave_incl_scan_add(bb[3], lane);
        const float excl = incl - bb[3];
#pragma unroll
        for (int j = 0; j < 4; ++j) bb[j] += excl;
        const float g = __shfl(incl, 63);
        float amax = -INFINITY, uu[4], cm[4];
#pragma unroll
        for (int j = 0; j < 4; ++j) { amax = fmaxf(amax, logi[j] + g - bb[j]); uu[j] = logi[j] - bb[j]; }
        amax = wave_max(amax);
        const float mnew = fmaxf(g + mprev, amax);
        cm[0] = uu[0]; cm[1] = fmaxf(cm[0], uu[1]); cm[2] = fmaxf(cm[1], uu[2]); cm[3] = fmaxf(cm[2], uu[3]);
        const float cincl = wave_incl_scan_max(cm[3], lane);
        float cexcl = __shfl_up(cincl, 1); if (lane == 0) cexcl = -INFINITY;
#pragma unroll
        for (int j = 0; j < 4; ++j) {
            const float M = fmaxf(mprev, fmaxf(cexcl, cm[j]));
            float* o = gs + ((t0 + j) * 4 + h) * 8;
            o[0] = uu[j] * 1.4426950408889634f; o[1] = M * 1.4426950408889634f; o[2] = expf(logi[j] + g - bb[j] - mnew); o[3] = expf(mprev - M); o[4] = expf(-(bb[j] + M));
        }
        if (lane == 0) decay[(b * 16 + c) * 4 + h] = expf(g + mprev - mnew);
        mprev = mnew;
    }
}
__device__ __forceinline__ void transpose_tile64(int tid, float* sm, const bf16_t* __restrict__ src, int src_ld, bf16_t* __restrict__ dst, int dst_ld, const float* __restrict__ scale, int sstride) {
    unsigned short (*tl)[66] = (unsigned short (*)[66])sm;
    __syncthreads();
#pragma unroll
    for (int i = 0; i < 2; ++i) {
        const int ch = tid + i * 256, r = ch >> 3, c8 = (ch & 7) * 8;
        const uint4 v = *(const uint4*)(src + (size_t)r * src_ld + c8);
        const float sc = scale ? scale[(size_t)r * sstride] : 1.0f;
        const unsigned w[4] = {v.x, v.y, v.z, v.w};
#pragma unroll
        for (int k = 0; k < 4; ++k) {
            tl[r][c8 + 2 * k] = (unsigned short)f2bf(bf2f((unsigned short)(w[k] & 0xFFFFu)) * sc);
            tl[r][c8 + 2 * k + 1] = (unsigned short)f2bf(bf2f((unsigned short)(w[k] >> 16)) * sc);
        }
    }
    __syncthreads();
#pragma unroll
    for (int i = 0; i < 2; ++i) {
        const int ch = tid + i * 256, c = ch >> 3, r8 = (ch & 7) * 8;
        uint4 o;
        o.x = (unsigned)tl[r8 + 0][c] | ((unsigned)tl[r8 + 1][c] << 16); o.y = (unsigned)tl[r8 + 2][c] | ((unsigned)tl[r8 + 3][c] << 16);
        o.z = (unsigned)tl[r8 + 4][c] | ((unsigned)tl[r8 + 5][c] << 16); o.w = (unsigned)tl[r8 + 6][c] | ((unsigned)tl[r8 + 7][c] << 16);
        *(uint4*)(dst + (size_t)c * dst_ld + r8) = o;
    }
}

__device__ __forceinline__ void rope_table_fill(float2* __restrict__ cs, int gtid, int nth) {
    for (int idx = gtid; idx < 4096 * 64; idx += nth) {
        const int i = idx & 63, s = idx >> 6;
        const float inv = exp2f(-(float)i * 0.20762050593046014f);
        const float ang = (float)s * inv;
        float sn, c; sincosf(ang, &sn, &c);
        cs[idx] = make_float2(c, sn);
    }
}
__device__ __forceinline__ void rope_q_pass(bf16_t* __restrict__ aq, const float2* __restrict__ cs, size_t gtid, size_t nth) {
    for (size_t idx = gtid; idx < (size_t)T * 8 * 8; idx += nth) {
        const int c8 = (int)(idx & 7), hd = (int)((idx >> 3) & 7); const size_t t = idx >> 6; const int s = (int)(t & (S - 1));
        bf16_t* p = aq + t * 1024 + hd * 128 + c8 * 8;
        const uint4 a = *(const uint4*)p, b = *(const uint4*)(p + 64);
        const unsigned aw[4] = {a.x, a.y, a.z, a.w}, bw[4] = {b.x, b.y, b.z, b.w};
        unsigned ao[4], bo[4];
#pragma unroll
        for (int k = 0; k < 4; ++k) {
            const float4 cc = *(const float4*)(cs + (size_t)s * 64 + c8 * 8 + 2 * k);
            const float x10 = __uint_as_float(aw[k] << 16), x11 = __uint_as_float(aw[k] & 0xFFFF0000u), x20 = __uint_as_float(bw[k] << 16), x21 = __uint_as_float(bw[k] & 0xFFFF0000u);
            ao[k] = pk2(x10 * cc.x - x20 * cc.y, x11 * cc.z - x21 * cc.w);
            bo[k] = pk2(x20 * cc.x + x10 * cc.y, x21 * cc.z + x11 * cc.w);
        }
        *(uint4*)p = make_uint4(ao[0], ao[1], ao[2], ao[3]); *(uint4*)(p + 64) = make_uint4(bo[0], bo[1], bo[2], bo[3]);
    }
}
__device__ __forceinline__ void dil_tile_prep(int item, int lane, LAS unsigned short* wl, const bf16_t* __restrict__ ak, const bf16_t* __restrict__ av, const float2* __restrict__ cs,
                                              bf16_t* __restrict__ KB, bf16_t* __restrict__ VB) {
    const int TT = item & 255, hd = (item >> 8) & 7, b = (item >> 11) & 1, br = item >> 12;
    const int ld = 2 * br, tpr = 256 >> ld, rho = TT / tpr, tile = TT - rho * tpr;
    const int i = lane & 15, c = lane >> 4;
    const int s = rho + ((16 * tile + i) << ld);
    const size_t trow = (size_t)b * S + s;
    bf16_t* kdst = KB + (size_t)item * 2048;
    bf16_t* vdst = VB + (size_t)item * 2048;
    {
        const bf16_t* kr = ak + trow * 1024 + hd * 128 + 16 * c;
        const uint4 a0 = *(const uint4*)kr, a1 = *(const uint4*)(kr + 8), b0 = *(const uint4*)(kr + 64), b1 = *(const uint4*)(kr + 72);
        const unsigned aw[8] = {a0.x, a0.y, a0.z, a0.w, a1.x, a1.y, a1.z, a1.w}, bw[8] = {b0.x, b0.y, b0.z, b0.w, b1.x, b1.y, b1.z, b1.w};
        unsigned ao[8], bo[8];
#pragma unroll
        for (int k = 0; k < 8; ++k) {
            const float4 cc = *(const float4*)(cs + (size_t)s * 64 + 16 * c + 2 * k);
            const float x10 = __uint_as_float(aw[k] << 16), x11 = __uint_as_float(aw[k] & 0xFFFF0000u), x20 = __uint_as_float(bw[k] << 16), x21 = __uint_as_float(bw[k] & 0xFFFF0000u);
            ao[k] = pk2(x10 * cc.x - x20 * cc.y, x11 * cc.z - x21 * cc.w);
            bo[k] = pk2(x20 * cc.x + x10 * cc.y, x21 * cc.z + x11 * cc.w);
        }
        bf16_t* d0 = kdst + (c >> 1) * 512 + i * 32 + (c & 1) * 16;
        *(uint4*)d0 = make_uint4(ao[0], ao[1], ao[2], ao[3]); *(uint4*)(d0 + 8) = make_uint4(ao[4], ao[5], ao[6], ao[7]);
        bf16_t* d1 = d0 + 1024;
        *(uint4*)d1 = make_uint4(bo[0], bo[1], bo[2], bo[3]); *(uint4*)(d1 + 8) = make_uint4(bo[4], bo[5], bo[6], bo[7]);
    }
    {
        const bf16_t* vr = av + trow * 1024 + hd * 128 + 32 * c;
        const uint4 v0 = *(const uint4*)vr, v1 = *(const uint4*)(vr + 8), v2 = *(const uint4*)(vr + 16), v3 = *(const uint4*)(vr + 24);
        LAS unsigned short* wr = wl + i * 136 + 32 * c;
        typedef unsigned u32x4_t __attribute__((ext_vector_type(4)));
        *(LAS u32x4_t*)wr = (u32x4_t){v0.x, v0.y, v0.z, v0.w}; *(LAS u32x4_t*)(wr + 8) = (u32x4_t){v1.x, v1.y, v1.z, v1.w};
        *(LAS u32x4_t*)(wr + 16) = (u32x4_t){v2.x, v2.y, v2.z, v2.w}; *(LAS u32x4_t*)(wr + 24) = (u32x4_t){v3.x, v3.y, v3.z, v3.w};
        asm volatile("s_waitcnt lgkmcnt(0)" ::: "memory");
        unsigned o[16];
#pragma unroll
        for (int k = 0; k < 8; ++k) {
            const unsigned p0 = *(const LAS unsigned*)(wl + (2 * k) * 136 + 2 * lane), p1 = *(const LAS unsigned*)(wl + (2 * k + 1) * 136 + 2 * lane);
            o[k] = (p0 & 0xFFFFu) | (p1 << 16);
            o[8 + k] = (p0 >> 16) | (p1 & 0xFFFF0000u);
        }
        bf16_t* d = vdst + (2 * lane) * 16;
        *(uint4*)d = make_uint4(o[0], o[1], o[2], o[3]); *(uint4*)(d + 8) = make_uint4(o[4], o[5], o[6], o[7]);
        *(uint4*)(d + 16) = make_uint4(o[8], o[9], o[10], o[11]); *(uint4*)(d + 24) = make_uint4(o[12], o[13], o[14], o[15]);
        asm volatile("s_waitcnt lgkmcnt(0)" ::: "memory");
    }
}

typedef short bf16x8_t __attribute__((ext_vector_type(8)));
typedef short bf16x4_t __attribute__((ext_vector_type(4)));
typedef float f32x4_t __attribute__((ext_vector_type(4)));
__device__ __forceinline__ void dilated_wave_tile(int qt, int lane, const bf16_t* __restrict__ AQ, const bf16_t* __restrict__ KB, const bf16_t* __restrict__ VB,
                                                  const float* __restrict__ g_ahead, bf16_t* __restrict__ mix) {
    const int r = qt & 15, blk = (qt >> 4) & 15, hd = (qt >> 8) & 7, b = qt >> 11;
    const int j = lane & 15, g = lane >> 4;
    const int t0 = blk * 256;
    const int sq = t0 + r + 16 * j;
    bf16x8_t qf[4];
    {
        const bf16_t* qrow = AQ + ((size_t)b * S + sq) * 1024 + hd * 128 + 8 * g;
#pragma unroll
        for (int ks = 0; ks < 4; ++ks) qf[ks] = *(const bf16x8_t*)(qrow + 32 * ks);
    }
    const float sc = 0.08838834764831845f * 1.4426950408889634f;
    float m_run = -1e30f, l_run = 0.f;
    f32x4_t o[8];
#pragma unroll
    for (int dt = 0; dt < 8; ++dt) o[dt] = (f32x4_t){0.f, 0.f, 0.f, 0.f};
#pragma nounroll
    for (int br = 0; br < 3; ++br) {
        const int ld = 2 * br, d = 1 << ld;
        const int rho = r & (d - 1);
        const int qj = (sq - rho) >> ld;
        const int q_lo = ((t0 + r - rho) >> ld) - 128, q_hi = (t0 + r + 240 - rho) >> ld;
        const int tile_lo = q_lo < 0 ? 0 : (q_lo >> 4), tile_hi = q_hi >> 4, tile_max = (256 >> ld) - 1;
        const size_t tbase = ((size_t)((br * 2 + b) * 8 + hd) * 256 + (size_t)rho * (256 >> ld)) * 2048;
        const bf16_t* kbb = KB + tbase + j * 32 + 8 * g;
        const bf16_t* vbb = VB + tbase + j * 16 + 4 * g;
#pragma nounroll
        for (int tp = tile_lo; tp <= tile_hi; tp += 2) {
            f32x4_t su[2];
#pragma unroll
            for (int u = 0; u < 2; ++u) {
                int tl = tp + u; if (tl > tile_max) tl = tile_max;
                const bf16_t* krow = kbb + (size_t)tl * 2048;
                f32x4_t a = (f32x4_t){0.f, 0.f, 0.f, 0.f};
#pragma unroll
                for (int ks = 0; ks < 4; ++ks) a = __builtin_amdgcn_mfma_f32_16x16x32_bf16(*(const bf16x8_t*)(krow + 512 * ks), qf[ks], a, 0, 0, 0);
                su[u] = a;
            }
            float p[2][4]; float mx = -1e30f;
#pragma unroll
            for (int u = 0; u < 2; ++u)
#pragma unroll
                for (int e = 0; e < 4; ++e) {
                    const int n = qj - (16 * (tp + u) + 4 * g + e);
                    const bool valid = (n >= 0) && (n <= 128);
                    p[u][e] = valid ? su[u][e] * sc : -1e30f;
                    mx = fmaxf(mx, p[u][e]);
                }
            mx = fmaxf(mx, __shfl_xor(mx, 16)); mx = fmaxf(mx, __shfl_xor(mx, 32));
            const float m_new = fmaxf(m_run, mx);
            const float alpha = __builtin_amdgcn_exp2f(m_run - m_new);
            m_run = m_new;
            float ps = 0.f;
#pragma unroll
            for (int u = 0; u < 2; ++u)
#pragma unroll
                for (int e = 0; e < 4; ++e) { p[u][e] = (p[u][e] > -1e29f) ? __builtin_amdgcn_exp2f(p[u][e] - m_new) : 0.f; ps += p[u][e]; }
            l_run = l_run * alpha + ps;
            bf16x8_t pb;
            {
                const unsigned w0 = pk2(p[0][0], p[0][1]), w1 = pk2(p[0][2], p[0][3]), w2 = pk2(p[1][0], p[1][1]), w3 = pk2(p[1][2], p[1][3]);
                pb[0] = (short)(w0 & 0xFFFF); pb[1] = (short)(w0 >> 16); pb[2] = (short)(w1 & 0xFFFF); pb[3] = (short)(w1 >> 16);
                pb[4] = (short)(w2 & 0xFFFF); pb[5] = (short)(w2 >> 16); pb[6] = (short)(w3 & 0xFFFF); pb[7] = (short)(w3 >> 16);
            }
            int tl0 = tp, tl1 = tp + 1; if (tl0 > tile_max) tl0 = tile_max; if (tl1 > tile_max) tl1 = tile_max;
#pragma unroll
            for (int dt = 0; dt < 8; ++dt) {
                const bf16_t* vrow = vbb + dt * 256;
                const bf16x4_t v0 = *(const bf16x4_t*)(vrow + (size_t)tl0 * 2048), v1 = *(const bf16x4_t*)(vrow + (size_t)tl1 * 2048);
                bf16x8_t va; va[0] = v0[0]; va[1] = v0[1]; va[2] = v0[2]; va[3] = v0[3]; va[4] = v1[0]; va[5] = v1[1]; va[6] = v1[2]; va[7] = v1[3];
                f32x4_t oo = o[dt]; oo = oo * alpha;
                o[dt] = __builtin_amdgcn_mfma_f32_16x16x32_bf16(va, pb, oo, 0, 0, 0);
            }
        }
    }
    float lt = l_run; lt += __shfl_xor(lt, 16); lt += __shfl_xor(lt, 32);
    const float inv = 1.0f / lt;
    float ss = 0.f;
#pragma unroll
    for (int dt = 0; dt < 8; ++dt) { o[dt] = o[dt] * inv; ss += (o[dt][0] * o[dt][0] + o[dt][1] * o[dt][1]) + (o[dt][2] * o[dt][2] + o[dt][3] * o[dt][3]); }
    ss += __shfl_xor(ss, 16); ss += __shfl_xor(ss, 32);
    const float rn = rsqrtf(ss * (1.0f / 128.0f) + EPS);
    bf16_t* orow = mix + ((size_t)b * S + sq) * D + 1024 + hd * 128 + 4 * g;
#pragma unroll
    for (int dt = 0; dt < 8; ++dt) {
        const f32x4_t gv = *(const f32x4_t*)(g_ahead + hd * 128 + 16 * dt + 4 * g);
        uint2 w; w.x = pk2(o[dt][0] * rn * gv[0], o[dt][1] * rn * gv[1]); w.y = pk2(o[dt][2] * rn * gv[2], o[dt][3] * rn * gv[3]);
        *(uint2*)(orow + 16 * dt) = w;
    }
}

__device__ __forceinline__ unsigned ord_key(float s) { const unsigned u = __float_as_uint(s); return u ^ ((unsigned)((int)u >> 31) | 0x80000000u); }
__device__ __forceinline__ unsigned wave_max_u32(unsigned v) {
    unsigned t;
    t = (unsigned)__builtin_amdgcn_update_dpp(0, (int)v, 0xB1, 0xF, 0xF, true); v = v > t ? v : t;
    t = (unsigned)__builtin_amdgcn_update_dpp(0, (int)v, 0x4E, 0xF, 0xF, true); v = v > t ? v : t;
    t = (unsigned)__builtin_amdgcn_update_dpp(0, (int)v, 0x141, 0xF, 0xF, true); v = v > t ? v : t;
    t = (unsigned)__builtin_amdgcn_update_dpp(0, (int)v, 0x140, 0xF, 0xF, true); v = v > t ? v : t;
    const unsigned a = (unsigned)__builtin_amdgcn_readlane((int)v, 0), b = (unsigned)__builtin_amdgcn_readlane((int)v, 16),
                   c = (unsigned)__builtin_amdgcn_readlane((int)v, 32), d = (unsigned)__builtin_amdgcn_readlane((int)v, 48);
    const unsigned ab = a > b ? a : b, cd = c > d ? c : d;
    return ab > cd ? ab : cd;
}
__device__ __forceinline__ void peer_topk_wave(int item, int lane, LAS float* wl, const bf16_t* __restrict__ qp, const bf16_t* __restrict__ skb, int* __restrict__ ids, float* __restrict__ gates) {
    const int hd = item & 7, tt = item >> 3, j = lane & 15, g = lane >> 4;
    const size_t t0 = (size_t)tt * 16;
    LAS float* sc = wl;
    LAS float* lst = wl + 2048;
#pragma unroll 1
    for (int p = 0; p < 2; ++p) {
        bf16x8_t qf[4];
        const bf16_t* qrow = qp + (t0 + j) * D + hd * 256 + p * 128 + 8 * g;
#pragma unroll
        for (int ks = 0; ks < 4; ++ks) qf[ks] = *(const bf16x8_t*)(qrow + 32 * ks);
        const bf16_t* kb = skb + ((size_t)(hd * 2 + p) * 128 + j) * 128 + 8 * g;
#pragma unroll
        for (int kt = 0; kt < 8; ++kt) {
            f32x4_t a = (f32x4_t){0.f, 0.f, 0.f, 0.f};
#pragma unroll
            for (int ks = 0; ks < 4; ++ks) a = __builtin_amdgcn_mfma_f32_16x16x32_bf16(*(const bf16x8_t*)(kb + (size_t)kt * (16 * 128) + 32 * ks), qf[ks], a, 0, 0, 0);
            *(LAS f32x4_t*)(sc + j * 128 + 16 * kt + 4 * g) = a;
        }
        asm volatile("s_waitcnt lgkmcnt(0)" ::: "memory");
#pragma unroll 1
        for (int tok = 0; tok < 16; ++tok) {
            const float s0 = sc[tok * 128 + lane], s1 = sc[tok * 128 + 64 + lane];
            unsigned k0 = (ord_key(s0) & ~127u) | (unsigned)(127 - lane), k1 = (ord_key(s1) & ~127u) | (unsigned)(63 - lane);
            unsigned sel = 0u;
#pragma unroll 4
            for (int it = 0; it < 16; ++it) {
                unsigned m = k0 > k1 ? k0 : k1;
                m = wave_max_u32(m);
                if (lane == it) sel = m;
                if (k0 == m) k0 = 0u;
                if (k1 == m) k1 = 0u;
            }
            if (lane < 16) {
                const int idx = 127 - (int)(sel & 127u);
                lst[((p * 16 + tok) * 16 + lane) * 2 + 0] = sc[tok * 128 + idx];
                lst[((p * 16 + tok) * 16 + lane) * 2 + 1] = __int_as_float(idx);
            }
        }
        asm volatile("s_waitcnt lgkmcnt(0)" ::: "memory");
    }
#pragma unroll 1
    for (int tok = 0; tok < 16; ++tok) {
        const int i = lane >> 2;
        const float sA = lst[((0 * 16 + tok) * 16 + i) * 2];
        unsigned kk[4];
#pragma unroll
        for (int r = 0; r < 4; ++r) {
            const int jb = (lane & 3) * 4 + r;
            const float sum = sA + lst[((1 * 16 + tok) * 16 + jb) * 2];
            kk[r] = (ord_key(sum) & ~255u) | (unsigned)(255 - (lane * 4 + r));
        }
        unsigned sel = 0u;
#pragma unroll 4
        for (int it = 0; it < 16; ++it) {
            unsigned m = kk[0] > kk[1] ? kk[0] : kk[1]; const unsigned m2 = kk[2] > kk[3] ? kk[2] : kk[3]; m = m > m2 ? m : m2;
            m = wave_max_u32(m);
            if (lane == it) sel = m;
#pragma unroll
            for (int r = 0; r < 4; ++r) if (kk[r] == m) kk[r] = 0u;
        }
        float bs = -INFINITY; int eid = 0;
        if (lane < 16) {
            const int c = 255 - (int)(sel & 255u), ia = c >> 4, ib = c & 15;
            bs = lst[((0 * 16 + tok) * 16 + ia) * 2] + lst[((1 * 16 + tok) * 16 + ib) * 2];
            eid = __float_as_int(lst[((0 * 16 + tok) * 16 + ia) * 2 + 1]) * 128 + __float_as_int(lst[((1 * 16 + tok) * 16 + ib) * 2 + 1]);
        }
        const float mx = wave_max(bs);
        const float ev = lane < 16 ? __expf(bs - mx) : 0.f;
        const float tot = wave_sum(ev);
        if (lane < 16) {
            ids[(t0 + tok) * 128 + hd * 16 + lane] = eid;
            gates[(t0 + tok) * 128 + hd * 16 + lane] = ev / tot;
        }
    }
}

typedef float f32x2_t __attribute__((ext_vector_type(2)));
__device__ __forceinline__ void table_row_to_fp8(const float* __restrict__ srow, unsigned char* __restrict__ drow, float* __restrict__ rscale, int lane) {
    float4 f[8];
#pragma unroll
    for (int i = 0; i < 8; ++i) f[i] = *(const float4*)(srow + i * 256 + lane * 4);
    float am = 0.f;
#pragma unroll
    for (int i = 0; i < 8; ++i) am = fmaxf(am, fmaxf(fmaxf(fabsf(f[i].x), fabsf(f[i].y)), fmaxf(fabsf(f[i].z), fabsf(f[i].w))));
    am = wave_max(am);
    const float e = floorf(log2f(448.0f / fmaxf(am, 1e-30f)));
    const float s = exp2f(fminf(e, 100.0f));
    unsigned w[8];
#pragma unroll
    for (int i = 0; i < 8; ++i) {
        int t = 0;
        t = __builtin_amdgcn_cvt_pk_fp8_f32(f[i].x * s, f[i].y * s, t, false);
        t = __builtin_amdgcn_cvt_pk_fp8_f32(f[i].z * s, f[i].w * s, t, true);
        w[i] = (unsigned)t;
    }
#pragma unroll
    for (int i = 0; i < 8; ++i) *(unsigned*)(drow + i * 256 + lane * 4) = w[i];
    if (lane == 0) *rscale = 1.0f / s;
}
__device__ __forceinline__ float dot16_fp8(const uint4 q, const float* x) {
    float d = 0.f;
    const unsigned w[4] = {q.x, q.y, q.z, q.w};
#pragma unroll
    for (int k = 0; k < 4; ++k) {
        const f32x2_t lo = __builtin_amdgcn_cvt_pk_f32_fp8((int)w[k], false), hi = __builtin_amdgcn_cvt_pk_f32_fp8((int)w[k], true);
        d = fmaf(lo.x, x[4 * k], d); d = fmaf(lo.y, x[4 * k + 1], d); d = fmaf(hi.x, x[4 * k + 2], d); d = fmaf(hi.y, x[4 * k + 3], d);
    }
    return d;
}
__device__ __forceinline__ void axpy16_fp8(const uint4 q, float c, float* acc) {
    const unsigned w[4] = {q.x, q.y, q.z, q.w};
#pragma unroll
    for (int k = 0; k < 4; ++k) {
        const f32x2_t lo = __builtin_amdgcn_cvt_pk_f32_fp8((int)w[k], false), hi = __builtin_amdgcn_cvt_pk_f32_fp8((int)w[k], true);
        acc[4 * k] = fmaf(c, lo.x, acc[4 * k]); acc[4 * k + 1] = fmaf(c, lo.y, acc[4 * k + 1]); acc[4 * k + 2] = fmaf(c, hi.x, acc[4 * k + 2]); acc[4 * k + 3] = fmaf(c, hi.y, acc[4 * k + 3]);
    }
}
__device__ __forceinline__ void d_peer_out8(int vb, int tid, float* sm, const bf16_t* __restrict__ h3, const float* __restrict__ x2, const int* __restrict__ ids, const float* __restrict__ gates,
                                            const unsigned char* __restrict__ ut8, const unsigned char* __restrict__ vt8, const float* __restrict__ rsc, const float* __restrict__ rstd, const float* __restrict__ g_final, float* __restrict__ out) {
    float (*part)[2048] = (float (*)[2048])sm;
    float* red = sm + 4 * 2048;
    const int lane = tid & 63, w = tid >> 6, t = vb;
    float x[32], acc[32];
    {
        const bf16_t* hrow = h3 + (size_t)t * D + lane * 16;
#pragma unroll
        for (int hh = 0; hh < 2; ++hh) {
            const uint4 a = *(const uint4*)(hrow + hh * 1024), b = *(const uint4*)(hrow + hh * 1024 + 8);
            const unsigned ww[8] = {a.x, a.y, a.z, a.w, b.x, b.y, b.z, b.w};
#pragma unroll
            for (int k = 0; k < 8; ++k) { x[hh * 16 + 2 * k] = __uint_as_float(ww[k] << 16); x[hh * 16 + 2 * k + 1] = __uint_as_float(ww[k] & 0xFFFF0000u); }
        }
#pragma unroll
        for (int i = 0; i < 32; ++i) acc[i] = 0.f;
    }
    const float xrs = rstd[t];
    const int myid = ids[(size_t)t * 128 + w * 32 + (lane & 31)];
    const float mygate = gates[(size_t)t * 128 + w * 32 + (lane & 31)];
#pragma unroll 1
    for (int j = 0; j < 32; j += 4) {
        int e[4]; uint4 uq[4][2], vq[4][2];
#pragma unroll
        for (int q = 0; q < 4; ++q) {
            e[q] = __builtin_amdgcn_readfirstlane(__shfl(myid, j + q));
            const unsigned char* ur = ut8 + (size_t)e[q] * 2048 + lane * 16;
            uq[q][0] = *(const uint4*)ur; uq[q][1] = *(const uint4*)(ur + 1024);
        }
#pragma unroll
        for (int q = 0; q < 4; ++q) {
            const unsigned char* vr = vt8 + (size_t)e[q] * 2048 + lane * 16;
            vq[q][0] = *(const uint4*)vr; vq[q][1] = *(const uint4*)(vr + 1024);
        }
        float d[4];
#pragma unroll
        for (int q = 0; q < 4; ++q) d[q] = dot16_fp8(uq[q][0], x) + dot16_fp8(uq[q][1], x + 16);
#pragma unroll
        for (int o = 32; o >= 1; o >>= 1) {
#pragma unroll
            for (int q = 0; q < 4; ++q) d[q] += __shfl_xor(d[q], o);
        }
#pragma unroll
        for (int q = 0; q < 4; ++q) {
            const float a = d[q] * rsc[e[q]] * xrs;
            const float act = 0.5f * a * (1.0f + erff(a * 0.7071067811865476f));
            const float cf = __shfl(mygate, j + q) * act * rsc[16384 + e[q]];
            axpy16_fp8(vq[q][0], cf, acc); axpy16_fp8(vq[q][1], cf, acc + 16);
        }
    }
    __syncthreads();
#pragma unroll
    for (int hh = 0; hh < 2; ++hh)
#pragma unroll
        for (int k = 0; k < 4; ++k) *(float4*)&part[w][hh * 1024 + lane * 16 + 4 * k] = make_float4(acc[hh * 16 + 4 * k], acc[hh * 16 + 4 * k + 1], acc[hh * 16 + 4 * k + 2], acc[hh * 16 + 4 * k + 3]);
    __syncthreads();
    float4 r0, r1;
    {
        const float4 a = *(const float4*)&part[0][tid * 4], b = *(const float4*)&part[1][tid * 4], c = *(const float4*)&part[2][tid * 4], dd = *(const float4*)&part[3][tid * 4];
        const float4 xx = *(const float4*)(x2 + (size_t)t * D + tid * 4);
        r0 = make_float4(xx.x + a.x + b.x + c.x + dd.x, xx.y + a.y + b.y + c.y + dd.y, xx.z + a.z + b.z + c.z + dd.z, xx.w + a.w + b.w + c.w + dd.w);
    }
    {
        const float4 a = *(const float4*)&part[0][1024 + tid * 4], b = *(const float4*)&part[1][1024 + tid * 4], c = *(const float4*)&part[2][1024 + tid * 4], dd = *(const float4*)&part[3][1024 + tid * 4];
        const float4 xx = *(const float4*)(x2 + (size_t)t * D + 1024 + tid * 4);
        r1 = make_float4(xx.x + a.x + b.x + c.x + dd.x, xx.y + a.y + b.y + c.y + dd.y, xx.z + a.z + b.z + c.z + dd.z, xx.w + a.w + b.w + c.w + dd.w);
    }
    float s = r0.x * r0.x + r0.y * r0.y + r0.z * r0.z + r0.w * r0.w + r1.x * r1.x + r1.y * r1.y + r1.z * r1.z + r1.w * r1.w;
    s = wave_sum(s);
    if (lane == 0) red[w] = s;
    __syncthreads();
    const float tot = red[0] + red[1] + red[2] + red[3];
    const float r = rsqrtf(tot * (1.0f / D) + EPS);
    const float4 g0 = *(const float4*)(g_final + tid * 4), g1 = *(const float4*)(g_final + 1024 + tid * 4);
    *(float4*)(out + (size_t)t * D + tid * 4) = make_float4(r0.x * r * g0.x, r0.y * r * g0.y, r0.z * r * g0.z, r0.w * r * g0.w);
    *(float4*)(out + (size_t)t * D + 1024 + tid * 4) = make_float4(r1.x * r * g1.x, r1.y * r * g1.y, r1.z * r * g1.z, r1.w * r * g1.w);
}

struct Params {
    const float *x, *mem, *g_mix, *w_in, *conv_w, *conv_b, *w_mq, *w_mk, *b_mi, *b_mf, *g_mhead, *g_ahead, *w_out, *g_cross, *g_mem,
                *w_xq, *w_xk, *w_xv, *w_xo, *g_ffn, *w_pq, *sub_keys, *u_tab, *v_tab, *g_final;
    float* out;
    unsigned* bar;
    float* ws;
};

#define PHASE_LOOP(nvb) for (int base_ = blockIdx.x * 2; base_ < (nvb); base_ += gridDim.x * 2)
#define VB (base_ + half)

__global__ void __launch_bounds__(NTHR) mega(Params P) {
    volatile LAS unsigned* st = (volatile LAS unsigned*)(LAS unsigned char*)(smem_raw + GEMM_LDS);
    if (threadIdx.x == 0) { st[0] = 0u; st[1] = 0u; st[2] = 0u; st[3] = 0u; }
    if (threadIdx.x < I_NPTR) ((LAS unsigned long long*)(LAS unsigned char*)(smem_raw + GEMM_LDS + 64))[threadIdx.x] = ((const unsigned long long*)&P)[threadIdx.x];
    __syncthreads();
    XcdBarrier xb = xcd_barrier_post((unsigned*)ldp_raw(I_BAR), st);

    constexpr size_t TD = (size_t)T * D;
    constexpr size_t O_HB = 6 * P6S * 2, O_CBUF = O_HB + (size_t)T * D * 2, O_MQ = O_CBUF + (size_t)T * 1024 * 2, O_MK = O_MQ + (size_t)T * 1024 * 2,
                     O_MIXB = O_MK + (size_t)T * 1024 * 2, O_WIN = O_MIXB + (size_t)T * D * 2, O_WOUT = O_WIN + (size_t)6144 * D * 2, O_WXQ = O_WOUT + (size_t)D * D * 2,
                     O_WXK = O_WXQ + (size_t)D * D * 2, O_WXV = O_WXK + (size_t)D * D * 2, O_WXO = O_WXV + (size_t)D * D * 2, O_WPQ = O_WXO + (size_t)D * D * 2,
                     O_WQK = O_WPQ + (size_t)D * D * 2, O_GPRE = O_WQK + (size_t)8 * 256 * 256 * 2, O_UT = O_GPRE + (size_t)T * 8 * 4, O_VT = O_UT + (size_t)16384 * D, O_RSC = O_VT + (size_t)16384 * D,
                     O_BH = O_RSC + (size_t)32768 * 4, O_GS = O_BH + (size_t)128 * 256 * 512 * 2, O_DENP = O_GS + (size_t)T * 4 * 8 * 4, O_QN = O_DENP + (size_t)T * 4 * 4 * 4,
                     O_DN = O_QN + (size_t)T * 4 * 4, O_DECAY = O_DN + (size_t)128 * 256 * 4, O_KB = O_DECAY + 4096, O_VB = O_KB + (size_t)12288 * 2048 * 2, O_CS = O_VB + (size_t)12288 * 2048 * 2, O_SKB = O_CS + (size_t)4096 * 64 * 8, O_RSSP = O_SKB + (size_t)262144 * 2, O_RSTD = O_RSSP + (size_t)T * 32 * 4, O_MN = O_RSTD + (size_t)T * 4, O_END = O_MN + (size_t)512 * D * 2;
    static_assert(O_END + 16384 <= (size_t)536870912, "workspace overflow");
#define W_P6    ((bf16_t*)wsb)
#define W_HB    ((bf16_t*)(wsb + O_HB))
#define W_CBUF  ((bf16_t*)(wsb + O_CBUF))
#define W_MQ    ((bf16_t*)(wsb + O_MQ))
#define W_MK    ((bf16_t*)(wsb + O_MK))
#define W_MIXB  ((bf16_t*)(wsb + O_MIXB))
#define W_GPRE  ((float*)(wsb + O_GPRE))
#define W_HRAW  ((float*)(wsb + O_HB))
#define W_XR    ((float*)wsb)
#define W_MN    ((bf16_t*)((float*)wsb + TD))
#define W_KM    ((bf16_t*)((float*)wsb + TD + (size_t)256 * D))
#define W_VMT   ((bf16_t*)((float*)wsb + TD + (size_t)768 * D))
#define W_PX    ((bf16_t*)(wsb + O_MK))
#define W_GATES ((float*)wsb + TD + (size_t)1280 * D)
#define W_IDS   ((int*)((float*)wsb + TD + (size_t)1280 * D + (size_t)T * 128))
#define W_QX    ((bf16_t*)(wsb + O_CBUF))
#define W_BH    ((bf16_t*)(wsb + O_BH))
#define W_KB    ((bf16_t*)(wsb + O_KB))
#define W_VB    ((bf16_t*)(wsb + O_VB))
#define W_CS    ((float2*)(wsb + O_CS))
#define W_SKB   ((bf16_t*)(wsb + O_SKB))
#define W_RSSP  ((float*)(wsb + O_RSSP))
#define W_RSTD  ((float*)(wsb + O_RSTD))
#define W_MN2   ((bf16_t*)(wsb + O_MN))
#define W_GS    ((float*)(wsb + O_GS))
#define W_DENP  ((float*)(wsb + O_DENP))
#define W_QN    ((float*)(wsb + O_QN))
#define W_DN    ((float*)(wsb + O_DN))
#define W_DECAY ((float*)(wsb + O_DECAY))
#define W_PQ    ((bf16_t*)(wsb + O_HB))
#define W_KWT   ((bf16_t*)(wsb + O_CBUF))
#define W_DC    ((float*)(wsb + 3 * P6S * 2))
#define W_UT    ((unsigned char*)(wsb + O_UT))
#define W_VT    ((unsigned char*)(wsb + O_VT))
#define W_RSC   ((float*)(wsb + O_RSC))
#define PH_BEGIN() int tidx = threadIdx.x; asm volatile("" : "+v"(tidx)); const int half = tidx >> 8, tid = tidx & 255; float* sm = (float*)smem_raw + half * HALF_SM_FLOATS; \
                   char* wsb = (char*)ldp_raw(I_WS); (void)half; (void)tid; (void)sm; (void)wsb
#define GJOB_DEFAULT(g) pg8::GJob g; g.lda = D; g.ldb = D; g.K = D; g.nM = 32; g.nN = 8; g.a_pm_step = 256 * D; g.a_pn_shift = 0; g.a_pn_mask = 0; g.a_pn_step = 0; g.b_pm_shift = 0; g.b_pm_step = 0; g.b_pn_step = 256 * D; \
                        g.ldc = D; g.R = nullptr; g.ldr = D; g.mode = 0; g.escale = 1.0f; g.gs = nullptr; g.denp = nullptr; g.qn = nullptr; g.gvec = nullptr; g.mo = nullptr; g.C2 = nullptr; g.rssp = nullptr; g.rstd = nullptr
#define GEMM_LDSP ((LAS unsigned char*)smem_raw)

    {
        PH_BEGIN();
        {
            LAS float* scr = (LAS float*)(LAS unsigned char*)(smem_raw) + (tidx >> 6) * (64 * 33);
            const int lane = tidx & 63;
            const int gw = blockIdx.x * 8 + (tidx >> 6), NGW = gridDim.x * 8;
            constexpr int I_IN = 32 * 192, I_SQ = 32 * 64, I_QK = 8 * 4 * 8;
            constexpr int NITEMS = I_IN + 6 * I_SQ + I_QK;
#pragma nounroll
            for (int it = gw; it < NITEMS; it += NGW) {
                const float* W; int ldw, K, csrc0, row0, kb; bf16_t* WT; float wscale = 1.0f;
                int r = it;
                if (r < I_IN) { const int nb = r % 192; kb = r / 192; W = PF(I_WIN); ldw = INC; K = D; csrc0 = nb * 32 + (nb >= 96 ? 8 : 0); WT = (bf16_t*)(wsb + O_WIN); row0 = nb * 32; }
                else if ((r -= I_IN) < 6 * I_SQ) {
                    const int wsel = r / I_SQ; r -= wsel * I_SQ; const int nb = r % 64; kb = r / 64; ldw = D; K = D; csrc0 = nb * 32; row0 = nb * 32;
                    W = PF(wsel == 0 ? I_WOUT : wsel == 1 ? I_WXQ : wsel == 2 ? I_WXK : wsel == 3 ? I_WXV : wsel == 4 ? I_WXO : I_WPQ);
                    WT = (bf16_t*)(wsb + O_WOUT + (size_t)wsel * ((size_t)D * D * 2));
                } else {
                    r -= 6 * I_SQ; const int hq = r / 32; r -= hq * 32; const int nb = r % 8; kb = r / 8;
                    W = PF(hq < 4 ? I_WMQ : I_WMK) + (size_t)(hq & 3) * 65536; ldw = 256; K = 256; csrc0 = nb * 32; WT = (bf16_t*)(wsb + O_WQK); row0 = hq * 256 + nb * 32;
                    if (hq >= 4) wscale = 0.0625f;
                }
                p0_transpose_item(W, ldw, K, csrc0, WT, row0, scr, kb, lane, wscale);
            }
            {
                const float* ut = PF(I_UTAB); const float* vt = PF(I_VTAB);
#pragma nounroll
                for (int row = gw; row < 32768; row += NGW) {
                    const bool second = row >= 16384; const int rr = second ? row - 16384 : row;
                    table_row_to_fp8((second ? vt : ut) + (size_t)rr * D, (second ? W_VT : W_UT) + (size_t)rr * D, W_RSC + row, lane);
                }
            }
            rope_table_fill(W_CS, blockIdx.x * NTHR + tidx, gridDim.x * NTHR);
            {
                const float* sk = PF(I_SUBK);
#pragma nounroll
                for (int i = blockIdx.x * NTHR + tidx; i < 262144 / 8; i += gridDim.x * NTHR) {
                    const float4 a = *(const float4*)(sk + (size_t)i * 8), b = *(const float4*)(sk + (size_t)i * 8 + 4);
                    uint4 o; o.x = pk2(a.x, a.y); o.y = pk2(a.z, a.w); o.z = pk2(b.x, b.y); o.w = pk2(b.z, b.w);
                    *(uint4*)(W_SKB + (size_t)i * 8) = o;
                }
            }
            __syncthreads();
        }
        {
            const float* rin = PF(I_X); const float* rg = PF(I_GMIX); const float* win = PF(I_WIN);
            float* gwl = (float*)smem_raw + 1024;
            for (int k = tidx; k < 2048; k += NTHR) { const float4 a = *(const float4*)(win + (size_t)k * INC + C_MI), b = *(const float4*)(win + (size_t)k * INC + C_MI + 4);
                *(float4*)(gwl + k * 8) = a; *(float4*)(gwl + k * 8 + 4) = b; }
            __syncthreads();
            float* red = (float*)smem_raw + half * 256;
#pragma nounroll
            PHASE_LOOP(T) d_rmsnorm(VB, tid, red, rin, rg, W_HB, gwl, W_GPRE);
            const float* min_ = PF(I_MEM); const float* mg = PF(I_GMEM);
#pragma nounroll
            PHASE_LOOP(512) d_rmsnorm(VB, tid, red, min_, mg, W_MN2, nullptr, nullptr);
        }
    }
    xcd_barrier(xb);
    {
        PH_BEGIN();
        GJOB_DEFAULT(g); g.A = W_HB; g.Bt = (bf16_t*)(wsb + O_WIN); g.nN = 24; g.C = (float*)W_P6; g.ldc = 1024;
        pg8::gemm_phase<4>(GEMM_LDSP, g, tidx);
    }
    xcd_barrier(xb);
    {
        PH_BEGIN();
        const float* cw = PF(I_CONVW); const float* cb = PF(I_CONVB);
#pragma nounroll
        PHASE_LOOP(T) d_conv_silu(VB, tid, W_P6, cw, cb, W_CBUF);
        rope_q_pass(W_P6 + 3 * P6S, W_CS, (size_t)blockIdx.x * NTHR + tidx, (size_t)gridDim.x * NTHR);
        {
            LAS unsigned short* wl = (LAS unsigned short*)(LAS unsigned char*)smem_raw + (tidx >> 6) * (16 * 136);
#pragma nounroll
            for (int item = blockIdx.x * 8 + (tidx >> 6); item < 12288; item += gridDim.x * 8) dil_tile_prep(item, tidx & 63, wl, W_P6 + 4 * P6S, W_P6 + 5 * P6S, W_CS, W_KB, W_VB);
            __syncthreads();
        }
        if (blockIdx.x < 8 && tidx < 64) mlstm_gates_wave(blockIdx.x >> 2, blockIdx.x & 3, tidx, W_GPRE, PF(I_BMI), PF(I_BMF), W_GS, W_DECAY);
#pragma nounroll
        PHASE_LOOP(2048) { const int it = VB, lt = it & 3, et = (it >> 2) & 3, h = (it >> 4) & 3, cg = it >> 6;
            transpose_tile64(tid, sm, W_P6 + P6S + (size_t)(cg * 256 + lt * 64) * 1024 + h * 256 + et * 64, 1024, W_BH + ((size_t)(cg * 4 + h) * 256 + et * 64) * 512 + lt * 64, 512, nullptr, 0); }
    }
    xcd_barrier(xb);
    {
        PH_BEGIN();
        {
            GJOB_DEFAULT(g); g.A = W_CBUF; g.lda = 1024; g.a_pm_step = 256 * 1024; g.Bt = (bf16_t*)(wsb + O_WQK); g.ldb = 256; g.b_pn_step = 256 * 256; g.K = 256; g.a_pn_mask = 3; g.a_pn_step = 256; g.C = (float*)W_MQ; g.ldc = 1024;
            pg8::gemm_phase<4>(GEMM_LDSP, g, tidx);
            __syncthreads();
        }
        const float* ga = PF(I_GAHEAD);
#pragma nounroll
        for (int qt = blockIdx.x * 8 + (tidx >> 6); qt < 4096; qt += gridDim.x * 8) dilated_wave_tile(qt, tidx & 63, W_P6 + 3 * P6S, W_KB, W_VB, ga, W_MIXB);
    }
    xcd_barrier(xb);
    {
        PH_BEGIN();
#pragma nounroll
        PHASE_LOOP(2048) { const int it = VB, lt = it & 3, dt = (it >> 2) & 3, h = (it >> 4) & 3, cg = it >> 6;
            transpose_tile64(tid, sm, W_MK + (size_t)(cg * 256 + lt * 64) * 1024 + h * 256 + dt * 64, 1024, W_KWT + ((size_t)(cg * 4 + h) * 256 + dt * 64) * 256 + lt * 64, 256,
                             W_GS + ((size_t)(cg * 256 + lt * 64) * 4 + h) * 8 + 2, 32); }
        {
            const size_t nth = (size_t)gridDim.x * NTHR;
#pragma nounroll
            for (size_t i = (size_t)blockIdx.x * NTHR + tidx; i < (size_t)T * 128; i += nth) {
                const size_t t = i >> 7; const int c8 = (int)(i & 127) * 8, h = c8 >> 8, d = c8 & 255;
                const float sc = W_GS[(t * 4 + h) * 8 + 3];
                const uint4 v = *(const uint4*)(W_MQ + t * 1024 + c8);
                uint4 o;
                o.x = pk2(bf2f((unsigned short)(v.x & 0xFFFFu)) * sc, bf2f((unsigned short)(v.x >> 16)) * sc); o.y = pk2(bf2f((unsigned short)(v.y & 0xFFFFu)) * sc, bf2f((unsigned short)(v.y >> 16)) * sc);
                o.z = pk2(bf2f((unsigned short)(v.z & 0xFFFFu)) * sc, bf2f((unsigned short)(v.z >> 16)) * sc); o.w = pk2(bf2f((unsigned short)(v.w & 0xFFFFu)) * sc, bf2f((unsigned short)(v.w >> 16)) * sc);
                *(uint4*)(W_PQ + t * 2048 + h * 512 + 256 + d) = o;
            }
        }
#pragma nounroll
        PHASE_LOOP(128) { const int cgh = VB, cg = cgh >> 2, h = cgh & 3;
            float a = 0.f;
            for (int l = 0; l < 256; ++l) { const size_t t = (size_t)cg * 256 + l; a = fmaf(W_GS[(t * 4 + h) * 8 + 2], bf2f(W_MK[t * 1024 + h * 256 + tid]), a); }
            W_DN[(size_t)cgh * 256 + tid] = a; }
        __syncthreads();
        {
            GJOB_DEFAULT(g); g.A = W_MQ; g.lda = 1024; g.a_pm_step = 256 * 1024; g.a_pn_mask = 3; g.a_pn_step = 256; g.K = 256; g.nN = 4;
            g.Bt = W_MK; g.ldb = 1024; g.b_pn_step = 256; g.b_pm_step = 256 * 1024; g.C = (float*)W_PQ; g.gs = W_GS; g.denp = W_DENP;
            pg8::gemm_phase<6>(GEMM_LDSP, g, tidx);
        }
    }
    xcd_barrier(xb);
    {
        PH_BEGIN();
        GJOB_DEFAULT(g); g.A = W_BH; g.lda = 512; g.a_pm_step = 4 * 256 * 512; g.a_pn_mask = 3; g.a_pn_step = 256 * 512; g.K = 256; g.nN = 4;
        g.Bt = W_KWT; g.ldb = 256; g.b_pn_step = 65536; g.b_pm_step = 4 * 65536; g.C = W_DC;
        pg8::gemm_phase<7>(GEMM_LDSP, g, tidx);
    }
    xcd_barrier(xb);
    {
        PH_BEGIN();
        {
#pragma nounroll
            for (int gid = blockIdx.x * NTHR + tidx; gid < 131072; gid += gridDim.x * NTHR) {
                const int bh = gid >> 14, b = bh >> 2, h = bh & 3, e = (gid >> 6) & 255, d = (gid & 63) * 4;
                float4 C = make_float4(0.f, 0.f, 0.f, 0.f);
#pragma unroll 4
                for (int c = 0; c < 16; ++c) {
                    const int cgh = (b * 16 + c) * 4 + h;
                    uint2 o; o.x = pk2(C.x, C.y); o.y = pk2(C.z, C.w);
                    *(uint2*)(W_BH + ((size_t)cgh * 256 + e) * 512 + 256 + d) = o;
                    const float dec = W_DECAY[cgh];
                    const float4 dc = *(const float4*)(W_DC + ((size_t)cgh * 256 + e) * 256 + d);
                    C.x = fmaf(dec, C.x, dc.x); C.y = fmaf(dec, C.y, dc.y); C.z = fmaf(dec, C.z, dc.z); C.w = fmaf(dec, C.w, dc.w);
                }
            }
        }
#pragma nounroll
        PHASE_LOOP(128) { const int cgh = VB, cg = cgh >> 2, h = cgh & 3, b = cg >> 4, c = cg & 15;
            float n = 0.f;
            for (int cc = 0; cc < c; ++cc) { const int j = (b * 16 + cc) * 4 + h; n = fmaf(W_DECAY[j], n, W_DN[(size_t)j * 256 + tid]); }
            __syncthreads();
            sm[tid] = n;
            __syncthreads();
            const int lane = tid & 63, w = tid >> 6;
            const float4 nv = *(const float4*)(sm + lane * 4);
            for (int i = 0; i < 64; ++i) {
                const size_t t = (size_t)cg * 256 + w * 64 + i;
                const ushort4 q4 = *(const ushort4*)(W_MQ + t * 1024 + h * 256 + lane * 4);
                float s = bf2f(q4.x) * nv.x + bf2f(q4.y) * nv.y + bf2f(q4.z) * nv.z + bf2f(q4.w) * nv.w;
                s = wave_sum(s);
                if (lane == 0) W_QN[t * 4 + h] = s;
            }
        }
    }
    xcd_barrier(xb);
    {
        PH_BEGIN();
        GJOB_DEFAULT(g); g.A = W_PQ; g.a_pn_mask = 3; g.a_pn_step = 512; g.K = 512; g.nN = 4;
        g.Bt = W_BH; g.ldb = 512; g.b_pn_step = 256 * 512; g.b_pm_step = 4 * 256 * 512; g.C = (float*)W_MIXB;
        g.gs = W_GS; g.denp = W_DENP; g.qn = W_QN; g.gvec = PF(I_GMHEAD); g.mo = W_P6 + 2 * P6S;
        pg8::gemm_phase<8>(GEMM_LDSP, g, tidx);
    }
    xcd_barrier(xb);
    {
        PH_BEGIN();
        GJOB_DEFAULT(g); g.A = W_MIXB; g.Bt = (bf16_t*)(wsb + O_WOUT); g.C = W_XR; g.R = PF(I_X); g.C2 = W_HB; g.gvec = PF(I_GCROSS); g.rssp = W_RSSP;
        pg8::gemm_phase<10>(GEMM_LDSP, g, tidx);
    }
    xcd_barrier(xb);
    {
        PH_BEGIN();
        {
            GJOB_DEFAULT(g); g.A = W_HB; g.Bt = (bf16_t*)(wsb + O_WXQ); g.C = (float*)W_QX;
            pg8::Unit u0;
            if (pg8::unit_next(g, 0, u0) && tidx < 256) { const size_t r = (size_t)u0.pm * 256 + tidx; float s = 0.f; for (int k = 0; k < 32; ++k) s += W_RSSP[r * 32 + k];
                ((LAS float*)(LAS unsigned char*)(smem_raw + GEMM_LDS + 1024 + 8192))[tidx] = rsqrtf(s * (1.0f / D) + EPS); }
            __syncthreads();
            pg8::gemm_phase<11>(GEMM_LDSP, g, tidx); __syncthreads();
        }
        { GJOB_DEFAULT(g); g.A = W_MN2; g.Bt = (bf16_t*)(wsb + O_WXK); g.nM = 2; g.C = (float*)W_KM; pg8::gemm_phase<3>(GEMM_LDSP, g, tidx); __syncthreads(); }
        { GJOB_DEFAULT(g); g.A = (bf16_t*)(wsb + O_WXV); g.Bt = W_MN2; g.nM = 8; g.nN = 2; g.C = (float*)W_VMT; g.ldc = 512; pg8::gemm_phase<3>(GEMM_LDSP, g, tidx); }
    }
    xcd_barrier(xb);
    {
        PH_BEGIN();
        GJOB_DEFAULT(g); g.A = W_QX; g.K = 512; g.a_pn_mask = 3; g.a_pn_step = 512; g.Bt = W_KM; g.b_pn_step = 512; g.b_pm_shift = 4; g.b_pm_step = 256 * D; g.nN = 4;
        g.C = (float*)W_PX; g.ldc = 1024; g.escale = 0.04419417382415922f * 1.4426950408889634f;
        pg8::gemm_phase<5>(GEMM_LDSP, g, tidx);
    }
    xcd_barrier(xb);
    {
        PH_BEGIN();
        GJOB_DEFAULT(g); g.A = W_PX; g.lda = 1024; g.a_pm_step = 256 * 1024; g.K = 256; g.a_pn_shift = 1; g.a_pn_mask = 3; g.a_pn_step = 256; g.Bt = W_VMT; g.ldb = 512; g.b_pn_step = 256 * 512; g.b_pm_shift = 4; g.b_pm_step = 256;
        g.C = (float*)W_MIXB;
        pg8::gemm_phase<3>(GEMM_LDSP, g, tidx);
    }
    xcd_barrier(xb);
    {
        PH_BEGIN();
        GJOB_DEFAULT(g); g.A = W_MIXB; g.Bt = (bf16_t*)(wsb + O_WXO); g.C = W_XR; g.R = W_XR; g.C2 = W_HB; g.gvec = PF(I_GFFN); g.rssp = W_RSSP;
        pg8::gemm_phase<10>(GEMM_LDSP, g, tidx);
    }
    xcd_barrier(xb);
    {
        PH_BEGIN();
        GJOB_DEFAULT(g); g.A = W_HB; g.Bt = (bf16_t*)(wsb + O_WPQ); g.C = (float*)W_QX;
        pg8::Unit u0;
        if (pg8::unit_next(g, 0, u0) && tidx < 256) { const size_t r = (size_t)u0.pm * 256 + tidx; float s = 0.f; for (int k = 0; k < 32; ++k) s += W_RSSP[r * 32 + k];
            const float rs = rsqrtf(s * (1.0f / D) + EPS);
            ((LAS float*)(LAS unsigned char*)(smem_raw + GEMM_LDS + 1024 + 8192))[tidx] = rs; W_RSTD[r] = rs; }
        __syncthreads();
        pg8::gemm_phase<11>(GEMM_LDSP, g, tidx);
    }
    xcd_barrier(xb);
    {
        PH_BEGIN();
        LAS float* wl = (LAS float*)(LAS unsigned char*)smem_raw + (tidx >> 6) * 3072;
#pragma nounroll
        for (int item = blockIdx.x * 8 + (tidx >> 6); item < 4096; item += gridDim.x * 8) peer_topk_wave(item, tidx & 63, wl, W_QX, W_SKB, W_IDS, W_GATES);
    }
    xcd_barrier(xb);
    {
        PH_BEGIN();
        const float* gf = PF(I_GFINAL); float* outp = (float*)ldp_raw(I_OUT);
#pragma nounroll
        PHASE_LOOP(T) d_peer_out8(VB, tid, sm, W_HB, W_XR, W_IDS, W_GATES, W_UT, W_VT, W_RSC, W_RSTD, gf, outp);
    }
}
}

extern "C" void kernel_launch(void* const* d_in, const int* in_sizes, int n_in, void* d_out, int out_size, void* d_ws, size_t ws_size, hipStream_t stream) {
    static int grid_blocks = 0;
    if (!grid_blocks) {
        int dev = 0, cus = 0, per_cu = 0;
        hipGetDevice(&dev);
        hipDeviceGetAttribute(&cus, hipDeviceAttributeMultiprocessorCount, dev);
        hipFuncSetAttribute((const void*)mega, hipFuncAttributeMaxDynamicSharedMemorySize, SMEM_BYTES);
        hipOccupancyMaxActiveBlocksPerMultiprocessor(&per_cu, mega, NTHR, SMEM_BYTES);
        if (per_cu > 1) per_cu = 1;
        if (per_cu < 1) per_cu = 1;
        grid_blocks = cus * per_cu;
    }
    Params P{};
    const float** pp = (const float**)&P;
    for (int i = 0; i < 25; ++i) pp[i] = (const float*)d_in[i];
    P.out = (float*)d_out;
    P.bar = (unsigned*)d_ws;
    P.ws = (float*)((char*)d_ws + 16384);
    hipMemsetAsync(d_ws, 0, 16384, stream);
    void* args[] = {&P};
    hipError_t e = hipLaunchCooperativeKernel((const void*)mega, dim3(grid_blocks), dim3(NTHR), args, SMEM_BYTES, stream);
    if (e != hipSuccess) fprintf(stderr, "cooperative launch failed: %s (grid %d)\n", hipGetErrorString(e), grid_blocks);
}
```

```cpp
#include <hip/hip_runtime.h>
#include <stdint.h>
#include <math.h>
#include <cstdio>

#define LAS_ __attribute__((address_space(3)))
namespace {
constexpr int D = 2048, NB = 2, S = 4096, T = NB * S;
constexpr int INC = 6152;
constexpr int C_MIN = 0, C_MV = 1024, C_MO = 2048, C_MI = 3072, C_MF = 3076, C_AQ = 3080, C_AK = 4104, C_AV = 5128;
constexpr float EPS = 1e-6f;
constexpr size_t P6S = (size_t)8192 * 1024;
constexpr int NTHR = 512;
constexpr int HALF_SM_FLOATS = 8704;
constexpr int GEMM_LDS = 131072;
constexpr int SMEM_BYTES = GEMM_LDS + 1024 + 8192 + 1024;
typedef unsigned short bf16_t;
__device__ __forceinline__ unsigned f2bf(float f) { unsigned u = __float_as_uint(f); u += 0x7FFFu + ((u >> 16) & 1u); return u >> 16; }
__device__ __forceinline__ unsigned pk2(float lo, float hi) { return f2bf(lo) | (f2bf(hi) << 16); }
__device__ __forceinline__ float bf2f(unsigned short b) { return __uint_as_float(((unsigned)b) << 16); }
extern __shared__ __attribute__((aligned(16))) unsigned char smem_raw[];
enum { I_X = 0, I_MEM, I_GMIX, I_WIN, I_CONVW, I_CONVB, I_WMQ, I_WMK, I_BMI, I_BMF, I_GMHEAD, I_GAHEAD, I_WOUT, I_GCROSS, I_GMEM,
       I_WXQ, I_WXK, I_WXV, I_WXO, I_GFFN, I_WPQ, I_SUBK, I_UTAB, I_VTAB, I_GFINAL, I_OUT, I_BAR, I_WS, I_NPTR };
__device__ __forceinline__ unsigned long long ldp_raw(int i) {
    const LAS_ unsigned long long* tab = (const LAS_ unsigned long long*)(LAS_ unsigned char*)(smem_raw + GEMM_LDS + 64);
    const unsigned long long v = tab[i];
    const unsigned lo = __builtin_amdgcn_readfirstlane((unsigned)v), hi = __builtin_amdgcn_readfirstlane((unsigned)(v >> 32));
    return ((unsigned long long)hi << 32) | lo;
}
#define PF(i) ((const float*)ldp_raw(i))

#define XB_TMO      128
#define XB_XCNT(j)  (256  + 64 * (j))
#define XB_XSUB(j)  (1280 + 64 * (j))
#define XB_XGEN(j)  (2304 + 64 * (j))
#define XB_TOP      3328
#define XB_TOPGEN   3392
#define XCD_BAR_WORDS 3456
#define XB_SPIN_CAP (1u << 22)
#define LAS __attribute__((address_space(3)))

__device__ __forceinline__ unsigned xb_ld(unsigned* p)              { return __hip_atomic_load(p, __ATOMIC_RELAXED, __HIP_MEMORY_SCOPE_AGENT); }
__device__ __forceinline__ unsigned xb_add(unsigned* p, unsigned v) { return __hip_atomic_fetch_add(p, v, __ATOMIC_RELAXED, __HIP_MEMORY_SCOPE_AGENT); }
__device__ __forceinline__ unsigned xb_xcc_id() { return (unsigned)__builtin_amdgcn_s_getreg((3 << 11) | 20) & 0xFu; }
#define XB_SPIN(cond, bar) do { unsigned _sp = 0; while (cond) { __builtin_amdgcn_s_sleep(1); \
    if ((++_sp & 255u) == 0u) { if (xb_ld(&(bar)[XB_TMO])) break; if (_sp > XB_SPIN_CAP) { atomicAdd(&(bar)[XB_TMO], 1u); break; } } } } while (0)

struct XcdBarrier { unsigned* bar; unsigned x; volatile LAS unsigned* st; };

__device__ __forceinline__ XcdBarrier xcd_barrier_post(unsigned* bar, volatile LAS unsigned* st) {
    XcdBarrier b; b.bar = bar; b.x = xb_xcc_id(); b.st = st;
    if (threadIdx.x == 0) (void)xb_add(&bar[XB_XCNT(b.x)], 1u);
    return b;
}
__device__ __forceinline__ void xcd_barrier_complete(unsigned* bar, unsigned x, unsigned& nloc, unsigned& nx) {
    const unsigned G = gridDim.x * gridDim.y * gridDim.z;
    unsigned sum, cnt, mine, sp = 0u;
    for (;;) {
        sum = 0u; cnt = 0u; mine = 0u;
#pragma unroll
        for (unsigned j = 0; j < 16; ++j) { const unsigned c = xb_ld(&bar[XB_XCNT(j)]); sum += c; cnt += (c > 0u) ? 1u : 0u; mine = (j == x) ? c : mine; }
        if (sum == G) break;
        __builtin_amdgcn_s_sleep(1);
        if ((++sp & 255u) == 0u) { if (xb_ld(&bar[XB_TMO])) break; if (sp > XB_SPIN_CAP) { atomicAdd(&bar[XB_TMO], 1u); break; } }
    }
    nloc = mine > 0u ? mine : 1u; nx = cnt > 0u ? cnt : 1u;
}
__device__ __forceinline__ void xcd_barrier(const XcdBarrier& b) {
    asm volatile("s_waitcnt vmcnt(0)" ::: "memory");
    __syncthreads();
    if (threadIdx.x == 0) {
        unsigned* bar = b.bar;
        __builtin_amdgcn_s_waitcnt(0);
        unsigned nloc = b.st[0], nx = b.st[1];
        if (nloc == 0u) { xcd_barrier_complete(bar, b.x, nloc, nx); b.st[0] = nloc; b.st[1] = nx; }
        const unsigned old = xb_add(&bar[XB_XSUB(b.x)], 1u);
        const unsigned gen = old / nloc;
        if (old + 1u == (gen + 1u) * nloc) {
            __builtin_amdgcn_fence(__ATOMIC_RELEASE, "agent");
            asm volatile("s_waitcnt vmcnt(0)" ::: "memory");
            const unsigned og = xb_add(&bar[XB_TOP], 1u);
            const unsigned tg = og / nx;
            if (og + 1u == (tg + 1u) * nx) xb_add(&bar[XB_TOPGEN], 1u);
            else XB_SPIN(xb_ld(&bar[XB_TOPGEN]) == tg, bar);
            __builtin_amdgcn_fence(__ATOMIC_ACQUIRE, "agent");
            xb_add(&bar[XB_XGEN(b.x)], 1u);
            asm volatile("s_waitcnt vmcnt(0)" ::: "memory");
        } else {
            XB_SPIN(xb_ld(&bar[XB_XGEN(b.x)]) == gen, bar);
            __builtin_amdgcn_fence(__ATOMIC_ACQUIRE, "agent");
            asm volatile("s_waitcnt vmcnt(0)" ::: "memory");
        }
    }
    __syncthreads();
}

__device__ __forceinline__ float wave_sum(float v) {
#pragma unroll
    for (int o = 32; o >= 1; o >>= 1) v += __shfl_xor(v, o);
    return v;
}
__device__ __forceinline__ float wave_max(float v) {
#pragma unroll
    for (int o = 32; o >= 1; o >>= 1) v = fmaxf(v, __shfl_xor(v, o));
    return v;
}
__device__ __forceinline__ float log_sigmoid(float x) { return fminf(x, 0.f) - log1pf(expf(-fabsf(x))); }


__device__ __forceinline__ void d_rmsnorm(int vb, int t, float* sm, const float* __restrict__ in, const float* __restrict__ g, bf16_t* __restrict__ out,
                                          const float* gwl  , float* __restrict__ gpre) {
    float* red = sm;
    const int row = vb;
    const float4* p = (const float4*)(in + (size_t)row * D);
    float4 a = p[t], b = p[t + 256];
    float s = a.x * a.x + a.y * a.y + a.z * a.z + a.w * a.w + b.x * b.x + b.y * b.y + b.z * b.z + b.w * b.w;
    s = wave_sum(s);
    __syncthreads();
    if ((t & 63) == 0) red[t >> 6] = s;
    __syncthreads();
    const float tot = red[0] + red[1] + red[2] + red[3];
    const float r = rsqrtf(tot * (1.0f / D) + EPS);
    const float4* gp = (const float4*)g;
    float4 ga = gp[t], gb = gp[t + 256];
    float hv[8] = {a.x * r * ga.x, a.y * r * ga.y, a.z * r * ga.z, a.w * r * ga.w, b.x * r * gb.x, b.y * r * gb.y, b.z * r * gb.z, b.w * r * gb.w};
    uint2 o0, o1;
    o0.x = pk2(hv[0], hv[1]); o0.y = pk2(hv[2], hv[3]); o1.x = pk2(hv[4], hv[5]); o1.y = pk2(hv[6], hv[7]);
    *(uint2*)(out + (size_t)row * D + t * 4) = o0;
    *(uint2*)(out + (size_t)row * D + 1024 + t * 4) = o1;
    if (gpre) {
        float gs[8];
#pragma unroll
        for (int c = 0; c < 8; ++c) gs[c] = 0.f;
#pragma unroll
        for (int j = 0; j < 8; ++j) {
            const int k = (j < 4) ? (t * 4 + j) : (1024 + t * 4 + (j - 4));
            const float4 w0 = *(const float4*)(gwl + k * 8), w1 = *(const float4*)(gwl + k * 8 + 4);
            gs[0] = fmaf(hv[j], w0.x, gs[0]); gs[1] = fmaf(hv[j], w0.y, gs[1]); gs[2] = fmaf(hv[j], w0.z, gs[2]); gs[3] = fmaf(hv[j], w0.w, gs[3]);
            gs[4] = fmaf(hv[j], w1.x, gs[4]); gs[5] = fmaf(hv[j], w1.y, gs[5]); gs[6] = fmaf(hv[j], w1.z, gs[6]); gs[7] = fmaf(hv[j], w1.w, gs[7]);
        }
#pragma unroll
        for (int c = 0; c < 8; ++c) gs[c] = wave_sum(gs[c]);
        __syncthreads();
        if ((t & 63) == 0) {
#pragma unroll
            for (int c = 0; c < 8; ++c) red[8 + (t >> 6) * 8 + c] = gs[c];
        }
        __syncthreads();
        if (t < 8) gpre[(size_t)row * 8 + t] = red[8 + t] + red[16 + t] + red[24 + t] + red[32 + t];
    }
}

namespace pg8 {
typedef short bf16x8 __attribute__((ext_vector_type(8)));
typedef float f32x4 __attribute__((ext_vector_type(4)));
constexpr int BM = 256, BK = 64, HALF = 128, HTB = HALF * BK * 2, NXCD = 8, WGM = 8;
__device__ __forceinline__ int lds_byte(int r, int c) { const int st = (r >> 4) * 2 + (c >> 5), rr = r & 15, cc = c & 31, ob = rr * 64 + cc * 2; return st * 1024 + (ob ^ (((ob >> 9) & 1) << 5)); }
__device__ __forceinline__ void stage_rc(int b, int& R, int& C) { const int st = b / 1024, sb = b % 1024, swz = sb ^ (((sb >> 9) & 1) << 5); R = (st >> 1) * 16 + swz / 64; C = (st & 1) * 32 + (swz % 64) / 2; }
struct Unit { int pm, pn; };
struct GJob {
    const bf16_t* A; const bf16_t* Bt;
    int lda, ldb, K, nM, nN;
    int a_pn_shift, a_pn_mask, a_pn_step;
    int b_pm_shift, b_pm_step, b_pn_step;
    int a_pm_step;
    int b_pn_mask, b_pn_shift, b_pn_step2;
    int bid0, nblk;
    float escale;
    const float* gs; float* denp; const float* qn; const float* gvec; const bf16_t* mo;
    bf16_t* C2; float* rssp; const float* rstd;
    float* C; int ldc; const float* R; int ldr;
    int mode;
};
__device__ __forceinline__ bool unit_next(const GJob& g, int i, Unit& u) {
    const int nwg = g.nM * g.nN;
    const int bid = (int)blockIdx.x - g.bid0; if (bid < 0 || bid >= g.nblk) return false;
    const long L = (long)i * g.nblk + bid; if (L >= nwg) return false;
    int wgid = (int)L; { const int q = nwg / NXCD, r = nwg % NXCD, xcd = wgid % NXCD, off = wgid / NXCD; wgid = (xcd < r ? xcd * (q + 1) : r * (q + 1) + (xcd - r) * q) + off; }
    const int nig = WGM * g.nN, gid = wgid / nig, fm = gid * WGM, gsz = (g.nM - fm) < WGM ? (g.nM - fm) : WGM;
    u.pm = fm + ((wgid % nig) % gsz); u.pn = (wgid % nig) / gsz; return true;
}
template <int MODE> __device__ __forceinline__ void epilogue(const GJob& g, f32x4 (&acc)[2][2][4][2], const Unit& u, int wr, int wc, int fr, int fq, LAS unsigned char* xlds) {
    const int row0 = u.pm * BM + wr * 64 + fr;
    if constexpr (MODE == 0) {
        const int col0 = u.pn * BM + wc * 32 + 4 * fq;
#pragma unroll
        for (int ai = 0; ai < 2; ++ai)
#pragma unroll
            for (int m = 0; m < 4; ++m) {
                const int row = row0 + ai * HALF + m * 16;
                float* rowp = g.C + (size_t)row * g.ldc + col0;
                const float* rp = g.R ? g.R + (size_t)row * g.ldr + col0 : nullptr;
#pragma unroll
                for (int bj = 0; bj < 2; ++bj)
#pragma unroll
                    for (int n = 0; n < 2; ++n) {
                        f32x4 v = acc[ai][bj][m][n];
                        if (rp) v = v + *(const f32x4*)(rp + bj * HALF + n * 16);
                        *(f32x4*)(rowp + bj * HALF + n * 16) = v;
                    }
            }
    } else if constexpr (MODE == 10) {
        const int col0 = u.pn * BM + wc * 32 + 4 * fq;
#pragma unroll
        for (int ai = 0; ai < 2; ++ai)
#pragma unroll
            for (int m = 0; m < 4; ++m) {
                const int row = row0 + ai * HALF + m * 16;
                float* rowp = g.C + (size_t)row * g.ldc + col0;
                const float* rp = g.R + (size_t)row * g.ldr + col0;
                bf16_t* r2 = g.C2 + (size_t)row * D + col0;
                float ss = 0.f;
#pragma unroll
                for (int bj = 0; bj < 2; ++bj)
#pragma unroll
                    for (int n = 0; n < 2; ++n) {
                        const f32x4 v = acc[ai][bj][m][n] + *(const f32x4*)(rp + bj * HALF + n * 16);
                        *(f32x4*)(rowp + bj * HALF + n * 16) = v;
                        const f32x4 gv = *(const f32x4*)(g.gvec + col0 + bj * HALF + n * 16);
                        uint2 o; o.x = pk2(v[0] * gv[0], v[1] * gv[1]); o.y = pk2(v[2] * gv[2], v[3] * gv[3]);
                        *(uint2*)(r2 + bj * HALF + n * 16) = o;
                        ss += (v[0] * v[0] + v[1] * v[1]) + (v[2] * v[2] + v[3] * v[3]);
                    }
                ss += __shfl_xor(ss, 16); ss += __shfl_xor(ss, 32);
                if (fq == 0) g.rssp[(size_t)row * 32 + u.pn * 4 + wc] = ss;
            }
    } else if constexpr (MODE == 11) {
        bf16_t* Cb = (bf16_t*)g.C;
        const int col0 = u.pn * BM + wc * 32 + 4 * fq;
#pragma unroll
        for (int ai = 0; ai < 2; ++ai)
#pragma unroll
            for (int m = 0; m < 4; ++m) {
                const int row = row0 + ai * HALF + m * 16;
                const float rs = ((const LAS float*)(xlds + 8192))[row - u.pm * BM];
                bf16_t* rowp = Cb + (size_t)row * g.ldc + col0;
#pragma unroll
                for (int bj = 0; bj < 2; ++bj)
#pragma unroll
                    for (int n = 0; n < 2; ++n) {
                        const f32x4 v = acc[ai][bj][m][n] * rs;
                        uint2 o; o.x = pk2(v[0], v[1]); o.y = pk2(v[2], v[3]);
                        *(uint2*)(rowp + bj * HALF + n * 16) = o;
                    }
            }
    } else if constexpr (MODE == 6) {
        const int h = u.pn; const size_t t0 = (size_t)u.pm * BM;
        bf16_t* Cb = (bf16_t*)g.C;
#pragma unroll
        for (int ai = 0; ai < 2; ++ai)
#pragma unroll
            for (int m = 0; m < 4; ++m) {
                const int l = ai * HALF + wr * 64 + m * 16 + fr;
                const float M2 = g.gs[((t0 + l) * 4 + h) * 8 + 1];
                bf16_t* rowp = Cb + (t0 + l) * 2048 + h * 512 + wc * 32 + 4 * fq;
                float rs = 0.f;
#pragma unroll
                for (int bj = 0; bj < 2; ++bj)
#pragma unroll
                    for (int n = 0; n < 2; ++n) {
                        const f32x4 a = acc[ai][bj][m][n];
                        const int s0 = bj * HALF + wc * 32 + n * 16 + 4 * fq;
                        float p[4];
#pragma unroll
                        for (int r = 0; r < 4; ++r) { const float u2 = g.gs[((t0 + s0 + r) * 4 + h) * 8 + 0]; p[r] = (s0 + r <= l) ? a[r] * __builtin_amdgcn_exp2f(u2 - M2) : 0.f; rs += p[r]; }
                        uint2 o; o.x = pk2(p[0], p[1]); o.y = pk2(p[2], p[3]);
                        *(uint2*)(rowp + bj * HALF + n * 16) = o;
                    }
                rs += __shfl_xor(rs, 16); rs += __shfl_xor(rs, 32);
                if (fq == 0) g.denp[((t0 + l) * 4 + h) * 4 + wc] = rs;
            }
    } else if constexpr (MODE == 12) {
        float* Ct = g.C + (size_t)(u.pn >> 4) * ((size_t)512 * 4096) + (size_t)(u.pn & 15) * 256;
        const int col0 = wc * 32 + 4 * fq;
#pragma unroll
        for (int ai = 0; ai < 2; ++ai)
#pragma unroll
            for (int m = 0; m < 4; ++m) {
                float* rowp = Ct + (size_t)(row0 + ai * HALF + m * 16) * 4096 + col0;
#pragma unroll
                for (int bj = 0; bj < 2; ++bj)
#pragma unroll
                    for (int n = 0; n < 2; ++n) *(f32x4*)(rowp + bj * HALF + n * 16) = acc[ai][bj][m][n];
            }
    } else if constexpr (MODE == 7) {
        float* Ct = g.C + (size_t)(u.pm * 4 + u.pn) * 65536;
        const int col0 = wc * 32 + 4 * fq;
#pragma unroll
        for (int ai = 0; ai < 2; ++ai)
#pragma unroll
            for (int m = 0; m < 4; ++m) {
                float* rowp = Ct + (size_t)(ai * HALF + wr * 64 + m * 16 + fr) * 256 + col0;
#pragma unroll
                for (int bj = 0; bj < 2; ++bj)
#pragma unroll
                    for (int n = 0; n < 2; ++n) *(f32x4*)(rowp + bj * HALF + n * 16) = acc[ai][bj][m][n];
            }
    } else if constexpr (MODE == 8) {
        const int h = u.pn; const size_t t0 = (size_t)u.pm * BM;
        LAS float* X0 = (LAS float*)xlds + wr * 512;
#pragma unroll
        for (int ai = 0; ai < 2; ++ai)
#pragma unroll
            for (int m = 0; m < 4; ++m) {
                const size_t th = (t0 + ai * HALF + wr * 64 + m * 16 + fr) * 4 + h;
                const f32x4 dp = *(const f32x4*)(g.denp + th * 4);
                const float den = (dp[0] + dp[1]) + (dp[2] + dp[3]) + g.gs[th * 8 + 3] * g.qn[th];
                const float rden = 1.0f / fmaxf(fabsf(den), g.gs[th * 8 + 4]);
                float ss = 0.f;
#pragma unroll
                for (int bj = 0; bj < 2; ++bj)
#pragma unroll
                    for (int n = 0; n < 2; ++n) { f32x4 a = acc[ai][bj][m][n] * rden; acc[ai][bj][m][n] = a; ss += (a[0] * a[0] + a[1] * a[1]) + (a[2] * a[2] + a[3] * a[3]); }
                ss += __shfl_xor(ss, 16); ss += __shfl_xor(ss, 32);
                if (fq == 0) X0[(ai * 64 + m * 16 + fr) * 4 + wc] = ss;
            }
        asm volatile("s_waitcnt lgkmcnt(0)" ::: "memory"); __builtin_amdgcn_s_barrier(); asm volatile("" ::: "memory");
        bf16_t* Cb = (bf16_t*)g.C;
        const int col0 = wc * 32 + 4 * fq;
#pragma unroll
        for (int ai = 0; ai < 2; ++ai)
#pragma unroll
            for (int m = 0; m < 4; ++m) {
                const f32x4 p4 = *(const LAS f32x4*)(X0 + (ai * 64 + m * 16 + fr) * 4);
                const float rsn = rsqrtf(((p4[0] + p4[1]) + (p4[2] + p4[3])) * (1.0f / 256.0f) + EPS);
                const size_t t = t0 + ai * HALF + wr * 64 + m * 16 + fr;
                bf16_t* rowp = Cb + t * 2048 + h * 256 + col0;
                const bf16_t* mop = g.mo + t * 1024 + h * 256 + col0;
#pragma unroll
                for (int bj = 0; bj < 2; ++bj)
#pragma unroll
                    for (int n = 0; n < 2; ++n) {
                        const f32x4 a = acc[ai][bj][m][n];
                        const ushort4 mo4 = *(const ushort4*)(mop + bj * HALF + n * 16);
                        const f32x4 gv = *(const f32x4*)(g.gvec + h * 256 + col0 + bj * HALF + n * 16);
                        const float o0 = a[0] * rsn * gv[0] / (1.0f + __expf(-bf2f(mo4.x)));
                        const float o1 = a[1] * rsn * gv[1] / (1.0f + __expf(-bf2f(mo4.y)));
                        const float o2 = a[2] * rsn * gv[2] / (1.0f + __expf(-bf2f(mo4.z)));
                        const float o3 = a[3] * rsn * gv[3] / (1.0f + __expf(-bf2f(mo4.w)));
                        uint2 o; o.x = pk2(o0, o1); o.y = pk2(o2, o3);
                        *(uint2*)(rowp + bj * HALF + n * 16) = o;
                    }
            }
    } else if constexpr (MODE == 5) {
        LAS float* X0 = (LAS float*)xlds + wr * 512;
        LAS float* X1 = (LAS float*)xlds + 1024 + wr * 512;
#pragma unroll
        for (int ai = 0; ai < 2; ++ai)
#pragma unroll
            for (int m = 0; m < 4; ++m) {
                float v = -INFINITY;
#pragma unroll
                for (int bj = 0; bj < 2; ++bj)
#pragma unroll
                    for (int n = 0; n < 2; ++n) { const f32x4 a = acc[ai][bj][m][n]; v = fmaxf(v, fmaxf(fmaxf(a[0], a[1]), fmaxf(a[2], a[3]))); }
                v = fmaxf(v, __shfl_xor(v, 16)); v = fmaxf(v, __shfl_xor(v, 32));
                if (fq == 0) X0[(ai * 64 + m * 16 + fr) * 4 + wc] = v;
            }
        asm volatile("s_waitcnt lgkmcnt(0)" ::: "memory"); __builtin_amdgcn_s_barrier(); asm volatile("" ::: "memory");
#pragma unroll
        for (int ai = 0; ai < 2; ++ai)
#pragma unroll
            for (int m = 0; m < 4; ++m) {
                const f32x4 p4 = *(const LAS f32x4*)(X0 + (ai * 64 + m * 16 + fr) * 4);
                const float mxr = fmaxf(fmaxf(p4[0], p4[1]), fmaxf(p4[2], p4[3])) * g.escale;
                float s = 0.f;
#pragma unroll
                for (int bj = 0; bj < 2; ++bj)
#pragma unroll
                    for (int n = 0; n < 2; ++n) { f32x4 a = acc[ai][bj][m][n];
                        a[0] = __builtin_amdgcn_exp2f(a[0] * g.escale - mxr); a[1] = __builtin_amdgcn_exp2f(a[1] * g.escale - mxr); a[2] = __builtin_amdgcn_exp2f(a[2] * g.escale - mxr); a[3] = __builtin_amdgcn_exp2f(a[3] * g.escale - mxr);
                        acc[ai][bj][m][n] = a; s += (a[0] + a[1]) + (a[2] + a[3]); }
                s += __shfl_xor(s, 16); s += __shfl_xor(s, 32);
                if (fq == 0) X1[(ai * 64 + m * 16 + fr) * 4 + wc] = s;
            }
        asm volatile("s_waitcnt lgkmcnt(0)" ::: "memory"); __builtin_amdgcn_s_barrier(); asm volatile("" ::: "memory");
        bf16_t* Cb = (bf16_t*)g.C;
        const int col0 = u.pn * BM + wc * 32 + 4 * fq;
#pragma unroll
        for (int ai = 0; ai < 2; ++ai)
#pragma unroll
            for (int m = 0; m < 4; ++m) {
                const f32x4 p4 = *(const LAS f32x4*)(X1 + (ai * 64 + m * 16 + fr) * 4);
                const float inv = 1.0f / ((p4[0] + p4[1]) + (p4[2] + p4[3]));
                bf16_t* rowp = Cb + (size_t)(row0 + ai * HALF + m * 16) * g.ldc + col0;
#pragma unroll
                for (int bj = 0; bj < 2; ++bj)
#pragma unroll
                    for (int n = 0; n < 2; ++n) {
                        const f32x4 a = acc[ai][bj][m][n];
                        uint2 o; o.x = pk2(a[0] * inv, a[1] * inv); o.y = pk2(a[2] * inv, a[3] * inv);
                        *(uint2*)(rowp + bj * HALF + n * 16) = o;
                    }
            }
    } else {
        bf16_t* Cb = (bf16_t*)g.C; int ccol = u.pn * BM;
        if constexpr (MODE == 4) { Cb += (size_t)(u.pn >> 2) * P6S; ccol = (u.pn & 3) * 256; }
        const int col0 = ccol + wc * 32 + 4 * fq;
#pragma unroll
        for (int ai = 0; ai < 2; ++ai)
#pragma unroll
            for (int m = 0; m < 4; ++m) {
                bf16_t* rowp = Cb + (size_t)(row0 + ai * HALF + m * 16) * g.ldc + col0;
#pragma unroll
                for (int bj = 0; bj < 2; ++bj)
#pragma unroll
                    for (int n = 0; n < 2; ++n) {
                        const f32x4 v = acc[ai][bj][m][n];
                        uint2 o; o.x = pk2(v[0], v[1]); o.y = pk2(v[2], v[3]);
                        *(uint2*)(rowp + bj * HALF + n * 16) = o;
                    }
            }
    }
}
template <int MODE> __device__ __forceinline__ void gemm_phase(LAS unsigned char* lds, const GJob& g, int tid) {
    const int wid = __builtin_amdgcn_readfirstlane(tid >> 6), lane = tid & 63, wr = wid >> 2, wc = wid & 3, fr = lane & 15, fq = lane >> 4;
    const int K = g.K, nt = K / BK;
    unsigned voffA[2], voffB[2];
#pragma unroll
    for (int i = 0; i < 2; ++i) { int R, C; stage_rc(tid * 16 + i * 8192, R, C);
        voffA[i] = (unsigned)(R * g.lda + C) * 2u; voffB[i] = (unsigned)(R * g.ldb + C) * 2u; }
    const size_t kstep = (size_t)(BK * 2);
    const size_t hstepA = (size_t)HALF * g.lda * 2, hstepB = (size_t)HALF * g.ldb * 2;
    const unsigned ldsw = (unsigned)wid * 1024u;
    const int aoff = lds_byte(wr * 64 + fr, fq * 8), boff = lds_byte(wc * 32 + fr, fq * 8);
#define PG8_SA(b, h) (((b) * 2 + (h)) * HTB)
#define PG8_SB(b, h) ((4 + (b) * 2 + (h)) * HTB)
#define PG8_STAGE(bufoff, gbase, voff) do { _Pragma("unroll") for (int _i = 0; _i < 2; ++_i) \
        __builtin_amdgcn_global_load_lds((const unsigned*)((const char*)(gbase) + (voff)[_i]), (LAS unsigned*)(lds + (bufoff) + ldsw + _i * 8192), 16, 0, 0); } while (0)
#define PG8_LDA(dst, b, h) do { _Pragma("unroll") for (int m = 0; m < 4; ++m) _Pragma("unroll") for (int k = 0; k < 2; ++k) dst[m][k] = *(const LAS bf16x8*)(lds + PG8_SA(b, h) + aoff + m * 2048 + k * 1024); } while (0)
#define PG8_LDB(dst, b, h) do { _Pragma("unroll") for (int n = 0; n < 2; ++n) _Pragma("unroll") for (int k = 0; k < 2; ++k) dst[n][k] = *(const LAS bf16x8*)(lds + PG8_SB(b, h) + boff + n * 2048 + k * 1024); } while (0)
#define PG8_MMA(ai, bj, At, Bt) do { __builtin_amdgcn_s_setprio(1); _Pragma("unroll") for (int m = 0; m < 4; ++m) _Pragma("unroll") for (int n = 0; n < 2; ++n) _Pragma("unroll") for (int k = 0; k < 2; ++k) \
        acc[ai][bj][m][n] = __builtin_amdgcn_mfma_f32_16x16x32_bf16(Bt[n][k], At[m][k], acc[ai][bj][m][n], 0, 0, 0); __builtin_amdgcn_s_setprio(0); } while (0)
#define PG8_WAIT_V(n) asm volatile("s_waitcnt vmcnt(" #n ")" ::: "memory")
#define PG8_WAIT_L(n) asm volatile("s_waitcnt lgkmcnt(" #n ")" ::: "memory")
#define PG8_BAR __builtin_amdgcn_s_barrier()
#define PG8_SCHED __builtin_amdgcn_sched_barrier(0)
#define PG8_ABASE(u) ((const char*)g.A + ((size_t)(u).pm * g.a_pm_step + (size_t)(((u).pn >> g.a_pn_shift) & g.a_pn_mask) * g.a_pn_step) * 2)
#define PG8_BBASE(u) ((const char*)g.Bt + ((size_t)((u).pn & g.b_pn_mask) * g.b_pn_step + (size_t)((u).pn >> g.b_pn_shift) * g.b_pn_step2 + (size_t)((u).pm >> g.b_pm_shift) * g.b_pm_step) * 2)
    Unit cur, nxt; int ui = 0;
    if (!unit_next(g, 0, cur)) return;
    f32x4 acc[2][2][4][2];
#pragma unroll
    for (int a = 0; a < 2; ++a)
#pragma unroll
        for (int b = 0; b < 2; ++b)
#pragma unroll
            for (int m = 0; m < 4; ++m)
#pragma unroll
                for (int n = 0; n < 2; ++n) acc[a][b][m][n] = (f32x4){0.f, 0.f, 0.f, 0.f};
    bf16x8 At[4][2], B0[2][2], B1[2][2];
    const char* cA = PG8_ABASE(cur); const char* cB = PG8_BBASE(cur);
    PG8_STAGE(PG8_SB(0, 0), cB, voffB); PG8_STAGE(PG8_SA(0, 0), cA, voffA); PG8_STAGE(PG8_SB(0, 1), cB + hstepB, voffB); PG8_STAGE(PG8_SA(0, 1), cA + hstepA, voffA);
    if (wr == 1) PG8_BAR;
    PG8_WAIT_V(4); PG8_BAR;
    PG8_STAGE(PG8_SB(1, 0), cB + kstep, voffB); PG8_STAGE(PG8_SA(1, 0), cA + kstep, voffA); PG8_STAGE(PG8_SB(1, 1), cB + hstepB + kstep, voffB);
    PG8_WAIT_V(6); PG8_BAR;
    for (;;) {
        const bool has_next = unit_next(g, ui + 1, nxt);
        const char* nA = has_next ? PG8_ABASE(nxt) : cA; const char* nB = has_next ? PG8_BBASE(nxt) : cB;
        for (int t = 0; t < nt; t += 2) {
            const bool last = (t == nt - 2);
            const char* a1 = cA + (size_t)(t + 1) * kstep;
            const char* a2 = last ? nA : cA + (size_t)(t + 2) * kstep; const char* b2 = last ? nB : cB + (size_t)(t + 2) * kstep;
            const char* a3 = a2 + kstep; const char* b3 = b2 + kstep;
            PG8_LDB(B0, 0, 0); PG8_SCHED; PG8_LDA(At, 0, 0); PG8_STAGE(PG8_SA(1, 1), a1 + hstepA, voffA);
            PG8_WAIT_L(8); PG8_BAR; PG8_WAIT_L(0); PG8_MMA(0, 0, At, B0); PG8_BAR; PG8_SCHED;
            PG8_LDB(B1, 0, 1); PG8_STAGE(PG8_SB(0, 0), b2, voffB);
            PG8_BAR; PG8_WAIT_L(0); PG8_MMA(0, 1, At, B1); PG8_BAR;
            PG8_LDA(At, 0, 1); PG8_STAGE(PG8_SA(0, 0), a2, voffA);
            PG8_BAR; PG8_WAIT_L(0); PG8_MMA(1, 0, At, B0); PG8_BAR; PG8_SCHED;
            PG8_STAGE(PG8_SB(0, 1), b2 + hstepB, voffB);
            PG8_WAIT_V(6); PG8_BAR; PG8_MMA(1, 1, At, B1); PG8_BAR;
            PG8_LDB(B0, 1, 0); PG8_SCHED; PG8_LDA(At, 1, 0); PG8_STAGE(PG8_SA(0, 1), a2 + hstepA, voffA);
            PG8_WAIT_L(8); PG8_BAR; PG8_WAIT_L(0); PG8_MMA(0, 0, At, B0); PG8_BAR; PG8_SCHED;
            PG8_LDB(B1, 1, 1); PG8_STAGE(PG8_SB(1, 0), b3, voffB);
            PG8_BAR; PG8_WAIT_L(0); PG8_MMA(0, 1, At, B1); PG8_BAR;
            PG8_LDA(At, 1, 1); PG8_STAGE(PG8_SA(1, 0), a3, voffA);
            PG8_BAR; PG8_WAIT_L(0); PG8_MMA(1, 0, At, B0); PG8_BAR; PG8_SCHED;
            PG8_STAGE(PG8_SB(1, 1), b3 + hstepB, voffB);
            PG8_WAIT_V(6); PG8_BAR; PG8_MMA(1, 1, At, B1); PG8_BAR;
        }
        epilogue<MODE>(g, acc, cur, wr, wc, fr, fq, lds + GEMM_LDS + 1024);
        if (!has_next) break;
#pragma unroll
        for (int a = 0; a < 2; ++a)
#pragma unroll
            for (int b = 0; b < 2; ++b)
#pragma unroll
                for (int m = 0; m < 4; ++m)
#pragma unroll
                    for (int n = 0; n < 2; ++n) acc[a][b][m][n] = (f32x4){0.f, 0.f, 0.f, 0.f};
        cur = nxt; cA = nA; cB = nB; ++ui;
    }
    PG8_WAIT_V(0);
    if (wr == 0) PG8_BAR;
    PG8_BAR;
#undef PG8_SA
#undef PG8_SB
#undef PG8_STAGE
#undef PG8_LDA
#undef PG8_LDB
#undef PG8_MMA
#undef PG8_WAIT_V
#undef PG8_WAIT_L
#undef PG8_BAR
#undef PG8_SCHED
#undef PG8_ABASE
#undef PG8_BBASE
}
}

__device__ __forceinline__ void p0_transpose_item(const float* W, int ldw, int K, int csrc0, bf16_t* WT, int row0, LAS float* scr, int kb, int lane, float wscale) {
    const int k0 = 64 * kb;
#pragma unroll
    for (int i = 0; i < 8; ++i) { const int kk = 8 * i + (lane >> 3), n4 = (lane & 7) * 4;
        const float4 v = *(const float4*)(W + (size_t)(k0 + kk) * ldw + csrc0 + n4);
        scr[kk * 33 + n4] = v.x * wscale; scr[kk * 33 + n4 + 1] = v.y * wscale; scr[kk * 33 + n4 + 2] = v.z * wscale; scr[kk * 33 + n4 + 3] = v.w * wscale; }
    asm volatile("s_waitcnt lgkmcnt(0)" ::: "memory");
    const int c = lane & 7;
#pragma unroll
    for (int j = 0; j < 4; ++j) { const int n = (lane >> 3) + 8 * j; const LAS float* s = scr + (8 * c) * 33 + n;
        uint4 o; o.x = pk2(s[0 * 33], s[1 * 33]); o.y = pk2(s[2 * 33], s[3 * 33]); o.z = pk2(s[4 * 33], s[5 * 33]); o.w = pk2(s[6 * 33], s[7 * 33]);
        *(uint4*)(WT + (size_t)(row0 + n) * K + k0 + 8 * c) = o; }
    asm volatile("s_waitcnt lgkmcnt(0)" ::: "memory");
}

__device__ __forceinline__ void d_conv_silu(int vb, int tid, const bf16_t* __restrict__ p6, const float* __restrict__ cw, const float* __restrict__ cb, bf16_t* __restrict__ c) {
    const int t = vb, s = t % S;
    for (int ch = tid; ch < 1024; ch += 256) {
        float y = cb[ch];
#pragma unroll
        for (int j = 0; j < 4; ++j) {
            const int ss = s - 3 + j;
            if (ss >= 0) y = fmaf(cw[j * 1024 + ch], bf2f(p6[(size_t)(t - 3 + j) * 1024 + ch]), y);
        }
        c[(size_t)t * 1024 + ch] = (bf16_t)f2bf(y / (1.0f + expf(-y)));
    }
}

__device__ __forceinline__ void d_mlstm(int vb, int tid, const bf16_t* __restrict__ mq, const bf16_t* __restrict__ mk, const bf16_t* __restrict__ p6,
                                        const float* __restrict__ gpre, const float* __restrict__ b_mi, const float* __restrict__ b_mf, float* __restrict__ hraw) {
    const int lane = tid & 63, w = tid >> 6;
    const int gid = vb * 4 + w;
    const int e = gid & 255, h = (gid >> 8) & 3, b = gid >> 10;
    const float bi = b_mi[h], bf = b_mf[h];
    float C0 = 0.f, C1 = 0.f, C2 = 0.f, C3 = 0.f, n0 = 0.f, n1 = 0.f, n2 = 0.f, n3 = 0.f, m = 0.f;
    const size_t tb = (size_t)b * S;
    const bf16_t* qp = mq + tb * 1024 + h * 256 + lane * 4;
    const bf16_t* kp = mk + tb * 1024 + h * 256 + lane * 4;
    const bf16_t* pp = p6 + P6S + tb * 1024 + h * 256 + e;
    ushort4 qn = *(const ushort4*)qp, kn = *(const ushort4*)kp;
    const float* gp = gpre + tb * 8;
    float vn = bf2f(pp[0]), in_ = gp[h], fn = gp[4 + h];
    for (int s = 0; s < S; ++s) {
        const float4 q = make_float4(bf2f(qn.x), bf2f(qn.y), bf2f(qn.z), bf2f(qn.w)), k = make_float4(bf2f(kn.x), bf2f(kn.y), bf2f(kn.z), bf2f(kn.w)); const float v = vn, ipre = in_ + bi, fpre = fn + bf;
        if (s + 1 < S) {
            qn = *(const ushort4*)(qp + (size_t)(s + 1) * 1024);
            kn = *(const ushort4*)(kp + (size_t)(s + 1) * 1024);
            vn = bf2f(pp[(size_t)(s + 1) * 1024]); in_ = gp[(size_t)(s + 1) * 8 + h]; fn = gp[(size_t)(s + 1) * 8 + 4 + h];
        }
        const float logf = log_sigmoid(fpre);
        const float mnew = fmaxf(logf + m, ipre);
        const float fd = expf(logf + m - mnew), ig = expf(ipre - mnew);
        m = mnew;
        const float sc = ig * 0.0625f;
        C0 = fd * C0 + sc * k.x * v; C1 = fd * C1 + sc * k.y * v; C2 = fd * C2 + sc * k.z * v; C3 = fd * C3 + sc * k.w * v;
        n0 = fd * n0 + sc * k.x; n1 = fd * n1 + sc * k.y; n2 = fd * n2 + sc * k.z; n3 = fd * n3 + sc * k.w;
        float num = q.x * C0 + q.y * C1 + q.z * C2 + q.w * C3;
        float den = q.x * n0 + q.y * n1 + q.z * n2 + q.w * n3;
        num = wave_sum(num); den = wave_sum(den);
        if (lane == 0) hraw[(tb + s) * 1024 + h * 256 + e] = num / fmaxf(fabsf(den), expf(-mnew));
    }
}

__device__ __forceinline__ void d_mhead_norm(int vb, int tid, const float* __restrict__ hraw, const bf16_t* __restrict__ p6, const float* __restrict__ g, bf16_t* __restrict__ mix) {
    const int t = vb, h = tid >> 6, lane = tid & 63;
    const float4 v = *(const float4*)(hraw + (size_t)t * 1024 + h * 256 + lane * 4);
    float s = v.x * v.x + v.y * v.y + v.z * v.z + v.w * v.w;
    s = wave_sum(s);
    const float r = rsqrtf(s * (1.0f / 256.0f) + EPS);
    const float4 gg = *(const float4*)(g + h * 256 + lane * 4);
    const ushort4 mo = *(const ushort4*)(p6 + 2 * P6S + (size_t)t * 1024 + h * 256 + lane * 4);
    float4 o;
    o.x = v.x * r * gg.x / (1.0f + expf(-bf2f(mo.x)));
    o.y = v.y * r * gg.y / (1.0f + expf(-bf2f(mo.y)));
    o.z = v.z * r * gg.z / (1.0f + expf(-bf2f(mo.z)));
    o.w = v.w * r * gg.w / (1.0f + expf(-bf2f(mo.w)));
    uint2 ob; ob.x = pk2(o.x, o.y); ob.y = pk2(o.z, o.w);
    *(uint2*)(mix + (size_t)t * D + h * 256 + lane * 4) = ob;
}

__device__ __forceinline__ void d_rope(int vb, int tid, bf16_t* __restrict__ p6) {
    const int t = vb, s = t % S;
    for (int idx = tid; idx < 2 * 8 * 64; idx += 256) {
        const int i = idx & 63, hd = (idx >> 6) & 7, qk = idx >> 9;
        const float inv = exp2f(-(float)i * 0.20762050593046014f);
        const float ang = (float)s * inv;
        float sn, cs; sincosf(ang, &sn, &cs);
        bf16_t* p = p6 + (size_t)(3 + qk) * P6S + (size_t)t * 1024 + hd * 128;
        const float x1 = bf2f(p[i]), x2 = bf2f(p[64 + i]);
        p[i] = (bf16_t)f2bf(x1 * cs - x2 * sn);
        p[64 + i] = (bf16_t)f2bf(x2 * cs + x1 * sn);
    }
}

__device__ __forceinline__ void d_dilated(int vb, int tid, float* sm, const bf16_t* __restrict__ p6, const float* __restrict__ g_ahead, bf16_t* __restrict__ mix) {
    float (*qs)[128] = (float (*)[128])sm;
    float (*ps)[576] = (float (*)[576])(sm + 512);
    const int lane = tid & 63, w = tid >> 6;
    const int gid = vb * 4 + w;
    const int s = gid % S, hd = (gid / S) & 7, b = gid / (S * 8);
    const size_t t = (size_t)b * S + s;
    const bf16_t* qrow = p6 + 3 * P6S + t * 1024 + hd * 128;
    __syncthreads();
    qs[w][lane] = bf2f(qrow[lane]); qs[w][lane + 64] = bf2f(qrow[lane + 64]);
    __syncthreads();
    const float scale = 0.08838834764831845f;
    float mloc = -INFINITY;
    for (int br = 0; br < 3; ++br) {
        const int dil = br == 0 ? 1 : (br == 1 ? 4 : 16);
        for (int jj = 0; jj < 192; jj += 64) {
            const int j = jj + lane;
            float sc = -INFINITY;
            if (j <= 128 && s - j * dil >= 0) {
                const bf16_t* krow = p6 + 4 * P6S + (t - (size_t)j * dil) * 1024 + hd * 128;
                float d = 0.f;
#pragma unroll 8
                for (int c = 0; c < 128; c += 4) {
                    const ushort4 kv = *(const ushort4*)(krow + c);
                    d = fmaf(qs[w][c], bf2f(kv.x), d); d = fmaf(qs[w][c + 1], bf2f(kv.y), d); d = fmaf(qs[w][c + 2], bf2f(kv.z), d); d = fmaf(qs[w][c + 3], bf2f(kv.w), d);
                }
                sc = d * scale;
            }
            ps[w][br * 192 + j] = sc;
            mloc = fmaxf(mloc, sc);
        }
    }
    const float mx = wave_max(mloc);
    __syncthreads();
    float lsum = 0.f;
    for (int i = lane; i < 3 * 192; i += 64) {
        const float sc = ps[w][i];
        const float pv = (sc == -INFINITY) ? 0.f : expf(sc - mx);
        ps[w][i] = pv; lsum += pv;
    }
    const float tot = wave_sum(lsum);
    __syncthreads();
    float o0 = 0.f, o1 = 0.f;
    for (int br = 0; br < 3; ++br) {
        const int dil = br == 0 ? 1 : (br == 1 ? 4 : 16);
        for (int j = 0; j <= 128; ++j) {
            if (s - j * dil < 0) break;
            const float pv = ps[w][br * 192 + j];
            const bf16_t* vrow = p6 + 5 * P6S + (t - (size_t)j * dil) * 1024 + hd * 128;
            o0 = fmaf(pv, bf2f(vrow[lane]), o0); o1 = fmaf(pv, bf2f(vrow[lane + 64]), o1);
        }
    }
    o0 /= tot; o1 /= tot;
    float ss = wave_sum(o0 * o0 + o1 * o1);
    const float r = rsqrtf(ss * (1.0f / 128.0f) + EPS);
    bf16_t* orow = mix + t * D + 1024 + hd * 128;
    orow[lane] = (bf16_t)f2bf(o0 * r * g_ahead[hd * 128 + lane]);
    orow[lane + 64] = (bf16_t)f2bf(o1 * r * g_ahead[hd * 128 + lane + 64]);
}

__device__ __forceinline__ void d_cross(int vb, int tid, float* sm, const bf16_t* __restrict__ q, const float* __restrict__ km, const float* __restrict__ vm, bf16_t* __restrict__ o) {
    float (*qs)[512] = (float (*)[512])sm;
    float (*ps)[256] = (float (*)[256])(sm + 2048);
    const int lane = tid & 63, w = tid >> 6;
    const int t = vb, hd = w, b = t / S;
    const bf16_t* qrow = q + (size_t)t * D + hd * 512;
    __syncthreads();
    for (int i = lane; i < 512; i += 64) qs[w][i] = bf2f(qrow[i]);
    __syncthreads();
    const float scale = 0.04419417382415922f;
    float sc[4]; float mloc = -INFINITY;
#pragma unroll
    for (int r = 0; r < 4; ++r) {
        const int mi = lane + 64 * r;
        const float* krow = km + ((size_t)b * 256 + mi) * D + hd * 512;
        float d = 0.f;
#pragma unroll 8
        for (int c = 0; c < 512; c += 4) {
            const float4 kv = *(const float4*)(krow + c);
            d = fmaf(qs[w][c], kv.x, d); d = fmaf(qs[w][c + 1], kv.y, d); d = fmaf(qs[w][c + 2], kv.z, d); d = fmaf(qs[w][c + 3], kv.w, d);
        }
        sc[r] = d * scale; mloc = fmaxf(mloc, sc[r]);
    }
    const float mx = wave_max(mloc);
    float lsum = 0.f;
#pragma unroll
    for (int r = 0; r < 4; ++r) { const float pv = expf(sc[r] - mx); ps[w][lane + 64 * r] = pv; lsum += pv; }
    const float tot = wave_sum(lsum);
    __syncthreads();
    float acc[8];
#pragma unroll
    for (int i = 0; i < 8; ++i) acc[i] = 0.f;
    for (int mi = 0; mi < 256; ++mi) {
        const float pv = ps[w][mi];
        const float* vrow = vm + ((size_t)b * 256 + mi) * D + hd * 512;
#pragma unroll
        for (int i = 0; i < 8; ++i) acc[i] = fmaf(pv, vrow[lane + 64 * i], acc[i]);
    }
    bf16_t* orow = o + (size_t)t * D + hd * 512;
#pragma unroll
    for (int i = 0; i < 8; ++i) orow[lane + 64 * i] = (bf16_t)f2bf(acc[i] / tot);
}

__device__ __forceinline__ void wave_argmax(float& best, int& bidx) {
#pragma unroll
    for (int o = 32; o >= 1; o >>= 1) {
        const float ob = __shfl_xor(best, o); const int oi = __shfl_xor(bidx, o);
        if (ob > best || (ob == best && oi < bidx)) { best = ob; bidx = oi; }
    }
}
__device__ __forceinline__ void d_peer_topk(int vb, int tid, float* sm, const bf16_t* __restrict__ qp, const float* __restrict__ sub_keys, int* __restrict__ ids, float* __restrict__ gates) {
    float (*qs)[256] = (float (*)[256])sm;
    const int lane = tid & 63, w = tid >> 6;
    const int gid = vb * 4 + w;
    const int hd = gid & 7, t = gid >> 3;
    const bf16_t* qrow = qp + (size_t)t * D + hd * 256;
    __syncthreads();
    for (int i = lane; i < 256; i += 64) qs[w][i] = bf2f(qrow[i]);
    __syncthreads();
    float tops[2]; int topi[2];
#pragma unroll
    for (int p = 0; p < 2; ++p) {
        float v0, v1;
        {
            const float* k0 = sub_keys + ((size_t)(hd * 2 + p) * 128 + lane) * 128;
            const float* k1 = k0 + 64 * 128;
            float d0 = 0.f, d1 = 0.f;
#pragma unroll 8
            for (int c = 0; c < 128; c += 4) {
                const float4 a = *(const float4*)(k0 + c), bb = *(const float4*)(k1 + c);
                const float q0 = qs[w][p * 128 + c], q1 = qs[w][p * 128 + c + 1], q2 = qs[w][p * 128 + c + 2], q3 = qs[w][p * 128 + c + 3];
                d0 = fmaf(q0, a.x, d0); d0 = fmaf(q1, a.y, d0); d0 = fmaf(q2, a.z, d0); d0 = fmaf(q3, a.w, d0);
                d1 = fmaf(q0, bb.x, d1); d1 = fmaf(q1, bb.y, d1); d1 = fmaf(q2, bb.z, d1); d1 = fmaf(q3, bb.w, d1);
            }
            v0 = d0; v1 = d1;
        }
        float ts = 0.f; int ti = 0;
        for (int it = 0; it < 16; ++it) {
            float best; int bidx;
            if (v0 >= v1) { best = v0; bidx = lane; } else { best = v1; bidx = lane + 64; }
            wave_argmax(best, bidx);
            if (lane == it) { ts = best; ti = bidx; }
            if (bidx == lane) v0 = -INFINITY;
            if (bidx == lane + 64) v1 = -INFINITY;
        }
        tops[p] = ts; topi[p] = ti;
    }
    float cv[4]; int ci[4];
#pragma unroll
    for (int r = 0; r < 4; ++r) {
        const int c = lane * 4 + r, i = c >> 4, j = c & 15;
        const float s0 = __shfl(tops[0], i), s1 = __shfl(tops[1], j);
        const int i0 = __shfl(topi[0], i), i1 = __shfl(topi[1], j);
        cv[r] = s0 + s1; ci[r] = i0 * 128 + i1;
    }
    float bs = 0.f; int bid = 0;
    for (int it = 0; it < 16; ++it) {
        float best = cv[0]; int bidx = lane * 4;
#pragma unroll
        for (int r = 1; r < 4; ++r) if (cv[r] > best) { best = cv[r]; bidx = lane * 4 + r; }
        wave_argmax(best, bidx);
        const int owner = bidx >> 2, rr = bidx & 3;
        int myid = ci[0];
        if (rr == 1) myid = ci[1]; else if (rr == 2) myid = ci[2]; else if (rr == 3) myid = ci[3];
        const int eid = __shfl(myid, owner);
        if (lane == it) { bs = best; bid = eid; }
        if (owner == lane) {
#pragma unroll
            for (int r = 0; r < 4; ++r) if (rr == r) cv[r] = -INFINITY;
        }
    }
    float v = lane < 16 ? bs : -INFINITY;
    const float mx = wave_max(v);
    const float ev = lane < 16 ? expf(bs - mx) : 0.f;
    const float tot = wave_sum(ev);
    if (lane < 16) {
        ids[(size_t)t * 128 + hd * 16 + lane] = bid;
        gates[(size_t)t * 128 + hd * 16 + lane] = ev / tot;
    }
}

__device__ __forceinline__ void d_peer_out(int vb, int tid, float* sm, const bf16_t* __restrict__ h3, const float* __restrict__ x2, const int* __restrict__ ids, const float* __restrict__ gates,
                                           const bf16_t* __restrict__ u_tab, const bf16_t* __restrict__ v_tab, const float* __restrict__ g_final, float* __restrict__ out) {
    float (*part)[2048] = (float (*)[2048])sm;
    float* red = sm + 4 * 2048;
    const int lane = tid & 63, w = tid >> 6, t = vb;
    float4 xr[8], acc[8];
    const bf16_t* hrow = h3 + (size_t)t * D;
#pragma unroll
    for (int i = 0; i < 8; ++i) { const ushort4 hv = *(const ushort4*)(hrow + i * 256 + lane * 4);
        xr[i] = make_float4(bf2f(hv.x), bf2f(hv.y), bf2f(hv.z), bf2f(hv.w)); acc[i] = make_float4(0.f, 0.f, 0.f, 0.f); }
    for (int j = 0; j < 32; ++j) {
        const int slot = w * 32 + j;
        const int e = ids[(size_t)t * 128 + slot];
        const float gt = gates[(size_t)t * 128 + slot];
        const bf16_t* ur = u_tab + (size_t)e * D;
        const bf16_t* vr = v_tab + (size_t)e * D;
        float d = 0.f;
#pragma unroll
        for (int i = 0; i < 8; ++i) {
            const ushort4 u = *(const ushort4*)(ur + i * 256 + lane * 4);
            d = fmaf(xr[i].x, bf2f(u.x), d); d = fmaf(xr[i].y, bf2f(u.y), d); d = fmaf(xr[i].z, bf2f(u.z), d); d = fmaf(xr[i].w, bf2f(u.w), d);
        }
        d = wave_sum(d);
        const float act = 0.5f * d * (1.0f + erff(d * 0.7071067811865476f));
        const float cf = gt * act;
#pragma unroll
        for (int i = 0; i < 8; ++i) {
            const ushort4 v = *(const ushort4*)(vr + i * 256 + lane * 4);
            acc[i].x = fmaf(cf, bf2f(v.x), acc[i].x); acc[i].y = fmaf(cf, bf2f(v.y), acc[i].y); acc[i].z = fmaf(cf, bf2f(v.z), acc[i].z); acc[i].w = fmaf(cf, bf2f(v.w), acc[i].w);
        }
    }
    __syncthreads();
#pragma unroll
    for (int i = 0; i < 8; ++i) *(float4*)&part[w][i * 256 + lane * 4] = acc[i];
    __syncthreads();
    float4 r0, r1;
    {
        const float4 a = *(const float4*)&part[0][tid * 4], b = *(const float4*)&part[1][tid * 4], c = *(const float4*)&part[2][tid * 4], d = *(const float4*)&part[3][tid * 4];
        const float4 x = *(const float4*)(x2 + (size_t)t * D + tid * 4);
        r0 = make_float4(x.x + a.x + b.x + c.x + d.x, x.y + a.y + b.y + c.y + d.y, x.z + a.z + b.z + c.z + d.z, x.w + a.w + b.w + c.w + d.w);
    }
    {
        const float4 a = *(const float4*)&part[0][1024 + tid * 4], b = *(const float4*)&part[1][1024 + tid * 4], c = *(const float4*)&part[2][1024 + tid * 4], d = *(const float4*)&part[3][1024 + tid * 4];
        const float4 x = *(const float4*)(x2 + (size_t)t * D + 1024 + tid * 4);
        r1 = make_float4(x.x + a.x + b.x + c.x + d.x, x.y + a.y + b.y + c.y + d.y, x.z + a.z + b.z + c.z + d.z, x.w + a.w + b.w + c.w + d.w);
    }
    float s = r0.x * r0.x + r0.y * r0.y + r0.z * r0.z + r0.w * r0.w + r1.x * r1.x + r1.y * r1.y + r1.z * r1.z + r1.w * r1.w;
    s = wave_sum(s);
    if (lane == 0) red[w] = s;
    __syncthreads();
    const float tot = red[0] + red[1] + red[2] + red[3];
    const float r = rsqrtf(tot * (1.0f / D) + EPS);
    const float4 g0 = *(const float4*)(g_final + tid * 4), g1 = *(const float4*)(g_final + 1024 + tid * 4);
    *(float4*)(out + (size_t)t * D + tid * 4) = make_float4(r0.x * r * g0.x, r0.y * r * g0.y, r0.z * r * g0.z, r0.w * r * g0.w);
    *(float4*)(out + (size_t)t * D + 1024 + tid * 4) = make_float4(r1.x * r * g1.x, r1.y * r * g1.y, r1.z * r * g1.z, r1.w * r * g1.w);
}


__device__ __forceinline__ float wave_incl_scan_add(float v, int lane) {
#pragma unroll
    for (int o = 1; o < 64; o <<= 1) { const float t = __shfl_up(v, o); if (lane >= o) v += t; }
    return v;
}
__device__ __forceinline__ float wave_incl_scan_max(float v, int lane) {
#pragma unroll
    for (int o = 1; o < 64; o <<= 1) { const float t = __shfl_up(v, o); if (lane >= o) v = fmaxf(v, t); }
    return v;
}
__device__ __forceinline__ void mlstm_gates_wave(int b, int h, int lane, const float* __restrict__ gpre, const float* __restrict__ b_mi, const float* __restrict__ b_mf,
                                                 float* __restrict__ gs, float* __restrict__ decay) {
    const float bi = b_mi[h], bf = b_mf[h];
    float mprev = 0.f;
    for (int c = 0; c < 16; ++c) {
        const size_t t0 = (size_t)b * S + c * 256 + lane * 4;
        float logi[4], lf[4], bb[4];
#pragma unroll
        for (int j = 0; j < 4; ++j) { logi[j] = gpre[(t0 + j) * 8 + h] + bi; lf[j] = log_sigmoid(gpre[(t0 + j) * 8 + 4 + h] + bf); }
        bb[0] = lf[0]; bb[1] = bb[0] + lf[1]; bb[2] = bb[1] + lf[2]; bb[3] = bb[2] + lf[3];
        const float incl = wave_incl_scan_add(bb[3], lane);
        const float excl = incl - bb[3];
#pragma unroll
        for (int j = 0; j < 4; ++j) bb[j] += excl;
        const float g = __shfl(incl, 63);
        float amax = -INFINITY, uu[4], cm[4];
#pragma unroll
        for (int j = 0; j < 4; ++j) { amax = fmaxf(amax, logi[j] + g - bb[j]); uu[j] = logi[j] - bb[j]; }
        amax = wave_max(amax);
        const float mnew = fmaxf(g + mprev, amax);
        cm[0] = uu[0]; cm[1] = fmaxf(cm[0], uu[1]); cm[2] = fmaxf(cm[1], uu[2]); cm[3] = fmaxf(cm[2], uu[3]);
        const float cincl = wave_incl_scan_max(cm[3], lane);
        float cexcl = __shfl_up(cincl, 1); if (lane == 0) cexcl = -INFINITY;
#pragma unroll
        for (int j = 0; j < 4; ++j) {
            const float M = fmaxf(mprev, fmaxf(cexcl, cm[j]));
            float* o = gs + ((t0 + j) * 4 + h) * 8;
            o[0] = uu[j] * 1.4426950408889634f; o[1] = M * 1.4426950408889634f; o[2] = expf(logi[j] + g - bb[j] - mnew); o[3] = expf(mprev - M); o[4] = expf(-(bb[j] + M));
        }
        if (lane == 0) decay[(b * 16 + c) * 4 + h] = expf(g + mprev - mnew);
        mprev = mnew;
    }
}
__device__ __forceinline__ void transpose_tile64(int tid, float* sm, const bf16_t* __restrict__ src, int src_ld, bf16_t* __restrict__ dst, int dst_ld, const float* __restrict__ scale, int sstride) {
    unsigned short (*tl)[66] = (unsigned short (*)[66])sm;
    __syncthreads();
#pragma unroll
    for (int i = 0; i < 2; ++i) {
        const int ch = tid + i * 256, r = ch >> 3, c8 = (ch & 7) * 8;
        const uint4 v = *(const uint4*)(src + (size_t)r * src_ld + c8);
        const float sc = scale ? scale[(size_t)r * sstride] : 1.0f;
        const unsigned w[4] = {v.x, v.y, v.z, v.w};
#pragma unroll
        for (int k = 0; k < 4; ++k) {
            tl[r][c8 + 2 * k] = (unsigned short)f2bf(bf2f((unsigned short)(w[k] & 0xFFFFu)) * sc);
            tl[r][c8 + 2 * k + 1] = (unsigned short)f2bf(bf2f((unsigned short)(w[k] >> 16)) * sc);
        }
    }
    __syncthreads();
#pragma unroll
    for (int i = 0; i < 2; ++i) {
        const int ch = tid + i * 256, c = ch >> 3, r8 = (ch & 7) * 8;
        uint4 o;
        o.x = (unsigned)tl[r8 + 0][c] | ((unsigned)tl[r8 + 1][c] << 16); o.y = (unsigned)tl[r8 + 2][c] | ((unsigned)tl[r8 + 3][c] << 16);
        o.z = (unsigned)tl[r8 + 4][c] | ((unsigned)tl[r8 + 5][c] << 16); o.w = (unsigned)tl[r8 + 6][c] | ((unsigned)tl[r8 + 7][c] << 16);
        *(uint4*)(dst + (size_t)c * dst_ld + r8) = o;
    }
}

__device__ __forceinline__ void rope_table_fill(float2* __restrict__ cs, int gtid, int nth) {
    for (int idx = gtid; idx < 4096 * 64; idx += nth) {
        const int i = idx & 63, s = idx >> 6;
        const float inv = exp2f(-(float)i * 0.20762050593046014f);
        const float ang = (float)s * inv;
        float sn, c; sincosf(ang, &sn, &c);
        cs[idx] = make_float2(c, sn);
    }
}
__device__ __forceinline__ void rope_q_pass(bf16_t* __restrict__ aq, const float2* __restrict__ cs, size_t gtid, size_t nth) {
    for (size_t idx = gtid; idx < (size_t)T * 8 * 8; idx += nth) {
        const int c8 = (int)(idx & 7), hd = (int)((idx >> 3) & 7); const size_t t = idx >> 6; const int s = (int)(t & (S - 1));
        bf16_t* p = aq + t * 1024 + hd * 128 + c8 * 8;
        const uint4 a = *(const uint4*)p, b = *(const uint4*)(p + 64);
        const unsigned aw[4] = {a.x, a.y, a.z, a.w}, bw[4] = {b.x, b.y, b.z, b.w};
        unsigned ao[4], bo[4];
#pragma unroll
        for (int k = 0; k < 4; ++k) {
            const float4 cc = *(const float4*)(cs + (size_t)s * 64 + c8 * 8 + 2 * k);
            const float x10 = __uint_as_float(aw[k] << 16), x11 = __uint_as_float(aw[k] & 0xFFFF0000u), x20 = __uint_as_float(bw[k] << 16), x21 = __uint_as_float(bw[k] & 0xFFFF0000u);
            ao[k] = pk2(x10 * cc.x - x20 * cc.y, x11 * cc.z - x21 * cc.w);
            bo[k] = pk2(x20 * cc.x + x10 * cc.y, x21 * cc.z + x11 * cc.w);
        }
        *(uint4*)p = make_uint4(ao[0], ao[1], ao[2], ao[3]); *(uint4*)(p + 64) = make_uint4(bo[0], bo[1], bo[2], bo[3]);
    }
}
__device__ __forceinline__ void dil_tile_prep(int item, int lane, LAS unsigned short* wl, const bf16_t* __restrict__ ak, const bf16_t* __restrict__ av, const float2* __restrict__ cs,
                                              bf16_t* __restrict__ KB, bf16_t* __restrict__ VB) {
    const int TT = item & 255, hd = (item >> 8) & 7, b = (item >> 11) & 1, br = item >> 12;
    const int ld = 2 * br, tpr = 256 >> ld, rho = TT / tpr, tile = TT - rho * tpr;
    const int i = lane & 15, c = lane >> 4;
    const int s = rho + ((16 * tile + i) << ld);
    const size_t trow = (size_t)b * S + s;
    bf16_t* kdst = KB + (size_t)item * 2048;
    bf16_t* vdst = VB + (size_t)item * 2048;
    {
        const bf16_t* kr = ak + trow * 1024 + hd * 128 + 16 * c;
        const uint4 a0 = *(const uint4*)kr, a1 = *(const uint4*)(kr + 8), b0 = *(const uint4*)(kr + 64), b1 = *(const uint4*)(kr + 72);
        const unsigned aw[8] = {a0.x, a0.y, a0.z, a0.w, a1.x, a1.y, a1.z, a1.w}, bw[8] = {b0.x, b0.y, b0.z, b0.w, b1.x, b1.y, b1.z, b1.w};
        unsigned ao[8], bo[8];
#pragma unroll
        for (int k = 0; k < 8; ++k) {
            const float4 cc = *(const float4*)(cs + (size_t)s * 64 + 16 * c + 2 * k);
            const float x10 = __uint_as_float(aw[k] << 16), x11 = __uint_as_float(aw[k] & 0xFFFF0000u), x20 = __uint_as_float(bw[k] << 16), x21 = __uint_as_float(bw[k] & 0xFFFF0000u);
            ao[k] = pk2(x10 * cc.x - x20 * cc.y, x11 * cc.z - x21 * cc.w);
            bo[k] = pk2(x20 * cc.x + x10 * cc.y, x21 * cc.z + x11 * cc.w);
        }
        bf16_t* d0 = kdst + (c >> 1) * 512 + i * 32 + (c & 1) * 16;
        *(uint4*)d0 = make_uint4(ao[0], ao[1], ao[2], ao[3]); *(uint4*)(d0 + 8) = make_uint4(ao[4], ao[5], ao[6], ao[7]);
        bf16_t* d1 = d0 + 1024;
        *(uint4*)d1 = make_uint4(bo[0], bo[1], bo[2], bo[3]); *(uint4*)(d1 + 8) = make_uint4(bo[4], bo[5], bo[6], bo[7]);
    }
    {
        const bf16_t* vr = av + trow * 1024 + hd * 128 + 32 * c;
        const uint4 v0 = *(const uint4*)vr, v1 = *(const uint4*)(vr + 8), v2 = *(const uint4*)(vr + 16), v3 = *(const uint4*)(vr + 24);
        LAS unsigned short* wr = wl + i * 136 + 32 * c;
        typedef unsigned u32x4_t __attribute__((ext_vector_type(4)));
        *(LAS u32x4_t*)wr = (u32x4_t){v0.x, v0.y, v0.z, v0.w}; *(LAS u32x4_t*)(wr + 8) = (u32x4_t){v1.x, v1.y, v1.z, v1.w};
        *(LAS u32x4_t*)(wr + 16) = (u32x4_t){v2.x, v2.y, v2.z, v2.w}; *(LAS u32x4_t*)(wr + 24) = (u32x4_t){v3.x, v3.y, v3.z, v3.w};
        asm volatile("s_waitcnt lgkmcnt(0)" ::: "memory");
        unsigned o[16];
#pragma unroll
        for (int k = 0; k < 8; ++k) {
            const unsigned p0 = *(const LAS unsigned*)(wl + (2 * k) * 136 + 2 * lane), p1 = *(const LAS unsigned*)(wl + (2 * k + 1) * 136 + 2 * lane);
            o[k] = (p0 & 0xFFFFu) | (p1 << 16);
            o[8 + k] = (p0 >> 16) | (p1 & 0xFFFF0000u);
        }
        bf16_t* d = vdst + (2 * lane) * 16;
        *(uint4*)d = make_uint4(o[0], o[1], o[2], o[3]); *(uint4*)(d + 8) = make_uint4(o[4], o[5], o[6], o[7]);
        *(uint4*)(d + 16) = make_uint4(o[8], o[9], o[10], o[11]); *(uint4*)(d + 24) = make_uint4(o[12], o[13], o[14], o[15]);
        asm volatile("s_waitcnt lgkmcnt(0)" ::: "memory");
    }
}

typedef short bf16x8_t __attribute__((ext_vector_type(8)));
typedef short bf16x4_t __attribute__((ext_vector_type(4)));
typedef float f32x4_t __attribute__((ext_vector_type(4)));
__device__ __forceinline__ void dilated_wave_tile(int qt, int lane, const bf16_t* __restrict__ AQ, const bf16_t* __restrict__ KB, const bf16_t* __restrict__ VB,
                                                  const float* __restrict__ g_ahead, bf16_t* __restrict__ mix) {
    const int r = qt & 15, blk = (qt >> 4) & 15, hd = (qt >> 8) & 7, b = qt >> 11;
    const int j = lane & 15, g = lane >> 4;
    const int t0 = blk * 256;
    const int sq = t0 + r + 16 * j;
    bf16x8_t qf[4];
    {
        const bf16_t* qrow = AQ + ((size_t)b * S + sq) * 1024 + hd * 128 + 8 * g;
#pragma unroll
        for (int ks = 0; ks < 4; ++ks) qf[ks] = *(const bf16x8_t*)(qrow + 32 * ks);
    }
    const float sc = 0.08838834764831845f * 1.4426950408889634f;
    float m_run = -1e30f, l_run = 0.f;
    f32x4_t o[8];
#pragma unroll
    for (int dt = 0; dt < 8; ++dt) o[dt] = (f32x4_t){0.f, 0.f, 0.f, 0.f};
#pragma nounroll
    for (int br = 0; br < 3; ++br) {
        const int ld = 2 * br, d = 1 << ld;
        const int rho = r & (d - 1);
        const int qj = (sq - rho) >> ld;
        const int q_lo = ((t0 + r - rho) >> ld) - 128, q_hi = (t0 + r + 240 - rho) >> ld;
        const int tile_lo = q_lo < 0 ? 0 : (q_lo >> 4), tile_hi = q_hi >> 4, tile_max = (256 >> ld) - 1;
        const size_t tbase = ((size_t)((br * 2 + b) * 8 + hd) * 256 + (size_t)rho * (256 >> ld)) * 2048;
        const bf16_t* kbb = KB + tbase + j * 32 + 8 * g;
        const bf16_t* vbb = VB + tbase + j * 16 + 4 * g;
#pragma nounroll
        for (int tp = tile_lo; tp <= tile_hi; tp += 2) {
            f32x4_t su[2];
#pragma unroll
            for (int u = 0; u < 2; ++u) {
                int tl = tp + u; if (tl > tile_max) tl = tile_max;
                const bf16_t* krow = kbb + (size_t)tl * 2048;
                f32x4_t a = (f32x4_t){0.f, 0.f, 0.f, 0.f};
#pragma unroll
                for (int ks = 0; ks < 4; ++ks) a = __builtin_amdgcn_mfma_f32_16x16x32_bf16(*(const bf16x8_t*)(krow + 512 * ks), qf[ks], a, 0, 0, 0);
                su[u] = a;
            }
            float p[2][4]; float mx = -1e30f;
#pragma unroll
            for (int u = 0; u < 2; ++u)
#pragma unroll
                for (int e = 0; e < 4; ++e) {
                    const int n = qj - (16 * (tp + u) + 4 * g + e);
                    const bool valid = (n >= 0) && (n <= 128);
                    p[u][e] = valid ? su[u][e] * sc : -1e30f;
                    mx = fmaxf(mx, p[u][e]);
                }
            mx = fmaxf(mx, __shfl_xor(mx, 16)); mx = fmaxf(mx, __shfl_xor(mx, 32));
            const float m_new = fmaxf(m_run, mx);
            const float alpha = __builtin_amdgcn_exp2f(m_run - m_new);
            m_run = m_new;
            float ps = 0.f;
#pragma unroll
            for (int u = 0; u < 2; ++u)
#pragma unroll
                for (int e = 0; e < 4; ++e) { p[u][e] = (p[u][e] > -1e29f) ? __builtin_amdgcn_exp2f(p[u][e] - m_new) : 0.f; ps += p[u][e]; }
            l_run = l_run * alpha + ps;
            bf16x8_t pb;
            {
                const unsigned w0 = pk2(p[0][0], p[0][1]), w1 = pk2(p[0][2], p[0][3]), w2 = pk2(p[1][0], p[1][1]), w3 = pk2(p[1][2], p[1][3]);
                pb[0] = (short)(w0 & 0xFFFF); pb[1] = (short)(w0 >> 16); pb[2] = (short)(w1 & 0xFFFF); pb[3] = (short)(w1 >> 16);
                pb[4] = (short)(w2 & 0xFFFF); pb[5] = (short)(w2 >> 16); pb[6] = (short)(w3 & 0xFFFF); pb[7] = (short)(w3 >> 16);
            }
            int tl0 = tp, tl1 = tp + 1; if (tl0 > tile_max) tl0 = tile_max; if (tl1 > tile_max) tl1 = tile_max;
#pragma unroll
            for (int dt = 0; dt < 8; ++dt) {
                const bf16_t* vrow = vbb + dt * 256;
                const bf16x4_t v0 = *(const bf16x4_t*)(vrow + (size_t)tl0 * 2048), v1 = *(const bf16x4_t*)(vrow + (size_t)tl1 * 2048);
                bf16x8_t va; va[0] = v0[0]; va[1] = v0[1]; va[2] = v0[2]; va[3] = v0[3]; va[4] = v1[0]; va[5] = v1[1]; va[6] = v1[2]; va[7] = v1[3];
                f32x4_t oo = o[dt]; oo = oo * alpha;
                o[dt] = __builtin_amdgcn_mfma_f32_16x16x32_bf16(va, pb, oo, 0, 0, 0);
            }
        }
    }
    float lt = l_run; lt += __shfl_xor(lt, 16); lt += __shfl_xor(lt, 32);
    const float inv = 1.0f / lt;
    float ss = 0.f;
#pragma unroll
    for (int dt = 0; dt < 8; ++dt) { o[dt] = o[dt] * inv; ss += (o[dt][0] * o[dt][0] + o[dt][1] * o[dt][1]) + (o[dt][2] * o[dt][2] + o[dt][3] * o[dt][3]); }
    ss += __shfl_xor(ss, 16); ss += __shfl_xor(ss, 32);
    const float rn = rsqrtf(ss * (1.0f / 128.0f) + EPS);
    bf16_t* orow = mix + ((size_t)b * S + sq) * D + 1024 + hd * 128 + 4 * g;
#pragma unroll
    for (int dt = 0; dt < 8; ++dt) {
        const f32x4_t gv = *(const f32x4_t*)(g_ahead + hd * 128 + 16 * dt + 4 * g);
        uint2 w; w.x = pk2(o[dt][0] * rn * gv[0], o[dt][1] * rn * gv[1]); w.y = pk2(o[dt][2] * rn * gv[2], o[dt][3] * rn * gv[3]);
        *(uint2*)(orow + 16 * dt) = w;
    }
}

__device__ __forceinline__ unsigned ord_key(float s) { const unsigned u = __float_as_uint(s); return u ^ ((unsigned)((int)u >> 31) | 0x80000000u); }
__device__ __forceinline__ unsigned wave_max_u32(unsigned v) {
    unsigned t;
    t = (unsigned)__builtin_amdgcn_update_dpp(0, (int)v, 0xB1, 0xF, 0xF, true); v = v > t ? v : t;
    t = (unsigned)__builtin_amdgcn_update_dpp(0, (int)v, 0x4E, 0xF, 0xF, true); v = v > t ? v : t;
    t = (unsigned)__builtin_amdgcn_update_dpp(0, (int)v, 0x141, 0xF, 0xF, true); v = v > t ? v : t;
    t = (unsigned)__builtin_amdgcn_update_dpp(0, (int)v, 0x140, 0xF, 0xF, true); v = v > t ? v : t;
    const unsigned a = (unsigned)__builtin_amdgcn_readlane((int)v, 0), b = (unsigned)__builtin_amdgcn_readlane((int)v, 16),
                   c = (unsigned)__builtin_amdgcn_readlane((int)v, 32), d = (unsigned)__builtin_amdgcn_readlane((int)v, 48);
    const unsigned ab = a > b ? a : b, cd = c > d ? c : d;
    return ab > cd ? ab : cd;
}
__device__ __forceinline__ void peer_topk_wave(int item, int lane, LAS float* wl, const bf16_t* __restrict__ qp, const bf16_t* __restrict__ skb, int* __restrict__ ids, float* __restrict__ gates) {
    const int hd = item & 7, tt = item >> 3, j = lane & 15, g = lane >> 4;
    const size_t t0 = (size_t)tt * 16;
    LAS float* sc = wl;
    LAS float* lst = wl + 2048;
#pragma unroll 1
    for (int p = 0; p < 2; ++p) {
        bf16x8_t qf[4];
        const bf16_t* qrow = qp + (t0 + j) * D + hd * 256 + p * 128 + 8 * g;
#pragma unroll
        for (int ks = 0; ks < 4; ++ks) qf[ks] = *(const bf16x8_t*)(qrow + 32 * ks);
        const bf16_t* kb = skb + ((size_t)(hd * 2 + p) * 128 + j) * 128 + 8 * g;
#pragma unroll
        for (int kt = 0; kt < 8; ++kt) {
            f32x4_t a = (f32x4_t){0.f, 0.f, 0.f, 0.f};
#pragma unroll
            for (int ks = 0; ks < 4; ++ks) a = __builtin_amdgcn_mfma_f32_16x16x32_bf16(*(const bf16x8_t*)(kb + (size_t)kt * (16 * 128) + 32 * ks), qf[ks], a, 0, 0, 0);
            *(LAS f32x4_t*)(sc + j * 128 + 16 * kt + 4 * g) = a;
        }
        asm volatile("s_waitcnt lgkmcnt(0)" ::: "memory");
#pragma unroll 1
        for (int tok = 0; tok < 16; ++tok) {
            const float s0 = sc[tok * 128 + lane], s1 = sc[tok * 128 + 64 + lane];
            unsigned k0 = (ord_key(s0) & ~127u) | (unsigned)(127 - lane), k1 = (ord_key(s1) & ~127u) | (unsigned)(63 - lane);
            unsigned sel = 0u;
#pragma unroll 4
            for (int it = 0; it < 16; ++it) {
                unsigned m = k0 > k1 ? k0 : k1;
                m = wave_max_u32(m);
                if (lane == it) sel = m;
                if (k0 == m) k0 = 0u;
                if (k1 == m) k1 = 0u;
            }
            if (lane < 16) {
                const int idx = 127 - (int)(sel & 127u);
                lst[((p * 16 + tok) * 16 + lane) * 2 + 0] = sc[tok * 128 + idx];
                lst[((p * 16 + tok) * 16 + lane) * 2 + 1] = __int_as_float(idx);
            }
        }
        asm volatile("s_waitcnt lgkmcnt(0)" ::: "memory");
    }
#pragma unroll 1
    for (int tok = 0; tok < 16; ++tok) {
        const int i = lane >> 2;
        const float sA = lst[((0 * 16 + tok) * 16 + i) * 2];
        unsigned kk[4];
#pragma unroll
        for (int r = 0; r < 4; ++r) {
            const int jb = (lane & 3) * 4 + r;
            const float sum = sA + lst[((1 * 16 + tok) * 16 + jb) * 2];
            kk[r] = (ord_key(sum) & ~255u) | (unsigned)(255 - (lane * 4 + r));
        }
        unsigned sel = 0u;
#pragma unroll 4
        for (int it = 0; it < 16; ++it) {
            unsigned m = kk[0] > kk[1] ? kk[0] : kk[1]; const unsigned m2 = kk[2] > kk[3] ? kk[2] : kk[3]; m = m > m2 ? m : m2;
            m = wave_max_u32(m);
            if (lane == it) sel = m;
#pragma unroll
            for (int r = 0; r < 4; ++r) if (kk[r] == m) kk[r] = 0u;
        }
        float bs = -INFINITY; int eid = 0;
        if (lane < 16) {
            const int c = 255 - (int)(sel & 255u), ia = c >> 4, ib = c & 15;
            bs = lst[((0 * 16 + tok) * 16 + ia) * 2] + lst[((1 * 16 + tok) * 16 + ib) * 2];
            eid = __float_as_int(lst[((0 * 16 + tok) * 16 + ia) * 2 + 1]) * 128 + __float_as_int(lst[((1 * 16 + tok) * 16 + ib) * 2 + 1]);
        }
        const float mx = wave_max(bs);
        const float ev = lane < 16 ? __expf(bs - mx) : 0.f;
        const float tot = wave_sum(ev);
        if (lane < 16) {
            ids[(t0 + tok) * 128 + hd * 16 + lane] = eid;
            gates[(t0 + tok) * 128 + hd * 16 + lane] = ev / tot;
        }
    }
}

typedef float f32x2_t __attribute__((ext_vector_type(2)));
__device__ __forceinline__ void table_row_to_fp8(const float* __restrict__ srow, unsigned char* __restrict__ drow, float* __restrict__ rscale, int lane) {
    float4 f[8];
#pragma unroll
    for (int i = 0; i < 8; ++i) f[i] = *(const float4*)(srow + i * 256 + lane * 4);
    float am = 0.f;
#pragma unroll
    for (int i = 0; i < 8; ++i) am = fmaxf(am, fmaxf(fmaxf(fabsf(f[i].x), fabsf(f[i].y)), fmaxf(fabsf(f[i].z), fabsf(f[i].w))));
    am = wave_max(am);
    const float e = floorf(log2f(448.0f / fmaxf(am, 1e-30f)));
    const float s = exp2f(fminf(e, 100.0f));
    unsigned w[8];
#pragma unroll
    for (int i = 0; i < 8; ++i) {
        int t = 0;
        t = __builtin_amdgcn_cvt_pk_fp8_f32(f[i].x * s, f[i].y * s, t, false);
        t = __builtin_amdgcn_cvt_pk_fp8_f32(f[i].z * s, f[i].w * s, t, true);
        w[i] = (unsigned)t;
    }
#pragma unroll
    for (int i = 0; i < 8; ++i) *(unsigned*)(drow + i * 256 + lane * 4) = w[i];
    if (lane == 0) *rscale = 1.0f / s;
}
__device__ __forceinline__ float dot16_fp8(const uint4 q, const float* x) {
    float d = 0.f;
    const unsigned w[4] = {q.x, q.y, q.z, q.w};
#pragma unroll
    for (int k = 0; k < 4; ++k) {
        const f32x2_t lo = __builtin_amdgcn_cvt_pk_f32_fp8((int)w[k], false), hi = __builtin_amdgcn_cvt_pk_f32_fp8((int)w[k], true);
        d = fmaf(lo.x, x[4 * k], d); d = fmaf(lo.y, x[4 * k + 1], d); d = fmaf(hi.x, x[4 * k + 2], d); d = fmaf(hi.y, x[4 * k + 3], d);
    }
    return d;
}
__device__ __forceinline__ void axpy16_fp8(const uint4 q, float c, float* acc) {
    const unsigned w[4] = {q.x, q.y, q.z, q.w};
#pragma unroll
    for (int k = 0; k < 4; ++k) {
        const f32x2_t lo = __builtin_amdgcn_cvt_pk_f32_fp8((int)w[k], false), hi = __builtin_amdgcn_cvt_pk_f32_fp8((int)w[k], true);
        acc[4 * k] = fmaf(c, lo.x, acc[4 * k]); acc[4 * k + 1] = fmaf(c, lo.y, acc[4 * k + 1]); acc[4 * k + 2] = fmaf(c, hi.x, acc[4 * k + 2]); acc[4 * k + 3] = fmaf(c, hi.y, acc[4 * k + 3]);
    }
}
__device__ __forceinline__ void d_peer_out8(int vb, int tid, float* sm, const bf16_t* __restrict__ h3, const float* __restrict__ x2, const int* __restrict__ ids, const float* __restrict__ gates,
                                            const unsigned char* __restrict__ ut8, const unsigned char* __restrict__ vt8, const float* __restrict__ rsc, const float* __restrict__ rstd, const float* __restrict__ g_final, float* __restrict__ out) {
    float (*part)[2048] = (float (*)[2048])sm;
    float* red = sm + 4 * 2048;
    const int lane = tid & 63, w = tid >> 6, t = vb;
    float x[32], acc[32];
    {
        const bf16_t* hrow = h3 + (size_t)t * D + lane * 16;
#pragma unroll
        for (int hh = 0; hh < 2; ++hh) {
            const uint4 a = *(const uint4*)(hrow + hh * 1024), b = *(const uint4*)(hrow + hh * 1024 + 8);
            const unsigned ww[8] = {a.x, a.y, a.z, a.w, b.x, b.y, b.z, b.w};
#pragma unroll
            for (int k = 0; k < 8; ++k) { x[hh * 16 + 2 * k] = __uint_as_float(ww[k] << 16); x[hh * 16 + 2 * k + 1] = __uint_as_float(ww[k] & 0xFFFF0000u); }
        }
#pragma unroll
        for (int i = 0; i < 32; ++i) acc[i] = 0.f;
    }
    const float xrs = rstd[t];
    const int myid = ids[(size_t)t * 128 + w * 32 + (lane & 31)];
    const float mygate = gates[(size_t)t * 128 + w * 32 + (lane & 31)];
#pragma unroll 1
    for (int j = 0; j < 32; j += 4) {
        int e[4]; uint4 uq[4][2], vq[4][2];
#pragma unroll
        for (int q = 0; q < 4; ++q) {
            e[q] = __builtin_amdgcn_readfirstlane(__shfl(myid, j + q));
            const unsigned char* ur = ut8 + (size_t)e[q] * 2048 + lane * 16;
            uq[q][0] = *(const uint4*)ur; uq[q][1] = *(const uint4*)(ur + 1024);
        }
#pragma unroll
        for (int q = 0; q < 4; ++q) {
            const unsigned char* vr = vt8 + (size_t)e[q] * 2048 + lane * 16;
            vq[q][0] = *(const uint4*)vr; vq[q][1] = *(const uint4*)(vr + 1024);
        }
        float d[4];
#pragma unroll
        for (int q = 0; q < 4; ++q) d[q] = dot16_fp8(uq[q][0], x) + dot16_fp8(uq[q][1], x + 16);
#pragma unroll
        for (int o = 32; o >= 1; o >>= 1) {
#pragma unroll
            for (int q = 0; q < 4; ++q) d[q] += __shfl_xor(d[q], o);
        }
#pragma unroll
        for (int q = 0; q < 4; ++q) {
            const float a = d[q] * rsc[e[q]] * xrs;
            const float act = 0.5f * a * (1.0f + erff(a * 0.7071067811865476f));
            const float cf = __shfl(mygate, j + q) * act * rsc[16384 + e[q]];
            axpy16_fp8(vq[q][0], cf, acc); axpy16_fp8(vq[q][1], cf, acc + 16);
        }
    }
    __syncthreads();
#pragma unroll
    for (int hh = 0; hh < 2; ++hh)
#pragma unroll
        for (int k = 0; k < 4; ++k) *(float4*)&part[w][hh * 1024 + lane * 16 + 4 * k] = make_float4(acc[hh * 16 + 4 * k], acc[hh * 16 + 4 * k + 1], acc[hh * 16 + 4 * k + 2], acc[hh * 16 + 4 * k + 3]);
    __syncthreads();
    float4 r0, r1;
    {
        const float4 a = *(const float4*)&part[0][tid * 4], b = *(const float4*)&part[1][tid * 4], c = *(const float4*)&part[2][tid * 4], dd = *(const float4*)&part[3][tid * 4];
        const float4 xx = *(const float4*)(x2 + (size_t)t * D + tid * 4);
        r0 = make_float4(xx.x + a.x + b.x + c.x + dd.x, xx.y + a.y + b.y + c.y + dd.y, xx.z + a.z + b.z + c.z + dd.z, xx.w + a.w + b.w + c.w + dd.w);
    }
    {
        const float4 a = *(const float4*)&part[0][1024 + tid * 4], b = *(const float4*)&part[1][1024 + tid * 4], c = *(const float4*)&part[2][1024 + tid * 4], dd = *(const float4*)&part[3][1024 + tid * 4];
        const float4 xx = *(const float4*)(x2 + (size_t)t * D + 1024 + tid * 4);
        r1 = make_float4(xx.x + a.x + b.x + c.x + dd.x, xx.y + a.y + b.y + c.y + dd.y, xx.z + a.z + b.z + c.z + dd.z, xx.w + a.w + b.w + c.w + dd.w);
    }
    float s = r0.x * r0.x + r0.y * r0.y + r0.z * r0.z + r0.w * r0.w + r1.x * r1.x + r1.y * r1.y + r1.z * r1.z + r1.w * r1.w;
    s = wave_sum(s);
    if (lane == 0) red[w] = s;
    __syncthreads();
    const float tot = red[0] + red[1] + red[2] + red[3];
    const float r = rsqrtf(tot * (1.0f / D) + EPS);
    const float4 g0 = *(const float4*)(g_final + tid * 4), g1 = *(const float4*)(g_final + 1024 + tid * 4);
    *(float4*)(out + (size_t)t * D + tid * 4) = make_float4(r0.x * r * g0.x, r0.y * r * g0.y, r0.z * r * g0.z, r0.w * r * g0.w);
    *(float4*)(out + (size_t)t * D + 1024 + tid * 4) = make_float4(r1.x * r * g1.x, r1.y * r * g1.y, r1.z * r * g1.z, r1.w * r * g1.w);
}

struct Params {
    const float *x, *mem, *g_mix, *w_in, *conv_w, *conv_b, *w_mq, *w_mk, *b_mi, *b_mf, *g_mhead, *g_ahead, *w_out, *g_cross, *g_mem,
                *w_xq, *w_xk, *w_xv, *w_xo, *g_ffn, *w_pq, *sub_keys, *u_tab, *v_tab, *g_final;
    float* out;
    unsigned* bar;
    float* ws;
};

#define PHASE_LOOP(nvb) for (int base_ = blockIdx.x * 2; base_ < (nvb); base_ += gridDim.x * 2)
#define VB (base_ + half)

__global__ void __launch_bounds__(NTHR) mega(Params P) {
    volatile LAS unsigned* st = (volatile LAS unsigned*)(LAS unsigned char*)(smem_raw + GEMM_LDS);
    if (threadIdx.x == 0) { st[0] = 0u; st[1] = 0u; st[2] = 0u; st[3] = 0u; }
    if (threadIdx.x < I_NPTR) ((LAS unsigned long long*)(LAS unsigned char*)(smem_raw + GEMM_LDS + 64))[threadIdx.x] = ((const unsigned long long*)&P)[threadIdx.x];
    __syncthreads();
    XcdBarrier xb = xcd_barrier_post((unsigned*)ldp_raw(I_BAR), st);

    constexpr size_t TD = (size_t)T * D;
    constexpr size_t O_HB = 6 * P6S * 2, O_CBUF = O_HB + (size_t)T * D * 2, O_MQ = O_CBUF + (size_t)T * 1024 * 2, O_MK = O_MQ + (size_t)T * 1024 * 2,
                     O_MIXB = O_MK + (size_t)T * 1024 * 2, O_WIN = O_MIXB + (size_t)T * D * 2, O_WOUT = O_WIN + (size_t)6144 * D * 2, O_WXQ = O_WOUT + (size_t)D * D * 2,
                     O_WXK = O_WXQ + (size_t)D * D * 2, O_WXV = O_WXK + (size_t)D * D * 2, O_WXO = O_WXV + (size_t)D * D * 2, O_WPQ = O_WXO + (size_t)D * D * 2,
                     O_WQK = O_WPQ + (size_t)D * D * 2, O_GPRE = O_WQK + (size_t)8 * 256 * 256 * 2, O_UT = O_GPRE + (size_t)T * 8 * 4, O_VT = O_UT + (size_t)16384 * D, O_RSC = O_VT + (size_t)16384 * D,
                     O_BH = O_RSC + (size_t)32768 * 4, O_GS = O_BH + (size_t)128 * 256 * 512 * 2, O_DENP = O_GS + (size_t)T * 4 * 8 * 4, O_QN = O_DENP + (size_t)T * 4 * 4 * 4,
                     O_DN = O_QN + (size_t)T * 4 * 4, O_DECAY = O_DN + (size_t)128 * 256 * 4, O_KB = O_DECAY + 4096, O_VB = O_KB + (size_t)12288 * 2048 * 2, O_CS = O_VB + (size_t)12288 * 2048 * 2, O_SKB = O_CS + (size_t)4096 * 64 * 8, O_RSSP = O_SKB + (size_t)262144 * 2, O_RSTD = O_RSSP + (size_t)T * 32 * 4, O_MN = O_RSTD + (size_t)T * 4, O_KVP = O_MN + (size_t)512 * D * 2, O_END = O_KVP + (size_t)2 * 512 * 4096 * 4;
    static_assert(O_END + 16384 <= (size_t)536870912, "workspace overflow");
#define W_P6    ((bf16_t*)wsb)
#define W_HB    ((bf16_t*)(wsb + O_HB))
#define W_CBUF  ((bf16_t*)(wsb + O_CBUF))
#define W_MQ    ((bf16_t*)(wsb + O_MQ))
#define W_MK    ((bf16_t*)(wsb + O_MK))
#define W_MIXB  ((bf16_t*)(wsb + O_MIXB))
#define W_GPRE  ((float*)(wsb + O_GPRE))
#define W_HRAW  ((float*)(wsb + O_HB))
#define W_XR    ((float*)wsb)
#define W_MN    ((bf16_t*)((float*)wsb + TD))
#define W_KM    ((bf16_t*)((float*)wsb + TD + (size_t)256 * D))
#define W_VMT   ((bf16_t*)((float*)wsb + TD + (size_t)768 * D))
#define W_PX    ((bf16_t*)(wsb + O_MK))
#define W_GATES ((float*)wsb + TD + (size_t)1280 * D)
#define W_IDS   ((int*)((float*)wsb + TD + (size_t)1280 * D + (size_t)T * 128))
#define W_QX    ((bf16_t*)(wsb + O_CBUF))
#define W_BH    ((bf16_t*)(wsb + O_BH))
#define W_KB    ((bf16_t*)(wsb + O_KB))
#define W_VB    ((bf16_t*)(wsb + O_VB))
#define W_CS    ((float2*)(wsb + O_CS))
#define W_SKB   ((bf16_t*)(wsb + O_SKB))
#define W_RSSP  ((float*)(wsb + O_RSSP))
#define W_RSTD  ((float*)(wsb + O_RSTD))
#define W_MN2   ((bf16_t*)(wsb + O_MN))
#define W_KVP   ((float*)(wsb + O_KVP))
#define W_GS    ((float*)(wsb + O_GS))
#define W_DENP  ((float*)(wsb + O_DENP))
#define W_QN    ((float*)(wsb + O_QN))
#define W_DN    ((float*)(wsb + O_DN))
#define W_DECAY ((float*)(wsb + O_DECAY))
#define W_PQ    ((bf16_t*)(wsb + O_HB))
#define W_KWT   ((bf16_t*)(wsb + O_CBUF))
#define W_DC    ((float*)(wsb + 3 * P6S * 2))
#define W_UT    ((unsigned char*)(wsb + O_UT))
#define W_VT    ((unsigned char*)(wsb + O_VT))
#define W_RSC   ((float*)(wsb + O_RSC))
#define PH_BEGIN() int tidx = threadIdx.x; asm volatile("" : "+v"(tidx)); const int half = tidx >> 8, tid = tidx & 255; float* sm = (float*)smem_raw + half * HALF_SM_FLOATS; \
                   char* wsb = (char*)ldp_raw(I_WS); (void)half; (void)tid; (void)sm; (void)wsb
#define GJOB_DEFAULT(g) pg8::GJob g; g.lda = D; g.ldb = D; g.K = D; g.nM = 32; g.nN = 8; g.a_pm_step = 256 * D; g.b_pn_mask = 0x7fffffff; g.b_pn_shift = 30; g.b_pn_step2 = 0; g.bid0 = 0; g.nblk = gridDim.x; g.a_pn_shift = 0; g.a_pn_mask = 0; g.a_pn_step = 0; g.b_pm_shift = 0; g.b_pm_step = 0; g.b_pn_step = 256 * D; \
                        g.ldc = D; g.R = nullptr; g.ldr = D; g.mode = 0; g.escale = 1.0f; g.gs = nullptr; g.denp = nullptr; g.qn = nullptr; g.gvec = nullptr; g.mo = nullptr; g.C2 = nullptr; g.rssp = nullptr; g.rstd = nullptr
#define GEMM_LDSP ((LAS unsigned char*)smem_raw)

    {
        PH_BEGIN();
        {
            LAS float* scr = (LAS float*)(LAS unsigned char*)(smem_raw) + (tidx >> 6) * (64 * 33);
            const int lane = tidx & 63;
            const int gw = blockIdx.x * 8 + (tidx >> 6), NGW = gridDim.x * 8;
            constexpr int I_IN = 32 * 192, I_SQ = 32 * 64, I_QK = 8 * 4 * 8;
            constexpr int NITEMS = I_IN + 6 * I_SQ + I_QK;
#pragma nounroll
            for (int it = gw; it < NITEMS; it += NGW) {
                const float* W; int ldw, K, csrc0, row0, kb; bf16_t* WT; float wscale = 1.0f;
                int r = it;
                if (r < I_IN) { const int nb = r % 192; kb = r / 192; W = PF(I_WIN); ldw = INC; K = D; csrc0 = nb * 32 + (nb >= 96 ? 8 : 0); WT = (bf16_t*)(wsb + O_WIN); row0 = nb * 32; }
                else if ((r -= I_IN) < 6 * I_SQ) {
                    const int wsel = r / I_SQ; r -= wsel * I_SQ; const int nb = r % 64; kb = r / 64; ldw = D; K = D; csrc0 = nb * 32; row0 = nb * 32;
                    W = PF(wsel == 0 ? I_WOUT : wsel == 1 ? I_WXQ : wsel == 2 ? I_WXK : wsel == 3 ? I_WXV : wsel == 4 ? I_WXO : I_WPQ);
                    WT = (bf16_t*)(wsb + O_WOUT + (size_t)wsel * ((size_t)D * D * 2));
                } else {
                    r -= 6 * I_SQ; const int hq = r / 32; r -= hq * 32; const int nb = r % 8; kb = r / 8;
                    W = PF(hq < 4 ? I_WMQ : I_WMK) + (size_t)(hq & 3) * 65536; ldw = 256; K = 256; csrc0 = nb * 32; WT = (bf16_t*)(wsb + O_WQK); row0 = hq * 256 + nb * 32;
                    if (hq >= 4) wscale = 0.0625f;
                }
                p0_transpose_item(W, ldw, K, csrc0, WT, row0, scr, kb, lane, wscale);
            }
            {
                const float* ut = PF(I_UTAB); const float* vt = PF(I_VTAB);
#pragma nounroll
                for (int row = gw; row < 32768; row += NGW) {
                    const bool second = row >= 16384; const int rr = second ? row - 16384 : row;
                    table_row_to_fp8((second ? vt : ut) + (size_t)rr * D, (second ? W_VT : W_UT) + (size_t)rr * D, W_RSC + row, lane);
                }
            }
            rope_table_fill(W_CS, blockIdx.x * NTHR + tidx, gridDim.x * NTHR);
            {
                const float* sk = PF(I_SUBK);
#pragma nounroll
                for (int i = blockIdx.x * NTHR + tidx; i < 262144 / 8; i += gridDim.x * NTHR) {
                    const float4 a = *(const float4*)(sk + (size_t)i * 8), b = *(const float4*)(sk + (size_t)i * 8 + 4);
                    uint4 o; o.x = pk2(a.x, a.y); o.y = pk2(a.z, a.w); o.z = pk2(b.x, b.y); o.w = pk2(b.z, b.w);
                    *(uint4*)(W_SKB + (size_t)i * 8) = o;
                }
            }
            __syncthreads();
        }
        {
            const float* rin = PF(I_X); const float* rg = PF(I_GMIX); const float* win = PF(I_WIN);
            float* gwl = (float*)smem_raw + 1024;
            for (int k = tidx; k < 2048; k += NTHR) { const float4 a = *(const float4*)(win + (size_t)k * INC + C_MI), b = *(const float4*)(win + (size_t)k * INC + C_MI + 4);
                *(float4*)(gwl + k * 8) = a; *(float4*)(gwl + k * 8 + 4) = b; }
            __syncthreads();
            float* red = (float*)smem_raw + half * 256;
#pragma nounroll
            PHASE_LOOP(T) d_rmsnorm(VB, tid, red, rin, rg, W_HB, gwl, W_GPRE);
            const float* min_ = PF(I_MEM); const float* mg = PF(I_GMEM);
#pragma nounroll
            PHASE_LOOP(512) d_rmsnorm(VB, tid, red, min_, mg, W_MN2, nullptr, nullptr);
        }
    }
    xcd_barrier(xb);
    {
        PH_BEGIN();
        GJOB_DEFAULT(g); g.A = W_HB; g.Bt = (bf16_t*)(wsb + O_WIN); g.nN = 24; g.C = (float*)W_P6; g.ldc = 1024;
        pg8::gemm_phase<4>(GEMM_LDSP, g, tidx);
    }
    xcd_barrier(xb);
    {
        PH_BEGIN();
        const float* cw = PF(I_CONVW); const float* cb = PF(I_CONVB);
#pragma nounroll
        PHASE_LOOP(T) d_conv_silu(VB, tid, W_P6, cw, cb, W_CBUF);
        rope_q_pass(W_P6 + 3 * P6S, W_CS, (size_t)blockIdx.x * NTHR + tidx, (size_t)gridDim.x * NTHR);
        {
            LAS unsigned short* wl = (LAS unsigned short*)(LAS unsigned char*)smem_raw + (tidx >> 6) * (16 * 136);
#pragma nounroll
            for (int item = blockIdx.x * 8 + (tidx >> 6); item < 12288; item += gridDim.x * 8) dil_tile_prep(item, tidx & 63, wl, W_P6 + 4 * P6S, W_P6 + 5 * P6S, W_CS, W_KB, W_VB);
            __syncthreads();
        }
        if (blockIdx.x < 8 && tidx < 64) mlstm_gates_wave(blockIdx.x >> 2, blockIdx.x & 3, tidx, W_GPRE, PF(I_BMI), PF(I_BMF), W_GS, W_DECAY);
#pragma nounroll
        PHASE_LOOP(2048) { const int it = VB, lt = it & 3, et = (it >> 2) & 3, h = (it >> 4) & 3, cg = it >> 6;
            transpose_tile64(tid, sm, W_P6 + P6S + (size_t)(cg * 256 + lt * 64) * 1024 + h * 256 + et * 64, 1024, W_BH + ((size_t)(cg * 4 + h) * 256 + et * 64) * 512 + lt * 64, 512, nullptr, 0); }
    }
    xcd_barrier(xb);
    {
        PH_BEGIN();
        {
            GJOB_DEFAULT(g); g.A = W_CBUF; g.lda = 1024; g.a_pm_step = 256 * 1024; g.Bt = (bf16_t*)(wsb + O_WQK); g.ldb = 256; g.b_pn_step = 256 * 256; g.K = 256; g.a_pn_mask = 3; g.a_pn_step = 256; g.C = (float*)W_MQ; g.ldc = 1024;
            pg8::gemm_phase<4>(GEMM_LDSP, g, tidx);
            __syncthreads();
        }
        const float* ga = PF(I_GAHEAD);
#pragma nounroll
        for (int qt = blockIdx.x * 8 + (tidx >> 6); qt < 4096; qt += gridDim.x * 8) dilated_wave_tile(qt, tidx & 63, W_P6 + 3 * P6S, W_KB, W_VB, ga, W_MIXB);
    }
    xcd_barrier(xb);
    {
        PH_BEGIN();
#pragma nounroll
        PHASE_LOOP(2048) { const int it = VB, lt = it & 3, dt = (it >> 2) & 3, h = (it >> 4) & 3, cg = it >> 6;
            transpose_tile64(tid, sm, W_MK + (size_t)(cg * 256 + lt * 64) * 1024 + h * 256 + dt * 64, 1024, W_KWT + ((size_t)(cg * 4 + h) * 256 + dt * 64) * 256 + lt * 64, 256,
                             W_GS + ((size_t)(cg * 256 + lt * 64) * 4 + h) * 8 + 2, 32); }
        {
            const size_t nth = (size_t)gridDim.x * NTHR;
#pragma nounroll
            for (size_t i = (size_t)blockIdx.x * NTHR + tidx; i < (size_t)T * 128; i += nth) {
                const size_t t = i >> 7; const int c8 = (int)(i & 127) * 8, h = c8 >> 8, d = c8 & 255;
                const float sc = W_GS[(t * 4 + h) * 8 + 3];
                const uint4 v = *(const uint4*)(W_MQ + t * 1024 + c8);
                uint4 o;
                o.x = pk2(bf2f((unsigned short)(v.x & 0xFFFFu)) * sc, bf2f((unsigned short)(v.x >> 16)) * sc); o.y = pk2(bf2f((unsigned short)(v.y & 0xFFFFu)) * sc, bf2f((unsigned short)(v.y >> 16)) * sc);
                o.z = pk2(bf2f((unsigned short)(v.z & 0xFFFFu)) * sc, bf2f((unsigned short)(v.z >> 16)) * sc); o.w = pk2(bf2f((unsigned short)(v.w & 0xFFFFu)) * sc, bf2f((unsigned short)(v.w >> 16)) * sc);
                *(uint4*)(W_PQ + t * 2048 + h * 512 + 256 + d) = o;
            }
        }
#pragma nounroll
        PHASE_LOOP(128) { const int cgh = VB, cg = cgh >> 2, h = cgh & 3;
            float a = 0.f;
            for (int l = 0; l < 256; ++l) { const size_t t = (size_t)cg * 256 + l; a = fmaf(W_GS[(t * 4 + h) * 8 + 2], bf2f(W_MK[t * 1024 + h * 256 + tid]), a); }
            W_DN[(size_t)cgh * 256 + tid] = a; }
        __syncthreads();
        {
            GJOB_DEFAULT(g); g.A = W_MQ; g.lda = 1024; g.a_pm_step = 256 * 1024; g.a_pn_mask = 3; g.a_pn_step = 256; g.K = 256; g.nN = 4;
            g.Bt = W_MK; g.ldb = 1024; g.b_pn_step = 256; g.b_pm_step = 256 * 1024; g.C = (float*)W_PQ; g.gs = W_GS; g.denp = W_DENP;
            pg8::gemm_phase<6>(GEMM_LDSP, g, tidx);
        }
    }
    xcd_barrier(xb);
    {
        PH_BEGIN();
        GJOB_DEFAULT(g); g.A = W_BH; g.lda = 512; g.a_pm_step = 4 * 256 * 512; g.a_pn_mask = 3; g.a_pn_step = 256 * 512; g.K = 256; g.nN = 4;
        g.Bt = W_KWT; g.ldb = 256; g.b_pn_step = 65536; g.b_pm_step = 4 * 65536; g.C = W_DC;
        pg8::gemm_phase<7>(GEMM_LDSP, g, tidx);
    }
    xcd_barrier(xb);
    {
        PH_BEGIN();
        {
#pragma nounroll
            for (int gid = blockIdx.x * NTHR + tidx; gid < 131072; gid += gridDim.x * NTHR) {
                const int bh = gid >> 14, b = bh >> 2, h = bh & 3, e = (gid >> 6) & 255, d = (gid & 63) * 4;
                float4 C = make_float4(0.f, 0.f, 0.f, 0.f);
#pragma unroll 4
                for (int c = 0; c < 16; ++c) {
                    const int cgh = (b * 16 + c) * 4 + h;
                    uint2 o; o.x = pk2(C.x, C.y); o.y = pk2(C.z, C.w);
                    *(uint2*)(W_BH + ((size_t)cgh * 256 + e) * 512 + 256 + d) = o;
                    const float dec = W_DECAY[cgh];
                    const float4 dc = *(const float4*)(W_DC + ((size_t)cgh * 256 + e) * 256 + d);
                    C.x = fmaf(dec, C.x, dc.x); C.y = fmaf(dec, C.y, dc.y); C.z = fmaf(dec, C.z, dc.z); C.w = fmaf(dec, C.w, dc.w);
                }
            }
        }
#pragma nounroll
        PHASE_LOOP(128) { const int cgh = VB, cg = cgh >> 2, h = cgh & 3, b = cg >> 4, c = cg & 15;
            float n = 0.f;
            for (int cc = 0; cc < c; ++cc) { const int j = (b * 16 + cc) * 4 + h; n = fmaf(W_DECAY[j], n, W_DN[(size_t)j * 256 + tid]); }
            __syncthreads();
            sm[tid] = n;
            __syncthreads();
            const int lane = tid & 63, w = tid >> 6;
            const float4 nv = *(const float4*)(sm + lane * 4);
            for (int i = 0; i < 64; ++i) {
                const size_t t = (size_t)cg * 256 + w * 64 + i;
                const ushort4 q4 = *(const ushort4*)(W_MQ + t * 1024 + h * 256 + lane * 4);
                float s = bf2f(q4.x) * nv.x + bf2f(q4.y) * nv.y + bf2f(q4.z) * nv.z + bf2f(q4.w) * nv.w;
                s = wave_sum(s);
                if (lane == 0) W_QN[t * 4 + h] = s;
            }
        }
    }
    xcd_barrier(xb);
    {
        PH_BEGIN();
        GJOB_DEFAULT(g); g.A = W_PQ; g.a_pn_mask = 3; g.a_pn_step = 512; g.K = 512; g.nN = 4;
        g.Bt = W_BH; g.ldb = 512; g.b_pn_step = 256 * 512; g.b_pm_step = 4 * 256 * 512; g.C = (float*)W_MIXB;
        g.gs = W_GS; g.denp = W_DENP; g.qn = W_QN; g.gvec = PF(I_GMHEAD); g.mo = W_P6 + 2 * P6S; g.nblk = 128;
        if (blockIdx.x < 128) pg8::gemm_phase<8>(GEMM_LDSP, g, tidx);
        else {
            GJOB_DEFAULT(k); k.A = W_MN2; k.K = 1024; k.nM = 2; k.nN = 32; k.a_pn_shift = 4; k.a_pn_mask = 1; k.a_pn_step = 1024;
            k.Bt = (bf16_t*)(wsb + O_WXK); k.b_pn_mask = 15; k.b_pn_shift = 4; k.b_pn_step2 = 1024; k.C = W_KVP; k.bid0 = 128; k.nblk = 128;
            pg8::gemm_phase<12>(GEMM_LDSP, k, tidx);
        }
    }
    xcd_barrier(xb);
    {
        PH_BEGIN();
        for (int i = blockIdx.x * NTHR + tidx; i < 512 * 4096 / 4; i += gridDim.x * NTHR) {
            const int r = i >> 10, c = (i & 1023) * 4;
            const float4 a = *(const float4*)(W_KVP + (size_t)r * 4096 + c), b = *(const float4*)(W_KVP + (size_t)512 * 4096 + (size_t)r * 4096 + c);
            const float v0 = a.x + b.x, v1 = a.y + b.y, v2 = a.z + b.z, v3 = a.w + b.w;
            if (c < 2048) { uint2 o; o.x = pk2(v0, v1); o.y = pk2(v2, v3); *(uint2*)(W_KM + (size_t)r * 2048 + c) = o; }
            else { bf16_t* d = W_VMT + (size_t)(c - 2048) * 512 + r; d[0] = (bf16_t)f2bf(v0); d[512] = (bf16_t)f2bf(v1); d[1024] = (bf16_t)f2bf(v2); d[1536] = (bf16_t)f2bf(v3); }
        }
        GJOB_DEFAULT(g); g.A = W_MIXB; g.Bt = (bf16_t*)(wsb + O_WOUT); g.C = W_XR; g.R = PF(I_X); g.C2 = W_HB; g.gvec = PF(I_GCROSS); g.rssp = W_RSSP;
        pg8::gemm_phase<10>(GEMM_LDSP, g, tidx);
    }
    xcd_barrier(xb);
    {
        PH_BEGIN();
        {
            GJOB_DEFAULT(g); g.A = W_HB; g.Bt = (bf16_t*)(wsb + O_WXQ); g.C = (float*)W_QX;
            pg8::Unit u0;
            if (pg8::unit_next(g, 0, u0) && tidx < 256) { const size_t r = (size_t)u0.pm * 256 + tidx; float s = 0.f; for (int k = 0; k < 32; ++k) s += W_RSSP[r * 32 + k];
                ((LAS float*)(LAS unsigned char*)(smem_raw + GEMM_LDS + 1024 + 8192))[tidx] = rsqrtf(s * (1.0f / D) + EPS); }
            __syncthreads();
            pg8::gemm_phase<11>(GEMM_LDSP, g, tidx); __syncthreads();
        }

    }
    xcd_barrier(xb);
    {
        PH_BEGIN();
        GJOB_DEFAULT(g); g.A = W_QX; g.K = 512; g.a_pn_mask = 3; g.a_pn_step = 512; g.Bt = W_KM; g.b_pn_step = 512; g.b_pm_shift = 4; g.b_pm_step = 256 * D; g.nN = 4;
        g.C = (float*)W_PX; g.ldc = 1024; g.escale = 0.04419417382415922f * 1.4426950408889634f;
        pg8::gemm_phase<5>(GEMM_LDSP, g, tidx);
    }
    xcd_barrier(xb);
    {
        PH_BEGIN();
        GJOB_DEFAULT(g); g.A = W_PX; g.lda = 1024; g.a_pm_step = 256 * 1024; g.K = 256; g.a_pn_shift = 1; g.a_pn_mask = 3; g.a_pn_step = 256; g.Bt = W_VMT; g.ldb = 512; g.b_pn_step = 256 * 512; g.b_pm_shift = 4; g.b_pm_step = 256;
        g.C = (float*)W_MIXB;
        pg8::gemm_phase<3>(GEMM_LDSP, g, tidx);
    }
    xcd_barrier(xb);
    {
        PH_BEGIN();
        GJOB_DEFAULT(g); g.A = W_MIXB; g.Bt = (bf16_t*)(wsb + O_WXO); g.C = W_XR; g.R = W_XR; g.C2 = W_HB; g.gvec = PF(I_GFFN); g.rssp = W_RSSP;
        pg8::gemm_phase<10>(GEMM_LDSP, g, tidx);
    }
    xcd_barrier(xb);
    {
        PH_BEGIN();
        GJOB_DEFAULT(g); g.A = W_HB; g.Bt = (bf16_t*)(wsb + O_WPQ); g.C = (float*)W_QX;
        pg8::Unit u0;
        if (pg8::unit_next(g, 0, u0) && tidx < 256) { const size_t r = (size_t)u0.pm * 256 + tidx; float s = 0.f; for (int k = 0; k < 32; ++k) s += W_RSSP[r * 32 + k];
            const float rs = rsqrtf(s * (1.0f / D) + EPS);
            ((LAS float*)(LAS unsigned char*)(smem_raw + GEMM_LDS + 1024 + 8192))[tidx] = rs; W_RSTD[r] = rs; }
        __syncthreads();
        pg8::gemm_phase<11>(GEMM_LDSP, g, tidx);
    }
    xcd_barrier(xb);
    {
        PH_BEGIN();
        LAS float* wl = (LAS float*)(LAS unsigned char*)smem_raw + (tidx >> 6) * 3072;
#pragma nounroll
        for (int item = blockIdx.x * 8 + (tidx >> 6); item < 4096; item += gridDim.x * 8) peer_topk_wave(item, tidx & 63, wl, W_QX, W_SKB, W_IDS, W_GATES);
    }
    xcd_barrier(xb);
    {
        PH_BEGIN();
        const float* gf = PF(I_GFINAL); float* outp = (float*)ldp_raw(I_OUT);
#pragma nounroll
        PHASE_LOOP(T) d_peer_out8(VB, tid, sm, W_HB, W_XR, W_IDS, W_GATES, W_UT, W_VT, W_RSC, W_RSTD, gf, outp);
    }
}
}

extern "C" void kernel_launch(void* const* d_in, const int* in_sizes, int n_in, void* d_out, int out_size, void* d_ws, size_t ws_size, hipStream_t stream) {
    static int grid_blocks = 0;
    if (!grid_blocks) {
        int dev = 0, cus = 0, per_cu = 0;
        hipGetDevice(&dev);
        hipDeviceGetAttribute(&cus, hipDeviceAttributeMultiprocessorCount, dev);
        hipFuncSetAttribute((const void*)mega, hipFuncAttributeMaxDynamicSharedMemorySize, SMEM_BYTES);
        hipOccupancyMaxActiveBlocksPerMultiprocessor(&per_cu, mega, NTHR, SMEM_BYTES);
        if (per_cu > 1) per_cu = 1;
        if (per_cu < 1) per_cu = 1;
        grid_blocks = cus * per_cu;
    }
    Params P{};
    const float** pp = (const float**)&P;
    for (int i = 0; i < 25; ++i) pp[i] = (const float*)d_in[i];
    P.out = (float*)d_out;
    P.bar = (unsigned*)d_ws;
    P.ws = (float*)((char*)d_ws + 16384);
    hipMemsetAsync(d_ws, 0, 16384, stream);
    void* args[] = {&P};
    hipError_t e = hipLaunchCooperativeKernel((const void*)mega, dim3(grid_blocks), dim3(NTHR), args, SMEM_BYTES, stream);
    if (e != hipSuccess) fprintf(stderr, "cooperative launch failed: %s (grid %d)\n", hipGetErrorString(e), grid_blocks);
}
```

```cpp
#include <hip/hip_runtime.h>
#include <stdint.h>
#include <math.h>
#include <cstdio>

#define LAS_ __attribute__((address_space(3)))
namespace {
constexpr int D = 2048, NB = 2, S = 4096, T = NB * S;
constexpr int INC = 6152;
constexpr int C_MIN = 0, C_MV = 1024, C_MO = 2048, C_MI = 3072, C_MF = 3076, C_AQ = 3080, C_AK = 4104, C_AV = 5128;
constexpr float EPS = 1e-6f;
constexpr size_t P6S = (size_t)8192 * 1024;
constexpr int NTHR = 512;
constexpr int HALF_SM_FLOATS = 8704;
constexpr int GEMM_LDS = 131072;
constexpr int SMEM_BYTES = GEMM_LDS + 1024 + 8192 + 1024;
typedef unsigned short bf16_t;
__device__ __forceinline__ unsigned f2bf(float f) { unsigned u = __float_as_uint(f); u += 0x7FFFu + ((u >> 16) & 1u); return u >> 16; }
__device__ __forceinline__ unsigned pk2(float lo, float hi) { return f2bf(lo) | (f2bf(hi) << 16); }
__device__ __forceinline__ float bf2f(unsigned short b) { return __uint_as_float(((unsigned)b) << 16); }
extern __shared__ __attribute__((aligned(16))) unsigned char smem_raw[];
enum { I_X = 0, I_MEM, I_GMIX, I_WIN, I_CONVW, I_CONVB, I_WMQ, I_WMK, I_BMI, I_BMF, I_GMHEAD, I_GAHEAD, I_WOUT, I_GCROSS, I_GMEM,
       I_WXQ, I_WXK, I_WXV, I_WXO, I_GFFN, I_WPQ, I_SUBK, I_UTAB, I_VTAB, I_GFINAL, I_OUT, I_BAR, I_WS, I_NPTR };
__device__ __forceinline__ unsigned long long ldp_raw(int i) {
    const LAS_ unsigned long long* tab = (const LAS_ unsigned long long*)(LAS_ unsigned char*)(smem_raw + GEMM_LDS + 64);
    const unsigned long long v = tab[i];
    const unsigned lo = __builtin_amdgcn_readfirstlane((unsigned)v), hi = __builtin_amdgcn_readfirstlane((unsigned)(v >> 32));
    return ((unsigned long long)hi << 32) | lo;
}
#define PF(i) ((const float*)ldp_raw(i))

#define XB_TMO      128
#define XB_XCNT(j)  (256  + 64 * (j))
#define XB_XSUB(j)  (1280 + 64 * (j))
#define XB_XGEN(j)  (2304 + 64 * (j))
#define XB_TOP      3328
#define XB_TOPGEN   3392
#define XCD_BAR_WORDS 3456
#define XB_SPIN_CAP (1u << 22)
#define LAS __attribute__((address_space(3)))

__device__ __forceinline__ unsigned xb_ld(unsigned* p)              { return __hip_atomic_load(p, __ATOMIC_RELAXED, __HIP_MEMORY_SCOPE_AGENT); }
__device__ __forceinline__ unsigned xb_add(unsigned* p, unsigned v) { return __hip_atomic_fetch_add(p, v, __ATOMIC_RELAXED, __HIP_MEMORY_SCOPE_AGENT); }
__device__ __forceinline__ unsigned xb_xcc_id() { return (unsigned)__builtin_amdgcn_s_getreg((3 << 11) | 20) & 0xFu; }
#define XB_SPIN(cond, bar) do { unsigned _sp = 0; while (cond) { __builtin_amdgcn_s_sleep(1); \
    if ((++_sp & 255u) == 0u) { if (xb_ld(&(bar)[XB_TMO])) break; if (_sp > XB_SPIN_CAP) { atomicAdd(&(bar)[XB_TMO], 1u); break; } } } } while (0)

struct XcdBarrier { unsigned* bar; unsigned x; volatile LAS unsigned* st; };

__device__ __forceinline__ XcdBarrier xcd_barrier_post(unsigned* bar, volatile LAS unsigned* st) {
    XcdBarrier b; b.bar = bar; b.x = xb_xcc_id(); b.st = st;
    if (threadIdx.x == 0) (void)xb_add(&bar[XB_XCNT(b.x)], 1u);
    return b;
}
__device__ __forceinline__ void xcd_barrier_complete(unsigned* bar, unsigned x, unsigned& nloc, unsigned& nx) {
    const unsigned G = gridDim.x * gridDim.y * gridDim.z;
    unsigned sum, cnt, mine, sp = 0u;
    for (;;) {
        sum = 0u; cnt = 0u; mine = 0u;
#pragma unroll
        for (unsigned j = 0; j < 16; ++j) { const unsigned c = xb_ld(&bar[XB_XCNT(j)]); sum += c; cnt += (c > 0u) ? 1u : 0u; mine = (j == x) ? c : mine; }
        if (sum == G) break;
        __builtin_amdgcn_s_sleep(1);
        if ((++sp & 255u) == 0u) { if (xb_ld(&bar[XB_TMO])) break; if (sp > XB_SPIN_CAP) { atomicAdd(&bar[XB_TMO], 1u); break; } }
    }
    nloc = mine > 0u ? mine : 1u; nx = cnt > 0u ? cnt : 1u;
}
__device__ __forceinline__ void xcd_barrier(const XcdBarrier& b) {
    asm volatile("s_waitcnt vmcnt(0)" ::: "memory");
    __syncthreads();
    if (threadIdx.x == 0) {
        unsigned* bar = b.bar;
        __builtin_amdgcn_s_waitcnt(0);
        unsigned nloc = b.st[0], nx = b.st[1];
        if (nloc == 0u) { xcd_barrier_complete(bar, b.x, nloc, nx); b.st[0] = nloc; b.st[1] = nx; }
        const unsigned old = xb_add(&bar[XB_XSUB(b.x)], 1u);
        const unsigned gen = old / nloc;
        if (old + 1u == (gen + 1u) * nloc) {
            __builtin_amdgcn_fence(__ATOMIC_RELEASE, "agent");
            asm volatile("s_waitcnt vmcnt(0)" ::: "memory");
            const unsigned og = xb_add(&bar[XB_TOP], 1u);
            const unsigned tg = og / nx;
            if (og + 1u == (tg + 1u) * nx) xb_add(&bar[XB_TOPGEN], 1u);
            else XB_SPIN(xb_ld(&bar[XB_TOPGEN]) == tg, bar);
            __builtin_amdgcn_fence(__ATOMIC_ACQUIRE, "agent");
            xb_add(&bar[XB_XGEN(b.x)], 1u);
            asm volatile("s_waitcnt vmcnt(0)" ::: "memory");
        } else {
            XB_SPIN(xb_ld(&bar[XB_XGEN(b.x)]) == gen, bar);
            __builtin_amdgcn_fence(__ATOMIC_ACQUIRE, "agent");
            asm volatile("s_waitcnt vmcnt(0)" ::: "memory");
        }
    }
    __syncthreads();
}

__device__ __forceinline__ float wave_sum(float v) {
#pragma unroll
    for (int o = 32; o >= 1; o >>= 1) v += __shfl_xor(v, o);
    return v;
}
__device__ __forceinline__ float wave_max(float v) {
#pragma unroll
    for (int o = 32; o >= 1; o >>= 1) v = fmaxf(v, __shfl_xor(v, o));
    return v;
}
__device__ __forceinline__ float log_sigmoid(float x) { return fminf(x, 0.f) - log1pf(expf(-fabsf(x))); }


__device__ __forceinline__ void d_rmsnorm(int vb, int t, float* sm, const float* __restrict__ in, const float* __restrict__ g, bf16_t* __restrict__ out,
                                          const float* gwl  , float* __restrict__ gpre) {
    float* red = sm;
    const int row = vb;
    const float4* p = (const float4*)(in + (size_t)row * D);
    float4 a = p[t], b = p[t + 256];
    float s = a.x * a.x + a.y * a.y + a.z * a.z + a.w * a.w + b.x * b.x + b.y * b.y + b.z * b.z + b.w * b.w;
    s = wave_sum(s);
    __syncthreads();
    if ((t & 63) == 0) red[t >> 6] = s;
    __syncthreads();
    const float tot = red[0] + red[1] + red[2] + red[3];
    const float r = rsqrtf(tot * (1.0f / D) + EPS);
    const float4* gp = (const float4*)g;
    float4 ga = gp[t], gb = gp[t + 256];
    float hv[8] = {a.x * r * ga.x, a.y * r * ga.y, a.z * r * ga.z, a.w * r * ga.w, b.x * r * gb.x, b.y * r * gb.y, b.z * r * gb.z, b.w * r * gb.w};
    uint2 o0, o1;
    o0.x = pk2(hv[0], hv[1]); o0.y = pk2(hv[2], hv[3]); o1.x = pk2(hv[4], hv[5]); o1.y = pk2(hv[6], hv[7]);
    *(uint2*)(out + (size_t)row * D + t * 4) = o0;
    *(uint2*)(out + (size_t)row * D + 1024 + t * 4) = o1;
    if (gpre) {
        float gs[8];
#pragma unroll
        for (int c = 0; c < 8; ++c) gs[c] = 0.f;
#pragma unroll
        for (int j = 0; j < 8; ++j) {
            const int k = (j < 4) ? (t * 4 + j) : (1024 + t * 4 + (j - 4));
            const float4 w0 = *(const float4*)(gwl + k * 8), w1 = *(const float4*)(gwl + k * 8 + 4);
            gs[0] = fmaf(hv[j], w0.x, gs[0]); gs[1] = fmaf(hv[j], w0.y, gs[1]); gs[2] = fmaf(hv[j], w0.z, gs[2]); gs[3] = fmaf(hv[j], w0.w, gs[3]);
            gs[4] = fmaf(hv[j], w1.x, gs[4]); gs[5] = fmaf(hv[j], w1.y, gs[5]); gs[6] = fmaf(hv[j], w1.z, gs[6]); gs[7] = fmaf(hv[j], w1.w, gs[7]);
        }
#pragma unroll
        for (int c = 0; c < 8; ++c) gs[c] = wave_sum(gs[c]);
        __syncthreads();
        if ((t & 63) == 0) {
#pragma unroll
            for (int c = 0; c < 8; ++c) red[8 + (t >> 6) * 8 + c] = gs[c];
        }
        __syncthreads();
        if (t < 8) gpre[(size_t)row * 8 + t] = red[8 + t] + red[16 + t] + red[24 + t] + red[32 + t];
    }
}

namespace pg8 {
typedef short bf16x8 __attribute__((ext_vector_type(8)));
typedef float f32x4 __attribute__((ext_vector_type(4)));
constexpr int BM = 256, BK = 64, HALF = 128, HTB = HALF * BK * 2, NXCD = 8, WGM = 8;
__device__ __forceinline__ int lds_byte(int r, int c) { const int st = (r >> 4) * 2 + (c >> 5), rr = r & 15, cc = c & 31, ob = rr * 64 + cc * 2; return st * 1024 + (ob ^ (((ob >> 9) & 1) << 5)); }
__device__ __forceinline__ void stage_rc(int b, int& R, int& C) { const int st = b / 1024, sb = b % 1024, swz = sb ^ (((sb >> 9) & 1) << 5); R = (st >> 1) * 16 + swz / 64; C = (st & 1) * 32 + (swz % 64) / 2; }
struct Unit { int pm, pn; };
struct GJob {
    const bf16_t* A; const bf16_t* Bt;
    int lda, ldb, K, nM, nN;
    int a_pn_shift, a_pn_mask, a_pn_step;
    int b_pm_shift, b_pm_step, b_pn_step;
    int a_pm_step;
    int b_pn_mask, b_pn_shift, b_pn_step2;
    int bid0, nblk;
    float escale;
    const float* gs; float* denp; const float* qn; const float* gvec; const bf16_t* mo;
    bf16_t* C2; float* rssp; const float* rstd;
    float* C; int ldc; const float* R; int ldr;
    int mode;
};
__device__ __forceinline__ bool unit_next(const GJob& g, int i, Unit& u) {
    const int nwg = g.nM * g.nN;
    const int bid = (int)blockIdx.x - g.bid0; if (bid < 0 || bid >= g.nblk) return false;
    const long L = (long)i * g.nblk + bid; if (L >= nwg) return false;
    int wgid = (int)L; { const int q = nwg / NXCD, r = nwg % NXCD, xcd = wgid % NXCD, off = wgid / NXCD; wgid = (xcd < r ? xcd * (q + 1) : r * (q + 1) + (xcd - r) * q) + off; }
    const int nig = WGM * g.nN, gid = wgid / nig, fm = gid * WGM, gsz = (g.nM - fm) < WGM ? (g.nM - fm) : WGM;
    u.pm = fm + ((wgid % nig) % gsz); u.pn = (wgid % nig) / gsz; return true;
}
template <int MODE> __device__ __forceinline__ void epilogue(const GJob& g, f32x4 (&acc)[2][2][4][2], const Unit& u, int wr, int wc, int fr, int fq, LAS unsigned char* xlds) {
    const int row0 = u.pm * BM + wr * 64 + fr;
    if constexpr (MODE == 0) {
        const int col0 = u.pn * BM + wc * 32 + 4 * fq;
#pragma unroll
        for (int ai = 0; ai < 2; ++ai)
#pragma unroll
            for (int m = 0; m < 4; ++m) {
                const int row = row0 + ai * HALF + m * 16;
                float* rowp = g.C + (size_t)row * g.ldc + col0;
                const float* rp = g.R ? g.R + (size_t)row * g.ldr + col0 : nullptr;
#pragma unroll
                for (int bj = 0; bj < 2; ++bj)
#pragma unroll
                    for (int n = 0; n < 2; ++n) {
                        f32x4 v = acc[ai][bj][m][n];
                        if (rp) v = v + *(const f32x4*)(rp + bj * HALF + n * 16);
                        *(f32x4*)(rowp + bj * HALF + n * 16) = v;
                    }
            }
    } else if constexpr (MODE == 10) {
        const int col0 = u.pn * BM + wc * 32 + 4 * fq;
#pragma unroll
        for (int ai = 0; ai < 2; ++ai)
#pragma unroll
            for (int m = 0; m < 4; ++m) {
                const int row = row0 + ai * HALF + m * 16;
                float* rowp = g.C + (size_t)row * g.ldc + col0;
                const float* rp = g.R + (size_t)row * g.ldr + col0;
                bf16_t* r2 = g.C2 + (size_t)row * D + col0;
                float ss = 0.f;
#pragma unroll
                for (int bj = 0; bj < 2; ++bj)
#pragma unroll
                    for (int n = 0; n < 2; ++n) {
                        const f32x4 v = acc[ai][bj][m][n] + *(const f32x4*)(rp + bj * HALF + n * 16);
                        *(f32x4*)(rowp + bj * HALF + n * 16) = v;
                        const f32x4 gv = *(const f32x4*)(g.gvec + col0 + bj * HALF + n * 16);
                        uint2 o; o.x = pk2(v[0] * gv[0], v[1] * gv[1]); o.y = pk2(v[2] * gv[2], v[3] * gv[3]);
                        *(uint2*)(r2 + bj * HALF + n * 16) = o;
                        ss += (v[0] * v[0] + v[1] * v[1]) + (v[2] * v[2] + v[3] * v[3]);
                    }
                ss += __shfl_xor(ss, 16); ss += __shfl_xor(ss, 32);
                if (fq == 0) g.rssp[(size_t)row * 32 + u.pn * 4 + wc] = ss;
            }
    } else if constexpr (MODE == 11) {
        bf16_t* Cb = (bf16_t*)g.C;
        const int col0 = u.pn * BM + wc * 32 + 4 * fq;
#pragma unroll
        for (int ai = 0; ai < 2; ++ai)
#pragma unroll
            for (int m = 0; m < 4; ++m) {
                const int row = row0 + ai * HALF + m * 16;
                const float rs = ((const LAS float*)(xlds + 8192))[row - u.pm * BM];
                bf16_t* rowp = Cb + (size_t)row * g.ldc + col0;
#pragma unroll
                for (int bj = 0; bj < 2; ++bj)
#pragma unroll
                    for (int n = 0; n < 2; ++n) {
                        const f32x4 v = acc[ai][bj][m][n] * rs;
                        uint2 o; o.x = pk2(v[0], v[1]); o.y = pk2(v[2], v[3]);
                        *(uint2*)(rowp + bj * HALF + n * 16) = o;
                    }
            }
    } else if constexpr (MODE == 6) {
        const int h = u.pn; const size_t t0 = (size_t)u.pm * BM;
        bf16_t* Cb = (bf16_t*)g.C;
#pragma unroll
        for (int ai = 0; ai < 2; ++ai)
#pragma unroll
            for (int m = 0; m < 4; ++m) {
                const int l = ai * HALF + wr * 64 + m * 16 + fr;
                const float M2 = g.gs[((t0 + l) * 4 + h) * 8 + 1];
                bf16_t* rowp = Cb + (t0 + l) * 2048 + h * 512 + wc * 32 + 4 * fq;
                float rs = 0.f;
#pragma unroll
                for (int bj = 0; bj < 2; ++bj)
#pragma unroll
                    for (int n = 0; n < 2; ++n) {
                        const f32x4 a = acc[ai][bj][m][n];
                        const int s0 = bj * HALF + wc * 32 + n * 16 + 4 * fq;
                        float p[4];
#pragma unroll
                        for (int r = 0; r < 4; ++r) { const float u2 = g.gs[((t0 + s0 + r) * 4 + h) * 8 + 0]; p[r] = (s0 + r <= l) ? a[r] * __builtin_amdgcn_exp2f(u2 - M2) : 0.f; rs += p[r]; }
                        uint2 o; o.x = pk2(p[0], p[1]); o.y = pk2(p[2], p[3]);
                        *(uint2*)(rowp + bj * HALF + n * 16) = o;
                    }
                rs += __shfl_xor(rs, 16); rs += __shfl_xor(rs, 32);
                if (fq == 0) g.denp[((t0 + l) * 4 + h) * 4 + wc] = rs;
            }
    } else if constexpr (MODE == 12) {
        float* Ct = g.C + (size_t)(u.pn >> 4) * ((size_t)512 * 4096) + (size_t)(u.pn & 15) * 256;
        const int col0 = wc * 32 + 4 * fq;
#pragma unroll
        for (int ai = 0; ai < 2; ++ai)
#pragma unroll
            for (int m = 0; m < 4; ++m) {
                float* rowp = Ct + (size_t)(row0 + ai * HALF + m * 16) * 4096 + col0;
#pragma unroll
                for (int bj = 0; bj < 2; ++bj)
#pragma unroll
                    for (int n = 0; n < 2; ++n) *(f32x4*)(rowp + bj * HALF + n * 16) = acc[ai][bj][m][n];
            }
    } else if constexpr (MODE == 7) {
        float* Ct = g.C + (size_t)(u.pm * 4 + u.pn) * 65536;
        const int col0 = wc * 32 + 4 * fq;
#pragma unroll
        for (int ai = 0; ai < 2; ++ai)
#pragma unroll
            for (int m = 0; m < 4; ++m) {
                float* rowp = Ct + (size_t)(ai * HALF + wr * 64 + m * 16 + fr) * 256 + col0;
#pragma unroll
                for (int bj = 0; bj < 2; ++bj)
#pragma unroll
                    for (int n = 0; n < 2; ++n) *(f32x4*)(rowp + bj * HALF + n * 16) = acc[ai][bj][m][n];
            }
    } else if constexpr (MODE == 8) {
        const int h = u.pn; const size_t t0 = (size_t)u.pm * BM;
        LAS float* X0 = (LAS float*)xlds + wr * 512;
#pragma unroll
        for (int ai = 0; ai < 2; ++ai)
#pragma unroll
            for (int m = 0; m < 4; ++m) {
                const size_t th = (t0 + ai * HALF + wr * 64 + m * 16 + fr) * 4 + h;
                const f32x4 dp = *(const f32x4*)(g.denp + th * 4);
                const float den = (dp[0] + dp[1]) + (dp[2] + dp[3]) + g.gs[th * 8 + 3] * g.qn[th];
                const float rden = 1.0f / fmaxf(fabsf(den), g.gs[th * 8 + 4]);
                float ss = 0.f;
#pragma unroll
                for (int bj = 0; bj < 2; ++bj)
#pragma unroll
                    for (int n = 0; n < 2; ++n) { f32x4 a = acc[ai][bj][m][n] * rden; acc[ai][bj][m][n] = a; ss += (a[0] * a[0] + a[1] * a[1]) + (a[2] * a[2] + a[3] * a[3]); }
                ss += __shfl_xor(ss, 16); ss += __shfl_xor(ss, 32);
                if (fq == 0) X0[(ai * 64 + m * 16 + fr) * 4 + wc] = ss;
            }
        asm volatile("s_waitcnt lgkmcnt(0)" ::: "memory"); __builtin_amdgcn_s_barrier(); asm volatile("" ::: "memory");
        bf16_t* Cb = (bf16_t*)g.C;
        const int col0 = wc * 32 + 4 * fq;
#pragma unroll
        for (int ai = 0; ai < 2; ++ai)
#pragma unroll
            for (int m = 0; m < 4; ++m) {
                const f32x4 p4 = *(const LAS f32x4*)(X0 + (ai * 64 + m * 16 + fr) * 4);
                const float rsn = rsqrtf(((p4[0] + p4[1]) + (p4[2] + p4[3])) * (1.0f / 256.0f) + EPS);
                const size_t t = t0 + ai * HALF + wr * 64 + m * 16 + fr;
                bf16_t* rowp = Cb + t * 2048 + h * 256 + col0;
                const bf16_t* mop = g.mo + t * 1024 + h * 256 + col0;
#pragma unroll
                for (int bj = 0; bj < 2; ++bj)
#pragma unroll
                    for (int n = 0; n < 2; ++n) {
                        const f32x4 a = acc[ai][bj][m][n];
                        const ushort4 mo4 = *(const ushort4*)(mop + bj * HALF + n * 16);
                        const f32x4 gv = *(const f32x4*)(g.gvec + h * 256 + col0 + bj * HALF + n * 16);
                        const float o0 = a[0] * rsn * gv[0] / (1.0f + __expf(-bf2f(mo4.x)));
                        const float o1 = a[1] * rsn * gv[1] / (1.0f + __expf(-bf2f(mo4.y)));
                        const float o2 = a[2] * rsn * gv[2] / (1.0f + __expf(-bf2f(mo4.z)));
                        const float o3 = a[3] * rsn * gv[3] / (1.0f + __expf(-bf2f(mo4.w)));
                        uint2 o; o.x = pk2(o0, o1); o.y = pk2(o2, o3);
                        *(uint2*)(rowp + bj * HALF + n * 16) = o;
                    }
            }
    } else if constexpr (MODE == 5) {
        LAS float* X0 = (LAS float*)xlds + wr * 512;
        LAS float* X1 = (LAS float*)xlds + 1024 + wr * 512;
#pragma unroll
        for (int ai = 0; ai < 2; ++ai)
#pragma unroll
            for (int m = 0; m < 4; ++m) {
                float v = -INFINITY;
#pragma unroll
                for (int bj = 0; bj < 2; ++bj)
#pragma unroll
                    for (int n = 0; n < 2; ++n) { const f32x4 a = acc[ai][bj][m][n]; v = fmaxf(v, fmaxf(fmaxf(a[0], a[1]), fmaxf(a[2], a[3]))); }
                v = fmaxf(v, __shfl_xor(v, 16)); v = fmaxf(v, __shfl_xor(v, 32));
                if (fq == 0) X0[(ai * 64 + m * 16 + fr) * 4 + wc] = v;
            }
        asm volatile("s_waitcnt lgkmcnt(0)" ::: "memory"); __builtin_amdgcn_s_barrier(); asm volatile("" ::: "memory");
#pragma unroll
        for (int ai = 0; ai < 2; ++ai)
#pragma unroll
            for (int m = 0; m < 4; ++m) {
                const f32x4 p4 = *(const LAS f32x4*)(X0 + (ai * 64 + m * 16 + fr) * 4);
                const float mxr = fmaxf(fmaxf(p4[0], p4[1]), fmaxf(p4[2], p4[3])) * g.escale;
                float s = 0.f;
#pragma unroll
                for (int bj = 0; bj < 2; ++bj)
#pragma unroll
                    for (int n = 0; n < 2; ++n) { f32x4 a = acc[ai][bj][m][n];
                        a[0] = __builtin_amdgcn_exp2f(a[0] * g.escale - mxr); a[1] = __builtin_amdgcn_exp2f(a[1] * g.escale - mxr); a[2] = __builtin_amdgcn_exp2f(a[2] * g.escale - mxr); a[3] = __builtin_amdgcn_exp2f(a[3] * g.escale - mxr);
                        acc[ai][bj][m][n] = a; s += (a[0] + a[1]) + (a[2] + a[3]); }
                s += __shfl_xor(s, 16); s += __shfl_xor(s, 32);
                if (fq == 0) X1[(ai * 64 + m * 16 + fr) * 4 + wc] = s;
            }
        asm volatile("s_waitcnt lgkmcnt(0)" ::: "memory"); __builtin_amdgcn_s_barrier(); asm volatile("" ::: "memory");
        bf16_t* Cb = (bf16_t*)g.C;
        const int col0 = u.pn * BM + wc * 32 + 4 * fq;
#pragma unroll
        for (int ai = 0; ai < 2; ++ai)
#pragma unroll
            for (int m = 0; m < 4; ++m) {
                const f32x4 p4 = *(const LAS f32x4*)(X1 + (ai * 64 + m * 16 + fr) * 4);
                const float inv = 1.0f / ((p4[0] + p4[1]) + (p4[2] + p4[3]));
                bf16_t* rowp = Cb + (size_t)(row0 + ai * HALF + m * 16) * g.ldc + col0;
#pragma unroll
                for (int bj = 0; bj < 2; ++bj)
#pragma unroll
                    for (int n = 0; n < 2; ++n) {
                        const f32x4 a = acc[ai][bj][m][n];
                        uint2 o; o.x = pk2(a[0] * inv, a[1] * inv); o.y = pk2(a[2] * inv, a[3] * inv);
                        *(uint2*)(rowp + bj * HALF + n * 16) = o;
                    }
            }
    } else {
        bf16_t* Cb = (bf16_t*)g.C; int ccol = u.pn * BM;
        if constexpr (MODE == 4) { Cb += (size_t)(u.pn >> 2) * P6S; ccol = (u.pn & 3) * 256; }
        const int col0 = ccol + wc * 32 + 4 * fq;
#pragma unroll
        for (int ai = 0; ai < 2; ++ai)
#pragma unroll
            for (int m = 0; m < 4; ++m) {
                bf16_t* rowp = Cb + (size_t)(row0 + ai * HALF + m * 16) * g.ldc + col0;
#pragma unroll
                for (int bj = 0; bj < 2; ++bj)
#pragma unroll
                    for (int n = 0; n < 2; ++n) {
                        const f32x4 v = acc[ai][bj][m][n];
                        uint2 o; o.x = pk2(v[0], v[1]); o.y = pk2(v[2], v[3]);
                        *(uint2*)(rowp + bj * HALF + n * 16) = o;
                    }
            }
    }
}
template <int MODE> __device__ __forceinline__ void gemm_phase(LAS unsigned char* lds, const GJob& g, int tid) {
    const int wid = __builtin_amdgcn_readfirstlane(tid >> 6), lane = tid & 63, wr = wid >> 2, wc = wid & 3, fr = lane & 15, fq = lane >> 4;
    const int K = g.K, nt = K / BK;
    unsigned voffA[2], voffB[2];
#pragma unroll
    for (int i = 0; i < 2; ++i) { int R, C; stage_rc(tid * 16 + i * 8192, R, C);
        voffA[i] = (unsigned)(R * g.lda + C) * 2u; voffB[i] = (unsigned)(R * g.ldb + C) * 2u; }
    const size_t kstep = (size_t)(BK * 2);
    const size_t hstepA = (size_t)HALF * g.lda * 2, hstepB = (size_t)HALF * g.ldb * 2;
    const unsigned ldsw = (unsigned)wid * 1024u;
    const int aoff = lds_byte(wr * 64 + fr, fq * 8), boff = lds_byte(wc * 32 + fr, fq * 8);
#define PG8_SA(b, h) (((b) * 2 + (h)) * HTB)
#define PG8_SB(b, h) ((4 + (b) * 2 + (h)) * HTB)
#define PG8_STAGE(bufoff, gbase, voff) do { _Pragma("unroll") for (int _i = 0; _i < 2; ++_i) \
        __builtin_amdgcn_global_load_lds((const unsigned*)((const char*)(gbase) + (voff)[_i]), (LAS unsigned*)(lds + (bufoff) + ldsw + _i * 8192), 16, 0, 0); } while (0)
#define PG8_LDA(dst, b, h) do { _Pragma("unroll") for (int m = 0; m < 4; ++m) _Pragma("unroll") for (int k = 0; k < 2; ++k) dst[m][k] = *(const LAS bf16x8*)(lds + PG8_SA(b, h) + aoff + m * 2048 + k * 1024); } while (0)
#define PG8_LDB(dst, b, h) do { _Pragma("unroll") for (int n = 0; n < 2; ++n) _Pragma("unroll") for (int k = 0; k < 2; ++k) dst[n][k] = *(const LAS bf16x8*)(lds + PG8_SB(b, h) + boff + n * 2048 + k * 1024); } while (0)
#define PG8_MMA(ai, bj, At, Bt) do { __builtin_amdgcn_s_setprio(1); _Pragma("unroll") for (int m = 0; m < 4; ++m) _Pragma("unroll") for (int n = 0; n < 2; ++n) _Pragma("unroll") for (int k = 0; k < 2; ++k) \
        acc[ai][bj][m][n] = __builtin_amdgcn_mfma_f32_16x16x32_bf16(Bt[n][k], At[m][k], acc[ai][bj][m][n], 0, 0, 0); __builtin_amdgcn_s_setprio(0); } while (0)
#define PG8_WAIT_V(n) asm volatile("s_waitcnt vmcnt(" #n ")" ::: "memory")
#define PG8_WAIT_L(n) asm volatile("s_waitcnt lgkmcnt(" #n ")" ::: "memory")
#define PG8_BAR __builtin_amdgcn_s_barrier()
#define PG8_SCHED __builtin_amdgcn_sched_barrier(0)
#define PG8_ABASE(u) ((const char*)g.A + ((size_t)(u).pm * g.a_pm_step + (size_t)(((u).pn >> g.a_pn_shift) & g.a_pn_mask) * g.a_pn_step) * 2)
#define PG8_BBASE(u) ((const char*)g.Bt + ((size_t)((u).pn & g.b_pn_mask) * g.b_pn_step + (size_t)((u).pn >> g.b_pn_shift) * g.b_pn_step2 + (size_t)((u).pm >> g.b_pm_shift) * g.b_pm_step) * 2)
    Unit cur, nxt; int ui = 0;
    if (!unit_next(g, 0, cur)) return;
    f32x4 acc[2][2][4][2];
#pragma unroll
    for (int a = 0; a < 2; ++a)
#pragma unroll
        for (int b = 0; b < 2; ++b)
#pragma unroll
            for (int m = 0; m < 4; ++m)
#pragma unroll
                for (int n = 0; n < 2; ++n) acc[a][b][m][n] = (f32x4){0.f, 0.f, 0.f, 0.f};
    bf16x8 At[4][2], B0[2][2], B1[2][2];
    const char* cA = PG8_ABASE(cur); const char* cB = PG8_BBASE(cur);
    PG8_STAGE(PG8_SB(0, 0), cB, voffB); PG8_STAGE(PG8_SA(0, 0), cA, voffA); PG8_STAGE(PG8_SB(0, 1), cB + hstepB, voffB); PG8_STAGE(PG8_SA(0, 1), cA + hstepA, voffA);
    if (wr == 1) PG8_BAR;
    PG8_WAIT_V(4); PG8_BAR;
    PG8_STAGE(PG8_SB(1, 0), cB + kstep, voffB); PG8_STAGE(PG8_SA(1, 0), cA + kstep, voffA); PG8_STAGE(PG8_SB(1, 1), cB + hstepB + kstep, voffB);
    PG8_WAIT_V(6); PG8_BAR;
    for (;;) {
        const bool has_next = unit_next(g, ui + 1, nxt);
        const char* nA = has_next ? PG8_ABASE(nxt) : cA; const char* nB = has_next ? PG8_BBASE(nxt) : cB;
        for (int t = 0; t < nt; t += 2) {
            const bool last = (t == nt - 2);
            const char* a1 = cA + (size_t)(t + 1) * kstep;
            const char* a2 = last ? nA : cA + (size_t)(t + 2) * kstep; const char* b2 = last ? nB : cB + (size_t)(t + 2) * kstep;
            const char* a3 = a2 + kstep; const char* b3 = b2 + kstep;
            PG8_LDB(B0, 0, 0); PG8_SCHED; PG8_LDA(At, 0, 0); PG8_STAGE(PG8_SA(1, 1), a1 + hstepA, voffA);
            PG8_WAIT_L(8); PG8_BAR; PG8_WAIT_L(0); PG8_MMA(0, 0, At, B0); PG8_BAR; PG8_SCHED;
            PG8_LDB(B1, 0, 1); PG8_STAGE(PG8_SB(0, 0), b2, voffB);
            PG8_BAR; PG8_WAIT_L(0); PG8_MMA(0, 1, At, B1); PG8_BAR;
            PG8_LDA(At, 0, 1); PG8_STAGE(PG8_SA(0, 0), a2, voffA);
            PG8_BAR; PG8_WAIT_L(0); PG8_MMA(1, 0, At, B0); PG8_BAR; PG8_SCHED;
            PG8_STAGE(PG8_SB(0, 1), b2 + hstepB, voffB);
            PG8_WAIT_V(6); PG8_BAR; PG8_MMA(1, 1, At, B1); PG8_BAR;
            PG8_LDB(B0, 1, 0); PG8_SCHED; PG8_LDA(At, 1, 0); PG8_STAGE(PG8_SA(0, 1), a2 + hstepA, voffA);
            PG8_WAIT_L(8); PG8_BAR; PG8_WAIT_L(0); PG8_MMA(0, 0, At, B0); PG8_BAR; PG8_SCHED;
            PG8_LDB(B1, 1, 1); PG8_STAGE(PG8_SB(1, 0), b3, voffB);
            PG8_BAR; PG8_WAIT_L(0); PG8_MMA(0, 1, At, B1); PG8_BAR;
            PG8_LDA(At, 1, 1); PG8_STAGE(PG8_SA(1, 0), a3, voffA);
            PG8_BAR; PG8_WAIT_L(0); PG8_MMA(1, 0, At, B0); PG8_BAR; PG8_SCHED;
            PG8_STAGE(PG8_SB(1, 1), b3 + hstepB, voffB);
            PG8_WAIT_V(6); PG8_BAR; PG8_MMA(1, 1, At, B1); PG8_BAR;
        }
        epilogue<MODE>(g, acc, cur, wr, wc, fr, fq, lds + GEMM_LDS + 1024);
        if (!has_next) break;
#pragma unroll
        for (int a = 0; a < 2; ++a)
#pragma unroll
            for (int b = 0; b < 2; ++b)
#pragma unroll
                for (int m = 0; m < 4; ++m)
#pragma unroll
                    for (int n = 0; n < 2; ++n) acc[a][b][m][n] = (f32x4){0.f, 0.f, 0.f, 0.f};
        cur = nxt; cA = nA; cB = nB; ++ui;
    }
    PG8_WAIT_V(0);
    if (wr == 0) PG8_BAR;
    PG8_BAR;
#undef PG8_SA
#undef PG8_SB
#undef PG8_STAGE
#undef PG8_LDA
#undef PG8_LDB
#undef PG8_MMA
#undef PG8_WAIT_V
#undef PG8_WAIT_L
#undef PG8_BAR
#undef PG8_SCHED
#undef PG8_ABASE
#undef PG8_BBASE
}
}

__device__ __forceinline__ void p0_transpose_item(const float* W, int ldw, int K, int csrc0, bf16_t* WT, int row0, LAS float* scr, int kb, int lane, float wscale) {
    const int k0 = 64 * kb;
#pragma unroll
    for (int i = 0; i < 8; ++i) { const int kk = 8 * i + (lane >> 3), n4 = (lane & 7) * 4;
        const float4 v = *(const float4*)(W + (size_t)(k0 + kk) * ldw + csrc0 + n4);
        scr[kk * 33 + n4] = v.x * wscale; scr[kk * 33 + n4 + 1] = v.y * wscale; scr[kk * 33 + n4 + 2] = v.z * wscale; scr[kk * 33 + n4 + 3] = v.w * wscale; }
    asm volatile("s_waitcnt lgkmcnt(0)" ::: "memory");
    const int c = lane & 7;
#pragma unroll
    for (int j = 0; j < 4; ++j) { const int n = (lane >> 3) + 8 * j; const LAS float* s = scr + (8 * c) * 33 + n;
        uint4 o; o.x = pk2(s[0 * 33], s[1 * 33]); o.y = pk2(s[2 * 33], s[3 * 33]); o.z = pk2(s[4 * 33], s[5 * 33]); o.w = pk2(s[6 * 33], s[7 * 33]);
        *(uint4*)(WT + (size_t)(row0 + n) * K + k0 + 8 * c) = o; }
    asm volatile("s_waitcnt lgkmcnt(0)" ::: "memory");
}

__device__ __forceinline__ void d_conv_silu(int vb, int tid, const bf16_t* __restrict__ p6, const float* __restrict__ cw, const float* __restrict__ cb, bf16_t* __restrict__ c) {
    const int t = vb, s = t % S;
    for (int ch = tid; ch < 1024; ch += 256) {
        float y = cb[ch];
#pragma unroll
        for (int j = 0; j < 4; ++j) {
            const int ss = s - 3 + j;
            if (ss >= 0) y = fmaf(cw[j * 1024 + ch], bf2f(p6[(size_t)(t - 3 + j) * 1024 + ch]), y);
        }
        c[(size_t)t * 1024 + ch] = (bf16_t)f2bf(y / (1.0f + expf(-y)));
    }
}

__device__ __forceinline__ void d_mlstm(int vb, int tid, const bf16_t* __restrict__ mq, const bf16_t* __restrict__ mk, const bf16_t* __restrict__ p6,
                                        const float* __restrict__ gpre, const float* __restrict__ b_mi, const float* __restrict__ b_mf, float* __restrict__ hraw) {
    const int lane = tid & 63, w = tid >> 6;
    const int gid = vb * 4 + w;
    const int e = gid & 255, h = (gid >> 8) & 3, b = gid >> 10;
    const float bi = b_mi[h], bf = b_mf[h];
    float C0 = 0.f, C1 = 0.f, C2 = 0.f, C3 = 0.f, n0 = 0.f, n1 = 0.f, n2 = 0.f, n3 = 0.f, m = 0.f;
    const size_t tb = (size_t)b * S;
    const bf16_t* qp = mq + tb * 1024 + h * 256 + lane * 4;
    const bf16_t* kp = mk + tb * 1024 + h * 256 + lane * 4;
    const bf16_t* pp = p6 + P6S + tb * 1024 + h * 256 + e;
    ushort4 qn = *(const ushort4*)qp, kn = *(const ushort4*)kp;
    const float* gp = gpre + tb * 8;
    float vn = bf2f(pp[0]), in_ = gp[h], fn = gp[4 + h];
    for (int s = 0; s < S; ++s) {
        const float4 q = make_float4(bf2f(qn.x), bf2f(qn.y), bf2f(qn.z), bf2f(qn.w)), k = make_float4(bf2f(kn.x), bf2f(kn.y), bf2f(kn.z), bf2f(kn.w)); const float v = vn, ipre = in_ + bi, fpre = fn + bf;
        if (s + 1 < S) {
            qn = *(const ushort4*)(qp + (size_t)(s + 1) * 1024);
            kn = *(const ushort4*)(kp + (size_t)(s + 1) * 1024);
            vn = bf2f(pp[(size_t)(s + 1) * 1024]); in_ = gp[(size_t)(s + 1) * 8 + h]; fn = gp[(size_t)(s + 1) * 8 + 4 + h];
        }
        const float logf = log_sigmoid(fpre);
        const float mnew = fmaxf(logf + m, ipre);
        const float fd = expf(logf + m - mnew), ig = expf(ipre - mnew);
        m = mnew;
        const float sc = ig * 0.0625f;
        C0 = fd * C0 + sc * k.x * v; C1 = fd * C1 + sc * k.y * v; C2 = fd * C2 + sc * k.z * v; C3 = fd * C3 + sc * k.w * v;
        n0 = fd * n0 + sc * k.x; n1 = fd * n1 + sc * k.y; n2 = fd * n2 + sc * k.z; n3 = fd * n3 + sc * k.w;
        float num = q.x * C0 + q.y * C1 + q.z * C2 + q.w * C3;
        float den = q.x * n0 + q.y * n1 + q.z * n2 + q.w * n3;
        num = wave_sum(num); den = wave_sum(den);
        if (lane == 0) hraw[(tb + s) * 1024 + h * 256 + e] = num / fmaxf(fabsf(den), expf(-mnew));
    }
}

__device__ __forceinline__ void d_mhead_norm(int vb, int tid, const float* __restrict__ hraw, const bf16_t* __restrict__ p6, const float* __restrict__ g, bf16_t* __restrict__ mix) {
    const int t = vb, h = tid >> 6, lane = tid & 63;
    const float4 v = *(const float4*)(hraw + (size_t)t * 1024 + h * 256 + lane * 4);
    float s = v.x * v.x + v.y * v.y + v.z * v.z + v.w * v.w;
    s = wave_sum(s);
    const float r = rsqrtf(s * (1.0f / 256.0f) + EPS);
    const float4 gg = *(const float4*)(g + h * 256 + lane * 4);
    const ushort4 mo = *(const ushort4*)(p6 + 2 * P6S + (size_t)t * 1024 + h * 256 + lane * 4);
    float4 o;
    o.x = v.x * r * gg.x / (1.0f + expf(-bf2f(mo.x)));
    o.y = v.y * r * gg.y / (1.0f + expf(-bf2f(mo.y)));
    o.z = v.z * r * gg.z / (1.0f + expf(-bf2f(mo.z)));
    o.w = v.w * r * gg.w / (1.0f + expf(-bf2f(mo.w)));
    uint2 ob; ob.x = pk2(o.x, o.y); ob.y = pk2(o.z, o.w);
    *(uint2*)(mix + (size_t)t * D + h * 256 + lane * 4) = ob;
}

__device__ __forceinline__ void d_rope(int vb, int tid, bf16_t* __restrict__ p6) {
    const int t = vb, s = t % S;
    for (int idx = tid; idx < 2 * 8 * 64; idx += 256) {
        const int i = idx & 63, hd = (idx >> 6) & 7, qk = idx >> 9;
        const float inv = exp2f(-(float)i * 0.20762050593046014f);
        const float ang = (float)s * inv;
        float sn, cs; sincosf(ang, &sn, &cs);
        bf16_t* p = p6 + (size_t)(3 + qk) * P6S + (size_t)t * 1024 + hd * 128;
        const float x1 = bf2f(p[i]), x2 = bf2f(p[64 + i]);
        p[i] = (bf16_t)f2bf(x1 * cs - x2 * sn);
        p[64 + i] = (bf16_t)f2bf(x2 * cs + x1 * sn);
    }
}

__device__ __forceinline__ void d_dilated(int vb, int tid, float* sm, const bf16_t* __restrict__ p6, const float* __restrict__ g_ahead, bf16_t* __restrict__ mix) {
    float (*qs)[128] = (float (*)[128])sm;
    float (*ps)[576] = (float (*)[576])(sm + 512);
    const int lane = tid & 63, w = tid >> 6;
    const int gid = vb * 4 + w;
    const int s = gid % S, hd = (gid / S) & 7, b = gid / (S * 8);
    const size_t t = (size_t)b * S + s;
    const bf16_t* qrow = p6 + 3 * P6S + t * 1024 + hd * 128;
    __syncthreads();
    qs[w][lane] = bf2f(qrow[lane]); qs[w][lane + 64] = bf2f(qrow[lane + 64]);
    __syncthreads();
    const float scale = 0.08838834764831845f;
    float mloc = -INFINITY;
    for (int br = 0; br < 3; ++br) {
        const int dil = br == 0 ? 1 : (br == 1 ? 4 : 16);
        for (int jj = 0; jj < 192; jj += 64) {
            const int j = jj + lane;
            float sc = -INFINITY;
            if (j <= 128 && s - j * dil >= 0) {
                const bf16_t* krow = p6 + 4 * P6S + (t - (size_t)j * dil) * 1024 + hd * 128;
                float d = 0.f;
#pragma unroll 8
                for (int c = 0; c < 128; c += 4) {
                    const ushort4 kv = *(const ushort4*)(krow + c);
                    d = fmaf(qs[w][c], bf2f(kv.x), d); d = fmaf(qs[w][c + 1], bf2f(kv.y), d); d = fmaf(qs[w][c + 2], bf2f(kv.z), d); d = fmaf(qs[w][c + 3], bf2f(kv.w), d);
                }
                sc = d * scale;
            }
            ps[w][br * 192 + j] = sc;
            mloc = fmaxf(mloc, sc);
        }
    }
    const float mx = wave_max(mloc);
    __syncthreads();
    float lsum = 0.f;
    for (int i = lane; i < 3 * 192; i += 64) {
        const float sc = ps[w][i];
        const float pv = (sc == -INFINITY) ? 0.f : expf(sc - mx);
        ps[w][i] = pv; lsum += pv;
    }
    const float tot = wave_sum(lsum);
    __syncthreads();
    float o0 = 0.f, o1 = 0.f;
    for (int br = 0; br < 3; ++br) {
        const int dil = br == 0 ? 1 : (br == 1 ? 4 : 16);
        for (int j = 0; j <= 128; ++j) {
            if (s - j * dil < 0) break;
            const float pv = ps[w][br * 192 + j];
            const bf16_t* vrow = p6 + 5 * P6S + (t - (size_t)j * dil) * 1024 + hd * 128;
            o0 = fmaf(pv, bf2f(vrow[lane]), o0); o1 = fmaf(pv, bf2f(vrow[lane + 64]), o1);
        }
    }
    o0 /= tot; o1 /= tot;
    float ss = wave_sum(o0 * o0 + o1 * o1);
    const float r = rsqrtf(ss * (1.0f / 128.0f) + EPS);
    bf16_t* orow = mix + t * D + 1024 + hd * 128;
    orow[lane] = (bf16_t)f2bf(o0 * r * g_ahead[hd * 128 + lane]);
    orow[lane + 64] = (bf16_t)f2bf(o1 * r * g_ahead[hd * 128 + lane + 64]);
}

__device__ __forceinline__ void d_cross(int vb, int tid, float* sm, const bf16_t* __restrict__ q, const float* __restrict__ km, const float* __restrict__ vm, bf16_t* __restrict__ o) {
    float (*qs)[512] = (float (*)[512])sm;
    float (*ps)[256] = (float (*)[256])(sm + 2048);
    const int lane = tid & 63, w = tid >> 6;
    const int t = vb, hd = w, b = t / S;
    const bf16_t* qrow = q + (size_t)t * D + hd * 512;
    __syncthreads();
    for (int i = lane; i < 512; i += 64) qs[w][i] = bf2f(qrow[i]);
    __syncthreads();
    const float scale = 0.04419417382415922f;
    float sc[4]; float mloc = -INFINITY;
#pragma unroll
    for (int r = 0; r < 4; ++r) {
        const int mi = lane + 64 * r;
        const float* krow = km + ((size_t)b * 256 + mi) * D + hd * 512;
        float d = 0.f;
#pragma unroll 8
        for (int c = 0; c < 512; c += 4) {
            const float4 kv = *(const float4*)(krow + c);
            d = fmaf(qs[w][c], kv.x, d); d = fmaf(qs[w][c + 1], kv.y, d); d = fmaf(qs[w][c + 2], kv.z, d); d = fmaf(qs[w][c + 3], kv.w, d);
        }
        sc[r] = d * scale; mloc = fmaxf(mloc, sc[r]);
    }
    const float mx = wave_max(mloc);
    float lsum = 0.f;
#pragma unroll
    for (int r = 0; r < 4; ++r) { const float pv = expf(sc[r] - mx); ps[w][lane + 64 * r] = pv; lsum += pv; }
    const float tot = wave_sum(lsum);
    __syncthreads();
    float acc[8];
#pragma unroll
    for (int i = 0; i < 8; ++i) acc[i] = 0.f;
    for (int mi = 0; mi < 256; ++mi) {
        const float pv = ps[w][mi];
        const float* vrow = vm + ((size_t)b * 256 + mi) * D + hd * 512;
#pragma unroll
        for (int i = 0; i < 8; ++i) acc[i] = fmaf(pv, vrow[lane + 64 * i], acc[i]);
    }
    bf16_t* orow = o + (size_t)t * D + hd * 512;
#pragma unroll
    for (int i = 0; i < 8; ++i) orow[lane + 64 * i] = (bf16_t)f2bf(acc[i] / tot);
}

__device__ __forceinline__ void wave_argmax(float& best, int& bidx) {
#pragma unroll
    for (int o = 32; o >= 1; o >>= 1) {
        const float ob = __shfl_xor(best, o); const int oi = __shfl_xor(bidx, o);
        if (ob > best || (ob == best && oi < bidx)) { best = ob; bidx = oi; }
    }
}
__device__ __forceinline__ void d_peer_topk(int vb, int tid, float* sm, const bf16_t* __restrict__ qp, const float* __restrict__ sub_keys, int* __restrict__ ids, float* __restrict__ gates) {
    float (*qs)[256] = (float (*)[256])sm;
    const int lane = tid & 63, w = tid >> 6;
    const int gid = vb * 4 + w;
    const int hd = gid & 7, t = gid >> 3;
    const bf16_t* qrow = qp + (size_t)t * D + hd * 256;
    __syncthreads();
    for (int i = lane; i < 256; i += 64) qs[w][i] = bf2f(qrow[i]);
    __syncthreads();
    float tops[2]; int topi[2];
#pragma unroll
    for (int p = 0; p < 2; ++p) {
        float v0, v1;
        {
            const float* k0 = sub_keys + ((size_t)(hd * 2 + p) * 128 + lane) * 128;
            const float* k1 = k0 + 64 * 128;
            float d0 = 0.f, d1 = 0.f;
#pragma unroll 8
            for (int c = 0; c < 128; c += 4) {
                const float4 a = *(const float4*)(k0 + c), bb = *(const float4*)(k1 + c);
                const float q0 = qs[w][p * 128 + c], q1 = qs[w][p * 128 + c + 1], q2 = qs[w][p * 128 + c + 2], q3 = qs[w][p * 128 + c + 3];
                d0 = fmaf(q0, a.x, d0); d0 = fmaf(q1, a.y, d0); d0 = fmaf(q2, a.z, d0); d0 = fmaf(q3, a.w, d0);
                d1 = fmaf(q0, bb.x, d1); d1 = fmaf(q1, bb.y, d1); d1 = fmaf(q2, bb.z, d1); d1 = fmaf(q3, bb.w, d1);
            }
            v0 = d0; v1 = d1;
        }
        float ts = 0.f; int ti = 0;
        for (int it = 0; it < 16; ++it) {
            float best; int bidx;
            if (v0 >= v1) { best = v0; bidx = lane; } else { best = v1; bidx = lane + 64; }
            wave_argmax(best, bidx);
            if (lane == it) { ts = best; ti = bidx; }
            if (bidx == lane) v0 = -INFINITY;
            if (bidx == lane + 64) v1 = -INFINITY;
        }
        tops[p] = ts; topi[p] = ti;
    }
    float cv[4]; int ci[4];
#pragma unroll
    for (int r = 0; r < 4; ++r) {
        const int c = lane * 4 + r, i = c >> 4, j = c & 15;
        const float s0 = __shfl(tops[0], i), s1 = __shfl(tops[1], j);
        const int i0 = __shfl(topi[0], i), i1 = __shfl(topi[1], j);
        cv[r] = s0 + s1; ci[r] = i0 * 128 + i1;
    }
    float bs = 0.f; int bid = 0;
    for (int it = 0; it < 16; ++it) {
        float best = cv[0]; int bidx = lane * 4;
#pragma unroll
        for (int r = 1; r < 4; ++r) if (cv[r] > best) { best = cv[r]; bidx = lane * 4 + r; }
        wave_argmax(best, bidx);
        const int owner = bidx >> 2, rr = bidx & 3;
        int myid = ci[0];
        if (rr == 1) myid = ci[1]; else if (rr == 2) myid = ci[2]; else if (rr == 3) myid = ci[3];
        const int eid = __shfl(myid, owner);
        if (lane == it) { bs = best; bid = eid; }
        if (owner == lane) {
#pragma unroll
            for (int r = 0; r < 4; ++r) if (rr == r) cv[r] = -INFINITY;
        }
    }
    float v = lane < 16 ? bs : -INFINITY;
    const float mx = wave_max(v);
    const float ev = lane < 16 ? expf(bs - mx) : 0.f;
    const float tot = wave_sum(ev);
    if (lane < 16) {
        ids[(size_t)t * 128 + hd * 16 + lane] = bid;
        gates[(size_t)t * 128 + hd * 16 + lane] = ev / tot;
    }
}

__device__ __forceinline__ void d_peer_out(int vb, int tid, float* sm, const bf16_t* __restrict__ h3, const float* __restrict__ x2, const int* __restrict__ ids, const float* __restrict__ gates,
                                           const bf16_t* __restrict__ u_tab, const bf16_t* __restrict__ v_tab, const float* __restrict__ g_final, float* __restrict__ out) {
    float (*part)[2048] = (float (*)[2048])sm;
    float* red = sm + 4 * 2048;
    const int lane = tid & 63, w = tid >> 6, t = vb;
    float4 xr[8], acc[8];
    const bf16_t* hrow = h3 + (size_t)t * D;
#pragma unroll
    for (int i = 0; i < 8; ++i) { const ushort4 hv = *(const ushort4*)(hrow + i * 256 + lane * 4);
        xr[i] = make_float4(bf2f(hv.x), bf2f(hv.y), bf2f(hv.z), bf2f(hv.w)); acc[i] = make_float4(0.f, 0.f, 0.f, 0.f); }
    for (int j = 0; j < 32; ++j) {
        const int slot = w * 32 + j;
        const int e = ids[(size_t)t * 128 + slot];
        const float gt = gates[(size_t)t * 128 + slot];
        const bf16_t* ur = u_tab + (size_t)e * D;
        const bf16_t* vr = v_tab + (size_t)e * D;
        float d = 0.f;
#pragma unroll
        for (int i = 0; i < 8; ++i) {
            const ushort4 u = *(const ushort4*)(ur + i * 256 + lane * 4);
            d = fmaf(xr[i].x, bf2f(u.x), d); d = fmaf(xr[i].y, bf2f(u.y), d); d = fmaf(xr[i].z, bf2f(u.z), d); d = fmaf(xr[i].w, bf2f(u.w), d);
        }
        d = wave_sum(d);
        const float act = 0.5f * d * (1.0f + erff(d * 0.7071067811865476f));
        const float cf = gt * act;
#pragma unroll
        for (int i = 0; i < 8; ++i) {
            const ushort4 v = *(const ushort4*)(vr + i * 256 + lane * 4);
            acc[i].x = fmaf(cf, bf2f(v.x), acc[i].x); acc[i].y = fmaf(cf, bf2f(v.y), acc[i].y); acc[i].z = fmaf(cf, bf2f(v.z), acc[i].z); acc[i].w = fmaf(cf, bf2f(v.w), acc[i].w);
        }
    }
    __syncthreads();
#pragma unroll
    for (int i = 0; i < 8; ++i) *(float4*)&part[w][i * 256 + lane * 4] = acc[i];
    __syncthreads();
    float4 r0, r1;
    {
        const float4 a = *(const float4*)&part[0][tid * 4], b = *(const float4*)&part[1][tid * 4], c = *(const float4*)&part[2][tid * 4], d = *(const float4*)&part[3][tid * 4];
        const float4 x = *(const float4*)(x2 + (size_t)t * D + tid * 4);
        r0 = make_float4(x.x + a.x + b.x + c.x + d.x, x.y + a.y + b.y + c.y + d.y, x.z + a.z + b.z + c.z + d.z, x.w + a.w + b.w + c.w + d.w);
    }
    {
        const float4 a = *(const float4*)&part[0][1024 + tid * 4], b = *(const float4*)&part[1][1024 + tid * 4], c = *(const float4*)&part[2][1024 + tid * 4], d = *(const float4*)&part[3][1024 + tid * 4];
        const float4 x = *(const float4*)(x2 + (size_t)t * D + 1024 + tid * 4);
        r1 = make_float4(x.x + a.x + b.x + c.x + d.x, x.y + a.y + b.y + c.y + d.y, x.z + a.z + b.z + c.z + d.z, x.w + a.w + b.w + c.w + d.w);
    }
    float s = r0.x * r0.x + r0.y * r0.y + r0.z * r0.z + r0.w * r0.w + r1.x * r1.x + r1.y * r1.y + r1.z * r1.z + r1.w * r1.w;
    s = wave_sum(s);
    if (lane == 0) red[w] = s;
    __syncthreads();
    const float tot = red[0] + red[1] + red[2] + red[3];
    const float r = rsqrtf(tot * (1.0f / D) + EPS);
    const float4 g0 = *(const float4*)(g_final + tid * 4), g1 = *(const float4*)(g_final + 1024 + tid * 4);
    *(float4*)(out + (size_t)t * D + tid * 4) = make_float4(r0.x * r * g0.x, r0.y * r * g0.y, r0.z * r * g0.z, r0.w * r * g0.w);
    *(float4*)(out + (size_t)t * D + 1024 + tid * 4) = make_float4(r1.x * r * g1.x, r1.y * r * g1.y, r1.z * r * g1.z, r1.w * r * g1.w);
}


__device__ __forceinline__ float wave_incl_scan_add(float v, int lane) {
#pragma unroll
    for (int o = 1; o < 64; o <<= 1) { const float t = __shfl_up(v, o); if (lane >= o) v += t; }
    return v;
}
__device__ __forceinline__ float wave_incl_scan_max(float v, int lane) {
#pragma unroll
    for (int o = 1; o < 64; o <<= 1) { const float t = __shfl_up(v, o); if (lane >= o) v = fmaxf(v, t); }
    return v;
}
__device__ __forceinline__ void mlstm_gates_wave(int b, int h, int lane, const float* __restrict__ gpre, const float* __restrict__ b_mi, const float* __restrict__ b_mf,
                                                 float* __restrict__ gs, float* __restrict__ decay) {
    const float bi = b_mi[h], bf = b_mf[h];
    float mprev = 0.f;
    for (int c = 0; c < 16; ++c) {
        const size_t t0 = (size_t)b * S + c * 256 + lane * 4;
        float logi[4], lf[4], bb[4];
#pragma unroll
        for (int j = 0; j < 4; ++j) { logi[j] = gpre[(t0 + j) * 8 + h] + bi; lf[j] = log_sigmoid(gpre[(t0 + j) * 8 + 4 + h] + bf); }
        bb[0] = lf[0]; bb[1] = bb[0] + lf[1]; bb[2] = bb[1] + lf[2]; bb[3] = bb[2] + lf[3];
        const float incl = wave_incl_scan_add(bb[3], lane);
        const float excl = incl - bb[3];
#pragma unroll
        for (int j = 0; j < 4; ++j) bb[j] += excl;
        const float g = __shfl(incl, 63);
        float amax = -INFINITY, uu[4], cm[4];
#pragma unroll
        for (int j = 0; j < 4; ++j) { amax = fmaxf(amax, logi[j] + g - bb[j]); uu[j] = logi[j] - bb[j]; }
        amax = wave_max(amax);
        const float mnew = fmaxf(g + mprev, amax);
        cm[0] = uu[0]; cm[1] = fmaxf(cm[0], uu[1]); cm[2] = fmaxf(cm[1], uu[2]); cm[3] = fmaxf(cm[2], uu[3]);
        const float cincl = wave_incl_scan_max(cm[3], lane);
        float cexcl = __shfl_up(cincl, 1); if (lane == 0) cexcl = -INFINITY;
#pragma unroll
        for (int j = 0; j < 4; ++j) {
            const float M = fmaxf(mprev, fmaxf(cexcl, cm[j]));
            float* o = gs + ((t0 + j) * 4 + h) * 8;
            o[0] = uu[j] * 1.4426950408889634f; o[1] = M * 1.4426950408889634f; o[2] = expf(logi[j] + g - bb[j] - mnew); o[3] = expf(mprev - M); o[4] = expf(-(bb[j] + M));
        }
        if (lane == 0) decay[(b * 16 + c) * 4 + h] = expf(g + mprev - mnew);
        mprev = mnew;
    }
}
__device__ __forceinline__ void transpose_tile64(int tid, float* sm, const bf16_t* __restrict__ src, int src_ld, bf16_t* __restrict__ dst, int dst_ld, const float* __restrict__ scale, int sstride) {
    unsigned short (*tl)[66] = (unsigned short (*)[66])sm;
    __syncthreads();
#pragma unroll
    for (int i = 0; i < 2; ++i) {
        const int ch = tid + i * 256, r = ch >> 3, c8 = (ch & 7) * 8;
        const uint4 v = *(const uint4*)(src + (size_t)r * src_ld + c8);
        const float sc = scale ? scale[(size_t)r * sstride] : 1.0f;
        const unsigned w[4] = {v.x, v.y, v.z, v.w};
#pragma unroll
        for (int k = 0; k < 4; ++k) {
            tl[r][c8 + 2 * k] = (unsigned short)f2bf(bf2f((unsigned short)(w[k] & 0xFFFFu)) * sc);
            tl[r][c8 + 2 * k + 1] = (unsigned short)f2bf(bf2f((unsigned short)(w[k] >> 16)) * sc);
        }
    }
    __syncthreads();
#pragma unroll
    for (int i = 0; i < 2; ++i) {
        const int ch = tid + i * 256, c = ch >> 3, r8 = (ch & 7) * 8;
        uint4 o;
        o.x = (unsigned)tl[r8 + 0][c] | ((unsigned)tl[r8 + 1][c] << 16); o.y = (unsigned)tl[r8 + 2][c] | ((unsigned)tl[r8 + 3][c] << 16);
        o.z = (unsigned)tl[r8 + 4][c] | ((unsigned)tl[r8 + 5][c] << 16); o.w = (unsigned)tl[r8 + 6][c] | ((unsigned)tl[r8 + 7][c] << 16);
        *(uint4*)(dst + (size_t)c * dst_ld + r8) = o;
    }
}

__device__ __forceinline__ void rope_table_fill(float2* __restrict__ cs, int gtid, int nth) {
    for (int idx = gtid; idx < 4096 * 64; idx += nth) {
        const int i = idx & 63, s = idx >> 6;
        const float inv = exp2f(-(float)i * 0.20762050593046014f);
        const float ang = (float)s * inv;
        float sn, c; sincosf(ang, &sn, &c);
        cs[idx] = make_float2(c, sn);
    }
}
__device__ __forceinline__ void rope_q_pass(bf16_t* __restrict__ aq, const float2* __restrict__ cs, size_t gtid, size_t nth) {
    for (size_t idx = gtid; idx < (size_t)T * 8 * 8; idx += nth) {
        const int c8 = (int)(idx & 7), hd = (int)((idx >> 3) & 7); const size_t t = idx >> 6; const int s = (int)(t & (S - 1));
        bf16_t* p = aq + t * 1024 + hd * 128 + c8 * 8;
        const uint4 a = *(const uint4*)p, b = *(const uint4*)(p + 64);
        const unsigned aw[4] = {a.x, a.y, a.z, a.w}, bw[4] = {b.x, b.y, b.z, b.w};
        unsigned ao[4], bo[4];
#pragma unroll
        for (int k = 0; k < 4; ++k) {
            const float4 cc = *(const float4*)(cs + (size_t)s * 64 + c8 * 8 + 2 * k);
            const float x10 = __uint_as_float(aw[k] << 16), x11 = __uint_as_float(aw[k] & 0xFFFF0000u), x20 = __uint_as_float(bw[k] << 16), x21 = __uint_as_float(bw[k] & 0xFFFF0000u);
            ao[k] = pk2(x10 * cc.x - x20 * cc.y, x11 * cc.z - x21 * cc.w);
            bo[k] = pk2(x20 * cc.x + x10 * cc.y, x21 * cc.z + x11 * cc.w);
        }
        *(uint4*)p = make_uint4(ao[0], ao[1], ao[2], ao[3]); *(uint4*)(p + 64) = make_uint4(bo[0], bo[1], bo[2], bo[3]);
    }
}
__device__ __forceinline__ void dil_tile_prep(int item, int lane, LAS unsigned short* wl, const bf16_t* __restrict__ ak, const bf16_t* __restrict__ av, const float2* __restrict__ cs,
                                              bf16_t* __restrict__ KB, bf16_t* __restrict__ VB) {
    const int TT = item & 255, hd = (item >> 8) & 7, b = (item >> 11) & 1, br = item >> 12;
    const int ld = 2 * br, tpr = 256 >> ld, rho = TT / tpr, tile = TT - rho * tpr;
    const int i = lane & 15, c = lane >> 4;
    const int s = rho + ((16 * tile + i) << ld);
    const size_t trow = (size_t)b * S + s;
    bf16_t* kdst = KB + (size_t)item * 2048;
    bf16_t* vdst = VB + (size_t)item * 2048;
    {
        const bf16_t* kr = ak + trow * 1024 + hd * 128 + 16 * c;
        const uint4 a0 = *(const uint4*)kr, a1 = *(const uint4*)(kr + 8), b0 = *(const uint4*)(kr + 64), b1 = *(const uint4*)(kr + 72);
        const unsigned aw[8] = {a0.x, a0.y, a0.z, a0.w, a1.x, a1.y, a1.z, a1.w}, bw[8] = {b0.x, b0.y, b0.z, b0.w, b1.x, b1.y, b1.z, b1.w};
        unsigned ao[8], bo[8];
#pragma unroll
        for (int k = 0; k < 8; ++k) {
            const float4 cc = *(const float4*)(cs + (size_t)s * 64 + 16 * c + 2 * k);
            const float x10 = __uint_as_float(aw[k] << 16), x11 = __uint_as_float(aw[k] & 0xFFFF0000u), x20 = __uint_as_float(bw[k] << 16), x21 = __uint_as_float(bw[k] & 0xFFFF0000u);
            ao[k] = pk2(x10 * cc.x - x20 * cc.y, x11 * cc.z - x21 * cc.w);
            bo[k] = pk2(x20 * cc.x + x10 * cc.y, x21 * cc.z + x11 * cc.w);
        }
        bf16_t* d0 = kdst + (c >> 1) * 512 + i * 32 + (c & 1) * 16;
        *(uint4*)d0 = make_uint4(ao[0], ao[1], ao[2], ao[3]); *(uint4*)(d0 + 8) = make_uint4(ao[4], ao[5], ao[6], ao[7]);
        bf16_t* d1 = d0 + 1024;
        *(uint4*)d1 = make_uint4(bo[0], bo[1], bo[2], bo[3]); *(uint4*)(d1 + 8) = make_uint4(bo[4], bo[5], bo[6], bo[7]);
    }
    {
        const bf16_t* vr = av + trow * 1024 + hd * 128 + 32 * c;
        const uint4 v0 = *(const uint4*)vr, v1 = *(const uint4*)(vr + 8), v2 = *(const uint4*)(vr + 16), v3 = *(const uint4*)(vr + 24);
        LAS unsigned short* wr = wl + i * 136 + 32 * c;
        typedef unsigned u32x4_t __attribute__((ext_vector_type(4)));
        *(LAS u32x4_t*)wr = (u32x4_t){v0.x, v0.y, v0.z, v0.w}; *(LAS u32x4_t*)(wr + 8) = (u32x4_t){v1.x, v1.y, v1.z, v1.w};
        *(LAS u32x4_t*)(wr + 16) = (u32x4_t){v2.x, v2.y, v2.z, v2.w}; *(LAS u32x4_t*)(wr + 24) = (u32x4_t){v3.x, v3.y, v3.z, v3.w};
        asm volatile("s_waitcnt lgkmcnt(0)" ::: "memory");
        unsigned o[16];
#pragma unroll
        for (int k = 0; k < 8; ++k) {
            const unsigned p0 = *(const LAS unsigned*)(wl + (2 * k) * 136 + 2 * lane), p1 = *(const LAS unsigned*)(wl + (2 * k + 1) * 136 + 2 * lane);
            o[k] = (p0 & 0xFFFFu) | (p1 << 16);
            o[8 + k] = (p0 >> 16) | (p1 & 0xFFFF0000u);
        }
        bf16_t* d = vdst + (2 * lane) * 16;
        *(uint4*)d = make_uint4(o[0], o[1], o[2], o[3]); *(uint4*)(d + 8) = make_uint4(o[4], o[5], o[6], o[7]);
        *(uint4*)(d + 16) = make_uint4(o[8], o[9], o[10], o[11]); *(uint4*)(d + 24) = make_uint4(o[12], o[13], o[14], o[15]);
        asm volatile("s_waitcnt lgkmcnt(0)" ::: "memory");
    }
}

typedef short bf16x8_t __attribute__((ext_vector_type(8)));
typedef short bf16x4_t __attribute__((ext_vector_type(4)));
typedef float f32x4_t __attribute__((ext_vector_type(4)));
__device__ __forceinline__ void dilated_wave_tile(int qt, int lane, const bf16_t* __restrict__ AQ, const bf16_t* __restrict__ KB, const bf16_t* __restrict__ VB,
                                                  const float* __restrict__ g_ahead, bf16_t* __restrict__ mix) {
    const int r = qt & 15, blk = (qt >> 4) & 15, hd = (qt >> 8) & 7, b = qt >> 11;
    const int j = lane & 15, g = lane >> 4;
    const int t0 = blk * 256;
    const int sq = t0 + r + 16 * j;
    bf16x8_t qf[4];
    {
        const bf16_t* qrow = AQ + ((size_t)b * S + sq) * 1024 + hd * 128 + 8 * g;
#pragma unroll
        for (int ks = 0; ks < 4; ++ks) qf[ks] = *(const bf16x8_t*)(qrow + 32 * ks);
    }
    const float sc = 0.08838834764831845f * 1.4426950408889634f;
    float m_run = -1e30f, l_run = 0.f;
    f32x4_t o[8];
#pragma unroll
    for (int dt = 0; dt < 8; ++dt) o[dt] = (f32x4_t){0.f, 0.f, 0.f, 0.f};
#pragma nounroll
    for (int br = 0; br < 3; ++br) {
        const int ld = 2 * br, d = 1 << ld;
        const int rho = r & (d - 1);
        const int qj = (sq - rho) >> ld;
        const int q_lo = ((t0 + r - rho) >> ld) - 128, q_hi = (t0 + r + 240 - rho) >> ld;
        const int tile_lo = q_lo < 0 ? 0 : (q_lo >> 4), tile_hi = q_hi >> 4, tile_max = (256 >> ld) - 1;
        const size_t tbase = ((size_t)((br * 2 + b) * 8 + hd) * 256 + (size_t)rho * (256 >> ld)) * 2048;
        const bf16_t* kbb = KB + tbase + j * 32 + 8 * g;
        const bf16_t* vbb = VB + tbase + j * 16 + 4 * g;
#pragma nounroll
        for (int tp = tile_lo; tp <= tile_hi; tp += 2) {
            f32x4_t su[2];
#pragma unroll
            for (int u = 0; u < 2; ++u) {
                int tl = tp + u; if (tl > tile_max) tl = tile_max;
                const bf16_t* krow = kbb + (size_t)tl * 2048;
                f32x4_t a = (f32x4_t){0.f, 0.f, 0.f, 0.f};
#pragma unroll
                for (int ks = 0; ks < 4; ++ks) a = __builtin_amdgcn_mfma_f32_16x16x32_bf16(*(const bf16x8_t*)(krow + 512 * ks), qf[ks], a, 0, 0, 0);
                su[u] = a;
            }
            float p[2][4]; float mx = -1e30f;
#pragma unroll
            for (int u = 0; u < 2; ++u)
#pragma unroll
                for (int e = 0; e < 4; ++e) {
                    const int n = qj - (16 * (tp + u) + 4 * g + e);
                    const bool valid = (n >= 0) && (n <= 128);
                    p[u][e] = valid ? su[u][e] * sc : -1e30f;
                    mx = fmaxf(mx, p[u][e]);
                }
            mx = fmaxf(mx, __shfl_xor(mx, 16)); mx = fmaxf(mx, __shfl_xor(mx, 32));
            const float m_new = fmaxf(m_run, mx);
            const float alpha = __builtin_amdgcn_exp2f(m_run - m_new);
            m_run = m_new;
            float ps = 0.f;
#pragma unroll
            for (int u = 0; u < 2; ++u)
#pragma unroll
                for (int e = 0; e < 4; ++e) { p[u][e] = (p[u][e] > -1e29f) ? __builtin_amdgcn_exp2f(p[u][e] - m_new) : 0.f; ps += p[u][e]; }
            l_run = l_run * alpha + ps;
            bf16x8_t pb;
            {
                const unsigned w0 = pk2(p[0][0], p[0][1]), w1 = pk2(p[0][2], p[0][3]), w2 = pk2(p[1][0], p[1][1]), w3 = pk2(p[1][2], p[1][3]);
                pb[0] = (short)(w0 & 0xFFFF); pb[1] = (short)(w0 >> 16); pb[2] = (short)(w1 & 0xFFFF); pb[3] = (short)(w1 >> 16);
                pb[4] = (short)(w2 & 0xFFFF); pb[5] = (short)(w2 >> 16); pb[6] = (short)(w3 & 0xFFFF); pb[7] = (short)(w3 >> 16);
            }
            int tl0 = tp, tl1 = tp + 1; if (tl0 > tile_max) tl0 = tile_max; if (tl1 > tile_max) tl1 = tile_max;
#pragma unroll
            for (int dt = 0; dt < 8; ++dt) {
                const bf16_t* vrow = vbb + dt * 256;
                const bf16x4_t v0 = *(const bf16x4_t*)(vrow + (size_t)tl0 * 2048), v1 = *(const bf16x4_t*)(vrow + (size_t)tl1 * 2048);
                bf16x8_t va; va[0] = v0[0]; va[1] = v0[1]; va[2] = v0[2]; va[3] = v0[3]; va[4] = v1[0]; va[5] = v1[1]; va[6] = v1[2]; va[7] = v1[3];
                f32x4_t oo = o[dt]; oo = oo * alpha;
                o[dt] = __builtin_amdgcn_mfma_f32_16x16x32_bf16(va, pb, oo, 0, 0, 0);
            }
        }
    }
    float lt = l_run; lt += __shfl_xor(lt, 16); lt += __shfl_xor(lt, 32);
    const float inv = 1.0f / lt;
    float ss = 0.f;
#pragma unroll
    for (int dt = 0; dt < 8; ++dt) { o[dt] = o[dt] * inv; ss += (o[dt][0] * o[dt][0] + o[dt][1] * o[dt][1]) + (o[dt][2] * o[dt][2] + o[dt][3] * o[dt][3]); }
    ss += __shfl_xor(ss, 16); ss += __shfl_xor(ss, 32);
    const float rn = rsqrtf(ss * (1.0f / 128.0f) + EPS);
    bf16_t* orow = mix + ((size_t)b * S + sq) * D + 1024 + hd * 128 + 4 * g;
#pragma unroll
    for (int dt = 0; dt < 8; ++dt) {
        const f32x4_t gv = *(const f32x4_t*)(g_ahead + hd * 128 + 16 * dt + 4 * g);
        uint2 w; w.x = pk2(o[dt][0] * rn * gv[0], o[dt][1] * rn * gv[1]); w.y = pk2(o[dt][2] * rn * gv[2], o[dt][3] * rn * gv[3]);
        *(uint2*)(orow + 16 * dt) = w;
    }
}

__device__ __forceinline__ unsigned ord_key(float s) { const unsigned u = __float_as_uint(s); return u ^ ((unsigned)((int)u >> 31) | 0x80000000u); }
__device__ __forceinline__ unsigned wave_max_u32(unsigned v) {
    unsigned t;
    t = (unsigned)__builtin_amdgcn_update_dpp(0, (int)v, 0xB1, 0xF, 0xF, true); v = v > t ? v : t;
    t = (unsigned)__builtin_amdgcn_update_dpp(0, (int)v, 0x4E, 0xF, 0xF, true); v = v > t ? v : t;
    t = (unsigned)__builtin_amdgcn_update_dpp(0, (int)v, 0x141, 0xF, 0xF, true); v = v > t ? v : t;
    t = (unsigned)__builtin_amdgcn_update_dpp(0, (int)v, 0x140, 0xF, 0xF, true); v = v > t ? v : t;
    const unsigned a = (unsigned)__builtin_amdgcn_readlane((int)v, 0), b = (unsigned)__builtin_amdgcn_readlane((int)v, 16),
                   c = (unsigned)__builtin_amdgcn_readlane((int)v, 32), d = (unsigned)__builtin_amdgcn_readlane((int)v, 48);
    const unsigned ab = a > b ? a : b, cd = c > d ? c : d;
    return ab > cd ? ab : cd;
}
__device__ __forceinline__ void peer_topk_wave(int item, int lane, LAS float* wl, const bf16_t* __restrict__ qp, const bf16_t* __restrict__ skb, int* __restrict__ ids, float* __restrict__ gates) {
    const int hd = item & 7, tt = item >> 3, j = lane & 15, g = lane >> 4;
    const size_t t0 = (size_t)tt * 16;
    LAS float* sc = wl;
    LAS float* lst = wl + 2048;
#pragma unroll 1
    for (int p = 0; p < 2; ++p) {
        bf16x8_t qf[4];
        const bf16_t* qrow = qp + (t0 + j) * D + hd * 256 + p * 128 + 8 * g;
#pragma unroll
        for (int ks = 0; ks < 4; ++ks) qf[ks] = *(const bf16x8_t*)(qrow + 32 * ks);
        const bf16_t* kb = skb + ((size_t)(hd * 2 + p) * 128 + j) * 128 + 8 * g;
#pragma unroll
        for (int kt = 0; kt < 8; ++kt) {
            f32x4_t a = (f32x4_t){0.f, 0.f, 0.f, 0.f};
#pragma unroll
            for (int ks = 0; ks < 4; ++ks) a = __builtin_amdgcn_mfma_f32_16x16x32_bf16(*(const bf16x8_t*)(kb + (size_t)kt * (16 * 128) + 32 * ks), qf[ks], a, 0, 0, 0);
            *(LAS f32x4_t*)(sc + j * 128 + 16 * kt + 4 * g) = a;
        }
        asm volatile("s_waitcnt lgkmcnt(0)" ::: "memory");
#pragma unroll 1
        for (int tok = 0; tok < 16; ++tok) {
            const float s0 = sc[tok * 128 + lane], s1 = sc[tok * 128 + 64 + lane];
            unsigned k0 = (ord_key(s0) & ~127u) | (unsigned)(127 - lane), k1 = (ord_key(s1) & ~127u) | (unsigned)(63 - lane);
            unsigned sel = 0u;
#pragma unroll 4
            for (int it = 0; it < 16; ++it) {
                unsigned m = k0 > k1 ? k0 : k1;
                m = wave_max_u32(m);
                if (lane == it) sel = m;
                if (k0 == m) k0 = 0u;
                if (k1 == m) k1 = 0u;
            }
            if (lane < 16) {
                const int idx = 127 - (int)(sel & 127u);
                lst[((p * 16 + tok) * 16 + lane) * 2 + 0] = sc[tok * 128 + idx];
                lst[((p * 16 + tok) * 16 + lane) * 2 + 1] = __int_as_float(idx);
            }
        }
        asm volatile("s_waitcnt lgkmcnt(0)" ::: "memory");
    }
#pragma unroll 1
    for (int tok = 0; tok < 16; ++tok) {
        const int i = lane >> 2;
        const float sA = lst[((0 * 16 + tok) * 16 + i) * 2];
        unsigned kk[4];
#pragma unroll
        for (int r = 0; r < 4; ++r) {
            const int jb = (lane & 3) * 4 + r;
            const float sum = sA + lst[((1 * 16 + tok) * 16 + jb) * 2];
            kk[r] = (ord_key(sum) & ~255u) | (unsigned)(255 - (lane * 4 + r));
        }
        unsigned sel = 0u;
#pragma unroll 4
        for (int it = 0; it < 16; ++it) {
            unsigned m = kk[0] > kk[1] ? kk[0] : kk[1]; const unsigned m2 = kk[2] > kk[3] ? kk[2] : kk[3]; m = m > m2 ? m : m2;
            m = wave_max_u32(m);
            if (lane == it) sel = m;
#pragma unroll
            for (int r = 0; r < 4; ++r) if (kk[r] == m) kk[r] = 0u;
        }
        float bs = -INFINITY; int eid = 0;
        if (lane < 16) {
            const int c = 255 - (int)(sel & 255u), ia = c >> 4, ib = c & 15;
            bs = lst[((0 * 16 + tok) * 16 + ia) * 2] + lst[((1 * 16 + tok) * 16 + ib) * 2];
            eid = __float_as_int(lst[((0 * 16 + tok) * 16 + ia) * 2 + 1]) * 128 + __float_as_int(lst[((1 * 16 + tok) * 16 + ib) * 2 + 1]);
        }
        const float mx = wave_max(bs);
        const float ev = lane < 16 ? __expf(bs - mx) : 0.f;
        const float tot = wave_sum(ev);
        if (lane < 16) {
            ids[(t0 + tok) * 128 + hd * 16 + lane] = eid;
            gates[(t0 + tok) * 128 + hd * 16 + lane] = ev / tot;
        }
    }
}

typedef float f32x2_t __attribute__((ext_vector_type(2)));
__device__ __forceinline__ void table_row_to_fp8(const float* __restrict__ srow, unsigned char* __restrict__ drow, float* __restrict__ rscale, int lane) {
    float4 f[8];
#pragma unroll
    for (int i = 0; i < 8; ++i) f[i] = *(const float4*)(srow + i * 256 + lane * 4);
    float am = 0.f;
#pragma unroll
    for (int i = 0; i < 8; ++i) am = fmaxf(am, fmaxf(fmaxf(fabsf(f[i].x), fabsf(f[i].y)), fmaxf(fabsf(f[i].z), fabsf(f[i].w))));
    am = wave_max(am);
    const float e = floorf(log2f(448.0f / fmaxf(am, 1e-30f)));
    const float s = exp2f(fminf(e, 100.0f));
    unsigned w[8];
#pragma unroll
    for (int i = 0; i < 8; ++i) {
        int t = 0;
        t = __builtin_amdgcn_cvt_pk_fp8_f32(f[i].x * s, f[i].y * s, t, false);
        t = __builtin_amdgcn_cvt_pk_fp8_f32(f[i].z * s, f[i].w * s, t, true);
        w[i] = (unsigned)t;
    }
#pragma unroll
    for (int i = 0; i < 8; ++i) *(unsigned*)(drow + i * 256 + lane * 4) = w[i];
    if (lane == 0) *rscale = 1.0f / s;
}
__device__ __forceinline__ float dot16_fp8(const uint4 q, const float* x) {
    float d = 0.f;
    const unsigned w[4] = {q.x, q.y, q.z, q.w};
#pragma unroll
    for (int k = 0; k < 4; ++k) {
        const f32x2_t lo = __builtin_amdgcn_cvt_pk_f32_fp8((int)w[k], false), hi = __builtin_amdgcn_cvt_pk_f32_fp8((int)w[k], true);
        d = fmaf(lo.x, x[4 * k], d); d = fmaf(lo.y, x[4 * k + 1], d); d = fmaf(hi.x, x[4 * k + 2], d); d = fmaf(hi.y, x[4 * k + 3], d);
    }
    return d;
}
__device__ __forceinline__ void axpy16_fp8(const uint4 q, float c, float* acc) {
    const unsigned w[4] = {q.x, q.y, q.z, q.w};
#pragma unroll
    for (int k = 0; k < 4; ++k) {
        const f32x2_t lo = __builtin_amdgcn_cvt_pk_f32_fp8((int)w[k], false), hi = __builtin_amdgcn_cvt_pk_f32_fp8((int)w[k], true);
        acc[4 * k] = fmaf(c, lo.x, acc[4 * k]); acc[4 * k + 1] = fmaf(c, lo.y, acc[4 * k + 1]); acc[4 * k + 2] = fmaf(c, hi.x, acc[4 * k + 2]); acc[4 * k + 3] = fmaf(c, hi.y, acc[4 * k + 3]);
    }
}
__device__ __forceinline__ void d_peer_out8(int vb, int tid, float* sm, const bf16_t* __restrict__ h3, const float* __restrict__ x2, const int* __restrict__ ids, const float* __restrict__ gates,
                                            const unsigned char* __restrict__ ut8, const unsigned char* __restrict__ vt8, const float* __restrict__ rsc, const float* __restrict__ rstd, const float* __restrict__ g_final, float* __restrict__ out) {
    float (*part)[2048] = (float (*)[2048])sm;
    float* red = sm + 4 * 2048;
    const int lane = tid & 63, w = tid >> 6, t = vb;
    float x[32], acc[32];
    {
        const bf16_t* hrow = h3 + (size_t)t * D + lane * 16;
#pragma unroll
        for (int hh = 0; hh < 2; ++hh) {
            const uint4 a = *(const uint4*)(hrow + hh * 1024), b = *(const uint4*)(hrow + hh * 1024 + 8);
            const unsigned ww[8] = {a.x, a.y, a.z, a.w, b.x, b.y, b.z, b.w};
#pragma unroll
            for (int k = 0; k < 8; ++k) { x[hh * 16 + 2 * k] = __uint_as_float(ww[k] << 16); x[hh * 16 + 2 * k + 1] = __uint_as_float(ww[k] & 0xFFFF0000u); }
        }
#pragma unroll
        for (int i = 0; i < 32; ++i) acc[i] = 0.f;
    }
    const float xrs = rstd[t];
    const int myid = ids[(size_t)t * 128 + w * 32 + (lane & 31)];
    const float mygate = gates[(size_t)t * 128 + w * 32 + (lane & 31)];
#pragma unroll 1
    for (int j = 0; j < 32; j += 4) {
        int e[4]; uint4 uq[4][2], vq[4][2];
#pragma unroll
        for (int q = 0; q < 4; ++q) {
            e[q] = __builtin_amdgcn_readfirstlane(__shfl(myid, j + q));
            const unsigned char* ur = ut8 + (size_t)e[q] * 2048 + lane * 16;
            uq[q][0] = *(const uint4*)ur; uq[q][1] = *(const uint4*)(ur + 1024);
        }
#pragma unroll
        for (int q = 0; q < 4; ++q) {
            const unsigned char* vr = vt8 + (size_t)e[q] * 2048 + lane * 16;
            vq[q][0] = *(const uint4*)vr; vq[q][1] = *(const uint4*)(vr + 1024);
        }
        float d[4];
#pragma unroll
        for (int q = 0; q < 4; ++q) d[q] = dot16_fp8(uq[q][0], x) + dot16_fp8(uq[q][1], x + 16);
#pragma unroll
        for (int o = 32; o >= 1; o >>= 1) {
#pragma unroll
            for (int q = 0; q < 4; ++q) d[q] += __shfl_xor(d[q], o);
        }
#pragma unroll
        for (int q = 0; q < 4; ++q) {
            const float a = d[q] * rsc[e[q]] * xrs;
            const float act = 0.5f * a * (1.0f + erff(a * 0.7071067811865476f));
            const float cf = __shfl(mygate, j + q) * act * rsc[16384 + e[q]];
            axpy16_fp8(vq[q][0], cf, acc); axpy16_fp8(vq[q][1], cf, acc + 16);
        }
    }
    __syncthreads();
#pragma unroll
    for (int hh = 0; hh < 2; ++hh)
#pragma unroll
        for (int k = 0; k < 4; ++k) *(float4*)&part[w][hh * 1024 + lane * 16 + 4 * k] = make_float4(acc[hh * 16 + 4 * k], acc[hh * 16 + 4 * k + 1], acc[hh * 16 + 4 * k + 2], acc[hh * 16 + 4 * k + 3]);
    __syncthreads();
    float4 r0, r1;
    {
        const float4 a = *(const float4*)&part[0][tid * 4], b = *(const float4*)&part[1][tid * 4], c = *(const float4*)&part[2][tid * 4], dd = *(const float4*)&part[3][tid * 4];
        const float4 xx = *(const float4*)(x2 + (size_t)t * D + tid * 4);
        r0 = make_float4(xx.x + a.x + b.x + c.x + dd.x, xx.y + a.y + b.y + c.y + dd.y, xx.z + a.z + b.z + c.z + dd.z, xx.w + a.w + b.w + c.w + dd.w);
    }
    {
        const float4 a = *(const float4*)&part[0][1024 + tid * 4], b = *(const float4*)&part[1][1024 + tid * 4], c = *(const float4*)&part[2][1024 + tid * 4], dd = *(const float4*)&part[3][1024 + tid * 4];
        const float4 xx = *(const float4*)(x2 + (size_t)t * D + 1024 + tid * 4);
        r1 = make_float4(xx.x + a.x + b.x + c.x + dd.x, xx.y + a.y + b.y + c.y + dd.y, xx.z + a.z + b.z + c.z + dd.z, xx.w + a.w + b.w + c.w + dd.w);
    }
    float s = r0.x * r0.x + r0.y * r0.y + r0.z * r0.z + r0.w * r0.w + r1.x * r1.x + r1.y * r1.y + r1.z * r1.z + r1.w * r1.w;
    s = wave_sum(s);
    if (lane == 0) red[w] = s;
    __syncthreads();
    const float tot = red[0] + red[1] + red[2] + red[3];
    const float r = rsqrtf(tot * (1.0f / D) + EPS);
    const float4 g0 = *(const float4*)(g_final + tid * 4), g1 = *(const float4*)(g_final + 1024 + tid * 4);
    *(float4*)(out + (size_t)t * D + tid * 4) = make_float4(r0.x * r * g0.x, r0.y * r * g0.y, r0.z * r * g0.z, r0.w * r * g0.w);
    *(float4*)(out + (size_t)t * D + 1024 + tid * 4) = make_float4(r1.x * r * g1.x, r1.y * r * g1.y, r1.z * r * g1.z, r1.w * r * g1.w);
}

__device__ __forceinline__ unsigned xg_sum_u32(unsigned v) {
    auto a = __builtin_amdgcn_permlane16_swap(v, v, false, false); v = a[0] + a[1];
    auto b = __builtin_amdgcn_permlane32_swap(v, v, false, false); return b[0] + b[1];
}
__device__ __forceinline__ float xg_sum_f32(float v) {
    auto a = __builtin_amdgcn_permlane16_swap(__float_as_uint(v), __float_as_uint(v), false, false); v = __uint_as_float(a[0]) + __uint_as_float(a[1]);
    auto b = __builtin_amdgcn_permlane32_swap(__float_as_uint(v), __float_as_uint(v), false, false); return __uint_as_float(b[0]) + __uint_as_float(b[1]);
}
__device__ __forceinline__ float xg_max_f32(float v) {
    auto a = __builtin_amdgcn_permlane16_swap(__float_as_uint(v), __float_as_uint(v), false, false); v = fmaxf(__uint_as_float(a[0]), __uint_as_float(a[1]));
    auto b = __builtin_amdgcn_permlane32_swap(__float_as_uint(v), __float_as_uint(v), false, false); return fmaxf(__uint_as_float(b[0]), __uint_as_float(b[1]));
}
template <int N> __device__ __forceinline__ unsigned bisect16(const unsigned (&kk)[N]) {
    unsigned tau = 0u; bool done = false;
#pragma unroll 1
    for (int bit = 31; bit >= 0; --bit) {
        const unsigned cand = tau | (1u << bit);
        unsigned c = 0u;
#pragma unroll
        for (int i = 0; i < N; ++i) c += (kk[i] >= cand) ? 1u : 0u;
        c = xg_sum_u32(c);
        if (!done && c >= 16u) { tau = cand; done = (c == 16u); }
        if (__all(done ? 1 : 0)) break;
    }
    return tau;
}
__device__ __forceinline__ void peer_topk_wave2(int item, int lane, LAS float* wl, const bf16_t* __restrict__ qp, const bf16_t* __restrict__ skb, int* __restrict__ ids, float* __restrict__ gates) {
    const int hd = item & 7, tt = item >> 3, j = lane & 15, g = lane >> 4;
    const size_t t0 = (size_t)tt * 16;
#pragma unroll 1
    for (int p = 0; p < 2; ++p) {
        bf16x8_t qf[4];
        const bf16_t* qrow = qp + (t0 + j) * D + hd * 256 + p * 128 + 8 * g;
#pragma unroll
        for (int ks = 0; ks < 4; ++ks) qf[ks] = *(const bf16x8_t*)(qrow + 32 * ks);
        const bf16_t* kb = skb + ((size_t)(hd * 2 + p) * 128 + j) * 128 + 8 * g;
        float sc[32]; unsigned kk[32];
#pragma unroll
        for (int kt = 0; kt < 8; ++kt) {
            f32x4_t a = (f32x4_t){0.f, 0.f, 0.f, 0.f};
#pragma unroll
            for (int ks = 0; ks < 4; ++ks) a = __builtin_amdgcn_mfma_f32_16x16x32_bf16(*(const bf16x8_t*)(kb + (size_t)kt * (16 * 128) + 32 * ks), qf[ks], a, 0, 0, 0);
#pragma unroll
            for (int r = 0; r < 4; ++r) { sc[kt * 4 + r] = a[r]; kk[kt * 4 + r] = (ord_key(a[r]) & ~127u) | (unsigned)(127 - (16 * kt + 4 * g + r)); }
        }
        const unsigned tau = bisect16<32>(kk);
        unsigned cnt = 0u;
#pragma unroll
        for (int i = 0; i < 32; ++i) cnt += (kk[i] >= tau) ? 1u : 0u;
        const unsigned c0 = (unsigned)__shfl((int)cnt, j), c1 = (unsigned)__shfl((int)cnt, j + 16), c2 = (unsigned)__shfl((int)cnt, j + 32);
        unsigned off = (g > 0 ? c0 : 0u) + (g > 1 ? c1 : 0u) + (g > 2 ? c2 : 0u);
        LAS float* ls = wl + p * 256 + j * 16;
        LAS float* li = wl + 512 + p * 256 + j * 16;
#pragma unroll
        for (int i = 0; i < 32; ++i) {
            if (kk[i] >= tau && off < 16u) { ls[off] = sc[i]; li[off] = __int_as_float(16 * (i >> 2) + 4 * g + (i & 3)); ++off; }
        }
    }
    asm volatile("s_waitcnt lgkmcnt(0)" ::: "memory");
    {
        float sA[4], sB[16]; int iA[4];
        {
            const f32x4_t a = *(const LAS f32x4_t*)(wl + j * 16 + 4 * g);
            const f32x4_t ai = *(const LAS f32x4_t*)(wl + 512 + j * 16 + 4 * g);
#pragma unroll
            for (int r = 0; r < 4; ++r) { sA[r] = a[r]; iA[r] = __float_as_int(ai[r]); }
#pragma unroll
            for (int q = 0; q < 4; ++q) { const f32x4_t b = *(const LAS f32x4_t*)(wl + 256 + j * 16 + 4 * q); sB[4 * q] = b[0]; sB[4 * q + 1] = b[1]; sB[4 * q + 2] = b[2]; sB[4 * q + 3] = b[3]; }
        }
        unsigned kk[64];
#pragma unroll
        for (int a = 0; a < 4; ++a)
#pragma unroll
            for (int b = 0; b < 16; ++b) kk[a * 16 + b] = (ord_key(sA[a] + sB[b]) & ~255u) | (unsigned)(255 - ((4 * g + a) * 16 + b));
        const unsigned tau = bisect16<64>(kk);
        float mx = -INFINITY; unsigned cnt = 0u;
#pragma unroll
        for (int i = 0; i < 64; ++i) if (kk[i] >= tau) { mx = fmaxf(mx, sA[i >> 4] + sB[i & 15]); ++cnt; }
        mx = xg_max_f32(mx);
        float es = 0.f;
#pragma unroll
        for (int i = 0; i < 64; ++i) if (kk[i] >= tau) es += __expf(sA[i >> 4] + sB[i & 15] - mx);
        const float inv = 1.0f / xg_sum_f32(es);
        const unsigned c0 = (unsigned)__shfl((int)cnt, j), c1 = (unsigned)__shfl((int)cnt, j + 16), c2 = (unsigned)__shfl((int)cnt, j + 32);
        unsigned off = (g > 0 ? c0 : 0u) + (g > 1 ? c1 : 0u) + (g > 2 ? c2 : 0u);
        int* idp = ids + (t0 + j) * 128 + hd * 16;
        float* gtp = gates + (t0 + j) * 128 + hd * 16;
        const LAS float* liB = wl + 512 + 256 + j * 16;
#pragma unroll
        for (int i = 0; i < 64; ++i) {
            if (kk[i] >= tau && off < 16u) {
                idp[off] = iA[i >> 4] * 128 + __float_as_int(liB[i & 15]);
                gtp[off] = __expf(sA[i >> 4] + sB[i & 15] - mx) * inv;
                ++off;
            }
        }
    }
}

struct Params {
    const float *x, *mem, *g_mix, *w_in, *conv_w, *conv_b, *w_mq, *w_mk, *b_mi, *b_mf, *g_mhead, *g_ahead, *w_out, *g_cross, *g_mem,
                *w_xq, *w_xk, *w_xv, *w_xo, *g_ffn, *w_pq, *sub_keys, *u_tab, *v_tab, *g_final;
    float* out;
    unsigned* bar;
    float* ws;
};

#define PHASE_LOOP(nvb) for (int base_ = blockIdx.x * 2; base_ < (nvb); base_ += gridDim.x * 2)
#define VB (base_ + half)

__global__ void __launch_bounds__(NTHR) mega(Params P) {
    volatile LAS unsigned* st = (volatile LAS unsigned*)(LAS unsigned char*)(smem_raw + GEMM_LDS);
    if (threadIdx.x == 0) { st[0] = 0u; st[1] = 0u; st[2] = 0u; st[3] = 0u; }
    if (threadIdx.x < I_NPTR) ((LAS unsigned long long*)(LAS unsigned char*)(smem_raw + GEMM_LDS + 64))[threadIdx.x] = ((const unsigned long long*)&P)[threadIdx.x];
    __syncthreads();
    XcdBarrier xb = xcd_barrier_post((unsigned*)ldp_raw(I_BAR), st);

    constexpr size_t TD = (size_t)T * D;
    constexpr size_t O_HB = 6 * P6S * 2, O_CBUF = O_HB + (size_t)T * D * 2, O_MQ = O_CBUF + (size_t)T * 1024 * 2, O_MK = O_MQ + (size_t)T * 1024 * 2,
                     O_MIXB = O_MK + (size_t)T * 1024 * 2, O_WIN = O_MIXB + (size_t)T * D * 2, O_WOUT = O_WIN + (size_t)6144 * D * 2, O_WXQ = O_WOUT + (size_t)D * D * 2,
                     O_WXK = O_WXQ + (size_t)D * D * 2, O_WXV = O_WXK + (size_t)D * D * 2, O_WXO = O_WXV + (size_t)D * D * 2, O_WPQ = O_WXO + (size_t)D * D * 2,
                     O_WQK = O_WPQ + (size_t)D * D * 2, O_GPRE = O_WQK + (size_t)8 * 256 * 256 * 2, O_UT = O_GPRE + (size_t)T * 8 * 4, O_VT = O_UT + (size_t)16384 * D, O_RSC = O_VT + (size_t)16384 * D,
                     O_BH = O_RSC + (size_t)32768 * 4, O_GS = O_BH + (size_t)128 * 256 * 512 * 2, O_DENP = O_GS + (size_t)T * 4 * 8 * 4, O_QN = O_DENP + (size_t)T * 4 * 4 * 4,
                     O_DN = O_QN + (size_t)T * 4 * 4, O_DECAY = O_DN + (size_t)128 * 256 * 4, O_KB = O_DECAY + 4096, O_VB = O_KB + (size_t)12288 * 2048 * 2, O_CS = O_VB + (size_t)12288 * 2048 * 2, O_SKB = O_CS + (size_t)4096 * 64 * 8, O_RSSP = O_SKB + (size_t)262144 * 2, O_RSTD = O_RSSP + (size_t)T * 32 * 4, O_MN = O_RSTD + (size_t)T * 4, O_KVP = O_MN + (size_t)512 * D * 2, O_END = O_KVP + (size_t)2 * 512 * 4096 * 4;
    static_assert(O_END + 16384 <= (size_t)536870912, "workspace overflow");
#define W_P6    ((bf16_t*)wsb)
#define W_HB    ((bf16_t*)(wsb + O_HB))
#define W_CBUF  ((bf16_t*)(wsb + O_CBUF))
#define W_MQ    ((bf16_t*)(wsb + O_MQ))
#define W_MK    ((bf16_t*)(wsb + O_MK))
#define W_MIXB  ((bf16_t*)(wsb + O_MIXB))
#define W_GPRE  ((float*)(wsb + O_GPRE))
#define W_HRAW  ((float*)(wsb + O_HB))
#define W_XR    ((float*)wsb)
#define W_MN    ((bf16_t*)((float*)wsb + TD))
#define W_KM    ((bf16_t*)((float*)wsb + TD + (size_t)256 * D))
#define W_VMT   ((bf16_t*)((float*)wsb + TD + (size_t)768 * D))
#define W_PX    ((bf16_t*)(wsb + O_MK))
#define W_GATES ((float*)wsb + TD + (size_t)1280 * D)
#define W_IDS   ((int*)((float*)wsb + TD + (size_t)1280 * D + (size_t)T * 128))
#define W_QX    ((bf16_t*)(wsb + O_CBUF))
#define W_BH    ((bf16_t*)(wsb + O_BH))
#define W_KB    ((bf16_t*)(wsb + O_KB))
#define W_VB    ((bf16_t*)(wsb + O_VB))
#define W_CS    ((float2*)(wsb + O_CS))
#define W_SKB   ((bf16_t*)(wsb + O_SKB))
#define W_RSSP  ((float*)(wsb + O_RSSP))
#define W_RSTD  ((float*)(wsb + O_RSTD))
#define W_MN2   ((bf16_t*)(wsb + O_MN))
#define W_KVP   ((float*)(wsb + O_KVP))
#define W_GS    ((float*)(wsb + O_GS))
#define W_DENP  ((float*)(wsb + O_DENP))
#define W_QN    ((float*)(wsb + O_QN))
#define W_DN    ((float*)(wsb + O_DN))
#define W_DECAY ((float*)(wsb + O_DECAY))
#define W_PQ    ((bf16_t*)(wsb + O_HB))
#define W_KWT   ((bf16_t*)(wsb + O_CBUF))
#define W_DC    ((float*)(wsb + 3 * P6S * 2))
#define W_UT    ((unsigned char*)(wsb + O_UT))
#define W_VT    ((unsigned char*)(wsb + O_VT))
#define W_RSC   ((float*)(wsb + O_RSC))
#define PH_BEGIN() int tidx = threadIdx.x; asm volatile("" : "+v"(tidx)); const int half = tidx >> 8, tid = tidx & 255; float* sm = (float*)smem_raw + half * HALF_SM_FLOATS; \
                   char* wsb = (char*)ldp_raw(I_WS); (void)half; (void)tid; (void)sm; (void)wsb
#define GJOB_DEFAULT(g) pg8::GJob g; g.lda = D; g.ldb = D; g.K = D; g.nM = 32; g.nN = 8; g.a_pm_step = 256 * D; g.b_pn_mask = 0x7fffffff; g.b_pn_shift = 30; g.b_pn_step2 = 0; g.bid0 = 0; g.nblk = gridDim.x; g.a_pn_shift = 0; g.a_pn_mask = 0; g.a_pn_step = 0; g.b_pm_shift = 0; g.b_pm_step = 0; g.b_pn_step = 256 * D; \
                        g.ldc = D; g.R = nullptr; g.ldr = D; g.mode = 0; g.escale = 1.0f; g.gs = nullptr; g.denp = nullptr; g.qn = nullptr; g.gvec = nullptr; g.mo = nullptr; g.C2 = nullptr; g.rssp = nullptr; g.rstd = nullptr
#define GEMM_LDSP ((LAS unsigned char*)smem_raw)

    {
        PH_BEGIN();
        {
            LAS float* scr = (LAS float*)(LAS unsigned char*)(smem_raw) + (tidx >> 6) * (64 * 33);
            const int lane = tidx & 63;
            const int gw = blockIdx.x * 8 + (tidx >> 6), NGW = gridDim.x * 8;
            constexpr int I_IN = 32 * 192, I_SQ = 32 * 64, I_QK = 8 * 4 * 8;
            constexpr int NITEMS = I_IN + 6 * I_SQ + I_QK;
#pragma nounroll
            for (int it = gw; it < NITEMS; it += NGW) {
                const float* W; int ldw, K, csrc0, row0, kb; bf16_t* WT; float wscale = 1.0f;
                int r = it;
                if (r < I_IN) { const int nb = r % 192; kb = r / 192; W = PF(I_WIN); ldw = INC; K = D; csrc0 = nb * 32 + (nb >= 96 ? 8 : 0); WT = (bf16_t*)(wsb + O_WIN); row0 = nb * 32; }
                else if ((r -= I_IN) < 6 * I_SQ) {
                    const int wsel = r / I_SQ; r -= wsel * I_SQ; const int nb = r % 64; kb = r / 64; ldw = D; K = D; csrc0 = nb * 32; row0 = nb * 32;
                    W = PF(wsel == 0 ? I_WOUT : wsel == 1 ? I_WXQ : wsel == 2 ? I_WXK : wsel == 3 ? I_WXV : wsel == 4 ? I_WXO : I_WPQ);
                    WT = (bf16_t*)(wsb + O_WOUT + (size_t)wsel * ((size_t)D * D * 2));
                } else {
                    r -= 6 * I_SQ; const int hq = r / 32; r -= hq * 32; const int nb = r % 8; kb = r / 8;
                    W = PF(hq < 4 ? I_WMQ : I_WMK) + (size_t)(hq & 3) * 65536; ldw = 256; K = 256; csrc0 = nb * 32; WT = (bf16_t*)(wsb + O_WQK); row0 = hq * 256 + nb * 32;
                    if (hq >= 4) wscale = 0.0625f;
                }
                p0_transpose_item(W, ldw, K, csrc0, WT, row0, scr, kb, lane, wscale);
            }
            {
                const float* ut = PF(I_UTAB); const float* vt = PF(I_VTAB);
#pragma nounroll
                for (int row = gw; row < 32768; row += NGW) {
                    const bool second = row >= 16384; const int rr = second ? row - 16384 : row;
                    table_row_to_fp8((second ? vt : ut) + (size_t)rr * D, (second ? W_VT : W_UT) + (size_t)rr * D, W_RSC + row, lane);
                }
            }
            rope_table_fill(W_CS, blockIdx.x * NTHR + tidx, gridDim.x * NTHR);
            {
                const float* sk = PF(I_SUBK);
#pragma nounroll
                for (int i = blockIdx.x * NTHR + tidx; i < 262144 / 8; i += gridDim.x * NTHR) {
                    const float4 a = *(const float4*)(sk + (size_t)i * 8), b = *(const float4*)(sk + (size_t)i * 8 + 4);
                    uint4 o; o.x = pk2(a.x, a.y); o.y = pk2(a.z, a.w); o.z = pk2(b.x, b.y); o.w = pk2(b.z, b.w);
                    *(uint4*)(W_SKB + (size_t)i * 8) = o;
                }
            }
            __syncthreads();
        }
        {
            const float* rin = PF(I_X); const float* rg = PF(I_GMIX); const float* win = PF(I_WIN);
            float* gwl = (float*)smem_raw + 1024;
            for (int k = tidx; k < 2048; k += NTHR) { const float4 a = *(const float4*)(win + (size_t)k * INC + C_MI), b = *(const float4*)(win + (size_t)k * INC + C_MI + 4);
                *(float4*)(gwl + k * 8) = a; *(float4*)(gwl + k * 8 + 4) = b; }
            __syncthreads();
            float* red = (float*)smem_raw + half * 256;
#pragma nounroll
            PHASE_LOOP(T) d_rmsnorm(VB, tid, red, rin, rg, W_HB, gwl, W_GPRE);
            const float* min_ = PF(I_MEM); const float* mg = PF(I_GMEM);
#pragma nounroll
            PHASE_LOOP(512) d_rmsnorm(VB, tid, red, min_, mg, W_MN2, nullptr, nullptr);
        }
    }
    xcd_barrier(xb);
    {
        PH_BEGIN();
        GJOB_DEFAULT(g); g.A = W_HB; g.Bt = (bf16_t*)(wsb + O_WIN); g.nN = 24; g.C = (float*)W_P6; g.ldc = 1024;
        pg8::gemm_phase<4>(GEMM_LDSP, g, tidx);
    }
    xcd_barrier(xb);
    {
        PH_BEGIN();
        const float* cw = PF(I_CONVW); const float* cb = PF(I_CONVB);
#pragma nounroll
        PHASE_LOOP(T) d_conv_silu(VB, tid, W_P6, cw, cb, W_CBUF);
        rope_q_pass(W_P6 + 3 * P6S, W_CS, (size_t)blockIdx.x * NTHR + tidx, (size_t)gridDim.x * NTHR);
        {
            LAS unsigned short* wl = (LAS unsigned short*)(LAS unsigned char*)smem_raw + (tidx >> 6) * (16 * 136);
#pragma nounroll
            for (int item = blockIdx.x * 8 + (tidx >> 6); item < 12288; item += gridDim.x * 8) dil_tile_prep(item, tidx & 63, wl, W_P6 + 4 * P6S, W_P6 + 5 * P6S, W_CS, W_KB, W_VB);
            __syncthreads();
        }
        if (blockIdx.x < 8 && tidx < 64) mlstm_gates_wave(blockIdx.x >> 2, blockIdx.x & 3, tidx, W_GPRE, PF(I_BMI), PF(I_BMF), W_GS, W_DECAY);
#pragma nounroll
        PHASE_LOOP(2048) { const int it = VB, lt = it & 3, et = (it >> 2) & 3, h = (it >> 4) & 3, cg = it >> 6;
            transpose_tile64(tid, sm, W_P6 + P6S + (size_t)(cg * 256 + lt * 64) * 1024 + h * 256 + et * 64, 1024, W_BH + ((size_t)(cg * 4 + h) * 256 + et * 64) * 512 + lt * 64, 512, nullptr, 0); }
    }
    xcd_barrier(xb);
    {
        PH_BEGIN();
        {
            GJOB_DEFAULT(g); g.A = W_CBUF; g.lda = 1024; g.a_pm_step = 256 * 1024; g.Bt = (bf16_t*)(wsb + O_WQK); g.ldb = 256; g.b_pn_step = 256 * 256; g.K = 256; g.a_pn_mask = 3; g.a_pn_step = 256; g.C = (float*)W_MQ; g.ldc = 1024;
            pg8::gemm_phase<4>(GEMM_LDSP, g, tidx);
            __syncthreads();
        }
        const float* ga = PF(I_GAHEAD);
#pragma nounroll
        for (int qt = blockIdx.x * 8 + (tidx >> 6); qt < 4096; qt += gridDim.x * 8) dilated_wave_tile(qt, tidx & 63, W_P6 + 3 * P6S, W_KB, W_VB, ga, W_MIXB);
    }
    xcd_barrier(xb);
    {
        PH_BEGIN();
#pragma nounroll
        PHASE_LOOP(2048) { const int it = VB, lt = it & 3, dt = (it >> 2) & 3, h = (it >> 4) & 3, cg = it >> 6;
            transpose_tile64(tid, sm, W_MK + (size_t)(cg * 256 + lt * 64) * 1024 + h * 256 + dt * 64, 1024, W_KWT + ((size_t)(cg * 4 + h) * 256 + dt * 64) * 256 + lt * 64, 256,
                             W_GS + ((size_t)(cg * 256 + lt * 64) * 4 + h) * 8 + 2, 32); }
        {
            const size_t nth = (size_t)gridDim.x * NTHR;
#pragma nounroll
            for (size_t i = (size_t)blockIdx.x * NTHR + tidx; i < (size_t)T * 128; i += nth) {
                const size_t t = i >> 7; const int c8 = (int)(i & 127) * 8, h = c8 >> 8, d = c8 & 255;
                const float sc = W_GS[(t * 4 + h) * 8 + 3];
                const uint4 v = *(const uint4*)(W_MQ + t * 1024 + c8);
                uint4 o;
                o.x = pk2(bf2f((unsigned short)(v.x & 0xFFFFu)) * sc, bf2f((unsigned short)(v.x >> 16)) * sc); o.y = pk2(bf2f((unsigned short)(v.y & 0xFFFFu)) * sc, bf2f((unsigned short)(v.y >> 16)) * sc);
                o.z = pk2(bf2f((unsigned short)(v.z & 0xFFFFu)) * sc, bf2f((unsigned short)(v.z >> 16)) * sc); o.w = pk2(bf2f((unsigned short)(v.w & 0xFFFFu)) * sc, bf2f((unsigned short)(v.w >> 16)) * sc);
                *(uint4*)(W_PQ + t * 2048 + h * 512 + 256 + d) = o;
            }
        }
#pragma nounroll
        PHASE_LOOP(128) { const int cgh = VB, cg = cgh >> 2, h = cgh & 3;
            float a = 0.f;
            for (int l = 0; l < 256; ++l) { const size_t t = (size_t)cg * 256 + l; a = fmaf(W_GS[(t * 4 + h) * 8 + 2], bf2f(W_MK[t * 1024 + h * 256 + tid]), a); }
            W_DN[(size_t)cgh * 256 + tid] = a; }
        __syncthreads();
        {
            GJOB_DEFAULT(g); g.A = W_MQ; g.lda = 1024; g.a_pm_step = 256 * 1024; g.a_pn_mask = 3; g.a_pn_step = 256; g.K = 256; g.nN = 4;
            g.Bt = W_MK; g.ldb = 1024; g.b_pn_step = 256; g.b_pm_step = 256 * 1024; g.C = (float*)W_PQ; g.gs = W_GS; g.denp = W_DENP;
            pg8::gemm_phase<6>(GEMM_LDSP, g, tidx);
        }
    }
    xcd_barrier(xb);
    {
        PH_BEGIN();
        GJOB_DEFAULT(g); g.A = W_BH; g.lda = 512; g.a_pm_step = 4 * 256 * 512; g.a_pn_mask = 3; g.a_pn_step = 256 * 512; g.K = 256; g.nN = 4;
        g.Bt = W_KWT; g.ldb = 256; g.b_pn_step = 65536; g.b_pm_step = 4 * 65536; g.C = W_DC;
        pg8::gemm_phase<7>(GEMM_LDSP, g, tidx);
    }
    xcd_barrier(xb);
    {
        PH_BEGIN();
        {
#pragma nounroll
            for (int gid = blockIdx.x * NTHR + tidx; gid < 131072; gid += gridDim.x * NTHR) {
                const int bh = gid >> 14, b = bh >> 2, h = bh & 3, e = (gid >> 6) & 255, d = (gid & 63) * 4;
                float4 C = make_float4(0.f, 0.f, 0.f, 0.f);
#pragma unroll 4
                for (int c = 0; c < 16; ++c) {
                    const int cgh = (b * 16 + c) * 4 + h;
                    uint2 o; o.x = pk2(C.x, C.y); o.y = pk2(C.z, C.w);
                    *(uint2*)(W_BH + ((size_t)cgh * 256 + e) * 512 + 256 + d) = o;
                    const float dec = W_DECAY[cgh];
                    const float4 dc = *(const float4*)(W_DC + ((size_t)cgh * 256 + e) * 256 + d);
                    C.x = fmaf(dec, C.x, dc.x); C.y = fmaf(dec, C.y, dc.y); C.z = fmaf(dec, C.z, dc.z); C.w = fmaf(dec, C.w, dc.w);
                }
            }
        }
#pragma nounroll
        PHASE_LOOP(128) { const int cgh = VB, cg = cgh >> 2, h = cgh & 3, b = cg >> 4, c = cg & 15;
            float n = 0.f;
            for (int cc = 0; cc < c; ++cc) { const int j = (b * 16 + cc) * 4 + h; n = fmaf(W_DECAY[j], n, W_DN[(size_t)j * 256 + tid]); }
            __syncthreads();
            sm[tid] = n;
            __syncthreads();
            const int lane = tid & 63, w = tid >> 6;
            const float4 nv = *(const float4*)(sm + lane * 4);
            for (int i = 0; i < 64; ++i) {
                const size_t t = (size_t)cg * 256 + w * 64 + i;
                const ushort4 q4 = *(const ushort4*)(W_MQ + t * 1024 + h * 256 + lane * 4);
                float s = bf2f(q4.x) * nv.x + bf2f(q4.y) * nv.y + bf2f(q4.z) * nv.z + bf2f(q4.w) * nv.w;
                s = wave_sum(s);
                if (lane == 0) W_QN[t * 4 + h] = s;
            }
        }
    }
    xcd_barrier(xb);
    {
        PH_BEGIN();
        GJOB_DEFAULT(g); g.A = W_PQ; g.a_pn_mask = 3; g.a_pn_step = 512; g.K = 512; g.nN = 4;
        g.Bt = W_BH; g.ldb = 512; g.b_pn_step = 256 * 512; g.b_pm_step = 4 * 256 * 512; g.C = (float*)W_MIXB;
        g.gs = W_GS; g.denp = W_DENP; g.qn = W_QN; g.gvec = PF(I_GMHEAD); g.mo = W_P6 + 2 * P6S; g.nblk = 128;
        if (blockIdx.x < 128) pg8::gemm_phase<8>(GEMM_LDSP, g, tidx);
        else {
            GJOB_DEFAULT(k); k.A = W_MN2; k.K = 1024; k.nM = 2; k.nN = 32; k.a_pn_shift = 4; k.a_pn_mask = 1; k.a_pn_step = 1024;
            k.Bt = (bf16_t*)(wsb + O_WXK); k.b_pn_mask = 15; k.b_pn_shift = 4; k.b_pn_step2 = 1024; k.C = W_KVP; k.bid0 = 128; k.nblk = 128;
            pg8::gemm_phase<12>(GEMM_LDSP, k, tidx);
        }
    }
    xcd_barrier(xb);
    {
        PH_BEGIN();
        for (int i = blockIdx.x * NTHR + tidx; i < 512 * 4096 / 4; i += gridDim.x * NTHR) {
            const int r = i >> 10, c = (i & 1023) * 4;
            const float4 a = *(const float4*)(W_KVP + (size_t)r * 4096 + c), b = *(const float4*)(W_KVP + (size_t)512 * 4096 + (size_t)r * 4096 + c);
            const float v0 = a.x + b.x, v1 = a.y + b.y, v2 = a.z + b.z, v3 = a.w + b.w;
            if (c < 2048) { uint2 o; o.x = pk2(v0, v1); o.y = pk2(v2, v3); *(uint2*)(W_KM + (size_t)r * 2048 + c) = o; }
            else { bf16_t* d = W_VMT + (size_t)(c - 2048) * 512 + r; d[0] = (bf16_t)f2bf(v0); d[512] = (bf16_t)f2bf(v1); d[1024] = (bf16_t)f2bf(v2); d[1536] = (bf16_t)f2bf(v3); }
        }
        GJOB_DEFAULT(g); g.A = W_MIXB; g.Bt = (bf16_t*)(wsb + O_WOUT); g.C = W_XR; g.R = PF(I_X); g.C2 = W_HB; g.gvec = PF(I_GCROSS); g.rssp = W_RSSP;
        pg8::gemm_phase<10>(GEMM_LDSP, g, tidx);
    }
    xcd_barrier(xb);
    {
        PH_BEGIN();
        {
            GJOB_DEFAULT(g); g.A = W_HB; g.Bt = (bf16_t*)(wsb + O_WXQ); g.C = (float*)W_QX;
            pg8::Unit u0;
            if (pg8::unit_next(g, 0, u0) && tidx < 256) { const size_t r = (size_t)u0.pm * 256 + tidx; float s = 0.f; for (int k = 0; k < 32; ++k) s += W_RSSP[r * 32 + k];
                ((LAS float*)(LAS unsigned char*)(smem_raw + GEMM_LDS + 1024 + 8192))[tidx] = rsqrtf(s * (1.0f / D) + EPS); }
            __syncthreads();
            pg8::gemm_phase<11>(GEMM_LDSP, g, tidx); __syncthreads();
        }

    }
    xcd_barrier(xb);
    {
        PH_BEGIN();
        GJOB_DEFAULT(g); g.A = W_QX; g.K = 512; g.a_pn_mask = 3; g.a_pn_step = 512; g.Bt = W_KM; g.b_pn_step = 512; g.b_pm_shift = 4; g.b_pm_step = 256 * D; g.nN = 4;
        g.C = (float*)W_PX; g.ldc = 1024; g.escale = 0.04419417382415922f * 1.4426950408889634f;
        pg8::gemm_phase<5>(GEMM_LDSP, g, tidx);
    }
    xcd_barrier(xb);
    {
        PH_BEGIN();
        GJOB_DEFAULT(g); g.A = W_PX; g.lda = 1024; g.a_pm_step = 256 * 1024; g.K = 256; g.a_pn_shift = 1; g.a_pn_mask = 3; g.a_pn_step = 256; g.Bt = W_VMT; g.ldb = 512; g.b_pn_step = 256 * 512; g.b_pm_shift = 4; g.b_pm_step = 256;
        g.C = (float*)W_MIXB;
        pg8::gemm_phase<3>(GEMM_LDSP, g, tidx);
    }
    xcd_barrier(xb);
    {
        PH_BEGIN();
        GJOB_DEFAULT(g); g.A = W_MIXB; g.Bt = (bf16_t*)(wsb + O_WXO); g.C = W_XR; g.R = W_XR; g.C2 = W_HB; g.gvec = PF(I_GFFN); g.rssp = W_RSSP;
        pg8::gemm_phase<10>(GEMM_LDSP, g, tidx);
    }
    xcd_barrier(xb);
    {
        PH_BEGIN();
        GJOB_DEFAULT(g); g.A = W_HB; g.Bt = (bf16_t*)(wsb + O_WPQ); g.C = (float*)W_QX;
        pg8::Unit u0;
        if (pg8::unit_next(g, 0, u0) && tidx < 256) { const size_t r = (size_t)u0.pm * 256 + tidx; float s = 0.f; for (int k = 0; k < 32; ++k) s += W_RSSP[r * 32 + k];
            const float rs = rsqrtf(s * (1.0f / D) + EPS);
            ((LAS float*)(LAS unsigned char*)(smem_raw + GEMM_LDS + 1024 + 8192))[tidx] = rs; W_RSTD[r] = rs; }
        __syncthreads();
        pg8::gemm_phase<11>(GEMM_LDSP, g, tidx);
    }
    xcd_barrier(xb);
    {
        PH_BEGIN();
        LAS float* wl = (LAS float*)(LAS unsigned char*)smem_raw + (tidx >> 6) * 1024;
#pragma nounroll
        for (int item = blockIdx.x * 8 + (tidx >> 6); item < 4096; item += gridDim.x * 8) peer_topk_wave2(item, tidx & 63, wl, W_QX, W_SKB, W_IDS, W_GATES);
    }
    xcd_barrier(xb);
    {
        PH_BEGIN();
        const float* gf = PF(I_GFINAL); float* outp = (float*)ldp_raw(I_OUT);
#pragma nounroll
        PHASE_LOOP(T) d_peer_out8(VB, tid, sm, W_HB, W_XR, W_IDS, W_GATES, W_UT, W_VT, W_RSC, W_RSTD, gf, outp);
    }
}
}

extern "C" void kernel_launch(void* const* d_in, const int* in_sizes, int n_in, void* d_out, int out_size, void* d_ws, size_t ws_size, hipStream_t stream) {
    static int grid_blocks = 0;
    if (!grid_blocks) {
        int dev = 0, cus = 0, per_cu = 0;
        hipGetDevice(&dev);
        hipDeviceGetAttribute(&cus, hipDeviceAttributeMultiprocessorCount, dev);
        hipFuncSetAttribute((const void*)mega, hipFuncAttributeMaxDynamicSharedMemorySize, SMEM_BYTES);
        hipOccupancyMaxActiveBlocksPerMultiprocessor(&per_cu, mega, NTHR, SMEM_BYTES);
        if (per_cu > 1) per_cu = 1;
        if (per_cu < 1) per_cu = 1;
        grid_blocks = cus * per_cu;
    }
    Params P{};
    const float** pp = (const float**)&P;
    for (int i = 0; i < 25; ++i) pp[i] = (const float*)d_in[i];
    P.out = (float*)d_out;
    P.bar = (unsigned*)d_ws;
    P.ws = (float*)((char*)d_ws + 16384);
    hipMemsetAsync(d_ws, 0, 16384, stream);
    void* args[] = {&P};
    hipError_t e = hipLaunchCooperativeKernel((const void*)mega, dim3(grid_blocks), dim3(NTHR), args, SMEM_BYTES, stream);
    if (e != hipSuccess) fprintf(stderr, "cooperative launch failed: %s (grid %d)\n", hipGetErrorString(e), grid_blocks);
}
```

```cpp
#include <hip/hip_runtime.h>
#include <stdint.h>
#include <math.h>
#include <cstdio>

#define LAS_ __attribute__((address_space(3)))
namespace {
constexpr int D = 2048, NB = 2, S = 4096, T = NB * S;
constexpr int INC = 6152;
constexpr int C_MIN = 0, C_MV = 1024, C_MO = 2048, C_MI = 3072, C_MF = 3076, C_AQ = 3080, C_AK = 4104, C_AV = 5128;
constexpr float EPS = 1e-6f;
constexpr size_t P6S = (size_t)8192 * 1024;
constexpr int NTHR = 512;
constexpr int HALF_SM_FLOATS = 8704;
constexpr int GEMM_LDS = 131072;
constexpr int SMEM_BYTES = 163840;
constexpr int CTRL_OFF = SMEM_BYTES - 1024;
typedef unsigned short bf16_t;
__device__ __forceinline__ unsigned f2bf(float f) { unsigned u = __float_as_uint(f); u += 0x7FFFu + ((u >> 16) & 1u); return u >> 16; }
__device__ __forceinline__ unsigned pk2(float lo, float hi) { return f2bf(lo) | (f2bf(hi) << 16); }
__device__ __forceinline__ float bf2f(unsigned short b) { return __uint_as_float(((unsigned)b) << 16); }
extern __shared__ __attribute__((aligned(16))) unsigned char smem_raw[];
enum { I_X = 0, I_MEM, I_GMIX, I_WIN, I_CONVW, I_CONVB, I_WMQ, I_WMK, I_BMI, I_BMF, I_GMHEAD, I_GAHEAD, I_WOUT, I_GCROSS, I_GMEM,
       I_WXQ, I_WXK, I_WXV, I_WXO, I_GFFN, I_WPQ, I_SUBK, I_UTAB, I_VTAB, I_GFINAL, I_OUT, I_BAR, I_WS, I_NPTR };
__device__ __forceinline__ unsigned long long ldp_raw(int i) {
    const LAS_ unsigned long long* tab = (const LAS_ unsigned long long*)(LAS_ unsigned char*)(smem_raw + CTRL_OFF + 64);
    const unsigned long long v = tab[i];
    const unsigned lo = __builtin_amdgcn_readfirstlane((unsigned)v), hi = __builtin_amdgcn_readfirstlane((unsigned)(v >> 32));
    return ((unsigned long long)hi << 32) | lo;
}
#define PF(i) ((const float*)ldp_raw(i))

#define XB_TMO      128
#define XB_XCNT(j)  (256  + 64 * (j))
#define XB_XSUB(j)  (1280 + 64 * (j))
#define XB_XGEN(j)  (2304 + 64 * (j))
#define XB_TOP      3328
#define XB_TOPGEN   3392
#define XCD_BAR_WORDS 3456
#define XB_SPIN_CAP (1u << 22)
#define LAS __attribute__((address_space(3)))

__device__ __forceinline__ unsigned xb_ld(unsigned* p)              { return __hip_atomic_load(p, __ATOMIC_RELAXED, __HIP_MEMORY_SCOPE_AGENT); }
__device__ __forceinline__ unsigned xb_add(unsigned* p, unsigned v) { return __hip_atomic_fetch_add(p, v, __ATOMIC_RELAXED, __HIP_MEMORY_SCOPE_AGENT); }
__device__ __forceinline__ unsigned xb_xcc_id() { return (unsigned)__builtin_amdgcn_s_getreg((3 << 11) | 20) & 0xFu; }
#define XB_SPIN(cond, bar) do { unsigned _sp = 0; while (cond) { __builtin_amdgcn_s_sleep(1); \
    if ((++_sp & 255u) == 0u) { if (xb_ld(&(bar)[XB_TMO])) break; if (_sp > XB_SPIN_CAP) { atomicAdd(&(bar)[XB_TMO], 1u); break; } } } } while (0)

struct XcdBarrier { unsigned* bar; unsigned x; volatile LAS unsigned* st; };

__device__ __forceinline__ XcdBarrier xcd_barrier_post(unsigned* bar, volatile LAS unsigned* st) {
    XcdBarrier b; b.bar = bar; b.x = xb_xcc_id(); b.st = st;
    if (threadIdx.x == 0) (void)xb_add(&bar[XB_XCNT(b.x)], 1u);
    return b;
}
__device__ __forceinline__ void xcd_barrier_complete(unsigned* bar, unsigned x, unsigned& nloc, unsigned& nx) {
    const unsigned G = gridDim.x * gridDim.y * gridDim.z;
    unsigned sum, cnt, mine, sp = 0u;
    for (;;) {
        sum = 0u; cnt = 0u; mine = 0u;
#pragma unroll
        for (unsigned j = 0; j < 16; ++j) { const unsigned c = xb_ld(&bar[XB_XCNT(j)]); sum += c; cnt += (c > 0u) ? 1u : 0u; mine = (j == x) ? c : mine; }
        if (sum == G) break;
        __builtin_amdgcn_s_sleep(1);
        if ((++sp & 255u) == 0u) { if (xb_ld(&bar[XB_TMO])) break; if (sp > XB_SPIN_CAP) { atomicAdd(&bar[XB_TMO], 1u); break; } }
    }
    nloc = mine > 0u ? mine : 1u; nx = cnt > 0u ? cnt : 1u;
}
__device__ __forceinline__ void xcd_barrier(const XcdBarrier& b) {
    asm volatile("s_waitcnt vmcnt(0)" ::: "memory");
    __syncthreads();
    if (threadIdx.x == 0) {
        unsigned* bar = b.bar;
        __builtin_amdgcn_s_waitcnt(0);
        unsigned nloc = b.st[0], nx = b.st[1];
        if (nloc == 0u) { xcd_barrier_complete(bar, b.x, nloc, nx); b.st[0] = nloc; b.st[1] = nx; }
        const unsigned old = xb_add(&bar[XB_XSUB(b.x)], 1u);
        const unsigned gen = old / nloc;
        if (old + 1u == (gen + 1u) * nloc) {
            __builtin_amdgcn_fence(__ATOMIC_RELEASE, "agent");
            asm volatile("s_waitcnt vmcnt(0)" ::: "memory");
            const unsigned og = xb_add(&bar[XB_TOP], 1u);
            const unsigned tg = og / nx;
            if (og + 1u == (tg + 1u) * nx) xb_add(&bar[XB_TOPGEN], 1u);
            else XB_SPIN(xb_ld(&bar[XB_TOPGEN]) == tg, bar);
            __builtin_amdgcn_fence(__ATOMIC_ACQUIRE, "agent");
            xb_add(&bar[XB_XGEN(b.x)], 1u);
            asm volatile("s_waitcnt vmcnt(0)" ::: "memory");
        } else {
            XB_SPIN(xb_ld(&bar[XB_XGEN(b.x)]) == gen, bar);
            __builtin_amdgcn_fence(__ATOMIC_ACQUIRE, "agent");
            asm volatile("s_waitcnt vmcnt(0)" ::: "memory");
        }
    }
    __syncthreads();
}

__device__ __forceinline__ float wave_sum(float v) {
#pragma unroll
    for (int o = 32; o >= 1; o >>= 1) v += __shfl_xor(v, o);
    return v;
}
__device__ __forceinline__ float wave_max(float v) {
#pragma unroll
    for (int o = 32; o >= 1; o >>= 1) v = fmaxf(v, __shfl_xor(v, o));
    return v;
}
__device__ __forceinline__ float log_sigmoid(float x) { return fminf(x, 0.f) - log1pf(expf(-fabsf(x))); }


__device__ __forceinline__ void d_rmsnorm(int vb, int t, float* sm, const float* __restrict__ in, const float* __restrict__ g, bf16_t* __restrict__ out,
                                          const float* gwl  , float* __restrict__ gpre) {
    float* red = sm;
    const int row = vb;
    const float4* p = (const float4*)(in + (size_t)row * D);
    float4 a = p[t], b = p[t + 256];
    float s = a.x * a.x + a.y * a.y + a.z * a.z + a.w * a.w + b.x * b.x + b.y * b.y + b.z * b.z + b.w * b.w;
    s = wave_sum(s);
    __syncthreads();
    if ((t & 63) == 0) red[t >> 6] = s;
    __syncthreads();
    const float tot = red[0] + red[1] + red[2] + red[3];
    const float r = rsqrtf(tot * (1.0f / D) + EPS);
    const float4* gp = (const float4*)g;
    float4 ga = gp[t], gb = gp[t + 256];
    float hv[8] = {a.x * r * ga.x, a.y * r * ga.y, a.z * r * ga.z, a.w * r * ga.w, b.x * r * gb.x, b.y * r * gb.y, b.z * r * gb.z, b.w * r * gb.w};
    uint2 o0, o1;
    o0.x = pk2(hv[0], hv[1]); o0.y = pk2(hv[2], hv[3]); o1.x = pk2(hv[4], hv[5]); o1.y = pk2(hv[6], hv[7]);
    *(uint2*)(out + (size_t)row * D + t * 4) = o0;
    *(uint2*)(out + (size_t)row * D + 1024 + t * 4) = o1;
    if (gpre) {
        float gs[8];
#pragma unroll
        for (int c = 0; c < 8; ++c) gs[c] = 0.f;
#pragma unroll
        for (int j = 0; j < 8; ++j) {
            const int k = (j < 4) ? (t * 4 + j) : (1024 + t * 4 + (j - 4));
            const float4 w0 = *(const float4*)(gwl + k * 8), w1 = *(const float4*)(gwl + k * 8 + 4);
            gs[0] = fmaf(hv[j], w0.x, gs[0]); gs[1] = fmaf(hv[j], w0.y, gs[1]); gs[2] = fmaf(hv[j], w0.z, gs[2]); gs[3] = fmaf(hv[j], w0.w, gs[3]);
            gs[4] = fmaf(hv[j], w1.x, gs[4]); gs[5] = fmaf(hv[j], w1.y, gs[5]); gs[6] = fmaf(hv[j], w1.z, gs[6]); gs[7] = fmaf(hv[j], w1.w, gs[7]);
        }
#pragma unroll
        for (int c = 0; c < 8; ++c) gs[c] = wave_sum(gs[c]);
        __syncthreads();
        if ((t & 63) == 0) {
#pragma unroll
            for (int c = 0; c < 8; ++c) red[8 + (t >> 6) * 8 + c] = gs[c];
        }
        __syncthreads();
        if (t < 8) gpre[(size_t)row * 8 + t] = red[8 + t] + red[16 + t] + red[24 + t] + red[32 + t];
    }
}

namespace pg8 {
typedef short bf16x8 __attribute__((ext_vector_type(8)));
typedef float f32x4 __attribute__((ext_vector_type(4)));
constexpr int BM = 256, BK = 64, HALF = 128, HTB = HALF * BK * 2, NXCD = 8, WGM = 8;
__device__ __forceinline__ int lds_byte(int r, int c) { const int st = (r >> 4) * 2 + (c >> 5), rr = r & 15, cc = c & 31, ob = rr * 64 + cc * 2; return st * 1024 + (ob ^ (((ob >> 9) & 1) << 5)); }
__device__ __forceinline__ void stage_rc(int b, int& R, int& C) { const int st = b / 1024, sb = b % 1024, swz = sb ^ (((sb >> 9) & 1) << 5); R = (st >> 1) * 16 + swz / 64; C = (st & 1) * 32 + (swz % 64) / 2; }
struct Unit { int pm, pn; };
struct GJob {
    const bf16_t* A; const bf16_t* Bt;
    int lda, ldb, K, nM, nN;
    int a_pn_shift, a_pn_mask, a_pn_step;
    int b_pm_shift, b_pm_step, b_pn_step;
    int a_pm_step;
    int b_pn_mask, b_pn_shift, b_pn_step2;
    int bid0, nblk;
    float escale;
    const float* gs; float* denp; const float* qn; const float* gvec; const bf16_t* mo;
    bf16_t* C2; float* rssp; const float* rstd;
    float* C; int ldc; const float* R; int ldr;
    int mode;
};
__device__ __forceinline__ bool unit_next(const GJob& g, int i, Unit& u) {
    const int nwg = g.nM * g.nN;
    const int bid = (int)blockIdx.x - g.bid0; if (bid < 0 || bid >= g.nblk) return false;
    const long L = (long)i * g.nblk + bid; if (L >= nwg) return false;
    int wgid = (int)L; { const int q = nwg / NXCD, r = nwg % NXCD, xcd = wgid % NXCD, off = wgid / NXCD; wgid = (xcd < r ? xcd * (q + 1) : r * (q + 1) + (xcd - r) * q) + off; }
    const int nig = WGM * g.nN, gid = wgid / nig, fm = gid * WGM, gsz = (g.nM - fm) < WGM ? (g.nM - fm) : WGM;
    u.pm = fm + ((wgid % nig) % gsz); u.pn = (wgid % nig) / gsz; return true;
}
template <int MODE> __device__ __forceinline__ void epilogue(const GJob& g, f32x4 (&acc)[2][2][4][2], const Unit& u, int wr, int wc, int fr, int fq, LAS unsigned char* xlds) {
    const int row0 = u.pm * BM + wr * 64 + fr;
    if constexpr (MODE == 0) {
        const int col0 = u.pn * BM + wc * 32 + 4 * fq;
#pragma unroll
        for (int ai = 0; ai < 2; ++ai)
#pragma unroll
            for (int m = 0; m < 4; ++m) {
                const int row = row0 + ai * HALF + m * 16;
                float* rowp = g.C + (size_t)row * g.ldc + col0;
                const float* rp = g.R ? g.R + (size_t)row * g.ldr + col0 : nullptr;
#pragma unroll
                for (int bj = 0; bj < 2; ++bj)
#pragma unroll
                    for (int n = 0; n < 2; ++n) {
                        f32x4 v = acc[ai][bj][m][n];
                        if (rp) v = v + *(const f32x4*)(rp + bj * HALF + n * 16);
                        *(f32x4*)(rowp + bj * HALF + n * 16) = v;
                    }
            }
    } else if constexpr (MODE == 10) {
        const int col0 = u.pn * BM + wc * 32 + 4 * fq;
#pragma unroll
        for (int ai = 0; ai < 2; ++ai)
#pragma unroll
            for (int m = 0; m < 4; ++m) {
                const int row = row0 + ai * HALF + m * 16;
                float* rowp = g.C + (size_t)row * g.ldc + col0;
                const float* rp = g.R + (size_t)row * g.ldr + col0;
                bf16_t* r2 = g.C2 + (size_t)row * D + col0;
                float ss = 0.f;
#pragma unroll
                for (int bj = 0; bj < 2; ++bj)
#pragma unroll
                    for (int n = 0; n < 2; ++n) {
                        const f32x4 v = acc[ai][bj][m][n] + *(const f32x4*)(rp + bj * HALF + n * 16);
                        *(f32x4*)(rowp + bj * HALF + n * 16) = v;
                        const f32x4 gv = *(const f32x4*)(g.gvec + col0 + bj * HALF + n * 16);
                        uint2 o; o.x = pk2(v[0] * gv[0], v[1] * gv[1]); o.y = pk2(v[2] * gv[2], v[3] * gv[3]);
                        *(uint2*)(r2 + bj * HALF + n * 16) = o;
                        ss += (v[0] * v[0] + v[1] * v[1]) + (v[2] * v[2] + v[3] * v[3]);
                    }
                ss += __shfl_xor(ss, 16); ss += __shfl_xor(ss, 32);
                if (fq == 0) g.rssp[(size_t)row * 32 + u.pn * 4 + wc] = ss;
            }
    } else if constexpr (MODE == 11) {
        bf16_t* Cb = (bf16_t*)g.C;
        const int col0 = u.pn * BM + wc * 32 + 4 * fq;
#pragma unroll
        for (int ai = 0; ai < 2; ++ai)
#pragma unroll
            for (int m = 0; m < 4; ++m) {
                const int row = row0 + ai * HALF + m * 16;
                const float rs = ((const LAS float*)(xlds + 8192))[row - u.pm * BM];
                bf16_t* rowp = Cb + (size_t)row * g.ldc + col0;
#pragma unroll
                for (int bj = 0; bj < 2; ++bj)
#pragma unroll
                    for (int n = 0; n < 2; ++n) {
                        const f32x4 v = acc[ai][bj][m][n] * rs;
                        uint2 o; o.x = pk2(v[0], v[1]); o.y = pk2(v[2], v[3]);
                        *(uint2*)(rowp + bj * HALF + n * 16) = o;
                    }
            }
    } else if constexpr (MODE == 6) {
        const int h = u.pn; const size_t t0 = (size_t)u.pm * BM;
        bf16_t* Cb = (bf16_t*)g.C;
#pragma unroll
        for (int ai = 0; ai < 2; ++ai)
#pragma unroll
            for (int m = 0; m < 4; ++m) {
                const int l = ai * HALF + wr * 64 + m * 16 + fr;
                const float M2 = g.gs[((t0 + l) * 4 + h) * 8 + 1];
                bf16_t* rowp = Cb + (t0 + l) * 2048 + h * 512 + wc * 32 + 4 * fq;
                float rs = 0.f;
#pragma unroll
                for (int bj = 0; bj < 2; ++bj)
#pragma unroll
                    for (int n = 0; n < 2; ++n) {
                        const f32x4 a = acc[ai][bj][m][n];
                        const int s0 = bj * HALF + wc * 32 + n * 16 + 4 * fq;
                        float p[4];
#pragma unroll
                        for (int r = 0; r < 4; ++r) { const float u2 = g.gs[((t0 + s0 + r) * 4 + h) * 8 + 0]; p[r] = (s0 + r <= l) ? a[r] * __builtin_amdgcn_exp2f(u2 - M2) : 0.f; rs += p[r]; }
                        uint2 o; o.x = pk2(p[0], p[1]); o.y = pk2(p[2], p[3]);
                        *(uint2*)(rowp + bj * HALF + n * 16) = o;
                    }
                rs += __shfl_xor(rs, 16); rs += __shfl_xor(rs, 32);
                if (fq == 0) g.denp[((t0 + l) * 4 + h) * 4 + wc] = rs;
            }
    } else if constexpr (MODE == 12) {
        float* Ct = g.C + (size_t)(u.pn >> 4) * ((size_t)512 * 4096) + (size_t)(u.pn & 15) * 256;
        const int col0 = wc * 32 + 4 * fq;
#pragma unroll
        for (int ai = 0; ai < 2; ++ai)
#pragma unroll
            for (int m = 0; m < 4; ++m) {
                float* rowp = Ct + (size_t)(row0 + ai * HALF + m * 16) * 4096 + col0;
#pragma unroll
                for (int bj = 0; bj < 2; ++bj)
#pragma unroll
                    for (int n = 0; n < 2; ++n) *(f32x4*)(rowp + bj * HALF + n * 16) = acc[ai][bj][m][n];
            }
    } else if constexpr (MODE == 7) {
        float* Ct = g.C + (size_t)(u.pm * 4 + u.pn) * 65536;
        const int col0 = wc * 32 + 4 * fq;
#pragma unroll
        for (int ai = 0; ai < 2; ++ai)
#pragma unroll
            for (int m = 0; m < 4; ++m) {
                float* rowp = Ct + (size_t)(ai * HALF + wr * 64 + m * 16 + fr) * 256 + col0;
#pragma unroll
                for (int bj = 0; bj < 2; ++bj)
#pragma unroll
                    for (int n = 0; n < 2; ++n) *(f32x4*)(rowp + bj * HALF + n * 16) = acc[ai][bj][m][n];
            }
    } else if constexpr (MODE == 8) {
        const int h = u.pn; const size_t t0 = (size_t)u.pm * BM;
        LAS float* X0 = (LAS float*)xlds + wr * 512;
#pragma unroll
        for (int ai = 0; ai < 2; ++ai)
#pragma unroll
            for (int m = 0; m < 4; ++m) {
                const size_t th = (t0 + ai * HALF + wr * 64 + m * 16 + fr) * 4 + h;
                const f32x4 dp = *(const f32x4*)(g.denp + th * 4);
                const float den = (dp[0] + dp[1]) + (dp[2] + dp[3]) + g.gs[th * 8 + 3] * g.qn[th];
                const float rden = 1.0f / fmaxf(fabsf(den), g.gs[th * 8 + 4]);
                float ss = 0.f;
#pragma unroll
                for (int bj = 0; bj < 2; ++bj)
#pragma unroll
                    for (int n = 0; n < 2; ++n) { f32x4 a = acc[ai][bj][m][n] * rden; acc[ai][bj][m][n] = a; ss += (a[0] * a[0] + a[1] * a[1]) + (a[2] * a[2] + a[3] * a[3]); }
                ss += __shfl_xor(ss, 16); ss += __shfl_xor(ss, 32);
                if (fq == 0) X0[(ai * 64 + m * 16 + fr) * 4 + wc] = ss;
            }
        asm volatile("s_waitcnt lgkmcnt(0)" ::: "memory"); __builtin_amdgcn_s_barrier(); asm volatile("" ::: "memory");
        bf16_t* Cb = (bf16_t*)g.C;
        const int col0 = wc * 32 + 4 * fq;
#pragma unroll
        for (int ai = 0; ai < 2; ++ai)
#pragma unroll
            for (int m = 0; m < 4; ++m) {
                const f32x4 p4 = *(const LAS f32x4*)(X0 + (ai * 64 + m * 16 + fr) * 4);
                const float rsn = rsqrtf(((p4[0] + p4[1]) + (p4[2] + p4[3])) * (1.0f / 256.0f) + EPS);
                const size_t t = t0 + ai * HALF + wr * 64 + m * 16 + fr;
                bf16_t* rowp = Cb + t * 2048 + h * 256 + col0;
                const bf16_t* mop = g.mo + t * 1024 + h * 256 + col0;
#pragma unroll
                for (int bj = 0; bj < 2; ++bj)
#pragma unroll
                    for (int n = 0; n < 2; ++n) {
                        const f32x4 a = acc[ai][bj][m][n];
                        const ushort4 mo4 = *(const ushort4*)(mop + bj * HALF + n * 16);
                        const f32x4 gv = *(const f32x4*)(g.gvec + h * 256 + col0 + bj * HALF + n * 16);
                        const float o0 = a[0] * rsn * gv[0] / (1.0f + __expf(-bf2f(mo4.x)));
                        const float o1 = a[1] * rsn * gv[1] / (1.0f + __expf(-bf2f(mo4.y)));
                        const float o2 = a[2] * rsn * gv[2] / (1.0f + __expf(-bf2f(mo4.z)));
                        const float o3 = a[3] * rsn * gv[3] / (1.0f + __expf(-bf2f(mo4.w)));
                        uint2 o; o.x = pk2(o0, o1); o.y = pk2(o2, o3);
                        *(uint2*)(rowp + bj * HALF + n * 16) = o;
                    }
            }
    } else if constexpr (MODE == 5) {
        LAS float* X0 = (LAS float*)xlds + wr * 512;
        LAS float* X1 = (LAS float*)xlds + 1024 + wr * 512;
#pragma unroll
        for (int ai = 0; ai < 2; ++ai)
#pragma unroll
            for (int m = 0; m < 4; ++m) {
                float v = -INFINITY;
#pragma unroll
                for (int bj = 0; bj < 2; ++bj)
#pragma unroll
                    for (int n = 0; n < 2; ++n) { const f32x4 a = acc[ai][bj][m][n]; v = fmaxf(v, fmaxf(fmaxf(a[0], a[1]), fmaxf(a[2], a[3]))); }
                v = fmaxf(v, __shfl_xor(v, 16)); v = fmaxf(v, __shfl_xor(v, 32));
                if (fq == 0) X0[(ai * 64 + m * 16 + fr) * 4 + wc] = v;
            }
        asm volatile("s_waitcnt lgkmcnt(0)" ::: "memory"); __builtin_amdgcn_s_barrier(); asm volatile("" ::: "memory");
#pragma unroll
        for (int ai = 0; ai < 2; ++ai)
#pragma unroll
            for (int m = 0; m < 4; ++m) {
                const f32x4 p4 = *(const LAS f32x4*)(X0 + (ai * 64 + m * 16 + fr) * 4);
                const float mxr = fmaxf(fmaxf(p4[0], p4[1]), fmaxf(p4[2], p4[3])) * g.escale;
                float s = 0.f;
#pragma unroll
                for (int bj = 0; bj < 2; ++bj)
#pragma unroll
                    for (int n = 0; n < 2; ++n) { f32x4 a = acc[ai][bj][m][n];
                        a[0] = __builtin_amdgcn_exp2f(a[0] * g.escale - mxr); a[1] = __builtin_amdgcn_exp2f(a[1] * g.escale - mxr); a[2] = __builtin_amdgcn_exp2f(a[2] * g.escale - mxr); a[3] = __builtin_amdgcn_exp2f(a[3] * g.escale - mxr);
                        acc[ai][bj][m][n] = a; s += (a[0] + a[1]) + (a[2] + a[3]); }
                s += __shfl_xor(s, 16); s += __shfl_xor(s, 32);
                if (fq == 0) X1[(ai * 64 + m * 16 + fr) * 4 + wc] = s;
            }
        asm volatile("s_waitcnt lgkmcnt(0)" ::: "memory"); __builtin_amdgcn_s_barrier(); asm volatile("" ::: "memory");
        bf16_t* Cb = (bf16_t*)g.C;
        const int col0 = u.pn * BM + wc * 32 + 4 * fq;
#pragma unroll
        for (int ai = 0; ai < 2; ++ai)
#pragma unroll
            for (int m = 0; m < 4; ++m) {
                const f32x4 p4 = *(const LAS f32x4*)(X1 + (ai * 64 + m * 16 + fr) * 4);
                const float inv = 1.0f / ((p4[0] + p4[1]) + (p4[2] + p4[3]));
                bf16_t* rowp = Cb + (size_t)(row0 + ai * HALF + m * 16) * g.ldc + col0;
#pragma unroll
                for (int bj = 0; bj < 2; ++bj)
#pragma unroll
                    for (int n = 0; n < 2; ++n) {
                        const f32x4 a = acc[ai][bj][m][n];
                        uint2 o; o.x = pk2(a[0] * inv, a[1] * inv); o.y = pk2(a[2] * inv, a[3] * inv);
                        *(uint2*)(rowp + bj * HALF + n * 16) = o;
                    }
            }
    } else {
        bf16_t* Cb = (bf16_t*)g.C; int ccol = u.pn * BM;
        if constexpr (MODE == 4) { Cb += (size_t)(u.pn >> 2) * P6S; ccol = (u.pn & 3) * 256; }
        const int col0 = ccol + wc * 32 + 4 * fq;
#pragma unroll
        for (int ai = 0; ai < 2; ++ai)
#pragma unroll
            for (int m = 0; m < 4; ++m) {
                bf16_t* rowp = Cb + (size_t)(row0 + ai * HALF + m * 16) * g.ldc + col0;
#pragma unroll
                for (int bj = 0; bj < 2; ++bj)
#pragma unroll
                    for (int n = 0; n < 2; ++n) {
                        const f32x4 v = acc[ai][bj][m][n];
                        uint2 o; o.x = pk2(v[0], v[1]); o.y = pk2(v[2], v[3]);
                        *(uint2*)(rowp + bj * HALF + n * 16) = o;
                    }
            }
    }
}
template <int MODE> __device__ __forceinline__ void gemm_phase(LAS unsigned char* lds, const GJob& g, int tid) {
    const int wid = __builtin_amdgcn_readfirstlane(tid >> 6), lane = tid & 63, wr = wid >> 2, wc = wid & 3, fr = lane & 15, fq = lane >> 4;
    const int K = g.K, nt = K / BK;
    unsigned voffA[2], voffB[2];
#pragma unroll
    for (int i = 0; i < 2; ++i) { int R, C; stage_rc(tid * 16 + i * 8192, R, C);
        voffA[i] = (unsigned)(R * g.lda + C) * 2u; voffB[i] = (unsigned)(R * g.ldb + C) * 2u; }
    const size_t kstep = (size_t)(BK * 2);
    const size_t hstepA = (size_t)HALF * g.lda * 2, hstepB = (size_t)HALF * g.ldb * 2;
    const unsigned ldsw = (unsigned)wid * 1024u;
    const int aoff = lds_byte(wr * 64 + fr, fq * 8), boff = lds_byte(wc * 32 + fr, fq * 8);
#define PG8_SA(b, h) (((b) * 2 + (h)) * HTB)
#define PG8_SB(b, h) ((4 + (b) * 2 + (h)) * HTB)
#define PG8_STAGE(bufoff, gbase, voff) do { _Pragma("unroll") for (int _i = 0; _i < 2; ++_i) \
        __builtin_amdgcn_global_load_lds((const unsigned*)((const char*)(gbase) + (voff)[_i]), (LAS unsigned*)(lds + (bufoff) + ldsw + _i * 8192), 16, 0, 0); } while (0)
#define PG8_LDA(dst, b, h) do { _Pragma("unroll") for (int m = 0; m < 4; ++m) _Pragma("unroll") for (int k = 0; k < 2; ++k) dst[m][k] = *(const LAS bf16x8*)(lds + PG8_SA(b, h) + aoff + m * 2048 + k * 1024); } while (0)
#define PG8_LDB(dst, b, h) do { _Pragma("unroll") for (int n = 0; n < 2; ++n) _Pragma("unroll") for (int k = 0; k < 2; ++k) dst[n][k] = *(const LAS bf16x8*)(lds + PG8_SB(b, h) + boff + n * 2048 + k * 1024); } while (0)
#define PG8_MMA(ai, bj, At, Bt) do { __builtin_amdgcn_s_setprio(1); _Pragma("unroll") for (int m = 0; m < 4; ++m) _Pragma("unroll") for (int n = 0; n < 2; ++n) _Pragma("unroll") for (int k = 0; k < 2; ++k) \
        acc[ai][bj][m][n] = __builtin_amdgcn_mfma_f32_16x16x32_bf16(Bt[n][k], At[m][k], acc[ai][bj][m][n], 0, 0, 0); __builtin_amdgcn_s_setprio(0); } while (0)
#define PG8_WAIT_V(n) asm volatile("s_waitcnt vmcnt(" #n ")" ::: "memory")
#define PG8_WAIT_L(n) asm volatile("s_waitcnt lgkmcnt(" #n ")" ::: "memory")
#define PG8_BAR __builtin_amdgcn_s_barrier()
#define PG8_SCHED __builtin_amdgcn_sched_barrier(0)
#define PG8_ABASE(u) ((const char*)g.A + ((size_t)(u).pm * g.a_pm_step + (size_t)(((u).pn >> g.a_pn_shift) & g.a_pn_mask) * g.a_pn_step) * 2)
#define PG8_BBASE(u) ((const char*)g.Bt + ((size_t)((u).pn & g.b_pn_mask) * g.b_pn_step + (size_t)((u).pn >> g.b_pn_shift) * g.b_pn_step2 + (size_t)((u).pm >> g.b_pm_shift) * g.b_pm_step) * 2)
    Unit cur, nxt; int ui = 0;
    if (!unit_next(g, 0, cur)) return;
    f32x4 acc[2][2][4][2];
#pragma unroll
    for (int a = 0; a < 2; ++a)
#pragma unroll
        for (int b = 0; b < 2; ++b)
#pragma unroll
            for (int m = 0; m < 4; ++m)
#pragma unroll
                for (int n = 0; n < 2; ++n) acc[a][b][m][n] = (f32x4){0.f, 0.f, 0.f, 0.f};
    bf16x8 At[4][2], B0[2][2], B1[2][2];
    const char* cA = PG8_ABASE(cur); const char* cB = PG8_BBASE(cur);
    PG8_STAGE(PG8_SB(0, 0), cB, voffB); PG8_STAGE(PG8_SA(0, 0), cA, voffA); PG8_STAGE(PG8_SB(0, 1), cB + hstepB, voffB); PG8_STAGE(PG8_SA(0, 1), cA + hstepA, voffA);
    if (wr == 1) PG8_BAR;
    PG8_WAIT_V(4); PG8_BAR;
    PG8_STAGE(PG8_SB(1, 0), cB + kstep, voffB); PG8_STAGE(PG8_SA(1, 0), cA + kstep, voffA); PG8_STAGE(PG8_SB(1, 1), cB + hstepB + kstep, voffB);
    PG8_WAIT_V(6); PG8_BAR;
    for (;;) {
        const bool has_next = unit_next(g, ui + 1, nxt);
        const char* nA = has_next ? PG8_ABASE(nxt) : cA; const char* nB = has_next ? PG8_BBASE(nxt) : cB;
        for (int t = 0; t < nt; t += 2) {
            const bool last = (t == nt - 2);
            const char* a1 = cA + (size_t)(t + 1) * kstep;
            const char* a2 = last ? nA : cA + (size_t)(t + 2) * kstep; const char* b2 = last ? nB : cB + (size_t)(t + 2) * kstep;
            const char* a3 = a2 + kstep; const char* b3 = b2 + kstep;
            PG8_LDB(B0, 0, 0); PG8_SCHED; PG8_LDA(At, 0, 0); PG8_STAGE(PG8_SA(1, 1), a1 + hstepA, voffA);
            PG8_WAIT_L(8); PG8_BAR; PG8_WAIT_L(0); PG8_MMA(0, 0, At, B0); PG8_BAR; PG8_SCHED;
            PG8_LDB(B1, 0, 1); PG8_STAGE(PG8_SB(0, 0), b2, voffB);
            PG8_BAR; PG8_WAIT_L(0); PG8_MMA(0, 1, At, B1); PG8_BAR;
            PG8_LDA(At, 0, 1); PG8_STAGE(PG8_SA(0, 0), a2, voffA);
            PG8_BAR; PG8_WAIT_L(0); PG8_MMA(1, 0, At, B0); PG8_BAR; PG8_SCHED;
            PG8_STAGE(PG8_SB(0, 1), b2 + hstepB, voffB);
            PG8_WAIT_V(6); PG8_BAR; PG8_MMA(1, 1, At, B1); PG8_BAR;
            PG8_LDB(B0, 1, 0); PG8_SCHED; PG8_LDA(At, 1, 0); PG8_STAGE(PG8_SA(0, 1), a2 + hstepA, voffA);
            PG8_WAIT_L(8); PG8_BAR; PG8_WAIT_L(0); PG8_MMA(0, 0, At, B0); PG8_BAR; PG8_SCHED;
            PG8_LDB(B1, 1, 1); PG8_STAGE(PG8_SB(1, 0), b3, voffB);
            PG8_BAR; PG8_WAIT_L(0); PG8_MMA(0, 1, At, B1); PG8_BAR;
            PG8_LDA(At, 1, 1); PG8_STAGE(PG8_SA(1, 0), a3, voffA);
            PG8_BAR; PG8_WAIT_L(0); PG8_MMA(1, 0, At, B0); PG8_BAR; PG8_SCHED;
            PG8_STAGE(PG8_SB(1, 1), b3 + hstepB, voffB);
            PG8_WAIT_V(6); PG8_BAR; PG8_MMA(1, 1, At, B1); PG8_BAR;
        }
        epilogue<MODE>(g, acc, cur, wr, wc, fr, fq, lds + GEMM_LDS + 1024);
        if (!has_next) break;
#pragma unroll
        for (int a = 0; a < 2; ++a)
#pragma unroll
            for (int b = 0; b < 2; ++b)
#pragma unroll
                for (int m = 0; m < 4; ++m)
#pragma unroll
                    for (int n = 0; n < 2; ++n) acc[a][b][m][n] = (f32x4){0.f, 0.f, 0.f, 0.f};
        cur = nxt; cA = nA; cB = nB; ++ui;
    }
    PG8_WAIT_V(0);
    if (wr == 0) PG8_BAR;
    PG8_BAR;
#undef PG8_SA
#undef PG8_SB
#undef PG8_STAGE
#undef PG8_LDA
#undef PG8_LDB
#undef PG8_MMA
#undef PG8_WAIT_V
#undef PG8_WAIT_L
#undef PG8_BAR
#undef PG8_SCHED
#undef PG8_ABASE
#undef PG8_BBASE
}
}

__device__ __forceinline__ void p0_transpose_item(const float* W, int ldw, int K, int csrc0, bf16_t* WT, int row0, LAS float* scr, int kb, int lane, float wscale) {
    const int k0 = 64 * kb;
#pragma unroll
    for (int i = 0; i < 8; ++i) { const int kk = 8 * i + (lane >> 3), n4 = (lane & 7) * 4;
        const float4 v = *(const float4*)(W + (size_t)(k0 + kk) * ldw + csrc0 + n4);
        scr[kk * 33 + n4] = v.x * wscale; scr[kk * 33 + n4 + 1] = v.y * wscale; scr[kk * 33 + n4 + 2] = v.z * wscale; scr[kk * 33 + n4 + 3] = v.w * wscale; }
    asm volatile("s_waitcnt lgkmcnt(0)" ::: "memory");
    const int c = lane & 7;
#pragma unroll
    for (int j = 0; j < 4; ++j) { const int n = (lane >> 3) + 8 * j; const LAS float* s = scr + (8 * c) * 33 + n;
        uint4 o; o.x = pk2(s[0 * 33], s[1 * 33]); o.y = pk2(s[2 * 33], s[3 * 33]); o.z = pk2(s[4 * 33], s[5 * 33]); o.w = pk2(s[6 * 33], s[7 * 33]);
        *(uint4*)(WT + (size_t)(row0 + n) * K + k0 + 8 * c) = o; }
    asm volatile("s_waitcnt lgkmcnt(0)" ::: "memory");
}

__device__ __forceinline__ void d_conv_silu(int vb, int tid, const bf16_t* __restrict__ p6, const float* __restrict__ cw, const float* __restrict__ cb, bf16_t* __restrict__ c) {
    const int t = vb, s = t % S;
    for (int ch = tid; ch < 1024; ch += 256) {
        float y = cb[ch];
#pragma unroll
        for (int j = 0; j < 4; ++j) {
            const int ss = s - 3 + j;
            if (ss >= 0) y = fmaf(cw[j * 1024 + ch], bf2f(p6[(size_t)(t - 3 + j) * 1024 + ch]), y);
        }
        c[(size_t)t * 1024 + ch] = (bf16_t)f2bf(y / (1.0f + expf(-y)));
    }
}

__device__ __forceinline__ void d_mlstm(int vb, int tid, const bf16_t* __restrict__ mq, const bf16_t* __restrict__ mk, const bf16_t* __restrict__ p6,
                                        const float* __restrict__ gpre, const float* __restrict__ b_mi, const float* __restrict__ b_mf, float* __restrict__ hraw) {
    const int lane = tid & 63, w = tid >> 6;
    const int gid = vb * 4 + w;
    const int e = gid & 255, h = (gid >> 8) & 3, b = gid >> 10;
    const float bi = b_mi[h], bf = b_mf[h];
    float C0 = 0.f, C1 = 0.f, C2 = 0.f, C3 = 0.f, n0 = 0.f, n1 = 0.f, n2 = 0.f, n3 = 0.f, m = 0.f;
    const size_t tb = (size_t)b * S;
    const bf16_t* qp = mq + tb * 1024 + h * 256 + lane * 4;
    const bf16_t* kp = mk + tb * 1024 + h * 256 + lane * 4;
    const bf16_t* pp = p6 + P6S + tb * 1024 + h * 256 + e;
    ushort4 qn = *(const ushort4*)qp, kn = *(const ushort4*)kp;
    const float* gp = gpre + tb * 8;
    float vn = bf2f(pp[0]), in_ = gp[h], fn = gp[4 + h];
    for (int s = 0; s < S; ++s) {
        const float4 q = make_float4(bf2f(qn.x), bf2f(qn.y), bf2f(qn.z), bf2f(qn.w)), k = make_float4(bf2f(kn.x), bf2f(kn.y), bf2f(kn.z), bf2f(kn.w)); const float v = vn, ipre = in_ + bi, fpre = fn + bf;
        if (s + 1 < S) {
            qn = *(const ushort4*)(qp + (size_t)(s + 1) * 1024);
            kn = *(const ushort4*)(kp + (size_t)(s + 1) * 1024);
            vn = bf2f(pp[(size_t)(s + 1) * 1024]); in_ = gp[(size_t)(s + 1) * 8 + h]; fn = gp[(size_t)(s + 1) * 8 + 4 + h];
        }
        const float logf = log_sigmoid(fpre);
        const float mnew = fmaxf(logf + m, ipre);
        const float fd = expf(logf + m - mnew), ig = expf(ipre - mnew);
        m = mnew;
        const float sc = ig * 0.0625f;
        C0 = fd * C0 + sc * k.x * v; C1 = fd * C1 + sc * k.y * v; C2 = fd * C2 + sc * k.z * v; C3 = fd * C3 + sc * k.w * v;
        n0 = fd * n0 + sc * k.x; n1 = fd * n1 + sc * k.y; n2 = fd * n2 + sc * k.z; n3 = fd * n3 + sc * k.w;
        float num = q.x * C0 + q.y * C1 + q.z * C2 + q.w * C3;
        float den = q.x * n0 + q.y * n1 + q.z * n2 + q.w * n3;
        num = wave_sum(num); den = wave_sum(den);
        if (lane == 0) hraw[(tb + s) * 1024 + h * 256 + e] = num / fmaxf(fabsf(den), expf(-mnew));
    }
}

__device__ __forceinline__ void d_mhead_norm(int vb, int tid, const float* __restrict__ hraw, const bf16_t* __restrict__ p6, const float* __restrict__ g, bf16_t* __restrict__ mix) {
    const int t = vb, h = tid >> 6, lane = tid & 63;
    const float4 v = *(const float4*)(hraw + (size_t)t * 1024 + h * 256 + lane * 4);
    float s = v.x * v.x + v.y * v.y + v.z * v.z + v.w * v.w;
    s = wave_sum(s);
    const float r = rsqrtf(s * (1.0f / 256.0f) + EPS);
    const float4 gg = *(const float4*)(g + h * 256 + lane * 4);
    const ushort4 mo = *(const ushort4*)(p6 + 2 * P6S + (size_t)t * 1024 + h * 256 + lane * 4);
    float4 o;
    o.x = v.x * r * gg.x / (1.0f + expf(-bf2f(mo.x)));
    o.y = v.y * r * gg.y / (1.0f + expf(-bf2f(mo.y)));
    o.z = v.z * r * gg.z / (1.0f + expf(-bf2f(mo.z)));
    o.w = v.w * r * gg.w / (1.0f + expf(-bf2f(mo.w)));
    uint2 ob; ob.x = pk2(o.x, o.y); ob.y = pk2(o.z, o.w);
    *(uint2*)(mix + (size_t)t * D + h * 256 + lane * 4) = ob;
}

__device__ __forceinline__ void d_rope(int vb, int tid, bf16_t* __restrict__ p6) {
    const int t = vb, s = t % S;
    for (int idx = tid; idx < 2 * 8 * 64; idx += 256) {
        const int i = idx & 63, hd = (idx >> 6) & 7, qk = idx >> 9;
        const float inv = exp2f(-(float)i * 0.20762050593046014f);
        const float ang = (float)s * inv;
        float sn, cs; sincosf(ang, &sn, &cs);
        bf16_t* p = p6 + (size_t)(3 + qk) * P6S + (size_t)t * 1024 + hd * 128;
        const float x1 = bf2f(p[i]), x2 = bf2f(p[64 + i]);
        p[i] = (bf16_t)f2bf(x1 * cs - x2 * sn);
        p[64 + i] = (bf16_t)f2bf(x2 * cs + x1 * sn);
    }
}

__device__ __forceinline__ void d_dilated(int vb, int tid, float* sm, const bf16_t* __restrict__ p6, const float* __restrict__ g_ahead, bf16_t* __restrict__ mix) {
    float (*qs)[128] = (float (*)[128])sm;
    float (*ps)[576] = (float (*)[576])(sm + 512);
    const int lane = tid & 63, w = tid >> 6;
    const int gid = vb * 4 + w;
    const int s = gid % S, hd = (gid / S) & 7, b = gid / (S * 8);
    const size_t t = (size_t)b * S + s;
    const bf16_t* qrow = p6 + 3 * P6S + t * 1024 + hd * 128;
    __syncthreads();
    qs[w][lane] = bf2f(qrow[lane]); qs[w][lane + 64] = bf2f(qrow[lane + 64]);
    __syncthreads();
    const float scale = 0.08838834764831845f;
    float mloc = -INFINITY;
    for (int br = 0; br < 3; ++br) {
        const int dil = br == 0 ? 1 : (br == 1 ? 4 : 16);
        for (int jj = 0; jj < 192; jj += 64) {
            const int j = jj + lane;
            float sc = -INFINITY;
            if (j <= 128 && s - j * dil >= 0) {
                const bf16_t* krow = p6 + 4 * P6S + (t - (size_t)j * dil) * 1024 + hd * 128;
                float d = 0.f;
#pragma unroll 8
                for (int c = 0; c < 128; c += 4) {
                    const ushort4 kv = *(const ushort4*)(krow + c);
                    d = fmaf(qs[w][c], bf2f(kv.x), d); d = fmaf(qs[w][c + 1], bf2f(kv.y), d); d = fmaf(qs[w][c + 2], bf2f(kv.z), d); d = fmaf(qs[w][c + 3], bf2f(kv.w), d);
                }
                sc = d * scale;
            }
            ps[w][br * 192 + j] = sc;
            mloc = fmaxf(mloc, sc);
        }
    }
    const float mx = wave_max(mloc);
    __syncthreads();
    float lsum = 0.f;
    for (int i = lane; i < 3 * 192; i += 64) {
        const float sc = ps[w][i];
        const float pv = (sc == -INFINITY) ? 0.f : expf(sc - mx);
        ps[w][i] = pv; lsum += pv;
    }
    const float tot = wave_sum(lsum);
    __syncthreads();
    float o0 = 0.f, o1 = 0.f;
    for (int br = 0; br < 3; ++br) {
        const int dil = br == 0 ? 1 : (br == 1 ? 4 : 16);
        for (int j = 0; j <= 128; ++j) {
            if (s - j * dil < 0) break;
            const float pv = ps[w][br * 192 + j];
            const bf16_t* vrow = p6 + 5 * P6S + (t - (size_t)j * dil) * 1024 + hd * 128;
            o0 = fmaf(pv, bf2f(vrow[lane]), o0); o1 = fmaf(pv, bf2f(vrow[lane + 64]), o1);
        }
    }
    o0 /= tot; o1 /= tot;
    float ss = wave_sum(o0 * o0 + o1 * o1);
    const float r = rsqrtf(ss * (1.0f / 128.0f) + EPS);
    bf16_t* orow = mix + t * D + 1024 + hd * 128;
    orow[lane] = (bf16_t)f2bf(o0 * r * g_ahead[hd * 128 + lane]);
    orow[lane + 64] = (bf16_t)f2bf(o1 * r * g_ahead[hd * 128 + lane + 64]);
}

__device__ __forceinline__ void d_cross(int vb, int tid, float* sm, const bf16_t* __restrict__ q, const float* __restrict__ km, const float* __restrict__ vm, bf16_t* __restrict__ o) {
    float (*qs)[512] = (float (*)[512])sm;
    float (*ps)[256] = (float (*)[256])(sm + 2048);
    const int lane = tid & 63, w = tid >> 6;
    const int t = vb, hd = w, b = t / S;
    const bf16_t* qrow = q + (size_t)t * D + hd * 512;
    __syncthreads();
    for (int i = lane; i < 512; i += 64) qs[w][i] = bf2f(qrow[i]);
    __syncthreads();
    const float scale = 0.04419417382415922f;
    float sc[4]; float mloc = -INFINITY;
#pragma unroll
    for (int r = 0; r < 4; ++r) {
        const int mi = lane + 64 * r;
        const float* krow = km + ((size_t)b * 256 + mi) * D + hd * 512;
        float d = 0.f;
#pragma unroll 8
        for (int c = 0; c < 512; c += 4) {
            const float4 kv = *(const float4*)(krow + c);
            d = fmaf(qs[w][c], kv.x, d); d = fmaf(qs[w][c + 1], kv.y, d); d = fmaf(qs[w][c + 2], kv.z, d); d = fmaf(qs[w][c + 3], kv.w, d);
        }
        sc[r] = d * scale; mloc = fmaxf(mloc, sc[r]);
    }
    const float mx = wave_max(mloc);
    float lsum = 0.f;
#pragma unroll
    for (int r = 0; r < 4; ++r) { const float pv = expf(sc[r] - mx); ps[w][lane + 64 * r] = pv; lsum += pv; }
    const float tot = wave_sum(lsum);
    __syncthreads();
    float acc[8];
#pragma unroll
    for (int i = 0; i < 8; ++i) acc[i] = 0.f;
    for (int mi = 0; mi < 256; ++mi) {
        const float pv = ps[w][mi];
        const float* vrow = vm + ((size_t)b * 256 + mi) * D + hd * 512;
#pragma unroll
        for (int i = 0; i < 8; ++i) acc[i] = fmaf(pv, vrow[lane + 64 * i], acc[i]);
    }
    bf16_t* orow = o + (size_t)t * D + hd * 512;
#pragma unroll
    for (int i = 0; i < 8; ++i) orow[lane + 64 * i] = (bf16_t)f2bf(acc[i] / tot);
}

__device__ __forceinline__ void wave_argmax(float& best, int& bidx) {
#pragma unroll
    for (int o = 32; o >= 1; o >>= 1) {
        const float ob = __shfl_xor(best, o); const int oi = __shfl_xor(bidx, o);
        if (ob > best || (ob == best && oi < bidx)) { best = ob; bidx = oi; }
    }
}
__device__ __forceinline__ void d_peer_topk(int vb, int tid, float* sm, const bf16_t* __restrict__ qp, const float* __restrict__ sub_keys, int* __restrict__ ids, float* __restrict__ gates) {
    float (*qs)[256] = (float (*)[256])sm;
    const int lane = tid & 63, w = tid >> 6;
    const int gid = vb * 4 + w;
    const int hd = gid & 7, t = gid >> 3;
    const bf16_t* qrow = qp + (size_t)t * D + hd * 256;
    __syncthreads();
    for (int i = lane; i < 256; i += 64) qs[w][i] = bf2f(qrow[i]);
    __syncthreads();
    float tops[2]; int topi[2];
#pragma unroll
    for (int p = 0; p < 2; ++p) {
        float v0, v1;
        {
            const float* k0 = sub_keys + ((size_t)(hd * 2 + p) * 128 + lane) * 128;
            const float* k1 = k0 + 64 * 128;
            float d0 = 0.f, d1 = 0.f;
#pragma unroll 8
            for (int c = 0; c < 128; c += 4) {
                const float4 a = *(const float4*)(k0 + c), bb = *(const float4*)(k1 + c);
                const float q0 = qs[w][p * 128 + c], q1 = qs[w][p * 128 + c + 1], q2 = qs[w][p * 128 + c + 2], q3 = qs[w][p * 128 + c + 3];
                d0 = fmaf(q0, a.x, d0); d0 = fmaf(q1, a.y, d0); d0 = fmaf(q2, a.z, d0); d0 = fmaf(q3, a.w, d0);
                d1 = fmaf(q0, bb.x, d1); d1 = fmaf(q1, bb.y, d1); d1 = fmaf(q2, bb.z, d1); d1 = fmaf(q3, bb.w, d1);
            }
            v0 = d0; v1 = d1;
        }
        float ts = 0.f; int ti = 0;
        for (int it = 0; it < 16; ++it) {
            float best; int bidx;
            if (v0 >= v1) { best = v0; bidx = lane; } else { best = v1; bidx = lane + 64; }
            wave_argmax(best, bidx);
            if (lane == it) { ts = best; ti = bidx; }
            if (bidx == lane) v0 = -INFINITY;
            if (bidx == lane + 64) v1 = -INFINITY;
        }
        tops[p] = ts; topi[p] = ti;
    }
    float cv[4]; int ci[4];
#pragma unroll
    for (int r = 0; r < 4; ++r) {
        const int c = lane * 4 + r, i = c >> 4, j = c & 15;
        const float s0 = __shfl(tops[0], i), s1 = __shfl(tops[1], j);
        const int i0 = __shfl(topi[0], i), i1 = __shfl(topi[1], j);
        cv[r] = s0 + s1; ci[r] = i0 * 128 + i1;
    }
    float bs = 0.f; int bid = 0;
    for (int it = 0; it < 16; ++it) {
        float best = cv[0]; int bidx = lane * 4;
#pragma unroll
        for (int r = 1; r < 4; ++r) if (cv[r] > best) { best = cv[r]; bidx = lane * 4 + r; }
        wave_argmax(best, bidx);
        const int owner = bidx >> 2, rr = bidx & 3;
        int myid = ci[0];
        if (rr == 1) myid = ci[1]; else if (rr == 2) myid = ci[2]; else if (rr == 3) myid = ci[3];
        const int eid = __shfl(myid, owner);
        if (lane == it) { bs = best; bid = eid; }
        if (owner == lane) {
#pragma unroll
            for (int r = 0; r < 4; ++r) if (rr == r) cv[r] = -INFINITY;
        }
    }
    float v = lane < 16 ? bs : -INFINITY;
    const float mx = wave_max(v);
    const float ev = lane < 16 ? expf(bs - mx) : 0.f;
    const float tot = wave_sum(ev);
    if (lane < 16) {
        ids[(size_t)t * 128 + hd * 16 + lane] = bid;
        gates[(size_t)t * 128 + hd * 16 + lane] = ev / tot;
    }
}

__device__ __forceinline__ void d_peer_out(int vb, int tid, float* sm, const bf16_t* __restrict__ h3, const float* __restrict__ x2, const int* __restrict__ ids, const float* __restrict__ gates,
                                           const bf16_t* __restrict__ u_tab, const bf16_t* __restrict__ v_tab, const float* __restrict__ g_final, float* __restrict__ out) {
    float (*part)[2048] = (float (*)[2048])sm;
    float* red = sm + 4 * 2048;
    const int lane = tid & 63, w = tid >> 6, t = vb;
    float4 xr[8], acc[8];
    const bf16_t* hrow = h3 + (size_t)t * D;
#pragma unroll
    for (int i = 0; i < 8; ++i) { const ushort4 hv = *(const ushort4*)(hrow + i * 256 + lane * 4);
        xr[i] = make_float4(bf2f(hv.x), bf2f(hv.y), bf2f(hv.z), bf2f(hv.w)); acc[i] = make_float4(0.f, 0.f, 0.f, 0.f); }
    for (int j = 0; j < 32; ++j) {
        const int slot = w * 32 + j;
        const int e = ids[(size_t)t * 128 + slot];
        const float gt = gates[(size_t)t * 128 + slot];
        const bf16_t* ur = u_tab + (size_t)e * D;
        const bf16_t* vr = v_tab + (size_t)e * D;
        float d = 0.f;
#pragma unroll
        for (int i = 0; i < 8; ++i) {
            const ushort4 u = *(const ushort4*)(ur + i * 256 + lane * 4);
            d = fmaf(xr[i].x, bf2f(u.x), d); d = fmaf(xr[i].y, bf2f(u.y), d); d = fmaf(xr[i].z, bf2f(u.z), d); d = fmaf(xr[i].w, bf2f(u.w), d);
        }
        d = wave_sum(d);
        const float act = 0.5f * d * (1.0f + erff(d * 0.7071067811865476f));
        const float cf = gt * act;
#pragma unroll
        for (int i = 0; i < 8; ++i) {
            const ushort4 v = *(const ushort4*)(vr + i * 256 + lane * 4);
            acc[i].x = fmaf(cf, bf2f(v.x), acc[i].x); acc[i].y = fmaf(cf, bf2f(v.y), acc[i].y); acc[i].z = fmaf(cf, bf2f(v.z), acc[i].z); acc[i].w = fmaf(cf, bf2f(v.w), acc[i].w);
        }
    }
    __syncthreads();
#pragma unroll
    for (int i = 0; i < 8; ++i) *(float4*)&part[w][i * 256 + lane * 4] = acc[i];
    __syncthreads();
    float4 r0, r1;
    {
        const float4 a = *(const float4*)&part[0][tid * 4], b = *(const float4*)&part[1][tid * 4], c = *(const float4*)&part[2][tid * 4], d = *(const float4*)&part[3][tid * 4];
        const float4 x = *(const float4*)(x2 + (size_t)t * D + tid * 4);
        r0 = make_float4(x.x + a.x + b.x + c.x + d.x, x.y + a.y + b.y + c.y + d.y, x.z + a.z + b.z + c.z + d.z, x.w + a.w + b.w + c.w + d.w);
    }
    {
        const float4 a = *(const float4*)&part[0][1024 + tid * 4], b = *(const float4*)&part[1][1024 + tid * 4], c = *(const float4*)&part[2][1024 + tid * 4], d = *(const float4*)&part[3][1024 + tid * 4];
        const float4 x = *(const float4*)(x2 + (size_t)t * D + 1024 + tid * 4);
        r1 = make_float4(x.x + a.x + b.x + c.x + d.x, x.y + a.y + b.y + c.y + d.y, x.z + a.z + b.z + c.z + d.z, x.w + a.w + b.w + c.w + d.w);
    }
    float s = r0.x * r0.x + r0.y * r0.y + r0.z * r0.z + r0.w * r0.w + r1.x * r1.x + r1.y * r1.y + r1.z * r1.z + r1.w * r1.w;
    s = wave_sum(s);
    if (lane == 0) red[w] = s;
    __syncthreads();
    const float tot = red[0] + red[1] + red[2] + red[3];
    const float r = rsqrtf(tot * (1.0f / D) + EPS);
    const float4 g0 = *(const float4*)(g_final + tid * 4), g1 = *(const float4*)(g_final + 1024 + tid * 4);
    *(float4*)(out + (size_t)t * D + tid * 4) = make_float4(r0.x * r * g0.x, r0.y * r * g0.y, r0.z * r * g0.z, r0.w * r * g0.w);
    *(float4*)(out + (size_t)t * D + 1024 + tid * 4) = make_float4(r1.x * r * g1.x, r1.y * r * g1.y, r1.z * r * g1.z, r1.w * r * g1.w);
}


__device__ __forceinline__ float wave_incl_scan_add(float v, int lane) {
#pragma unroll
    for (int o = 1; o < 64; o <<= 1) { const float t = __shfl_up(v, o); if (lane >= o) v += t; }
    return v;
}
__device__ __forceinline__ float wave_incl_scan_max(float v, int lane) {
#pragma unroll
    for (int o = 1; o < 64; o <<= 1) { const float t = __shfl_up(v, o); if (lane >= o) v = fmaxf(v, t); }
    return v;
}
__device__ __forceinline__ void mlstm_gates_wave(int b, int h, int lane, const float* __restrict__ gpre, const float* __restrict__ b_mi, const float* __restrict__ b_mf,
                                                 float* __restrict__ gs, float* __restrict__ decay) {
    const float bi = b_mi[h], bf = b_mf[h];
    float mprev = 0.f;
    for (int c = 0; c < 16; ++c) {
        const size_t t0 = (size_t)b * S + c * 256 + lane * 4;
        float logi[4], lf[4], bb[4];
#pragma unroll
        for (int j = 0; j < 4; ++j) { logi[j] = gpre[(t0 + j) * 8 + h] + bi; lf[j] = log_sigmoid(gpre[(t0 + j) * 8 + 4 + h] + bf); }
        bb[0] = lf[0]; bb[1] = bb[0] + lf[1]; bb[2] = bb[1] + lf[2]; bb[3] = bb[2] + lf[3];
        const float incl = wave_incl_scan_add(bb[3], lane);
        const float excl = incl - bb[3];
#pragma unroll
        for (int j = 0; j < 4; ++j) bb[j] += excl;
        const float g = __shfl(incl, 63);
        float amax = -INFINITY, uu[4], cm[4];
#pragma unroll
        for (int j = 0; j < 4; ++j) { amax = fmaxf(amax, logi[j] + g - bb[j]); uu[j] = logi[j] - bb[j]; }
        amax = wave_max(amax);
        const float mnew = fmaxf(g + mprev, amax);
        cm[0] = uu[0]; cm[1] = fmaxf(cm[0], uu[1]); cm[2] = fmaxf(cm[1], uu[2]); cm[3] = fmaxf(cm[2], uu[3]);
        const float cincl = wave_incl_scan_max(cm[3], lane);
        float cexcl = __shfl_up(cincl, 1); if (lane == 0) cexcl = -INFINITY;
#pragma unroll
        for (int j = 0; j < 4; ++j) {
            const float M = fmaxf(mprev, fmaxf(cexcl, cm[j]));
            float* o = gs + ((t0 + j) * 4 + h) * 8;
            o[0] = uu[j] * 1.4426950408889634f; o[1] = M * 1.4426950408889634f; o[2] = expf(logi[j] + g - bb[j] - mnew); o[3] = expf(mprev - M); o[4] = expf(-(bb[j] + M));
        }
        if (lane == 0) decay[(b * 16 + c) * 4 + h] = expf(g + mprev - mnew);
        mprev = mnew;
    }
}
__device__ __forceinline__ void transpose_tile64(int tid, float* sm, const bf16_t* __restrict__ src, int src_ld, bf16_t* __restrict__ dst, int dst_ld, const float* __restrict__ scale, int sstride) {
    unsigned short (*tl)[66] = (unsigned short (*)[66])sm;
    __syncthreads();
#pragma unroll
    for (int i = 0; i < 2; ++i) {
        const int ch = tid + i * 256, r = ch >> 3, c8 = (ch & 7) * 8;
        const uint4 v = *(const uint4*)(src + (size_t)r * src_ld + c8);
        const float sc = scale ? scale[(size_t)r * sstride] : 1.0f;
        const unsigned w[4] = {v.x, v.y, v.z, v.w};
#pragma unroll
        for (int k = 0; k < 4; ++k) {
            tl[r][c8 + 2 * k] = (unsigned short)f2bf(bf2f((unsigned short)(w[k] & 0xFFFFu)) * sc);
            tl[r][c8 + 2 * k + 1] = (unsigned short)f2bf(bf2f((unsigned short)(w[k] >> 16)) * sc);
        }
    }
    __syncthreads();
#pragma unroll
    for (int i = 0; i < 2; ++i) {
        const int ch = tid + i * 256, c = ch >> 3, r8 = (ch & 7) * 8;
        uint4 o;
        o.x = (unsigned)tl[r8 + 0][c] | ((unsigned)tl[r8 + 1][c] << 16); o.y = (unsigned)tl[r8 + 2][c] | ((unsigned)tl[r8 + 3][c] << 16);
        o.z = (unsigned)tl[r8 + 4][c] | ((unsigned)tl[r8 + 5][c] << 16); o.w = (unsigned)tl[r8 + 6][c] | ((unsigned)tl[r8 + 7][c] << 16);
        *(uint4*)(dst + (size_t)c * dst_ld + r8) = o;
    }
}

__device__ __forceinline__ void rope_table_fill(float2* __restrict__ cs, int gtid, int nth) {
    for (int idx = gtid; idx < 4096 * 64; idx += nth) {
        const int i = idx & 63, s = idx >> 6;
        const float inv = exp2f(-(float)i * 0.20762050593046014f);
        const float ang = (float)s * inv;
        float sn, c; sincosf(ang, &sn, &c);
        cs[idx] = make_float2(c, sn);
    }
}
__device__ __forceinline__ void rope_q_pass(bf16_t* __restrict__ aq, const float2* __restrict__ cs, size_t gtid, size_t nth) {
    for (size_t idx = gtid; idx < (size_t)T * 8 * 8; idx += nth) {
        const int c8 = (int)(idx & 7), hd = (int)((idx >> 3) & 7); const size_t t = idx >> 6; const int s = (int)(t & (S - 1));
        bf16_t* p = aq + t * 1024 + hd * 128 + c8 * 8;
        const uint4 a = *(const uint4*)p, b = *(const uint4*)(p + 64);
        const unsigned aw[4] = {a.x, a.y, a.z, a.w}, bw[4] = {b.x, b.y, b.z, b.w};
        unsigned ao[4], bo[4];
#pragma unroll
        for (int k = 0; k < 4; ++k) {
            const float4 cc = *(const float4*)(cs + (size_t)s * 64 + c8 * 8 + 2 * k);
            const float x10 = __uint_as_float(aw[k] << 16), x11 = __uint_as_float(aw[k] & 0xFFFF0000u), x20 = __uint_as_float(bw[k] << 16), x21 = __uint_as_float(bw[k] & 0xFFFF0000u);
            ao[k] = pk2(x10 * cc.x - x20 * cc.y, x11 * cc.z - x21 * cc.w);
            bo[k] = pk2(x20 * cc.x + x10 * cc.y, x21 * cc.z + x11 * cc.w);
        }
        *(uint4*)p = make_uint4(ao[0], ao[1], ao[2], ao[3]); *(uint4*)(p + 64) = make_uint4(bo[0], bo[1], bo[2], bo[3]);
    }
}
__device__ __forceinline__ void dil_tile_prep(int item, int lane, LAS unsigned short* wl, const bf16_t* __restrict__ ak, const bf16_t* __restrict__ av, const float2* __restrict__ cs,
                                              bf16_t* __restrict__ KB, bf16_t* __restrict__ VB) {
    const int TT = item & 255, hd = (item >> 8) & 7, b = (item >> 11) & 1, br = item >> 12;
    const int ld = 2 * br, tpr = 256 >> ld, rho = TT / tpr, tile = TT - rho * tpr;
    const int i = lane & 15, c = lane >> 4;
    const int s = rho + ((16 * tile + i) << ld);
    const size_t trow = (size_t)b * S + s;
    bf16_t* kdst = KB + (size_t)item * 2048;
    bf16_t* vdst = VB + (size_t)item * 2048;
    {
        const bf16_t* kr = ak + trow * 1024 + hd * 128 + 16 * c;
        const uint4 a0 = *(const uint4*)kr, a1 = *(const uint4*)(kr + 8), b0 = *(const uint4*)(kr + 64), b1 = *(const uint4*)(kr + 72);
        const unsigned aw[8] = {a0.x, a0.y, a0.z, a0.w, a1.x, a1.y, a1.z, a1.w}, bw[8] = {b0.x, b0.y, b0.z, b0.w, b1.x, b1.y, b1.z, b1.w};
        unsigned ao[8], bo[8];
#pragma unroll
        for (int k = 0; k < 8; ++k) {
            const float4 cc = *(const float4*)(cs + (size_t)s * 64 + 16 * c + 2 * k);
            const float x10 = __uint_as_float(aw[k] << 16), x11 = __uint_as_float(aw[k] & 0xFFFF0000u), x20 = __uint_as_float(bw[k] << 16), x21 = __uint_as_float(bw[k] & 0xFFFF0000u);
            ao[k] = pk2(x10 * cc.x - x20 * cc.y, x11 * cc.z - x21 * cc.w);
            bo[k] = pk2(x20 * cc.x + x10 * cc.y, x21 * cc.z + x11 * cc.w);
        }
        bf16_t* d0 = kdst + (c >> 1) * 512 + i * 32 + (c & 1) * 16;
        *(uint4*)d0 = make_uint4(ao[0], ao[1], ao[2], ao[3]); *(uint4*)(d0 + 8) = make_uint4(ao[4], ao[5], ao[6], ao[7]);
        bf16_t* d1 = d0 + 1024;
        *(uint4*)d1 = make_uint4(bo[0], bo[1], bo[2], bo[3]); *(uint4*)(d1 + 8) = make_uint4(bo[4], bo[5], bo[6], bo[7]);
    }
    {
        const bf16_t* vr = av + trow * 1024 + hd * 128 + 32 * c;
        const uint4 v0 = *(const uint4*)vr, v1 = *(const uint4*)(vr + 8), v2 = *(const uint4*)(vr + 16), v3 = *(const uint4*)(vr + 24);
        LAS unsigned short* wr = wl + i * 136 + 32 * c;
        typedef unsigned u32x4_t __attribute__((ext_vector_type(4)));
        *(LAS u32x4_t*)wr = (u32x4_t){v0.x, v0.y, v0.z, v0.w}; *(LAS u32x4_t*)(wr + 8) = (u32x4_t){v1.x, v1.y, v1.z, v1.w};
        *(LAS u32x4_t*)(wr + 16) = (u32x4_t){v2.x, v2.y, v2.z, v2.w}; *(LAS u32x4_t*)(wr + 24) = (u32x4_t){v3.x, v3.y, v3.z, v3.w};
        asm volatile("s_waitcnt lgkmcnt(0)" ::: "memory");
        unsigned o[16];
#pragma unroll
        for (int k = 0; k < 8; ++k) {
            const unsigned p0 = *(const LAS unsigned*)(wl + (2 * k) * 136 + 2 * lane), p1 = *(const LAS unsigned*)(wl + (2 * k + 1) * 136 + 2 * lane);
            o[k] = (p0 & 0xFFFFu) | (p1 << 16);
            o[8 + k] = (p0 >> 16) | (p1 & 0xFFFF0000u);
        }
        bf16_t* d = vdst + (2 * lane) * 16;
        *(uint4*)d = make_uint4(o[0], o[1], o[2], o[3]); *(uint4*)(d + 8) = make_uint4(o[4], o[5], o[6], o[7]);
        *(uint4*)(d + 16) = make_uint4(o[8], o[9], o[10], o[11]); *(uint4*)(d + 24) = make_uint4(o[12], o[13], o[14], o[15]);
        asm volatile("s_waitcnt lgkmcnt(0)" ::: "memory");
    }
}

typedef short bf16x8_t __attribute__((ext_vector_type(8)));
typedef short bf16x4_t __attribute__((ext_vector_type(4)));
typedef float f32x4_t __attribute__((ext_vector_type(4)));
__device__ __forceinline__ void dilated_wave_tile(int qt, int lane, const bf16_t* __restrict__ AQ, const bf16_t* __restrict__ KB, const bf16_t* __restrict__ VB,
                                                  const float* __restrict__ g_ahead, bf16_t* __restrict__ mix) {
    const int r = qt & 15, blk = (qt >> 4) & 15, hd = (qt >> 8) & 7, b = qt >> 11;
    const int j = lane & 15, g = lane >> 4;
    const int t0 = blk * 256;
    const int sq = t0 + r + 16 * j;
    bf16x8_t qf[4];
    {
        const bf16_t* qrow = AQ + ((size_t)b * S + sq) * 1024 + hd * 128 + 8 * g;
#pragma unroll
        for (int ks = 0; ks < 4; ++ks) qf[ks] = *(const bf16x8_t*)(qrow + 32 * ks);
    }
    const float sc = 0.08838834764831845f * 1.4426950408889634f;
    float m_run = -1e30f, l_run = 0.f;
    f32x4_t o[8];
#pragma unroll
    for (int dt = 0; dt < 8; ++dt) o[dt] = (f32x4_t){0.f, 0.f, 0.f, 0.f};
#pragma nounroll
    for (int br = 0; br < 3; ++br) {
        const int ld = 2 * br, d = 1 << ld;
        const int rho = r & (d - 1);
        const int qj = (sq - rho) >> ld;
        const int q_lo = ((t0 + r - rho) >> ld) - 128, q_hi = (t0 + r + 240 - rho) >> ld;
        const int tile_lo = q_lo < 0 ? 0 : (q_lo >> 4), tile_hi = q_hi >> 4, tile_max = (256 >> ld) - 1;
        const size_t tbase = ((size_t)((br * 2 + b) * 8 + hd) * 256 + (size_t)rho * (256 >> ld)) * 2048;
        const bf16_t* kbb = KB + tbase + j * 32 + 8 * g;
        const bf16_t* vbb = VB + tbase + j * 16 + 4 * g;
#pragma nounroll
        for (int tp = tile_lo; tp <= tile_hi; tp += 2) {
            f32x4_t su[2];
#pragma unroll
            for (int u = 0; u < 2; ++u) {
                int tl = tp + u; if (tl > tile_max) tl = tile_max;
                const bf16_t* krow = kbb + (size_t)tl * 2048;
                f32x4_t a = (f32x4_t){0.f, 0.f, 0.f, 0.f};
#pragma unroll
                for (int ks = 0; ks < 4; ++ks) a = __builtin_amdgcn_mfma_f32_16x16x32_bf16(*(const bf16x8_t*)(krow + 512 * ks), qf[ks], a, 0, 0, 0);
                su[u] = a;
            }
            float p[2][4]; float mx = -1e30f;
#pragma unroll
            for (int u = 0; u < 2; ++u)
#pragma unroll
                for (int e = 0; e < 4; ++e) {
                    const int n = qj - (16 * (tp + u) + 4 * g + e);
                    const bool valid = (n >= 0) && (n <= 128);
                    p[u][e] = valid ? su[u][e] * sc : -1e30f;
                    mx = fmaxf(mx, p[u][e]);
                }
            mx = fmaxf(mx, __shfl_xor(mx, 16)); mx = fmaxf(mx, __shfl_xor(mx, 32));
            const float m_new = fmaxf(m_run, mx);
            const float alpha = __builtin_amdgcn_exp2f(m_run - m_new);
            m_run = m_new;
            float ps = 0.f;
#pragma unroll
            for (int u = 0; u < 2; ++u)
#pragma unroll
                for (int e = 0; e < 4; ++e) { p[u][e] = (p[u][e] > -1e29f) ? __builtin_amdgcn_exp2f(p[u][e] - m_new) : 0.f; ps += p[u][e]; }
            l_run = l_run * alpha + ps;
            bf16x8_t pb;
            {
                const unsigned w0 = pk2(p[0][0], p[0][1]), w1 = pk2(p[0][2], p[0][3]), w2 = pk2(p[1][0], p[1][1]), w3 = pk2(p[1][2], p[1][3]);
                pb[0] = (short)(w0 & 0xFFFF); pb[1] = (short)(w0 >> 16); pb[2] = (short)(w1 & 0xFFFF); pb[3] = (short)(w1 >> 16);
                pb[4] = (short)(w2 & 0xFFFF); pb[5] = (short)(w2 >> 16); pb[6] = (short)(w3 & 0xFFFF); pb[7] = (short)(w3 >> 16);
            }
            int tl0 = tp, tl1 = tp + 1; if (tl0 > tile_max) tl0 = tile_max; if (tl1 > tile_max) tl1 = tile_max;
#pragma unroll
            for (int dt = 0; dt < 8; ++dt) {
                const bf16_t* vrow = vbb + dt * 256;
                const bf16x4_t v0 = *(const bf16x4_t*)(vrow + (size_t)tl0 * 2048), v1 = *(const bf16x4_t*)(vrow + (size_t)tl1 * 2048);
                bf16x8_t va; va[0] = v0[0]; va[1] = v0[1]; va[2] = v0[2]; va[3] = v0[3]; va[4] = v1[0]; va[5] = v1[1]; va[6] = v1[2]; va[7] = v1[3];
                f32x4_t oo = o[dt]; oo = oo * alpha;
                o[dt] = __builtin_amdgcn_mfma_f32_16x16x32_bf16(va, pb, oo, 0, 0, 0);
            }
        }
    }
    float lt = l_run; lt += __shfl_xor(lt, 16); lt += __shfl_xor(lt, 32);
    const float inv = 1.0f / lt;
    float ss = 0.f;
#pragma unroll
    for (int dt = 0; dt < 8; ++dt) { o[dt] = o[dt] * inv; ss += (o[dt][0] * o[dt][0] + o[dt][1] * o[dt][1]) + (o[dt][2] * o[dt][2] + o[dt][3] * o[dt][3]); }
    ss += __shfl_xor(ss, 16); ss += __shfl_xor(ss, 32);
    const float rn = rsqrtf(ss * (1.0f / 128.0f) + EPS);
    bf16_t* orow = mix + ((size_t)b * S + sq) * D + 1024 + hd * 128 + 4 * g;
#pragma unroll
    for (int dt = 0; dt < 8; ++dt) {
        const f32x4_t gv = *(const f32x4_t*)(g_ahead + hd * 128 + 16 * dt + 4 * g);
        uint2 w; w.x = pk2(o[dt][0] * rn * gv[0], o[dt][1] * rn * gv[1]); w.y = pk2(o[dt][2] * rn * gv[2], o[dt][3] * rn * gv[3]);
        *(uint2*)(orow + 16 * dt) = w;
    }
}

__device__ __forceinline__ unsigned ord_key(float s) { const unsigned u = __float_as_uint(s); return u ^ ((unsigned)((int)u >> 31) | 0x80000000u); }
__device__ __forceinline__ unsigned wave_max_u32(unsigned v) {
    unsigned t;
    t = (unsigned)__builtin_amdgcn_update_dpp(0, (int)v, 0xB1, 0xF, 0xF, true); v = v > t ? v : t;
    t = (unsigned)__builtin_amdgcn_update_dpp(0, (int)v, 0x4E, 0xF, 0xF, true); v = v > t ? v : t;
    t = (unsigned)__builtin_amdgcn_update_dpp(0, (int)v, 0x141, 0xF, 0xF, true); v = v > t ? v : t;
    t = (unsigned)__builtin_amdgcn_update_dpp(0, (int)v, 0x140, 0xF, 0xF, true); v = v > t ? v : t;
    const unsigned a = (unsigned)__builtin_amdgcn_readlane((int)v, 0), b = (unsigned)__builtin_amdgcn_readlane((int)v, 16),
                   c = (unsigned)__builtin_amdgcn_readlane((int)v, 32), d = (unsigned)__builtin_amdgcn_readlane((int)v, 48);
    const unsigned ab = a > b ? a : b, cd = c > d ? c : d;
    return ab > cd ? ab : cd;
}
__device__ __forceinline__ void peer_topk_wave(int item, int lane, LAS float* wl, const bf16_t* __restrict__ qp, const bf16_t* __restrict__ skb, int* __restrict__ ids, float* __restrict__ gates) {
    const int hd = item & 7, tt = item >> 3, j = lane & 15, g = lane >> 4;
    const size_t t0 = (size_t)tt * 16;
    LAS float* sc = wl;
    LAS float* lst = wl + 2048;
#pragma unroll 1
    for (int p = 0; p < 2; ++p) {
        bf16x8_t qf[4];
        const bf16_t* qrow = qp + (t0 + j) * D + hd * 256 + p * 128 + 8 * g;
#pragma unroll
        for (int ks = 0; ks < 4; ++ks) qf[ks] = *(const bf16x8_t*)(qrow + 32 * ks);
        const bf16_t* kb = skb + ((size_t)(hd * 2 + p) * 128 + j) * 128 + 8 * g;
#pragma unroll
        for (int kt = 0; kt < 8; ++kt) {
            f32x4_t a = (f32x4_t){0.f, 0.f, 0.f, 0.f};
#pragma unroll
            for (int ks = 0; ks < 4; ++ks) a = __builtin_amdgcn_mfma_f32_16x16x32_bf16(*(const bf16x8_t*)(kb + (size_t)kt * (16 * 128) + 32 * ks), qf[ks], a, 0, 0, 0);
            *(LAS f32x4_t*)(sc + j * 128 + 16 * kt + 4 * g) = a;
        }
        asm volatile("s_waitcnt lgkmcnt(0)" ::: "memory");
#pragma unroll 1
        for (int tok = 0; tok < 16; ++tok) {
            const float s0 = sc[tok * 128 + lane], s1 = sc[tok * 128 + 64 + lane];
            unsigned k0 = (ord_key(s0) & ~127u) | (unsigned)(127 - lane), k1 = (ord_key(s1) & ~127u) | (unsigned)(63 - lane);
            unsigned sel = 0u;
#pragma unroll 4
            for (int it = 0; it < 16; ++it) {
                unsigned m = k0 > k1 ? k0 : k1;
                m = wave_max_u32(m);
                if (lane == it) sel = m;
                if (k0 == m) k0 = 0u;
                if (k1 == m) k1 = 0u;
            }
            if (lane < 16) {
                const int idx = 127 - (int)(sel & 127u);
                lst[((p * 16 + tok) * 16 + lane) * 2 + 0] = sc[tok * 128 + idx];
                lst[((p * 16 + tok) * 16 + lane) * 2 + 1] = __int_as_float(idx);
            }
        }
        asm volatile("s_waitcnt lgkmcnt(0)" ::: "memory");
    }
#pragma unroll 1
    for (int tok = 0; tok < 16; ++tok) {
        const int i = lane >> 2;
        const float sA = lst[((0 * 16 + tok) * 16 + i) * 2];
        unsigned kk[4];
#pragma unroll
        for (int r = 0; r < 4; ++r) {
            const int jb = (lane & 3) * 4 + r;
            const float sum = sA + lst[((1 * 16 + tok) * 16 + jb) * 2];
            kk[r] = (ord_key(sum) & ~255u) | (unsigned)(255 - (lane * 4 + r));
        }
        unsigned sel = 0u;
#pragma unroll 4
        for (int it = 0; it < 16; ++it) {
            unsigned m = kk[0] > kk[1] ? kk[0] : kk[1]; const unsigned m2 = kk[2] > kk[3] ? kk[2] : kk[3]; m = m > m2 ? m : m2;
            m = wave_max_u32(m);
            if (lane == it) sel = m;
#pragma unroll
            for (int r = 0; r < 4; ++r) if (kk[r] == m) kk[r] = 0u;
        }
        float bs = -INFINITY; int eid = 0;
        if (lane < 16) {
            const int c = 255 - (int)(sel & 255u), ia = c >> 4, ib = c & 15;
            bs = lst[((0 * 16 + tok) * 16 + ia) * 2] + lst[((1 * 16 + tok) * 16 + ib) * 2];
            eid = __float_as_int(lst[((0 * 16 + tok) * 16 + ia) * 2 + 1]) * 128 + __float_as_int(lst[((1 * 16 + tok) * 16 + ib) * 2 + 1]);
        }
        const float mx = wave_max(bs);
        const float ev = lane < 16 ? __expf(bs - mx) : 0.f;
        const float tot = wave_sum(ev);
        if (lane < 16) {
            ids[(t0 + tok) * 128 + hd * 16 + lane] = eid;
            gates[(t0 + tok) * 128 + hd * 16 + lane] = ev / tot;
        }
    }
}

typedef float f32x2_t __attribute__((ext_vector_type(2)));
__device__ __forceinline__ void table_row_to_fp8(const float* __restrict__ srow, unsigned char* __restrict__ drow, float* __restrict__ rscale, int lane) {
    float4 f[8];
#pragma unroll
    for (int i = 0; i < 8; ++i) f[i] = *(const float4*)(srow + i * 256 + lane * 4);
    float am = 0.f;
#pragma unroll
    for (int i = 0; i < 8; ++i) am = fmaxf(am, fmaxf(fmaxf(fabsf(f[i].x), fabsf(f[i].y)), fmaxf(fabsf(f[i].z), fabsf(f[i].w))));
    am = wave_max(am);
    const float e = floorf(log2f(448.0f / fmaxf(am, 1e-30f)));
    const float s = exp2f(fminf(e, 100.0f));
    unsigned w[8];
#pragma unroll
    for (int i = 0; i < 8; ++i) {
        int t = 0;
        t = __builtin_amdgcn_cvt_pk_fp8_f32(f[i].x * s, f[i].y * s, t, false);
        t = __builtin_amdgcn_cvt_pk_fp8_f32(f[i].z * s, f[i].w * s, t, true);
        w[i] = (unsigned)t;
    }
#pragma unroll
    for (int i = 0; i < 8; ++i) *(unsigned*)(drow + i * 256 + lane * 4) = w[i];
    if (lane == 0) *rscale = 1.0f / s;
}
__device__ __forceinline__ float dot16_fp8(const uint4 q, const float* x) {
    float d = 0.f;
    const unsigned w[4] = {q.x, q.y, q.z, q.w};
#pragma unroll
    for (int k = 0; k < 4; ++k) {
        const f32x2_t lo = __builtin_amdgcn_cvt_pk_f32_fp8((int)w[k], false), hi = __builtin_amdgcn_cvt_pk_f32_fp8((int)w[k], true);
        d = fmaf(lo.x, x[4 * k], d); d = fmaf(lo.y, x[4 * k + 1], d); d = fmaf(hi.x, x[4 * k + 2], d); d = fmaf(hi.y, x[4 * k + 3], d);
    }
    return d;
}
__device__ __forceinline__ void axpy16_fp8(const uint4 q, float c, float* acc) {
    const unsigned w[4] = {q.x, q.y, q.z, q.w};
#pragma unroll
    for (int k = 0; k < 4; ++k) {
        const f32x2_t lo = __builtin_amdgcn_cvt_pk_f32_fp8((int)w[k], false), hi = __builtin_amdgcn_cvt_pk_f32_fp8((int)w[k], true);
        acc[4 * k] = fmaf(c, lo.x, acc[4 * k]); acc[4 * k + 1] = fmaf(c, lo.y, acc[4 * k + 1]); acc[4 * k + 2] = fmaf(c, hi.x, acc[4 * k + 2]); acc[4 * k + 3] = fmaf(c, hi.y, acc[4 * k + 3]);
    }
}
__device__ __forceinline__ void d_peer_out8(int vb, int tid, float* sm, const bf16_t* __restrict__ h3, const float* __restrict__ x2, const int* __restrict__ ids, const float* __restrict__ gates,
                                            const unsigned char* __restrict__ ut8, const unsigned char* __restrict__ vt8, const float* __restrict__ rsc, const float* __restrict__ rstd, const float* __restrict__ g_final, float* __restrict__ out) {
    float (*part)[2048] = (float (*)[2048])sm;
    float* red = sm + 4 * 2048;
    const int lane = tid & 63, w = tid >> 6, t = vb;
    float x[32], acc[32];
    {
        const bf16_t* hrow = h3 + (size_t)t * D + lane * 16;
#pragma unroll
        for (int hh = 0; hh < 2; ++hh) {
            const uint4 a = *(const uint4*)(hrow + hh * 1024), b = *(const uint4*)(hrow + hh * 1024 + 8);
            const unsigned ww[8] = {a.x, a.y, a.z, a.w, b.x, b.y, b.z, b.w};
#pragma unroll
            for (int k = 0; k < 8; ++k) { x[hh * 16 + 2 * k] = __uint_as_float(ww[k] << 16); x[hh * 16 + 2 * k + 1] = __uint_as_float(ww[k] & 0xFFFF0000u); }
        }
#pragma unroll
        for (int i = 0; i < 32; ++i) acc[i] = 0.f;
    }
    const float xrs = rstd[t];
    const int myid = ids[(size_t)t * 128 + w * 32 + (lane & 31)];
    const float mygate = gates[(size_t)t * 128 + w * 32 + (lane & 31)];
#pragma unroll 1
    for (int j = 0; j < 32; j += 4) {
        int e[4]; uint4 uq[4][2], vq[4][2];
#pragma unroll
        for (int q = 0; q < 4; ++q) {
            e[q] = __builtin_amdgcn_readfirstlane(__shfl(myid, j + q));
            const unsigned char* ur = ut8 + (size_t)e[q] * 2048 + lane * 16;
            uq[q][0] = *(const uint4*)ur; uq[q][1] = *(const uint4*)(ur + 1024);
        }
#pragma unroll
        for (int q = 0; q < 4; ++q) {
            const unsigned char* vr = vt8 + (size_t)e[q] * 2048 + lane * 16;
            vq[q][0] = *(const uint4*)vr; vq[q][1] = *(const uint4*)(vr + 1024);
        }
        float d[4];
#pragma unroll
        for (int q = 0; q < 4; ++q) d[q] = dot16_fp8(uq[q][0], x) + dot16_fp8(uq[q][1], x + 16);
#pragma unroll
        for (int o = 32; o >= 1; o >>= 1) {
#pragma unroll
            for (int q = 0; q < 4; ++q) d[q] += __shfl_xor(d[q], o);
        }
#pragma unroll
        for (int q = 0; q < 4; ++q) {
            const float a = d[q] * rsc[e[q]] * xrs;
            const float act = 0.5f * a * (1.0f + erff(a * 0.7071067811865476f));
            const float cf = __shfl(mygate, j + q) * act * rsc[16384 + e[q]];
            axpy16_fp8(vq[q][0], cf, acc); axpy16_fp8(vq[q][1], cf, acc + 16);
        }
    }
    __syncthreads();
#pragma unroll
    for (int hh = 0; hh < 2; ++hh)
#pragma unroll
        for (int k = 0; k < 4; ++k) *(float4*)&part[w][hh * 1024 + lane * 16 + 4 * k] = make_float4(acc[hh * 16 + 4 * k], acc[hh * 16 + 4 * k + 1], acc[hh * 16 + 4 * k + 2], acc[hh * 16 + 4 * k + 3]);
    __syncthreads();
    float4 r0, r1;
    {
        const float4 a = *(const float4*)&part[0][tid * 4], b = *(const float4*)&part[1][tid * 4], c = *(const float4*)&part[2][tid * 4], dd = *(const float4*)&part[3][tid * 4];
        const float4 xx = *(const float4*)(x2 + (size_t)t * D + tid * 4);
        r0 = make_float4(xx.x + a.x + b.x + c.x + dd.x, xx.y + a.y + b.y + c.y + dd.y, xx.z + a.z + b.z + c.z + dd.z, xx.w + a.w + b.w + c.w + dd.w);
    }
    {
        const float4 a = *(const float4*)&part[0][1024 + tid * 4], b = *(const float4*)&part[1][1024 + tid * 4], c = *(const float4*)&part[2][1024 + tid * 4], dd = *(const float4*)&part[3][1024 + tid * 4];
        const float4 xx = *(const float4*)(x2 + (size_t)t * D + 1024 + tid * 4);
        r1 = make_float4(xx.x + a.x + b.x + c.x + dd.x, xx.y + a.y + b.y + c.y + dd.y, xx.z + a.z + b.z + c.z + dd.z, xx.w + a.w + b.w + c.w + dd.w);
    }
    float s = r0.x * r0.x + r0.y * r0.y + r0.z * r0.z + r0.w * r0.w + r1.x * r1.x + r1.y * r1.y + r1.z * r1.z + r1.w * r1.w;
    s = wave_sum(s);
    if (lane == 0) red[w] = s;
    __syncthreads();
    const float tot = red[0] + red[1] + red[2] + red[3];
    const float r = rsqrtf(tot * (1.0f / D) + EPS);
    const float4 g0 = *(const float4*)(g_final + tid * 4), g1 = *(const float4*)(g_final + 1024 + tid * 4);
    *(float4*)(out + (size_t)t * D + tid * 4) = make_float4(r0.x * r * g0.x, r0.y * r * g0.y, r0.z * r * g0.z, r0.w * r * g0.w);
    *(float4*)(out + (size_t)t * D + 1024 + tid * 4) = make_float4(r1.x * r * g1.x, r1.y * r * g1.y, r1.z * r * g1.z, r1.w * r * g1.w);
}

__device__ __forceinline__ unsigned xg_sum_u32(unsigned v) {
    auto a = __builtin_amdgcn_permlane16_swap(v, v, false, false); v = a[0] + a[1];
    auto b = __builtin_amdgcn_permlane32_swap(v, v, false, false); return b[0] + b[1];
}
__device__ __forceinline__ float xg_sum_f32(float v) {
    auto a = __builtin_amdgcn_permlane16_swap(__float_as_uint(v), __float_as_uint(v), false, false); v = __uint_as_float(a[0]) + __uint_as_float(a[1]);
    auto b = __builtin_amdgcn_permlane32_swap(__float_as_uint(v), __float_as_uint(v), false, false); return __uint_as_float(b[0]) + __uint_as_float(b[1]);
}
__device__ __forceinline__ float xg_max_f32(float v) {
    auto a = __builtin_amdgcn_permlane16_swap(__float_as_uint(v), __float_as_uint(v), false, false); v = fmaxf(__uint_as_float(a[0]), __uint_as_float(a[1]));
    auto b = __builtin_amdgcn_permlane32_swap(__float_as_uint(v), __float_as_uint(v), false, false); return fmaxf(__uint_as_float(b[0]), __uint_as_float(b[1]));
}
template <int N> __device__ __forceinline__ unsigned bisect16(const unsigned (&kk)[N]) {
    unsigned tau = 0u; bool done = false;
#pragma unroll 1
    for (int bit = 31; bit >= 0; --bit) {
        const unsigned cand = tau | (1u << bit);
        unsigned c = 0u;
#pragma unroll
        for (int i = 0; i < N; ++i) c += (kk[i] >= cand) ? 1u : 0u;
        c = xg_sum_u32(c);
        if (!done && c >= 16u) { tau = cand; done = (c == 16u); }
        if (__all(done ? 1 : 0)) break;
    }
    return tau;
}
__device__ __forceinline__ void peer_topk_wave2(int item, int lane, LAS float* wl, const bf16_t* __restrict__ qp, const bf16_t* __restrict__ skb, int* __restrict__ ids, float* __restrict__ gates) {
    const int hd = item & 7, tt = item >> 3, j = lane & 15, g = lane >> 4;
    const size_t t0 = (size_t)tt * 16;
#pragma unroll 1
    for (int p = 0; p < 2; ++p) {
        bf16x8_t qf[4];
        const bf16_t* qrow = qp + (t0 + j) * D + hd * 256 + p * 128 + 8 * g;
#pragma unroll
        for (int ks = 0; ks < 4; ++ks) qf[ks] = *(const bf16x8_t*)(qrow + 32 * ks);
        const bf16_t* kb = skb + ((size_t)(hd * 2 + p) * 128 + j) * 128 + 8 * g;
        float sc[32]; unsigned kk[32];
#pragma unroll
        for (int kt = 0; kt < 8; ++kt) {
            f32x4_t a = (f32x4_t){0.f, 0.f, 0.f, 0.f};
#pragma unroll
            for (int ks = 0; ks < 4; ++ks) a = __builtin_amdgcn_mfma_f32_16x16x32_bf16(*(const bf16x8_t*)(kb + (size_t)kt * (16 * 128) + 32 * ks), qf[ks], a, 0, 0, 0);
#pragma unroll
            for (int r = 0; r < 4; ++r) { sc[kt * 4 + r] = a[r]; kk[kt * 4 + r] = (ord_key(a[r]) & ~127u) | (unsigned)(127 - (16 * kt + 4 * g + r)); }
        }
        const unsigned tau = bisect16<32>(kk);
        unsigned cnt = 0u;
#pragma unroll
        for (int i = 0; i < 32; ++i) cnt += (kk[i] >= tau) ? 1u : 0u;
        const unsigned c0 = (unsigned)__shfl((int)cnt, j), c1 = (unsigned)__shfl((int)cnt, j + 16), c2 = (unsigned)__shfl((int)cnt, j + 32);
        unsigned off = (g > 0 ? c0 : 0u) + (g > 1 ? c1 : 0u) + (g > 2 ? c2 : 0u);
        LAS float* ls = wl + p * 256 + j * 16;
        LAS float* li = wl + 512 + p * 256 + j * 16;
#pragma unroll
        for (int i = 0; i < 32; ++i) {
            if (kk[i] >= tau && off < 16u) { ls[off] = sc[i]; li[off] = __int_as_float(16 * (i >> 2) + 4 * g + (i & 3)); ++off; }
        }
    }
    asm volatile("s_waitcnt lgkmcnt(0)" ::: "memory");
    {
        float sA[4], sB[16]; int iA[4];
        {
            const f32x4_t a = *(const LAS f32x4_t*)(wl + j * 16 + 4 * g);
            const f32x4_t ai = *(const LAS f32x4_t*)(wl + 512 + j * 16 + 4 * g);
#pragma unroll
            for (int r = 0; r < 4; ++r) { sA[r] = a[r]; iA[r] = __float_as_int(ai[r]); }
#pragma unroll
            for (int q = 0; q < 4; ++q) { const f32x4_t b = *(const LAS f32x4_t*)(wl + 256 + j * 16 + 4 * q); sB[4 * q] = b[0]; sB[4 * q + 1] = b[1]; sB[4 * q + 2] = b[2]; sB[4 * q + 3] = b[3]; }
        }
        unsigned kk[64];
#pragma unroll
        for (int a = 0; a < 4; ++a)
#pragma unroll
            for (int b = 0; b < 16; ++b) kk[a * 16 + b] = (ord_key(sA[a] + sB[b]) & ~255u) | (unsigned)(255 - ((4 * g + a) * 16 + b));
        const unsigned tau = bisect16<64>(kk);
        float mx = -INFINITY; unsigned cnt = 0u;
#pragma unroll
        for (int i = 0; i < 64; ++i) if (kk[i] >= tau) { mx = fmaxf(mx, sA[i >> 4] + sB[i & 15]); ++cnt; }
        mx = xg_max_f32(mx);
        float es = 0.f;
#pragma unroll
        for (int i = 0; i < 64; ++i) if (kk[i] >= tau) es += __expf(sA[i >> 4] + sB[i & 15] - mx);
        const float inv = 1.0f / xg_sum_f32(es);
        const unsigned c0 = (unsigned)__shfl((int)cnt, j), c1 = (unsigned)__shfl((int)cnt, j + 16), c2 = (unsigned)__shfl((int)cnt, j + 32);
        unsigned off = (g > 0 ? c0 : 0u) + (g > 1 ? c1 : 0u) + (g > 2 ? c2 : 0u);
        int* idp = ids + (t0 + j) * 128 + hd * 16;
        float* gtp = gates + (t0 + j) * 128 + hd * 16;
        const LAS float* liB = wl + 512 + 256 + j * 16;
#pragma unroll
        for (int i = 0; i < 64; ++i) {
            if (kk[i] >= tau && off < 16u) {
                idp[off] = iA[i >> 4] * 128 + __float_as_int(liB[i & 15]);
                gtp[off] = __expf(sA[i >> 4] + sB[i & 15] - mx) * inv;
                ++off;
            }
        }
    }
}

__device__ __forceinline__ float wave_sum_dpp(float v) {
    v += __uint_as_float((unsigned)__builtin_amdgcn_update_dpp(0, (int)__float_as_uint(v), 0xB1, 0xF, 0xF, true));
    v += __uint_as_float((unsigned)__builtin_amdgcn_update_dpp(0, (int)__float_as_uint(v), 0x4E, 0xF, 0xF, true));
    v += __uint_as_float((unsigned)__builtin_amdgcn_update_dpp(0, (int)__float_as_uint(v), 0x141, 0xF, 0xF, true));
    v += __uint_as_float((unsigned)__builtin_amdgcn_update_dpp(0, (int)__float_as_uint(v), 0x140, 0xF, 0xF, true));
    const float a = __uint_as_float((unsigned)__builtin_amdgcn_readlane((int)__float_as_uint(v), 0)), b = __uint_as_float((unsigned)__builtin_amdgcn_readlane((int)__float_as_uint(v), 16)),
                c = __uint_as_float((unsigned)__builtin_amdgcn_readlane((int)__float_as_uint(v), 32)), d = __uint_as_float((unsigned)__builtin_amdgcn_readlane((int)__float_as_uint(v), 48));
    return (a + b) + (c + d);
}
typedef __bf16 bf16x2v_t __attribute__((ext_vector_type(2)));
__device__ __forceinline__ float dot16_fp8_bf16(const uint4 q, const uint4 xa, const uint4 xb, float d) {
    const unsigned w[4] = {q.x, q.y, q.z, q.w};
    const unsigned xw[8] = {xa.x, xa.y, xa.z, xa.w, xb.x, xb.y, xb.z, xb.w};
#pragma unroll
    for (int k = 0; k < 4; ++k) {
        const bf16x2v_t lo = __builtin_amdgcn_cvt_scalef32_pk_bf16_fp8(w[k], 1.0f, false), hi = __builtin_amdgcn_cvt_scalef32_pk_bf16_fp8(w[k], 1.0f, true);
        d = __builtin_amdgcn_fdot2_f32_bf16(lo, __builtin_bit_cast(bf16x2v_t, xw[2 * k]), d, false);
        d = __builtin_amdgcn_fdot2_f32_bf16(hi, __builtin_bit_cast(bf16x2v_t, xw[2 * k + 1]), d, false);
    }
    return d;
}
__device__ __forceinline__ void axpy16_fp8_pk(const uint4 q, const f32x2_t c2, f32x2_t* acc) {
    const unsigned w[4] = {q.x, q.y, q.z, q.w};
#pragma unroll
    for (int k = 0; k < 4; ++k) {
        const f32x2_t lo = __builtin_amdgcn_cvt_pk_f32_fp8((int)w[k], false), hi = __builtin_amdgcn_cvt_pk_f32_fp8((int)w[k], true);
        acc[2 * k] = __builtin_elementwise_fma(c2, lo, acc[2 * k]); acc[2 * k + 1] = __builtin_elementwise_fma(c2, hi, acc[2 * k + 1]);
    }
}
__device__ __forceinline__ float gelu_as(float v) {
    const float av = fabsf(v), t = __builtin_amdgcn_rcpf(av * 0.2316418882f + 1.0f);
    float q = t * 0.5307027145f + (-0.7265760135f); q = q * t + 0.7107068705f; q = q * t + (-0.142248368f); q = q * t + 0.127414796f; q = q * t;
    const float e = __builtin_amdgcn_exp2f((v * v) * (-0.72134752044f));
    const float m = v * (q * e);
    return v < 0.f ? m : v - m;
}
__device__ __forceinline__ void peer_sweep_wave(int gw, int lane, LAS unsigned char* wl, const bf16_t* __restrict__ h3, const float* __restrict__ x2, const int* __restrict__ ids,
                                                const float* __restrict__ gates, const unsigned char* __restrict__ ut8, const unsigned char* __restrict__ vt8, const float* __restrict__ rsc,
                                                const float* __restrict__ rstd, const float* __restrict__ g_final, float* __restrict__ out) {
    typedef unsigned u32x4_t __attribute__((ext_vector_type(4)));
    LAS unsigned short* xs = (LAS unsigned short*)wl;
    LAS unsigned* sorted = (LAS unsigned*)(wl + 16384);
    LAS unsigned* cnt = (LAS unsigned*)(wl + 16384 + 2048);
    LAS unsigned* base = (LAS unsigned*)(wl + 16384 + 2048 + 256);
    const size_t t0 = (size_t)gw * 4;
#pragma unroll
    for (int tok = 0; tok < 4; ++tok)
#pragma unroll
        for (int c = 0; c < 4; ++c) {
            const uint4 v = *(const uint4*)(h3 + (t0 + tok) * D + c * 512 + lane * 8);
            *(LAS u32x4_t*)(xs + tok * 2048 + c * 512 + lane * 8) = (u32x4_t){v.x, v.y, v.z, v.w};
        }
    cnt[lane] = 0u;
    asm volatile("s_waitcnt lgkmcnt(0)" ::: "memory");
    unsigned key[8], rk[8];
#pragma unroll
    for (int r = 0; r < 8; ++r) {
        const int n = r * 64 + lane;
        const unsigned e = (unsigned)ids[t0 * 128 + n];
        key[r] = (e << 9) | (unsigned)n;
        rk[r] = __hip_atomic_fetch_add(&cnt[e >> 8], 1u, __ATOMIC_RELAXED, __HIP_MEMORY_SCOPE_WORKGROUP);
    }
    asm volatile("s_waitcnt lgkmcnt(0)" ::: "memory");
    {
        const unsigned c = cnt[lane];
        unsigned incl = c;
#pragma unroll
        for (int o = 1; o < 64; o <<= 1) { const unsigned t = (unsigned)__shfl_up((int)incl, o); if (lane >= o) incl += t; }
        base[lane] = incl - c;
    }
    asm volatile("s_waitcnt lgkmcnt(0)" ::: "memory");
#pragma unroll
    for (int r = 0; r < 8; ++r) sorted[base[key[r] >> 17] + rk[r]] = key[r];
    asm volatile("s_waitcnt lgkmcnt(0)" ::: "memory");
    float rs4[4];
#pragma unroll
    for (int tok = 0; tok < 4; ++tok) rs4[tok] = rstd[t0 + tok];
#define P1_LOAD(ENT, UQ, I0) _Pragma("unroll") for (int q = 0; q < 8; ++q) { \
            ENT[q] = (unsigned)__builtin_amdgcn_readfirstlane((int)sorted[(I0) + q]); \
            const unsigned char* ur = ut8 + (size_t)(ENT[q] >> 9) * 2048 + lane * 16; \
            UQ[q][0] = *(const uint4*)ur; UQ[q][1] = *(const uint4*)(ur + 1024); }
#define P1_COMP(ENT, UQ, I0) _Pragma("unroll") for (int h4 = 0; h4 < 8; h4 += 4) { float d[4]; \
            _Pragma("unroll") for (int q = 0; q < 4; ++q) { \
                const int tok = (ENT[h4 + q] >> 7) & 3; \
                const LAS unsigned short* xr = xs + tok * 2048 + lane * 16; \
                const u32x4_t a0 = *(const LAS u32x4_t*)xr, a1 = *(const LAS u32x4_t*)(xr + 8), b0 = *(const LAS u32x4_t*)(xr + 1024), b1 = *(const LAS u32x4_t*)(xr + 1032); \
                d[q] = dot16_fp8_bf16(UQ[h4 + q][0], make_uint4(a0[0], a0[1], a0[2], a0[3]), make_uint4(a1[0], a1[1], a1[2], a1[3]), 0.f); \
                d[q] = dot16_fp8_bf16(UQ[h4 + q][1], make_uint4(b0[0], b0[1], b0[2], b0[3]), make_uint4(b1[0], b1[1], b1[2], b1[3]), d[q]); } \
            _Pragma("unroll") for (int q = 0; q < 4; ++q) { \
                const float s = wave_sum_dpp(d[q]); \
                const unsigned e = ENT[h4 + q] >> 9; const int n = ENT[h4 + q] & 511, tok = n >> 7; \
                const float rsv = tok == 0 ? rs4[0] : tok == 1 ? rs4[1] : tok == 2 ? rs4[2] : rs4[3]; \
                const float a = s * rsc[e] * rsv; \
                const float cf = gates[t0 * 128 + n] * gelu_as(a) * rsc[16384 + e]; \
                if (lane == 0) sorted[(I0) + h4 + q] = (e << 18) | ((unsigned)tok << 16) | f2bf(cf); } }
    {
        unsigned entA[8], entB[8]; uint4 uqA[8][2], uqB[8][2];
        P1_LOAD(entA, uqA, 0)
#pragma unroll 1
        for (int i = 0; i < 512; i += 16) {
            P1_LOAD(entB, uqB, i + 8)
            P1_COMP(entA, uqA, i)
            { const int nx = i + 16 < 512 ? i + 16 : 504; P1_LOAD(entA, uqA, nx) }
            P1_COMP(entB, uqB, i + 8)
        }
    }
#undef P1_LOAD
#undef P1_COMP
    asm volatile("s_waitcnt lgkmcnt(0)" ::: "memory");
    f32x2_t acc0[16], acc1[16], acc2[16], acc3[16];
#pragma unroll
    for (int k = 0; k < 16; ++k) { acc0[k] = (f32x2_t){0.f, 0.f}; acc1[k] = (f32x2_t){0.f, 0.f}; acc2[k] = (f32x2_t){0.f, 0.f}; acc3[k] = (f32x2_t){0.f, 0.f}; }
#ifndef P2N
#define P2N 2
#endif
#define P2_LOAD(ENT, VQ, I0) _Pragma("unroll") for (int q = 0; q < P2N; ++q) { \
            ENT[q] = (unsigned)__builtin_amdgcn_readfirstlane((int)sorted[(I0) + q]); \
            const unsigned char* vr = vt8 + (size_t)(ENT[q] >> 18) * 2048 + lane * 16; \
            VQ[q][0] = *(const uint4*)vr; VQ[q][1] = *(const uint4*)(vr + 1024); }
#define P2_COMP(ENT, VQ) _Pragma("unroll") for (int q = 0; q < P2N; ++q) { \
            const int tok = (ENT[q] >> 16) & 3; \
            const float cfs = __uint_as_float(ENT[q] << 16); \
            const f32x2_t c2 = (f32x2_t){cfs, cfs}; \
            if (tok == 0) { axpy16_fp8_pk(VQ[q][0], c2, acc0); axpy16_fp8_pk(VQ[q][1], c2, acc0 + 8); } \
            else if (tok == 1) { axpy16_fp8_pk(VQ[q][0], c2, acc1); axpy16_fp8_pk(VQ[q][1], c2, acc1 + 8); } \
            else if (tok == 2) { axpy16_fp8_pk(VQ[q][0], c2, acc2); axpy16_fp8_pk(VQ[q][1], c2, acc2 + 8); } \
            else { axpy16_fp8_pk(VQ[q][0], c2, acc3); axpy16_fp8_pk(VQ[q][1], c2, acc3 + 8); } }
    {
        unsigned entA[P2N], entB[P2N]; uint4 vqA[P2N][2], vqB[P2N][2];
        P2_LOAD(entA, vqA, 0)
#pragma unroll 1
        for (int i = 0; i < 512; i += 2 * P2N) {
            P2_LOAD(entB, vqB, i + P2N)
            P2_COMP(entA, vqA)
            { const int nx = i + 2 * P2N < 512 ? i + 2 * P2N : 512 - P2N; P2_LOAD(entA, vqA, nx) }
            P2_COMP(entB, vqB)
        }
    }
#undef P2_LOAD
#undef P2_COMP
    int l2 = lane; asm volatile("" : "+v"(l2));
#define PEER_EPI(tok, ACC) { \
        const float* xr = x2 + (t0 + tok) * D + l2 * 16; \
        float ss = 0.f; \
        _Pragma("unroll") for (int hh = 0; hh < 2; ++hh) _Pragma("unroll") for (int k = 0; k < 4; ++k) { \
            const float4 xv = *(const float4*)(xr + hh * 1024 + 4 * k); \
            f32x2_t a0 = ACC[hh * 8 + 2 * k], a1 = ACC[hh * 8 + 2 * k + 1]; \
            a0.x += xv.x; a0.y += xv.y; a1.x += xv.z; a1.y += xv.w; ACC[hh * 8 + 2 * k] = a0; ACC[hh * 8 + 2 * k + 1] = a1; \
            ss += (a0.x * a0.x + a0.y * a0.y) + (a1.x * a1.x + a1.y * a1.y); } \
        ss = wave_sum_dpp(ss); \
        const float r = rsqrtf(ss * (1.0f / D) + EPS); \
        float* orow = out + (t0 + tok) * D + l2 * 16; \
        _Pragma("unroll") for (int hh = 0; hh < 2; ++hh) _Pragma("unroll") for (int k = 0; k < 4; ++k) { \
            const float4 gv = *(const float4*)(g_final + hh * 1024 + l2 * 16 + 4 * k); \
            const f32x2_t a0 = ACC[hh * 8 + 2 * k], a1 = ACC[hh * 8 + 2 * k + 1]; \
            *(float4*)(orow + hh * 1024 + 4 * k) = make_float4(a0.x * r * gv.x, a0.y * r * gv.y, a1.x * r * gv.z, a1.y * r * gv.w); } }
    PEER_EPI(0, acc0) PEER_EPI(1, acc1) PEER_EPI(2, acc2) PEER_EPI(3, acc3)
#undef PEER_EPI
}

struct Params {
    const float *x, *mem, *g_mix, *w_in, *conv_w, *conv_b, *w_mq, *w_mk, *b_mi, *b_mf, *g_mhead, *g_ahead, *w_out, *g_cross, *g_mem,
                *w_xq, *w_xk, *w_xv, *w_xo, *g_ffn, *w_pq, *sub_keys, *u_tab, *v_tab, *g_final;
    float* out;
    unsigned* bar;
    float* ws;
};

#define PHASE_LOOP(nvb) for (int base_ = blockIdx.x * 2; base_ < (nvb); base_ += gridDim.x * 2)
#define VB (base_ + half)

__global__ void __launch_bounds__(NTHR) mega(Params P) {
    volatile LAS unsigned* st = (volatile LAS unsigned*)(LAS unsigned char*)(smem_raw + CTRL_OFF);
    if (threadIdx.x == 0) { st[0] = 0u; st[1] = 0u; st[2] = 0u; st[3] = 0u; }
    if (threadIdx.x < I_NPTR) ((LAS unsigned long long*)(LAS unsigned char*)(smem_raw + CTRL_OFF + 64))[threadIdx.x] = ((const unsigned long long*)&P)[threadIdx.x];
    __syncthreads();
    XcdBarrier xb = xcd_barrier_post((unsigned*)ldp_raw(I_BAR), st);

    constexpr size_t TD = (size_t)T * D;
    constexpr size_t O_HB = 6 * P6S * 2, O_CBUF = O_HB + (size_t)T * D * 2, O_MQ = O_CBUF + (size_t)T * 1024 * 2, O_MK = O_MQ + (size_t)T * 1024 * 2,
                     O_MIXB = O_MK + (size_t)T * 1024 * 2, O_WIN = O_MIXB + (size_t)T * D * 2, O_WOUT = O_WIN + (size_t)6144 * D * 2, O_WXQ = O_WOUT + (size_t)D * D * 2,
                     O_WXK = O_WXQ + (size_t)D * D * 2, O_WXV = O_WXK + (size_t)D * D * 2, O_WXO = O_WXV + (size_t)D * D * 2, O_WPQ = O_WXO + (size_t)D * D * 2,
                     O_WQK = O_WPQ + (size_t)D * D * 2, O_GPRE = O_WQK + (size_t)8 * 256 * 256 * 2, O_UT = O_GPRE + (size_t)T * 8 * 4, O_VT = O_UT + (size_t)16384 * D, O_RSC = O_VT + (size_t)16384 * D,
                     O_BH = O_RSC + (size_t)32768 * 4, O_GS = O_BH + (size_t)128 * 256 * 512 * 2, O_DENP = O_GS + (size_t)T * 4 * 8 * 4, O_QN = O_DENP + (size_t)T * 4 * 4 * 4,
                     O_DN = O_QN + (size_t)T * 4 * 4, O_DECAY = O_DN + (size_t)128 * 256 * 4, O_KB = O_DECAY + 4096, O_VB = O_KB + (size_t)12288 * 2048 * 2, O_CS = O_VB + (size_t)12288 * 2048 * 2, O_SKB = O_CS + (size_t)4096 * 64 * 8, O_RSSP = O_SKB + (size_t)262144 * 2, O_RSTD = O_RSSP + (size_t)T * 32 * 4, O_MN = O_RSTD + (size_t)T * 4, O_KVP = O_MN + (size_t)512 * D * 2, O_END = O_KVP + (size_t)2 * 512 * 4096 * 4;
    static_assert(O_END + 16384 <= (size_t)536870912, "workspace overflow");
#define W_P6    ((bf16_t*)wsb)
#define W_HB    ((bf16_t*)(wsb + O_HB))
#define W_CBUF  ((bf16_t*)(wsb + O_CBUF))
#define W_MQ    ((bf16_t*)(wsb + O_MQ))
#define W_MK    ((bf16_t*)(wsb + O_MK))
#define W_MIXB  ((bf16_t*)(wsb + O_MIXB))
#define W_GPRE  ((float*)(wsb + O_GPRE))
#define W_HRAW  ((float*)(wsb + O_HB))
#define W_XR    ((float*)wsb)
#define W_MN    ((bf16_t*)((float*)wsb + TD))
#define W_KM    ((bf16_t*)((float*)wsb + TD + (size_t)256 * D))
#define W_VMT   ((bf16_t*)((float*)wsb + TD + (size_t)768 * D))
#define W_PX    ((bf16_t*)(wsb + O_MK))
#define W_GATES ((float*)wsb + TD + (size_t)1280 * D)
#define W_IDS   ((int*)((float*)wsb + TD + (size_t)1280 * D + (size_t)T * 128))
#define W_QX    ((bf16_t*)(wsb + O_CBUF))
#define W_BH    ((bf16_t*)(wsb + O_BH))
#define W_KB    ((bf16_t*)(wsb + O_KB))
#define W_VB    ((bf16_t*)(wsb + O_VB))
#define W_CS    ((float2*)(wsb + O_CS))
#define W_SKB   ((bf16_t*)(wsb + O_SKB))
#define W_RSSP  ((float*)(wsb + O_RSSP))
#define W_RSTD  ((float*)(wsb + O_RSTD))
#define W_MN2   ((bf16_t*)(wsb + O_MN))
#define W_KVP   ((float*)(wsb + O_KVP))
#define W_GS    ((float*)(wsb + O_GS))
#define W_DENP  ((float*)(wsb + O_DENP))
#define W_QN    ((float*)(wsb + O_QN))
#define W_DN    ((float*)(wsb + O_DN))
#define W_DECAY ((float*)(wsb + O_DECAY))
#define W_PQ    ((bf16_t*)(wsb + O_HB))
#define W_KWT   ((bf16_t*)(wsb + O_CBUF))
#define W_DC    ((float*)(wsb + 3 * P6S * 2))
#define W_UT    ((unsigned char*)(wsb + O_UT))
#define W_VT    ((unsigned char*)(wsb + O_VT))
#define W_RSC   ((float*)(wsb + O_RSC))
#define PH_BEGIN() int tidx = threadIdx.x; asm volatile("" : "+v"(tidx)); const int half = tidx >> 8, tid = tidx & 255; float* sm = (float*)smem_raw + half * HALF_SM_FLOATS; \
                   char* wsb = (char*)ldp_raw(I_WS); (void)half; (void)tid; (void)sm; (void)wsb
#define GJOB_DEFAULT(g) pg8::GJob g; g.lda = D; g.ldb = D; g.K = D; g.nM = 32; g.nN = 8; g.a_pm_step = 256 * D; g.b_pn_mask = 0x7fffffff; g.b_pn_shift = 30; g.b_pn_step2 = 0; g.bid0 = 0; g.nblk = gridDim.x; g.a_pn_shift = 0; g.a_pn_mask = 0; g.a_pn_step = 0; g.b_pm_shift = 0; g.b_pm_step = 0; g.b_pn_step = 256 * D; \
                        g.ldc = D; g.R = nullptr; g.ldr = D; g.mode = 0; g.escale = 1.0f; g.gs = nullptr; g.denp = nullptr; g.qn = nullptr; g.gvec = nullptr; g.mo = nullptr; g.C2 = nullptr; g.rssp = nullptr; g.rstd = nullptr
#define GEMM_LDSP ((LAS unsigned char*)smem_raw)

    {
        PH_BEGIN();
        {
            LAS float* scr = (LAS float*)(LAS unsigned char*)(smem_raw) + (tidx >> 6) * (64 * 33);
            const int lane = tidx & 63;
            const int gw = blockIdx.x * 8 + (tidx >> 6), NGW = gridDim.x * 8;
            constexpr int I_IN = 32 * 192, I_SQ = 32 * 64, I_QK = 8 * 4 * 8;
            constexpr int NITEMS = I_IN + 6 * I_SQ + I_QK;
#pragma nounroll
            for (int it = gw; it < NITEMS; it += NGW) {
                const float* W; int ldw, K, csrc0, row0, kb; bf16_t* WT; float wscale = 1.0f;
                int r = it;
                if (r < I_IN) { const int nb = r % 192; kb = r / 192; W = PF(I_WIN); ldw = INC; K = D; csrc0 = nb * 32 + (nb >= 96 ? 8 : 0); WT = (bf16_t*)(wsb + O_WIN); row0 = nb * 32; }
                else if ((r -= I_IN) < 6 * I_SQ) {
                    const int wsel = r / I_SQ; r -= wsel * I_SQ; const int nb = r % 64; kb = r / 64; ldw = D; K = D; csrc0 = nb * 32; row0 = nb * 32;
                    W = PF(wsel == 0 ? I_WOUT : wsel == 1 ? I_WXQ : wsel == 2 ? I_WXK : wsel == 3 ? I_WXV : wsel == 4 ? I_WXO : I_WPQ);
                    WT = (bf16_t*)(wsb + O_WOUT + (size_t)wsel * ((size_t)D * D * 2));
                } else {
                    r -= 6 * I_SQ; const int hq = r / 32; r -= hq * 32; const int nb = r % 8; kb = r / 8;
                    W = PF(hq < 4 ? I_WMQ : I_WMK) + (size_t)(hq & 3) * 65536; ldw = 256; K = 256; csrc0 = nb * 32; WT = (bf16_t*)(wsb + O_WQK); row0 = hq * 256 + nb * 32;
                    if (hq >= 4) wscale = 0.0625f;
                }
                p0_transpose_item(W, ldw, K, csrc0, WT, row0, scr, kb, lane, wscale);
            }
            {
                const float* ut = PF(I_UTAB); const float* vt = PF(I_VTAB);
#pragma nounroll
                for (int row = gw; row < 32768; row += NGW) {
                    const bool second = row >= 16384; const int rr = second ? row - 16384 : row;
                    table_row_to_fp8((second ? vt : ut) + (size_t)rr * D, (second ? W_VT : W_UT) + (size_t)rr * D, W_RSC + row, lane);
                }
            }
            rope_table_fill(W_CS, blockIdx.x * NTHR + tidx, gridDim.x * NTHR);
            {
                const float* sk = PF(I_SUBK);
#pragma nounroll
                for (int i = blockIdx.x * NTHR + tidx; i < 262144 / 8; i += gridDim.x * NTHR) {
                    const float4 a = *(const float4*)(sk + (size_t)i * 8), b = *(const float4*)(sk + (size_t)i * 8 + 4);
                    uint4 o; o.x = pk2(a.x, a.y); o.y = pk2(a.z, a.w); o.z = pk2(b.x, b.y); o.w = pk2(b.z, b.w);
                    *(uint4*)(W_SKB + (size_t)i * 8) = o;
                }
            }
            __syncthreads();
        }
        {
            const float* rin = PF(I_X); const float* rg = PF(I_GMIX); const float* win = PF(I_WIN);
            float* gwl = (float*)smem_raw + 1024;
            for (int k = tidx; k < 2048; k += NTHR) { const float4 a = *(const float4*)(win + (size_t)k * INC + C_MI), b = *(const float4*)(win + (size_t)k * INC + C_MI + 4);
                *(float4*)(gwl + k * 8) = a; *(float4*)(gwl + k * 8 + 4) = b; }
            __syncthreads();
            float* red = (float*)smem_raw + half * 256;
#pragma nounroll
            PHASE_LOOP(T) d_rmsnorm(VB, tid, red, rin, rg, W_HB, gwl, W_GPRE);
            const float* min_ = PF(I_MEM); const float* mg = PF(I_GMEM);
#pragma nounroll
            PHASE_LOOP(512) d_rmsnorm(VB, tid, red, min_, mg, W_MN2, nullptr, nullptr);
        }
    }
    xcd_barrier(xb);
    {
        PH_BEGIN();
        GJOB_DEFAULT(g); g.A = W_HB; g.Bt = (bf16_t*)(wsb + O_WIN); g.nN = 24; g.C = (float*)W_P6; g.ldc = 1024;
        pg8::gemm_phase<4>(GEMM_LDSP, g, tidx);
    }
    xcd_barrier(xb);
    {
        PH_BEGIN();
        const float* cw = PF(I_CONVW); const float* cb = PF(I_CONVB);
#pragma nounroll
        PHASE_LOOP(T) d_conv_silu(VB, tid, W_P6, cw, cb, W_CBUF);
        rope_q_pass(W_P6 + 3 * P6S, W_CS, (size_t)blockIdx.x * NTHR + tidx, (size_t)gridDim.x * NTHR);
        {
            LAS unsigned short* wl = (LAS unsigned short*)(LAS unsigned char*)smem_raw + (tidx >> 6) * (16 * 136);
#pragma nounroll
            for (int item = blockIdx.x * 8 + (tidx >> 6); item < 12288; item += gridDim.x * 8) dil_tile_prep(item, tidx & 63, wl, W_P6 + 4 * P6S, W_P6 + 5 * P6S, W_CS, W_KB, W_VB);
            __syncthreads();
        }
        if (blockIdx.x < 8 && tidx < 64) mlstm_gates_wave(blockIdx.x >> 2, blockIdx.x & 3, tidx, W_GPRE, PF(I_BMI), PF(I_BMF), W_GS, W_DECAY);
#pragma nounroll
        PHASE_LOOP(2048) { const int it = VB, lt = it & 3, et = (it >> 2) & 3, h = (it >> 4) & 3, cg = it >> 6;
            transpose_tile64(tid, sm, W_P6 + P6S + (size_t)(cg * 256 + lt * 64) * 1024 + h * 256 + et * 64, 1024, W_BH + ((size_t)(cg * 4 + h) * 256 + et * 64) * 512 + lt * 64, 512, nullptr, 0); }
    }
    xcd_barrier(xb);
    {
        PH_BEGIN();
        {
            GJOB_DEFAULT(g); g.A = W_CBUF; g.lda = 1024; g.a_pm_step = 256 * 1024; g.Bt = (bf16_t*)(wsb + O_WQK); g.ldb = 256; g.b_pn_step = 256 * 256; g.K = 256; g.a_pn_mask = 3; g.a_pn_step = 256; g.C = (float*)W_MQ; g.ldc = 1024;
            pg8::gemm_phase<4>(GEMM_LDSP, g, tidx);
            __syncthreads();
        }
        const float* ga = PF(I_GAHEAD);
#pragma nounroll
        for (int qt = blockIdx.x * 8 + (tidx >> 6); qt < 4096; qt += gridDim.x * 8) dilated_wave_tile(qt, tidx & 63, W_P6 + 3 * P6S, W_KB, W_VB, ga, W_MIXB);
    }
    xcd_barrier(xb);
    {
        PH_BEGIN();
#pragma nounroll
        PHASE_LOOP(2048) { const int it = VB, lt = it & 3, dt = (it >> 2) & 3, h = (it >> 4) & 3, cg = it >> 6;
            transpose_tile64(tid, sm, W_MK + (size_t)(cg * 256 + lt * 64) * 1024 + h * 256 + dt * 64, 1024, W_KWT + ((size_t)(cg * 4 + h) * 256 + dt * 64) * 256 + lt * 64, 256,
                             W_GS + ((size_t)(cg * 256 + lt * 64) * 4 + h) * 8 + 2, 32); }
        {
            const size_t nth = (size_t)gridDim.x * NTHR;
#pragma nounroll
            for (size_t i = (size_t)blockIdx.x * NTHR + tidx; i < (size_t)T * 128; i += nth) {
                const size_t t = i >> 7; const int c8 = (int)(i & 127) * 8, h = c8 >> 8, d = c8 & 255;
                const float sc = W_GS[(t * 4 + h) * 8 + 3];
                const uint4 v = *(const uint4*)(W_MQ + t * 1024 + c8);
                uint4 o;
                o.x = pk2(bf2f((unsigned short)(v.x & 0xFFFFu)) * sc, bf2f((unsigned short)(v.x >> 16)) * sc); o.y = pk2(bf2f((unsigned short)(v.y & 0xFFFFu)) * sc, bf2f((unsigned short)(v.y >> 16)) * sc);
                o.z = pk2(bf2f((unsigned short)(v.z & 0xFFFFu)) * sc, bf2f((unsigned short)(v.z >> 16)) * sc); o.w = pk2(bf2f((unsigned short)(v.w & 0xFFFFu)) * sc, bf2f((unsigned short)(v.w >> 16)) * sc);
                *(uint4*)(W_PQ + t * 2048 + h * 512 + 256 + d) = o;
            }
        }
#pragma nounroll
        PHASE_LOOP(128) { const int cgh = VB, cg = cgh >> 2, h = cgh & 3;
            float a = 0.f;
            for (int l = 0; l < 256; ++l) { const size_t t = (size_t)cg * 256 + l; a = fmaf(W_GS[(t * 4 + h) * 8 + 2], bf2f(W_MK[t * 1024 + h * 256 + tid]), a); }
            W_DN[(size_t)cgh * 256 + tid] = a; }
        __syncthreads();
        {
            GJOB_DEFAULT(g); g.A = W_MQ; g.lda = 1024; g.a_pm_step = 256 * 1024; g.a_pn_mask = 3; g.a_pn_step = 256; g.K = 256; g.nN = 4;
            g.Bt = W_MK; g.ldb = 1024; g.b_pn_step = 256; g.b_pm_step = 256 * 1024; g.C = (float*)W_PQ; g.gs = W_GS; g.denp = W_DENP;
            pg8::gemm_phase<6>(GEMM_LDSP, g, tidx);
        }
    }
    xcd_barrier(xb);
    {
        PH_BEGIN();
        GJOB_DEFAULT(g); g.A = W_BH; g.lda = 512; g.a_pm_step = 4 * 256 * 512; g.a_pn_mask = 3; g.a_pn_step = 256 * 512; g.K = 256; g.nN = 4;
        g.Bt = W_KWT; g.ldb = 256; g.b_pn_step = 65536; g.b_pm_step = 4 * 65536; g.C = W_DC;
        pg8::gemm_phase<7>(GEMM_LDSP, g, tidx);
    }
    xcd_barrier(xb);
    {
        PH_BEGIN();
        {
#pragma nounroll
            for (int gid = blockIdx.x * NTHR + tidx; gid < 131072; gid += gridDim.x * NTHR) {
                const int bh = gid >> 14, b = bh >> 2, h = bh & 3, e = (gid >> 6) & 255, d = (gid & 63) * 4;
                float4 C = make_float4(0.f, 0.f, 0.f, 0.f);
#pragma unroll 4
                for (int c = 0; c < 16; ++c) {
                    const int cgh = (b * 16 + c) * 4 + h;
                    uint2 o; o.x = pk2(C.x, C.y); o.y = pk2(C.z, C.w);
                    *(uint2*)(W_BH + ((size_t)cgh * 256 + e) * 512 + 256 + d) = o;
                    const float dec = W_DECAY[cgh];
                    const float4 dc = *(const float4*)(W_DC + ((size_t)cgh * 256 + e) * 256 + d);
                    C.x = fmaf(dec, C.x, dc.x); C.y = fmaf(dec, C.y, dc.y); C.z = fmaf(dec, C.z, dc.z); C.w = fmaf(dec, C.w, dc.w);
                }
            }
        }
#pragma nounroll
        PHASE_LOOP(128) { const int cgh = VB, cg = cgh >> 2, h = cgh & 3, b = cg >> 4, c = cg & 15;
            float n = 0.f;
            for (int cc = 0; cc < c; ++cc) { const int j = (b * 16 + cc) * 4 + h; n = fmaf(W_DECAY[j], n, W_DN[(size_t)j * 256 + tid]); }
            __syncthreads();
            sm[tid] = n;
            __syncthreads();
            const int lane = tid & 63, w = tid >> 6;
            const float4 nv = *(const float4*)(sm + lane * 4);
            for (int i = 0; i < 64; ++i) {
                const size_t t = (size_t)cg * 256 + w * 64 + i;
                const ushort4 q4 = *(const ushort4*)(W_MQ + t * 1024 + h * 256 + lane * 4);
                float s = bf2f(q4.x) * nv.x + bf2f(q4.y) * nv.y + bf2f(q4.z) * nv.z + bf2f(q4.w) * nv.w;
                s = wave_sum(s);
                if (lane == 0) W_QN[t * 4 + h] = s;
            }
        }
    }
    xcd_barrier(xb);
    {
        PH_BEGIN();
        GJOB_DEFAULT(g); g.A = W_PQ; g.a_pn_mask = 3; g.a_pn_step = 512; g.K = 512; g.nN = 4;
        g.Bt = W_BH; g.ldb = 512; g.b_pn_step = 256 * 512; g.b_pm_step = 4 * 256 * 512; g.C = (float*)W_MIXB;
        g.gs = W_GS; g.denp = W_DENP; g.qn = W_QN; g.gvec = PF(I_GMHEAD); g.mo = W_P6 + 2 * P6S; g.nblk = 128;
        if (blockIdx.x < 128) pg8::gemm_phase<8>(GEMM_LDSP, g, tidx);
        else {
            GJOB_DEFAULT(k); k.A = W_MN2; k.K = 1024; k.nM = 2; k.nN = 32; k.a_pn_shift = 4; k.a_pn_mask = 1; k.a_pn_step = 1024;
            k.Bt = (bf16_t*)(wsb + O_WXK); k.b_pn_mask = 15; k.b_pn_shift = 4; k.b_pn_step2 = 1024; k.C = W_KVP; k.bid0 = 128; k.nblk = 128;
            pg8::gemm_phase<12>(GEMM_LDSP, k, tidx);
        }
    }
    xcd_barrier(xb);
    {
        PH_BEGIN();
        for (int i = blockIdx.x * NTHR + tidx; i < 512 * 4096 / 4; i += gridDim.x * NTHR) {
            const int r = i >> 10, c = (i & 1023) * 4;
            const float4 a = *(const float4*)(W_KVP + (size_t)r * 4096 + c), b = *(const float4*)(W_KVP + (size_t)512 * 4096 + (size_t)r * 4096 + c);
            const float v0 = a.x + b.x, v1 = a.y + b.y, v2 = a.z + b.z, v3 = a.w + b.w;
            if (c < 2048) { uint2 o; o.x = pk2(v0, v1); o.y = pk2(v2, v3); *(uint2*)(W_KM + (size_t)r * 2048 + c) = o; }
            else { bf16_t* d = W_VMT + (size_t)(c - 2048) * 512 + r; d[0] = (bf16_t)f2bf(v0); d[512] = (bf16_t)f2bf(v1); d[1024] = (bf16_t)f2bf(v2); d[1536] = (bf16_t)f2bf(v3); }
        }
        GJOB_DEFAULT(g); g.A = W_MIXB; g.Bt = (bf16_t*)(wsb + O_WOUT); g.C = W_XR; g.R = PF(I_X); g.C2 = W_HB; g.gvec = PF(I_GCROSS); g.rssp = W_RSSP;
        pg8::gemm_phase<10>(GEMM_LDSP, g, tidx);
    }
    xcd_barrier(xb);
    {
        PH_BEGIN();
        {
            GJOB_DEFAULT(g); g.A = W_HB; g.Bt = (bf16_t*)(wsb + O_WXQ); g.C = (float*)W_QX;
            pg8::Unit u0;
            if (pg8::unit_next(g, 0, u0) && tidx < 256) { const size_t r = (size_t)u0.pm * 256 + tidx; float s = 0.f; for (int k = 0; k < 32; ++k) s += W_RSSP[r * 32 + k];
                ((LAS float*)(LAS unsigned char*)(smem_raw + GEMM_LDS + 1024 + 8192))[tidx] = rsqrtf(s * (1.0f / D) + EPS); }
            __syncthreads();
            pg8::gemm_phase<11>(GEMM_LDSP, g, tidx); __syncthreads();
        }

    }
    xcd_barrier(xb);
    {
        PH_BEGIN();
        GJOB_DEFAULT(g); g.A = W_QX; g.K = 512; g.a_pn_mask = 3; g.a_pn_step = 512; g.Bt = W_KM; g.b_pn_step = 512; g.b_pm_shift = 4; g.b_pm_step = 256 * D; g.nN = 4;
        g.C = (float*)W_PX; g.ldc = 1024; g.escale = 0.04419417382415922f * 1.4426950408889634f;
        pg8::gemm_phase<5>(GEMM_LDSP, g, tidx);
    }
    xcd_barrier(xb);
    {
        PH_BEGIN();
        GJOB_DEFAULT(g); g.A = W_PX; g.lda = 1024; g.a_pm_step = 256 * 1024; g.K = 256; g.a_pn_shift = 1; g.a_pn_mask = 3; g.a_pn_step = 256; g.Bt = W_VMT; g.ldb = 512; g.b_pn_step = 256 * 512; g.b_pm_shift = 4; g.b_pm_step = 256;
        g.C = (float*)W_MIXB;
        pg8::gemm_phase<3>(GEMM_LDSP, g, tidx);
    }
    xcd_barrier(xb);
    {
        PH_BEGIN();
        GJOB_DEFAULT(g); g.A = W_MIXB; g.Bt = (bf16_t*)(wsb + O_WXO); g.C = W_XR; g.R = W_XR; g.C2 = W_HB; g.gvec = PF(I_GFFN); g.rssp = W_RSSP;
        pg8::gemm_phase<10>(GEMM_LDSP, g, tidx);
    }
    xcd_barrier(xb);
    {
        PH_BEGIN();
        GJOB_DEFAULT(g); g.A = W_HB; g.Bt = (bf16_t*)(wsb + O_WPQ); g.C = (float*)W_QX;
        pg8::Unit u0;
        if (pg8::unit_next(g, 0, u0) && tidx < 256) { const size_t r = (size_t)u0.pm * 256 + tidx; float s = 0.f; for (int k = 0; k < 32; ++k) s += W_RSSP[r * 32 + k];
            const float rs = rsqrtf(s * (1.0f / D) + EPS);
            ((LAS float*)(LAS unsigned char*)(smem_raw + GEMM_LDS + 1024 + 8192))[tidx] = rs; W_RSTD[r] = rs; }
        __syncthreads();
        pg8::gemm_phase<11>(GEMM_LDSP, g, tidx);
    }
    xcd_barrier(xb);
    {
        PH_BEGIN();
        LAS float* wl = (LAS float*)(LAS unsigned char*)smem_raw + (tidx >> 6) * 1024;
#pragma nounroll
        for (int item = blockIdx.x * 8 + (tidx >> 6); item < 4096; item += gridDim.x * 8) peer_topk_wave2(item, tidx & 63, wl, W_QX, W_SKB, W_IDS, W_GATES);
    }
    xcd_barrier(xb);
    {
        PH_BEGIN();
        const float* gf = PF(I_GFINAL); float* outp = (float*)ldp_raw(I_OUT);
        LAS unsigned char* wl = (LAS unsigned char*)smem_raw + (tidx >> 6) * 18944;
#pragma nounroll
        for (int gw = blockIdx.x * 8 + (tidx >> 6); gw < T / 4; gw += gridDim.x * 8) { int ln = tidx & 63; asm volatile("" : "+v"(ln));
            peer_sweep_wave(gw, ln, wl, W_HB, W_XR, W_IDS, W_GATES, W_UT, W_VT, W_RSC, W_RSTD, gf, outp); }
    }
}
}

extern "C" void kernel_launch(void* const* d_in, const int* in_sizes, int n_in, void* d_out, int out_size, void* d_ws, size_t ws_size, hipStream_t stream) {
    static int grid_blocks = 0;
    if (!grid_blocks) {
        int dev = 0, cus = 0, per_cu = 0;
        hipGetDevice(&dev);
        hipDeviceGetAttribute(&cus, hipDeviceAttributeMultiprocessorCount, dev);
        hipFuncSetAttribute((const void*)mega, hipFuncAttributeMaxDynamicSharedMemorySize, SMEM_BYTES);
        hipOccupancyMaxActiveBlocksPerMultiprocessor(&per_cu, mega, NTHR, SMEM_BYTES);
        if (per_cu > 1) per_cu = 1;
        if (per_cu < 1) per_cu = 1;
        grid_blocks = cus * per_cu;
    }
    Params P{};
    const float** pp = (const float**)&P;
    for (int i = 0; i < 25; ++i) pp[i] = (const float*)d_in[i];
    P.out = (float*)d_out;
    P.bar = (unsigned*)d_ws;
    P.ws = (float*)((char*)d_ws + 16384);
    hipMemsetAsync(d_ws, 0, 16384, stream);
    void* args[] = {&P};
    hipError_t e = hipLaunchCooperativeKernel((const void*)mega, dim3(grid_blocks), dim3(NTHR), args, SMEM_BYTES, stream);
    if (e != hipSuccess) fprintf(stderr, "cooperative launch failed: %s (grid %d)\n", hipGetErrorString(e), grid_blocks);
}
```

```cpp
#include <hip/hip_runtime.h>
#include <stdint.h>
#include <math.h>
#include <cstdio>

#define LAS_ __attribute__((address_space(3)))
namespace {
constexpr int D = 2048, NB = 2, S = 4096, T = NB * S;
constexpr int INC = 6152;
constexpr int C_MIN = 0, C_MV = 1024, C_MO = 2048, C_MI = 3072, C_MF = 3076, C_AQ = 3080, C_AK = 4104, C_AV = 5128;
constexpr float EPS = 1e-6f;
constexpr size_t P6S = (size_t)8192 * 1024;
constexpr int NTHR = 512;
constexpr int HALF_SM_FLOATS = 8704;
constexpr int GEMM_LDS = 131072;
constexpr int SMEM_BYTES = 163840;
constexpr int CTRL_OFF = SMEM_BYTES - 1024;
typedef unsigned short bf16_t;
__device__ __forceinline__ unsigned f2bf(float f) { unsigned u = __float_as_uint(f); u += 0x7FFFu + ((u >> 16) & 1u); return u >> 16; }
__device__ __forceinline__ unsigned pk2(float lo, float hi) { return f2bf(lo) | (f2bf(hi) << 16); }
__device__ __forceinline__ float bf2f(unsigned short b) { return __uint_as_float(((unsigned)b) << 16); }
extern __shared__ __attribute__((aligned(16))) unsigned char smem_raw[];
enum { I_X = 0, I_MEM, I_GMIX, I_WIN, I_CONVW, I_CONVB, I_WMQ, I_WMK, I_BMI, I_BMF, I_GMHEAD, I_GAHEAD, I_WOUT, I_GCROSS, I_GMEM,
       I_WXQ, I_WXK, I_WXV, I_WXO, I_GFFN, I_WPQ, I_SUBK, I_UTAB, I_VTAB, I_GFINAL, I_OUT, I_BAR, I_WS, I_NPTR };
__device__ __forceinline__ unsigned long long ldp_raw(int i) {
    const LAS_ unsigned long long* tab = (const LAS_ unsigned long long*)(LAS_ unsigned char*)(smem_raw + CTRL_OFF + 64);
    const unsigned long long v = tab[i];
    const unsigned lo = __builtin_amdgcn_readfirstlane((unsigned)v), hi = __builtin_amdgcn_readfirstlane((unsigned)(v >> 32));
    return ((unsigned long long)hi << 32) | lo;
}
#define PF(i) ((const float*)ldp_raw(i))

#define XB_TMO      128
#define XB_XCNT(j)  (256  + 64 * (j))
#define XB_XSUB(j)  (1280 + 64 * (j))
#define XB_XGEN(j)  (2304 + 64 * (j))
#define XB_TOP      3328
#define XB_TOPGEN   3392
#define XCD_BAR_WORDS 3456
#define XB_SPIN_CAP (1u << 22)
#define LAS __attribute__((address_space(3)))

__device__ __forceinline__ unsigned xb_ld(unsigned* p)              { return __hip_atomic_load(p, __ATOMIC_RELAXED, __HIP_MEMORY_SCOPE_AGENT); }
__device__ __forceinline__ unsigned xb_add(unsigned* p, unsigned v) { return __hip_atomic_fetch_add(p, v, __ATOMIC_RELAXED, __HIP_MEMORY_SCOPE_AGENT); }
__device__ __forceinline__ unsigned xb_xcc_id() { return (unsigned)__builtin_amdgcn_s_getreg((3 << 11) | 20) & 0xFu; }
#define XB_SPIN(cond, bar) do { unsigned _sp = 0; while (cond) { __builtin_amdgcn_s_sleep(1); \
    if ((++_sp & 255u) == 0u) { if (xb_ld(&(bar)[XB_TMO])) break; if (_sp > XB_SPIN_CAP) { atomicAdd(&(bar)[XB_TMO], 1u); break; } } } } while (0)

struct XcdBarrier { unsigned* bar; unsigned x; volatile LAS unsigned* st; };

__device__ __forceinline__ XcdBarrier xcd_barrier_post(unsigned* bar, volatile LAS unsigned* st) {
    XcdBarrier b; b.bar = bar; b.x = xb_xcc_id(); b.st = st;
    if (threadIdx.x == 0) (void)xb_add(&bar[XB_XCNT(b.x)], 1u);
    return b;
}
__device__ __forceinline__ void xcd_barrier_complete(unsigned* bar, unsigned x, unsigned& nloc, unsigned& nx) {
    const unsigned G = gridDim.x * gridDim.y * gridDim.z;
    unsigned sum, cnt, mine, sp = 0u;
    for (;;) {
        sum = 0u; cnt = 0u; mine = 0u;
#pragma unroll
        for (unsigned j = 0; j < 16; ++j) { const unsigned c = xb_ld(&bar[XB_XCNT(j)]); sum += c; cnt += (c > 0u) ? 1u : 0u; mine = (j == x) ? c : mine; }
        if (sum == G) break;
        __builtin_amdgcn_s_sleep(1);
        if ((++sp & 255u) == 0u) { if (xb_ld(&bar[XB_TMO])) break; if (sp > XB_SPIN_CAP) { atomicAdd(&bar[XB_TMO], 1u); break; } }
    }
    nloc = mine > 0u ? mine : 1u; nx = cnt > 0u ? cnt : 1u;
}
__device__ __forceinline__ void xcd_barrier(const XcdBarrier& b) {
    asm volatile("s_waitcnt vmcnt(0)" ::: "memory");
    __syncthreads();
    if (threadIdx.x == 0) {
        unsigned* bar = b.bar;
        __builtin_amdgcn_s_waitcnt(0);
        unsigned nloc = b.st[0], nx = b.st[1];
        if (nloc == 0u) { xcd_barrier_complete(bar, b.x, nloc, nx); b.st[0] = nloc; b.st[1] = nx; }
        const unsigned old = xb_add(&bar[XB_XSUB(b.x)], 1u);
        const unsigned gen = old / nloc;
        if (old + 1u == (gen + 1u) * nloc) {
            __builtin_amdgcn_fence(__ATOMIC_RELEASE, "agent");
            asm volatile("s_waitcnt vmcnt(0)" ::: "memory");
            const unsigned og = xb_add(&bar[XB_TOP], 1u);
            const unsigned tg = og / nx;
            if (og + 1u == (tg + 1u) * nx) xb_add(&bar[XB_TOPGEN], 1u);
            else XB_SPIN(xb_ld(&bar[XB_TOPGEN]) == tg, bar);
            __builtin_amdgcn_fence(__ATOMIC_ACQUIRE, "agent");
            xb_add(&bar[XB_XGEN(b.x)], 1u);
            asm volatile("s_waitcnt vmcnt(0)" ::: "memory");
        } else {
            XB_SPIN(xb_ld(&bar[XB_XGEN(b.x)]) == gen, bar);
            __builtin_amdgcn_fence(__ATOMIC_ACQUIRE, "agent");
            asm volatile("s_waitcnt vmcnt(0)" ::: "memory");
        }
    }
    __syncthreads();
}

__device__ __forceinline__ float wave_sum(float v) {
#pragma unroll
    for (int o = 32; o >= 1; o >>= 1) v += __shfl_xor(v, o);
    return v;
}
__device__ __forceinline__ float wave_max(float v) {
#pragma unroll
    for (int o = 32; o >= 1; o >>= 1) v = fmaxf(v, __shfl_xor(v, o));
    return v;
}
__device__ __forceinline__ float log_sigmoid(float x) { return fminf(x, 0.f) - log1pf(expf(-fabsf(x))); }


__device__ __forceinline__ void d_rmsnorm(int vb, int t, float* sm, const float* __restrict__ in, const float* __restrict__ g, bf16_t* __restrict__ out,
                                          const float* gwl  , float* __restrict__ gpre) {
    float* red = sm;
    const int row = vb;
    const float4* p = (const float4*)(in + (size_t)row * D);
    float4 a = p[t], b = p[t + 256];
    float s = a.x * a.x + a.y * a.y + a.z * a.z + a.w * a.w + b.x * b.x + b.y * b.y + b.z * b.z + b.w * b.w;
    s = wave_sum(s);
    __syncthreads();
    if ((t & 63) == 0) red[t >> 6] = s;
    __syncthreads();
    const float tot = red[0] + red[1] + red[2] + red[3];
    const float r = rsqrtf(tot * (1.0f / D) + EPS);
    const float4* gp = (const float4*)g;
    float4 ga = gp[t], gb = gp[t + 256];
    float hv[8] = {a.x * r * ga.x, a.y * r * ga.y, a.z * r * ga.z, a.w * r * ga.w, b.x * r * gb.x, b.y * r * gb.y, b.z * r * gb.z, b.w * r * gb.w};
    uint2 o0, o1;
    o0.x = pk2(hv[0], hv[1]); o0.y = pk2(hv[2], hv[3]); o1.x = pk2(hv[4], hv[5]); o1.y = pk2(hv[6], hv[7]);
    *(uint2*)(out + (size_t)row * D + t * 4) = o0;
    *(uint2*)(out + (size_t)row * D + 1024 + t * 4) = o1;
    if (gpre) {
        float gs[8];
#pragma unroll
        for (int c = 0; c < 8; ++c) gs[c] = 0.f;
#pragma unroll
        for (int j = 0; j < 8; ++j) {
            const int k = (j < 4) ? (t * 4 + j) : (1024 + t * 4 + (j - 4));
            const float4 w0 = *(const float4*)(gwl + k * 8), w1 = *(const float4*)(gwl + k * 8 + 4);
            gs[0] = fmaf(hv[j], w0.x, gs[0]); gs[1] = fmaf(hv[j], w0.y, gs[1]); gs[2] = fmaf(hv[j], w0.z, gs[2]); gs[3] = fmaf(hv[j], w0.w, gs[3]);
            gs[4] = fmaf(hv[j], w1.x, gs[4]); gs[5] = fmaf(hv[j], w1.y, gs[5]); gs[6] = fmaf(hv[j], w1.z, gs[6]); gs[7] = fmaf(hv[j], w1.w, gs[7]);
        }
#pragma unroll
        for (int c = 0; c < 8; ++c) gs[c] = wave_sum(gs[c]);
        __syncthreads();
        if ((t & 63) == 0) {
#pragma unroll
            for (int c = 0; c < 8; ++c) red[8 + (t >> 6) * 8 + c] = gs[c];
        }
        __syncthreads();
        if (t < 8) gpre[(size_t)row * 8 + t] = red[8 + t] + red[16 + t] + red[24 + t] + red[32 + t];
    }
}

namespace pg8 {
typedef short bf16x8 __attribute__((ext_vector_type(8)));
typedef float f32x4 __attribute__((ext_vector_type(4)));
constexpr int BM = 256, BK = 64, HALF = 128, HTB = HALF * BK * 2, NXCD = 8, WGM = 8;
__device__ __forceinline__ int lds_byte(int r, int c) { const int st = (r >> 4) * 2 + (c >> 5), rr = r & 15, cc = c & 31, ob = rr * 64 + cc * 2; return st * 1024 + (ob ^ (((ob >> 9) & 1) << 5)); }
__device__ __forceinline__ void stage_rc(int b, int& R, int& C) { const int st = b / 1024, sb = b % 1024, swz = sb ^ (((sb >> 9) & 1) << 5); R = (st >> 1) * 16 + swz / 64; C = (st & 1) * 32 + (swz % 64) / 2; }
struct Unit { int pm, pn; };
struct GJob {
    const bf16_t* A; const bf16_t* Bt;
    int lda, ldb, K, nM, nN;
    int a_pn_shift, a_pn_mask, a_pn_step;
    int b_pm_shift, b_pm_step, b_pn_step;
    int a_pm_step;
    int b_pn_mask, b_pn_shift, b_pn_step2;
    int bid0, nblk;
    float escale;
    const float* gs; float* denp; const float* qn; const float* gvec; const bf16_t* mo;
    bf16_t* C2; float* rssp; const float* rstd;
    float* C; int ldc; const float* R; int ldr;
    int mode;
};
__device__ __forceinline__ bool unit_next(const GJob& g, int i, Unit& u) {
    const int nwg = g.nM * g.nN;
    const int bid = (int)blockIdx.x - g.bid0; if (bid < 0 || bid >= g.nblk) return false;
    const long L = (long)i * g.nblk + bid; if (L >= nwg) return false;
    int wgid = (int)L; { const int q = nwg / NXCD, r = nwg % NXCD, xcd = wgid % NXCD, off = wgid / NXCD; wgid = (xcd < r ? xcd * (q + 1) : r * (q + 1) + (xcd - r) * q) + off; }
    const int nig = WGM * g.nN, gid = wgid / nig, fm = gid * WGM, gsz = (g.nM - fm) < WGM ? (g.nM - fm) : WGM;
    u.pm = fm + ((wgid % nig) % gsz); u.pn = (wgid % nig) / gsz; return true;
}
template <int MODE> __device__ __forceinline__ void epilogue(const GJob& g, f32x4 (&acc)[2][2][4][2], const Unit& u, int wr, int wc, int fr, int fq, LAS unsigned char* xlds) {
    const int row0 = u.pm * BM + wr * 64 + fr;
    if constexpr (MODE == 0) {
        const int col0 = u.pn * BM + wc * 32 + 4 * fq;
#pragma unroll
        for (int ai = 0; ai < 2; ++ai)
#pragma unroll
            for (int m = 0; m < 4; ++m) {
                const int row = row0 + ai * HALF + m * 16;
                float* rowp = g.C + (size_t)row * g.ldc + col0;
                const float* rp = g.R ? g.R + (size_t)row * g.ldr + col0 : nullptr;
#pragma unroll
                for (int bj = 0; bj < 2; ++bj)
#pragma unroll
                    for (int n = 0; n < 2; ++n) {
                        f32x4 v = acc[ai][bj][m][n];
                        if (rp) v = v + *(const f32x4*)(rp + bj * HALF + n * 16);
                        *(f32x4*)(rowp + bj * HALF + n * 16) = v;
                    }
            }
    } else if constexpr (MODE == 10) {
        const int col0 = u.pn * BM + wc * 32 + 4 * fq;
#pragma unroll
        for (int ai = 0; ai < 2; ++ai)
#pragma unroll
            for (int m = 0; m < 4; ++m) {
                const int row = row0 + ai * HALF + m * 16;
                bf16_t* r2 = g.C2 + (size_t)row * D + col0;
                float ss = 0.f;
#pragma unroll
                for (int bj = 0; bj < 2; ++bj)
#pragma unroll
                    for (int n = 0; n < 2; ++n) {
                        f32x4 v = acc[ai][bj][m][n];
                        if (g.R) v = v + *(const f32x4*)(g.R + (size_t)row * g.ldr + col0 + bj * HALF + n * 16);
                        else { const uint2 pr = *(const uint2*)(r2 + bj * HALF + n * 16);
                               v[0] += __uint_as_float(pr.x << 16); v[1] += __uint_as_float(pr.x & 0xFFFF0000u); v[2] += __uint_as_float(pr.y << 16); v[3] += __uint_as_float(pr.y & 0xFFFF0000u); }
                        uint2 o; o.x = pk2(v[0], v[1]); o.y = pk2(v[2], v[3]);
                        *(uint2*)(r2 + bj * HALF + n * 16) = o;
                        ss += (v[0] * v[0] + v[1] * v[1]) + (v[2] * v[2] + v[3] * v[3]);
                    }
                ss += __shfl_xor(ss, 16); ss += __shfl_xor(ss, 32);
                if (fq == 0) g.rssp[(size_t)row * 32 + u.pn * 4 + wc] = ss;
            }
    } else if constexpr (MODE == 11) {
        bf16_t* Cb = (bf16_t*)g.C;
        const int col0 = u.pn * BM + wc * 32 + 4 * fq;
#pragma unroll
        for (int ai = 0; ai < 2; ++ai)
#pragma unroll
            for (int m = 0; m < 4; ++m) {
                const int row = row0 + ai * HALF + m * 16;
                const float rs = ((const LAS float*)(xlds + 8192))[row - u.pm * BM];
                bf16_t* rowp = Cb + (size_t)row * g.ldc + col0;
#pragma unroll
                for (int bj = 0; bj < 2; ++bj)
#pragma unroll
                    for (int n = 0; n < 2; ++n) {
                        const f32x4 v = acc[ai][bj][m][n] * rs;
                        uint2 o; o.x = pk2(v[0], v[1]); o.y = pk2(v[2], v[3]);
                        *(uint2*)(rowp + bj * HALF + n * 16) = o;
                    }
            }
    } else if constexpr (MODE == 6) {
        const int h = u.pn; const size_t t0 = (size_t)u.pm * BM;
        bf16_t* Cb = (bf16_t*)g.C;
#pragma unroll
        for (int ai = 0; ai < 2; ++ai)
#pragma unroll
            for (int m = 0; m < 4; ++m) {
                const int l = ai * HALF + wr * 64 + m * 16 + fr;
                const float M2 = g.gs[((t0 + l) * 4 + h) * 8 + 1];
                bf16_t* rowp = Cb + (t0 + l) * 2048 + h * 512 + wc * 32 + 4 * fq;
                float rs = 0.f;
#pragma unroll
                for (int bj = 0; bj < 2; ++bj)
#pragma unroll
                    for (int n = 0; n < 2; ++n) {
                        const f32x4 a = acc[ai][bj][m][n];
                        const int s0 = bj * HALF + wc * 32 + n * 16 + 4 * fq;
                        float p[4];
#pragma unroll
                        for (int r = 0; r < 4; ++r) { const float u2 = g.gs[((t0 + s0 + r) * 4 + h) * 8 + 0]; p[r] = (s0 + r <= l) ? a[r] * __builtin_amdgcn_exp2f(u2 - M2) : 0.f; rs += p[r]; }
                        uint2 o; o.x = pk2(p[0], p[1]); o.y = pk2(p[2], p[3]);
                        *(uint2*)(rowp + bj * HALF + n * 16) = o;
                    }
                rs += __shfl_xor(rs, 16); rs += __shfl_xor(rs, 32);
                if (fq == 0) g.denp[((t0 + l) * 4 + h) * 4 + wc] = rs;
            }
    } else if constexpr (MODE == 12) {
        float* Ct = g.C + (size_t)(u.pn >> 4) * ((size_t)512 * 4096) + (size_t)(u.pn & 15) * 256;
        const int col0 = wc * 32 + 4 * fq;
#pragma unroll
        for (int ai = 0; ai < 2; ++ai)
#pragma unroll
            for (int m = 0; m < 4; ++m) {
                float* rowp = Ct + (size_t)(row0 + ai * HALF + m * 16) * 4096 + col0;
#pragma unroll
                for (int bj = 0; bj < 2; ++bj)
#pragma unroll
                    for (int n = 0; n < 2; ++n) *(f32x4*)(rowp + bj * HALF + n * 16) = acc[ai][bj][m][n];
            }
    } else if constexpr (MODE == 7) {
        float* Ct = g.C + (size_t)(u.pm * 4 + u.pn) * 65536;
        const int col0 = wc * 32 + 4 * fq;
#pragma unroll
        for (int ai = 0; ai < 2; ++ai)
#pragma unroll
            for (int m = 0; m < 4; ++m) {
                float* rowp = Ct + (size_t)(ai * HALF + wr * 64 + m * 16 + fr) * 256 + col0;
#pragma unroll
                for (int bj = 0; bj < 2; ++bj)
#pragma unroll
                    for (int n = 0; n < 2; ++n) *(f32x4*)(rowp + bj * HALF + n * 16) = acc[ai][bj][m][n];
            }
    } else if constexpr (MODE == 8) {
        const int h = u.pn; const size_t t0 = (size_t)u.pm * BM;
        LAS float* X0 = (LAS float*)xlds + wr * 512;
#pragma unroll
        for (int ai = 0; ai < 2; ++ai)
#pragma unroll
            for (int m = 0; m < 4; ++m) {
                const size_t th = (t0 + ai * HALF + wr * 64 + m * 16 + fr) * 4 + h;
                const f32x4 dp = *(const f32x4*)(g.denp + th * 4);
                const float den = (dp[0] + dp[1]) + (dp[2] + dp[3]) + g.gs[th * 8 + 3] * g.qn[th];
                const float rden = 1.0f / fmaxf(fabsf(den), g.gs[th * 8 + 4]);
                float ss = 0.f;
#pragma unroll
                for (int bj = 0; bj < 2; ++bj)
#pragma unroll
                    for (int n = 0; n < 2; ++n) { f32x4 a = acc[ai][bj][m][n] * rden; acc[ai][bj][m][n] = a; ss += (a[0] * a[0] + a[1] * a[1]) + (a[2] * a[2] + a[3] * a[3]); }
                ss += __shfl_xor(ss, 16); ss += __shfl_xor(ss, 32);
                if (fq == 0) X0[(ai * 64 + m * 16 + fr) * 4 + wc] = ss;
            }
        asm volatile("s_waitcnt lgkmcnt(0)" ::: "memory"); __builtin_amdgcn_s_barrier(); asm volatile("" ::: "memory");
        bf16_t* Cb = (bf16_t*)g.C;
        const int col0 = wc * 32 + 4 * fq;
#pragma unroll
        for (int ai = 0; ai < 2; ++ai)
#pragma unroll
            for (int m = 0; m < 4; ++m) {
                const f32x4 p4 = *(const LAS f32x4*)(X0 + (ai * 64 + m * 16 + fr) * 4);
                const float rsn = rsqrtf(((p4[0] + p4[1]) + (p4[2] + p4[3])) * (1.0f / 256.0f) + EPS);
                const size_t t = t0 + ai * HALF + wr * 64 + m * 16 + fr;
                bf16_t* rowp = Cb + t * 2048 + h * 256 + col0;
                const bf16_t* mop = g.mo + t * 1024 + h * 256 + col0;
#pragma unroll
                for (int bj = 0; bj < 2; ++bj)
#pragma unroll
                    for (int n = 0; n < 2; ++n) {
                        const f32x4 a = acc[ai][bj][m][n];
                        const ushort4 mo4 = *(const ushort4*)(mop + bj * HALF + n * 16);
                        const f32x4 gv = *(const f32x4*)(g.gvec + h * 256 + col0 + bj * HALF + n * 16);
                        const float o0 = a[0] * rsn * gv[0] / (1.0f + __expf(-bf2f(mo4.x)));
                        const float o1 = a[1] * rsn * gv[1] / (1.0f + __expf(-bf2f(mo4.y)));
                        const float o2 = a[2] * rsn * gv[2] / (1.0f + __expf(-bf2f(mo4.z)));
                        const float o3 = a[3] * rsn * gv[3] / (1.0f + __expf(-bf2f(mo4.w)));
                        uint2 o; o.x = pk2(o0, o1); o.y = pk2(o2, o3);
                        *(uint2*)(rowp + bj * HALF + n * 16) = o;
                    }
            }
    } else if constexpr (MODE == 5) {
        LAS float* X0 = (LAS float*)xlds + wr * 512;
        LAS float* X1 = (LAS float*)xlds + 1024 + wr * 512;
#pragma unroll
        for (int ai = 0; ai < 2; ++ai)
#pragma unroll
            for (int m = 0; m < 4; ++m) {
                float v = -INFINITY;
#pragma unroll
                for (int bj = 0; bj < 2; ++bj)
#pragma unroll
                    for (int n = 0; n < 2; ++n) { const f32x4 a = acc[ai][bj][m][n]; v = fmaxf(v, fmaxf(fmaxf(a[0], a[1]), fmaxf(a[2], a[3]))); }
                v = fmaxf(v, __shfl_xor(v, 16)); v = fmaxf(v, __shfl_xor(v, 32));
                if (fq == 0) X0[(ai * 64 + m * 16 + fr) * 4 + wc] = v;
            }
        asm volatile("s_waitcnt lgkmcnt(0)" ::: "memory"); __builtin_amdgcn_s_barrier(); asm volatile("" ::: "memory");
#pragma unroll
        for (int ai = 0; ai < 2; ++ai)
#pragma unroll
            for (int m = 0; m < 4; ++m) {
                const f32x4 p4 = *(const LAS f32x4*)(X0 + (ai * 64 + m * 16 + fr) * 4);
                const float mxr = fmaxf(fmaxf(p4[0], p4[1]), fmaxf(p4[2], p4[3])) * g.escale;
                float s = 0.f;
#pragma unroll
                for (int bj = 0; bj < 2; ++bj)
#pragma unroll
                    for (int n = 0; n < 2; ++n) { f32x4 a = acc[ai][bj][m][n];
                        a[0] = __builtin_amdgcn_exp2f(a[0] * g.escale - mxr); a[1] = __builtin_amdgcn_exp2f(a[1] * g.escale - mxr); a[2] = __builtin_amdgcn_exp2f(a[2] * g.escale - mxr); a[3] = __builtin_amdgcn_exp2f(a[3] * g.escale - mxr);
                        acc[ai][bj][m][n] = a; s += (a[0] + a[1]) + (a[2] + a[3]); }
                s += __shfl_xor(s, 16); s += __shfl_xor(s, 32);
                if (fq == 0) X1[(ai * 64 + m * 16 + fr) * 4 + wc] = s;
            }
        asm volatile("s_waitcnt lgkmcnt(0)" ::: "memory"); __builtin_amdgcn_s_barrier(); asm volatile("" ::: "memory");
        bf16_t* Cb = (bf16_t*)g.C;
        const int col0 = u.pn * BM + wc * 32 + 4 * fq;
#pragma unroll
        for (int ai = 0; ai < 2; ++ai)
#pragma unroll
            for (int m = 0; m < 4; ++m) {
                const f32x4 p4 = *(const LAS f32x4*)(X1 + (ai * 64 + m * 16 + fr) * 4);
                const float inv = 1.0f / ((p4[0] + p4[1]) + (p4[2] + p4[3]));
                bf16_t* rowp = Cb + (size_t)(row0 + ai * HALF + m * 16) * g.ldc + col0;
#pragma unroll
                for (int bj = 0; bj < 2; ++bj)
#pragma unroll
                    for (int n = 0; n < 2; ++n) {
                        const f32x4 a = acc[ai][bj][m][n];
                        uint2 o; o.x = pk2(a[0] * inv, a[1] * inv); o.y = pk2(a[2] * inv, a[3] * inv);
                        *(uint2*)(rowp + bj * HALF + n * 16) = o;
                    }
            }
    } else {
        bf16_t* Cb = (bf16_t*)g.C; int ccol = u.pn * BM;
        if constexpr (MODE == 4) { Cb += (size_t)(u.pn >> 2) * P6S; ccol = (u.pn & 3) * 256; }
        const int col0 = ccol + wc * 32 + 4 * fq;
#pragma unroll
        for (int ai = 0; ai < 2; ++ai)
#pragma unroll
            for (int m = 0; m < 4; ++m) {
                bf16_t* rowp = Cb + (size_t)(row0 + ai * HALF + m * 16) * g.ldc + col0;
#pragma unroll
                for (int bj = 0; bj < 2; ++bj)
#pragma unroll
                    for (int n = 0; n < 2; ++n) {
                        const f32x4 v = acc[ai][bj][m][n];
                        uint2 o; o.x = pk2(v[0], v[1]); o.y = pk2(v[2], v[3]);
                        *(uint2*)(rowp + bj * HALF + n * 16) = o;
                    }
            }
    }
}
template <int MODE> __device__ __forceinline__ void gemm_phase(LAS unsigned char* lds, const GJob& g, int tid) {
    const int wid = __builtin_amdgcn_readfirstlane(tid >> 6), lane = tid & 63, wr = wid >> 2, wc = wid & 3, fr = lane & 15, fq = lane >> 4;
    const int K = g.K, nt = K / BK;
    unsigned voffA[2], voffB[2];
#pragma unroll
    for (int i = 0; i < 2; ++i) { int R, C; stage_rc(tid * 16 + i * 8192, R, C);
        voffA[i] = (unsigned)(R * g.lda + C) * 2u; voffB[i] = (unsigned)(R * g.ldb + C) * 2u; }
    const size_t kstep = (size_t)(BK * 2);
    const size_t hstepA = (size_t)HALF * g.lda * 2, hstepB = (size_t)HALF * g.ldb * 2;
    const unsigned ldsw = (unsigned)wid * 1024u;
    const int aoff = lds_byte(wr * 64 + fr, fq * 8), boff = lds_byte(wc * 32 + fr, fq * 8);
#define PG8_SA(b, h) (((b) * 2 + (h)) * HTB)
#define PG8_SB(b, h) ((4 + (b) * 2 + (h)) * HTB)
#define PG8_STAGE(bufoff, gbase, voff) do { _Pragma("unroll") for (int _i = 0; _i < 2; ++_i) \
        __builtin_amdgcn_global_load_lds((const unsigned*)((const char*)(gbase) + (voff)[_i]), (LAS unsigned*)(lds + (bufoff) + ldsw + _i * 8192), 16, 0, 0); } while (0)
#define PG8_LDA(dst, b, h) do { _Pragma("unroll") for (int m = 0; m < 4; ++m) _Pragma("unroll") for (int k = 0; k < 2; ++k) dst[m][k] = *(const LAS bf16x8*)(lds + PG8_SA(b, h) + aoff + m * 2048 + k * 1024); } while (0)
#define PG8_LDB(dst, b, h) do { _Pragma("unroll") for (int n = 0; n < 2; ++n) _Pragma("unroll") for (int k = 0; k < 2; ++k) dst[n][k] = *(const LAS bf16x8*)(lds + PG8_SB(b, h) + boff + n * 2048 + k * 1024); } while (0)
#define PG8_MMA(ai, bj, At, Bt) do { __builtin_amdgcn_s_setprio(1); _Pragma("unroll") for (int m = 0; m < 4; ++m) _Pragma("unroll") for (int n = 0; n < 2; ++n) _Pragma("unroll") for (int k = 0; k < 2; ++k) \
        acc[ai][bj][m][n] = __builtin_amdgcn_mfma_f32_16x16x32_bf16(Bt[n][k], At[m][k], acc[ai][bj][m][n], 0, 0, 0); __builtin_amdgcn_s_setprio(0); } while (0)
#define PG8_WAIT_V(n) asm volatile("s_waitcnt vmcnt(" #n ")" ::: "memory")
#define PG8_WAIT_L(n) asm volatile("s_waitcnt lgkmcnt(" #n ")" ::: "memory")
#define PG8_BAR __builtin_amdgcn_s_barrier()
#define PG8_SCHED __builtin_amdgcn_sched_barrier(0)
#define PG8_ABASE(u) ((const char*)g.A + ((size_t)(u).pm * g.a_pm_step + (size_t)(((u).pn >> g.a_pn_shift) & g.a_pn_mask) * g.a_pn_step) * 2)
#define PG8_BBASE(u) ((const char*)g.Bt + ((size_t)((u).pn & g.b_pn_mask) * g.b_pn_step + (size_t)((u).pn >> g.b_pn_shift) * g.b_pn_step2 + (size_t)((u).pm >> g.b_pm_shift) * g.b_pm_step) * 2)
    Unit cur, nxt; int ui = 0;
    if (!unit_next(g, 0, cur)) return;
    f32x4 acc[2][2][4][2];
#pragma unroll
    for (int a = 0; a < 2; ++a)
#pragma unroll
        for (int b = 0; b < 2; ++b)
#pragma unroll
            for (int m = 0; m < 4; ++m)
#pragma unroll
                for (int n = 0; n < 2; ++n) acc[a][b][m][n] = (f32x4){0.f, 0.f, 0.f, 0.f};
    bf16x8 At[4][2], B0[2][2], B1[2][2];
    const char* cA = PG8_ABASE(cur); const char* cB = PG8_BBASE(cur);
    PG8_STAGE(PG8_SB(0, 0), cB, voffB); PG8_STAGE(PG8_SA(0, 0), cA, voffA); PG8_STAGE(PG8_SB(0, 1), cB + hstepB, voffB); PG8_STAGE(PG8_SA(0, 1), cA + hstepA, voffA);
    if (wr == 1) PG8_BAR;
    PG8_WAIT_V(4); PG8_BAR;
    PG8_STAGE(PG8_SB(1, 0), cB + kstep, voffB); PG8_STAGE(PG8_SA(1, 0), cA + kstep, voffA); PG8_STAGE(PG8_SB(1, 1), cB + hstepB + kstep, voffB);
    PG8_WAIT_V(6); PG8_BAR;
    for (;;) {
        const bool has_next = unit_next(g, ui + 1, nxt);
        const char* nA = has_next ? PG8_ABASE(nxt) : cA; const char* nB = has_next ? PG8_BBASE(nxt) : cB;
        for (int t = 0; t < nt; t += 2) {
            const bool last = (t == nt - 2);
            const char* a1 = cA + (size_t)(t + 1) * kstep;
            const char* a2 = last ? nA : cA + (size_t)(t + 2) * kstep; const char* b2 = last ? nB : cB + (size_t)(t + 2) * kstep;
            const char* a3 = a2 + kstep; const char* b3 = b2 + kstep;
            PG8_LDB(B0, 0, 0); PG8_SCHED; PG8_LDA(At, 0, 0); PG8_STAGE(PG8_SA(1, 1), a1 + hstepA, voffA);
            PG8_WAIT_L(8); PG8_BAR; PG8_WAIT_L(0); PG8_MMA(0, 0, At, B0); PG8_BAR; PG8_SCHED;
            PG8_LDB(B1, 0, 1); PG8_STAGE(PG8_SB(0, 0), b2, voffB);
            PG8_BAR; PG8_WAIT_L(0); PG8_MMA(0, 1, At, B1); PG8_BAR;
            PG8_LDA(At, 0, 1); PG8_STAGE(PG8_SA(0, 0), a2, voffA);
            PG8_BAR; PG8_WAIT_L(0); PG8_MMA(1, 0, At, B0); PG8_BAR; PG8_SCHED;
            PG8_STAGE(PG8_SB(0, 1), b2 + hstepB, voffB);
            PG8_WAIT_V(6); PG8_BAR; PG8_MMA(1, 1, At, B1); PG8_BAR;
            PG8_LDB(B0, 1, 0); PG8_SCHED; PG8_LDA(At, 1, 0); PG8_STAGE(PG8_SA(0, 1), a2 + hstepA, voffA);
            PG8_WAIT_L(8); PG8_BAR; PG8_WAIT_L(0); PG8_MMA(0, 0, At, B0); PG8_BAR; PG8_SCHED;
            PG8_LDB(B1, 1, 1); PG8_STAGE(PG8_SB(1, 0), b3, voffB);
            PG8_BAR; PG8_WAIT_L(0); PG8_MMA(0, 1, At, B1); PG8_BAR;
            PG8_LDA(At, 1, 1); PG8_STAGE(PG8_SA(1, 0), a3, voffA);
            PG8_BAR; PG8_WAIT_L(0); PG8_MMA(1, 0, At, B0); PG8_BAR; PG8_SCHED;
            PG8_STAGE(PG8_SB(1, 1), b3 + hstepB, voffB);
            PG8_WAIT_V(6); PG8_BAR; PG8_MMA(1, 1, At, B1); PG8_BAR;
        }
        epilogue<MODE>(g, acc, cur, wr, wc, fr, fq, lds + GEMM_LDS + 1024);
        if (!has_next) break;
#pragma unroll
        for (int a = 0; a < 2; ++a)
#pragma unroll
            for (int b = 0; b < 2; ++b)
#pragma unroll
                for (int m = 0; m < 4; ++m)
#pragma unroll
                    for (int n = 0; n < 2; ++n) acc[a][b][m][n] = (f32x4){0.f, 0.f, 0.f, 0.f};
        cur = nxt; cA = nA; cB = nB; ++ui;
    }
    PG8_WAIT_V(0);
    if (wr == 0) PG8_BAR;
    PG8_BAR;
#undef PG8_SA
#undef PG8_SB
#undef PG8_STAGE
#undef PG8_LDA
#undef PG8_LDB
#undef PG8_MMA
#undef PG8_WAIT_V
#undef PG8_WAIT_L
#undef PG8_BAR
#undef PG8_SCHED
#undef PG8_ABASE
#undef PG8_BBASE
}
}

__device__ __forceinline__ void p0_transpose_item(const float* W, int ldw, int K, int csrc0, bf16_t* WT, int row0, LAS float* scr, int kb, int lane, float wscale, const float* kgain) {
    const int k0 = 64 * kb;
#pragma unroll
    for (int i = 0; i < 8; ++i) { const int kk = 8 * i + (lane >> 3), n4 = (lane & 7) * 4;
        const float4 v = *(const float4*)(W + (size_t)(k0 + kk) * ldw + csrc0 + n4);
        const float ws = kgain ? kgain[k0 + kk] : wscale; (void)wscale;
        scr[kk * 33 + n4] = v.x * ws; scr[kk * 33 + n4 + 1] = v.y * ws; scr[kk * 33 + n4 + 2] = v.z * ws; scr[kk * 33 + n4 + 3] = v.w * ws; }
    asm volatile("s_waitcnt lgkmcnt(0)" ::: "memory");
    const int c = lane & 7;
#pragma unroll
    for (int j = 0; j < 4; ++j) { const int n = (lane >> 3) + 8 * j; const LAS float* s = scr + (8 * c) * 33 + n;
        uint4 o; o.x = pk2(s[0 * 33], s[1 * 33]); o.y = pk2(s[2 * 33], s[3 * 33]); o.z = pk2(s[4 * 33], s[5 * 33]); o.w = pk2(s[6 * 33], s[7 * 33]);
        *(uint4*)(WT + (size_t)(row0 + n) * K + k0 + 8 * c) = o; }
    asm volatile("s_waitcnt lgkmcnt(0)" ::: "memory");
}

__device__ __forceinline__ void d_conv_silu(int vb, int tid, const bf16_t* __restrict__ p6, const float* __restrict__ cw, const float* __restrict__ cb, bf16_t* __restrict__ c) {
    const int t = vb, s = t % S;
    for (int ch = tid; ch < 1024; ch += 256) {
        float y = cb[ch];
#pragma unroll
        for (int j = 0; j < 4; ++j) {
            const int ss = s - 3 + j;
            if (ss >= 0) y = fmaf(cw[j * 1024 + ch], bf2f(p6[(size_t)(t - 3 + j) * 1024 + ch]), y);
        }
        c[(size_t)t * 1024 + ch] = (bf16_t)f2bf(y / (1.0f + expf(-y)));
    }
}

__device__ __forceinline__ void d_mlstm(int vb, int tid, const bf16_t* __restrict__ mq, const bf16_t* __restrict__ mk, const bf16_t* __restrict__ p6,
                                        const float* __restrict__ gpre, const float* __restrict__ b_mi, const float* __restrict__ b_mf, float* __restrict__ hraw) {
    const int lane = tid & 63, w = tid >> 6;
    const int gid = vb * 4 + w;
    const int e = gid & 255, h = (gid >> 8) & 3, b = gid >> 10;
    const float bi = b_mi[h], bf = b_mf[h];
    float C0 = 0.f, C1 = 0.f, C2 = 0.f, C3 = 0.f, n0 = 0.f, n1 = 0.f, n2 = 0.f, n3 = 0.f, m = 0.f;
    const size_t tb = (size_t)b * S;
    const bf16_t* qp = mq + tb * 1024 + h * 256 + lane * 4;
    const bf16_t* kp = mk + tb * 1024 + h * 256 + lane * 4;
    const bf16_t* pp = p6 + P6S + tb * 1024 + h * 256 + e;
    ushort4 qn = *(const ushort4*)qp, kn = *(const ushort4*)kp;
    const float* gp = gpre + tb * 8;
    float vn = bf2f(pp[0]), in_ = gp[h], fn = gp[4 + h];
    for (int s = 0; s < S; ++s) {
        const float4 q = make_float4(bf2f(qn.x), bf2f(qn.y), bf2f(qn.z), bf2f(qn.w)), k = make_float4(bf2f(kn.x), bf2f(kn.y), bf2f(kn.z), bf2f(kn.w)); const float v = vn, ipre = in_ + bi, fpre = fn + bf;
        if (s + 1 < S) {
            qn = *(const ushort4*)(qp + (size_t)(s + 1) * 1024);
            kn = *(const ushort4*)(kp + (size_t)(s + 1) * 1024);
            vn = bf2f(pp[(size_t)(s + 1) * 1024]); in_ = gp[(size_t)(s + 1) * 8 + h]; fn = gp[(size_t)(s + 1) * 8 + 4 + h];
        }
        const float logf = log_sigmoid(fpre);
        const float mnew = fmaxf(logf + m, ipre);
        const float fd = expf(logf + m - mnew), ig = expf(ipre - mnew);
        m = mnew;
        const float sc = ig * 0.0625f;
        C0 = fd * C0 + sc * k.x * v; C1 = fd * C1 + sc * k.y * v; C2 = fd * C2 + sc * k.z * v; C3 = fd * C3 + sc * k.w * v;
        n0 = fd * n0 + sc * k.x; n1 = fd * n1 + sc * k.y; n2 = fd * n2 + sc * k.z; n3 = fd * n3 + sc * k.w;
        float num = q.x * C0 + q.y * C1 + q.z * C2 + q.w * C3;
        float den = q.x * n0 + q.y * n1 + q.z * n2 + q.w * n3;
        num = wave_sum(num); den = wave_sum(den);
        if (lane == 0) hraw[(tb + s) * 1024 + h * 256 + e] = num / fmaxf(fabsf(den), expf(-mnew));
    }
}

__device__ __forceinline__ void d_mhead_norm(int vb, int tid, const float* __restrict__ hraw, const bf16_t* __restrict__ p6, const float* __restrict__ g, bf16_t* __restrict__ mix) {
    const int t = vb, h = tid >> 6, lane = tid & 63;
    const float4 v = *(const float4*)(hraw + (size_t)t * 1024 + h * 256 + lane * 4);
    float s = v.x * v.x + v.y * v.y + v.z * v.z + v.w * v.w;
    s = wave_sum(s);
    const float r = rsqrtf(s * (1.0f / 256.0f) + EPS);
    const float4 gg = *(const float4*)(g + h * 256 + lane * 4);
    const ushort4 mo = *(const ushort4*)(p6 + 2 * P6S + (size_t)t * 1024 + h * 256 + lane * 4);
    float4 o;
    o.x = v.x * r * gg.x / (1.0f + expf(-bf2f(mo.x)));
    o.y = v.y * r * gg.y / (1.0f + expf(-bf2f(mo.y)));
    o.z = v.z * r * gg.z / (1.0f + expf(-bf2f(mo.z)));
    o.w = v.w * r * gg.w / (1.0f + expf(-bf2f(mo.w)));
    uint2 ob; ob.x = pk2(o.x, o.y); ob.y = pk2(o.z, o.w);
    *(uint2*)(mix + (size_t)t * D + h * 256 + lane * 4) = ob;
}

__device__ __forceinline__ void d_rope(int vb, int tid, bf16_t* __restrict__ p6) {
    const int t = vb, s = t % S;
    for (int idx = tid; idx < 2 * 8 * 64; idx += 256) {
        const int i = idx & 63, hd = (idx >> 6) & 7, qk = idx >> 9;
        const float inv = exp2f(-(float)i * 0.20762050593046014f);
        const float ang = (float)s * inv;
        float sn, cs; sincosf(ang, &sn, &cs);
        bf16_t* p = p6 + (size_t)(3 + qk) * P6S + (size_t)t * 1024 + hd * 128;
        const float x1 = bf2f(p[i]), x2 = bf2f(p[64 + i]);
        p[i] = (bf16_t)f2bf(x1 * cs - x2 * sn);
        p[64 + i] = (bf16_t)f2bf(x2 * cs + x1 * sn);
    }
}

__device__ __forceinline__ void d_dilated(int vb, int tid, float* sm, const bf16_t* __restrict__ p6, const float* __restrict__ g_ahead, bf16_t* __restrict__ mix) {
    float (*qs)[128] = (float (*)[128])sm;
    float (*ps)[576] = (float (*)[576])(sm + 512);
    const int lane = tid & 63, w = tid >> 6;
    const int gid = vb * 4 + w;
    const int s = gid % S, hd = (gid / S) & 7, b = gid / (S * 8);
    const size_t t = (size_t)b * S + s;
    const bf16_t* qrow = p6 + 3 * P6S + t * 1024 + hd * 128;
    __syncthreads();
    qs[w][lane] = bf2f(qrow[lane]); qs[w][lane + 64] = bf2f(qrow[lane + 64]);
    __syncthreads();
    const float scale = 0.08838834764831845f;
    float mloc = -INFINITY;
    for (int br = 0; br < 3; ++br) {
        const int dil = br == 0 ? 1 : (br == 1 ? 4 : 16);
        for (int jj = 0; jj < 192; jj += 64) {
            const int j = jj + lane;
            float sc = -INFINITY;
            if (j <= 128 && s - j * dil >= 0) {
                const bf16_t* krow = p6 + 4 * P6S + (t - (size_t)j * dil) * 1024 + hd * 128;
                float d = 0.f;
#pragma unroll 8
                for (int c = 0; c < 128; c += 4) {
                    const ushort4 kv = *(const ushort4*)(krow + c);
                    d = fmaf(qs[w][c], bf2f(kv.x), d); d = fmaf(qs[w][c + 1], bf2f(kv.y), d); d = fmaf(qs[w][c + 2], bf2f(kv.z), d); d = fmaf(qs[w][c + 3], bf2f(kv.w), d);
                }
                sc = d * scale;
            }
            ps[w][br * 192 + j] = sc;
            mloc = fmaxf(mloc, sc);
        }
    }
    const float mx = wave_max(mloc);
    __syncthreads();
    float lsum = 0.f;
    for (int i = lane; i < 3 * 192; i += 64) {
        const float sc = ps[w][i];
        const float pv = (sc == -INFINITY) ? 0.f : expf(sc - mx);
        ps[w][i] = pv; lsum += pv;
    }
    const float tot = wave_sum(lsum);
    __syncthreads();
    float o0 = 0.f, o1 = 0.f;
    for (int br = 0; br < 3; ++br) {
        const int dil = br == 0 ? 1 : (br == 1 ? 4 : 16);
        for (int j = 0; j <= 128; ++j) {
            if (s - j * dil < 0) break;
            const float pv = ps[w][br * 192 + j];
            const bf16_t* vrow = p6 + 5 * P6S + (t - (size_t)j * dil) * 1024 + hd * 128;
            o0 = fmaf(pv, bf2f(vrow[lane]), o0); o1 = fmaf(pv, bf2f(vrow[lane + 64]), o1);
        }
    }
    o0 /= tot; o1 /= tot;
    float ss = wave_sum(o0 * o0 + o1 * o1);
    const float r = rsqrtf(ss * (1.0f / 128.0f) + EPS);
    bf16_t* orow = mix + t * D + 1024 + hd * 128;
    orow[lane] = (bf16_t)f2bf(o0 * r * g_ahead[hd * 128 + lane]);
    orow[lane + 64] = (bf16_t)f2bf(o1 * r * g_ahead[hd * 128 + lane + 64]);
}

__device__ __forceinline__ void d_cross(int vb, int tid, float* sm, const bf16_t* __restrict__ q, const float* __restrict__ km, const float* __restrict__ vm, bf16_t* __restrict__ o) {
    float (*qs)[512] = (float (*)[512])sm;
    float (*ps)[256] = (float (*)[256])(sm + 2048);
    const int lane = tid & 63, w = tid >> 6;
    const int t = vb, hd = w, b = t / S;
    const bf16_t* qrow = q + (size_t)t * D + hd * 512;
    __syncthreads();
    for (int i = lane; i < 512; i += 64) qs[w][i] = bf2f(qrow[i]);
    __syncthreads();
    const float scale = 0.04419417382415922f;
    float sc[4]; float mloc = -INFINITY;
#pragma unroll
    for (int r = 0; r < 4; ++r) {
        const int mi = lane + 64 * r;
        const float* krow = km + ((size_t)b * 256 + mi) * D + hd * 512;
        float d = 0.f;
#pragma unroll 8
        for (int c = 0; c < 512; c += 4) {
            const float4 kv = *(const float4*)(krow + c);
            d = fmaf(qs[w][c], kv.x, d); d = fmaf(qs[w][c + 1], kv.y, d); d = fmaf(qs[w][c + 2], kv.z, d); d = fmaf(qs[w][c + 3], kv.w, d);
        }
        sc[r] = d * scale; mloc = fmaxf(mloc, sc[r]);
    }
    const float mx = wave_max(mloc);
    float lsum = 0.f;
#pragma unroll
    for (int r = 0; r < 4; ++r) { const float pv = expf(sc[r] - mx); ps[w][lane + 64 * r] = pv; lsum += pv; }
    const float tot = wave_sum(lsum);
    __syncthreads();
    float acc[8];
#pragma unroll
    for (int i = 0; i < 8; ++i) acc[i] = 0.f;
    for (int mi = 0; mi < 256; ++mi) {
        const float pv = ps[w][mi];
        const float* vrow = vm + ((size_t)b * 256 + mi) * D + hd * 512;
#pragma unroll
        for (int i = 0; i < 8; ++i) acc[i] = fmaf(pv, vrow[lane + 64 * i], acc[i]);
    }
    bf16_t* orow = o + (size_t)t * D + hd * 512;
#pragma unroll
    for (int i = 0; i < 8; ++i) orow[lane + 64 * i] = (bf16_t)f2bf(acc[i] / tot);
}

__device__ __forceinline__ void wave_argmax(float& best, int& bidx) {
#pragma unroll
    for (int o = 32; o >= 1; o >>= 1) {
        const float ob = __shfl_xor(best, o); const int oi = __shfl_xor(bidx, o);
        if (ob > best || (ob == best && oi < bidx)) { best = ob; bidx = oi; }
    }
}
__device__ __forceinline__ void d_peer_topk(int vb, int tid, float* sm, const bf16_t* __restrict__ qp, const float* __restrict__ sub_keys, int* __restrict__ ids, float* __restrict__ gates) {
    float (*qs)[256] = (float (*)[256])sm;
    const int lane = tid & 63, w = tid >> 6;
    const int gid = vb * 4 + w;
    const int hd = gid & 7, t = gid >> 3;
    const bf16_t* qrow = qp + (size_t)t * D + hd * 256;
    __syncthreads();
    for (int i = lane; i < 256; i += 64) qs[w][i] = bf2f(qrow[i]);
    __syncthreads();
    float tops[2]; int topi[2];
#pragma unroll
    for (int p = 0; p < 2; ++p) {
        float v0, v1;
        {
            const float* k0 = sub_keys + ((size_t)(hd * 2 + p) * 128 + lane) * 128;
            const float* k1 = k0 + 64 * 128;
            float d0 = 0.f, d1 = 0.f;
#pragma unroll 8
            for (int c = 0; c < 128; c += 4) {
                const float4 a = *(const float4*)(k0 + c), bb = *(const float4*)(k1 + c);
                const float q0 = qs[w][p * 128 + c], q1 = qs[w][p * 128 + c + 1], q2 = qs[w][p * 128 + c + 2], q3 = qs[w][p * 128 + c + 3];
                d0 = fmaf(q0, a.x, d0); d0 = fmaf(q1, a.y, d0); d0 = fmaf(q2, a.z, d0); d0 = fmaf(q3, a.w, d0);
                d1 = fmaf(q0, bb.x, d1); d1 = fmaf(q1, bb.y, d1); d1 = fmaf(q2, bb.z, d1); d1 = fmaf(q3, bb.w, d1);
            }
            v0 = d0; v1 = d1;
        }
        float ts = 0.f; int ti = 0;
        for (int it = 0; it < 16; ++it) {
            float best; int bidx;
            if (v0 >= v1) { best = v0; bidx = lane; } else { best = v1; bidx = lane + 64; }
            wave_argmax(best, bidx);
            if (lane == it) { ts = best; ti = bidx; }
            if (bidx == lane) v0 = -INFINITY;
            if (bidx == lane + 64) v1 = -INFINITY;
        }
        tops[p] = ts; topi[p] = ti;
    }
    float cv[4]; int ci[4];
#pragma unroll
    for (int r = 0; r < 4; ++r) {
        const int c = lane * 4 + r, i = c >> 4, j = c & 15;
        const float s0 = __shfl(tops[0], i), s1 = __shfl(tops[1], j);
        const int i0 = __shfl(topi[0], i), i1 = __shfl(topi[1], j);
        cv[r] = s0 + s1; ci[r] = i0 * 128 + i1;
    }
    float bs = 0.f; int bid = 0;
    for (int it = 0; it < 16; ++it) {
        float best = cv[0]; int bidx = lane * 4;
#pragma unroll
        for (int r = 1; r < 4; ++r) if (cv[r] > best) { best = cv[r]; bidx = lane * 4 + r; }
        wave_argmax(best, bidx);
        const int owner = bidx >> 2, rr = bidx & 3;
        int myid = ci[0];
        if (rr == 1) myid = ci[1]; else if (rr == 2) myid = ci[2]; else if (rr == 3) myid = ci[3];
        const int eid = __shfl(myid, owner);
        if (lane == it) { bs = best; bid = eid; }
        if (owner == lane) {
#pragma unroll
            for (int r = 0; r < 4; ++r) if (rr == r) cv[r] = -INFINITY;
        }
    }
    float v = lane < 16 ? bs : -INFINITY;
    const float mx = wave_max(v);
    const float ev = lane < 16 ? expf(bs - mx) : 0.f;
    const float tot = wave_sum(ev);
    if (lane < 16) {
        ids[(size_t)t * 128 + hd * 16 + lane] = bid;
        gates[(size_t)t * 128 + hd * 16 + lane] = ev / tot;
    }
}

__device__ __forceinline__ void d_peer_out(int vb, int tid, float* sm, const bf16_t* __restrict__ h3, const float* __restrict__ x2, const int* __restrict__ ids, const float* __restrict__ gates,
                                           const bf16_t* __restrict__ u_tab, const bf16_t* __restrict__ v_tab, const float* __restrict__ g_final, float* __restrict__ out) {
    float (*part)[2048] = (float (*)[2048])sm;
    float* red = sm + 4 * 2048;
    const int lane = tid & 63, w = tid >> 6, t = vb;
    float4 xr[8], acc[8];
    const bf16_t* hrow = h3 + (size_t)t * D;
#pragma unroll
    for (int i = 0; i < 8; ++i) { const ushort4 hv = *(const ushort4*)(hrow + i * 256 + lane * 4);
        xr[i] = make_float4(bf2f(hv.x), bf2f(hv.y), bf2f(hv.z), bf2f(hv.w)); acc[i] = make_float4(0.f, 0.f, 0.f, 0.f); }
    for (int j = 0; j < 32; ++j) {
        const int slot = w * 32 + j;
        const int e = ids[(size_t)t * 128 + slot];
        const float gt = gates[(size_t)t * 128 + slot];
        const bf16_t* ur = u_tab + (size_t)e * D;
        const bf16_t* vr = v_tab + (size_t)e * D;
        float d = 0.f;
#pragma unroll
        for (int i = 0; i < 8; ++i) {
            const ushort4 u = *(const ushort4*)(ur + i * 256 + lane * 4);
            d = fmaf(xr[i].x, bf2f(u.x), d); d = fmaf(xr[i].y, bf2f(u.y), d); d = fmaf(xr[i].z, bf2f(u.z), d); d = fmaf(xr[i].w, bf2f(u.w), d);
        }
        d = wave_sum(d);
        const float act = 0.5f * d * (1.0f + erff(d * 0.7071067811865476f));
        const float cf = gt * act;
#pragma unroll
        for (int i = 0; i < 8; ++i) {
            const ushort4 v = *(const ushort4*)(vr + i * 256 + lane * 4);
            acc[i].x = fmaf(cf, bf2f(v.x), acc[i].x); acc[i].y = fmaf(cf, bf2f(v.y), acc[i].y); acc[i].z = fmaf(cf, bf2f(v.z), acc[i].z); acc[i].w = fmaf(cf, bf2f(v.w), acc[i].w);
        }
    }
    __syncthreads();
#pragma unroll
    for (int i = 0; i < 8; ++i) *(float4*)&part[w][i * 256 + lane * 4] = acc[i];
    __syncthreads();
    float4 r0, r1;
    {
        const float4 a = *(const float4*)&part[0][tid * 4], b = *(const float4*)&part[1][tid * 4], c = *(const float4*)&part[2][tid * 4], d = *(const float4*)&part[3][tid * 4];
        const float4 x = *(const float4*)(x2 + (size_t)t * D + tid * 4);
        r0 = make_float4(x.x + a.x + b.x + c.x + d.x, x.y + a.y + b.y + c.y + d.y, x.z + a.z + b.z + c.z + d.z, x.w + a.w + b.w + c.w + d.w);
    }
    {
        const float4 a = *(const float4*)&part[0][1024 + tid * 4], b = *(const float4*)&part[1][1024 + tid * 4], c = *(const float4*)&part[2][1024 + tid * 4], d = *(const float4*)&part[3][1024 + tid * 4];
        const float4 x = *(const float4*)(x2 + (size_t)t * D + 1024 + tid * 4);
        r1 = make_float4(x.x + a.x + b.x + c.x + d.x, x.y + a.y + b.y + c.y + d.y, x.z + a.z + b.z + c.z + d.z, x.w + a.w + b.w + c.w + d.w);
    }
    float s = r0.x * r0.x + r0.y * r0.y + r0.z * r0.z + r0.w * r0.w + r1.x * r1.x + r1.y * r1.y + r1.z * r1.z + r1.w * r1.w;
    s = wave_sum(s);
    if (lane == 0) red[w] = s;
    __syncthreads();
    const float tot = red[0] + red[1] + red[2] + red[3];
    const float r = rsqrtf(tot * (1.0f / D) + EPS);
    const float4 g0 = *(const float4*)(g_final + tid * 4), g1 = *(const float4*)(g_final + 1024 + tid * 4);
    *(float4*)(out + (size_t)t * D + tid * 4) = make_float4(r0.x * r * g0.x, r0.y * r * g0.y, r0.z * r * g0.z, r0.w * r * g0.w);
    *(float4*)(out + (size_t)t * D + 1024 + tid * 4) = make_float4(r1.x * r * g1.x, r1.y * r * g1.y, r1.z * r * g1.z, r1.w * r * g1.w);
}


__device__ __forceinline__ float wave_incl_scan_add(float v, int lane) {
#pragma unroll
    for (int o = 1; o < 64; o <<= 1) { const float t = __shfl_up(v, o); if (lane >= o) v += t; }
    return v;
}
__device__ __forceinline__ float wave_incl_scan_max(float v, int lane) {
#pragma unroll
    for (int o = 1; o < 64; o <<= 1) { const float t = __shfl_up(v, o); if (lane >= o) v = fmaxf(v, t); }
    return v;
}
__device__ __forceinline__ void mlstm_gates_wave(int b, int h, int lane, const float* __restrict__ gpre, const float* __restrict__ b_mi, const float* __restrict__ b_mf,
                                                 float* __restrict__ gs, float* __restrict__ decay) {
    const float bi = b_mi[h], bf = b_mf[h];
    float mprev = 0.f;
    for (int c = 0; c < 16; ++c) {
        const size_t t0 = (size_t)b * S + c * 256 + lane * 4;
        float logi[4], lf[4], bb[4];
#pragma unroll
        for (int j = 0; j < 4; ++j) { logi[j] = gpre[(t0 + j) * 8 + h] + bi; lf[j] = log_sigmoid(gpre[(t0 + j) * 8 + 4 + h] + bf); }
        bb[0] = lf[0]; bb[1] = bb[0] + lf[1]; bb[2] = bb[1] + lf[2]; bb[3] = bb[2] + lf[3];
        const float incl = wave_incl_scan_add(bb[3], lane);
        const float excl = incl - bb[3];
#pragma unroll
        for (int j = 0; j < 4; ++j) bb[j] += excl;
        const float g = __shfl(incl, 63);
        float amax = -INFINITY, uu[4], cm[4];
#pragma unroll
        for (int j = 0; j < 4; ++j) { amax = fmaxf(amax, logi[j] + g - bb[j]); uu[j] = logi[j] - bb[j]; }
        amax = wave_max(amax);
        const float mnew = fmaxf(g + mprev, amax);
        cm[0] = uu[0]; cm[1] = fmaxf(cm[0], uu[1]); cm[2] = fmaxf(cm[1], uu[2]); cm[3] = fmaxf(cm[2], uu[3]);
        const float cincl = wave_incl_scan_max(cm[3], lane);
        float cexcl = __shfl_up(cincl, 1); if (lane == 0) cexcl = -INFINITY;
#pragma unroll
        for (int j = 0; j < 4; ++j) {
            const float M = fmaxf(mprev, fmaxf(cexcl, cm[j]));
            float* o = gs + ((t0 + j) * 4 + h) * 8;
            o[0] = uu[j] * 1.4426950408889634f; o[1] = M * 1.4426950408889634f; o[2] = expf(logi[j] + g - bb[j] - mnew); o[3] = expf(mprev - M); o[4] = expf(-(bb[j] + M));
        }
        if (lane == 0) decay[(b * 16 + c) * 4 + h] = expf(g + mprev - mnew);
        mprev = mnew;
    }
}
__device__ __forceinline__ void transpose_tile64(int tid, float* sm, const bf16_t* __restrict__ src, int src_ld, bf16_t* __restrict__ dst, int dst_ld, const float* __restrict__ scale, int sstride) {
    unsigned short (*tl)[66] = (unsigned short (*)[66])sm;
    __syncthreads();
#pragma unroll
    for (int i = 0; i < 2; ++i) {
        const int ch = tid + i * 256, r = ch >> 3, c8 = (ch & 7) * 8;
        const uint4 v = *(const uint4*)(src + (size_t)r * src_ld + c8);
        const float sc = scale ? scale[(size_t)r * sstride] : 1.0f;
        const unsigned w[4] = {v.x, v.y, v.z, v.w};
#pragma unroll
        for (int k = 0; k < 4; ++k) {
            tl[r][c8 + 2 * k] = (unsigned short)f2bf(bf2f((unsigned short)(w[k] & 0xFFFFu)) * sc);
            tl[r][c8 + 2 * k + 1] = (unsigned short)f2bf(bf2f((unsigned short)(w[k] >> 16)) * sc);
        }
    }
    __syncthreads();
#pragma unroll
    for (int i = 0; i < 2; ++i) {
        const int ch = tid + i * 256, c = ch >> 3, r8 = (ch & 7) * 8;
        uint4 o;
        o.x = (unsigned)tl[r8 + 0][c] | ((unsigned)tl[r8 + 1][c] << 16); o.y = (unsigned)tl[r8 + 2][c] | ((unsigned)tl[r8 + 3][c] << 16);
        o.z = (unsigned)tl[r8 + 4][c] | ((unsigned)tl[r8 + 5][c] << 16); o.w = (unsigned)tl[r8 + 6][c] | ((unsigned)tl[r8 + 7][c] << 16);
        *(uint4*)(dst + (size_t)c * dst_ld + r8) = o;
    }
}

__device__ __forceinline__ void rope_table_fill(float2* __restrict__ cs, int gtid, int nth) {
    for (int idx = gtid; idx < 4096 * 64; idx += nth) {
        const int i = idx & 63, s = idx >> 6;
        const float inv = exp2f(-(float)i * 0.20762050593046014f);
        const float ang = (float)s * inv;
        float sn, c; sincosf(ang, &sn, &c);
        cs[idx] = make_float2(c, sn);
    }
}
__device__ __forceinline__ void rope_q_pass(bf16_t* __restrict__ aq, const float2* __restrict__ cs, size_t gtid, size_t nth) {
    for (size_t idx = gtid; idx < (size_t)T * 8 * 8; idx += nth) {
        const int c8 = (int)(idx & 7), hd = (int)((idx >> 3) & 7); const size_t t = idx >> 6; const int s = (int)(t & (S - 1));
        bf16_t* p = aq + t * 1024 + hd * 128 + c8 * 8;
        const uint4 a = *(const uint4*)p, b = *(const uint4*)(p + 64);
        const unsigned aw[4] = {a.x, a.y, a.z, a.w}, bw[4] = {b.x, b.y, b.z, b.w};
        unsigned ao[4], bo[4];
#pragma unroll
        for (int k = 0; k < 4; ++k) {
            const float4 cc = *(const float4*)(cs + (size_t)s * 64 + c8 * 8 + 2 * k);
            const float x10 = __uint_as_float(aw[k] << 16), x11 = __uint_as_float(aw[k] & 0xFFFF0000u), x20 = __uint_as_float(bw[k] << 16), x21 = __uint_as_float(bw[k] & 0xFFFF0000u);
            ao[k] = pk2(x10 * cc.x - x20 * cc.y, x11 * cc.z - x21 * cc.w);
            bo[k] = pk2(x20 * cc.x + x10 * cc.y, x21 * cc.z + x11 * cc.w);
        }
        *(uint4*)p = make_uint4(ao[0], ao[1], ao[2], ao[3]); *(uint4*)(p + 64) = make_uint4(bo[0], bo[1], bo[2], bo[3]);
    }
}
__device__ __forceinline__ void dil_tile_prep(int item, int lane, LAS unsigned short* wl, const bf16_t* __restrict__ ak, const bf16_t* __restrict__ av, const float2* __restrict__ cs,
                                              bf16_t* __restrict__ KB, bf16_t* __restrict__ VB) {
    const int TT = item & 255, hd = (item >> 8) & 7, b = (item >> 11) & 1, br = item >> 12;
    const int ld = 2 * br, tpr = 256 >> ld, rho = TT / tpr, tile = TT - rho * tpr;
    const int i = lane & 15, c = lane >> 4;
    const int s = rho + ((16 * tile + i) << ld);
    const size_t trow = (size_t)b * S + s;
    bf16_t* kdst = KB + (size_t)item * 2048;
    bf16_t* vdst = VB + (size_t)item * 2048;
    {
        const bf16_t* kr = ak + trow * 1024 + hd * 128 + 16 * c;
        const uint4 a0 = *(const uint4*)kr, a1 = *(const uint4*)(kr + 8), b0 = *(const uint4*)(kr + 64), b1 = *(const uint4*)(kr + 72);
        const unsigned aw[8] = {a0.x, a0.y, a0.z, a0.w, a1.x, a1.y, a1.z, a1.w}, bw[8] = {b0.x, b0.y, b0.z, b0.w, b1.x, b1.y, b1.z, b1.w};
        unsigned ao[8], bo[8];
#pragma unroll
        for (int k = 0; k < 8; ++k) {
            const float4 cc = *(const float4*)(cs + (size_t)s * 64 + 16 * c + 2 * k);
            const float x10 = __uint_as_float(aw[k] << 16), x11 = __uint_as_float(aw[k] & 0xFFFF0000u), x20 = __uint_as_float(bw[k] << 16), x21 = __uint_as_float(bw[k] & 0xFFFF0000u);
            ao[k] = pk2(x10 * cc.x - x20 * cc.y, x11 * cc.z - x21 * cc.w);
            bo[k] = pk2(x20 * cc.x + x10 * cc.y, x21 * cc.z + x11 * cc.w);
        }
        bf16_t* d0 = kdst + (c >> 1) * 512 + i * 32 + (c & 1) * 16;
        *(uint4*)d0 = make_uint4(ao[0], ao[1], ao[2], ao[3]); *(uint4*)(d0 + 8) = make_uint4(ao[4], ao[5], ao[6], ao[7]);
        bf16_t* d1 = d0 + 1024;
        *(uint4*)d1 = make_uint4(bo[0], bo[1], bo[2], bo[3]); *(uint4*)(d1 + 8) = make_uint4(bo[4], bo[5], bo[6], bo[7]);
    }
    {
        const bf16_t* vr = av + trow * 1024 + hd * 128 + 32 * c;
        const uint4 v0 = *(const uint4*)vr, v1 = *(const uint4*)(vr + 8), v2 = *(const uint4*)(vr + 16), v3 = *(const uint4*)(vr + 24);
        LAS unsigned short* wr = wl + i * 136 + 32 * c;
        typedef unsigned u32x4_t __attribute__((ext_vector_type(4)));
        *(LAS u32x4_t*)wr = (u32x4_t){v0.x, v0.y, v0.z, v0.w}; *(LAS u32x4_t*)(wr + 8) = (u32x4_t){v1.x, v1.y, v1.z, v1.w};
        *(LAS u32x4_t*)(wr + 16) = (u32x4_t){v2.x, v2.y, v2.z, v2.w}; *(LAS u32x4_t*)(wr + 24) = (u32x4_t){v3.x, v3.y, v3.z, v3.w};
        asm volatile("s_waitcnt lgkmcnt(0)" ::: "memory");
        unsigned o[16];
#pragma unroll
        for (int k = 0; k < 8; ++k) {
            const unsigned p0 = *(const LAS unsigned*)(wl + (2 * k) * 136 + 2 * lane), p1 = *(const LAS unsigned*)(wl + (2 * k + 1) * 136 + 2 * lane);
            o[k] = (p0 & 0xFFFFu) | (p1 << 16);
            o[8 + k] = (p0 >> 16) | (p1 & 0xFFFF0000u);
        }
        bf16_t* d = vdst + (2 * lane) * 16;
        *(uint4*)d = make_uint4(o[0], o[1], o[2], o[3]); *(uint4*)(d + 8) = make_uint4(o[4], o[5], o[6], o[7]);
        *(uint4*)(d + 16) = make_uint4(o[8], o[9], o[10], o[11]); *(uint4*)(d + 24) = make_uint4(o[12], o[13], o[14], o[15]);
        asm volatile("s_waitcnt lgkmcnt(0)" ::: "memory");
    }
}

typedef short bf16x8_t __attribute__((ext_vector_type(8)));
typedef short bf16x4_t __attribute__((ext_vector_type(4)));
typedef float f32x4_t __attribute__((ext_vector_type(4)));
__device__ __forceinline__ void dilated_wave_tile(int qt, int lane, const bf16_t* __restrict__ AQ, const bf16_t* __restrict__ KB, const bf16_t* __restrict__ VB,
                                                  const float* __restrict__ g_ahead, bf16_t* __restrict__ mix) {
    const int r = qt & 15, blk = (qt >> 4) & 15, hd = (qt >> 8) & 7, b = qt >> 11;
    const int j = lane & 15, g = lane >> 4;
    const int t0 = blk * 256;
    const int sq = t0 + r + 16 * j;
    bf16x8_t qf[4];
    {
        const bf16_t* qrow = AQ + ((size_t)b * S + sq) * 1024 + hd * 128 + 8 * g;
#pragma unroll
        for (int ks = 0; ks < 4; ++ks) qf[ks] = *(const bf16x8_t*)(qrow + 32 * ks);
    }
    const float sc = 0.08838834764831845f * 1.4426950408889634f;
    float m_run = -1e30f, l_run = 0.f;
    f32x4_t o[8];
#pragma unroll
    for (int dt = 0; dt < 8; ++dt) o[dt] = (f32x4_t){0.f, 0.f, 0.f, 0.f};
#pragma nounroll
    for (int br = 0; br < 3; ++br) {
        const int ld = 2 * br, d = 1 << ld;
        const int rho = r & (d - 1);
        const int qj = (sq - rho) >> ld;
        const int q_lo = ((t0 + r - rho) >> ld) - 128, q_hi = (t0 + r + 240 - rho) >> ld;
        const int tile_lo = q_lo < 0 ? 0 : (q_lo >> 4), tile_hi = q_hi >> 4, tile_max = (256 >> ld) - 1;
        const size_t tbase = ((size_t)((br * 2 + b) * 8 + hd) * 256 + (size_t)rho * (256 >> ld)) * 2048;
        const bf16_t* kbb = KB + tbase + j * 32 + 8 * g;
        const bf16_t* vbb = VB + tbase + j * 16 + 4 * g;
#pragma nounroll
        for (int tp = tile_lo; tp <= tile_hi; tp += 2) {
            f32x4_t su[2];
#pragma unroll
            for (int u = 0; u < 2; ++u) {
                int tl = tp + u; if (tl > tile_max) tl = tile_max;
                const bf16_t* krow = kbb + (size_t)tl * 2048;
                f32x4_t a = (f32x4_t){0.f, 0.f, 0.f, 0.f};
#pragma unroll
                for (int ks = 0; ks < 4; ++ks) a = __builtin_amdgcn_mfma_f32_16x16x32_bf16(*(const bf16x8_t*)(krow + 512 * ks), qf[ks], a, 0, 0, 0);
                su[u] = a;
            }
            float p[2][4]; float mx = -1e30f;
#pragma unroll
            for (int u = 0; u < 2; ++u)
#pragma unroll
                for (int e = 0; e < 4; ++e) {
                    const int n = qj - (16 * (tp + u) + 4 * g + e);
                    const bool valid = (n >= 0) && (n <= 128);
                    p[u][e] = valid ? su[u][e] * sc : -1e30f;
                    mx = fmaxf(mx, p[u][e]);
                }
            mx = fmaxf(mx, __shfl_xor(mx, 16)); mx = fmaxf(mx, __shfl_xor(mx, 32));
            const float m_new = fmaxf(m_run, mx);
            const float alpha = __builtin_amdgcn_exp2f(m_run - m_new);
            m_run = m_new;
            float ps = 0.f;
#pragma unroll
            for (int u = 0; u < 2; ++u)
#pragma unroll
                for (int e = 0; e < 4; ++e) { p[u][e] = (p[u][e] > -1e29f) ? __builtin_amdgcn_exp2f(p[u][e] - m_new) : 0.f; ps += p[u][e]; }
            l_run = l_run * alpha + ps;
            bf16x8_t pb;
            {
                const unsigned w0 = pk2(p[0][0], p[0][1]), w1 = pk2(p[0][2], p[0][3]), w2 = pk2(p[1][0], p[1][1]), w3 = pk2(p[1][2], p[1][3]);
                pb[0] = (short)(w0 & 0xFFFF); pb[1] = (short)(w0 >> 16); pb[2] = (short)(w1 & 0xFFFF); pb[3] = (short)(w1 >> 16);
                pb[4] = (short)(w2 & 0xFFFF); pb[5] = (short)(w2 >> 16); pb[6] = (short)(w3 & 0xFFFF); pb[7] = (short)(w3 >> 16);
            }
            int tl0 = tp, tl1 = tp + 1; if (tl0 > tile_max) tl0 = tile_max; if (tl1 > tile_max) tl1 = tile_max;
#pragma unroll
            for (int dt = 0; dt < 8; ++dt) {
                const bf16_t* vrow = vbb + dt * 256;
                const bf16x4_t v0 = *(const bf16x4_t*)(vrow + (size_t)tl0 * 2048), v1 = *(const bf16x4_t*)(vrow + (size_t)tl1 * 2048);
                bf16x8_t va; va[0] = v0[0]; va[1] = v0[1]; va[2] = v0[2]; va[3] = v0[3]; va[4] = v1[0]; va[5] = v1[1]; va[6] = v1[2]; va[7] = v1[3];
                f32x4_t oo = o[dt]; oo = oo * alpha;
                o[dt] = __builtin_amdgcn_mfma_f32_16x16x32_bf16(va, pb, oo, 0, 0, 0);
            }
        }
    }
    float lt = l_run; lt += __shfl_xor(lt, 16); lt += __shfl_xor(lt, 32);
    const float inv = 1.0f / lt;
    float ss = 0.f;
#pragma unroll
    for (int dt = 0; dt < 8; ++dt) { o[dt] = o[dt] * inv; ss += (o[dt][0] * o[dt][0] + o[dt][1] * o[dt][1]) + (o[dt][2] * o[dt][2] + o[dt][3] * o[dt][3]); }
    ss += __shfl_xor(ss, 16); ss += __shfl_xor(ss, 32);
    const float rn = rsqrtf(ss * (1.0f / 128.0f) + EPS);
    bf16_t* orow = mix + ((size_t)b * S + sq) * D + 1024 + hd * 128 + 4 * g;
#pragma unroll
    for (int dt = 0; dt < 8; ++dt) {
        const f32x4_t gv = *(const f32x4_t*)(g_ahead + hd * 128 + 16 * dt + 4 * g);
        uint2 w; w.x = pk2(o[dt][0] * rn * gv[0], o[dt][1] * rn * gv[1]); w.y = pk2(o[dt][2] * rn * gv[2], o[dt][3] * rn * gv[3]);
        *(uint2*)(orow + 16 * dt) = w;
    }
}

__device__ __forceinline__ unsigned ord_key(float s) { const unsigned u = __float_as_uint(s); return u ^ ((unsigned)((int)u >> 31) | 0x80000000u); }
__device__ __forceinline__ unsigned wave_max_u32(unsigned v) {
    unsigned t;
    t = (unsigned)__builtin_amdgcn_update_dpp(0, (int)v, 0xB1, 0xF, 0xF, true); v = v > t ? v : t;
    t = (unsigned)__builtin_amdgcn_update_dpp(0, (int)v, 0x4E, 0xF, 0xF, true); v = v > t ? v : t;
    t = (unsigned)__builtin_amdgcn_update_dpp(0, (int)v, 0x141, 0xF, 0xF, true); v = v > t ? v : t;
    t = (unsigned)__builtin_amdgcn_update_dpp(0, (int)v, 0x140, 0xF, 0xF, true); v = v > t ? v : t;
    const unsigned a = (unsigned)__builtin_amdgcn_readlane((int)v, 0), b = (unsigned)__builtin_amdgcn_readlane((int)v, 16),
                   c = (unsigned)__builtin_amdgcn_readlane((int)v, 32), d = (unsigned)__builtin_amdgcn_readlane((int)v, 48);
    const unsigned ab = a > b ? a : b, cd = c > d ? c : d;
    return ab > cd ? ab : cd;
}
__device__ __forceinline__ void peer_topk_wave(int item, int lane, LAS float* wl, const bf16_t* __restrict__ qp, const bf16_t* __restrict__ skb, int* __restrict__ ids, float* __restrict__ gates) {
    const int hd = item & 7, tt = item >> 3, j = lane & 15, g = lane >> 4;
    const size_t t0 = (size_t)tt * 16;
    LAS float* sc = wl;
    LAS float* lst = wl + 2048;
#pragma unroll 1
    for (int p = 0; p < 2; ++p) {
        bf16x8_t qf[4];
        const bf16_t* qrow = qp + (t0 + j) * D + hd * 256 + p * 128 + 8 * g;
#pragma unroll
        for (int ks = 0; ks < 4; ++ks) qf[ks] = *(const bf16x8_t*)(qrow + 32 * ks);
        const bf16_t* kb = skb + ((size_t)(hd * 2 + p) * 128 + j) * 128 + 8 * g;
#pragma unroll
        for (int kt = 0; kt < 8; ++kt) {
            f32x4_t a = (f32x4_t){0.f, 0.f, 0.f, 0.f};
#pragma unroll
            for (int ks = 0; ks < 4; ++ks) a = __builtin_amdgcn_mfma_f32_16x16x32_bf16(*(const bf16x8_t*)(kb + (size_t)kt * (16 * 128) + 32 * ks), qf[ks], a, 0, 0, 0);
            *(LAS f32x4_t*)(sc + j * 128 + 16 * kt + 4 * g) = a;
        }
        asm volatile("s_waitcnt lgkmcnt(0)" ::: "memory");
#pragma unroll 1
        for (int tok = 0; tok < 16; ++tok) {
            const float s0 = sc[tok * 128 + lane], s1 = sc[tok * 128 + 64 + lane];
            unsigned k0 = (ord_key(s0) & ~127u) | (unsigned)(127 - lane), k1 = (ord_key(s1) & ~127u) | (unsigned)(63 - lane);
            unsigned sel = 0u;
#pragma unroll 4
            for (int it = 0; it < 16; ++it) {
                unsigned m = k0 > k1 ? k0 : k1;
                m = wave_max_u32(m);
                if (lane == it) sel = m;
                if (k0 == m) k0 = 0u;
                if (k1 == m) k1 = 0u;
            }
            if (lane < 16) {
                const int idx = 127 - (int)(sel & 127u);
                lst[((p * 16 + tok) * 16 + lane) * 2 + 0] = sc[tok * 128 + idx];
                lst[((p * 16 + tok) * 16 + lane) * 2 + 1] = __int_as_float(idx);
            }
        }
        asm volatile("s_waitcnt lgkmcnt(0)" ::: "memory");
    }
#pragma unroll 1
    for (int tok = 0; tok < 16; ++tok) {
        const int i = lane >> 2;
        const float sA = lst[((0 * 16 + tok) * 16 + i) * 2];
        unsigned kk[4];
#pragma unroll
        for (int r = 0; r < 4; ++r) {
            const int jb = (lane & 3) * 4 + r;
            const float sum = sA + lst[((1 * 16 + tok) * 16 + jb) * 2];
            kk[r] = (ord_key(sum) & ~255u) | (unsigned)(255 - (lane * 4 + r));
        }
        unsigned sel = 0u;
#pragma unroll 4
        for (int it = 0; it < 16; ++it) {
            unsigned m = kk[0] > kk[1] ? kk[0] : kk[1]; const unsigned m2 = kk[2] > kk[3] ? kk[2] : kk[3]; m = m > m2 ? m : m2;
            m = wave_max_u32(m);
            if (lane == it) sel = m;
#pragma unroll
            for (int r = 0; r < 4; ++r) if (kk[r] == m) kk[r] = 0u;
        }
        float bs = -INFINITY; int eid = 0;
        if (lane < 16) {
            const int c = 255 - (int)(sel & 255u), ia = c >> 4, ib = c & 15;
            bs = lst[((0 * 16 + tok) * 16 + ia) * 2] + lst[((1 * 16 + tok) * 16 + ib) * 2];
            eid = __float_as_int(lst[((0 * 16 + tok) * 16 + ia) * 2 + 1]) * 128 + __float_as_int(lst[((1 * 16 + tok) * 16 + ib) * 2 + 1]);
        }
        const float mx = wave_max(bs);
        const float ev = lane < 16 ? __expf(bs - mx) : 0.f;
        const float tot = wave_sum(ev);
        if (lane < 16) {
            ids[(t0 + tok) * 128 + hd * 16 + lane] = eid;
            gates[(t0 + tok) * 128 + hd * 16 + lane] = ev / tot;
        }
    }
}

typedef float f32x2_t __attribute__((ext_vector_type(2)));
__device__ __forceinline__ void table_row_to_fp8(const float* __restrict__ srow, unsigned char* __restrict__ drow, float* __restrict__ rscale, int lane, const float* __restrict__ dgain) {
    float4 f[8];
#pragma unroll
    for (int i = 0; i < 8; ++i) f[i] = *(const float4*)(srow + i * 256 + lane * 4);
    if (dgain) {
#pragma unroll
        for (int i = 0; i < 8; ++i) { const float4 gq = *(const float4*)(dgain + i * 256 + lane * 4); f[i].x *= gq.x; f[i].y *= gq.y; f[i].z *= gq.z; f[i].w *= gq.w; }
    }
    float am = 0.f;
#pragma unroll
    for (int i = 0; i < 8; ++i) am = fmaxf(am, fmaxf(fmaxf(fabsf(f[i].x), fabsf(f[i].y)), fmaxf(fabsf(f[i].z), fabsf(f[i].w))));
    am = wave_max(am);
    const float e = floorf(log2f(448.0f / fmaxf(am, 1e-30f)));
    const float s = exp2f(fminf(e, 100.0f));
    unsigned w[8];
#pragma unroll
    for (int i = 0; i < 8; ++i) {
        int t = 0;
        t = __builtin_amdgcn_cvt_pk_fp8_f32(f[i].x * s, f[i].y * s, t, false);
        t = __builtin_amdgcn_cvt_pk_fp8_f32(f[i].z * s, f[i].w * s, t, true);
        w[i] = (unsigned)t;
    }
#pragma unroll
    for (int i = 0; i < 8; ++i) *(unsigned*)(drow + i * 256 + lane * 4) = w[i];
    if (lane == 0) *rscale = 1.0f / s;
}
__device__ __forceinline__ float dot16_fp8(const uint4 q, const float* x) {
    float d = 0.f;
    const unsigned w[4] = {q.x, q.y, q.z, q.w};
#pragma unroll
    for (int k = 0; k < 4; ++k) {
        const f32x2_t lo = __builtin_amdgcn_cvt_pk_f32_fp8((int)w[k], false), hi = __builtin_amdgcn_cvt_pk_f32_fp8((int)w[k], true);
        d = fmaf(lo.x, x[4 * k], d); d = fmaf(lo.y, x[4 * k + 1], d); d = fmaf(hi.x, x[4 * k + 2], d); d = fmaf(hi.y, x[4 * k + 3], d);
    }
    return d;
}
__device__ __forceinline__ void axpy16_fp8(const uint4 q, float c, float* acc) {
    const unsigned w[4] = {q.x, q.y, q.z, q.w};
#pragma unroll
    for (int k = 0; k < 4; ++k) {
        const f32x2_t lo = __builtin_amdgcn_cvt_pk_f32_fp8((int)w[k], false), hi = __builtin_amdgcn_cvt_pk_f32_fp8((int)w[k], true);
        acc[4 * k] = fmaf(c, lo.x, acc[4 * k]); acc[4 * k + 1] = fmaf(c, lo.y, acc[4 * k + 1]); acc[4 * k + 2] = fmaf(c, hi.x, acc[4 * k + 2]); acc[4 * k + 3] = fmaf(c, hi.y, acc[4 * k + 3]);
    }
}
__device__ __forceinline__ void d_peer_out8(int vb, int tid, float* sm, const bf16_t* __restrict__ h3, const float* __restrict__ x2, const int* __restrict__ ids, const float* __restrict__ gates,
                                            const unsigned char* __restrict__ ut8, const unsigned char* __restrict__ vt8, const float* __restrict__ rsc, const float* __restrict__ rstd, const float* __restrict__ g_final, float* __restrict__ out) {
    float (*part)[2048] = (float (*)[2048])sm;
    float* red = sm + 4 * 2048;
    const int lane = tid & 63, w = tid >> 6, t = vb;
    float x[32], acc[32];
    {
        const bf16_t* hrow = h3 + (size_t)t * D + lane * 16;
#pragma unroll
        for (int hh = 0; hh < 2; ++hh) {
            const uint4 a = *(const uint4*)(hrow + hh * 1024), b = *(const uint4*)(hrow + hh * 1024 + 8);
            const unsigned ww[8] = {a.x, a.y, a.z, a.w, b.x, b.y, b.z, b.w};
#pragma unroll
            for (int k = 0; k < 8; ++k) { x[hh * 16 + 2 * k] = __uint_as_float(ww[k] << 16); x[hh * 16 + 2 * k + 1] = __uint_as_float(ww[k] & 0xFFFF0000u); }
        }
#pragma unroll
        for (int i = 0; i < 32; ++i) acc[i] = 0.f;
    }
    const float xrs = rstd[t];
    const int myid = ids[(size_t)t * 128 + w * 32 + (lane & 31)];
    const float mygate = gates[(size_t)t * 128 + w * 32 + (lane & 31)];
#pragma unroll 1
    for (int j = 0; j < 32; j += 4) {
        int e[4]; uint4 uq[4][2], vq[4][2];
#pragma unroll
        for (int q = 0; q < 4; ++q) {
            e[q] = __builtin_amdgcn_readfirstlane(__shfl(myid, j + q));
            const unsigned char* ur = ut8 + (size_t)e[q] * 2048 + lane * 16;
            uq[q][0] = *(const uint4*)ur; uq[q][1] = *(const uint4*)(ur + 1024);
        }
#pragma unroll
        for (int q = 0; q < 4; ++q) {
            const unsigned char* vr = vt8 + (size_t)e[q] * 2048 + lane * 16;
            vq[q][0] = *(const uint4*)vr; vq[q][1] = *(const uint4*)(vr + 1024);
        }
        float d[4];
#pragma unroll
        for (int q = 0; q < 4; ++q) d[q] = dot16_fp8(uq[q][0], x) + dot16_fp8(uq[q][1], x + 16);
#pragma unroll
        for (int o = 32; o >= 1; o >>= 1) {
#pragma unroll
            for (int q = 0; q < 4; ++q) d[q] += __shfl_xor(d[q], o);
        }
#pragma unroll
        for (int q = 0; q < 4; ++q) {
            const float a = d[q] * rsc[e[q]] * xrs;
            const float act = 0.5f * a * (1.0f + erff(a * 0.7071067811865476f));
            const float cf = __shfl(mygate, j + q) * act * rsc[16384 + e[q]];
            axpy16_fp8(vq[q][0], cf, acc); axpy16_fp8(vq[q][1], cf, acc + 16);
        }
    }
    __syncthreads();
#pragma unroll
    for (int hh = 0; hh < 2; ++hh)
#pragma unroll
        for (int k = 0; k < 4; ++k) *(float4*)&part[w][hh * 1024 + lane * 16 + 4 * k] = make_float4(acc[hh * 16 + 4 * k], acc[hh * 16 + 4 * k + 1], acc[hh * 16 + 4 * k + 2], acc[hh * 16 + 4 * k + 3]);
    __syncthreads();
    float4 r0, r1;
    {
        const float4 a = *(const float4*)&part[0][tid * 4], b = *(const float4*)&part[1][tid * 4], c = *(const float4*)&part[2][tid * 4], dd = *(const float4*)&part[3][tid * 4];
        const float4 xx = *(const float4*)(x2 + (size_t)t * D + tid * 4);
        r0 = make_float4(xx.x + a.x + b.x + c.x + dd.x, xx.y + a.y + b.y + c.y + dd.y, xx.z + a.z + b.z + c.z + dd.z, xx.w + a.w + b.w + c.w + dd.w);
    }
    {
        const float4 a = *(const float4*)&part[0][1024 + tid * 4], b = *(const float4*)&part[1][1024 + tid * 4], c = *(const float4*)&part[2][1024 + tid * 4], dd = *(const float4*)&part[3][1024 + tid * 4];
        const float4 xx = *(const float4*)(x2 + (size_t)t * D + 1024 + tid * 4);
        r1 = make_float4(xx.x + a.x + b.x + c.x + dd.x, xx.y + a.y + b.y + c.y + dd.y, xx.z + a.z + b.z + c.z + dd.z, xx.w + a.w + b.w + c.w + dd.w);
    }
    float s = r0.x * r0.x + r0.y * r0.y + r0.z * r0.z + r0.w * r0.w + r1.x * r1.x + r1.y * r1.y + r1.z * r1.z + r1.w * r1.w;
    s = wave_sum(s);
    if (lane == 0) red[w] = s;
    __syncthreads();
    const float tot = red[0] + red[1] + red[2] + red[3];
    const float r = rsqrtf(tot * (1.0f / D) + EPS);
    const float4 g0 = *(const float4*)(g_final + tid * 4), g1 = *(const float4*)(g_final + 1024 + tid * 4);
    *(float4*)(out + (size_t)t * D + tid * 4) = make_float4(r0.x * r * g0.x, r0.y * r * g0.y, r0.z * r * g0.z, r0.w * r * g0.w);
    *(float4*)(out + (size_t)t * D + 1024 + tid * 4) = make_float4(r1.x * r * g1.x, r1.y * r * g1.y, r1.z * r * g1.z, r1.w * r * g1.w);
}

__device__ __forceinline__ unsigned xg_sum_u32(unsigned v) {
    auto a = __builtin_amdgcn_permlane16_swap(v, v, false, false); v = a[0] + a[1];
    auto b = __builtin_amdgcn_permlane32_swap(v, v, false, false); return b[0] + b[1];
}
__device__ __forceinline__ float xg_sum_f32(float v) {
    auto a = __builtin_amdgcn_permlane16_swap(__float_as_uint(v), __float_as_uint(v), false, false); v = __uint_as_float(a[0]) + __uint_as_float(a[1]);
    auto b = __builtin_amdgcn_permlane32_swap(__float_as_uint(v), __float_as_uint(v), false, false); return __uint_as_float(b[0]) + __uint_as_float(b[1]);
}
__device__ __forceinline__ float xg_max_f32(float v) {
    auto a = __builtin_amdgcn_permlane16_swap(__float_as_uint(v), __float_as_uint(v), false, false); v = fmaxf(__uint_as_float(a[0]), __uint_as_float(a[1]));
    auto b = __builtin_amdgcn_permlane32_swap(__float_as_uint(v), __float_as_uint(v), false, false); return fmaxf(__uint_as_float(b[0]), __uint_as_float(b[1]));
}
template <int N> __device__ __forceinline__ unsigned bisect16(const unsigned (&kk)[N]) {
    unsigned tau = 0u; bool done = false;
#pragma unroll 1
    for (int bit = 31; bit >= 0; --bit) {
        const unsigned cand = tau | (1u << bit);
        unsigned c = 0u;
#pragma unroll
        for (int i = 0; i < N; ++i) c += (kk[i] >= cand) ? 1u : 0u;
        c = xg_sum_u32(c);
        if (!done && c >= 16u) { tau = cand; done = (c == 16u); }
        if (__all(done ? 1 : 0)) break;
    }
    return tau;
}
__device__ __forceinline__ void peer_topk_wave2(int item, int lane, LAS float* wl, const bf16_t* __restrict__ qp, const bf16_t* __restrict__ skb, int* __restrict__ ids, float* __restrict__ gates) {
    const int hd = item & 7, tt = item >> 3, j = lane & 15, g = lane >> 4;
    const size_t t0 = (size_t)tt * 16;
#pragma unroll 1
    for (int p = 0; p < 2; ++p) {
        bf16x8_t qf[4];
        const bf16_t* qrow = qp + (t0 + j) * D + hd * 256 + p * 128 + 8 * g;
#pragma unroll
        for (int ks = 0; ks < 4; ++ks) qf[ks] = *(const bf16x8_t*)(qrow + 32 * ks);
        const bf16_t* kb = skb + ((size_t)(hd * 2 + p) * 128 + j) * 128 + 8 * g;
        float sc[32]; unsigned kk[32];
#pragma unroll
        for (int kt = 0; kt < 8; ++kt) {
            f32x4_t a = (f32x4_t){0.f, 0.f, 0.f, 0.f};
#pragma unroll
            for (int ks = 0; ks < 4; ++ks) a = __builtin_amdgcn_mfma_f32_16x16x32_bf16(*(const bf16x8_t*)(kb + (size_t)kt * (16 * 128) + 32 * ks), qf[ks], a, 0, 0, 0);
#pragma unroll
            for (int r = 0; r < 4; ++r) { sc[kt * 4 + r] = a[r]; kk[kt * 4 + r] = (ord_key(a[r]) & ~127u) | (unsigned)(127 - (16 * kt + 4 * g + r)); }
        }
        const unsigned tau = bisect16<32>(kk);
        unsigned cnt = 0u;
#pragma unroll
        for (int i = 0; i < 32; ++i) cnt += (kk[i] >= tau) ? 1u : 0u;
        const unsigned c0 = (unsigned)__shfl((int)cnt, j), c1 = (unsigned)__shfl((int)cnt, j + 16), c2 = (unsigned)__shfl((int)cnt, j + 32);
        unsigned off = (g > 0 ? c0 : 0u) + (g > 1 ? c1 : 0u) + (g > 2 ? c2 : 0u);
        LAS float* ls = wl + p * 256 + j * 16;
        LAS float* li = wl + 512 + p * 256 + j * 16;
#pragma unroll
        for (int i = 0; i < 32; ++i) {
            if (kk[i] >= tau && off < 16u) { ls[off] = sc[i]; li[off] = __int_as_float(16 * (i >> 2) + 4 * g + (i & 3)); ++off; }
        }
    }
    asm volatile("s_waitcnt lgkmcnt(0)" ::: "memory");
    {
        float sA[4], sB[16]; int iA[4];
        {
            const f32x4_t a = *(const LAS f32x4_t*)(wl + j * 16 + 4 * g);
            const f32x4_t ai = *(const LAS f32x4_t*)(wl + 512 + j * 16 + 4 * g);
#pragma unroll
            for (int r = 0; r < 4; ++r) { sA[r] = a[r]; iA[r] = __float_as_int(ai[r]); }
#pragma unroll
            for (int q = 0; q < 4; ++q) { const f32x4_t b = *(const LAS f32x4_t*)(wl + 256 + j * 16 + 4 * q); sB[4 * q] = b[0]; sB[4 * q + 1] = b[1]; sB[4 * q + 2] = b[2]; sB[4 * q + 3] = b[3]; }
        }
        unsigned kk[64];
#pragma unroll
        for (int a = 0; a < 4; ++a)
#pragma unroll
            for (int b = 0; b < 16; ++b) kk[a * 16 + b] = (ord_key(sA[a] + sB[b]) & ~255u) | (unsigned)(255 - ((4 * g + a) * 16 + b));
        const unsigned tau = bisect16<64>(kk);
        float mx = -INFINITY; unsigned cnt = 0u;
#pragma unroll
        for (int i = 0; i < 64; ++i) if (kk[i] >= tau) { mx = fmaxf(mx, sA[i >> 4] + sB[i & 15]); ++cnt; }
        mx = xg_max_f32(mx);
        float es = 0.f;
#pragma unroll
        for (int i = 0; i < 64; ++i) if (kk[i] >= tau) es += __expf(sA[i >> 4] + sB[i & 15] - mx);
        const float inv = 1.0f / xg_sum_f32(es);
        const unsigned c0 = (unsigned)__shfl((int)cnt, j), c1 = (unsigned)__shfl((int)cnt, j + 16), c2 = (unsigned)__shfl((int)cnt, j + 32);
        unsigned off = (g > 0 ? c0 : 0u) + (g > 1 ? c1 : 0u) + (g > 2 ? c2 : 0u);
        int* idp = ids + (t0 + j) * 128 + hd * 16;
        float* gtp = gates + (t0 + j) * 128 + hd * 16;
        const LAS float* liB = wl + 512 + 256 + j * 16;
#pragma unroll
        for (int i = 0; i < 64; ++i) {
            if (kk[i] >= tau && off < 16u) {
                idp[off] = iA[i >> 4] * 128 + __float_as_int(liB[i & 15]);
                gtp[off] = __expf(sA[i >> 4] + sB[i & 15] - mx) * inv;
                ++off;
            }
        }
    }
}

__device__ __forceinline__ float wave_sum_dpp(float v) {
    v += __uint_as_float((unsigned)__builtin_amdgcn_update_dpp(0, (int)__float_as_uint(v), 0xB1, 0xF, 0xF, true));
    v += __uint_as_float((unsigned)__builtin_amdgcn_update_dpp(0, (int)__float_as_uint(v), 0x4E, 0xF, 0xF, true));
    v += __uint_as_float((unsigned)__builtin_amdgcn_update_dpp(0, (int)__float_as_uint(v), 0x141, 0xF, 0xF, true));
    v += __uint_as_float((unsigned)__builtin_amdgcn_update_dpp(0, (int)__float_as_uint(v), 0x140, 0xF, 0xF, true));
    const float a = __uint_as_float((unsigned)__builtin_amdgcn_readlane((int)__float_as_uint(v), 0)), b = __uint_as_float((unsigned)__builtin_amdgcn_readlane((int)__float_as_uint(v), 16)),
                c = __uint_as_float((unsigned)__builtin_amdgcn_readlane((int)__float_as_uint(v), 32)), d = __uint_as_float((unsigned)__builtin_amdgcn_readlane((int)__float_as_uint(v), 48));
    return (a + b) + (c + d);
}
typedef __bf16 bf16x2v_t __attribute__((ext_vector_type(2)));
__device__ __forceinline__ float dot16_fp8_bf16(const uint4 q, const uint4 xa, const uint4 xb, float d) {
    const unsigned w[4] = {q.x, q.y, q.z, q.w};
    const unsigned xw[8] = {xa.x, xa.y, xa.z, xa.w, xb.x, xb.y, xb.z, xb.w};
#pragma unroll
    for (int k = 0; k < 4; ++k) {
        const bf16x2v_t lo = __builtin_amdgcn_cvt_scalef32_pk_bf16_fp8(w[k], 1.0f, false), hi = __builtin_amdgcn_cvt_scalef32_pk_bf16_fp8(w[k], 1.0f, true);
        d = __builtin_amdgcn_fdot2_f32_bf16(lo, __builtin_bit_cast(bf16x2v_t, xw[2 * k]), d, false);
        d = __builtin_amdgcn_fdot2_f32_bf16(hi, __builtin_bit_cast(bf16x2v_t, xw[2 * k + 1]), d, false);
    }
    return d;
}
__device__ __forceinline__ void axpy16_fp8_pk(const uint4 q, const f32x2_t c2, f32x2_t* acc) {
    const unsigned w[4] = {q.x, q.y, q.z, q.w};
#pragma unroll
    for (int k = 0; k < 4; ++k) {
        const f32x2_t lo = __builtin_amdgcn_cvt_pk_f32_fp8((int)w[k], false), hi = __builtin_amdgcn_cvt_pk_f32_fp8((int)w[k], true);
        acc[2 * k] = __builtin_elementwise_fma(c2, lo, acc[2 * k]); acc[2 * k + 1] = __builtin_elementwise_fma(c2, hi, acc[2 * k + 1]);
    }
}
__device__ __forceinline__ float gelu_as(float v) {
    const float av = fabsf(v), t = __builtin_amdgcn_rcpf(av * 0.2316418882f + 1.0f);
    float q = t * 0.5307027145f + (-0.7265760135f); q = q * t + 0.7107068705f; q = q * t + (-0.142248368f); q = q * t + 0.127414796f; q = q * t;
    const float e = __builtin_amdgcn_exp2f((v * v) * (-0.72134752044f));
    const float m = v * (q * e);
    return v < 0.f ? m : v - m;
}
__device__ __forceinline__ void peer_sweep_wave(int gw, int lane, LAS unsigned char* wl, const bf16_t* __restrict__ h3, const float* __restrict__ x2, const int* __restrict__ ids,
                                                const float* __restrict__ gates, const unsigned char* __restrict__ ut8, const unsigned char* __restrict__ vt8, const float* __restrict__ rsc,
                                                const float* __restrict__ rstd, const float* __restrict__ g_final, float* __restrict__ out) {
    typedef unsigned u32x4_t __attribute__((ext_vector_type(4)));
    LAS unsigned short* xs = (LAS unsigned short*)wl;
    LAS unsigned* sorted = (LAS unsigned*)(wl + 16384);
    LAS unsigned* cnt = (LAS unsigned*)(wl + 16384 + 2048);
    LAS unsigned* base = (LAS unsigned*)(wl + 16384 + 2048 + 256);
    const size_t t0 = (size_t)gw * 4;
#pragma unroll
    for (int tok = 0; tok < 4; ++tok)
#pragma unroll
        for (int c = 0; c < 4; ++c) {
            const uint4 v = *(const uint4*)(h3 + (t0 + tok) * D + c * 512 + lane * 8);
            *(LAS u32x4_t*)(xs + tok * 2048 + c * 512 + lane * 8) = (u32x4_t){v.x, v.y, v.z, v.w};
        }
    cnt[lane] = 0u;
    asm volatile("s_waitcnt lgkmcnt(0)" ::: "memory");
    unsigned key[8], rk[8];
#pragma unroll
    for (int r = 0; r < 8; ++r) {
        const int n = r * 64 + lane;
        const unsigned e = (unsigned)ids[t0 * 128 + n];
        key[r] = (e << 9) | (unsigned)n;
        rk[r] = __hip_atomic_fetch_add(&cnt[e >> 8], 1u, __ATOMIC_RELAXED, __HIP_MEMORY_SCOPE_WORKGROUP);
    }
    asm volatile("s_waitcnt lgkmcnt(0)" ::: "memory");
    {
        const unsigned c = cnt[lane];
        unsigned incl = c;
#pragma unroll
        for (int o = 1; o < 64; o <<= 1) { const unsigned t = (unsigned)__shfl_up((int)incl, o); if (lane >= o) incl += t; }
        base[lane] = incl - c;
    }
    asm volatile("s_waitcnt lgkmcnt(0)" ::: "memory");
#pragma unroll
    for (int r = 0; r < 8; ++r) sorted[base[key[r] >> 17] + rk[r]] = key[r];
    asm volatile("s_waitcnt lgkmcnt(0)" ::: "memory");
    float rs4[4];
#pragma unroll
    for (int tok = 0; tok < 4; ++tok) rs4[tok] = rstd[t0 + tok];
#define P1_LOAD(ENT, UQ, I0) _Pragma("unroll") for (int q = 0; q < 8; ++q) { \
            ENT[q] = (unsigned)__builtin_amdgcn_readfirstlane((int)sorted[(I0) + q]); \
            const unsigned char* ur = ut8 + (size_t)(ENT[q] >> 9) * 2048 + lane * 16; \
            UQ[q][0] = *(const uint4*)ur; UQ[q][1] = *(const uint4*)(ur + 1024); }
#define P1_COMP(ENT, UQ, I0) _Pragma("unroll") for (int h4 = 0; h4 < 8; h4 += 4) { float d[4]; \
            _Pragma("unroll") for (int q = 0; q < 4; ++q) { \
                const int tok = (ENT[h4 + q] >> 7) & 3; \
                const LAS unsigned short* xr = xs + tok * 2048 + lane * 16; \
                const u32x4_t a0 = *(const LAS u32x4_t*)xr, a1 = *(const LAS u32x4_t*)(xr + 8), b0 = *(const LAS u32x4_t*)(xr + 1024), b1 = *(const LAS u32x4_t*)(xr + 1032); \
                d[q] = dot16_fp8_bf16(UQ[h4 + q][0], make_uint4(a0[0], a0[1], a0[2], a0[3]), make_uint4(a1[0], a1[1], a1[2], a1[3]), 0.f); \
                d[q] = dot16_fp8_bf16(UQ[h4 + q][1], make_uint4(b0[0], b0[1], b0[2], b0[3]), make_uint4(b1[0], b1[1], b1[2], b1[3]), d[q]); } \
            _Pragma("unroll") for (int q = 0; q < 4; ++q) { \
                const float s = wave_sum_dpp(d[q]); \
                const unsigned e = ENT[h4 + q] >> 9; const int n = ENT[h4 + q] & 511, tok = n >> 7; \
                const float rsv = tok == 0 ? rs4[0] : tok == 1 ? rs4[1] : tok == 2 ? rs4[2] : rs4[3]; \
                const float a = s * rsc[e] * rsv; \
                const float cf = gates[t0 * 128 + n] * gelu_as(a) * rsc[16384 + e]; \
                if (lane == 0) sorted[(I0) + h4 + q] = (e << 18) | ((unsigned)tok << 16) | f2bf(cf); } }
    {
        unsigned entA[8], entB[8]; uint4 uqA[8][2], uqB[8][2];
        P1_LOAD(entA, uqA, 0)
#pragma unroll 1
        for (int i = 0; i < 512; i += 16) {
            P1_LOAD(entB, uqB, i + 8)
            P1_COMP(entA, uqA, i)
            { const int nx = i + 16 < 512 ? i + 16 : 504; P1_LOAD(entA, uqA, nx) }
            P1_COMP(entB, uqB, i + 8)
        }
    }
#undef P1_LOAD
#undef P1_COMP
    asm volatile("s_waitcnt lgkmcnt(0)" ::: "memory");
    f32x2_t acc0[16], acc1[16], acc2[16], acc3[16];
#pragma unroll
    for (int k = 0; k < 16; ++k) { acc0[k] = (f32x2_t){0.f, 0.f}; acc1[k] = (f32x2_t){0.f, 0.f}; acc2[k] = (f32x2_t){0.f, 0.f}; acc3[k] = (f32x2_t){0.f, 0.f}; }
#ifndef P2N
#define P2N 2
#endif
#define P2_LOAD(ENT, VQ, I0) _Pragma("unroll") for (int q = 0; q < P2N; ++q) { \
            ENT[q] = (unsigned)__builtin_amdgcn_readfirstlane((int)sorted[(I0) + q]); \
            const unsigned char* vr = vt8 + (size_t)(ENT[q] >> 18) * 2048 + lane * 16; \
            VQ[q][0] = *(const uint4*)vr; VQ[q][1] = *(const uint4*)(vr + 1024); }
#define P2_COMP(ENT, VQ) _Pragma("unroll") for (int q = 0; q < P2N; ++q) { \
            const int tok = (ENT[q] >> 16) & 3; \
            const float cfs = __uint_as_float(ENT[q] << 16); \
            const f32x2_t c2 = (f32x2_t){cfs, cfs}; \
            if (tok == 0) { axpy16_fp8_pk(VQ[q][0], c2, acc0); axpy16_fp8_pk(VQ[q][1], c2, acc0 + 8); } \
            else if (tok == 1) { axpy16_fp8_pk(VQ[q][0], c2, acc1); axpy16_fp8_pk(VQ[q][1], c2, acc1 + 8); } \
            else if (tok == 2) { axpy16_fp8_pk(VQ[q][0], c2, acc2); axpy16_fp8_pk(VQ[q][1], c2, acc2 + 8); } \
            else { axpy16_fp8_pk(VQ[q][0], c2, acc3); axpy16_fp8_pk(VQ[q][1], c2, acc3 + 8); } }
    {
        unsigned entA[P2N], entB[P2N]; uint4 vqA[P2N][2], vqB[P2N][2];
        P2_LOAD(entA, vqA, 0)
#pragma unroll 1
        for (int i = 0; i < 512; i += 2 * P2N) {
            P2_LOAD(entB, vqB, i + P2N)
            P2_COMP(entA, vqA)
            { const int nx = i + 2 * P2N < 512 ? i + 2 * P2N : 512 - P2N; P2_LOAD(entA, vqA, nx) }
            P2_COMP(entB, vqB)
        }
    }
#undef P2_LOAD
#undef P2_COMP
    int l2 = lane; asm volatile("" : "+v"(l2));
#define PEER_EPI(tok, ACC) { \
        const bf16_t* xr = h3 + (t0 + tok) * D + l2 * 16; \
        float ss = 0.f; \
        _Pragma("unroll") for (int hh = 0; hh < 2; ++hh) _Pragma("unroll") for (int k = 0; k < 4; ++k) { \
            const uint2 xp = *(const uint2*)(xr + hh * 1024 + 4 * k); \
            const float4 xv = make_float4(__uint_as_float(xp.x << 16), __uint_as_float(xp.x & 0xFFFF0000u), __uint_as_float(xp.y << 16), __uint_as_float(xp.y & 0xFFFF0000u)); \
            f32x2_t a0 = ACC[hh * 8 + 2 * k], a1 = ACC[hh * 8 + 2 * k + 1]; \
            a0.x += xv.x; a0.y += xv.y; a1.x += xv.z; a1.y += xv.w; ACC[hh * 8 + 2 * k] = a0; ACC[hh * 8 + 2 * k + 1] = a1; \
            ss += (a0.x * a0.x + a0.y * a0.y) + (a1.x * a1.x + a1.y * a1.y); } \
        ss = wave_sum_dpp(ss); \
        const float r = rsqrtf(ss * (1.0f / D) + EPS); \
        float* orow = out + (t0 + tok) * D + l2 * 16; \
        _Pragma("unroll") for (int hh = 0; hh < 2; ++hh) _Pragma("unroll") for (int k = 0; k < 4; ++k) { \
            const float4 gv = *(const float4*)(g_final + hh * 1024 + l2 * 16 + 4 * k); \
            const f32x2_t a0 = ACC[hh * 8 + 2 * k], a1 = ACC[hh * 8 + 2 * k + 1]; \
            *(float4*)(orow + hh * 1024 + 4 * k) = make_float4(a0.x * r * gv.x, a0.y * r * gv.y, a1.x * r * gv.z, a1.y * r * gv.w); } }
    PEER_EPI(0, acc0) PEER_EPI(1, acc1) PEER_EPI(2, acc2) PEER_EPI(3, acc3)
#undef PEER_EPI
}

struct Params {
    const float *x, *mem, *g_mix, *w_in, *conv_w, *conv_b, *w_mq, *w_mk, *b_mi, *b_mf, *g_mhead, *g_ahead, *w_out, *g_cross, *g_mem,
                *w_xq, *w_xk, *w_xv, *w_xo, *g_ffn, *w_pq, *sub_keys, *u_tab, *v_tab, *g_final;
    float* out;
    unsigned* bar;
    float* ws;
};

#define PHASE_LOOP(nvb) for (int base_ = blockIdx.x * 2; base_ < (nvb); base_ += gridDim.x * 2)
#define VB (base_ + half)

__global__ void __launch_bounds__(NTHR) mega(Params P) {
    volatile LAS unsigned* st = (volatile LAS unsigned*)(LAS unsigned char*)(smem_raw + CTRL_OFF);
    if (threadIdx.x == 0) { st[0] = 0u; st[1] = 0u; st[2] = 0u; st[3] = 0u; }
    if (threadIdx.x < I_NPTR) ((LAS unsigned long long*)(LAS unsigned char*)(smem_raw + CTRL_OFF + 64))[threadIdx.x] = ((const unsigned long long*)&P)[threadIdx.x];
    __syncthreads();
    XcdBarrier xb = xcd_barrier_post((unsigned*)ldp_raw(I_BAR), st);

    constexpr size_t TD = (size_t)T * D;
    constexpr size_t O_HB = 6 * P6S * 2, O_CBUF = O_HB + (size_t)T * D * 2, O_MQ = O_CBUF + (size_t)T * 1024 * 2, O_MK = O_MQ + (size_t)T * 1024 * 2,
                     O_MIXB = O_MK + (size_t)T * 1024 * 2, O_WIN = O_MIXB + (size_t)T * D * 2, O_WOUT = O_WIN + (size_t)6144 * D * 2, O_WXQ = O_WOUT + (size_t)D * D * 2,
                     O_WXK = O_WXQ + (size_t)D * D * 2, O_WXV = O_WXK + (size_t)D * D * 2, O_WXO = O_WXV + (size_t)D * D * 2, O_WPQ = O_WXO + (size_t)D * D * 2,
                     O_WQK = O_WPQ + (size_t)D * D * 2, O_GPRE = O_WQK + (size_t)8 * 256 * 256 * 2, O_UT = O_GPRE + (size_t)T * 8 * 4, O_VT = O_UT + (size_t)16384 * D, O_RSC = O_VT + (size_t)16384 * D,
                     O_BH = O_RSC + (size_t)32768 * 4, O_GS = O_BH + (size_t)128 * 256 * 512 * 2, O_DENP = O_GS + (size_t)T * 4 * 8 * 4, O_QN = O_DENP + (size_t)T * 4 * 4 * 4,
                     O_DN = O_QN + (size_t)T * 4 * 4, O_DECAY = O_DN + (size_t)128 * 256 * 4, O_KB = O_DECAY + 4096, O_VB = O_KB + (size_t)12288 * 2048 * 2, O_CS = O_VB + (size_t)12288 * 2048 * 2, O_SKB = O_CS + (size_t)4096 * 64 * 8, O_RSSP = O_SKB + (size_t)262144 * 2, O_RSTD = O_RSSP + (size_t)T * 32 * 4, O_MN = O_RSTD + (size_t)T * 4, O_KVP = O_MN + (size_t)512 * D * 2, O_END = O_KVP + (size_t)2 * 512 * 4096 * 4;
    static_assert(O_END + 16384 <= (size_t)536870912, "workspace overflow");
#define W_P6    ((bf16_t*)wsb)
#define W_HB    ((bf16_t*)(wsb + O_HB))
#define W_CBUF  ((bf16_t*)(wsb + O_CBUF))
#define W_MQ    ((bf16_t*)(wsb + O_MQ))
#define W_MK    ((bf16_t*)(wsb + O_MK))
#define W_MIXB  ((bf16_t*)(wsb + O_MIXB))
#define W_GPRE  ((float*)(wsb + O_GPRE))
#define W_HRAW  ((float*)(wsb + O_HB))
#define W_XR    ((float*)wsb)
#define W_MN    ((bf16_t*)((float*)wsb + TD))
#define W_KM    ((bf16_t*)((float*)wsb + TD + (size_t)256 * D))
#define W_VMT   ((bf16_t*)((float*)wsb + TD + (size_t)768 * D))
#define W_PX    ((bf16_t*)(wsb + O_MK))
#define W_GATES ((float*)wsb + TD + (size_t)1280 * D)
#define W_IDS   ((int*)((float*)wsb + TD + (size_t)1280 * D + (size_t)T * 128))
#define W_QX    ((bf16_t*)(wsb + O_CBUF))
#define W_BH    ((bf16_t*)(wsb + O_BH))
#define W_KB    ((bf16_t*)(wsb + O_KB))
#define W_VB    ((bf16_t*)(wsb + O_VB))
#define W_CS    ((float2*)(wsb + O_CS))
#define W_SKB   ((bf16_t*)(wsb + O_SKB))
#define W_RSSP  ((float*)(wsb + O_RSSP))
#define W_RSTD  ((float*)(wsb + O_RSTD))
#define W_MN2   ((bf16_t*)(wsb + O_MN))
#define W_KVP   ((float*)(wsb + O_KVP))
#define W_GS    ((float*)(wsb + O_GS))
#define W_DENP  ((float*)(wsb + O_DENP))
#define W_QN    ((float*)(wsb + O_QN))
#define W_DN    ((float*)(wsb + O_DN))
#define W_DECAY ((float*)(wsb + O_DECAY))
#define W_PQ    ((bf16_t*)(wsb + O_HB))
#define W_KWT   ((bf16_t*)(wsb + O_CBUF))
#define W_DC    ((float*)(wsb + 3 * P6S * 2))
#define W_UT    ((unsigned char*)(wsb + O_UT))
#define W_VT    ((unsigned char*)(wsb + O_VT))
#define W_RSC   ((float*)(wsb + O_RSC))
#define PH_BEGIN() int tidx = threadIdx.x; asm volatile("" : "+v"(tidx)); const int half = tidx >> 8, tid = tidx & 255; float* sm = (float*)smem_raw + half * HALF_SM_FLOATS; \
                   char* wsb = (char*)ldp_raw(I_WS); (void)half; (void)tid; (void)sm; (void)wsb
#define GJOB_DEFAULT(g) pg8::GJob g; g.lda = D; g.ldb = D; g.K = D; g.nM = 32; g.nN = 8; g.a_pm_step = 256 * D; g.b_pn_mask = 0x7fffffff; g.b_pn_shift = 30; g.b_pn_step2 = 0; g.bid0 = 0; g.nblk = gridDim.x; g.a_pn_shift = 0; g.a_pn_mask = 0; g.a_pn_step = 0; g.b_pm_shift = 0; g.b_pm_step = 0; g.b_pn_step = 256 * D; \
                        g.ldc = D; g.R = nullptr; g.ldr = D; g.mode = 0; g.escale = 1.0f; g.gs = nullptr; g.denp = nullptr; g.qn = nullptr; g.gvec = nullptr; g.mo = nullptr; g.C2 = nullptr; g.rssp = nullptr; g.rstd = nullptr
#define GEMM_LDSP ((LAS unsigned char*)smem_raw)

    {
        PH_BEGIN();
        {
            LAS float* scr = (LAS float*)(LAS unsigned char*)(smem_raw) + (tidx >> 6) * (64 * 33);
            const int lane = tidx & 63;
            const int gw = blockIdx.x * 8 + (tidx >> 6), NGW = gridDim.x * 8;
            constexpr int I_IN = 32 * 192, I_SQ = 32 * 64, I_QK = 8 * 4 * 8;
            constexpr int NITEMS = I_IN + 6 * I_SQ + I_QK;
#pragma nounroll
            for (int it = gw; it < NITEMS; it += NGW) {
                const float* W; int ldw, K, csrc0, row0, kb; bf16_t* WT; float wscale = 1.0f; const float* kgain = nullptr;
                int r = it;
                if (r < I_IN) { const int nb = r % 192; kb = r / 192; W = PF(I_WIN); ldw = INC; K = D; csrc0 = nb * 32 + (nb >= 96 ? 8 : 0); WT = (bf16_t*)(wsb + O_WIN); row0 = nb * 32; }
                else if ((r -= I_IN) < 6 * I_SQ) {
                    const int wsel = r / I_SQ; r -= wsel * I_SQ; const int nb = r % 64; kb = r / 64; ldw = D; K = D; csrc0 = nb * 32; row0 = nb * 32;
                    W = PF(wsel == 0 ? I_WOUT : wsel == 1 ? I_WXQ : wsel == 2 ? I_WXK : wsel == 3 ? I_WXV : wsel == 4 ? I_WXO : I_WPQ);
                    WT = (bf16_t*)(wsb + O_WOUT + (size_t)wsel * ((size_t)D * D * 2));
                    if (wsel == 1) kgain = PF(I_GCROSS); else if (wsel == 5) kgain = PF(I_GFFN);
                } else {
                    r -= 6 * I_SQ; const int hq = r / 32; r -= hq * 32; const int nb = r % 8; kb = r / 8;
                    W = PF(hq < 4 ? I_WMQ : I_WMK) + (size_t)(hq & 3) * 65536; ldw = 256; K = 256; csrc0 = nb * 32; WT = (bf16_t*)(wsb + O_WQK); row0 = hq * 256 + nb * 32;
                    if (hq >= 4) wscale = 0.0625f;
                }
                p0_transpose_item(W, ldw, K, csrc0, WT, row0, scr, kb, lane, wscale, kgain);
            }
            {
                const float* ut = PF(I_UTAB); const float* vt = PF(I_VTAB); const float* gffn = PF(I_GFFN);
#pragma nounroll
                for (int row = gw; row < 32768; row += NGW) {
                    const bool second = row >= 16384; const int rr = second ? row - 16384 : row;
                    table_row_to_fp8((second ? vt : ut) + (size_t)rr * D, (second ? W_VT : W_UT) + (size_t)rr * D, W_RSC + row, lane, second ? nullptr : gffn);
                }
            }
            rope_table_fill(W_CS, blockIdx.x * NTHR + tidx, gridDim.x * NTHR);
            {
                const float* sk = PF(I_SUBK);
#pragma nounroll
                for (int i = blockIdx.x * NTHR + tidx; i < 262144 / 8; i += gridDim.x * NTHR) {
                    const float4 a = *(const float4*)(sk + (size_t)i * 8), b = *(const float4*)(sk + (size_t)i * 8 + 4);
                    uint4 o; o.x = pk2(a.x, a.y); o.y = pk2(a.z, a.w); o.z = pk2(b.x, b.y); o.w = pk2(b.z, b.w);
                    *(uint4*)(W_SKB + (size_t)i * 8) = o;
                }
            }
            __syncthreads();
        }
        {
            const float* rin = PF(I_X); const float* rg = PF(I_GMIX); const float* win = PF(I_WIN);
            float* gwl = (float*)smem_raw + 1024;
            for (int k = tidx; k < 2048; k += NTHR) { const float4 a = *(const float4*)(win + (size_t)k * INC + C_MI), b = *(const float4*)(win + (size_t)k * INC + C_MI + 4);
                *(float4*)(gwl + k * 8) = a; *(float4*)(gwl + k * 8 + 4) = b; }
            __syncthreads();
            float* red = (float*)smem_raw + half * 256;
#pragma nounroll
            PHASE_LOOP(T) d_rmsnorm(VB, tid, red, rin, rg, W_HB, gwl, W_GPRE);
            const float* min_ = PF(I_MEM); const float* mg = PF(I_GMEM);
#pragma nounroll
            PHASE_LOOP(512) d_rmsnorm(VB, tid, red, min_, mg, W_MN2, nullptr, nullptr);
        }
    }
    xcd_barrier(xb);
    {
        PH_BEGIN();
        GJOB_DEFAULT(g); g.A = W_HB; g.Bt = (bf16_t*)(wsb + O_WIN); g.nN = 24; g.C = (float*)W_P6; g.ldc = 1024;
        pg8::gemm_phase<4>(GEMM_LDSP, g, tidx);
    }
    xcd_barrier(xb);
    {
        PH_BEGIN();
        const float* cw = PF(I_CONVW); const float* cb = PF(I_CONVB);
#pragma nounroll
        PHASE_LOOP(T) d_conv_silu(VB, tid, W_P6, cw, cb, W_CBUF);
        rope_q_pass(W_P6 + 3 * P6S, W_CS, (size_t)blockIdx.x * NTHR + tidx, (size_t)gridDim.x * NTHR);
        {
            LAS unsigned short* wl = (LAS unsigned short*)(LAS unsigned char*)smem_raw + (tidx >> 6) * (16 * 136);
#pragma nounroll
            for (int item = blockIdx.x * 8 + (tidx >> 6); item < 12288; item += gridDim.x * 8) dil_tile_prep(item, tidx & 63, wl, W_P6 + 4 * P6S, W_P6 + 5 * P6S, W_CS, W_KB, W_VB);
            __syncthreads();
        }
        if (blockIdx.x < 8 && tidx < 64) mlstm_gates_wave(blockIdx.x >> 2, blockIdx.x & 3, tidx, W_GPRE, PF(I_BMI), PF(I_BMF), W_GS, W_DECAY);
#pragma nounroll
        PHASE_LOOP(2048) { const int it = VB, lt = it & 3, et = (it >> 2) & 3, h = (it >> 4) & 3, cg = it >> 6;
            transpose_tile64(tid, sm, W_P6 + P6S + (size_t)(cg * 256 + lt * 64) * 1024 + h * 256 + et * 64, 1024, W_BH + ((size_t)(cg * 4 + h) * 256 + et * 64) * 512 + lt * 64, 512, nullptr, 0); }
    }
    xcd_barrier(xb);
    {
        PH_BEGIN();
        {
            GJOB_DEFAULT(g); g.A = W_CBUF; g.lda = 1024; g.a_pm_step = 256 * 1024; g.Bt = (bf16_t*)(wsb + O_WQK); g.ldb = 256; g.b_pn_step = 256 * 256; g.K = 256; g.a_pn_mask = 3; g.a_pn_step = 256; g.C = (float*)W_MQ; g.ldc = 1024;
            pg8::gemm_phase<4>(GEMM_LDSP, g, tidx);
            __syncthreads();
        }
        const float* ga = PF(I_GAHEAD);
#pragma nounroll
        for (int qt = blockIdx.x * 8 + (tidx >> 6); qt < 4096; qt += gridDim.x * 8) dilated_wave_tile(qt, tidx & 63, W_P6 + 3 * P6S, W_KB, W_VB, ga, W_MIXB);
    }
    xcd_barrier(xb);
    {
        PH_BEGIN();
#pragma nounroll
        PHASE_LOOP(2048) { const int it = VB, lt = it & 3, dt = (it >> 2) & 3, h = (it >> 4) & 3, cg = it >> 6;
            transpose_tile64(tid, sm, W_MK + (size_t)(cg * 256 + lt * 64) * 1024 + h * 256 + dt * 64, 1024, W_KWT + ((size_t)(cg * 4 + h) * 256 + dt * 64) * 256 + lt * 64, 256,
                             W_GS + ((size_t)(cg * 256 + lt * 64) * 4 + h) * 8 + 2, 32); }
        {
            const size_t nth = (size_t)gridDim.x * NTHR;
#pragma nounroll
            for (size_t i = (size_t)blockIdx.x * NTHR + tidx; i < (size_t)T * 128; i += nth) {
                const size_t t = i >> 7; const int c8 = (int)(i & 127) * 8, h = c8 >> 8, d = c8 & 255;
                const float sc = W_GS[(t * 4 + h) * 8 + 3];
                const uint4 v = *(const uint4*)(W_MQ + t * 1024 + c8);
                uint4 o;
                o.x = pk2(bf2f((unsigned short)(v.x & 0xFFFFu)) * sc, bf2f((unsigned short)(v.x >> 16)) * sc); o.y = pk2(bf2f((unsigned short)(v.y & 0xFFFFu)) * sc, bf2f((unsigned short)(v.y >> 16)) * sc);
                o.z = pk2(bf2f((unsigned short)(v.z & 0xFFFFu)) * sc, bf2f((unsigned short)(v.z >> 16)) * sc); o.w = pk2(bf2f((unsigned short)(v.w & 0xFFFFu)) * sc, bf2f((unsigned short)(v.w >> 16)) * sc);
                *(uint4*)(W_PQ + t * 2048 + h * 512 + 256 + d) = o;
            }
        }
#pragma nounroll
        PHASE_LOOP(128) { const int cgh = VB, cg = cgh >> 2, h = cgh & 3;
            float a = 0.f;
            for (int l = 0; l < 256; ++l) { const size_t t = (size_t)cg * 256 + l; a = fmaf(W_GS[(t * 4 + h) * 8 + 2], bf2f(W_MK[t * 1024 + h * 256 + tid]), a); }
            W_DN[(size_t)cgh * 256 + tid] = a; }
        __syncthreads();
        {
            GJOB_DEFAULT(g); g.A = W_MQ; g.lda = 1024; g.a_pm_step = 256 * 1024; g.a_pn_mask = 3; g.a_pn_step = 256; g.K = 256; g.nN = 4;
            g.Bt = W_MK; g.ldb = 1024; g.b_pn_step = 256; g.b_pm_step = 256 * 1024; g.C = (float*)W_PQ; g.gs = W_GS; g.denp = W_DENP;
            pg8::gemm_phase<6>(GEMM_LDSP, g, tidx);
        }
    }
    xcd_barrier(xb);
    {
        PH_BEGIN();
        GJOB_DEFAULT(g); g.A = W_BH; g.lda = 512; g.a_pm_step = 4 * 256 * 512; g.a_pn_mask = 3; g.a_pn_step = 256 * 512; g.K = 256; g.nN = 4;
        g.Bt = W_KWT; g.ldb = 256; g.b_pn_step = 65536; g.b_pm_step = 4 * 65536; g.C = W_DC;
        pg8::gemm_phase<7>(GEMM_LDSP, g, tidx);
    }
    xcd_barrier(xb);
    {
        PH_BEGIN();
        {
#pragma nounroll
            for (int gid = blockIdx.x * NTHR + tidx; gid < 131072; gid += gridDim.x * NTHR) {
                const int bh = gid >> 14, b = bh >> 2, h = bh & 3, e = (gid >> 6) & 255, d = (gid & 63) * 4;
                float4 C = make_float4(0.f, 0.f, 0.f, 0.f);
#pragma unroll 4
                for (int c = 0; c < 16; ++c) {
                    const int cgh = (b * 16 + c) * 4 + h;
                    uint2 o; o.x = pk2(C.x, C.y); o.y = pk2(C.z, C.w);
                    *(uint2*)(W_BH + ((size_t)cgh * 256 + e) * 512 + 256 + d) = o;
                    const float dec = W_DECAY[cgh];
                    const float4 dc = *(const float4*)(W_DC + ((size_t)cgh * 256 + e) * 256 + d);
                    C.x = fmaf(dec, C.x, dc.x); C.y = fmaf(dec, C.y, dc.y); C.z = fmaf(dec, C.z, dc.z); C.w = fmaf(dec, C.w, dc.w);
                }
            }
        }
#pragma nounroll
        PHASE_LOOP(128) { const int cgh = VB, cg = cgh >> 2, h = cgh & 3, b = cg >> 4, c = cg & 15;
            float n = 0.f;
            for (int cc = 0; cc < c; ++cc) { const int j = (b * 16 + cc) * 4 + h; n = fmaf(W_DECAY[j], n, W_DN[(size_t)j * 256 + tid]); }
            __syncthreads();
            sm[tid] = n;
            __syncthreads();
            const int lane = tid & 63, w = tid >> 6;
            const float4 nv = *(const float4*)(sm + lane * 4);
            for (int i = 0; i < 64; ++i) {
                const size_t t = (size_t)cg * 256 + w * 64 + i;
                const ushort4 q4 = *(const ushort4*)(W_MQ + t * 1024 + h * 256 + lane * 4);
                float s = bf2f(q4.x) * nv.x + bf2f(q4.y) * nv.y + bf2f(q4.z) * nv.z + bf2f(q4.w) * nv.w;
                s = wave_sum(s);
                if (lane == 0) W_QN[t * 4 + h] = s;
            }
        }
    }
    xcd_barrier(xb);
    {
        PH_BEGIN();
        GJOB_DEFAULT(g); g.A = W_PQ; g.a_pn_mask = 3; g.a_pn_step = 512; g.K = 512; g.nN = 4;
        g.Bt = W_BH; g.ldb = 512; g.b_pn_step = 256 * 512; g.b_pm_step = 4 * 256 * 512; g.C = (float*)W_MIXB;
        g.gs = W_GS; g.denp = W_DENP; g.qn = W_QN; g.gvec = PF(I_GMHEAD); g.mo = W_P6 + 2 * P6S; g.nblk = 128;
        if (blockIdx.x < 128) pg8::gemm_phase<8>(GEMM_LDSP, g, tidx);
        else {
            GJOB_DEFAULT(k); k.A = W_MN2; k.K = 1024; k.nM = 2; k.nN = 32; k.a_pn_shift = 4; k.a_pn_mask = 1; k.a_pn_step = 1024;
            k.Bt = (bf16_t*)(wsb + O_WXK); k.b_pn_mask = 15; k.b_pn_shift = 4; k.b_pn_step2 = 1024; k.C = W_KVP; k.bid0 = 128; k.nblk = 128;
            pg8::gemm_phase<12>(GEMM_LDSP, k, tidx);
        }
    }
    xcd_barrier(xb);
    {
        PH_BEGIN();
        for (int i = blockIdx.x * NTHR + tidx; i < 512 * 4096 / 4; i += gridDim.x * NTHR) {
            const int r = i >> 10, c = (i & 1023) * 4;
            const float4 a = *(const float4*)(W_KVP + (size_t)r * 4096 + c), b = *(const float4*)(W_KVP + (size_t)512 * 4096 + (size_t)r * 4096 + c);
            const float v0 = a.x + b.x, v1 = a.y + b.y, v2 = a.z + b.z, v3 = a.w + b.w;
            if (c < 2048) { uint2 o; o.x = pk2(v0, v1); o.y = pk2(v2, v3); *(uint2*)(W_KM + (size_t)r * 2048 + c) = o; }
            else { bf16_t* d = W_VMT + (size_t)(c - 2048) * 512 + r; d[0] = (bf16_t)f2bf(v0); d[512] = (bf16_t)f2bf(v1); d[1024] = (bf16_t)f2bf(v2); d[1536] = (bf16_t)f2bf(v3); }
        }
        GJOB_DEFAULT(g); g.A = W_MIXB; g.Bt = (bf16_t*)(wsb + O_WOUT); g.R = PF(I_X); g.C2 = W_HB; g.rssp = W_RSSP;
        pg8::gemm_phase<10>(GEMM_LDSP, g, tidx);
    }
    xcd_barrier(xb);
    {
        PH_BEGIN();
        {
            GJOB_DEFAULT(g); g.A = W_HB; g.Bt = (bf16_t*)(wsb + O_WXQ); g.C = (float*)W_QX;
            pg8::Unit u0;
            if (pg8::unit_next(g, 0, u0) && tidx < 256) { const size_t r = (size_t)u0.pm * 256 + tidx; float s = 0.f; for (int k = 0; k < 32; ++k) s += W_RSSP[r * 32 + k];
                ((LAS float*)(LAS unsigned char*)(smem_raw + GEMM_LDS + 1024 + 8192))[tidx] = rsqrtf(s * (1.0f / D) + EPS); }
            __syncthreads();
            pg8::gemm_phase<11>(GEMM_LDSP, g, tidx); __syncthreads();
        }

    }
    xcd_barrier(xb);
    {
        PH_BEGIN();
        GJOB_DEFAULT(g); g.A = W_QX; g.K = 512; g.a_pn_mask = 3; g.a_pn_step = 512; g.Bt = W_KM; g.b_pn_step = 512; g.b_pm_shift = 4; g.b_pm_step = 256 * D; g.nN = 4;
        g.C = (float*)W_PX; g.ldc = 1024; g.escale = 0.04419417382415922f * 1.4426950408889634f;
        pg8::gemm_phase<5>(GEMM_LDSP, g, tidx);
    }
    xcd_barrier(xb);
    {
        PH_BEGIN();
        GJOB_DEFAULT(g); g.A = W_PX; g.lda = 1024; g.a_pm_step = 256 * 1024; g.K = 256; g.a_pn_shift = 1; g.a_pn_mask = 3; g.a_pn_step = 256; g.Bt = W_VMT; g.ldb = 512; g.b_pn_step = 256 * 512; g.b_pm_shift = 4; g.b_pm_step = 256;
        g.C = (float*)W_MIXB;
        pg8::gemm_phase<3>(GEMM_LDSP, g, tidx);
    }
    xcd_barrier(xb);
    {
        PH_BEGIN();
        GJOB_DEFAULT(g); g.A = W_MIXB; g.Bt = (bf16_t*)(wsb + O_WXO); g.R = nullptr; g.C2 = W_HB; g.rssp = W_RSSP;
        pg8::gemm_phase<10>(GEMM_LDSP, g, tidx);
    }
    xcd_barrier(xb);
    {
        PH_BEGIN();
        GJOB_DEFAULT(g); g.A = W_HB; g.Bt = (bf16_t*)(wsb + O_WPQ); g.C = (float*)W_QX;
        pg8::Unit u0;
        if (pg8::unit_next(g, 0, u0) && tidx < 256) { const size_t r = (size_t)u0.pm * 256 + tidx; float s = 0.f; for (int k = 0; k < 32; ++k) s += W_RSSP[r * 32 + k];
            const float rs = rsqrtf(s * (1.0f / D) + EPS);
            ((LAS float*)(LAS unsigned char*)(smem_raw + GEMM_LDS + 1024 + 8192))[tidx] = rs; W_RSTD[r] = rs; }
        __syncthreads();
        pg8::gemm_phase<11>(GEMM_LDSP, g, tidx);
    }
    xcd_barrier(xb);
    {
        PH_BEGIN();
        LAS float* wl = (LAS float*)(LAS unsigned char*)smem_raw + (tidx >> 6) * 1024;
#pragma nounroll
        for (int item = blockIdx.x * 8 + (tidx >> 6); item < 4096; item += gridDim.x * 8) peer_topk_wave2(item, tidx & 63, wl, W_QX, W_SKB, W_IDS, W_GATES);
    }
    xcd_barrier(xb);
    {
        PH_BEGIN();
        const float* gf = PF(I_GFINAL); float* outp = (float*)ldp_raw(I_OUT);
        LAS unsigned char* wl = (LAS unsigned char*)smem_raw + (tidx >> 6) * 18944;
#pragma nounroll
        for (int gw = blockIdx.x * 8 + (tidx >> 6); gw < T / 4; gw += gridDim.x * 8) { int ln = tidx & 63; asm volatile("" : "+v"(ln));
            peer_sweep_wave(gw, ln, wl, W_HB, W_XR, W_IDS, W_GATES, W_UT, W_VT, W_RSC, W_RSTD, gf, outp); }
    }
}
}

extern "C" void kernel_launch(void* const* d_in, const int* in_sizes, int n_in, void* d_out, int out_size, void* d_ws, size_t ws_size, hipStream_t stream) {
    static int grid_blocks = 0;
    if (!grid_blocks) {
        int dev = 0, cus = 0, per_cu = 0;
        hipGetDevice(&dev);
        hipDeviceGetAttribute(&cus, hipDeviceAttributeMultiprocessorCount, dev);
        hipFuncSetAttribute((const void*)mega, hipFuncAttributeMaxDynamicSharedMemorySize, SMEM_BYTES);
        hipOccupancyMaxActiveBlocksPerMultiprocessor(&per_cu, mega, NTHR, SMEM_BYTES);
        if (per_cu > 1) per_cu = 1;
        if (per_cu < 1) per_cu = 1;
        grid_blocks = cus * per_cu;
    }
    Params P{};
    const float** pp = (const float**)&P;
    for (int i = 0; i < 25; ++i) pp[i] = (const float*)d_in[i];
    P.out = (float*)d_out;
    P.bar = (unsigned*)d_ws;
    P.ws = (float*)((char*)d_ws + 16384);
    hipMemsetAsync(d_ws, 0, 16384, stream);
    void* args[] = {&P};
    hipError_t e = hipLaunchCooperativeKernel((const void*)mega, dim3(grid_blocks), dim3(NTHR), args, SMEM_BYTES, stream);
    if (e != hipSuccess) fprintf(stderr, "cooperative launch failed: %s (grid %d)\n", hipGetErrorString(e), grid_blocks);
}
```

```cpp
#include <hip/hip_runtime.h>
#include <stdint.h>
#include <math.h>
#include <cstdio>

#define LAS_ __attribute__((address_space(3)))
namespace {
constexpr int D = 2048, NB = 2, S = 4096, T = NB * S;
constexpr int INC = 6152;
constexpr int C_MIN = 0, C_MV = 1024, C_MO = 2048, C_MI = 3072, C_MF = 3076, C_AQ = 3080, C_AK = 4104, C_AV = 5128;
constexpr float EPS = 1e-6f;
constexpr size_t P6S = (size_t)8192 * 1024;
constexpr int NTHR = 512;
constexpr int HALF_SM_FLOATS = 8704;
constexpr int GEMM_LDS = 131072;
constexpr int SMEM_BYTES = 163840;
constexpr int CTRL_OFF = SMEM_BYTES - 1024;
typedef unsigned short bf16_t;
__device__ __forceinline__ unsigned f2bf(float f) { unsigned u = __float_as_uint(f); u += 0x7FFFu + ((u >> 16) & 1u); return u >> 16; }
__device__ __forceinline__ unsigned pk2(float lo, float hi) { return f2bf(lo) | (f2bf(hi) << 16); }
__device__ __forceinline__ float bf2f(unsigned short b) { return __uint_as_float(((unsigned)b) << 16); }
extern __shared__ __attribute__((aligned(16))) unsigned char smem_raw[];
enum { I_X = 0, I_MEM, I_GMIX, I_WIN, I_CONVW, I_CONVB, I_WMQ, I_WMK, I_BMI, I_BMF, I_GMHEAD, I_GAHEAD, I_WOUT, I_GCROSS, I_GMEM,
       I_WXQ, I_WXK, I_WXV, I_WXO, I_GFFN, I_WPQ, I_SUBK, I_UTAB, I_VTAB, I_GFINAL, I_OUT, I_BAR, I_WS, I_NPTR };
__device__ __forceinline__ unsigned long long ldp_raw(int i) {
    const LAS_ unsigned long long* tab = (const LAS_ unsigned long long*)(LAS_ unsigned char*)(smem_raw + CTRL_OFF + 64);
    const unsigned long long v = tab[i];
    const unsigned lo = __builtin_amdgcn_readfirstlane((unsigned)v), hi = __builtin_amdgcn_readfirstlane((unsigned)(v >> 32));
    return ((unsigned long long)hi << 32) | lo;
}
#define PF(i) ((const float*)ldp_raw(i))

#define XB_TMO      128
#define XB_XCNT(j)  (256  + 64 * (j))
#define XB_XSUB(j)  (1280 + 64 * (j))
#define XB_XGEN(j)  (2304 + 64 * (j))
#define XB_TOP      3328
#define XB_TOPGEN   3392
#define XCD_BAR_WORDS 3456
#define XB_SPIN_CAP (1u << 22)
#define LAS __attribute__((address_space(3)))

__device__ __forceinline__ unsigned xb_ld(unsigned* p)              { return __hip_atomic_load(p, __ATOMIC_RELAXED, __HIP_MEMORY_SCOPE_AGENT); }
__device__ __forceinline__ unsigned xb_add(unsigned* p, unsigned v) { return __hip_atomic_fetch_add(p, v, __ATOMIC_RELAXED, __HIP_MEMORY_SCOPE_AGENT); }
__device__ __forceinline__ unsigned xb_xcc_id() { return (unsigned)__builtin_amdgcn_s_getreg((3 << 11) | 20) & 0xFu; }
#define XB_SPIN(cond, bar) do { unsigned _sp = 0; while (cond) { __builtin_amdgcn_s_sleep(1); \
    if ((++_sp & 255u) == 0u) { if (xb_ld(&(bar)[XB_TMO])) break; if (_sp > XB_SPIN_CAP) { atomicAdd(&(bar)[XB_TMO], 1u); break; } } } } while (0)

struct XcdBarrier { unsigned* bar; unsigned x; volatile LAS unsigned* st; };

__device__ __forceinline__ XcdBarrier xcd_barrier_post(unsigned* bar, volatile LAS unsigned* st) {
    XcdBarrier b; b.bar = bar; b.x = xb_xcc_id(); b.st = st;
    if (threadIdx.x == 0) (void)xb_add(&bar[XB_XCNT(b.x)], 1u);
    return b;
}
__device__ __forceinline__ void xcd_barrier_complete(unsigned* bar, unsigned x, unsigned& nloc, unsigned& nx) {
    const unsigned G = gridDim.x * gridDim.y * gridDim.z;
    unsigned sum, cnt, mine, sp = 0u;
    for (;;) {
        sum = 0u; cnt = 0u; mine = 0u;
#pragma unroll
        for (unsigned j = 0; j < 16; ++j) { const unsigned c = xb_ld(&bar[XB_XCNT(j)]); sum += c; cnt += (c > 0u) ? 1u : 0u; mine = (j == x) ? c : mine; }
        if (sum == G) break;
        __builtin_amdgcn_s_sleep(1);
        if ((++sp & 255u) == 0u) { if (xb_ld(&bar[XB_TMO])) break; if (sp > XB_SPIN_CAP) { atomicAdd(&bar[XB_TMO], 1u); break; } }
    }
    nloc = mine > 0u ? mine : 1u; nx = cnt > 0u ? cnt : 1u;
}
__device__ __forceinline__ void xcd_barrier(const XcdBarrier& b) {
    asm volatile("s_waitcnt vmcnt(0)" ::: "memory");
    __syncthreads();
    if (threadIdx.x == 0) {
        unsigned* bar = b.bar;
        __builtin_amdgcn_s_waitcnt(0);
        unsigned nloc = b.st[0], nx = b.st[1];
        if (nloc == 0u) { xcd_barrier_complete(bar, b.x, nloc, nx); b.st[0] = nloc; b.st[1] = nx; }
        const unsigned old = xb_add(&bar[XB_XSUB(b.x)], 1u);
        const unsigned gen = old / nloc;
        if (old + 1u == (gen + 1u) * nloc) {
            __builtin_amdgcn_fence(__ATOMIC_RELEASE, "agent");
            asm volatile("s_waitcnt vmcnt(0)" ::: "memory");
            const unsigned og = xb_add(&bar[XB_TOP], 1u);
            const unsigned tg = og / nx;
            if (og + 1u == (tg + 1u) * nx) xb_add(&bar[XB_TOPGEN], 1u);
            else XB_SPIN(xb_ld(&bar[XB_TOPGEN]) == tg, bar);
            __builtin_amdgcn_fence(__ATOMIC_ACQUIRE, "agent");
            xb_add(&bar[XB_XGEN(b.x)], 1u);
            asm volatile("s_waitcnt vmcnt(0)" ::: "memory");
        } else {
            XB_SPIN(xb_ld(&bar[XB_XGEN(b.x)]) == gen, bar);
            __builtin_amdgcn_fence(__ATOMIC_ACQUIRE, "agent");
            asm volatile("s_waitcnt vmcnt(0)" ::: "memory");
        }
    }
    __syncthreads();
}

__device__ __forceinline__ float wave_sum(float v) {
#pragma unroll
    for (int o = 32; o >= 1; o >>= 1) v += __shfl_xor(v, o);
    return v;
}
__device__ __forceinline__ float wave_max(float v) {
#pragma unroll
    for (int o = 32; o >= 1; o >>= 1) v = fmaxf(v, __shfl_xor(v, o));
    return v;
}
__device__ __forceinline__ float log_sigmoid(float x) { return fminf(x, 0.f) - log1pf(expf(-fabsf(x))); }


__device__ __forceinline__ void d_rmsnorm(int vb, int t, float* sm, const float* __restrict__ in, const float* __restrict__ g, bf16_t* __restrict__ out,
                                          const float* gwl  , float* __restrict__ gpre) {
    float* red = sm;
    const int row = vb;
    const float4* p = (const float4*)(in + (size_t)row * D);
    float4 a = p[t], b = p[t + 256];
    float s = a.x * a.x + a.y * a.y + a.z * a.z + a.w * a.w + b.x * b.x + b.y * b.y + b.z * b.z + b.w * b.w;
    s = wave_sum(s);
    __syncthreads();
    if ((t & 63) == 0) red[t >> 6] = s;
    __syncthreads();
    const float tot = red[0] + red[1] + red[2] + red[3];
    const float r = rsqrtf(tot * (1.0f / D) + EPS);
    const float4* gp = (const float4*)g;
    float4 ga = gp[t], gb = gp[t + 256];
    float hv[8] = {a.x * r * ga.x, a.y * r * ga.y, a.z * r * ga.z, a.w * r * ga.w, b.x * r * gb.x, b.y * r * gb.y, b.z * r * gb.z, b.w * r * gb.w};
    uint2 o0, o1;
    o0.x = pk2(hv[0], hv[1]); o0.y = pk2(hv[2], hv[3]); o1.x = pk2(hv[4], hv[5]); o1.y = pk2(hv[6], hv[7]);
    *(uint2*)(out + (size_t)row * D + t * 4) = o0;
    *(uint2*)(out + (size_t)row * D + 1024 + t * 4) = o1;
    if (gpre) {
        float gs[8];
#pragma unroll
        for (int c = 0; c < 8; ++c) gs[c] = 0.f;
#pragma unroll
        for (int j = 0; j < 8; ++j) {
            const int k = (j < 4) ? (t * 4 + j) : (1024 + t * 4 + (j - 4));
            const float4 w0 = *(const float4*)(gwl + k * 8), w1 = *(const float4*)(gwl + k * 8 + 4);
            gs[0] = fmaf(hv[j], w0.x, gs[0]); gs[1] = fmaf(hv[j], w0.y, gs[1]); gs[2] = fmaf(hv[j], w0.z, gs[2]); gs[3] = fmaf(hv[j], w0.w, gs[3]);
            gs[4] = fmaf(hv[j], w1.x, gs[4]); gs[5] = fmaf(hv[j], w1.y, gs[5]); gs[6] = fmaf(hv[j], w1.z, gs[6]); gs[7] = fmaf(hv[j], w1.w, gs[7]);
        }
#pragma unroll
        for (int c = 0; c < 8; ++c) gs[c] = wave_sum(gs[c]);
        __syncthreads();
        if ((t & 63) == 0) {
#pragma unroll
            for (int c = 0; c < 8; ++c) red[8 + (t >> 6) * 8 + c] = gs[c];
        }
        __syncthreads();
        if (t < 8) gpre[(size_t)row * 8 + t] = red[8 + t] + red[16 + t] + red[24 + t] + red[32 + t];
    }
}

namespace pg8 {
typedef short bf16x8 __attribute__((ext_vector_type(8)));
typedef float f32x4 __attribute__((ext_vector_type(4)));
constexpr int BM = 256, BK = 64, HALF = 128, HTB = HALF * BK * 2, NXCD = 8, WGM = 8;
__device__ __forceinline__ int lds_byte(int r, int c) { const int st = (r >> 4) * 2 + (c >> 5), rr = r & 15, cc = c & 31, ob = rr * 64 + cc * 2; return st * 1024 + (ob ^ (((ob >> 9) & 1) << 5)); }
__device__ __forceinline__ void stage_rc(int b, int& R, int& C) { const int st = b / 1024, sb = b % 1024, swz = sb ^ (((sb >> 9) & 1) << 5); R = (st >> 1) * 16 + swz / 64; C = (st & 1) * 32 + (swz % 64) / 2; }
struct Unit { int pm, pn; };
struct GJob {
    const bf16_t* A; const bf16_t* Bt;
    int lda, ldb, K, nM, nN;
    int a_pn_shift, a_pn_mask, a_pn_step;
    int b_pm_shift, b_pm_step, b_pn_step;
    int a_pm_step;
    int b_pn_mask, b_pn_shift, b_pn_step2;
    int bid0, nblk;
    float escale;
    const float* gs; float* denp; const float* qn; const float* gvec; const bf16_t* mo;
    bf16_t* C2; float* rssp; const float* rstd;
    float* C; int ldc; const float* R; int ldr;
    int mode;
};
__device__ __forceinline__ bool unit_next(const GJob& g, int i, Unit& u) {
    const int nwg = g.nM * g.nN;
    const int bid = (int)blockIdx.x - g.bid0; if (bid < 0 || bid >= g.nblk) return false;
    const long L = (long)i * g.nblk + bid; if (L >= nwg) return false;
    int wgid = (int)L; { const int q = nwg / NXCD, r = nwg % NXCD, xcd = wgid % NXCD, off = wgid / NXCD; wgid = (xcd < r ? xcd * (q + 1) : r * (q + 1) + (xcd - r) * q) + off; }
    const int nig = WGM * g.nN, gid = wgid / nig, fm = gid * WGM, gsz = (g.nM - fm) < WGM ? (g.nM - fm) : WGM;
    u.pm = fm + ((wgid % nig) % gsz); u.pn = (wgid % nig) / gsz; return true;
}
template <int MODE> __device__ __forceinline__ void epilogue(const GJob& g, f32x4 (&acc)[2][2][4][2], const Unit& u, int wr, int wc, int fr, int fq, LAS unsigned char* xlds) {
    const int row0 = u.pm * BM + wr * 64 + fr;
    if constexpr (MODE == 0) {
        const int col0 = u.pn * BM + wc * 32 + 4 * fq;
#pragma unroll
        for (int ai = 0; ai < 2; ++ai)
#pragma unroll
            for (int m = 0; m < 4; ++m) {
                const int row = row0 + ai * HALF + m * 16;
                float* rowp = g.C + (size_t)row * g.ldc + col0;
                const float* rp = g.R ? g.R + (size_t)row * g.ldr + col0 : nullptr;
#pragma unroll
                for (int bj = 0; bj < 2; ++bj)
#pragma unroll
                    for (int n = 0; n < 2; ++n) {
                        f32x4 v = acc[ai][bj][m][n];
                        if (rp) v = v + *(const f32x4*)(rp + bj * HALF + n * 16);
                        *(f32x4*)(rowp + bj * HALF + n * 16) = v;
                    }
            }
    } else if constexpr (MODE == 10) {
        const int col0 = u.pn * BM + wc * 32 + 4 * fq;
#pragma unroll
        for (int ai = 0; ai < 2; ++ai)
#pragma unroll
            for (int m = 0; m < 4; ++m) {
                const int row = row0 + ai * HALF + m * 16;
                bf16_t* r2 = g.C2 + (size_t)row * D + col0;
                float ss = 0.f;
#pragma unroll
                for (int bj = 0; bj < 2; ++bj)
#pragma unroll
                    for (int n = 0; n < 2; ++n) {
                        f32x4 v = acc[ai][bj][m][n];
                        if (g.R) v = v + *(const f32x4*)(g.R + (size_t)row * g.ldr + col0 + bj * HALF + n * 16);
                        else { const uint2 pr = *(const uint2*)(r2 + bj * HALF + n * 16);
                               v[0] += __uint_as_float(pr.x << 16); v[1] += __uint_as_float(pr.x & 0xFFFF0000u); v[2] += __uint_as_float(pr.y << 16); v[3] += __uint_as_float(pr.y & 0xFFFF0000u); }
                        uint2 o; o.x = pk2(v[0], v[1]); o.y = pk2(v[2], v[3]);
                        *(uint2*)(r2 + bj * HALF + n * 16) = o;
                        ss += (v[0] * v[0] + v[1] * v[1]) + (v[2] * v[2] + v[3] * v[3]);
                    }
                ss += __shfl_xor(ss, 16); ss += __shfl_xor(ss, 32);
                if (fq == 0) g.rssp[(size_t)row * 32 + u.pn * 4 + wc] = ss;
            }
    } else if constexpr (MODE == 11) {
        bf16_t* Cb = (bf16_t*)g.C;
        const int col0 = u.pn * BM + wc * 32 + 4 * fq;
#pragma unroll
        for (int ai = 0; ai < 2; ++ai)
#pragma unroll
            for (int m = 0; m < 4; ++m) {
                const int row = row0 + ai * HALF + m * 16;
                const float rs = ((const LAS float*)(xlds + 8192))[row - u.pm * BM];
                bf16_t* rowp = Cb + (size_t)row * g.ldc + col0;
#pragma unroll
                for (int bj = 0; bj < 2; ++bj)
#pragma unroll
                    for (int n = 0; n < 2; ++n) {
                        const f32x4 v = acc[ai][bj][m][n] * rs;
                        uint2 o; o.x = pk2(v[0], v[1]); o.y = pk2(v[2], v[3]);
                        *(uint2*)(rowp + bj * HALF + n * 16) = o;
                    }
            }
    } else if constexpr (MODE == 6) {
        const int h = u.pn; const size_t t0 = (size_t)u.pm * BM;
        bf16_t* Cb = (bf16_t*)g.C;
#pragma unroll
        for (int ai = 0; ai < 2; ++ai)
#pragma unroll
            for (int m = 0; m < 4; ++m) {
                const int l = ai * HALF + wr * 64 + m * 16 + fr;
                const float M2 = g.gs[((t0 + l) * 4 + h) * 8 + 1];
                bf16_t* rowp = Cb + (t0 + l) * 2048 + h * 512 + wc * 32 + 4 * fq;
                float rs = 0.f;
#pragma unroll
                for (int bj = 0; bj < 2; ++bj)
#pragma unroll
                    for (int n = 0; n < 2; ++n) {
                        const f32x4 a = acc[ai][bj][m][n];
                        const int s0 = bj * HALF + wc * 32 + n * 16 + 4 * fq;
                        float p[4];
#pragma unroll
                        for (int r = 0; r < 4; ++r) { const float u2 = g.gs[((t0 + s0 + r) * 4 + h) * 8 + 0]; p[r] = (s0 + r <= l) ? a[r] * __builtin_amdgcn_exp2f(u2 - M2) : 0.f; rs += p[r]; }
                        uint2 o; o.x = pk2(p[0], p[1]); o.y = pk2(p[2], p[3]);
                        *(uint2*)(rowp + bj * HALF + n * 16) = o;
                    }
                rs += __shfl_xor(rs, 16); rs += __shfl_xor(rs, 32);
                if (fq == 0) g.denp[((t0 + l) * 4 + h) * 4 + wc] = rs;
            }
    } else if constexpr (MODE == 12) {
        float* Ct = g.C + (size_t)(u.pn >> 4) * ((size_t)512 * 4096) + (size_t)(u.pn & 15) * 256;
        const int col0 = wc * 32 + 4 * fq;
#pragma unroll
        for (int ai = 0; ai < 2; ++ai)
#pragma unroll
            for (int m = 0; m < 4; ++m) {
                float* rowp = Ct + (size_t)(row0 + ai * HALF + m * 16) * 4096 + col0;
#pragma unroll
                for (int bj = 0; bj < 2; ++bj)
#pragma unroll
                    for (int n = 0; n < 2; ++n) *(f32x4*)(rowp + bj * HALF + n * 16) = acc[ai][bj][m][n];
            }
    } else if constexpr (MODE == 7) {
        float* Ct = g.C + (size_t)(u.pm * 4 + u.pn) * 65536;
        const int col0 = wc * 32 + 4 * fq;
#pragma unroll
        for (int ai = 0; ai < 2; ++ai)
#pragma unroll
            for (int m = 0; m < 4; ++m) {
                float* rowp = Ct + (size_t)(ai * HALF + wr * 64 + m * 16 + fr) * 256 + col0;
#pragma unroll
                for (int bj = 0; bj < 2; ++bj)
#pragma unroll
                    for (int n = 0; n < 2; ++n) *(f32x4*)(rowp + bj * HALF + n * 16) = acc[ai][bj][m][n];
            }
    } else if constexpr (MODE == 8) {
        const int h = u.pn; const size_t t0 = (size_t)u.pm * BM;
        LAS float* X0 = (LAS float*)xlds + wr * 512;
#pragma unroll
        for (int ai = 0; ai < 2; ++ai)
#pragma unroll
            for (int m = 0; m < 4; ++m) {
                const size_t th = (t0 + ai * HALF + wr * 64 + m * 16 + fr) * 4 + h;
                const f32x4 dp = *(const f32x4*)(g.denp + th * 4);
                const float den = (dp[0] + dp[1]) + (dp[2] + dp[3]) + g.gs[th * 8 + 3] * g.qn[th];
                const float rden = 1.0f / fmaxf(fabsf(den), g.gs[th * 8 + 4]);
                float ss = 0.f;
#pragma unroll
                for (int bj = 0; bj < 2; ++bj)
#pragma unroll
                    for (int n = 0; n < 2; ++n) { f32x4 a = acc[ai][bj][m][n] * rden; acc[ai][bj][m][n] = a; ss += (a[0] * a[0] + a[1] * a[1]) + (a[2] * a[2] + a[3] * a[3]); }
                ss += __shfl_xor(ss, 16); ss += __shfl_xor(ss, 32);
                if (fq == 0) X0[(ai * 64 + m * 16 + fr) * 4 + wc] = ss;
            }
        asm volatile("s_waitcnt lgkmcnt(0)" ::: "memory"); __builtin_amdgcn_s_barrier(); asm volatile("" ::: "memory");
        bf16_t* Cb = (bf16_t*)g.C;
        const int col0 = wc * 32 + 4 * fq;
#pragma unroll
        for (int ai = 0; ai < 2; ++ai)
#pragma unroll
            for (int m = 0; m < 4; ++m) {
                const f32x4 p4 = *(const LAS f32x4*)(X0 + (ai * 64 + m * 16 + fr) * 4);
                const float rsn = rsqrtf(((p4[0] + p4[1]) + (p4[2] + p4[3])) * (1.0f / 256.0f) + EPS);
                const size_t t = t0 + ai * HALF + wr * 64 + m * 16 + fr;
                bf16_t* rowp = Cb + t * 2048 + h * 256 + col0;
                const bf16_t* mop = g.mo + t * 1024 + h * 256 + col0;
#pragma unroll
                for (int bj = 0; bj < 2; ++bj)
#pragma unroll
                    for (int n = 0; n < 2; ++n) {
                        const f32x4 a = acc[ai][bj][m][n];
                        const ushort4 mo4 = *(const ushort4*)(mop + bj * HALF + n * 16);
                        const f32x4 gv = *(const f32x4*)(g.gvec + h * 256 + col0 + bj * HALF + n * 16);
                        const float o0 = a[0] * rsn * gv[0] / (1.0f + __expf(-bf2f(mo4.x)));
                        const float o1 = a[1] * rsn * gv[1] / (1.0f + __expf(-bf2f(mo4.y)));
                        const float o2 = a[2] * rsn * gv[2] / (1.0f + __expf(-bf2f(mo4.z)));
                        const float o3 = a[3] * rsn * gv[3] / (1.0f + __expf(-bf2f(mo4.w)));
                        uint2 o; o.x = pk2(o0, o1); o.y = pk2(o2, o3);
                        *(uint2*)(rowp + bj * HALF + n * 16) = o;
                    }
            }
    } else if constexpr (MODE == 5) {
        LAS float* X0 = (LAS float*)xlds + wr * 512;
        LAS float* X1 = (LAS float*)xlds + 1024 + wr * 512;
#pragma unroll
        for (int ai = 0; ai < 2; ++ai)
#pragma unroll
            for (int m = 0; m < 4; ++m) {
                float v = -INFINITY;
#pragma unroll
                for (int bj = 0; bj < 2; ++bj)
#pragma unroll
                    for (int n = 0; n < 2; ++n) { const f32x4 a = acc[ai][bj][m][n]; v = fmaxf(v, fmaxf(fmaxf(a[0], a[1]), fmaxf(a[2], a[3]))); }
                v = fmaxf(v, __shfl_xor(v, 16)); v = fmaxf(v, __shfl_xor(v, 32));
                if (fq == 0) X0[(ai * 64 + m * 16 + fr) * 4 + wc] = v;
            }
        asm volatile("s_waitcnt lgkmcnt(0)" ::: "memory"); __builtin_amdgcn_s_barrier(); asm volatile("" ::: "memory");
#pragma unroll
        for (int ai = 0; ai < 2; ++ai)
#pragma unroll
            for (int m = 0; m < 4; ++m) {
                const f32x4 p4 = *(const LAS f32x4*)(X0 + (ai * 64 + m * 16 + fr) * 4);
                const float mxr = fmaxf(fmaxf(p4[0], p4[1]), fmaxf(p4[2], p4[3])) * g.escale;
                float s = 0.f;
#pragma unroll
                for (int bj = 0; bj < 2; ++bj)
#pragma unroll
                    for (int n = 0; n < 2; ++n) { f32x4 a = acc[ai][bj][m][n];
                        a[0] = __builtin_amdgcn_exp2f(a[0] * g.escale - mxr); a[1] = __builtin_amdgcn_exp2f(a[1] * g.escale - mxr); a[2] = __builtin_amdgcn_exp2f(a[2] * g.escale - mxr); a[3] = __builtin_amdgcn_exp2f(a[3] * g.escale - mxr);
                        acc[ai][bj][m][n] = a; s += (a[0] + a[1]) + (a[2] + a[3]); }
                s += __shfl_xor(s, 16); s += __shfl_xor(s, 32);
                if (fq == 0) X1[(ai * 64 + m * 16 + fr) * 4 + wc] = s;
            }
        asm volatile("s_waitcnt lgkmcnt(0)" ::: "memory"); __builtin_amdgcn_s_barrier(); asm volatile("" ::: "memory");
        bf16_t* Cb = (bf16_t*)g.C;
        const int col0 = u.pn * BM + wc * 32 + 4 * fq;
#pragma unroll
        for (int ai = 0; ai < 2; ++ai)
#pragma unroll
            for (int m = 0; m < 4; ++m) {
                const f32x4 p4 = *(const LAS f32x4*)(X1 + (ai * 64 + m * 16 + fr) * 4);
                const float inv = 1.0f / ((p4[0] + p4[1]) + (p4[2] + p4[3]));
                bf16_t* rowp = Cb + (size_t)(row0 + ai * HALF + m * 16) * g.ldc + col0;
#pragma unroll
                for (int bj = 0; bj < 2; ++bj)
#pragma unroll
                    for (int n = 0; n < 2; ++n) {
                        const f32x4 a = acc[ai][bj][m][n];
                        uint2 o; o.x = pk2(a[0] * inv, a[1] * inv); o.y = pk2(a[2] * inv, a[3] * inv);
                        *(uint2*)(rowp + bj * HALF + n * 16) = o;
                    }
            }
    } else {
        bf16_t* Cb = (bf16_t*)g.C; int ccol = u.pn * BM;
        if constexpr (MODE == 4) { Cb += (size_t)(u.pn >> 2) * P6S; ccol = (u.pn & 3) * 256; }
        const int col0 = ccol + wc * 32 + 4 * fq;
#pragma unroll
        for (int ai = 0; ai < 2; ++ai)
#pragma unroll
            for (int m = 0; m < 4; ++m) {
                bf16_t* rowp = Cb + (size_t)(row0 + ai * HALF + m * 16) * g.ldc + col0;
#pragma unroll
                for (int bj = 0; bj < 2; ++bj)
#pragma unroll
                    for (int n = 0; n < 2; ++n) {
                        const f32x4 v = acc[ai][bj][m][n];
                        uint2 o; o.x = pk2(v[0], v[1]); o.y = pk2(v[2], v[3]);
                        *(uint2*)(rowp + bj * HALF + n * 16) = o;
                    }
            }
    }
}
template <int MODE> __device__ __forceinline__ void gemm_phase(LAS unsigned char* lds, const GJob& g, int tid) {
    const int wid = __builtin_amdgcn_readfirstlane(tid >> 6), lane = tid & 63, wr = wid >> 2, wc = wid & 3, fr = lane & 15, fq = lane >> 4;
    const int K = g.K, nt = K / BK;
    unsigned voffA[2], voffB[2];
#pragma unroll
    for (int i = 0; i < 2; ++i) { int R, C; stage_rc(tid * 16 + i * 8192, R, C);
        voffA[i] = (unsigned)(R * g.lda + C) * 2u; voffB[i] = (unsigned)(R * g.ldb + C) * 2u; }
    const size_t kstep = (size_t)(BK * 2);
    const size_t hstepA = (size_t)HALF * g.lda * 2, hstepB = (size_t)HALF * g.ldb * 2;
    const unsigned ldsw = (unsigned)wid * 1024u;
    const int aoff = lds_byte(wr * 64 + fr, fq * 8), boff = lds_byte(wc * 32 + fr, fq * 8);
#define PG8_SA(b, h) (((b) * 2 + (h)) * HTB)
#define PG8_SB(b, h) ((4 + (b) * 2 + (h)) * HTB)
#define PG8_STAGE(bufoff, gbase, voff) do { _Pragma("unroll") for (int _i = 0; _i < 2; ++_i) \
        __builtin_amdgcn_global_load_lds((const unsigned*)((const char*)(gbase) + (voff)[_i]), (LAS unsigned*)(lds + (bufoff) + ldsw + _i * 8192), 16, 0, 0); } while (0)
#define PG8_LDA(dst, b, h) do { _Pragma("unroll") for (int m = 0; m < 4; ++m) _Pragma("unroll") for (int k = 0; k < 2; ++k) dst[m][k] = *(const LAS bf16x8*)(lds + PG8_SA(b, h) + aoff + m * 2048 + k * 1024); } while (0)
#define PG8_LDB(dst, b, h) do { _Pragma("unroll") for (int n = 0; n < 2; ++n) _Pragma("unroll") for (int k = 0; k < 2; ++k) dst[n][k] = *(const LAS bf16x8*)(lds + PG8_SB(b, h) + boff + n * 2048 + k * 1024); } while (0)
#define PG8_MMA(ai, bj, At, Bt) do { __builtin_amdgcn_s_setprio(1); _Pragma("unroll") for (int m = 0; m < 4; ++m) _Pragma("unroll") for (int n = 0; n < 2; ++n) _Pragma("unroll") for (int k = 0; k < 2; ++k) \
        acc[ai][bj][m][n] = __builtin_amdgcn_mfma_f32_16x16x32_bf16(Bt[n][k], At[m][k], acc[ai][bj][m][n], 0, 0, 0); __builtin_amdgcn_s_setprio(0); } while (0)
#define PG8_WAIT_V(n) asm volatile("s_waitcnt vmcnt(" #n ")" ::: "memory")
#define PG8_WAIT_L(n) asm volatile("s_waitcnt lgkmcnt(" #n ")" ::: "memory")
#define PG8_BAR __builtin_amdgcn_s_barrier()
#define PG8_SCHED __builtin_amdgcn_sched_barrier(0)
#define PG8_ABASE(u) ((const char*)g.A + ((size_t)(u).pm * g.a_pm_step + (size_t)(((u).pn >> g.a_pn_shift) & g.a_pn_mask) * g.a_pn_step) * 2)
#define PG8_BBASE(u) ((const char*)g.Bt + ((size_t)((u).pn & g.b_pn_mask) * g.b_pn_step + (size_t)((u).pn >> g.b_pn_shift) * g.b_pn_step2 + (size_t)((u).pm >> g.b_pm_shift) * g.b_pm_step) * 2)
    Unit cur, nxt; int ui = 0;
    if (!unit_next(g, 0, cur)) return;
    f32x4 acc[2][2][4][2];
#pragma unroll
    for (int a = 0; a < 2; ++a)
#pragma unroll
        for (int b = 0; b < 2; ++b)
#pragma unroll
            for (int m = 0; m < 4; ++m)
#pragma unroll
                for (int n = 0; n < 2; ++n) acc[a][b][m][n] = (f32x4){0.f, 0.f, 0.f, 0.f};
    bf16x8 At[4][2], B0[2][2], B1[2][2];
    const char* cA = PG8_ABASE(cur); const char* cB = PG8_BBASE(cur);
    PG8_STAGE(PG8_SB(0, 0), cB, voffB); PG8_STAGE(PG8_SA(0, 0), cA, voffA); PG8_STAGE(PG8_SB(0, 1), cB + hstepB, voffB); PG8_STAGE(PG8_SA(0, 1), cA + hstepA, voffA);
    if (wr == 1) PG8_BAR;
    PG8_WAIT_V(4); PG8_BAR;
    PG8_STAGE(PG8_SB(1, 0), cB + kstep, voffB); PG8_STAGE(PG8_SA(1, 0), cA + kstep, voffA); PG8_STAGE(PG8_SB(1, 1), cB + hstepB + kstep, voffB);
    PG8_WAIT_V(6); PG8_BAR;
    for (;;) {
        const bool has_next = unit_next(g, ui + 1, nxt);
        const char* nA = has_next ? PG8_ABASE(nxt) : cA; const char* nB = has_next ? PG8_BBASE(nxt) : cB;
        for (int t = 0; t < nt; t += 2) {
            const bool last = (t == nt - 2);
            const char* a1 = cA + (size_t)(t + 1) * kstep;
            const char* a2 = last ? nA : cA + (size_t)(t + 2) * kstep; const char* b2 = last ? nB : cB + (size_t)(t + 2) * kstep;
            const char* a3 = a2 + kstep; const char* b3 = b2 + kstep;
            PG8_LDB(B0, 0, 0); PG8_SCHED; PG8_LDA(At, 0, 0); PG8_STAGE(PG8_SA(1, 1), a1 + hstepA, voffA);
            PG8_WAIT_L(8); PG8_BAR; PG8_WAIT_L(0); PG8_MMA(0, 0, At, B0); PG8_BAR; PG8_SCHED;
            PG8_LDB(B1, 0, 1); PG8_STAGE(PG8_SB(0, 0), b2, voffB);
            PG8_BAR; PG8_WAIT_L(0); PG8_MMA(0, 1, At, B1); PG8_BAR;
            PG8_LDA(At, 0, 1); PG8_STAGE(PG8_SA(0, 0), a2, voffA);
            PG8_BAR; PG8_WAIT_L(0); PG8_MMA(1, 0, At, B0); PG8_BAR; PG8_SCHED;
            PG8_STAGE(PG8_SB(0, 1), b2 + hstepB, voffB);
            PG8_WAIT_V(6); PG8_BAR; PG8_MMA(1, 1, At, B1); PG8_BAR;
            PG8_LDB(B0, 1, 0); PG8_SCHED; PG8_LDA(At, 1, 0); PG8_STAGE(PG8_SA(0, 1), a2 + hstepA, voffA);
            PG8_WAIT_L(8); PG8_BAR; PG8_WAIT_L(0); PG8_MMA(0, 0, At, B0); PG8_BAR; PG8_SCHED;
            PG8_LDB(B1, 1, 1); PG8_STAGE(PG8_SB(1, 0), b3, voffB);
            PG8_BAR; PG8_WAIT_L(0); PG8_MMA(0, 1, At, B1); PG8_BAR;
            PG8_LDA(At, 1, 1); PG8_STAGE(PG8_SA(1, 0), a3, voffA);
            PG8_BAR; PG8_WAIT_L(0); PG8_MMA(1, 0, At, B0); PG8_BAR; PG8_SCHED;
            PG8_STAGE(PG8_SB(1, 1), b3 + hstepB, voffB);
            PG8_WAIT_V(6); PG8_BAR; PG8_MMA(1, 1, At, B1); PG8_BAR;
        }
        epilogue<MODE>(g, acc, cur, wr, wc, fr, fq, lds + GEMM_LDS + 1024);
        if (!has_next) break;
#pragma unroll
        for (int a = 0; a < 2; ++a)
#pragma unroll
            for (int b = 0; b < 2; ++b)
#pragma unroll
                for (int m = 0; m < 4; ++m)
#pragma unroll
                    for (int n = 0; n < 2; ++n) acc[a][b][m][n] = (f32x4){0.f, 0.f, 0.f, 0.f};
        cur = nxt; cA = nA; cB = nB; ++ui;
    }
    PG8_WAIT_V(0);
    if (wr == 0) PG8_BAR;
    PG8_BAR;
#undef PG8_SA
#undef PG8_SB
#undef PG8_STAGE
#undef PG8_LDA
#undef PG8_LDB
#undef PG8_MMA
#undef PG8_WAIT_V
#undef PG8_WAIT_L
#undef PG8_BAR
#undef PG8_SCHED
#undef PG8_ABASE
#undef PG8_BBASE
}
}

__device__ __forceinline__ void p0_transpose_item(const float* W, int ldw, int K, int csrc0, bf16_t* WT, int row0, LAS float* scr, int kb, int lane, float wscale, const float* kgain) {
    const int k0 = 64 * kb;
#pragma unroll
    for (int i = 0; i < 8; ++i) { const int kk = 8 * i + (lane >> 3), n4 = (lane & 7) * 4;
        const float4 v = *(const float4*)(W + (size_t)(k0 + kk) * ldw + csrc0 + n4);
        const float ws = kgain ? kgain[k0 + kk] : wscale; (void)wscale;
        scr[kk * 33 + n4] = v.x * ws; scr[kk * 33 + n4 + 1] = v.y * ws; scr[kk * 33 + n4 + 2] = v.z * ws; scr[kk * 33 + n4 + 3] = v.w * ws; }
    asm volatile("s_waitcnt lgkmcnt(0)" ::: "memory");
    const int c = lane & 7;
#pragma unroll
    for (int j = 0; j < 4; ++j) { const int n = (lane >> 3) + 8 * j; const LAS float* s = scr + (8 * c) * 33 + n;
        uint4 o; o.x = pk2(s[0 * 33], s[1 * 33]); o.y = pk2(s[2 * 33], s[3 * 33]); o.z = pk2(s[4 * 33], s[5 * 33]); o.w = pk2(s[6 * 33], s[7 * 33]);
        *(uint4*)(WT + (size_t)(row0 + n) * K + k0 + 8 * c) = o; }
    asm volatile("s_waitcnt lgkmcnt(0)" ::: "memory");
}

__device__ __forceinline__ void d_conv_silu(int vb, int tid, const bf16_t* __restrict__ p6, const float* __restrict__ cw, const float* __restrict__ cb, bf16_t* __restrict__ c) {
    const int t = vb, s = t % S;
    for (int ch = tid; ch < 1024; ch += 256) {
        float y = cb[ch];
#pragma unroll
        for (int j = 0; j < 4; ++j) {
            const int ss = s - 3 + j;
            if (ss >= 0) y = fmaf(cw[j * 1024 + ch], bf2f(p6[(size_t)(t - 3 + j) * 1024 + ch]), y);
        }
        c[(size_t)t * 1024 + ch] = (bf16_t)f2bf(y / (1.0f + expf(-y)));
    }
}

__device__ __forceinline__ void d_mlstm(int vb, int tid, const bf16_t* __restrict__ mq, const bf16_t* __restrict__ mk, const bf16_t* __restrict__ p6,
                                        const float* __restrict__ gpre, const float* __restrict__ b_mi, const float* __restrict__ b_mf, float* __restrict__ hraw) {
    const int lane = tid & 63, w = tid >> 6;
    const int gid = vb * 4 + w;
    const int e = gid & 255, h = (gid >> 8) & 3, b = gid >> 10;
    const float bi = b_mi[h], bf = b_mf[h];
    float C0 = 0.f, C1 = 0.f, C2 = 0.f, C3 = 0.f, n0 = 0.f, n1 = 0.f, n2 = 0.f, n3 = 0.f, m = 0.f;
    const size_t tb = (size_t)b * S;
    const bf16_t* qp = mq + tb * 1024 + h * 256 + lane * 4;
    const bf16_t* kp = mk + tb * 1024 + h * 256 + lane * 4;
    const bf16_t* pp = p6 + P6S + tb * 1024 + h * 256 + e;
    ushort4 qn = *(const ushort4*)qp, kn = *(const ushort4*)kp;
    const float* gp = gpre + tb * 8;
    float vn = bf2f(pp[0]), in_ = gp[h], fn = gp[4 + h];
    for (int s = 0; s < S; ++s) {
        const float4 q = make_float4(bf2f(qn.x), bf2f(qn.y), bf2f(qn.z), bf2f(qn.w)), k = make_float4(bf2f(kn.x), bf2f(kn.y), bf2f(kn.z), bf2f(kn.w)); const float v = vn, ipre = in_ + bi, fpre = fn + bf;
        if (s + 1 < S) {
            qn = *(const ushort4*)(qp + (size_t)(s + 1) * 1024);
            kn = *(const ushort4*)(kp + (size_t)(s + 1) * 1024);
            vn = bf2f(pp[(size_t)(s + 1) * 1024]); in_ = gp[(size_t)(s + 1) * 8 + h]; fn = gp[(size_t)(s + 1) * 8 + 4 + h];
        }
        const float logf = log_sigmoid(fpre);
        const float mnew = fmaxf(logf + m, ipre);
        const float fd = expf(logf + m - mnew), ig = expf(ipre - mnew);
        m = mnew;
        const float sc = ig * 0.0625f;
        C0 = fd * C0 + sc * k.x * v; C1 = fd * C1 + sc * k.y * v; C2 = fd * C2 + sc * k.z * v; C3 = fd * C3 + sc * k.w * v;
        n0 = fd * n0 + sc * k.x; n1 = fd * n1 + sc * k.y; n2 = fd * n2 + sc * k.z; n3 = fd * n3 + sc * k.w;
        float num = q.x * C0 + q.y * C1 + q.z * C2 + q.w * C3;
        float den = q.x * n0 + q.y * n1 + q.z * n2 + q.w * n3;
        num = wave_sum(num); den = wave_sum(den);
        if (lane == 0) hraw[(tb + s) * 1024 + h * 256 + e] = num / fmaxf(fabsf(den), expf(-mnew));
    }
}

__device__ __forceinline__ void d_mhead_norm(int vb, int tid, const float* __restrict__ hraw, const bf16_t* __restrict__ p6, const float* __restrict__ g, bf16_t* __restrict__ mix) {
    const int t = vb, h = tid >> 6, lane = tid & 63;
    const float4 v = *(const float4*)(hraw + (size_t)t * 1024 + h * 256 + lane * 4);
    float s = v.x * v.x + v.y * v.y + v.z * v.z + v.w * v.w;
    s = wave_sum(s);
    const float r = rsqrtf(s * (1.0f / 256.0f) + EPS);
    const float4 gg = *(const float4*)(g + h * 256 + lane * 4);
    const ushort4 mo = *(const ushort4*)(p6 + 2 * P6S + (size_t)t * 1024 + h * 256 + lane * 4);
    float4 o;
    o.x = v.x * r * gg.x / (1.0f + expf(-bf2f(mo.x)));
    o.y = v.y * r * gg.y / (1.0f + expf(-bf2f(mo.y)));
    o.z = v.z * r * gg.z / (1.0f + expf(-bf2f(mo.z)));
    o.w = v.w * r * gg.w / (1.0f + expf(-bf2f(mo.w)));
    uint2 ob; ob.x = pk2(o.x, o.y); ob.y = pk2(o.z, o.w);
    *(uint2*)(mix + (size_t)t * D + h * 256 + lane * 4) = ob;
}

__device__ __forceinline__ void d_rope(int vb, int tid, bf16_t* __restrict__ p6) {
    const int t = vb, s = t % S;
    for (int idx = tid; idx < 2 * 8 * 64; idx += 256) {
        const int i = idx & 63, hd = (idx >> 6) & 7, qk = idx >> 9;
        const float inv = exp2f(-(float)i * 0.20762050593046014f);
        const float ang = (float)s * inv;
        float sn, cs; sincosf(ang, &sn, &cs);
        bf16_t* p = p6 + (size_t)(3 + qk) * P6S + (size_t)t * 1024 + hd * 128;
        const float x1 = bf2f(p[i]), x2 = bf2f(p[64 + i]);
        p[i] = (bf16_t)f2bf(x1 * cs - x2 * sn);
        p[64 + i] = (bf16_t)f2bf(x2 * cs + x1 * sn);
    }
}

__device__ __forceinline__ void d_dilated(int vb, int tid, float* sm, const bf16_t* __restrict__ p6, const float* __restrict__ g_ahead, bf16_t* __restrict__ mix) {
    float (*qs)[128] = (float (*)[128])sm;
    float (*ps)[576] = (float (*)[576])(sm + 512);
    const int lane = tid & 63, w = tid >> 6;
    const int gid = vb * 4 + w;
    const int s = gid % S, hd = (gid / S) & 7, b = gid / (S * 8);
    const size_t t = (size_t)b * S + s;
    const bf16_t* qrow = p6 + 3 * P6S + t * 1024 + hd * 128;
    __syncthreads();
    qs[w][lane] = bf2f(qrow[lane]); qs[w][lane + 64] = bf2f(qrow[lane + 64]);
    __syncthreads();
    const float scale = 0.08838834764831845f;
    float mloc = -INFINITY;
    for (int br = 0; br < 3; ++br) {
        const int dil = br == 0 ? 1 : (br == 1 ? 4 : 16);
        for (int jj = 0; jj < 192; jj += 64) {
            const int j = jj + lane;
            float sc = -INFINITY;
            if (j <= 128 && s - j * dil >= 0) {
                const bf16_t* krow = p6 + 4 * P6S + (t - (size_t)j * dil) * 1024 + hd * 128;
                float d = 0.f;
#pragma unroll 8
                for (int c = 0; c < 128; c += 4) {
                    const ushort4 kv = *(const ushort4*)(krow + c);
                    d = fmaf(qs[w][c], bf2f(kv.x), d); d = fmaf(qs[w][c + 1], bf2f(kv.y), d); d = fmaf(qs[w][c + 2], bf2f(kv.z), d); d = fmaf(qs[w][c + 3], bf2f(kv.w), d);
                }
                sc = d * scale;
            }
            ps[w][br * 192 + j] = sc;
            mloc = fmaxf(mloc, sc);
        }
    }
    const float mx = wave_max(mloc);
    __syncthreads();
    float lsum = 0.f;
    for (int i = lane; i < 3 * 192; i += 64) {
        const float sc = ps[w][i];
        const float pv = (sc == -INFINITY) ? 0.f : expf(sc - mx);
        ps[w][i] = pv; lsum += pv;
    }
    const float tot = wave_sum(lsum);
    __syncthreads();
    float o0 = 0.f, o1 = 0.f;
    for (int br = 0; br < 3; ++br) {
        const int dil = br == 0 ? 1 : (br == 1 ? 4 : 16);
        for (int j = 0; j <= 128; ++j) {
            if (s - j * dil < 0) break;
            const float pv = ps[w][br * 192 + j];
            const bf16_t* vrow = p6 + 5 * P6S + (t - (size_t)j * dil) * 1024 + hd * 128;
            o0 = fmaf(pv, bf2f(vrow[lane]), o0); o1 = fmaf(pv, bf2f(vrow[lane + 64]), o1);
        }
    }
    o0 /= tot; o1 /= tot;
    float ss = wave_sum(o0 * o0 + o1 * o1);
    const float r = rsqrtf(ss * (1.0f / 128.0f) + EPS);
    bf16_t* orow = mix + t * D + 1024 + hd * 128;
    orow[lane] = (bf16_t)f2bf(o0 * r * g_ahead[hd * 128 + lane]);
    orow[lane + 64] = (bf16_t)f2bf(o1 * r * g_ahead[hd * 128 + lane + 64]);
}

__device__ __forceinline__ void d_cross(int vb, int tid, float* sm, const bf16_t* __restrict__ q, const float* __restrict__ km, const float* __restrict__ vm, bf16_t* __restrict__ o) {
    float (*qs)[512] = (float (*)[512])sm;
    float (*ps)[256] = (float (*)[256])(sm + 2048);
    const int lane = tid & 63, w = tid >> 6;
    const int t = vb, hd = w, b = t / S;
    const bf16_t* qrow = q + (size_t)t * D + hd * 512;
    __syncthreads();
    for (int i = lane; i < 512; i += 64) qs[w][i] = bf2f(qrow[i]);
    __syncthreads();
    const float scale = 0.04419417382415922f;
    float sc[4]; float mloc = -INFINITY;
#pragma unroll
    for (int r = 0; r < 4; ++r) {
        const int mi = lane + 64 * r;
        const float* krow = km + ((size_t)b * 256 + mi) * D + hd * 512;
        float d = 0.f;
#pragma unroll 8
        for (int c = 0; c < 512; c += 4) {
            const float4 kv = *(const float4*)(krow + c);
            d = fmaf(qs[w][c], kv.x, d); d = fmaf(qs[w][c + 1], kv.y, d); d = fmaf(qs[w][c + 2], kv.z, d); d = fmaf(qs[w][c + 3], kv.w, d);
        }
        sc[r] = d * scale; mloc = fmaxf(mloc, sc[r]);
    }
    const float mx = wave_max(mloc);
    float lsum = 0.f;
#pragma unroll
    for (int r = 0; r < 4; ++r) { const float pv = expf(sc[r] - mx); ps[w][lane + 64 * r] = pv; lsum += pv; }
    const float tot = wave_sum(lsum);
    __syncthreads();
    float acc[8];
#pragma unroll
    for (int i = 0; i < 8; ++i) acc[i] = 0.f;
    for (int mi = 0; mi < 256; ++mi) {
        const float pv = ps[w][mi];
        const float* vrow = vm + ((size_t)b * 256 + mi) * D + hd * 512;
#pragma unroll
        for (int i = 0; i < 8; ++i) acc[i] = fmaf(pv, vrow[lane + 64 * i], acc[i]);
    }
    bf16_t* orow = o + (size_t)t * D + hd * 512;
#pragma unroll
    for (int i = 0; i < 8; ++i) orow[lane + 64 * i] = (bf16_t)f2bf(acc[i] / tot);
}

__device__ __forceinline__ void wave_argmax(float& best, int& bidx) {
#pragma unroll
    for (int o = 32; o >= 1; o >>= 1) {
        const float ob = __shfl_xor(best, o); const int oi = __shfl_xor(bidx, o);
        if (ob > best || (ob == best && oi < bidx)) { best = ob; bidx = oi; }
    }
}
__device__ __forceinline__ void d_peer_topk(int vb, int tid, float* sm, const bf16_t* __restrict__ qp, const float* __restrict__ sub_keys, int* __restrict__ ids, float* __restrict__ gates) {
    float (*qs)[256] = (float (*)[256])sm;
    const int lane = tid & 63, w = tid >> 6;
    const int gid = vb * 4 + w;
    const int hd = gid & 7, t = gid >> 3;
    const bf16_t* qrow = qp + (size_t)t * D + hd * 256;
    __syncthreads();
    for (int i = lane; i < 256; i += 64) qs[w][i] = bf2f(qrow[i]);
    __syncthreads();
    float tops[2]; int topi[2];
#pragma unroll
    for (int p = 0; p < 2; ++p) {
        float v0, v1;
        {
            const float* k0 = sub_keys + ((size_t)(hd * 2 + p) * 128 + lane) * 128;
            const float* k1 = k0 + 64 * 128;
            float d0 = 0.f, d1 = 0.f;
#pragma unroll 8
            for (int c = 0; c < 128; c += 4) {
                const float4 a = *(const float4*)(k0 + c), bb = *(const float4*)(k1 + c);
                const float q0 = qs[w][p * 128 + c], q1 = qs[w][p * 128 + c + 1], q2 = qs[w][p * 128 + c + 2], q3 = qs[w][p * 128 + c + 3];
                d0 = fmaf(q0, a.x, d0); d0 = fmaf(q1, a.y, d0); d0 = fmaf(q2, a.z, d0); d0 = fmaf(q3, a.w, d0);
                d1 = fmaf(q0, bb.x, d1); d1 = fmaf(q1, bb.y, d1); d1 = fmaf(q2, bb.z, d1); d1 = fmaf(q3, bb.w, d1);
            }
            v0 = d0; v1 = d1;
        }
        float ts = 0.f; int ti = 0;
        for (int it = 0; it < 16; ++it) {
            float best; int bidx;
            if (v0 >= v1) { best = v0; bidx = lane; } else { best = v1; bidx = lane + 64; }
            wave_argmax(best, bidx);
            if (lane == it) { ts = best; ti = bidx; }
            if (bidx == lane) v0 = -INFINITY;
            if (bidx == lane + 64) v1 = -INFINITY;
        }
        tops[p] = ts; topi[p] = ti;
    }
    float cv[4]; int ci[4];
#pragma unroll
    for (int r = 0; r < 4; ++r) {
        const int c = lane * 4 + r, i = c >> 4, j = c & 15;
        const float s0 = __shfl(tops[0], i), s1 = __shfl(tops[1], j);
        const int i0 = __shfl(topi[0], i), i1 = __shfl(topi[1], j);
        cv[r] = s0 + s1; ci[r] = i0 * 128 + i1;
    }
    float bs = 0.f; int bid = 0;
    for (int it = 0; it < 16; ++it) {
        float best = cv[0]; int bidx = lane * 4;
#pragma unroll
        for (int r = 1; r < 4; ++r) if (cv[r] > best) { best = cv[r]; bidx = lane * 4 + r; }
        wave_argmax(best, bidx);
        const int owner = bidx >> 2, rr = bidx & 3;
        int myid = ci[0];
        if (rr == 1) myid = ci[1]; else if (rr == 2) myid = ci[2]; else if (rr == 3) myid = ci[3];
        const int eid = __shfl(myid, owner);
        if (lane == it) { bs = best; bid = eid; }
        if (owner == lane) {
#pragma unroll
            for (int r = 0; r < 4; ++r) if (rr == r) cv[r] = -INFINITY;
        }
    }
    float v = lane < 16 ? bs : -INFINITY;
    const float mx = wave_max(v);
    const float ev = lane < 16 ? expf(bs - mx) : 0.f;
    const float tot = wave_sum(ev);
    if (lane < 16) {
        ids[(size_t)t * 128 + hd * 16 + lane] = bid;
        gates[(size_t)t * 128 + hd * 16 + lane] = ev / tot;
    }
}

__device__ __forceinline__ void d_peer_out(int vb, int tid, float* sm, const bf16_t* __restrict__ h3, const float* __restrict__ x2, const int* __restrict__ ids, const float* __restrict__ gates,
                                           const bf16_t* __restrict__ u_tab, const bf16_t* __restrict__ v_tab, const float* __restrict__ g_final, float* __restrict__ out) {
    float (*part)[2048] = (float (*)[2048])sm;
    float* red = sm + 4 * 2048;
    const int lane = tid & 63, w = tid >> 6, t = vb;
    float4 xr[8], acc[8];
    const bf16_t* hrow = h3 + (size_t)t * D;
#pragma unroll
    for (int i = 0; i < 8; ++i) { const ushort4 hv = *(const ushort4*)(hrow + i * 256 + lane * 4);
        xr[i] = make_float4(bf2f(hv.x), bf2f(hv.y), bf2f(hv.z), bf2f(hv.w)); acc[i] = make_float4(0.f, 0.f, 0.f, 0.f); }
    for (int j = 0; j < 32; ++j) {
        const int slot = w * 32 + j;
        const int e = ids[(size_t)t * 128 + slot];
        const float gt = gates[(size_t)t * 128 + slot];
        const bf16_t* ur = u_tab + (size_t)e * D;
        const bf16_t* vr = v_tab + (size_t)e * D;
        float d = 0.f;
#pragma unroll
        for (int i = 0; i < 8; ++i) {
            const ushort4 u = *(const ushort4*)(ur + i * 256 + lane * 4);
            d = fmaf(xr[i].x, bf2f(u.x), d); d = fmaf(xr[i].y, bf2f(u.y), d); d = fmaf(xr[i].z, bf2f(u.z), d); d = fmaf(xr[i].w, bf2f(u.w), d);
        }
        d = wave_sum(d);
        const float act = 0.5f * d * (1.0f + erff(d * 0.7071067811865476f));
        const float cf = gt * act;
#pragma unroll
        for (int i = 0; i < 8; ++i) {
            const ushort4 v = *(const ushort4*)(vr + i * 256 + lane * 4);
            acc[i].x = fmaf(cf, bf2f(v.x), acc[i].x); acc[i].y = fmaf(cf, bf2f(v.y), acc[i].y); acc[i].z = fmaf(cf, bf2f(v.z), acc[i].z); acc[i].w = fmaf(cf, bf2f(v.w), acc[i].w);
        }
    }
    __syncthreads();
#pragma unroll
    for (int i = 0; i < 8; ++i) *(float4*)&part[w][i * 256 + lane * 4] = acc[i];
    __syncthreads();
    float4 r0, r1;
    {
        const float4 a = *(const float4*)&part[0][tid * 4], b = *(const float4*)&part[1][tid * 4], c = *(const float4*)&part[2][tid * 4], d = *(const float4*)&part[3][tid * 4];
        const float4 x = *(const float4*)(x2 + (size_t)t * D + tid * 4);
        r0 = make_float4(x.x + a.x + b.x + c.x + d.x, x.y + a.y + b.y + c.y + d.y, x.z + a.z + b.z + c.z + d.z, x.w + a.w + b.w + c.w + d.w);
    }
    {
        const float4 a = *(const float4*)&part[0][1024 + tid * 4], b = *(const float4*)&part[1][1024 + tid * 4], c = *(const float4*)&part[2][1024 + tid * 4], d = *(const float4*)&part[3][1024 + tid * 4];
        const float4 x = *(const float4*)(x2 + (size_t)t * D + 1024 + tid * 4);
        r1 = make_float4(x.x + a.x + b.x + c.x + d.x, x.y + a.y + b.y + c.y + d.y, x.z + a.z + b.z + c.z + d.z, x.w + a.w + b.w + c.w + d.w);
    }
    float s = r0.x * r0.x + r0.y * r0.y + r0.z * r0.z + r0.w * r0.w + r1.x * r1.x + r1.y * r1.y + r1.z * r1.z + r1.w * r1.w;
    s = wave_sum(s);
    if (lane == 0) red[w] = s;
    __syncthreads();
    const float tot = red[0] + red[1] + red[2] + red[3];
    const float r = rsqrtf(tot * (1.0f / D) + EPS);
    const float4 g0 = *(const float4*)(g_final + tid * 4), g1 = *(const float4*)(g_final + 1024 + tid * 4);
    *(float4*)(out + (size_t)t * D + tid * 4) = make_float4(r0.x * r * g0.x, r0.y * r * g0.y, r0.z * r * g0.z, r0.w * r * g0.w);
    *(float4*)(out + (size_t)t * D + 1024 + tid * 4) = make_float4(r1.x * r * g1.x, r1.y * r * g1.y, r1.z * r * g1.z, r1.w * r * g1.w);
}


__device__ __forceinline__ float wave_incl_scan_add(float v, int lane) {
#pragma unroll
    for (int o = 1; o < 64; o <<= 1) { const float t = __shfl_up(v, o); if (lane >= o) v += t; }
    return v;
}
__device__ __forceinline__ float wave_incl_scan_max(float v, int lane) {
#pragma unroll
    for (int o = 1; o < 64; o <<= 1) { const float t = __shfl_up(v, o); if (lane >= o) v = fmaxf(v, t); }
    return v;
}
__device__ __forceinline__ void mlstm_gates_wave(int b, int h, int lane, const float* __restrict__ gpre, const float* __restrict__ b_mi, const float* __restrict__ b_mf,
                                                 float* __restrict__ gs, float* __restrict__ decay) {
    const float bi = b_mi[h], bf = b_mf[h];
    float mprev = 0.f;
    for (int c = 0; c < 16; ++c) {
        const size_t t0 = (size_t)b * S + c * 256 + lane * 4;
        float logi[4], lf[4], bb[4];
#pragma unroll
        for (int j = 0; j < 4; ++j) { logi[j] = gpre[(t0 + j) * 8 + h] + bi; lf[j] = log_sigmoid(gpre[(t0 + j) * 8 + 4 + h] + bf); }
        bb[0] = lf[0]; bb[1] = bb[0] + lf[1]; bb[2] = bb[1] + lf[2]; bb[3] = bb[2] + lf[3];
        const float incl = wave_incl_scan_add(bb[3], lane);
        const float excl = incl - bb[3];
#pragma unroll
        for (int j = 0; j < 4; ++j) bb[j] += excl;
        const float g = __shfl(incl, 63);
        float amax = -INFINITY, uu[4], cm[4];
#pragma unroll
        for (int j = 0; j < 4; ++j) { amax = fmaxf(amax, logi[j] + g - bb[j]); uu[j] = logi[j] - bb[j]; }
        amax = wave_max(amax);
        const float mnew = fmaxf(g + mprev, amax);
        cm[0] = uu[0]; cm[1] = fmaxf(cm[0], uu[1]); cm[2] = fmaxf(cm[1], uu[2]); cm[3] = fmaxf(cm[2], uu[3]);
        const float cincl = wave_incl_scan_max(cm[3], lane);
        float cexcl = __shfl_up(cincl, 1); if (lane == 0) cexcl = -INFINITY;
#pragma unroll
        for (int j = 0; j < 4; ++j) {
            const float M = fmaxf(mprev, fmaxf(cexcl, cm[j]));
            float* o = gs + ((t0 + j) * 4 + h) * 8;
            o[0] = uu[j] * 1.4426950408889634f; o[1] = M * 1.4426950408889634f; o[2] = expf(logi[j] + g - bb[j] - mnew); o[3] = expf(mprev - M); o[4] = expf(-(bb[j] + M));
        }
        if (lane == 0) decay[(b * 16 + c) * 4 + h] = expf(g + mprev - mnew);
        mprev = mnew;
    }
}
__device__ __forceinline__ void transpose_tile64(int tid, float* sm, const bf16_t* __restrict__ src, int src_ld, bf16_t* __restrict__ dst, int dst_ld, const float* __restrict__ scale, int sstride) {
    unsigned short (*tl)[66] = (unsigned short (*)[66])sm;
    __syncthreads();
#pragma unroll
    for (int i = 0; i < 2; ++i) {
        const int ch = tid + i * 256, r = ch >> 3, c8 = (ch & 7) * 8;
        const uint4 v = *(const uint4*)(src + (size_t)r * src_ld + c8);
        const float sc = scale ? scale[(size_t)r * sstride] : 1.0f;
        const unsigned w[4] = {v.x, v.y, v.z, v.w};
#pragma unroll
        for (int k = 0; k < 4; ++k) {
            tl[r][c8 + 2 * k] = (unsigned short)f2bf(bf2f((unsigned short)(w[k] & 0xFFFFu)) * sc);
            tl[r][c8 + 2 * k + 1] = (unsigned short)f2bf(bf2f((unsigned short)(w[k] >> 16)) * sc);
        }
    }
    __syncthreads();
#pragma unroll
    for (int i = 0; i < 2; ++i) {
        const int ch = tid + i * 256, c = ch >> 3, r8 = (ch & 7) * 8;
        uint4 o;
        o.x = (unsigned)tl[r8 + 0][c] | ((unsigned)tl[r8 + 1][c] << 16); o.y = (unsigned)tl[r8 + 2][c] | ((unsigned)tl[r8 + 3][c] << 16);
        o.z = (unsigned)tl[r8 + 4][c] | ((unsigned)tl[r8 + 5][c] << 16); o.w = (unsigned)tl[r8 + 6][c] | ((unsigned)tl[r8 + 7][c] << 16);
        *(uint4*)(dst + (size_t)c * dst_ld + r8) = o;
    }
}

__device__ __forceinline__ void rope_table_fill(float2* __restrict__ cs, int gtid, int nth) {
    for (int idx = gtid; idx < 4096 * 64; idx += nth) {
        const int i = idx & 63, s = idx >> 6;
        const float inv = exp2f(-(float)i * 0.20762050593046014f);
        const float ang = (float)s * inv;
        float sn, c; sincosf(ang, &sn, &c);
        cs[idx] = make_float2(c, sn);
    }
}
__device__ __forceinline__ void rope_q_pass(bf16_t* __restrict__ aq, const float2* __restrict__ cs, size_t gtid, size_t nth) {
    for (size_t idx = gtid; idx < (size_t)T * 8 * 8; idx += nth) {
        const int c8 = (int)(idx & 7), hd = (int)((idx >> 3) & 7); const size_t t = idx >> 6; const int s = (int)(t & (S - 1));
        bf16_t* p = aq + t * 1024 + hd * 128 + c8 * 8;
        const uint4 a = *(const uint4*)p, b = *(const uint4*)(p + 64);
        const unsigned aw[4] = {a.x, a.y, a.z, a.w}, bw[4] = {b.x, b.y, b.z, b.w};
        unsigned ao[4], bo[4];
#pragma unroll
        for (int k = 0; k < 4; ++k) {
            const float4 cc = *(const float4*)(cs + (size_t)s * 64 + c8 * 8 + 2 * k);
            const float x10 = __uint_as_float(aw[k] << 16), x11 = __uint_as_float(aw[k] & 0xFFFF0000u), x20 = __uint_as_float(bw[k] << 16), x21 = __uint_as_float(bw[k] & 0xFFFF0000u);
            ao[k] = pk2(x10 * cc.x - x20 * cc.y, x11 * cc.z - x21 * cc.w);
            bo[k] = pk2(x20 * cc.x + x10 * cc.y, x21 * cc.z + x11 * cc.w);
        }
        *(uint4*)p = make_uint4(ao[0], ao[1], ao[2], ao[3]); *(uint4*)(p + 64) = make_uint4(bo[0], bo[1], bo[2], bo[3]);
    }
}
__device__ __forceinline__ void dil_tile_prep(int item, int lane, LAS unsigned short* wl, const bf16_t* __restrict__ ak, const bf16_t* __restrict__ av, const float2* __restrict__ cs,
                                              bf16_t* __restrict__ KB, bf16_t* __restrict__ VB) {
    const int TT = item & 255, hd = (item >> 8) & 7, b = (item >> 11) & 1, br = item >> 12;
    const int ld = 2 * br, tpr = 256 >> ld, rho = TT / tpr, tile = TT - rho * tpr;
    const int i = lane & 15, c = lane >> 4;
    const int s = rho + ((16 * tile + i) << ld);
    const size_t trow = (size_t)b * S + s;
    bf16_t* kdst = KB + (size_t)item * 2048;
    bf16_t* vdst = VB + (size_t)item * 2048;
    {
        const bf16_t* kr = ak + trow * 1024 + hd * 128 + 16 * c;
        const uint4 a0 = *(const uint4*)kr, a1 = *(const uint4*)(kr + 8), b0 = *(const uint4*)(kr + 64), b1 = *(const uint4*)(kr + 72);
        const unsigned aw[8] = {a0.x, a0.y, a0.z, a0.w, a1.x, a1.y, a1.z, a1.w}, bw[8] = {b0.x, b0.y, b0.z, b0.w, b1.x, b1.y, b1.z, b1.w};
        unsigned ao[8], bo[8];
#pragma unroll
        for (int k = 0; k < 8; ++k) {
            const float4 cc = *(const float4*)(cs + (size_t)s * 64 + 16 * c + 2 * k);
            const float x10 = __uint_as_float(aw[k] << 16), x11 = __uint_as_float(aw[k] & 0xFFFF0000u), x20 = __uint_as_float(bw[k] << 16), x21 = __uint_as_float(bw[k] & 0xFFFF0000u);
            ao[k] = pk2(x10 * cc.x - x20 * cc.y, x11 * cc.z - x21 * cc.w);
            bo[k] = pk2(x20 * cc.x + x10 * cc.y, x21 * cc.z + x11 * cc.w);
        }
        bf16_t* d0 = kdst + (c >> 1) * 512 + i * 32 + (c & 1) * 16;
        *(uint4*)d0 = make_uint4(ao[0], ao[1], ao[2], ao[3]); *(uint4*)(d0 + 8) = make_uint4(ao[4], ao[5], ao[6], ao[7]);
        bf16_t* d1 = d0 + 1024;
        *(uint4*)d1 = make_uint4(bo[0], bo[1], bo[2], bo[3]); *(uint4*)(d1 + 8) = make_uint4(bo[4], bo[5], bo[6], bo[7]);
    }
    {
        const bf16_t* vr = av + trow * 1024 + hd * 128 + 32 * c;
        const uint4 v0 = *(const uint4*)vr, v1 = *(const uint4*)(vr + 8), v2 = *(const uint4*)(vr + 16), v3 = *(const uint4*)(vr + 24);
        LAS unsigned short* wr = wl + i * 136 + 32 * c;
        typedef unsigned u32x4_t __attribute__((ext_vector_type(4)));
        *(LAS u32x4_t*)wr = (u32x4_t){v0.x, v0.y, v0.z, v0.w}; *(LAS u32x4_t*)(wr + 8) = (u32x4_t){v1.x, v1.y, v1.z, v1.w};
        *(LAS u32x4_t*)(wr + 16) = (u32x4_t){v2.x, v2.y, v2.z, v2.w}; *(LAS u32x4_t*)(wr + 24) = (u32x4_t){v3.x, v3.y, v3.z, v3.w};
        asm volatile("s_waitcnt lgkmcnt(0)" ::: "memory");
        unsigned o[16];
#pragma unroll
        for (int k = 0; k < 8; ++k) {
            const unsigned p0 = *(const LAS unsigned*)(wl + (2 * k) * 136 + 2 * lane), p1 = *(const LAS unsigned*)(wl + (2 * k + 1) * 136 + 2 * lane);
            o[k] = (p0 & 0xFFFFu) | (p1 << 16);
            o[8 + k] = (p0 >> 16) | (p1 & 0xFFFF0000u);
        }
        bf16_t* d = vdst + (2 * lane) * 16;
        *(uint4*)d = make_uint4(o[0], o[1], o[2], o[3]); *(uint4*)(d + 8) = make_uint4(o[4], o[5], o[6], o[7]);
        *(uint4*)(d + 16) = make_uint4(o[8], o[9], o[10], o[11]); *(uint4*)(d + 24) = make_uint4(o[12], o[13], o[14], o[15]);
        asm volatile("s_waitcnt lgkmcnt(0)" ::: "memory");
    }
}

typedef short bf16x8_t __attribute__((ext_vector_type(8)));
typedef short bf16x4_t __attribute__((ext_vector_type(4)));
typedef float f32x4_t __attribute__((ext_vector_type(4)));
__device__ __forceinline__ void dilated_wave_tile(int qt, int lane, const bf16_t* __restrict__ AQ, const bf16_t* __restrict__ KB, const bf16_t* __restrict__ VB,
                                                  const float* __restrict__ g_ahead, bf16_t* __restrict__ mix) {
    const int r = qt & 15, blk = (qt >> 4) & 15, hd = (qt >> 8) & 7, b = qt >> 11;
    const int j = lane & 15, g = lane >> 4;
    const int t0 = blk * 256;
    const int sq = t0 + r + 16 * j;
    bf16x8_t qf[4];
    {
        const bf16_t* qrow = AQ + ((size_t)b * S + sq) * 1024 + hd * 128 + 8 * g;
#pragma unroll
        for (int ks = 0; ks < 4; ++ks) qf[ks] = *(const bf16x8_t*)(qrow + 32 * ks);
    }
    const float sc = 0.08838834764831845f * 1.4426950408889634f;
    float m_run = -1e30f, l_run = 0.f;
    f32x4_t o[8];
#pragma unroll
    for (int dt = 0; dt < 8; ++dt) o[dt] = (f32x4_t){0.f, 0.f, 0.f, 0.f};
#pragma nounroll
    for (int br = 0; br < 3; ++br) {
        const int ld = 2 * br, d = 1 << ld;
        const int rho = r & (d - 1);
        const int qj = (sq - rho) >> ld;
        const int q_lo = ((t0 + r - rho) >> ld) - 128, q_hi = (t0 + r + 240 - rho) >> ld;
        const int tile_lo = q_lo < 0 ? 0 : (q_lo >> 4), tile_hi = q_hi >> 4, tile_max = (256 >> ld) - 1;
        const size_t tbase = ((size_t)((br * 2 + b) * 8 + hd) * 256 + (size_t)rho * (256 >> ld)) * 2048;
        const bf16_t* kbb = KB + tbase + j * 32 + 8 * g;
        const bf16_t* vbb = VB + tbase + j * 16 + 4 * g;
#pragma nounroll
        for (int tp = tile_lo; tp <= tile_hi; tp += 2) {
            f32x4_t su[2];
#pragma unroll
            for (int u = 0; u < 2; ++u) {
                int tl = tp + u; if (tl > tile_max) tl = tile_max;
                const bf16_t* krow = kbb + (size_t)tl * 2048;
                f32x4_t a = (f32x4_t){0.f, 0.f, 0.f, 0.f};
#pragma unroll
                for (int ks = 0; ks < 4; ++ks) a = __builtin_amdgcn_mfma_f32_16x16x32_bf16(*(const bf16x8_t*)(krow + 512 * ks), qf[ks], a, 0, 0, 0);
                su[u] = a;
            }
            float p[2][4]; float mx = -1e30f;
#pragma unroll
            for (int u = 0; u < 2; ++u)
#pragma unroll
                for (int e = 0; e < 4; ++e) {
                    const int n = qj - (16 * (tp + u) + 4 * g + e);
                    const bool valid = (n >= 0) && (n <= 128);
                    p[u][e] = valid ? su[u][e] * sc : -1e30f;
                    mx = fmaxf(mx, p[u][e]);
                }
            mx = fmaxf(mx, __shfl_xor(mx, 16)); mx = fmaxf(mx, __shfl_xor(mx, 32));
            const float m_new = fmaxf(m_run, mx);
            const float alpha = __builtin_amdgcn_exp2f(m_run - m_new);
            m_run = m_new;
            float ps = 0.f;
#pragma unroll
            for (int u = 0; u < 2; ++u)
#pragma unroll
                for (int e = 0; e < 4; ++e) { p[u][e] = (p[u][e] > -1e29f) ? __builtin_amdgcn_exp2f(p[u][e] - m_new) : 0.f; ps += p[u][e]; }
            l_run = l_run * alpha + ps;
            bf16x8_t pb;
            {
                const unsigned w0 = pk2(p[0][0], p[0][1]), w1 = pk2(p[0][2], p[0][3]), w2 = pk2(p[1][0], p[1][1]), w3 = pk2(p[1][2], p[1][3]);
                pb[0] = (short)(w0 & 0xFFFF); pb[1] = (short)(w0 >> 16); pb[2] = (short)(w1 & 0xFFFF); pb[3] = (short)(w1 >> 16);
                pb[4] = (short)(w2 & 0xFFFF); pb[5] = (short)(w2 >> 16); pb[6] = (short)(w3 & 0xFFFF); pb[7] = (short)(w3 >> 16);
            }
            int tl0 = tp, tl1 = tp + 1; if (tl0 > tile_max) tl0 = tile_max; if (tl1 > tile_max) tl1 = tile_max;
#pragma unroll
            for (int dt = 0; dt < 8; ++dt) {
                const bf16_t* vrow = vbb + dt * 256;
                const bf16x4_t v0 = *(const bf16x4_t*)(vrow + (size_t)tl0 * 2048), v1 = *(const bf16x4_t*)(vrow + (size_t)tl1 * 2048);
                bf16x8_t va; va[0] = v0[0]; va[1] = v0[1]; va[2] = v0[2]; va[3] = v0[3]; va[4] = v1[0]; va[5] = v1[1]; va[6] = v1[2]; va[7] = v1[3];
                f32x4_t oo = o[dt]; oo = oo * alpha;
                o[dt] = __builtin_amdgcn_mfma_f32_16x16x32_bf16(va, pb, oo, 0, 0, 0);
            }
        }
    }
    float lt = l_run; lt += __shfl_xor(lt, 16); lt += __shfl_xor(lt, 32);
    const float inv = 1.0f / lt;
    float ss = 0.f;
#pragma unroll
    for (int dt = 0; dt < 8; ++dt) { o[dt] = o[dt] * inv; ss += (o[dt][0] * o[dt][0] + o[dt][1] * o[dt][1]) + (o[dt][2] * o[dt][2] + o[dt][3] * o[dt][3]); }
    ss += __shfl_xor(ss, 16); ss += __shfl_xor(ss, 32);
    const float rn = rsqrtf(ss * (1.0f / 128.0f) + EPS);
    bf16_t* orow = mix + ((size_t)b * S + sq) * D + 1024 + hd * 128 + 4 * g;
#pragma unroll
    for (int dt = 0; dt < 8; ++dt) {
        const f32x4_t gv = *(const f32x4_t*)(g_ahead + hd * 128 + 16 * dt + 4 * g);
        uint2 w; w.x = pk2(o[dt][0] * rn * gv[0], o[dt][1] * rn * gv[1]); w.y = pk2(o[dt][2] * rn * gv[2], o[dt][3] * rn * gv[3]);
        *(uint2*)(orow + 16 * dt) = w;
    }
}

__device__ __forceinline__ unsigned ord_key(float s) { const unsigned u = __float_as_uint(s); return u ^ ((unsigned)((int)u >> 31) | 0x80000000u); }
__device__ __forceinline__ unsigned wave_max_u32(unsigned v) {
    unsigned t;
    t = (unsigned)__builtin_amdgcn_update_dpp(0, (int)v, 0xB1, 0xF, 0xF, true); v = v > t ? v : t;
    t = (unsigned)__builtin_amdgcn_update_dpp(0, (int)v, 0x4E, 0xF, 0xF, true); v = v > t ? v : t;
    t = (unsigned)__builtin_amdgcn_update_dpp(0, (int)v, 0x141, 0xF, 0xF, true); v = v > t ? v : t;
    t = (unsigned)__builtin_amdgcn_update_dpp(0, (int)v, 0x140, 0xF, 0xF, true); v = v > t ? v : t;
    const unsigned a = (unsigned)__builtin_amdgcn_readlane((int)v, 0), b = (unsigned)__builtin_amdgcn_readlane((int)v, 16),
                   c = (unsigned)__builtin_amdgcn_readlane((int)v, 32), d = (unsigned)__builtin_amdgcn_readlane((int)v, 48);
    const unsigned ab = a > b ? a : b, cd = c > d ? c : d;
    return ab > cd ? ab : cd;
}
__device__ __forceinline__ void peer_topk_wave(int item, int lane, LAS float* wl, const bf16_t* __restrict__ qp, const bf16_t* __restrict__ skb, int* __restrict__ ids, float* __restrict__ gates) {
    const int hd = item & 7, tt = item >> 3, j = lane & 15, g = lane >> 4;
    const size_t t0 = (size_t)tt * 16;
    LAS float* sc = wl;
    LAS float* lst = wl + 2048;
#pragma unroll 1
    for (int p = 0; p < 2; ++p) {
        bf16x8_t qf[4];
        const bf16_t* qrow = qp + (t0 + j) * D + hd * 256 + p * 128 + 8 * g;
#pragma unroll
        for (int ks = 0; ks < 4; ++ks) qf[ks] = *(const bf16x8_t*)(qrow + 32 * ks);
        const bf16_t* kb = skb + ((size_t)(hd * 2 + p) * 128 + j) * 128 + 8 * g;
#pragma unroll
        for (int kt = 0; kt < 8; ++kt) {
            f32x4_t a = (f32x4_t){0.f, 0.f, 0.f, 0.f};
#pragma unroll
            for (int ks = 0; ks < 4; ++ks) a = __builtin_amdgcn_mfma_f32_16x16x32_bf16(*(const bf16x8_t*)(kb + (size_t)kt * (16 * 128) + 32 * ks), qf[ks], a, 0, 0, 0);
            *(LAS f32x4_t*)(sc + j * 128 + 16 * kt + 4 * g) = a;
        }
        asm volatile("s_waitcnt lgkmcnt(0)" ::: "memory");
#pragma unroll 1
        for (int tok = 0; tok < 16; ++tok) {
            const float s0 = sc[tok * 128 + lane], s1 = sc[tok * 128 + 64 + lane];
            unsigned k0 = (ord_key(s0) & ~127u) | (unsigned)(127 - lane), k1 = (ord_key(s1) & ~127u) | (unsigned)(63 - lane);
            unsigned sel = 0u;
#pragma unroll 4
            for (int it = 0; it < 16; ++it) {
                unsigned m = k0 > k1 ? k0 : k1;
                m = wave_max_u32(m);
                if (lane == it) sel = m;
                if (k0 == m) k0 = 0u;
                if (k1 == m) k1 = 0u;
            }
            if (lane < 16) {
                const int idx = 127 - (int)(sel & 127u);
                lst[((p * 16 + tok) * 16 + lane) * 2 + 0] = sc[tok * 128 + idx];
                lst[((p * 16 + tok) * 16 + lane) * 2 + 1] = __int_as_float(idx);
            }
        }
        asm volatile("s_waitcnt lgkmcnt(0)" ::: "memory");
    }
#pragma unroll 1
    for (int tok = 0; tok < 16; ++tok) {
        const int i = lane >> 2;
        const float sA = lst[((0 * 16 + tok) * 16 + i) * 2];
        unsigned kk[4];
#pragma unroll
        for (int r = 0; r < 4; ++r) {
            const int jb = (lane & 3) * 4 + r;
            const float sum = sA + lst[((1 * 16 + tok) * 16 + jb) * 2];
            kk[r] = (ord_key(sum) & ~255u) | (unsigned)(255 - (lane * 4 + r));
        }
        unsigned sel = 0u;
#pragma unroll 4
        for (int it = 0; it < 16; ++it) {
            unsigned m = kk[0] > kk[1] ? kk[0] : kk[1]; const unsigned m2 = kk[2] > kk[3] ? kk[2] : kk[3]; m = m > m2 ? m : m2;
            m = wave_max_u32(m);
            if (lane == it) sel = m;
#pragma unroll
            for (int r = 0; r < 4; ++r) if (kk[r] == m) kk[r] = 0u;
        }
        float bs = -INFINITY; int eid = 0;
        if (lane < 16) {
            const int c = 255 - (int)(sel & 255u), ia = c >> 4, ib = c & 15;
            bs = lst[((0 * 16 + tok) * 16 + ia) * 2] + lst[((1 * 16 + tok) * 16 + ib) * 2];
            eid = __float_as_int(lst[((0 * 16 + tok) * 16 + ia) * 2 + 1]) * 128 + __float_as_int(lst[((1 * 16 + tok) * 16 + ib) * 2 + 1]);
        }
        const float mx = wave_max(bs);
        const float ev = lane < 16 ? __expf(bs - mx) : 0.f;
        const float tot = wave_sum(ev);
        if (lane < 16) {
            ids[(t0 + tok) * 128 + hd * 16 + lane] = eid;
            gates[(t0 + tok) * 128 + hd * 16 + lane] = ev / tot;
        }
    }
}

typedef float f32x2_t __attribute__((ext_vector_type(2)));
__device__ __forceinline__ void table_row_to_fp8(const float* __restrict__ srow, unsigned char* __restrict__ drow, float* __restrict__ rscale, int lane, const float* __restrict__ dgain) {
    float4 f[8];
#pragma unroll
    for (int i = 0; i < 8; ++i) f[i] = *(const float4*)(srow + i * 256 + lane * 4);
    if (dgain) {
#pragma unroll
        for (int i = 0; i < 8; ++i) { const float4 gq = *(const float4*)(dgain + i * 256 + lane * 4); f[i].x *= gq.x; f[i].y *= gq.y; f[i].z *= gq.z; f[i].w *= gq.w; }
    }
    float am = 0.f;
#pragma unroll
    for (int i = 0; i < 8; ++i) am = fmaxf(am, fmaxf(fmaxf(fabsf(f[i].x), fabsf(f[i].y)), fmaxf(fabsf(f[i].z), fabsf(f[i].w))));
    am = wave_max(am);
    const float e = floorf(log2f(448.0f / fmaxf(am, 1e-30f)));
    const float s = exp2f(fminf(e, 100.0f));
    unsigned w[8];
#pragma unroll
    for (int i = 0; i < 8; ++i) {
        int t = 0;
        t = __builtin_amdgcn_cvt_pk_fp8_f32(f[i].x * s, f[i].y * s, t, false);
        t = __builtin_amdgcn_cvt_pk_fp8_f32(f[i].z * s, f[i].w * s, t, true);
        w[i] = (unsigned)t;
    }
#pragma unroll
    for (int i = 0; i < 8; ++i) *(unsigned*)(drow + i * 256 + lane * 4) = w[i];
    if (lane == 0) *rscale = 1.0f / s;
}
__device__ __forceinline__ float dot16_fp8(const uint4 q, const float* x) {
    float d = 0.f;
    const unsigned w[4] = {q.x, q.y, q.z, q.w};
#pragma unroll
    for (int k = 0; k < 4; ++k) {
        const f32x2_t lo = __builtin_amdgcn_cvt_pk_f32_fp8((int)w[k], false), hi = __builtin_amdgcn_cvt_pk_f32_fp8((int)w[k], true);
        d = fmaf(lo.x, x[4 * k], d); d = fmaf(lo.y, x[4 * k + 1], d); d = fmaf(hi.x, x[4 * k + 2], d); d = fmaf(hi.y, x[4 * k + 3], d);
    }
    return d;
}
__device__ __forceinline__ void axpy16_fp8(const uint4 q, float c, float* acc) {
    const unsigned w[4] = {q.x, q.y, q.z, q.w};
#pragma unroll
    for (int k = 0; k < 4; ++k) {
        const f32x2_t lo = __builtin_amdgcn_cvt_pk_f32_fp8((int)w[k], false), hi = __builtin_amdgcn_cvt_pk_f32_fp8((int)w[k], true);
        acc[4 * k] = fmaf(c, lo.x, acc[4 * k]); acc[4 * k + 1] = fmaf(c, lo.y, acc[4 * k + 1]); acc[4 * k + 2] = fmaf(c, hi.x, acc[4 * k + 2]); acc[4 * k + 3] = fmaf(c, hi.y, acc[4 * k + 3]);
    }
}
__device__ __forceinline__ void d_peer_out8(int vb, int tid, float* sm, const bf16_t* __restrict__ h3, const float* __restrict__ x2, const int* __restrict__ ids, const float* __restrict__ gates,
                                            const unsigned char* __restrict__ ut8, const unsigned char* __restrict__ vt8, const float* __restrict__ rsc, const float* __restrict__ rstd, const float* __restrict__ g_final, float* __restrict__ out) {
    float (*part)[2048] = (float (*)[2048])sm;
    float* red = sm + 4 * 2048;
    const int lane = tid & 63, w = tid >> 6, t = vb;
    float x[32], acc[32];
    {
        const bf16_t* hrow = h3 + (size_t)t * D + lane * 16;
#pragma unroll
        for (int hh = 0; hh < 2; ++hh) {
            const uint4 a = *(const uint4*)(hrow + hh * 1024), b = *(const uint4*)(hrow + hh * 1024 + 8);
            const unsigned ww[8] = {a.x, a.y, a.z, a.w, b.x, b.y, b.z, b.w};
#pragma unroll
            for (int k = 0; k < 8; ++k) { x[hh * 16 + 2 * k] = __uint_as_float(ww[k] << 16); x[hh * 16 + 2 * k + 1] = __uint_as_float(ww[k] & 0xFFFF0000u); }
        }
#pragma unroll
        for (int i = 0; i < 32; ++i) acc[i] = 0.f;
    }
    const float xrs = rstd[t];
    const int myid = ids[(size_t)t * 128 + w * 32 + (lane & 31)];
    const float mygate = gates[(size_t)t * 128 + w * 32 + (lane & 31)];
#pragma unroll 1
    for (int j = 0; j < 32; j += 4) {
        int e[4]; uint4 uq[4][2], vq[4][2];
#pragma unroll
        for (int q = 0; q < 4; ++q) {
            e[q] = __builtin_amdgcn_readfirstlane(__shfl(myid, j + q));
            const unsigned char* ur = ut8 + (size_t)e[q] * 2048 + lane * 16;
            uq[q][0] = *(const uint4*)ur; uq[q][1] = *(const uint4*)(ur + 1024);
        }
#pragma unroll
        for (int q = 0; q < 4; ++q) {
            const unsigned char* vr = vt8 + (size_t)e[q] * 2048 + lane * 16;
            vq[q][0] = *(const uint4*)vr; vq[q][1] = *(const uint4*)(vr + 1024);
        }
        float d[4];
#pragma unroll
        for (int q = 0; q < 4; ++q) d[q] = dot16_fp8(uq[q][0], x) + dot16_fp8(uq[q][1], x + 16);
#pragma unroll
        for (int o = 32; o >= 1; o >>= 1) {
#pragma unroll
            for (int q = 0; q < 4; ++q) d[q] += __shfl_xor(d[q], o);
        }
#pragma unroll
        for (int q = 0; q < 4; ++q) {
            const float a = d[q] * rsc[e[q]] * xrs;
            const float act = 0.5f * a * (1.0f + erff(a * 0.7071067811865476f));
            const float cf = __shfl(mygate, j + q) * act * rsc[16384 + e[q]];
            axpy16_fp8(vq[q][0], cf, acc); axpy16_fp8(vq[q][1], cf, acc + 16);
        }
    }
    __syncthreads();
#pragma unroll
    for (int hh = 0; hh < 2; ++hh)
#pragma unroll
        for (int k = 0; k < 4; ++k) *(float4*)&part[w][hh * 1024 + lane * 16 + 4 * k] = make_float4(acc[hh * 16 + 4 * k], acc[hh * 16 + 4 * k + 1], acc[hh * 16 + 4 * k + 2], acc[hh * 16 + 4 * k + 3]);
    __syncthreads();
    float4 r0, r1;
    {
        const float4 a = *(const float4*)&part[0][tid * 4], b = *(const float4*)&part[1][tid * 4], c = *(const float4*)&part[2][tid * 4], dd = *(const float4*)&part[3][tid * 4];
        const float4 xx = *(const float4*)(x2 + (size_t)t * D + tid * 4);
        r0 = make_float4(xx.x + a.x + b.x + c.x + dd.x, xx.y + a.y + b.y + c.y + dd.y, xx.z + a.z + b.z + c.z + dd.z, xx.w + a.w + b.w + c.w + dd.w);
    }
    {
        const float4 a = *(const float4*)&part[0][1024 + tid * 4], b = *(const float4*)&part[1][1024 + tid * 4], c = *(const float4*)&part[2][1024 + tid * 4], dd = *(const float4*)&part[3][1024 + tid * 4];
        const float4 xx = *(const float4*)(x2 + (size_t)t * D + 1024 + tid * 4);
        r1 = make_float4(xx.x + a.x + b.x + c.x + dd.x, xx.y + a.y + b.y + c.y + dd.y, xx.z + a.z + b.z + c.z + dd.z, xx.w + a.w + b.w + c.w + dd.w);
    }
    float s = r0.x * r0.x + r0.y * r0.y + r0.z * r0.z + r0.w * r0.w + r1.x * r1.x + r1.y * r1.y + r1.z * r1.z + r1.w * r1.w;
    s = wave_sum(s);
    if (lane == 0) red[w] = s;
    __syncthreads();
    const float tot = red[0] + red[1] + red[2] + red[3];
    const float r = rsqrtf(tot * (1.0f / D) + EPS);
    const float4 g0 = *(const float4*)(g_final + tid * 4), g1 = *(const float4*)(g_final + 1024 + tid * 4);
    *(float4*)(out + (size_t)t * D + tid * 4) = make_float4(r0.x * r * g0.x, r0.y * r * g0.y, r0.z * r * g0.z, r0.w * r * g0.w);
    *(float4*)(out + (size_t)t * D + 1024 + tid * 4) = make_float4(r1.x * r * g1.x, r1.y * r * g1.y, r1.z * r * g1.z, r1.w * r * g1.w);
}

__device__ __forceinline__ unsigned xg_sum_u32(unsigned v) {
    auto a = __builtin_amdgcn_permlane16_swap(v, v, false, false); v = a[0] + a[1];
    auto b = __builtin_amdgcn_permlane32_swap(v, v, false, false); return b[0] + b[1];
}
__device__ __forceinline__ float xg_sum_f32(float v) {
    auto a = __builtin_amdgcn_permlane16_swap(__float_as_uint(v), __float_as_uint(v), false, false); v = __uint_as_float(a[0]) + __uint_as_float(a[1]);
    auto b = __builtin_amdgcn_permlane32_swap(__float_as_uint(v), __float_as_uint(v), false, false); return __uint_as_float(b[0]) + __uint_as_float(b[1]);
}
__device__ __forceinline__ float xg_max_f32(float v) {
    auto a = __builtin_amdgcn_permlane16_swap(__float_as_uint(v), __float_as_uint(v), false, false); v = fmaxf(__uint_as_float(a[0]), __uint_as_float(a[1]));
    auto b = __builtin_amdgcn_permlane32_swap(__float_as_uint(v), __float_as_uint(v), false, false); return fmaxf(__uint_as_float(b[0]), __uint_as_float(b[1]));
}
template <int N> __device__ __forceinline__ unsigned bisect16(const unsigned (&kk)[N]) {
    unsigned tau = 0u; bool done = false;
#pragma unroll 1
    for (int bit = 31; bit >= 0; --bit) {
        const unsigned cand = tau | (1u << bit);
        unsigned c = 0u;
#pragma unroll
        for (int i = 0; i < N; ++i) c += (kk[i] >= cand) ? 1u : 0u;
        c = xg_sum_u32(c);
        if (!done && c >= 16u) { tau = cand; done = (c == 16u); }
        if (__all(done ? 1 : 0)) break;
    }
    return tau;
}
__device__ __forceinline__ void peer_topk_wave2(int item, int lane, LAS float* wl, const bf16_t* __restrict__ qp, const bf16_t* __restrict__ skb, int* __restrict__ ids, float* __restrict__ gates) {
    const int hd = item & 7, tt = item >> 3, j = lane & 15, g = lane >> 4;
    const size_t t0 = (size_t)tt * 16;
#pragma unroll 1
    for (int p = 0; p < 2; ++p) {
        bf16x8_t qf[4];
        const bf16_t* qrow = qp + (t0 + j) * D + hd * 256 + p * 128 + 8 * g;
#pragma unroll
        for (int ks = 0; ks < 4; ++ks) qf[ks] = *(const bf16x8_t*)(qrow + 32 * ks);
        const bf16_t* kb = skb + ((size_t)(hd * 2 + p) * 128 + j) * 128 + 8 * g;
        float sc[32]; unsigned kk[32];
#pragma unroll
        for (int kt = 0; kt < 8; ++kt) {
            f32x4_t a = (f32x4_t){0.f, 0.f, 0.f, 0.f};
#pragma unroll
            for (int ks = 0; ks < 4; ++ks) a = __builtin_amdgcn_mfma_f32_16x16x32_bf16(*(const bf16x8_t*)(kb + (size_t)kt * (16 * 128) + 32 * ks), qf[ks], a, 0, 0, 0);
#pragma unroll
            for (int r = 0; r < 4; ++r) { sc[kt * 4 + r] = a[r]; kk[kt * 4 + r] = (ord_key(a[r]) & ~127u) | (unsigned)(127 - (16 * kt + 4 * g + r)); }
        }
        const unsigned tau = bisect16<32>(kk);
        unsigned cnt = 0u;
#pragma unroll
        for (int i = 0; i < 32; ++i) cnt += (kk[i] >= tau) ? 1u : 0u;
        const unsigned c0 = (unsigned)__shfl((int)cnt, j), c1 = (unsigned)__shfl((int)cnt, j + 16), c2 = (unsigned)__shfl((int)cnt, j + 32);
        unsigned off = (g > 0 ? c0 : 0u) + (g > 1 ? c1 : 0u) + (g > 2 ? c2 : 0u);
        LAS float* ls = wl + p * 256 + j * 16;
        LAS float* li = wl + 512 + p * 256 + j * 16;
#pragma unroll
        for (int i = 0; i < 32; ++i) {
            if (kk[i] >= tau && off < 16u) { ls[off] = sc[i]; li[off] = __int_as_float(16 * (i >> 2) + 4 * g + (i & 3)); ++off; }
        }
    }
    asm volatile("s_waitcnt lgkmcnt(0)" ::: "memory");
    {
        float sA[4], sB[16]; int iA[4];
        {
            const f32x4_t a = *(const LAS f32x4_t*)(wl + j * 16 + 4 * g);
            const f32x4_t ai = *(const LAS f32x4_t*)(wl + 512 + j * 16 + 4 * g);
#pragma unroll
            for (int r = 0; r < 4; ++r) { sA[r] = a[r]; iA[r] = __float_as_int(ai[r]); }
#pragma unroll
            for (int q = 0; q < 4; ++q) { const f32x4_t b = *(const LAS f32x4_t*)(wl + 256 + j * 16 + 4 * q); sB[4 * q] = b[0]; sB[4 * q + 1] = b[1]; sB[4 * q + 2] = b[2]; sB[4 * q + 3] = b[3]; }
        }
        unsigned kk[64];
#pragma unroll
        for (int a = 0; a < 4; ++a)
#pragma unroll
            for (int b = 0; b < 16; ++b) kk[a * 16 + b] = (ord_key(sA[a] + sB[b]) & ~255u) | (unsigned)(255 - ((4 * g + a) * 16 + b));
        const unsigned tau = bisect16<64>(kk);
        float mx = -INFINITY; unsigned cnt = 0u;
#pragma unroll
        for (int i = 0; i < 64; ++i) if (kk[i] >= tau) { mx = fmaxf(mx, sA[i >> 4] + sB[i & 15]); ++cnt; }
        mx = xg_max_f32(mx);
        float es = 0.f;
#pragma unroll
        for (int i = 0; i < 64; ++i) if (kk[i] >= tau) es += __expf(sA[i >> 4] + sB[i & 15] - mx);
        const float inv = 1.0f / xg_sum_f32(es);
        const unsigned c0 = (unsigned)__shfl((int)cnt, j), c1 = (unsigned)__shfl((int)cnt, j + 16), c2 = (unsigned)__shfl((int)cnt, j + 32);
        unsigned off = (g > 0 ? c0 : 0u) + (g > 1 ? c1 : 0u) + (g > 2 ? c2 : 0u);
        int* idp = ids + (t0 + j) * 128 + hd * 16;
        float* gtp = gates + (t0 + j) * 128 + hd * 16;
        const LAS float* liB = wl + 512 + 256 + j * 16;
#pragma unroll
        for (int i = 0; i < 64; ++i) {
            if (kk[i] >= tau && off < 16u) {
                idp[off] = iA[i >> 4] * 128 + __float_as_int(liB[i & 15]);
                gtp[off] = __expf(sA[i >> 4] + sB[i & 15] - mx) * inv;
                ++off;
            }
        }
    }
}

__device__ __forceinline__ float wave_sum_dpp(float v) {
    v += __uint_as_float((unsigned)__builtin_amdgcn_update_dpp(0, (int)__float_as_uint(v), 0xB1, 0xF, 0xF, true));
    v += __uint_as_float((unsigned)__builtin_amdgcn_update_dpp(0, (int)__float_as_uint(v), 0x4E, 0xF, 0xF, true));
    v += __uint_as_float((unsigned)__builtin_amdgcn_update_dpp(0, (int)__float_as_uint(v), 0x141, 0xF, 0xF, true));
    v += __uint_as_float((unsigned)__builtin_amdgcn_update_dpp(0, (int)__float_as_uint(v), 0x140, 0xF, 0xF, true));
    const float a = __uint_as_float((unsigned)__builtin_amdgcn_readlane((int)__float_as_uint(v), 0)), b = __uint_as_float((unsigned)__builtin_amdgcn_readlane((int)__float_as_uint(v), 16)),
                c = __uint_as_float((unsigned)__builtin_amdgcn_readlane((int)__float_as_uint(v), 32)), d = __uint_as_float((unsigned)__builtin_amdgcn_readlane((int)__float_as_uint(v), 48));
    return (a + b) + (c + d);
}
typedef __bf16 bf16x2v_t __attribute__((ext_vector_type(2)));
__device__ __forceinline__ float wave_sum_all(float v) {
    v += __uint_as_float((unsigned)__builtin_amdgcn_update_dpp(0, (int)__float_as_uint(v), 0xB1, 0xF, 0xF, true));
    v += __uint_as_float((unsigned)__builtin_amdgcn_update_dpp(0, (int)__float_as_uint(v), 0x4E, 0xF, 0xF, true));
    v += __uint_as_float((unsigned)__builtin_amdgcn_update_dpp(0, (int)__float_as_uint(v), 0x141, 0xF, 0xF, true));
    v += __uint_as_float((unsigned)__builtin_amdgcn_update_dpp(0, (int)__float_as_uint(v), 0x140, 0xF, 0xF, true));
    auto a = __builtin_amdgcn_permlane16_swap(__float_as_uint(v), __float_as_uint(v), false, false); v = __uint_as_float(a[0]) + __uint_as_float(a[1]);
    auto b = __builtin_amdgcn_permlane32_swap(__float_as_uint(v), __float_as_uint(v), false, false); return __uint_as_float(b[0]) + __uint_as_float(b[1]);
}
__device__ __forceinline__ float dot16_fp8_bf16(const uint4 q, const uint4 xa, const uint4 xb, float d) {
    const unsigned w[4] = {q.x, q.y, q.z, q.w};
    const unsigned xw[8] = {xa.x, xa.y, xa.z, xa.w, xb.x, xb.y, xb.z, xb.w};
#pragma unroll
    for (int k = 0; k < 4; ++k) {
        const bf16x2v_t lo = __builtin_amdgcn_cvt_scalef32_pk_bf16_fp8(w[k], 1.0f, false), hi = __builtin_amdgcn_cvt_scalef32_pk_bf16_fp8(w[k], 1.0f, true);
        d = __builtin_amdgcn_fdot2_f32_bf16(lo, __builtin_bit_cast(bf16x2v_t, xw[2 * k]), d, false);
        d = __builtin_amdgcn_fdot2_f32_bf16(hi, __builtin_bit_cast(bf16x2v_t, xw[2 * k + 1]), d, false);
    }
    return d;
}
__device__ __forceinline__ void axpy16_fp8_pk(const uint4 q, const f32x2_t c2, f32x2_t* acc) {
    const unsigned w[4] = {q.x, q.y, q.z, q.w};
#pragma unroll
    for (int k = 0; k < 4; ++k) {
        const f32x2_t lo = __builtin_amdgcn_cvt_pk_f32_fp8((int)w[k], false), hi = __builtin_amdgcn_cvt_pk_f32_fp8((int)w[k], true);
        acc[2 * k] = __builtin_elementwise_fma(c2, lo, acc[2 * k]); acc[2 * k + 1] = __builtin_elementwise_fma(c2, hi, acc[2 * k + 1]);
    }
}
__device__ __forceinline__ float gelu_as(float v) {
    const float av = fabsf(v), t = __builtin_amdgcn_rcpf(av * 0.2316418882f + 1.0f);
    float q = t * 0.5307027145f + (-0.7265760135f); q = q * t + 0.7107068705f; q = q * t + (-0.142248368f); q = q * t + 0.127414796f; q = q * t;
    const float e = __builtin_amdgcn_exp2f((v * v) * (-0.72134752044f));
    const float m = v * (q * e);
    return v < 0.f ? m : v - m;
}
__device__ __forceinline__ void peer_sweep_wave(int gw, int lane, LAS unsigned char* wl, const bf16_t* __restrict__ h3, const float* __restrict__ x2, const int* __restrict__ ids,
                                                const float* __restrict__ gates, const unsigned char* __restrict__ ut8, const unsigned char* __restrict__ vt8, const float* __restrict__ rsc,
                                                const float* __restrict__ rstd, const float* __restrict__ g_final, float* __restrict__ out) {
    typedef unsigned u32x4_t __attribute__((ext_vector_type(4)));
    LAS unsigned short* xs = (LAS unsigned short*)wl;
    LAS unsigned* sorted = (LAS unsigned*)(wl + 16384);
    LAS unsigned* cnt = (LAS unsigned*)(wl + 16384 + 2048);
    LAS unsigned* base = (LAS unsigned*)(wl + 16384 + 2048 + 256);
    LAS unsigned short* gsv = (LAS unsigned short*)(wl + 16384 + 2048 + 512);
    const size_t t0 = (size_t)gw * 4;
#pragma unroll
    for (int tok = 0; tok < 4; ++tok)
#pragma unroll
        for (int c = 0; c < 4; ++c) {
            const uint4 v = *(const uint4*)(h3 + (t0 + tok) * D + c * 512 + lane * 8);
            *(LAS u32x4_t*)(xs + tok * 2048 + c * 512 + lane * 8) = (u32x4_t){v.x, v.y, v.z, v.w};
        }
    cnt[lane] = 0u;
    asm volatile("s_waitcnt lgkmcnt(0)" ::: "memory");
    unsigned key[8], rk[8]; unsigned short fv[8];
#pragma unroll
    for (int r = 0; r < 8; ++r) {
        const int n = r * 64 + lane;
        const unsigned e = (unsigned)ids[t0 * 128 + n];
        key[r] = (e << 9) | (unsigned)n | (__float_as_uint(rsc[e]) & 0x7F800000u);
        fv[r] = (unsigned short)f2bf(gates[t0 * 128 + n] * rsc[16384 + e]);
        rk[r] = __hip_atomic_fetch_add(&cnt[e >> 8], 1u, __ATOMIC_RELAXED, __HIP_MEMORY_SCOPE_WORKGROUP);
    }
    asm volatile("s_waitcnt lgkmcnt(0)" ::: "memory");
    {
        const unsigned c = cnt[lane];
        unsigned incl = c;
#pragma unroll
        for (int o = 1; o < 64; o <<= 1) { const unsigned t = (unsigned)__shfl_up((int)incl, o); if (lane >= o) incl += t; }
        base[lane] = incl - c;
    }
    asm volatile("s_waitcnt lgkmcnt(0)" ::: "memory");
#pragma unroll
    for (int r = 0; r < 8; ++r) { const unsigned pos = base[(key[r] >> 17) & 63u] + rk[r]; sorted[pos] = key[r]; gsv[pos] = fv[r]; }
    asm volatile("s_waitcnt lgkmcnt(0)" ::: "memory");
    float rs4[4];
#pragma unroll
    for (int tok = 0; tok < 4; ++tok) rs4[tok] = rstd[t0 + tok];
#define P1_LOAD(ENT, UQ, I0) _Pragma("unroll") for (int q = 0; q < 8; ++q) { \
            ENT[q] = (unsigned)__builtin_amdgcn_readfirstlane((int)sorted[(I0) + q]); \
            const unsigned char* ur = ut8 + (size_t)((ENT[q] >> 9) & 16383u) * 2048 + lane * 16; \
            UQ[q][0] = *(const uint4*)ur; UQ[q][1] = *(const uint4*)(ur + 1024); }
#define P1_COMP(ENT, UQ, I0) _Pragma("unroll") for (int h4 = 0; h4 < 8; h4 += 4) { float d[4]; \
            _Pragma("unroll") for (int q = 0; q < 4; ++q) { \
                const int tok = (ENT[h4 + q] >> 7) & 3; \
                const LAS unsigned short* xr = xs + tok * 2048 + lane * 16; \
                const u32x4_t a0 = *(const LAS u32x4_t*)xr, a1 = *(const LAS u32x4_t*)(xr + 8), b0 = *(const LAS u32x4_t*)(xr + 1024), b1 = *(const LAS u32x4_t*)(xr + 1032); \
                d[q] = dot16_fp8_bf16(UQ[h4 + q][0], make_uint4(a0[0], a0[1], a0[2], a0[3]), make_uint4(a1[0], a1[1], a1[2], a1[3]), 0.f); \
                d[q] = dot16_fp8_bf16(UQ[h4 + q][1], make_uint4(b0[0], b0[1], b0[2], b0[3]), make_uint4(b1[0], b1[1], b1[2], b1[3]), d[q]); } \
            _Pragma("unroll") for (int q = 0; q < 4; ++q) { \
                const float s = wave_sum_all(d[q]); \
                const unsigned e = (ENT[h4 + q] >> 9) & 16383u; const int n = ENT[h4 + q] & 511, tok = n >> 7; \
                const float rsv = tok == 0 ? rs4[0] : tok == 1 ? rs4[1] : tok == 2 ? rs4[2] : rs4[3]; \
                const float a = s * (__uint_as_float(ENT[h4 + q] & 0x7F800000u) * rsv); \
                const float cf = __uint_as_float((unsigned)gsv[(I0) + h4 + q] << 16) * gelu_as(a); \
                if (lane == 0) sorted[(I0) + h4 + q] = (e << 18) | ((unsigned)tok << 16) | f2bf(cf); } }
    {
        unsigned entA[8], entB[8]; uint4 uqA[8][2], uqB[8][2];
        P1_LOAD(entA, uqA, 0)
#pragma unroll 1
        for (int i = 0; i < 512; i += 16) {
            P1_LOAD(entB, uqB, i + 8)
            P1_COMP(entA, uqA, i)
            { const int nx = i + 16 < 512 ? i + 16 : 504; P1_LOAD(entA, uqA, nx) }
            P1_COMP(entB, uqB, i + 8)
        }
    }
#undef P1_LOAD
#undef P1_COMP
    asm volatile("s_waitcnt lgkmcnt(0)" ::: "memory");
    f32x2_t acc0[16], acc1[16], acc2[16], acc3[16];
#pragma unroll
    for (int k = 0; k < 16; ++k) { acc0[k] = (f32x2_t){0.f, 0.f}; acc1[k] = (f32x2_t){0.f, 0.f}; acc2[k] = (f32x2_t){0.f, 0.f}; acc3[k] = (f32x2_t){0.f, 0.f}; }
#ifndef P2N
#define P2N 2
#endif
#define P2_LOAD(ENT, VQ, I0) _Pragma("unroll") for (int q = 0; q < P2N; ++q) { \
            ENT[q] = (unsigned)__builtin_amdgcn_readfirstlane((int)sorted[(I0) + q]); \
            const unsigned char* vr = vt8 + (size_t)(ENT[q] >> 18) * 2048 + lane * 16; \
            VQ[q][0] = *(const uint4*)vr; VQ[q][1] = *(const uint4*)(vr + 1024); }
#define P2_COMP(ENT, VQ) _Pragma("unroll") for (int q = 0; q < P2N; ++q) { \
            const int tok = (ENT[q] >> 16) & 3; \
            const float cfs = __uint_as_float(ENT[q] << 16); \
            const f32x2_t c2 = (f32x2_t){cfs, cfs}; \
            if (tok == 0) { axpy16_fp8_pk(VQ[q][0], c2, acc0); axpy16_fp8_pk(VQ[q][1], c2, acc0 + 8); } \
            else if (tok == 1) { axpy16_fp8_pk(VQ[q][0], c2, acc1); axpy16_fp8_pk(VQ[q][1], c2, acc1 + 8); } \
            else if (tok == 2) { axpy16_fp8_pk(VQ[q][0], c2, acc2); axpy16_fp8_pk(VQ[q][1], c2, acc2 + 8); } \
            else { axpy16_fp8_pk(VQ[q][0], c2, acc3); axpy16_fp8_pk(VQ[q][1], c2, acc3 + 8); } }
    {
        unsigned entA[P2N], entB[P2N]; uint4 vqA[P2N][2], vqB[P2N][2];
        P2_LOAD(entA, vqA, 0)
#pragma unroll 1
        for (int i = 0; i < 512; i += 2 * P2N) {
            P2_LOAD(entB, vqB, i + P2N)
            P2_COMP(entA, vqA)
            { const int nx = i + 2 * P2N < 512 ? i + 2 * P2N : 512 - P2N; P2_LOAD(entA, vqA, nx) }
            P2_COMP(entB, vqB)
        }
    }
#undef P2_LOAD
#undef P2_COMP
    int l2 = lane; asm volatile("" : "+v"(l2));
#define PEER_EPI(tok, ACC) { \
        const bf16_t* xr = h3 + (t0 + tok) * D + l2 * 16; \
        float ss = 0.f; \
        _Pragma("unroll") for (int hh = 0; hh < 2; ++hh) _Pragma("unroll") for (int k = 0; k < 4; ++k) { \
            const uint2 xp = *(const uint2*)(xr + hh * 1024 + 4 * k); \
            const float4 xv = make_float4(__uint_as_float(xp.x << 16), __uint_as_float(xp.x & 0xFFFF0000u), __uint_as_float(xp.y << 16), __uint_as_float(xp.y & 0xFFFF0000u)); \
            f32x2_t a0 = ACC[hh * 8 + 2 * k], a1 = ACC[hh * 8 + 2 * k + 1]; \
            a0.x += xv.x; a0.y += xv.y; a1.x += xv.z; a1.y += xv.w; ACC[hh * 8 + 2 * k] = a0; ACC[hh * 8 + 2 * k + 1] = a1; \
            ss += (a0.x * a0.x + a0.y * a0.y) + (a1.x * a1.x + a1.y * a1.y); } \
        ss = wave_sum_dpp(ss); \
        const float r = rsqrtf(ss * (1.0f / D) + EPS); \
        float* orow = out + (t0 + tok) * D + l2 * 16; \
        _Pragma("unroll") for (int hh = 0; hh < 2; ++hh) _Pragma("unroll") for (int k = 0; k < 4; ++k) { \
            const float4 gv = *(const float4*)(g_final + hh * 1024 + l2 * 16 + 4 * k); \
            const f32x2_t a0 = ACC[hh * 8 + 2 * k], a1 = ACC[hh * 8 + 2 * k + 1]; \
            *(float4*)(orow + hh * 1024 + 4 * k) = make_float4(a0.x * r * gv.x, a0.y * r * gv.y, a1.x * r * gv.z, a1.y * r * gv.w); } }
    PEER_EPI(0, acc0) PEER_EPI(1, acc1) PEER_EPI(2, acc2) PEER_EPI(3, acc3)
#undef PEER_EPI
}

struct Params {
    const float *x, *mem, *g_mix, *w_in, *conv_w, *conv_b, *w_mq, *w_mk, *b_mi, *b_mf, *g_mhead, *g_ahead, *w_out, *g_cross, *g_mem,
                *w_xq, *w_xk, *w_xv, *w_xo, *g_ffn, *w_pq, *sub_keys, *u_tab, *v_tab, *g_final;
    float* out;
    unsigned* bar;
    float* ws;
};

#define PHASE_LOOP(nvb) for (int base_ = blockIdx.x * 2; base_ < (nvb); base_ += gridDim.x * 2)
#define VB (base_ + half)

__global__ void __launch_bounds__(NTHR) mega(Params P) {
    volatile LAS unsigned* st = (volatile LAS unsigned*)(LAS unsigned char*)(smem_raw + CTRL_OFF);
    if (threadIdx.x == 0) { st[0] = 0u; st[1] = 0u; st[2] = 0u; st[3] = 0u; }
    if (threadIdx.x < I_NPTR) ((LAS unsigned long long*)(LAS unsigned char*)(smem_raw + CTRL_OFF + 64))[threadIdx.x] = ((const unsigned long long*)&P)[threadIdx.x];
    __syncthreads();
    XcdBarrier xb = xcd_barrier_post((unsigned*)ldp_raw(I_BAR), st);

    constexpr size_t TD = (size_t)T * D;
    constexpr size_t O_HB = 6 * P6S * 2, O_CBUF = O_HB + (size_t)T * D * 2, O_MQ = O_CBUF + (size_t)T * 1024 * 2, O_MK = O_MQ + (size_t)T * 1024 * 2,
                     O_MIXB = O_MK + (size_t)T * 1024 * 2, O_WIN = O_MIXB + (size_t)T * D * 2, O_WOUT = O_WIN + (size_t)6144 * D * 2, O_WXQ = O_WOUT + (size_t)D * D * 2,
                     O_WXK = O_WXQ + (size_t)D * D * 2, O_WXV = O_WXK + (size_t)D * D * 2, O_WXO = O_WXV + (size_t)D * D * 2, O_WPQ = O_WXO + (size_t)D * D * 2,
                     O_WQK = O_WPQ + (size_t)D * D * 2, O_GPRE = O_WQK + (size_t)8 * 256 * 256 * 2, O_UT = O_GPRE + (size_t)T * 8 * 4, O_VT = O_UT + (size_t)16384 * D, O_RSC = O_VT + (size_t)16384 * D,
                     O_BH = O_RSC + (size_t)32768 * 4, O_GS = O_BH + (size_t)128 * 256 * 512 * 2, O_DENP = O_GS + (size_t)T * 4 * 8 * 4, O_QN = O_DENP + (size_t)T * 4 * 4 * 4,
                     O_DN = O_QN + (size_t)T * 4 * 4, O_DECAY = O_DN + (size_t)128 * 256 * 4, O_KB = O_DECAY + 4096, O_VB = O_KB + (size_t)12288 * 2048 * 2, O_CS = O_VB + (size_t)12288 * 2048 * 2, O_SKB = O_CS + (size_t)4096 * 64 * 8, O_RSSP = O_SKB + (size_t)262144 * 2, O_RSTD = O_RSSP + (size_t)T * 32 * 4, O_MN = O_RSTD + (size_t)T * 4, O_KVP = O_MN + (size_t)512 * D * 2, O_END = O_KVP + (size_t)2 * 512 * 4096 * 4;
    static_assert(O_END + 16384 <= (size_t)536870912, "workspace overflow");
#define W_P6    ((bf16_t*)wsb)
#define W_HB    ((bf16_t*)(wsb + O_HB))
#define W_CBUF  ((bf16_t*)(wsb + O_CBUF))
#define W_MQ    ((bf16_t*)(wsb + O_MQ))
#define W_MK    ((bf16_t*)(wsb + O_MK))
#define W_MIXB  ((bf16_t*)(wsb + O_MIXB))
#define W_GPRE  ((float*)(wsb + O_GPRE))
#define W_HRAW  ((float*)(wsb + O_HB))
#define W_XR    ((float*)wsb)
#define W_MN    ((bf16_t*)((float*)wsb + TD))
#define W_KM    ((bf16_t*)((float*)wsb + TD + (size_t)256 * D))
#define W_VMT   ((bf16_t*)((float*)wsb + TD + (size_t)768 * D))
#define W_PX    ((bf16_t*)(wsb + O_MK))
#define W_GATES ((float*)wsb + TD + (size_t)1280 * D)
#define W_IDS   ((int*)((float*)wsb + TD + (size_t)1280 * D + (size_t)T * 128))
#define W_QX    ((bf16_t*)(wsb + O_CBUF))
#define W_BH    ((bf16_t*)(wsb + O_BH))
#define W_KB    ((bf16_t*)(wsb + O_KB))
#define W_VB    ((bf16_t*)(wsb + O_VB))
#define W_CS    ((float2*)(wsb + O_CS))
#define W_SKB   ((bf16_t*)(wsb + O_SKB))
#define W_RSSP  ((float*)(wsb + O_RSSP))
#define W_RSTD  ((float*)(wsb + O_RSTD))
#define W_MN2   ((bf16_t*)(wsb + O_MN))
#define W_KVP   ((float*)(wsb + O_KVP))
#define W_GS    ((float*)(wsb + O_GS))
#define W_DENP  ((float*)(wsb + O_DENP))
#define W_QN    ((float*)(wsb + O_QN))
#define W_DN    ((float*)(wsb + O_DN))
#define W_DECAY ((float*)(wsb + O_DECAY))
#define W_PQ    ((bf16_t*)(wsb + O_HB))
#define W_KWT   ((bf16_t*)(wsb + O_CBUF))
#define W_DC    ((float*)(wsb + 3 * P6S * 2))
#define W_UT    ((unsigned char*)(wsb + O_UT))
#define W_VT    ((unsigned char*)(wsb + O_VT))
#define W_RSC   ((float*)(wsb + O_RSC))
#define PH_BEGIN() int tidx = threadIdx.x; asm volatile("" : "+v"(tidx)); const int half = tidx >> 8, tid = tidx & 255; float* sm = (float*)smem_raw + half * HALF_SM_FLOATS; \
                   char* wsb = (char*)ldp_raw(I_WS); (void)half; (void)tid; (void)sm; (void)wsb
#define GJOB_DEFAULT(g) pg8::GJob g; g.lda = D; g.ldb = D; g.K = D; g.nM = 32; g.nN = 8; g.a_pm_step = 256 * D; g.b_pn_mask = 0x7fffffff; g.b_pn_shift = 30; g.b_pn_step2 = 0; g.bid0 = 0; g.nblk = gridDim.x; g.a_pn_shift = 0; g.a_pn_mask = 0; g.a_pn_step = 0; g.b_pm_shift = 0; g.b_pm_step = 0; g.b_pn_step = 256 * D; \
                        g.ldc = D; g.R = nullptr; g.ldr = D; g.mode = 0; g.escale = 1.0f; g.gs = nullptr; g.denp = nullptr; g.qn = nullptr; g.gvec = nullptr; g.mo = nullptr; g.C2 = nullptr; g.rssp = nullptr; g.rstd = nullptr
#define GEMM_LDSP ((LAS unsigned char*)smem_raw)

    {
        PH_BEGIN();
        {
            LAS float* scr = (LAS float*)(LAS unsigned char*)(smem_raw) + (tidx >> 6) * (64 * 33);
            const int lane = tidx & 63;
            const int gw = blockIdx.x * 8 + (tidx >> 6), NGW = gridDim.x * 8;
            constexpr int I_IN = 32 * 192, I_SQ = 32 * 64, I_QK = 8 * 4 * 8;
            constexpr int NITEMS = I_IN + 6 * I_SQ + I_QK;
#pragma nounroll
            for (int it = gw; it < NITEMS; it += NGW) {
                const float* W; int ldw, K, csrc0, row0, kb; bf16_t* WT; float wscale = 1.0f; const float* kgain = nullptr;
                int r = it;
                if (r < I_IN) { const int nb = r % 192; kb = r / 192; W = PF(I_WIN); ldw = INC; K = D; csrc0 = nb * 32 + (nb >= 96 ? 8 : 0); WT = (bf16_t*)(wsb + O_WIN); row0 = nb * 32; }
                else if ((r -= I_IN) < 6 * I_SQ) {
                    const int wsel = r / I_SQ; r -= wsel * I_SQ; const int nb = r % 64; kb = r / 64; ldw = D; K = D; csrc0 = nb * 32; row0 = nb * 32;
                    W = PF(wsel == 0 ? I_WOUT : wsel == 1 ? I_WXQ : wsel == 2 ? I_WXK : wsel == 3 ? I_WXV : wsel == 4 ? I_WXO : I_WPQ);
                    WT = (bf16_t*)(wsb + O_WOUT + (size_t)wsel * ((size_t)D * D * 2));
                    if (wsel == 1) kgain = PF(I_GCROSS); else if (wsel == 5) kgain = PF(I_GFFN);
                } else {
                    r -= 6 * I_SQ; const int hq = r / 32; r -= hq * 32; const int nb = r % 8; kb = r / 8;
                    W = PF(hq < 4 ? I_WMQ : I_WMK) + (size_t)(hq & 3) * 65536; ldw = 256; K = 256; csrc0 = nb * 32; WT = (bf16_t*)(wsb + O_WQK); row0 = hq * 256 + nb * 32;
                    if (hq >= 4) wscale = 0.0625f;
                }
                p0_transpose_item(W, ldw, K, csrc0, WT, row0, scr, kb, lane, wscale, kgain);
            }
            {
                const float* ut = PF(I_UTAB); const float* vt = PF(I_VTAB); const float* gffn = PF(I_GFFN);
#pragma nounroll
                for (int row = gw; row < 32768; row += NGW) {
                    const bool second = row >= 16384; const int rr = second ? row - 16384 : row;
                    table_row_to_fp8((second ? vt : ut) + (size_t)rr * D, (second ? W_VT : W_UT) + (size_t)rr * D, W_RSC + row, lane, second ? nullptr : gffn);
                }
            }
            rope_table_fill(W_CS, blockIdx.x * NTHR + tidx, gridDim.x * NTHR);
            {
                const float* sk = PF(I_SUBK);
#pragma nounroll
                for (int i = blockIdx.x * NTHR + tidx; i < 262144 / 8; i += gridDim.x * NTHR) {
                    const float4 a = *(const float4*)(sk + (size_t)i * 8), b = *(const float4*)(sk + (size_t)i * 8 + 4);
                    uint4 o; o.x = pk2(a.x, a.y); o.y = pk2(a.z, a.w); o.z = pk2(b.x, b.y); o.w = pk2(b.z, b.w);
                    *(uint4*)(W_SKB + (size_t)i * 8) = o;
                }
            }
            __syncthreads();
        }
        {
            const float* rin = PF(I_X); const float* rg = PF(I_GMIX); const float* win = PF(I_WIN);
            float* gwl = (float*)smem_raw + 1024;
            for (int k = tidx; k < 2048; k += NTHR) { const float4 a = *(const float4*)(win + (size_t)k * INC + C_MI), b = *(const float4*)(win + (size_t)k * INC + C_MI + 4);
                *(float4*)(gwl + k * 8) = a; *(float4*)(gwl + k * 8 + 4) = b; }
            __syncthreads();
            float* red = (float*)smem_raw + half * 256;
#pragma nounroll
            PHASE_LOOP(T) d_rmsnorm(VB, tid, red, rin, rg, W_HB, gwl, W_GPRE);
            const float* min_ = PF(I_MEM); const float* mg = PF(I_GMEM);
#pragma nounroll
            PHASE_LOOP(512) d_rmsnorm(VB, tid, red, min_, mg, W_MN2, nullptr, nullptr);
        }
    }
    xcd_barrier(xb);
    {
        PH_BEGIN();
        GJOB_DEFAULT(g); g.A = W_HB; g.Bt = (bf16_t*)(wsb + O_WIN); g.nN = 24; g.C = (float*)W_P6; g.ldc = 1024;
        pg8::gemm_phase<4>(GEMM_LDSP, g, tidx);
    }
    xcd_barrier(xb);
    {
        PH_BEGIN();
        const float* cw = PF(I_CONVW); const float* cb = PF(I_CONVB);
#pragma nounroll
        PHASE_LOOP(T) d_conv_silu(VB, tid, W_P6, cw, cb, W_CBUF);
        rope_q_pass(W_P6 + 3 * P6S, W_CS, (size_t)blockIdx.x * NTHR + tidx, (size_t)gridDim.x * NTHR);
        {
            LAS unsigned short* wl = (LAS unsigned short*)(LAS unsigned char*)smem_raw + (tidx >> 6) * (16 * 136);
#pragma nounroll
            for (int item = blockIdx.x * 8 + (tidx >> 6); item < 12288; item += gridDim.x * 8) dil_tile_prep(item, tidx & 63, wl, W_P6 + 4 * P6S, W_P6 + 5 * P6S, W_CS, W_KB, W_VB);
            __syncthreads();
        }
        if (blockIdx.x < 8 && tidx < 64) mlstm_gates_wave(blockIdx.x >> 2, blockIdx.x & 3, tidx, W_GPRE, PF(I_BMI), PF(I_BMF), W_GS, W_DECAY);
#pragma nounroll
        PHASE_LOOP(2048) { const int it = VB, lt = it & 3, et = (it >> 2) & 3, h = (it >> 4) & 3, cg = it >> 6;
            transpose_tile64(tid, sm, W_P6 + P6S + (size_t)(cg * 256 + lt * 64) * 1024 + h * 256 + et * 64, 1024, W_BH + ((size_t)(cg * 4 + h) * 256 + et * 64) * 512 + lt * 64, 512, nullptr, 0); }
    }
    xcd_barrier(xb);
    {
        PH_BEGIN();
        {
            GJOB_DEFAULT(g); g.A = W_CBUF; g.lda = 1024; g.a_pm_step = 256 * 1024; g.Bt = (bf16_t*)(wsb + O_WQK); g.ldb = 256; g.b_pn_step = 256 * 256; g.K = 256; g.a_pn_mask = 3; g.a_pn_step = 256; g.C = (float*)W_MQ; g.ldc = 1024;
            pg8::gemm_phase<4>(GEMM_LDSP, g, tidx);
            __syncthreads();
        }
        const float* ga = PF(I_GAHEAD);
#pragma nounroll
        for (int qt = blockIdx.x * 8 + (tidx >> 6); qt < 4096; qt += gridDim.x * 8) dilated_wave_tile(qt, tidx & 63, W_P6 + 3 * P6S, W_KB, W_VB, ga, W_MIXB);
    }
    xcd_barrier(xb);
    {
        PH_BEGIN();
#pragma nounroll
        PHASE_LOOP(2048) { const int it = VB, lt = it & 3, dt = (it >> 2) & 3, h = (it >> 4) & 3, cg = it >> 6;
            transpose_tile64(tid, sm, W_MK + (size_t)(cg * 256 + lt * 64) * 1024 + h * 256 + dt * 64, 1024, W_KWT + ((size_t)(cg * 4 + h) * 256 + dt * 64) * 256 + lt * 64, 256,
                             W_GS + ((size_t)(cg * 256 + lt * 64) * 4 + h) * 8 + 2, 32); }
        {
            const size_t nth = (size_t)gridDim.x * NTHR;
#pragma nounroll
            for (size_t i = (size_t)blockIdx.x * NTHR + tidx; i < (size_t)T * 128; i += nth) {
                const size_t t = i >> 7; const int c8 = (int)(i & 127) * 8, h = c8 >> 8, d = c8 & 255;
                const float sc = W_GS[(t * 4 + h) * 8 + 3];
                const uint4 v = *(const uint4*)(W_MQ + t * 1024 + c8);
                uint4 o;
                o.x = pk2(bf2f((unsigned short)(v.x & 0xFFFFu)) * sc, bf2f((unsigned short)(v.x >> 16)) * sc); o.y = pk2(bf2f((unsigned short)(v.y & 0xFFFFu)) * sc, bf2f((unsigned short)(v.y >> 16)) * sc);
                o.z = pk2(bf2f((unsigned short)(v.z & 0xFFFFu)) * sc, bf2f((unsigned short)(v.z >> 16)) * sc); o.w = pk2(bf2f((unsigned short)(v.w & 0xFFFFu)) * sc, bf2f((unsigned short)(v.w >> 16)) * sc);
                *(uint4*)(W_PQ + t * 2048 + h * 512 + 256 + d) = o;
            }
        }
#pragma nounroll
        PHASE_LOOP(128) { const int cgh = VB, cg = cgh >> 2, h = cgh & 3;
            float a = 0.f;
            for (int l = 0; l < 256; ++l) { const size_t t = (size_t)cg * 256 + l; a = fmaf(W_GS[(t * 4 + h) * 8 + 2], bf2f(W_MK[t * 1024 + h * 256 + tid]), a); }
            W_DN[(size_t)cgh * 256 + tid] = a; }
        __syncthreads();
        {
            GJOB_DEFAULT(g); g.A = W_MQ; g.lda = 1024; g.a_pm_step = 256 * 1024; g.a_pn_mask = 3; g.a_pn_step = 256; g.K = 256; g.nN = 4;
            g.Bt = W_MK; g.ldb = 1024; g.b_pn_step = 256; g.b_pm_step = 256 * 1024; g.C = (float*)W_PQ; g.gs = W_GS; g.denp = W_DENP;
            pg8::gemm_phase<6>(GEMM_LDSP, g, tidx);
        }
    }
    xcd_barrier(xb);
    {
        PH_BEGIN();
        GJOB_DEFAULT(g); g.A = W_BH; g.lda = 512; g.a_pm_step = 4 * 256 * 512; g.a_pn_mask = 3; g.a_pn_step = 256 * 512; g.K = 256; g.nN = 4;
        g.Bt = W_KWT; g.ldb = 256; g.b_pn_step = 65536; g.b_pm_step = 4 * 65536; g.C = W_DC;
        pg8::gemm_phase<7>(GEMM_LDSP, g, tidx);
    }
    xcd_barrier(xb);
    {
        PH_BEGIN();
        {
#pragma nounroll
            for (int gid = blockIdx.x * NTHR + tidx; gid < 131072; gid += gridDim.x * NTHR) {
                const int bh = gid >> 14, b = bh >> 2, h = bh & 3, e = (gid >> 6) & 255, d = (gid & 63) * 4;
                float4 C = make_float4(0.f, 0.f, 0.f, 0.f);
#pragma unroll 4
                for (int c = 0; c < 16; ++c) {
                    const int cgh = (b * 16 + c) * 4 + h;
                    uint2 o; o.x = pk2(C.x, C.y); o.y = pk2(C.z, C.w);
                    *(uint2*)(W_BH + ((size_t)cgh * 256 + e) * 512 + 256 + d) = o;
                    const float dec = W_DECAY[cgh];
                    const float4 dc = *(const float4*)(W_DC + ((size_t)cgh * 256 + e) * 256 + d);
                    C.x = fmaf(dec, C.x, dc.x); C.y = fmaf(dec, C.y, dc.y); C.z = fmaf(dec, C.z, dc.z); C.w = fmaf(dec, C.w, dc.w);
                }
            }
        }
#pragma nounroll
        PHASE_LOOP(128) { const int cgh = VB, cg = cgh >> 2, h = cgh & 3, b = cg >> 4, c = cg & 15;
            float n = 0.f;
            for (int cc = 0; cc < c; ++cc) { const int j = (b * 16 + cc) * 4 + h; n = fmaf(W_DECAY[j], n, W_DN[(size_t)j * 256 + tid]); }
            __syncthreads();
            sm[tid] = n;
            __syncthreads();
            const int lane = tid & 63, w = tid >> 6;
            const float4 nv = *(const float4*)(sm + lane * 4);
            for (int i = 0; i < 64; ++i) {
                const size_t t = (size_t)cg * 256 + w * 64 + i;
                const ushort4 q4 = *(const ushort4*)(W_MQ + t * 1024 + h * 256 + lane * 4);
                float s = bf2f(q4.x) * nv.x + bf2f(q4.y) * nv.y + bf2f(q4.z) * nv.z + bf2f(q4.w) * nv.w;
                s = wave_sum(s);
                if (lane == 0) W_QN[t * 4 + h] = s;
            }
        }
    }
    xcd_barrier(xb);
    {
        PH_BEGIN();
        GJOB_DEFAULT(g); g.A = W_PQ; g.a_pn_mask = 3; g.a_pn_step = 512; g.K = 512; g.nN = 4;
        g.Bt = W_BH; g.ldb = 512; g.b_pn_step = 256 * 512; g.b_pm_step = 4 * 256 * 512; g.C = (float*)W_MIXB;
        g.gs = W_GS; g.denp = W_DENP; g.qn = W_QN; g.gvec = PF(I_GMHEAD); g.mo = W_P6 + 2 * P6S; g.nblk = 128;
        if (blockIdx.x < 128) pg8::gemm_phase<8>(GEMM_LDSP, g, tidx);
        else {
            GJOB_DEFAULT(k); k.A = W_MN2; k.K = 1024; k.nM = 2; k.nN = 32; k.a_pn_shift = 4; k.a_pn_mask = 1; k.a_pn_step = 1024;
            k.Bt = (bf16_t*)(wsb + O_WXK); k.b_pn_mask = 15; k.b_pn_shift = 4; k.b_pn_step2 = 1024; k.C = W_KVP; k.bid0 = 128; k.nblk = 128;
            pg8::gemm_phase<12>(GEMM_LDSP, k, tidx);
        }
    }
    xcd_barrier(xb);
    {
        PH_BEGIN();
        for (int i = blockIdx.x * NTHR + tidx; i < 512 * 4096 / 4; i += gridDim.x * NTHR) {
            const int r = i >> 10, c = (i & 1023) * 4;
            const float4 a = *(const float4*)(W_KVP + (size_t)r * 4096 + c), b = *(const float4*)(W_KVP + (size_t)512 * 4096 + (size_t)r * 4096 + c);
            const float v0 = a.x + b.x, v1 = a.y + b.y, v2 = a.z + b.z, v3 = a.w + b.w;
            if (c < 2048) { uint2 o; o.x = pk2(v0, v1); o.y = pk2(v2, v3); *(uint2*)(W_KM + (size_t)r * 2048 + c) = o; }
            else { bf16_t* d = W_VMT + (size_t)(c - 2048) * 512 + r; d[0] = (bf16_t)f2bf(v0); d[512] = (bf16_t)f2bf(v1); d[1024] = (bf16_t)f2bf(v2); d[1536] = (bf16_t)f2bf(v3); }
        }
        GJOB_DEFAULT(g); g.A = W_MIXB; g.Bt = (bf16_t*)(wsb + O_WOUT); g.R = PF(I_X); g.C2 = W_HB; g.rssp = W_RSSP;
        pg8::gemm_phase<10>(GEMM_LDSP, g, tidx);
    }
    xcd_barrier(xb);
    {
        PH_BEGIN();
        {
            GJOB_DEFAULT(g); g.A = W_HB; g.Bt = (bf16_t*)(wsb + O_WXQ); g.C = (float*)W_QX;
            pg8::Unit u0;
            if (pg8::unit_next(g, 0, u0) && tidx < 256) { const size_t r = (size_t)u0.pm * 256 + tidx; float s = 0.f; for (int k = 0; k < 32; ++k) s += W_RSSP[r * 32 + k];
                ((LAS float*)(LAS unsigned char*)(smem_raw + GEMM_LDS + 1024 + 8192))[tidx] = rsqrtf(s * (1.0f / D) + EPS); }
            __syncthreads();
            pg8::gemm_phase<11>(GEMM_LDSP, g, tidx); __syncthreads();
        }

    }
    xcd_barrier(xb);
    {
        PH_BEGIN();
        GJOB_DEFAULT(g); g.A = W_QX; g.K = 512; g.a_pn_mask = 3; g.a_pn_step = 512; g.Bt = W_KM; g.b_pn_step = 512; g.b_pm_shift = 4; g.b_pm_step = 256 * D; g.nN = 4;
        g.C = (float*)W_PX; g.ldc = 1024; g.escale = 0.04419417382415922f * 1.4426950408889634f;
        pg8::gemm_phase<5>(GEMM_LDSP, g, tidx);
    }
    xcd_barrier(xb);
    {
        PH_BEGIN();
        GJOB_DEFAULT(g); g.A = W_PX; g.lda = 1024; g.a_pm_step = 256 * 1024; g.K = 256; g.a_pn_shift = 1; g.a_pn_mask = 3; g.a_pn_step = 256; g.Bt = W_VMT; g.ldb = 512; g.b_pn_step = 256 * 512; g.b_pm_shift = 4; g.b_pm_step = 256;
        g.C = (float*)W_MIXB;
        pg8::gemm_phase<3>(GEMM_LDSP, g, tidx);
    }
    xcd_barrier(xb);
    {
        PH_BEGIN();
        GJOB_DEFAULT(g); g.A = W_MIXB; g.Bt = (bf16_t*)(wsb + O_WXO); g.R = nullptr; g.C2 = W_HB; g.rssp = W_RSSP;
        pg8::gemm_phase<10>(GEMM_LDSP, g, tidx);
    }
    xcd_barrier(xb);
    {
        PH_BEGIN();
        GJOB_DEFAULT(g); g.A = W_HB; g.Bt = (bf16_t*)(wsb + O_WPQ); g.C = (float*)W_QX;
        pg8::Unit u0;
        if (pg8::unit_next(g, 0, u0) && tidx < 256) { const size_t r = (size_t)u0.pm * 256 + tidx; float s = 0.f; for (int k = 0; k < 32; ++k) s += W_RSSP[r * 32 + k];
            const float rs = rsqrtf(s * (1.0f / D) + EPS);
            ((LAS float*)(LAS unsigned char*)(smem_raw + GEMM_LDS + 1024 + 8192))[tidx] = rs; W_RSTD[r] = rs; }
        __syncthreads();
        pg8::gemm_phase<11>(GEMM_LDSP, g, tidx);
    }
    xcd_barrier(xb);
    {
        PH_BEGIN();
        LAS float* wl = (LAS float*)(LAS unsigned char*)smem_raw + (tidx >> 6) * 1024;
#pragma nounroll
        for (int item = blockIdx.x * 8 + (tidx >> 6); item < 4096; item += gridDim.x * 8) peer_topk_wave2(item, tidx & 63, wl, W_QX, W_SKB, W_IDS, W_GATES);
    }
    xcd_barrier(xb);
    {
        PH_BEGIN();
        const float* gf = PF(I_GFINAL); float* outp = (float*)ldp_raw(I_OUT);
        LAS unsigned char* wl = (LAS unsigned char*)smem_raw + (tidx >> 6) * 19968;
#pragma nounroll
        for (int gw = blockIdx.x * 8 + (tidx >> 6); gw < T / 4; gw += gridDim.x * 8) { int ln = tidx & 63; asm volatile("" : "+v"(ln));
            peer_sweep_wave(gw, ln, wl, W_HB, W_XR, W_IDS, W_GATES, W_UT, W_VT, W_RSC, W_RSTD, gf, outp); }
    }
}
}

extern "C" void kernel_launch(void* const* d_in, const int* in_sizes, int n_in, void* d_out, int out_size, void* d_ws, size_t ws_size, hipStream_t stream) {
    static int grid_blocks = 0;
    if (!grid_blocks) {
        int dev = 0, cus = 0, per_cu = 0;
        hipGetDevice(&dev);
        hipDeviceGetAttribute(&cus, hipDeviceAttributeMultiprocessorCount, dev);
        hipFuncSetAttribute((const void*)mega, hipFuncAttributeMaxDynamicSharedMemorySize, SMEM_BYTES);
        hipOccupancyMaxActiveBlocksPerMultiprocessor(&per_cu, mega, NTHR, SMEM_BYTES);
        if (per_cu > 1) per_cu = 1;
        if (per_cu < 1) per_cu = 1;
        grid_blocks = cus * per_cu;
    }
    Params P{};
    const float** pp = (const float**)&P;
    for (int i = 0; i < 25; ++i) pp[i] = (const float*)d_in[i];
    P.out = (float*)d_out;
    P.bar = (unsigned*)d_ws;
    P.ws = (float*)((char*)d_ws + 16384);
    hipMemsetAsync(d_ws, 0, 16384, stream);
    void* args[] = {&P};
    hipError_t e = hipLaunchCooperativeKernel((const void*)mega, dim3(grid_blocks), dim3(NTHR), args, SMEM_BYTES, stream);
    if (e != hipSuccess) fprintf(stderr, "cooperative launch failed: %s (grid %d)\n", hipGetErrorString(e), grid_blocks);
}
```

```cpp
#include <hip/hip_runtime.h>
#include <stdint.h>
#include <math.h>
#include <cstdio>

#define LAS_ __attribute__((address_space(3)))
namespace {
constexpr int D = 2048, NB = 2, S = 4096, T = NB * S;
constexpr int INC = 6152;
constexpr int C_MIN = 0, C_MV = 1024, C_MO = 2048, C_MI = 3072, C_MF = 3076, C_AQ = 3080, C_AK = 4104, C_AV = 5128;
constexpr float EPS = 1e-6f;
constexpr size_t P6S = (size_t)8192 * 1024;
constexpr int NTHR = 512;
constexpr int HALF_SM_FLOATS = 8704;
constexpr int GEMM_LDS = 131072;
constexpr int SMEM_BYTES = 163840;
constexpr int CTRL_OFF = SMEM_BYTES - 1024;
typedef unsigned short bf16_t;
__device__ __forceinline__ unsigned f2bf(float f) { unsigned u = __float_as_uint(f); u += 0x7FFFu + ((u >> 16) & 1u); return u >> 16; }
__device__ __forceinline__ unsigned pk2(float lo, float hi) { return f2bf(lo) | (f2bf(hi) << 16); }
__device__ __forceinline__ float bf2f(unsigned short b) { return __uint_as_float(((unsigned)b) << 16); }
extern __shared__ __attribute__((aligned(16))) unsigned char smem_raw[];
enum { I_X = 0, I_MEM, I_GMIX, I_WIN, I_CONVW, I_CONVB, I_WMQ, I_WMK, I_BMI, I_BMF, I_GMHEAD, I_GAHEAD, I_WOUT, I_GCROSS, I_GMEM,
       I_WXQ, I_WXK, I_WXV, I_WXO, I_GFFN, I_WPQ, I_SUBK, I_UTAB, I_VTAB, I_GFINAL, I_OUT, I_BAR, I_WS, I_NPTR };
__device__ __forceinline__ unsigned long long ldp_raw(int i) {
    const LAS_ unsigned long long* tab = (const LAS_ unsigned long long*)(LAS_ unsigned char*)(smem_raw + CTRL_OFF + 64);
    const unsigned long long v = tab[i];
    const unsigned lo = __builtin_amdgcn_readfirstlane((unsigned)v), hi = __builtin_amdgcn_readfirstlane((unsigned)(v >> 32));
    return ((unsigned long long)hi << 32) | lo;
}
#define PF(i) ((const float*)ldp_raw(i))

#define XB_TMO      128
#define XB_XCNT(j)  (256  + 64 * (j))
#define XB_XSUB(j)  (1280 + 64 * (j))
#define XB_XGEN(j)  (2304 + 64 * (j))
#define XB_TOP      3328
#define XB_TOPGEN   3392
#define XCD_BAR_WORDS 3456
#define XB_SPIN_CAP (1u << 22)
#define LAS __attribute__((address_space(3)))

__device__ __forceinline__ unsigned xb_ld(unsigned* p)              { return __hip_atomic_load(p, __ATOMIC_RELAXED, __HIP_MEMORY_SCOPE_AGENT); }
__device__ __forceinline__ unsigned xb_add(unsigned* p, unsigned v) { return __hip_atomic_fetch_add(p, v, __ATOMIC_RELAXED, __HIP_MEMORY_SCOPE_AGENT); }
__device__ __forceinline__ unsigned xb_xcc_id() { return (unsigned)__builtin_amdgcn_s_getreg((3 << 11) | 20) & 0xFu; }
#define XB_SPIN(cond, bar) do { unsigned _sp = 0; while (cond) { __builtin_amdgcn_s_sleep(1); \
    if ((++_sp & 255u) == 0u) { if (xb_ld(&(bar)[XB_TMO])) break; if (_sp > XB_SPIN_CAP) { atomicAdd(&(bar)[XB_TMO], 1u); break; } } } } while (0)

struct XcdBarrier { unsigned* bar; unsigned x; volatile LAS unsigned* st; };

__device__ __forceinline__ XcdBarrier xcd_barrier_post(unsigned* bar, volatile LAS unsigned* st) {
    XcdBarrier b; b.bar = bar; b.x = xb_xcc_id(); b.st = st;
    if (threadIdx.x == 0) (void)xb_add(&bar[XB_XCNT(b.x)], 1u);
    return b;
}
__device__ __forceinline__ void xcd_barrier_complete(unsigned* bar, unsigned x, unsigned& nloc, unsigned& nx) {
    const unsigned G = gridDim.x * gridDim.y * gridDim.z;
    unsigned sum, cnt, mine, sp = 0u;
    for (;;) {
        sum = 0u; cnt = 0u; mine = 0u;
#pragma unroll
        for (unsigned j = 0; j < 16; ++j) { const unsigned c = xb_ld(&bar[XB_XCNT(j)]); sum += c; cnt += (c > 0u) ? 1u : 0u; mine = (j == x) ? c : mine; }
        if (sum == G) break;
        __builtin_amdgcn_s_sleep(1);
        if ((++sp & 255u) == 0u) { if (xb_ld(&bar[XB_TMO])) break; if (sp > XB_SPIN_CAP) { atomicAdd(&bar[XB_TMO], 1u); break; } }
    }
    nloc = mine > 0u ? mine : 1u; nx = cnt > 0u ? cnt : 1u;
}
__device__ __forceinline__ void xcd_barrier(const XcdBarrier& b) {
    asm volatile("s_waitcnt vmcnt(0)" ::: "memory");
    __syncthreads();
    if (threadIdx.x == 0) {
        unsigned* bar = b.bar;
        __builtin_amdgcn_s_waitcnt(0);
        unsigned nloc = b.st[0], nx = b.st[1];
        if (nloc == 0u) { xcd_barrier_complete(bar, b.x, nloc, nx); b.st[0] = nloc; b.st[1] = nx; }
        const unsigned old = xb_add(&bar[XB_XSUB(b.x)], 1u);
        const unsigned gen = old / nloc;
        if (old + 1u == (gen + 1u) * nloc) {
            __builtin_amdgcn_fence(__ATOMIC_RELEASE, "agent");
            asm volatile("s_waitcnt vmcnt(0)" ::: "memory");
            const unsigned og = xb_add(&bar[XB_TOP], 1u);
            const unsigned tg = og / nx;
            if (og + 1u == (tg + 1u) * nx) xb_add(&bar[XB_TOPGEN], 1u);
            else XB_SPIN(xb_ld(&bar[XB_TOPGEN]) == tg, bar);
            __builtin_amdgcn_fence(__ATOMIC_ACQUIRE, "agent");
            xb_add(&bar[XB_XGEN(b.x)], 1u);
            asm volatile("s_waitcnt vmcnt(0)" ::: "memory");
        } else {
            XB_SPIN(xb_ld(&bar[XB_XGEN(b.x)]) == gen, bar);
            __builtin_amdgcn_fence(__ATOMIC_ACQUIRE, "agent");
            asm volatile("s_waitcnt vmcnt(0)" ::: "memory");
        }
    }
    __syncthreads();
}

__device__ __forceinline__ float wave_sum(float v) {
#pragma unroll
    for (int o = 32; o >= 1; o >>= 1) v += __shfl_xor(v, o);
    return v;
}
__device__ __forceinline__ float wave_max(float v) {
#pragma unroll
    for (int o = 32; o >= 1; o >>= 1) v = fmaxf(v, __shfl_xor(v, o));
    return v;
}
__device__ __forceinline__ float log_sigmoid(float x) { return fminf(x, 0.f) - log1pf(expf(-fabsf(x))); }


__device__ __forceinline__ void d_rmsnorm(int vb, int t, float* sm, const float* __restrict__ in, const float* __restrict__ g, bf16_t* __restrict__ out,
                                          const float* gwl  , float* __restrict__ gpre) {
    float* red = sm;
    const int row = vb;
    const float4* p = (const float4*)(in + (size_t)row * D);
    float4 a = p[t], b = p[t + 256];
    float s = a.x * a.x + a.y * a.y + a.z * a.z + a.w * a.w + b.x * b.x + b.y * b.y + b.z * b.z + b.w * b.w;
    s = wave_sum(s);
    __syncthreads();
    if ((t & 63) == 0) red[t >> 6] = s;
    __syncthreads();
    const float tot = red[0] + red[1] + red[2] + red[3];
    const float r = rsqrtf(tot * (1.0f / D) + EPS);
    const float4* gp = (const float4*)g;
    float4 ga = gp[t], gb = gp[t + 256];
    float hv[8] = {a.x * r * ga.x, a.y * r * ga.y, a.z * r * ga.z, a.w * r * ga.w, b.x * r * gb.x, b.y * r * gb.y, b.z * r * gb.z, b.w * r * gb.w};
    uint2 o0, o1;
    o0.x = pk2(hv[0], hv[1]); o0.y = pk2(hv[2], hv[3]); o1.x = pk2(hv[4], hv[5]); o1.y = pk2(hv[6], hv[7]);
    *(uint2*)(out + (size_t)row * D + t * 4) = o0;
    *(uint2*)(out + (size_t)row * D + 1024 + t * 4) = o1;
    if (gpre) {
        float gs[8];
#pragma unroll
        for (int c = 0; c < 8; ++c) gs[c] = 0.f;
#pragma unroll
        for (int j = 0; j < 8; ++j) {
            const int k = (j < 4) ? (t * 4 + j) : (1024 + t * 4 + (j - 4));
            const float4 w0 = *(const float4*)(gwl + k * 8), w1 = *(const float4*)(gwl + k * 8 + 4);
            gs[0] = fmaf(hv[j], w0.x, gs[0]); gs[1] = fmaf(hv[j], w0.y, gs[1]); gs[2] = fmaf(hv[j], w0.z, gs[2]); gs[3] = fmaf(hv[j], w0.w, gs[3]);
            gs[4] = fmaf(hv[j], w1.x, gs[4]); gs[5] = fmaf(hv[j], w1.y, gs[5]); gs[6] = fmaf(hv[j], w1.z, gs[6]); gs[7] = fmaf(hv[j], w1.w, gs[7]);
        }
#pragma unroll
        for (int c = 0; c < 8; ++c) gs[c] = wave_sum(gs[c]);
        __syncthreads();
        if ((t & 63) == 0) {
#pragma unroll
            for (int c = 0; c < 8; ++c) red[8 + (t >> 6) * 8 + c] = gs[c];
        }
        __syncthreads();
        if (t < 8) gpre[(size_t)row * 8 + t] = red[8 + t] + red[16 + t] + red[24 + t] + red[32 + t];
    }
}

namespace pg8 {
typedef short bf16x8 __attribute__((ext_vector_type(8)));
typedef float f32x4 __attribute__((ext_vector_type(4)));
constexpr int BM = 256, BK = 64, HALF = 128, HTB = HALF * BK * 2, NXCD = 8, WGM = 8;
__device__ __forceinline__ int lds_byte(int r, int c) { const int st = (r >> 4) * 2 + (c >> 5), rr = r & 15, cc = c & 31, ob = rr * 64 + cc * 2; return st * 1024 + (ob ^ (((ob >> 9) & 1) << 5)); }
__device__ __forceinline__ void stage_rc(int b, int& R, int& C) { const int st = b / 1024, sb = b % 1024, swz = sb ^ (((sb >> 9) & 1) << 5); R = (st >> 1) * 16 + swz / 64; C = (st & 1) * 32 + (swz % 64) / 2; }
struct Unit { int pm, pn; };
struct GJob {
    const bf16_t* A; const bf16_t* Bt;
    int lda, ldb, K, nM, nN;
    int a_pn_shift, a_pn_mask, a_pn_step;
    int b_pm_shift, b_pm_step, b_pn_step;
    int a_pm_step;
    int b_pn_mask, b_pn_shift, b_pn_step2;
    int bid0, nblk;
    float escale;
    const float* gs; float* denp; const float* qn; const float* gvec; const bf16_t* mo;
    bf16_t* C2; float* rssp; const float* rstd;
    float* C; int ldc; const float* R; int ldr;
    int mode;
};
__device__ __forceinline__ bool unit_next(const GJob& g, int i, Unit& u) {
    const int nwg = g.nM * g.nN;
    const int bid = (int)blockIdx.x - g.bid0; if (bid < 0 || bid >= g.nblk) return false;
    const long L = (long)i * g.nblk + bid; if (L >= nwg) return false;
    int wgid = (int)L; { const int q = nwg / NXCD, r = nwg % NXCD, xcd = wgid % NXCD, off = wgid / NXCD; wgid = (xcd < r ? xcd * (q + 1) : r * (q + 1) + (xcd - r) * q) + off; }
    const int nig = WGM * g.nN, gid = wgid / nig, fm = gid * WGM, gsz = (g.nM - fm) < WGM ? (g.nM - fm) : WGM;
    u.pm = fm + ((wgid % nig) % gsz); u.pn = (wgid % nig) / gsz; return true;
}
template <int MODE> __device__ __forceinline__ void epilogue(const GJob& g, f32x4 (&acc)[2][2][4][2], const Unit& u, int wr, int wc, int fr, int fq, LAS unsigned char* xlds) {
    const int row0 = u.pm * BM + wr * 64 + fr;
    if constexpr (MODE == 0) {
        const int col0 = u.pn * BM + wc * 32 + 4 * fq;
#pragma unroll
        for (int ai = 0; ai < 2; ++ai)
#pragma unroll
            for (int m = 0; m < 4; ++m) {
                const int row = row0 + ai * HALF + m * 16;
                float* rowp = g.C + (size_t)row * g.ldc + col0;
                const float* rp = g.R ? g.R + (size_t)row * g.ldr + col0 : nullptr;
#pragma unroll
                for (int bj = 0; bj < 2; ++bj)
#pragma unroll
                    for (int n = 0; n < 2; ++n) {
                        f32x4 v = acc[ai][bj][m][n];
                        if (rp) v = v + *(const f32x4*)(rp + bj * HALF + n * 16);
                        *(f32x4*)(rowp + bj * HALF + n * 16) = v;
                    }
            }
    } else if constexpr (MODE == 10) {
        const int col0 = u.pn * BM + wc * 32 + 4 * fq;
#pragma unroll
        for (int ai = 0; ai < 2; ++ai)
#pragma unroll
            for (int m = 0; m < 4; ++m) {
                const int row = row0 + ai * HALF + m * 16;
                bf16_t* r2 = g.C2 + (size_t)row * D + col0;
                float ss = 0.f;
#pragma unroll
                for (int bj = 0; bj < 2; ++bj)
#pragma unroll
                    for (int n = 0; n < 2; ++n) {
                        f32x4 v = acc[ai][bj][m][n];
                        if (g.R) v = v + *(const f32x4*)(g.R + (size_t)row * g.ldr + col0 + bj * HALF + n * 16);
                        else { const uint2 pr = *(const uint2*)(r2 + bj * HALF + n * 16);
                               v[0] += __uint_as_float(pr.x << 16); v[1] += __uint_as_float(pr.x & 0xFFFF0000u); v[2] += __uint_as_float(pr.y << 16); v[3] += __uint_as_float(pr.y & 0xFFFF0000u); }
                        uint2 o; o.x = pk2(v[0], v[1]); o.y = pk2(v[2], v[3]);
                        *(uint2*)(r2 + bj * HALF + n * 16) = o;
                        ss += (v[0] * v[0] + v[1] * v[1]) + (v[2] * v[2] + v[3] * v[3]);
                    }
                ss += __shfl_xor(ss, 16); ss += __shfl_xor(ss, 32);
                if (fq == 0) g.rssp[(size_t)row * 32 + u.pn * 4 + wc] = ss;
            }
    } else if constexpr (MODE == 11) {
        bf16_t* Cb = (bf16_t*)g.C;
        const int col0 = u.pn * BM + wc * 32 + 4 * fq;
#pragma unroll
        for (int ai = 0; ai < 2; ++ai)
#pragma unroll
            for (int m = 0; m < 4; ++m) {
                const int row = row0 + ai * HALF + m * 16;
                const float rs = ((const LAS float*)(xlds + 8192))[row - u.pm * BM];
                bf16_t* rowp = Cb + (size_t)row * g.ldc + col0;
#pragma unroll
                for (int bj = 0; bj < 2; ++bj)
#pragma unroll
                    for (int n = 0; n < 2; ++n) {
                        const f32x4 v = acc[ai][bj][m][n] * rs;
                        uint2 o; o.x = pk2(v[0], v[1]); o.y = pk2(v[2], v[3]);
                        *(uint2*)(rowp + bj * HALF + n * 16) = o;
                    }
            }
    } else if constexpr (MODE == 6) {
        const int h = u.pn; const size_t t0 = (size_t)u.pm * BM;
        bf16_t* Cb = (bf16_t*)g.C;
#pragma unroll
        for (int ai = 0; ai < 2; ++ai)
#pragma unroll
            for (int m = 0; m < 4; ++m) {
                const int l = ai * HALF + wr * 64 + m * 16 + fr;
                const float M2 = g.gs[((t0 + l) * 4 + h) * 8 + 1];
                bf16_t* rowp = Cb + (t0 + l) * 2048 + h * 512 + wc * 32 + 4 * fq;
                float rs = 0.f;
#pragma unroll
                for (int bj = 0; bj < 2; ++bj)
#pragma unroll
                    for (int n = 0; n < 2; ++n) {
                        const f32x4 a = acc[ai][bj][m][n];
                        const int s0 = bj * HALF + wc * 32 + n * 16 + 4 * fq;
                        float p[4];
#pragma unroll
                        for (int r = 0; r < 4; ++r) { const float u2 = g.gs[((t0 + s0 + r) * 4 + h) * 8 + 0]; p[r] = (s0 + r <= l) ? a[r] * __builtin_amdgcn_exp2f(u2 - M2) : 0.f; rs += p[r]; }
                        uint2 o; o.x = pk2(p[0], p[1]); o.y = pk2(p[2], p[3]);
                        *(uint2*)(rowp + bj * HALF + n * 16) = o;
                    }
                rs += __shfl_xor(rs, 16); rs += __shfl_xor(rs, 32);
                if (fq == 0) g.denp[((t0 + l) * 4 + h) * 4 + wc] = rs;
            }
    } else if constexpr (MODE == 12) {
        float* Ct = g.C + (size_t)(u.pn >> 4) * ((size_t)512 * 4096) + (size_t)(u.pn & 15) * 256;
        const int col0 = wc * 32 + 4 * fq;
#pragma unroll
        for (int ai = 0; ai < 2; ++ai)
#pragma unroll
            for (int m = 0; m < 4; ++m) {
                float* rowp = Ct + (size_t)(row0 + ai * HALF + m * 16) * 4096 + col0;
#pragma unroll
                for (int bj = 0; bj < 2; ++bj)
#pragma unroll
                    for (int n = 0; n < 2; ++n) *(f32x4*)(rowp + bj * HALF + n * 16) = acc[ai][bj][m][n];
            }
    } else if constexpr (MODE == 7) {
        float* Ct = g.C + (size_t)(u.pm * 4 + u.pn) * 65536;
        const int col0 = wc * 32 + 4 * fq;
#pragma unroll
        for (int ai = 0; ai < 2; ++ai)
#pragma unroll
            for (int m = 0; m < 4; ++m) {
                float* rowp = Ct + (size_t)(ai * HALF + wr * 64 + m * 16 + fr) * 256 + col0;
#pragma unroll
                for (int bj = 0; bj < 2; ++bj)
#pragma unroll
                    for (int n = 0; n < 2; ++n) *(f32x4*)(rowp + bj * HALF + n * 16) = acc[ai][bj][m][n];
            }
    } else if constexpr (MODE == 8) {
        const int h = u.pn; const size_t t0 = (size_t)u.pm * BM;
        LAS float* X0 = (LAS float*)xlds + wr * 512;
#pragma unroll
        for (int ai = 0; ai < 2; ++ai)
#pragma unroll
            for (int m = 0; m < 4; ++m) {
                const size_t th = (t0 + ai * HALF + wr * 64 + m * 16 + fr) * 4 + h;
                const f32x4 dp = *(const f32x4*)(g.denp + th * 4);
                const float den = (dp[0] + dp[1]) + (dp[2] + dp[3]) + g.gs[th * 8 + 3] * g.qn[th];
                const float rden = 1.0f / fmaxf(fabsf(den), g.gs[th * 8 + 4]);
                float ss = 0.f;
#pragma unroll
                for (int bj = 0; bj < 2; ++bj)
#pragma unroll
                    for (int n = 0; n < 2; ++n) { f32x4 a = acc[ai][bj][m][n] * rden; acc[ai][bj][m][n] = a; ss += (a[0] * a[0] + a[1] * a[1]) + (a[2] * a[2] + a[3] * a[3]); }
                ss += __shfl_xor(ss, 16); ss += __shfl_xor(ss, 32);
                if (fq == 0) X0[(ai * 64 + m * 16 + fr) * 4 + wc] = ss;
            }
        asm volatile("s_waitcnt lgkmcnt(0)" ::: "memory"); __builtin_amdgcn_s_barrier(); asm volatile("" ::: "memory");
        bf16_t* Cb = (bf16_t*)g.C;
        const int col0 = wc * 32 + 4 * fq;
#pragma unroll
        for (int ai = 0; ai < 2; ++ai)
#pragma unroll
            for (int m = 0; m < 4; ++m) {
                const f32x4 p4 = *(const LAS f32x4*)(X0 + (ai * 64 + m * 16 + fr) * 4);
                const float rsn = rsqrtf(((p4[0] + p4[1]) + (p4[2] + p4[3])) * (1.0f / 256.0f) + EPS);
                const size_t t = t0 + ai * HALF + wr * 64 + m * 16 + fr;
                bf16_t* rowp = Cb + t * 2048 + h * 256 + col0;
                const bf16_t* mop = g.mo + t * 1024 + h * 256 + col0;
#pragma unroll
                for (int bj = 0; bj < 2; ++bj)
#pragma unroll
                    for (int n = 0; n < 2; ++n) {
                        const f32x4 a = acc[ai][bj][m][n];
                        const ushort4 mo4 = *(const ushort4*)(mop + bj * HALF + n * 16);
                        const f32x4 gv = *(const f32x4*)(g.gvec + h * 256 + col0 + bj * HALF + n * 16);
                        const float o0 = a[0] * rsn * gv[0] / (1.0f + __expf(-bf2f(mo4.x)));
                        const float o1 = a[1] * rsn * gv[1] / (1.0f + __expf(-bf2f(mo4.y)));
                        const float o2 = a[2] * rsn * gv[2] / (1.0f + __expf(-bf2f(mo4.z)));
                        const float o3 = a[3] * rsn * gv[3] / (1.0f + __expf(-bf2f(mo4.w)));
                        uint2 o; o.x = pk2(o0, o1); o.y = pk2(o2, o3);
                        *(uint2*)(rowp + bj * HALF + n * 16) = o;
                    }
            }
    } else if constexpr (MODE == 5) {
        LAS float* X0 = (LAS float*)xlds + wr * 512;
        LAS float* X1 = (LAS float*)xlds + 1024 + wr * 512;
#pragma unroll
        for (int ai = 0; ai < 2; ++ai)
#pragma unroll
            for (int m = 0; m < 4; ++m) {
                float v = -INFINITY;
#pragma unroll
                for (int bj = 0; bj < 2; ++bj)
#pragma unroll
                    for (int n = 0; n < 2; ++n) { const f32x4 a = acc[ai][bj][m][n]; v = fmaxf(v, fmaxf(fmaxf(a[0], a[1]), fmaxf(a[2], a[3]))); }
                v = fmaxf(v, __shfl_xor(v, 16)); v = fmaxf(v, __shfl_xor(v, 32));
                if (fq == 0) X0[(ai * 64 + m * 16 + fr) * 4 + wc] = v;
            }
        asm volatile("s_waitcnt lgkmcnt(0)" ::: "memory"); __builtin_amdgcn_s_barrier(); asm volatile("" ::: "memory");
#pragma unroll
        for (int ai = 0; ai < 2; ++ai)
#pragma unroll
            for (int m = 0; m < 4; ++m) {
                const f32x4 p4 = *(const LAS f32x4*)(X0 + (ai * 64 + m * 16 + fr) * 4);
                const float mxr = fmaxf(fmaxf(p4[0], p4[1]), fmaxf(p4[2], p4[3])) * g.escale;
                float s = 0.f;
#pragma unroll
                for (int bj = 0; bj < 2; ++bj)
#pragma unroll
                    for (int n = 0; n < 2; ++n) { f32x4 a = acc[ai][bj][m][n];
                        a[0] = __builtin_amdgcn_exp2f(a[0] * g.escale - mxr); a[1] = __builtin_amdgcn_exp2f(a[1] * g.escale - mxr); a[2] = __builtin_amdgcn_exp2f(a[2] * g.escale - mxr); a[3] = __builtin_amdgcn_exp2f(a[3] * g.escale - mxr);
                        acc[ai][bj][m][n] = a; s += (a[0] + a[1]) + (a[2] + a[3]); }
                s += __shfl_xor(s, 16); s += __shfl_xor(s, 32);
                if (fq == 0) X1[(ai * 64 + m * 16 + fr) * 4 + wc] = s;
            }
        asm volatile("s_waitcnt lgkmcnt(0)" ::: "memory"); __builtin_amdgcn_s_barrier(); asm volatile("" ::: "memory");
        bf16_t* Cb = (bf16_t*)g.C;
        const int col0 = u.pn * BM + wc * 32 + 4 * fq;
#pragma unroll
        for (int ai = 0; ai < 2; ++ai)
#pragma unroll
            for (int m = 0; m < 4; ++m) {
                const f32x4 p4 = *(const LAS f32x4*)(X1 + (ai * 64 + m * 16 + fr) * 4);
                const float inv = 1.0f / ((p4[0] + p4[1]) + (p4[2] + p4[3]));
                bf16_t* rowp = Cb + (size_t)(row0 + ai * HALF + m * 16) * g.ldc + col0;
#pragma unroll
                for (int bj = 0; bj < 2; ++bj)
#pragma unroll
                    for (int n = 0; n < 2; ++n) {
                        const f32x4 a = acc[ai][bj][m][n];
                        uint2 o; o.x = pk2(a[0] * inv, a[1] * inv); o.y = pk2(a[2] * inv, a[3] * inv);
                        *(uint2*)(rowp + bj * HALF + n * 16) = o;
                    }
            }
    } else {
        bf16_t* Cb = (bf16_t*)g.C; int ccol = u.pn * BM;
        if constexpr (MODE == 4) { Cb += (size_t)(u.pn >> 2) * P6S; ccol = (u.pn & 3) * 256; }
        const int col0 = ccol + wc * 32 + 4 * fq;
#pragma unroll
        for (int ai = 0; ai < 2; ++ai)
#pragma unroll
            for (int m = 0; m < 4; ++m) {
                bf16_t* rowp = Cb + (size_t)(row0 + ai * HALF + m * 16) * g.ldc + col0;
#pragma unroll
                for (int bj = 0; bj < 2; ++bj)
#pragma unroll
                    for (int n = 0; n < 2; ++n) {
                        const f32x4 v = acc[ai][bj][m][n];
                        uint2 o; o.x = pk2(v[0], v[1]); o.y = pk2(v[2], v[3]);
                        *(uint2*)(rowp + bj * HALF + n * 16) = o;
                    }
            }
    }
}
template <int MODE> __device__ __forceinline__ void gemm_phase(LAS unsigned char* lds, const GJob& g, int tid) {
    const int wid = __builtin_amdgcn_readfirstlane(tid >> 6), lane = tid & 63, wr = wid >> 2, wc = wid & 3, fr = lane & 15, fq = lane >> 4;
    const int K = g.K, nt = K / BK;
    unsigned voffA[2], voffB[2];
#pragma unroll
    for (int i = 0; i < 2; ++i) { int R, C; stage_rc(tid * 16 + i * 8192, R, C);
        voffA[i] = (unsigned)(R * g.lda + C) * 2u; voffB[i] = (unsigned)(R * g.ldb + C) * 2u; }
    const size_t kstep = (size_t)(BK * 2);
    const size_t hstepA = (size_t)HALF * g.lda * 2, hstepB = (size_t)HALF * g.ldb * 2;
    const unsigned ldsw = (unsigned)wid * 1024u;
    const int aoff = lds_byte(wr * 64 + fr, fq * 8), boff = lds_byte(wc * 32 + fr, fq * 8);
#define PG8_SA(b, h) (((b) * 2 + (h)) * HTB)
#define PG8_SB(b, h) ((4 + (b) * 2 + (h)) * HTB)
#define PG8_STAGE(bufoff, gbase, voff) do { _Pragma("unroll") for (int _i = 0; _i < 2; ++_i) \
        __builtin_amdgcn_global_load_lds((const unsigned*)((const char*)(gbase) + (voff)[_i]), (LAS unsigned*)(lds + (bufoff) + ldsw + _i * 8192), 16, 0, 0); } while (0)
#define PG8_LDA(dst, b, h) do { _Pragma("unroll") for (int m = 0; m < 4; ++m) _Pragma("unroll") for (int k = 0; k < 2; ++k) dst[m][k] = *(const LAS bf16x8*)(lds + PG8_SA(b, h) + aoff + m * 2048 + k * 1024); } while (0)
#define PG8_LDB(dst, b, h) do { _Pragma("unroll") for (int n = 0; n < 2; ++n) _Pragma("unroll") for (int k = 0; k < 2; ++k) dst[n][k] = *(const LAS bf16x8*)(lds + PG8_SB(b, h) + boff + n * 2048 + k * 1024); } while (0)
#define PG8_MMA(ai, bj, At, Bt) do { __builtin_amdgcn_s_setprio(1); _Pragma("unroll") for (int m = 0; m < 4; ++m) _Pragma("unroll") for (int n = 0; n < 2; ++n) _Pragma("unroll") for (int k = 0; k < 2; ++k) \
        acc[ai][bj][m][n] = __builtin_amdgcn_mfma_f32_16x16x32_bf16(Bt[n][k], At[m][k], acc[ai][bj][m][n], 0, 0, 0); __builtin_amdgcn_s_setprio(0); } while (0)
#define PG8_WAIT_V(n) asm volatile("s_waitcnt vmcnt(" #n ")" ::: "memory")
#define PG8_WAIT_L(n) asm volatile("s_waitcnt lgkmcnt(" #n ")" ::: "memory")
#define PG8_BAR __builtin_amdgcn_s_barrier()
#define PG8_SCHED __builtin_amdgcn_sched_barrier(0)
#define PG8_ABASE(u) ((const char*)g.A + ((size_t)(u).pm * g.a_pm_step + (size_t)(((u).pn >> g.a_pn_shift) & g.a_pn_mask) * g.a_pn_step) * 2)
#define PG8_BBASE(u) ((const char*)g.Bt + ((size_t)((u).pn & g.b_pn_mask) * g.b_pn_step + (size_t)((u).pn >> g.b_pn_shift) * g.b_pn_step2 + (size_t)((u).pm >> g.b_pm_shift) * g.b_pm_step) * 2)
    Unit cur, nxt; int ui = 0;
    if (!unit_next(g, 0, cur)) return;
    f32x4 acc[2][2][4][2];
#pragma unroll
    for (int a = 0; a < 2; ++a)
#pragma unroll
        for (int b = 0; b < 2; ++b)
#pragma unroll
            for (int m = 0; m < 4; ++m)
#pragma unroll
                for (int n = 0; n < 2; ++n) acc[a][b][m][n] = (f32x4){0.f, 0.f, 0.f, 0.f};
    bf16x8 At[4][2], B0[2][2], B1[2][2];
    const char* cA = PG8_ABASE(cur); const char* cB = PG8_BBASE(cur);
    PG8_STAGE(PG8_SB(0, 0), cB, voffB); PG8_STAGE(PG8_SA(0, 0), cA, voffA); PG8_STAGE(PG8_SB(0, 1), cB + hstepB, voffB); PG8_STAGE(PG8_SA(0, 1), cA + hstepA, voffA);
    if (wr == 1) PG8_BAR;
    PG8_WAIT_V(4); PG8_BAR;
    PG8_STAGE(PG8_SB(1, 0), cB + kstep, voffB); PG8_STAGE(PG8_SA(1, 0), cA + kstep, voffA); PG8_STAGE(PG8_SB(1, 1), cB + hstepB + kstep, voffB);
    PG8_WAIT_V(6); PG8_BAR;
    for (;;) {
        const bool has_next = unit_next(g, ui + 1, nxt);
        const char* nA = has_next ? PG8_ABASE(nxt) : cA; const char* nB = has_next ? PG8_BBASE(nxt) : cB;
        for (int t = 0; t < nt; t += 2) {
            const bool last = (t == nt - 2);
            const char* a1 = cA + (size_t)(t + 1) * kstep;
            const char* a2 = last ? nA : cA + (size_t)(t + 2) * kstep; const char* b2 = last ? nB : cB + (size_t)(t + 2) * kstep;
            const char* a3 = a2 + kstep; const char* b3 = b2 + kstep;
            PG8_LDB(B0, 0, 0); PG8_SCHED; PG8_LDA(At, 0, 0); PG8_STAGE(PG8_SA(1, 1), a1 + hstepA, voffA);
            PG8_WAIT_L(8); PG8_BAR; PG8_WAIT_L(0); PG8_MMA(0, 0, At, B0); PG8_BAR; PG8_SCHED;
            PG8_LDB(B1, 0, 1); PG8_STAGE(PG8_SB(0, 0), b2, voffB);
            PG8_BAR; PG8_WAIT_L(0); PG8_MMA(0, 1, At, B1); PG8_BAR;
            PG8_LDA(At, 0, 1); PG8_STAGE(PG8_SA(0, 0), a2, voffA);
            PG8_BAR; PG8_WAIT_L(0); PG8_MMA(1, 0, At, B0); PG8_BAR; PG8_SCHED;
            PG8_STAGE(PG8_SB(0, 1), b2 + hstepB, voffB);
            PG8_WAIT_V(6); PG8_BAR; PG8_MMA(1, 1, At, B1); PG8_BAR;
            PG8_LDB(B0, 1, 0); PG8_SCHED; PG8_LDA(At, 1, 0); PG8_STAGE(PG8_SA(0, 1), a2 + hstepA, voffA);
            PG8_WAIT_L(8); PG8_BAR; PG8_WAIT_L(0); PG8_MMA(0, 0, At, B0); PG8_BAR; PG8_SCHED;
            PG8_LDB(B1, 1, 1); PG8_STAGE(PG8_SB(1, 0), b3, voffB);
            PG8_BAR; PG8_WAIT_L(0); PG8_MMA(0, 1, At, B1); PG8_BAR;
            PG8_LDA(At, 1, 1); PG8_STAGE(PG8_SA(1, 0), a3, voffA);
            PG8_BAR; PG8_WAIT_L(0); PG8_MMA(1, 0, At, B0); PG8_BAR; PG8_SCHED;
            PG8_STAGE(PG8_SB(1, 1), b3 + hstepB, voffB);
            PG8_WAIT_V(6); PG8_BAR; PG8_MMA(1, 1, At, B1); PG8_BAR;
        }
        epilogue<MODE>(g, acc, cur, wr, wc, fr, fq, lds + GEMM_LDS + 1024);
        if (!has_next) break;
#pragma unroll
        for (int a = 0; a < 2; ++a)
#pragma unroll
            for (int b = 0; b < 2; ++b)
#pragma unroll
                for (int m = 0; m < 4; ++m)
#pragma unroll
                    for (int n = 0; n < 2; ++n) acc[a][b][m][n] = (f32x4){0.f, 0.f, 0.f, 0.f};
        cur = nxt; cA = nA; cB = nB; ++ui;
    }
    PG8_WAIT_V(0);
    if (wr == 0) PG8_BAR;
    PG8_BAR;
#undef PG8_SA
#undef PG8_SB
#undef PG8_STAGE
#undef PG8_LDA
#undef PG8_LDB
#undef PG8_MMA
#undef PG8_WAIT_V
#undef PG8_WAIT_L
#undef PG8_BAR
#undef PG8_SCHED
#undef PG8_ABASE
#undef PG8_BBASE
}
}

__device__ __forceinline__ void p0_transpose_item(const float* W, int ldw, int K, int csrc0, bf16_t* WT, int row0, LAS float* scr, int kb, int lane, float wscale, const float* kgain) {
    const int k0 = 64 * kb;
#pragma unroll
    for (int i = 0; i < 8; ++i) { const int kk = 8 * i + (lane >> 3), n4 = (lane & 7) * 4;
        const float4 v = *(const float4*)(W + (size_t)(k0 + kk) * ldw + csrc0 + n4);
        const float ws = kgain ? kgain[k0 + kk] : wscale; (void)wscale;
        scr[kk * 33 + n4] = v.x * ws; scr[kk * 33 + n4 + 1] = v.y * ws; scr[kk * 33 + n4 + 2] = v.z * ws; scr[kk * 33 + n4 + 3] = v.w * ws; }
    asm volatile("s_waitcnt lgkmcnt(0)" ::: "memory");
    const int c = lane & 7;
#pragma unroll
    for (int j = 0; j < 4; ++j) { const int n = (lane >> 3) + 8 * j; const LAS float* s = scr + (8 * c) * 33 + n;
        uint4 o; o.x = pk2(s[0 * 33], s[1 * 33]); o.y = pk2(s[2 * 33], s[3 * 33]); o.z = pk2(s[4 * 33], s[5 * 33]); o.w = pk2(s[6 * 33], s[7 * 33]);
        *(uint4*)(WT + (size_t)(row0 + n) * K + k0 + 8 * c) = o; }
    asm volatile("s_waitcnt lgkmcnt(0)" ::: "memory");
}

__device__ __forceinline__ void d_conv_silu(int vb, int tid, const bf16_t* __restrict__ p6, const float* __restrict__ cw, const float* __restrict__ cb, bf16_t* __restrict__ c) {
    const int t = vb, s = t % S;
    for (int ch = tid; ch < 1024; ch += 256) {
        float y = cb[ch];
#pragma unroll
        for (int j = 0; j < 4; ++j) {
            const int ss = s - 3 + j;
            if (ss >= 0) y = fmaf(cw[j * 1024 + ch], bf2f(p6[(size_t)(t - 3 + j) * 1024 + ch]), y);
        }
        c[(size_t)t * 1024 + ch] = (bf16_t)f2bf(y / (1.0f + expf(-y)));
    }
}

__device__ __forceinline__ void d_mlstm(int vb, int tid, const bf16_t* __restrict__ mq, const bf16_t* __restrict__ mk, const bf16_t* __restrict__ p6,
                                        const float* __restrict__ gpre, const float* __restrict__ b_mi, const float* __restrict__ b_mf, float* __restrict__ hraw) {
    const int lane = tid & 63, w = tid >> 6;
    const int gid = vb * 4 + w;
    const int e = gid & 255, h = (gid >> 8) & 3, b = gid >> 10;
    const float bi = b_mi[h], bf = b_mf[h];
    float C0 = 0.f, C1 = 0.f, C2 = 0.f, C3 = 0.f, n0 = 0.f, n1 = 0.f, n2 = 0.f, n3 = 0.f, m = 0.f;
    const size_t tb = (size_t)b * S;
    const bf16_t* qp = mq + tb * 1024 + h * 256 + lane * 4;
    const bf16_t* kp = mk + tb * 1024 + h * 256 + lane * 4;
    const bf16_t* pp = p6 + P6S + tb * 1024 + h * 256 + e;
    ushort4 qn = *(const ushort4*)qp, kn = *(const ushort4*)kp;
    const float* gp = gpre + tb * 8;
    float vn = bf2f(pp[0]), in_ = gp[h], fn = gp[4 + h];
    for (int s = 0; s < S; ++s) {
        const float4 q = make_float4(bf2f(qn.x), bf2f(qn.y), bf2f(qn.z), bf2f(qn.w)), k = make_float4(bf2f(kn.x), bf2f(kn.y), bf2f(kn.z), bf2f(kn.w)); const float v = vn, ipre = in_ + bi, fpre = fn + bf;
        if (s + 1 < S) {
            qn = *(const ushort4*)(qp + (size_t)(s + 1) * 1024);
            kn = *(const ushort4*)(kp + (size_t)(s + 1) * 1024);
            vn = bf2f(pp[(size_t)(s + 1) * 1024]); in_ = gp[(size_t)(s + 1) * 8 + h]; fn = gp[(size_t)(s + 1) * 8 + 4 + h];
        }
        const float logf = log_sigmoid(fpre);
        const float mnew = fmaxf(logf + m, ipre);
        const float fd = expf(logf + m - mnew), ig = expf(ipre - mnew);
        m = mnew;
        const float sc = ig * 0.0625f;
        C0 = fd * C0 + sc * k.x * v; C1 = fd * C1 + sc * k.y * v; C2 = fd * C2 + sc * k.z * v; C3 = fd * C3 + sc * k.w * v;
        n0 = fd * n0 + sc * k.x; n1 = fd * n1 + sc * k.y; n2 = fd * n2 + sc * k.z; n3 = fd * n3 + sc * k.w;
        float num = q.x * C0 + q.y * C1 + q.z * C2 + q.w * C3;
        float den = q.x * n0 + q.y * n1 + q.z * n2 + q.w * n3;
        num = wave_sum(num); den = wave_sum(den);
        if (lane == 0) hraw[(tb + s) * 1024 + h * 256 + e] = num / fmaxf(fabsf(den), expf(-mnew));
    }
}

__device__ __forceinline__ void d_mhead_norm(int vb, int tid, const float* __restrict__ hraw, const bf16_t* __restrict__ p6, const float* __restrict__ g, bf16_t* __restrict__ mix) {
    const int t = vb, h = tid >> 6, lane = tid & 63;
    const float4 v = *(const float4*)(hraw + (size_t)t * 1024 + h * 256 + lane * 4);
    float s = v.x * v.x + v.y * v.y + v.z * v.z + v.w * v.w;
    s = wave_sum(s);
    const float r = rsqrtf(s * (1.0f / 256.0f) + EPS);
    const float4 gg = *(const float4*)(g + h * 256 + lane * 4);
    const ushort4 mo = *(const ushort4*)(p6 + 2 * P6S + (size_t)t * 1024 + h * 256 + lane * 4);
    float4 o;
    o.x = v.x * r * gg.x / (1.0f + expf(-bf2f(mo.x)));
    o.y = v.y * r * gg.y / (1.0f + expf(-bf2f(mo.y)));
    o.z = v.z * r * gg.z / (1.0f + expf(-bf2f(mo.z)));
    o.w = v.w * r * gg.w / (1.0f + expf(-bf2f(mo.w)));
    uint2 ob; ob.x = pk2(o.x, o.y); ob.y = pk2(o.z, o.w);
    *(uint2*)(mix + (size_t)t * D + h * 256 + lane * 4) = ob;
}

__device__ __forceinline__ void d_rope(int vb, int tid, bf16_t* __restrict__ p6) {
    const int t = vb, s = t % S;
    for (int idx = tid; idx < 2 * 8 * 64; idx += 256) {
        const int i = idx & 63, hd = (idx >> 6) & 7, qk = idx >> 9;
        const float inv = exp2f(-(float)i * 0.20762050593046014f);
        const float ang = (float)s * inv;
        float sn, cs; sincosf(ang, &sn, &cs);
        bf16_t* p = p6 + (size_t)(3 + qk) * P6S + (size_t)t * 1024 + hd * 128;
        const float x1 = bf2f(p[i]), x2 = bf2f(p[64 + i]);
        p[i] = (bf16_t)f2bf(x1 * cs - x2 * sn);
        p[64 + i] = (bf16_t)f2bf(x2 * cs + x1 * sn);
    }
}

__device__ __forceinline__ void d_dilated(int vb, int tid, float* sm, const bf16_t* __restrict__ p6, const float* __restrict__ g_ahead, bf16_t* __restrict__ mix) {
    float (*qs)[128] = (float (*)[128])sm;
    float (*ps)[576] = (float (*)[576])(sm + 512);
    const int lane = tid & 63, w = tid >> 6;
    const int gid = vb * 4 + w;
    const int s = gid % S, hd = (gid / S) & 7, b = gid / (S * 8);
    const size_t t = (size_t)b * S + s;
    const bf16_t* qrow = p6 + 3 * P6S + t * 1024 + hd * 128;
    __syncthreads();
    qs[w][lane] = bf2f(qrow[lane]); qs[w][lane + 64] = bf2f(qrow[lane + 64]);
    __syncthreads();
    const float scale = 0.08838834764831845f;
    float mloc = -INFINITY;
    for (int br = 0; br < 3; ++br) {
        const int dil = br == 0 ? 1 : (br == 1 ? 4 : 16);
        for (int jj = 0; jj < 192; jj += 64) {
            const int j = jj + lane;
            float sc = -INFINITY;
            if (j <= 128 && s - j * dil >= 0) {
                const bf16_t* krow = p6 + 4 * P6S + (t - (size_t)j * dil) * 1024 + hd * 128;
                float d = 0.f;
#pragma unroll 8
                for (int c = 0; c < 128; c += 4) {
                    const ushort4 kv = *(const ushort4*)(krow + c);
                    d = fmaf(qs[w][c], bf2f(kv.x), d); d = fmaf(qs[w][c + 1], bf2f(kv.y), d); d = fmaf(qs[w][c + 2], bf2f(kv.z), d); d = fmaf(qs[w][c + 3], bf2f(kv.w), d);
                }
                sc = d * scale;
            }
            ps[w][br * 192 + j] = sc;
            mloc = fmaxf(mloc, sc);
        }
    }
    const float mx = wave_max(mloc);
    __syncthreads();
    float lsum = 0.f;
    for (int i = lane; i < 3 * 192; i += 64) {
        const float sc = ps[w][i];
        const float pv = (sc == -INFINITY) ? 0.f : expf(sc - mx);
        ps[w][i] = pv; lsum += pv;
    }
    const float tot = wave_sum(lsum);
    __syncthreads();
    float o0 = 0.f, o1 = 0.f;
    for (int br = 0; br < 3; ++br) {
        const int dil = br == 0 ? 1 : (br == 1 ? 4 : 16);
        for (int j = 0; j <= 128; ++j) {
            if (s - j * dil < 0) break;
            const float pv = ps[w][br * 192 + j];
            const bf16_t* vrow = p6 + 5 * P6S + (t - (size_t)j * dil) * 1024 + hd * 128;
            o0 = fmaf(pv, bf2f(vrow[lane]), o0); o1 = fmaf(pv, bf2f(vrow[lane + 64]), o1);
        }
    }
    o0 /= tot; o1 /= tot;
    float ss = wave_sum(o0 * o0 + o1 * o1);
    const float r = rsqrtf(ss * (1.0f / 128.0f) + EPS);
    bf16_t* orow = mix + t * D + 1024 + hd * 128;
    orow[lane] = (bf16_t)f2bf(o0 * r * g_ahead[hd * 128 + lane]);
    orow[lane + 64] = (bf16_t)f2bf(o1 * r * g_ahead[hd * 128 + lane + 64]);
}

__device__ __forceinline__ void d_cross(int vb, int tid, float* sm, const bf16_t* __restrict__ q, const float* __restrict__ km, const float* __restrict__ vm, bf16_t* __restrict__ o) {
    float (*qs)[512] = (float (*)[512])sm;
    float (*ps)[256] = (float (*)[256])(sm + 2048);
    const int lane = tid & 63, w = tid >> 6;
    const int t = vb, hd = w, b = t / S;
    const bf16_t* qrow = q + (size_t)t * D + hd * 512;
    __syncthreads();
    for (int i = lane; i < 512; i += 64) qs[w][i] = bf2f(qrow[i]);
    __syncthreads();
    const float scale = 0.04419417382415922f;
    float sc[4]; float mloc = -INFINITY;
#pragma unroll
    for (int r = 0; r < 4; ++r) {
        const int mi = lane + 64 * r;
        const float* krow = km + ((size_t)b * 256 + mi) * D + hd * 512;
        float d = 0.f;
#pragma unroll 8
        for (int c = 0; c < 512; c += 4) {
            const float4 kv = *(const float4*)(krow + c);
            d = fmaf(qs[w][c], kv.x, d); d = fmaf(qs[w][c + 1], kv.y, d); d = fmaf(qs[w][c + 2], kv.z, d); d = fmaf(qs[w][c + 3], kv.w, d);
        }
        sc[r] = d * scale; mloc = fmaxf(mloc, sc[r]);
    }
    const float mx = wave_max(mloc);
    float lsum = 0.f;
#pragma unroll
    for (int r = 0; r < 4; ++r) { const float pv = expf(sc[r] - mx); ps[w][lane + 64 * r] = pv; lsum += pv; }
    const float tot = wave_sum(lsum);
    __syncthreads();
    float acc[8];
#pragma unroll
    for (int i = 0; i < 8; ++i) acc[i] = 0.f;
    for (int mi = 0; mi < 256; ++mi) {
        const float pv = ps[w][mi];
        const float* vrow = vm + ((size_t)b * 256 + mi) * D + hd * 512;
#pragma unroll
        for (int i = 0; i < 8; ++i) acc[i] = fmaf(pv, vrow[lane + 64 * i], acc[i]);
    }
    bf16_t* orow = o + (size_t)t * D + hd * 512;
#pragma unroll
    for (int i = 0; i < 8; ++i) orow[lane + 64 * i] = (bf16_t)f2bf(acc[i] / tot);
}

__device__ __forceinline__ void wave_argmax(float& best, int& bidx) {
#pragma unroll
    for (int o = 32; o >= 1; o >>= 1) {
        const float ob = __shfl_xor(best, o); const int oi = __shfl_xor(bidx, o);
        if (ob > best || (ob == best && oi < bidx)) { best = ob; bidx = oi; }
    }
}
__device__ __forceinline__ void d_peer_topk(int vb, int tid, float* sm, const bf16_t* __restrict__ qp, const float* __restrict__ sub_keys, int* __restrict__ ids, float* __restrict__ gates) {
    float (*qs)[256] = (float (*)[256])sm;
    const int lane = tid & 63, w = tid >> 6;
    const int gid = vb * 4 + w;
    const int hd = gid & 7, t = gid >> 3;
    const bf16_t* qrow = qp + (size_t)t * D + hd * 256;
    __syncthreads();
    for (int i = lane; i < 256; i += 64) qs[w][i] = bf2f(qrow[i]);
    __syncthreads();
    float tops[2]; int topi[2];
#pragma unroll
    for (int p = 0; p < 2; ++p) {
        float v0, v1;
        {
            const float* k0 = sub_keys + ((size_t)(hd * 2 + p) * 128 + lane) * 128;
            const float* k1 = k0 + 64 * 128;
            float d0 = 0.f, d1 = 0.f;
#pragma unroll 8
            for (int c = 0; c < 128; c += 4) {
                const float4 a = *(const float4*)(k0 + c), bb = *(const float4*)(k1 + c);
                const float q0 = qs[w][p * 128 + c], q1 = qs[w][p * 128 + c + 1], q2 = qs[w][p * 128 + c + 2], q3 = qs[w][p * 128 + c + 3];
                d0 = fmaf(q0, a.x, d0); d0 = fmaf(q1, a.y, d0); d0 = fmaf(q2, a.z, d0); d0 = fmaf(q3, a.w, d0);
                d1 = fmaf(q0, bb.x, d1); d1 = fmaf(q1, bb.y, d1); d1 = fmaf(q2, bb.z, d1); d1 = fmaf(q3, bb.w, d1);
            }
            v0 = d0; v1 = d1;
        }
        float ts = 0.f; int ti = 0;
        for (int it = 0; it < 16; ++it) {
            float best; int bidx;
            if (v0 >= v1) { best = v0; bidx = lane; } else { best = v1; bidx = lane + 64; }
            wave_argmax(best, bidx);
            if (lane == it) { ts = best; ti = bidx; }
            if (bidx == lane) v0 = -INFINITY;
            if (bidx == lane + 64) v1 = -INFINITY;
        }
        tops[p] = ts; topi[p] = ti;
    }
    float cv[4]; int ci[4];
#pragma unroll
    for (int r = 0; r < 4; ++r) {
        const int c = lane * 4 + r, i = c >> 4, j = c & 15;
        const float s0 = __shfl(tops[0], i), s1 = __shfl(tops[1], j);
        const int i0 = __shfl(topi[0], i), i1 = __shfl(topi[1], j);
        cv[r] = s0 + s1; ci[r] = i0 * 128 + i1;
    }
    float bs = 0.f; int bid = 0;
    for (int it = 0; it < 16; ++it) {
        float best = cv[0]; int bidx = lane * 4;
#pragma unroll
        for (int r = 1; r < 4; ++r) if (cv[r] > best) { best = cv[r]; bidx = lane * 4 + r; }
        wave_argmax(best, bidx);
        const int owner = bidx >> 2, rr = bidx & 3;
        int myid = ci[0];
        if (rr == 1) myid = ci[1]; else if (rr == 2) myid = ci[2]; else if (rr == 3) myid = ci[3];
        const int eid = __shfl(myid, owner);
        if (lane == it) { bs = best; bid = eid; }
        if (owner == lane) {
#pragma unroll
            for (int r = 0; r < 4; ++r) if (rr == r) cv[r] = -INFINITY;
        }
    }
    float v = lane < 16 ? bs : -INFINITY;
    const float mx = wave_max(v);
    const float ev = lane < 16 ? expf(bs - mx) : 0.f;
    const float tot = wave_sum(ev);
    if (lane < 16) {
        ids[(size_t)t * 128 + hd * 16 + lane] = bid;
        gates[(size_t)t * 128 + hd * 16 + lane] = ev / tot;
    }
}

__device__ __forceinline__ void d_peer_out(int vb, int tid, float* sm, const bf16_t* __restrict__ h3, const float* __restrict__ x2, const int* __restrict__ ids, const float* __restrict__ gates,
                                           const bf16_t* __restrict__ u_tab, const bf16_t* __restrict__ v_tab, const float* __restrict__ g_final, float* __restrict__ out) {
    float (*part)[2048] = (float (*)[2048])sm;
    float* red = sm + 4 * 2048;
    const int lane = tid & 63, w = tid >> 6, t = vb;
    float4 xr[8], acc[8];
    const bf16_t* hrow = h3 + (size_t)t * D;
#pragma unroll
    for (int i = 0; i < 8; ++i) { const ushort4 hv = *(const ushort4*)(hrow + i * 256 + lane * 4);
        xr[i] = make_float4(bf2f(hv.x), bf2f(hv.y), bf2f(hv.z), bf2f(hv.w)); acc[i] = make_float4(0.f, 0.f, 0.f, 0.f); }
    for (int j = 0; j < 32; ++j) {
        const int slot = w * 32 + j;
        const int e = ids[(size_t)t * 128 + slot];
        const float gt = gates[(size_t)t * 128 + slot];
        const bf16_t* ur = u_tab + (size_t)e * D;
        const bf16_t* vr = v_tab + (size_t)e * D;
        float d = 0.f;
#pragma unroll
        for (int i = 0; i < 8; ++i) {
            const ushort4 u = *(const ushort4*)(ur + i * 256 + lane * 4);
            d = fmaf(xr[i].x, bf2f(u.x), d); d = fmaf(xr[i].y, bf2f(u.y), d); d = fmaf(xr[i].z, bf2f(u.z), d); d = fmaf(xr[i].w, bf2f(u.w), d);
        }
        d = wave_sum(d);
        const float act = 0.5f * d * (1.0f + erff(d * 0.7071067811865476f));
        const float cf = gt * act;
#pragma unroll
        for (int i = 0; i < 8; ++i) {
            const ushort4 v = *(const ushort4*)(vr + i * 256 + lane * 4);
            acc[i].x = fmaf(cf, bf2f(v.x), acc[i].x); acc[i].y = fmaf(cf, bf2f(v.y), acc[i].y); acc[i].z = fmaf(cf, bf2f(v.z), acc[i].z); acc[i].w = fmaf(cf, bf2f(v.w), acc[i].w);
        }
    }
    __syncthreads();
#pragma unroll
    for (int i = 0; i < 8; ++i) *(float4*)&part[w][i * 256 + lane * 4] = acc[i];
    __syncthreads();
    float4 r0, r1;
    {
        const float4 a = *(const float4*)&part[0][tid * 4], b = *(const float4*)&part[1][tid * 4], c = *(const float4*)&part[2][tid * 4], d = *(const float4*)&part[3][tid * 4];
        const float4 x = *(const float4*)(x2 + (size_t)t * D + tid * 4);
        r0 = make_float4(x.x + a.x + b.x + c.x + d.x, x.y + a.y + b.y + c.y + d.y, x.z + a.z + b.z + c.z + d.z, x.w + a.w + b.w + c.w + d.w);
    }
    {
        const float4 a = *(const float4*)&part[0][1024 + tid * 4], b = *(const float4*)&part[1][1024 + tid * 4], c = *(const float4*)&part[2][1024 + tid * 4], d = *(const float4*)&part[3][1024 + tid * 4];
        const float4 x = *(const float4*)(x2 + (size_t)t * D + 1024 + tid * 4);
        r1 = make_float4(x.x + a.x + b.x + c.x + d.x, x.y + a.y + b.y + c.y + d.y, x.z + a.z + b.z + c.z + d.z, x.w + a.w + b.w + c.w + d.w);
    }
    float s = r0.x * r0.x + r0.y * r0.y + r0.z * r0.z + r0.w * r0.w + r1.x * r1.x + r1.y * r1.y + r1.z * r1.z + r1.w * r1.w;
    s = wave_sum(s);
    if (lane == 0) red[w] = s;
    __syncthreads();
    const float tot = red[0] + red[1] + red[2] + red[3];
    const float r = rsqrtf(tot * (1.0f / D) + EPS);
    const float4 g0 = *(const float4*)(g_final + tid * 4), g1 = *(const float4*)(g_final + 1024 + tid * 4);
    *(float4*)(out + (size_t)t * D + tid * 4) = make_float4(r0.x * r * g0.x, r0.y * r * g0.y, r0.z * r * g0.z, r0.w * r * g0.w);
    *(float4*)(out + (size_t)t * D + 1024 + tid * 4) = make_float4(r1.x * r * g1.x, r1.y * r * g1.y, r1.z * r * g1.z, r1.w * r * g1.w);
}


__device__ __forceinline__ float wave_incl_scan_add(float v, int lane) {
#pragma unroll
    for (int o = 1; o < 64; o <<= 1) { const float t = __shfl_up(v, o); if (lane >= o) v += t; }
    return v;
}
__device__ __forceinline__ float wave_incl_scan_max(float v, int lane) {
#pragma unroll
    for (int o = 1; o < 64; o <<= 1) { const float t = __shfl_up(v, o); if (lane >= o) v = fmaxf(v, t); }
    return v;
}
__device__ __forceinline__ void mlstm_gates_wave(int b, int h, int lane, const float* __restrict__ gpre, const float* __restrict__ b_mi, const float* __restrict__ b_mf,
                                                 float* __restrict__ gs, float* __restrict__ decay) {
    const float bi = b_mi[h], bf = b_mf[h];
    float mprev = 0.f;
    for (int c = 0; c < 16; ++c) {
        const size_t t0 = (size_t)b * S + c * 256 + lane * 4;
        float logi[4], lf[4], bb[4];
#pragma unroll
        for (int j = 0; j < 4; ++j) { logi[j] = gpre[(t0 + j) * 8 + h] + bi; lf[j] = log_sigmoid(gpre[(t0 + j) * 8 + 4 + h] + bf); }
        bb[0] = lf[0]; bb[1] = bb[0] + lf[1]; bb[2] = bb[1] + lf[2]; bb[3] = bb[2] + lf[3];
        const float incl = wave_incl_scan_add(bb[3], lane);
        const float excl = incl - bb[3];
#pragma unroll
        for (int j = 0; j < 4; ++j) bb[j] += excl;
        const float g = __shfl(incl, 63);
        float amax = -INFINITY, uu[4], cm[4];
#pragma unroll
        for (int j = 0; j < 4; ++j) { amax = fmaxf(amax, logi[j] + g - bb[j]); uu[j] = logi[j] - bb[j]; }
        amax = wave_max(amax);
        const float mnew = fmaxf(g + mprev, amax);
        cm[0] = uu[0]; cm[1] = fmaxf(cm[0], uu[1]); cm[2] = fmaxf(cm[1], uu[2]); cm[3] = fmaxf(cm[2], uu[3]);
        const float cincl = wave_incl_scan_max(cm[3], lane);
        float cexcl = __shfl_up(cincl, 1); if (lane == 0) cexcl = -INFINITY;
#pragma unroll
        for (int j = 0; j < 4; ++j) {
            const float M = fmaxf(mprev, fmaxf(cexcl, cm[j]));
            float* o = gs + ((t0 + j) * 4 + h) * 8;
            o[0] = uu[j] * 1.4426950408889634f; o[1] = M * 1.4426950408889634f; o[2] = expf(logi[j] + g - bb[j] - mnew); o[3] = expf(mprev - M); o[4] = expf(-(bb[j] + M));
        }
        if (lane == 0) decay[(b * 16 + c) * 4 + h] = expf(g + mprev - mnew);
        mprev = mnew;
    }
}
__device__ __forceinline__ void transpose_tile64(int tid, float* sm, const bf16_t* __restrict__ src, int src_ld, bf16_t* __restrict__ dst, int dst_ld, const float* __restrict__ scale, int sstride) {
    unsigned short (*tl)[66] = (unsigned short (*)[66])sm;
    __syncthreads();
#pragma unroll
    for (int i = 0; i < 2; ++i) {
        const int ch = tid + i * 256, r = ch >> 3, c8 = (ch & 7) * 8;
        const uint4 v = *(const uint4*)(src + (size_t)r * src_ld + c8);
        const float sc = scale ? scale[(size_t)r * sstride] : 1.0f;
        const unsigned w[4] = {v.x, v.y, v.z, v.w};
#pragma unroll
        for (int k = 0; k < 4; ++k) {
            tl[r][c8 + 2 * k] = (unsigned short)f2bf(bf2f((unsigned short)(w[k] & 0xFFFFu)) * sc);
            tl[r][c8 + 2 * k + 1] = (unsigned short)f2bf(bf2f((unsigned short)(w[k] >> 16)) * sc);
        }
    }
    __syncthreads();
#pragma unroll
    for (int i = 0; i < 2; ++i) {
        const int ch = tid + i * 256, c = ch >> 3, r8 = (ch & 7) * 8;
        uint4 o;
        o.x = (unsigned)tl[r8 + 0][c] | ((unsigned)tl[r8 + 1][c] << 16); o.y = (unsigned)tl[r8 + 2][c] | ((unsigned)tl[r8 + 3][c] << 16);
        o.z = (unsigned)tl[r8 + 4][c] | ((unsigned)tl[r8 + 5][c] << 16); o.w = (unsigned)tl[r8 + 6][c] | ((unsigned)tl[r8 + 7][c] << 16);
        *(uint4*)(dst + (size_t)c * dst_ld + r8) = o;
    }
}

__device__ __forceinline__ void rope_table_fill(float2* __restrict__ cs, int gtid, int nth) {
    for (int idx = gtid; idx < 4096 * 64; idx += nth) {
        const int i = idx & 63, s = idx >> 6;
        const float inv = exp2f(-(float)i * 0.20762050593046014f);
        const float ang = (float)s * inv;
        float sn, c; sincosf(ang, &sn, &c);
        cs[idx] = make_float2(c, sn);
    }
}
__device__ __forceinline__ void rope_q_pass(bf16_t* __restrict__ aq, const float2* __restrict__ cs, size_t gtid, size_t nth) {
    for (size_t idx = gtid; idx < (size_t)T * 8 * 8; idx += nth) {
        const int c8 = (int)(idx & 7), hd = (int)((idx >> 3) & 7); const size_t t = idx >> 6; const int s = (int)(t & (S - 1));
        bf16_t* p = aq + t * 1024 + hd * 128 + c8 * 8;
        const uint4 a = *(const uint4*)p, b = *(const uint4*)(p + 64);
        const unsigned aw[4] = {a.x, a.y, a.z, a.w}, bw[4] = {b.x, b.y, b.z, b.w};
        unsigned ao[4], bo[4];
#pragma unroll
        for (int k = 0; k < 4; ++k) {
            const float4 cc = *(const float4*)(cs + (size_t)s * 64 + c8 * 8 + 2 * k);
            const float x10 = __uint_as_float(aw[k] << 16), x11 = __uint_as_float(aw[k] & 0xFFFF0000u), x20 = __uint_as_float(bw[k] << 16), x21 = __uint_as_float(bw[k] & 0xFFFF0000u);
            ao[k] = pk2(x10 * cc.x - x20 * cc.y, x11 * cc.z - x21 * cc.w);
            bo[k] = pk2(x20 * cc.x + x10 * cc.y, x21 * cc.z + x11 * cc.w);
        }
        *(uint4*)p = make_uint4(ao[0], ao[1], ao[2], ao[3]); *(uint4*)(p + 64) = make_uint4(bo[0], bo[1], bo[2], bo[3]);
    }
}
__device__ __forceinline__ void dil_tile_prep(int item, int lane, LAS unsigned short* wl, const bf16_t* __restrict__ ak, const bf16_t* __restrict__ av, const float2* __restrict__ cs,
                                              bf16_t* __restrict__ KB, bf16_t* __restrict__ VB) {
    const int TT = item & 255, hd = (item >> 8) & 7, b = (item >> 11) & 1, br = item >> 12;
    const int ld = 2 * br, tpr = 256 >> ld, rho = TT / tpr, tile = TT - rho * tpr;
    const int i = lane & 15, c = lane >> 4;
    const int s = rho + ((16 * tile + i) << ld);
    const size_t trow = (size_t)b * S + s;
    bf16_t* kdst = KB + (size_t)item * 2048;
    bf16_t* vdst = VB + (size_t)item * 2048;
    {
        const bf16_t* kr = ak + trow * 1024 + hd * 128 + 16 * c;
        const uint4 a0 = *(const uint4*)kr, a1 = *(const uint4*)(kr + 8), b0 = *(const uint4*)(kr + 64), b1 = *(const uint4*)(kr + 72);
        const unsigned aw[8] = {a0.x, a0.y, a0.z, a0.w, a1.x, a1.y, a1.z, a1.w}, bw[8] = {b0.x, b0.y, b0.z, b0.w, b1.x, b1.y, b1.z, b1.w};
        unsigned ao[8], bo[8];
#pragma unroll
        for (int k = 0; k < 8; ++k) {
            const float4 cc = *(const float4*)(cs + (size_t)s * 64 + 16 * c + 2 * k);
            const float x10 = __uint_as_float(aw[k] << 16), x11 = __uint_as_float(aw[k] & 0xFFFF0000u), x20 = __uint_as_float(bw[k] << 16), x21 = __uint_as_float(bw[k] & 0xFFFF0000u);
            ao[k] = pk2(x10 * cc.x - x20 * cc.y, x11 * cc.z - x21 * cc.w);
            bo[k] = pk2(x20 * cc.x + x10 * cc.y, x21 * cc.z + x11 * cc.w);
        }
        bf16_t* d0 = kdst + (c >> 1) * 512 + i * 32 + (c & 1) * 16;
        *(uint4*)d0 = make_uint4(ao[0], ao[1], ao[2], ao[3]); *(uint4*)(d0 + 8) = make_uint4(ao[4], ao[5], ao[6], ao[7]);
        bf16_t* d1 = d0 + 1024;
        *(uint4*)d1 = make_uint4(bo[0], bo[1], bo[2], bo[3]); *(uint4*)(d1 + 8) = make_uint4(bo[4], bo[5], bo[6], bo[7]);
    }
    {
        const bf16_t* vr = av + trow * 1024 + hd * 128 + 32 * c;
        const uint4 v0 = *(const uint4*)vr, v1 = *(const uint4*)(vr + 8), v2 = *(const uint4*)(vr + 16), v3 = *(const uint4*)(vr + 24);
        LAS unsigned short* wr = wl + i * 136 + 32 * c;
        typedef unsigned u32x4_t __attribute__((ext_vector_type(4)));
        *(LAS u32x4_t*)wr = (u32x4_t){v0.x, v0.y, v0.z, v0.w}; *(LAS u32x4_t*)(wr + 8) = (u32x4_t){v1.x, v1.y, v1.z, v1.w};
        *(LAS u32x4_t*)(wr + 16) = (u32x4_t){v2.x, v2.y, v2.z, v2.w}; *(LAS u32x4_t*)(wr + 24) = (u32x4_t){v3.x, v3.y, v3.z, v3.w};
        asm volatile("s_waitcnt lgkmcnt(0)" ::: "memory");
        unsigned o[16];
#pragma unroll
        for (int k = 0; k < 8; ++k) {
            const unsigned p0 = *(const LAS unsigned*)(wl + (2 * k) * 136 + 2 * lane), p1 = *(const LAS unsigned*)(wl + (2 * k + 1) * 136 + 2 * lane);
            o[k] = (p0 & 0xFFFFu) | (p1 << 16);
            o[8 + k] = (p0 >> 16) | (p1 & 0xFFFF0000u);
        }
        bf16_t* d = vdst + (2 * lane) * 16;
        *(uint4*)d = make_uint4(o[0], o[1], o[2], o[3]); *(uint4*)(d + 8) = make_uint4(o[4], o[5], o[6], o[7]);
        *(uint4*)(d + 16) = make_uint4(o[8], o[9], o[10], o[11]); *(uint4*)(d + 24) = make_uint4(o[12], o[13], o[14], o[15]);
        asm volatile("s_waitcnt lgkmcnt(0)" ::: "memory");
    }
}

typedef short bf16x8_t __attribute__((ext_vector_type(8)));
typedef short bf16x4_t __attribute__((ext_vector_type(4)));
typedef float f32x4_t __attribute__((ext_vector_type(4)));
__device__ __forceinline__ void dilated_wave_tile(int qt, int lane, const bf16_t* __restrict__ AQ, const bf16_t* __restrict__ KB, const bf16_t* __restrict__ VB,
                                                  const float* __restrict__ g_ahead, bf16_t* __restrict__ mix) {
    const int r = qt & 15, blk = (qt >> 4) & 15, hd = (qt >> 8) & 7, b = qt >> 11;
    const int j = lane & 15, g = lane >> 4;
    const int t0 = blk * 256;
    const int sq = t0 + r + 16 * j;
    bf16x8_t qf[4];
    {
        const bf16_t* qrow = AQ + ((size_t)b * S + sq) * 1024 + hd * 128 + 8 * g;
#pragma unroll
        for (int ks = 0; ks < 4; ++ks) qf[ks] = *(const bf16x8_t*)(qrow + 32 * ks);
    }
    const float sc = 0.08838834764831845f * 1.4426950408889634f;
    float m_run = -1e30f, l_run = 0.f;
    f32x4_t o[8];
#pragma unroll
    for (int dt = 0; dt < 8; ++dt) o[dt] = (f32x4_t){0.f, 0.f, 0.f, 0.f};
#pragma nounroll
    for (int br = 0; br < 3; ++br) {
        const int ld = 2 * br, d = 1 << ld;
        const int rho = r & (d - 1);
        const int qj = (sq - rho) >> ld;
        const int q_lo = ((t0 + r - rho) >> ld) - 128, q_hi = (t0 + r + 240 - rho) >> ld;
        const int tile_lo = q_lo < 0 ? 0 : (q_lo >> 4), tile_hi = q_hi >> 4, tile_max = (256 >> ld) - 1;
        const size_t tbase = ((size_t)((br * 2 + b) * 8 + hd) * 256 + (size_t)rho * (256 >> ld)) * 2048;
        const bf16_t* kbb = KB + tbase + j * 32 + 8 * g;
        const bf16_t* vbb = VB + tbase + j * 16 + 4 * g;
#pragma nounroll
        for (int tp = tile_lo; tp <= tile_hi; tp += 2) {
            f32x4_t su[2];
#pragma unroll
            for (int u = 0; u < 2; ++u) {
                int tl = tp + u; if (tl > tile_max) tl = tile_max;
                const bf16_t* krow = kbb + (size_t)tl * 2048;
                f32x4_t a = (f32x4_t){0.f, 0.f, 0.f, 0.f};
#pragma unroll
                for (int ks = 0; ks < 4; ++ks) a = __builtin_amdgcn_mfma_f32_16x16x32_bf16(*(const bf16x8_t*)(krow + 512 * ks), qf[ks], a, 0, 0, 0);
                su[u] = a;
            }
            float p[2][4]; float mx = -1e30f;
#pragma unroll
            for (int u = 0; u < 2; ++u)
#pragma unroll
                for (int e = 0; e < 4; ++e) {
                    const int n = qj - (16 * (tp + u) + 4 * g + e);
                    const bool valid = (n >= 0) && (n <= 128);
                    p[u][e] = valid ? su[u][e] * sc : -1e30f;
                    mx = fmaxf(mx, p[u][e]);
                }
            mx = fmaxf(mx, __shfl_xor(mx, 16)); mx = fmaxf(mx, __shfl_xor(mx, 32));
            const float m_new = fmaxf(m_run, mx);
            const float alpha = __builtin_amdgcn_exp2f(m_run - m_new);
            m_run = m_new;
            float ps = 0.f;
#pragma unroll
            for (int u = 0; u < 2; ++u)
#pragma unroll
                for (int e = 0; e < 4; ++e) { p[u][e] = (p[u][e] > -1e29f) ? __builtin_amdgcn_exp2f(p[u][e] - m_new) : 0.f; ps += p[u][e]; }
            l_run = l_run * alpha + ps;
            bf16x8_t pb;
            {
                const unsigned w0 = pk2(p[0][0], p[0][1]), w1 = pk2(p[0][2], p[0][3]), w2 = pk2(p[1][0], p[1][1]), w3 = pk2(p[1][2], p[1][3]);
                pb[0] = (short)(w0 & 0xFFFF); pb[1] = (short)(w0 >> 16); pb[2] = (short)(w1 & 0xFFFF); pb[3] = (short)(w1 >> 16);
                pb[4] = (short)(w2 & 0xFFFF); pb[5] = (short)(w2 >> 16); pb[6] = (short)(w3 & 0xFFFF); pb[7] = (short)(w3 >> 16);
            }
            int tl0 = tp, tl1 = tp + 1; if (tl0 > tile_max) tl0 = tile_max; if (tl1 > tile_max) tl1 = tile_max;
#pragma unroll
            for (int dt = 0; dt < 8; ++dt) {
                const bf16_t* vrow = vbb + dt * 256;
                const bf16x4_t v0 = *(const bf16x4_t*)(vrow + (size_t)tl0 * 2048), v1 = *(const bf16x4_t*)(vrow + (size_t)tl1 * 2048);
                bf16x8_t va; va[0] = v0[0]; va[1] = v0[1]; va[2] = v0[2]; va[3] = v0[3]; va[4] = v1[0]; va[5] = v1[1]; va[6] = v1[2]; va[7] = v1[3];
                f32x4_t oo = o[dt]; oo = oo * alpha;
                o[dt] = __builtin_amdgcn_mfma_f32_16x16x32_bf16(va, pb, oo, 0, 0, 0);
            }
        }
    }
    float lt = l_run; lt += __shfl_xor(lt, 16); lt += __shfl_xor(lt, 32);
    const float inv = 1.0f / lt;
    float ss = 0.f;
#pragma unroll
    for (int dt = 0; dt < 8; ++dt) { o[dt] = o[dt] * inv; ss += (o[dt][0] * o[dt][0] + o[dt][1] * o[dt][1]) + (o[dt][2] * o[dt][2] + o[dt][3] * o[dt][3]); }
    ss += __shfl_xor(ss, 16); ss += __shfl_xor(ss, 32);
    const float rn = rsqrtf(ss * (1.0f / 128.0f) + EPS);
    bf16_t* orow = mix + ((size_t)b * S + sq) * D + 1024 + hd * 128 + 4 * g;
#pragma unroll
    for (int dt = 0; dt < 8; ++dt) {
        const f32x4_t gv = *(const f32x4_t*)(g_ahead + hd * 128 + 16 * dt + 4 * g);
        uint2 w; w.x = pk2(o[dt][0] * rn * gv[0], o[dt][1] * rn * gv[1]); w.y = pk2(o[dt][2] * rn * gv[2], o[dt][3] * rn * gv[3]);
        *(uint2*)(orow + 16 * dt) = w;
    }
}

__device__ __forceinline__ unsigned ord_key(float s) { const unsigned u = __float_as_uint(s); return u ^ ((unsigned)((int)u >> 31) | 0x80000000u); }
__device__ __forceinline__ unsigned wave_max_u32(unsigned v) {
    unsigned t;
    t = (unsigned)__builtin_amdgcn_update_dpp(0, (int)v, 0xB1, 0xF, 0xF, true); v = v > t ? v : t;
    t = (unsigned)__builtin_amdgcn_update_dpp(0, (int)v, 0x4E, 0xF, 0xF, true); v = v > t ? v : t;
    t = (unsigned)__builtin_amdgcn_update_dpp(0, (int)v, 0x141, 0xF, 0xF, true); v = v > t ? v : t;
    t = (unsigned)__builtin_amdgcn_update_dpp(0, (int)v, 0x140, 0xF, 0xF, true); v = v > t ? v : t;
    const unsigned a = (unsigned)__builtin_amdgcn_readlane((int)v, 0), b = (unsigned)__builtin_amdgcn_readlane((int)v, 16),
                   c = (unsigned)__builtin_amdgcn_readlane((int)v, 32), d = (unsigned)__builtin_amdgcn_readlane((int)v, 48);
    const unsigned ab = a > b ? a : b, cd = c > d ? c : d;
    return ab > cd ? ab : cd;
}
__device__ __forceinline__ void peer_topk_wave(int item, int lane, LAS float* wl, const bf16_t* __restrict__ qp, const bf16_t* __restrict__ skb, int* __restrict__ ids, float* __restrict__ gates) {
    const int hd = item & 7, tt = item >> 3, j = lane & 15, g = lane >> 4;
    const size_t t0 = (size_t)tt * 16;
    LAS float* sc = wl;
    LAS float* lst = wl + 2048;
#pragma unroll 1
    for (int p = 0; p < 2; ++p) {
        bf16x8_t qf[4];
        const bf16_t* qrow = qp + (t0 + j) * D + hd * 256 + p * 128 + 8 * g;
#pragma unroll
        for (int ks = 0; ks < 4; ++ks) qf[ks] = *(const bf16x8_t*)(qrow + 32 * ks);
        const bf16_t* kb = skb + ((size_t)(hd * 2 + p) * 128 + j) * 128 + 8 * g;
#pragma unroll
        for (int kt = 0; kt < 8; ++kt) {
            f32x4_t a = (f32x4_t){0.f, 0.f, 0.f, 0.f};
#pragma unroll
            for (int ks = 0; ks < 4; ++ks) a = __builtin_amdgcn_mfma_f32_16x16x32_bf16(*(const bf16x8_t*)(kb + (size_t)kt * (16 * 128) + 32 * ks), qf[ks], a, 0, 0, 0);
            *(LAS f32x4_t*)(sc + j * 128 + 16 * kt + 4 * g) = a;
        }
        asm volatile("s_waitcnt lgkmcnt(0)" ::: "memory");
#pragma unroll 1
        for (int tok = 0; tok < 16; ++tok) {
            const float s0 = sc[tok * 128 + lane], s1 = sc[tok * 128 + 64 + lane];
            unsigned k0 = (ord_key(s0) & ~127u) | (unsigned)(127 - lane), k1 = (ord_key(s1) & ~127u) | (unsigned)(63 - lane);
            unsigned sel = 0u;
#pragma unroll 4
            for (int it = 0; it < 16; ++it) {
                unsigned m = k0 > k1 ? k0 : k1;
                m = wave_max_u32(m);
                if (lane == it) sel = m;
                if (k0 == m) k0 = 0u;
                if (k1 == m) k1 = 0u;
            }
            if (lane < 16) {
                const int idx = 127 - (int)(sel & 127u);
                lst[((p * 16 + tok) * 16 + lane) * 2 + 0] = sc[tok * 128 + idx];
                lst[((p * 16 + tok) * 16 + lane) * 2 + 1] = __int_as_float(idx);
            }
        }
        asm volatile("s_waitcnt lgkmcnt(0)" ::: "memory");
    }
#pragma unroll 1
    for (int tok = 0; tok < 16; ++tok) {
        const int i = lane >> 2;
        const float sA = lst[((0 * 16 + tok) * 16 + i) * 2];
        unsigned kk[4];
#pragma unroll
        for (int r = 0; r < 4; ++r) {
            const int jb = (lane & 3) * 4 + r;
            const float sum = sA + lst[((1 * 16 + tok) * 16 + jb) * 2];
            kk[r] = (ord_key(sum) & ~255u) | (unsigned)(255 - (lane * 4 + r));
        }
        unsigned sel = 0u;
#pragma unroll 4
        for (int it = 0; it < 16; ++it) {
            unsigned m = kk[0] > kk[1] ? kk[0] : kk[1]; const unsigned m2 = kk[2] > kk[3] ? kk[2] : kk[3]; m = m > m2 ? m : m2;
            m = wave_max_u32(m);
            if (lane == it) sel = m;
#pragma unroll
            for (int r = 0; r < 4; ++r) if (kk[r] == m) kk[r] = 0u;
        }
        float bs = -INFINITY; int eid = 0;
        if (lane < 16) {
            const int c = 255 - (int)(sel & 255u), ia = c >> 4, ib = c & 15;
            bs = lst[((0 * 16 + tok) * 16 + ia) * 2] + lst[((1 * 16 + tok) * 16 + ib) * 2];
            eid = __float_as_int(lst[((0 * 16 + tok) * 16 + ia) * 2 + 1]) * 128 + __float_as_int(lst[((1 * 16 + tok) * 16 + ib) * 2 + 1]);
        }
        const float mx = wave_max(bs);
        const float ev = lane < 16 ? __expf(bs - mx) : 0.f;
        const float tot = wave_sum(ev);
        if (lane < 16) {
            ids[(t0 + tok) * 128 + hd * 16 + lane] = eid;
            gates[(t0 + tok) * 128 + hd * 16 + lane] = ev / tot;
        }
    }
}

typedef float f32x2_t __attribute__((ext_vector_type(2)));
__device__ __forceinline__ void table_row_to_fp8(const float* __restrict__ srow, unsigned char* __restrict__ drow, float* __restrict__ rscale, int lane, const float* __restrict__ dgain) {
    float4 f[8];
#pragma unroll
    for (int i = 0; i < 8; ++i) f[i] = *(const float4*)(srow + i * 256 + lane * 4);
    if (dgain) {
#pragma unroll
        for (int i = 0; i < 8; ++i) { const float4 gq = *(const float4*)(dgain + i * 256 + lane * 4); f[i].x *= gq.x; f[i].y *= gq.y; f[i].z *= gq.z; f[i].w *= gq.w; }
    }
    float am = 0.f;
#pragma unroll
    for (int i = 0; i < 8; ++i) am = fmaxf(am, fmaxf(fmaxf(fabsf(f[i].x), fabsf(f[i].y)), fmaxf(fabsf(f[i].z), fabsf(f[i].w))));
    am = wave_max(am);
    const float e = floorf(log2f(448.0f / fmaxf(am, 1e-30f)));
    const float s = exp2f(fminf(e, 100.0f));
    unsigned w[8];
#pragma unroll
    for (int i = 0; i < 8; ++i) {
        int t = 0;
        t = __builtin_amdgcn_cvt_pk_fp8_f32(f[i].x * s, f[i].y * s, t, false);
        t = __builtin_amdgcn_cvt_pk_fp8_f32(f[i].z * s, f[i].w * s, t, true);
        w[i] = (unsigned)t;
    }
#pragma unroll
    for (int i = 0; i < 8; ++i) *(unsigned*)(drow + i * 256 + lane * 4) = w[i];
    if (lane == 0) *rscale = 1.0f / s;
}
__device__ __forceinline__ void table_row_to_i8(const float* __restrict__ srow, unsigned char* __restrict__ drow, float* __restrict__ rscale, int lane, const float* __restrict__ dgain) {
    float4 f[8];
#pragma unroll
    for (int i = 0; i < 8; ++i) { f[i] = *(const float4*)(srow + i * 256 + lane * 4); const float4 gq = *(const float4*)(dgain + i * 256 + lane * 4); f[i].x *= gq.x; f[i].y *= gq.y; f[i].z *= gq.z; f[i].w *= gq.w; }
    float am = 0.f;
#pragma unroll
    for (int i = 0; i < 8; ++i) am = fmaxf(am, fmaxf(fmaxf(fabsf(f[i].x), fabsf(f[i].y)), fmaxf(fabsf(f[i].z), fabsf(f[i].w))));
    am = wave_max(am);
    const float s = exp2f(fminf(floorf(log2f(127.0f / fmaxf(am, 1e-30f))), 100.0f));
#pragma unroll
    for (int i = 0; i < 8; ++i) {
        const int q0 = __float2int_rn(f[i].x * s), q1 = __float2int_rn(f[i].y * s), q2 = __float2int_rn(f[i].z * s), q3 = __float2int_rn(f[i].w * s);
        *(unsigned*)(drow + i * 256 + lane * 4) = ((unsigned)q0 & 255u) | (((unsigned)q1 & 255u) << 8) | (((unsigned)q2 & 255u) << 16) | (((unsigned)q3 & 255u) << 24);
    }
    if (lane == 0) *rscale = 1.0f / s;
}
__device__ __forceinline__ float dot16_fp8(const uint4 q, const float* x) {
    float d = 0.f;
    const unsigned w[4] = {q.x, q.y, q.z, q.w};
#pragma unroll
    for (int k = 0; k < 4; ++k) {
        const f32x2_t lo = __builtin_amdgcn_cvt_pk_f32_fp8((int)w[k], false), hi = __builtin_amdgcn_cvt_pk_f32_fp8((int)w[k], true);
        d = fmaf(lo.x, x[4 * k], d); d = fmaf(lo.y, x[4 * k + 1], d); d = fmaf(hi.x, x[4 * k + 2], d); d = fmaf(hi.y, x[4 * k + 3], d);
    }
    return d;
}
__device__ __forceinline__ void axpy16_fp8(const uint4 q, float c, float* acc) {
    const unsigned w[4] = {q.x, q.y, q.z, q.w};
#pragma unroll
    for (int k = 0; k < 4; ++k) {
        const f32x2_t lo = __builtin_amdgcn_cvt_pk_f32_fp8((int)w[k], false), hi = __builtin_amdgcn_cvt_pk_f32_fp8((int)w[k], true);
        acc[4 * k] = fmaf(c, lo.x, acc[4 * k]); acc[4 * k + 1] = fmaf(c, lo.y, acc[4 * k + 1]); acc[4 * k + 2] = fmaf(c, hi.x, acc[4 * k + 2]); acc[4 * k + 3] = fmaf(c, hi.y, acc[4 * k + 3]);
    }
}
__device__ __forceinline__ void d_peer_out8(int vb, int tid, float* sm, const bf16_t* __restrict__ h3, const float* __restrict__ x2, const int* __restrict__ ids, const float* __restrict__ gates,
                                            const unsigned char* __restrict__ ut8, const unsigned char* __restrict__ vt8, const float* __restrict__ rsc, const float* __restrict__ rstd, const float* __restrict__ g_final, float* __restrict__ out) {
    float (*part)[2048] = (float (*)[2048])sm;
    float* red = sm + 4 * 2048;
    const int lane = tid & 63, w = tid >> 6, t = vb;
    float x[32], acc[32];
    {
        const bf16_t* hrow = h3 + (size_t)t * D + lane * 16;
#pragma unroll
        for (int hh = 0; hh < 2; ++hh) {
            const uint4 a = *(const uint4*)(hrow + hh * 1024), b = *(const uint4*)(hrow + hh * 1024 + 8);
            const unsigned ww[8] = {a.x, a.y, a.z, a.w, b.x, b.y, b.z, b.w};
#pragma unroll
            for (int k = 0; k < 8; ++k) { x[hh * 16 + 2 * k] = __uint_as_float(ww[k] << 16); x[hh * 16 + 2 * k + 1] = __uint_as_float(ww[k] & 0xFFFF0000u); }
        }
#pragma unroll
        for (int i = 0; i < 32; ++i) acc[i] = 0.f;
    }
    const float xrs = rstd[t];
    const int myid = ids[(size_t)t * 128 + w * 32 + (lane & 31)];
    const float mygate = gates[(size_t)t * 128 + w * 32 + (lane & 31)];
#pragma unroll 1
    for (int j = 0; j < 32; j += 4) {
        int e[4]; uint4 uq[4][2], vq[4][2];
#pragma unroll
        for (int q = 0; q < 4; ++q) {
            e[q] = __builtin_amdgcn_readfirstlane(__shfl(myid, j + q));
            const unsigned char* ur = ut8 + (size_t)e[q] * 2048 + lane * 16;
            uq[q][0] = *(const uint4*)ur; uq[q][1] = *(const uint4*)(ur + 1024);
        }
#pragma unroll
        for (int q = 0; q < 4; ++q) {
            const unsigned char* vr = vt8 + (size_t)e[q] * 2048 + lane * 16;
            vq[q][0] = *(const uint4*)vr; vq[q][1] = *(const uint4*)(vr + 1024);
        }
        float d[4];
#pragma unroll
        for (int q = 0; q < 4; ++q) d[q] = dot16_fp8(uq[q][0], x) + dot16_fp8(uq[q][1], x + 16);
#pragma unroll
        for (int o = 32; o >= 1; o >>= 1) {
#pragma unroll
            for (int q = 0; q < 4; ++q) d[q] += __shfl_xor(d[q], o);
        }
#pragma unroll
        for (int q = 0; q < 4; ++q) {
            const float a = d[q] * rsc[e[q]] * xrs;
            const float act = 0.5f * a * (1.0f + erff(a * 0.7071067811865476f));
            const float cf = __shfl(mygate, j + q) * act * rsc[16384 + e[q]];
            axpy16_fp8(vq[q][0], cf, acc); axpy16_fp8(vq[q][1], cf, acc + 16);
        }
    }
    __syncthreads();
#pragma unroll
    for (int hh = 0; hh < 2; ++hh)
#pragma unroll
        for (int k = 0; k < 4; ++k) *(float4*)&part[w][hh * 1024 + lane * 16 + 4 * k] = make_float4(acc[hh * 16 + 4 * k], acc[hh * 16 + 4 * k + 1], acc[hh * 16 + 4 * k + 2], acc[hh * 16 + 4 * k + 3]);
    __syncthreads();
    float4 r0, r1;
    {
        const float4 a = *(const float4*)&part[0][tid * 4], b = *(const float4*)&part[1][tid * 4], c = *(const float4*)&part[2][tid * 4], dd = *(const float4*)&part[3][tid * 4];
        const float4 xx = *(const float4*)(x2 + (size_t)t * D + tid * 4);
        r0 = make_float4(xx.x + a.x + b.x + c.x + dd.x, xx.y + a.y + b.y + c.y + dd.y, xx.z + a.z + b.z + c.z + dd.z, xx.w + a.w + b.w + c.w + dd.w);
    }
    {
        const float4 a = *(const float4*)&part[0][1024 + tid * 4], b = *(const float4*)&part[1][1024 + tid * 4], c = *(const float4*)&part[2][1024 + tid * 4], dd = *(const float4*)&part[3][1024 + tid * 4];
        const float4 xx = *(const float4*)(x2 + (size_t)t * D + 1024 + tid * 4);
        r1 = make_float4(xx.x + a.x + b.x + c.x + dd.x, xx.y + a.y + b.y + c.y + dd.y, xx.z + a.z + b.z + c.z + dd.z, xx.w + a.w + b.w + c.w + dd.w);
    }
    float s = r0.x * r0.x + r0.y * r0.y + r0.z * r0.z + r0.w * r0.w + r1.x * r1.x + r1.y * r1.y + r1.z * r1.z + r1.w * r1.w;
    s = wave_sum(s);
    if (lane == 0) red[w] = s;
    __syncthreads();
    const float tot = red[0] + red[1] + red[2] + red[3];
    const float r = rsqrtf(tot * (1.0f / D) + EPS);
    const float4 g0 = *(const float4*)(g_final + tid * 4), g1 = *(const float4*)(g_final + 1024 + tid * 4);
    *(float4*)(out + (size_t)t * D + tid * 4) = make_float4(r0.x * r * g0.x, r0.y * r * g0.y, r0.z * r * g0.z, r0.w * r * g0.w);
    *(float4*)(out + (size_t)t * D + 1024 + tid * 4) = make_float4(r1.x * r * g1.x, r1.y * r * g1.y, r1.z * r * g1.z, r1.w * r * g1.w);
}

__device__ __forceinline__ unsigned xg_sum_u32(unsigned v) {
    auto a = __builtin_amdgcn_permlane16_swap(v, v, false, false); v = a[0] + a[1];
    auto b = __builtin_amdgcn_permlane32_swap(v, v, false, false); return b[0] + b[1];
}
__device__ __forceinline__ float xg_sum_f32(float v) {
    auto a = __builtin_amdgcn_permlane16_swap(__float_as_uint(v), __float_as_uint(v), false, false); v = __uint_as_float(a[0]) + __uint_as_float(a[1]);
    auto b = __builtin_amdgcn_permlane32_swap(__float_as_uint(v), __float_as_uint(v), false, false); return __uint_as_float(b[0]) + __uint_as_float(b[1]);
}
__device__ __forceinline__ float xg_max_f32(float v) {
    auto a = __builtin_amdgcn_permlane16_swap(__float_as_uint(v), __float_as_uint(v), false, false); v = fmaxf(__uint_as_float(a[0]), __uint_as_float(a[1]));
    auto b = __builtin_amdgcn_permlane32_swap(__float_as_uint(v), __float_as_uint(v), false, false); return fmaxf(__uint_as_float(b[0]), __uint_as_float(b[1]));
}
template <int N> __device__ __forceinline__ unsigned bisect16(const unsigned (&kk)[N]) {
    unsigned tau = 0u; bool done = false;
#pragma unroll 1
    for (int bit = 31; bit >= 0; --bit) {
        const unsigned cand = tau | (1u << bit);
        unsigned c = 0u;
#pragma unroll
        for (int i = 0; i < N; ++i) c += (kk[i] >= cand) ? 1u : 0u;
        c = xg_sum_u32(c);
        if (!done && c >= 16u) { tau = cand; done = (c == 16u); }
        if (__all(done ? 1 : 0)) break;
    }
    return tau;
}
__device__ __forceinline__ void peer_topk_wave2(int item, int lane, LAS float* wl, const bf16_t* __restrict__ qp, const bf16_t* __restrict__ skb, int* __restrict__ ids, float* __restrict__ gates) {
    const int hd = item & 7, tt = item >> 3, j = lane & 15, g = lane >> 4;
    const size_t t0 = (size_t)tt * 16;
#pragma unroll 1
    for (int p = 0; p < 2; ++p) {
        bf16x8_t qf[4];
        const bf16_t* qrow = qp + (t0 + j) * D + hd * 256 + p * 128 + 8 * g;
#pragma unroll
        for (int ks = 0; ks < 4; ++ks) qf[ks] = *(const bf16x8_t*)(qrow + 32 * ks);
        const bf16_t* kb = skb + ((size_t)(hd * 2 + p) * 128 + j) * 128 + 8 * g;
        float sc[32]; unsigned kk[32];
#pragma unroll
        for (int kt = 0; kt < 8; ++kt) {
            f32x4_t a = (f32x4_t){0.f, 0.f, 0.f, 0.f};
#pragma unroll
            for (int ks = 0; ks < 4; ++ks) a = __builtin_amdgcn_mfma_f32_16x16x32_bf16(*(const bf16x8_t*)(kb + (size_t)kt * (16 * 128) + 32 * ks), qf[ks], a, 0, 0, 0);
#pragma unroll
            for (int r = 0; r < 4; ++r) { sc[kt * 4 + r] = a[r]; kk[kt * 4 + r] = (ord_key(a[r]) & ~127u) | (unsigned)(127 - (16 * kt + 4 * g + r)); }
        }
        const unsigned tau = bisect16<32>(kk);
        unsigned cnt = 0u;
#pragma unroll
        for (int i = 0; i < 32; ++i) cnt += (kk[i] >= tau) ? 1u : 0u;
        const unsigned c0 = (unsigned)__shfl((int)cnt, j), c1 = (unsigned)__shfl((int)cnt, j + 16), c2 = (unsigned)__shfl((int)cnt, j + 32);
        unsigned off = (g > 0 ? c0 : 0u) + (g > 1 ? c1 : 0u) + (g > 2 ? c2 : 0u);
        LAS float* ls = wl + p * 256 + j * 16;
        LAS float* li = wl + 512 + p * 256 + j * 16;
#pragma unroll
        for (int i = 0; i < 32; ++i) {
            if (kk[i] >= tau && off < 16u) { ls[off] = sc[i]; li[off] = __int_as_float(16 * (i >> 2) + 4 * g + (i & 3)); ++off; }
        }
    }
    asm volatile("s_waitcnt lgkmcnt(0)" ::: "memory");
    {
        float sA[4], sB[16]; int iA[4];
        {
            const f32x4_t a = *(const LAS f32x4_t*)(wl + j * 16 + 4 * g);
            const f32x4_t ai = *(const LAS f32x4_t*)(wl + 512 + j * 16 + 4 * g);
#pragma unroll
            for (int r = 0; r < 4; ++r) { sA[r] = a[r]; iA[r] = __float_as_int(ai[r]); }
#pragma unroll
            for (int q = 0; q < 4; ++q) { const f32x4_t b = *(const LAS f32x4_t*)(wl + 256 + j * 16 + 4 * q); sB[4 * q] = b[0]; sB[4 * q + 1] = b[1]; sB[4 * q + 2] = b[2]; sB[4 * q + 3] = b[3]; }
        }
        unsigned kk[64];
#pragma unroll
        for (int a = 0; a < 4; ++a)
#pragma unroll
            for (int b = 0; b < 16; ++b) kk[a * 16 + b] = (ord_key(sA[a] + sB[b]) & ~255u) | (unsigned)(255 - ((4 * g + a) * 16 + b));
        const unsigned tau = bisect16<64>(kk);
        float mx = -INFINITY; unsigned cnt = 0u;
#pragma unroll
        for (int i = 0; i < 64; ++i) if (kk[i] >= tau) { mx = fmaxf(mx, sA[i >> 4] + sB[i & 15]); ++cnt; }
        mx = xg_max_f32(mx);
        float es = 0.f;
#pragma unroll
        for (int i = 0; i < 64; ++i) if (kk[i] >= tau) es += __expf(sA[i >> 4] + sB[i & 15] - mx);
        const float inv = 1.0f / xg_sum_f32(es);
        const unsigned c0 = (unsigned)__shfl((int)cnt, j), c1 = (unsigned)__shfl((int)cnt, j + 16), c2 = (unsigned)__shfl((int)cnt, j + 32);
        unsigned off = (g > 0 ? c0 : 0u) + (g > 1 ? c1 : 0u) + (g > 2 ? c2 : 0u);
        int* idp = ids + (t0 + j) * 128 + hd * 16;
        float* gtp = gates + (t0 + j) * 128 + hd * 16;
        const LAS float* liB = wl + 512 + 256 + j * 16;
#pragma unroll
        for (int i = 0; i < 64; ++i) {
            if (kk[i] >= tau && off < 16u) {
                idp[off] = iA[i >> 4] * 128 + __float_as_int(liB[i & 15]);
                gtp[off] = __expf(sA[i >> 4] + sB[i & 15] - mx) * inv;
                ++off;
            }
        }
    }
}

__device__ __forceinline__ float wave_sum_dpp(float v) {
    v += __uint_as_float((unsigned)__builtin_amdgcn_update_dpp(0, (int)__float_as_uint(v), 0xB1, 0xF, 0xF, true));
    v += __uint_as_float((unsigned)__builtin_amdgcn_update_dpp(0, (int)__float_as_uint(v), 0x4E, 0xF, 0xF, true));
    v += __uint_as_float((unsigned)__builtin_amdgcn_update_dpp(0, (int)__float_as_uint(v), 0x141, 0xF, 0xF, true));
    v += __uint_as_float((unsigned)__builtin_amdgcn_update_dpp(0, (int)__float_as_uint(v), 0x140, 0xF, 0xF, true));
    const float a = __uint_as_float((unsigned)__builtin_amdgcn_readlane((int)__float_as_uint(v), 0)), b = __uint_as_float((unsigned)__builtin_amdgcn_readlane((int)__float_as_uint(v), 16)),
                c = __uint_as_float((unsigned)__builtin_amdgcn_readlane((int)__float_as_uint(v), 32)), d = __uint_as_float((unsigned)__builtin_amdgcn_readlane((int)__float_as_uint(v), 48));
    return (a + b) + (c + d);
}
typedef __bf16 bf16x2v_t __attribute__((ext_vector_type(2)));
__device__ __forceinline__ int wave_sum_all_i32(int v) {
    v += __builtin_amdgcn_update_dpp(0, v, 0xB1, 0xF, 0xF, true);
    v += __builtin_amdgcn_update_dpp(0, v, 0x4E, 0xF, 0xF, true);
    v += __builtin_amdgcn_update_dpp(0, v, 0x141, 0xF, 0xF, true);
    v += __builtin_amdgcn_update_dpp(0, v, 0x140, 0xF, 0xF, true);
    auto a = __builtin_amdgcn_permlane16_swap((unsigned)v, (unsigned)v, false, false); v = (int)(a[0] + a[1]);
    auto b = __builtin_amdgcn_permlane32_swap((unsigned)v, (unsigned)v, false, false); return (int)(b[0] + b[1]);
}
__device__ __forceinline__ float wave_sum_all(float v) {
    v += __uint_as_float((unsigned)__builtin_amdgcn_update_dpp(0, (int)__float_as_uint(v), 0xB1, 0xF, 0xF, true));
    v += __uint_as_float((unsigned)__builtin_amdgcn_update_dpp(0, (int)__float_as_uint(v), 0x4E, 0xF, 0xF, true));
    v += __uint_as_float((unsigned)__builtin_amdgcn_update_dpp(0, (int)__float_as_uint(v), 0x141, 0xF, 0xF, true));
    v += __uint_as_float((unsigned)__builtin_amdgcn_update_dpp(0, (int)__float_as_uint(v), 0x140, 0xF, 0xF, true));
    auto a = __builtin_amdgcn_permlane16_swap(__float_as_uint(v), __float_as_uint(v), false, false); v = __uint_as_float(a[0]) + __uint_as_float(a[1]);
    auto b = __builtin_amdgcn_permlane32_swap(__float_as_uint(v), __float_as_uint(v), false, false); return __uint_as_float(b[0]) + __uint_as_float(b[1]);
}
__device__ __forceinline__ float dot16_fp8_bf16(const uint4 q, const uint4 xa, const uint4 xb, float d) {
    const unsigned w[4] = {q.x, q.y, q.z, q.w};
    const unsigned xw[8] = {xa.x, xa.y, xa.z, xa.w, xb.x, xb.y, xb.z, xb.w};
#pragma unroll
    for (int k = 0; k < 4; ++k) {
        const bf16x2v_t lo = __builtin_amdgcn_cvt_scalef32_pk_bf16_fp8(w[k], 1.0f, false), hi = __builtin_amdgcn_cvt_scalef32_pk_bf16_fp8(w[k], 1.0f, true);
        d = __builtin_amdgcn_fdot2_f32_bf16(lo, __builtin_bit_cast(bf16x2v_t, xw[2 * k]), d, false);
        d = __builtin_amdgcn_fdot2_f32_bf16(hi, __builtin_bit_cast(bf16x2v_t, xw[2 * k + 1]), d, false);
    }
    return d;
}
__device__ __forceinline__ void axpy16_fp8_pk(const uint4 q, const f32x2_t c2, f32x2_t* acc) {
    const unsigned w[4] = {q.x, q.y, q.z, q.w};
#pragma unroll
    for (int k = 0; k < 4; ++k) {
        const f32x2_t lo = __builtin_amdgcn_cvt_pk_f32_fp8((int)w[k], false), hi = __builtin_amdgcn_cvt_pk_f32_fp8((int)w[k], true);
        acc[2 * k] = __builtin_elementwise_fma(c2, lo, acc[2 * k]); acc[2 * k + 1] = __builtin_elementwise_fma(c2, hi, acc[2 * k + 1]);
    }
}
__device__ __forceinline__ float gelu_as(float v) {
    const float av = fabsf(v), t = __builtin_amdgcn_rcpf(av * 0.2316418882f + 1.0f);
    float q = t * 0.5307027145f + (-0.7265760135f); q = q * t + 0.7107068705f; q = q * t + (-0.142248368f); q = q * t + 0.127414796f; q = q * t;
    const float e = __builtin_amdgcn_exp2f((v * v) * (-0.72134752044f));
    const float m = v * (q * e);
    return v < 0.f ? m : v - m;
}
__device__ __forceinline__ void peer_sweep_wave(int gw, int lane, LAS unsigned char* wl, const bf16_t* __restrict__ h3, const float* __restrict__ x2, const int* __restrict__ ids,
                                                const float* __restrict__ gates, const unsigned char* __restrict__ ut8, const unsigned char* __restrict__ vt8, const float* __restrict__ rsc,
                                                const float* __restrict__ rstd, const float* __restrict__ g_final, float* __restrict__ out) {
    typedef unsigned u32x4_t __attribute__((ext_vector_type(4)));
    typedef int i32x4_t __attribute__((ext_vector_type(4)));
    LAS unsigned char* x8 = wl;
    LAS unsigned* sorted = (LAS unsigned*)(wl + 8192);
    LAS unsigned* cnt = (LAS unsigned*)(wl + 8192 + 2048);
    LAS unsigned* base = (LAS unsigned*)(wl + 8192 + 2048 + 256);
    LAS unsigned short* gsv = (LAS unsigned short*)(wl + 8192 + 2048 + 512);
    const size_t t0 = (size_t)gw * 4;
    float fac = 0.f;
#pragma unroll
    for (int tok = 0; tok < 4; ++tok) {
        uint4 xv[4]; float am = 0.f;
#pragma unroll
        for (int c = 0; c < 4; ++c) {
            xv[c] = *(const uint4*)(h3 + (t0 + tok) * D + c * 512 + lane * 8);
            const unsigned w[4] = {xv[c].x, xv[c].y, xv[c].z, xv[c].w};
#pragma unroll
            for (int k = 0; k < 4; ++k) am = fmaxf(am, fmaxf(fabsf(__uint_as_float(w[k] << 16)), fabsf(__uint_as_float(w[k] & 0xFFFF0000u))));
        }
        am = wave_max(am);
        const float s = exp2f(fminf(floorf(log2f(127.0f / fmaxf(am, 1e-30f))), 100.0f));
        if ((lane & 3) == tok) fac = rstd[t0 + tok] / s;
#pragma unroll
        for (int c = 0; c < 4; ++c) {
            const unsigned w[4] = {xv[c].x, xv[c].y, xv[c].z, xv[c].w};
            unsigned o[2];
#pragma unroll
            for (int h = 0; h < 2; ++h) {
                const int q0 = __float2int_rn(__uint_as_float(w[2 * h] << 16) * s), q1 = __float2int_rn(__uint_as_float(w[2 * h] & 0xFFFF0000u) * s);
                const int q2 = __float2int_rn(__uint_as_float(w[2 * h + 1] << 16) * s), q3 = __float2int_rn(__uint_as_float(w[2 * h + 1] & 0xFFFF0000u) * s);
                o[h] = ((unsigned)q0 & 255u) | (((unsigned)q1 & 255u) << 8) | (((unsigned)q2 & 255u) << 16) | (((unsigned)q3 & 255u) << 24);
            }
            typedef unsigned u32x2_t __attribute__((ext_vector_type(2)));
            *(LAS u32x2_t*)(x8 + tok * 2048 + c * 512 + lane * 8) = (u32x2_t){o[0], o[1]};
        }
    }
    cnt[lane] = 0u;
    asm volatile("s_waitcnt lgkmcnt(0)" ::: "memory");
    unsigned key[8], rk[8]; unsigned short fv[8];
#pragma unroll
    for (int r = 0; r < 8; ++r) {
        const int n = r * 64 + lane;
        const unsigned e = (unsigned)ids[t0 * 128 + n];
        key[r] = (e << 9) | (unsigned)n | (__float_as_uint(rsc[e]) & 0x7F800000u);
        fv[r] = (unsigned short)f2bf(gates[t0 * 128 + n] * rsc[16384 + e]);
        rk[r] = __hip_atomic_fetch_add(&cnt[e >> 8], 1u, __ATOMIC_RELAXED, __HIP_MEMORY_SCOPE_WORKGROUP);
    }
    asm volatile("s_waitcnt lgkmcnt(0)" ::: "memory");
    {
        const unsigned c = cnt[lane];
        unsigned incl = c;
#pragma unroll
        for (int o = 1; o < 64; o <<= 1) { const unsigned t = (unsigned)__shfl_up((int)incl, o); if (lane >= o) incl += t; }
        base[lane] = incl - c;
    }
    asm volatile("s_waitcnt lgkmcnt(0)" ::: "memory");
#pragma unroll
    for (int r = 0; r < 8; ++r) { const unsigned pos = base[(key[r] >> 17) & 63u] + rk[r]; sorted[pos] = key[r]; gsv[pos] = fv[r]; }
    asm volatile("s_waitcnt lgkmcnt(0)" ::: "memory");
    float rs4[4];
#pragma unroll
    for (int tok = 0; tok < 4; ++tok) rs4[tok] = __uint_as_float((unsigned)__builtin_amdgcn_readlane((int)__float_as_uint(fac), tok));
#define P1_LOAD(ENT, UQ, I0) _Pragma("unroll") for (int q = 0; q < 8; ++q) { \
            ENT[q] = (unsigned)__builtin_amdgcn_readfirstlane((int)sorted[(I0) + q]); \
            const unsigned char* ur = ut8 + (size_t)((ENT[q] >> 9) & 16383u) * 2048 + lane * 16; \
            UQ[q][0] = *(const uint4*)ur; UQ[q][1] = *(const uint4*)(ur + 1024); }
#define P1_COMP(ENT, UQ, I0) _Pragma("unroll") for (int h4 = 0; h4 < 8; h4 += 4) { int d[4]; \
            _Pragma("unroll") for (int q = 0; q < 4; ++q) { \
                const int tok = (ENT[h4 + q] >> 7) & 3; \
                const LAS unsigned char* xr = x8 + tok * 2048 + lane * 16; \
                const u32x4_t a0 = *(const LAS u32x4_t*)xr, b0 = *(const LAS u32x4_t*)(xr + 1024); \
                int dd = 0; \
                dd = __builtin_amdgcn_sdot4((int)UQ[h4 + q][0].x, (int)a0[0], dd, false); dd = __builtin_amdgcn_sdot4((int)UQ[h4 + q][0].y, (int)a0[1], dd, false); \
                dd = __builtin_amdgcn_sdot4((int)UQ[h4 + q][0].z, (int)a0[2], dd, false); dd = __builtin_amdgcn_sdot4((int)UQ[h4 + q][0].w, (int)a0[3], dd, false); \
                dd = __builtin_amdgcn_sdot4((int)UQ[h4 + q][1].x, (int)b0[0], dd, false); dd = __builtin_amdgcn_sdot4((int)UQ[h4 + q][1].y, (int)b0[1], dd, false); \
                dd = __builtin_amdgcn_sdot4((int)UQ[h4 + q][1].z, (int)b0[2], dd, false); dd = __builtin_amdgcn_sdot4((int)UQ[h4 + q][1].w, (int)b0[3], dd, false); \
                d[q] = dd; } \
            _Pragma("unroll") for (int q = 0; q < 4; ++q) { \
                const int s = wave_sum_all_i32(d[q]); \
                const unsigned e = (ENT[h4 + q] >> 9) & 16383u; const int n = ENT[h4 + q] & 511, tok = n >> 7; \
                const float rsv = tok == 0 ? rs4[0] : tok == 1 ? rs4[1] : tok == 2 ? rs4[2] : rs4[3]; \
                const float a = (float)s * (__uint_as_float(ENT[h4 + q] & 0x7F800000u) * rsv); \
                const float cf = __uint_as_float((unsigned)gsv[(I0) + h4 + q] << 16) * gelu_as(a); \
                if (lane == 0) sorted[(I0) + h4 + q] = (e << 18) | ((unsigned)tok << 16) | f2bf(cf); } }
    {
        unsigned entA[8], entB[8]; uint4 uqA[8][2], uqB[8][2];
        P1_LOAD(entA, uqA, 0)
#pragma unroll 1
        for (int i = 0; i < 512; i += 16) {
            P1_LOAD(entB, uqB, i + 8)
            P1_COMP(entA, uqA, i)
            { const int nx = i + 16 < 512 ? i + 16 : 504; P1_LOAD(entA, uqA, nx) }
            P1_COMP(entB, uqB, i + 8)
        }
    }
#undef P1_LOAD
#undef P1_COMP
    asm volatile("s_waitcnt lgkmcnt(0)" ::: "memory");
    f32x2_t acc0[16], acc1[16], acc2[16], acc3[16];
#pragma unroll
    for (int k = 0; k < 16; ++k) { acc0[k] = (f32x2_t){0.f, 0.f}; acc1[k] = (f32x2_t){0.f, 0.f}; acc2[k] = (f32x2_t){0.f, 0.f}; acc3[k] = (f32x2_t){0.f, 0.f}; }
#ifndef P2N
#define P2N 2
#endif
#define P2_LOAD(ENT, VQ, I0) _Pragma("unroll") for (int q = 0; q < P2N; ++q) { \
            ENT[q] = (unsigned)__builtin_amdgcn_readfirstlane((int)sorted[(I0) + q]); \
            const unsigned char* vr = vt8 + (size_t)(ENT[q] >> 18) * 2048 + lane * 16; \
            VQ[q][0] = *(const uint4*)vr; VQ[q][1] = *(const uint4*)(vr + 1024); }
#define P2_COMP(ENT, VQ) _Pragma("unroll") for (int q = 0; q < P2N; ++q) { \
            const int tok = (ENT[q] >> 16) & 3; \
            const float cfs = __uint_as_float(ENT[q] << 16); \
            const f32x2_t c2 = (f32x2_t){cfs, cfs}; \
            if (tok == 0) { axpy16_fp8_pk(VQ[q][0], c2, acc0); axpy16_fp8_pk(VQ[q][1], c2, acc0 + 8); } \
            else if (tok == 1) { axpy16_fp8_pk(VQ[q][0], c2, acc1); axpy16_fp8_pk(VQ[q][1], c2, acc1 + 8); } \
            else if (tok == 2) { axpy16_fp8_pk(VQ[q][0], c2, acc2); axpy16_fp8_pk(VQ[q][1], c2, acc2 + 8); } \
            else { axpy16_fp8_pk(VQ[q][0], c2, acc3); axpy16_fp8_pk(VQ[q][1], c2, acc3 + 8); } }
    {
        unsigned entA[P2N], entB[P2N]; uint4 vqA[P2N][2], vqB[P2N][2];
        P2_LOAD(entA, vqA, 0)
#pragma unroll 1
        for (int i = 0; i < 512; i += 2 * P2N) {
            P2_LOAD(entB, vqB, i + P2N)
            P2_COMP(entA, vqA)
            { const int nx = i + 2 * P2N < 512 ? i + 2 * P2N : 512 - P2N; P2_LOAD(entA, vqA, nx) }
            P2_COMP(entB, vqB)
        }
    }
#undef P2_LOAD
#undef P2_COMP
    int l2 = lane; asm volatile("" : "+v"(l2));
#define PEER_EPI(tok, ACC) { \
        const bf16_t* xr = h3 + (t0 + tok) * D + l2 * 16; \
        float ss = 0.f; \
        _Pragma("unroll") for (int hh = 0; hh < 2; ++hh) _Pragma("unroll") for (int k = 0; k < 4; ++k) { \
            const uint2 xp = *(const uint2*)(xr + hh * 1024 + 4 * k); \
            const float4 xv = make_float4(__uint_as_float(xp.x << 16), __uint_as_float(xp.x & 0xFFFF0000u), __uint_as_float(xp.y << 16), __uint_as_float(xp.y & 0xFFFF0000u)); \
            f32x2_t a0 = ACC[hh * 8 + 2 * k], a1 = ACC[hh * 8 + 2 * k + 1]; \
            a0.x += xv.x; a0.y += xv.y; a1.x += xv.z; a1.y += xv.w; ACC[hh * 8 + 2 * k] = a0; ACC[hh * 8 + 2 * k + 1] = a1; \
            ss += (a0.x * a0.x + a0.y * a0.y) + (a1.x * a1.x + a1.y * a1.y); } \
        ss = wave_sum_dpp(ss); \
        const float r = rsqrtf(ss * (1.0f / D) + EPS); \
        float* orow = out + (t0 + tok) * D + l2 * 16; \
        _Pragma("unroll") for (int hh = 0; hh < 2; ++hh) _Pragma("unroll") for (int k = 0; k < 4; ++k) { \
            const float4 gv = *(const float4*)(g_final + hh * 1024 + l2 * 16 + 4 * k); \
            const f32x2_t a0 = ACC[hh * 8 + 2 * k], a1 = ACC[hh * 8 + 2 * k + 1]; \
            *(float4*)(orow + hh * 1024 + 4 * k) = make_float4(a0.x * r * gv.x, a0.y * r * gv.y, a1.x * r * gv.z, a1.y * r * gv.w); } }
    PEER_EPI(0, acc0) PEER_EPI(1, acc1) PEER_EPI(2, acc2) PEER_EPI(3, acc3)
#undef PEER_EPI
}

struct Params {
    const float *x, *mem, *g_mix, *w_in, *conv_w, *conv_b, *w_mq, *w_mk, *b_mi, *b_mf, *g_mhead, *g_ahead, *w_out, *g_cross, *g_mem,
                *w_xq, *w_xk, *w_xv, *w_xo, *g_ffn, *w_pq, *sub_keys, *u_tab, *v_tab, *g_final;
    float* out;
    unsigned* bar;
    float* ws;
};

#define PHASE_LOOP(nvb) for (int base_ = blockIdx.x * 2; base_ < (nvb); base_ += gridDim.x * 2)
#define VB (base_ + half)

__global__ void __launch_bounds__(NTHR) mega(Params P) {
    volatile LAS unsigned* st = (volatile LAS unsigned*)(LAS unsigned char*)(smem_raw + CTRL_OFF);
    if (threadIdx.x == 0) { st[0] = 0u; st[1] = 0u; st[2] = 0u; st[3] = 0u; }
    if (threadIdx.x < I_NPTR) ((LAS unsigned long long*)(LAS unsigned char*)(smem_raw + CTRL_OFF + 64))[threadIdx.x] = ((const unsigned long long*)&P)[threadIdx.x];
    __syncthreads();
    XcdBarrier xb = xcd_barrier_post((unsigned*)ldp_raw(I_BAR), st);

    constexpr size_t TD = (size_t)T * D;
    constexpr size_t O_HB = 6 * P6S * 2, O_CBUF = O_HB + (size_t)T * D * 2, O_MQ = O_CBUF + (size_t)T * 1024 * 2, O_MK = O_MQ + (size_t)T * 1024 * 2,
                     O_MIXB = O_MK + (size_t)T * 1024 * 2, O_WIN = O_MIXB + (size_t)T * D * 2, O_WOUT = O_WIN + (size_t)6144 * D * 2, O_WXQ = O_WOUT + (size_t)D * D * 2,
                     O_WXK = O_WXQ + (size_t)D * D * 2, O_WXV = O_WXK + (size_t)D * D * 2, O_WXO = O_WXV + (size_t)D * D * 2, O_WPQ = O_WXO + (size_t)D * D * 2,
                     O_WQK = O_WPQ + (size_t)D * D * 2, O_GPRE = O_WQK + (size_t)8 * 256 * 256 * 2, O_UT = O_GPRE + (size_t)T * 8 * 4, O_VT = O_UT + (size_t)16384 * D, O_RSC = O_VT + (size_t)16384 * D,
                     O_BH = O_RSC + (size_t)32768 * 4, O_GS = O_BH + (size_t)128 * 256 * 512 * 2, O_DENP = O_GS + (size_t)T * 4 * 8 * 4, O_QN = O_DENP + (size_t)T * 4 * 4 * 4,
                     O_DN = O_QN + (size_t)T * 4 * 4, O_DECAY = O_DN + (size_t)128 * 256 * 4, O_KB = O_DECAY + 4096, O_VB = O_KB + (size_t)12288 * 2048 * 2, O_CS = O_VB + (size_t)12288 * 2048 * 2, O_SKB = O_CS + (size_t)4096 * 64 * 8, O_RSSP = O_SKB + (size_t)262144 * 2, O_RSTD = O_RSSP + (size_t)T * 32 * 4, O_MN = O_RSTD + (size_t)T * 4, O_KVP = O_MN + (size_t)512 * D * 2, O_END = O_KVP + (size_t)2 * 512 * 4096 * 4;
    static_assert(O_END + 16384 <= (size_t)536870912, "workspace overflow");
#define W_P6    ((bf16_t*)wsb)
#define W_HB    ((bf16_t*)(wsb + O_HB))
#define W_CBUF  ((bf16_t*)(wsb + O_CBUF))
#define W_MQ    ((bf16_t*)(wsb + O_MQ))
#define W_MK    ((bf16_t*)(wsb + O_MK))
#define W_MIXB  ((bf16_t*)(wsb + O_MIXB))
#define W_GPRE  ((float*)(wsb + O_GPRE))
#define W_HRAW  ((float*)(wsb + O_HB))
#define W_XR    ((float*)wsb)
#define W_MN    ((bf16_t*)((float*)wsb + TD))
#define W_KM    ((bf16_t*)((float*)wsb + TD + (size_t)256 * D))
#define W_VMT   ((bf16_t*)((float*)wsb + TD + (size_t)768 * D))
#define W_PX    ((bf16_t*)(wsb + O_MK))
#define W_GATES ((float*)wsb + TD + (size_t)1280 * D)
#define W_IDS   ((int*)((float*)wsb + TD + (size_t)1280 * D + (size_t)T * 128))
#define W_QX    ((bf16_t*)(wsb + O_CBUF))
#define W_BH    ((bf16_t*)(wsb + O_BH))
#define W_KB    ((bf16_t*)(wsb + O_KB))
#define W_VB    ((bf16_t*)(wsb + O_VB))
#define W_CS    ((float2*)(wsb + O_CS))
#define W_SKB   ((bf16_t*)(wsb + O_SKB))
#define W_RSSP  ((float*)(wsb + O_RSSP))
#define W_RSTD  ((float*)(wsb + O_RSTD))
#define W_MN2   ((bf16_t*)(wsb + O_MN))
#define W_KVP   ((float*)(wsb + O_KVP))
#define W_GS    ((float*)(wsb + O_GS))
#define W_DENP  ((float*)(wsb + O_DENP))
#define W_QN    ((float*)(wsb + O_QN))
#define W_DN    ((float*)(wsb + O_DN))
#define W_DECAY ((float*)(wsb + O_DECAY))
#define W_PQ    ((bf16_t*)(wsb + O_HB))
#define W_KWT   ((bf16_t*)(wsb + O_CBUF))
#define W_DC    ((float*)(wsb + 3 * P6S * 2))
#define W_UT    ((unsigned char*)(wsb + O_UT))
#define W_VT    ((unsigned char*)(wsb + O_VT))
#define W_RSC   ((float*)(wsb + O_RSC))
#define PH_BEGIN() int tidx = threadIdx.x; asm volatile("" : "+v"(tidx)); const int half = tidx >> 8, tid = tidx & 255; float* sm = (float*)smem_raw + half * HALF_SM_FLOATS; \
                   char* wsb = (char*)ldp_raw(I_WS); (void)half; (void)tid; (void)sm; (void)wsb
#define GJOB_DEFAULT(g) pg8::GJob g; g.lda = D; g.ldb = D; g.K = D; g.nM = 32; g.nN = 8; g.a_pm_step = 256 * D; g.b_pn_mask = 0x7fffffff; g.b_pn_shift = 30; g.b_pn_step2 = 0; g.bid0 = 0; g.nblk = gridDim.x; g.a_pn_shift = 0; g.a_pn_mask = 0; g.a_pn_step = 0; g.b_pm_shift = 0; g.b_pm_step = 0; g.b_pn_step = 256 * D; \
                        g.ldc = D; g.R = nullptr; g.ldr = D; g.mode = 0; g.escale = 1.0f; g.gs = nullptr; g.denp = nullptr; g.qn = nullptr; g.gvec = nullptr; g.mo = nullptr; g.C2 = nullptr; g.rssp = nullptr; g.rstd = nullptr
#define GEMM_LDSP ((LAS unsigned char*)smem_raw)

    {
        PH_BEGIN();
        {
            LAS float* scr = (LAS float*)(LAS unsigned char*)(smem_raw) + (tidx >> 6) * (64 * 33);
            const int lane = tidx & 63;
            const int gw = blockIdx.x * 8 + (tidx >> 6), NGW = gridDim.x * 8;
            constexpr int I_IN = 32 * 192, I_SQ = 32 * 64, I_QK = 8 * 4 * 8;
            constexpr int NITEMS = I_IN + 6 * I_SQ + I_QK;
#pragma nounroll
            for (int it = gw; it < NITEMS; it += NGW) {
                const float* W; int ldw, K, csrc0, row0, kb; bf16_t* WT; float wscale = 1.0f; const float* kgain = nullptr;
                int r = it;
                if (r < I_IN) { const int nb = r % 192; kb = r / 192; W = PF(I_WIN); ldw = INC; K = D; csrc0 = nb * 32 + (nb >= 96 ? 8 : 0); WT = (bf16_t*)(wsb + O_WIN); row0 = nb * 32; }
                else if ((r -= I_IN) < 6 * I_SQ) {
                    const int wsel = r / I_SQ; r -= wsel * I_SQ; const int nb = r % 64; kb = r / 64; ldw = D; K = D; csrc0 = nb * 32; row0 = nb * 32;
                    W = PF(wsel == 0 ? I_WOUT : wsel == 1 ? I_WXQ : wsel == 2 ? I_WXK : wsel == 3 ? I_WXV : wsel == 4 ? I_WXO : I_WPQ);
                    WT = (bf16_t*)(wsb + O_WOUT + (size_t)wsel * ((size_t)D * D * 2));
                    if (wsel == 1) kgain = PF(I_GCROSS); else if (wsel == 5) kgain = PF(I_GFFN);
                } else {
                    r -= 6 * I_SQ; const int hq = r / 32; r -= hq * 32; const int nb = r % 8; kb = r / 8;
                    W = PF(hq < 4 ? I_WMQ : I_WMK) + (size_t)(hq & 3) * 65536; ldw = 256; K = 256; csrc0 = nb * 32; WT = (bf16_t*)(wsb + O_WQK); row0 = hq * 256 + nb * 32;
                    if (hq >= 4) wscale = 0.0625f;
                }
                p0_transpose_item(W, ldw, K, csrc0, WT, row0, scr, kb, lane, wscale, kgain);
            }
            {
                const float* ut = PF(I_UTAB); const float* vt = PF(I_VTAB); const float* gffn = PF(I_GFFN);
#pragma nounroll
                for (int row = gw; row < 32768; row += NGW) {
                    const bool second = row >= 16384; const int rr = second ? row - 16384 : row;
                    if (second) table_row_to_fp8(vt + (size_t)rr * D, W_VT + (size_t)rr * D, W_RSC + row, lane, nullptr);
                    else table_row_to_i8(ut + (size_t)rr * D, W_UT + (size_t)rr * D, W_RSC + row, lane, gffn);
                }
            }
            rope_table_fill(W_CS, blockIdx.x * NTHR + tidx, gridDim.x * NTHR);
            {
                const float* sk = PF(I_SUBK);
#pragma nounroll
                for (int i = blockIdx.x * NTHR + tidx; i < 262144 / 8; i += gridDim.x * NTHR) {
                    const float4 a = *(const float4*)(sk + (size_t)i * 8), b = *(const float4*)(sk + (size_t)i * 8 + 4);
                    uint4 o; o.x = pk2(a.x, a.y); o.y = pk2(a.z, a.w); o.z = pk2(b.x, b.y); o.w = pk2(b.z, b.w);
                    *(uint4*)(W_SKB + (size_t)i * 8) = o;
                }
            }
            __syncthreads();
        }
        {
            const float* rin = PF(I_X); const float* rg = PF(I_GMIX); const float* win = PF(I_WIN);
            float* gwl = (float*)smem_raw + 1024;
            for (int k = tidx; k < 2048; k += NTHR) { const float4 a = *(const float4*)(win + (size_t)k * INC + C_MI), b = *(const float4*)(win + (size_t)k * INC + C_MI + 4);
                *(float4*)(gwl + k * 8) = a; *(float4*)(gwl + k * 8 + 4) = b; }
            __syncthreads();
            float* red = (float*)smem_raw + half * 256;
#pragma nounroll
            PHASE_LOOP(T) d_rmsnorm(VB, tid, red, rin, rg, W_HB, gwl, W_GPRE);
            const float* min_ = PF(I_MEM); const float* mg = PF(I_GMEM);
#pragma nounroll
            PHASE_LOOP(512) d_rmsnorm(VB, tid, red, min_, mg, W_MN2, nullptr, nullptr);
        }
    }
    xcd_barrier(xb);
    {
        PH_BEGIN();
        GJOB_DEFAULT(g); g.A = W_HB; g.Bt = (bf16_t*)(wsb + O_WIN); g.nN = 24; g.C = (float*)W_P6; g.ldc = 1024;
        pg8::gemm_phase<4>(GEMM_LDSP, g, tidx);
    }
    xcd_barrier(xb);
    {
        PH_BEGIN();
        const float* cw = PF(I_CONVW); const float* cb = PF(I_CONVB);
#pragma nounroll
        PHASE_LOOP(T) d_conv_silu(VB, tid, W_P6, cw, cb, W_CBUF);
        rope_q_pass(W_P6 + 3 * P6S, W_CS, (size_t)blockIdx.x * NTHR + tidx, (size_t)gridDim.x * NTHR);
        {
            LAS unsigned short* wl = (LAS unsigned short*)(LAS unsigned char*)smem_raw + (tidx >> 6) * (16 * 136);
#pragma nounroll
            for (int item = blockIdx.x * 8 + (tidx >> 6); item < 12288; item += gridDim.x * 8) dil_tile_prep(item, tidx & 63, wl, W_P6 + 4 * P6S, W_P6 + 5 * P6S, W_CS, W_KB, W_VB);
            __syncthreads();
        }
        if (blockIdx.x < 8 && tidx < 64) mlstm_gates_wave(blockIdx.x >> 2, blockIdx.x & 3, tidx, W_GPRE, PF(I_BMI), PF(I_BMF), W_GS, W_DECAY);
#pragma nounroll
        PHASE_LOOP(2048) { const int it = VB, lt = it & 3, et = (it >> 2) & 3, h = (it >> 4) & 3, cg = it >> 6;
            transpose_tile64(tid, sm, W_P6 + P6S + (size_t)(cg * 256 + lt * 64) * 1024 + h * 256 + et * 64, 1024, W_BH + ((size_t)(cg * 4 + h) * 256 + et * 64) * 512 + lt * 64, 512, nullptr, 0); }
    }
    xcd_barrier(xb);
    {
        PH_BEGIN();
        {
            GJOB_DEFAULT(g); g.A = W_CBUF; g.lda = 1024; g.a_pm_step = 256 * 1024; g.Bt = (bf16_t*)(wsb + O_WQK); g.ldb = 256; g.b_pn_step = 256 * 256; g.K = 256; g.a_pn_mask = 3; g.a_pn_step = 256; g.C = (float*)W_MQ; g.ldc = 1024;
            pg8::gemm_phase<4>(GEMM_LDSP, g, tidx);
            __syncthreads();
        }
        const float* ga = PF(I_GAHEAD);
#pragma nounroll
        for (int qt = blockIdx.x * 8 + (tidx >> 6); qt < 4096; qt += gridDim.x * 8) dilated_wave_tile(qt, tidx & 63, W_P6 + 3 * P6S, W_KB, W_VB, ga, W_MIXB);
    }
    xcd_barrier(xb);
    {
        PH_BEGIN();
#pragma nounroll
        PHASE_LOOP(2048) { const int it = VB, lt = it & 3, dt = (it >> 2) & 3, h = (it >> 4) & 3, cg = it >> 6;
            transpose_tile64(tid, sm, W_MK + (size_t)(cg * 256 + lt * 64) * 1024 + h * 256 + dt * 64, 1024, W_KWT + ((size_t)(cg * 4 + h) * 256 + dt * 64) * 256 + lt * 64, 256,
                             W_GS + ((size_t)(cg * 256 + lt * 64) * 4 + h) * 8 + 2, 32); }
        {
            const size_t nth = (size_t)gridDim.x * NTHR;
#pragma nounroll
            for (size_t i = (size_t)blockIdx.x * NTHR + tidx; i < (size_t)T * 128; i += nth) {
                const size_t t = i >> 7; const int c8 = (int)(i & 127) * 8, h = c8 >> 8, d = c8 & 255;
                const float sc = W_GS[(t * 4 + h) * 8 + 3];
                const uint4 v = *(const uint4*)(W_MQ + t * 1024 + c8);
                uint4 o;
                o.x = pk2(bf2f((unsigned short)(v.x & 0xFFFFu)) * sc, bf2f((unsigned short)(v.x >> 16)) * sc); o.y = pk2(bf2f((unsigned short)(v.y & 0xFFFFu)) * sc, bf2f((unsigned short)(v.y >> 16)) * sc);
                o.z = pk2(bf2f((unsigned short)(v.z & 0xFFFFu)) * sc, bf2f((unsigned short)(v.z >> 16)) * sc); o.w = pk2(bf2f((unsigned short)(v.w & 0xFFFFu)) * sc, bf2f((unsigned short)(v.w >> 16)) * sc);
                *(uint4*)(W_PQ + t * 2048 + h * 512 + 256 + d) = o;
            }
        }
#pragma nounroll
        PHASE_LOOP(128) { const int cgh = VB, cg = cgh >> 2, h = cgh & 3;
            float a = 0.f;
            for (int l = 0; l < 256; ++l) { const size_t t = (size_t)cg * 256 + l; a = fmaf(W_GS[(t * 4 + h) * 8 + 2], bf2f(W_MK[t * 1024 + h * 256 + tid]), a); }
            W_DN[(size_t)cgh * 256 + tid] = a; }
        __syncthreads();
        {
            GJOB_DEFAULT(g); g.A = W_MQ; g.lda = 1024; g.a_pm_step = 256 * 1024; g.a_pn_mask = 3; g.a_pn_step = 256; g.K = 256; g.nN = 4;
            g.Bt = W_MK; g.ldb = 1024; g.b_pn_step = 256; g.b_pm_step = 256 * 1024; g.C = (float*)W_PQ; g.gs = W_GS; g.denp = W_DENP;
            pg8::gemm_phase<6>(GEMM_LDSP, g, tidx);
        }
    }
    xcd_barrier(xb);
    {
        PH_BEGIN();
        GJOB_DEFAULT(g); g.A = W_BH; g.lda = 512; g.a_pm_step = 4 * 256 * 512; g.a_pn_mask = 3; g.a_pn_step = 256 * 512; g.K = 256; g.nN = 4;
        g.Bt = W_KWT; g.ldb = 256; g.b_pn_step = 65536; g.b_pm_step = 4 * 65536; g.C = W_DC;
        pg8::gemm_phase<7>(GEMM_LDSP, g, tidx);
    }
    xcd_barrier(xb);
    {
        PH_BEGIN();
        {
#pragma nounroll
            for (int gid = blockIdx.x * NTHR + tidx; gid < 131072; gid += gridDim.x * NTHR) {
                const int bh = gid >> 14, b = bh >> 2, h = bh & 3, e = (gid >> 6) & 255, d = (gid & 63) * 4;
                float4 C = make_float4(0.f, 0.f, 0.f, 0.f);
#pragma unroll 4
                for (int c = 0; c < 16; ++c) {
                    const int cgh = (b * 16 + c) * 4 + h;
                    uint2 o; o.x = pk2(C.x, C.y); o.y = pk2(C.z, C.w);
                    *(uint2*)(W_BH + ((size_t)cgh * 256 + e) * 512 + 256 + d) = o;
                    const float dec = W_DECAY[cgh];
                    const float4 dc = *(const float4*)(W_DC + ((size_t)cgh * 256 + e) * 256 + d);
                    C.x = fmaf(dec, C.x, dc.x); C.y = fmaf(dec, C.y, dc.y); C.z = fmaf(dec, C.z, dc.z); C.w = fmaf(dec, C.w, dc.w);
                }
            }
        }
#pragma nounroll
        PHASE_LOOP(128) { const int cgh = VB, cg = cgh >> 2, h = cgh & 3, b = cg >> 4, c = cg & 15;
            float n = 0.f;
            for (int cc = 0; cc < c; ++cc) { const int j = (b * 16 + cc) * 4 + h; n = fmaf(W_DECAY[j], n, W_DN[(size_t)j * 256 + tid]); }
            __syncthreads();
            sm[tid] = n;
            __syncthreads();
            const int lane = tid & 63, w = tid >> 6;
            const float4 nv = *(const float4*)(sm + lane * 4);
            for (int i = 0; i < 64; ++i) {
                const size_t t = (size_t)cg * 256 + w * 64 + i;
                const ushort4 q4 = *(const ushort4*)(W_MQ + t * 1024 + h * 256 + lane * 4);
                float s = bf2f(q4.x) * nv.x + bf2f(q4.y) * nv.y + bf2f(q4.z) * nv.z + bf2f(q4.w) * nv.w;
                s = wave_sum(s);
                if (lane == 0) W_QN[t * 4 + h] = s;
            }
        }
    }
    xcd_barrier(xb);
    {
        PH_BEGIN();
        GJOB_DEFAULT(g); g.A = W_PQ; g.a_pn_mask = 3; g.a_pn_step = 512; g.K = 512; g.nN = 4;
        g.Bt = W_BH; g.ldb = 512; g.b_pn_step = 256 * 512; g.b_pm_step = 4 * 256 * 512; g.C = (float*)W_MIXB;
        g.gs = W_GS; g.denp = W_DENP; g.qn = W_QN; g.gvec = PF(I_GMHEAD); g.mo = W_P6 + 2 * P6S; g.nblk = 128;
        if (blockIdx.x < 128) pg8::gemm_phase<8>(GEMM_LDSP, g, tidx);
        else {
            GJOB_DEFAULT(k); k.A = W_MN2; k.K = 1024; k.nM = 2; k.nN = 32; k.a_pn_shift = 4; k.a_pn_mask = 1; k.a_pn_step = 1024;
            k.Bt = (bf16_t*)(wsb + O_WXK); k.b_pn_mask = 15; k.b_pn_shift = 4; k.b_pn_step2 = 1024; k.C = W_KVP; k.bid0 = 128; k.nblk = 128;
            pg8::gemm_phase<12>(GEMM_LDSP, k, tidx);
        }
    }
    xcd_barrier(xb);
    {
        PH_BEGIN();
        for (int i = blockIdx.x * NTHR + tidx; i < 512 * 4096 / 4; i += gridDim.x * NTHR) {
            const int r = i >> 10, c = (i & 1023) * 4;
            const float4 a = *(const float4*)(W_KVP + (size_t)r * 4096 + c), b = *(const float4*)(W_KVP + (size_t)512 * 4096 + (size_t)r * 4096 + c);
            const float v0 = a.x + b.x, v1 = a.y + b.y, v2 = a.z + b.z, v3 = a.w + b.w;
            if (c < 2048) { uint2 o; o.x = pk2(v0, v1); o.y = pk2(v2, v3); *(uint2*)(W_KM + (size_t)r * 2048 + c) = o; }
            else { bf16_t* d = W_VMT + (size_t)(c - 2048) * 512 + r; d[0] = (bf16_t)f2bf(v0); d[512] = (bf16_t)f2bf(v1); d[1024] = (bf16_t)f2bf(v2); d[1536] = (bf16_t)f2bf(v3); }
        }
        GJOB_DEFAULT(g); g.A = W_MIXB; g.Bt = (bf16_t*)(wsb + O_WOUT); g.R = PF(I_X); g.C2 = W_HB; g.rssp = W_RSSP;
        pg8::gemm_phase<10>(GEMM_LDSP, g, tidx);
    }
    xcd_barrier(xb);
    {
        PH_BEGIN();
        {
            GJOB_DEFAULT(g); g.A = W_HB; g.Bt = (bf16_t*)(wsb + O_WXQ); g.C = (float*)W_QX;
            pg8::Unit u0;
            if (pg8::unit_next(g, 0, u0) && tidx < 256) { const size_t r = (size_t)u0.pm * 256 + tidx; float s = 0.f; for (int k = 0; k < 32; ++k) s += W_RSSP[r * 32 + k];
                ((LAS float*)(LAS unsigned char*)(smem_raw + GEMM_LDS + 1024 + 8192))[tidx] = rsqrtf(s * (1.0f / D) + EPS); }
            __syncthreads();
            pg8::gemm_phase<11>(GEMM_LDSP, g, tidx); __syncthreads();
        }

    }
    xcd_barrier(xb);
    {
        PH_BEGIN();
        GJOB_DEFAULT(g); g.A = W_QX; g.K = 512; g.a_pn_mask = 3; g.a_pn_step = 512; g.Bt = W_KM; g.b_pn_step = 512; g.b_pm_shift = 4; g.b_pm_step = 256 * D; g.nN = 4;
        g.C = (float*)W_PX; g.ldc = 1024; g.escale = 0.04419417382415922f * 1.4426950408889634f;
        pg8::gemm_phase<5>(GEMM_LDSP, g, tidx);
    }
    xcd_barrier(xb);
    {
        PH_BEGIN();
        GJOB_DEFAULT(g); g.A = W_PX; g.lda = 1024; g.a_pm_step = 256 * 1024; g.K = 256; g.a_pn_shift = 1; g.a_pn_mask = 3; g.a_pn_step = 256; g.Bt = W_VMT; g.ldb = 512; g.b_pn_step = 256 * 512; g.b_pm_shift = 4; g.b_pm_step = 256;
        g.C = (float*)W_MIXB;
        pg8::gemm_phase<3>(GEMM_LDSP, g, tidx);
    }
    xcd_barrier(xb);
    {
        PH_BEGIN();
        GJOB_DEFAULT(g); g.A = W_MIXB; g.Bt = (bf16_t*)(wsb + O_WXO); g.R = nullptr; g.C2 = W_HB; g.rssp = W_RSSP;
        pg8::gemm_phase<10>(GEMM_LDSP, g, tidx);
    }
    xcd_barrier(xb);
    {
        PH_BEGIN();
        GJOB_DEFAULT(g); g.A = W_HB; g.Bt = (bf16_t*)(wsb + O_WPQ); g.C = (float*)W_QX;
        pg8::Unit u0;
        if (pg8::unit_next(g, 0, u0) && tidx < 256) { const size_t r = (size_t)u0.pm * 256 + tidx; float s = 0.f; for (int k = 0; k < 32; ++k) s += W_RSSP[r * 32 + k];
            const float rs = rsqrtf(s * (1.0f / D) + EPS);
            ((LAS float*)(LAS unsigned char*)(smem_raw + GEMM_LDS + 1024 + 8192))[tidx] = rs; W_RSTD[r] = rs; }
        __syncthreads();
        pg8::gemm_phase<11>(GEMM_LDSP, g, tidx);
    }
    xcd_barrier(xb);
    {
        PH_BEGIN();
        LAS float* wl = (LAS float*)(LAS unsigned char*)smem_raw + (tidx >> 6) * 1024;
#pragma nounroll
        for (int item = blockIdx.x * 8 + (tidx >> 6); item < 4096; item += gridDim.x * 8) peer_topk_wave2(item, tidx & 63, wl, W_QX, W_SKB, W_IDS, W_GATES);
    }
    xcd_barrier(xb);
    {
        PH_BEGIN();
        const float* gf = PF(I_GFINAL); float* outp = (float*)ldp_raw(I_OUT);
        LAS unsigned char* wl = (LAS unsigned char*)smem_raw + (tidx >> 6) * 11776;
#pragma nounroll
        for (int gw = blockIdx.x * 8 + (tidx >> 6); gw < T / 4; gw += gridDim.x * 8) { int ln = tidx & 63; asm volatile("" : "+v"(ln));
            peer_sweep_wave(gw, ln, wl, W_HB, W_XR, W_IDS, W_GATES, W_UT, W_VT, W_RSC, W_RSTD, gf, outp); }
    }
}
}

extern "C" void kernel_launch(void* const* d_in, const int* in_sizes, int n_in, void* d_out, int out_size, void* d_ws, size_t ws_size, hipStream_t stream) {
    static int grid_blocks = 0;
    if (!grid_blocks) {
        int dev = 0, cus = 0, per_cu = 0;
        hipGetDevice(&dev);
        hipDeviceGetAttribute(&cus, hipDeviceAttributeMultiprocessorCount, dev);
        hipFuncSetAttribute((const void*)mega, hipFuncAttributeMaxDynamicSharedMemorySize, SMEM_BYTES);
        hipOccupancyMaxActiveBlocksPerMultiprocessor(&per_cu, mega, NTHR, SMEM_BYTES);
        if (per_cu > 1) per_cu = 1;
        if (per_cu < 1) per_cu = 1;
        grid_blocks = cus * per_cu;
    }
    Params P{};
    const float** pp = (const float**)&P;
    for (int i = 0; i < 25; ++i) pp[i] = (const float*)d_in[i];
    P.out = (float*)d_out;
    P.bar = (unsigned*)d_ws;
    P.ws = (float*)((char*)d_ws + 16384);
    hipMemsetAsync(d_ws, 0, 16384, stream);
    void* args[] = {&P};
    hipError_t e = hipLaunchCooperativeKernel((const void*)mega, dim3(grid_blocks), dim3(NTHR), args, SMEM_BYTES, stream);
    if (e != hipSuccess) fprintf(stderr, "cooperative launch failed: %s (grid %d)\n", hipGetErrorString(e), grid_blocks);
}
```

```cpp
#include <hip/hip_runtime.h>
#include <stdint.h>
#include <math.h>
#include <cstdio>

#define LAS_ __attribute__((address_space(3)))
namespace {
constexpr int D = 2048, NB = 2, S = 4096, T = NB * S;
constexpr int INC = 6152;
constexpr int C_MIN = 0, C_MV = 1024, C_MO = 2048, C_MI = 3072, C_MF = 3076, C_AQ = 3080, C_AK = 4104, C_AV = 5128;
constexpr float EPS = 1e-6f;
constexpr size_t P6S = (size_t)8192 * 1024;
constexpr int NTHR = 512;
constexpr int HALF_SM_FLOATS = 8704;
constexpr int GEMM_LDS = 131072;
constexpr int SMEM_BYTES = 163840;
constexpr int CTRL_OFF = SMEM_BYTES - 1024;
typedef unsigned short bf16_t;
__device__ __forceinline__ unsigned f2bf(float f) { unsigned u = __float_as_uint(f); u += 0x7FFFu + ((u >> 16) & 1u); return u >> 16; }
__device__ __forceinline__ unsigned pk2(float lo, float hi) { return f2bf(lo) | (f2bf(hi) << 16); }
__device__ __forceinline__ float bf2f(unsigned short b) { return __uint_as_float(((unsigned)b) << 16); }
extern __shared__ __attribute__((aligned(16))) unsigned char smem_raw[];
enum { I_X = 0, I_MEM, I_GMIX, I_WIN, I_CONVW, I_CONVB, I_WMQ, I_WMK, I_BMI, I_BMF, I_GMHEAD, I_GAHEAD, I_WOUT, I_GCROSS, I_GMEM,
       I_WXQ, I_WXK, I_WXV, I_WXO, I_GFFN, I_WPQ, I_SUBK, I_UTAB, I_VTAB, I_GFINAL, I_OUT, I_BAR, I_WS, I_NPTR };
__device__ __forceinline__ unsigned long long ldp_raw(int i) {
    const LAS_ unsigned long long* tab = (const LAS_ unsigned long long*)(LAS_ unsigned char*)(smem_raw + CTRL_OFF + 64);
    const unsigned long long v = tab[i];
    const unsigned lo = __builtin_amdgcn_readfirstlane((unsigned)v), hi = __builtin_amdgcn_readfirstlane((unsigned)(v >> 32));
    return ((unsigned long long)hi << 32) | lo;
}
#define PF(i) ((const float*)ldp_raw(i))

#define XB_TMO      128
#define XB_XCNT(j)  (256  + 64 * (j))
#define XB_XSUB(j)  (1280 + 64 * (j))
#define XB_XGEN(j)  (2304 + 64 * (j))
#define XB_TOP      3328
#define XB_TOPGEN   3392
#define XCD_BAR_WORDS 3456
#define XB_SPIN_CAP (1u << 22)
#define LAS __attribute__((address_space(3)))

__device__ __forceinline__ unsigned xb_ld(unsigned* p)              { return __hip_atomic_load(p, __ATOMIC_RELAXED, __HIP_MEMORY_SCOPE_AGENT); }
__device__ __forceinline__ unsigned xb_add(unsigned* p, unsigned v) { return __hip_atomic_fetch_add(p, v, __ATOMIC_RELAXED, __HIP_MEMORY_SCOPE_AGENT); }
__device__ __forceinline__ unsigned xb_xcc_id() { return (unsigned)__builtin_amdgcn_s_getreg((3 << 11) | 20) & 0xFu; }
#define XB_SPIN(cond, bar) do { unsigned _sp = 0; while (cond) { __builtin_amdgcn_s_sleep(1); \
    if ((++_sp & 255u) == 0u) { if (xb_ld(&(bar)[XB_TMO])) break; if (_sp > XB_SPIN_CAP) { atomicAdd(&(bar)[XB_TMO], 1u); break; } } } } while (0)

struct XcdBarrier { unsigned* bar; unsigned x; volatile LAS unsigned* st; };

__device__ __forceinline__ XcdBarrier xcd_barrier_post(unsigned* bar, volatile LAS unsigned* st) {
    XcdBarrier b; b.bar = bar; b.x = xb_xcc_id(); b.st = st;
    if (threadIdx.x == 0) (void)xb_add(&bar[XB_XCNT(b.x)], 1u);
    return b;
}
__device__ __forceinline__ void xcd_barrier_complete(unsigned* bar, unsigned x, unsigned& nloc, unsigned& nx) {
    const unsigned G = gridDim.x * gridDim.y * gridDim.z;
    unsigned sum, cnt, mine, sp = 0u;
    for (;;) {
        sum = 0u; cnt = 0u; mine = 0u;
#pragma unroll
        for (unsigned j = 0; j < 16; ++j) { const unsigned c = xb_ld(&bar[XB_XCNT(j)]); sum += c; cnt += (c > 0u) ? 1u : 0u; mine = (j == x) ? c : mine; }
        if (sum == G) break;
        __builtin_amdgcn_s_sleep(1);
        if ((++sp & 255u) == 0u) { if (xb_ld(&bar[XB_TMO])) break; if (sp > XB_SPIN_CAP) { atomicAdd(&bar[XB_TMO], 1u); break; } }
    }
    nloc = mine > 0u ? mine : 1u; nx = cnt > 0u ? cnt : 1u;
}
__device__ __forceinline__ void xcd_barrier(const XcdBarrier& b) {
    asm volatile("s_waitcnt vmcnt(0)" ::: "memory");
    __syncthreads();
    if (threadIdx.x == 0) {
        unsigned* bar = b.bar;
        __builtin_amdgcn_s_waitcnt(0);
        unsigned nloc = b.st[0], nx = b.st[1];
        if (nloc == 0u) { xcd_barrier_complete(bar, b.x, nloc, nx); b.st[0] = nloc; b.st[1] = nx; }
        const unsigned old = xb_add(&bar[XB_XSUB(b.x)], 1u);
        const unsigned gen = old / nloc;
        if (old + 1u == (gen + 1u) * nloc) {
            __builtin_amdgcn_fence(__ATOMIC_RELEASE, "agent");
            asm volatile("s_waitcnt vmcnt(0)" ::: "memory");
            const unsigned og = xb_add(&bar[XB_TOP], 1u);
            const unsigned tg = og / nx;
            if (og + 1u == (tg + 1u) * nx) xb_add(&bar[XB_TOPGEN], 1u);
            else XB_SPIN(xb_ld(&bar[XB_TOPGEN]) == tg, bar);
            __builtin_amdgcn_fence(__ATOMIC_ACQUIRE, "agent");
            xb_add(&bar[XB_XGEN(b.x)], 1u);
            asm volatile("s_waitcnt vmcnt(0)" ::: "memory");
        } else {
            XB_SPIN(xb_ld(&bar[XB_XGEN(b.x)]) == gen, bar);
            __builtin_amdgcn_fence(__ATOMIC_ACQUIRE, "agent");
            asm volatile("s_waitcnt vmcnt(0)" ::: "memory");
        }
    }
    __syncthreads();
}

__device__ __forceinline__ float wave_sum(float v) {
#pragma unroll
    for (int o = 32; o >= 1; o >>= 1) v += __shfl_xor(v, o);
    return v;
}
__device__ __forceinline__ float wave_max(float v) {
#pragma unroll
    for (int o = 32; o >= 1; o >>= 1) v = fmaxf(v, __shfl_xor(v, o));
    return v;
}
__device__ __forceinline__ float log_sigmoid(float x) { return fminf(x, 0.f) - log1pf(expf(-fabsf(x))); }


__device__ __forceinline__ void d_rmsnorm(int vb, int t, float* sm, const float* __restrict__ in, const float* __restrict__ g, bf16_t* __restrict__ out,
                                          const float* gwl  , float* __restrict__ gpre) {
    float* red = sm;
    const int row = vb;
    const float4* p = (const float4*)(in + (size_t)row * D);
    float4 a = p[t], b = p[t + 256];
    float s = a.x * a.x + a.y * a.y + a.z * a.z + a.w * a.w + b.x * b.x + b.y * b.y + b.z * b.z + b.w * b.w;
    s = wave_sum(s);
    __syncthreads();
    if ((t & 63) == 0) red[t >> 6] = s;
    __syncthreads();
    const float tot = red[0] + red[1] + red[2] + red[3];
    const float r = rsqrtf(tot * (1.0f / D) + EPS);
    const float4* gp = (const float4*)g;
    float4 ga = gp[t], gb = gp[t + 256];
    float hv[8] = {a.x * r * ga.x, a.y * r * ga.y, a.z * r * ga.z, a.w * r * ga.w, b.x * r * gb.x, b.y * r * gb.y, b.z * r * gb.z, b.w * r * gb.w};
    uint2 o0, o1;
    o0.x = pk2(hv[0], hv[1]); o0.y = pk2(hv[2], hv[3]); o1.x = pk2(hv[4], hv[5]); o1.y = pk2(hv[6], hv[7]);
    *(uint2*)(out + (size_t)row * D + t * 4) = o0;
    *(uint2*)(out + (size_t)row * D + 1024 + t * 4) = o1;
    if (gpre) {
        float gs[8];
#pragma unroll
        for (int c = 0; c < 8; ++c) gs[c] = 0.f;
#pragma unroll
        for (int j = 0; j < 8; ++j) {
            const int k = (j < 4) ? (t * 4 + j) : (1024 + t * 4 + (j - 4));
            const float4 w0 = *(const float4*)(gwl + k * 8), w1 = *(const float4*)(gwl + k * 8 + 4);
            gs[0] = fmaf(hv[j], w0.x, gs[0]); gs[1] = fmaf(hv[j], w0.y, gs[1]); gs[2] = fmaf(hv[j], w0.z, gs[2]); gs[3] = fmaf(hv[j], w0.w, gs[3]);
            gs[4] = fmaf(hv[j], w1.x, gs[4]); gs[5] = fmaf(hv[j], w1.y, gs[5]); gs[6] = fmaf(hv[j], w1.z, gs[6]); gs[7] = fmaf(hv[j], w1.w, gs[7]);
        }
#pragma unroll
        for (int c = 0; c < 8; ++c) gs[c] = wave_sum(gs[c]);
        __syncthreads();
        if ((t & 63) == 0) {
#pragma unroll
            for (int c = 0; c < 8; ++c) red[8 + (t >> 6) * 8 + c] = gs[c];
        }
        __syncthreads();
        if (t < 8) gpre[(size_t)row * 8 + t] = red[8 + t] + red[16 + t] + red[24 + t] + red[32 + t];
    }
}

namespace pg8 {
typedef short bf16x8 __attribute__((ext_vector_type(8)));
typedef float f32x4 __attribute__((ext_vector_type(4)));
constexpr int BM = 256, BK = 64, HALF = 128, HTB = HALF * BK * 2, NXCD = 8, WGM = 8;
__device__ __forceinline__ int lds_byte(int r, int c) { const int st = (r >> 4) * 2 + (c >> 5), rr = r & 15, cc = c & 31, ob = rr * 64 + cc * 2; return st * 1024 + (ob ^ (((ob >> 9) & 1) << 5)); }
__device__ __forceinline__ void stage_rc(int b, int& R, int& C) { const int st = b / 1024, sb = b % 1024, swz = sb ^ (((sb >> 9) & 1) << 5); R = (st >> 1) * 16 + swz / 64; C = (st & 1) * 32 + (swz % 64) / 2; }
struct Unit { int pm, pn; };
struct GJob {
    const bf16_t* A; const bf16_t* Bt;
    int lda, ldb, K, nM, nN;
    int a_pn_shift, a_pn_mask, a_pn_step;
    int b_pm_shift, b_pm_step, b_pn_step;
    int a_pm_step;
    int b_pn_mask, b_pn_shift, b_pn_step2;
    int bid0, nblk;
    float escale;
    const float* gs; float* denp; const float* qn; const float* gvec; const bf16_t* mo;
    bf16_t* C2; float* rssp; const float* rstd;
    float* C; int ldc; const float* R; int ldr;
    int mode;
};
__device__ __forceinline__ bool unit_next(const GJob& g, int i, Unit& u) {
    const int nwg = g.nM * g.nN;
    const int bid = (int)blockIdx.x - g.bid0; if (bid < 0 || bid >= g.nblk) return false;
    const long L = (long)i * g.nblk + bid; if (L >= nwg) return false;
    int wgid = (int)L; { const int q = nwg / NXCD, r = nwg % NXCD, xcd = wgid % NXCD, off = wgid / NXCD; wgid = (xcd < r ? xcd * (q + 1) : r * (q + 1) + (xcd - r) * q) + off; }
    const int nig = WGM * g.nN, gid = wgid / nig, fm = gid * WGM, gsz = (g.nM - fm) < WGM ? (g.nM - fm) : WGM;
    u.pm = fm + ((wgid % nig) % gsz); u.pn = (wgid % nig) / gsz; return true;
}
template <int MODE> __device__ __forceinline__ void epilogue(const GJob& g, f32x4 (&acc)[2][2][4][2], const Unit& u, int wr, int wc, int fr, int fq, LAS unsigned char* xlds) {
    const int row0 = u.pm * BM + wr * 64 + fr;
    if constexpr (MODE == 0) {
        const int col0 = u.pn * BM + wc * 32 + 4 * fq;
#pragma unroll
        for (int ai = 0; ai < 2; ++ai)
#pragma unroll
            for (int m = 0; m < 4; ++m) {
                const int row = row0 + ai * HALF + m * 16;
                float* rowp = g.C + (size_t)row * g.ldc + col0;
                const float* rp = g.R ? g.R + (size_t)row * g.ldr + col0 : nullptr;
#pragma unroll
                for (int bj = 0; bj < 2; ++bj)
#pragma unroll
                    for (int n = 0; n < 2; ++n) {
                        f32x4 v = acc[ai][bj][m][n];
                        if (rp) v = v + *(const f32x4*)(rp + bj * HALF + n * 16);
                        *(f32x4*)(rowp + bj * HALF + n * 16) = v;
                    }
            }
    } else if constexpr (MODE == 10) {
        const int col0 = u.pn * BM + wc * 32 + 4 * fq;
#pragma unroll
        for (int ai = 0; ai < 2; ++ai)
#pragma unroll
            for (int m = 0; m < 4; ++m) {
                const int row = row0 + ai * HALF + m * 16;
                bf16_t* r2 = g.C2 + (size_t)row * D + col0;
                float ss = 0.f;
#pragma unroll
                for (int bj = 0; bj < 2; ++bj)
#pragma unroll
                    for (int n = 0; n < 2; ++n) {
                        f32x4 v = acc[ai][bj][m][n];
                        if (g.R) v = v + *(const f32x4*)(g.R + (size_t)row * g.ldr + col0 + bj * HALF + n * 16);
                        else { const uint2 pr = *(const uint2*)(r2 + bj * HALF + n * 16);
                               v[0] += __uint_as_float(pr.x << 16); v[1] += __uint_as_float(pr.x & 0xFFFF0000u); v[2] += __uint_as_float(pr.y << 16); v[3] += __uint_as_float(pr.y & 0xFFFF0000u); }
                        uint2 o; o.x = pk2(v[0], v[1]); o.y = pk2(v[2], v[3]);
                        *(uint2*)(r2 + bj * HALF + n * 16) = o;
                        ss += (v[0] * v[0] + v[1] * v[1]) + (v[2] * v[2] + v[3] * v[3]);
                    }
                ss += __shfl_xor(ss, 16); ss += __shfl_xor(ss, 32);
                if (fq == 0) g.rssp[(size_t)row * 32 + u.pn * 4 + wc] = ss;
            }
    } else if constexpr (MODE == 11) {
        bf16_t* Cb = (bf16_t*)g.C;
        const int col0 = u.pn * BM + wc * 32 + 4 * fq;
#pragma unroll
        for (int ai = 0; ai < 2; ++ai)
#pragma unroll
            for (int m = 0; m < 4; ++m) {
                const int row = row0 + ai * HALF + m * 16;
                const float rs = ((const LAS float*)(xlds + 8192))[row - u.pm * BM];
                bf16_t* rowp = Cb + (size_t)row * g.ldc + col0;
#pragma unroll
                for (int bj = 0; bj < 2; ++bj)
#pragma unroll
                    for (int n = 0; n < 2; ++n) {
                        const f32x4 v = acc[ai][bj][m][n] * rs;
                        uint2 o; o.x = pk2(v[0], v[1]); o.y = pk2(v[2], v[3]);
                        *(uint2*)(rowp + bj * HALF + n * 16) = o;
                    }
            }
    } else if constexpr (MODE == 6) {
        const int h = u.pn; const size_t t0 = (size_t)u.pm * BM;
        bf16_t* Cb = (bf16_t*)g.C;
#pragma unroll
        for (int ai = 0; ai < 2; ++ai)
#pragma unroll
            for (int m = 0; m < 4; ++m) {
                const int l = ai * HALF + wr * 64 + m * 16 + fr;
                const float M2 = g.gs[((t0 + l) * 4 + h) * 8 + 1];
                bf16_t* rowp = Cb + (t0 + l) * 2048 + h * 512 + wc * 32 + 4 * fq;
                float rs = 0.f;
#pragma unroll
                for (int bj = 0; bj < 2; ++bj)
#pragma unroll
                    for (int n = 0; n < 2; ++n) {
                        const f32x4 a = acc[ai][bj][m][n];
                        const int s0 = bj * HALF + wc * 32 + n * 16 + 4 * fq;
                        float p[4];
#pragma unroll
                        for (int r = 0; r < 4; ++r) { const float u2 = g.gs[((t0 + s0 + r) * 4 + h) * 8 + 0]; p[r] = (s0 + r <= l) ? a[r] * __builtin_amdgcn_exp2f(u2 - M2) : 0.f; rs += p[r]; }
                        uint2 o; o.x = pk2(p[0], p[1]); o.y = pk2(p[2], p[3]);
                        *(uint2*)(rowp + bj * HALF + n * 16) = o;
                    }
                rs += __shfl_xor(rs, 16); rs += __shfl_xor(rs, 32);
                if (fq == 0) g.denp[((t0 + l) * 4 + h) * 4 + wc] = rs;
            }
    } else if constexpr (MODE == 12) {
        float* Ct = g.C + (size_t)(u.pn >> 4) * ((size_t)512 * 4096) + (size_t)(u.pn & 15) * 256;
        const int col0 = wc * 32 + 4 * fq;
#pragma unroll
        for (int ai = 0; ai < 2; ++ai)
#pragma unroll
            for (int m = 0; m < 4; ++m) {
                float* rowp = Ct + (size_t)(row0 + ai * HALF + m * 16) * 4096 + col0;
#pragma unroll
                for (int bj = 0; bj < 2; ++bj)
#pragma unroll
                    for (int n = 0; n < 2; ++n) *(f32x4*)(rowp + bj * HALF + n * 16) = acc[ai][bj][m][n];
            }
    } else if constexpr (MODE == 7) {
        float* Ct = g.C + (size_t)(u.pm * 4 + u.pn) * 65536;
        const int col0 = wc * 32 + 4 * fq;
#pragma unroll
        for (int ai = 0; ai < 2; ++ai)
#pragma unroll
            for (int m = 0; m < 4; ++m) {
                float* rowp = Ct + (size_t)(ai * HALF + wr * 64 + m * 16 + fr) * 256 + col0;
#pragma unroll
                for (int bj = 0; bj < 2; ++bj)
#pragma unroll
                    for (int n = 0; n < 2; ++n) *(f32x4*)(rowp + bj * HALF + n * 16) = acc[ai][bj][m][n];
            }
    } else if constexpr (MODE == 8) {
        const int h = u.pn; const size_t t0 = (size_t)u.pm * BM;
        LAS float* X0 = (LAS float*)xlds + wr * 512;
#pragma unroll
        for (int ai = 0; ai < 2; ++ai)
#pragma unroll
            for (int m = 0; m < 4; ++m) {
                const size_t th = (t0 + ai * HALF + wr * 64 + m * 16 + fr) * 4 + h;
                const f32x4 dp = *(const f32x4*)(g.denp + th * 4);
                const float den = (dp[0] + dp[1]) + (dp[2] + dp[3]) + g.gs[th * 8 + 3] * g.qn[th];
                const float rden = 1.0f / fmaxf(fabsf(den), g.gs[th * 8 + 4]);
                float ss = 0.f;
#pragma unroll
                for (int bj = 0; bj < 2; ++bj)
#pragma unroll
                    for (int n = 0; n < 2; ++n) { f32x4 a = acc[ai][bj][m][n] * rden; acc[ai][bj][m][n] = a; ss += (a[0] * a[0] + a[1] * a[1]) + (a[2] * a[2] + a[3] * a[3]); }
                ss += __shfl_xor(ss, 16); ss += __shfl_xor(ss, 32);
                if (fq == 0) X0[(ai * 64 + m * 16 + fr) * 4 + wc] = ss;
            }
        asm volatile("s_waitcnt lgkmcnt(0)" ::: "memory"); __builtin_amdgcn_s_barrier(); asm volatile("" ::: "memory");
        bf16_t* Cb = (bf16_t*)g.C;
        const int col0 = wc * 32 + 4 * fq;
#pragma unroll
        for (int ai = 0; ai < 2; ++ai)
#pragma unroll
            for (int m = 0; m < 4; ++m) {
                const f32x4 p4 = *(const LAS f32x4*)(X0 + (ai * 64 + m * 16 + fr) * 4);
                const float rsn = rsqrtf(((p4[0] + p4[1]) + (p4[2] + p4[3])) * (1.0f / 256.0f) + EPS);
                const size_t t = t0 + ai * HALF + wr * 64 + m * 16 + fr;
                bf16_t* rowp = Cb + t * 2048 + h * 256 + col0;
                const bf16_t* mop = g.mo + t * 1024 + h * 256 + col0;
#pragma unroll
                for (int bj = 0; bj < 2; ++bj)
#pragma unroll
                    for (int n = 0; n < 2; ++n) {
                        const f32x4 a = acc[ai][bj][m][n];
                        const ushort4 mo4 = *(const ushort4*)(mop + bj * HALF + n * 16);
                        const f32x4 gv = *(const f32x4*)(g.gvec + h * 256 + col0 + bj * HALF + n * 16);
                        const float o0 = a[0] * rsn * gv[0] / (1.0f + __expf(-bf2f(mo4.x)));
                        const float o1 = a[1] * rsn * gv[1] / (1.0f + __expf(-bf2f(mo4.y)));
                        const float o2 = a[2] * rsn * gv[2] / (1.0f + __expf(-bf2f(mo4.z)));
                        const float o3 = a[3] * rsn * gv[3] / (1.0f + __expf(-bf2f(mo4.w)));
                        uint2 o; o.x = pk2(o0, o1); o.y = pk2(o2, o3);
                        *(uint2*)(rowp + bj * HALF + n * 16) = o;
                    }
            }
    } else if constexpr (MODE == 5) {
        LAS float* X0 = (LAS float*)xlds + wr * 512;
        LAS float* X1 = (LAS float*)xlds + 1024 + wr * 512;
#pragma unroll
        for (int ai = 0; ai < 2; ++ai)
#pragma unroll
            for (int m = 0; m < 4; ++m) {
                float v = -INFINITY;
#pragma unroll
                for (int bj = 0; bj < 2; ++bj)
#pragma unroll
                    for (int n = 0; n < 2; ++n) { const f32x4 a = acc[ai][bj][m][n]; v = fmaxf(v, fmaxf(fmaxf(a[0], a[1]), fmaxf(a[2], a[3]))); }
                v = fmaxf(v, __shfl_xor(v, 16)); v = fmaxf(v, __shfl_xor(v, 32));
                if (fq == 0) X0[(ai * 64 + m * 16 + fr) * 4 + wc] = v;
            }
        asm volatile("s_waitcnt lgkmcnt(0)" ::: "memory"); __builtin_amdgcn_s_barrier(); asm volatile("" ::: "memory");
#pragma unroll
        for (int ai = 0; ai < 2; ++ai)
#pragma unroll
            for (int m = 0; m < 4; ++m) {
                const f32x4 p4 = *(const LAS f32x4*)(X0 + (ai * 64 + m * 16 + fr) * 4);
                const float mxr = fmaxf(fmaxf(p4[0], p4[1]), fmaxf(p4[2], p4[3])) * g.escale;
                float s = 0.f;
#pragma unroll
                for (int bj = 0; bj < 2; ++bj)
#pragma unroll
                    for (int n = 0; n < 2; ++n) { f32x4 a = acc[ai][bj][m][n];
                        a[0] = __builtin_amdgcn_exp2f(a[0] * g.escale - mxr); a[1] = __builtin_amdgcn_exp2f(a[1] * g.escale - mxr); a[2] = __builtin_amdgcn_exp2f(a[2] * g.escale - mxr); a[3] = __builtin_amdgcn_exp2f(a[3] * g.escale - mxr);
                        acc[ai][bj][m][n] = a; s += (a[0] + a[1]) + (a[2] + a[3]); }
                s += __shfl_xor(s, 16); s += __shfl_xor(s, 32);
                if (fq == 0) X1[(ai * 64 + m * 16 + fr) * 4 + wc] = s;
            }
        asm volatile("s_waitcnt lgkmcnt(0)" ::: "memory"); __builtin_amdgcn_s_barrier(); asm volatile("" ::: "memory");
        bf16_t* Cb = (bf16_t*)g.C;
        const int col0 = u.pn * BM + wc * 32 + 4 * fq;
#pragma unroll
        for (int ai = 0; ai < 2; ++ai)
#pragma unroll
            for (int m = 0; m < 4; ++m) {
                const f32x4 p4 = *(const LAS f32x4*)(X1 + (ai * 64 + m * 16 + fr) * 4);
                const float inv = 1.0f / ((p4[0] + p4[1]) + (p4[2] + p4[3]));
                bf16_t* rowp = Cb + (size_t)(row0 + ai * HALF + m * 16) * g.ldc + col0;
#pragma unroll
                for (int bj = 0; bj < 2; ++bj)
#pragma unroll
                    for (int n = 0; n < 2; ++n) {
                        const f32x4 a = acc[ai][bj][m][n];
                        uint2 o; o.x = pk2(a[0] * inv, a[1] * inv); o.y = pk2(a[2] * inv, a[3] * inv);
                        *(uint2*)(rowp + bj * HALF + n * 16) = o;
                    }
            }
    } else {
        bf16_t* Cb = (bf16_t*)g.C; int ccol = u.pn * BM;
        if constexpr (MODE == 4) { Cb += (size_t)(u.pn >> 2) * P6S; ccol = (u.pn & 3) * 256; }
        const int col0 = ccol + wc * 32 + 4 * fq;
#pragma unroll
        for (int ai = 0; ai < 2; ++ai)
#pragma unroll
            for (int m = 0; m < 4; ++m) {
                bf16_t* rowp = Cb + (size_t)(row0 + ai * HALF + m * 16) * g.ldc + col0;
#pragma unroll
                for (int bj = 0; bj < 2; ++bj)
#pragma unroll
                    for (int n = 0; n < 2; ++n) {
                        const f32x4 v = acc[ai][bj][m][n];
                        uint2 o; o.x = pk2(v[0], v[1]); o.y = pk2(v[2], v[3]);
                        *(uint2*)(rowp + bj * HALF + n * 16) = o;
                    }
            }
    }
}
template <int MODE> __device__ __forceinline__ void gemm_phase(LAS unsigned char* lds, const GJob& g, int tid) {
    const int wid = __builtin_amdgcn_readfirstlane(tid >> 6), lane = tid & 63, wr = wid >> 2, wc = wid & 3, fr = lane & 15, fq = lane >> 4;
    const int K = g.K, nt = K / BK;
    unsigned voffA[2], voffB[2];
#pragma unroll
    for (int i = 0; i < 2; ++i) { int R, C; stage_rc(tid * 16 + i * 8192, R, C);
        voffA[i] = (unsigned)(R * g.lda + C) * 2u; voffB[i] = (unsigned)(R * g.ldb + C) * 2u; }
    const size_t kstep = (size_t)(BK * 2);
    const size_t hstepA = (size_t)HALF * g.lda * 2, hstepB = (size_t)HALF * g.ldb * 2;
    const unsigned ldsw = (unsigned)wid * 1024u;
    const int aoff = lds_byte(wr * 64 + fr, fq * 8), boff = lds_byte(wc * 32 + fr, fq * 8);
#define PG8_SA(b, h) (((b) * 2 + (h)) * HTB)
#define PG8_SB(b, h) ((4 + (b) * 2 + (h)) * HTB)
#define PG8_STAGE(bufoff, gbase, voff) do { _Pragma("unroll") for (int _i = 0; _i < 2; ++_i) \
        __builtin_amdgcn_global_load_lds((const unsigned*)((const char*)(gbase) + (voff)[_i]), (LAS unsigned*)(lds + (bufoff) + ldsw + _i * 8192), 16, 0, 0); } while (0)
#define PG8_LDA(dst, b, h) do { _Pragma("unroll") for (int m = 0; m < 4; ++m) _Pragma("unroll") for (int k = 0; k < 2; ++k) dst[m][k] = *(const LAS bf16x8*)(lds + PG8_SA(b, h) + aoff + m * 2048 + k * 1024); } while (0)
#define PG8_LDB(dst, b, h) do { _Pragma("unroll") for (int n = 0; n < 2; ++n) _Pragma("unroll") for (int k = 0; k < 2; ++k) dst[n][k] = *(const LAS bf16x8*)(lds + PG8_SB(b, h) + boff + n * 2048 + k * 1024); } while (0)
#define PG8_MMA(ai, bj, At, Bt) do { __builtin_amdgcn_s_setprio(1); _Pragma("unroll") for (int m = 0; m < 4; ++m) _Pragma("unroll") for (int n = 0; n < 2; ++n) _Pragma("unroll") for (int k = 0; k < 2; ++k) \
        acc[ai][bj][m][n] = __builtin_amdgcn_mfma_f32_16x16x32_bf16(Bt[n][k], At[m][k], acc[ai][bj][m][n], 0, 0, 0); __builtin_amdgcn_s_setprio(0); } while (0)
#define PG8_WAIT_V(n) asm volatile("s_waitcnt vmcnt(" #n ")" ::: "memory")
#define PG8_WAIT_L(n) asm volatile("s_waitcnt lgkmcnt(" #n ")" ::: "memory")
#define PG8_BAR __builtin_amdgcn_s_barrier()
#define PG8_SCHED __builtin_amdgcn_sched_barrier(0)
#define PG8_ABASE(u) ((const char*)g.A + ((size_t)(u).pm * g.a_pm_step + (size_t)(((u).pn >> g.a_pn_shift) & g.a_pn_mask) * g.a_pn_step) * 2)
#define PG8_BBASE(u) ((const char*)g.Bt + ((size_t)((u).pn & g.b_pn_mask) * g.b_pn_step + (size_t)((u).pn >> g.b_pn_shift) * g.b_pn_step2 + (size_t)((u).pm >> g.b_pm_shift) * g.b_pm_step) * 2)
    Unit cur, nxt; int ui = 0;
    if (!unit_next(g, 0, cur)) return;
    f32x4 acc[2][2][4][2];
#pragma unroll
    for (int a = 0; a < 2; ++a)
#pragma unroll
        for (int b = 0; b < 2; ++b)
#pragma unroll
            for (int m = 0; m < 4; ++m)
#pragma unroll
                for (int n = 0; n < 2; ++n) acc[a][b][m][n] = (f32x4){0.f, 0.f, 0.f, 0.f};
    bf16x8 At[4][2], B0[2][2], B1[2][2];
    const char* cA = PG8_ABASE(cur); const char* cB = PG8_BBASE(cur);
    PG8_STAGE(PG8_SB(0, 0), cB, voffB); PG8_STAGE(PG8_SA(0, 0), cA, voffA); PG8_STAGE(PG8_SB(0, 1), cB + hstepB, voffB); PG8_STAGE(PG8_SA(0, 1), cA + hstepA, voffA);
    if (wr == 1) PG8_BAR;
    PG8_WAIT_V(4); PG8_BAR;
    PG8_STAGE(PG8_SB(1, 0), cB + kstep, voffB); PG8_STAGE(PG8_SA(1, 0), cA + kstep, voffA); PG8_STAGE(PG8_SB(1, 1), cB + hstepB + kstep, voffB);
    PG8_WAIT_V(6); PG8_BAR;
    for (;;) {
        const bool has_next = unit_next(g, ui + 1, nxt);
        const char* nA = has_next ? PG8_ABASE(nxt) : cA; const char* nB = has_next ? PG8_BBASE(nxt) : cB;
        for (int t = 0; t < nt; t += 2) {
            const bool last = (t == nt - 2);
            const char* a1 = cA + (size_t)(t + 1) * kstep;
            const char* a2 = last ? nA : cA + (size_t)(t + 2) * kstep; const char* b2 = last ? nB : cB + (size_t)(t + 2) * kstep;
            const char* a3 = a2 + kstep; const char* b3 = b2 + kstep;
            PG8_LDB(B0, 0, 0); PG8_SCHED; PG8_LDA(At, 0, 0); PG8_STAGE(PG8_SA(1, 1), a1 + hstepA, voffA);
            PG8_WAIT_L(8); PG8_BAR; PG8_WAIT_L(0); PG8_MMA(0, 0, At, B0); PG8_BAR; PG8_SCHED;
            PG8_LDB(B1, 0, 1); PG8_STAGE(PG8_SB(0, 0), b2, voffB);
            PG8_BAR; PG8_WAIT_L(0); PG8_MMA(0, 1, At, B1); PG8_BAR;
            PG8_LDA(At, 0, 1); PG8_STAGE(PG8_SA(0, 0), a2, voffA);
            PG8_BAR; PG8_WAIT_L(0); PG8_MMA(1, 0, At, B0); PG8_BAR; PG8_SCHED;
            PG8_STAGE(PG8_SB(0, 1), b2 + hstepB, voffB);
            PG8_WAIT_V(6); PG8_BAR; PG8_MMA(1, 1, At, B1); PG8_BAR;
            PG8_LDB(B0, 1, 0); PG8_SCHED; PG8_LDA(At, 1, 0); PG8_STAGE(PG8_SA(0, 1), a2 + hstepA, voffA);
            PG8_WAIT_L(8); PG8_BAR; PG8_WAIT_L(0); PG8_MMA(0, 0, At, B0); PG8_BAR; PG8_SCHED;
            PG8_LDB(B1, 1, 1); PG8_STAGE(PG8_SB(1, 0), b3, voffB);
            PG8_BAR; PG8_WAIT_L(0); PG8_MMA(0, 1, At, B1); PG8_BAR;
            PG8_LDA(At, 1, 1); PG8_STAGE(PG8_SA(1, 0), a3, voffA);
            PG8_BAR; PG8_WAIT_L(0); PG8_MMA(1, 0, At, B0); PG8_BAR; PG8_SCHED;
            PG8_STAGE(PG8_SB(1, 1), b3 + hstepB, voffB);
            PG8_WAIT_V(6); PG8_BAR; PG8_MMA(1, 1, At, B1); PG8_BAR;
        }
        epilogue<MODE>(g, acc, cur, wr, wc, fr, fq, lds + GEMM_LDS + 1024);
        if (!has_next) break;
#pragma unroll
        for (int a = 0; a < 2; ++a)
#pragma unroll
            for (int b = 0; b < 2; ++b)
#pragma unroll
                for (int m = 0; m < 4; ++m)
#pragma unroll
                    for (int n = 0; n < 2; ++n) acc[a][b][m][n] = (f32x4){0.f, 0.f, 0.f, 0.f};
        cur = nxt; cA = nA; cB = nB; ++ui;
    }
    PG8_WAIT_V(0);
    if (wr == 0) PG8_BAR;
    PG8_BAR;
#undef PG8_SA
#undef PG8_SB
#undef PG8_STAGE
#undef PG8_LDA
#undef PG8_LDB
#undef PG8_MMA
#undef PG8_WAIT_V
#undef PG8_WAIT_L
#undef PG8_BAR
#undef PG8_SCHED
#undef PG8_ABASE
#undef PG8_BBASE
}
}

__device__ __forceinline__ void p0_transpose_item(const float* W, int ldw, int K, int csrc0, bf16_t* WT, int row0, LAS float* scr, int kb, int lane, float wscale, const float* kgain) {
    const int k0 = 64 * kb;
#pragma unroll
    for (int i = 0; i < 8; ++i) { const int kk = 8 * i + (lane >> 3), n4 = (lane & 7) * 4;
        const float4 v = *(const float4*)(W + (size_t)(k0 + kk) * ldw + csrc0 + n4);
        const float ws = kgain ? kgain[k0 + kk] : wscale; (void)wscale;
        scr[kk * 33 + n4] = v.x * ws; scr[kk * 33 + n4 + 1] = v.y * ws; scr[kk * 33 + n4 + 2] = v.z * ws; scr[kk * 33 + n4 + 3] = v.w * ws; }
    asm volatile("s_waitcnt lgkmcnt(0)" ::: "memory");
    const int c = lane & 7;
#pragma unroll
    for (int j = 0; j < 4; ++j) { const int n = (lane >> 3) + 8 * j; const LAS float* s = scr + (8 * c) * 33 + n;
        uint4 o; o.x = pk2(s[0 * 33], s[1 * 33]); o.y = pk2(s[2 * 33], s[3 * 33]); o.z = pk2(s[4 * 33], s[5 * 33]); o.w = pk2(s[6 * 33], s[7 * 33]);
        *(uint4*)(WT + (size_t)(row0 + n) * K + k0 + 8 * c) = o; }
    asm volatile("s_waitcnt lgkmcnt(0)" ::: "memory");
}

__device__ __forceinline__ void d_conv_silu(int vb, int tid, const bf16_t* __restrict__ p6, const float* __restrict__ cw, const float* __restrict__ cb, bf16_t* __restrict__ c) {
    const int t = vb, s = t % S;
    for (int ch = tid; ch < 1024; ch += 256) {
        float y = cb[ch];
#pragma unroll
        for (int j = 0; j < 4; ++j) {
            const int ss = s - 3 + j;
            if (ss >= 0) y = fmaf(cw[j * 1024 + ch], bf2f(p6[(size_t)(t - 3 + j) * 1024 + ch]), y);
        }
        c[(size_t)t * 1024 + ch] = (bf16_t)f2bf(y / (1.0f + expf(-y)));
    }
}

__device__ __forceinline__ void d_mlstm(int vb, int tid, const bf16_t* __restrict__ mq, const bf16_t* __restrict__ mk, const bf16_t* __restrict__ p6,
                                        const float* __restrict__ gpre, const float* __restrict__ b_mi, const float* __restrict__ b_mf, float* __restrict__ hraw) {
    const int lane = tid & 63, w = tid >> 6;
    const int gid = vb * 4 + w;
    const int e = gid & 255, h = (gid >> 8) & 3, b = gid >> 10;
    const float bi = b_mi[h], bf = b_mf[h];
    float C0 = 0.f, C1 = 0.f, C2 = 0.f, C3 = 0.f, n0 = 0.f, n1 = 0.f, n2 = 0.f, n3 = 0.f, m = 0.f;
    const size_t tb = (size_t)b * S;
    const bf16_t* qp = mq + tb * 1024 + h * 256 + lane * 4;
    const bf16_t* kp = mk + tb * 1024 + h * 256 + lane * 4;
    const bf16_t* pp = p6 + P6S + tb * 1024 + h * 256 + e;
    ushort4 qn = *(const ushort4*)qp, kn = *(const ushort4*)kp;
    const float* gp = gpre + tb * 8;
    float vn = bf2f(pp[0]), in_ = gp[h], fn = gp[4 + h];
    for (int s = 0; s < S; ++s) {
        const float4 q = make_float4(bf2f(qn.x), bf2f(qn.y), bf2f(qn.z), bf2f(qn.w)), k = make_float4(bf2f(kn.x), bf2f(kn.y), bf2f(kn.z), bf2f(kn.w)); const float v = vn, ipre = in_ + bi, fpre = fn + bf;
        if (s + 1 < S) {
            qn = *(const ushort4*)(qp + (size_t)(s + 1) * 1024);
            kn = *(const ushort4*)(kp + (size_t)(s + 1) * 1024);
            vn = bf2f(pp[(size_t)(s + 1) * 1024]); in_ = gp[(size_t)(s + 1) * 8 + h]; fn = gp[(size_t)(s + 1) * 8 + 4 + h];
        }
        const float logf = log_sigmoid(fpre);
        const float mnew = fmaxf(logf + m, ipre);
        const float fd = expf(logf + m - mnew), ig = expf(ipre - mnew);
        m = mnew;
        const float sc = ig * 0.0625f;
        C0 = fd * C0 + sc * k.x * v; C1 = fd * C1 + sc * k.y * v; C2 = fd * C2 + sc * k.z * v; C3 = fd * C3 + sc * k.w * v;
        n0 = fd * n0 + sc * k.x; n1 = fd * n1 + sc * k.y; n2 = fd * n2 + sc * k.z; n3 = fd * n3 + sc * k.w;
        float num = q.x * C0 + q.y * C1 + q.z * C2 + q.w * C3;
        float den = q.x * n0 + q.y * n1 + q.z * n2 + q.w * n3;
        num = wave_sum(num); den = wave_sum(den);
        if (lane == 0) hraw[(tb + s) * 1024 + h * 256 + e] = num / fmaxf(fabsf(den), expf(-mnew));
    }
}

__device__ __forceinline__ void d_mhead_norm(int vb, int tid, const float* __restrict__ hraw, const bf16_t* __restrict__ p6, const float* __restrict__ g, bf16_t* __restrict__ mix) {
    const int t = vb, h = tid >> 6, lane = tid & 63;
    const float4 v = *(const float4*)(hraw + (size_t)t * 1024 + h * 256 + lane * 4);
    float s = v.x * v.x + v.y * v.y + v.z * v.z + v.w * v.w;
    s = wave_sum(s);
    const float r = rsqrtf(s * (1.0f / 256.0f) + EPS);
    const float4 gg = *(const float4*)(g + h * 256 + lane * 4);
    const ushort4 mo = *(const ushort4*)(p6 + 2 * P6S + (size_t)t * 1024 + h * 256 + lane * 4);
    float4 o;
    o.x = v.x * r * gg.x / (1.0f + expf(-bf2f(mo.x)));
    o.y = v.y * r * gg.y / (1.0f + expf(-bf2f(mo.y)));
    o.z = v.z * r * gg.z / (1.0f + expf(-bf2f(mo.z)));
    o.w = v.w * r * gg.w / (1.0f + expf(-bf2f(mo.w)));
    uint2 ob; ob.x = pk2(o.x, o.y); ob.y = pk2(o.z, o.w);
    *(uint2*)(mix + (size_t)t * D + h * 256 + lane * 4) = ob;
}

__device__ __forceinline__ void d_rope(int vb, int tid, bf16_t* __restrict__ p6) {
    const int t = vb, s = t % S;
    for (int idx = tid; idx < 2 * 8 * 64; idx += 256) {
        const int i = idx & 63, hd = (idx >> 6) & 7, qk = idx >> 9;
        const float inv = exp2f(-(float)i * 0.20762050593046014f);
        const float ang = (float)s * inv;
        float sn, cs; sincosf(ang, &sn, &cs);
        bf16_t* p = p6 + (size_t)(3 + qk) * P6S + (size_t)t * 1024 + hd * 128;
        const float x1 = bf2f(p[i]), x2 = bf2f(p[64 + i]);
        p[i] = (bf16_t)f2bf(x1 * cs - x2 * sn);
        p[64 + i] = (bf16_t)f2bf(x2 * cs + x1 * sn);
    }
}

__device__ __forceinline__ void d_dilated(int vb, int tid, float* sm, const bf16_t* __restrict__ p6, const float* __restrict__ g_ahead, bf16_t* __restrict__ mix) {
    float (*qs)[128] = (float (*)[128])sm;
    float (*ps)[576] = (float (*)[576])(sm + 512);
    const int lane = tid & 63, w = tid >> 6;
    const int gid = vb * 4 + w;
    const int s = gid % S, hd = (gid / S) & 7, b = gid / (S * 8);
    const size_t t = (size_t)b * S + s;
    const bf16_t* qrow = p6 + 3 * P6S + t * 1024 + hd * 128;
    __syncthreads();
    qs[w][lane] = bf2f(qrow[lane]); qs[w][lane + 64] = bf2f(qrow[lane + 64]);
    __syncthreads();
    const float scale = 0.08838834764831845f;
    float mloc = -INFINITY;
    for (int br = 0; br < 3; ++br) {
        const int dil = br == 0 ? 1 : (br == 1 ? 4 : 16);
        for (int jj = 0; jj < 192; jj += 64) {
            const int j = jj + lane;
            float sc = -INFINITY;
            if (j <= 128 && s - j * dil >= 0) {
                const bf16_t* krow = p6 + 4 * P6S + (t - (size_t)j * dil) * 1024 + hd * 128;
                float d = 0.f;
#pragma unroll 8
                for (int c = 0; c < 128; c += 4) {
                    const ushort4 kv = *(const ushort4*)(krow + c);
                    d = fmaf(qs[w][c], bf2f(kv.x), d); d = fmaf(qs[w][c + 1], bf2f(kv.y), d); d = fmaf(qs[w][c + 2], bf2f(kv.z), d); d = fmaf(qs[w][c + 3], bf2f(kv.w), d);
                }
                sc = d * scale;
            }
            ps[w][br * 192 + j] = sc;
            mloc = fmaxf(mloc, sc);
        }
    }
    const float mx = wave_max(mloc);
    __syncthreads();
    float lsum = 0.f;
    for (int i = lane; i < 3 * 192; i += 64) {
        const float sc = ps[w][i];
        const float pv = (sc == -INFINITY) ? 0.f : expf(sc - mx);
        ps[w][i] = pv; lsum += pv;
    }
    const float tot = wave_sum(lsum);
    __syncthreads();
    float o0 = 0.f, o1 = 0.f;
    for (int br = 0; br < 3; ++br) {
        const int dil = br == 0 ? 1 : (br == 1 ? 4 : 16);
        for (int j = 0; j <= 128; ++j) {
            if (s - j * dil < 0) break;
            const float pv = ps[w][br * 192 + j];
            const bf16_t* vrow = p6 + 5 * P6S + (t - (size_t)j * dil) * 1024 + hd * 128;
            o0 = fmaf(pv, bf2f(vrow[lane]), o0); o1 = fmaf(pv, bf2f(vrow[lane + 64]), o1);
        }
    }
    o0 /= tot; o1 /= tot;
    float ss = wave_sum(o0 * o0 + o1 * o1);
    const float r = rsqrtf(ss * (1.0f / 128.0f) + EPS);
    bf16_t* orow = mix + t * D + 1024 + hd * 128;
    orow[lane] = (bf16_t)f2bf(o0 * r * g_ahead[hd * 128 + lane]);
    orow[lane + 64] = (bf16_t)f2bf(o1 * r * g_ahead[hd * 128 + lane + 64]);
}

__device__ __forceinline__ void d_cross(int vb, int tid, float* sm, const bf16_t* __restrict__ q, const float* __restrict__ km, const float* __restrict__ vm, bf16_t* __restrict__ o) {
    float (*qs)[512] = (float (*)[512])sm;
    float (*ps)[256] = (float (*)[256])(sm + 2048);
    const int lane = tid & 63, w = tid >> 6;
    const int t = vb, hd = w, b = t / S;
    const bf16_t* qrow = q + (size_t)t * D + hd * 512;
    __syncthreads();
    for (int i = lane; i < 512; i += 64) qs[w][i] = bf2f(qrow[i]);
    __syncthreads();
    const float scale = 0.04419417382415922f;
    float sc[4]; float mloc = -INFINITY;
#pragma unroll
    for (int r = 0; r < 4; ++r) {
        const int mi = lane + 64 * r;
        const float* krow = km + ((size_t)b * 256 + mi) * D + hd * 512;
        float d = 0.f;
#pragma unroll 8
        for (int c = 0; c < 512; c += 4) {
            const float4 kv = *(const float4*)(krow + c);
            d = fmaf(qs[w][c], kv.x, d); d = fmaf(qs[w][c + 1], kv.y, d); d = fmaf(qs[w][c + 2], kv.z, d); d = fmaf(qs[w][c + 3], kv.w, d);
        }
        sc[r] = d * scale; mloc = fmaxf(mloc, sc[r]);
    }
    const float mx = wave_max(mloc);
    float lsum = 0.f;
#pragma unroll
    for (int r = 0; r < 4; ++r) { const float pv = expf(sc[r] - mx); ps[w][lane + 64 * r] = pv; lsum += pv; }
    const float tot = wave_sum(lsum);
    __syncthreads();
    float acc[8];
#pragma unroll
    for (int i = 0; i < 8; ++i) acc[i] = 0.f;
    for (int mi = 0; mi < 256; ++mi) {
        const float pv = ps[w][mi];
        const float* vrow = vm + ((size_t)b * 256 + mi) * D + hd * 512;
#pragma unroll
        for (int i = 0; i < 8; ++i) acc[i] = fmaf(pv, vrow[lane + 64 * i], acc[i]);
    }
    bf16_t* orow = o + (size_t)t * D + hd * 512;
#pragma unroll
    for (int i = 0; i < 8; ++i) orow[lane + 64 * i] = (bf16_t)f2bf(acc[i] / tot);
}

__device__ __forceinline__ void wave_argmax(float& best, int& bidx) {
#pragma unroll
    for (int o = 32; o >= 1; o >>= 1) {
        const float ob = __shfl_xor(best, o); const int oi = __shfl_xor(bidx, o);
        if (ob > best || (ob == best && oi < bidx)) { best = ob; bidx = oi; }
    }
}
__device__ __forceinline__ void d_peer_topk(int vb, int tid, float* sm, const bf16_t* __restrict__ qp, const float* __restrict__ sub_keys, int* __restrict__ ids, float* __restrict__ gates) {
    float (*qs)[256] = (float (*)[256])sm;
    const int lane = tid & 63, w = tid >> 6;
    const int gid = vb * 4 + w;
    const int hd = gid & 7, t = gid >> 3;
    const bf16_t* qrow = qp + (size_t)t * D + hd * 256;
    __syncthreads();
    for (int i = lane; i < 256; i += 64) qs[w][i] = bf2f(qrow[i]);
    __syncthreads();
    float tops[2]; int topi[2];
#pragma unroll
    for (int p = 0; p < 2; ++p) {
        float v0, v1;
        {
            const float* k0 = sub_keys + ((size_t)(hd * 2 + p) * 128 + lane) * 128;
            const float* k1 = k0 + 64 * 128;
            float d0 = 0.f, d1 = 0.f;
#pragma unroll 8
            for (int c = 0; c < 128; c += 4) {
                const float4 a = *(const float4*)(k0 + c), bb = *(const float4*)(k1 + c);
                const float q0 = qs[w][p * 128 + c], q1 = qs[w][p * 128 + c + 1], q2 = qs[w][p * 128 + c + 2], q3 = qs[w][p * 128 + c + 3];
                d0 = fmaf(q0, a.x, d0); d0 = fmaf(q1, a.y, d0); d0 = fmaf(q2, a.z, d0); d0 = fmaf(q3, a.w, d0);
                d1 = fmaf(q0, bb.x, d1); d1 = fmaf(q1, bb.y, d1); d1 = fmaf(q2, bb.z, d1); d1 = fmaf(q3, bb.w, d1);
            }
            v0 = d0; v1 = d1;
        }
        float ts = 0.f; int ti = 0;
        for (int it = 0; it < 16; ++it) {
            float best; int bidx;
            if (v0 >= v1) { best = v0; bidx = lane; } else { best = v1; bidx = lane + 64; }
            wave_argmax(best, bidx);
            if (lane == it) { ts = best; ti = bidx; }
            if (bidx == lane) v0 = -INFINITY;
            if (bidx == lane + 64) v1 = -INFINITY;
        }
        tops[p] = ts; topi[p] = ti;
    }
    float cv[4]; int ci[4];
#pragma unroll
    for (int r = 0; r < 4; ++r) {
        const int c = lane * 4 + r, i = c >> 4, j = c & 15;
        const float s0 = __shfl(tops[0], i), s1 = __shfl(tops[1], j);
        const int i0 = __shfl(topi[0], i), i1 = __shfl(topi[1], j);
        cv[r] = s0 + s1; ci[r] = i0 * 128 + i1;
    }
    float bs = 0.f; int bid = 0;
    for (int it = 0; it < 16; ++it) {
        float best = cv[0]; int bidx = lane * 4;
#pragma unroll
        for (int r = 1; r < 4; ++r) if (cv[r] > best) { best = cv[r]; bidx = lane * 4 + r; }
        wave_argmax(best, bidx);
        const int owner = bidx >> 2, rr = bidx & 3;
        int myid = ci[0];
        if (rr == 1) myid = ci[1]; else if (rr == 2) myid = ci[2]; else if (rr == 3) myid = ci[3];
        const int eid = __shfl(myid, owner);
        if (lane == it) { bs = best; bid = eid; }
        if (owner == lane) {
#pragma unroll
            for (int r = 0; r < 4; ++r) if (rr == r) cv[r] = -INFINITY;
        }
    }
    float v = lane < 16 ? bs : -INFINITY;
    const float mx = wave_max(v);
    const float ev = lane < 16 ? expf(bs - mx) : 0.f;
    const float tot = wave_sum(ev);
    if (lane < 16) {
        ids[(size_t)t * 128 + hd * 16 + lane] = bid;
        gates[(size_t)t * 128 + hd * 16 + lane] = ev / tot;
    }
}

__device__ __forceinline__ void d_peer_out(int vb, int tid, float* sm, const bf16_t* __restrict__ h3, const float* __restrict__ x2, const int* __restrict__ ids, const float* __restrict__ gates,
                                           const bf16_t* __restrict__ u_tab, const bf16_t* __restrict__ v_tab, const float* __restrict__ g_final, float* __restrict__ out) {
    float (*part)[2048] = (float (*)[2048])sm;
    float* red = sm + 4 * 2048;
    const int lane = tid & 63, w = tid >> 6, t = vb;
    float4 xr[8], acc[8];
    const bf16_t* hrow = h3 + (size_t)t * D;
#pragma unroll
    for (int i = 0; i < 8; ++i) { const ushort4 hv = *(const ushort4*)(hrow + i * 256 + lane * 4);
        xr[i] = make_float4(bf2f(hv.x), bf2f(hv.y), bf2f(hv.z), bf2f(hv.w)); acc[i] = make_float4(0.f, 0.f, 0.f, 0.f); }
    for (int j = 0; j < 32; ++j) {
        const int slot = w * 32 + j;
        const int e = ids[(size_t)t * 128 + slot];
        const float gt = gates[(size_t)t * 128 + slot];
        const bf16_t* ur = u_tab + (size_t)e * D;
        const bf16_t* vr = v_tab + (size_t)e * D;
        float d = 0.f;
#pragma unroll
        for (int i = 0; i < 8; ++i) {
            const ushort4 u = *(const ushort4*)(ur + i * 256 + lane * 4);
            d = fmaf(xr[i].x, bf2f(u.x), d); d = fmaf(xr[i].y, bf2f(u.y), d); d = fmaf(xr[i].z, bf2f(u.z), d); d = fmaf(xr[i].w, bf2f(u.w), d);
        }
        d = wave_sum(d);
        const float act = 0.5f * d * (1.0f + erff(d * 0.7071067811865476f));
        const float cf = gt * act;
#pragma unroll
        for (int i = 0; i < 8; ++i) {
            const ushort4 v = *(const ushort4*)(vr + i * 256 + lane * 4);
            acc[i].x = fmaf(cf, bf2f(v.x), acc[i].x); acc[i].y = fmaf(cf, bf2f(v.y), acc[i].y); acc[i].z = fmaf(cf, bf2f(v.z), acc[i].z); acc[i].w = fmaf(cf, bf2f(v.w), acc[i].w);
        }
    }
    __syncthreads();
#pragma unroll
    for (int i = 0; i < 8; ++i) *(float4*)&part[w][i * 256 + lane * 4] = acc[i];
    __syncthreads();
    float4 r0, r1;
    {
        const float4 a = *(const float4*)&part[0][tid * 4], b = *(const float4*)&part[1][tid * 4], c = *(const float4*)&part[2][tid * 4], d = *(const float4*)&part[3][tid * 4];
        const float4 x = *(const float4*)(x2 + (size_t)t * D + tid * 4);
        r0 = make_float4(x.x + a.x + b.x + c.x + d.x, x.y + a.y + b.y + c.y + d.y, x.z + a.z + b.z + c.z + d.z, x.w + a.w + b.w + c.w + d.w);
    }
    {
        const float4 a = *(const float4*)&part[0][1024 + tid * 4], b = *(const float4*)&part[1][1024 + tid * 4], c = *(const float4*)&part[2][1024 + tid * 4], d = *(const float4*)&part[3][1024 + tid * 4];
        const float4 x = *(const float4*)(x2 + (size_t)t * D + 1024 + tid * 4);
        r1 = make_float4(x.x + a.x + b.x + c.x + d.x, x.y + a.y + b.y + c.y + d.y, x.z + a.z + b.z + c.z + d.z, x.w + a.w + b.w + c.w + d.w);
    }
    float s = r0.x * r0.x + r0.y * r0.y + r0.z * r0.z + r0.w * r0.w + r1.x * r1.x + r1.y * r1.y + r1.z * r1.z + r1.w * r1.w;
    s = wave_sum(s);
    if (lane == 0) red[w] = s;
    __syncthreads();
    const float tot = red[0] + red[1] + red[2] + red[3];
    const float r = rsqrtf(tot * (1.0f / D) + EPS);
    const float4 g0 = *(const float4*)(g_final + tid * 4), g1 = *(const float4*)(g_final + 1024 + tid * 4);
    *(float4*)(out + (size_t)t * D + tid * 4) = make_float4(r0.x * r * g0.x, r0.y * r * g0.y, r0.z * r * g0.z, r0.w * r * g0.w);
    *(float4*)(out + (size_t)t * D + 1024 + tid * 4) = make_float4(r1.x * r * g1.x, r1.y * r * g1.y, r1.z * r * g1.z, r1.w * r * g1.w);
}


__device__ __forceinline__ float wave_incl_scan_add(float v, int lane) {
#pragma unroll
    for (int o = 1; o < 64; o <<= 1) { const float t = __shfl_up(v, o); if (lane >= o) v += t; }
    return v;
}
__device__ __forceinline__ float wave_incl_scan_max(float v, int lane) {
#pragma unroll
    for (int o = 1; o < 64; o <<= 1) { const float t = __shfl_up(v, o); if (lane >= o) v = fmaxf(v, t); }
    return v;
}
__device__ __forceinline__ void mlstm_gates_wave(int b, int h, int lane, const float* __restrict__ gpre, const float* __restrict__ b_mi, const float* __restrict__ b_mf,
                                                 float* __restrict__ gs, float* __restrict__ decay) {
    const float bi = b_mi[h], bf = b_mf[h];
    float mprev = 0.f;
    for (int c = 0; c < 16; ++c) {
        const size_t t0 = (size_t)b * S + c * 256 + lane * 4;
        float logi[4], lf[4], bb[4];
#pragma unroll
        for (int j = 0; j < 4; ++j) { logi[j] = gpre[(t0 + j) * 8 + h] + bi; lf[j] = log_sigmoid(gpre[(t0 + j) * 8 + 4 + h] + bf); }
        bb[0] = lf[0]; bb[1] = bb[0] + lf[1]; bb[2] = bb[1] + lf[2]; bb[3] = bb[2] + lf[3];
        const float incl = wave_incl_scan_add(bb[3], lane);
        const float excl = incl - bb[3];
#pragma unroll
        for (int j = 0; j < 4; ++j) bb[j] += excl;
        const float g = __shfl(incl, 63);
        float amax = -INFINITY, uu[4], cm[4];
#pragma unroll
        for (int j = 0; j < 4; ++j) { amax = fmaxf(amax, logi[j] + g - bb[j]); uu[j] = logi[j] - bb[j]; }
        amax = wave_max(amax);
        const float mnew = fmaxf(g + mprev, amax);
        cm[0] = uu[0]; cm[1] = fmaxf(cm[0], uu[1]); cm[2] = fmaxf(cm[1], uu[2]); cm[3] = fmaxf(cm[2], uu[3]);
        const float cincl = wave_incl_scan_max(cm[3], lane);
        float cexcl = __shfl_up(cincl, 1); if (lane == 0) cexcl = -INFINITY;
#pragma unroll
        for (int j = 0; j < 4; ++j) {
            const float M = fmaxf(mprev, fmaxf(cexcl, cm[j]));
            float* o = gs + ((t0 + j) * 4 + h) * 8;
            o[0] = uu[j] * 1.4426950408889634f; o[1] = M * 1.4426950408889634f; o[2] = expf(logi[j] + g - bb[j] - mnew); o[3] = expf(mprev - M); o[4] = expf(-(bb[j] + M));
        }
        if (lane == 0) decay[(b * 16 + c) * 4 + h] = expf(g + mprev - mnew);
        mprev = mnew;
    }
}
__device__ __forceinline__ void transpose_tile64(int tid, float* sm, const bf16_t* __restrict__ src, int src_ld, bf16_t* __restrict__ dst, int dst_ld, const float* __restrict__ scale, int sstride) {
    unsigned short (*tl)[66] = (unsigned short (*)[66])sm;
    __syncthreads();
#pragma unroll
    for (int i = 0; i < 2; ++i) {
        const int ch = tid + i * 256, r = ch >> 3, c8 = (ch & 7) * 8;
        const uint4 v = *(const uint4*)(src + (size_t)r * src_ld + c8);
        const float sc = scale ? scale[(size_t)r * sstride] : 1.0f;
        const unsigned w[4] = {v.x, v.y, v.z, v.w};
#pragma unroll
        for (int k = 0; k < 4; ++k) {
            tl[r][c8 + 2 * k] = (unsigned short)f2bf(bf2f((unsigned short)(w[k] & 0xFFFFu)) * sc);
            tl[r][c8 + 2 * k + 1] = (unsigned short)f2bf(bf2f((unsigned short)(w[k] >> 16)) * sc);
        }
    }
    __syncthreads();
#pragma unroll
    for (int i = 0; i < 2; ++i) {
        const int ch = tid + i * 256, c = ch >> 3, r8 = (ch & 7) * 8;
        uint4 o;
        o.x = (unsigned)tl[r8 + 0][c] | ((unsigned)tl[r8 + 1][c] << 16); o.y = (unsigned)tl[r8 + 2][c] | ((unsigned)tl[r8 + 3][c] << 16);
        o.z = (unsigned)tl[r8 + 4][c] | ((unsigned)tl[r8 + 5][c] << 16); o.w = (unsigned)tl[r8 + 6][c] | ((unsigned)tl[r8 + 7][c] << 16);
        *(uint4*)(dst + (size_t)c * dst_ld + r8) = o;
    }
}

__device__ __forceinline__ void rope_table_fill(float2* __restrict__ cs, int gtid, int nth) {
    for (int idx = gtid; idx < 4096 * 64; idx += nth) {
        const int i = idx & 63, s = idx >> 6;
        const float inv = exp2f(-(float)i * 0.20762050593046014f);
        const float ang = (float)s * inv;
        float sn, c; sincosf(ang, &sn, &c);
        cs[idx] = make_float2(c, sn);
    }
}
__device__ __forceinline__ void rope_q_pass(bf16_t* __restrict__ aq, const float2* __restrict__ cs, size_t gtid, size_t nth) {
    for (size_t idx = gtid; idx < (size_t)T * 8 * 8; idx += nth) {
        const int c8 = (int)(idx & 7), hd = (int)((idx >> 3) & 7); const size_t t = idx >> 6; const int s = (int)(t & (S - 1));
        bf16_t* p = aq + t * 1024 + hd * 128 + c8 * 8;
        const uint4 a = *(const uint4*)p, b = *(const uint4*)(p + 64);
        const unsigned aw[4] = {a.x, a.y, a.z, a.w}, bw[4] = {b.x, b.y, b.z, b.w};
        unsigned ao[4], bo[4];
#pragma unroll
        for (int k = 0; k < 4; ++k) {
            const float4 cc = *(const float4*)(cs + (size_t)s * 64 + c8 * 8 + 2 * k);
            const float x10 = __uint_as_float(aw[k] << 16), x11 = __uint_as_float(aw[k] & 0xFFFF0000u), x20 = __uint_as_float(bw[k] << 16), x21 = __uint_as_float(bw[k] & 0xFFFF0000u);
            ao[k] = pk2(x10 * cc.x - x20 * cc.y, x11 * cc.z - x21 * cc.w);
            bo[k] = pk2(x20 * cc.x + x10 * cc.y, x21 * cc.z + x11 * cc.w);
        }
        *(uint4*)p = make_uint4(ao[0], ao[1], ao[2], ao[3]); *(uint4*)(p + 64) = make_uint4(bo[0], bo[1], bo[2], bo[3]);
    }
}
__device__ __forceinline__ void dil_tile_prep(int item, int lane, LAS unsigned short* wl, const bf16_t* __restrict__ ak, const bf16_t* __restrict__ av, const float2* __restrict__ cs,
                                              bf16_t* __restrict__ KB, bf16_t* __restrict__ VB) {
    const int TT = item & 255, hd = (item >> 8) & 7, b = (item >> 11) & 1, br = item >> 12;
    const int ld = 2 * br, tpr = 256 >> ld, rho = TT / tpr, tile = TT - rho * tpr;
    const int i = lane & 15, c = lane >> 4;
    const int s = rho + ((16 * tile + i) << ld);
    const size_t trow = (size_t)b * S + s;
    bf16_t* kdst = KB + (size_t)item * 2048;
    bf16_t* vdst = VB + (size_t)item * 2048;
    {
        const bf16_t* kr = ak + trow * 1024 + hd * 128 + 16 * c;
        const uint4 a0 = *(const uint4*)kr, a1 = *(const uint4*)(kr + 8), b0 = *(const uint4*)(kr + 64), b1 = *(const uint4*)(kr + 72);
        const unsigned aw[8] = {a0.x, a0.y, a0.z, a0.w, a1.x, a1.y, a1.z, a1.w}, bw[8] = {b0.x, b0.y, b0.z, b0.w, b1.x, b1.y, b1.z, b1.w};
        unsigned ao[8], bo[8];
#pragma unroll
        for (int k = 0; k < 8; ++k) {
            const float4 cc = *(const float4*)(cs + (size_t)s * 64 + 16 * c + 2 * k);
            const float x10 = __uint_as_float(aw[k] << 16), x11 = __uint_as_float(aw[k] & 0xFFFF0000u), x20 = __uint_as_float(bw[k] << 16), x21 = __uint_as_float(bw[k] & 0xFFFF0000u);
            ao[k] = pk2(x10 * cc.x - x20 * cc.y, x11 * cc.z - x21 * cc.w);
            bo[k] = pk2(x20 * cc.x + x10 * cc.y, x21 * cc.z + x11 * cc.w);
        }
        bf16_t* d0 = kdst + (c >> 1) * 512 + i * 32 + (c & 1) * 16;
        *(uint4*)d0 = make_uint4(ao[0], ao[1], ao[2], ao[3]); *(uint4*)(d0 + 8) = make_uint4(ao[4], ao[5], ao[6], ao[7]);
        bf16_t* d1 = d0 + 1024;
        *(uint4*)d1 = make_uint4(bo[0], bo[1], bo[2], bo[3]); *(uint4*)(d1 + 8) = make_uint4(bo[4], bo[5], bo[6], bo[7]);
    }
    {
        const bf16_t* vr = av + trow * 1024 + hd * 128 + 32 * c;
        const uint4 v0 = *(const uint4*)vr, v1 = *(const uint4*)(vr + 8), v2 = *(const uint4*)(vr + 16), v3 = *(const uint4*)(vr + 24);
        LAS unsigned short* wr = wl + i * 136 + 32 * c;
        typedef unsigned u32x4_t __attribute__((ext_vector_type(4)));
        *(LAS u32x4_t*)wr = (u32x4_t){v0.x, v0.y, v0.z, v0.w}; *(LAS u32x4_t*)(wr + 8) = (u32x4_t){v1.x, v1.y, v1.z, v1.w};
        *(LAS u32x4_t*)(wr + 16) = (u32x4_t){v2.x, v2.y, v2.z, v2.w}; *(LAS u32x4_t*)(wr + 24) = (u32x4_t){v3.x, v3.y, v3.z, v3.w};
        asm volatile("s_waitcnt lgkmcnt(0)" ::: "memory");
        unsigned o[16];
#pragma unroll
        for (int k = 0; k < 8; ++k) {
            const unsigned p0 = *(const LAS unsigned*)(wl + (2 * k) * 136 + 2 * lane), p1 = *(const LAS unsigned*)(wl + (2 * k + 1) * 136 + 2 * lane);
            o[k] = (p0 & 0xFFFFu) | (p1 << 16);
            o[8 + k] = (p0 >> 16) | (p1 & 0xFFFF0000u);
        }
        bf16_t* d = vdst + (2 * lane) * 16;
        *(uint4*)d = make_uint4(o[0], o[1], o[2], o[3]); *(uint4*)(d + 8) = make_uint4(o[4], o[5], o[6], o[7]);
        *(uint4*)(d + 16) = make_uint4(o[8], o[9], o[10], o[11]); *(uint4*)(d + 24) = make_uint4(o[12], o[13], o[14], o[15]);
        asm volatile("s_waitcnt lgkmcnt(0)" ::: "memory");
    }
}

typedef short bf16x8_t __attribute__((ext_vector_type(8)));
typedef short bf16x4_t __attribute__((ext_vector_type(4)));
typedef float f32x4_t __attribute__((ext_vector_type(4)));
__device__ __forceinline__ float xg_max_f32(float v);
__device__ __forceinline__ float xg_sum_f32(float v);
__device__ __forceinline__ void dilated_wave_tile(int qt2, int lane, const bf16_t* __restrict__ AQ, const float2* __restrict__ cs, const bf16_t* __restrict__ KB, const bf16_t* __restrict__ VB,
                                                  const float* __restrict__ g_ahead, bf16_t* __restrict__ mix) {
    const int r = qt2 & 7, blk = (qt2 >> 3) & 15, hd = (qt2 >> 7) & 7, b = qt2 >> 10;
    const int j = lane & 15, g = lane >> 4;
    const int t0 = blk * 256;
    bf16x8_t qf[2][4];
#pragma unroll
    for (int qi = 0; qi < 2; ++qi) {
        const int sq = t0 + r + 8 * qi + 16 * j;
        const bf16_t* qrow = AQ + ((size_t)b * S + sq) * 1024 + hd * 128 + 8 * g;
        const float sc = 0.08838834764831845f * 1.4426950408889634f;
#pragma unroll
        for (int ks = 0; ks < 2; ++ks) {
            const bf16x8_t lo = *(const bf16x8_t*)(qrow + 32 * ks), hi = *(const bf16x8_t*)(qrow + 32 * ks + 64);
            bf16x8_t olo, ohi;
#pragma unroll
            for (int e2 = 0; e2 < 4; ++e2) {
                const float4 cc = *(const float4*)(cs + (size_t)sq * 64 + 32 * ks + 8 * g + 2 * e2);
                const float x10 = bf2f((unsigned short)lo[2 * e2]), x11 = bf2f((unsigned short)lo[2 * e2 + 1]), x20 = bf2f((unsigned short)hi[2 * e2]), x21 = bf2f((unsigned short)hi[2 * e2 + 1]);
                const unsigned wl_ = pk2((x10 * cc.x - x20 * cc.y) * sc, (x11 * cc.z - x21 * cc.w) * sc), wh_ = pk2((x20 * cc.x + x10 * cc.y) * sc, (x21 * cc.z + x11 * cc.w) * sc);
                olo[2 * e2] = (short)(wl_ & 0xFFFF); olo[2 * e2 + 1] = (short)(wl_ >> 16); ohi[2 * e2] = (short)(wh_ & 0xFFFF); ohi[2 * e2 + 1] = (short)(wh_ >> 16);
            }
            qf[qi][ks] = olo; qf[qi][ks + 2] = ohi;
        }
    }
    float m_run[2] = {-1e30f, -1e30f}, l_run[2] = {0.f, 0.f};
    f32x4_t o[2][8];
#pragma unroll
    for (int qi = 0; qi < 2; ++qi)
#pragma unroll
        for (int dt = 0; dt < 8; ++dt) o[qi][dt] = (f32x4_t){0.f, 0.f, 0.f, 0.f};
#define DIL_STEP(QI, QJ, TP, KF, VF) { \
        f32x4_t su[2]; \
        _Pragma("unroll") for (int u = 0; u < 2; ++u) { f32x4_t a = (f32x4_t){0.f, 0.f, 0.f, 0.f}; \
            _Pragma("unroll") for (int ks = 0; ks < 4; ++ks) a = __builtin_amdgcn_mfma_f32_16x16x32_bf16(KF[u][ks], qf[QI][ks], a, 0, 0, 0); su[u] = a; } \
        float p[2][4]; float mx = -1e30f; \
        _Pragma("unroll") for (int u = 0; u < 2; ++u) _Pragma("unroll") for (int e = 0; e < 4; ++e) { \
            const int n = (QJ) - (16 * ((TP) + u) + 4 * g + e); const bool valid = (n >= 0) && (n <= 128); \
            p[u][e] = valid ? su[u][e] : -1e30f; mx = fmaxf(mx, p[u][e]); } \
        mx = xg_max_f32(mx); \
        const float m_new = fmaxf(m_run[QI], mx); const float alpha = __builtin_amdgcn_exp2f(m_run[QI] - m_new); m_run[QI] = m_new; \
        float ps = 0.f; \
        _Pragma("unroll") for (int u = 0; u < 2; ++u) _Pragma("unroll") for (int e = 0; e < 4; ++e) { p[u][e] = (p[u][e] > -1e29f) ? __builtin_amdgcn_exp2f(p[u][e] - m_new) : 0.f; ps += p[u][e]; } \
        l_run[QI] = l_run[QI] * alpha + ps; \
        bf16x8_t pb; { const unsigned w0 = pk2(p[0][0], p[0][1]), w1 = pk2(p[0][2], p[0][3]), w2 = pk2(p[1][0], p[1][1]), w3 = pk2(p[1][2], p[1][3]); \
            pb[0] = (short)(w0 & 0xFFFF); pb[1] = (short)(w0 >> 16); pb[2] = (short)(w1 & 0xFFFF); pb[3] = (short)(w1 >> 16); \
            pb[4] = (short)(w2 & 0xFFFF); pb[5] = (short)(w2 >> 16); pb[6] = (short)(w3 & 0xFFFF); pb[7] = (short)(w3 >> 16); } \
        _Pragma("unroll") for (int dt = 0; dt < 8; ++dt) { const bf16x4_t v0 = VF[dt][0], v1 = VF[dt][1]; \
            bf16x8_t va; va[0] = v0[0]; va[1] = v0[1]; va[2] = v0[2]; va[3] = v0[3]; va[4] = v1[0]; va[5] = v1[1]; va[6] = v1[2]; va[7] = v1[3]; \
            f32x4_t oo = o[QI][dt]; oo = oo * alpha; o[QI][dt] = __builtin_amdgcn_mfma_f32_16x16x32_bf16(va, pb, oo, 0, 0, 0); } }
#define DIL_LOADK(KF, TL) _Pragma("unroll") for (int u = 0; u < 2; ++u) { int tl_ = (TL) + u; if (tl_ > tile_max) tl_ = tile_max; \
            _Pragma("unroll") for (int ks = 0; ks < 4; ++ks) KF[u][ks] = *(const bf16x8_t*)(kbb + (size_t)tl_ * 2048 + 512 * ks); }
#define DIL_LOADV(VF, TP) { int tl0 = (TP), tl1 = (TP) + 1; if (tl0 > tile_max) tl0 = tile_max; if (tl1 > tile_max) tl1 = tile_max; \
            _Pragma("unroll") for (int dt = 0; dt < 8; ++dt) { VF[dt][0] = *(const bf16x4_t*)(vbb + dt * 256 + (size_t)tl0 * 2048); VF[dt][1] = *(const bf16x4_t*)(vbb + dt * 256 + (size_t)tl1 * 2048); } }
#pragma nounroll
    for (int br = 0; br < 2; ++br) {
        const int ld = 2 * br, d = 1 << ld;
        const int rho = r & (d - 1);
        const int qj0 = (t0 + r + 16 * j - rho) >> ld, qj1 = (t0 + r + 8 + 16 * j - rho) >> ld;
        const int q_lo = ((t0 + r - rho) >> ld) - 128, q_hi = (t0 + r + 8 + 240 - rho) >> ld;
        const int tile_lo = q_lo < 0 ? 0 : (q_lo >> 4), tile_hi = q_hi >> 4, tile_max = (256 >> ld) - 1;
        const size_t tbase = ((size_t)((br * 2 + b) * 8 + hd) * 256 + (size_t)rho * (256 >> ld)) * 2048;
        const bf16_t* kbb = KB + tbase + j * 32 + 8 * g;
        const bf16_t* vbb = VB + tbase + j * 16 + 4 * g;
        bf16x8_t kf[2][4];
        DIL_LOADK(kf, tile_lo)
#pragma nounroll
        for (int tp = tile_lo; tp <= tile_hi; tp += 2) {
            bf16x4_t vf[8][2];
            DIL_LOADV(vf, tp)
            bf16x8_t kc[2][4];
#pragma unroll
            for (int u = 0; u < 2; ++u)
#pragma unroll
                for (int ks = 0; ks < 4; ++ks) kc[u][ks] = kf[u][ks];
            DIL_LOADK(kf, tp + 2)
            DIL_STEP(0, qj0, tp, kc, vf)
            DIL_STEP(1, qj1, tp, kc, vf)
        }
    }
#pragma unroll
    for (int qi = 0; qi < 2; ++qi) {
        const int rho = r + 8 * qi;
        const int qj = (t0 + 16 * j) >> 4;
        const int q_lo = (t0 >> 4) - 128, q_hi = (t0 + 240) >> 4;
        const int tile_lo = q_lo < 0 ? 0 : (q_lo >> 4), tile_hi = q_hi >> 4, tile_max = 15;
        const size_t tbase = ((size_t)((2 * 2 + b) * 8 + hd) * 256 + (size_t)rho * 16) * 2048;
        const bf16_t* kbb = KB + tbase + j * 32 + 8 * g;
        const bf16_t* vbb = VB + tbase + j * 16 + 4 * g;
        bf16x8_t kf[2][4];
        DIL_LOADK(kf, tile_lo)
#pragma nounroll
        for (int tp = tile_lo; tp <= tile_hi; tp += 2) {
            bf16x4_t vf[8][2];
            DIL_LOADV(vf, tp)
            bf16x8_t kc[2][4];
#pragma unroll
            for (int u = 0; u < 2; ++u)
#pragma unroll
                for (int ks = 0; ks < 4; ++ks) kc[u][ks] = kf[u][ks];
            DIL_LOADK(kf, tp + 2)
            if (qi == 0) { DIL_STEP(0, qj, tp, kc, vf) } else { DIL_STEP(1, qj, tp, kc, vf) }
        }
    }
#undef DIL_STEP
#undef DIL_LOADK
#undef DIL_LOADV
#pragma unroll
    for (int qi = 0; qi < 2; ++qi) {
        const int sq = t0 + r + 8 * qi + 16 * j;
        const float inv = 1.0f / xg_sum_f32(l_run[qi]);
        float ss = 0.f;
#pragma unroll
        for (int dt = 0; dt < 8; ++dt) { o[qi][dt] = o[qi][dt] * inv; ss += (o[qi][dt][0] * o[qi][dt][0] + o[qi][dt][1] * o[qi][dt][1]) + (o[qi][dt][2] * o[qi][dt][2] + o[qi][dt][3] * o[qi][dt][3]); }
        ss = xg_sum_f32(ss);
        const float rn = rsqrtf(ss * (1.0f / 128.0f) + EPS);
        bf16_t* orow = mix + ((size_t)b * S + sq) * D + 1024 + hd * 128 + 4 * g;
#pragma unroll
        for (int dt = 0; dt < 8; ++dt) {
            const f32x4_t gv = *(const f32x4_t*)(g_ahead + hd * 128 + 16 * dt + 4 * g);
            uint2 w; w.x = pk2(o[qi][dt][0] * rn * gv[0], o[qi][dt][1] * rn * gv[1]); w.y = pk2(o[qi][dt][2] * rn * gv[2], o[qi][dt][3] * rn * gv[3]);
            *(uint2*)(orow + 16 * dt) = w;
        }
    }
}

__device__ __forceinline__ unsigned ord_key(float s) { const unsigned u = __float_as_uint(s); return u ^ ((unsigned)((int)u >> 31) | 0x80000000u); }
__device__ __forceinline__ unsigned wave_max_u32(unsigned v) {
    unsigned t;
    t = (unsigned)__builtin_amdgcn_update_dpp(0, (int)v, 0xB1, 0xF, 0xF, true); v = v > t ? v : t;
    t = (unsigned)__builtin_amdgcn_update_dpp(0, (int)v, 0x4E, 0xF, 0xF, true); v = v > t ? v : t;
    t = (unsigned)__builtin_amdgcn_update_dpp(0, (int)v, 0x141, 0xF, 0xF, true); v = v > t ? v : t;
    t = (unsigned)__builtin_amdgcn_update_dpp(0, (int)v, 0x140, 0xF, 0xF, true); v = v > t ? v : t;
    const unsigned a = (unsigned)__builtin_amdgcn_readlane((int)v, 0), b = (unsigned)__builtin_amdgcn_readlane((int)v, 16),
                   c = (unsigned)__builtin_amdgcn_readlane((int)v, 32), d = (unsigned)__builtin_amdgcn_readlane((int)v, 48);
    const unsigned ab = a > b ? a : b, cd = c > d ? c : d;
    return ab > cd ? ab : cd;
}
__device__ __forceinline__ void peer_topk_wave(int item, int lane, LAS float* wl, const bf16_t* __restrict__ qp, const bf16_t* __restrict__ skb, int* __restrict__ ids, float* __restrict__ gates) {
    const int hd = item & 7, tt = item >> 3, j = lane & 15, g = lane >> 4;
    const size_t t0 = (size_t)tt * 16;
    LAS float* sc = wl;
    LAS float* lst = wl + 2048;
#pragma unroll 1
    for (int p = 0; p < 2; ++p) {
        bf16x8_t qf[4];
        const bf16_t* qrow = qp + (t0 + j) * D + hd * 256 + p * 128 + 8 * g;
#pragma unroll
        for (int ks = 0; ks < 4; ++ks) qf[ks] = *(const bf16x8_t*)(qrow + 32 * ks);
        const bf16_t* kb = skb + ((size_t)(hd * 2 + p) * 128 + j) * 128 + 8 * g;
#pragma unroll
        for (int kt = 0; kt < 8; ++kt) {
            f32x4_t a = (f32x4_t){0.f, 0.f, 0.f, 0.f};
#pragma unroll
            for (int ks = 0; ks < 4; ++ks) a = __builtin_amdgcn_mfma_f32_16x16x32_bf16(*(const bf16x8_t*)(kb + (size_t)kt * (16 * 128) + 32 * ks), qf[ks], a, 0, 0, 0);
            *(LAS f32x4_t*)(sc + j * 128 + 16 * kt + 4 * g) = a;
        }
        asm volatile("s_waitcnt lgkmcnt(0)" ::: "memory");
#pragma unroll 1
        for (int tok = 0; tok < 16; ++tok) {
            const float s0 = sc[tok * 128 + lane], s1 = sc[tok * 128 + 64 + lane];
            unsigned k0 = (ord_key(s0) & ~127u) | (unsigned)(127 - lane), k1 = (ord_key(s1) & ~127u) | (unsigned)(63 - lane);
            unsigned sel = 0u;
#pragma unroll 4
            for (int it = 0; it < 16; ++it) {
                unsigned m = k0 > k1 ? k0 : k1;
                m = wave_max_u32(m);
                if (lane == it) sel = m;
                if (k0 == m) k0 = 0u;
                if (k1 == m) k1 = 0u;
            }
            if (lane < 16) {
                const int idx = 127 - (int)(sel & 127u);
                lst[((p * 16 + tok) * 16 + lane) * 2 + 0] = sc[tok * 128 + idx];
                lst[((p * 16 + tok) * 16 + lane) * 2 + 1] = __int_as_float(idx);
            }
        }
        asm volatile("s_waitcnt lgkmcnt(0)" ::: "memory");
    }
#pragma unroll 1
    for (int tok = 0; tok < 16; ++tok) {
        const int i = lane >> 2;
        const float sA = lst[((0 * 16 + tok) * 16 + i) * 2];
        unsigned kk[4];
#pragma unroll
        for (int r = 0; r < 4; ++r) {
            const int jb = (lane & 3) * 4 + r;
            const float sum = sA + lst[((1 * 16 + tok) * 16 + jb) * 2];
            kk[r] = (ord_key(sum) & ~255u) | (unsigned)(255 - (lane * 4 + r));
        }
        unsigned sel = 0u;
#pragma unroll 4
        for (int it = 0; it < 16; ++it) {
            unsigned m = kk[0] > kk[1] ? kk[0] : kk[1]; const unsigned m2 = kk[2] > kk[3] ? kk[2] : kk[3]; m = m > m2 ? m : m2;
            m = wave_max_u32(m);
            if (lane == it) sel = m;
#pragma unroll
            for (int r = 0; r < 4; ++r) if (kk[r] == m) kk[r] = 0u;
        }
        float bs = -INFINITY; int eid = 0;
        if (lane < 16) {
            const int c = 255 - (int)(sel & 255u), ia = c >> 4, ib = c & 15;
            bs = lst[((0 * 16 + tok) * 16 + ia) * 2] + lst[((1 * 16 + tok) * 16 + ib) * 2];
            eid = __float_as_int(lst[((0 * 16 + tok) * 16 + ia) * 2 + 1]) * 128 + __float_as_int(lst[((1 * 16 + tok) * 16 + ib) * 2 + 1]);
        }
        const float mx = wave_max(bs);
        const float ev = lane < 16 ? __expf(bs - mx) : 0.f;
        const float tot = wave_sum(ev);
        if (lane < 16) {
            ids[(t0 + tok) * 128 + hd * 16 + lane] = eid;
            gates[(t0 + tok) * 128 + hd * 16 + lane] = ev / tot;
        }
    }
}

typedef float f32x2_t __attribute__((ext_vector_type(2)));
__device__ __forceinline__ void table_row_to_fp8(const float* __restrict__ srow, unsigned char* __restrict__ drow, float* __restrict__ rscale, int lane, const float* __restrict__ dgain) {
    float4 f[8];
#pragma unroll
    for (int i = 0; i < 8; ++i) f[i] = *(const float4*)(srow + i * 256 + lane * 4);
    if (dgain) {
#pragma unroll
        for (int i = 0; i < 8; ++i) { const float4 gq = *(const float4*)(dgain + i * 256 + lane * 4); f[i].x *= gq.x; f[i].y *= gq.y; f[i].z *= gq.z; f[i].w *= gq.w; }
    }
    float am = 0.f;
#pragma unroll
    for (int i = 0; i < 8; ++i) am = fmaxf(am, fmaxf(fmaxf(fabsf(f[i].x), fabsf(f[i].y)), fmaxf(fabsf(f[i].z), fabsf(f[i].w))));
    am = wave_max(am);
    const float e = floorf(log2f(448.0f / fmaxf(am, 1e-30f)));
    const float s = exp2f(fminf(e, 100.0f));
    unsigned w[8];
#pragma unroll
    for (int i = 0; i < 8; ++i) {
        int t = 0;
        t = __builtin_amdgcn_cvt_pk_fp8_f32(f[i].x * s, f[i].y * s, t, false);
        t = __builtin_amdgcn_cvt_pk_fp8_f32(f[i].z * s, f[i].w * s, t, true);
        w[i] = (unsigned)t;
    }
#pragma unroll
    for (int i = 0; i < 8; ++i) *(unsigned*)(drow + i * 256 + lane * 4) = w[i];
    if (lane == 0) *rscale = 1.0f / s;
}
__device__ __forceinline__ void table_row_to_i8(const float* __restrict__ srow, unsigned char* __restrict__ drow, float* __restrict__ rscale, int lane, const float* __restrict__ dgain) {
    float4 f[8];
#pragma unroll
    for (int i = 0; i < 8; ++i) { f[i] = *(const float4*)(srow + i * 256 + lane * 4); const float4 gq = *(const float4*)(dgain + i * 256 + lane * 4); f[i].x *= gq.x; f[i].y *= gq.y; f[i].z *= gq.z; f[i].w *= gq.w; }
    float am = 0.f;
#pragma unroll
    for (int i = 0; i < 8; ++i) am = fmaxf(am, fmaxf(fmaxf(fabsf(f[i].x), fabsf(f[i].y)), fmaxf(fabsf(f[i].z), fabsf(f[i].w))));
    am = wave_max(am);
    const float s = exp2f(fminf(floorf(log2f(127.0f / fmaxf(am, 1e-30f))), 100.0f));
#pragma unroll
    for (int i = 0; i < 8; ++i) {
        const int q0 = __float2int_rn(f[i].x * s), q1 = __float2int_rn(f[i].y * s), q2 = __float2int_rn(f[i].z * s), q3 = __float2int_rn(f[i].w * s);
        *(unsigned*)(drow + i * 256 + lane * 4) = ((unsigned)q0 & 255u) | (((unsigned)q1 & 255u) << 8) | (((unsigned)q2 & 255u) << 16) | (((unsigned)q3 & 255u) << 24);
    }
    if (lane == 0) *rscale = 1.0f / s;
}
__device__ __forceinline__ float dot16_fp8(const uint4 q, const float* x) {
    float d = 0.f;
    const unsigned w[4] = {q.x, q.y, q.z, q.w};
#pragma unroll
    for (int k = 0; k < 4; ++k) {
        const f32x2_t lo = __builtin_amdgcn_cvt_pk_f32_fp8((int)w[k], false), hi = __builtin_amdgcn_cvt_pk_f32_fp8((int)w[k], true);
        d = fmaf(lo.x, x[4 * k], d); d = fmaf(lo.y, x[4 * k + 1], d); d = fmaf(hi.x, x[4 * k + 2], d); d = fmaf(hi.y, x[4 * k + 3], d);
    }
    return d;
}
__device__ __forceinline__ void axpy16_fp8(const uint4 q, float c, float* acc) {
    const unsigned w[4] = {q.x, q.y, q.z, q.w};
#pragma unroll
    for (int k = 0; k < 4; ++k) {
        const f32x2_t lo = __builtin_amdgcn_cvt_pk_f32_fp8((int)w[k], false), hi = __builtin_amdgcn_cvt_pk_f32_fp8((int)w[k], true);
        acc[4 * k] = fmaf(c, lo.x, acc[4 * k]); acc[4 * k + 1] = fmaf(c, lo.y, acc[4 * k + 1]); acc[4 * k + 2] = fmaf(c, hi.x, acc[4 * k + 2]); acc[4 * k + 3] = fmaf(c, hi.y, acc[4 * k + 3]);
    }
}
__device__ __forceinline__ void d_peer_out8(int vb, int tid, float* sm, const bf16_t* __restrict__ h3, const float* __restrict__ x2, const int* __restrict__ ids, const float* __restrict__ gates,
                                            const unsigned char* __restrict__ ut8, const unsigned char* __restrict__ vt8, const float* __restrict__ rsc, const float* __restrict__ rstd, const float* __restrict__ g_final, float* __restrict__ out) {
    float (*part)[2048] = (float (*)[2048])sm;
    float* red = sm + 4 * 2048;
    const int lane = tid & 63, w = tid >> 6, t = vb;
    float x[32], acc[32];
    {
        const bf16_t* hrow = h3 + (size_t)t * D + lane * 16;
#pragma unroll
        for (int hh = 0; hh < 2; ++hh) {
            const uint4 a = *(const uint4*)(hrow + hh * 1024), b = *(const uint4*)(hrow + hh * 1024 + 8);
            const unsigned ww[8] = {a.x, a.y, a.z, a.w, b.x, b.y, b.z, b.w};
#pragma unroll
            for (int k = 0; k < 8; ++k) { x[hh * 16 + 2 * k] = __uint_as_float(ww[k] << 16); x[hh * 16 + 2 * k + 1] = __uint_as_float(ww[k] & 0xFFFF0000u); }
        }
#pragma unroll
        for (int i = 0; i < 32; ++i) acc[i] = 0.f;
    }
    const float xrs = rstd[t];
    const int myid = ids[(size_t)t * 128 + w * 32 + (lane & 31)];
    const float mygate = gates[(size_t)t * 128 + w * 32 + (lane & 31)];
#pragma unroll 1
    for (int j = 0; j < 32; j += 4) {
        int e[4]; uint4 uq[4][2], vq[4][2];
#pragma unroll
        for (int q = 0; q < 4; ++q) {
            e[q] = __builtin_amdgcn_readfirstlane(__shfl(myid, j + q));
            const unsigned char* ur = ut8 + (size_t)e[q] * 2048 + lane * 16;
            uq[q][0] = *(const uint4*)ur; uq[q][1] = *(const uint4*)(ur + 1024);
        }
#pragma unroll
        for (int q = 0; q < 4; ++q) {
            const unsigned char* vr = vt8 + (size_t)e[q] * 2048 + lane * 16;
            vq[q][0] = *(const uint4*)vr; vq[q][1] = *(const uint4*)(vr + 1024);
        }
        float d[4];
#pragma unroll
        for (int q = 0; q < 4; ++q) d[q] = dot16_fp8(uq[q][0], x) + dot16_fp8(uq[q][1], x + 16);
#pragma unroll
        for (int o = 32; o >= 1; o >>= 1) {
#pragma unroll
            for (int q = 0; q < 4; ++q) d[q] += __shfl_xor(d[q], o);
        }
#pragma unroll
        for (int q = 0; q < 4; ++q) {
            const float a = d[q] * rsc[e[q]] * xrs;
            const float act = 0.5f * a * (1.0f + erff(a * 0.7071067811865476f));
            const float cf = __shfl(mygate, j + q) * act * rsc[16384 + e[q]];
            axpy16_fp8(vq[q][0], cf, acc); axpy16_fp8(vq[q][1], cf, acc + 16);
        }
    }
    __syncthreads();
#pragma unroll
    for (int hh = 0; hh < 2; ++hh)
#pragma unroll
        for (int k = 0; k < 4; ++k) *(float4*)&part[w][hh * 1024 + lane * 16 + 4 * k] = make_float4(acc[hh * 16 + 4 * k], acc[hh * 16 + 4 * k + 1], acc[hh * 16 + 4 * k + 2], acc[hh * 16 + 4 * k + 3]);
    __syncthreads();
    float4 r0, r1;
    {
        const float4 a = *(const float4*)&part[0][tid * 4], b = *(const float4*)&part[1][tid * 4], c = *(const float4*)&part[2][tid * 4], dd = *(const float4*)&part[3][tid * 4];
        const float4 xx = *(const float4*)(x2 + (size_t)t * D + tid * 4);
        r0 = make_float4(xx.x + a.x + b.x + c.x + dd.x, xx.y + a.y + b.y + c.y + dd.y, xx.z + a.z + b.z + c.z + dd.z, xx.w + a.w + b.w + c.w + dd.w);
    }
    {
        const float4 a = *(const float4*)&part[0][1024 + tid * 4], b = *(const float4*)&part[1][1024 + tid * 4], c = *(const float4*)&part[2][1024 + tid * 4], dd = *(const float4*)&part[3][1024 + tid * 4];
        const float4 xx = *(const float4*)(x2 + (size_t)t * D + 1024 + tid * 4);
        r1 = make_float4(xx.x + a.x + b.x + c.x + dd.x, xx.y + a.y + b.y + c.y + dd.y, xx.z + a.z + b.z + c.z + dd.z, xx.w + a.w + b.w + c.w + dd.w);
    }
    float s = r0.x * r0.x + r0.y * r0.y + r0.z * r0.z + r0.w * r0.w + r1.x * r1.x + r1.y * r1.y + r1.z * r1.z + r1.w * r1.w;
    s = wave_sum(s);
    if (lane == 0) red[w] = s;
    __syncthreads();
    const float tot = red[0] + red[1] + red[2] + red[3];
    const float r = rsqrtf(tot * (1.0f / D) + EPS);
    const float4 g0 = *(const float4*)(g_final + tid * 4), g1 = *(const float4*)(g_final + 1024 + tid * 4);
    *(float4*)(out + (size_t)t * D + tid * 4) = make_float4(r0.x * r * g0.x, r0.y * r * g0.y, r0.z * r * g0.z, r0.w * r * g0.w);
    *(float4*)(out + (size_t)t * D + 1024 + tid * 4) = make_float4(r1.x * r * g1.x, r1.y * r * g1.y, r1.z * r * g1.z, r1.w * r * g1.w);
}

__device__ __forceinline__ unsigned xg_sum_u32(unsigned v) {
    auto a = __builtin_amdgcn_permlane16_swap(v, v, false, false); v = a[0] + a[1];
    auto b = __builtin_amdgcn_permlane32_swap(v, v, false, false); return b[0] + b[1];
}
__device__ __forceinline__ float xg_sum_f32(float v) {
    auto a = __builtin_amdgcn_permlane16_swap(__float_as_uint(v), __float_as_uint(v), false, false); v = __uint_as_float(a[0]) + __uint_as_float(a[1]);
    auto b = __builtin_amdgcn_permlane32_swap(__float_as_uint(v), __float_as_uint(v), false, false); return __uint_as_float(b[0]) + __uint_as_float(b[1]);
}
__device__ __forceinline__ float xg_max_f32(float v) {
    auto a = __builtin_amdgcn_permlane16_swap(__float_as_uint(v), __float_as_uint(v), false, false); v = fmaxf(__uint_as_float(a[0]), __uint_as_float(a[1]));
    auto b = __builtin_amdgcn_permlane32_swap(__float_as_uint(v), __float_as_uint(v), false, false); return fmaxf(__uint_as_float(b[0]), __uint_as_float(b[1]));
}
template <int N> __device__ __forceinline__ unsigned bisect16(const unsigned (&kk)[N]) {
    unsigned tau = 0u; bool done = false;
#pragma unroll 1
    for (int bit = 31; bit >= 0; --bit) {
        const unsigned cand = tau | (1u << bit);
        unsigned c = 0u;
#pragma unroll
        for (int i = 0; i < N; ++i) c += (kk[i] >= cand) ? 1u : 0u;
        c = xg_sum_u32(c);
        if (!done && c >= 16u) { tau = cand; done = (c == 16u); }
        if (__all(done ? 1 : 0)) break;
    }
    return tau;
}
__device__ __forceinline__ void peer_topk_wave2(int item, int lane, LAS float* wl, const bf16_t* __restrict__ qp, const bf16_t* __restrict__ skb, int* __restrict__ ids, float* __restrict__ gates) {
    const int hd = item & 7, tt = item >> 3, j = lane & 15, g = lane >> 4;
    const size_t t0 = (size_t)tt * 16;
#pragma unroll 1
    for (int p = 0; p < 2; ++p) {
        bf16x8_t qf[4];
        const bf16_t* qrow = qp + (t0 + j) * D + hd * 256 + p * 128 + 8 * g;
#pragma unroll
        for (int ks = 0; ks < 4; ++ks) qf[ks] = *(const bf16x8_t*)(qrow + 32 * ks);
        const bf16_t* kb = skb + ((size_t)(hd * 2 + p) * 128 + j) * 128 + 8 * g;
        float sc[32]; unsigned kk[32];
#pragma unroll
        for (int kt = 0; kt < 8; ++kt) {
            f32x4_t a = (f32x4_t){0.f, 0.f, 0.f, 0.f};
#pragma unroll
            for (int ks = 0; ks < 4; ++ks) a = __builtin_amdgcn_mfma_f32_16x16x32_bf16(*(const bf16x8_t*)(kb + (size_t)kt * (16 * 128) + 32 * ks), qf[ks], a, 0, 0, 0);
#pragma unroll
            for (int r = 0; r < 4; ++r) { sc[kt * 4 + r] = a[r]; kk[kt * 4 + r] = (ord_key(a[r]) & ~127u) | (unsigned)(127 - (16 * kt + 4 * g + r)); }
        }
        const unsigned tau = bisect16<32>(kk);
        unsigned cnt = 0u;
#pragma unroll
        for (int i = 0; i < 32; ++i) cnt += (kk[i] >= tau) ? 1u : 0u;
        const unsigned c0 = (unsigned)__shfl((int)cnt, j), c1 = (unsigned)__shfl((int)cnt, j + 16), c2 = (unsigned)__shfl((int)cnt, j + 32);
        unsigned off = (g > 0 ? c0 : 0u) + (g > 1 ? c1 : 0u) + (g > 2 ? c2 : 0u);
        LAS float* ls = wl + p * 256 + j * 16;
        LAS float* li = wl + 512 + p * 256 + j * 16;
#pragma unroll
        for (int i = 0; i < 32; ++i) {
            if (kk[i] >= tau && off < 16u) { ls[off] = sc[i]; li[off] = __int_as_float(16 * (i >> 2) + 4 * g + (i & 3)); ++off; }
        }
    }
    asm volatile("s_waitcnt lgkmcnt(0)" ::: "memory");
    {
        float sA[4], sB[16]; int iA[4];
        {
            const f32x4_t a = *(const LAS f32x4_t*)(wl + j * 16 + 4 * g);
            const f32x4_t ai = *(const LAS f32x4_t*)(wl + 512 + j * 16 + 4 * g);
#pragma unroll
            for (int r = 0; r < 4; ++r) { sA[r] = a[r]; iA[r] = __float_as_int(ai[r]); }
#pragma unroll
            for (int q = 0; q < 4; ++q) { const f32x4_t b = *(const LAS f32x4_t*)(wl + 256 + j * 16 + 4 * q); sB[4 * q] = b[0]; sB[4 * q + 1] = b[1]; sB[4 * q + 2] = b[2]; sB[4 * q + 3] = b[3]; }
        }
        unsigned kk[64];
#pragma unroll
        for (int a = 0; a < 4; ++a)
#pragma unroll
            for (int b = 0; b < 16; ++b) kk[a * 16 + b] = (ord_key(sA[a] + sB[b]) & ~255u) | (unsigned)(255 - ((4 * g + a) * 16 + b));
        const unsigned tau = bisect16<64>(kk);
        float mx = -INFINITY; unsigned cnt = 0u;
#pragma unroll
        for (int i = 0; i < 64; ++i) if (kk[i] >= tau) { mx = fmaxf(mx, sA[i >> 4] + sB[i & 15]); ++cnt; }
        mx = xg_max_f32(mx);
        float es = 0.f;
#pragma unroll
        for (int i = 0; i < 64; ++i) if (kk[i] >= tau) es += __expf(sA[i >> 4] + sB[i & 15] - mx);
        const float inv = 1.0f / xg_sum_f32(es);
        const unsigned c0 = (unsigned)__shfl((int)cnt, j), c1 = (unsigned)__shfl((int)cnt, j + 16), c2 = (unsigned)__shfl((int)cnt, j + 32);
        unsigned off = (g > 0 ? c0 : 0u) + (g > 1 ? c1 : 0u) + (g > 2 ? c2 : 0u);
        int* idp = ids + (t0 + j) * 128 + hd * 16;
        float* gtp = gates + (t0 + j) * 128 + hd * 16;
        const LAS float* liB = wl + 512 + 256 + j * 16;
#pragma unroll
        for (int i = 0; i < 64; ++i) {
            if (kk[i] >= tau && off < 16u) {
                idp[off] = iA[i >> 4] * 128 + __float_as_int(liB[i & 15]);
                gtp[off] = __expf(sA[i >> 4] + sB[i & 15] - mx) * inv;
                ++off;
            }
        }
    }
}

__device__ __forceinline__ float wave_sum_dpp(float v) {
    v += __uint_as_float((unsigned)__builtin_amdgcn_update_dpp(0, (int)__float_as_uint(v), 0xB1, 0xF, 0xF, true));
    v += __uint_as_float((unsigned)__builtin_amdgcn_update_dpp(0, (int)__float_as_uint(v), 0x4E, 0xF, 0xF, true));
    v += __uint_as_float((unsigned)__builtin_amdgcn_update_dpp(0, (int)__float_as_uint(v), 0x141, 0xF, 0xF, true));
    v += __uint_as_float((unsigned)__builtin_amdgcn_update_dpp(0, (int)__float_as_uint(v), 0x140, 0xF, 0xF, true));
    const float a = __uint_as_float((unsigned)__builtin_amdgcn_readlane((int)__float_as_uint(v), 0)), b = __uint_as_float((unsigned)__builtin_amdgcn_readlane((int)__float_as_uint(v), 16)),
                c = __uint_as_float((unsigned)__builtin_amdgcn_readlane((int)__float_as_uint(v), 32)), d = __uint_as_float((unsigned)__builtin_amdgcn_readlane((int)__float_as_uint(v), 48));
    return (a + b) + (c + d);
}
typedef __bf16 bf16x2v_t __attribute__((ext_vector_type(2)));
__device__ __forceinline__ int wave_sum_all_i32(int v) {
    v += __builtin_amdgcn_update_dpp(0, v, 0xB1, 0xF, 0xF, true);
    v += __builtin_amdgcn_update_dpp(0, v, 0x4E, 0xF, 0xF, true);
    v += __builtin_amdgcn_update_dpp(0, v, 0x141, 0xF, 0xF, true);
    v += __builtin_amdgcn_update_dpp(0, v, 0x140, 0xF, 0xF, true);
    auto a = __builtin_amdgcn_permlane16_swap((unsigned)v, (unsigned)v, false, false); v = (int)(a[0] + a[1]);
    auto b = __builtin_amdgcn_permlane32_swap((unsigned)v, (unsigned)v, false, false); return (int)(b[0] + b[1]);
}
__device__ __forceinline__ float wave_sum_all(float v) {
    v += __uint_as_float((unsigned)__builtin_amdgcn_update_dpp(0, (int)__float_as_uint(v), 0xB1, 0xF, 0xF, true));
    v += __uint_as_float((unsigned)__builtin_amdgcn_update_dpp(0, (int)__float_as_uint(v), 0x4E, 0xF, 0xF, true));
    v += __uint_as_float((unsigned)__builtin_amdgcn_update_dpp(0, (int)__float_as_uint(v), 0x141, 0xF, 0xF, true));
    v += __uint_as_float((unsigned)__builtin_amdgcn_update_dpp(0, (int)__float_as_uint(v), 0x140, 0xF, 0xF, true));
    auto a = __builtin_amdgcn_permlane16_swap(__float_as_uint(v), __float_as_uint(v), false, false); v = __uint_as_float(a[0]) + __uint_as_float(a[1]);
    auto b = __builtin_amdgcn_permlane32_swap(__float_as_uint(v), __float_as_uint(v), false, false); return __uint_as_float(b[0]) + __uint_as_float(b[1]);
}
__device__ __forceinline__ float dot16_fp8_bf16(const uint4 q, const uint4 xa, const uint4 xb, float d) {
    const unsigned w[4] = {q.x, q.y, q.z, q.w};
    const unsigned xw[8] = {xa.x, xa.y, xa.z, xa.w, xb.x, xb.y, xb.z, xb.w};
#pragma unroll
    for (int k = 0; k < 4; ++k) {
        const bf16x2v_t lo = __builtin_amdgcn_cvt_scalef32_pk_bf16_fp8(w[k], 1.0f, false), hi = __builtin_amdgcn_cvt_scalef32_pk_bf16_fp8(w[k], 1.0f, true);
        d = __builtin_amdgcn_fdot2_f32_bf16(lo, __builtin_bit_cast(bf16x2v_t, xw[2 * k]), d, false);
        d = __builtin_amdgcn_fdot2_f32_bf16(hi, __builtin_bit_cast(bf16x2v_t, xw[2 * k + 1]), d, false);
    }
    return d;
}
__device__ __forceinline__ void axpy16_fp8_pk(const uint4 q, const f32x2_t c2, f32x2_t* acc) {
    const unsigned w[4] = {q.x, q.y, q.z, q.w};
#pragma unroll
    for (int k = 0; k < 4; ++k) {
        const f32x2_t lo = __builtin_amdgcn_cvt_pk_f32_fp8((int)w[k], false), hi = __builtin_amdgcn_cvt_pk_f32_fp8((int)w[k], true);
        acc[2 * k] = __builtin_elementwise_fma(c2, lo, acc[2 * k]); acc[2 * k + 1] = __builtin_elementwise_fma(c2, hi, acc[2 * k + 1]);
    }
}
__device__ __forceinline__ float gelu_as(float v) {
    const float av = fabsf(v), t = __builtin_amdgcn_rcpf(av * 0.2316418882f + 1.0f);
    float q = t * 0.5307027145f + (-0.7265760135f); q = q * t + 0.7107068705f; q = q * t + (-0.142248368f); q = q * t + 0.127414796f; q = q * t;
    const float e = __builtin_amdgcn_exp2f((v * v) * (-0.72134752044f));
    const float m = v * (q * e);
    return v < 0.f ? m : v - m;
}
__device__ __forceinline__ void peer_sweep_wave(int gw, int lane, LAS unsigned char* wl, const bf16_t* __restrict__ h3, const float* __restrict__ x2, const int* __restrict__ ids,
                                                const float* __restrict__ gates, const unsigned char* __restrict__ ut8, const unsigned char* __restrict__ vt8, const float* __restrict__ rsc,
                                                const float* __restrict__ rstd, const float* __restrict__ g_final, float* __restrict__ out) {
    typedef unsigned u32x4_t __attribute__((ext_vector_type(4)));
    typedef int i32x4_t __attribute__((ext_vector_type(4)));
    LAS unsigned char* x8 = wl;
    LAS unsigned* sorted = (LAS unsigned*)(wl + 8192);
    LAS unsigned* cnt = (LAS unsigned*)(wl + 8192 + 2048);
    LAS unsigned* base = (LAS unsigned*)(wl + 8192 + 2048 + 256);
    LAS unsigned short* gsv = (LAS unsigned short*)(wl + 8192 + 2048 + 512);
    const size_t t0 = (size_t)gw * 4;
    float fac = 0.f;
#pragma unroll
    for (int tok = 0; tok < 4; ++tok) {
        uint4 xv[4]; float am = 0.f;
#pragma unroll
        for (int c = 0; c < 4; ++c) {
            xv[c] = *(const uint4*)(h3 + (t0 + tok) * D + c * 512 + lane * 8);
            const unsigned w[4] = {xv[c].x, xv[c].y, xv[c].z, xv[c].w};
#pragma unroll
            for (int k = 0; k < 4; ++k) am = fmaxf(am, fmaxf(fabsf(__uint_as_float(w[k] << 16)), fabsf(__uint_as_float(w[k] & 0xFFFF0000u))));
        }
        am = wave_max(am);
        const float s = exp2f(fminf(floorf(log2f(127.0f / fmaxf(am, 1e-30f))), 100.0f));
        if ((lane & 3) == tok) fac = rstd[t0 + tok] / s;
#pragma unroll
        for (int c = 0; c < 4; ++c) {
            const unsigned w[4] = {xv[c].x, xv[c].y, xv[c].z, xv[c].w};
            unsigned o[2];
#pragma unroll
            for (int h = 0; h < 2; ++h) {
                const int q0 = __float2int_rn(__uint_as_float(w[2 * h] << 16) * s), q1 = __float2int_rn(__uint_as_float(w[2 * h] & 0xFFFF0000u) * s);
                const int q2 = __float2int_rn(__uint_as_float(w[2 * h + 1] << 16) * s), q3 = __float2int_rn(__uint_as_float(w[2 * h + 1] & 0xFFFF0000u) * s);
                o[h] = ((unsigned)q0 & 255u) | (((unsigned)q1 & 255u) << 8) | (((unsigned)q2 & 255u) << 16) | (((unsigned)q3 & 255u) << 24);
            }
            typedef unsigned u32x2_t __attribute__((ext_vector_type(2)));
            *(LAS u32x2_t*)(x8 + tok * 2048 + c * 512 + lane * 8) = (u32x2_t){o[0], o[1]};
        }
    }
    cnt[lane] = 0u;
    asm volatile("s_waitcnt lgkmcnt(0)" ::: "memory");
    unsigned key[8], rk[8]; unsigned short fv[8];
#pragma unroll
    for (int r = 0; r < 8; ++r) {
        const int n = r * 64 + lane;
        const unsigned e = (unsigned)ids[t0 * 128 + n];
        key[r] = (e << 9) | (unsigned)n | (__float_as_uint(rsc[e]) & 0x7F800000u);
        fv[r] = (unsigned short)f2bf(gates[t0 * 128 + n] * rsc[16384 + e]);
        rk[r] = __hip_atomic_fetch_add(&cnt[e >> 8], 1u, __ATOMIC_RELAXED, __HIP_MEMORY_SCOPE_WORKGROUP);
    }
    asm volatile("s_waitcnt lgkmcnt(0)" ::: "memory");
    {
        const unsigned c = cnt[lane];
        unsigned incl = c;
#pragma unroll
        for (int o = 1; o < 64; o <<= 1) { const unsigned t = (unsigned)__shfl_up((int)incl, o); if (lane >= o) incl += t; }
        base[lane] = incl - c;
    }
    asm volatile("s_waitcnt lgkmcnt(0)" ::: "memory");
#pragma unroll
    for (int r = 0; r < 8; ++r) { const unsigned pos = base[(key[r] >> 17) & 63u] + rk[r]; sorted[pos] = key[r]; gsv[pos] = fv[r]; }
    asm volatile("s_waitcnt lgkmcnt(0)" ::: "memory");
    float rs4[4];
#pragma unroll
    for (int tok = 0; tok < 4; ++tok) rs4[tok] = __uint_as_float((unsigned)__builtin_amdgcn_readlane((int)__float_as_uint(fac), tok));
#define P1_LOAD(ENT, UQ, I0) _Pragma("unroll") for (int q = 0; q < 8; ++q) { \
            ENT[q] = (unsigned)__builtin_amdgcn_readfirstlane((int)sorted[(I0) + q]); \
            const unsigned char* ur = ut8 + (size_t)((ENT[q] >> 9) & 16383u) * 2048 + lane * 16; \
            UQ[q][0] = *(const uint4*)ur; UQ[q][1] = *(const uint4*)(ur + 1024); }
#define P1_COMP(ENT, UQ, I0) _Pragma("unroll") for (int h4 = 0; h4 < 8; h4 += 4) { int d[4]; \
            _Pragma("unroll") for (int q = 0; q < 4; ++q) { \
                const int tok = (ENT[h4 + q] >> 7) & 3; \
                const LAS unsigned char* xr = x8 + tok * 2048 + lane * 16; \
                const u32x4_t a0 = *(const LAS u32x4_t*)xr, b0 = *(const LAS u32x4_t*)(xr + 1024); \
                int dd = 0; \
                dd = __builtin_amdgcn_sdot4((int)UQ[h4 + q][0].x, (int)a0[0], dd, false); dd = __builtin_amdgcn_sdot4((int)UQ[h4 + q][0].y, (int)a0[1], dd, false); \
                dd = __builtin_amdgcn_sdot4((int)UQ[h4 + q][0].z, (int)a0[2], dd, false); dd = __builtin_amdgcn_sdot4((int)UQ[h4 + q][0].w, (int)a0[3], dd, false); \
                dd = __builtin_amdgcn_sdot4((int)UQ[h4 + q][1].x, (int)b0[0], dd, false); dd = __builtin_amdgcn_sdot4((int)UQ[h4 + q][1].y, (int)b0[1], dd, false); \
                dd = __builtin_amdgcn_sdot4((int)UQ[h4 + q][1].z, (int)b0[2], dd, false); dd = __builtin_amdgcn_sdot4((int)UQ[h4 + q][1].w, (int)b0[3], dd, false); \
                d[q] = dd; } \
            _Pragma("unroll") for (int q = 0; q < 4; ++q) { \
                const int s = wave_sum_all_i32(d[q]); \
                const unsigned e = (ENT[h4 + q] >> 9) & 16383u; const int n = ENT[h4 + q] & 511, tok = n >> 7; \
                const float rsv = tok == 0 ? rs4[0] : tok == 1 ? rs4[1] : tok == 2 ? rs4[2] : rs4[3]; \
                const float a = (float)s * (__uint_as_float(ENT[h4 + q] & 0x7F800000u) * rsv); \
                const float cf = __uint_as_float((unsigned)gsv[(I0) + h4 + q] << 16) * gelu_as(a); \
                if (lane == 0) sorted[(I0) + h4 + q] = (e << 18) | ((unsigned)tok << 16) | f2bf(cf); } }
    {
        unsigned entA[8], entB[8]; uint4 uqA[8][2], uqB[8][2];
        P1_LOAD(entA, uqA, 0)
#pragma unroll 1
        for (int i = 0; i < 512; i += 16) {
            P1_LOAD(entB, uqB, i + 8)
            P1_COMP(entA, uqA, i)
            { const int nx = i + 16 < 512 ? i + 16 : 504; P1_LOAD(entA, uqA, nx) }
            P1_COMP(entB, uqB, i + 8)
        }
    }
#undef P1_LOAD
#undef P1_COMP
    asm volatile("s_waitcnt lgkmcnt(0)" ::: "memory");
    f32x2_t acc0[16], acc1[16], acc2[16], acc3[16];
#pragma unroll
    for (int k = 0; k < 16; ++k) { acc0[k] = (f32x2_t){0.f, 0.f}; acc1[k] = (f32x2_t){0.f, 0.f}; acc2[k] = (f32x2_t){0.f, 0.f}; acc3[k] = (f32x2_t){0.f, 0.f}; }
#ifndef P2N
#define P2N 2
#endif
#define P2_LOAD(ENT, VQ, I0) _Pragma("unroll") for (int q = 0; q < P2N; ++q) { \
            ENT[q] = (unsigned)__builtin_amdgcn_readfirstlane((int)sorted[(I0) + q]); \
            const unsigned char* vr = vt8 + (size_t)(ENT[q] >> 18) * 2048 + lane * 16; \
            VQ[q][0] = *(const uint4*)vr; VQ[q][1] = *(const uint4*)(vr + 1024); }
#define P2_COMP(ENT, VQ) _Pragma("unroll") for (int q = 0; q < P2N; ++q) { \
            const int tok = (ENT[q] >> 16) & 3; \
            const float cfs = __uint_as_float(ENT[q] << 16); \
            const f32x2_t c2 = (f32x2_t){cfs, cfs}; \
            if (tok == 0) { axpy16_fp8_pk(VQ[q][0], c2, acc0); axpy16_fp8_pk(VQ[q][1], c2, acc0 + 8); } \
            else if (tok == 1) { axpy16_fp8_pk(VQ[q][0], c2, acc1); axpy16_fp8_pk(VQ[q][1], c2, acc1 + 8); } \
            else if (tok == 2) { axpy16_fp8_pk(VQ[q][0], c2, acc2); axpy16_fp8_pk(VQ[q][1], c2, acc2 + 8); } \
            else { axpy16_fp8_pk(VQ[q][0], c2, acc3); axpy16_fp8_pk(VQ[q][1], c2, acc3 + 8); } }
    {
        unsigned entA[P2N], entB[P2N]; uint4 vqA[P2N][2], vqB[P2N][2];
        P2_LOAD(entA, vqA, 0)
#pragma unroll 1
        for (int i = 0; i < 512; i += 2 * P2N) {
            P2_LOAD(entB, vqB, i + P2N)
            P2_COMP(entA, vqA)
            { const int nx = i + 2 * P2N < 512 ? i + 2 * P2N : 512 - P2N; P2_LOAD(entA, vqA, nx) }
            P2_COMP(entB, vqB)
        }
    }
#undef P2_LOAD
#undef P2_COMP
    int l2 = lane; asm volatile("" : "+v"(l2));
#define PEER_EPI(tok, ACC) { \
        const bf16_t* xr = h3 + (t0 + tok) * D + l2 * 16; \
        float ss = 0.f; \
        _Pragma("unroll") for (int hh = 0; hh < 2; ++hh) _Pragma("unroll") for (int k = 0; k < 4; ++k) { \
            const uint2 xp = *(const uint2*)(xr + hh * 1024 + 4 * k); \
            const float4 xv = make_float4(__uint_as_float(xp.x << 16), __uint_as_float(xp.x & 0xFFFF0000u), __uint_as_float(xp.y << 16), __uint_as_float(xp.y & 0xFFFF0000u)); \
            f32x2_t a0 = ACC[hh * 8 + 2 * k], a1 = ACC[hh * 8 + 2 * k + 1]; \
            a0.x += xv.x; a0.y += xv.y; a1.x += xv.z; a1.y += xv.w; ACC[hh * 8 + 2 * k] = a0; ACC[hh * 8 + 2 * k + 1] = a1; \
            ss += (a0.x * a0.x + a0.y * a0.y) + (a1.x * a1.x + a1.y * a1.y); } \
        ss = wave_sum_dpp(ss); \
        const float r = rsqrtf(ss * (1.0f / D) + EPS); \
        float* orow = out + (t0 + tok) * D + l2 * 16; \
        _Pragma("unroll") for (int hh = 0; hh < 2; ++hh) _Pragma("unroll") for (int k = 0; k < 4; ++k) { \
            const float4 gv = *(const float4*)(g_final + hh * 1024 + l2 * 16 + 4 * k); \
            const f32x2_t a0 = ACC[hh * 8 + 2 * k], a1 = ACC[hh * 8 + 2 * k + 1]; \
            *(float4*)(orow + hh * 1024 + 4 * k) = make_float4(a0.x * r * gv.x, a0.y * r * gv.y, a1.x * r * gv.z, a1.y * r * gv.w); } }
    PEER_EPI(0, acc0) PEER_EPI(1, acc1) PEER_EPI(2, acc2) PEER_EPI(3, acc3)
#undef PEER_EPI
}

struct Params {
    const float *x, *mem, *g_mix, *w_in, *conv_w, *conv_b, *w_mq, *w_mk, *b_mi, *b_mf, *g_mhead, *g_ahead, *w_out, *g_cross, *g_mem,
                *w_xq, *w_xk, *w_xv, *w_xo, *g_ffn, *w_pq, *sub_keys, *u_tab, *v_tab, *g_final;
    float* out;
    unsigned* bar;
    float* ws;
};

#define PHASE_LOOP(nvb) for (int base_ = blockIdx.x * 2; base_ < (nvb); base_ += gridDim.x * 2)
#define VB (base_ + half)

__global__ void __launch_bounds__(NTHR) mega(Params P) {
    volatile LAS unsigned* st = (volatile LAS unsigned*)(LAS unsigned char*)(smem_raw + CTRL_OFF);
    if (threadIdx.x == 0) { st[0] = 0u; st[1] = 0u; st[2] = 0u; st[3] = 0u; }
    if (threadIdx.x < I_NPTR) ((LAS unsigned long long*)(LAS unsigned char*)(smem_raw + CTRL_OFF + 64))[threadIdx.x] = ((const unsigned long long*)&P)[threadIdx.x];
    __syncthreads();
    XcdBarrier xb = xcd_barrier_post((unsigned*)ldp_raw(I_BAR), st);

    constexpr size_t TD = (size_t)T * D;
    constexpr size_t O_HB = 6 * P6S * 2, O_CBUF = O_HB + (size_t)T * D * 2, O_MQ = O_CBUF + (size_t)T * 1024 * 2, O_MK = O_MQ + (size_t)T * 1024 * 2,
                     O_MIXB = O_MK + (size_t)T * 1024 * 2, O_WIN = O_MIXB + (size_t)T * D * 2, O_WOUT = O_WIN + (size_t)6144 * D * 2, O_WXQ = O_WOUT + (size_t)D * D * 2,
                     O_WXK = O_WXQ + (size_t)D * D * 2, O_WXV = O_WXK + (size_t)D * D * 2, O_WXO = O_WXV + (size_t)D * D * 2, O_WPQ = O_WXO + (size_t)D * D * 2,
                     O_WQK = O_WPQ + (size_t)D * D * 2, O_GPRE = O_WQK + (size_t)8 * 256 * 256 * 2, O_UT = O_GPRE + (size_t)T * 8 * 4, O_VT = O_UT + (size_t)16384 * D, O_RSC = O_VT + (size_t)16384 * D,
                     O_BH = O_RSC + (size_t)32768 * 4, O_GS = O_BH + (size_t)128 * 256 * 512 * 2, O_DENP = O_GS + (size_t)T * 4 * 8 * 4, O_QN = O_DENP + (size_t)T * 4 * 4 * 4,
                     O_DN = O_QN + (size_t)T * 4 * 4, O_DECAY = O_DN + (size_t)128 * 256 * 4, O_KB = O_DECAY + 4096, O_VB = O_KB + (size_t)12288 * 2048 * 2, O_CS = O_VB + (size_t)12288 * 2048 * 2, O_SKB = O_CS + (size_t)4096 * 64 * 8, O_RSSP = O_SKB + (size_t)262144 * 2, O_RSTD = O_RSSP + (size_t)T * 32 * 4, O_MN = O_RSTD + (size_t)T * 4, O_KVP = O_MN + (size_t)512 * D * 2, O_END = O_KVP + (size_t)2 * 512 * 4096 * 4;
    static_assert(O_END + 16384 <= (size_t)536870912, "workspace overflow");
#define W_P6    ((bf16_t*)wsb)
#define W_HB    ((bf16_t*)(wsb + O_HB))
#define W_CBUF  ((bf16_t*)(wsb + O_CBUF))
#define W_MQ    ((bf16_t*)(wsb + O_MQ))
#define W_MK    ((bf16_t*)(wsb + O_MK))
#define W_MIXB  ((bf16_t*)(wsb + O_MIXB))
#define W_GPRE  ((float*)(wsb + O_GPRE))
#define W_HRAW  ((float*)(wsb + O_HB))
#define W_XR    ((float*)wsb)
#define W_MN    ((bf16_t*)((float*)wsb + TD))
#define W_KM    ((bf16_t*)((float*)wsb + TD + (size_t)256 * D))
#define W_VMT   ((bf16_t*)((float*)wsb + TD + (size_t)768 * D))
#define W_PX    ((bf16_t*)(wsb + O_MK))
#define W_GATES ((float*)wsb + TD + (size_t)1280 * D)
#define W_IDS   ((int*)((float*)wsb + TD + (size_t)1280 * D + (size_t)T * 128))
#define W_QX    ((bf16_t*)(wsb + O_CBUF))
#define W_BH    ((bf16_t*)(wsb + O_BH))
#define W_KB    ((bf16_t*)(wsb + O_KB))
#define W_VB    ((bf16_t*)(wsb + O_VB))
#define W_CS    ((float2*)(wsb + O_CS))
#define W_SKB   ((bf16_t*)(wsb + O_SKB))
#define W_RSSP  ((float*)(wsb + O_RSSP))
#define W_RSTD  ((float*)(wsb + O_RSTD))
#define W_MN2   ((bf16_t*)(wsb + O_MN))
#define W_KVP   ((float*)(wsb + O_KVP))
#define W_GS    ((float*)(wsb + O_GS))
#define W_DENP  ((float*)(wsb + O_DENP))
#define W_QN    ((float*)(wsb + O_QN))
#define W_DN    ((float*)(wsb + O_DN))
#define W_DECAY ((float*)(wsb + O_DECAY))
#define W_PQ    ((bf16_t*)(wsb + O_HB))
#define W_KWT   ((bf16_t*)(wsb + O_CBUF))
#define W_DC    ((float*)(wsb + 3 * P6S * 2))
#define W_UT    ((unsigned char*)(wsb + O_UT))
#define W_VT    ((unsigned char*)(wsb + O_VT))
#define W_RSC   ((float*)(wsb + O_RSC))
#define PH_BEGIN() int tidx = threadIdx.x; asm volatile("" : "+v"(tidx)); const int half = tidx >> 8, tid = tidx & 255; float* sm = (float*)smem_raw + half * HALF_SM_FLOATS; \
                   char* wsb = (char*)ldp_raw(I_WS); (void)half; (void)tid; (void)sm; (void)wsb
#define GJOB_DEFAULT(g) pg8::GJob g; g.lda = D; g.ldb = D; g.K = D; g.nM = 32; g.nN = 8; g.a_pm_step = 256 * D; g.b_pn_mask = 0x7fffffff; g.b_pn_shift = 30; g.b_pn_step2 = 0; g.bid0 = 0; g.nblk = gridDim.x; g.a_pn_shift = 0; g.a_pn_mask = 0; g.a_pn_step = 0; g.b_pm_shift = 0; g.b_pm_step = 0; g.b_pn_step = 256 * D; \
                        g.ldc = D; g.R = nullptr; g.ldr = D; g.mode = 0; g.escale = 1.0f; g.gs = nullptr; g.denp = nullptr; g.qn = nullptr; g.gvec = nullptr; g.mo = nullptr; g.C2 = nullptr; g.rssp = nullptr; g.rstd = nullptr
#define GEMM_LDSP ((LAS unsigned char*)smem_raw)

    {
        PH_BEGIN();
        {
            LAS float* scr = (LAS float*)(LAS unsigned char*)(smem_raw) + (tidx >> 6) * (64 * 33);
            const int lane = tidx & 63;
            const int gw = blockIdx.x * 8 + (tidx >> 6), NGW = gridDim.x * 8;
            constexpr int I_IN = 32 * 192, I_SQ = 32 * 64, I_QK = 8 * 4 * 8;
            constexpr int NITEMS = I_IN + 6 * I_SQ + I_QK;
#pragma nounroll
            for (int it = gw; it < NITEMS; it += NGW) {
                const float* W; int ldw, K, csrc0, row0, kb; bf16_t* WT; float wscale = 1.0f; const float* kgain = nullptr;
                int r = it;
                if (r < I_IN) { const int nb = r % 192; kb = r / 192; W = PF(I_WIN); ldw = INC; K = D; csrc0 = nb * 32 + (nb >= 96 ? 8 : 0); WT = (bf16_t*)(wsb + O_WIN); row0 = nb * 32; }
                else if ((r -= I_IN) < 6 * I_SQ) {
                    const int wsel = r / I_SQ; r -= wsel * I_SQ; const int nb = r % 64; kb = r / 64; ldw = D; K = D; csrc0 = nb * 32; row0 = nb * 32;
                    W = PF(wsel == 0 ? I_WOUT : wsel == 1 ? I_WXQ : wsel == 2 ? I_WXK : wsel == 3 ? I_WXV : wsel == 4 ? I_WXO : I_WPQ);
                    WT = (bf16_t*)(wsb + O_WOUT + (size_t)wsel * ((size_t)D * D * 2));
                    if (wsel == 1) kgain = PF(I_GCROSS); else if (wsel == 5) kgain = PF(I_GFFN);
                } else {
                    r -= 6 * I_SQ; const int hq = r / 32; r -= hq * 32; const int nb = r % 8; kb = r / 8;
                    W = PF(hq < 4 ? I_WMQ : I_WMK) + (size_t)(hq & 3) * 65536; ldw = 256; K = 256; csrc0 = nb * 32; WT = (bf16_t*)(wsb + O_WQK); row0 = hq * 256 + nb * 32;
                    if (hq >= 4) wscale = 0.0625f;
                }
                p0_transpose_item(W, ldw, K, csrc0, WT, row0, scr, kb, lane, wscale, kgain);
            }
            {
                const float* ut = PF(I_UTAB); const float* vt = PF(I_VTAB); const float* gffn = PF(I_GFFN);
#pragma nounroll
                for (int row = gw; row < 32768; row += NGW) {
                    const bool second = row >= 16384; const int rr = second ? row - 16384 : row;
                    if (second) table_row_to_fp8(vt + (size_t)rr * D, W_VT + (size_t)rr * D, W_RSC + row, lane, nullptr);
                    else table_row_to_i8(ut + (size_t)rr * D, W_UT + (size_t)rr * D, W_RSC + row, lane, gffn);
                }
            }
            rope_table_fill(W_CS, blockIdx.x * NTHR + tidx, gridDim.x * NTHR);
            {
                const float* sk = PF(I_SUBK);
#pragma nounroll
                for (int i = blockIdx.x * NTHR + tidx; i < 262144 / 8; i += gridDim.x * NTHR) {
                    const float4 a = *(const float4*)(sk + (size_t)i * 8), b = *(const float4*)(sk + (size_t)i * 8 + 4);
                    uint4 o; o.x = pk2(a.x, a.y); o.y = pk2(a.z, a.w); o.z = pk2(b.x, b.y); o.w = pk2(b.z, b.w);
                    *(uint4*)(W_SKB + (size_t)i * 8) = o;
                }
            }
            __syncthreads();
        }
        {
            const float* rin = PF(I_X); const float* rg = PF(I_GMIX); const float* win = PF(I_WIN);
            float* gwl = (float*)smem_raw + 1024;
            for (int k = tidx; k < 2048; k += NTHR) { const float4 a = *(const float4*)(win + (size_t)k * INC + C_MI), b = *(const float4*)(win + (size_t)k * INC + C_MI + 4);
                *(float4*)(gwl + k * 8) = a; *(float4*)(gwl + k * 8 + 4) = b; }
            __syncthreads();
            float* red = (float*)smem_raw + half * 256;
#pragma nounroll
            PHASE_LOOP(T) d_rmsnorm(VB, tid, red, rin, rg, W_HB, gwl, W_GPRE);
            const float* min_ = PF(I_MEM); const float* mg = PF(I_GMEM);
#pragma nounroll
            PHASE_LOOP(512) d_rmsnorm(VB, tid, red, min_, mg, W_MN2, nullptr, nullptr);
        }
    }
    xcd_barrier(xb);
    {
        PH_BEGIN();
        GJOB_DEFAULT(g); g.A = W_HB; g.Bt = (bf16_t*)(wsb + O_WIN); g.nN = 24; g.C = (float*)W_P6; g.ldc = 1024;
        pg8::gemm_phase<4>(GEMM_LDSP, g, tidx);
    }
    xcd_barrier(xb);
    {
        PH_BEGIN();
        const float* cw = PF(I_CONVW); const float* cb = PF(I_CONVB);
#pragma nounroll
        PHASE_LOOP(T) d_conv_silu(VB, tid, W_P6, cw, cb, W_CBUF);
        {
            LAS unsigned short* wl = (LAS unsigned short*)(LAS unsigned char*)smem_raw + (tidx >> 6) * (16 * 136);
#pragma nounroll
            for (int item = blockIdx.x * 8 + (tidx >> 6); item < 12288; item += gridDim.x * 8) dil_tile_prep(item, tidx & 63, wl, W_P6 + 4 * P6S, W_P6 + 5 * P6S, W_CS, W_KB, W_VB);
            __syncthreads();
        }
        if (blockIdx.x < 8 && tidx < 64) mlstm_gates_wave(blockIdx.x >> 2, blockIdx.x & 3, tidx, W_GPRE, PF(I_BMI), PF(I_BMF), W_GS, W_DECAY);
#pragma nounroll
        PHASE_LOOP(2048) { const int it = VB, lt = it & 3, et = (it >> 2) & 3, h = (it >> 4) & 3, cg = it >> 6;
            transpose_tile64(tid, sm, W_P6 + P6S + (size_t)(cg * 256 + lt * 64) * 1024 + h * 256 + et * 64, 1024, W_BH + ((size_t)(cg * 4 + h) * 256 + et * 64) * 512 + lt * 64, 512, nullptr, 0); }
    }
    xcd_barrier(xb);
    {
        PH_BEGIN();
        {
            GJOB_DEFAULT(g); g.A = W_CBUF; g.lda = 1024; g.a_pm_step = 256 * 1024; g.Bt = (bf16_t*)(wsb + O_WQK); g.ldb = 256; g.b_pn_step = 256 * 256; g.K = 256; g.a_pn_mask = 3; g.a_pn_step = 256; g.C = (float*)W_MQ; g.ldc = 1024;
            pg8::gemm_phase<4>(GEMM_LDSP, g, tidx);
            __syncthreads();
        }
        const float* ga = PF(I_GAHEAD);
#pragma nounroll
        for (int qt = blockIdx.x * 8 + (tidx >> 6); qt < 2048; qt += gridDim.x * 8) dilated_wave_tile(qt, tidx & 63, W_P6 + 3 * P6S, W_CS, W_KB, W_VB, ga, W_MIXB);
    }
    xcd_barrier(xb);
    {
        PH_BEGIN();
#pragma nounroll
        PHASE_LOOP(2048) { const int it = VB, lt = it & 3, dt = (it >> 2) & 3, h = (it >> 4) & 3, cg = it >> 6;
            transpose_tile64(tid, sm, W_MK + (size_t)(cg * 256 + lt * 64) * 1024 + h * 256 + dt * 64, 1024, W_KWT + ((size_t)(cg * 4 + h) * 256 + dt * 64) * 256 + lt * 64, 256,
                             W_GS + ((size_t)(cg * 256 + lt * 64) * 4 + h) * 8 + 2, 32); }
        {
            const size_t nth = (size_t)gridDim.x * NTHR;
#pragma nounroll
            for (size_t i = (size_t)blockIdx.x * NTHR + tidx; i < (size_t)T * 128; i += nth) {
                const size_t t = i >> 7; const int c8 = (int)(i & 127) * 8, h = c8 >> 8, d = c8 & 255;
                const float sc = W_GS[(t * 4 + h) * 8 + 3];
                const uint4 v = *(const uint4*)(W_MQ + t * 1024 + c8);
                uint4 o;
                o.x = pk2(bf2f((unsigned short)(v.x & 0xFFFFu)) * sc, bf2f((unsigned short)(v.x >> 16)) * sc); o.y = pk2(bf2f((unsigned short)(v.y & 0xFFFFu)) * sc, bf2f((unsigned short)(v.y >> 16)) * sc);
                o.z = pk2(bf2f((unsigned short)(v.z & 0xFFFFu)) * sc, bf2f((unsigned short)(v.z >> 16)) * sc); o.w = pk2(bf2f((unsigned short)(v.w & 0xFFFFu)) * sc, bf2f((unsigned short)(v.w >> 16)) * sc);
                *(uint4*)(W_PQ + t * 2048 + h * 512 + 256 + d) = o;
            }
        }
#pragma nounroll
        PHASE_LOOP(128) { const int cgh = VB, cg = cgh >> 2, h = cgh & 3;
            float a = 0.f;
            for (int l = 0; l < 256; ++l) { const size_t t = (size_t)cg * 256 + l; a = fmaf(W_GS[(t * 4 + h) * 8 + 2], bf2f(W_MK[t * 1024 + h * 256 + tid]), a); }
            W_DN[(size_t)cgh * 256 + tid] = a; }
        __syncthreads();
        {
            GJOB_DEFAULT(g); g.A = W_MQ; g.lda = 1024; g.a_pm_step = 256 * 1024; g.a_pn_mask = 3; g.a_pn_step = 256; g.K = 256; g.nN = 4;
            g.Bt = W_MK; g.ldb = 1024; g.b_pn_step = 256; g.b_pm_step = 256 * 1024; g.C = (float*)W_PQ; g.gs = W_GS; g.denp = W_DENP;
            pg8::gemm_phase<6>(GEMM_LDSP, g, tidx);
        }
    }
    xcd_barrier(xb);
    {
        PH_BEGIN();
        GJOB_DEFAULT(g); g.A = W_BH; g.lda = 512; g.a_pm_step = 4 * 256 * 512; g.a_pn_mask = 3; g.a_pn_step = 256 * 512; g.K = 256; g.nN = 4;
        g.Bt = W_KWT; g.ldb = 256; g.b_pn_step = 65536; g.b_pm_step = 4 * 65536; g.C = W_DC;
        pg8::gemm_phase<7>(GEMM_LDSP, g, tidx);
    }
    xcd_barrier(xb);
    {
        PH_BEGIN();
        {
#pragma nounroll
            for (int gid = blockIdx.x * NTHR + tidx; gid < 131072; gid += gridDim.x * NTHR) {
                const int bh = gid >> 14, b = bh >> 2, h = bh & 3, e = (gid >> 6) & 255, d = (gid & 63) * 4;
                float4 C = make_float4(0.f, 0.f, 0.f, 0.f);
#pragma unroll 4
                for (int c = 0; c < 16; ++c) {
                    const int cgh = (b * 16 + c) * 4 + h;
                    uint2 o; o.x = pk2(C.x, C.y); o.y = pk2(C.z, C.w);
                    *(uint2*)(W_BH + ((size_t)cgh * 256 + e) * 512 + 256 + d) = o;
                    const float dec = W_DECAY[cgh];
                    const float4 dc = *(const float4*)(W_DC + ((size_t)cgh * 256 + e) * 256 + d);
                    C.x = fmaf(dec, C.x, dc.x); C.y = fmaf(dec, C.y, dc.y); C.z = fmaf(dec, C.z, dc.z); C.w = fmaf(dec, C.w, dc.w);
                }
            }
        }
#pragma nounroll
        PHASE_LOOP(128) { const int cgh = VB, cg = cgh >> 2, h = cgh & 3, b = cg >> 4, c = cg & 15;
            float n = 0.f;
            for (int cc = 0; cc < c; ++cc) { const int j = (b * 16 + cc) * 4 + h; n = fmaf(W_DECAY[j], n, W_DN[(size_t)j * 256 + tid]); }
            __syncthreads();
            sm[tid] = n;
            __syncthreads();
            const int lane = tid & 63, w = tid >> 6;
            const float4 nv = *(const float4*)(sm + lane * 4);
            for (int i = 0; i < 64; ++i) {
                const size_t t = (size_t)cg * 256 + w * 64 + i;
                const ushort4 q4 = *(const ushort4*)(W_MQ + t * 1024 + h * 256 + lane * 4);
                float s = bf2f(q4.x) * nv.x + bf2f(q4.y) * nv.y + bf2f(q4.z) * nv.z + bf2f(q4.w) * nv.w;
                s = wave_sum(s);
                if (lane == 0) W_QN[t * 4 + h] = s;
            }
        }
    }
    xcd_barrier(xb);
    {
        PH_BEGIN();
        GJOB_DEFAULT(g); g.A = W_PQ; g.a_pn_mask = 3; g.a_pn_step = 512; g.K = 512; g.nN = 4;
        g.Bt = W_BH; g.ldb = 512; g.b_pn_step = 256 * 512; g.b_pm_step = 4 * 256 * 512; g.C = (float*)W_MIXB;
        g.gs = W_GS; g.denp = W_DENP; g.qn = W_QN; g.gvec = PF(I_GMHEAD); g.mo = W_P6 + 2 * P6S; g.nblk = 128;
        if (blockIdx.x < 128) pg8::gemm_phase<8>(GEMM_LDSP, g, tidx);
        else {
            GJOB_DEFAULT(k); k.A = W_MN2; k.K = 1024; k.nM = 2; k.nN = 32; k.a_pn_shift = 4; k.a_pn_mask = 1; k.a_pn_step = 1024;
            k.Bt = (bf16_t*)(wsb + O_WXK); k.b_pn_mask = 15; k.b_pn_shift = 4; k.b_pn_step2 = 1024; k.C = W_KVP; k.bid0 = 128; k.nblk = 128;
            pg8::gemm_phase<12>(GEMM_LDSP, k, tidx);
        }
    }
    xcd_barrier(xb);
    {
        PH_BEGIN();
        for (int i = blockIdx.x * NTHR + tidx; i < 512 * 4096 / 4; i += gridDim.x * NTHR) {
            const int r = i >> 10, c = (i & 1023) * 4;
            const float4 a = *(const float4*)(W_KVP + (size_t)r * 4096 + c), b = *(const float4*)(W_KVP + (size_t)512 * 4096 + (size_t)r * 4096 + c);
            const float v0 = a.x + b.x, v1 = a.y + b.y, v2 = a.z + b.z, v3 = a.w + b.w;
            if (c < 2048) { uint2 o; o.x = pk2(v0, v1); o.y = pk2(v2, v3); *(uint2*)(W_KM + (size_t)r * 2048 + c) = o; }
            else { bf16_t* d = W_VMT + (size_t)(c - 2048) * 512 + r; d[0] = (bf16_t)f2bf(v0); d[512] = (bf16_t)f2bf(v1); d[1024] = (bf16_t)f2bf(v2); d[1536] = (bf16_t)f2bf(v3); }
        }
        GJOB_DEFAULT(g); g.A = W_MIXB; g.Bt = (bf16_t*)(wsb + O_WOUT); g.R = PF(I_X); g.C2 = W_HB; g.rssp = W_RSSP;
        pg8::gemm_phase<10>(GEMM_LDSP, g, tidx);
    }
    xcd_barrier(xb);
    {
        PH_BEGIN();
        {
            GJOB_DEFAULT(g); g.A = W_HB; g.Bt = (bf16_t*)(wsb + O_WXQ); g.C = (float*)W_QX;
            pg8::Unit u0;
            if (pg8::unit_next(g, 0, u0) && tidx < 256) { const size_t r = (size_t)u0.pm * 256 + tidx; float s = 0.f; for (int k = 0; k < 32; ++k) s += W_RSSP[r * 32 + k];
                ((LAS float*)(LAS unsigned char*)(smem_raw + GEMM_LDS + 1024 + 8192))[tidx] = rsqrtf(s * (1.0f / D) + EPS); }
            __syncthreads();
            pg8::gemm_phase<11>(GEMM_LDSP, g, tidx); __syncthreads();
        }

    }
    xcd_barrier(xb);
    {
        PH_BEGIN();
        GJOB_DEFAULT(g); g.A = W_QX; g.K = 512; g.a_pn_mask = 3; g.a_pn_step = 512; g.Bt = W_KM; g.b_pn_step = 512; g.b_pm_shift = 4; g.b_pm_step = 256 * D; g.nN = 4;
        g.C = (float*)W_PX; g.ldc = 1024; g.escale = 0.04419417382415922f * 1.4426950408889634f;
        pg8::gemm_phase<5>(GEMM_LDSP, g, tidx);
    }
    xcd_barrier(xb);
    {
        PH_BEGIN();
        GJOB_DEFAULT(g); g.A = W_PX; g.lda = 1024; g.a_pm_step = 256 * 1024; g.K = 256; g.a_pn_shift = 1; g.a_pn_mask = 3; g.a_pn_step = 256; g.Bt = W_VMT; g.ldb = 512; g.b_pn_step = 256 * 512; g.b_pm_shift = 4; g.b_pm_step = 256;
        g.C = (float*)W_MIXB;
        pg8::gemm_phase<3>(GEMM_LDSP, g, tidx);
    }
    xcd_barrier(xb);
    {
        PH_BEGIN();
        GJOB_DEFAULT(g); g.A = W_MIXB; g.Bt = (bf16_t*)(wsb + O_WXO); g.R = nullptr; g.C2 = W_HB; g.rssp = W_RSSP;
        pg8::gemm_phase<10>(GEMM_LDSP, g, tidx);
    }
    xcd_barrier(xb);
    {
        PH_BEGIN();
        GJOB_DEFAULT(g); g.A = W_HB; g.Bt = (bf16_t*)(wsb + O_WPQ); g.C = (float*)W_QX;
        pg8::Unit u0;
        if (pg8::unit_next(g, 0, u0) && tidx < 256) { const size_t r = (size_t)u0.pm * 256 + tidx; float s = 0.f; for (int k = 0; k < 32; ++k) s += W_RSSP[r * 32 + k];
            const float rs = rsqrtf(s * (1.0f / D) + EPS);
            ((LAS float*)(LAS unsigned char*)(smem_raw + GEMM_LDS + 1024 + 8192))[tidx] = rs; W_RSTD[r] = rs; }
        __syncthreads();
        pg8::gemm_phase<11>(GEMM_LDSP, g, tidx);
    }
    xcd_barrier(xb);
    {
        PH_BEGIN();
        LAS float* wl = (LAS float*)(LAS unsigned char*)smem_raw + (tidx >> 6) * 1024;
#pragma nounroll
        for (int item = blockIdx.x * 8 + (tidx >> 6); item < 4096; item += gridDim.x * 8) peer_topk_wave2(item, tidx & 63, wl, W_QX, W_SKB, W_IDS, W_GATES);
    }
    xcd_barrier(xb);
    {
        PH_BEGIN();
        const float* gf = PF(I_GFINAL); float* outp = (float*)ldp_raw(I_OUT);
        LAS unsigned char* wl = (LAS unsigned char*)smem_raw + (tidx >> 6) * 11776;
#pragma nounroll
        for (int gw = blockIdx.x * 8 + (tidx >> 6); gw < T / 4; gw += gridDim.x * 8) { int ln = tidx & 63; asm volatile("" : "+v"(ln));
            peer_sweep_wave(gw, ln, wl, W_HB, W_XR, W_IDS, W_GATES, W_UT, W_VT, W_RSC, W_RSTD, gf, outp); }
    }
}
}

extern "C" void kernel_launch(void* const* d_in, const int* in_sizes, int n_in, void* d_out, int out_size, void* d_ws, size_t ws_size, hipStream_t stream) {
    static int grid_blocks = 0;
    if (!grid_blocks) {
        int dev = 0, cus = 0, per_cu = 0;
        hipGetDevice(&dev);
        hipDeviceGetAttribute(&cus, hipDeviceAttributeMultiprocessorCount, dev);
        hipFuncSetAttribute((const void*)mega, hipFuncAttributeMaxDynamicSharedMemorySize, SMEM_BYTES);
        hipOccupancyMaxActiveBlocksPerMultiprocessor(&per_cu, mega, NTHR, SMEM_BYTES);
        if (per_cu > 1) per_cu = 1;
        if (per_cu < 1) per_cu = 1;
        grid_blocks = cus * per_cu;
    }
    Params P{};
    const float** pp = (const float**)&P;
    for (int i = 0; i < 25; ++i) pp[i] = (const float*)d_in[i];
    P.out = (float*)d_out;
    P.bar = (unsigned*)d_ws;
    P.ws = (float*)((char*)d_ws + 16384);
    hipMemsetAsync(d_ws, 0, 16384, stream);
    void* args[] = {&P};
    hipError_t e = hipLaunchCooperativeKernel((const void*)mega, dim3(grid_blocks), dim3(NTHR), args, SMEM_BYTES, stream);
    if (e != hipSuccess) fprintf(stderr, "cooperative launch failed: %s (grid %d)\n", hipGetErrorString(e), grid_blocks);
}
```

```cpp
#include <hip/hip_runtime.h>
#include <stdint.h>
#include <math.h>
#include <cstdio>

#define LAS_ __attribute__((address_space(3)))
namespace {
constexpr int D = 2048, NB = 2, S = 4096, T = NB * S;
constexpr int INC = 6152;
constexpr int C_MIN = 0, C_MV = 1024, C_MO = 2048, C_MI = 3072, C_MF = 3076, C_AQ = 3080, C_AK = 4104, C_AV = 5128;
constexpr float EPS = 1e-6f;
constexpr size_t P6S = (size_t)8192 * 1024;
constexpr int NTHR = 512;
constexpr int HALF_SM_FLOATS = 8704;
constexpr int GEMM_LDS = 131072;
constexpr int SMEM_BYTES = 163840;
constexpr int CTRL_OFF = SMEM_BYTES - 1024;
typedef unsigned short bf16_t;
__device__ __forceinline__ unsigned f2bf(float f) { unsigned u = __float_as_uint(f); u += 0x7FFFu + ((u >> 16) & 1u); return u >> 16; }
__device__ __forceinline__ unsigned pk2(float lo, float hi) { return f2bf(lo) | (f2bf(hi) << 16); }
__device__ __forceinline__ float bf2f(unsigned short b) { return __uint_as_float(((unsigned)b) << 16); }
extern __shared__ __attribute__((aligned(16))) unsigned char smem_raw[];
enum { I_X = 0, I_MEM, I_GMIX, I_WIN, I_CONVW, I_CONVB, I_WMQ, I_WMK, I_BMI, I_BMF, I_GMHEAD, I_GAHEAD, I_WOUT, I_GCROSS, I_GMEM,
       I_WXQ, I_WXK, I_WXV, I_WXO, I_GFFN, I_WPQ, I_SUBK, I_UTAB, I_VTAB, I_GFINAL, I_OUT, I_BAR, I_WS, I_NPTR };
__device__ __forceinline__ unsigned long long ldp_raw(int i) {
    const LAS_ unsigned long long* tab = (const LAS_ unsigned long long*)(LAS_ unsigned char*)(smem_raw + CTRL_OFF + 64);
    const unsigned long long v = tab[i];
    const unsigned lo = __builtin_amdgcn_readfirstlane((unsigned)v), hi = __builtin_amdgcn_readfirstlane((unsigned)(v >> 32));
    return ((unsigned long long)hi << 32) | lo;
}
#define PF(i) ((const float*)ldp_raw(i))

#define XB_TMO      128
#define XB_XCNT(j)  (256  + 64 * (j))
#define XB_XSUB(j)  (1280 + 64 * (j))
#define XB_XGEN(j)  (2304 + 64 * (j))
#define XB_TOP      3328
#define XB_TOPGEN   3392
#define XCD_BAR_WORDS 3456
#define XB_SPIN_CAP (1u << 22)
#define LAS __attribute__((address_space(3)))

__device__ __forceinline__ unsigned xb_ld(unsigned* p)              { return __hip_atomic_load(p, __ATOMIC_RELAXED, __HIP_MEMORY_SCOPE_AGENT); }
__device__ __forceinline__ unsigned xb_add(unsigned* p, unsigned v) { return __hip_atomic_fetch_add(p, v, __ATOMIC_RELAXED, __HIP_MEMORY_SCOPE_AGENT); }
__device__ __forceinline__ unsigned xb_xcc_id() { return (unsigned)__builtin_amdgcn_s_getreg((3 << 11) | 20) & 0xFu; }
#define XB_SPIN(cond, bar) do { unsigned _sp = 0; while (cond) { __builtin_amdgcn_s_sleep(1); \
    if ((++_sp & 255u) == 0u) { if (xb_ld(&(bar)[XB_TMO])) break; if (_sp > XB_SPIN_CAP) { atomicAdd(&(bar)[XB_TMO], 1u); break; } } } } while (0)

struct XcdBarrier { unsigned* bar; unsigned x; volatile LAS unsigned* st; };

__device__ __forceinline__ XcdBarrier xcd_barrier_post(unsigned* bar, volatile LAS unsigned* st) {
    XcdBarrier b; b.bar = bar; b.x = xb_xcc_id(); b.st = st;
    if (threadIdx.x == 0) (void)xb_add(&bar[XB_XCNT(b.x)], 1u);
    return b;
}
__device__ __forceinline__ void xcd_barrier_complete(unsigned* bar, unsigned x, unsigned& nloc, unsigned& nx) {
    const unsigned G = gridDim.x * gridDim.y * gridDim.z;
    unsigned sum, cnt, mine, sp = 0u;
    for (;;) {
        sum = 0u; cnt = 0u; mine = 0u;
#pragma unroll
        for (unsigned j = 0; j < 16; ++j) { const unsigned c = xb_ld(&bar[XB_XCNT(j)]); sum += c; cnt += (c > 0u) ? 1u : 0u; mine = (j == x) ? c : mine; }
        if (sum == G) break;
        __builtin_amdgcn_s_sleep(1);
        if ((++sp & 255u) == 0u) { if (xb_ld(&bar[XB_TMO])) break; if (sp > XB_SPIN_CAP) { atomicAdd(&bar[XB_TMO], 1u); break; } }
    }
    nloc = mine > 0u ? mine : 1u; nx = cnt > 0u ? cnt : 1u;
}
__device__ __forceinline__ void xcd_barrier(const XcdBarrier& b) {
    asm volatile("s_waitcnt vmcnt(0)" ::: "memory");
    __syncthreads();
    if (threadIdx.x == 0) {
        unsigned* bar = b.bar;
        __builtin_amdgcn_s_waitcnt(0);
        unsigned nloc = b.st[0], nx = b.st[1];
        if (nloc == 0u) { xcd_barrier_complete(bar, b.x, nloc, nx); b.st[0] = nloc; b.st[1] = nx; }
        const unsigned old = xb_add(&bar[XB_XSUB(b.x)], 1u);
        const unsigned gen = old / nloc;
        if (old + 1u == (gen + 1u) * nloc) {
            __builtin_amdgcn_fence(__ATOMIC_RELEASE, "agent");
            asm volatile("s_waitcnt vmcnt(0)" ::: "memory");
            const unsigned og = xb_add(&bar[XB_TOP], 1u);
            const unsigned tg = og / nx;
            if (og + 1u == (tg + 1u) * nx) xb_add(&bar[XB_TOPGEN], 1u);
            else XB_SPIN(xb_ld(&bar[XB_TOPGEN]) == tg, bar);
            __builtin_amdgcn_fence(__ATOMIC_ACQUIRE, "agent");
            xb_add(&bar[XB_XGEN(b.x)], 1u);
            asm volatile("s_waitcnt vmcnt(0)" ::: "memory");
        } else {
            XB_SPIN(xb_ld(&bar[XB_XGEN(b.x)]) == gen, bar);
            __builtin_amdgcn_fence(__ATOMIC_ACQUIRE, "agent");
            asm volatile("s_waitcnt vmcnt(0)" ::: "memory");
        }
    }
    __syncthreads();
}

__device__ __forceinline__ float wave_sum(float v) {
#pragma unroll
    for (int o = 32; o >= 1; o >>= 1) v += __shfl_xor(v, o);
    return v;
}
__device__ __forceinline__ float wave_max(float v) {
#pragma unroll
    for (int o = 32; o >= 1; o >>= 1) v = fmaxf(v, __shfl_xor(v, o));
    return v;
}
__device__ __forceinline__ float log_sigmoid(float x) { return fminf(x, 0.f) - log1pf(expf(-fabsf(x))); }


__device__ __forceinline__ void d_rmsnorm(int vb, int t, float* sm, const float* __restrict__ in, const float* __restrict__ g, bf16_t* __restrict__ out,
                                          const float* gwl  , float* __restrict__ gpre) {
    float* red = sm;
    const int row = vb;
    const float4* p = (const float4*)(in + (size_t)row * D);
    float4 a = p[t], b = p[t + 256];
    float s = a.x * a.x + a.y * a.y + a.z * a.z + a.w * a.w + b.x * b.x + b.y * b.y + b.z * b.z + b.w * b.w;
    s = wave_sum(s);
    __syncthreads();
    if ((t & 63) == 0) red[t >> 6] = s;
    __syncthreads();
    const float tot = red[0] + red[1] + red[2] + red[3];
    const float r = rsqrtf(tot * (1.0f / D) + EPS);
    const float4* gp = (const float4*)g;
    float4 ga = gp[t], gb = gp[t + 256];
    float hv[8] = {a.x * r * ga.x, a.y * r * ga.y, a.z * r * ga.z, a.w * r * ga.w, b.x * r * gb.x, b.y * r * gb.y, b.z * r * gb.z, b.w * r * gb.w};
    uint2 o0, o1;
    o0.x = pk2(hv[0], hv[1]); o0.y = pk2(hv[2], hv[3]); o1.x = pk2(hv[4], hv[5]); o1.y = pk2(hv[6], hv[7]);
    *(uint2*)(out + (size_t)row * D + t * 4) = o0;
    *(uint2*)(out + (size_t)row * D + 1024 + t * 4) = o1;
    if (gpre) {
        float gs[8];
#pragma unroll
        for (int c = 0; c < 8; ++c) gs[c] = 0.f;
#pragma unroll
        for (int j = 0; j < 8; ++j) {
            const int k = (j < 4) ? (t * 4 + j) : (1024 + t * 4 + (j - 4));
            const float4 w0 = *(const float4*)(gwl + k * 8), w1 = *(const float4*)(gwl + k * 8 + 4);
            gs[0] = fmaf(hv[j], w0.x, gs[0]); gs[1] = fmaf(hv[j], w0.y, gs[1]); gs[2] = fmaf(hv[j], w0.z, gs[2]); gs[3] = fmaf(hv[j], w0.w, gs[3]);
            gs[4] = fmaf(hv[j], w1.x, gs[4]); gs[5] = fmaf(hv[j], w1.y, gs[5]); gs[6] = fmaf(hv[j], w1.z, gs[6]); gs[7] = fmaf(hv[j], w1.w, gs[7]);
        }
#pragma unroll
        for (int c = 0; c < 8; ++c) gs[c] = wave_sum(gs[c]);
        __syncthreads();
        if ((t & 63) == 0) {
#pragma unroll
            for (int c = 0; c < 8; ++c) red[8 + (t >> 6) * 8 + c] = gs[c];
        }
        __syncthreads();
        if (t < 8) gpre[(size_t)row * 8 + t] = red[8 + t] + red[16 + t] + red[24 + t] + red[32 + t];
    }
}

namespace pg8 {
typedef short bf16x8 __attribute__((ext_vector_type(8)));
typedef float f32x4 __attribute__((ext_vector_type(4)));
constexpr int BM = 256, BK = 64, HALF = 128, HTB = HALF * BK * 2, NXCD = 8, WGM = 8;
__device__ __forceinline__ int lds_byte(int r, int c) { const int st = (r >> 4) * 2 + (c >> 5), rr = r & 15, cc = c & 31, ob = rr * 64 + cc * 2; return st * 1024 + (ob ^ (((ob >> 9) & 1) << 5)); }
__device__ __forceinline__ void stage_rc(int b, int& R, int& C) { const int st = b / 1024, sb = b % 1024, swz = sb ^ (((sb >> 9) & 1) << 5); R = (st >> 1) * 16 + swz / 64; C = (st & 1) * 32 + (swz % 64) / 2; }
struct Unit { int pm, pn; };
struct GJob {
    const bf16_t* A; const bf16_t* Bt;
    int lda, ldb, K, nM, nN;
    int a_pn_shift, a_pn_mask, a_pn_step;
    int b_pm_shift, b_pm_step, b_pn_step;
    int a_pm_step;
    int b_pn_mask, b_pn_shift, b_pn_step2;
    int bid0, nblk;
    float escale;
    const float* gs; float* denp; const float* qn; const float* gvec; const bf16_t* mo;
    bf16_t* C2; float* rssp; const float* rstd;
    float* C; int ldc; const float* R; int ldr;
    int mode;
};
__device__ __forceinline__ bool unit_next(const GJob& g, int i, Unit& u) {
    const int nwg = g.nM * g.nN;
    const int bid = (int)blockIdx.x - g.bid0; if (bid < 0 || bid >= g.nblk) return false;
    const long L = (long)i * g.nblk + bid; if (L >= nwg) return false;
    int wgid = (int)L; { const int q = nwg / NXCD, r = nwg % NXCD, xcd = wgid % NXCD, off = wgid / NXCD; wgid = (xcd < r ? xcd * (q + 1) : r * (q + 1) + (xcd - r) * q) + off; }
    const int nig = WGM * g.nN, gid = wgid / nig, fm = gid * WGM, gsz = (g.nM - fm) < WGM ? (g.nM - fm) : WGM;
    u.pm = fm + ((wgid % nig) % gsz); u.pn = (wgid % nig) / gsz; return true;
}
template <int MODE> __device__ __forceinline__ void epilogue(const GJob& g, f32x4 (&acc)[2][2][4][2], const Unit& u, int wr, int wc, int fr, int fq, LAS unsigned char* xlds) {
    const int row0 = u.pm * BM + wr * 64 + fr;
    if constexpr (MODE == 0) {
        const int col0 = u.pn * BM + wc * 32 + 4 * fq;
#pragma unroll
        for (int ai = 0; ai < 2; ++ai)
#pragma unroll
            for (int m = 0; m < 4; ++m) {
                const int row = row0 + ai * HALF + m * 16;
                float* rowp = g.C + (size_t)row * g.ldc + col0;
                const float* rp = g.R ? g.R + (size_t)row * g.ldr + col0 : nullptr;
#pragma unroll
                for (int bj = 0; bj < 2; ++bj)
#pragma unroll
                    for (int n = 0; n < 2; ++n) {
                        f32x4 v = acc[ai][bj][m][n];
                        if (rp) v = v + *(const f32x4*)(rp + bj * HALF + n * 16);
                        *(f32x4*)(rowp + bj * HALF + n * 16) = v;
                    }
            }
    } else if constexpr (MODE == 10) {
        const int col0 = u.pn * BM + wc * 32 + 4 * fq;
#pragma unroll
        for (int ai = 0; ai < 2; ++ai)
#pragma unroll
            for (int m = 0; m < 4; ++m) {
                const int row = row0 + ai * HALF + m * 16;
                bf16_t* r2 = g.C2 + (size_t)row * D + col0;
                float ss = 0.f;
#pragma unroll
                for (int bj = 0; bj < 2; ++bj)
#pragma unroll
                    for (int n = 0; n < 2; ++n) {
                        f32x4 v = acc[ai][bj][m][n];
                        if (g.R) v = v + *(const f32x4*)(g.R + (size_t)row * g.ldr + col0 + bj * HALF + n * 16);
                        else { const uint2 pr = *(const uint2*)(r2 + bj * HALF + n * 16);
                               v[0] += __uint_as_float(pr.x << 16); v[1] += __uint_as_float(pr.x & 0xFFFF0000u); v[2] += __uint_as_float(pr.y << 16); v[3] += __uint_as_float(pr.y & 0xFFFF0000u); }
                        uint2 o; o.x = pk2(v[0], v[1]); o.y = pk2(v[2], v[3]);
                        *(uint2*)(r2 + bj * HALF + n * 16) = o;
                        ss += (v[0] * v[0] + v[1] * v[1]) + (v[2] * v[2] + v[3] * v[3]);
                    }
                ss += __shfl_xor(ss, 16); ss += __shfl_xor(ss, 32);
                if (fq == 0) g.rssp[(size_t)row * 32 + u.pn * 4 + wc] = ss;
            }
    } else if constexpr (MODE == 11) {
        bf16_t* Cb = (bf16_t*)g.C;
        const int col0 = u.pn * BM + wc * 32 + 4 * fq;
#pragma unroll
        for (int ai = 0; ai < 2; ++ai)
#pragma unroll
            for (int m = 0; m < 4; ++m) {
                const int row = row0 + ai * HALF + m * 16;
                const float rs = ((const LAS float*)(xlds + 8192))[row - u.pm * BM];
                bf16_t* rowp = Cb + (size_t)row * g.ldc + col0;
#pragma unroll
                for (int bj = 0; bj < 2; ++bj)
#pragma unroll
                    for (int n = 0; n < 2; ++n) {
                        const f32x4 v = acc[ai][bj][m][n] * rs;
                        uint2 o; o.x = pk2(v[0], v[1]); o.y = pk2(v[2], v[3]);
                        *(uint2*)(rowp + bj * HALF + n * 16) = o;
                    }
            }
    } else if constexpr (MODE == 6) {
        const int h = u.pn; const size_t t0 = (size_t)u.pm * BM;
        bf16_t* Cb = (bf16_t*)g.C;
#pragma unroll
        for (int ai = 0; ai < 2; ++ai)
#pragma unroll
            for (int m = 0; m < 4; ++m) {
                const int l = ai * HALF + wr * 64 + m * 16 + fr;
                const float M2 = g.gs[((t0 + l) * 4 + h) * 8 + 1];
                bf16_t* rowp = Cb + (t0 + l) * 2048 + h * 512 + wc * 32 + 4 * fq;
                float rs = 0.f;
#pragma unroll
                for (int bj = 0; bj < 2; ++bj)
#pragma unroll
                    for (int n = 0; n < 2; ++n) {
                        const f32x4 a = acc[ai][bj][m][n];
                        const int s0 = bj * HALF + wc * 32 + n * 16 + 4 * fq;
                        float p[4];
#pragma unroll
                        for (int r = 0; r < 4; ++r) { const float u2 = g.gs[((t0 + s0 + r) * 4 + h) * 8 + 0]; p[r] = (s0 + r <= l) ? a[r] * __builtin_amdgcn_exp2f(u2 - M2) : 0.f; rs += p[r]; }
                        uint2 o; o.x = pk2(p[0], p[1]); o.y = pk2(p[2], p[3]);
                        *(uint2*)(rowp + bj * HALF + n * 16) = o;
                    }
                rs += __shfl_xor(rs, 16); rs += __shfl_xor(rs, 32);
                if (fq == 0) g.denp[((t0 + l) * 4 + h) * 4 + wc] = rs;
            }
    } else if constexpr (MODE == 12) {
        float* Ct = g.C + (size_t)(u.pn >> 4) * ((size_t)512 * 4096) + (size_t)(u.pn & 15) * 256;
        const int col0 = wc * 32 + 4 * fq;
#pragma unroll
        for (int ai = 0; ai < 2; ++ai)
#pragma unroll
            for (int m = 0; m < 4; ++m) {
                float* rowp = Ct + (size_t)(row0 + ai * HALF + m * 16) * 4096 + col0;
#pragma unroll
                for (int bj = 0; bj < 2; ++bj)
#pragma unroll
                    for (int n = 0; n < 2; ++n) *(f32x4*)(rowp + bj * HALF + n * 16) = acc[ai][bj][m][n];
            }
    } else if constexpr (MODE == 7) {
        float* Ct = g.C + (size_t)(u.pm * 4 + u.pn) * 65536;
        const int col0 = wc * 32 + 4 * fq;
#pragma unroll
        for (int ai = 0; ai < 2; ++ai)
#pragma unroll
            for (int m = 0; m < 4; ++m) {
                float* rowp = Ct + (size_t)(ai * HALF + wr * 64 + m * 16 + fr) * 256 + col0;
#pragma unroll
                for (int bj = 0; bj < 2; ++bj)
#pragma unroll
                    for (int n = 0; n < 2; ++n) *(f32x4*)(rowp + bj * HALF + n * 16) = acc[ai][bj][m][n];
            }
    } else if constexpr (MODE == 8) {
        const int h = u.pn; const size_t t0 = (size_t)u.pm * BM;
        LAS float* X0 = (LAS float*)xlds + wr * 512;
#pragma unroll
        for (int ai = 0; ai < 2; ++ai)
#pragma unroll
            for (int m = 0; m < 4; ++m) {
                const size_t th = (t0 + ai * HALF + wr * 64 + m * 16 + fr) * 4 + h;
                const f32x4 dp = *(const f32x4*)(g.denp + th * 4);
                const float den = (dp[0] + dp[1]) + (dp[2] + dp[3]) + g.gs[th * 8 + 3] * g.qn[th];
                const float rden = 1.0f / fmaxf(fabsf(den), g.gs[th * 8 + 4]);
                float ss = 0.f;
#pragma unroll
                for (int bj = 0; bj < 2; ++bj)
#pragma unroll
                    for (int n = 0; n < 2; ++n) { f32x4 a = acc[ai][bj][m][n] * rden; acc[ai][bj][m][n] = a; ss += (a[0] * a[0] + a[1] * a[1]) + (a[2] * a[2] + a[3] * a[3]); }
                ss += __shfl_xor(ss, 16); ss += __shfl_xor(ss, 32);
                if (fq == 0) X0[(ai * 64 + m * 16 + fr) * 4 + wc] = ss;
            }
        asm volatile("s_waitcnt lgkmcnt(0)" ::: "memory"); __builtin_amdgcn_s_barrier(); asm volatile("" ::: "memory");
        bf16_t* Cb = (bf16_t*)g.C;
        const int col0 = wc * 32 + 4 * fq;
#pragma unroll
        for (int ai = 0; ai < 2; ++ai)
#pragma unroll
            for (int m = 0; m < 4; ++m) {
                const f32x4 p4 = *(const LAS f32x4*)(X0 + (ai * 64 + m * 16 + fr) * 4);
                const float rsn = rsqrtf(((p4[0] + p4[1]) + (p4[2] + p4[3])) * (1.0f / 256.0f) + EPS);
                const size_t t = t0 + ai * HALF + wr * 64 + m * 16 + fr;
                bf16_t* rowp = Cb + t * 2048 + h * 256 + col0;
                const bf16_t* mop = g.mo + t * 1024 + h * 256 + col0;
#pragma unroll
                for (int bj = 0; bj < 2; ++bj)
#pragma unroll
                    for (int n = 0; n < 2; ++n) {
                        const f32x4 a = acc[ai][bj][m][n];
                        const ushort4 mo4 = *(const ushort4*)(mop + bj * HALF + n * 16);
                        const f32x4 gv = *(const f32x4*)(g.gvec + h * 256 + col0 + bj * HALF + n * 16);
                        const float o0 = a[0] * rsn * gv[0] / (1.0f + __expf(-bf2f(mo4.x)));
                        const float o1 = a[1] * rsn * gv[1] / (1.0f + __expf(-bf2f(mo4.y)));
                        const float o2 = a[2] * rsn * gv[2] / (1.0f + __expf(-bf2f(mo4.z)));
                        const float o3 = a[3] * rsn * gv[3] / (1.0f + __expf(-bf2f(mo4.w)));
                        uint2 o; o.x = pk2(o0, o1); o.y = pk2(o2, o3);
                        *(uint2*)(rowp + bj * HALF + n * 16) = o;
                    }
            }
    } else if constexpr (MODE == 5) {
        LAS float* X0 = (LAS float*)xlds + wr * 512;
        LAS float* X1 = (LAS float*)xlds + 1024 + wr * 512;
#pragma unroll
        for (int ai = 0; ai < 2; ++ai)
#pragma unroll
            for (int m = 0; m < 4; ++m) {
                float v = -INFINITY;
#pragma unroll
                for (int bj = 0; bj < 2; ++bj)
#pragma unroll
                    for (int n = 0; n < 2; ++n) { const f32x4 a = acc[ai][bj][m][n]; v = fmaxf(v, fmaxf(fmaxf(a[0], a[1]), fmaxf(a[2], a[3]))); }
                v = fmaxf(v, __shfl_xor(v, 16)); v = fmaxf(v, __shfl_xor(v, 32));
                if (fq == 0) X0[(ai * 64 + m * 16 + fr) * 4 + wc] = v;
            }
        asm volatile("s_waitcnt lgkmcnt(0)" ::: "memory"); __builtin_amdgcn_s_barrier(); asm volatile("" ::: "memory");
#pragma unroll
        for (int ai = 0; ai < 2; ++ai)
#pragma unroll
            for (int m = 0; m < 4; ++m) {
                const f32x4 p4 = *(const LAS f32x4*)(X0 + (ai * 64 + m * 16 + fr) * 4);
                const float mxr = fmaxf(fmaxf(p4[0], p4[1]), fmaxf(p4[2], p4[3])) * g.escale;
                float s = 0.f;
#pragma unroll
                for (int bj = 0; bj < 2; ++bj)
#pragma unroll
                    for (int n = 0; n < 2; ++n) { f32x4 a = acc[ai][bj][m][n];
                        a[0] = __builtin_amdgcn_exp2f(a[0] * g.escale - mxr); a[1] = __builtin_amdgcn_exp2f(a[1] * g.escale - mxr); a[2] = __builtin_amdgcn_exp2f(a[2] * g.escale - mxr); a[3] = __builtin_amdgcn_exp2f(a[3] * g.escale - mxr);
                        acc[ai][bj][m][n] = a; s += (a[0] + a[1]) + (a[2] + a[3]); }
                s += __shfl_xor(s, 16); s += __shfl_xor(s, 32);
                if (fq == 0) X1[(ai * 64 + m * 16 + fr) * 4 + wc] = s;
            }
        asm volatile("s_waitcnt lgkmcnt(0)" ::: "memory"); __builtin_amdgcn_s_barrier(); asm volatile("" ::: "memory");
        bf16_t* Cb = (bf16_t*)g.C;
        const int col0 = u.pn * BM + wc * 32 + 4 * fq;
#pragma unroll
        for (int ai = 0; ai < 2; ++ai)
#pragma unroll
            for (int m = 0; m < 4; ++m) {
                const f32x4 p4 = *(const LAS f32x4*)(X1 + (ai * 64 + m * 16 + fr) * 4);
                const float inv = 1.0f / ((p4[0] + p4[1]) + (p4[2] + p4[3]));
                bf16_t* rowp = Cb + (size_t)(row0 + ai * HALF + m * 16) * g.ldc + col0;
#pragma unroll
                for (int bj = 0; bj < 2; ++bj)
#pragma unroll
                    for (int n = 0; n < 2; ++n) {
                        const f32x4 a = acc[ai][bj][m][n];
                        uint2 o; o.x = pk2(a[0] * inv, a[1] * inv); o.y = pk2(a[2] * inv, a[3] * inv);
                        *(uint2*)(rowp + bj * HALF + n * 16) = o;
                    }
            }
    } else {
        bf16_t* Cb = (bf16_t*)g.C; int ccol = u.pn * BM;
        if constexpr (MODE == 4) { Cb += (size_t)(u.pn >> 2) * P6S; ccol = (u.pn & 3) * 256; }
        const int col0 = ccol + wc * 32 + 4 * fq;
#pragma unroll
        for (int ai = 0; ai < 2; ++ai)
#pragma unroll
            for (int m = 0; m < 4; ++m) {
                bf16_t* rowp = Cb + (size_t)(row0 + ai * HALF + m * 16) * g.ldc + col0;
#pragma unroll
                for (int bj = 0; bj < 2; ++bj)
#pragma unroll
                    for (int n = 0; n < 2; ++n) {
                        const f32x4 v = acc[ai][bj][m][n];
                        uint2 o; o.x = pk2(v[0], v[1]); o.y = pk2(v[2], v[3]);
                        *(uint2*)(rowp + bj * HALF + n * 16) = o;
                    }
            }
    }
}
template <int MODE> __device__ __forceinline__ void gemm_phase(LAS unsigned char* lds, const GJob& g, int tid) {
    const int wid = __builtin_amdgcn_readfirstlane(tid >> 6), lane = tid & 63, wr = wid >> 2, wc = wid & 3, fr = lane & 15, fq = lane >> 4;
    const int K = g.K, nt = K / BK;
    unsigned voffA[2], voffB[2];
#pragma unroll
    for (int i = 0; i < 2; ++i) { int R, C; stage_rc(tid * 16 + i * 8192, R, C);
        voffA[i] = (unsigned)(R * g.lda + C) * 2u; voffB[i] = (unsigned)(R * g.ldb + C) * 2u; }
    const size_t kstep = (size_t)(BK * 2);
    const size_t hstepA = (size_t)HALF * g.lda * 2, hstepB = (size_t)HALF * g.ldb * 2;
    const unsigned ldsw = (unsigned)wid * 1024u;
    const int aoff = lds_byte(wr * 64 + fr, fq * 8), boff = lds_byte(wc * 32 + fr, fq * 8);
#define PG8_SA(b, h) (((b) * 2 + (h)) * HTB)
#define PG8_SB(b, h) ((4 + (b) * 2 + (h)) * HTB)
#define PG8_STAGE(bufoff, gbase, voff) do { _Pragma("unroll") for (int _i = 0; _i < 2; ++_i) \
        __builtin_amdgcn_global_load_lds((const unsigned*)((const char*)(gbase) + (voff)[_i]), (LAS unsigned*)(lds + (bufoff) + ldsw + _i * 8192), 16, 0, 0); } while (0)
#define PG8_LDA(dst, b, h) do { _Pragma("unroll") for (int m = 0; m < 4; ++m) _Pragma("unroll") for (int k = 0; k < 2; ++k) dst[m][k] = *(const LAS bf16x8*)(lds + PG8_SA(b, h) + aoff + m * 2048 + k * 1024); } while (0)
#define PG8_LDB(dst, b, h) do { _Pragma("unroll") for (int n = 0; n < 2; ++n) _Pragma("unroll") for (int k = 0; k < 2; ++k) dst[n][k] = *(const LAS bf16x8*)(lds + PG8_SB(b, h) + boff + n * 2048 + k * 1024); } while (0)
#define PG8_MMA(ai, bj, At, Bt) do { __builtin_amdgcn_s_setprio(1); _Pragma("unroll") for (int m = 0; m < 4; ++m) _Pragma("unroll") for (int n = 0; n < 2; ++n) _Pragma("unroll") for (int k = 0; k < 2; ++k) \
        acc[ai][bj][m][n] = __builtin_amdgcn_mfma_f32_16x16x32_bf16(Bt[n][k], At[m][k], acc[ai][bj][m][n], 0, 0, 0); __builtin_amdgcn_s_setprio(0); } while (0)
#define PG8_WAIT_V(n) asm volatile("s_waitcnt vmcnt(" #n ")" ::: "memory")
#define PG8_WAIT_L(n) asm volatile("s_waitcnt lgkmcnt(" #n ")" ::: "memory")
#define PG8_BAR __builtin_amdgcn_s_barrier()
#define PG8_SCHED __builtin_amdgcn_sched_barrier(0)
#define PG8_ABASE(u) ((const char*)g.A + ((size_t)(u).pm * g.a_pm_step + (size_t)(((u).pn >> g.a_pn_shift) & g.a_pn_mask) * g.a_pn_step) * 2)
#define PG8_BBASE(u) ((const char*)g.Bt + ((size_t)((u).pn & g.b_pn_mask) * g.b_pn_step + (size_t)((u).pn >> g.b_pn_shift) * g.b_pn_step2 + (size_t)((u).pm >> g.b_pm_shift) * g.b_pm_step) * 2)
    Unit cur, nxt; int ui = 0;
    if (!unit_next(g, 0, cur)) return;
    f32x4 acc[2][2][4][2];
#pragma unroll
    for (int a = 0; a < 2; ++a)
#pragma unroll
        for (int b = 0; b < 2; ++b)
#pragma unroll
            for (int m = 0; m < 4; ++m)
#pragma unroll
                for (int n = 0; n < 2; ++n) acc[a][b][m][n] = (f32x4){0.f, 0.f, 0.f, 0.f};
    bf16x8 At[4][2], B0[2][2], B1[2][2];
    const char* cA = PG8_ABASE(cur); const char* cB = PG8_BBASE(cur);
    PG8_STAGE(PG8_SB(0, 0), cB, voffB); PG8_STAGE(PG8_SA(0, 0), cA, voffA); PG8_STAGE(PG8_SB(0, 1), cB + hstepB, voffB); PG8_STAGE(PG8_SA(0, 1), cA + hstepA, voffA);
    if (wr == 1) PG8_BAR;
    PG8_WAIT_V(4); PG8_BAR;
    PG8_STAGE(PG8_SB(1, 0), cB + kstep, voffB); PG8_STAGE(PG8_SA(1, 0), cA + kstep, voffA); PG8_STAGE(PG8_SB(1, 1), cB + hstepB + kstep, voffB);
    PG8_WAIT_V(6); PG8_BAR;
    for (;;) {
        const bool has_next = unit_next(g, ui + 1, nxt);
        const char* nA = has_next ? PG8_ABASE(nxt) : cA; const char* nB = has_next ? PG8_BBASE(nxt) : cB;
        for (int t = 0; t < nt; t += 2) {
            const bool last = (t == nt - 2);
            const char* a1 = cA + (size_t)(t + 1) * kstep;
            const char* a2 = last ? nA : cA + (size_t)(t + 2) * kstep; const char* b2 = last ? nB : cB + (size_t)(t + 2) * kstep;
            const char* a3 = a2 + kstep; const char* b3 = b2 + kstep;
            PG8_LDB(B0, 0, 0); PG8_SCHED; PG8_LDA(At, 0, 0); PG8_STAGE(PG8_SA(1, 1), a1 + hstepA, voffA);
            PG8_WAIT_L(8); PG8_BAR; PG8_WAIT_L(0); PG8_MMA(0, 0, At, B0); PG8_BAR; PG8_SCHED;
            PG8_LDB(B1, 0, 1); PG8_STAGE(PG8_SB(0, 0), b2, voffB);
            PG8_BAR; PG8_WAIT_L(0); PG8_MMA(0, 1, At, B1); PG8_BAR;
            PG8_LDA(At, 0, 1); PG8_STAGE(PG8_SA(0, 0), a2, voffA);
            PG8_BAR; PG8_WAIT_L(0); PG8_MMA(1, 0, At, B0); PG8_BAR; PG8_SCHED;
            PG8_STAGE(PG8_SB(0, 1), b2 + hstepB, voffB);
            PG8_WAIT_V(6); PG8_BAR; PG8_MMA(1, 1, At, B1); PG8_BAR;
            PG8_LDB(B0, 1, 0); PG8_SCHED; PG8_LDA(At, 1, 0); PG8_STAGE(PG8_SA(0, 1), a2 + hstepA, voffA);
            PG8_WAIT_L(8); PG8_BAR; PG8_WAIT_L(0); PG8_MMA(0, 0, At, B0); PG8_BAR; PG8_SCHED;
            PG8_LDB(B1, 1, 1); PG8_STAGE(PG8_SB(1, 0), b3, voffB);
            PG8_BAR; PG8_WAIT_L(0); PG8_MMA(0, 1, At, B1); PG8_BAR;
            PG8_LDA(At, 1, 1); PG8_STAGE(PG8_SA(1, 0), a3, voffA);
            PG8_BAR; PG8_WAIT_L(0); PG8_MMA(1, 0, At, B0); PG8_BAR; PG8_SCHED;
            PG8_STAGE(PG8_SB(1, 1), b3 + hstepB, voffB);
            PG8_WAIT_V(6); PG8_BAR; PG8_MMA(1, 1, At, B1); PG8_BAR;
        }
        epilogue<MODE>(g, acc, cur, wr, wc, fr, fq, lds + GEMM_LDS + 1024);
        if (!has_next) break;
#pragma unroll
        for (int a = 0; a < 2; ++a)
#pragma unroll
            for (int b = 0; b < 2; ++b)
#pragma unroll
                for (int m = 0; m < 4; ++m)
#pragma unroll
                    for (int n = 0; n < 2; ++n) acc[a][b][m][n] = (f32x4){0.f, 0.f, 0.f, 0.f};
        cur = nxt; cA = nA; cB = nB; ++ui;
    }
    PG8_WAIT_V(0);
    if (wr == 0) PG8_BAR;
    PG8_BAR;
#undef PG8_SA
#undef PG8_SB
#undef PG8_STAGE
#undef PG8_LDA
#undef PG8_LDB
#undef PG8_MMA
#undef PG8_WAIT_V
#undef PG8_WAIT_L
#undef PG8_BAR
#undef PG8_SCHED
#undef PG8_ABASE
#undef PG8_BBASE
}
}

__device__ __forceinline__ void p0_transpose_item(const float* W, int ldw, int K, int csrc0, bf16_t* WT, int row0, LAS float* scr, int kb, int lane, float wscale, const float* kgain) {
    const int k0 = 64 * kb;
#pragma unroll
    for (int i = 0; i < 8; ++i) { const int kk = 8 * i + (lane >> 3), n4 = (lane & 7) * 4;
        const float4 v = *(const float4*)(W + (size_t)(k0 + kk) * ldw + csrc0 + n4);
        const float ws = kgain ? kgain[k0 + kk] : wscale; (void)wscale;
        scr[kk * 33 + n4] = v.x * ws; scr[kk * 33 + n4 + 1] = v.y * ws; scr[kk * 33 + n4 + 2] = v.z * ws; scr[kk * 33 + n4 + 3] = v.w * ws; }
    asm volatile("s_waitcnt lgkmcnt(0)" ::: "memory");
    const int c = lane & 7;
#pragma unroll
    for (int j = 0; j < 4; ++j) { const int n = (lane >> 3) + 8 * j; const LAS float* s = scr + (8 * c) * 33 + n;
        uint4 o; o.x = pk2(s[0 * 33], s[1 * 33]); o.y = pk2(s[2 * 33], s[3 * 33]); o.z = pk2(s[4 * 33], s[5 * 33]); o.w = pk2(s[6 * 33], s[7 * 33]);
        *(uint4*)(WT + (size_t)(row0 + n) * K + k0 + 8 * c) = o; }
    asm volatile("s_waitcnt lgkmcnt(0)" ::: "memory");
}

__device__ __forceinline__ void d_conv_silu(int vb, int tid, const bf16_t* __restrict__ p6, const float* __restrict__ cw, const float* __restrict__ cb, bf16_t* __restrict__ c) {
    const int t = vb, s = t % S;
    for (int ch = tid; ch < 1024; ch += 256) {
        float y = cb[ch];
#pragma unroll
        for (int j = 0; j < 4; ++j) {
            const int ss = s - 3 + j;
            if (ss >= 0) y = fmaf(cw[j * 1024 + ch], bf2f(p6[(size_t)(t - 3 + j) * 1024 + ch]), y);
        }
        c[(size_t)t * 1024 + ch] = (bf16_t)f2bf(y / (1.0f + expf(-y)));
    }
}

__device__ __forceinline__ void d_mlstm(int vb, int tid, const bf16_t* __restrict__ mq, const bf16_t* __restrict__ mk, const bf16_t* __restrict__ p6,
                                        const float* __restrict__ gpre, const float* __restrict__ b_mi, const float* __restrict__ b_mf, float* __restrict__ hraw) {
    const int lane = tid & 63, w = tid >> 6;
    const int gid = vb * 4 + w;
    const int e = gid & 255, h = (gid >> 8) & 3, b = gid >> 10;
    const float bi = b_mi[h], bf = b_mf[h];
    float C0 = 0.f, C1 = 0.f, C2 = 0.f, C3 = 0.f, n0 = 0.f, n1 = 0.f, n2 = 0.f, n3 = 0.f, m = 0.f;
    const size_t tb = (size_t)b * S;
    const bf16_t* qp = mq + tb * 1024 + h * 256 + lane * 4;
    const bf16_t* kp = mk + tb * 1024 + h * 256 + lane * 4;
    const bf16_t* pp = p6 + P6S + tb * 1024 + h * 256 + e;
    ushort4 qn = *(const ushort4*)qp, kn = *(const ushort4*)kp;
    const float* gp = gpre + tb * 8;
    float vn = bf2f(pp[0]), in_ = gp[h], fn = gp[4 + h];
    for (int s = 0; s < S; ++s) {
        const float4 q = make_float4(bf2f(qn.x), bf2f(qn.y), bf2f(qn.z), bf2f(qn.w)), k = make_float4(bf2f(kn.x), bf2f(kn.y), bf2f(kn.z), bf2f(kn.w)); const float v = vn, ipre = in_ + bi, fpre = fn + bf;
        if (s + 1 < S) {
            qn = *(const ushort4*)(qp + (size_t)(s + 1) * 1024);
            kn = *(const ushort4*)(kp + (size_t)(s + 1) * 1024);
            vn = bf2f(pp[(size_t)(s + 1) * 1024]); in_ = gp[(size_t)(s + 1) * 8 + h]; fn = gp[(size_t)(s + 1) * 8 + 4 + h];
        }
        const float logf = log_sigmoid(fpre);
        const float mnew = fmaxf(logf + m, ipre);
        const float fd = expf(logf + m - mnew), ig = expf(ipre - mnew);
        m = mnew;
        const float sc = ig * 0.0625f;
        C0 = fd * C0 + sc * k.x * v; C1 = fd * C1 + sc * k.y * v; C2 = fd * C2 + sc * k.z * v; C3 = fd * C3 + sc * k.w * v;
        n0 = fd * n0 + sc * k.x; n1 = fd * n1 + sc * k.y; n2 = fd * n2 + sc * k.z; n3 = fd * n3 + sc * k.w;
        float num = q.x * C0 + q.y * C1 + q.z * C2 + q.w * C3;
        float den = q.x * n0 + q.y * n1 + q.z * n2 + q.w * n3;
        num = wave_sum(num); den = wave_sum(den);
        if (lane == 0) hraw[(tb + s) * 1024 + h * 256 + e] = num / fmaxf(fabsf(den), expf(-mnew));
    }
}

__device__ __forceinline__ void d_mhead_norm(int vb, int tid, const float* __restrict__ hraw, const bf16_t* __restrict__ p6, const float* __restrict__ g, bf16_t* __restrict__ mix) {
    const int t = vb, h = tid >> 6, lane = tid & 63;
    const float4 v = *(const float4*)(hraw + (size_t)t * 1024 + h * 256 + lane * 4);
    float s = v.x * v.x + v.y * v.y + v.z * v.z + v.w * v.w;
    s = wave_sum(s);
    const float r = rsqrtf(s * (1.0f / 256.0f) + EPS);
    const float4 gg = *(const float4*)(g + h * 256 + lane * 4);
    const ushort4 mo = *(const ushort4*)(p6 + 2 * P6S + (size_t)t * 1024 + h * 256 + lane * 4);
    float4 o;
    o.x = v.x * r * gg.x / (1.0f + expf(-bf2f(mo.x)));
    o.y = v.y * r * gg.y / (1.0f + expf(-bf2f(mo.y)));
    o.z = v.z * r * gg.z / (1.0f + expf(-bf2f(mo.z)));
    o.w = v.w * r * gg.w / (1.0f + expf(-bf2f(mo.w)));
    uint2 ob; ob.x = pk2(o.x, o.y); ob.y = pk2(o.z, o.w);
    *(uint2*)(mix + (size_t)t * D + h * 256 + lane * 4) = ob;
}

__device__ __forceinline__ void d_rope(int vb, int tid, bf16_t* __restrict__ p6) {
    const int t = vb, s = t % S;
    for (int idx = tid; idx < 2 * 8 * 64; idx += 256) {
        const int i = idx & 63, hd = (idx >> 6) & 7, qk = idx >> 9;
        const float inv = exp2f(-(float)i * 0.20762050593046014f);
        const float ang = (float)s * inv;
        float sn, cs; sincosf(ang, &sn, &cs);
        bf16_t* p = p6 + (size_t)(3 + qk) * P6S + (size_t)t * 1024 + hd * 128;
        const float x1 = bf2f(p[i]), x2 = bf2f(p[64 + i]);
        p[i] = (bf16_t)f2bf(x1 * cs - x2 * sn);
        p[64 + i] = (bf16_t)f2bf(x2 * cs + x1 * sn);
    }
}

__device__ __forceinline__ void d_dilated(int vb, int tid, float* sm, const bf16_t* __restrict__ p6, const float* __restrict__ g_ahead, bf16_t* __restrict__ mix) {
    float (*qs)[128] = (float (*)[128])sm;
    float (*ps)[576] = (float (*)[576])(sm + 512);
    const int lane = tid & 63, w = tid >> 6;
    const int gid = vb * 4 + w;
    const int s = gid % S, hd = (gid / S) & 7, b = gid / (S * 8);
    const size_t t = (size_t)b * S + s;
    const bf16_t* qrow = p6 + 3 * P6S + t * 1024 + hd * 128;
    __syncthreads();
    qs[w][lane] = bf2f(qrow[lane]); qs[w][lane + 64] = bf2f(qrow[lane + 64]);
    __syncthreads();
    const float scale = 0.08838834764831845f;
    float mloc = -INFINITY;
    for (int br = 0; br < 3; ++br) {
        const int dil = br == 0 ? 1 : (br == 1 ? 4 : 16);
        for (int jj = 0; jj < 192; jj += 64) {
            const int j = jj + lane;
            float sc = -INFINITY;
            if (j <= 128 && s - j * dil >= 0) {
                const bf16_t* krow = p6 + 4 * P6S + (t - (size_t)j * dil) * 1024 + hd * 128;
                float d = 0.f;
#pragma unroll 8
                for (int c = 0; c < 128; c += 4) {
                    const ushort4 kv = *(const ushort4*)(krow + c);
                    d = fmaf(qs[w][c], bf2f(kv.x), d); d = fmaf(qs[w][c + 1], bf2f(kv.y), d); d = fmaf(qs[w][c + 2], bf2f(kv.z), d); d = fmaf(qs[w][c + 3], bf2f(kv.w), d);
                }
                sc = d * scale;
            }
            ps[w][br * 192 + j] = sc;
            mloc = fmaxf(mloc, sc);
        }
    }
    const float mx = wave_max(mloc);
    __syncthreads();
    float lsum = 0.f;
    for (int i = lane; i < 3 * 192; i += 64) {
        const float sc = ps[w][i];
        const float pv = (sc == -INFINITY) ? 0.f : expf(sc - mx);
        ps[w][i] = pv; lsum += pv;
    }
    const float tot = wave_sum(lsum);
    __syncthreads();
    float o0 = 0.f, o1 = 0.f;
    for (int br = 0; br < 3; ++br) {
        const int dil = br == 0 ? 1 : (br == 1 ? 4 : 16);
        for (int j = 0; j <= 128; ++j) {
            if (s - j * dil < 0) break;
            const float pv = ps[w][br * 192 + j];
            const bf16_t* vrow = p6 + 5 * P6S + (t - (size_t)j * dil) * 1024 + hd * 128;
            o0 = fmaf(pv, bf2f(vrow[lane]), o0); o1 = fmaf(pv, bf2f(vrow[lane + 64]), o1);
        }
    }
    o0 /= tot; o1 /= tot;
    float ss = wave_sum(o0 * o0 + o1 * o1);
    const float r = rsqrtf(ss * (1.0f / 128.0f) + EPS);
    bf16_t* orow = mix + t * D + 1024 + hd * 128;
    orow[lane] = (bf16_t)f2bf(o0 * r * g_ahead[hd * 128 + lane]);
    orow[lane + 64] = (bf16_t)f2bf(o1 * r * g_ahead[hd * 128 + lane + 64]);
}

__device__ __forceinline__ void d_cross(int vb, int tid, float* sm, const bf16_t* __restrict__ q, const float* __restrict__ km, const float* __restrict__ vm, bf16_t* __restrict__ o) {
    float (*qs)[512] = (float (*)[512])sm;
    float (*ps)[256] = (float (*)[256])(sm + 2048);
    const int lane = tid & 63, w = tid >> 6;
    const int t = vb, hd = w, b = t / S;
    const bf16_t* qrow = q + (size_t)t * D + hd * 512;
    __syncthreads();
    for (int i = lane; i < 512; i += 64) qs[w][i] = bf2f(qrow[i]);
    __syncthreads();
    const float scale = 0.04419417382415922f;
    float sc[4]; float mloc = -INFINITY;
#pragma unroll
    for (int r = 0; r < 4; ++r) {
        const int mi = lane + 64 * r;
        const float* krow = km + ((size_t)b * 256 + mi) * D + hd * 512;
        float d = 0.f;
#pragma unroll 8
        for (int c = 0; c < 512; c += 4) {
            const float4 kv = *(const float4*)(krow + c);
            d = fmaf(qs[w][c], kv.x, d); d = fmaf(qs[w][c + 1], kv.y, d); d = fmaf(qs[w][c + 2], kv.z, d); d = fmaf(qs[w][c + 3], kv.w, d);
        }
        sc[r] = d * scale; mloc = fmaxf(mloc, sc[r]);
    }
    const float mx = wave_max(mloc);
    float lsum = 0.f;
#pragma unroll
    for (int r = 0; r < 4; ++r) { const float pv = expf(sc[r] - mx); ps[w][lane + 64 * r] = pv; lsum += pv; }
    const float tot = wave_sum(lsum);
    __syncthreads();
    float acc[8];
#pragma unroll
    for (int i = 0; i < 8; ++i) acc[i] = 0.f;
    for (int mi = 0; mi < 256; ++mi) {
        const float pv = ps[w][mi];
        const float* vrow = vm + ((size_t)b * 256 + mi) * D + hd * 512;
#pragma unroll
        for (int i = 0; i < 8; ++i) acc[i] = fmaf(pv, vrow[lane + 64 * i], acc[i]);
    }
    bf16_t* orow = o + (size_t)t * D + hd * 512;
#pragma unroll
    for (int i = 0; i < 8; ++i) orow[lane + 64 * i] = (bf16_t)f2bf(acc[i] / tot);
}

__device__ __forceinline__ void wave_argmax(float& best, int& bidx) {
#pragma unroll
    for (int o = 32; o >= 1; o >>= 1) {
        const float ob = __shfl_xor(best, o); const int oi = __shfl_xor(bidx, o);
        if (ob > best || (ob == best && oi < bidx)) { best = ob; bidx = oi; }
    }
}
__device__ __forceinline__ void d_peer_topk(int vb, int tid, float* sm, const bf16_t* __restrict__ qp, const float* __restrict__ sub_keys, int* __restrict__ ids, float* __restrict__ gates) {
    float (*qs)[256] = (float (*)[256])sm;
    const int lane = tid & 63, w = tid >> 6;
    const int gid = vb * 4 + w;
    const int hd = gid & 7, t = gid >> 3;
    const bf16_t* qrow = qp + (size_t)t * D + hd * 256;
    __syncthreads();
    for (int i = lane; i < 256; i += 64) qs[w][i] = bf2f(qrow[i]);
    __syncthreads();
    float tops[2]; int topi[2];
#pragma unroll
    for (int p = 0; p < 2; ++p) {
        float v0, v1;
        {
            const float* k0 = sub_keys + ((size_t)(hd * 2 + p) * 128 + lane) * 128;
            const float* k1 = k0 + 64 * 128;
            float d0 = 0.f, d1 = 0.f;
#pragma unroll 8
            for (int c = 0; c < 128; c += 4) {
                const float4 a = *(const float4*)(k0 + c), bb = *(const float4*)(k1 + c);
                const float q0 = qs[w][p * 128 + c], q1 = qs[w][p * 128 + c + 1], q2 = qs[w][p * 128 + c + 2], q3 = qs[w][p * 128 + c + 3];
                d0 = fmaf(q0, a.x, d0); d0 = fmaf(q1, a.y, d0); d0 = fmaf(q2, a.z, d0); d0 = fmaf(q3, a.w, d0);
                d1 = fmaf(q0, bb.x, d1); d1 = fmaf(q1, bb.y, d1); d1 = fmaf(q2, bb.z, d1); d1 = fmaf(q3, bb.w, d1);
            }
            v0 = d0; v1 = d1;
        }
        float ts = 0.f; int ti = 0;
        for (int it = 0; it < 16; ++it) {
            float best; int bidx;
            if (v0 >= v1) { best = v0; bidx = lane; } else { best = v1; bidx = lane + 64; }
            wave_argmax(best, bidx);
            if (lane == it) { ts = best; ti = bidx; }
            if (bidx == lane) v0 = -INFINITY;
            if (bidx == lane + 64) v1 = -INFINITY;
        }
        tops[p] = ts; topi[p] = ti;
    }
    float cv[4]; int ci[4];
#pragma unroll
    for (int r = 0; r < 4; ++r) {
        const int c = lane * 4 + r, i = c >> 4, j = c & 15;
        const float s0 = __shfl(tops[0], i), s1 = __shfl(tops[1], j);
        const int i0 = __shfl(topi[0], i), i1 = __shfl(topi[1], j);
        cv[r] = s0 + s1; ci[r] = i0 * 128 + i1;
    }
    float bs = 0.f; int bid = 0;
    for (int it = 0; it < 16; ++it) {
        float best = cv[0]; int bidx = lane * 4;
#pragma unroll
        for (int r = 1; r < 4; ++r) if (cv[r] > best) { best = cv[r]; bidx = lane * 4 + r; }
        wave_argmax(best, bidx);
        const int owner = bidx >> 2, rr = bidx & 3;
        int myid = ci[0];
        if (rr == 1) myid = ci[1]; else if (rr == 2) myid = ci[2]; else if (rr == 3) myid = ci[3];
        const int eid = __shfl(myid, owner);
        if (lane == it) { bs = best; bid = eid; }
        if (owner == lane) {
#pragma unroll
            for (int r = 0; r < 4; ++r) if (rr == r) cv[r] = -INFINITY;
        }
    }
    float v = lane < 16 ? bs : -INFINITY;
    const float mx = wave_max(v);
    const float ev = lane < 16 ? expf(bs - mx) : 0.f;
    const float tot = wave_sum(ev);
    if (lane < 16) {
        ids[(size_t)t * 128 + hd * 16 + lane] = bid;
        gates[(size_t)t * 128 + hd * 16 + lane] = ev / tot;
    }
}

__device__ __forceinline__ void d_peer_out(int vb, int tid, float* sm, const bf16_t* __restrict__ h3, const float* __restrict__ x2, const int* __restrict__ ids, const float* __restrict__ gates,
                                           const bf16_t* __restrict__ u_tab, const bf16_t* __restrict__ v_tab, const float* __restrict__ g_final, float* __restrict__ out) {
    float (*part)[2048] = (float (*)[2048])sm;
    float* red = sm + 4 * 2048;
    const int lane = tid & 63, w = tid >> 6, t = vb;
    float4 xr[8], acc[8];
    const bf16_t* hrow = h3 + (size_t)t * D;
#pragma unroll
    for (int i = 0; i < 8; ++i) { const ushort4 hv = *(const ushort4*)(hrow + i * 256 + lane * 4);
        xr[i] = make_float4(bf2f(hv.x), bf2f(hv.y), bf2f(hv.z), bf2f(hv.w)); acc[i] = make_float4(0.f, 0.f, 0.f, 0.f); }
    for (int j = 0; j < 32; ++j) {
        const int slot = w * 32 + j;
        const int e = ids[(size_t)t * 128 + slot];
        const float gt = gates[(size_t)t * 128 + slot];
        const bf16_t* ur = u_tab + (size_t)e * D;
        const bf16_t* vr = v_tab + (size_t)e * D;
        float d = 0.f;
#pragma unroll
        for (int i = 0; i < 8; ++i) {
            const ushort4 u = *(const ushort4*)(ur + i * 256 + lane * 4);
            d = fmaf(xr[i].x, bf2f(u.x), d); d = fmaf(xr[i].y, bf2f(u.y), d); d = fmaf(xr[i].z, bf2f(u.z), d); d = fmaf(xr[i].w, bf2f(u.w), d);
        }
        d = wave_sum(d);
        const float act = 0.5f * d * (1.0f + erff(d * 0.7071067811865476f));
        const float cf = gt * act;
#pragma unroll
        for (int i = 0; i < 8; ++i) {
            const ushort4 v = *(const ushort4*)(vr + i * 256 + lane * 4);
            acc[i].x = fmaf(cf, bf2f(v.x), acc[i].x); acc[i].y = fmaf(cf, bf2f(v.y), acc[i].y); acc[i].z = fmaf(cf, bf2f(v.z), acc[i].z); acc[i].w = fmaf(cf, bf2f(v.w), acc[i].w);
        }
    }
    __syncthreads();
#pragma unroll
    for (int i = 0; i < 8; ++i) *(float4*)&part[w][i * 256 + lane * 4] = acc[i];
    __syncthreads();
    float4 r0, r1;
    {
        const float4 a = *(const float4*)&part[0][tid * 4], b = *(const float4*)&part[1][tid * 4], c = *(const float4*)&part[2][tid * 4], d = *(const float4*)&part[3][tid * 4];
        const float4 x = *(const float4*)(x2 + (size_t)t * D + tid * 4);
        r0 = make_float4(x.x + a.x + b.x + c.x + d.x, x.y + a.y + b.y + c.y + d.y, x.z + a.z + b.z + c.z + d.z, x.w + a.w + b.w + c.w + d.w);
    }
    {
        const float4 a = *(const float4*)&part[0][1024 + tid * 4], b = *(const float4*)&part[1][1024 + tid * 4], c = *(const float4*)&part[2][1024 + tid * 4], d = *(const float4*)&part[3][1024 + tid * 4];
        const float4 x = *(const float4*)(x2 + (size_t)t * D + 1024 + tid * 4);
        r1 = make_float4(x.x + a.x + b.x + c.x + d.x, x.y + a.y + b.y + c.y + d.y, x.z + a.z + b.z + c.z + d.z, x.w + a.w + b.w + c.w + d.w);
    }
    float s = r0.x * r0.x + r0.y * r0.y + r0.z * r0.z + r0.w * r0.w + r1.x * r1.x + r1.y * r1.y + r1.z * r1.z + r1.w * r1.w;
    s = wave_sum(s);
    if (lane == 0) red[w] = s;
    __syncthreads();
    const float tot = red[0] + red[1] + red[2] + red[3];
    const float r = rsqrtf(tot * (1.0f / D) + EPS);
    const float4 g0 = *(const float4*)(g_final + tid * 4), g1 = *(const float4*)(g_final + 1024 + tid * 4);
    *(float4*)(out + (size_t)t * D + tid * 4) = make_float4(r0.x * r * g0.x, r0.y * r * g0.y, r0.z * r * g0.z, r0.w * r * g0.w);
    *(float4*)(out + (size_t)t * D + 1024 + tid * 4) = make_float4(r1.x * r * g1.x, r1.y * r * g1.y, r1.z * r * g1.z, r1.w * r * g1.w);
}


__device__ __forceinline__ float wave_sum_dpp(float v);
__device__ __forceinline__ void rmsnorm_row_wave(int row, int lane, const float* __restrict__ in, const float* __restrict__ g, bf16_t* __restrict__ out, const float* gwT, float* __restrict__ gpre) {
    float4 x[8];
    const float* p = in + (size_t)row * D + lane * 4;
#pragma unroll
    for (int i = 0; i < 8; ++i) x[i] = *(const float4*)(p + i * 256);
    float s = 0.f;
#pragma unroll
    for (int i = 0; i < 8; ++i) s += (x[i].x * x[i].x + x[i].y * x[i].y) + (x[i].z * x[i].z + x[i].w * x[i].w);
    s = wave_sum_dpp(s);
    const float r = rsqrtf(s * (1.0f / D) + EPS);
    bf16_t* o = out + (size_t)row * D + lane * 4;
#pragma unroll
    for (int i = 0; i < 8; ++i) {
        const float4 gv = *(const float4*)(g + i * 256 + lane * 4);
        x[i].x *= r * gv.x; x[i].y *= r * gv.y; x[i].z *= r * gv.z; x[i].w *= r * gv.w;
        uint2 w; w.x = pk2(x[i].x, x[i].y); w.y = pk2(x[i].z, x[i].w);
        *(uint2*)(o + i * 256) = w;
    }
    if (gpre) {
#pragma unroll 1
        for (int c = 0; c < 8; c += 2) {
            float a0 = 0.f, a1 = 0.f;
#pragma unroll
            for (int i = 0; i < 8; ++i) {
                const float4 w0 = *(const float4*)(gwT + c * 2048 + i * 256 + lane * 4), w1 = *(const float4*)(gwT + (c + 1) * 2048 + i * 256 + lane * 4);
                a0 = fmaf(x[i].x, w0.x, a0); a0 = fmaf(x[i].y, w0.y, a0); a0 = fmaf(x[i].z, w0.z, a0); a0 = fmaf(x[i].w, w0.w, a0);
                a1 = fmaf(x[i].x, w1.x, a1); a1 = fmaf(x[i].y, w1.y, a1); a1 = fmaf(x[i].z, w1.z, a1); a1 = fmaf(x[i].w, w1.w, a1);
            }
            const float t0_ = wave_sum_dpp(a0), t1_ = wave_sum_dpp(a1);
            if (lane == 0) { gpre[(size_t)row * 8 + c] = t0_; gpre[(size_t)row * 8 + c + 1] = t1_; }
        }
    }
}

__device__ __forceinline__ float wave_incl_scan_add(float v, int lane) {
#pragma unroll
    for (int o = 1; o < 64; o <<= 1) { const float t = __shfl_up(v, o); if (lane >= o) v += t; }
    return v;
}
__device__ __forceinline__ float wave_incl_scan_max(float v, int lane) {
#pragma unroll
    for (int o = 1; o < 64; o <<= 1) { const float t = __shfl_up(v, o); if (lane >= o) v = fmaxf(v, t); }
    return v;
}
__device__ __forceinline__ void mlstm_gates_wave(int b, int h, int lane, const float* __restrict__ gpre, const float* __restrict__ b_mi, const float* __restrict__ b_mf,
                                                 float* __restrict__ gs, float* __restrict__ decay) {
    const float bi = b_mi[h], bf = b_mf[h];
    float mprev = 0.f;
    float gi_n[4], gf_n[4];
#pragma unroll
    for (int j = 0; j < 4; ++j) { const size_t t = (size_t)b * S + lane * 4 + j; gi_n[j] = gpre[t * 8 + h]; gf_n[j] = gpre[t * 8 + 4 + h]; }
#pragma unroll 1
    for (int c = 0; c < 16; ++c) {
        const size_t t0 = (size_t)b * S + c * 256 + lane * 4;
        float logi[4], lf[4], bb[4], gf_c[4];
#pragma unroll
        for (int j = 0; j < 4; ++j) { logi[j] = gi_n[j] + bi; gf_c[j] = gf_n[j]; }
        if (c < 15) {
#pragma unroll
            for (int j = 0; j < 4; ++j) { gi_n[j] = gpre[(t0 + 256 + j) * 8 + h]; gf_n[j] = gpre[(t0 + 256 + j) * 8 + 4 + h]; }
        }
#pragma unroll
        for (int j = 0; j < 4; ++j) lf[j] = log_sigmoid(gf_c[j] + bf);
        bb[0] = lf[0]; bb[1] = bb[0] + lf[1]; bb[2] = bb[1] + lf[2]; bb[3] = bb[2] + lf[3];
        const float incl = wave_incl_scan_add(bb[3], lane);
        const float excl = incl - bb[3];
#pragma unroll
        for (int j = 0; j < 4; ++j) bb[j] += excl;
        const float g = __shfl(incl, 63);
        float amax = -INFINITY, uu[4], cm[4];
#pragma unroll
        for (int j = 0; j < 4; ++j) { amax = fmaxf(amax, logi[j] + g - bb[j]); uu[j] = logi[j] - bb[j]; }
        amax = wave_max(amax);
        const float mnew = fmaxf(g + mprev, amax);
        cm[0] = uu[0]; cm[1] = fmaxf(cm[0], uu[1]); cm[2] = fmaxf(cm[1], uu[2]); cm[3] = fmaxf(cm[2], uu[3]);
        const float cincl = wave_incl_scan_max(cm[3], lane);
        float cexcl = __shfl_up(cincl, 1); if (lane == 0) cexcl = -INFINITY;
#pragma unroll
        for (int j = 0; j < 4; ++j) {
            const float M = fmaxf(mprev, fmaxf(cexcl, cm[j]));
            float* o = gs + ((t0 + j) * 4 + h) * 8;
            o[0] = uu[j] * 1.4426950408889634f; o[1] = M * 1.4426950408889634f; o[2] = expf(logi[j] + g - bb[j] - mnew); o[3] = expf(mprev - M); o[4] = expf(-(bb[j] + M));
        }
        if (lane == 0) decay[(b * 16 + c) * 4 + h] = expf(g + mprev - mnew);
        mprev = mnew;
    }
}
__device__ __forceinline__ void transpose_tile64(int tid, float* sm, const bf16_t* __restrict__ src, int src_ld, bf16_t* __restrict__ dst, int dst_ld, const float* __restrict__ scale, int sstride) {
    unsigned short (*tl)[66] = (unsigned short (*)[66])sm;
    __syncthreads();
#pragma unroll
    for (int i = 0; i < 2; ++i) {
        const int ch = tid + i * 256, r = ch >> 3, c8 = (ch & 7) * 8;
        const uint4 v = *(const uint4*)(src + (size_t)r * src_ld + c8);
        const float sc = scale ? scale[(size_t)r * sstride] : 1.0f;
        const unsigned w[4] = {v.x, v.y, v.z, v.w};
#pragma unroll
        for (int k = 0; k < 4; ++k) {
            tl[r][c8 + 2 * k] = (unsigned short)f2bf(bf2f((unsigned short)(w[k] & 0xFFFFu)) * sc);
            tl[r][c8 + 2 * k + 1] = (unsigned short)f2bf(bf2f((unsigned short)(w[k] >> 16)) * sc);
        }
    }
    __syncthreads();
#pragma unroll
    for (int i = 0; i < 2; ++i) {
        const int ch = tid + i * 256, c = ch >> 3, r8 = (ch & 7) * 8;
        uint4 o;
        o.x = (unsigned)tl[r8 + 0][c] | ((unsigned)tl[r8 + 1][c] << 16); o.y = (unsigned)tl[r8 + 2][c] | ((unsigned)tl[r8 + 3][c] << 16);
        o.z = (unsigned)tl[r8 + 4][c] | ((unsigned)tl[r8 + 5][c] << 16); o.w = (unsigned)tl[r8 + 6][c] | ((unsigned)tl[r8 + 7][c] << 16);
        *(uint4*)(dst + (size_t)c * dst_ld + r8) = o;
    }
}

__device__ __forceinline__ void rope_table_fill(float2* __restrict__ cs, int gtid, int nth) {
    for (int idx = gtid; idx < 4096 * 64; idx += nth) {
        const int i = idx & 63, s = idx >> 6;
        const float inv = exp2f(-(float)i * 0.20762050593046014f);
        const float ang = (float)s * inv;
        float sn, c; sincosf(ang, &sn, &c);
        cs[idx] = make_float2(c, sn);
    }
}
__device__ __forceinline__ void rope_q_pass(bf16_t* __restrict__ aq, const float2* __restrict__ cs, size_t gtid, size_t nth) {
    for (size_t idx = gtid; idx < (size_t)T * 8 * 8; idx += nth) {
        const int c8 = (int)(idx & 7), hd = (int)((idx >> 3) & 7); const size_t t = idx >> 6; const int s = (int)(t & (S - 1));
        bf16_t* p = aq + t * 1024 + hd * 128 + c8 * 8;
        const uint4 a = *(const uint4*)p, b = *(const uint4*)(p + 64);
        const unsigned aw[4] = {a.x, a.y, a.z, a.w}, bw[4] = {b.x, b.y, b.z, b.w};
        unsigned ao[4], bo[4];
#pragma unroll
        for (int k = 0; k < 4; ++k) {
            const float4 cc = *(const float4*)(cs + (size_t)s * 64 + c8 * 8 + 2 * k);
            const float x10 = __uint_as_float(aw[k] << 16), x11 = __uint_as_float(aw[k] & 0xFFFF0000u), x20 = __uint_as_float(bw[k] << 16), x21 = __uint_as_float(bw[k] & 0xFFFF0000u);
            ao[k] = pk2(x10 * cc.x - x20 * cc.y, x11 * cc.z - x21 * cc.w);
            bo[k] = pk2(x20 * cc.x + x10 * cc.y, x21 * cc.z + x11 * cc.w);
        }
        *(uint4*)p = make_uint4(ao[0], ao[1], ao[2], ao[3]); *(uint4*)(p + 64) = make_uint4(bo[0], bo[1], bo[2], bo[3]);
    }
}
__device__ __forceinline__ void dil_tile_prep(int item, int lane, LAS unsigned short* wl, const bf16_t* __restrict__ ak, const bf16_t* __restrict__ av, const float2* __restrict__ cs,
                                              bf16_t* __restrict__ KB, bf16_t* __restrict__ VB) {
    const int TT = item & 255, hd = (item >> 8) & 7, b = (item >> 11) & 1, br = item >> 12;
    const int ld = 2 * br, tpr = 256 >> ld, rho = TT / tpr, tile = TT - rho * tpr;
    const int i = lane & 15, c = lane >> 4;
    const int s = rho + ((16 * tile + i) << ld);
    const size_t trow = (size_t)b * S + s;
    bf16_t* kdst = KB + (size_t)item * 2048;
    bf16_t* vdst = VB + (size_t)item * 2048;
    {
        const bf16_t* kr = ak + trow * 1024 + hd * 128 + 16 * c;
        const uint4 a0 = *(const uint4*)kr, a1 = *(const uint4*)(kr + 8), b0 = *(const uint4*)(kr + 64), b1 = *(const uint4*)(kr + 72);
        const unsigned aw[8] = {a0.x, a0.y, a0.z, a0.w, a1.x, a1.y, a1.z, a1.w}, bw[8] = {b0.x, b0.y, b0.z, b0.w, b1.x, b1.y, b1.z, b1.w};
        unsigned ao[8], bo[8];
#pragma unroll
        for (int k = 0; k < 8; ++k) {
            const float4 cc = *(const float4*)(cs + (size_t)s * 64 + 16 * c + 2 * k);
            const float x10 = __uint_as_float(aw[k] << 16), x11 = __uint_as_float(aw[k] & 0xFFFF0000u), x20 = __uint_as_float(bw[k] << 16), x21 = __uint_as_float(bw[k] & 0xFFFF0000u);
            ao[k] = pk2(x10 * cc.x - x20 * cc.y, x11 * cc.z - x21 * cc.w);
            bo[k] = pk2(x20 * cc.x + x10 * cc.y, x21 * cc.z + x11 * cc.w);
        }
        bf16_t* d0 = kdst + (c >> 1) * 512 + i * 32 + (c & 1) * 16;
        *(uint4*)d0 = make_uint4(ao[0], ao[1], ao[2], ao[3]); *(uint4*)(d0 + 8) = make_uint4(ao[4], ao[5], ao[6], ao[7]);
        bf16_t* d1 = d0 + 1024;
        *(uint4*)d1 = make_uint4(bo[0], bo[1], bo[2], bo[3]); *(uint4*)(d1 + 8) = make_uint4(bo[4], bo[5], bo[6], bo[7]);
    }
    {
        const bf16_t* vr = av + trow * 1024 + hd * 128 + 32 * c;
        const uint4 v0 = *(const uint4*)vr, v1 = *(const uint4*)(vr + 8), v2 = *(const uint4*)(vr + 16), v3 = *(const uint4*)(vr + 24);
        LAS unsigned short* wr = wl + i * 136 + 32 * c;
        typedef unsigned u32x4_t __attribute__((ext_vector_type(4)));
        *(LAS u32x4_t*)wr = (u32x4_t){v0.x, v0.y, v0.z, v0.w}; *(LAS u32x4_t*)(wr + 8) = (u32x4_t){v1.x, v1.y, v1.z, v1.w};
        *(LAS u32x4_t*)(wr + 16) = (u32x4_t){v2.x, v2.y, v2.z, v2.w}; *(LAS u32x4_t*)(wr + 24) = (u32x4_t){v3.x, v3.y, v3.z, v3.w};
        asm volatile("s_waitcnt lgkmcnt(0)" ::: "memory");
        unsigned o[16];
#pragma unroll
        for (int k = 0; k < 8; ++k) {
            const unsigned p0 = *(const LAS unsigned*)(wl + (2 * k) * 136 + 2 * lane), p1 = *(const LAS unsigned*)(wl + (2 * k + 1) * 136 + 2 * lane);
            o[k] = (p0 & 0xFFFFu) | (p1 << 16);
            o[8 + k] = (p0 >> 16) | (p1 & 0xFFFF0000u);
        }
        bf16_t* d = vdst + (2 * lane) * 16;
        *(uint4*)d = make_uint4(o[0], o[1], o[2], o[3]); *(uint4*)(d + 8) = make_uint4(o[4], o[5], o[6], o[7]);
        *(uint4*)(d + 16) = make_uint4(o[8], o[9], o[10], o[11]); *(uint4*)(d + 24) = make_uint4(o[12], o[13], o[14], o[15]);
        asm volatile("s_waitcnt lgkmcnt(0)" ::: "memory");
    }
}

typedef short bf16x8_t __attribute__((ext_vector_type(8)));
typedef short bf16x4_t __attribute__((ext_vector_type(4)));
typedef float f32x4_t __attribute__((ext_vector_type(4)));
__device__ __forceinline__ float xg_max_f32(float v);
__device__ __forceinline__ float xg_sum_f32(float v);
__device__ __forceinline__ void dilated_wave_tile(int qt2, int lane, const bf16_t* __restrict__ AQ, const float2* __restrict__ cs, const bf16_t* __restrict__ KB, const bf16_t* __restrict__ VB,
                                                  const float* __restrict__ g_ahead, bf16_t* __restrict__ mix) {
    const int r = qt2 & 7, blk = (qt2 >> 3) & 15, hd = (qt2 >> 7) & 7, b = qt2 >> 10;
    const int j = lane & 15, g = lane >> 4;
    const int t0 = blk * 256;
    bf16x8_t qf[2][4];
#pragma unroll
    for (int qi = 0; qi < 2; ++qi) {
        const int sq = t0 + r + 8 * qi + 16 * j;
        const bf16_t* qrow = AQ + ((size_t)b * S + sq) * 1024 + hd * 128 + 8 * g;
        const float sc = 0.08838834764831845f * 1.4426950408889634f;
#pragma unroll
        for (int ks = 0; ks < 2; ++ks) {
            const bf16x8_t lo = *(const bf16x8_t*)(qrow + 32 * ks), hi = *(const bf16x8_t*)(qrow + 32 * ks + 64);
            bf16x8_t olo, ohi;
#pragma unroll
            for (int e2 = 0; e2 < 4; ++e2) {
                const float4 cc = *(const float4*)(cs + (size_t)sq * 64 + 32 * ks + 8 * g + 2 * e2);
                const float x10 = bf2f((unsigned short)lo[2 * e2]), x11 = bf2f((unsigned short)lo[2 * e2 + 1]), x20 = bf2f((unsigned short)hi[2 * e2]), x21 = bf2f((unsigned short)hi[2 * e2 + 1]);
                const unsigned wl_ = pk2((x10 * cc.x - x20 * cc.y) * sc, (x11 * cc.z - x21 * cc.w) * sc), wh_ = pk2((x20 * cc.x + x10 * cc.y) * sc, (x21 * cc.z + x11 * cc.w) * sc);
                olo[2 * e2] = (short)(wl_ & 0xFFFF); olo[2 * e2 + 1] = (short)(wl_ >> 16); ohi[2 * e2] = (short)(wh_ & 0xFFFF); ohi[2 * e2 + 1] = (short)(wh_ >> 16);
            }
            qf[qi][ks] = olo; qf[qi][ks + 2] = ohi;
        }
    }
    float m_run[2] = {-1e30f, -1e30f}, l_run[2] = {0.f, 0.f};
    f32x4_t o[2][8];
#pragma unroll
    for (int qi = 0; qi < 2; ++qi)
#pragma unroll
        for (int dt = 0; dt < 8; ++dt) o[qi][dt] = (f32x4_t){0.f, 0.f, 0.f, 0.f};
#define DIL_STEP(QI, QJ, TP, KF, VF) { \
        f32x4_t su[2]; \
        _Pragma("unroll") for (int u = 0; u < 2; ++u) { f32x4_t a = (f32x4_t){0.f, 0.f, 0.f, 0.f}; \
            _Pragma("unroll") for (int ks = 0; ks < 4; ++ks) a = __builtin_amdgcn_mfma_f32_16x16x32_bf16(KF[u][ks], qf[QI][ks], a, 0, 0, 0); su[u] = a; } \
        float p[2][4]; float mx = -1e30f; \
        _Pragma("unroll") for (int u = 0; u < 2; ++u) _Pragma("unroll") for (int e = 0; e < 4; ++e) { \
            const int n = (QJ) - (16 * ((TP) + u) + 4 * g + e); const bool valid = (n >= 0) && (n <= 128); \
            p[u][e] = valid ? su[u][e] : -1e30f; mx = fmaxf(mx, p[u][e]); } \
        mx = xg_max_f32(mx); \
        const float m_new = fmaxf(m_run[QI], mx); const float alpha = __builtin_amdgcn_exp2f(m_run[QI] - m_new); m_run[QI] = m_new; \
        float ps = 0.f; \
        _Pragma("unroll") for (int u = 0; u < 2; ++u) _Pragma("unroll") for (int e = 0; e < 4; ++e) { p[u][e] = (p[u][e] > -1e29f) ? __builtin_amdgcn_exp2f(p[u][e] - m_new) : 0.f; ps += p[u][e]; } \
        l_run[QI] = l_run[QI] * alpha + ps; \
        bf16x8_t pb; { const unsigned w0 = pk2(p[0][0], p[0][1]), w1 = pk2(p[0][2], p[0][3]), w2 = pk2(p[1][0], p[1][1]), w3 = pk2(p[1][2], p[1][3]); \
            pb[0] = (short)(w0 & 0xFFFF); pb[1] = (short)(w0 >> 16); pb[2] = (short)(w1 & 0xFFFF); pb[3] = (short)(w1 >> 16); \
            pb[4] = (short)(w2 & 0xFFFF); pb[5] = (short)(w2 >> 16); pb[6] = (short)(w3 & 0xFFFF); pb[7] = (short)(w3 >> 16); } \
        _Pragma("unroll") for (int dt = 0; dt < 8; ++dt) { const bf16x4_t v0 = VF[dt][0], v1 = VF[dt][1]; \
            bf16x8_t va; va[0] = v0[0]; va[1] = v0[1]; va[2] = v0[2]; va[3] = v0[3]; va[4] = v1[0]; va[5] = v1[1]; va[6] = v1[2]; va[7] = v1[3]; \
            f32x4_t oo = o[QI][dt]; oo = oo * alpha; o[QI][dt] = __builtin_amdgcn_mfma_f32_16x16x32_bf16(va, pb, oo, 0, 0, 0); } }
#define DIL_LOADK(KF, TL) _Pragma("unroll") for (int u = 0; u < 2; ++u) { int tl_ = (TL) + u; if (tl_ > tile_max) tl_ = tile_max; \
            _Pragma("unroll") for (int ks = 0; ks < 4; ++ks) KF[u][ks] = *(const bf16x8_t*)(kbb + (size_t)tl_ * 2048 + 512 * ks); }
#define DIL_LOADV(VF, TP) { int tl0 = (TP), tl1 = (TP) + 1; if (tl0 > tile_max) tl0 = tile_max; if (tl1 > tile_max) tl1 = tile_max; \
            _Pragma("unroll") for (int dt = 0; dt < 8; ++dt) { VF[dt][0] = *(const bf16x4_t*)(vbb + dt * 256 + (size_t)tl0 * 2048); VF[dt][1] = *(const bf16x4_t*)(vbb + dt * 256 + (size_t)tl1 * 2048); } }
#pragma nounroll
    for (int br = 0; br < 2; ++br) {
        const int ld = 2 * br, d = 1 << ld;
        const int rho = r & (d - 1);
        const int qj0 = (t0 + r + 16 * j - rho) >> ld, qj1 = (t0 + r + 8 + 16 * j - rho) >> ld;
        const int q_lo = ((t0 + r - rho) >> ld) - 128, q_hi = (t0 + r + 8 + 240 - rho) >> ld;
        const int tile_lo = q_lo < 0 ? 0 : (q_lo >> 4), tile_hi = q_hi >> 4, tile_max = (256 >> ld) - 1;
        const size_t tbase = ((size_t)((br * 2 + b) * 8 + hd) * 256 + (size_t)rho * (256 >> ld)) * 2048;
        const bf16_t* kbb = KB + tbase + j * 32 + 8 * g;
        const bf16_t* vbb = VB + tbase + j * 16 + 4 * g;
        bf16x8_t kf[2][4];
        DIL_LOADK(kf, tile_lo)
#pragma nounroll
        for (int tp = tile_lo; tp <= tile_hi; tp += 2) {
            bf16x4_t vf[8][2];
            DIL_LOADV(vf, tp)
            bf16x8_t kc[2][4];
#pragma unroll
            for (int u = 0; u < 2; ++u)
#pragma unroll
                for (int ks = 0; ks < 4; ++ks) kc[u][ks] = kf[u][ks];
            DIL_LOADK(kf, tp + 2)
            DIL_STEP(0, qj0, tp, kc, vf)
            DIL_STEP(1, qj1, tp, kc, vf)
        }
    }
#pragma unroll
    for (int qi = 0; qi < 2; ++qi) {
        const int rho = r + 8 * qi;
        const int qj = (t0 + 16 * j) >> 4;
        const int q_lo = (t0 >> 4) - 128, q_hi = (t0 + 240) >> 4;
        const int tile_lo = q_lo < 0 ? 0 : (q_lo >> 4), tile_hi = q_hi >> 4, tile_max = 15;
        const size_t tbase = ((size_t)((2 * 2 + b) * 8 + hd) * 256 + (size_t)rho * 16) * 2048;
        const bf16_t* kbb = KB + tbase + j * 32 + 8 * g;
        const bf16_t* vbb = VB + tbase + j * 16 + 4 * g;
        bf16x8_t kf[2][4];
        DIL_LOADK(kf, tile_lo)
#pragma nounroll
        for (int tp = tile_lo; tp <= tile_hi; tp += 2) {
            bf16x4_t vf[8][2];
            DIL_LOADV(vf, tp)
            bf16x8_t kc[2][4];
#pragma unroll
            for (int u = 0; u < 2; ++u)
#pragma unroll
                for (int ks = 0; ks < 4; ++ks) kc[u][ks] = kf[u][ks];
            DIL_LOADK(kf, tp + 2)
            if (qi == 0) { DIL_STEP(0, qj, tp, kc, vf) } else { DIL_STEP(1, qj, tp, kc, vf) }
        }
    }
#undef DIL_STEP
#undef DIL_LOADK
#undef DIL_LOADV
#pragma unroll
    for (int qi = 0; qi < 2; ++qi) {
        const int sq = t0 + r + 8 * qi + 16 * j;
        const float inv = 1.0f / xg_sum_f32(l_run[qi]);
        float ss = 0.f;
#pragma unroll
        for (int dt = 0; dt < 8; ++dt) { o[qi][dt] = o[qi][dt] * inv; ss += (o[qi][dt][0] * o[qi][dt][0] + o[qi][dt][1] * o[qi][dt][1]) + (o[qi][dt][2] * o[qi][dt][2] + o[qi][dt][3] * o[qi][dt][3]); }
        ss = xg_sum_f32(ss);
        const float rn = rsqrtf(ss * (1.0f / 128.0f) + EPS);
        bf16_t* orow = mix + ((size_t)b * S + sq) * D + 1024 + hd * 128 + 4 * g;
#pragma unroll
        for (int dt = 0; dt < 8; ++dt) {
            const f32x4_t gv = *(const f32x4_t*)(g_ahead + hd * 128 + 16 * dt + 4 * g);
            uint2 w; w.x = pk2(o[qi][dt][0] * rn * gv[0], o[qi][dt][1] * rn * gv[1]); w.y = pk2(o[qi][dt][2] * rn * gv[2], o[qi][dt][3] * rn * gv[3]);
            *(uint2*)(orow + 16 * dt) = w;
        }
    }
}

__device__ __forceinline__ unsigned ord_key(float s) { const unsigned u = __float_as_uint(s); return u ^ ((unsigned)((int)u >> 31) | 0x80000000u); }
__device__ __forceinline__ unsigned wave_max_u32(unsigned v) {
    unsigned t;
    t = (unsigned)__builtin_amdgcn_update_dpp(0, (int)v, 0xB1, 0xF, 0xF, true); v = v > t ? v : t;
    t = (unsigned)__builtin_amdgcn_update_dpp(0, (int)v, 0x4E, 0xF, 0xF, true); v = v > t ? v : t;
    t = (unsigned)__builtin_amdgcn_update_dpp(0, (int)v, 0x141, 0xF, 0xF, true); v = v > t ? v : t;
    t = (unsigned)__builtin_amdgcn_update_dpp(0, (int)v, 0x140, 0xF, 0xF, true); v = v > t ? v : t;
    const unsigned a = (unsigned)__builtin_amdgcn_readlane((int)v, 0), b = (unsigned)__builtin_amdgcn_readlane((int)v, 16),
                   c = (unsigned)__builtin_amdgcn_readlane((int)v, 32), d = (unsigned)__builtin_amdgcn_readlane((int)v, 48);
    const unsigned ab = a > b ? a : b, cd = c > d ? c : d;
    return ab > cd ? ab : cd;
}
__device__ __forceinline__ void peer_topk_wave(int item, int lane, LAS float* wl, const bf16_t* __restrict__ qp, const bf16_t* __restrict__ skb, int* __restrict__ ids, float* __restrict__ gates) {
    const int hd = item & 7, tt = item >> 3, j = lane & 15, g = lane >> 4;
    const size_t t0 = (size_t)tt * 16;
    LAS float* sc = wl;
    LAS float* lst = wl + 2048;
#pragma unroll 1
    for (int p = 0; p < 2; ++p) {
        bf16x8_t qf[4];
        const bf16_t* qrow = qp + (t0 + j) * D + hd * 256 + p * 128 + 8 * g;
#pragma unroll
        for (int ks = 0; ks < 4; ++ks) qf[ks] = *(const bf16x8_t*)(qrow + 32 * ks);
        const bf16_t* kb = skb + ((size_t)(hd * 2 + p) * 128 + j) * 128 + 8 * g;
#pragma unroll
        for (int kt = 0; kt < 8; ++kt) {
            f32x4_t a = (f32x4_t){0.f, 0.f, 0.f, 0.f};
#pragma unroll
            for (int ks = 0; ks < 4; ++ks) a = __builtin_amdgcn_mfma_f32_16x16x32_bf16(*(const bf16x8_t*)(kb + (size_t)kt * (16 * 128) + 32 * ks), qf[ks], a, 0, 0, 0);
            *(LAS f32x4_t*)(sc + j * 128 + 16 * kt + 4 * g) = a;
        }
        asm volatile("s_waitcnt lgkmcnt(0)" ::: "memory");
#pragma unroll 1
        for (int tok = 0; tok < 16; ++tok) {
            const float s0 = sc[tok * 128 + lane], s1 = sc[tok * 128 + 64 + lane];
            unsigned k0 = (ord_key(s0) & ~127u) | (unsigned)(127 - lane), k1 = (ord_key(s1) & ~127u) | (unsigned)(63 - lane);
            unsigned sel = 0u;
#pragma unroll 4
            for (int it = 0; it < 16; ++it) {
                unsigned m = k0 > k1 ? k0 : k1;
                m = wave_max_u32(m);
                if (lane == it) sel = m;
                if (k0 == m) k0 = 0u;
                if (k1 == m) k1 = 0u;
            }
            if (lane < 16) {
                const int idx = 127 - (int)(sel & 127u);
                lst[((p * 16 + tok) * 16 + lane) * 2 + 0] = sc[tok * 128 + idx];
                lst[((p * 16 + tok) * 16 + lane) * 2 + 1] = __int_as_float(idx);
            }
        }
        asm volatile("s_waitcnt lgkmcnt(0)" ::: "memory");
    }
#pragma unroll 1
    for (int tok = 0; tok < 16; ++tok) {
        const int i = lane >> 2;
        const float sA = lst[((0 * 16 + tok) * 16 + i) * 2];
        unsigned kk[4];
#pragma unroll
        for (int r = 0; r < 4; ++r) {
            const int jb = (lane & 3) * 4 + r;
            const float sum = sA + lst[((1 * 16 + tok) * 16 + jb) * 2];
            kk[r] = (ord_key(sum) & ~255u) | (unsigned)(255 - (lane * 4 + r));
        }
        unsigned sel = 0u;
#pragma unroll 4
        for (int it = 0; it < 16; ++it) {
            unsigned m = kk[0] > kk[1] ? kk[0] : kk[1]; const unsigned m2 = kk[2] > kk[3] ? kk[2] : kk[3]; m = m > m2 ? m : m2;
            m = wave_max_u32(m);
            if (lane == it) sel = m;
#pragma unroll
            for (int r = 0; r < 4; ++r) if (kk[r] == m) kk[r] = 0u;
        }
        float bs = -INFINITY; int eid = 0;
        if (lane < 16) {
            const int c = 255 - (int)(sel & 255u), ia = c >> 4, ib = c & 15;
            bs = lst[((0 * 16 + tok) * 16 + ia) * 2] + lst[((1 * 16 + tok) * 16 + ib) * 2];
            eid = __float_as_int(lst[((0 * 16 + tok) * 16 + ia) * 2 + 1]) * 128 + __float_as_int(lst[((1 * 16 + tok) * 16 + ib) * 2 + 1]);
        }
        const float mx = wave_max(bs);
        const float ev = lane < 16 ? __expf(bs - mx) : 0.f;
        const float tot = wave_sum(ev);
        if (lane < 16) {
            ids[(t0 + tok) * 128 + hd * 16 + lane] = eid;
            gates[(t0 + tok) * 128 + hd * 16 + lane] = ev / tot;
        }
    }
}

typedef float f32x2_t __attribute__((ext_vector_type(2)));
__device__ __forceinline__ void table_row_to_fp8(const float* __restrict__ srow, unsigned char* __restrict__ drow, float* __restrict__ rscale, int lane, const float* __restrict__ dgain) {
    float4 f[8];
#pragma unroll
    for (int i = 0; i < 8; ++i) f[i] = *(const float4*)(srow + i * 256 + lane * 4);
    if (dgain) {
#pragma unroll
        for (int i = 0; i < 8; ++i) { const float4 gq = *(const float4*)(dgain + i * 256 + lane * 4); f[i].x *= gq.x; f[i].y *= gq.y; f[i].z *= gq.z; f[i].w *= gq.w; }
    }
    float am = 0.f;
#pragma unroll
    for (int i = 0; i < 8; ++i) am = fmaxf(am, fmaxf(fmaxf(fabsf(f[i].x), fabsf(f[i].y)), fmaxf(fabsf(f[i].z), fabsf(f[i].w))));
    am = wave_max(am);
    const float e = floorf(log2f(448.0f / fmaxf(am, 1e-30f)));
    const float s = exp2f(fminf(e, 100.0f));
    unsigned w[8];
#pragma unroll
    for (int i = 0; i < 8; ++i) {
        int t = 0;
        t = __builtin_amdgcn_cvt_pk_fp8_f32(f[i].x * s, f[i].y * s, t, false);
        t = __builtin_amdgcn_cvt_pk_fp8_f32(f[i].z * s, f[i].w * s, t, true);
        w[i] = (unsigned)t;
    }
#pragma unroll
    for (int i = 0; i < 8; ++i) *(unsigned*)(drow + i * 256 + lane * 4) = w[i];
    if (lane == 0) *rscale = 1.0f / s;
}
__device__ __forceinline__ void table_row_to_i8(const float* __restrict__ srow, unsigned char* __restrict__ drow, float* __restrict__ rscale, int lane, const float* __restrict__ dgain) {
    float4 f[8];
#pragma unroll
    for (int i = 0; i < 8; ++i) { f[i] = *(const float4*)(srow + i * 256 + lane * 4); const float4 gq = *(const float4*)(dgain + i * 256 + lane * 4); f[i].x *= gq.x; f[i].y *= gq.y; f[i].z *= gq.z; f[i].w *= gq.w; }
    float am = 0.f;
#pragma unroll
    for (int i = 0; i < 8; ++i) am = fmaxf(am, fmaxf(fmaxf(fabsf(f[i].x), fabsf(f[i].y)), fmaxf(fabsf(f[i].z), fabsf(f[i].w))));
    am = wave_max(am);
    const float s = exp2f(fminf(floorf(log2f(127.0f / fmaxf(am, 1e-30f))), 100.0f));
#pragma unroll
    for (int i = 0; i < 8; ++i) {
        const int q0 = __float2int_rn(f[i].x * s), q1 = __float2int_rn(f[i].y * s), q2 = __float2int_rn(f[i].z * s), q3 = __float2int_rn(f[i].w * s);
        *(unsigned*)(drow + i * 256 + lane * 4) = ((unsigned)q0 & 255u) | (((unsigned)q1 & 255u) << 8) | (((unsigned)q2 & 255u) << 16) | (((unsigned)q3 & 255u) << 24);
    }
    if (lane == 0) *rscale = 1.0f / s;
}
__device__ __forceinline__ float dot16_fp8(const uint4 q, const float* x) {
    float d = 0.f;
    const unsigned w[4] = {q.x, q.y, q.z, q.w};
#pragma unroll
    for (int k = 0; k < 4; ++k) {
        const f32x2_t lo = __builtin_amdgcn_cvt_pk_f32_fp8((int)w[k], false), hi = __builtin_amdgcn_cvt_pk_f32_fp8((int)w[k], true);
        d = fmaf(lo.x, x[4 * k], d); d = fmaf(lo.y, x[4 * k + 1], d); d = fmaf(hi.x, x[4 * k + 2], d); d = fmaf(hi.y, x[4 * k + 3], d);
    }
    return d;
}
__device__ __forceinline__ void axpy16_fp8(const uint4 q, float c, float* acc) {
    const unsigned w[4] = {q.x, q.y, q.z, q.w};
#pragma unroll
    for (int k = 0; k < 4; ++k) {
        const f32x2_t lo = __builtin_amdgcn_cvt_pk_f32_fp8((int)w[k], false), hi = __builtin_amdgcn_cvt_pk_f32_fp8((int)w[k], true);
        acc[4 * k] = fmaf(c, lo.x, acc[4 * k]); acc[4 * k + 1] = fmaf(c, lo.y, acc[4 * k + 1]); acc[4 * k + 2] = fmaf(c, hi.x, acc[4 * k + 2]); acc[4 * k + 3] = fmaf(c, hi.y, acc[4 * k + 3]);
    }
}
__device__ __forceinline__ void d_peer_out8(int vb, int tid, float* sm, const bf16_t* __restrict__ h3, const float* __restrict__ x2, const int* __restrict__ ids, const float* __restrict__ gates,
                                            const unsigned char* __restrict__ ut8, const unsigned char* __restrict__ vt8, const float* __restrict__ rsc, const float* __restrict__ rstd, const float* __restrict__ g_final, float* __restrict__ out) {
    float (*part)[2048] = (float (*)[2048])sm;
    float* red = sm + 4 * 2048;
    const int lane = tid & 63, w = tid >> 6, t = vb;
    float x[32], acc[32];
    {
        const bf16_t* hrow = h3 + (size_t)t * D + lane * 16;
#pragma unroll
        for (int hh = 0; hh < 2; ++hh) {
            const uint4 a = *(const uint4*)(hrow + hh * 1024), b = *(const uint4*)(hrow + hh * 1024 + 8);
            const unsigned ww[8] = {a.x, a.y, a.z, a.w, b.x, b.y, b.z, b.w};
#pragma unroll
            for (int k = 0; k < 8; ++k) { x[hh * 16 + 2 * k] = __uint_as_float(ww[k] << 16); x[hh * 16 + 2 * k + 1] = __uint_as_float(ww[k] & 0xFFFF0000u); }
        }
#pragma unroll
        for (int i = 0; i < 32; ++i) acc[i] = 0.f;
    }
    const float xrs = rstd[t];
    const int myid = ids[(size_t)t * 128 + w * 32 + (lane & 31)];
    const float mygate = gates[(size_t)t * 128 + w * 32 + (lane & 31)];
#pragma unroll 1
    for (int j = 0; j < 32; j += 4) {
        int e[4]; uint4 uq[4][2], vq[4][2];
#pragma unroll
        for (int q = 0; q < 4; ++q) {
            e[q] = __builtin_amdgcn_readfirstlane(__shfl(myid, j + q));
            const unsigned char* ur = ut8 + (size_t)e[q] * 2048 + lane * 16;
            uq[q][0] = *(const uint4*)ur; uq[q][1] = *(const uint4*)(ur + 1024);
        }
#pragma unroll
        for (int q = 0; q < 4; ++q) {
            const unsigned char* vr = vt8 + (size_t)e[q] * 2048 + lane * 16;
            vq[q][0] = *(const uint4*)vr; vq[q][1] = *(const uint4*)(vr + 1024);
        }
        float d[4];
#pragma unroll
        for (int q = 0; q < 4; ++q) d[q] = dot16_fp8(uq[q][0], x) + dot16_fp8(uq[q][1], x + 16);
#pragma unroll
        for (int o = 32; o >= 1; o >>= 1) {
#pragma unroll
            for (int q = 0; q < 4; ++q) d[q] += __shfl_xor(d[q], o);
        }
#pragma unroll
        for (int q = 0; q < 4; ++q) {
            const float a = d[q] * rsc[e[q]] * xrs;
            const float act = 0.5f * a * (1.0f + erff(a * 0.7071067811865476f));
            const float cf = __shfl(mygate, j + q) * act * rsc[16384 + e[q]];
            axpy16_fp8(vq[q][0], cf, acc); axpy16_fp8(vq[q][1], cf, acc + 16);
        }
    }
    __syncthreads();
#pragma unroll
    for (int hh = 0; hh < 2; ++hh)
#pragma unroll
        for (int k = 0; k < 4; ++k) *(float4*)&part[w][hh * 1024 + lane * 16 + 4 * k] = make_float4(acc[hh * 16 + 4 * k], acc[hh * 16 + 4 * k + 1], acc[hh * 16 + 4 * k + 2], acc[hh * 16 + 4 * k + 3]);
    __syncthreads();
    float4 r0, r1;
    {
        const float4 a = *(const float4*)&part[0][tid * 4], b = *(const float4*)&part[1][tid * 4], c = *(const float4*)&part[2][tid * 4], dd = *(const float4*)&part[3][tid * 4];
        const float4 xx = *(const float4*)(x2 + (size_t)t * D + tid * 4);
        r0 = make_float4(xx.x + a.x + b.x + c.x + dd.x, xx.y + a.y + b.y + c.y + dd.y, xx.z + a.z + b.z + c.z + dd.z, xx.w + a.w + b.w + c.w + dd.w);
    }
    {
        const float4 a = *(const float4*)&part[0][1024 + tid * 4], b = *(const float4*)&part[1][1024 + tid * 4], c = *(const float4*)&part[2][1024 + tid * 4], dd = *(const float4*)&part[3][1024 + tid * 4];
        const float4 xx = *(const float4*)(x2 + (size_t)t * D + 1024 + tid * 4);
        r1 = make_float4(xx.x + a.x + b.x + c.x + dd.x, xx.y + a.y + b.y + c.y + dd.y, xx.z + a.z + b.z + c.z + dd.z, xx.w + a.w + b.w + c.w + dd.w);
    }
    float s = r0.x * r0.x + r0.y * r0.y + r0.z * r0.z + r0.w * r0.w + r1.x * r1.x + r1.y * r1.y + r1.z * r1.z + r1.w * r1.w;
    s = wave_sum(s);
    if (lane == 0) red[w] = s;
    __syncthreads();
    const float tot = red[0] + red[1] + red[2] + red[3];
    const float r = rsqrtf(tot * (1.0f / D) + EPS);
    const float4 g0 = *(const float4*)(g_final + tid * 4), g1 = *(const float4*)(g_final + 1024 + tid * 4);
    *(float4*)(out + (size_t)t * D + tid * 4) = make_float4(r0.x * r * g0.x, r0.y * r * g0.y, r0.z * r * g0.z, r0.w * r * g0.w);
    *(float4*)(out + (size_t)t * D + 1024 + tid * 4) = make_float4(r1.x * r * g1.x, r1.y * r * g1.y, r1.z * r * g1.z, r1.w * r * g1.w);
}

__device__ __forceinline__ unsigned xg_sum_u32(unsigned v) {
    auto a = __builtin_amdgcn_permlane16_swap(v, v, false, false); v = a[0] + a[1];
    auto b = __builtin_amdgcn_permlane32_swap(v, v, false, false); return b[0] + b[1];
}
__device__ __forceinline__ float xg_sum_f32(float v) {
    auto a = __builtin_amdgcn_permlane16_swap(__float_as_uint(v), __float_as_uint(v), false, false); v = __uint_as_float(a[0]) + __uint_as_float(a[1]);
    auto b = __builtin_amdgcn_permlane32_swap(__float_as_uint(v), __float_as_uint(v), false, false); return __uint_as_float(b[0]) + __uint_as_float(b[1]);
}
__device__ __forceinline__ float xg_max_f32(float v) {
    auto a = __builtin_amdgcn_permlane16_swap(__float_as_uint(v), __float_as_uint(v), false, false); v = fmaxf(__uint_as_float(a[0]), __uint_as_float(a[1]));
    auto b = __builtin_amdgcn_permlane32_swap(__float_as_uint(v), __float_as_uint(v), false, false); return fmaxf(__uint_as_float(b[0]), __uint_as_float(b[1]));
}
template <int N> __device__ __forceinline__ unsigned bisect16(const unsigned (&kk)[N]) {
    unsigned tau = 0u; bool done = false;
#pragma unroll 1
    for (int bit = 31; bit >= 0; --bit) {
        const unsigned cand = tau | (1u << bit);
        unsigned c0 = 0u, c1 = 0u, c2 = 0u, c3 = 0u;
#pragma unroll
        for (int i = 0; i < N; i += 4) { c0 += (kk[i] >= cand) ? 1u : 0u; c1 += (kk[i + 1] >= cand) ? 1u : 0u; c2 += (kk[i + 2] >= cand) ? 1u : 0u; c3 += (kk[i + 3] >= cand) ? 1u : 0u; }
        unsigned c = xg_sum_u32((c0 + c1) + (c2 + c3));
        if (!done && c >= 16u) { tau = cand; done = (c == 16u); }
        if (__all(done ? 1 : 0)) break;
    }
    return tau;
}
__device__ __forceinline__ void peer_topk_wave2(int item, int lane, LAS float* wl, const bf16_t* __restrict__ qp, const bf16_t* __restrict__ skb, int* __restrict__ ids, float* __restrict__ gates) {
    const int hd = item & 7, tt = item >> 3, j = lane & 15, g = lane >> 4;
    const size_t t0 = (size_t)tt * 16;
#pragma unroll 1
    for (int p = 0; p < 2; ++p) {
        bf16x8_t qf[4];
        const bf16_t* qrow = qp + (t0 + j) * D + hd * 256 + p * 128 + 8 * g;
#pragma unroll
        for (int ks = 0; ks < 4; ++ks) qf[ks] = *(const bf16x8_t*)(qrow + 32 * ks);
        const bf16_t* kb = skb + ((size_t)(hd * 2 + p) * 128 + j) * 128 + 8 * g;
        float sc[32]; unsigned kk[32];
#pragma unroll
        for (int kt = 0; kt < 8; ++kt) {
            f32x4_t a = (f32x4_t){0.f, 0.f, 0.f, 0.f};
#pragma unroll
            for (int ks = 0; ks < 4; ++ks) a = __builtin_amdgcn_mfma_f32_16x16x32_bf16(*(const bf16x8_t*)(kb + (size_t)kt * (16 * 128) + 32 * ks), qf[ks], a, 0, 0, 0);
#pragma unroll
            for (int r = 0; r < 4; ++r) { sc[kt * 4 + r] = a[r]; kk[kt * 4 + r] = (ord_key(a[r]) & ~127u) | (unsigned)(127 - (16 * kt + 4 * g + r)); }
        }
        const unsigned tau = bisect16<32>(kk);
        unsigned cnt = 0u;
#pragma unroll
        for (int i = 0; i < 32; ++i) cnt += (kk[i] >= tau) ? 1u : 0u;
        const unsigned c0 = (unsigned)__shfl((int)cnt, j), c1 = (unsigned)__shfl((int)cnt, j + 16), c2 = (unsigned)__shfl((int)cnt, j + 32);
        unsigned off = (g > 0 ? c0 : 0u) + (g > 1 ? c1 : 0u) + (g > 2 ? c2 : 0u);
        LAS float* ls = wl + p * 256 + j * 16;
        LAS float* li = wl + 512 + p * 256 + j * 16;
#pragma unroll
        for (int i = 0; i < 32; ++i) {
            if (kk[i] >= tau && off < 16u) { ls[off] = sc[i]; li[off] = __int_as_float(16 * (i >> 2) + 4 * g + (i & 3)); ++off; }
        }
    }
    asm volatile("s_waitcnt lgkmcnt(0)" ::: "memory");
    {
        float sA[4], sB[16]; int iA[4];
        {
            const f32x4_t a = *(const LAS f32x4_t*)(wl + j * 16 + 4 * g);
            const f32x4_t ai = *(const LAS f32x4_t*)(wl + 512 + j * 16 + 4 * g);
#pragma unroll
            for (int r = 0; r < 4; ++r) { sA[r] = a[r]; iA[r] = __float_as_int(ai[r]); }
#pragma unroll
            for (int q = 0; q < 4; ++q) { const f32x4_t b = *(const LAS f32x4_t*)(wl + 256 + j * 16 + 4 * q); sB[4 * q] = b[0]; sB[4 * q + 1] = b[1]; sB[4 * q + 2] = b[2]; sB[4 * q + 3] = b[3]; }
        }
        unsigned kk[64];
#pragma unroll
        for (int a = 0; a < 4; ++a)
#pragma unroll
            for (int b = 0; b < 16; ++b) kk[a * 16 + b] = (ord_key(sA[a] + sB[b]) & ~255u) | (unsigned)(255 - ((4 * g + a) * 16 + b));
        const unsigned tau = bisect16<64>(kk);
        float mx = -INFINITY; unsigned cnt = 0u;
#pragma unroll
        for (int i = 0; i < 64; ++i) if (kk[i] >= tau) { mx = fmaxf(mx, sA[i >> 4] + sB[i & 15]); ++cnt; }
        mx = xg_max_f32(mx);
        float es = 0.f;
#pragma unroll
        for (int i = 0; i < 64; ++i) if (kk[i] >= tau) es += __expf(sA[i >> 4] + sB[i & 15] - mx);
        const float inv = 1.0f / xg_sum_f32(es);
        const unsigned c0 = (unsigned)__shfl((int)cnt, j), c1 = (unsigned)__shfl((int)cnt, j + 16), c2 = (unsigned)__shfl((int)cnt, j + 32);
        unsigned off = (g > 0 ? c0 : 0u) + (g > 1 ? c1 : 0u) + (g > 2 ? c2 : 0u);
        int* idp = ids + (t0 + j) * 128 + hd * 16;
        float* gtp = gates + (t0 + j) * 128 + hd * 16;
        const LAS float* liB = wl + 512 + 256 + j * 16;
#pragma unroll
        for (int i = 0; i < 64; ++i) {
            if (kk[i] >= tau && off < 16u) {
                idp[off] = iA[i >> 4] * 128 + __float_as_int(liB[i & 15]);
                gtp[off] = __expf(sA[i >> 4] + sB[i & 15] - mx) * inv;
                ++off;
            }
        }
    }
}

__device__ __forceinline__ float wave_sum_dpp(float v) {
    v += __uint_as_float((unsigned)__builtin_amdgcn_update_dpp(0, (int)__float_as_uint(v), 0xB1, 0xF, 0xF, true));
    v += __uint_as_float((unsigned)__builtin_amdgcn_update_dpp(0, (int)__float_as_uint(v), 0x4E, 0xF, 0xF, true));
    v += __uint_as_float((unsigned)__builtin_amdgcn_update_dpp(0, (int)__float_as_uint(v), 0x141, 0xF, 0xF, true));
    v += __uint_as_float((unsigned)__builtin_amdgcn_update_dpp(0, (int)__float_as_uint(v), 0x140, 0xF, 0xF, true));
    const float a = __uint_as_float((unsigned)__builtin_amdgcn_readlane((int)__float_as_uint(v), 0)), b = __uint_as_float((unsigned)__builtin_amdgcn_readlane((int)__float_as_uint(v), 16)),
                c = __uint_as_float((unsigned)__builtin_amdgcn_readlane((int)__float_as_uint(v), 32)), d = __uint_as_float((unsigned)__builtin_amdgcn_readlane((int)__float_as_uint(v), 48));
    return (a + b) + (c + d);
}
typedef __bf16 bf16x2v_t __attribute__((ext_vector_type(2)));
__device__ __forceinline__ int wave_sum_all_i32(int v) {
    v += __builtin_amdgcn_update_dpp(0, v, 0xB1, 0xF, 0xF, true);
    v += __builtin_amdgcn_update_dpp(0, v, 0x4E, 0xF, 0xF, true);
    v += __builtin_amdgcn_update_dpp(0, v, 0x141, 0xF, 0xF, true);
    v += __builtin_amdgcn_update_dpp(0, v, 0x140, 0xF, 0xF, true);
    auto a = __builtin_amdgcn_permlane16_swap((unsigned)v, (unsigned)v, false, false); v = (int)(a[0] + a[1]);
    auto b = __builtin_amdgcn_permlane32_swap((unsigned)v, (unsigned)v, false, false); return (int)(b[0] + b[1]);
}
__device__ __forceinline__ float wave_sum_all(float v) {
    v += __uint_as_float((unsigned)__builtin_amdgcn_update_dpp(0, (int)__float_as_uint(v), 0xB1, 0xF, 0xF, true));
    v += __uint_as_float((unsigned)__builtin_amdgcn_update_dpp(0, (int)__float_as_uint(v), 0x4E, 0xF, 0xF, true));
    v += __uint_as_float((unsigned)__builtin_amdgcn_update_dpp(0, (int)__float_as_uint(v), 0x141, 0xF, 0xF, true));
    v += __uint_as_float((unsigned)__builtin_amdgcn_update_dpp(0, (int)__float_as_uint(v), 0x140, 0xF, 0xF, true));
    auto a = __builtin_amdgcn_permlane16_swap(__float_as_uint(v), __float_as_uint(v), false, false); v = __uint_as_float(a[0]) + __uint_as_float(a[1]);
    auto b = __builtin_amdgcn_permlane32_swap(__float_as_uint(v), __float_as_uint(v), false, false); return __uint_as_float(b[0]) + __uint_as_float(b[1]);
}
__device__ __forceinline__ float dot16_fp8_bf16(const uint4 q, const uint4 xa, const uint4 xb, float d) {
    const unsigned w[4] = {q.x, q.y, q.z, q.w};
    const unsigned xw[8] = {xa.x, xa.y, xa.z, xa.w, xb.x, xb.y, xb.z, xb.w};
#pragma unroll
    for (int k = 0; k < 4; ++k) {
        const bf16x2v_t lo = __builtin_amdgcn_cvt_scalef32_pk_bf16_fp8(w[k], 1.0f, false), hi = __builtin_amdgcn_cvt_scalef32_pk_bf16_fp8(w[k], 1.0f, true);
        d = __builtin_amdgcn_fdot2_f32_bf16(lo, __builtin_bit_cast(bf16x2v_t, xw[2 * k]), d, false);
        d = __builtin_amdgcn_fdot2_f32_bf16(hi, __builtin_bit_cast(bf16x2v_t, xw[2 * k + 1]), d, false);
    }
    return d;
}
__device__ __forceinline__ void axpy16_fp8_pk(const uint4 q, const f32x2_t c2, f32x2_t* acc) {
    const unsigned w[4] = {q.x, q.y, q.z, q.w};
#pragma unroll
    for (int k = 0; k < 4; ++k) {
        const f32x2_t lo = __builtin_amdgcn_cvt_pk_f32_fp8((int)w[k], false), hi = __builtin_amdgcn_cvt_pk_f32_fp8((int)w[k], true);
        acc[2 * k] = __builtin_elementwise_fma(c2, lo, acc[2 * k]); acc[2 * k + 1] = __builtin_elementwise_fma(c2, hi, acc[2 * k + 1]);
    }
}
__device__ __forceinline__ float gelu_as(float v) {
    const float av = fabsf(v), t = __builtin_amdgcn_rcpf(av * 0.2316418882f + 1.0f);
    float q = t * 0.5307027145f + (-0.7265760135f); q = q * t + 0.7107068705f; q = q * t + (-0.142248368f); q = q * t + 0.127414796f; q = q * t;
    const float e = __builtin_amdgcn_exp2f((v * v) * (-0.72134752044f));
    const float m = v * (q * e);
    return v < 0.f ? m : v - m;
}
__device__ __forceinline__ void peer_sweep_wave(int gw, int lane, LAS unsigned char* wl, const bf16_t* __restrict__ h3, const float* __restrict__ x2, const int* __restrict__ ids,
                                                const float* __restrict__ gates, const unsigned char* __restrict__ ut8, const unsigned char* __restrict__ vt8, const float* __restrict__ rsc,
                                                const float* __restrict__ rstd, const float* __restrict__ g_final, float* __restrict__ out) {
    typedef unsigned u32x4_t __attribute__((ext_vector_type(4)));
    typedef int i32x4_t __attribute__((ext_vector_type(4)));
    LAS unsigned char* x8 = wl;
    LAS unsigned* sorted = (LAS unsigned*)(wl + 8192);
    LAS unsigned* cnt = (LAS unsigned*)(wl + 8192 + 2048);
    LAS unsigned* base = (LAS unsigned*)(wl + 8192 + 2048 + 256);
    LAS unsigned short* gsv = (LAS unsigned short*)(wl + 8192 + 2048 + 512);
    const size_t t0 = (size_t)gw * 4;
    float fac = 0.f;
#pragma unroll
    for (int tok = 0; tok < 4; ++tok) {
        uint4 xv[4]; float am = 0.f;
#pragma unroll
        for (int c = 0; c < 4; ++c) {
            xv[c] = *(const uint4*)(h3 + (t0 + tok) * D + c * 512 + lane * 8);
            const unsigned w[4] = {xv[c].x, xv[c].y, xv[c].z, xv[c].w};
#pragma unroll
            for (int k = 0; k < 4; ++k) am = fmaxf(am, fmaxf(fabsf(__uint_as_float(w[k] << 16)), fabsf(__uint_as_float(w[k] & 0xFFFF0000u))));
        }
        am = wave_max(am);
        const float s = exp2f(fminf(floorf(log2f(127.0f / fmaxf(am, 1e-30f))), 100.0f));
        if ((lane & 3) == tok) fac = rstd[t0 + tok] / s;
#pragma unroll
        for (int c = 0; c < 4; ++c) {
            const unsigned w[4] = {xv[c].x, xv[c].y, xv[c].z, xv[c].w};
            unsigned o[2];
#pragma unroll
            for (int h = 0; h < 2; ++h) {
                const int q0 = __float2int_rn(__uint_as_float(w[2 * h] << 16) * s), q1 = __float2int_rn(__uint_as_float(w[2 * h] & 0xFFFF0000u) * s);
                const int q2 = __float2int_rn(__uint_as_float(w[2 * h + 1] << 16) * s), q3 = __float2int_rn(__uint_as_float(w[2 * h + 1] & 0xFFFF0000u) * s);
                o[h] = ((unsigned)q0 & 255u) | (((unsigned)q1 & 255u) << 8) | (((unsigned)q2 & 255u) << 16) | (((unsigned)q3 & 255u) << 24);
            }
            typedef unsigned u32x2_t __attribute__((ext_vector_type(2)));
            *(LAS u32x2_t*)(x8 + tok * 2048 + c * 512 + lane * 8) = (u32x2_t){o[0], o[1]};
        }
    }
    cnt[lane] = 0u;
    asm volatile("s_waitcnt lgkmcnt(0)" ::: "memory");
    unsigned key[8], rk[8]; unsigned short fv[8];
#pragma unroll
    for (int r = 0; r < 8; ++r) {
        const int n = r * 64 + lane;
        const unsigned e = (unsigned)ids[t0 * 128 + n];
        key[r] = (e << 9) | (unsigned)n | (__float_as_uint(rsc[e]) & 0x7F800000u);
        fv[r] = (unsigned short)f2bf(gates[t0 * 128 + n] * rsc[16384 + e]);
        rk[r] = __hip_atomic_fetch_add(&cnt[e >> 8], 1u, __ATOMIC_RELAXED, __HIP_MEMORY_SCOPE_WORKGROUP);
    }
    asm volatile("s_waitcnt lgkmcnt(0)" ::: "memory");
    {
        const unsigned c = cnt[lane];
        unsigned incl = c;
#pragma unroll
        for (int o = 1; o < 64; o <<= 1) { const unsigned t = (unsigned)__shfl_up((int)incl, o); if (lane >= o) incl += t; }
        base[lane] = incl - c;
    }
    asm volatile("s_waitcnt lgkmcnt(0)" ::: "memory");
#pragma unroll
    for (int r = 0; r < 8; ++r) { const unsigned pos = base[(key[r] >> 17) & 63u] + rk[r]; sorted[pos] = key[r]; gsv[pos] = fv[r]; }
    asm volatile("s_waitcnt lgkmcnt(0)" ::: "memory");
    float rs4[4];
#pragma unroll
    for (int tok = 0; tok < 4; ++tok) rs4[tok] = __uint_as_float((unsigned)__builtin_amdgcn_readlane((int)__float_as_uint(fac), tok));
#define P1_LOAD(ENT, UQ, I0) _Pragma("unroll") for (int q = 0; q < 8; ++q) { \
            ENT[q] = (unsigned)__builtin_amdgcn_readfirstlane((int)sorted[(I0) + q]); \
            const unsigned char* ur = ut8 + (size_t)((ENT[q] >> 9) & 16383u) * 2048 + lane * 16; \
            UQ[q][0] = *(const uint4*)ur; UQ[q][1] = *(const uint4*)(ur + 1024); }
#define P1_COMP(ENT, UQ, I0) _Pragma("unroll") for (int h4 = 0; h4 < 8; h4 += 4) { int d[4]; \
            _Pragma("unroll") for (int q = 0; q < 4; ++q) { \
                const int tok = (ENT[h4 + q] >> 7) & 3; \
                const LAS unsigned char* xr = x8 + tok * 2048 + lane * 16; \
                const u32x4_t a0 = *(const LAS u32x4_t*)xr, b0 = *(const LAS u32x4_t*)(xr + 1024); \
                int dd = 0; \
                dd = __builtin_amdgcn_sdot4((int)UQ[h4 + q][0].x, (int)a0[0], dd, false); dd = __builtin_amdgcn_sdot4((int)UQ[h4 + q][0].y, (int)a0[1], dd, false); \
                dd = __builtin_amdgcn_sdot4((int)UQ[h4 + q][0].z, (int)a0[2], dd, false); dd = __builtin_amdgcn_sdot4((int)UQ[h4 + q][0].w, (int)a0[3], dd, false); \
                dd = __builtin_amdgcn_sdot4((int)UQ[h4 + q][1].x, (int)b0[0], dd, false); dd = __builtin_amdgcn_sdot4((int)UQ[h4 + q][1].y, (int)b0[1], dd, false); \
                dd = __builtin_amdgcn_sdot4((int)UQ[h4 + q][1].z, (int)b0[2], dd, false); dd = __builtin_amdgcn_sdot4((int)UQ[h4 + q][1].w, (int)b0[3], dd, false); \
                d[q] = dd; } \
            _Pragma("unroll") for (int q = 0; q < 4; ++q) { \
                const int s = wave_sum_all_i32(d[q]); \
                const unsigned e = (ENT[h4 + q] >> 9) & 16383u; const int n = ENT[h4 + q] & 511, tok = n >> 7; \
                const float rsv = tok == 0 ? rs4[0] : tok == 1 ? rs4[1] : tok == 2 ? rs4[2] : rs4[3]; \
                const float a = (float)s * (__uint_as_float(ENT[h4 + q] & 0x7F800000u) * rsv); \
                const float cf = __uint_as_float((unsigned)gsv[(I0) + h4 + q] << 16) * gelu_as(a); \
                if (lane == 0) sorted[(I0) + h4 + q] = (e << 18) | ((unsigned)tok << 16) | f2bf(cf); } }
    {
        unsigned entA[8], entB[8]; uint4 uqA[8][2], uqB[8][2];
        P1_LOAD(entA, uqA, 0)
#pragma unroll 1
        for (int i = 0; i < 512; i += 16) {
            P1_LOAD(entB, uqB, i + 8)
            P1_COMP(entA, uqA, i)
            { const int nx = i + 16 < 512 ? i + 16 : 504; P1_LOAD(entA, uqA, nx) }
            P1_COMP(entB, uqB, i + 8)
        }
    }
#undef P1_LOAD
#undef P1_COMP
    asm volatile("s_waitcnt lgkmcnt(0)" ::: "memory");
    f32x2_t acc0[16], acc1[16], acc2[16], acc3[16];
#pragma unroll
    for (int k = 0; k < 16; ++k) { acc0[k] = (f32x2_t){0.f, 0.f}; acc1[k] = (f32x2_t){0.f, 0.f}; acc2[k] = (f32x2_t){0.f, 0.f}; acc3[k] = (f32x2_t){0.f, 0.f}; }
#ifndef P2N
#define P2N 2
#endif
#define P2_LOAD(ENT, VQ, I0) _Pragma("unroll") for (int q = 0; q < P2N; ++q) { \
            ENT[q] = (unsigned)__builtin_amdgcn_readfirstlane((int)sorted[(I0) + q]); \
            const unsigned char* vr = vt8 + (size_t)(ENT[q] >> 18) * 2048 + lane * 16; \
            VQ[q][0] = *(const uint4*)vr; VQ[q][1] = *(const uint4*)(vr + 1024); }
#define P2_COMP(ENT, VQ) _Pragma("unroll") for (int q = 0; q < P2N; ++q) { \
            const int tok = (ENT[q] >> 16) & 3; \
            const float cfs = __uint_as_float(ENT[q] << 16); \
            const f32x2_t c2 = (f32x2_t){cfs, cfs}; \
            if (tok == 0) { axpy16_fp8_pk(VQ[q][0], c2, acc0); axpy16_fp8_pk(VQ[q][1], c2, acc0 + 8); } \
            else if (tok == 1) { axpy16_fp8_pk(VQ[q][0], c2, acc1); axpy16_fp8_pk(VQ[q][1], c2, acc1 + 8); } \
            else if (tok == 2) { axpy16_fp8_pk(VQ[q][0], c2, acc2); axpy16_fp8_pk(VQ[q][1], c2, acc2 + 8); } \
            else { axpy16_fp8_pk(VQ[q][0], c2, acc3); axpy16_fp8_pk(VQ[q][1], c2, acc3 + 8); } }
    {
        unsigned entA[P2N], entB[P2N]; uint4 vqA[P2N][2], vqB[P2N][2];
        P2_LOAD(entA, vqA, 0)
#pragma unroll 1
        for (int i = 0; i < 512; i += 2 * P2N) {
            P2_LOAD(entB, vqB, i + P2N)
            P2_COMP(entA, vqA)
            { const int nx = i + 2 * P2N < 512 ? i + 2 * P2N : 512 - P2N; P2_LOAD(entA, vqA, nx) }
            P2_COMP(entB, vqB)
        }
    }
#undef P2_LOAD
#undef P2_COMP
    int l2 = lane; asm volatile("" : "+v"(l2));
#define PEER_EPI(tok, ACC) { \
        const bf16_t* xr = h3 + (t0 + tok) * D + l2 * 16; \
        float ss = 0.f; \
        _Pragma("unroll") for (int hh = 0; hh < 2; ++hh) _Pragma("unroll") for (int k = 0; k < 4; ++k) { \
            const uint2 xp = *(const uint2*)(xr + hh * 1024 + 4 * k); \
            const float4 xv = make_float4(__uint_as_float(xp.x << 16), __uint_as_float(xp.x & 0xFFFF0000u), __uint_as_float(xp.y << 16), __uint_as_float(xp.y & 0xFFFF0000u)); \
            f32x2_t a0 = ACC[hh * 8 + 2 * k], a1 = ACC[hh * 8 + 2 * k + 1]; \
            a0.x += xv.x; a0.y += xv.y; a1.x += xv.z; a1.y += xv.w; ACC[hh * 8 + 2 * k] = a0; ACC[hh * 8 + 2 * k + 1] = a1; \
            ss += (a0.x * a0.x + a0.y * a0.y) + (a1.x * a1.x + a1.y * a1.y); } \
        ss = wave_sum_dpp(ss); \
        const float r = rsqrtf(ss * (1.0f / D) + EPS); \
        float* orow = out + (t0 + tok) * D + l2 * 16; \
        _Pragma("unroll") for (int hh = 0; hh < 2; ++hh) _Pragma("unroll") for (int k = 0; k < 4; ++k) { \
            const float4 gv = *(const float4*)(g_final + hh * 1024 + l2 * 16 + 4 * k); \
            const f32x2_t a0 = ACC[hh * 8 + 2 * k], a1 = ACC[hh * 8 + 2 * k + 1]; \
            *(float4*)(orow + hh * 1024 + 4 * k) = make_float4(a0.x * r * gv.x, a0.y * r * gv.y, a1.x * r * gv.z, a1.y * r * gv.w); } }
    PEER_EPI(0, acc0) PEER_EPI(1, acc1) PEER_EPI(2, acc2) PEER_EPI(3, acc3)
#undef PEER_EPI
}

struct Params {
    const float *x, *mem, *g_mix, *w_in, *conv_w, *conv_b, *w_mq, *w_mk, *b_mi, *b_mf, *g_mhead, *g_ahead, *w_out, *g_cross, *g_mem,
                *w_xq, *w_xk, *w_xv, *w_xo, *g_ffn, *w_pq, *sub_keys, *u_tab, *v_tab, *g_final;
    float* out;
    unsigned* bar;
    float* ws;
};

#define PHASE_LOOP(nvb) for (int base_ = blockIdx.x * 2; base_ < (nvb); base_ += gridDim.x * 2)
#define VB (base_ + half)

__global__ void __launch_bounds__(NTHR) mega(Params P) {
    volatile LAS unsigned* st = (volatile LAS unsigned*)(LAS unsigned char*)(smem_raw + CTRL_OFF);
    if (threadIdx.x == 0) { st[0] = 0u; st[1] = 0u; st[2] = 0u; st[3] = 0u; }
    if (threadIdx.x < I_NPTR) ((LAS unsigned long long*)(LAS unsigned char*)(smem_raw + CTRL_OFF + 64))[threadIdx.x] = ((const unsigned long long*)&P)[threadIdx.x];
    __syncthreads();
    XcdBarrier xb = xcd_barrier_post((unsigned*)ldp_raw(I_BAR), st);

    constexpr size_t TD = (size_t)T * D;
    constexpr size_t O_HB = 6 * P6S * 2, O_CBUF = O_HB + (size_t)T * D * 2, O_MQ = O_CBUF + (size_t)T * 1024 * 2, O_MK = O_MQ + (size_t)T * 1024 * 2,
                     O_MIXB = O_MK + (size_t)T * 1024 * 2, O_WIN = O_MIXB + (size_t)T * D * 2, O_WOUT = O_WIN + (size_t)6144 * D * 2, O_WXQ = O_WOUT + (size_t)D * D * 2,
                     O_WXK = O_WXQ + (size_t)D * D * 2, O_WXV = O_WXK + (size_t)D * D * 2, O_WXO = O_WXV + (size_t)D * D * 2, O_WPQ = O_WXO + (size_t)D * D * 2,
                     O_WQK = O_WPQ + (size_t)D * D * 2, O_GPRE = O_WQK + (size_t)8 * 256 * 256 * 2, O_UT = O_GPRE + (size_t)T * 8 * 4, O_VT = O_UT + (size_t)16384 * D, O_RSC = O_VT + (size_t)16384 * D,
                     O_BH = O_RSC + (size_t)32768 * 4, O_GS = O_BH + (size_t)128 * 256 * 512 * 2, O_DENP = O_GS + (size_t)T * 4 * 8 * 4, O_QN = O_DENP + (size_t)T * 4 * 4 * 4,
                     O_DN = O_QN + (size_t)T * 4 * 4, O_DECAY = O_DN + (size_t)128 * 256 * 4, O_KB = O_DECAY + 4096, O_VB = O_KB + (size_t)12288 * 2048 * 2, O_CS = O_VB + (size_t)12288 * 2048 * 2, O_SKB = O_CS + (size_t)4096 * 64 * 8, O_RSSP = O_SKB + (size_t)262144 * 2, O_RSTD = O_RSSP + (size_t)T * 32 * 4, O_MN = O_RSTD + (size_t)T * 4, O_KVP = O_MN + (size_t)512 * D * 2, O_END = O_KVP + (size_t)2 * 512 * 4096 * 4;
    static_assert(O_END + 16384 <= (size_t)536870912, "workspace overflow");
#define W_P6    ((bf16_t*)wsb)
#define W_HB    ((bf16_t*)(wsb + O_HB))
#define W_CBUF  ((bf16_t*)(wsb + O_CBUF))
#define W_MQ    ((bf16_t*)(wsb + O_MQ))
#define W_MK    ((bf16_t*)(wsb + O_MK))
#define W_MIXB  ((bf16_t*)(wsb + O_MIXB))
#define W_GPRE  ((float*)(wsb + O_GPRE))
#define W_HRAW  ((float*)(wsb + O_HB))
#define W_XR    ((float*)wsb)
#define W_MN    ((bf16_t*)((float*)wsb + TD))
#define W_KM    ((bf16_t*)((float*)wsb + TD + (size_t)256 * D))
#define W_VMT   ((bf16_t*)((float*)wsb + TD + (size_t)768 * D))
#define W_PX    ((bf16_t*)(wsb + O_MK))
#define W_GATES ((float*)wsb + TD + (size_t)1280 * D)
#define W_IDS   ((int*)((float*)wsb + TD + (size_t)1280 * D + (size_t)T * 128))
#define W_QX    ((bf16_t*)(wsb + O_CBUF))
#define W_BH    ((bf16_t*)(wsb + O_BH))
#define W_KB    ((bf16_t*)(wsb + O_KB))
#define W_VB    ((bf16_t*)(wsb + O_VB))
#define W_CS    ((float2*)(wsb + O_CS))
#define W_SKB   ((bf16_t*)(wsb + O_SKB))
#define W_RSSP  ((float*)(wsb + O_RSSP))
#define W_RSTD  ((float*)(wsb + O_RSTD))
#define W_MN2   ((bf16_t*)(wsb + O_MN))
#define W_KVP   ((float*)(wsb + O_KVP))
#define W_GS    ((float*)(wsb + O_GS))
#define W_DENP  ((float*)(wsb + O_DENP))
#define W_QN    ((float*)(wsb + O_QN))
#define W_DN    ((float*)(wsb + O_DN))
#define W_DECAY ((float*)(wsb + O_DECAY))
#define W_PQ    ((bf16_t*)(wsb + O_HB))
#define W_KWT   ((bf16_t*)(wsb + O_CBUF))
#define W_DC    ((float*)(wsb + 3 * P6S * 2))
#define W_UT    ((unsigned char*)(wsb + O_UT))
#define W_VT    ((unsigned char*)(wsb + O_VT))
#define W_RSC   ((float*)(wsb + O_RSC))
#define PH_BEGIN() int tidx = threadIdx.x; asm volatile("" : "+v"(tidx)); const int half = tidx >> 8, tid = tidx & 255; float* sm = (float*)smem_raw + half * HALF_SM_FLOATS; \
                   char* wsb = (char*)ldp_raw(I_WS); (void)half; (void)tid; (void)sm; (void)wsb
#define GJOB_DEFAULT(g) pg8::GJob g; g.lda = D; g.ldb = D; g.K = D; g.nM = 32; g.nN = 8; g.a_pm_step = 256 * D; g.b_pn_mask = 0x7fffffff; g.b_pn_shift = 30; g.b_pn_step2 = 0; g.bid0 = 0; g.nblk = gridDim.x; g.a_pn_shift = 0; g.a_pn_mask = 0; g.a_pn_step = 0; g.b_pm_shift = 0; g.b_pm_step = 0; g.b_pn_step = 256 * D; \
                        g.ldc = D; g.R = nullptr; g.ldr = D; g.mode = 0; g.escale = 1.0f; g.gs = nullptr; g.denp = nullptr; g.qn = nullptr; g.gvec = nullptr; g.mo = nullptr; g.C2 = nullptr; g.rssp = nullptr; g.rstd = nullptr
#define GEMM_LDSP ((LAS unsigned char*)smem_raw)

    {
        PH_BEGIN();
        {
            LAS float* scr = (LAS float*)(LAS unsigned char*)(smem_raw) + (tidx >> 6) * (64 * 33);
            const int lane = tidx & 63;
            const int gw = blockIdx.x * 8 + (tidx >> 6), NGW = gridDim.x * 8;
            constexpr int I_IN = 32 * 192, I_SQ = 32 * 64, I_QK = 8 * 4 * 8;
            constexpr int NITEMS = I_IN + 6 * I_SQ + I_QK;
#pragma nounroll
            for (int it = gw; it < NITEMS; it += NGW) {
                const float* W; int ldw, K, csrc0, row0, kb; bf16_t* WT; float wscale = 1.0f; const float* kgain = nullptr;
                int r = it;
                if (r < I_IN) { const int nb = r % 192; kb = r / 192; W = PF(I_WIN); ldw = INC; K = D; csrc0 = nb * 32 + (nb >= 96 ? 8 : 0); WT = (bf16_t*)(wsb + O_WIN); row0 = nb * 32; }
                else if ((r -= I_IN) < 6 * I_SQ) {
                    const int wsel = r / I_SQ; r -= wsel * I_SQ; const int nb = r % 64; kb = r / 64; ldw = D; K = D; csrc0 = nb * 32; row0 = nb * 32;
                    W = PF(wsel == 0 ? I_WOUT : wsel == 1 ? I_WXQ : wsel == 2 ? I_WXK : wsel == 3 ? I_WXV : wsel == 4 ? I_WXO : I_WPQ);
                    WT = (bf16_t*)(wsb + O_WOUT + (size_t)wsel * ((size_t)D * D * 2));
                    if (wsel == 1) kgain = PF(I_GCROSS); else if (wsel == 5) kgain = PF(I_GFFN);
                } else {
                    r -= 6 * I_SQ; const int hq = r / 32; r -= hq * 32; const int nb = r % 8; kb = r / 8;
                    W = PF(hq < 4 ? I_WMQ : I_WMK) + (size_t)(hq & 3) * 65536; ldw = 256; K = 256; csrc0 = nb * 32; WT = (bf16_t*)(wsb + O_WQK); row0 = hq * 256 + nb * 32;
                    if (hq >= 4) wscale = 0.0625f;
                }
                p0_transpose_item(W, ldw, K, csrc0, WT, row0, scr, kb, lane, wscale, kgain);
            }
            {
                const float* ut = PF(I_UTAB); const float* vt = PF(I_VTAB); const float* gffn = PF(I_GFFN);
#pragma nounroll
                for (int row = gw; row < 32768; row += NGW) {
                    const bool second = row >= 16384; const int rr = second ? row - 16384 : row;
                    if (second) table_row_to_fp8(vt + (size_t)rr * D, W_VT + (size_t)rr * D, W_RSC + row, lane, nullptr);
                    else table_row_to_i8(ut + (size_t)rr * D, W_UT + (size_t)rr * D, W_RSC + row, lane, gffn);
                }
            }
            rope_table_fill(W_CS, blockIdx.x * NTHR + tidx, gridDim.x * NTHR);
            {
                const float* sk = PF(I_SUBK);
#pragma nounroll
                for (int i = blockIdx.x * NTHR + tidx; i < 262144 / 8; i += gridDim.x * NTHR) {
                    const float4 a = *(const float4*)(sk + (size_t)i * 8), b = *(const float4*)(sk + (size_t)i * 8 + 4);
                    uint4 o; o.x = pk2(a.x, a.y); o.y = pk2(a.z, a.w); o.z = pk2(b.x, b.y); o.w = pk2(b.z, b.w);
                    *(uint4*)(W_SKB + (size_t)i * 8) = o;
                }
            }
            __syncthreads();
        }
        {
            const float* rin = PF(I_X); const float* rg = PF(I_GMIX); const float* win = PF(I_WIN);
            float* gwT = (float*)smem_raw;
            for (int k = tidx; k < 2048; k += NTHR) { const float4 a = *(const float4*)(win + (size_t)k * INC + C_MI), b = *(const float4*)(win + (size_t)k * INC + C_MI + 4);
                gwT[k] = a.x; gwT[2048 + k] = a.y; gwT[4096 + k] = a.z; gwT[6144 + k] = a.w; gwT[8192 + k] = b.x; gwT[10240 + k] = b.y; gwT[12288 + k] = b.z; gwT[14336 + k] = b.w; }
            __syncthreads();
            {
#pragma nounroll
                for (int row = blockIdx.x * 8 + (tidx >> 6); row < T; row += gridDim.x * 8) { int ln = tidx & 63; asm volatile("" : "+v"(ln)); rmsnorm_row_wave(row, ln, rin, rg, W_HB, gwT, W_GPRE); }
                const float* min_ = PF(I_MEM); const float* mg = PF(I_GMEM);
#pragma nounroll
                for (int row = blockIdx.x * 8 + (tidx >> 6); row < 512; row += gridDim.x * 8) { int ln = tidx & 63; asm volatile("" : "+v"(ln)); rmsnorm_row_wave(row, ln, min_, mg, W_MN2, nullptr, nullptr); }
            }
        }
    }
    xcd_barrier(xb);
    {
        PH_BEGIN();
        GJOB_DEFAULT(g); g.A = W_HB; g.Bt = (bf16_t*)(wsb + O_WIN); g.nN = 24; g.C = (float*)W_P6; g.ldc = 1024;
        pg8::gemm_phase<4>(GEMM_LDSP, g, tidx);
    }
    xcd_barrier(xb);
    {
        PH_BEGIN();
        const float* cw = PF(I_CONVW); const float* cb = PF(I_CONVB);
#pragma nounroll
        PHASE_LOOP(T) d_conv_silu(VB, tid, W_P6, cw, cb, W_CBUF);
        {
            LAS unsigned short* wl = (LAS unsigned short*)(LAS unsigned char*)smem_raw + (tidx >> 6) * (16 * 136);
#pragma nounroll
            for (int item = blockIdx.x * 8 + (tidx >> 6); item < 12288; item += gridDim.x * 8) dil_tile_prep(item, tidx & 63, wl, W_P6 + 4 * P6S, W_P6 + 5 * P6S, W_CS, W_KB, W_VB);
            __syncthreads();
        }
        if (blockIdx.x < 8 && tidx < 64) mlstm_gates_wave(blockIdx.x >> 2, blockIdx.x & 3, tidx, W_GPRE, PF(I_BMI), PF(I_BMF), W_GS, W_DECAY);
#pragma nounroll
        PHASE_LOOP(2048) { const int it = VB, lt = it & 3, et = (it >> 2) & 3, h = (it >> 4) & 3, cg = it >> 6;
            transpose_tile64(tid, sm, W_P6 + P6S + (size_t)(cg * 256 + lt * 64) * 1024 + h * 256 + et * 64, 1024, W_BH + ((size_t)(cg * 4 + h) * 256 + et * 64) * 512 + lt * 64, 512, nullptr, 0); }
    }
    xcd_barrier(xb);
    {
        PH_BEGIN();
        {
            GJOB_DEFAULT(g); g.A = W_CBUF; g.lda = 1024; g.a_pm_step = 256 * 1024; g.Bt = (bf16_t*)(wsb + O_WQK); g.ldb = 256; g.b_pn_step = 256 * 256; g.K = 256; g.a_pn_mask = 3; g.a_pn_step = 256; g.C = (float*)W_MQ; g.ldc = 1024;
            pg8::gemm_phase<4>(GEMM_LDSP, g, tidx);
            __syncthreads();
        }
        const float* ga = PF(I_GAHEAD);
#pragma nounroll
        for (int qt = blockIdx.x * 8 + (tidx >> 6); qt < 2048; qt += gridDim.x * 8) dilated_wave_tile(qt, tidx & 63, W_P6 + 3 * P6S, W_CS, W_KB, W_VB, ga, W_MIXB);
    }
    xcd_barrier(xb);
    {
        PH_BEGIN();
#pragma nounroll
        PHASE_LOOP(2048) { const int it = VB, lt = it & 3, dt = (it >> 2) & 3, h = (it >> 4) & 3, cg = it >> 6;
            transpose_tile64(tid, sm, W_MK + (size_t)(cg * 256 + lt * 64) * 1024 + h * 256 + dt * 64, 1024, W_KWT + ((size_t)(cg * 4 + h) * 256 + dt * 64) * 256 + lt * 64, 256,
                             W_GS + ((size_t)(cg * 256 + lt * 64) * 4 + h) * 8 + 2, 32); }
        {
            const size_t nth = (size_t)gridDim.x * NTHR;
#pragma nounroll
            for (size_t i = (size_t)blockIdx.x * NTHR + tidx; i < (size_t)T * 128; i += nth) {
                const size_t t = i >> 7; const int c8 = (int)(i & 127) * 8, h = c8 >> 8, d = c8 & 255;
                const float sc = W_GS[(t * 4 + h) * 8 + 3];
                const uint4 v = *(const uint4*)(W_MQ + t * 1024 + c8);
                uint4 o;
                o.x = pk2(bf2f((unsigned short)(v.x & 0xFFFFu)) * sc, bf2f((unsigned short)(v.x >> 16)) * sc); o.y = pk2(bf2f((unsigned short)(v.y & 0xFFFFu)) * sc, bf2f((unsigned short)(v.y >> 16)) * sc);
                o.z = pk2(bf2f((unsigned short)(v.z & 0xFFFFu)) * sc, bf2f((unsigned short)(v.z >> 16)) * sc); o.w = pk2(bf2f((unsigned short)(v.w & 0xFFFFu)) * sc, bf2f((unsigned short)(v.w >> 16)) * sc);
                *(uint4*)(W_PQ + t * 2048 + h * 512 + 256 + d) = o;
            }
        }
#pragma nounroll
        PHASE_LOOP(128) { const int cgh = VB, cg = cgh >> 2, h = cgh & 3;
            float a = 0.f;
            for (int l = 0; l < 256; ++l) { const size_t t = (size_t)cg * 256 + l; a = fmaf(W_GS[(t * 4 + h) * 8 + 2], bf2f(W_MK[t * 1024 + h * 256 + tid]), a); }
            W_DN[(size_t)cgh * 256 + tid] = a; }
        __syncthreads();
        {
            GJOB_DEFAULT(g); g.A = W_MQ; g.lda = 1024; g.a_pm_step = 256 * 1024; g.a_pn_mask = 3; g.a_pn_step = 256; g.K = 256; g.nN = 4;
            g.Bt = W_MK; g.ldb = 1024; g.b_pn_step = 256; g.b_pm_step = 256 * 1024; g.C = (float*)W_PQ; g.gs = W_GS; g.denp = W_DENP;
            pg8::gemm_phase<6>(GEMM_LDSP, g, tidx);
        }
    }
    xcd_barrier(xb);
    {
        PH_BEGIN();
        GJOB_DEFAULT(g); g.A = W_BH; g.lda = 512; g.a_pm_step = 4 * 256 * 512; g.a_pn_mask = 3; g.a_pn_step = 256 * 512; g.K = 256; g.nN = 4;
        g.Bt = W_KWT; g.ldb = 256; g.b_pn_step = 65536; g.b_pm_step = 4 * 65536; g.C = W_DC;
        pg8::gemm_phase<7>(GEMM_LDSP, g, tidx);
    }
    xcd_barrier(xb);
    {
        PH_BEGIN();
        {
#pragma nounroll
            for (int gid = blockIdx.x * NTHR + tidx; gid < 131072; gid += gridDim.x * NTHR) {
                const int bh = gid >> 14, b = bh >> 2, h = bh & 3, e = (gid >> 6) & 255, d = (gid & 63) * 4;
                float4 C = make_float4(0.f, 0.f, 0.f, 0.f);
                float4 dcv[16]; float decv[16];
#pragma unroll
                for (int c = 0; c < 16; ++c) { const int cgh = (b * 16 + c) * 4 + h; decv[c] = W_DECAY[cgh]; dcv[c] = *(const float4*)(W_DC + ((size_t)cgh * 256 + e) * 256 + d); }
#pragma unroll
                for (int c = 0; c < 16; ++c) {
                    const int cgh = (b * 16 + c) * 4 + h;
                    uint2 o; o.x = pk2(C.x, C.y); o.y = pk2(C.z, C.w);
                    *(uint2*)(W_BH + ((size_t)cgh * 256 + e) * 512 + 256 + d) = o;
                    C.x = fmaf(decv[c], C.x, dcv[c].x); C.y = fmaf(decv[c], C.y, dcv[c].y); C.z = fmaf(decv[c], C.z, dcv[c].z); C.w = fmaf(decv[c], C.w, dcv[c].w);
                }
            }
        }
#pragma nounroll
        PHASE_LOOP(128) { const int cgh = VB, cg = cgh >> 2, h = cgh & 3, b = cg >> 4, c = cg & 15;
            float n = 0.f;
            for (int cc = 0; cc < c; ++cc) { const int j = (b * 16 + cc) * 4 + h; n = fmaf(W_DECAY[j], n, W_DN[(size_t)j * 256 + tid]); }
            __syncthreads();
            sm[tid] = n;
            __syncthreads();
            const int lane = tid & 63, w = tid >> 6;
            const float4 nv = *(const float4*)(sm + lane * 4);
#pragma unroll 1
            for (int i = 0; i < 64; i += 8) {
                float s[8];
#pragma unroll
                for (int k = 0; k < 8; ++k) {
                    const size_t t = (size_t)cg * 256 + w * 64 + i + k;
                    const ushort4 q4 = *(const ushort4*)(W_MQ + t * 1024 + h * 256 + lane * 4);
                    s[k] = bf2f(q4.x) * nv.x + bf2f(q4.y) * nv.y + bf2f(q4.z) * nv.z + bf2f(q4.w) * nv.w;
                }
#pragma unroll
                for (int k = 0; k < 8; ++k) { const float tot = wave_sum_dpp(s[k]); if (lane == 0) W_QN[((size_t)cg * 256 + w * 64 + i + k) * 4 + h] = tot; }
            }
        }
    }
    xcd_barrier(xb);
    {
        PH_BEGIN();
        GJOB_DEFAULT(g); g.A = W_PQ; g.a_pn_mask = 3; g.a_pn_step = 512; g.K = 512; g.nN = 4;
        g.Bt = W_BH; g.ldb = 512; g.b_pn_step = 256 * 512; g.b_pm_step = 4 * 256 * 512; g.C = (float*)W_MIXB;
        g.gs = W_GS; g.denp = W_DENP; g.qn = W_QN; g.gvec = PF(I_GMHEAD); g.mo = W_P6 + 2 * P6S; g.nblk = 128;
        if (blockIdx.x < 128) pg8::gemm_phase<8>(GEMM_LDSP, g, tidx);
        else {
            GJOB_DEFAULT(k); k.A = W_MN2; k.K = 1024; k.nM = 2; k.nN = 32; k.a_pn_shift = 4; k.a_pn_mask = 1; k.a_pn_step = 1024;
            k.Bt = (bf16_t*)(wsb + O_WXK); k.b_pn_mask = 15; k.b_pn_shift = 4; k.b_pn_step2 = 1024; k.C = W_KVP; k.bid0 = 128; k.nblk = 128;
            pg8::gemm_phase<12>(GEMM_LDSP, k, tidx);
        }
    }
    xcd_barrier(xb);
    {
        PH_BEGIN();
        for (int i = blockIdx.x * NTHR + tidx; i < 512 * 4096 / 4; i += gridDim.x * NTHR) {
            const int r = i >> 10, c = (i & 1023) * 4;
            const float4 a = *(const float4*)(W_KVP + (size_t)r * 4096 + c), b = *(const float4*)(W_KVP + (size_t)512 * 4096 + (size_t)r * 4096 + c);
            const float v0 = a.x + b.x, v1 = a.y + b.y, v2 = a.z + b.z, v3 = a.w + b.w;
            if (c < 2048) { uint2 o; o.x = pk2(v0, v1); o.y = pk2(v2, v3); *(uint2*)(W_KM + (size_t)r * 2048 + c) = o; }
            else { bf16_t* d = W_VMT + (size_t)(c - 2048) * 512 + r; d[0] = (bf16_t)f2bf(v0); d[512] = (bf16_t)f2bf(v1); d[1024] = (bf16_t)f2bf(v2); d[1536] = (bf16_t)f2bf(v3); }
        }
        GJOB_DEFAULT(g); g.A = W_MIXB; g.Bt = (bf16_t*)(wsb + O_WOUT); g.R = PF(I_X); g.C2 = W_HB; g.rssp = W_RSSP;
        pg8::gemm_phase<10>(GEMM_LDSP, g, tidx);
    }
    xcd_barrier(xb);
    {
        PH_BEGIN();
        {
            GJOB_DEFAULT(g); g.A = W_HB; g.Bt = (bf16_t*)(wsb + O_WXQ); g.C = (float*)W_QX;
            pg8::Unit u0;
            if (pg8::unit_next(g, 0, u0) && tidx < 256) { const size_t r = (size_t)u0.pm * 256 + tidx; float s = 0.f; for (int k = 0; k < 32; ++k) s += W_RSSP[r * 32 + k];
                ((LAS float*)(LAS unsigned char*)(smem_raw + GEMM_LDS + 1024 + 8192))[tidx] = rsqrtf(s * (1.0f / D) + EPS); }
            __syncthreads();
            pg8::gemm_phase<11>(GEMM_LDSP, g, tidx); __syncthreads();
        }

    }
    xcd_barrier(xb);
    {
        PH_BEGIN();
        GJOB_DEFAULT(g); g.A = W_QX; g.K = 512; g.a_pn_mask = 3; g.a_pn_step = 512; g.Bt = W_KM; g.b_pn_step = 512; g.b_pm_shift = 4; g.b_pm_step = 256 * D; g.nN = 4;
        g.C = (float*)W_PX; g.ldc = 1024; g.escale = 0.04419417382415922f * 1.4426950408889634f;
        pg8::gemm_phase<5>(GEMM_LDSP, g, tidx);
    }
    xcd_barrier(xb);
    {
        PH_BEGIN();
        GJOB_DEFAULT(g); g.A = W_PX; g.lda = 1024; g.a_pm_step = 256 * 1024; g.K = 256; g.a_pn_shift = 1; g.a_pn_mask = 3; g.a_pn_step = 256; g.Bt = W_VMT; g.ldb = 512; g.b_pn_step = 256 * 512; g.b_pm_shift = 4; g.b_pm_step = 256;
        g.C = (float*)W_MIXB;
        pg8::gemm_phase<3>(GEMM_LDSP, g, tidx);
    }
    xcd_barrier(xb);
    {
        PH_BEGIN();
        GJOB_DEFAULT(g); g.A = W_MIXB; g.Bt = (bf16_t*)(wsb + O_WXO); g.R = nullptr; g.C2 = W_HB; g.rssp = W_RSSP;
        pg8::gemm_phase<10>(GEMM_LDSP, g, tidx);
    }
    xcd_barrier(xb);
    {
        PH_BEGIN();
        GJOB_DEFAULT(g); g.A = W_HB; g.Bt = (bf16_t*)(wsb + O_WPQ); g.C = (float*)W_QX;
        pg8::Unit u0;
        if (pg8::unit_next(g, 0, u0) && tidx < 256) { const size_t r = (size_t)u0.pm * 256 + tidx; float s = 0.f; for (int k = 0; k < 32; ++k) s += W_RSSP[r * 32 + k];
            const float rs = rsqrtf(s * (1.0f / D) + EPS);
            ((LAS float*)(LAS unsigned char*)(smem_raw + GEMM_LDS + 1024 + 8192))[tidx] = rs; W_RSTD[r] = rs; }
        __syncthreads();
        pg8::gemm_phase<11>(GEMM_LDSP, g, tidx);
    }
    xcd_barrier(xb);
    {
        PH_BEGIN();
        LAS float* wl = (LAS float*)(LAS unsigned char*)smem_raw + (tidx >> 6) * 1024;
#pragma nounroll
        for (int item = blockIdx.x * 8 + (tidx >> 6); item < 4096; item += gridDim.x * 8) peer_topk_wave2(item, tidx & 63, wl, W_QX, W_SKB, W_IDS, W_GATES);
    }
    xcd_barrier(xb);
    {
        PH_BEGIN();
        const float* gf = PF(I_GFINAL); float* outp = (float*)ldp_raw(I_OUT);
        LAS unsigned char* wl = (LAS unsigned char*)smem_raw + (tidx >> 6) * 11776;
#pragma nounroll
        for (int gw = blockIdx.x * 8 + (tidx >> 6); gw < T / 4; gw += gridDim.x * 8) { int ln = tidx & 63; asm volatile("" : "+v"(ln));
            peer_sweep_wave(gw, ln, wl, W_HB, W_XR, W_IDS, W_GATES, W_UT, W_VT, W_RSC, W_RSTD, gf, outp); }
    }
}
}

extern "C" void kernel_launch(void* const* d_in, const int* in_sizes, int n_in, void* d_out, int out_size, void* d_ws, size_t ws_size, hipStream_t stream) {
    static int grid_blocks = 0;
    if (!grid_blocks) {
        int dev = 0, cus = 0, per_cu = 0;
        hipGetDevice(&dev);
        hipDeviceGetAttribute(&cus, hipDeviceAttributeMultiprocessorCount, dev);
        hipFuncSetAttribute((const void*)mega, hipFuncAttributeMaxDynamicSharedMemorySize, SMEM_BYTES);
        hipOccupancyMaxActiveBlocksPerMultiprocessor(&per_cu, mega, NTHR, SMEM_BYTES);
        if (per_cu > 1) per_cu = 1;
        if (per_cu < 1) per_cu = 1;
        grid_blocks = cus * per_cu;
    }
    Params P{};
    const float** pp = (const float**)&P;
    for (int i = 0; i < 25; ++i) pp[i] = (const float*)d_in[i];
    P.out = (float*)d_out;
    P.bar = (unsigned*)d_ws;
    P.ws = (float*)((char*)d_ws + 16384);
    hipMemsetAsync(d_ws, 0, 16384, stream);
    void* args[] = {&P};
    hipError_t e = hipLaunchCooperativeKernel((const void*)mega, dim3(grid_blocks), dim3(NTHR), args, SMEM_BYTES, stream);
    if (e != hipSuccess) fprintf(stderr, "cooperative launch failed: %s (grid %d)\n", hipGetErrorString(e), grid_blocks);
}
```

```cpp
#include <hip/hip_runtime.h>
#include <stdint.h>
#include <math.h>
#include <cstdio>

#define LAS_ __attribute__((address_space(3)))
namespace {
constexpr int D = 2048, NB = 2, S = 4096, T = NB * S;
constexpr int INC = 6152;
constexpr int C_MIN = 0, C_MV = 1024, C_MO = 2048, C_MI = 3072, C_MF = 3076, C_AQ = 3080, C_AK = 4104, C_AV = 5128;
constexpr float EPS = 1e-6f;
constexpr size_t P6S = (size_t)8192 * 1024;
constexpr int NTHR = 512;
constexpr int HALF_SM_FLOATS = 8704;
constexpr int GEMM_LDS = 131072;
constexpr int SMEM_BYTES = 163840;
constexpr int CTRL_OFF = SMEM_BYTES - 1024;
typedef unsigned short bf16_t;
__device__ __forceinline__ unsigned f2bf(float f) { unsigned u = __float_as_uint(f); u += 0x7FFFu + ((u >> 16) & 1u); return u >> 16; }
__device__ __forceinline__ unsigned pk2(float lo, float hi) { return f2bf(lo) | (f2bf(hi) << 16); }
__device__ __forceinline__ float bf2f(unsigned short b) { return __uint_as_float(((unsigned)b) << 16); }
extern __shared__ __attribute__((aligned(16))) unsigned char smem_raw[];
enum { I_X = 0, I_MEM, I_GMIX, I_WIN, I_CONVW, I_CONVB, I_WMQ, I_WMK, I_BMI, I_BMF, I_GMHEAD, I_GAHEAD, I_WOUT, I_GCROSS, I_GMEM,
       I_WXQ, I_WXK, I_WXV, I_WXO, I_GFFN, I_WPQ, I_SUBK, I_UTAB, I_VTAB, I_GFINAL, I_OUT, I_BAR, I_WS, I_NPTR };
__device__ __forceinline__ unsigned long long ldp_raw(int i) {
    const LAS_ unsigned long long* tab = (const LAS_ unsigned long long*)(LAS_ unsigned char*)(smem_raw + CTRL_OFF + 64);
    const unsigned long long v = tab[i];
    const unsigned lo = __builtin_amdgcn_readfirstlane((unsigned)v), hi = __builtin_amdgcn_readfirstlane((unsigned)(v >> 32));
    return ((unsigned long long)hi << 32) | lo;
}
#define PF(i) ((const float*)ldp_raw(i))

#define XB_TMO      128
#define XB_XCNT(j)  (256  + 64 * (j))
#define XB_XSUB(j)  (1280 + 64 * (j))
#define XB_XGEN(j)  (2304 + 64 * (j))
#define XB_TOP      3328
#define XB_TOPGEN   3392
#define XCD_BAR_WORDS 3456
#define XB_SPIN_CAP (1u << 22)
#define LAS __attribute__((address_space(3)))

__device__ __forceinline__ unsigned xb_ld(unsigned* p)              { return __hip_atomic_load(p, __ATOMIC_RELAXED, __HIP_MEMORY_SCOPE_AGENT); }
__device__ __forceinline__ unsigned xb_add(unsigned* p, unsigned v) { return __hip_atomic_fetch_add(p, v, __ATOMIC_RELAXED, __HIP_MEMORY_SCOPE_AGENT); }
__device__ __forceinline__ unsigned xb_xcc_id() { return (unsigned)__builtin_amdgcn_s_getreg((3 << 11) | 20) & 0xFu; }
#define XB_SPIN(cond, bar) do { unsigned _sp = 0; while (cond) { __builtin_amdgcn_s_sleep(1); \
    if ((++_sp & 255u) == 0u) { if (xb_ld(&(bar)[XB_TMO])) break; if (_sp > XB_SPIN_CAP) { atomicAdd(&(bar)[XB_TMO], 1u); break; } } } } while (0)

struct XcdBarrier { unsigned* bar; unsigned x; volatile LAS unsigned* st; };

__device__ __forceinline__ XcdBarrier xcd_barrier_post(unsigned* bar, volatile LAS unsigned* st) {
    XcdBarrier b; b.bar = bar; b.x = xb_xcc_id(); b.st = st;
    if (threadIdx.x == 0) (void)xb_add(&bar[XB_XCNT(b.x)], 1u);
    return b;
}
__device__ __forceinline__ void xcd_barrier_complete(unsigned* bar, unsigned x, unsigned& nloc, unsigned& nx) {
    const unsigned G = gridDim.x * gridDim.y * gridDim.z;
    unsigned sum, cnt, mine, sp = 0u;
    for (;;) {
        sum = 0u; cnt = 0u; mine = 0u;
#pragma unroll
        for (unsigned j = 0; j < 16; ++j) { const unsigned c = xb_ld(&bar[XB_XCNT(j)]); sum += c; cnt += (c > 0u) ? 1u : 0u; mine = (j == x) ? c : mine; }
        if (sum == G) break;
        __builtin_amdgcn_s_sleep(1);
        if ((++sp & 255u) == 0u) { if (xb_ld(&bar[XB_TMO])) break; if (sp > XB_SPIN_CAP) { atomicAdd(&bar[XB_TMO], 1u); break; } }
    }
    nloc = mine > 0u ? mine : 1u; nx = cnt > 0u ? cnt : 1u;
}
__device__ __forceinline__ void xcd_barrier(const XcdBarrier& b) {
    asm volatile("s_waitcnt vmcnt(0)" ::: "memory");
    __syncthreads();
    if (threadIdx.x == 0) {
        unsigned* bar = b.bar;
        __builtin_amdgcn_s_waitcnt(0);
        unsigned nloc = b.st[0], nx = b.st[1];
        if (nloc == 0u) { xcd_barrier_complete(bar, b.x, nloc, nx); b.st[0] = nloc; b.st[1] = nx; }
        const unsigned old = xb_add(&bar[XB_XSUB(b.x)], 1u);
        const unsigned gen = old / nloc;
        if (old + 1u == (gen + 1u) * nloc) {
            __builtin_amdgcn_fence(__ATOMIC_RELEASE, "agent");
            asm volatile("s_waitcnt vmcnt(0)" ::: "memory");
            const unsigned og = xb_add(&bar[XB_TOP], 1u);
            const unsigned tg = og / nx;
            if (og + 1u == (tg + 1u) * nx) xb_add(&bar[XB_TOPGEN], 1u);
            else XB_SPIN(xb_ld(&bar[XB_TOPGEN]) == tg, bar);
            __builtin_amdgcn_fence(__ATOMIC_ACQUIRE, "agent");
            xb_add(&bar[XB_XGEN(b.x)], 1u);
            asm volatile("s_waitcnt vmcnt(0)" ::: "memory");
        } else {
            XB_SPIN(xb_ld(&bar[XB_XGEN(b.x)]) == gen, bar);
            __builtin_amdgcn_fence(__ATOMIC_ACQUIRE, "agent");
            asm volatile("s_waitcnt vmcnt(0)" ::: "memory");
        }
    }
    __syncthreads();
}

__device__ __forceinline__ float wave_sum(float v) {
#pragma unroll
    for (int o = 32; o >= 1; o >>= 1) v += __shfl_xor(v, o);
    return v;
}
__device__ __forceinline__ float wave_max(float v) {
#pragma unroll
    for (int o = 32; o >= 1; o >>= 1) v = fmaxf(v, __shfl_xor(v, o));
    return v;
}
__device__ __forceinline__ float log_sigmoid(float x) { return fminf(x, 0.f) - log1pf(expf(-fabsf(x))); }


__device__ __forceinline__ void d_rmsnorm(int vb, int t, float* sm, const float* __restrict__ in, const float* __restrict__ g, bf16_t* __restrict__ out,
                                          const float* gwl  , float* __restrict__ gpre) {
    float* red = sm;
    const int row = vb;
    const float4* p = (const float4*)(in + (size_t)row * D);
    float4 a = p[t], b = p[t + 256];
    float s = a.x * a.x + a.y * a.y + a.z * a.z + a.w * a.w + b.x * b.x + b.y * b.y + b.z * b.z + b.w * b.w;
    s = wave_sum(s);
    __syncthreads();
    if ((t & 63) == 0) red[t >> 6] = s;
    __syncthreads();
    const float tot = red[0] + red[1] + red[2] + red[3];
    const float r = rsqrtf(tot * (1.0f / D) + EPS);
    const float4* gp = (const float4*)g;
    float4 ga = gp[t], gb = gp[t + 256];
    float hv[8] = {a.x * r * ga.x, a.y * r * ga.y, a.z * r * ga.z, a.w * r * ga.w, b.x * r * gb.x, b.y * r * gb.y, b.z * r * gb.z, b.w * r * gb.w};
    uint2 o0, o1;
    o0.x = pk2(hv[0], hv[1]); o0.y = pk2(hv[2], hv[3]); o1.x = pk2(hv[4], hv[5]); o1.y = pk2(hv[6], hv[7]);
    *(uint2*)(out + (size_t)row * D + t * 4) = o0;
    *(uint2*)(out + (size_t)row * D + 1024 + t * 4) = o1;
    if (gpre) {
        float gs[8];
#pragma unroll
        for (int c = 0; c < 8; ++c) gs[c] = 0.f;
#pragma unroll
        for (int j = 0; j < 8; ++j) {
            const int k = (j < 4) ? (t * 4 + j) : (1024 + t * 4 + (j - 4));
            const float4 w0 = *(const float4*)(gwl + k * 8), w1 = *(const float4*)(gwl + k * 8 + 4);
            gs[0] = fmaf(hv[j], w0.x, gs[0]); gs[1] = fmaf(hv[j], w0.y, gs[1]); gs[2] = fmaf(hv[j], w0.z, gs[2]); gs[3] = fmaf(hv[j], w0.w, gs[3]);
            gs[4] = fmaf(hv[j], w1.x, gs[4]); gs[5] = fmaf(hv[j], w1.y, gs[5]); gs[6] = fmaf(hv[j], w1.z, gs[6]); gs[7] = fmaf(hv[j], w1.w, gs[7]);
        }
#pragma unroll
        for (int c = 0; c < 8; ++c) gs[c] = wave_sum(gs[c]);
        __syncthreads();
        if ((t & 63) == 0) {
#pragma unroll
            for (int c = 0; c < 8; ++c) red[8 + (t >> 6) * 8 + c] = gs[c];
        }
        __syncthreads();
        if (t < 8) gpre[(size_t)row * 8 + t] = red[8 + t] + red[16 + t] + red[24 + t] + red[32 + t];
    }
}

namespace pg8 {
typedef short bf16x8 __attribute__((ext_vector_type(8)));
typedef float f32x4 __attribute__((ext_vector_type(4)));
constexpr int BM = 256, BK = 64, HALF = 128, HTB = HALF * BK * 2, NXCD = 8, WGM = 8;
__device__ __forceinline__ int lds_byte(int r, int c) { const int st = (r >> 4) * 2 + (c >> 5), rr = r & 15, cc = c & 31, ob = rr * 64 + cc * 2; return st * 1024 + (ob ^ (((ob >> 9) & 1) << 5)); }
__device__ __forceinline__ void stage_rc(int b, int& R, int& C) { const int st = b / 1024, sb = b % 1024, swz = sb ^ (((sb >> 9) & 1) << 5); R = (st >> 1) * 16 + swz / 64; C = (st & 1) * 32 + (swz % 64) / 2; }
struct Unit { int pm, pn; };
struct GJob {
    const bf16_t* A; const bf16_t* Bt;
    int lda, ldb, K, nM, nN;
    int a_pn_shift, a_pn_mask, a_pn_step;
    int b_pm_shift, b_pm_step, b_pn_step;
    int a_pm_step;
    int b_pn_mask, b_pn_shift, b_pn_step2;
    int bid0, nblk;
    float escale;
    const float* gs; float* denp; const float* qn; const float* gvec; const bf16_t* mo;
    bf16_t* C2; float* rssp; const float* rstd;
    float* C; int ldc; const float* R; int ldr;
    int mode;
};
__device__ __forceinline__ bool unit_next(const GJob& g, int i, Unit& u) {
    const int nwg = g.nM * g.nN;
    const int bid = (int)blockIdx.x - g.bid0; if (bid < 0 || bid >= g.nblk) return false;
    const long L = (long)i * g.nblk + bid; if (L >= nwg) return false;
    int wgid = (int)L; { const int q = nwg / NXCD, r = nwg % NXCD, xcd = wgid % NXCD, off = wgid / NXCD; wgid = (xcd < r ? xcd * (q + 1) : r * (q + 1) + (xcd - r) * q) + off; }
    const int nig = WGM * g.nN, gid = wgid / nig, fm = gid * WGM, gsz = (g.nM - fm) < WGM ? (g.nM - fm) : WGM;
    u.pm = fm + ((wgid % nig) % gsz); u.pn = (wgid % nig) / gsz; return true;
}
template <int MODE> __device__ __forceinline__ void epilogue(const GJob& g, f32x4 (&acc)[2][2][4][2], const Unit& u, int wr, int wc, int fr, int fq, LAS unsigned char* xlds) {
    const int row0 = u.pm * BM + wr * 64 + fr;
    if constexpr (MODE == 0) {
        const int col0 = u.pn * BM + wc * 32 + 4 * fq;
#pragma unroll
        for (int ai = 0; ai < 2; ++ai)
#pragma unroll
            for (int m = 0; m < 4; ++m) {
                const int row = row0 + ai * HALF + m * 16;
                float* rowp = g.C + (size_t)row * g.ldc + col0;
                const float* rp = g.R ? g.R + (size_t)row * g.ldr + col0 : nullptr;
#pragma unroll
                for (int bj = 0; bj < 2; ++bj)
#pragma unroll
                    for (int n = 0; n < 2; ++n) {
                        f32x4 v = acc[ai][bj][m][n];
                        if (rp) v = v + *(const f32x4*)(rp + bj * HALF + n * 16);
                        *(f32x4*)(rowp + bj * HALF + n * 16) = v;
                    }
            }
    } else if constexpr (MODE == 10) {
        const int col0 = u.pn * BM + wc * 32 + 4 * fq;
#pragma unroll
        for (int ai = 0; ai < 2; ++ai)
#pragma unroll
            for (int m = 0; m < 4; ++m) {
                const int row = row0 + ai * HALF + m * 16;
                bf16_t* r2 = g.C2 + (size_t)row * D + col0;
                float ss = 0.f;
#pragma unroll
                for (int bj = 0; bj < 2; ++bj)
#pragma unroll
                    for (int n = 0; n < 2; ++n) {
                        f32x4 v = acc[ai][bj][m][n];
                        if (g.R) v = v + *(const f32x4*)(g.R + (size_t)row * g.ldr + col0 + bj * HALF + n * 16);
                        else { const uint2 pr = *(const uint2*)(r2 + bj * HALF + n * 16);
                               v[0] += __uint_as_float(pr.x << 16); v[1] += __uint_as_float(pr.x & 0xFFFF0000u); v[2] += __uint_as_float(pr.y << 16); v[3] += __uint_as_float(pr.y & 0xFFFF0000u); }
                        uint2 o; o.x = pk2(v[0], v[1]); o.y = pk2(v[2], v[3]);
                        *(uint2*)(r2 + bj * HALF + n * 16) = o;
                        ss += (v[0] * v[0] + v[1] * v[1]) + (v[2] * v[2] + v[3] * v[3]);
                    }
                ss += __shfl_xor(ss, 16); ss += __shfl_xor(ss, 32);
                if (fq == 0) g.rssp[(size_t)row * 32 + u.pn * 4 + wc] = ss;
            }
    } else if constexpr (MODE == 11) {
        bf16_t* Cb = (bf16_t*)g.C;
        const int col0 = u.pn * BM + wc * 32 + 4 * fq;
#pragma unroll
        for (int ai = 0; ai < 2; ++ai)
#pragma unroll
            for (int m = 0; m < 4; ++m) {
                const int row = row0 + ai * HALF + m * 16;
                const float rs = ((const LAS float*)(xlds + 8192))[row - u.pm * BM];
                bf16_t* rowp = Cb + (size_t)row * g.ldc + col0;
#pragma unroll
                for (int bj = 0; bj < 2; ++bj)
#pragma unroll
                    for (int n = 0; n < 2; ++n) {
                        const f32x4 v = acc[ai][bj][m][n] * rs;
                        uint2 o; o.x = pk2(v[0], v[1]); o.y = pk2(v[2], v[3]);
                        *(uint2*)(rowp + bj * HALF + n * 16) = o;
                    }
            }
    } else if constexpr (MODE == 6) {
        const int h = u.pn; const size_t t0 = (size_t)u.pm * BM;
        bf16_t* Cb = (bf16_t*)g.C;
#pragma unroll
        for (int ai = 0; ai < 2; ++ai)
#pragma unroll
            for (int m = 0; m < 4; ++m) {
                const int l = ai * HALF + wr * 64 + m * 16 + fr;
                const float M2 = g.gs[((t0 + l) * 4 + h) * 8 + 1];
                bf16_t* rowp = Cb + (t0 + l) * 2048 + h * 512 + wc * 32 + 4 * fq;
                float rs = 0.f;
#pragma unroll
                for (int bj = 0; bj < 2; ++bj)
#pragma unroll
                    for (int n = 0; n < 2; ++n) {
                        const f32x4 a = acc[ai][bj][m][n];
                        const int s0 = bj * HALF + wc * 32 + n * 16 + 4 * fq;
                        float p[4];
#pragma unroll
                        for (int r = 0; r < 4; ++r) { const float u2 = g.gs[((t0 + s0 + r) * 4 + h) * 8 + 0]; p[r] = (s0 + r <= l) ? a[r] * __builtin_amdgcn_exp2f(u2 - M2) : 0.f; rs += p[r]; }
                        uint2 o; o.x = pk2(p[0], p[1]); o.y = pk2(p[2], p[3]);
                        *(uint2*)(rowp + bj * HALF + n * 16) = o;
                    }
                rs += __shfl_xor(rs, 16); rs += __shfl_xor(rs, 32);
                if (fq == 0) g.denp[((t0 + l) * 4 + h) * 4 + wc] = rs;
            }
    } else if constexpr (MODE == 12) {
        float* Ct = g.C + (size_t)(u.pn >> 4) * ((size_t)512 * 4096) + (size_t)(u.pn & 15) * 256;
        const int col0 = wc * 32 + 4 * fq;
#pragma unroll
        for (int ai = 0; ai < 2; ++ai)
#pragma unroll
            for (int m = 0; m < 4; ++m) {
                float* rowp = Ct + (size_t)(row0 + ai * HALF + m * 16) * 4096 + col0;
#pragma unroll
                for (int bj = 0; bj < 2; ++bj)
#pragma unroll
                    for (int n = 0; n < 2; ++n) *(f32x4*)(rowp + bj * HALF + n * 16) = acc[ai][bj][m][n];
            }
    } else if constexpr (MODE == 7) {
        float* Ct = g.C + (size_t)(u.pm * 4 + u.pn) * 65536;
        const int col0 = wc * 32 + 4 * fq;
#pragma unroll
        for (int ai = 0; ai < 2; ++ai)
#pragma unroll
            for (int m = 0; m < 4; ++m) {
                float* rowp = Ct + (size_t)(ai * HALF + wr * 64 + m * 16 + fr) * 256 + col0;
#pragma unroll
                for (int bj = 0; bj < 2; ++bj)
#pragma unroll
                    for (int n = 0; n < 2; ++n) *(f32x4*)(rowp + bj * HALF + n * 16) = acc[ai][bj][m][n];
            }
    } else if constexpr (MODE == 8) {
        const int h = u.pn; const size_t t0 = (size_t)u.pm * BM;
        LAS float* X0 = (LAS float*)xlds + wr * 512;
#pragma unroll
        for (int ai = 0; ai < 2; ++ai)
#pragma unroll
            for (int m = 0; m < 4; ++m) {
                const size_t th = (t0 + ai * HALF + wr * 64 + m * 16 + fr) * 4 + h;
                const f32x4 dp = *(const f32x4*)(g.denp + th * 4);
                const float den = (dp[0] + dp[1]) + (dp[2] + dp[3]) + g.gs[th * 8 + 3] * g.qn[th];
                const float rden = 1.0f / fmaxf(fabsf(den), g.gs[th * 8 + 4]);
                float ss = 0.f;
#pragma unroll
                for (int bj = 0; bj < 2; ++bj)
#pragma unroll
                    for (int n = 0; n < 2; ++n) { f32x4 a = acc[ai][bj][m][n] * rden; acc[ai][bj][m][n] = a; ss += (a[0] * a[0] + a[1] * a[1]) + (a[2] * a[2] + a[3] * a[3]); }
                ss += __shfl_xor(ss, 16); ss += __shfl_xor(ss, 32);
                if (fq == 0) X0[(ai * 64 + m * 16 + fr) * 4 + wc] = ss;
            }
        asm volatile("s_waitcnt lgkmcnt(0)" ::: "memory"); __builtin_amdgcn_s_barrier(); asm volatile("" ::: "memory");
        bf16_t* Cb = (bf16_t*)g.C;
        const int col0 = wc * 32 + 4 * fq;
#pragma unroll
        for (int ai = 0; ai < 2; ++ai)
#pragma unroll
            for (int m = 0; m < 4; ++m) {
                const f32x4 p4 = *(const LAS f32x4*)(X0 + (ai * 64 + m * 16 + fr) * 4);
                const float rsn = rsqrtf(((p4[0] + p4[1]) + (p4[2] + p4[3])) * (1.0f / 256.0f) + EPS);
                const size_t t = t0 + ai * HALF + wr * 64 + m * 16 + fr;
                bf16_t* rowp = Cb + t * 2048 + h * 256 + col0;
                const bf16_t* mop = g.mo + t * 1024 + h * 256 + col0;
#pragma unroll
                for (int bj = 0; bj < 2; ++bj)
#pragma unroll
                    for (int n = 0; n < 2; ++n) {
                        const f32x4 a = acc[ai][bj][m][n];
                        const ushort4 mo4 = *(const ushort4*)(mop + bj * HALF + n * 16);
                        const f32x4 gv = *(const f32x4*)(g.gvec + h * 256 + col0 + bj * HALF + n * 16);
                        const float o0 = a[0] * rsn * gv[0] / (1.0f + __expf(-bf2f(mo4.x)));
                        const float o1 = a[1] * rsn * gv[1] / (1.0f + __expf(-bf2f(mo4.y)));
                        const float o2 = a[2] * rsn * gv[2] / (1.0f + __expf(-bf2f(mo4.z)));
                        const float o3 = a[3] * rsn * gv[3] / (1.0f + __expf(-bf2f(mo4.w)));
                        uint2 o; o.x = pk2(o0, o1); o.y = pk2(o2, o3);
                        *(uint2*)(rowp + bj * HALF + n * 16) = o;
                    }
            }
    } else if constexpr (MODE == 5) {
        LAS float* X0 = (LAS float*)xlds + wr * 512;
        LAS float* X1 = (LAS float*)xlds + 1024 + wr * 512;
#pragma unroll
        for (int ai = 0; ai < 2; ++ai)
#pragma unroll
            for (int m = 0; m < 4; ++m) {
                float v = -INFINITY;
#pragma unroll
                for (int bj = 0; bj < 2; ++bj)
#pragma unroll
                    for (int n = 0; n < 2; ++n) { const f32x4 a = acc[ai][bj][m][n]; v = fmaxf(v, fmaxf(fmaxf(a[0], a[1]), fmaxf(a[2], a[3]))); }
                v = fmaxf(v, __shfl_xor(v, 16)); v = fmaxf(v, __shfl_xor(v, 32));
                if (fq == 0) X0[(ai * 64 + m * 16 + fr) * 4 + wc] = v;
            }
        asm volatile("s_waitcnt lgkmcnt(0)" ::: "memory"); __builtin_amdgcn_s_barrier(); asm volatile("" ::: "memory");
#pragma unroll
        for (int ai = 0; ai < 2; ++ai)
#pragma unroll
            for (int m = 0; m < 4; ++m) {
                const f32x4 p4 = *(const LAS f32x4*)(X0 + (ai * 64 + m * 16 + fr) * 4);
                const float mxr = fmaxf(fmaxf(p4[0], p4[1]), fmaxf(p4[2], p4[3])) * g.escale;
                float s = 0.f;
#pragma unroll
                for (int bj = 0; bj < 2; ++bj)
#pragma unroll
                    for (int n = 0; n < 2; ++n) { f32x4 a = acc[ai][bj][m][n];
                        a[0] = __builtin_amdgcn_exp2f(a[0] * g.escale - mxr); a[1] = __builtin_amdgcn_exp2f(a[1] * g.escale - mxr); a[2] = __builtin_amdgcn_exp2f(a[2] * g.escale - mxr); a[3] = __builtin_amdgcn_exp2f(a[3] * g.escale - mxr);
                        acc[ai][bj][m][n] = a; s += (a[0] + a[1]) + (a[2] + a[3]); }
                s += __shfl_xor(s, 16); s += __shfl_xor(s, 32);
                if (fq == 0) X1[(ai * 64 + m * 16 + fr) * 4 + wc] = s;
            }
        asm volatile("s_waitcnt lgkmcnt(0)" ::: "memory"); __builtin_amdgcn_s_barrier(); asm volatile("" ::: "memory");
        bf16_t* Cb = (bf16_t*)g.C;
        const int col0 = u.pn * BM + wc * 32 + 4 * fq;
#pragma unroll
        for (int ai = 0; ai < 2; ++ai)
#pragma unroll
            for (int m = 0; m < 4; ++m) {
                const f32x4 p4 = *(const LAS f32x4*)(X1 + (ai * 64 + m * 16 + fr) * 4);
                const float inv = 1.0f / ((p4[0] + p4[1]) + (p4[2] + p4[3]));
                bf16_t* rowp = Cb + (size_t)(row0 + ai * HALF + m * 16) * g.ldc + col0;
#pragma unroll
                for (int bj = 0; bj < 2; ++bj)
#pragma unroll
                    for (int n = 0; n < 2; ++n) {
                        const f32x4 a = acc[ai][bj][m][n];
                        uint2 o; o.x = pk2(a[0] * inv, a[1] * inv); o.y = pk2(a[2] * inv, a[3] * inv);
                        *(uint2*)(rowp + bj * HALF + n * 16) = o;
                    }
            }
    } else {
        bf16_t* Cb = (bf16_t*)g.C; int ccol = u.pn * BM;
        if constexpr (MODE == 4) { Cb += (size_t)(u.pn >> 2) * P6S; ccol = (u.pn & 3) * 256; }
        const int col0 = ccol + wc * 32 + 4 * fq;
#pragma unroll
        for (int ai = 0; ai < 2; ++ai)
#pragma unroll
            for (int m = 0; m < 4; ++m) {
                bf16_t* rowp = Cb + (size_t)(row0 + ai * HALF + m * 16) * g.ldc + col0;
#pragma unroll
                for (int bj = 0; bj < 2; ++bj)
#pragma unroll
                    for (int n = 0; n < 2; ++n) {
                        const f32x4 v = acc[ai][bj][m][n];
                        uint2 o; o.x = pk2(v[0], v[1]); o.y = pk2(v[2], v[3]);
                        *(uint2*)(rowp + bj * HALF + n * 16) = o;
                    }
            }
    }
}
template <int MODE> __device__ __forceinline__ void gemm_phase(LAS unsigned char* lds, const GJob& g, int tid) {
    const int wid = __builtin_amdgcn_readfirstlane(tid >> 6), lane = tid & 63, wr = wid >> 2, wc = wid & 3, fr = lane & 15, fq = lane >> 4;
    const int K = g.K, nt = K / BK;
    unsigned voffA[2], voffB[2];
#pragma unroll
    for (int i = 0; i < 2; ++i) { int R, C; stage_rc(tid * 16 + i * 8192, R, C);
        voffA[i] = (unsigned)(R * g.lda + C) * 2u; voffB[i] = (unsigned)(R * g.ldb + C) * 2u; }
    const size_t kstep = (size_t)(BK * 2);
    const size_t hstepA = (size_t)HALF * g.lda * 2, hstepB = (size_t)HALF * g.ldb * 2;
    const unsigned ldsw = (unsigned)wid * 1024u;
    const int aoff = lds_byte(wr * 64 + fr, fq * 8), boff = lds_byte(wc * 32 + fr, fq * 8);
#define PG8_SA(b, h) (((b) * 2 + (h)) * HTB)
#define PG8_SB(b, h) ((4 + (b) * 2 + (h)) * HTB)
#define PG8_STAGE(bufoff, gbase, voff) do { _Pragma("unroll") for (int _i = 0; _i < 2; ++_i) \
        __builtin_amdgcn_global_load_lds((const unsigned*)((const char*)(gbase) + (voff)[_i]), (LAS unsigned*)(lds + (bufoff) + ldsw + _i * 8192), 16, 0, 0); } while (0)
#define PG8_LDA(dst, b, h) do { _Pragma("unroll") for (int m = 0; m < 4; ++m) _Pragma("unroll") for (int k = 0; k < 2; ++k) dst[m][k] = *(const LAS bf16x8*)(lds + PG8_SA(b, h) + aoff + m * 2048 + k * 1024); } while (0)
#define PG8_LDB(dst, b, h) do { _Pragma("unroll") for (int n = 0; n < 2; ++n) _Pragma("unroll") for (int k = 0; k < 2; ++k) dst[n][k] = *(const LAS bf16x8*)(lds + PG8_SB(b, h) + boff + n * 2048 + k * 1024); } while (0)
#define PG8_MMA(ai, bj, At, Bt) do { __builtin_amdgcn_s_setprio(1); _Pragma("unroll") for (int m = 0; m < 4; ++m) _Pragma("unroll") for (int n = 0; n < 2; ++n) _Pragma("unroll") for (int k = 0; k < 2; ++k) \
        acc[ai][bj][m][n] = __builtin_amdgcn_mfma_f32_16x16x32_bf16(Bt[n][k], At[m][k], acc[ai][bj][m][n], 0, 0, 0); __builtin_amdgcn_s_setprio(0); } while (0)
#define PG8_WAIT_V(n) asm volatile("s_waitcnt vmcnt(" #n ")" ::: "memory")
#define PG8_WAIT_L(n) asm volatile("s_waitcnt lgkmcnt(" #n ")" ::: "memory")
#define PG8_BAR __builtin_amdgcn_s_barrier()
#define PG8_SCHED __builtin_amdgcn_sched_barrier(0)
#define PG8_ABASE(u) ((const char*)g.A + ((size_t)(u).pm * g.a_pm_step + (size_t)(((u).pn >> g.a_pn_shift) & g.a_pn_mask) * g.a_pn_step) * 2)
#define PG8_BBASE(u) ((const char*)g.Bt + ((size_t)((u).pn & g.b_pn_mask) * g.b_pn_step + (size_t)((u).pn >> g.b_pn_shift) * g.b_pn_step2 + (size_t)((u).pm >> g.b_pm_shift) * g.b_pm_step) * 2)
    Unit cur, nxt; int ui = 0;
    if (!unit_next(g, 0, cur)) return;
    f32x4 acc[2][2][4][2];
#pragma unroll
    for (int a = 0; a < 2; ++a)
#pragma unroll
        for (int b = 0; b < 2; ++b)
#pragma unroll
            for (int m = 0; m < 4; ++m)
#pragma unroll
                for (int n = 0; n < 2; ++n) acc[a][b][m][n] = (f32x4){0.f, 0.f, 0.f, 0.f};
    bf16x8 At[4][2], B0[2][2], B1[2][2];
    const char* cA = PG8_ABASE(cur); const char* cB = PG8_BBASE(cur);
    PG8_STAGE(PG8_SB(0, 0), cB, voffB); PG8_STAGE(PG8_SA(0, 0), cA, voffA); PG8_STAGE(PG8_SB(0, 1), cB + hstepB, voffB); PG8_STAGE(PG8_SA(0, 1), cA + hstepA, voffA);
    if (wr == 1) PG8_BAR;
    PG8_WAIT_V(4); PG8_BAR;
    PG8_STAGE(PG8_SB(1, 0), cB + kstep, voffB); PG8_STAGE(PG8_SA(1, 0), cA + kstep, voffA); PG8_STAGE(PG8_SB(1, 1), cB + hstepB + kstep, voffB);
    PG8_WAIT_V(6); PG8_BAR;
    for (;;) {
        const bool has_next = unit_next(g, ui + 1, nxt);
        const char* nA = has_next ? PG8_ABASE(nxt) : cA; const char* nB = has_next ? PG8_BBASE(nxt) : cB;
        for (int t = 0; t < nt; t += 2) {
            const bool last = (t == nt - 2);
            const char* a1 = cA + (size_t)(t + 1) * kstep;
            const char* a2 = last ? nA : cA + (size_t)(t + 2) * kstep; const char* b2 = last ? nB : cB + (size_t)(t + 2) * kstep;
            const char* a3 = a2 + kstep; const char* b3 = b2 + kstep;
            PG8_LDB(B0, 0, 0); PG8_SCHED; PG8_LDA(At, 0, 0); PG8_STAGE(PG8_SA(1, 1), a1 + hstepA, voffA);
            PG8_WAIT_L(8); PG8_BAR; PG8_WAIT_L(0); PG8_MMA(0, 0, At, B0); PG8_BAR; PG8_SCHED;
            PG8_LDB(B1, 0, 1); PG8_STAGE(PG8_SB(0, 0), b2, voffB);
            PG8_BAR; PG8_WAIT_L(0); PG8_MMA(0, 1, At, B1); PG8_BAR;
            PG8_LDA(At, 0, 1); PG8_STAGE(PG8_SA(0, 0), a2, voffA);
            PG8_BAR; PG8_WAIT_L(0); PG8_MMA(1, 0, At, B0); PG8_BAR; PG8_SCHED;
            PG8_STAGE(PG8_SB(0, 1), b2 + hstepB, voffB);
            PG8_WAIT_V(6); PG8_BAR; PG8_MMA(1, 1, At, B1); PG8_BAR;
            PG8_LDB(B0, 1, 0); PG8_SCHED; PG8_LDA(At, 1, 0); PG8_STAGE(PG8_SA(0, 1), a2 + hstepA, voffA);
            PG8_WAIT_L(8); PG8_BAR; PG8_WAIT_L(0); PG8_MMA(0, 0, At, B0); PG8_BAR; PG8_SCHED;
            PG8_LDB(B1, 1, 1); PG8_STAGE(PG8_SB(1, 0), b3, voffB);
            PG8_BAR; PG8_WAIT_L(0); PG8_MMA(0, 1, At, B1); PG8_BAR;
            PG8_LDA(At, 1, 1); PG8_STAGE(PG8_SA(1, 0), a3, voffA);
            PG8_BAR; PG8_WAIT_L(0); PG8_MMA(1, 0, At, B0); PG8_BAR; PG8_SCHED;
            PG8_STAGE(PG8_SB(1, 1), b3 + hstepB, voffB);
            PG8_WAIT_V(6); PG8_BAR; PG8_MMA(1, 1, At, B1); PG8_BAR;
        }
        epilogue<MODE>(g, acc, cur, wr, wc, fr, fq, lds + GEMM_LDS + 1024);
        if (!has_next) break;
#pragma unroll
        for (int a = 0; a < 2; ++a)
#pragma unroll
            for (int b = 0; b < 2; ++b)
#pragma unroll
                for (int m = 0; m < 4; ++m)
#pragma unroll
                    for (int n = 0; n < 2; ++n) acc[a][b][m][n] = (f32x4){0.f, 0.f, 0.f, 0.f};
        cur = nxt; cA = nA; cB = nB; ++ui;
    }
    PG8_WAIT_V(0);
    if (wr == 0) PG8_BAR;
    PG8_BAR;
#undef PG8_SA
#undef PG8_SB
#undef PG8_STAGE
#undef PG8_LDA
#undef PG8_LDB
#undef PG8_MMA
#undef PG8_WAIT_V
#undef PG8_WAIT_L
#undef PG8_BAR
#undef PG8_SCHED
#undef PG8_ABASE
#undef PG8_BBASE
}
}

__device__ __forceinline__ void p0_transpose_item(const float* W, int ldw, int K, int csrc0, bf16_t* WT, int row0, LAS float* scr, int kb, int lane, float wscale, const float* kgain) {
    const int k0 = 64 * kb;
#pragma unroll
    for (int i = 0; i < 8; ++i) { const int kk = 8 * i + (lane >> 3), n4 = (lane & 7) * 4;
        const float4 v = *(const float4*)(W + (size_t)(k0 + kk) * ldw + csrc0 + n4);
        const float ws = kgain ? kgain[k0 + kk] : wscale; (void)wscale;
        scr[kk * 33 + n4] = v.x * ws; scr[kk * 33 + n4 + 1] = v.y * ws; scr[kk * 33 + n4 + 2] = v.z * ws; scr[kk * 33 + n4 + 3] = v.w * ws; }
    asm volatile("s_waitcnt lgkmcnt(0)" ::: "memory");
    const int c = lane & 7;
#pragma unroll
    for (int j = 0; j < 4; ++j) { const int n = (lane >> 3) + 8 * j; const LAS float* s = scr + (8 * c) * 33 + n;
        uint4 o; o.x = pk2(s[0 * 33], s[1 * 33]); o.y = pk2(s[2 * 33], s[3 * 33]); o.z = pk2(s[4 * 33], s[5 * 33]); o.w = pk2(s[6 * 33], s[7 * 33]);
        *(uint4*)(WT + (size_t)(row0 + n) * K + k0 + 8 * c) = o; }
    asm volatile("s_waitcnt lgkmcnt(0)" ::: "memory");
}

__device__ __forceinline__ void d_conv_silu(int vb, int tid, const bf16_t* __restrict__ p6, const float* __restrict__ cw, const float* __restrict__ cb, bf16_t* __restrict__ c) {
    const int t = vb, s = t % S;
    for (int ch = tid; ch < 1024; ch += 256) {
        float y = cb[ch];
#pragma unroll
        for (int j = 0; j < 4; ++j) {
            const int ss = s - 3 + j;
            if (ss >= 0) y = fmaf(cw[j * 1024 + ch], bf2f(p6[(size_t)(t - 3 + j) * 1024 + ch]), y);
        }
        c[(size_t)t * 1024 + ch] = (bf16_t)f2bf(y / (1.0f + expf(-y)));
    }
}

__device__ __forceinline__ void d_mlstm(int vb, int tid, const bf16_t* __restrict__ mq, const bf16_t* __restrict__ mk, const bf16_t* __restrict__ p6,
                                        const float* __restrict__ gpre, const float* __restrict__ b_mi, const float* __restrict__ b_mf, float* __restrict__ hraw) {
    const int lane = tid & 63, w = tid >> 6;
    const int gid = vb * 4 + w;
    const int e = gid & 255, h = (gid >> 8) & 3, b = gid >> 10;
    const float bi = b_mi[h], bf = b_mf[h];
    float C0 = 0.f, C1 = 0.f, C2 = 0.f, C3 = 0.f, n0 = 0.f, n1 = 0.f, n2 = 0.f, n3 = 0.f, m = 0.f;
    const size_t tb = (size_t)b * S;
    const bf16_t* qp = mq + tb * 1024 + h * 256 + lane * 4;
    const bf16_t* kp = mk + tb * 1024 + h * 256 + lane * 4;
    const bf16_t* pp = p6 + P6S + tb * 1024 + h * 256 + e;
    ushort4 qn = *(const ushort4*)qp, kn = *(const ushort4*)kp;
    const float* gp = gpre + tb * 8;
    float vn = bf2f(pp[0]), in_ = gp[h], fn = gp[4 + h];
    for (int s = 0; s < S; ++s) {
        const float4 q = make_float4(bf2f(qn.x), bf2f(qn.y), bf2f(qn.z), bf2f(qn.w)), k = make_float4(bf2f(kn.x), bf2f(kn.y), bf2f(kn.z), bf2f(kn.w)); const float v = vn, ipre = in_ + bi, fpre = fn + bf;
        if (s + 1 < S) {
            qn = *(const ushort4*)(qp + (size_t)(s + 1) * 1024);
            kn = *(const ushort4*)(kp + (size_t)(s + 1) * 1024);
            vn = bf2f(pp[(size_t)(s + 1) * 1024]); in_ = gp[(size_t)(s + 1) * 8 + h]; fn = gp[(size_t)(s + 1) * 8 + 4 + h];
        }
        const float logf = log_sigmoid(fpre);
        const float mnew = fmaxf(logf + m, ipre);
        const float fd = expf(logf + m - mnew), ig = expf(ipre - mnew);
        m = mnew;
        const float sc = ig * 0.0625f;
        C0 = fd * C0 + sc * k.x * v; C1 = fd * C1 + sc * k.y * v; C2 = fd * C2 + sc * k.z * v; C3 = fd * C3 + sc * k.w * v;
        n0 = fd * n0 + sc * k.x; n1 = fd * n1 + sc * k.y; n2 = fd * n2 + sc * k.z; n3 = fd * n3 + sc * k.w;
        float num = q.x * C0 + q.y * C1 + q.z * C2 + q.w * C3;
        float den = q.x * n0 + q.y * n1 + q.z * n2 + q.w * n3;
        num = wave_sum(num); den = wave_sum(den);
        if (lane == 0) hraw[(tb + s) * 1024 + h * 256 + e] = num / fmaxf(fabsf(den), expf(-mnew));
    }
}

__device__ __forceinline__ void d_mhead_norm(int vb, int tid, const float* __restrict__ hraw, const bf16_t* __restrict__ p6, const float* __restrict__ g, bf16_t* __restrict__ mix) {
    const int t = vb, h = tid >> 6, lane = tid & 63;
    const float4 v = *(const float4*)(hraw + (size_t)t * 1024 + h * 256 + lane * 4);
    float s = v.x * v.x + v.y * v.y + v.z * v.z + v.w * v.w;
    s = wave_sum(s);
    const float r = rsqrtf(s * (1.0f / 256.0f) + EPS);
    const float4 gg = *(const float4*)(g + h * 256 + lane * 4);
    const ushort4 mo = *(const ushort4*)(p6 + 2 * P6S + (size_t)t * 1024 + h * 256 + lane * 4);
    float4 o;
    o.x = v.x * r * gg.x / (1.0f + expf(-bf2f(mo.x)));
    o.y = v.y * r * gg.y / (1.0f + expf(-bf2f(mo.y)));
    o.z = v.z * r * gg.z / (1.0f + expf(-bf2f(mo.z)));
    o.w = v.w * r * gg.w / (1.0f + expf(-bf2f(mo.w)));
    uint2 ob; ob.x = pk2(o.x, o.y); ob.y = pk2(o.z, o.w);
    *(uint2*)(mix + (size_t)t * D + h * 256 + lane * 4) = ob;
}

__device__ __forceinline__ void d_rope(int vb, int tid, bf16_t* __restrict__ p6) {
    const int t = vb, s = t % S;
    for (int idx = tid; idx < 2 * 8 * 64; idx += 256) {
        const int i = idx & 63, hd = (idx >> 6) & 7, qk = idx >> 9;
        const float inv = exp2f(-(float)i * 0.20762050593046014f);
        const float ang = (float)s * inv;
        float sn, cs; sincosf(ang, &sn, &cs);
        bf16_t* p = p6 + (size_t)(3 + qk) * P6S + (size_t)t * 1024 + hd * 128;
        const float x1 = bf2f(p[i]), x2 = bf2f(p[64 + i]);
        p[i] = (bf16_t)f2bf(x1 * cs - x2 * sn);
        p[64 + i] = (bf16_t)f2bf(x2 * cs + x1 * sn);
    }
}

__device__ __forceinline__ void d_dilated(int vb, int tid, float* sm, const bf16_t* __restrict__ p6, const float* __restrict__ g_ahead, bf16_t* __restrict__ mix) {
    float (*qs)[128] = (float (*)[128])sm;
    float (*ps)[576] = (float (*)[576])(sm + 512);
    const int lane = tid & 63, w = tid >> 6;
    const int gid = vb * 4 + w;
    const int s = gid % S, hd = (gid / S) & 7, b = gid / (S * 8);
    const size_t t = (size_t)b * S + s;
    const bf16_t* qrow = p6 + 3 * P6S + t * 1024 + hd * 128;
    __syncthreads();
    qs[w][lane] = bf2f(qrow[lane]); qs[w][lane + 64] = bf2f(qrow[lane + 64]);
    __syncthreads();
    const float scale = 0.08838834764831845f;
    float mloc = -INFINITY;
    for (int br = 0; br < 3; ++br) {
        const int dil = br == 0 ? 1 : (br == 1 ? 4 : 16);
        for (int jj = 0; jj < 192; jj += 64) {
            const int j = jj + lane;
            float sc = -INFINITY;
            if (j <= 128 && s - j * dil >= 0) {
                const bf16_t* krow = p6 + 4 * P6S + (t - (size_t)j * dil) * 1024 + hd * 128;
                float d = 0.f;
#pragma unroll 8
                for (int c = 0; c < 128; c += 4) {
                    const ushort4 kv = *(const ushort4*)(krow + c);
                    d = fmaf(qs[w][c], bf2f(kv.x), d); d = fmaf(qs[w][c + 1], bf2f(kv.y), d); d = fmaf(qs[w][c + 2], bf2f(kv.z), d); d = fmaf(qs[w][c + 3], bf2f(kv.w), d);
                }
                sc = d * scale;
            }
            ps[w][br * 192 + j] = sc;
            mloc = fmaxf(mloc, sc);
        }
    }
    const float mx = wave_max(mloc);
    __syncthreads();
    float lsum = 0.f;
    for (int i = lane; i < 3 * 192; i += 64) {
        const float sc = ps[w][i];
        const float pv = (sc == -INFINITY) ? 0.f : expf(sc - mx);
        ps[w][i] = pv; lsum += pv;
    }
    const float tot = wave_sum(lsum);
    __syncthreads();
    float o0 = 0.f, o1 = 0.f;
    for (int br = 0; br < 3; ++br) {
        const int dil = br == 0 ? 1 : (br == 1 ? 4 : 16);
        for (int j = 0; j <= 128; ++j) {
            if (s - j * dil < 0) break;
            const float pv = ps[w][br * 192 + j];
            const bf16_t* vrow = p6 + 5 * P6S + (t - (size_t)j * dil) * 1024 + hd * 128;
            o0 = fmaf(pv, bf2f(vrow[lane]), o0); o1 = fmaf(pv, bf2f(vrow[lane + 64]), o1);
        }
    }
    o0 /= tot; o1 /= tot;
    float ss = wave_sum(o0 * o0 + o1 * o1);
    const float r = rsqrtf(ss * (1.0f / 128.0f) + EPS);
    bf16_t* orow = mix + t * D + 1024 + hd * 128;
    orow[lane] = (bf16_t)f2bf(o0 * r * g_ahead[hd * 128 + lane]);
    orow[lane + 64] = (bf16_t)f2bf(o1 * r * g_ahead[hd * 128 + lane + 64]);
}

__device__ __forceinline__ void d_cross(int vb, int tid, float* sm, const bf16_t* __restrict__ q, const float* __restrict__ km, const float* __restrict__ vm, bf16_t* __restrict__ o) {
    float (*qs)[512] = (float (*)[512])sm;
    float (*ps)[256] = (float (*)[256])(sm + 2048);
    const int lane = tid & 63, w = tid >> 6;
    const int t = vb, hd = w, b = t / S;
    const bf16_t* qrow = q + (size_t)t * D + hd * 512;
    __syncthreads();
    for (int i = lane; i < 512; i += 64) qs[w][i] = bf2f(qrow[i]);
    __syncthreads();
    const float scale = 0.04419417382415922f;
    float sc[4]; float mloc = -INFINITY;
#pragma unroll
    for (int r = 0; r < 4; ++r) {
        const int mi = lane + 64 * r;
        const float* krow = km + ((size_t)b * 256 + mi) * D + hd * 512;
        float d = 0.f;
#pragma unroll 8
        for (int c = 0; c < 512; c += 4) {
            const float4 kv = *(const float4*)(krow + c);
            d = fmaf(qs[w][c], kv.x, d); d = fmaf(qs[w][c + 1], kv.y, d); d = fmaf(qs[w][c + 2], kv.z, d); d = fmaf(qs[w][c + 3], kv.w, d);
        }
        sc[r] = d * scale; mloc = fmaxf(mloc, sc[r]);
    }
    const float mx = wave_max(mloc);
    float lsum = 0.f;
#pragma unroll
    for (int r = 0; r < 4; ++r) { const float pv = expf(sc[r] - mx); ps[w][lane + 64 * r] = pv; lsum += pv; }
    const float tot = wave_sum(lsum);
    __syncthreads();
    float acc[8];
#pragma unroll
    for (int i = 0; i < 8; ++i) acc[i] = 0.f;
    for (int mi = 0; mi < 256; ++mi) {
        const float pv = ps[w][mi];
        const float* vrow = vm + ((size_t)b * 256 + mi) * D + hd * 512;
#pragma unroll
        for (int i = 0; i < 8; ++i) acc[i] = fmaf(pv, vrow[lane + 64 * i], acc[i]);
    }
    bf16_t* orow = o + (size_t)t * D + hd * 512;
#pragma unroll
    for (int i = 0; i < 8; ++i) orow[lane + 64 * i] = (bf16_t)f2bf(acc[i] / tot);
}

__device__ __forceinline__ void wave_argmax(float& best, int& bidx) {
#pragma unroll
    for (int o = 32; o >= 1; o >>= 1) {
        const float ob = __shfl_xor(best, o); const int oi = __shfl_xor(bidx, o);
        if (ob > best || (ob == best && oi < bidx)) { best = ob; bidx = oi; }
    }
}
__device__ __forceinline__ void d_peer_topk(int vb, int tid, float* sm, const bf16_t* __restrict__ qp, const float* __restrict__ sub_keys, int* __restrict__ ids, float* __restrict__ gates) {
    float (*qs)[256] = (float (*)[256])sm;
    const int lane = tid & 63, w = tid >> 6;
    const int gid = vb * 4 + w;
    const int hd = gid & 7, t = gid >> 3;
    const bf16_t* qrow = qp + (size_t)t * D + hd * 256;
    __syncthreads();
    for (int i = lane; i < 256; i += 64) qs[w][i] = bf2f(qrow[i]);
    __syncthreads();
    float tops[2]; int topi[2];
#pragma unroll
    for (int p = 0; p < 2; ++p) {
        float v0, v1;
        {
            const float* k0 = sub_keys + ((size_t)(hd * 2 + p) * 128 + lane) * 128;
            const float* k1 = k0 + 64 * 128;
            float d0 = 0.f, d1 = 0.f;
#pragma unroll 8
            for (int c = 0; c < 128; c += 4) {
                const float4 a = *(const float4*)(k0 + c), bb = *(const float4*)(k1 + c);
                const float q0 = qs[w][p * 128 + c], q1 = qs[w][p * 128 + c + 1], q2 = qs[w][p * 128 + c + 2], q3 = qs[w][p * 128 + c + 3];
                d0 = fmaf(q0, a.x, d0); d0 = fmaf(q1, a.y, d0); d0 = fmaf(q2, a.z, d0); d0 = fmaf(q3, a.w, d0);
                d1 = fmaf(q0, bb.x, d1); d1 = fmaf(q1, bb.y, d1); d1 = fmaf(q2, bb.z, d1); d1 = fmaf(q3, bb.w, d1);
            }
            v0 = d0; v1 = d1;
        }
        float ts = 0.f; int ti = 0;
        for (int it = 0; it < 16; ++it) {
            float best; int bidx;
            if (v0 >= v1) { best = v0; bidx = lane; } else { best = v1; bidx = lane + 64; }
            wave_argmax(best, bidx);
            if (lane == it) { ts = best; ti = bidx; }
            if (bidx == lane) v0 = -INFINITY;
            if (bidx == lane + 64) v1 = -INFINITY;
        }
        tops[p] = ts; topi[p] = ti;
    }
    float cv[4]; int ci[4];
#pragma unroll
    for (int r = 0; r < 4; ++r) {
        const int c = lane * 4 + r, i = c >> 4, j = c & 15;
        const float s0 = __shfl(tops[0], i), s1 = __shfl(tops[1], j);
        const int i0 = __shfl(topi[0], i), i1 = __shfl(topi[1], j);
        cv[r] = s0 + s1; ci[r] = i0 * 128 + i1;
    }
    float bs = 0.f; int bid = 0;
    for (int it = 0; it < 16; ++it) {
        float best = cv[0]; int bidx = lane * 4;
#pragma unroll
        for (int r = 1; r < 4; ++r) if (cv[r] > best) { best = cv[r]; bidx = lane * 4 + r; }
        wave_argmax(best, bidx);
        const int owner = bidx >> 2, rr = bidx & 3;
        int myid = ci[0];
        if (rr == 1) myid = ci[1]; else if (rr == 2) myid = ci[2]; else if (rr == 3) myid = ci[3];
        const int eid = __shfl(myid, owner);
        if (lane == it) { bs = best; bid = eid; }
        if (owner == lane) {
#pragma unroll
            for (int r = 0; r < 4; ++r) if (rr == r) cv[r] = -INFINITY;
        }
    }
    float v = lane < 16 ? bs : -INFINITY;
    const float mx = wave_max(v);
    const float ev = lane < 16 ? expf(bs - mx) : 0.f;
    const float tot = wave_sum(ev);
    if (lane < 16) {
        ids[(size_t)t * 128 + hd * 16 + lane] = bid;
        gates[(size_t)t * 128 + hd * 16 + lane] = ev / tot;
    }
}

__device__ __forceinline__ void d_peer_out(int vb, int tid, float* sm, const bf16_t* __restrict__ h3, const float* __restrict__ x2, const int* __restrict__ ids, const float* __restrict__ gates,
                                           const bf16_t* __restrict__ u_tab, const bf16_t* __restrict__ v_tab, const float* __restrict__ g_final, float* __restrict__ out) {
    float (*part)[2048] = (float (*)[2048])sm;
    float* red = sm + 4 * 2048;
    const int lane = tid & 63, w = tid >> 6, t = vb;
    float4 xr[8], acc[8];
    const bf16_t* hrow = h3 + (size_t)t * D;
#pragma unroll
    for (int i = 0; i < 8; ++i) { const ushort4 hv = *(const ushort4*)(hrow + i * 256 + lane * 4);
        xr[i] = make_float4(bf2f(hv.x), bf2f(hv.y), bf2f(hv.z), bf2f(hv.w)); acc[i] = make_float4(0.f, 0.f, 0.f, 0.f); }
    for (int j = 0; j < 32; ++j) {
        const int slot = w * 32 + j;
        const int e = ids[(size_t)t * 128 + slot];
        const float gt = gates[(size_t)t * 128 + slot];
        const bf16_t* ur = u_tab + (size_t)e * D;
        const bf16_t* vr = v_tab + (size_t)e * D;
        float d = 0.f;
#pragma unroll
        for (int i = 0; i < 8; ++i) {
            const ushort4 u = *(const ushort4*)(ur + i * 256 + lane * 4);
            d = fmaf(xr[i].x, bf2f(u.x), d); d = fmaf(xr[i].y, bf2f(u.y), d); d = fmaf(xr[i].z, bf2f(u.z), d); d = fmaf(xr[i].w, bf2f(u.w), d);
        }
        d = wave_sum(d);
        const float act = 0.5f * d * (1.0f + erff(d * 0.7071067811865476f));
        const float cf = gt * act;
#pragma unroll
        for (int i = 0; i < 8; ++i) {
            const ushort4 v = *(const ushort4*)(vr + i * 256 + lane * 4);
            acc[i].x = fmaf(cf, bf2f(v.x), acc[i].x); acc[i].y = fmaf(cf, bf2f(v.y), acc[i].y); acc[i].z = fmaf(cf, bf2f(v.z), acc[i].z); acc[i].w = fmaf(cf, bf2f(v.w), acc[i].w);
        }
    }
    __syncthreads();
#pragma unroll
    for (int i = 0; i < 8; ++i) *(float4*)&part[w][i * 256 + lane * 4] = acc[i];
    __syncthreads();
    float4 r0, r1;
    {
        const float4 a = *(const float4*)&part[0][tid * 4], b = *(const float4*)&part[1][tid * 4], c = *(const float4*)&part[2][tid * 4], d = *(const float4*)&part[3][tid * 4];
        const float4 x = *(const float4*)(x2 + (size_t)t * D + tid * 4);
        r0 = make_float4(x.x + a.x + b.x + c.x + d.x, x.y + a.y + b.y + c.y + d.y, x.z + a.z + b.z + c.z + d.z, x.w + a.w + b.w + c.w + d.w);
    }
    {
        const float4 a = *(const float4*)&part[0][1024 + tid * 4], b = *(const float4*)&part[1][1024 + tid * 4], c = *(const float4*)&part[2][1024 + tid * 4], d = *(const float4*)&part[3][1024 + tid * 4];
        const float4 x = *(const float4*)(x2 + (size_t)t * D + 1024 + tid * 4);
        r1 = make_float4(x.x + a.x + b.x + c.x + d.x, x.y + a.y + b.y + c.y + d.y, x.z + a.z + b.z + c.z + d.z, x.w + a.w + b.w + c.w + d.w);
    }
    float s = r0.x * r0.x + r0.y * r0.y + r0.z * r0.z + r0.w * r0.w + r1.x * r1.x + r1.y * r1.y + r1.z * r1.z + r1.w * r1.w;
    s = wave_sum(s);
    if (lane == 0) red[w] = s;
    __syncthreads();
    const float tot = red[0] + red[1] + red[2] + red[3];
    const float r = rsqrtf(tot * (1.0f / D) + EPS);
    const float4 g0 = *(const float4*)(g_final + tid * 4), g1 = *(const float4*)(g_final + 1024 + tid * 4);
    *(float4*)(out + (size_t)t * D + tid * 4) = make_float4(r0.x * r * g0.x, r0.y * r * g0.y, r0.z * r * g0.z, r0.w * r * g0.w);
    *(float4*)(out + (size_t)t * D + 1024 + tid * 4) = make_float4(r1.x * r * g1.x, r1.y * r * g1.y, r1.z * r * g1.z, r1.w * r * g1.w);
}


__device__ __forceinline__ float wave_sum_dpp(float v);
__device__ __forceinline__ void rmsnorm_row_wave(int row, int lane, const float* __restrict__ in, const float* __restrict__ g, bf16_t* __restrict__ out, const float* gwT, float* __restrict__ gpre) {
    float4 x[8];
    const float* p = in + (size_t)row * D + lane * 4;
#pragma unroll
    for (int i = 0; i < 8; ++i) x[i] = *(const float4*)(p + i * 256);
    float s = 0.f;
#pragma unroll
    for (int i = 0; i < 8; ++i) s += (x[i].x * x[i].x + x[i].y * x[i].y) + (x[i].z * x[i].z + x[i].w * x[i].w);
    s = wave_sum_dpp(s);
    const float r = rsqrtf(s * (1.0f / D) + EPS);
    bf16_t* o = out + (size_t)row * D + lane * 4;
#pragma unroll
    for (int i = 0; i < 8; ++i) {
        const float4 gv = *(const float4*)(g + i * 256 + lane * 4);
        x[i].x *= r * gv.x; x[i].y *= r * gv.y; x[i].z *= r * gv.z; x[i].w *= r * gv.w;
        uint2 w; w.x = pk2(x[i].x, x[i].y); w.y = pk2(x[i].z, x[i].w);
        *(uint2*)(o + i * 256) = w;
    }
    if (gpre) {
#pragma unroll 1
        for (int c = 0; c < 8; c += 2) {
            float a0 = 0.f, a1 = 0.f;
#pragma unroll
            for (int i = 0; i < 8; ++i) {
                const float4 w0 = *(const float4*)(gwT + c * 2048 + i * 256 + lane * 4), w1 = *(const float4*)(gwT + (c + 1) * 2048 + i * 256 + lane * 4);
                a0 = fmaf(x[i].x, w0.x, a0); a0 = fmaf(x[i].y, w0.y, a0); a0 = fmaf(x[i].z, w0.z, a0); a0 = fmaf(x[i].w, w0.w, a0);
                a1 = fmaf(x[i].x, w1.x, a1); a1 = fmaf(x[i].y, w1.y, a1); a1 = fmaf(x[i].z, w1.z, a1); a1 = fmaf(x[i].w, w1.w, a1);
            }
            const float t0_ = wave_sum_dpp(a0), t1_ = wave_sum_dpp(a1);
            if (lane == 0) { gpre[(size_t)row * 8 + c] = t0_; gpre[(size_t)row * 8 + c + 1] = t1_; }
        }
    }
}

__device__ __forceinline__ void conv_silu_run(int tokbase, int cg8, const bf16_t* __restrict__ min_, const float* __restrict__ cw, const float* __restrict__ cb, bf16_t* __restrict__ c) {
    float w[4][8], bias[8];
#pragma unroll
    for (int j = 0; j < 4; ++j) { const float4 a = *(const float4*)(cw + j * 1024 + cg8 * 8), b = *(const float4*)(cw + j * 1024 + cg8 * 8 + 4);
        w[j][0] = a.x; w[j][1] = a.y; w[j][2] = a.z; w[j][3] = a.w; w[j][4] = b.x; w[j][5] = b.y; w[j][6] = b.z; w[j][7] = b.w; }
    { const float4 a = *(const float4*)(cb + cg8 * 8), b = *(const float4*)(cb + cg8 * 8 + 4); bias[0] = a.x; bias[1] = a.y; bias[2] = a.z; bias[3] = a.w; bias[4] = b.x; bias[5] = b.y; bias[6] = b.z; bias[7] = b.w; }
    const int s0 = tokbase & (S - 1);
    uint4 rows[11];
#pragma unroll
    for (int i = 0; i < 11; ++i) { const int ss = s0 - 3 + i; rows[i] = ss >= 0 ? *(const uint4*)(min_ + (size_t)(tokbase - 3 + i) * 1024 + cg8 * 8) : make_uint4(0u, 0u, 0u, 0u); }
#pragma unroll
    for (int t = 0; t < 8; ++t) {
        float y[8];
#pragma unroll
        for (int k = 0; k < 8; ++k) y[k] = bias[k];
#pragma unroll
        for (int j = 0; j < 4; ++j) {
            const uint4 r = rows[t + j]; const unsigned rw[4] = {r.x, r.y, r.z, r.w};
#pragma unroll
            for (int k = 0; k < 4; ++k) { y[2 * k] = fmaf(w[j][2 * k], __uint_as_float(rw[k] << 16), y[2 * k]); y[2 * k + 1] = fmaf(w[j][2 * k + 1], __uint_as_float(rw[k] & 0xFFFF0000u), y[2 * k + 1]); }
        }
        uint4 o;
#pragma unroll
        for (int k = 0; k < 8; ++k) y[k] = y[k] / (1.0f + __expf(-y[k]));
        o.x = pk2(y[0], y[1]); o.y = pk2(y[2], y[3]); o.z = pk2(y[4], y[5]); o.w = pk2(y[6], y[7]);
        *(uint4*)(c + (size_t)(tokbase + t) * 1024 + cg8 * 8) = o;
    }
}

__device__ __forceinline__ float wave_incl_scan_add(float v, int lane) {
#pragma unroll
    for (int o = 1; o < 64; o <<= 1) { const float t = __shfl_up(v, o); if (lane >= o) v += t; }
    return v;
}
__device__ __forceinline__ float wave_incl_scan_max(float v, int lane) {
#pragma unroll
    for (int o = 1; o < 64; o <<= 1) { const float t = __shfl_up(v, o); if (lane >= o) v = fmaxf(v, t); }
    return v;
}
__device__ __forceinline__ void mlstm_gates_wave(int b, int h, int lane, const float* __restrict__ gpre, const float* __restrict__ b_mi, const float* __restrict__ b_mf,
                                                 float* __restrict__ gs, float* __restrict__ decay) {
    const float bi = b_mi[h], bf = b_mf[h];
    float mprev = 0.f;
    float gi_n[4], gf_n[4];
#pragma unroll
    for (int j = 0; j < 4; ++j) { const size_t t = (size_t)b * S + lane * 4 + j; gi_n[j] = gpre[t * 8 + h]; gf_n[j] = gpre[t * 8 + 4 + h]; }
#pragma unroll 1
    for (int c = 0; c < 16; ++c) {
        const size_t t0 = (size_t)b * S + c * 256 + lane * 4;
        float logi[4], lf[4], bb[4], gf_c[4];
#pragma unroll
        for (int j = 0; j < 4; ++j) { logi[j] = gi_n[j] + bi; gf_c[j] = gf_n[j]; }
        if (c < 15) {
#pragma unroll
            for (int j = 0; j < 4; ++j) { gi_n[j] = gpre[(t0 + 256 + j) * 8 + h]; gf_n[j] = gpre[(t0 + 256 + j) * 8 + 4 + h]; }
        }
#pragma unroll
        for (int j = 0; j < 4; ++j) lf[j] = log_sigmoid(gf_c[j] + bf);
        bb[0] = lf[0]; bb[1] = bb[0] + lf[1]; bb[2] = bb[1] + lf[2]; bb[3] = bb[2] + lf[3];
        const float incl = wave_incl_scan_add(bb[3], lane);
        const float excl = incl - bb[3];
#pragma unroll
        for (int j = 0; j < 4; ++j) bb[j] += excl;
        const float g = __shfl(incl, 63);
        float amax = -INFINITY, uu[4], cm[4];
#pragma unroll
        for (int j = 0; j < 4; ++j) { amax = fmaxf(amax, logi[j] + g - bb[j]); uu[j] = logi[j] - bb[j]; }
        amax = wave_max(amax);
        const float mnew = fmaxf(g + mprev, amax);
        cm[0] = uu[0]; cm[1] = fmaxf(cm[0], uu[1]); cm[2] = fmaxf(cm[1], uu[2]); cm[3] = fmaxf(cm[2], uu[3]);
        const float cincl = wave_incl_scan_max(cm[3], lane);
        float cexcl = __shfl_up(cincl, 1); if (lane == 0) cexcl = -INFINITY;
#pragma unroll
        for (int j = 0; j < 4; ++j) {
            const float M = fmaxf(mprev, fmaxf(cexcl, cm[j]));
            float* o = gs + ((t0 + j) * 4 + h) * 8;
            o[0] = uu[j] * 1.4426950408889634f; o[1] = M * 1.4426950408889634f; o[2] = expf(logi[j] + g - bb[j] - mnew); o[3] = expf(mprev - M); o[4] = expf(-(bb[j] + M));
        }
        if (lane == 0) decay[(b * 16 + c) * 4 + h] = expf(g + mprev - mnew);
        mprev = mnew;
    }
}
__device__ __forceinline__ void transpose_tile64(int tid, float* sm, const bf16_t* __restrict__ src, int src_ld, bf16_t* __restrict__ dst, int dst_ld, const float* __restrict__ scale, int sstride) {
    unsigned short (*tl)[66] = (unsigned short (*)[66])sm;
    __syncthreads();
#pragma unroll
    for (int i = 0; i < 2; ++i) {
        const int ch = tid + i * 256, r = ch >> 3, c8 = (ch & 7) * 8;
        const uint4 v = *(const uint4*)(src + (size_t)r * src_ld + c8);
        const float sc = scale ? scale[(size_t)r * sstride] : 1.0f;
        const unsigned w[4] = {v.x, v.y, v.z, v.w};
#pragma unroll
        for (int k = 0; k < 4; ++k) {
            tl[r][c8 + 2 * k] = (unsigned short)f2bf(bf2f((unsigned short)(w[k] & 0xFFFFu)) * sc);
            tl[r][c8 + 2 * k + 1] = (unsigned short)f2bf(bf2f((unsigned short)(w[k] >> 16)) * sc);
        }
    }
    __syncthreads();
#pragma unroll
    for (int i = 0; i < 2; ++i) {
        const int ch = tid + i * 256, c = ch >> 3, r8 = (ch & 7) * 8;
        uint4 o;
        o.x = (unsigned)tl[r8 + 0][c] | ((unsigned)tl[r8 + 1][c] << 16); o.y = (unsigned)tl[r8 + 2][c] | ((unsigned)tl[r8 + 3][c] << 16);
        o.z = (unsigned)tl[r8 + 4][c] | ((unsigned)tl[r8 + 5][c] << 16); o.w = (unsigned)tl[r8 + 6][c] | ((unsigned)tl[r8 + 7][c] << 16);
        *(uint4*)(dst + (size_t)c * dst_ld + r8) = o;
    }
}

__device__ __forceinline__ void rope_table_fill(float2* __restrict__ cs, int gtid, int nth) {
    for (int idx = gtid; idx < 4096 * 64; idx += nth) {
        const int i = idx & 63, s = idx >> 6;
        const float inv = exp2f(-(float)i * 0.20762050593046014f);
        const float ang = (float)s * inv;
        float sn, c; sincosf(ang, &sn, &c);
        cs[idx] = make_float2(c, sn);
    }
}
__device__ __forceinline__ void rope_q_pass(bf16_t* __restrict__ aq, const float2* __restrict__ cs, size_t gtid, size_t nth) {
    for (size_t idx = gtid; idx < (size_t)T * 8 * 8; idx += nth) {
        const int c8 = (int)(idx & 7), hd = (int)((idx >> 3) & 7); const size_t t = idx >> 6; const int s = (int)(t & (S - 1));
        bf16_t* p = aq + t * 1024 + hd * 128 + c8 * 8;
        const uint4 a = *(const uint4*)p, b = *(const uint4*)(p + 64);
        const unsigned aw[4] = {a.x, a.y, a.z, a.w}, bw[4] = {b.x, b.y, b.z, b.w};
        unsigned ao[4], bo[4];
#pragma unroll
        for (int k = 0; k < 4; ++k) {
            const float4 cc = *(const float4*)(cs + (size_t)s * 64 + c8 * 8 + 2 * k);
            const float x10 = __uint_as_float(aw[k] << 16), x11 = __uint_as_float(aw[k] & 0xFFFF0000u), x20 = __uint_as_float(bw[k] << 16), x21 = __uint_as_float(bw[k] & 0xFFFF0000u);
            ao[k] = pk2(x10 * cc.x - x20 * cc.y, x11 * cc.z - x21 * cc.w);
            bo[k] = pk2(x20 * cc.x + x10 * cc.y, x21 * cc.z + x11 * cc.w);
        }
        *(uint4*)p = make_uint4(ao[0], ao[1], ao[2], ao[3]); *(uint4*)(p + 64) = make_uint4(bo[0], bo[1], bo[2], bo[3]);
    }
}
__device__ __forceinline__ void dil_tile_prep(int item, int lane, LAS unsigned short* wl, const bf16_t* __restrict__ ak, const bf16_t* __restrict__ av, const float2* __restrict__ cs,
                                              bf16_t* __restrict__ KB, bf16_t* __restrict__ VB) {
    const int TT = item & 255, hd = (item >> 8) & 7, b = (item >> 11) & 1, br = item >> 12;
    const int ld = 2 * br, tpr = 256 >> ld, rho = TT / tpr, tile = TT - rho * tpr;
    const int i = lane & 15, c = lane >> 4;
    const int s = rho + ((16 * tile + i) << ld);
    const size_t trow = (size_t)b * S + s;
    bf16_t* kdst = KB + (size_t)item * 2048;
    bf16_t* vdst = VB + (size_t)item * 2048;
    {
        const bf16_t* kr = ak + trow * 1024 + hd * 128 + 16 * c;
        const uint4 a0 = *(const uint4*)kr, a1 = *(const uint4*)(kr + 8), b0 = *(const uint4*)(kr + 64), b1 = *(const uint4*)(kr + 72);
        const unsigned aw[8] = {a0.x, a0.y, a0.z, a0.w, a1.x, a1.y, a1.z, a1.w}, bw[8] = {b0.x, b0.y, b0.z, b0.w, b1.x, b1.y, b1.z, b1.w};
        unsigned ao[8], bo[8];
#pragma unroll
        for (int k = 0; k < 8; ++k) {
            const float4 cc = *(const float4*)(cs + (size_t)s * 64 + 16 * c + 2 * k);
            const float x10 = __uint_as_float(aw[k] << 16), x11 = __uint_as_float(aw[k] & 0xFFFF0000u), x20 = __uint_as_float(bw[k] << 16), x21 = __uint_as_float(bw[k] & 0xFFFF0000u);
            ao[k] = pk2(x10 * cc.x - x20 * cc.y, x11 * cc.z - x21 * cc.w);
            bo[k] = pk2(x20 * cc.x + x10 * cc.y, x21 * cc.z + x11 * cc.w);
        }
        bf16_t* d0 = kdst + (c >> 1) * 512 + i * 32 + (c & 1) * 16;
        *(uint4*)d0 = make_uint4(ao[0], ao[1], ao[2], ao[3]); *(uint4*)(d0 + 8) = make_uint4(ao[4], ao[5], ao[6], ao[7]);
        bf16_t* d1 = d0 + 1024;
        *(uint4*)d1 = make_uint4(bo[0], bo[1], bo[2], bo[3]); *(uint4*)(d1 + 8) = make_uint4(bo[4], bo[5], bo[6], bo[7]);
    }
    {
        const bf16_t* vr = av + trow * 1024 + hd * 128 + 32 * c;
        const uint4 v0 = *(const uint4*)vr, v1 = *(const uint4*)(vr + 8), v2 = *(const uint4*)(vr + 16), v3 = *(const uint4*)(vr + 24);
        LAS unsigned short* wr = wl + i * 136 + 32 * c;
        typedef unsigned u32x4_t __attribute__((ext_vector_type(4)));
        *(LAS u32x4_t*)wr = (u32x4_t){v0.x, v0.y, v0.z, v0.w}; *(LAS u32x4_t*)(wr + 8) = (u32x4_t){v1.x, v1.y, v1.z, v1.w};
        *(LAS u32x4_t*)(wr + 16) = (u32x4_t){v2.x, v2.y, v2.z, v2.w}; *(LAS u32x4_t*)(wr + 24) = (u32x4_t){v3.x, v3.y, v3.z, v3.w};
        asm volatile("s_waitcnt lgkmcnt(0)" ::: "memory");
        unsigned o[16];
#pragma unroll
        for (int k = 0; k < 8; ++k) {
            const unsigned p0 = *(const LAS unsigned*)(wl + (2 * k) * 136 + 2 * lane), p1 = *(const LAS unsigned*)(wl + (2 * k + 1) * 136 + 2 * lane);
            o[k] = (p0 & 0xFFFFu) | (p1 << 16);
            o[8 + k] = (p0 >> 16) | (p1 & 0xFFFF0000u);
        }
        bf16_t* d = vdst + (2 * lane) * 16;
        *(uint4*)d = make_uint4(o[0], o[1], o[2], o[3]); *(uint4*)(d + 8) = make_uint4(o[4], o[5], o[6], o[7]);
        *(uint4*)(d + 16) = make_uint4(o[8], o[9], o[10], o[11]); *(uint4*)(d + 24) = make_uint4(o[12], o[13], o[14], o[15]);
        asm volatile("s_waitcnt lgkmcnt(0)" ::: "memory");
    }
}

typedef short bf16x8_t __attribute__((ext_vector_type(8)));
typedef short bf16x4_t __attribute__((ext_vector_type(4)));
typedef float f32x4_t __attribute__((ext_vector_type(4)));
__device__ __forceinline__ float xg_max_f32(float v);
__device__ __forceinline__ float xg_sum_f32(float v);
__device__ __forceinline__ void dilated_wave_tile(int qt2, int lane, const bf16_t* __restrict__ AQ, const float2* __restrict__ cs, const bf16_t* __restrict__ KB, const bf16_t* __restrict__ VB,
                                                  const float* __restrict__ g_ahead, bf16_t* __restrict__ mix) {
    const int r = qt2 & 7, blk = (qt2 >> 3) & 15, hd = (qt2 >> 7) & 7, b = qt2 >> 10;
    const int j = lane & 15, g = lane >> 4;
    const int t0 = blk * 256;
    bf16x8_t qf[2][4];
#pragma unroll
    for (int qi = 0; qi < 2; ++qi) {
        const int sq = t0 + r + 8 * qi + 16 * j;
        const bf16_t* qrow = AQ + ((size_t)b * S + sq) * 1024 + hd * 128 + 8 * g;
        const float sc = 0.08838834764831845f * 1.4426950408889634f;
#pragma unroll
        for (int ks = 0; ks < 2; ++ks) {
            const bf16x8_t lo = *(const bf16x8_t*)(qrow + 32 * ks), hi = *(const bf16x8_t*)(qrow + 32 * ks + 64);
            bf16x8_t olo, ohi;
#pragma unroll
            for (int e2 = 0; e2 < 4; ++e2) {
                const float4 cc = *(const float4*)(cs + (size_t)sq * 64 + 32 * ks + 8 * g + 2 * e2);
                const float x10 = bf2f((unsigned short)lo[2 * e2]), x11 = bf2f((unsigned short)lo[2 * e2 + 1]), x20 = bf2f((unsigned short)hi[2 * e2]), x21 = bf2f((unsigned short)hi[2 * e2 + 1]);
                const unsigned wl_ = pk2((x10 * cc.x - x20 * cc.y) * sc, (x11 * cc.z - x21 * cc.w) * sc), wh_ = pk2((x20 * cc.x + x10 * cc.y) * sc, (x21 * cc.z + x11 * cc.w) * sc);
                olo[2 * e2] = (short)(wl_ & 0xFFFF); olo[2 * e2 + 1] = (short)(wl_ >> 16); ohi[2 * e2] = (short)(wh_ & 0xFFFF); ohi[2 * e2 + 1] = (short)(wh_ >> 16);
            }
            qf[qi][ks] = olo; qf[qi][ks + 2] = ohi;
        }
    }
    float m_run[2] = {-1e30f, -1e30f}, l_run[2] = {0.f, 0.f};
    f32x4_t o[2][8];
#pragma unroll
    for (int qi = 0; qi < 2; ++qi)
#pragma unroll
        for (int dt = 0; dt < 8; ++dt) o[qi][dt] = (f32x4_t){0.f, 0.f, 0.f, 0.f};
#define DIL_STEP(QI, QJ, TP, KF, VF) { \
        f32x4_t su[2]; \
        _Pragma("unroll") for (int u = 0; u < 2; ++u) { f32x4_t a = (f32x4_t){0.f, 0.f, 0.f, 0.f}; \
            _Pragma("unroll") for (int ks = 0; ks < 4; ++ks) a = __builtin_amdgcn_mfma_f32_16x16x32_bf16(KF[u][ks], qf[QI][ks], a, 0, 0, 0); su[u] = a; } \
        float p[2][4]; float mx = -1e30f; \
        _Pragma("unroll") for (int u = 0; u < 2; ++u) _Pragma("unroll") for (int e = 0; e < 4; ++e) { \
            const int n = (QJ) - (16 * ((TP) + u) + 4 * g + e); const bool valid = (n >= 0) && (n <= 128); \
            p[u][e] = valid ? su[u][e] : -1e30f; mx = fmaxf(mx, p[u][e]); } \
        mx = xg_max_f32(mx); \
        const float m_new = fmaxf(m_run[QI], mx); const float alpha = __builtin_amdgcn_exp2f(m_run[QI] - m_new); m_run[QI] = m_new; \
        float ps = 0.f; \
        _Pragma("unroll") for (int u = 0; u < 2; ++u) _Pragma("unroll") for (int e = 0; e < 4; ++e) { p[u][e] = (p[u][e] > -1e29f) ? __builtin_amdgcn_exp2f(p[u][e] - m_new) : 0.f; ps += p[u][e]; } \
        l_run[QI] = l_run[QI] * alpha + ps; \
        bf16x8_t pb; { const unsigned w0 = pk2(p[0][0], p[0][1]), w1 = pk2(p[0][2], p[0][3]), w2 = pk2(p[1][0], p[1][1]), w3 = pk2(p[1][2], p[1][3]); \
            pb[0] = (short)(w0 & 0xFFFF); pb[1] = (short)(w0 >> 16); pb[2] = (short)(w1 & 0xFFFF); pb[3] = (short)(w1 >> 16); \
            pb[4] = (short)(w2 & 0xFFFF); pb[5] = (short)(w2 >> 16); pb[6] = (short)(w3 & 0xFFFF); pb[7] = (short)(w3 >> 16); } \
        _Pragma("unroll") for (int dt = 0; dt < 8; ++dt) { const bf16x4_t v0 = VF[dt][0], v1 = VF[dt][1]; \
            bf16x8_t va; va[0] = v0[0]; va[1] = v0[1]; va[2] = v0[2]; va[3] = v0[3]; va[4] = v1[0]; va[5] = v1[1]; va[6] = v1[2]; va[7] = v1[3]; \
            f32x4_t oo = o[QI][dt]; oo = oo * alpha; o[QI][dt] = __builtin_amdgcn_mfma_f32_16x16x32_bf16(va, pb, oo, 0, 0, 0); } }
#define DIL_LOADK(KF, TL) _Pragma("unroll") for (int u = 0; u < 2; ++u) { int tl_ = (TL) + u; if (tl_ > tile_max) tl_ = tile_max; \
            _Pragma("unroll") for (int ks = 0; ks < 4; ++ks) KF[u][ks] = *(const bf16x8_t*)(kbb + (size_t)tl_ * 2048 + 512 * ks); }
#define DIL_LOADV(VF, TP) { int tl0 = (TP), tl1 = (TP) + 1; if (tl0 > tile_max) tl0 = tile_max; if (tl1 > tile_max) tl1 = tile_max; \
            _Pragma("unroll") for (int dt = 0; dt < 8; ++dt) { VF[dt][0] = *(const bf16x4_t*)(vbb + dt * 256 + (size_t)tl0 * 2048); VF[dt][1] = *(const bf16x4_t*)(vbb + dt * 256 + (size_t)tl1 * 2048); } }
#pragma nounroll
    for (int br = 0; br < 2; ++br) {
        const int ld = 2 * br, d = 1 << ld;
        const int rho = r & (d - 1);
        const int qj0 = (t0 + r + 16 * j - rho) >> ld, qj1 = (t0 + r + 8 + 16 * j - rho) >> ld;
        const int q_lo = ((t0 + r - rho) >> ld) - 128, q_hi = (t0 + r + 8 + 240 - rho) >> ld;
        const int tile_lo = q_lo < 0 ? 0 : (q_lo >> 4), tile_hi = q_hi >> 4, tile_max = (256 >> ld) - 1;
        const size_t tbase = ((size_t)((br * 2 + b) * 8 + hd) * 256 + (size_t)rho * (256 >> ld)) * 2048;
        const bf16_t* kbb = KB + tbase + j * 32 + 8 * g;
        const bf16_t* vbb = VB + tbase + j * 16 + 4 * g;
        bf16x8_t kf[2][4];
        DIL_LOADK(kf, tile_lo)
#pragma nounroll
        for (int tp = tile_lo; tp <= tile_hi; tp += 2) {
            bf16x4_t vf[8][2];
            DIL_LOADV(vf, tp)
            bf16x8_t kc[2][4];
#pragma unroll
            for (int u = 0; u < 2; ++u)
#pragma unroll
                for (int ks = 0; ks < 4; ++ks) kc[u][ks] = kf[u][ks];
            DIL_LOADK(kf, tp + 2)
            DIL_STEP(0, qj0, tp, kc, vf)
            DIL_STEP(1, qj1, tp, kc, vf)
        }
    }
#pragma unroll
    for (int qi = 0; qi < 2; ++qi) {
        const int rho = r + 8 * qi;
        const int qj = (t0 + 16 * j) >> 4;
        const int q_lo = (t0 >> 4) - 128, q_hi = (t0 + 240) >> 4;
        const int tile_lo = q_lo < 0 ? 0 : (q_lo >> 4), tile_hi = q_hi >> 4, tile_max = 15;
        const size_t tbase = ((size_t)((2 * 2 + b) * 8 + hd) * 256 + (size_t)rho * 16) * 2048;
        const bf16_t* kbb = KB + tbase + j * 32 + 8 * g;
        const bf16_t* vbb = VB + tbase + j * 16 + 4 * g;
        bf16x8_t kf[2][4];
        DIL_LOADK(kf, tile_lo)
#pragma nounroll
        for (int tp = tile_lo; tp <= tile_hi; tp += 2) {
            bf16x4_t vf[8][2];
            DIL_LOADV(vf, tp)
            bf16x8_t kc[2][4];
#pragma unroll
            for (int u = 0; u < 2; ++u)
#pragma unroll
                for (int ks = 0; ks < 4; ++ks) kc[u][ks] = kf[u][ks];
            DIL_LOADK(kf, tp + 2)
            if (qi == 0) { DIL_STEP(0, qj, tp, kc, vf) } else { DIL_STEP(1, qj, tp, kc, vf) }
        }
    }
#undef DIL_STEP
#undef DIL_LOADK
#undef DIL_LOADV
#pragma unroll
    for (int qi = 0; qi < 2; ++qi) {
        const int sq = t0 + r + 8 * qi + 16 * j;
        const float inv = 1.0f / xg_sum_f32(l_run[qi]);
        float ss = 0.f;
#pragma unroll
        for (int dt = 0; dt < 8; ++dt) { o[qi][dt] = o[qi][dt] * inv; ss += (o[qi][dt][0] * o[qi][dt][0] + o[qi][dt][1] * o[qi][dt][1]) + (o[qi][dt][2] * o[qi][dt][2] + o[qi][dt][3] * o[qi][dt][3]); }
        ss = xg_sum_f32(ss);
        const float rn = rsqrtf(ss * (1.0f / 128.0f) + EPS);
        bf16_t* orow = mix + ((size_t)b * S + sq) * D + 1024 + hd * 128 + 4 * g;
#pragma unroll
        for (int dt = 0; dt < 8; ++dt) {
            const f32x4_t gv = *(const f32x4_t*)(g_ahead + hd * 128 + 16 * dt + 4 * g);
            uint2 w; w.x = pk2(o[qi][dt][0] * rn * gv[0], o[qi][dt][1] * rn * gv[1]); w.y = pk2(o[qi][dt][2] * rn * gv[2], o[qi][dt][3] * rn * gv[3]);
            *(uint2*)(orow + 16 * dt) = w;
        }
    }
}

__device__ __forceinline__ unsigned ord_key(float s) { const unsigned u = __float_as_uint(s); return u ^ ((unsigned)((int)u >> 31) | 0x80000000u); }
__device__ __forceinline__ unsigned wave_max_u32(unsigned v) {
    unsigned t;
    t = (unsigned)__builtin_amdgcn_update_dpp(0, (int)v, 0xB1, 0xF, 0xF, true); v = v > t ? v : t;
    t = (unsigned)__builtin_amdgcn_update_dpp(0, (int)v, 0x4E, 0xF, 0xF, true); v = v > t ? v : t;
    t = (unsigned)__builtin_amdgcn_update_dpp(0, (int)v, 0x141, 0xF, 0xF, true); v = v > t ? v : t;
    t = (unsigned)__builtin_amdgcn_update_dpp(0, (int)v, 0x140, 0xF, 0xF, true); v = v > t ? v : t;
    const unsigned a = (unsigned)__builtin_amdgcn_readlane((int)v, 0), b = (unsigned)__builtin_amdgcn_readlane((int)v, 16),
                   c = (unsigned)__builtin_amdgcn_readlane((int)v, 32), d = (unsigned)__builtin_amdgcn_readlane((int)v, 48);
    const unsigned ab = a > b ? a : b, cd = c > d ? c : d;
    return ab > cd ? ab : cd;
}
__device__ __forceinline__ void peer_topk_wave(int item, int lane, LAS float* wl, const bf16_t* __restrict__ qp, const bf16_t* __restrict__ skb, int* __restrict__ ids, float* __restrict__ gates) {
    const int hd = item & 7, tt = item >> 3, j = lane & 15, g = lane >> 4;
    const size_t t0 = (size_t)tt * 16;
    LAS float* sc = wl;
    LAS float* lst = wl + 2048;
#pragma unroll 1
    for (int p = 0; p < 2; ++p) {
        bf16x8_t qf[4];
        const bf16_t* qrow = qp + (t0 + j) * D + hd * 256 + p * 128 + 8 * g;
#pragma unroll
        for (int ks = 0; ks < 4; ++ks) qf[ks] = *(const bf16x8_t*)(qrow + 32 * ks);
        const bf16_t* kb = skb + ((size_t)(hd * 2 + p) * 128 + j) * 128 + 8 * g;
#pragma unroll
        for (int kt = 0; kt < 8; ++kt) {
            f32x4_t a = (f32x4_t){0.f, 0.f, 0.f, 0.f};
#pragma unroll
            for (int ks = 0; ks < 4; ++ks) a = __builtin_amdgcn_mfma_f32_16x16x32_bf16(*(const bf16x8_t*)(kb + (size_t)kt * (16 * 128) + 32 * ks), qf[ks], a, 0, 0, 0);
            *(LAS f32x4_t*)(sc + j * 128 + 16 * kt + 4 * g) = a;
        }
        asm volatile("s_waitcnt lgkmcnt(0)" ::: "memory");
#pragma unroll 1
        for (int tok = 0; tok < 16; ++tok) {
            const float s0 = sc[tok * 128 + lane], s1 = sc[tok * 128 + 64 + lane];
            unsigned k0 = (ord_key(s0) & ~127u) | (unsigned)(127 - lane), k1 = (ord_key(s1) & ~127u) | (unsigned)(63 - lane);
            unsigned sel = 0u;
#pragma unroll 4
            for (int it = 0; it < 16; ++it) {
                unsigned m = k0 > k1 ? k0 : k1;
                m = wave_max_u32(m);
                if (lane == it) sel = m;
                if (k0 == m) k0 = 0u;
                if (k1 == m) k1 = 0u;
            }
            if (lane < 16) {
                const int idx = 127 - (int)(sel & 127u);
                lst[((p * 16 + tok) * 16 + lane) * 2 + 0] = sc[tok * 128 + idx];
                lst[((p * 16 + tok) * 16 + lane) * 2 + 1] = __int_as_float(idx);
            }
        }
        asm volatile("s_waitcnt lgkmcnt(0)" ::: "memory");
    }
#pragma unroll 1
    for (int tok = 0; tok < 16; ++tok) {
        const int i = lane >> 2;
        const float sA = lst[((0 * 16 + tok) * 16 + i) * 2];
        unsigned kk[4];
#pragma unroll
        for (int r = 0; r < 4; ++r) {
            const int jb = (lane & 3) * 4 + r;
            const float sum = sA + lst[((1 * 16 + tok) * 16 + jb) * 2];
            kk[r] = (ord_key(sum) & ~255u) | (unsigned)(255 - (lane * 4 + r));
        }
        unsigned sel = 0u;
#pragma unroll 4
        for (int it = 0; it < 16; ++it) {
            unsigned m = kk[0] > kk[1] ? kk[0] : kk[1]; const unsigned m2 = kk[2] > kk[3] ? kk[2] : kk[3]; m = m > m2 ? m : m2;
            m = wave_max_u32(m);
            if (lane == it) sel = m;
#pragma unroll
            for (int r = 0; r < 4; ++r) if (kk[r] == m) kk[r] = 0u;
        }
        float bs = -INFINITY; int eid = 0;
        if (lane < 16) {
            const int c = 255 - (int)(sel & 255u), ia = c >> 4, ib = c & 15;
            bs = lst[((0 * 16 + tok) * 16 + ia) * 2] + lst[((1 * 16 + tok) * 16 + ib) * 2];
            eid = __float_as_int(lst[((0 * 16 + tok) * 16 + ia) * 2 + 1]) * 128 + __float_as_int(lst[((1 * 16 + tok) * 16 + ib) * 2 + 1]);
        }
        const float mx = wave_max(bs);
        const float ev = lane < 16 ? __expf(bs - mx) : 0.f;
        const float tot = wave_sum(ev);
        if (lane < 16) {
            ids[(t0 + tok) * 128 + hd * 16 + lane] = eid;
            gates[(t0 + tok) * 128 + hd * 16 + lane] = ev / tot;
        }
    }
}

typedef float f32x2_t __attribute__((ext_vector_type(2)));
__device__ __forceinline__ float wave_max_all(float v) {
    v = fmaxf(v, __uint_as_float((unsigned)__builtin_amdgcn_update_dpp(0, (int)__float_as_uint(v), 0xB1, 0xF, 0xF, true)));
    v = fmaxf(v, __uint_as_float((unsigned)__builtin_amdgcn_update_dpp(0, (int)__float_as_uint(v), 0x4E, 0xF, 0xF, true)));
    v = fmaxf(v, __uint_as_float((unsigned)__builtin_amdgcn_update_dpp(0, (int)__float_as_uint(v), 0x141, 0xF, 0xF, true)));
    v = fmaxf(v, __uint_as_float((unsigned)__builtin_amdgcn_update_dpp(0, (int)__float_as_uint(v), 0x140, 0xF, 0xF, true)));
    auto a = __builtin_amdgcn_permlane16_swap(__float_as_uint(v), __float_as_uint(v), false, false); v = fmaxf(__uint_as_float(a[0]), __uint_as_float(a[1]));
    auto b = __builtin_amdgcn_permlane32_swap(__float_as_uint(v), __float_as_uint(v), false, false); return fmaxf(__uint_as_float(b[0]), __uint_as_float(b[1]));
}
template <bool I8> __device__ __forceinline__ void table_row_store(float4 (&f)[8], unsigned char* __restrict__ drow, float* __restrict__ rscale, int lane, const float* __restrict__ dgain) {
    if (I8) {
#pragma unroll
        for (int i = 0; i < 8; ++i) { const float4 gq = *(const float4*)(dgain + i * 256 + lane * 4); f[i].x *= gq.x; f[i].y *= gq.y; f[i].z *= gq.z; f[i].w *= gq.w; }
    }
    float am = 0.f;
#pragma unroll
    for (int i = 0; i < 8; ++i) am = fmaxf(am, fmaxf(fmaxf(fabsf(f[i].x), fabsf(f[i].y)), fmaxf(fabsf(f[i].z), fabsf(f[i].w))));
    am = wave_max_all(am);
    const float s = exp2f(fminf(floorf(log2f((I8 ? 127.0f : 448.0f) / fmaxf(am, 1e-30f))), 100.0f));
#pragma unroll
    for (int i = 0; i < 8; ++i) {
        unsigned w;
        if (I8) { const int q0 = __float2int_rn(f[i].x * s), q1 = __float2int_rn(f[i].y * s), q2 = __float2int_rn(f[i].z * s), q3 = __float2int_rn(f[i].w * s);
                  w = ((unsigned)q0 & 255u) | (((unsigned)q1 & 255u) << 8) | (((unsigned)q2 & 255u) << 16) | (((unsigned)q3 & 255u) << 24); }
        else { int t = 0; t = __builtin_amdgcn_cvt_pk_fp8_f32(f[i].x * s, f[i].y * s, t, false); t = __builtin_amdgcn_cvt_pk_fp8_f32(f[i].z * s, f[i].w * s, t, true); w = (unsigned)t; }
        *(unsigned*)(drow + i * 256 + lane * 4) = w;
    }
    if (lane == 0) *rscale = 1.0f / s;
}
__device__ __forceinline__ void table_row_to_fp8(const float* __restrict__ srow, unsigned char* __restrict__ drow, float* __restrict__ rscale, int lane, const float* __restrict__ dgain) {
    float4 f[8];
#pragma unroll
    for (int i = 0; i < 8; ++i) f[i] = *(const float4*)(srow + i * 256 + lane * 4);
    if (dgain) {
#pragma unroll
        for (int i = 0; i < 8; ++i) { const float4 gq = *(const float4*)(dgain + i * 256 + lane * 4); f[i].x *= gq.x; f[i].y *= gq.y; f[i].z *= gq.z; f[i].w *= gq.w; }
    }
    float am = 0.f;
#pragma unroll
    for (int i = 0; i < 8; ++i) am = fmaxf(am, fmaxf(fmaxf(fabsf(f[i].x), fabsf(f[i].y)), fmaxf(fabsf(f[i].z), fabsf(f[i].w))));
    am = wave_max(am);
    const float e = floorf(log2f(448.0f / fmaxf(am, 1e-30f)));
    const float s = exp2f(fminf(e, 100.0f));
    unsigned w[8];
#pragma unroll
    for (int i = 0; i < 8; ++i) {
        int t = 0;
        t = __builtin_amdgcn_cvt_pk_fp8_f32(f[i].x * s, f[i].y * s, t, false);
        t = __builtin_amdgcn_cvt_pk_fp8_f32(f[i].z * s, f[i].w * s, t, true);
        w[i] = (unsigned)t;
    }
#pragma unroll
    for (int i = 0; i < 8; ++i) *(unsigned*)(drow + i * 256 + lane * 4) = w[i];
    if (lane == 0) *rscale = 1.0f / s;
}
__device__ __forceinline__ void table_row_to_i8(const float* __restrict__ srow, unsigned char* __restrict__ drow, float* __restrict__ rscale, int lane, const float* __restrict__ dgain) {
    float4 f[8];
#pragma unroll
    for (int i = 0; i < 8; ++i) { f[i] = *(const float4*)(srow + i * 256 + lane * 4); const float4 gq = *(const float4*)(dgain + i * 256 + lane * 4); f[i].x *= gq.x; f[i].y *= gq.y; f[i].z *= gq.z; f[i].w *= gq.w; }
    float am = 0.f;
#pragma unroll
    for (int i = 0; i < 8; ++i) am = fmaxf(am, fmaxf(fmaxf(fabsf(f[i].x), fabsf(f[i].y)), fmaxf(fabsf(f[i].z), fabsf(f[i].w))));
    am = wave_max(am);
    const float s = exp2f(fminf(floorf(log2f(127.0f / fmaxf(am, 1e-30f))), 100.0f));
#pragma unroll
    for (int i = 0; i < 8; ++i) {
        const int q0 = __float2int_rn(f[i].x * s), q1 = __float2int_rn(f[i].y * s), q2 = __float2int_rn(f[i].z * s), q3 = __float2int_rn(f[i].w * s);
        *(unsigned*)(drow + i * 256 + lane * 4) = ((unsigned)q0 & 255u) | (((unsigned)q1 & 255u) << 8) | (((unsigned)q2 & 255u) << 16) | (((unsigned)q3 & 255u) << 24);
    }
    if (lane == 0) *rscale = 1.0f / s;
}
__device__ __forceinline__ float dot16_fp8(const uint4 q, const float* x) {
    float d = 0.f;
    const unsigned w[4] = {q.x, q.y, q.z, q.w};
#pragma unroll
    for (int k = 0; k < 4; ++k) {
        const f32x2_t lo = __builtin_amdgcn_cvt_pk_f32_fp8((int)w[k], false), hi = __builtin_amdgcn_cvt_pk_f32_fp8((int)w[k], true);
        d = fmaf(lo.x, x[4 * k], d); d = fmaf(lo.y, x[4 * k + 1], d); d = fmaf(hi.x, x[4 * k + 2], d); d = fmaf(hi.y, x[4 * k + 3], d);
    }
    return d;
}
__device__ __forceinline__ void axpy16_fp8(const uint4 q, float c, float* acc) {
    const unsigned w[4] = {q.x, q.y, q.z, q.w};
#pragma unroll
    for (int k = 0; k < 4; ++k) {
        const f32x2_t lo = __builtin_amdgcn_cvt_pk_f32_fp8((int)w[k], false), hi = __builtin_amdgcn_cvt_pk_f32_fp8((int)w[k], true);
        acc[4 * k] = fmaf(c, lo.x, acc[4 * k]); acc[4 * k + 1] = fmaf(c, lo.y, acc[4 * k + 1]); acc[4 * k + 2] = fmaf(c, hi.x, acc[4 * k + 2]); acc[4 * k + 3] = fmaf(c, hi.y, acc[4 * k + 3]);
    }
}
__device__ __forceinline__ void d_peer_out8(int vb, int tid, float* sm, const bf16_t* __restrict__ h3, const float* __restrict__ x2, const int* __restrict__ ids, const float* __restrict__ gates,
                                            const unsigned char* __restrict__ ut8, const unsigned char* __restrict__ vt8, const float* __restrict__ rsc, const float* __restrict__ rstd, const float* __restrict__ g_final, float* __restrict__ out) {
    float (*part)[2048] = (float (*)[2048])sm;
    float* red = sm + 4 * 2048;
    const int lane = tid & 63, w = tid >> 6, t = vb;
    float x[32], acc[32];
    {
        const bf16_t* hrow = h3 + (size_t)t * D + lane * 16;
#pragma unroll
        for (int hh = 0; hh < 2; ++hh) {
            const uint4 a = *(const uint4*)(hrow + hh * 1024), b = *(const uint4*)(hrow + hh * 1024 + 8);
            const unsigned ww[8] = {a.x, a.y, a.z, a.w, b.x, b.y, b.z, b.w};
#pragma unroll
            for (int k = 0; k < 8; ++k) { x[hh * 16 + 2 * k] = __uint_as_float(ww[k] << 16); x[hh * 16 + 2 * k + 1] = __uint_as_float(ww[k] & 0xFFFF0000u); }
        }
#pragma unroll
        for (int i = 0; i < 32; ++i) acc[i] = 0.f;
    }
    const float xrs = rstd[t];
    const int myid = ids[(size_t)t * 128 + w * 32 + (lane & 31)];
    const float mygate = gates[(size_t)t * 128 + w * 32 + (lane & 31)];
#pragma unroll 1
    for (int j = 0; j < 32; j += 4) {
        int e[4]; uint4 uq[4][2], vq[4][2];
#pragma unroll
        for (int q = 0; q < 4; ++q) {
            e[q] = __builtin_amdgcn_readfirstlane(__shfl(myid, j + q));
            const unsigned char* ur = ut8 + (size_t)e[q] * 2048 + lane * 16;
            uq[q][0] = *(const uint4*)ur; uq[q][1] = *(const uint4*)(ur + 1024);
        }
#pragma unroll
        for (int q = 0; q < 4; ++q) {
            const unsigned char* vr = vt8 + (size_t)e[q] * 2048 + lane * 16;
            vq[q][0] = *(const uint4*)vr; vq[q][1] = *(const uint4*)(vr + 1024);
        }
        float d[4];
#pragma unroll
        for (int q = 0; q < 4; ++q) d[q] = dot16_fp8(uq[q][0], x) + dot16_fp8(uq[q][1], x + 16);
#pragma unroll
        for (int o = 32; o >= 1; o >>= 1) {
#pragma unroll
            for (int q = 0; q < 4; ++q) d[q] += __shfl_xor(d[q], o);
        }
#pragma unroll
        for (int q = 0; q < 4; ++q) {
            const float a = d[q] * rsc[e[q]] * xrs;
            const float act = 0.5f * a * (1.0f + erff(a * 0.7071067811865476f));
            const float cf = __shfl(mygate, j + q) * act * rsc[16384 + e[q]];
            axpy16_fp8(vq[q][0], cf, acc); axpy16_fp8(vq[q][1], cf, acc + 16);
        }
    }
    __syncthreads();
#pragma unroll
    for (int hh = 0; hh < 2; ++hh)
#pragma unroll
        for (int k = 0; k < 4; ++k) *(float4*)&part[w][hh * 1024 + lane * 16 + 4 * k] = make_float4(acc[hh * 16 + 4 * k], acc[hh * 16 + 4 * k + 1], acc[hh * 16 + 4 * k + 2], acc[hh * 16 + 4 * k + 3]);
    __syncthreads();
    float4 r0, r1;
    {
        const float4 a = *(const float4*)&part[0][tid * 4], b = *(const float4*)&part[1][tid * 4], c = *(const float4*)&part[2][tid * 4], dd = *(const float4*)&part[3][tid * 4];
        const float4 xx = *(const float4*)(x2 + (size_t)t * D + tid * 4);
        r0 = make_float4(xx.x + a.x + b.x + c.x + dd.x, xx.y + a.y + b.y + c.y + dd.y, xx.z + a.z + b.z + c.z + dd.z, xx.w + a.w + b.w + c.w + dd.w);
    }
    {
        const float4 a = *(const float4*)&part[0][1024 + tid * 4], b = *(const float4*)&part[1][1024 + tid * 4], c = *(const float4*)&part[2][1024 + tid * 4], dd = *(const float4*)&part[3][1024 + tid * 4];
        const float4 xx = *(const float4*)(x2 + (size_t)t * D + 1024 + tid * 4);
        r1 = make_float4(xx.x + a.x + b.x + c.x + dd.x, xx.y + a.y + b.y + c.y + dd.y, xx.z + a.z + b.z + c.z + dd.z, xx.w + a.w + b.w + c.w + dd.w);
    }
    float s = r0.x * r0.x + r0.y * r0.y + r0.z * r0.z + r0.w * r0.w + r1.x * r1.x + r1.y * r1.y + r1.z * r1.z + r1.w * r1.w;
    s = wave_sum(s);
    if (lane == 0) red[w] = s;
    __syncthreads();
    const float tot = red[0] + red[1] + red[2] + red[3];
    const float r = rsqrtf(tot * (1.0f / D) + EPS);
    const float4 g0 = *(const float4*)(g_final + tid * 4), g1 = *(const float4*)(g_final + 1024 + tid * 4);
    *(float4*)(out + (size_t)t * D + tid * 4) = make_float4(r0.x * r * g0.x, r0.y * r * g0.y, r0.z * r * g0.z, r0.w * r * g0.w);
    *(float4*)(out + (size_t)t * D + 1024 + tid * 4) = make_float4(r1.x * r * g1.x, r1.y * r * g1.y, r1.z * r * g1.z, r1.w * r * g1.w);
}

__device__ __forceinline__ unsigned xg_sum_u32(unsigned v) {
    auto a = __builtin_amdgcn_permlane16_swap(v, v, false, false); v = a[0] + a[1];
    auto b = __builtin_amdgcn_permlane32_swap(v, v, false, false); return b[0] + b[1];
}
__device__ __forceinline__ float xg_sum_f32(float v) {
    auto a = __builtin_amdgcn_permlane16_swap(__float_as_uint(v), __float_as_uint(v), false, false); v = __uint_as_float(a[0]) + __uint_as_float(a[1]);
    auto b = __builtin_amdgcn_permlane32_swap(__float_as_uint(v), __float_as_uint(v), false, false); return __uint_as_float(b[0]) + __uint_as_float(b[1]);
}
__device__ __forceinline__ float xg_max_f32(float v) {
    auto a = __builtin_amdgcn_permlane16_swap(__float_as_uint(v), __float_as_uint(v), false, false); v = fmaxf(__uint_as_float(a[0]), __uint_as_float(a[1]));
    auto b = __builtin_amdgcn_permlane32_swap(__float_as_uint(v), __float_as_uint(v), false, false); return fmaxf(__uint_as_float(b[0]), __uint_as_float(b[1]));
}
template <int N> __device__ __forceinline__ unsigned bisect16(const unsigned (&kk)[N]) {
    unsigned tau = 0u; bool done = false;
#pragma unroll 1
    for (int bit = 31; bit >= 0; --bit) {
        const unsigned cand = tau | (1u << bit);
        unsigned c0 = 0u, c1 = 0u, c2 = 0u, c3 = 0u;
#pragma unroll
        for (int i = 0; i < N; i += 4) { c0 += (kk[i] >= cand) ? 1u : 0u; c1 += (kk[i + 1] >= cand) ? 1u : 0u; c2 += (kk[i + 2] >= cand) ? 1u : 0u; c3 += (kk[i + 3] >= cand) ? 1u : 0u; }
        unsigned c = xg_sum_u32((c0 + c1) + (c2 + c3));
        if (!done && c >= 16u) { tau = cand; done = (c == 16u); }
        if (__all(done ? 1 : 0)) break;
    }
    return tau;
}
__device__ __forceinline__ void peer_topk_wave2(int item, int lane, LAS float* wl, const bf16_t* __restrict__ qp, const bf16_t* __restrict__ skb, int* __restrict__ ids, float* __restrict__ gates) {
    const int hd = item & 7, tt = item >> 3, j = lane & 15, g = lane >> 4;
    const size_t t0 = (size_t)tt * 16;
#pragma unroll 1
    for (int p = 0; p < 2; ++p) {
        bf16x8_t qf[4];
        const bf16_t* qrow = qp + (t0 + j) * D + hd * 256 + p * 128 + 8 * g;
#pragma unroll
        for (int ks = 0; ks < 4; ++ks) qf[ks] = *(const bf16x8_t*)(qrow + 32 * ks);
        const bf16_t* kb = skb + ((size_t)(hd * 2 + p) * 128 + j) * 128 + 8 * g;
        float sc[32]; unsigned kk[32];
#pragma unroll
        for (int kt = 0; kt < 8; ++kt) {
            f32x4_t a = (f32x4_t){0.f, 0.f, 0.f, 0.f};
#pragma unroll
            for (int ks = 0; ks < 4; ++ks) a = __builtin_amdgcn_mfma_f32_16x16x32_bf16(*(const bf16x8_t*)(kb + (size_t)kt * (16 * 128) + 32 * ks), qf[ks], a, 0, 0, 0);
#pragma unroll
            for (int r = 0; r < 4; ++r) { sc[kt * 4 + r] = a[r]; kk[kt * 4 + r] = (ord_key(a[r]) & ~127u) | (unsigned)(127 - (16 * kt + 4 * g + r)); }
        }
        const unsigned tau = bisect16<32>(kk);
        unsigned cnt = 0u;
#pragma unroll
        for (int i = 0; i < 32; ++i) cnt += (kk[i] >= tau) ? 1u : 0u;
        const unsigned c0 = (unsigned)__shfl((int)cnt, j), c1 = (unsigned)__shfl((int)cnt, j + 16), c2 = (unsigned)__shfl((int)cnt, j + 32);
        unsigned off = (g > 0 ? c0 : 0u) + (g > 1 ? c1 : 0u) + (g > 2 ? c2 : 0u);
        LAS float* ls = wl + p * 256 + j * 16;
        LAS float* li = wl + 512 + p * 256 + j * 16;
#pragma unroll
        for (int i = 0; i < 32; ++i) {
            if (kk[i] >= tau && off < 16u) { ls[off] = sc[i]; li[off] = __int_as_float(16 * (i >> 2) + 4 * g + (i & 3)); ++off; }
        }
    }
    asm volatile("s_waitcnt lgkmcnt(0)" ::: "memory");
    {
        float sA[4], sB[16]; int iA[4];
        {
            const f32x4_t a = *(const LAS f32x4_t*)(wl + j * 16 + 4 * g);
            const f32x4_t ai = *(const LAS f32x4_t*)(wl + 512 + j * 16 + 4 * g);
#pragma unroll
            for (int r = 0; r < 4; ++r) { sA[r] = a[r]; iA[r] = __float_as_int(ai[r]); }
#pragma unroll
            for (int q = 0; q < 4; ++q) { const f32x4_t b = *(const LAS f32x4_t*)(wl + 256 + j * 16 + 4 * q); sB[4 * q] = b[0]; sB[4 * q + 1] = b[1]; sB[4 * q + 2] = b[2]; sB[4 * q + 3] = b[3]; }
        }
        unsigned kk[64];
#pragma unroll
        for (int a = 0; a < 4; ++a)
#pragma unroll
            for (int b = 0; b < 16; ++b) kk[a * 16 + b] = (ord_key(sA[a] + sB[b]) & ~255u) | (unsigned)(255 - ((4 * g + a) * 16 + b));
        const unsigned tau = bisect16<64>(kk);
        float mx = -INFINITY; unsigned cnt = 0u;
#pragma unroll
        for (int i = 0; i < 64; ++i) if (kk[i] >= tau) { mx = fmaxf(mx, sA[i >> 4] + sB[i & 15]); ++cnt; }
        mx = xg_max_f32(mx);
        float es = 0.f;
#pragma unroll
        for (int i = 0; i < 64; ++i) if (kk[i] >= tau) es += __expf(sA[i >> 4] + sB[i & 15] - mx);
        const float inv = 1.0f / xg_sum_f32(es);
        const unsigned c0 = (unsigned)__shfl((int)cnt, j), c1 = (unsigned)__shfl((int)cnt, j + 16), c2 = (unsigned)__shfl((int)cnt, j + 32);
        unsigned off = (g > 0 ? c0 : 0u) + (g > 1 ? c1 : 0u) + (g > 2 ? c2 : 0u);
        int* idp = ids + (t0 + j) * 128 + hd * 16;
        float* gtp = gates + (t0 + j) * 128 + hd * 16;
        const LAS float* liB = wl + 512 + 256 + j * 16;
#pragma unroll
        for (int i = 0; i < 64; ++i) {
            if (kk[i] >= tau && off < 16u) {
                idp[off] = iA[i >> 4] * 128 + __float_as_int(liB[i & 15]);
                gtp[off] = __expf(sA[i >> 4] + sB[i & 15] - mx) * inv;
                ++off;
            }
        }
    }
}

__device__ __forceinline__ float wave_sum_dpp(float v) {
    v += __uint_as_float((unsigned)__builtin_amdgcn_update_dpp(0, (int)__float_as_uint(v), 0xB1, 0xF, 0xF, true));
    v += __uint_as_float((unsigned)__builtin_amdgcn_update_dpp(0, (int)__float_as_uint(v), 0x4E, 0xF, 0xF, true));
    v += __uint_as_float((unsigned)__builtin_amdgcn_update_dpp(0, (int)__float_as_uint(v), 0x141, 0xF, 0xF, true));
    v += __uint_as_float((unsigned)__builtin_amdgcn_update_dpp(0, (int)__float_as_uint(v), 0x140, 0xF, 0xF, true));
    const float a = __uint_as_float((unsigned)__builtin_amdgcn_readlane((int)__float_as_uint(v), 0)), b = __uint_as_float((unsigned)__builtin_amdgcn_readlane((int)__float_as_uint(v), 16)),
                c = __uint_as_float((unsigned)__builtin_amdgcn_readlane((int)__float_as_uint(v), 32)), d = __uint_as_float((unsigned)__builtin_amdgcn_readlane((int)__float_as_uint(v), 48));
    return (a + b) + (c + d);
}
typedef __bf16 bf16x2v_t __attribute__((ext_vector_type(2)));
__device__ __forceinline__ int wave_sum_all_i32(int v) {
    v += __builtin_amdgcn_update_dpp(0, v, 0xB1, 0xF, 0xF, true);
    v += __builtin_amdgcn_update_dpp(0, v, 0x4E, 0xF, 0xF, true);
    v += __builtin_amdgcn_update_dpp(0, v, 0x141, 0xF, 0xF, true);
    v += __builtin_amdgcn_update_dpp(0, v, 0x140, 0xF, 0xF, true);
    auto a = __builtin_amdgcn_permlane16_swap((unsigned)v, (unsigned)v, false, false); v = (int)(a[0] + a[1]);
    auto b = __builtin_amdgcn_permlane32_swap((unsigned)v, (unsigned)v, false, false); return (int)(b[0] + b[1]);
}
__device__ __forceinline__ float wave_sum_all(float v) {
    v += __uint_as_float((unsigned)__builtin_amdgcn_update_dpp(0, (int)__float_as_uint(v), 0xB1, 0xF, 0xF, true));
    v += __uint_as_float((unsigned)__builtin_amdgcn_update_dpp(0, (int)__float_as_uint(v), 0x4E, 0xF, 0xF, true));
    v += __uint_as_float((unsigned)__builtin_amdgcn_update_dpp(0, (int)__float_as_uint(v), 0x141, 0xF, 0xF, true));
    v += __uint_as_float((unsigned)__builtin_amdgcn_update_dpp(0, (int)__float_as_uint(v), 0x140, 0xF, 0xF, true));
    auto a = __builtin_amdgcn_permlane16_swap(__float_as_uint(v), __float_as_uint(v), false, false); v = __uint_as_float(a[0]) + __uint_as_float(a[1]);
    auto b = __builtin_amdgcn_permlane32_swap(__float_as_uint(v), __float_as_uint(v), false, false); return __uint_as_float(b[0]) + __uint_as_float(b[1]);
}
__device__ __forceinline__ float dot16_fp8_bf16(const uint4 q, const uint4 xa, const uint4 xb, float d) {
    const unsigned w[4] = {q.x, q.y, q.z, q.w};
    const unsigned xw[8] = {xa.x, xa.y, xa.z, xa.w, xb.x, xb.y, xb.z, xb.w};
#pragma unroll
    for (int k = 0; k < 4; ++k) {
        const bf16x2v_t lo = __builtin_amdgcn_cvt_scalef32_pk_bf16_fp8(w[k], 1.0f, false), hi = __builtin_amdgcn_cvt_scalef32_pk_bf16_fp8(w[k], 1.0f, true);
        d = __builtin_amdgcn_fdot2_f32_bf16(lo, __builtin_bit_cast(bf16x2v_t, xw[2 * k]), d, false);
        d = __builtin_amdgcn_fdot2_f32_bf16(hi, __builtin_bit_cast(bf16x2v_t, xw[2 * k + 1]), d, false);
    }
    return d;
}
__device__ __forceinline__ void axpy16_fp8_pk(const uint4 q, const f32x2_t c2, f32x2_t* acc) {
    const unsigned w[4] = {q.x, q.y, q.z, q.w};
#pragma unroll
    for (int k = 0; k < 4; ++k) {
        const f32x2_t lo = __builtin_amdgcn_cvt_pk_f32_fp8((int)w[k], false), hi = __builtin_amdgcn_cvt_pk_f32_fp8((int)w[k], true);
        acc[2 * k] = __builtin_elementwise_fma(c2, lo, acc[2 * k]); acc[2 * k + 1] = __builtin_elementwise_fma(c2, hi, acc[2 * k + 1]);
    }
}
__device__ __forceinline__ float gelu_as(float v) {
    const float av = fabsf(v), t = __builtin_amdgcn_rcpf(av * 0.2316418882f + 1.0f);
    float q = t * 0.5307027145f + (-0.7265760135f); q = q * t + 0.7107068705f; q = q * t + (-0.142248368f); q = q * t + 0.127414796f; q = q * t;
    const float e = __builtin_amdgcn_exp2f((v * v) * (-0.72134752044f));
    const float m = v * (q * e);
    return v < 0.f ? m : v - m;
}
__device__ __forceinline__ void peer_sweep_wave(int gw, int lane, LAS unsigned char* wl, const bf16_t* __restrict__ h3, const float* __restrict__ x2, const int* __restrict__ ids,
                                                const float* __restrict__ gates, const unsigned char* __restrict__ ut8, const unsigned char* __restrict__ vt8, const float* __restrict__ rsc,
                                                const float* __restrict__ rstd, const float* __restrict__ g_final, float* __restrict__ out) {
    typedef unsigned u32x4_t __attribute__((ext_vector_type(4)));
    typedef int i32x4_t __attribute__((ext_vector_type(4)));
    LAS unsigned char* x8 = wl;
    LAS unsigned* sorted = (LAS unsigned*)(wl + 8192);
    LAS unsigned* cnt = (LAS unsigned*)(wl + 8192 + 2048);
    LAS unsigned* base = (LAS unsigned*)(wl + 8192 + 2048 + 256);
    LAS unsigned short* gsv = (LAS unsigned short*)(wl + 8192 + 2048 + 512);
    const size_t t0 = (size_t)gw * 4;
    float fac = 0.f;
#pragma unroll
    for (int tok = 0; tok < 4; ++tok) {
        uint4 xv[4]; float am = 0.f;
#pragma unroll
        for (int c = 0; c < 4; ++c) {
            xv[c] = *(const uint4*)(h3 + (t0 + tok) * D + c * 512 + lane * 8);
            const unsigned w[4] = {xv[c].x, xv[c].y, xv[c].z, xv[c].w};
#pragma unroll
            for (int k = 0; k < 4; ++k) am = fmaxf(am, fmaxf(fabsf(__uint_as_float(w[k] << 16)), fabsf(__uint_as_float(w[k] & 0xFFFF0000u))));
        }
        am = wave_max(am);
        const float s = exp2f(fminf(floorf(log2f(127.0f / fmaxf(am, 1e-30f))), 100.0f));
        if ((lane & 3) == tok) fac = rstd[t0 + tok] / s;
#pragma unroll
        for (int c = 0; c < 4; ++c) {
            const unsigned w[4] = {xv[c].x, xv[c].y, xv[c].z, xv[c].w};
            unsigned o[2];
#pragma unroll
            for (int h = 0; h < 2; ++h) {
                const int q0 = __float2int_rn(__uint_as_float(w[2 * h] << 16) * s), q1 = __float2int_rn(__uint_as_float(w[2 * h] & 0xFFFF0000u) * s);
                const int q2 = __float2int_rn(__uint_as_float(w[2 * h + 1] << 16) * s), q3 = __float2int_rn(__uint_as_float(w[2 * h + 1] & 0xFFFF0000u) * s);
                o[h] = ((unsigned)q0 & 255u) | (((unsigned)q1 & 255u) << 8) | (((unsigned)q2 & 255u) << 16) | (((unsigned)q3 & 255u) << 24);
            }
            typedef unsigned u32x2_t __attribute__((ext_vector_type(2)));
            *(LAS u32x2_t*)(x8 + tok * 2048 + c * 512 + lane * 8) = (u32x2_t){o[0], o[1]};
        }
    }
    cnt[lane] = 0u;
    asm volatile("s_waitcnt lgkmcnt(0)" ::: "memory");
    unsigned key[8], rk[8]; unsigned short fv[8];
#pragma unroll
    for (int r = 0; r < 8; ++r) {
        const int n = r * 64 + lane;
        const unsigned e = (unsigned)ids[t0 * 128 + n];
        key[r] = (e << 9) | (unsigned)n | (__float_as_uint(rsc[e]) & 0x7F800000u);
        fv[r] = (unsigned short)f2bf(gates[t0 * 128 + n] * rsc[16384 + e]);
        rk[r] = __hip_atomic_fetch_add(&cnt[e >> 8], 1u, __ATOMIC_RELAXED, __HIP_MEMORY_SCOPE_WORKGROUP);
    }
    asm volatile("s_waitcnt lgkmcnt(0)" ::: "memory");
    {
        const unsigned c = cnt[lane];
        unsigned incl = c;
#pragma unroll
        for (int o = 1; o < 64; o <<= 1) { const unsigned t = (unsigned)__shfl_up((int)incl, o); if (lane >= o) incl += t; }
        base[lane] = incl - c;
    }
    asm volatile("s_waitcnt lgkmcnt(0)" ::: "memory");
#pragma unroll
    for (int r = 0; r < 8; ++r) { const unsigned pos = base[(key[r] >> 17) & 63u] + rk[r]; sorted[pos] = key[r]; gsv[pos] = fv[r]; }
    asm volatile("s_waitcnt lgkmcnt(0)" ::: "memory");
    float rs4[4];
#pragma unroll
    for (int tok = 0; tok < 4; ++tok) rs4[tok] = __uint_as_float((unsigned)__builtin_amdgcn_readlane((int)__float_as_uint(fac), tok));
#define P1_LOAD(ENT, UQ, I0) _Pragma("unroll") for (int q = 0; q < 8; ++q) { \
            ENT[q] = (unsigned)__builtin_amdgcn_readfirstlane((int)sorted[(I0) + q]); \
            const unsigned char* ur = ut8 + (size_t)((ENT[q] >> 9) & 16383u) * 2048 + lane * 16; \
            UQ[q][0] = *(const uint4*)ur; UQ[q][1] = *(const uint4*)(ur + 1024); }
#define P1_COMP(ENT, UQ, I0) _Pragma("unroll") for (int h4 = 0; h4 < 8; h4 += 4) { int d[4]; \
            _Pragma("unroll") for (int q = 0; q < 4; ++q) { \
                const int tok = (ENT[h4 + q] >> 7) & 3; \
                const LAS unsigned char* xr = x8 + tok * 2048 + lane * 16; \
                const u32x4_t a0 = *(const LAS u32x4_t*)xr, b0 = *(const LAS u32x4_t*)(xr + 1024); \
                int dd = 0; \
                dd = __builtin_amdgcn_sdot4((int)UQ[h4 + q][0].x, (int)a0[0], dd, false); dd = __builtin_amdgcn_sdot4((int)UQ[h4 + q][0].y, (int)a0[1], dd, false); \
                dd = __builtin_amdgcn_sdot4((int)UQ[h4 + q][0].z, (int)a0[2], dd, false); dd = __builtin_amdgcn_sdot4((int)UQ[h4 + q][0].w, (int)a0[3], dd, false); \
                dd = __builtin_amdgcn_sdot4((int)UQ[h4 + q][1].x, (int)b0[0], dd, false); dd = __builtin_amdgcn_sdot4((int)UQ[h4 + q][1].y, (int)b0[1], dd, false); \
                dd = __builtin_amdgcn_sdot4((int)UQ[h4 + q][1].z, (int)b0[2], dd, false); dd = __builtin_amdgcn_sdot4((int)UQ[h4 + q][1].w, (int)b0[3], dd, false); \
                d[q] = dd; } \
            _Pragma("unroll") for (int q = 0; q < 4; ++q) { \
                const int s = wave_sum_all_i32(d[q]); \
                const unsigned e = (ENT[h4 + q] >> 9) & 16383u; const int n = ENT[h4 + q] & 511, tok = n >> 7; \
                const float rsv = tok == 0 ? rs4[0] : tok == 1 ? rs4[1] : tok == 2 ? rs4[2] : rs4[3]; \
                const float a = (float)s * (__uint_as_float(ENT[h4 + q] & 0x7F800000u) * rsv); \
                const float cf = __uint_as_float((unsigned)gsv[(I0) + h4 + q] << 16) * gelu_as(a); \
                if (lane == 0) sorted[(I0) + h4 + q] = (e << 18) | ((unsigned)tok << 16) | f2bf(cf); } }
    {
        unsigned entA[8], entB[8]; uint4 uqA[8][2], uqB[8][2];
        P1_LOAD(entA, uqA, 0)
#pragma unroll 1
        for (int i = 0; i < 512; i += 16) {
            P1_LOAD(entB, uqB, i + 8)
            P1_COMP(entA, uqA, i)
            { const int nx = i + 16 < 512 ? i + 16 : 504; P1_LOAD(entA, uqA, nx) }
            P1_COMP(entB, uqB, i + 8)
        }
    }
#undef P1_LOAD
#undef P1_COMP
    asm volatile("s_waitcnt lgkmcnt(0)" ::: "memory");
    f32x2_t acc0[16], acc1[16], acc2[16], acc3[16];
#pragma unroll
    for (int k = 0; k < 16; ++k) { acc0[k] = (f32x2_t){0.f, 0.f}; acc1[k] = (f32x2_t){0.f, 0.f}; acc2[k] = (f32x2_t){0.f, 0.f}; acc3[k] = (f32x2_t){0.f, 0.f}; }
#ifndef P2N
#define P2N 2
#endif
#define P2_LOAD(ENT, VQ, I0) _Pragma("unroll") for (int q = 0; q < P2N; ++q) { \
            ENT[q] = (unsigned)__builtin_amdgcn_readfirstlane((int)sorted[(I0) + q]); \
            const unsigned char* vr = vt8 + (size_t)(ENT[q] >> 18) * 2048 + lane * 16; \
            VQ[q][0] = *(const uint4*)vr; VQ[q][1] = *(const uint4*)(vr + 1024); }
#define P2_COMP(ENT, VQ) _Pragma("unroll") for (int q = 0; q < P2N; ++q) { \
            const int tok = (ENT[q] >> 16) & 3; \
            const float cfs = __uint_as_float(ENT[q] << 16); \
            const f32x2_t c2 = (f32x2_t){cfs, cfs}; \
            if (tok == 0) { axpy16_fp8_pk(VQ[q][0], c2, acc0); axpy16_fp8_pk(VQ[q][1], c2, acc0 + 8); } \
            else if (tok == 1) { axpy16_fp8_pk(VQ[q][0], c2, acc1); axpy16_fp8_pk(VQ[q][1], c2, acc1 + 8); } \
            else if (tok == 2) { axpy16_fp8_pk(VQ[q][0], c2, acc2); axpy16_fp8_pk(VQ[q][1], c2, acc2 + 8); } \
            else { axpy16_fp8_pk(VQ[q][0], c2, acc3); axpy16_fp8_pk(VQ[q][1], c2, acc3 + 8); } }
    {
        unsigned entA[P2N], entB[P2N]; uint4 vqA[P2N][2], vqB[P2N][2];
        P2_LOAD(entA, vqA, 0)
#pragma unroll 1
        for (int i = 0; i < 512; i += 2 * P2N) {
            P2_LOAD(entB, vqB, i + P2N)
            P2_COMP(entA, vqA)
            { const int nx = i + 2 * P2N < 512 ? i + 2 * P2N : 512 - P2N; P2_LOAD(entA, vqA, nx) }
            P2_COMP(entB, vqB)
        }
    }
#undef P2_LOAD
#undef P2_COMP
    int l2 = lane; asm volatile("" : "+v"(l2));
#define PEER_EPI(tok, ACC) { \
        const bf16_t* xr = h3 + (t0 + tok) * D + l2 * 16; \
        float ss = 0.f; \
        _Pragma("unroll") for (int hh = 0; hh < 2; ++hh) _Pragma("unroll") for (int k = 0; k < 4; ++k) { \
            const uint2 xp = *(const uint2*)(xr + hh * 1024 + 4 * k); \
            const float4 xv = make_float4(__uint_as_float(xp.x << 16), __uint_as_float(xp.x & 0xFFFF0000u), __uint_as_float(xp.y << 16), __uint_as_float(xp.y & 0xFFFF0000u)); \
            f32x2_t a0 = ACC[hh * 8 + 2 * k], a1 = ACC[hh * 8 + 2 * k + 1]; \
            a0.x += xv.x; a0.y += xv.y; a1.x += xv.z; a1.y += xv.w; ACC[hh * 8 + 2 * k] = a0; ACC[hh * 8 + 2 * k + 1] = a1; \
            ss += (a0.x * a0.x + a0.y * a0.y) + (a1.x * a1.x + a1.y * a1.y); } \
        ss = wave_sum_dpp(ss); \
        const float r = rsqrtf(ss * (1.0f / D) + EPS); \
        float* orow = out + (t0 + tok) * D + l2 * 16; \
        _Pragma("unroll") for (int hh = 0; hh < 2; ++hh) _Pragma("unroll") for (int k = 0; k < 4; ++k) { \
            const float4 gv = *(const float4*)(g_final + hh * 1024 + l2 * 16 + 4 * k); \
            const f32x2_t a0 = ACC[hh * 8 + 2 * k], a1 = ACC[hh * 8 + 2 * k + 1]; \
            *(float4*)(orow + hh * 1024 + 4 * k) = make_float4(a0.x * r * gv.x, a0.y * r * gv.y, a1.x * r * gv.z, a1.y * r * gv.w); } }
    PEER_EPI(0, acc0) PEER_EPI(1, acc1) PEER_EPI(2, acc2) PEER_EPI(3, acc3)
#undef PEER_EPI
}

struct Params {
    const float *x, *mem, *g_mix, *w_in, *conv_w, *conv_b, *w_mq, *w_mk, *b_mi, *b_mf, *g_mhead, *g_ahead, *w_out, *g_cross, *g_mem,
                *w_xq, *w_xk, *w_xv, *w_xo, *g_ffn, *w_pq, *sub_keys, *u_tab, *v_tab, *g_final;
    float* out;
    unsigned* bar;
    float* ws;
};

#define PHASE_LOOP(nvb) for (int base_ = blockIdx.x * 2; base_ < (nvb); base_ += gridDim.x * 2)
#define VB (base_ + half)

__global__ void __launch_bounds__(NTHR) mega(Params P) {
    volatile LAS unsigned* st = (volatile LAS unsigned*)(LAS unsigned char*)(smem_raw + CTRL_OFF);
    if (threadIdx.x == 0) { st[0] = 0u; st[1] = 0u; st[2] = 0u; st[3] = 0u; }
    if (threadIdx.x < I_NPTR) ((LAS unsigned long long*)(LAS unsigned char*)(smem_raw + CTRL_OFF + 64))[threadIdx.x] = ((const unsigned long long*)&P)[threadIdx.x];
    __syncthreads();
    XcdBarrier xb = xcd_barrier_post((unsigned*)ldp_raw(I_BAR), st);

    constexpr size_t TD = (size_t)T * D;
    constexpr size_t O_HB = 6 * P6S * 2, O_CBUF = O_HB + (size_t)T * D * 2, O_MQ = O_CBUF + (size_t)T * 1024 * 2, O_MK = O_MQ + (size_t)T * 1024 * 2,
                     O_MIXB = O_MK + (size_t)T * 1024 * 2, O_WIN = O_MIXB + (size_t)T * D * 2, O_WOUT = O_WIN + (size_t)6144 * D * 2, O_WXQ = O_WOUT + (size_t)D * D * 2,
                     O_WXK = O_WXQ + (size_t)D * D * 2, O_WXV = O_WXK + (size_t)D * D * 2, O_WXO = O_WXV + (size_t)D * D * 2, O_WPQ = O_WXO + (size_t)D * D * 2,
                     O_WQK = O_WPQ + (size_t)D * D * 2, O_GPRE = O_WQK + (size_t)8 * 256 * 256 * 2, O_UT = O_GPRE + (size_t)T * 8 * 4, O_VT = O_UT + (size_t)16384 * D, O_RSC = O_VT + (size_t)16384 * D,
                     O_BH = O_RSC + (size_t)32768 * 4, O_GS = O_BH + (size_t)128 * 256 * 512 * 2, O_DENP = O_GS + (size_t)T * 4 * 8 * 4, O_QN = O_DENP + (size_t)T * 4 * 4 * 4,
                     O_DN = O_QN + (size_t)T * 4 * 4, O_DECAY = O_DN + (size_t)128 * 256 * 4, O_KB = O_DECAY + 4096, O_VB = O_KB + (size_t)12288 * 2048 * 2, O_CS = O_VB + (size_t)12288 * 2048 * 2, O_SKB = O_CS + (size_t)4096 * 64 * 8, O_RSSP = O_SKB + (size_t)262144 * 2, O_RSTD = O_RSSP + (size_t)T * 32 * 4, O_MN = O_RSTD + (size_t)T * 4, O_KVP = O_MN + (size_t)512 * D * 2, O_END = O_KVP + (size_t)2 * 512 * 4096 * 4;
    static_assert(O_END + 16384 <= (size_t)536870912, "workspace overflow");
#define W_P6    ((bf16_t*)wsb)
#define W_HB    ((bf16_t*)(wsb + O_HB))
#define W_CBUF  ((bf16_t*)(wsb + O_CBUF))
#define W_MQ    ((bf16_t*)(wsb + O_MQ))
#define W_MK    ((bf16_t*)(wsb + O_MK))
#define W_MIXB  ((bf16_t*)(wsb + O_MIXB))
#define W_GPRE  ((float*)(wsb + O_GPRE))
#define W_HRAW  ((float*)(wsb + O_HB))
#define W_XR    ((float*)wsb)
#define W_MN    ((bf16_t*)((float*)wsb + TD))
#define W_KM    ((bf16_t*)((float*)wsb + TD + (size_t)256 * D))
#define W_VMT   ((bf16_t*)((float*)wsb + TD + (size_t)768 * D))
#define W_PX    ((bf16_t*)(wsb + O_MK))
#define W_GATES ((float*)wsb + TD + (size_t)1280 * D)
#define W_IDS   ((int*)((float*)wsb + TD + (size_t)1280 * D + (size_t)T * 128))
#define W_QX    ((bf16_t*)(wsb + O_CBUF))
#define W_BH    ((bf16_t*)(wsb + O_BH))
#define W_KB    ((bf16_t*)(wsb + O_KB))
#define W_VB    ((bf16_t*)(wsb + O_VB))
#define W_CS    ((float2*)(wsb + O_CS))
#define W_SKB   ((bf16_t*)(wsb + O_SKB))
#define W_RSSP  ((float*)(wsb + O_RSSP))
#define W_RSTD  ((float*)(wsb + O_RSTD))
#define W_MN2   ((bf16_t*)(wsb + O_MN))
#define W_KVP   ((float*)(wsb + O_KVP))
#define W_GS    ((float*)(wsb + O_GS))
#define W_DENP  ((float*)(wsb + O_DENP))
#define W_QN    ((float*)(wsb + O_QN))
#define W_DN    ((float*)(wsb + O_DN))
#define W_DECAY ((float*)(wsb + O_DECAY))
#define W_PQ    ((bf16_t*)(wsb + O_HB))
#define W_KWT   ((bf16_t*)(wsb + O_CBUF))
#define W_DC    ((float*)(wsb + 3 * P6S * 2))
#define W_UT    ((unsigned char*)(wsb + O_UT))
#define W_VT    ((unsigned char*)(wsb + O_VT))
#define W_RSC   ((float*)(wsb + O_RSC))
#define PH_BEGIN() int tidx = threadIdx.x; asm volatile("" : "+v"(tidx)); const int half = tidx >> 8, tid = tidx & 255; float* sm = (float*)smem_raw + half * HALF_SM_FLOATS; \
                   char* wsb = (char*)ldp_raw(I_WS); (void)half; (void)tid; (void)sm; (void)wsb
#define GJOB_DEFAULT(g) pg8::GJob g; g.lda = D; g.ldb = D; g.K = D; g.nM = 32; g.nN = 8; g.a_pm_step = 256 * D; g.b_pn_mask = 0x7fffffff; g.b_pn_shift = 30; g.b_pn_step2 = 0; g.bid0 = 0; g.nblk = gridDim.x; g.a_pn_shift = 0; g.a_pn_mask = 0; g.a_pn_step = 0; g.b_pm_shift = 0; g.b_pm_step = 0; g.b_pn_step = 256 * D; \
                        g.ldc = D; g.R = nullptr; g.ldr = D; g.mode = 0; g.escale = 1.0f; g.gs = nullptr; g.denp = nullptr; g.qn = nullptr; g.gvec = nullptr; g.mo = nullptr; g.C2 = nullptr; g.rssp = nullptr; g.rstd = nullptr
#define GEMM_LDSP ((LAS unsigned char*)smem_raw)

    {
        PH_BEGIN();
        {
            LAS float* scr = (LAS float*)(LAS unsigned char*)(smem_raw) + (tidx >> 6) * (64 * 33);
            const int lane = tidx & 63;
            const int gw = blockIdx.x * 8 + (tidx >> 6), NGW = gridDim.x * 8;
            constexpr int I_IN = 32 * 192, I_SQ = 32 * 64, I_QK = 8 * 4 * 8;
            constexpr int NITEMS = I_IN + 6 * I_SQ + I_QK;
#pragma nounroll
            for (int it = gw; it < NITEMS; it += NGW) {
                const float* W; int ldw, K, csrc0, row0, kb; bf16_t* WT; float wscale = 1.0f; const float* kgain = nullptr;
                int r = it;
                if (r < I_IN) { const int nb = r % 192; kb = r / 192; W = PF(I_WIN); ldw = INC; K = D; csrc0 = nb * 32 + (nb >= 96 ? 8 : 0); WT = (bf16_t*)(wsb + O_WIN); row0 = nb * 32; }
                else if ((r -= I_IN) < 6 * I_SQ) {
                    const int wsel = r / I_SQ; r -= wsel * I_SQ; const int nb = r % 64; kb = r / 64; ldw = D; K = D; csrc0 = nb * 32; row0 = nb * 32;
                    W = PF(wsel == 0 ? I_WOUT : wsel == 1 ? I_WXQ : wsel == 2 ? I_WXK : wsel == 3 ? I_WXV : wsel == 4 ? I_WXO : I_WPQ);
                    WT = (bf16_t*)(wsb + O_WOUT + (size_t)wsel * ((size_t)D * D * 2));
                    if (wsel == 1) kgain = PF(I_GCROSS); else if (wsel == 5) kgain = PF(I_GFFN);
                } else {
                    r -= 6 * I_SQ; const int hq = r / 32; r -= hq * 32; const int nb = r % 8; kb = r / 8;
                    W = PF(hq < 4 ? I_WMQ : I_WMK) + (size_t)(hq & 3) * 65536; ldw = 256; K = 256; csrc0 = nb * 32; WT = (bf16_t*)(wsb + O_WQK); row0 = hq * 256 + nb * 32;
                    if (hq >= 4) wscale = 0.0625f;
                }
                p0_transpose_item(W, ldw, K, csrc0, WT, row0, scr, kb, lane, wscale, kgain);
            }
            {
                const float* ut = PF(I_UTAB); const float* vt = PF(I_VTAB); const float* gffn = PF(I_GFFN);
#define TBL_LOAD(F, SRC, RR) _Pragma("unroll") for (int i = 0; i < 8; ++i) F[i] = *(const float4*)((SRC) + (size_t)(RR) * D + i * 256 + lane * 4);
                {
                    float4 fa[8], fb[8];
                    TBL_LOAD(fa, ut, gw)
#pragma nounroll
                    for (int rr = gw; rr < 16384; rr += 2 * NGW) {
                        TBL_LOAD(fb, ut, rr + NGW)
                        table_row_store<true>(fa, W_UT + (size_t)rr * D, W_RSC + rr, lane, gffn);
                        { const int nx = rr + 2 * NGW < 16384 ? rr + 2 * NGW : rr; TBL_LOAD(fa, ut, nx) }
                        table_row_store<true>(fb, W_UT + (size_t)(rr + NGW) * D, W_RSC + rr + NGW, lane, gffn);
                    }
                    TBL_LOAD(fa, vt, gw)
#pragma nounroll
                    for (int rr = gw; rr < 16384; rr += 2 * NGW) {
                        TBL_LOAD(fb, vt, rr + NGW)
                        table_row_store<false>(fa, W_VT + (size_t)rr * D, W_RSC + 16384 + rr, lane, nullptr);
                        { const int nx = rr + 2 * NGW < 16384 ? rr + 2 * NGW : rr; TBL_LOAD(fa, vt, nx) }
                        table_row_store<false>(fb, W_VT + (size_t)(rr + NGW) * D, W_RSC + 16384 + rr + NGW, lane, nullptr);
                    }
                }
#undef TBL_LOAD
            }
            rope_table_fill(W_CS, blockIdx.x * NTHR + tidx, gridDim.x * NTHR);
            {
                const float* sk = PF(I_SUBK);
#pragma nounroll
                for (int i = blockIdx.x * NTHR + tidx; i < 262144 / 8; i += gridDim.x * NTHR) {
                    const float4 a = *(const float4*)(sk + (size_t)i * 8), b = *(const float4*)(sk + (size_t)i * 8 + 4);
                    uint4 o; o.x = pk2(a.x, a.y); o.y = pk2(a.z, a.w); o.z = pk2(b.x, b.y); o.w = pk2(b.z, b.w);
                    *(uint4*)(W_SKB + (size_t)i * 8) = o;
                }
            }
            __syncthreads();
        }
        {
            const float* rin = PF(I_X); const float* rg = PF(I_GMIX); const float* win = PF(I_WIN);
            float* gwT = (float*)smem_raw;
            for (int k = tidx; k < 2048; k += NTHR) { const float4 a = *(const float4*)(win + (size_t)k * INC + C_MI), b = *(const float4*)(win + (size_t)k * INC + C_MI + 4);
                gwT[k] = a.x; gwT[2048 + k] = a.y; gwT[4096 + k] = a.z; gwT[6144 + k] = a.w; gwT[8192 + k] = b.x; gwT[10240 + k] = b.y; gwT[12288 + k] = b.z; gwT[14336 + k] = b.w; }
            __syncthreads();
            {
#pragma nounroll
                for (int row = blockIdx.x * 8 + (tidx >> 6); row < T; row += gridDim.x * 8) { int ln = tidx & 63; asm volatile("" : "+v"(ln)); rmsnorm_row_wave(row, ln, rin, rg, W_HB, gwT, W_GPRE); }
                const float* min_ = PF(I_MEM); const float* mg = PF(I_GMEM);
#pragma nounroll
                for (int row = blockIdx.x * 8 + (tidx >> 6); row < 512; row += gridDim.x * 8) { int ln = tidx & 63; asm volatile("" : "+v"(ln)); rmsnorm_row_wave(row, ln, min_, mg, W_MN2, nullptr, nullptr); }
            }
        }
    }
    xcd_barrier(xb);
    {
        PH_BEGIN();
        GJOB_DEFAULT(g); g.A = W_HB; g.Bt = (bf16_t*)(wsb + O_WIN); g.nN = 24; g.C = (float*)W_P6; g.ldc = 1024;
        pg8::gemm_phase<4>(GEMM_LDSP, g, tidx);
    }
    xcd_barrier(xb);
    {
        PH_BEGIN();
        const float* cw = PF(I_CONVW); const float* cb = PF(I_CONVB);
        const bool gates_wave = (blockIdx.x < 8) && ((tidx >> 6) == 7);
        {
            const int nconv = gridDim.x * NTHR;
#pragma nounroll
            for (int i = blockIdx.x * NTHR + tidx; i < 1024 * 128; i += nconv) conv_silu_run((i >> 7) * 8, i & 127, W_P6, cw, cb, W_CBUF);
        }
        if (gates_wave) mlstm_gates_wave(blockIdx.x >> 2, blockIdx.x & 3, tidx & 63, W_GPRE, PF(I_BMI), PF(I_BMF), W_GS, W_DECAY);
        else {
            LAS unsigned short* wl = (LAS unsigned short*)(LAS unsigned char*)smem_raw + (tidx >> 6) * (16 * 136);
            const int gwv = blockIdx.x * 8 + (tidx >> 6), rank = gwv - ((int)blockIdx.x < 8 ? (int)blockIdx.x : 8), nw = gridDim.x * 8 - 8;
#pragma nounroll
            for (int item = rank; item < 12288; item += nw) dil_tile_prep(item, tidx & 63, wl, W_P6 + 4 * P6S, W_P6 + 5 * P6S, W_CS, W_KB, W_VB);
        }
        __syncthreads();
#pragma nounroll
        PHASE_LOOP(2048) { const int it = VB, lt = it & 3, et = (it >> 2) & 3, h = (it >> 4) & 3, cg = it >> 6;
            transpose_tile64(tid, sm, W_P6 + P6S + (size_t)(cg * 256 + lt * 64) * 1024 + h * 256 + et * 64, 1024, W_BH + ((size_t)(cg * 4 + h) * 256 + et * 64) * 512 + lt * 64, 512, nullptr, 0); }
    }
    xcd_barrier(xb);
    {
        PH_BEGIN();
        {
            GJOB_DEFAULT(g); g.A = W_CBUF; g.lda = 1024; g.a_pm_step = 256 * 1024; g.Bt = (bf16_t*)(wsb + O_WQK); g.ldb = 256; g.b_pn_step = 256 * 256; g.K = 256; g.a_pn_mask = 3; g.a_pn_step = 256; g.C = (float*)W_MQ; g.ldc = 1024;
            pg8::gemm_phase<4>(GEMM_LDSP, g, tidx);
            __syncthreads();
        }
        const float* ga = PF(I_GAHEAD);
#pragma nounroll
        for (int qt = blockIdx.x * 8 + (tidx >> 6); qt < 2048; qt += gridDim.x * 8) dilated_wave_tile(qt, tidx & 63, W_P6 + 3 * P6S, W_CS, W_KB, W_VB, ga, W_MIXB);
    }
    xcd_barrier(xb);
    {
        PH_BEGIN();
#pragma nounroll
        PHASE_LOOP(2048) { const int it = VB, lt = it & 3, dt = (it >> 2) & 3, h = (it >> 4) & 3, cg = it >> 6;
            transpose_tile64(tid, sm, W_MK + (size_t)(cg * 256 + lt * 64) * 1024 + h * 256 + dt * 64, 1024, W_KWT + ((size_t)(cg * 4 + h) * 256 + dt * 64) * 256 + lt * 64, 256,
                             W_GS + ((size_t)(cg * 256 + lt * 64) * 4 + h) * 8 + 2, 32); }
        {
            const size_t nth = (size_t)gridDim.x * NTHR;
#pragma nounroll
            for (size_t i = (size_t)blockIdx.x * NTHR + tidx; i < (size_t)T * 128; i += nth) {
                const size_t t = i >> 7; const int c8 = (int)(i & 127) * 8, h = c8 >> 8, d = c8 & 255;
                const float sc = W_GS[(t * 4 + h) * 8 + 3];
                const uint4 v = *(const uint4*)(W_MQ + t * 1024 + c8);
                uint4 o;
                o.x = pk2(bf2f((unsigned short)(v.x & 0xFFFFu)) * sc, bf2f((unsigned short)(v.x >> 16)) * sc); o.y = pk2(bf2f((unsigned short)(v.y & 0xFFFFu)) * sc, bf2f((unsigned short)(v.y >> 16)) * sc);
                o.z = pk2(bf2f((unsigned short)(v.z & 0xFFFFu)) * sc, bf2f((unsigned short)(v.z >> 16)) * sc); o.w = pk2(bf2f((unsigned short)(v.w & 0xFFFFu)) * sc, bf2f((unsigned short)(v.w >> 16)) * sc);
                *(uint4*)(W_PQ + t * 2048 + h * 512 + 256 + d) = o;
            }
        }
#pragma nounroll
        PHASE_LOOP(128) { const int cgh = VB, cg = cgh >> 2, h = cgh & 3;
            float a = 0.f;
            for (int l = 0; l < 256; ++l) { const size_t t = (size_t)cg * 256 + l; a = fmaf(W_GS[(t * 4 + h) * 8 + 2], bf2f(W_MK[t * 1024 + h * 256 + tid]), a); }
            W_DN[(size_t)cgh * 256 + tid] = a; }
        __syncthreads();
        {
            GJOB_DEFAULT(g); g.A = W_MQ; g.lda = 1024; g.a_pm_step = 256 * 1024; g.a_pn_mask = 3; g.a_pn_step = 256; g.K = 256; g.nN = 4;
            g.Bt = W_MK; g.ldb = 1024; g.b_pn_step = 256; g.b_pm_step = 256 * 1024; g.C = (float*)W_PQ; g.gs = W_GS; g.denp = W_DENP;
            pg8::gemm_phase<6>(GEMM_LDSP, g, tidx);
        }
    }
    xcd_barrier(xb);
    {
        PH_BEGIN();
        GJOB_DEFAULT(g); g.A = W_BH; g.lda = 512; g.a_pm_step = 4 * 256 * 512; g.a_pn_mask = 3; g.a_pn_step = 256 * 512; g.K = 256; g.nN = 4;
        g.Bt = W_KWT; g.ldb = 256; g.b_pn_step = 65536; g.b_pm_step = 4 * 65536; g.C = W_DC;
        pg8::gemm_phase<7>(GEMM_LDSP, g, tidx);
    }
    xcd_barrier(xb);
    {
        PH_BEGIN();
        {
#pragma nounroll
            for (int gid = blockIdx.x * NTHR + tidx; gid < 131072; gid += gridDim.x * NTHR) {
                const int bh = gid >> 14, b = bh >> 2, h = bh & 3, e = (gid >> 6) & 255, d = (gid & 63) * 4;
                float4 C = make_float4(0.f, 0.f, 0.f, 0.f);
                float4 dcv[16]; float decv[16];
#pragma unroll
                for (int c = 0; c < 16; ++c) { const int cgh = (b * 16 + c) * 4 + h; decv[c] = W_DECAY[cgh]; dcv[c] = *(const float4*)(W_DC + ((size_t)cgh * 256 + e) * 256 + d); }
#pragma unroll
                for (int c = 0; c < 16; ++c) {
                    const int cgh = (b * 16 + c) * 4 + h;
                    uint2 o; o.x = pk2(C.x, C.y); o.y = pk2(C.z, C.w);
                    *(uint2*)(W_BH + ((size_t)cgh * 256 + e) * 512 + 256 + d) = o;
                    C.x = fmaf(decv[c], C.x, dcv[c].x); C.y = fmaf(decv[c], C.y, dcv[c].y); C.z = fmaf(decv[c], C.z, dcv[c].z); C.w = fmaf(decv[c], C.w, dcv[c].w);
                }
            }
        }
#pragma nounroll
        PHASE_LOOP(128) { const int cgh = VB, cg = cgh >> 2, h = cgh & 3, b = cg >> 4, c = cg & 15;
            float n = 0.f;
            for (int cc = 0; cc < c; ++cc) { const int j = (b * 16 + cc) * 4 + h; n = fmaf(W_DECAY[j], n, W_DN[(size_t)j * 256 + tid]); }
            __syncthreads();
            sm[tid] = n;
            __syncthreads();
            const int lane = tid & 63, w = tid >> 6;
            const float4 nv = *(const float4*)(sm + lane * 4);
#pragma unroll 1
            for (int i = 0; i < 64; i += 8) {
                float s[8];
#pragma unroll
                for (int k = 0; k < 8; ++k) {
                    const size_t t = (size_t)cg * 256 + w * 64 + i + k;
                    const ushort4 q4 = *(const ushort4*)(W_MQ + t * 1024 + h * 256 + lane * 4);
                    s[k] = bf2f(q4.x) * nv.x + bf2f(q4.y) * nv.y + bf2f(q4.z) * nv.z + bf2f(q4.w) * nv.w;
                }
#pragma unroll
                for (int k = 0; k < 8; ++k) { const float tot = wave_sum_dpp(s[k]); if (lane == 0) W_QN[((size_t)cg * 256 + w * 64 + i + k) * 4 + h] = tot; }
            }
        }
    }
    xcd_barrier(xb);
    {
        PH_BEGIN();
        GJOB_DEFAULT(g); g.A = W_PQ; g.a_pn_mask = 3; g.a_pn_step = 512; g.K = 512; g.nN = 4;
        g.Bt = W_BH; g.ldb = 512; g.b_pn_step = 256 * 512; g.b_pm_step = 4 * 256 * 512; g.C = (float*)W_MIXB;
        g.gs = W_GS; g.denp = W_DENP; g.qn = W_QN; g.gvec = PF(I_GMHEAD); g.mo = W_P6 + 2 * P6S; g.nblk = 128;
        if (blockIdx.x < 128) pg8::gemm_phase<8>(GEMM_LDSP, g, tidx);
        else {
            GJOB_DEFAULT(k); k.A = W_MN2; k.K = 1024; k.nM = 2; k.nN = 32; k.a_pn_shift = 4; k.a_pn_mask = 1; k.a_pn_step = 1024;
            k.Bt = (bf16_t*)(wsb + O_WXK); k.b_pn_mask = 15; k.b_pn_shift = 4; k.b_pn_step2 = 1024; k.C = W_KVP; k.bid0 = 128; k.nblk = 128;
            pg8::gemm_phase<12>(GEMM_LDSP, k, tidx);
        }
    }
    xcd_barrier(xb);
    {
        PH_BEGIN();
        for (int i = blockIdx.x * NTHR + tidx; i < 512 * 4096 / 4; i += gridDim.x * NTHR) {
            const int r = i >> 10, c = (i & 1023) * 4;
            const float4 a = *(const float4*)(W_KVP + (size_t)r * 4096 + c), b = *(const float4*)(W_KVP + (size_t)512 * 4096 + (size_t)r * 4096 + c);
            const float v0 = a.x + b.x, v1 = a.y + b.y, v2 = a.z + b.z, v3 = a.w + b.w;
            if (c < 2048) { uint2 o; o.x = pk2(v0, v1); o.y = pk2(v2, v3); *(uint2*)(W_KM + (size_t)r * 2048 + c) = o; }
            else { bf16_t* d = W_VMT + (size_t)(c - 2048) * 512 + r; d[0] = (bf16_t)f2bf(v0); d[512] = (bf16_t)f2bf(v1); d[1024] = (bf16_t)f2bf(v2); d[1536] = (bf16_t)f2bf(v3); }
        }
        GJOB_DEFAULT(g); g.A = W_MIXB; g.Bt = (bf16_t*)(wsb + O_WOUT); g.R = PF(I_X); g.C2 = W_HB; g.rssp = W_RSSP;
        pg8::gemm_phase<10>(GEMM_LDSP, g, tidx);
    }
    xcd_barrier(xb);
    {
        PH_BEGIN();
        {
            GJOB_DEFAULT(g); g.A = W_HB; g.Bt = (bf16_t*)(wsb + O_WXQ); g.C = (float*)W_QX;
            pg8::Unit u0;
            if (pg8::unit_next(g, 0, u0) && tidx < 256) { const size_t r = (size_t)u0.pm * 256 + tidx; float s = 0.f; for (int k = 0; k < 32; ++k) s += W_RSSP[r * 32 + k];
                ((LAS float*)(LAS unsigned char*)(smem_raw + GEMM_LDS + 1024 + 8192))[tidx] = rsqrtf(s * (1.0f / D) + EPS); }
            __syncthreads();
            pg8::gemm_phase<11>(GEMM_LDSP, g, tidx); __syncthreads();
        }

    }
    xcd_barrier(xb);
    {
        PH_BEGIN();
        GJOB_DEFAULT(g); g.A = W_QX; g.K = 512; g.a_pn_mask = 3; g.a_pn_step = 512; g.Bt = W_KM; g.b_pn_step = 512; g.b_pm_shift = 4; g.b_pm_step = 256 * D; g.nN = 4;
        g.C = (float*)W_PX; g.ldc = 1024; g.escale = 0.04419417382415922f * 1.4426950408889634f;
        pg8::gemm_phase<5>(GEMM_LDSP, g, tidx);
    }
    xcd_barrier(xb);
    {
        PH_BEGIN();
        GJOB_DEFAULT(g); g.A = W_PX; g.lda = 1024; g.a_pm_step = 256 * 1024; g.K = 256; g.a_pn_shift = 1; g.a_pn_mask = 3; g.a_pn_step = 256; g.Bt = W_VMT; g.ldb = 512; g.b_pn_step = 256 * 512; g.b_pm_shift = 4; g.b_pm_step = 256;
        g.C = (float*)W_MIXB;
        pg8::gemm_phase<3>(GEMM_LDSP, g, tidx);
    }
    xcd_barrier(xb);
    {
        PH_BEGIN();
        GJOB_DEFAULT(g); g.A = W_MIXB; g.Bt = (bf16_t*)(wsb + O_WXO); g.R = nullptr; g.C2 = W_HB; g.rssp = W_RSSP;
        pg8::gemm_phase<10>(GEMM_LDSP, g, tidx);
    }
    xcd_barrier(xb);
    {
        PH_BEGIN();
        GJOB_DEFAULT(g); g.A = W_HB; g.Bt = (bf16_t*)(wsb + O_WPQ); g.C = (float*)W_QX;
        pg8::Unit u0;
        if (pg8::unit_next(g, 0, u0) && tidx < 256) { const size_t r = (size_t)u0.pm * 256 + tidx; float s = 0.f; for (int k = 0; k < 32; ++k) s += W_RSSP[r * 32 + k];
            const float rs = rsqrtf(s * (1.0f / D) + EPS);
            ((LAS float*)(LAS unsigned char*)(smem_raw + GEMM_LDS + 1024 + 8192))[tidx] = rs; W_RSTD[r] = rs; }
        __syncthreads();
        pg8::gemm_phase<11>(GEMM_LDSP, g, tidx);
    }
    xcd_barrier(xb);
    {
        PH_BEGIN();
        LAS float* wl = (LAS float*)(LAS unsigned char*)smem_raw + (tidx >> 6) * 1024;
#pragma nounroll
        for (int item = blockIdx.x * 8 + (tidx >> 6); item < 4096; item += gridDim.x * 8) peer_topk_wave2(item, tidx & 63, wl, W_QX, W_SKB, W_IDS, W_GATES);
    }
    xcd_barrier(xb);
    {
        PH_BEGIN();
        const float* gf = PF(I_GFINAL); float* outp = (float*)ldp_raw(I_OUT);
        LAS unsigned char* wl = (LAS unsigned char*)smem_raw + (tidx >> 6) * 11776;
#pragma nounroll
        for (int gw = blockIdx.x * 8 + (tidx >> 6); gw < T / 4; gw += gridDim.x * 8) { int ln = tidx & 63; asm volatile("" : "+v"(ln));
            peer_sweep_wave(gw, ln, wl, W_HB, W_XR, W_IDS, W_GATES, W_UT, W_VT, W_RSC, W_RSTD, gf, outp); }
    }
}
}

extern "C" void kernel_launch(void* const* d_in, const int* in_sizes, int n_in, void* d_out, int out_size, void* d_ws, size_t ws_size, hipStream_t stream) {
    static int grid_blocks = 0;
    if (!grid_blocks) {
        int dev = 0, cus = 0, per_cu = 0;
        hipGetDevice(&dev);
        hipDeviceGetAttribute(&cus, hipDeviceAttributeMultiprocessorCount, dev);
        hipFuncSetAttribute((const void*)mega, hipFuncAttributeMaxDynamicSharedMemorySize, SMEM_BYTES);
        hipOccupancyMaxActiveBlocksPerMultiprocessor(&per_cu, mega, NTHR, SMEM_BYTES);
        if (per_cu > 1) per_cu = 1;
        if (per_cu < 1) per_cu = 1;
        grid_blocks = cus * per_cu;
    }
    Params P{};
    const float** pp = (const float**)&P;
    for (int i = 0; i < 25; ++i) pp[i] = (const float*)d_in[i];
    P.out = (float*)d_out;
    P.bar = (unsigned*)d_ws;
    P.ws = (float*)((char*)d_ws + 16384);
    hipMemsetAsync(d_ws, 0, 16384, stream);
    void* args[] = {&P};
    hipError_t e = hipLaunchCooperativeKernel((const void*)mega, dim3(grid_blocks), dim3(NTHR), args, SMEM_BYTES, stream);
    if (e != hipSuccess) fprintf(stderr, "cooperative launch failed: %s (grid %d)\n", hipGetErrorString(e), grid_blocks);
}
```

```cpp
#include <hip/hip_runtime.h>
#include <stdint.h>
#include <math.h>
#include <cstdio>

#define LAS_ __attribute__((address_space(3)))
namespace {
constexpr int D = 2048, NB = 2, S = 4096, T = NB * S;
constexpr int INC = 6152;
constexpr int C_MIN = 0, C_MV = 1024, C_MO = 2048, C_MI = 3072, C_MF = 3076, C_AQ = 3080, C_AK = 4104, C_AV = 5128;
constexpr float EPS = 1e-6f;
constexpr size_t P6S = (size_t)8192 * 1024;
constexpr int NTHR = 512;
constexpr int HALF_SM_FLOATS = 8704;
constexpr int GEMM_LDS = 131072;
constexpr int SMEM_BYTES = 163840;
constexpr int CTRL_OFF = SMEM_BYTES - 1024;
typedef unsigned short bf16_t;
__device__ __forceinline__ unsigned f2bf(float f) { unsigned u = __float_as_uint(f); u += 0x7FFFu + ((u >> 16) & 1u); return u >> 16; }
__device__ __forceinline__ unsigned pk2(float lo, float hi) { return f2bf(lo) | (f2bf(hi) << 16); }
__device__ __forceinline__ float bf2f(unsigned short b) { return __uint_as_float(((unsigned)b) << 16); }
extern __shared__ __attribute__((aligned(16))) unsigned char smem_raw[];
enum { I_X = 0, I_MEM, I_GMIX, I_WIN, I_CONVW, I_CONVB, I_WMQ, I_WMK, I_BMI, I_BMF, I_GMHEAD, I_GAHEAD, I_WOUT, I_GCROSS, I_GMEM,
       I_WXQ, I_WXK, I_WXV, I_WXO, I_GFFN, I_WPQ, I_SUBK, I_UTAB, I_VTAB, I_GFINAL, I_OUT, I_BAR, I_WS, I_NPTR };
__device__ __forceinline__ unsigned long long ldp_raw(int i) {
    const LAS_ unsigned long long* tab = (const LAS_ unsigned long long*)(LAS_ unsigned char*)(smem_raw + CTRL_OFF + 64);
    const unsigned long long v = tab[i];
    const unsigned lo = __builtin_amdgcn_readfirstlane((unsigned)v), hi = __builtin_amdgcn_readfirstlane((unsigned)(v >> 32));
    return ((unsigned long long)hi << 32) | lo;
}
#define PF(i) ((const float*)ldp_raw(i))

#define XB_TMO      128
#define XB_XCNT(j)  (256  + 64 * (j))
#define XB_XSUB(j)  (1280 + 64 * (j))
#define XB_XGEN(j)  (2304 + 64 * (j))
#define XB_TOP      3328
#define XB_TOPGEN   3392
#define XCD_BAR_WORDS 3456
#define XB_SPIN_CAP (1u << 22)
#define LAS __attribute__((address_space(3)))

__device__ __forceinline__ unsigned xb_ld(unsigned* p)              { return __hip_atomic_load(p, __ATOMIC_RELAXED, __HIP_MEMORY_SCOPE_AGENT); }
__device__ __forceinline__ unsigned xb_add(unsigned* p, unsigned v) { return __hip_atomic_fetch_add(p, v, __ATOMIC_RELAXED, __HIP_MEMORY_SCOPE_AGENT); }
__device__ __forceinline__ unsigned xb_xcc_id() { return (unsigned)__builtin_amdgcn_s_getreg((3 << 11) | 20) & 0xFu; }
#define XB_SPIN(cond, bar) do { unsigned _sp = 0; while (cond) { __builtin_amdgcn_s_sleep(1); \
    if ((++_sp & 255u) == 0u) { if (xb_ld(&(bar)[XB_TMO])) break; if (_sp > XB_SPIN_CAP) { atomicAdd(&(bar)[XB_TMO], 1u); break; } } } } while (0)

struct XcdBarrier { unsigned* bar; unsigned x; volatile LAS unsigned* st; };

__device__ __forceinline__ XcdBarrier xcd_barrier_post(unsigned* bar, volatile LAS unsigned* st) {
    XcdBarrier b; b.bar = bar; b.x = xb_xcc_id(); b.st = st;
    if (threadIdx.x == 0) (void)xb_add(&bar[XB_XCNT(b.x)], 1u);
    return b;
}
__device__ __forceinline__ void xcd_barrier_complete(unsigned* bar, unsigned x, unsigned& nloc, unsigned& nx) {
    const unsigned G = gridDim.x * gridDim.y * gridDim.z;
    unsigned sum, cnt, mine, sp = 0u;
    for (;;) {
        sum = 0u; cnt = 0u; mine = 0u;
#pragma unroll
        for (unsigned j = 0; j < 16; ++j) { const unsigned c = xb_ld(&bar[XB_XCNT(j)]); sum += c; cnt += (c > 0u) ? 1u : 0u; mine = (j == x) ? c : mine; }
        if (sum == G) break;
        __builtin_amdgcn_s_sleep(1);
        if ((++sp & 255u) == 0u) { if (xb_ld(&bar[XB_TMO])) break; if (sp > XB_SPIN_CAP) { atomicAdd(&bar[XB_TMO], 1u); break; } }
    }
    nloc = mine > 0u ? mine : 1u; nx = cnt > 0u ? cnt : 1u;
}
__device__ __forceinline__ void xcd_barrier(const XcdBarrier& b) {
    asm volatile("s_waitcnt vmcnt(0)" ::: "memory");
    __syncthreads();
    if (threadIdx.x == 0) {
        unsigned* bar = b.bar;
        __builtin_amdgcn_s_waitcnt(0);
        unsigned nloc = b.st[0], nx = b.st[1];
        if (nloc == 0u) { xcd_barrier_complete(bar, b.x, nloc, nx); b.st[0] = nloc; b.st[1] = nx; }
        const unsigned old = xb_add(&bar[XB_XSUB(b.x)], 1u);
        const unsigned gen = old / nloc;
        if (old + 1u == (gen + 1u) * nloc) {
            __builtin_amdgcn_fence(__ATOMIC_RELEASE, "agent");
            asm volatile("s_waitcnt vmcnt(0)" ::: "memory");
            const unsigned og = xb_add(&bar[XB_TOP], 1u);
            const unsigned tg = og / nx;
            if (og + 1u == (tg + 1u) * nx) xb_add(&bar[XB_TOPGEN], 1u);
            else XB_SPIN(xb_ld(&bar[XB_TOPGEN]) == tg, bar);
            __builtin_amdgcn_fence(__ATOMIC_ACQUIRE, "agent");
            xb_add(&bar[XB_XGEN(b.x)], 1u);
            asm volatile("s_waitcnt vmcnt(0)" ::: "memory");
        } else {
            XB_SPIN(xb_ld(&bar[XB_XGEN(b.x)]) == gen, bar);
            __builtin_amdgcn_fence(__ATOMIC_ACQUIRE, "agent");
            asm volatile("s_waitcnt vmcnt(0)" ::: "memory");
        }
    }
    __syncthreads();
}

__device__ __forceinline__ float wave_sum(float v) {
#pragma unroll
    for (int o = 32; o >= 1; o >>= 1) v += __shfl_xor(v, o);
    return v;
}
__device__ __forceinline__ float wave_max(float v) {
#pragma unroll
    for (int o = 32; o >= 1; o >>= 1) v = fmaxf(v, __shfl_xor(v, o));
    return v;
}
__device__ __forceinline__ float log_sigmoid(float x) { return fminf(x, 0.f) - log1pf(expf(-fabsf(x))); }


__device__ __forceinline__ void d_rmsnorm(int vb, int t, float* sm, const float* __restrict__ in, const float* __restrict__ g, bf16_t* __restrict__ out,
                                          const float* gwl  , float* __restrict__ gpre) {
    float* red = sm;
    const int row = vb;
    const float4* p = (const float4*)(in + (size_t)row * D);
    float4 a = p[t], b = p[t + 256];
    float s = a.x * a.x + a.y * a.y + a.z * a.z + a.w * a.w + b.x * b.x + b.y * b.y + b.z * b.z + b.w * b.w;
    s = wave_sum(s);
    __syncthreads();
    if ((t & 63) == 0) red[t >> 6] = s;
    __syncthreads();
    const float tot = red[0] + red[1] + red[2] + red[3];
    const float r = rsqrtf(tot * (1.0f / D) + EPS);
    const float4* gp = (const float4*)g;
    float4 ga = gp[t], gb = gp[t + 256];
    float hv[8] = {a.x * r * ga.x, a.y * r * ga.y, a.z * r * ga.z, a.w * r * ga.w, b.x * r * gb.x, b.y * r * gb.y, b.z * r * gb.z, b.w * r * gb.w};
    uint2 o0, o1;
    o0.x = pk2(hv[0], hv[1]); o0.y = pk2(hv[2], hv[3]); o1.x = pk2(hv[4], hv[5]); o1.y = pk2(hv[6], hv[7]);
    *(uint2*)(out + (size_t)row * D + t * 4) = o0;
    *(uint2*)(out + (size_t)row * D + 1024 + t * 4) = o1;
    if (gpre) {
        float gs[8];
#pragma unroll
        for (int c = 0; c < 8; ++c) gs[c] = 0.f;
#pragma unroll
        for (int j = 0; j < 8; ++j) {
            const int k = (j < 4) ? (t * 4 + j) : (1024 + t * 4 + (j - 4));
            const float4 w0 = *(const float4*)(gwl + k * 8), w1 = *(const float4*)(gwl + k * 8 + 4);
            gs[0] = fmaf(hv[j], w0.x, gs[0]); gs[1] = fmaf(hv[j], w0.y, gs[1]); gs[2] = fmaf(hv[j], w0.z, gs[2]); gs[3] = fmaf(hv[j], w0.w, gs[3]);
            gs[4] = fmaf(hv[j], w1.x, gs[4]); gs[5] = fmaf(hv[j], w1.y, gs[5]); gs[6] = fmaf(hv[j], w1.z, gs[6]); gs[7] = fmaf(hv[j], w1.w, gs[7]);
        }
#pragma unroll
        for (int c = 0; c < 8; ++c) gs[c] = wave_sum(gs[c]);
        __syncthreads();
        if ((t & 63) == 0) {
#pragma unroll
            for (int c = 0; c < 8; ++c) red[8 + (t >> 6) * 8 + c] = gs[c];
        }
        __syncthreads();
        if (t < 8) gpre[(size_t)row * 8 + t] = red[8 + t] + red[16 + t] + red[24 + t] + red[32 + t];
    }
}

namespace pg8 {
typedef short bf16x8 __attribute__((ext_vector_type(8)));
typedef float f32x4 __attribute__((ext_vector_type(4)));
constexpr int BM = 256, BK = 64, HALF = 128, HTB = HALF * BK * 2, NXCD = 8, WGM = 8;
__device__ __forceinline__ int lds_byte(int r, int c) { const int st = (r >> 4) * 2 + (c >> 5), rr = r & 15, cc = c & 31, ob = rr * 64 + cc * 2; return st * 1024 + (ob ^ (((ob >> 9) & 1) << 5)); }
__device__ __forceinline__ void stage_rc(int b, int& R, int& C) { const int st = b / 1024, sb = b % 1024, swz = sb ^ (((sb >> 9) & 1) << 5); R = (st >> 1) * 16 + swz / 64; C = (st & 1) * 32 + (swz % 64) / 2; }
struct Unit { int pm, pn; };
struct GJob {
    const bf16_t* A; const bf16_t* Bt;
    int lda, ldb, K, nM, nN;
    int a_pn_shift, a_pn_mask, a_pn_step;
    int b_pm_shift, b_pm_step, b_pn_step;
    int a_pm_step;
    int b_pn_mask, b_pn_shift, b_pn_step2;
    int bid0, nblk;
    float escale;
    const float* gs; float* denp; const float* qn; const float* gvec; const bf16_t* mo;
    bf16_t* C2; float* rssp; const float* rstd;
    float* C; int ldc; const float* R; int ldr;
    int mode;
};
__device__ __forceinline__ bool unit_next(const GJob& g, int i, Unit& u) {
    const int nwg = g.nM * g.nN;
    const int bid = (int)blockIdx.x - g.bid0; if (bid < 0 || bid >= g.nblk) return false;
    const long L = (long)i * g.nblk + bid; if (L >= nwg) return false;
    int wgid = (int)L; { const int q = nwg / NXCD, r = nwg % NXCD, xcd = wgid % NXCD, off = wgid / NXCD; wgid = (xcd < r ? xcd * (q + 1) : r * (q + 1) + (xcd - r) * q) + off; }
    const int nig = WGM * g.nN, gid = wgid / nig, fm = gid * WGM, gsz = (g.nM - fm) < WGM ? (g.nM - fm) : WGM;
    u.pm = fm + ((wgid % nig) % gsz); u.pn = (wgid % nig) / gsz; return true;
}
template <int MODE> __device__ __forceinline__ void epilogue(const GJob& g, f32x4 (&acc)[2][2][4][2], const Unit& u, int wr, int wc, int fr, int fq, LAS unsigned char* xlds) {
    const int row0 = u.pm * BM + wr * 64 + fr;
    if constexpr (MODE == 0) {
        const int col0 = u.pn * BM + wc * 32 + 4 * fq;
#pragma unroll
        for (int ai = 0; ai < 2; ++ai)
#pragma unroll
            for (int m = 0; m < 4; ++m) {
                const int row = row0 + ai * HALF + m * 16;
                float* rowp = g.C + (size_t)row * g.ldc + col0;
                const float* rp = g.R ? g.R + (size_t)row * g.ldr + col0 : nullptr;
#pragma unroll
                for (int bj = 0; bj < 2; ++bj)
#pragma unroll
                    for (int n = 0; n < 2; ++n) {
                        f32x4 v = acc[ai][bj][m][n];
                        if (rp) v = v + *(const f32x4*)(rp + bj * HALF + n * 16);
                        *(f32x4*)(rowp + bj * HALF + n * 16) = v;
                    }
            }
    } else if constexpr (MODE == 10) {
        const int col0 = u.pn * BM + wc * 32 + 4 * fq;
#pragma unroll
        for (int ai = 0; ai < 2; ++ai)
#pragma unroll
            for (int m = 0; m < 4; ++m) {
                const int row = row0 + ai * HALF + m * 16;
                bf16_t* r2 = g.C2 + (size_t)row * D + col0;
                float ss = 0.f;
#pragma unroll
                for (int bj = 0; bj < 2; ++bj)
#pragma unroll
                    for (int n = 0; n < 2; ++n) {
                        f32x4 v = acc[ai][bj][m][n];
                        if (g.R) v = v + *(const f32x4*)(g.R + (size_t)row * g.ldr + col0 + bj * HALF + n * 16);
                        else { const uint2 pr = *(const uint2*)(r2 + bj * HALF + n * 16);
                               v[0] += __uint_as_float(pr.x << 16); v[1] += __uint_as_float(pr.x & 0xFFFF0000u); v[2] += __uint_as_float(pr.y << 16); v[3] += __uint_as_float(pr.y & 0xFFFF0000u); }
                        uint2 o; o.x = pk2(v[0], v[1]); o.y = pk2(v[2], v[3]);
                        *(uint2*)(r2 + bj * HALF + n * 16) = o;
                        ss += (v[0] * v[0] + v[1] * v[1]) + (v[2] * v[2] + v[3] * v[3]);
                    }
                ss += __shfl_xor(ss, 16); ss += __shfl_xor(ss, 32);
                if (fq == 0) g.rssp[(size_t)row * 32 + u.pn * 4 + wc] = ss;
            }
    } else if constexpr (MODE == 11) {
        bf16_t* Cb = (bf16_t*)g.C;
        const int col0 = u.pn * BM + wc * 32 + 4 * fq;
#pragma unroll
        for (int ai = 0; ai < 2; ++ai)
#pragma unroll
            for (int m = 0; m < 4; ++m) {
                const int row = row0 + ai * HALF + m * 16;
                const float rs = ((const LAS float*)(xlds + 8192))[row - u.pm * BM];
                bf16_t* rowp = Cb + (size_t)row * g.ldc + col0;
#pragma unroll
                for (int bj = 0; bj < 2; ++bj)
#pragma unroll
                    for (int n = 0; n < 2; ++n) {
                        const f32x4 v = acc[ai][bj][m][n] * rs;
                        uint2 o; o.x = pk2(v[0], v[1]); o.y = pk2(v[2], v[3]);
                        *(uint2*)(rowp + bj * HALF + n * 16) = o;
                    }
            }
    } else if constexpr (MODE == 6) {
        const int h = u.pn; const size_t t0 = (size_t)u.pm * BM;
        bf16_t* Cb = (bf16_t*)g.C;
#pragma unroll
        for (int ai = 0; ai < 2; ++ai)
#pragma unroll
            for (int m = 0; m < 4; ++m) {
                const int l = ai * HALF + wr * 64 + m * 16 + fr;
                const float M2 = g.gs[((t0 + l) * 4 + h) * 8 + 1];
                bf16_t* rowp = Cb + (t0 + l) * 2048 + h * 512 + wc * 32 + 4 * fq;
                float rs = 0.f;
#pragma unroll
                for (int bj = 0; bj < 2; ++bj)
#pragma unroll
                    for (int n = 0; n < 2; ++n) {
                        const f32x4 a = acc[ai][bj][m][n];
                        const int s0 = bj * HALF + wc * 32 + n * 16 + 4 * fq;
                        float p[4];
#pragma unroll
                        for (int r = 0; r < 4; ++r) { const float u2 = g.gs[((t0 + s0 + r) * 4 + h) * 8 + 0]; p[r] = (s0 + r <= l) ? a[r] * __builtin_amdgcn_exp2f(u2 - M2) : 0.f; rs += p[r]; }
                        uint2 o; o.x = pk2(p[0], p[1]); o.y = pk2(p[2], p[3]);
                        *(uint2*)(rowp + bj * HALF + n * 16) = o;
                    }
                rs += __shfl_xor(rs, 16); rs += __shfl_xor(rs, 32);
                if (fq == 0) g.denp[((t0 + l) * 4 + h) * 4 + wc] = rs;
            }
    } else if constexpr (MODE == 12) {
        float* Ct = g.C + (size_t)(u.pn >> 4) * ((size_t)512 * 4096) + (size_t)(u.pn & 15) * 256;
        const int col0 = wc * 32 + 4 * fq;
#pragma unroll
        for (int ai = 0; ai < 2; ++ai)
#pragma unroll
            for (int m = 0; m < 4; ++m) {
                float* rowp = Ct + (size_t)(row0 + ai * HALF + m * 16) * 4096 + col0;
#pragma unroll
                for (int bj = 0; bj < 2; ++bj)
#pragma unroll
                    for (int n = 0; n < 2; ++n) *(f32x4*)(rowp + bj * HALF + n * 16) = acc[ai][bj][m][n];
            }
    } else if constexpr (MODE == 7) {
        float* Ct = g.C + (size_t)(u.pm * 4 + u.pn) * 65536;
        const int col0 = wc * 32 + 4 * fq;
#pragma unroll
        for (int ai = 0; ai < 2; ++ai)
#pragma unroll
            for (int m = 0; m < 4; ++m) {
                float* rowp = Ct + (size_t)(ai * HALF + wr * 64 + m * 16 + fr) * 256 + col0;
#pragma unroll
                for (int bj = 0; bj < 2; ++bj)
#pragma unroll
                    for (int n = 0; n < 2; ++n) *(f32x4*)(rowp + bj * HALF + n * 16) = acc[ai][bj][m][n];
            }
    } else if constexpr (MODE == 8) {
        const int h = u.pn; const size_t t0 = (size_t)u.pm * BM;
        LAS float* X0 = (LAS float*)xlds + wr * 512;
#pragma unroll
        for (int ai = 0; ai < 2; ++ai)
#pragma unroll
            for (int m = 0; m < 4; ++m) {
                const size_t th = (t0 + ai * HALF + wr * 64 + m * 16 + fr) * 4 + h;
                const f32x4 dp = *(const f32x4*)(g.denp + th * 4);
                const float den = (dp[0] + dp[1]) + (dp[2] + dp[3]) + g.gs[th * 8 + 3] * g.qn[th];
                const float rden = 1.0f / fmaxf(fabsf(den), g.gs[th * 8 + 4]);
                float ss = 0.f;
#pragma unroll
                for (int bj = 0; bj < 2; ++bj)
#pragma unroll
                    for (int n = 0; n < 2; ++n) { f32x4 a = acc[ai][bj][m][n] * rden; acc[ai][bj][m][n] = a; ss += (a[0] * a[0] + a[1] * a[1]) + (a[2] * a[2] + a[3] * a[3]); }
                ss += __shfl_xor(ss, 16); ss += __shfl_xor(ss, 32);
                if (fq == 0) X0[(ai * 64 + m * 16 + fr) * 4 + wc] = ss;
            }
        asm volatile("s_waitcnt lgkmcnt(0)" ::: "memory"); __builtin_amdgcn_s_barrier(); asm volatile("" ::: "memory");
        bf16_t* Cb = (bf16_t*)g.C;
        const int col0 = wc * 32 + 4 * fq;
#pragma unroll
        for (int ai = 0; ai < 2; ++ai)
#pragma unroll
            for (int m = 0; m < 4; ++m) {
                const f32x4 p4 = *(const LAS f32x4*)(X0 + (ai * 64 + m * 16 + fr) * 4);
                const float rsn = rsqrtf(((p4[0] + p4[1]) + (p4[2] + p4[3])) * (1.0f / 256.0f) + EPS);
                const size_t t = t0 + ai * HALF + wr * 64 + m * 16 + fr;
                bf16_t* rowp = Cb + t * 2048 + h * 256 + col0;
                const bf16_t* mop = g.mo + t * 1024 + h * 256 + col0;
#pragma unroll
                for (int bj = 0; bj < 2; ++bj)
#pragma unroll
                    for (int n = 0; n < 2; ++n) {
                        const f32x4 a = acc[ai][bj][m][n];
                        const ushort4 mo4 = *(const ushort4*)(mop + bj * HALF + n * 16);
                        const f32x4 gv = *(const f32x4*)(g.gvec + h * 256 + col0 + bj * HALF + n * 16);
                        const float o0 = a[0] * rsn * gv[0] / (1.0f + __expf(-bf2f(mo4.x)));
                        const float o1 = a[1] * rsn * gv[1] / (1.0f + __expf(-bf2f(mo4.y)));
                        const float o2 = a[2] * rsn * gv[2] / (1.0f + __expf(-bf2f(mo4.z)));
                        const float o3 = a[3] * rsn * gv[3] / (1.0f + __expf(-bf2f(mo4.w)));
                        uint2 o; o.x = pk2(o0, o1); o.y = pk2(o2, o3);
                        *(uint2*)(rowp + bj * HALF + n * 16) = o;
                    }
            }
    } else if constexpr (MODE == 5) {
        LAS float* X0 = (LAS float*)xlds + wr * 512;
        LAS float* X1 = (LAS float*)xlds + 1024 + wr * 512;
#pragma unroll
        for (int ai = 0; ai < 2; ++ai)
#pragma unroll
            for (int m = 0; m < 4; ++m) {
                float v = -INFINITY;
#pragma unroll
                for (int bj = 0; bj < 2; ++bj)
#pragma unroll
                    for (int n = 0; n < 2; ++n) { const f32x4 a = acc[ai][bj][m][n]; v = fmaxf(v, fmaxf(fmaxf(a[0], a[1]), fmaxf(a[2], a[3]))); }
                v = fmaxf(v, __shfl_xor(v, 16)); v = fmaxf(v, __shfl_xor(v, 32));
                if (fq == 0) X0[(ai * 64 + m * 16 + fr) * 4 + wc] = v;
            }
        asm volatile("s_waitcnt lgkmcnt(0)" ::: "memory"); __builtin_amdgcn_s_barrier(); asm volatile("" ::: "memory");
#pragma unroll
        for (int ai = 0; ai < 2; ++ai)
#pragma unroll
            for (int m = 0; m < 4; ++m) {
                const f32x4 p4 = *(const LAS f32x4*)(X0 + (ai * 64 + m * 16 + fr) * 4);
                const float mxr = fmaxf(fmaxf(p4[0], p4[1]), fmaxf(p4[2], p4[3])) * g.escale;
                float s = 0.f;
#pragma unroll
                for (int bj = 0; bj < 2; ++bj)
#pragma unroll
                    for (int n = 0; n < 2; ++n) { f32x4 a = acc[ai][bj][m][n];
                        a[0] = __builtin_amdgcn_exp2f(a[0] * g.escale - mxr); a[1] = __builtin_amdgcn_exp2f(a[1] * g.escale - mxr); a[2] = __builtin_amdgcn_exp2f(a[2] * g.escale - mxr); a[3] = __builtin_amdgcn_exp2f(a[3] * g.escale - mxr);
                        acc[ai][bj][m][n] = a; s += (a[0] + a[1]) + (a[2] + a[3]); }
                s += __shfl_xor(s, 16); s += __shfl_xor(s, 32);
                if (fq == 0) X1[(ai * 64 + m * 16 + fr) * 4 + wc] = s;
            }
        asm volatile("s_waitcnt lgkmcnt(0)" ::: "memory"); __builtin_amdgcn_s_barrier(); asm volatile("" ::: "memory");
        bf16_t* Cb = (bf16_t*)g.C;
        const int col0 = u.pn * BM + wc * 32 + 4 * fq;
#pragma unroll
        for (int ai = 0; ai < 2; ++ai)
#pragma unroll
            for (int m = 0; m < 4; ++m) {
                const f32x4 p4 = *(const LAS f32x4*)(X1 + (ai * 64 + m * 16 + fr) * 4);
                const float inv = 1.0f / ((p4[0] + p4[1]) + (p4[2] + p4[3]));
                bf16_t* rowp = Cb + (size_t)(row0 + ai * HALF + m * 16) * g.ldc + col0;
#pragma unroll
                for (int bj = 0; bj < 2; ++bj)
#pragma unroll
                    for (int n = 0; n < 2; ++n) {
                        const f32x4 a = acc[ai][bj][m][n];
                        uint2 o; o.x = pk2(a[0] * inv, a[1] * inv); o.y = pk2(a[2] * inv, a[3] * inv);
                        *(uint2*)(rowp + bj * HALF + n * 16) = o;
                    }
            }
    } else {
        bf16_t* Cb = (bf16_t*)g.C; int ccol = u.pn * BM;
        if constexpr (MODE == 4) { Cb += (size_t)(u.pn >> 2) * P6S; ccol = (u.pn & 3) * 256; }
        const int col0 = ccol + wc * 32 + 4 * fq;
#pragma unroll
        for (int ai = 0; ai < 2; ++ai)
#pragma unroll
            for (int m = 0; m < 4; ++m) {
                bf16_t* rowp = Cb + (size_t)(row0 + ai * HALF + m * 16) * g.ldc + col0;
#pragma unroll
                for (int bj = 0; bj < 2; ++bj)
#pragma unroll
                    for (int n = 0; n < 2; ++n) {
                        const f32x4 v = acc[ai][bj][m][n];
                        uint2 o; o.x = pk2(v[0], v[1]); o.y = pk2(v[2], v[3]);
                        *(uint2*)(rowp + bj * HALF + n * 16) = o;
                    }
            }
    }
}
template <int MODE> __device__ __forceinline__ void gemm_phase(LAS unsigned char* lds, const GJob& g, int tid) {
    const int wid = __builtin_amdgcn_readfirstlane(tid >> 6), lane = tid & 63, wr = wid >> 2, wc = wid & 3, fr = lane & 15, fq = lane >> 4;
    const int K = g.K, nt = K / BK;
    unsigned voffA[2], voffB[2];
#pragma unroll
    for (int i = 0; i < 2; ++i) { int R, C; stage_rc(tid * 16 + i * 8192, R, C);
        voffA[i] = (unsigned)(R * g.lda + C) * 2u; voffB[i] = (unsigned)(R * g.ldb + C) * 2u; }
    const size_t kstep = (size_t)(BK * 2);
    const size_t hstepA = (size_t)HALF * g.lda * 2, hstepB = (size_t)HALF * g.ldb * 2;
    const unsigned ldsw = (unsigned)wid * 1024u;
    const int aoff = lds_byte(wr * 64 + fr, fq * 8), boff = lds_byte(wc * 32 + fr, fq * 8);
#define PG8_SA(b, h) (((b) * 2 + (h)) * HTB)
#define PG8_SB(b, h) ((4 + (b) * 2 + (h)) * HTB)
#define PG8_STAGE(bufoff, gbase, voff) do { _Pragma("unroll") for (int _i = 0; _i < 2; ++_i) \
        __builtin_amdgcn_global_load_lds((const unsigned*)((const char*)(gbase) + (voff)[_i]), (LAS unsigned*)(lds + (bufoff) + ldsw + _i * 8192), 16, 0, 0); } while (0)
#define PG8_LDA(dst, b, h) do { _Pragma("unroll") for (int m = 0; m < 4; ++m) _Pragma("unroll") for (int k = 0; k < 2; ++k) dst[m][k] = *(const LAS bf16x8*)(lds + PG8_SA(b, h) + aoff + m * 2048 + k * 1024); } while (0)
#define PG8_LDB(dst, b, h) do { _Pragma("unroll") for (int n = 0; n < 2; ++n) _Pragma("unroll") for (int k = 0; k < 2; ++k) dst[n][k] = *(const LAS bf16x8*)(lds + PG8_SB(b, h) + boff + n * 2048 + k * 1024); } while (0)
#define PG8_MMA(ai, bj, At, Bt) do { __builtin_amdgcn_s_setprio(1); _Pragma("unroll") for (int m = 0; m < 4; ++m) _Pragma("unroll") for (int n = 0; n < 2; ++n) _Pragma("unroll") for (int k = 0; k < 2; ++k) \
        acc[ai][bj][m][n] = __builtin_amdgcn_mfma_f32_16x16x32_bf16(Bt[n][k], At[m][k], acc[ai][bj][m][n], 0, 0, 0); __builtin_amdgcn_s_setprio(0); } while (0)
#define PG8_WAIT_V(n) asm volatile("s_waitcnt vmcnt(" #n ")" ::: "memory")
#define PG8_WAIT_L(n) asm volatile("s_waitcnt lgkmcnt(" #n ")" ::: "memory")
#define PG8_BAR __builtin_amdgcn_s_barrier()
#define PG8_SCHED __builtin_amdgcn_sched_barrier(0)
#define PG8_ABASE(u) ((const char*)g.A + ((size_t)(u).pm * g.a_pm_step + (size_t)(((u).pn >> g.a_pn_shift) & g.a_pn_mask) * g.a_pn_step) * 2)
#define PG8_BBASE(u) ((const char*)g.Bt + ((size_t)((u).pn & g.b_pn_mask) * g.b_pn_step + (size_t)((u).pn >> g.b_pn_shift) * g.b_pn_step2 + (size_t)((u).pm >> g.b_pm_shift) * g.b_pm_step) * 2)
    Unit cur, nxt; int ui = 0;
    if (!unit_next(g, 0, cur)) return;
    f32x4 acc[2][2][4][2];
#pragma unroll
    for (int a = 0; a < 2; ++a)
#pragma unroll
        for (int b = 0; b < 2; ++b)
#pragma unroll
            for (int m = 0; m < 4; ++m)
#pragma unroll
                for (int n = 0; n < 2; ++n) acc[a][b][m][n] = (f32x4){0.f, 0.f, 0.f, 0.f};
    bf16x8 At[4][2], B0[2][2], B1[2][2];
    const char* cA = PG8_ABASE(cur); const char* cB = PG8_BBASE(cur);
    PG8_STAGE(PG8_SB(0, 0), cB, voffB); PG8_STAGE(PG8_SA(0, 0), cA, voffA); PG8_STAGE(PG8_SB(0, 1), cB + hstepB, voffB); PG8_STAGE(PG8_SA(0, 1), cA + hstepA, voffA);
    if (wr == 1) PG8_BAR;
    PG8_WAIT_V(4); PG8_BAR;
    PG8_STAGE(PG8_SB(1, 0), cB + kstep, voffB); PG8_STAGE(PG8_SA(1, 0), cA + kstep, voffA); PG8_STAGE(PG8_SB(1, 1), cB + hstepB + kstep, voffB);
    PG8_WAIT_V(6); PG8_BAR;
    for (;;) {
        const bool has_next = unit_next(g, ui + 1, nxt);
        const char* nA = has_next ? PG8_ABASE(nxt) : cA; const char* nB = has_next ? PG8_BBASE(nxt) : cB;
        for (int t = 0; t < nt; t += 2) {
            const bool last = (t == nt - 2);
            const char* a1 = cA + (size_t)(t + 1) * kstep;
            const char* a2 = last ? nA : cA + (size_t)(t + 2) * kstep; const char* b2 = last ? nB : cB + (size_t)(t + 2) * kstep;
            const char* a3 = a2 + kstep; const char* b3 = b2 + kstep;
            PG8_LDB(B0, 0, 0); PG8_SCHED; PG8_LDA(At, 0, 0); PG8_STAGE(PG8_SA(1, 1), a1 + hstepA, voffA);
            PG8_WAIT_L(8); PG8_BAR; PG8_WAIT_L(0); PG8_MMA(0, 0, At, B0); PG8_BAR; PG8_SCHED;
            PG8_LDB(B1, 0, 1); PG8_STAGE(PG8_SB(0, 0), b2, voffB);
            PG8_BAR; PG8_WAIT_L(0); PG8_MMA(0, 1, At, B1); PG8_BAR;
            PG8_LDA(At, 0, 1); PG8_STAGE(PG8_SA(0, 0), a2, voffA);
            PG8_BAR; PG8_WAIT_L(0); PG8_MMA(1, 0, At, B0); PG8_BAR; PG8_SCHED;
            PG8_STAGE(PG8_SB(0, 1), b2 + hstepB, voffB);
            PG8_WAIT_V(6); PG8_BAR; PG8_MMA(1, 1, At, B1); PG8_BAR;
            PG8_LDB(B0, 1, 0); PG8_SCHED; PG8_LDA(At, 1, 0); PG8_STAGE(PG8_SA(0, 1), a2 + hstepA, voffA);
            PG8_WAIT_L(8); PG8_BAR; PG8_WAIT_L(0); PG8_MMA(0, 0, At, B0); PG8_BAR; PG8_SCHED;
            PG8_LDB(B1, 1, 1); PG8_STAGE(PG8_SB(1, 0), b3, voffB);
            PG8_BAR; PG8_WAIT_L(0); PG8_MMA(0, 1, At, B1); PG8_BAR;
            PG8_LDA(At, 1, 1); PG8_STAGE(PG8_SA(1, 0), a3, voffA);
            PG8_BAR; PG8_WAIT_L(0); PG8_MMA(1, 0, At, B0); PG8_BAR; PG8_SCHED;
            PG8_STAGE(PG8_SB(1, 1), b3 + hstepB, voffB);
            PG8_WAIT_V(6); PG8_BAR; PG8_MMA(1, 1, At, B1); PG8_BAR;
        }
        epilogue<MODE>(g, acc, cur, wr, wc, fr, fq, lds + GEMM_LDS + 1024);
        if (!has_next) break;
#pragma unroll
        for (int a = 0; a < 2; ++a)
#pragma unroll
            for (int b = 0; b < 2; ++b)
#pragma unroll
                for (int m = 0; m < 4; ++m)
#pragma unroll
                    for (int n = 0; n < 2; ++n) acc[a][b][m][n] = (f32x4){0.f, 0.f, 0.f, 0.f};
        cur = nxt; cA = nA; cB = nB; ++ui;
    }
    PG8_WAIT_V(0);
    if (wr == 0) PG8_BAR;
    PG8_BAR;
#undef PG8_SA
#undef PG8_SB
#undef PG8_STAGE
#undef PG8_LDA
#undef PG8_LDB
#undef PG8_MMA
#undef PG8_WAIT_V
#undef PG8_WAIT_L
#undef PG8_BAR
#undef PG8_SCHED
#undef PG8_ABASE
#undef PG8_BBASE
}
}

__device__ __forceinline__ void p0_transpose_item(const float* W, int ldw, int K, int csrc0, bf16_t* WT, int row0, LAS float* scr, int kb, int lane, float wscale, const float* kgain) {
    const int k0 = 64 * kb;
#pragma unroll
    for (int i = 0; i < 8; ++i) { const int kk = 8 * i + (lane >> 3), n4 = (lane & 7) * 4;
        const float4 v = *(const float4*)(W + (size_t)(k0 + kk) * ldw + csrc0 + n4);
        const float ws = kgain ? kgain[k0 + kk] : wscale; (void)wscale;
        scr[kk * 33 + n4] = v.x * ws; scr[kk * 33 + n4 + 1] = v.y * ws; scr[kk * 33 + n4 + 2] = v.z * ws; scr[kk * 33 + n4 + 3] = v.w * ws; }
    asm volatile("s_waitcnt lgkmcnt(0)" ::: "memory");
    const int c = lane & 7;
#pragma unroll
    for (int j = 0; j < 4; ++j) { const int n = (lane >> 3) + 8 * j; const LAS float* s = scr + (8 * c) * 33 + n;
        uint4 o; o.x = pk2(s[0 * 33], s[1 * 33]); o.y = pk2(s[2 * 33], s[3 * 33]); o.z = pk2(s[4 * 33], s[5 * 33]); o.w = pk2(s[6 * 33], s[7 * 33]);
        *(uint4*)(WT + (size_t)(row0 + n) * K + k0 + 8 * c) = o; }
    asm volatile("s_waitcnt lgkmcnt(0)" ::: "memory");
}

__device__ __forceinline__ void d_conv_silu(int vb, int tid, const bf16_t* __restrict__ p6, const float* __restrict__ cw, const float* __restrict__ cb, bf16_t* __restrict__ c) {
    const int t = vb, s = t % S;
    for (int ch = tid; ch < 1024; ch += 256) {
        float y = cb[ch];
#pragma unroll
        for (int j = 0; j < 4; ++j) {
            const int ss = s - 3 + j;
            if (ss >= 0) y = fmaf(cw[j * 1024 + ch], bf2f(p6[(size_t)(t - 3 + j) * 1024 + ch]), y);
        }
        c[(size_t)t * 1024 + ch] = (bf16_t)f2bf(y / (1.0f + expf(-y)));
    }
}

__device__ __forceinline__ void d_mlstm(int vb, int tid, const bf16_t* __restrict__ mq, const bf16_t* __restrict__ mk, const bf16_t* __restrict__ p6,
                                        const float* __restrict__ gpre, const float* __restrict__ b_mi, const float* __restrict__ b_mf, float* __restrict__ hraw) {
    const int lane = tid & 63, w = tid >> 6;
    const int gid = vb * 4 + w;
    const int e = gid & 255, h = (gid >> 8) & 3, b = gid >> 10;
    const float bi = b_mi[h], bf = b_mf[h];
    float C0 = 0.f, C1 = 0.f, C2 = 0.f, C3 = 0.f, n0 = 0.f, n1 = 0.f, n2 = 0.f, n3 = 0.f, m = 0.f;
    const size_t tb = (size_t)b * S;
    const bf16_t* qp = mq + tb * 1024 + h * 256 + lane * 4;
    const bf16_t* kp = mk + tb * 1024 + h * 256 + lane * 4;
    const bf16_t* pp = p6 + P6S + tb * 1024 + h * 256 + e;
    ushort4 qn = *(const ushort4*)qp, kn = *(const ushort4*)kp;
    const float* gp = gpre + tb * 8;
    float vn = bf2f(pp[0]), in_ = gp[h], fn = gp[4 + h];
    for (int s = 0; s < S; ++s) {
        const float4 q = make_float4(bf2f(qn.x), bf2f(qn.y), bf2f(qn.z), bf2f(qn.w)), k = make_float4(bf2f(kn.x), bf2f(kn.y), bf2f(kn.z), bf2f(kn.w)); const float v = vn, ipre = in_ + bi, fpre = fn + bf;
        if (s + 1 < S) {
            qn = *(const ushort4*)(qp + (size_t)(s + 1) * 1024);
            kn = *(const ushort4*)(kp + (size_t)(s + 1) * 1024);
            vn = bf2f(pp[(size_t)(s + 1) * 1024]); in_ = gp[(size_t)(s + 1) * 8 + h]; fn = gp[(size_t)(s + 1) * 8 + 4 + h];
        }
        const float logf = log_sigmoid(fpre);
        const float mnew = fmaxf(logf + m, ipre);
        const float fd = expf(logf + m - mnew), ig = expf(ipre - mnew);
        m = mnew;
        const float sc = ig * 0.0625f;
        C0 = fd * C0 + sc * k.x * v; C1 = fd * C1 + sc * k.y * v; C2 = fd * C2 + sc * k.z * v; C3 = fd * C3 + sc * k.w * v;
        n0 = fd * n0 + sc * k.x; n1 = fd * n1 + sc * k.y; n2 = fd * n2 + sc * k.z; n3 = fd * n3 + sc * k.w;
        float num = q.x * C0 + q.y * C1 + q.z * C2 + q.w * C3;
        float den = q.x * n0 + q.y * n1 + q.z * n2 + q.w * n3;
        num = wave_sum(num); den = wave_sum(den);
        if (lane == 0) hraw[(tb + s) * 1024 + h * 256 + e] = num / fmaxf(fabsf(den), expf(-mnew));
    }
}

__device__ __forceinline__ void d_mhead_norm(int vb, int tid, const float* __restrict__ hraw, const bf16_t* __restrict__ p6, const float* __restrict__ g, bf16_t* __restrict__ mix) {
    const int t = vb, h = tid >> 6, lane = tid & 63;
    const float4 v = *(const float4*)(hraw + (size_t)t * 1024 + h * 256 + lane * 4);
    float s = v.x * v.x + v.y * v.y + v.z * v.z + v.w * v.w;
    s = wave_sum(s);
    const float r = rsqrtf(s * (1.0f / 256.0f) + EPS);
    const float4 gg = *(const float4*)(g + h * 256 + lane * 4);
    const ushort4 mo = *(const ushort4*)(p6 + 2 * P6S + (size_t)t * 1024 + h * 256 + lane * 4);
    float4 o;
    o.x = v.x * r * gg.x / (1.0f + expf(-bf2f(mo.x)));
    o.y = v.y * r * gg.y / (1.0f + expf(-bf2f(mo.y)));
    o.z = v.z * r * gg.z / (1.0f + expf(-bf2f(mo.z)));
    o.w = v.w * r * gg.w / (1.0f + expf(-bf2f(mo.w)));
    uint2 ob; ob.x = pk2(o.x, o.y); ob.y = pk2(o.z, o.w);
    *(uint2*)(mix + (size_t)t * D + h * 256 + lane * 4) = ob;
}

__device__ __forceinline__ void d_rope(int vb, int tid, bf16_t* __restrict__ p6) {
    const int t = vb, s = t % S;
    for (int idx = tid; idx < 2 * 8 * 64; idx += 256) {
        const int i = idx & 63, hd = (idx >> 6) & 7, qk = idx >> 9;
        const float inv = exp2f(-(float)i * 0.20762050593046014f);
        const float ang = (float)s * inv;
        float sn, cs; sincosf(ang, &sn, &cs);
        bf16_t* p = p6 + (size_t)(3 + qk) * P6S + (size_t)t * 1024 + hd * 128;
        const float x1 = bf2f(p[i]), x2 = bf2f(p[64 + i]);
        p[i] = (bf16_t)f2bf(x1 * cs - x2 * sn);
        p[64 + i] = (bf16_t)f2bf(x2 * cs + x1 * sn);
    }
}

__device__ __forceinline__ void d_dilated(int vb, int tid, float* sm, const bf16_t* __restrict__ p6, const float* __restrict__ g_ahead, bf16_t* __restrict__ mix) {
    float (*qs)[128] = (float (*)[128])sm;
    float (*ps)[576] = (float (*)[576])(sm + 512);
    const int lane = tid & 63, w = tid >> 6;
    const int gid = vb * 4 + w;
    const int s = gid % S, hd = (gid / S) & 7, b = gid / (S * 8);
    const size_t t = (size_t)b * S + s;
    const bf16_t* qrow = p6 + 3 * P6S + t * 1024 + hd * 128;
    __syncthreads();
    qs[w][lane] = bf2f(qrow[lane]); qs[w][lane + 64] = bf2f(qrow[lane + 64]);
    __syncthreads();
    const float scale = 0.08838834764831845f;
    float mloc = -INFINITY;
    for (int br = 0; br < 3; ++br) {
        const int dil = br == 0 ? 1 : (br == 1 ? 4 : 16);
        for (int jj = 0; jj < 192; jj += 64) {
            const int j = jj + lane;
            float sc = -INFINITY;
            if (j <= 128 && s - j * dil >= 0) {
                const bf16_t* krow = p6 + 4 * P6S + (t - (size_t)j * dil) * 1024 + hd * 128;
                float d = 0.f;
#pragma unroll 8
                for (int c = 0; c < 128; c += 4) {
                    const ushort4 kv = *(const ushort4*)(krow + c);
                    d = fmaf(qs[w][c], bf2f(kv.x), d); d = fmaf(qs[w][c + 1], bf2f(kv.y), d); d = fmaf(qs[w][c + 2], bf2f(kv.z), d); d = fmaf(qs[w][c + 3], bf2f(kv.w), d);
                }
                sc = d * scale;
            }
            ps[w][br * 192 + j] = sc;
            mloc = fmaxf(mloc, sc);
        }
    }
    const float mx = wave_max(mloc);
    __syncthreads();
    float lsum = 0.f;
    for (int i = lane; i < 3 * 192; i += 64) {
        const float sc = ps[w][i];
        const float pv = (sc == -INFINITY) ? 0.f : expf(sc - mx);
        ps[w][i] = pv; lsum += pv;
    }
    const float tot = wave_sum(lsum);
    __syncthreads();
    float o0 = 0.f, o1 = 0.f;
    for (int br = 0; br < 3; ++br) {
        const int dil = br == 0 ? 1 : (br == 1 ? 4 : 16);
        for (int j = 0; j <= 128; ++j) {
            if (s - j * dil < 0) break;
            const float pv = ps[w][br * 192 + j];
            const bf16_t* vrow = p6 + 5 * P6S + (t - (size_t)j * dil) * 1024 + hd * 128;
            o0 = fmaf(pv, bf2f(vrow[lane]), o0); o1 = fmaf(pv, bf2f(vrow[lane + 64]), o1);
        }
    }
    o0 /= tot; o1 /= tot;
    float ss = wave_sum(o0 * o0 + o1 * o1);
    const float r = rsqrtf(ss * (1.0f / 128.0f) + EPS);
    bf16_t* orow = mix + t * D + 1024 + hd * 128;
    orow[lane] = (bf16_t)f2bf(o0 * r * g_ahead[hd * 128 + lane]);
    orow[lane + 64] = (bf16_t)f2bf(o1 * r * g_ahead[hd * 128 + lane + 64]);
}

__device__ __forceinline__ void d_cross(int vb, int tid, float* sm, const bf16_t* __restrict__ q, const float* __restrict__ km, const float* __restrict__ vm, bf16_t* __restrict__ o) {
    float (*qs)[512] = (float (*)[512])sm;
    float (*ps)[256] = (float (*)[256])(sm + 2048);
    const int lane = tid & 63, w = tid >> 6;
    const int t = vb, hd = w, b = t / S;
    const bf16_t* qrow = q + (size_t)t * D + hd * 512;
    __syncthreads();
    for (int i = lane; i < 512; i += 64) qs[w][i] = bf2f(qrow[i]);
    __syncthreads();
    const float scale = 0.04419417382415922f;
    float sc[4]; float mloc = -INFINITY;
#pragma unroll
    for (int r = 0; r < 4; ++r) {
        const int mi = lane + 64 * r;
        const float* krow = km + ((size_t)b * 256 + mi) * D + hd * 512;
        float d = 0.f;
#pragma unroll 8
        for (int c = 0; c < 512; c += 4) {
            const float4 kv = *(const float4*)(krow + c);
            d = fmaf(qs[w][c], kv.x, d); d = fmaf(qs[w][c + 1], kv.y, d); d = fmaf(qs[w][c + 2], kv.z, d); d = fmaf(qs[w][c + 3], kv.w, d);
        }
        sc[r] = d * scale; mloc = fmaxf(mloc, sc[r]);
    }
    const float mx = wave_max(mloc);
    float lsum = 0.f;
#pragma unroll
    for (int r = 0; r < 4; ++r) { const float pv = expf(sc[r] - mx); ps[w][lane + 64 * r] = pv; lsum += pv; }
    const float tot = wave_sum(lsum);
    __syncthreads();
    float acc[8];
#pragma unroll
    for (int i = 0; i < 8; ++i) acc[i] = 0.f;
    for (int mi = 0; mi < 256; ++mi) {
        const float pv = ps[w][mi];
        const float* vrow = vm + ((size_t)b * 256 + mi) * D + hd * 512;
#pragma unroll
        for (int i = 0; i < 8; ++i) acc[i] = fmaf(pv, vrow[lane + 64 * i], acc[i]);
    }
    bf16_t* orow = o + (size_t)t * D + hd * 512;
#pragma unroll
    for (int i = 0; i < 8; ++i) orow[lane + 64 * i] = (bf16_t)f2bf(acc[i] / tot);
}

__device__ __forceinline__ void wave_argmax(float& best, int& bidx) {
#pragma unroll
    for (int o = 32; o >= 1; o >>= 1) {
        const float ob = __shfl_xor(best, o); const int oi = __shfl_xor(bidx, o);
        if (ob > best || (ob == best && oi < bidx)) { best = ob; bidx = oi; }
    }
}
__device__ __forceinline__ void d_peer_topk(int vb, int tid, float* sm, const bf16_t* __restrict__ qp, const float* __restrict__ sub_keys, int* __restrict__ ids, float* __restrict__ gates) {
    float (*qs)[256] = (float (*)[256])sm;
    const int lane = tid & 63, w = tid >> 6;
    const int gid = vb * 4 + w;
    const int hd = gid & 7, t = gid >> 3;
    const bf16_t* qrow = qp + (size_t)t * D + hd * 256;
    __syncthreads();
    for (int i = lane; i < 256; i += 64) qs[w][i] = bf2f(qrow[i]);
    __syncthreads();
    float tops[2]; int topi[2];
#pragma unroll
    for (int p = 0; p < 2; ++p) {
        float v0, v1;
        {
            const float* k0 = sub_keys + ((size_t)(hd * 2 + p) * 128 + lane) * 128;
            const float* k1 = k0 + 64 * 128;
            float d0 = 0.f, d1 = 0.f;
#pragma unroll 8
            for (int c = 0; c < 128; c += 4) {
                const float4 a = *(const float4*)(k0 + c), bb = *(const float4*)(k1 + c);
                const float q0 = qs[w][p * 128 + c], q1 = qs[w][p * 128 + c + 1], q2 = qs[w][p * 128 + c + 2], q3 = qs[w][p * 128 + c + 3];
                d0 = fmaf(q0, a.x, d0); d0 = fmaf(q1, a.y, d0); d0 = fmaf(q2, a.z, d0); d0 = fmaf(q3, a.w, d0);
                d1 = fmaf(q0, bb.x, d1); d1 = fmaf(q1, bb.y, d1); d1 = fmaf(q2, bb.z, d1); d1 = fmaf(q3, bb.w, d1);
            }
            v0 = d0; v1 = d1;
        }
        float ts = 0.f; int ti = 0;
        for (int it = 0; it < 16; ++it) {
            float best; int bidx;
            if (v0 >= v1) { best = v0; bidx = lane; } else { best = v1; bidx = lane + 64; }
            wave_argmax(best, bidx);
            if (lane == it) { ts = best; ti = bidx; }
            if (bidx == lane) v0 = -INFINITY;
            if (bidx == lane + 64) v1 = -INFINITY;
        }
        tops[p] = ts; topi[p] = ti;
    }
    float cv[4]; int ci[4];
#pragma unroll
    for (int r = 0; r < 4; ++r) {
        const int c = lane * 4 + r, i = c >> 4, j = c & 15;
        const float s0 = __shfl(tops[0], i), s1 = __shfl(tops[1], j);
        const int i0 = __shfl(topi[0], i), i1 = __shfl(topi[1], j);
        cv[r] = s0 + s1; ci[r] = i0 * 128 + i1;
    }
    float bs = 0.f; int bid = 0;
    for (int it = 0; it < 16; ++it) {
        float best = cv[0]; int bidx = lane * 4;
#pragma unroll
        for (int r = 1; r < 4; ++r) if (cv[r] > best) { best = cv[r]; bidx = lane * 4 + r; }
        wave_argmax(best, bidx);
        const int owner = bidx >> 2, rr = bidx & 3;
        int myid = ci[0];
        if (rr == 1) myid = ci[1]; else if (rr == 2) myid = ci[2]; else if (rr == 3) myid = ci[3];
        const int eid = __shfl(myid, owner);
        if (lane == it) { bs = best; bid = eid; }
        if (owner == lane) {
#pragma unroll
            for (int r = 0; r < 4; ++r) if (rr == r) cv[r] = -INFINITY;
        }
    }
    float v = lane < 16 ? bs : -INFINITY;
    const float mx = wave_max(v);
    const float ev = lane < 16 ? expf(bs - mx) : 0.f;
    const float tot = wave_sum(ev);
    if (lane < 16) {
        ids[(size_t)t * 128 + hd * 16 + lane] = bid;
        gates[(size_t)t * 128 + hd * 16 + lane] = ev / tot;
    }
}

__device__ __forceinline__ void d_peer_out(int vb, int tid, float* sm, const bf16_t* __restrict__ h3, const float* __restrict__ x2, const int* __restrict__ ids, const float* __restrict__ gates,
                                           const bf16_t* __restrict__ u_tab, const bf16_t* __restrict__ v_tab, const float* __restrict__ g_final, float* __restrict__ out) {
    float (*part)[2048] = (float (*)[2048])sm;
    float* red = sm + 4 * 2048;
    const int lane = tid & 63, w = tid >> 6, t = vb;
    float4 xr[8], acc[8];
    const bf16_t* hrow = h3 + (size_t)t * D;
#pragma unroll
    for (int i = 0; i < 8; ++i) { const ushort4 hv = *(const ushort4*)(hrow + i * 256 + lane * 4);
        xr[i] = make_float4(bf2f(hv.x), bf2f(hv.y), bf2f(hv.z), bf2f(hv.w)); acc[i] = make_float4(0.f, 0.f, 0.f, 0.f); }
    for (int j = 0; j < 32; ++j) {
        const int slot = w * 32 + j;
        const int e = ids[(size_t)t * 128 + slot];
        const float gt = gates[(size_t)t * 128 + slot];
        const bf16_t* ur = u_tab + (size_t)e * D;
        const bf16_t* vr = v_tab + (size_t)e * D;
        float d = 0.f;
#pragma unroll
        for (int i = 0; i < 8; ++i) {
            const ushort4 u = *(const ushort4*)(ur + i * 256 + lane * 4);
            d = fmaf(xr[i].x, bf2f(u.x), d); d = fmaf(xr[i].y, bf2f(u.y), d); d = fmaf(xr[i].z, bf2f(u.z), d); d = fmaf(xr[i].w, bf2f(u.w), d);
        }
        d = wave_sum(d);
        const float act = 0.5f * d * (1.0f + erff(d * 0.7071067811865476f));
        const float cf = gt * act;
#pragma unroll
        for (int i = 0; i < 8; ++i) {
            const ushort4 v = *(const ushort4*)(vr + i * 256 + lane * 4);
            acc[i].x = fmaf(cf, bf2f(v.x), acc[i].x); acc[i].y = fmaf(cf, bf2f(v.y), acc[i].y); acc[i].z = fmaf(cf, bf2f(v.z), acc[i].z); acc[i].w = fmaf(cf, bf2f(v.w), acc[i].w);
        }
    }
    __syncthreads();
#pragma unroll
    for (int i = 0; i < 8; ++i) *(float4*)&part[w][i * 256 + lane * 4] = acc[i];
    __syncthreads();
    float4 r0, r1;
    {
        const float4 a = *(const float4*)&part[0][tid * 4], b = *(const float4*)&part[1][tid * 4], c = *(const float4*)&part[2][tid * 4], d = *(const float4*)&part[3][tid * 4];
        const float4 x = *(const float4*)(x2 + (size_t)t * D + tid * 4);
        r0 = make_float4(x.x + a.x + b.x + c.x + d.x, x.y + a.y + b.y + c.y + d.y, x.z + a.z + b.z + c.z + d.z, x.w + a.w + b.w + c.w + d.w);
    }
    {
        const float4 a = *(const float4*)&part[0][1024 + tid * 4], b = *(const float4*)&part[1][1024 + tid * 4], c = *(const float4*)&part[2][1024 + tid * 4], d = *(const float4*)&part[3][1024 + tid * 4];
        const float4 x = *(const float4*)(x2 + (size_t)t * D + 1024 + tid * 4);
        r1 = make_float4(x.x + a.x + b.x + c.x + d.x, x.y + a.y + b.y + c.y + d.y, x.z + a.z + b.z + c.z + d.z, x.w + a.w + b.w + c.w + d.w);
    }
    float s = r0.x * r0.x + r0.y * r0.y + r0.z * r0.z + r0.w * r0.w + r1.x * r1.x + r1.y * r1.y + r1.z * r1.z + r1.w * r1.w;
    s = wave_sum(s);
    if (lane == 0) red[w] = s;
    __syncthreads();
    const float tot = red[0] + red[1] + red[2] + red[3];
    const float r = rsqrtf(tot * (1.0f / D) + EPS);
    const float4 g0 = *(const float4*)(g_final + tid * 4), g1 = *(const float4*)(g_final + 1024 + tid * 4);
    *(float4*)(out + (size_t)t * D + tid * 4) = make_float4(r0.x * r * g0.x, r0.y * r * g0.y, r0.z * r * g0.z, r0.w * r * g0.w);
    *(float4*)(out + (size_t)t * D + 1024 + tid * 4) = make_float4(r1.x * r * g1.x, r1.y * r * g1.y, r1.z * r * g1.z, r1.w * r * g1.w);
}


__device__ __forceinline__ float wave_sum_dpp(float v);
__device__ __forceinline__ void rmsnorm_row_wave(int row, int lane, const float* __restrict__ in, const float* __restrict__ g, bf16_t* __restrict__ out, const float* gwT, float* __restrict__ gpre) {
    float4 x[8];
    const float* p = in + (size_t)row * D + lane * 4;
#pragma unroll
    for (int i = 0; i < 8; ++i) x[i] = *(const float4*)(p + i * 256);
    float s = 0.f;
#pragma unroll
    for (int i = 0; i < 8; ++i) s += (x[i].x * x[i].x + x[i].y * x[i].y) + (x[i].z * x[i].z + x[i].w * x[i].w);
    s = wave_sum_dpp(s);
    const float r = rsqrtf(s * (1.0f / D) + EPS);
    bf16_t* o = out + (size_t)row * D + lane * 4;
#pragma unroll
    for (int i = 0; i < 8; ++i) {
        const float4 gv = *(const float4*)(g + i * 256 + lane * 4);
        x[i].x *= r * gv.x; x[i].y *= r * gv.y; x[i].z *= r * gv.z; x[i].w *= r * gv.w;
        uint2 w; w.x = pk2(x[i].x, x[i].y); w.y = pk2(x[i].z, x[i].w);
        *(uint2*)(o + i * 256) = w;
    }
    if (gpre) {
#pragma unroll 1
        for (int c = 0; c < 8; c += 2) {
            float a0 = 0.f, a1 = 0.f;
#pragma unroll
            for (int i = 0; i < 8; ++i) {
                const float4 w0 = *(const float4*)(gwT + c * 2048 + i * 256 + lane * 4), w1 = *(const float4*)(gwT + (c + 1) * 2048 + i * 256 + lane * 4);
                a0 = fmaf(x[i].x, w0.x, a0); a0 = fmaf(x[i].y, w0.y, a0); a0 = fmaf(x[i].z, w0.z, a0); a0 = fmaf(x[i].w, w0.w, a0);
                a1 = fmaf(x[i].x, w1.x, a1); a1 = fmaf(x[i].y, w1.y, a1); a1 = fmaf(x[i].z, w1.z, a1); a1 = fmaf(x[i].w, w1.w, a1);
            }
            const float t0_ = wave_sum_dpp(a0), t1_ = wave_sum_dpp(a1);
            if (lane == 0) { gpre[(size_t)row * 8 + c] = t0_; gpre[(size_t)row * 8 + c + 1] = t1_; }
        }
    }
}

__device__ __forceinline__ void conv_silu_run(int tokbase, int cg8, const bf16_t* __restrict__ min_, const float* __restrict__ cw, const float* __restrict__ cb, bf16_t* __restrict__ c) {
    float w[4][8], bias[8];
#pragma unroll
    for (int j = 0; j < 4; ++j) { const float4 a = *(const float4*)(cw + j * 1024 + cg8 * 8), b = *(const float4*)(cw + j * 1024 + cg8 * 8 + 4);
        w[j][0] = a.x; w[j][1] = a.y; w[j][2] = a.z; w[j][3] = a.w; w[j][4] = b.x; w[j][5] = b.y; w[j][6] = b.z; w[j][7] = b.w; }
    { const float4 a = *(const float4*)(cb + cg8 * 8), b = *(const float4*)(cb + cg8 * 8 + 4); bias[0] = a.x; bias[1] = a.y; bias[2] = a.z; bias[3] = a.w; bias[4] = b.x; bias[5] = b.y; bias[6] = b.z; bias[7] = b.w; }
    const int s0 = tokbase & (S - 1);
    uint4 rows[11];
#pragma unroll
    for (int i = 0; i < 11; ++i) { const int ss = s0 - 3 + i; rows[i] = ss >= 0 ? *(const uint4*)(min_ + (size_t)(tokbase - 3 + i) * 1024 + cg8 * 8) : make_uint4(0u, 0u, 0u, 0u); }
#pragma unroll
    for (int t = 0; t < 8; ++t) {
        float y[8];
#pragma unroll
        for (int k = 0; k < 8; ++k) y[k] = bias[k];
#pragma unroll
        for (int j = 0; j < 4; ++j) {
            const uint4 r = rows[t + j]; const unsigned rw[4] = {r.x, r.y, r.z, r.w};
#pragma unroll
            for (int k = 0; k < 4; ++k) { y[2 * k] = fmaf(w[j][2 * k], __uint_as_float(rw[k] << 16), y[2 * k]); y[2 * k + 1] = fmaf(w[j][2 * k + 1], __uint_as_float(rw[k] & 0xFFFF0000u), y[2 * k + 1]); }
        }
        uint4 o;
#pragma unroll
        for (int k = 0; k < 8; ++k) y[k] = y[k] / (1.0f + __expf(-y[k]));
        o.x = pk2(y[0], y[1]); o.y = pk2(y[2], y[3]); o.z = pk2(y[4], y[5]); o.w = pk2(y[6], y[7]);
        *(uint4*)(c + (size_t)(tokbase + t) * 1024 + cg8 * 8) = o;
    }
}

__device__ __forceinline__ float wave_incl_scan_add(float v, int lane) {
#pragma unroll
    for (int o = 1; o < 64; o <<= 1) { const float t = __shfl_up(v, o); if (lane >= o) v += t; }
    return v;
}
__device__ __forceinline__ float wave_incl_scan_max(float v, int lane) {
#pragma unroll
    for (int o = 1; o < 64; o <<= 1) { const float t = __shfl_up(v, o); if (lane >= o) v = fmaxf(v, t); }
    return v;
}
__device__ __forceinline__ void mlstm_gates_wave(int b, int h, int lane, const float* __restrict__ gpre, const float* __restrict__ b_mi, const float* __restrict__ b_mf,
                                                 float* __restrict__ gs, float* __restrict__ decay) {
    const float bi = b_mi[h], bf = b_mf[h];
    float mprev = 0.f;
    float gi_n[4], gf_n[4];
#pragma unroll
    for (int j = 0; j < 4; ++j) { const size_t t = (size_t)b * S + lane * 4 + j; gi_n[j] = gpre[t * 8 + h]; gf_n[j] = gpre[t * 8 + 4 + h]; }
#pragma unroll 1
    for (int c = 0; c < 16; ++c) {
        const size_t t0 = (size_t)b * S + c * 256 + lane * 4;
        float logi[4], lf[4], bb[4], gf_c[4];
#pragma unroll
        for (int j = 0; j < 4; ++j) { logi[j] = gi_n[j] + bi; gf_c[j] = gf_n[j]; }
        if (c < 15) {
#pragma unroll
            for (int j = 0; j < 4; ++j) { gi_n[j] = gpre[(t0 + 256 + j) * 8 + h]; gf_n[j] = gpre[(t0 + 256 + j) * 8 + 4 + h]; }
        }
#pragma unroll
        for (int j = 0; j < 4; ++j) lf[j] = log_sigmoid(gf_c[j] + bf);
        bb[0] = lf[0]; bb[1] = bb[0] + lf[1]; bb[2] = bb[1] + lf[2]; bb[3] = bb[2] + lf[3];
        const float incl = wave_incl_scan_add(bb[3], lane);
        const float excl = incl - bb[3];
#pragma unroll
        for (int j = 0; j < 4; ++j) bb[j] += excl;
        const float g = __shfl(incl, 63);
        float amax = -INFINITY, uu[4], cm[4];
#pragma unroll
        for (int j = 0; j < 4; ++j) { amax = fmaxf(amax, logi[j] + g - bb[j]); uu[j] = logi[j] - bb[j]; }
        amax = wave_max(amax);
        const float mnew = fmaxf(g + mprev, amax);
        cm[0] = uu[0]; cm[1] = fmaxf(cm[0], uu[1]); cm[2] = fmaxf(cm[1], uu[2]); cm[3] = fmaxf(cm[2], uu[3]);
        const float cincl = wave_incl_scan_max(cm[3], lane);
        float cexcl = __shfl_up(cincl, 1); if (lane == 0) cexcl = -INFINITY;
#pragma unroll
        for (int j = 0; j < 4; ++j) {
            const float M = fmaxf(mprev, fmaxf(cexcl, cm[j]));
            float* o = gs + ((t0 + j) * 4 + h) * 8;
            o[0] = uu[j] * 1.4426950408889634f; o[1] = M * 1.4426950408889634f; o[2] = expf(logi[j] + g - bb[j] - mnew); o[3] = expf(mprev - M); o[4] = expf(-(bb[j] + M));
        }
        if (lane == 0) decay[(b * 16 + c) * 4 + h] = expf(g + mprev - mnew);
        mprev = mnew;
    }
}
__device__ __forceinline__ void transpose_tile64(int tid, float* sm, const bf16_t* __restrict__ src, int src_ld, bf16_t* __restrict__ dst, int dst_ld, const float* __restrict__ scale, int sstride) {
    typedef unsigned u32x4_t __attribute__((ext_vector_type(4)));
    typedef short s16x4_t __attribute__((ext_vector_type(4)));
    LAS unsigned short* tl = (LAS unsigned short*)(LAS unsigned char*)sm;
    __syncthreads();
#pragma unroll
    for (int i = 0; i < 2; ++i) {
        const int ch = tid + i * 256, r = ch >> 3, c8 = (ch & 7) * 8;
        uint4 v = *(const uint4*)(src + (size_t)r * src_ld + c8);
        if (scale) {
            const float sc = scale[(size_t)r * sstride];
            unsigned w[4] = {v.x, v.y, v.z, v.w};
#pragma unroll
            for (int k = 0; k < 4; ++k) w[k] = pk2(__uint_as_float(w[k] << 16) * sc, __uint_as_float(w[k] & 0xFFFF0000u) * sc);
            v = make_uint4(w[0], w[1], w[2], w[3]);
        }
        *(LAS u32x4_t*)(tl + r * 72 + c8) = (u32x4_t){v.x, v.y, v.z, v.w};
    }
    __syncthreads();
    {
        const int G = tid >> 4, i = tid & 15, cb = G >> 2, rb = G & 3, q = i >> 2, p = i & 3;
        const int c0 = 16 * cb, r0 = 16 * rb;
        unsigned o[8];
#pragma unroll
        for (int m = 0; m < 4; ++m) {
            const s16x4_t t4 = __builtin_amdgcn_ds_read_tr16_b64_v4i16((LAS s16x4_t*)(tl + (r0 + 4 * m + q) * 72 + c0 + 4 * p));
            o[2 * m] = (unsigned)(unsigned short)t4[0] | ((unsigned)(unsigned short)t4[1] << 16);
            o[2 * m + 1] = (unsigned)(unsigned short)t4[2] | ((unsigned)(unsigned short)t4[3] << 16);
        }
        bf16_t* d = dst + (size_t)(c0 + i) * dst_ld + r0;
        *(uint4*)d = make_uint4(o[0], o[1], o[2], o[3]); *(uint4*)(d + 8) = make_uint4(o[4], o[5], o[6], o[7]);
    }
}

__device__ __forceinline__ void rope_table_fill(float2* __restrict__ cs, int gtid, int nth) {
    for (int idx = gtid; idx < 4096 * 64; idx += nth) {
        const int i = idx & 63, s = idx >> 6;
        const float inv = exp2f(-(float)i * 0.20762050593046014f);
        const float ang = (float)s * inv;
        float sn, c; sincosf(ang, &sn, &c);
        cs[idx] = make_float2(c, sn);
    }
}
__device__ __forceinline__ void rope_q_pass(bf16_t* __restrict__ aq, const float2* __restrict__ cs, size_t gtid, size_t nth) {
    for (size_t idx = gtid; idx < (size_t)T * 8 * 8; idx += nth) {
        const int c8 = (int)(idx & 7), hd = (int)((idx >> 3) & 7); const size_t t = idx >> 6; const int s = (int)(t & (S - 1));
        bf16_t* p = aq + t * 1024 + hd * 128 + c8 * 8;
        const uint4 a = *(const uint4*)p, b = *(const uint4*)(p + 64);
        const unsigned aw[4] = {a.x, a.y, a.z, a.w}, bw[4] = {b.x, b.y, b.z, b.w};
        unsigned ao[4], bo[4];
#pragma unroll
        for (int k = 0; k < 4; ++k) {
            const float4 cc = *(const float4*)(cs + (size_t)s * 64 + c8 * 8 + 2 * k);
            const float x10 = __uint_as_float(aw[k] << 16), x11 = __uint_as_float(aw[k] & 0xFFFF0000u), x20 = __uint_as_float(bw[k] << 16), x21 = __uint_as_float(bw[k] & 0xFFFF0000u);
            ao[k] = pk2(x10 * cc.x - x20 * cc.y, x11 * cc.z - x21 * cc.w);
            bo[k] = pk2(x20 * cc.x + x10 * cc.y, x21 * cc.z + x11 * cc.w);
        }
        *(uint4*)p = make_uint4(ao[0], ao[1], ao[2], ao[3]); *(uint4*)(p + 64) = make_uint4(bo[0], bo[1], bo[2], bo[3]);
    }
}
__device__ __forceinline__ void dil_tile_prep(int item, int lane, LAS unsigned short* wl, const bf16_t* __restrict__ ak, const bf16_t* __restrict__ av, const float2* __restrict__ cs,
                                              bf16_t* __restrict__ KB, bf16_t* __restrict__ VB) {
    const int TT = item & 255, hd = (item >> 8) & 7, b = (item >> 11) & 1, br = item >> 12;
    const int ld = 2 * br, tpr = 256 >> ld, rho = TT / tpr, tile = TT - rho * tpr;
    const int i = lane & 15, c = lane >> 4;
    const int s = rho + ((16 * tile + i) << ld);
    const size_t trow = (size_t)b * S + s;
    bf16_t* kdst = KB + (size_t)item * 2048;
    bf16_t* vdst = VB + (size_t)item * 2048;
    {
        const bf16_t* kr = ak + trow * 1024 + hd * 128 + 16 * c;
        const uint4 a0 = *(const uint4*)kr, a1 = *(const uint4*)(kr + 8), b0 = *(const uint4*)(kr + 64), b1 = *(const uint4*)(kr + 72);
        const unsigned aw[8] = {a0.x, a0.y, a0.z, a0.w, a1.x, a1.y, a1.z, a1.w}, bw[8] = {b0.x, b0.y, b0.z, b0.w, b1.x, b1.y, b1.z, b1.w};
        unsigned ao[8], bo[8];
#pragma unroll
        for (int k = 0; k < 8; ++k) {
            const float4 cc = *(const float4*)(cs + (size_t)s * 64 + 16 * c + 2 * k);
            const float x10 = __uint_as_float(aw[k] << 16), x11 = __uint_as_float(aw[k] & 0xFFFF0000u), x20 = __uint_as_float(bw[k] << 16), x21 = __uint_as_float(bw[k] & 0xFFFF0000u);
            ao[k] = pk2(x10 * cc.x - x20 * cc.y, x11 * cc.z - x21 * cc.w);
            bo[k] = pk2(x20 * cc.x + x10 * cc.y, x21 * cc.z + x11 * cc.w);
        }
        bf16_t* d0 = kdst + (c >> 1) * 512 + i * 32 + (c & 1) * 16;
        *(uint4*)d0 = make_uint4(ao[0], ao[1], ao[2], ao[3]); *(uint4*)(d0 + 8) = make_uint4(ao[4], ao[5], ao[6], ao[7]);
        bf16_t* d1 = d0 + 1024;
        *(uint4*)d1 = make_uint4(bo[0], bo[1], bo[2], bo[3]); *(uint4*)(d1 + 8) = make_uint4(bo[4], bo[5], bo[6], bo[7]);
    }
    {
        const bf16_t* vr = av + trow * 1024 + hd * 128 + 32 * c;
        const uint4 v0 = *(const uint4*)vr, v1 = *(const uint4*)(vr + 8), v2 = *(const uint4*)(vr + 16), v3 = *(const uint4*)(vr + 24);
        LAS unsigned short* wr = wl + i * 136 + 32 * c;
        typedef unsigned u32x4_t __attribute__((ext_vector_type(4)));
        *(LAS u32x4_t*)wr = (u32x4_t){v0.x, v0.y, v0.z, v0.w}; *(LAS u32x4_t*)(wr + 8) = (u32x4_t){v1.x, v1.y, v1.z, v1.w};
        *(LAS u32x4_t*)(wr + 16) = (u32x4_t){v2.x, v2.y, v2.z, v2.w}; *(LAS u32x4_t*)(wr + 24) = (u32x4_t){v3.x, v3.y, v3.z, v3.w};
        asm volatile("s_waitcnt lgkmcnt(0)" ::: "memory");
        unsigned o[16];
#pragma unroll
        for (int k = 0; k < 8; ++k) {
            const unsigned p0 = *(const LAS unsigned*)(wl + (2 * k) * 136 + 2 * lane), p1 = *(const LAS unsigned*)(wl + (2 * k + 1) * 136 + 2 * lane);
            o[k] = (p0 & 0xFFFFu) | (p1 << 16);
            o[8 + k] = (p0 >> 16) | (p1 & 0xFFFF0000u);
        }
        bf16_t* d = vdst + (2 * lane) * 16;
        *(uint4*)d = make_uint4(o[0], o[1], o[2], o[3]); *(uint4*)(d + 8) = make_uint4(o[4], o[5], o[6], o[7]);
        *(uint4*)(d + 16) = make_uint4(o[8], o[9], o[10], o[11]); *(uint4*)(d + 24) = make_uint4(o[12], o[13], o[14], o[15]);
        asm volatile("s_waitcnt lgkmcnt(0)" ::: "memory");
    }
}

typedef short bf16x8_t __attribute__((ext_vector_type(8)));
typedef short bf16x4_t __attribute__((ext_vector_type(4)));
typedef float f32x4_t __attribute__((ext_vector_type(4)));
__device__ __forceinline__ float xg_max_f32(float v);
__device__ __forceinline__ float xg_sum_f32(float v);
__device__ __forceinline__ void dilated_wave_tile(int qt2, int lane, const bf16_t* __restrict__ AQ, const float2* __restrict__ cs, const bf16_t* __restrict__ KB, const bf16_t* __restrict__ VB,
                                                  const float* __restrict__ g_ahead, bf16_t* __restrict__ mix) {
    const int r = qt2 & 7, blk = (qt2 >> 3) & 15, hd = (qt2 >> 7) & 7, b = qt2 >> 10;
    const int j = lane & 15, g = lane >> 4;
    const int t0 = blk * 256;
    bf16x8_t qf[2][4];
#pragma unroll
    for (int qi = 0; qi < 2; ++qi) {
        const int sq = t0 + r + 8 * qi + 16 * j;
        const bf16_t* qrow = AQ + ((size_t)b * S + sq) * 1024 + hd * 128 + 8 * g;
        const float sc = 0.08838834764831845f * 1.4426950408889634f;
#pragma unroll
        for (int ks = 0; ks < 2; ++ks) {
            const bf16x8_t lo = *(const bf16x8_t*)(qrow + 32 * ks), hi = *(const bf16x8_t*)(qrow + 32 * ks + 64);
            bf16x8_t olo, ohi;
#pragma unroll
            for (int e2 = 0; e2 < 4; ++e2) {
                const float4 cc = *(const float4*)(cs + (size_t)sq * 64 + 32 * ks + 8 * g + 2 * e2);
                const float x10 = bf2f((unsigned short)lo[2 * e2]), x11 = bf2f((unsigned short)lo[2 * e2 + 1]), x20 = bf2f((unsigned short)hi[2 * e2]), x21 = bf2f((unsigned short)hi[2 * e2 + 1]);
                const unsigned wl_ = pk2((x10 * cc.x - x20 * cc.y) * sc, (x11 * cc.z - x21 * cc.w) * sc), wh_ = pk2((x20 * cc.x + x10 * cc.y) * sc, (x21 * cc.z + x11 * cc.w) * sc);
                olo[2 * e2] = (short)(wl_ & 0xFFFF); olo[2 * e2 + 1] = (short)(wl_ >> 16); ohi[2 * e2] = (short)(wh_ & 0xFFFF); ohi[2 * e2 + 1] = (short)(wh_ >> 16);
            }
            qf[qi][ks] = olo; qf[qi][ks + 2] = ohi;
        }
    }
    float m_run[2] = {-1e30f, -1e30f}, l_run[2] = {0.f, 0.f};
    f32x4_t o[2][8];
#pragma unroll
    for (int qi = 0; qi < 2; ++qi)
#pragma unroll
        for (int dt = 0; dt < 8; ++dt) o[qi][dt] = (f32x4_t){0.f, 0.f, 0.f, 0.f};
#define DIL_STEP(QI, QJ, TP, KF, VF) { \
        f32x4_t su[2]; \
        _Pragma("unroll") for (int u = 0; u < 2; ++u) { f32x4_t a = (f32x4_t){0.f, 0.f, 0.f, 0.f}; \
            _Pragma("unroll") for (int ks = 0; ks < 4; ++ks) a = __builtin_amdgcn_mfma_f32_16x16x32_bf16(KF[u][ks], qf[QI][ks], a, 0, 0, 0); su[u] = a; } \
        float p[2][4]; float mx = -1e30f; \
        _Pragma("unroll") for (int u = 0; u < 2; ++u) _Pragma("unroll") for (int e = 0; e < 4; ++e) { \
            const int n = (QJ) - (16 * ((TP) + u) + 4 * g + e); const bool valid = (n >= 0) && (n <= 128); \
            p[u][e] = valid ? su[u][e] : -1e30f; mx = fmaxf(mx, p[u][e]); } \
        mx = xg_max_f32(mx); \
        const float m_new = fmaxf(m_run[QI], mx); const float alpha = __builtin_amdgcn_exp2f(m_run[QI] - m_new); m_run[QI] = m_new; \
        float ps = 0.f; \
        _Pragma("unroll") for (int u = 0; u < 2; ++u) _Pragma("unroll") for (int e = 0; e < 4; ++e) { p[u][e] = (p[u][e] > -1e29f) ? __builtin_amdgcn_exp2f(p[u][e] - m_new) : 0.f; ps += p[u][e]; } \
        l_run[QI] = l_run[QI] * alpha + ps; \
        bf16x8_t pb; { const unsigned w0 = pk2(p[0][0], p[0][1]), w1 = pk2(p[0][2], p[0][3]), w2 = pk2(p[1][0], p[1][1]), w3 = pk2(p[1][2], p[1][3]); \
            pb[0] = (short)(w0 & 0xFFFF); pb[1] = (short)(w0 >> 16); pb[2] = (short)(w1 & 0xFFFF); pb[3] = (short)(w1 >> 16); \
            pb[4] = (short)(w2 & 0xFFFF); pb[5] = (short)(w2 >> 16); pb[6] = (short)(w3 & 0xFFFF); pb[7] = (short)(w3 >> 16); } \
        _Pragma("unroll") for (int dt = 0; dt < 8; ++dt) { const bf16x4_t v0 = VF[dt][0], v1 = VF[dt][1]; \
            bf16x8_t va; va[0] = v0[0]; va[1] = v0[1]; va[2] = v0[2]; va[3] = v0[3]; va[4] = v1[0]; va[5] = v1[1]; va[6] = v1[2]; va[7] = v1[3]; \
            f32x4_t oo = o[QI][dt]; oo = oo * alpha; o[QI][dt] = __builtin_amdgcn_mfma_f32_16x16x32_bf16(va, pb, oo, 0, 0, 0); } }
#define DIL_LOADK(KF, TL) _Pragma("unroll") for (int u = 0; u < 2; ++u) { int tl_ = (TL) + u; if (tl_ > tile_max) tl_ = tile_max; \
            _Pragma("unroll") for (int ks = 0; ks < 4; ++ks) KF[u][ks] = *(const bf16x8_t*)(kbb + (size_t)tl_ * 2048 + 512 * ks); }
#define DIL_LOADV(VF, TP) { int tl0 = (TP), tl1 = (TP) + 1; if (tl0 > tile_max) tl0 = tile_max; if (tl1 > tile_max) tl1 = tile_max; \
            _Pragma("unroll") for (int dt = 0; dt < 8; ++dt) { VF[dt][0] = *(const bf16x4_t*)(vbb + dt * 256 + (size_t)tl0 * 2048); VF[dt][1] = *(const bf16x4_t*)(vbb + dt * 256 + (size_t)tl1 * 2048); } }
#pragma nounroll
    for (int br = 0; br < 2; ++br) {
        const int ld = 2 * br, d = 1 << ld;
        const int rho = r & (d - 1);
        const int qj0 = (t0 + r + 16 * j - rho) >> ld, qj1 = (t0 + r + 8 + 16 * j - rho) >> ld;
        const int q_lo = ((t0 + r - rho) >> ld) - 128, q_hi = (t0 + r + 8 + 240 - rho) >> ld;
        const int tile_lo = q_lo < 0 ? 0 : (q_lo >> 4), tile_hi = q_hi >> 4, tile_max = (256 >> ld) - 1;
        const size_t tbase = ((size_t)((br * 2 + b) * 8 + hd) * 256 + (size_t)rho * (256 >> ld)) * 2048;
        const bf16_t* kbb = KB + tbase + j * 32 + 8 * g;
        const bf16_t* vbb = VB + tbase + j * 16 + 4 * g;
        bf16x8_t kf[2][4];
        DIL_LOADK(kf, tile_lo)
#pragma nounroll
        for (int tp = tile_lo; tp <= tile_hi; tp += 2) {
            bf16x4_t vf[8][2];
            DIL_LOADV(vf, tp)
            bf16x8_t kc[2][4];
#pragma unroll
            for (int u = 0; u < 2; ++u)
#pragma unroll
                for (int ks = 0; ks < 4; ++ks) kc[u][ks] = kf[u][ks];
            DIL_LOADK(kf, tp + 2)
            DIL_STEP(0, qj0, tp, kc, vf)
            DIL_STEP(1, qj1, tp, kc, vf)
        }
    }
#pragma unroll
    for (int qi = 0; qi < 2; ++qi) {
        const int rho = r + 8 * qi;
        const int qj = (t0 + 16 * j) >> 4;
        const int q_lo = (t0 >> 4) - 128, q_hi = (t0 + 240) >> 4;
        const int tile_lo = q_lo < 0 ? 0 : (q_lo >> 4), tile_hi = q_hi >> 4, tile_max = 15;
        const size_t tbase = ((size_t)((2 * 2 + b) * 8 + hd) * 256 + (size_t)rho * 16) * 2048;
        const bf16_t* kbb = KB + tbase + j * 32 + 8 * g;
        const bf16_t* vbb = VB + tbase + j * 16 + 4 * g;
        bf16x8_t kf[2][4];
        DIL_LOADK(kf, tile_lo)
#pragma nounroll
        for (int tp = tile_lo; tp <= tile_hi; tp += 2) {
            bf16x4_t vf[8][2];
            DIL_LOADV(vf, tp)
            bf16x8_t kc[2][4];
#pragma unroll
            for (int u = 0; u < 2; ++u)
#pragma unroll
                for (int ks = 0; ks < 4; ++ks) kc[u][ks] = kf[u][ks];
            DIL_LOADK(kf, tp + 2)
            if (qi == 0) { DIL_STEP(0, qj, tp, kc, vf) } else { DIL_STEP(1, qj, tp, kc, vf) }
        }
    }
#undef DIL_STEP
#undef DIL_LOADK
#undef DIL_LOADV
#pragma unroll
    for (int qi = 0; qi < 2; ++qi) {
        const int sq = t0 + r + 8 * qi + 16 * j;
        const float inv = 1.0f / xg_sum_f32(l_run[qi]);
        float ss = 0.f;
#pragma unroll
        for (int dt = 0; dt < 8; ++dt) { o[qi][dt] = o[qi][dt] * inv; ss += (o[qi][dt][0] * o[qi][dt][0] + o[qi][dt][1] * o[qi][dt][1]) + (o[qi][dt][2] * o[qi][dt][2] + o[qi][dt][3] * o[qi][dt][3]); }
        ss = xg_sum_f32(ss);
        const float rn = rsqrtf(ss * (1.0f / 128.0f) + EPS);
        bf16_t* orow = mix + ((size_t)b * S + sq) * D + 1024 + hd * 128 + 4 * g;
#pragma unroll
        for (int dt = 0; dt < 8; ++dt) {
            const f32x4_t gv = *(const f32x4_t*)(g_ahead + hd * 128 + 16 * dt + 4 * g);
            uint2 w; w.x = pk2(o[qi][dt][0] * rn * gv[0], o[qi][dt][1] * rn * gv[1]); w.y = pk2(o[qi][dt][2] * rn * gv[2], o[qi][dt][3] * rn * gv[3]);
            *(uint2*)(orow + 16 * dt) = w;
        }
    }
}

__device__ __forceinline__ unsigned ord_key(float s) { const unsigned u = __float_as_uint(s); return u ^ ((unsigned)((int)u >> 31) | 0x80000000u); }
__device__ __forceinline__ unsigned wave_max_u32(unsigned v) {
    unsigned t;
    t = (unsigned)__builtin_amdgcn_update_dpp(0, (int)v, 0xB1, 0xF, 0xF, true); v = v > t ? v : t;
    t = (unsigned)__builtin_amdgcn_update_dpp(0, (int)v, 0x4E, 0xF, 0xF, true); v = v > t ? v : t;
    t = (unsigned)__builtin_amdgcn_update_dpp(0, (int)v, 0x141, 0xF, 0xF, true); v = v > t ? v : t;
    t = (unsigned)__builtin_amdgcn_update_dpp(0, (int)v, 0x140, 0xF, 0xF, true); v = v > t ? v : t;
    const unsigned a = (unsigned)__builtin_amdgcn_readlane((int)v, 0), b = (unsigned)__builtin_amdgcn_readlane((int)v, 16),
                   c = (unsigned)__builtin_amdgcn_readlane((int)v, 32), d = (unsigned)__builtin_amdgcn_readlane((int)v, 48);
    const unsigned ab = a > b ? a : b, cd = c > d ? c : d;
    return ab > cd ? ab : cd;
}
__device__ __forceinline__ void peer_topk_wave(int item, int lane, LAS float* wl, const bf16_t* __restrict__ qp, const bf16_t* __restrict__ skb, int* __restrict__ ids, float* __restrict__ gates) {
    const int hd = item & 7, tt = item >> 3, j = lane & 15, g = lane >> 4;
    const size_t t0 = (size_t)tt * 16;
    LAS float* sc = wl;
    LAS float* lst = wl + 2048;
#pragma unroll 1
    for (int p = 0; p < 2; ++p) {
        bf16x8_t qf[4];
        const bf16_t* qrow = qp + (t0 + j) * D + hd * 256 + p * 128 + 8 * g;
#pragma unroll
        for (int ks = 0; ks < 4; ++ks) qf[ks] = *(const bf16x8_t*)(qrow + 32 * ks);
        const bf16_t* kb = skb + ((size_t)(hd * 2 + p) * 128 + j) * 128 + 8 * g;
#pragma unroll
        for (int kt = 0; kt < 8; ++kt) {
            f32x4_t a = (f32x4_t){0.f, 0.f, 0.f, 0.f};
#pragma unroll
            for (int ks = 0; ks < 4; ++ks) a = __builtin_amdgcn_mfma_f32_16x16x32_bf16(*(const bf16x8_t*)(kb + (size_t)kt * (16 * 128) + 32 * ks), qf[ks], a, 0, 0, 0);
            *(LAS f32x4_t*)(sc + j * 128 + 16 * kt + 4 * g) = a;
        }
        asm volatile("s_waitcnt lgkmcnt(0)" ::: "memory");
#pragma unroll 1
        for (int tok = 0; tok < 16; ++tok) {
            const float s0 = sc[tok * 128 + lane], s1 = sc[tok * 128 + 64 + lane];
            unsigned k0 = (ord_key(s0) & ~127u) | (unsigned)(127 - lane), k1 = (ord_key(s1) & ~127u) | (unsigned)(63 - lane);
            unsigned sel = 0u;
#pragma unroll 4
            for (int it = 0; it < 16; ++it) {
                unsigned m = k0 > k1 ? k0 : k1;
                m = wave_max_u32(m);
                if (lane == it) sel = m;
                if (k0 == m) k0 = 0u;
                if (k1 == m) k1 = 0u;
            }
            if (lane < 16) {
                const int idx = 127 - (int)(sel & 127u);
                lst[((p * 16 + tok) * 16 + lane) * 2 + 0] = sc[tok * 128 + idx];
                lst[((p * 16 + tok) * 16 + lane) * 2 + 1] = __int_as_float(idx);
            }
        }
        asm volatile("s_waitcnt lgkmcnt(0)" ::: "memory");
    }
#pragma unroll 1
    for (int tok = 0; tok < 16; ++tok) {
        const int i = lane >> 2;
        const float sA = lst[((0 * 16 + tok) * 16 + i) * 2];
        unsigned kk[4];
#pragma unroll
        for (int r = 0; r < 4; ++r) {
            const int jb = (lane & 3) * 4 + r;
            const float sum = sA + lst[((1 * 16 + tok) * 16 + jb) * 2];
            kk[r] = (ord_key(sum) & ~255u) | (unsigned)(255 - (lane * 4 + r));
        }
        unsigned sel = 0u;
#pragma unroll 4
        for (int it = 0; it < 16; ++it) {
            unsigned m = kk[0] > kk[1] ? kk[0] : kk[1]; const unsigned m2 = kk[2] > kk[3] ? kk[2] : kk[3]; m = m > m2 ? m : m2;
            m = wave_max_u32(m);
            if (lane == it) sel = m;
#pragma unroll
            for (int r = 0; r < 4; ++r) if (kk[r] == m) kk[r] = 0u;
        }
        float bs = -INFINITY; int eid = 0;
        if (lane < 16) {
            const int c = 255 - (int)(sel & 255u), ia = c >> 4, ib = c & 15;
            bs = lst[((0 * 16 + tok) * 16 + ia) * 2] + lst[((1 * 16 + tok) * 16 + ib) * 2];
            eid = __float_as_int(lst[((0 * 16 + tok) * 16 + ia) * 2 + 1]) * 128 + __float_as_int(lst[((1 * 16 + tok) * 16 + ib) * 2 + 1]);
        }
        const float mx = wave_max(bs);
        const float ev = lane < 16 ? __expf(bs - mx) : 0.f;
        const float tot = wave_sum(ev);
        if (lane < 16) {
            ids[(t0 + tok) * 128 + hd * 16 + lane] = eid;
            gates[(t0 + tok) * 128 + hd * 16 + lane] = ev / tot;
        }
    }
}

typedef float f32x2_t __attribute__((ext_vector_type(2)));
__device__ __forceinline__ float wave_max_all(float v) {
    v = fmaxf(v, __uint_as_float((unsigned)__builtin_amdgcn_update_dpp(0, (int)__float_as_uint(v), 0xB1, 0xF, 0xF, true)));
    v = fmaxf(v, __uint_as_float((unsigned)__builtin_amdgcn_update_dpp(0, (int)__float_as_uint(v), 0x4E, 0xF, 0xF, true)));
    v = fmaxf(v, __uint_as_float((unsigned)__builtin_amdgcn_update_dpp(0, (int)__float_as_uint(v), 0x141, 0xF, 0xF, true)));
    v = fmaxf(v, __uint_as_float((unsigned)__builtin_amdgcn_update_dpp(0, (int)__float_as_uint(v), 0x140, 0xF, 0xF, true)));
    auto a = __builtin_amdgcn_permlane16_swap(__float_as_uint(v), __float_as_uint(v), false, false); v = fmaxf(__uint_as_float(a[0]), __uint_as_float(a[1]));
    auto b = __builtin_amdgcn_permlane32_swap(__float_as_uint(v), __float_as_uint(v), false, false); return fmaxf(__uint_as_float(b[0]), __uint_as_float(b[1]));
}
template <bool I8> __device__ __forceinline__ void table_row_store(float4 (&f)[8], unsigned char* __restrict__ drow, float* __restrict__ rscale, int lane, const float* __restrict__ dgain) {
    if (I8) {
#pragma unroll
        for (int i = 0; i < 8; ++i) { const float4 gq = *(const float4*)(dgain + i * 256 + lane * 4); f[i].x *= gq.x; f[i].y *= gq.y; f[i].z *= gq.z; f[i].w *= gq.w; }
    }
    float am = 0.f;
#pragma unroll
    for (int i = 0; i < 8; ++i) am = fmaxf(am, fmaxf(fmaxf(fabsf(f[i].x), fabsf(f[i].y)), fmaxf(fabsf(f[i].z), fabsf(f[i].w))));
    am = wave_max_all(am);
    const float s = exp2f(fminf(floorf(log2f((I8 ? 127.0f : 448.0f) / fmaxf(am, 1e-30f))), 100.0f));
#pragma unroll
    for (int i = 0; i < 8; ++i) {
        unsigned w;
        if (I8) { const int q0 = __float2int_rn(f[i].x * s), q1 = __float2int_rn(f[i].y * s), q2 = __float2int_rn(f[i].z * s), q3 = __float2int_rn(f[i].w * s);
                  w = ((unsigned)q0 & 255u) | (((unsigned)q1 & 255u) << 8) | (((unsigned)q2 & 255u) << 16) | (((unsigned)q3 & 255u) << 24); }
        else { int t = 0; t = __builtin_amdgcn_cvt_pk_fp8_f32(f[i].x * s, f[i].y * s, t, false); t = __builtin_amdgcn_cvt_pk_fp8_f32(f[i].z * s, f[i].w * s, t, true); w = (unsigned)t; }
        *(unsigned*)(drow + i * 256 + lane * 4) = w;
    }
    if (lane == 0) *rscale = 1.0f / s;
}
__device__ __forceinline__ void table_row_to_fp8(const float* __restrict__ srow, unsigned char* __restrict__ drow, float* __restrict__ rscale, int lane, const float* __restrict__ dgain) {
    float4 f[8];
#pragma unroll
    for (int i = 0; i < 8; ++i) f[i] = *(const float4*)(srow + i * 256 + lane * 4);
    if (dgain) {
#pragma unroll
        for (int i = 0; i < 8; ++i) { const float4 gq = *(const float4*)(dgain + i * 256 + lane * 4); f[i].x *= gq.x; f[i].y *= gq.y; f[i].z *= gq.z; f[i].w *= gq.w; }
    }
    float am = 0.f;
#pragma unroll
    for (int i = 0; i < 8; ++i) am = fmaxf(am, fmaxf(fmaxf(fabsf(f[i].x), fabsf(f[i].y)), fmaxf(fabsf(f[i].z), fabsf(f[i].w))));
    am = wave_max(am);
    const float e = floorf(log2f(448.0f / fmaxf(am, 1e-30f)));
    const float s = exp2f(fminf(e, 100.0f));
    unsigned w[8];
#pragma unroll
    for (int i = 0; i < 8; ++i) {
        int t = 0;
        t = __builtin_amdgcn_cvt_pk_fp8_f32(f[i].x * s, f[i].y * s, t, false);
        t = __builtin_amdgcn_cvt_pk_fp8_f32(f[i].z * s, f[i].w * s, t, true);
        w[i] = (unsigned)t;
    }
#pragma unroll
    for (int i = 0; i < 8; ++i) *(unsigned*)(drow + i * 256 + lane * 4) = w[i];
    if (lane == 0) *rscale = 1.0f / s;
}
__device__ __forceinline__ void table_row_to_i8(const float* __restrict__ srow, unsigned char* __restrict__ drow, float* __restrict__ rscale, int lane, const float* __restrict__ dgain) {
    float4 f[8];
#pragma unroll
    for (int i = 0; i < 8; ++i) { f[i] = *(const float4*)(srow + i * 256 + lane * 4); const float4 gq = *(const float4*)(dgain + i * 256 + lane * 4); f[i].x *= gq.x; f[i].y *= gq.y; f[i].z *= gq.z; f[i].w *= gq.w; }
    float am = 0.f;
#pragma unroll
    for (int i = 0; i < 8; ++i) am = fmaxf(am, fmaxf(fmaxf(fabsf(f[i].x), fabsf(f[i].y)), fmaxf(fabsf(f[i].z), fabsf(f[i].w))));
    am = wave_max(am);
    const float s = exp2f(fminf(floorf(log2f(127.0f / fmaxf(am, 1e-30f))), 100.0f));
#pragma unroll
    for (int i = 0; i < 8; ++i) {
        const int q0 = __float2int_rn(f[i].x * s), q1 = __float2int_rn(f[i].y * s), q2 = __float2int_rn(f[i].z * s), q3 = __float2int_rn(f[i].w * s);
        *(unsigned*)(drow + i * 256 + lane * 4) = ((unsigned)q0 & 255u) | (((unsigned)q1 & 255u) << 8) | (((unsigned)q2 & 255u) << 16) | (((unsigned)q3 & 255u) << 24);
    }
    if (lane == 0) *rscale = 1.0f / s;
}
__device__ __forceinline__ float dot16_fp8(const uint4 q, const float* x) {
    float d = 0.f;
    const unsigned w[4] = {q.x, q.y, q.z, q.w};
#pragma unroll
    for (int k = 0; k < 4; ++k) {
        const f32x2_t lo = __builtin_amdgcn_cvt_pk_f32_fp8((int)w[k], false), hi = __builtin_amdgcn_cvt_pk_f32_fp8((int)w[k], true);
        d = fmaf(lo.x, x[4 * k], d); d = fmaf(lo.y, x[4 * k + 1], d); d = fmaf(hi.x, x[4 * k + 2], d); d = fmaf(hi.y, x[4 * k + 3], d);
    }
    return d;
}
__device__ __forceinline__ void axpy16_fp8(const uint4 q, float c, float* acc) {
    const unsigned w[4] = {q.x, q.y, q.z, q.w};
#pragma unroll
    for (int k = 0; k < 4; ++k) {
        const f32x2_t lo = __builtin_amdgcn_cvt_pk_f32_fp8((int)w[k], false), hi = __builtin_amdgcn_cvt_pk_f32_fp8((int)w[k], true);
        acc[4 * k] = fmaf(c, lo.x, acc[4 * k]); acc[4 * k + 1] = fmaf(c, lo.y, acc[4 * k + 1]); acc[4 * k + 2] = fmaf(c, hi.x, acc[4 * k + 2]); acc[4 * k + 3] = fmaf(c, hi.y, acc[4 * k + 3]);
    }
}
__device__ __forceinline__ void d_peer_out8(int vb, int tid, float* sm, const bf16_t* __restrict__ h3, const float* __restrict__ x2, const int* __restrict__ ids, const float* __restrict__ gates,
                                            const unsigned char* __restrict__ ut8, const unsigned char* __restrict__ vt8, const float* __restrict__ rsc, const float* __restrict__ rstd, const float* __restrict__ g_final, float* __restrict__ out) {
    float (*part)[2048] = (float (*)[2048])sm;
    float* red = sm + 4 * 2048;
    const int lane = tid & 63, w = tid >> 6, t = vb;
    float x[32], acc[32];
    {
        const bf16_t* hrow = h3 + (size_t)t * D + lane * 16;
#pragma unroll
        for (int hh = 0; hh < 2; ++hh) {
            const uint4 a = *(const uint4*)(hrow + hh * 1024), b = *(const uint4*)(hrow + hh * 1024 + 8);
            const unsigned ww[8] = {a.x, a.y, a.z, a.w, b.x, b.y, b.z, b.w};
#pragma unroll
            for (int k = 0; k < 8; ++k) { x[hh * 16 + 2 * k] = __uint_as_float(ww[k] << 16); x[hh * 16 + 2 * k + 1] = __uint_as_float(ww[k] & 0xFFFF0000u); }
        }
#pragma unroll
        for (int i = 0; i < 32; ++i) acc[i] = 0.f;
    }
    const float xrs = rstd[t];
    const int myid = ids[(size_t)t * 128 + w * 32 + (lane & 31)];
    const float mygate = gates[(size_t)t * 128 + w * 32 + (lane & 31)];
#pragma unroll 1
    for (int j = 0; j < 32; j += 4) {
        int e[4]; uint4 uq[4][2], vq[4][2];
#pragma unroll
        for (int q = 0; q < 4; ++q) {
            e[q] = __builtin_amdgcn_readfirstlane(__shfl(myid, j + q));
            const unsigned char* ur = ut8 + (size_t)e[q] * 2048 + lane * 16;
            uq[q][0] = *(const uint4*)ur; uq[q][1] = *(const uint4*)(ur + 1024);
        }
#pragma unroll
        for (int q = 0; q < 4; ++q) {
            const unsigned char* vr = vt8 + (size_t)e[q] * 2048 + lane * 16;
            vq[q][0] = *(const uint4*)vr; vq[q][1] = *(const uint4*)(vr + 1024);
        }
        float d[4];
#pragma unroll
        for (int q = 0; q < 4; ++q) d[q] = dot16_fp8(uq[q][0], x) + dot16_fp8(uq[q][1], x + 16);
#pragma unroll
        for (int o = 32; o >= 1; o >>= 1) {
#pragma unroll
            for (int q = 0; q < 4; ++q) d[q] += __shfl_xor(d[q], o);
        }
#pragma unroll
        for (int q = 0; q < 4; ++q) {
            const float a = d[q] * rsc[e[q]] * xrs;
            const float act = 0.5f * a * (1.0f + erff(a * 0.7071067811865476f));
            const float cf = __shfl(mygate, j + q) * act * rsc[16384 + e[q]];
            axpy16_fp8(vq[q][0], cf, acc); axpy16_fp8(vq[q][1], cf, acc + 16);
        }
    }
    __syncthreads();
#pragma unroll
    for (int hh = 0; hh < 2; ++hh)
#pragma unroll
        for (int k = 0; k < 4; ++k) *(float4*)&part[w][hh * 1024 + lane * 16 + 4 * k] = make_float4(acc[hh * 16 + 4 * k], acc[hh * 16 + 4 * k + 1], acc[hh * 16 + 4 * k + 2], acc[hh * 16 + 4 * k + 3]);
    __syncthreads();
    float4 r0, r1;
    {
        const float4 a = *(const float4*)&part[0][tid * 4], b = *(const float4*)&part[1][tid * 4], c = *(const float4*)&part[2][tid * 4], dd = *(const float4*)&part[3][tid * 4];
        const float4 xx = *(const float4*)(x2 + (size_t)t * D + tid * 4);
        r0 = make_float4(xx.x + a.x + b.x + c.x + dd.x, xx.y + a.y + b.y + c.y + dd.y, xx.z + a.z + b.z + c.z + dd.z, xx.w + a.w + b.w + c.w + dd.w);
    }
    {
        const float4 a = *(const float4*)&part[0][1024 + tid * 4], b = *(const float4*)&part[1][1024 + tid * 4], c = *(const float4*)&part[2][1024 + tid * 4], dd = *(const float4*)&part[3][1024 + tid * 4];
        const float4 xx = *(const float4*)(x2 + (size_t)t * D + 1024 + tid * 4);
        r1 = make_float4(xx.x + a.x + b.x + c.x + dd.x, xx.y + a.y + b.y + c.y + dd.y, xx.z + a.z + b.z + c.z + dd.z, xx.w + a.w + b.w + c.w + dd.w);
    }
    float s = r0.x * r0.x + r0.y * r0.y + r0.z * r0.z + r0.w * r0.w + r1.x * r1.x + r1.y * r1.y + r1.z * r1.z + r1.w * r1.w;
    s = wave_sum(s);
    if (lane == 0) red[w] = s;
    __syncthreads();
    const float tot = red[0] + red[1] + red[2] + red[3];
    const float r = rsqrtf(tot * (1.0f / D) + EPS);
    const float4 g0 = *(const float4*)(g_final + tid * 4), g1 = *(const float4*)(g_final + 1024 + tid * 4);
    *(float4*)(out + (size_t)t * D + tid * 4) = make_float4(r0.x * r * g0.x, r0.y * r * g0.y, r0.z * r * g0.z, r0.w * r * g0.w);
    *(float4*)(out + (size_t)t * D + 1024 + tid * 4) = make_float4(r1.x * r * g1.x, r1.y * r * g1.y, r1.z * r * g1.z, r1.w * r * g1.w);
}

__device__ __forceinline__ unsigned xg_sum_u32(unsigned v) {
    auto a = __builtin_amdgcn_permlane16_swap(v, v, false, false); v = a[0] + a[1];
    auto b = __builtin_amdgcn_permlane32_swap(v, v, false, false); return b[0] + b[1];
}
__device__ __forceinline__ float xg_sum_f32(float v) {
    auto a = __builtin_amdgcn_permlane16_swap(__float_as_uint(v), __float_as_uint(v), false, false); v = __uint_as_float(a[0]) + __uint_as_float(a[1]);
    auto b = __builtin_amdgcn_permlane32_swap(__float_as_uint(v), __float_as_uint(v), false, false); return __uint_as_float(b[0]) + __uint_as_float(b[1]);
}
__device__ __forceinline__ float xg_max_f32(float v) {
    auto a = __builtin_amdgcn_permlane16_swap(__float_as_uint(v), __float_as_uint(v), false, false); v = fmaxf(__uint_as_float(a[0]), __uint_as_float(a[1]));
    auto b = __builtin_amdgcn_permlane32_swap(__float_as_uint(v), __float_as_uint(v), false, false); return fmaxf(__uint_as_float(b[0]), __uint_as_float(b[1]));
}
template <int N> __device__ __forceinline__ unsigned bisect16(const unsigned (&kk)[N]) {
    unsigned tau = 0u; bool done = false;
#pragma unroll 1
    for (int bit = 31; bit >= 0; --bit) {
        const unsigned cand = tau | (1u << bit);
        unsigned c0 = 0u, c1 = 0u, c2 = 0u, c3 = 0u;
#pragma unroll
        for (int i = 0; i < N; i += 4) { c0 += (kk[i] >= cand) ? 1u : 0u; c1 += (kk[i + 1] >= cand) ? 1u : 0u; c2 += (kk[i + 2] >= cand) ? 1u : 0u; c3 += (kk[i + 3] >= cand) ? 1u : 0u; }
        unsigned c = xg_sum_u32((c0 + c1) + (c2 + c3));
        if (!done && c >= 16u) { tau = cand; done = (c == 16u); }
        if (__all(done ? 1 : 0)) break;
    }
    return tau;
}
__device__ __forceinline__ void peer_topk_wave2(int item, int lane, LAS float* wl, const bf16_t* __restrict__ qp, const bf16_t* __restrict__ skb, int* __restrict__ ids, float* __restrict__ gates) {
    const int hd = item & 7, tt = item >> 3, j = lane & 15, g = lane >> 4;
    const size_t t0 = (size_t)tt * 16;
#pragma unroll 1
    for (int p = 0; p < 2; ++p) {
        bf16x8_t qf[4];
        const bf16_t* qrow = qp + (t0 + j) * D + hd * 256 + p * 128 + 8 * g;
#pragma unroll
        for (int ks = 0; ks < 4; ++ks) qf[ks] = *(const bf16x8_t*)(qrow + 32 * ks);
        const bf16_t* kb = skb + ((size_t)(hd * 2 + p) * 128 + j) * 128 + 8 * g;
        float sc[32]; unsigned kk[32];
#pragma unroll
        for (int kt = 0; kt < 8; ++kt) {
            f32x4_t a = (f32x4_t){0.f, 0.f, 0.f, 0.f};
#pragma unroll
            for (int ks = 0; ks < 4; ++ks) a = __builtin_amdgcn_mfma_f32_16x16x32_bf16(*(const bf16x8_t*)(kb + (size_t)kt * (16 * 128) + 32 * ks), qf[ks], a, 0, 0, 0);
#pragma unroll
            for (int r = 0; r < 4; ++r) { sc[kt * 4 + r] = a[r]; kk[kt * 4 + r] = (ord_key(a[r]) & ~127u) | (unsigned)(127 - (16 * kt + 4 * g + r)); }
        }
        const unsigned tau = bisect16<32>(kk);
        unsigned cnt = 0u;
#pragma unroll
        for (int i = 0; i < 32; ++i) cnt += (kk[i] >= tau) ? 1u : 0u;
        const unsigned c0 = (unsigned)__shfl((int)cnt, j), c1 = (unsigned)__shfl((int)cnt, j + 16), c2 = (unsigned)__shfl((int)cnt, j + 32);
        unsigned off = (g > 0 ? c0 : 0u) + (g > 1 ? c1 : 0u) + (g > 2 ? c2 : 0u);
        LAS float* ls = wl + p * 256 + j * 16;
        LAS float* li = wl + 512 + p * 256 + j * 16;
#pragma unroll
        for (int i = 0; i < 32; ++i) {
            if (kk[i] >= tau && off < 16u) { ls[off] = sc[i]; li[off] = __int_as_float(16 * (i >> 2) + 4 * g + (i & 3)); ++off; }
        }
    }
    asm volatile("s_waitcnt lgkmcnt(0)" ::: "memory");
    {
        float sAll[2][16];
#pragma unroll
        for (int p = 0; p < 2; ++p)
#pragma unroll
            for (int q = 0; q < 4; ++q) { const f32x4_t b = *(const LAS f32x4_t*)(wl + p * 256 + j * 16 + 4 * q); sAll[p][4 * q] = b[0]; sAll[p][4 * q + 1] = b[1]; sAll[p][4 * q + 2] = b[2]; sAll[p][4 * q + 3] = b[3]; }
        f32x4_t myi[2];
#pragma unroll
        for (int p = 0; p < 2; ++p) myi[p] = *(const LAS f32x4_t*)(wl + 512 + p * 256 + j * 16 + 4 * g);
        unsigned rk[2][4];
#pragma unroll
        for (int p = 0; p < 2; ++p) {
            unsigned key[16];
#pragma unroll
            for (int k = 0; k < 16; ++k) key[k] = (ord_key(sAll[p][k]) & ~15u) | (unsigned)(15 - k);
            unsigned mine[4];
#pragma unroll
            for (int e = 0; e < 4; ++e) mine[e] = g == 0 ? key[e] : g == 1 ? key[4 + e] : g == 2 ? key[8 + e] : key[12 + e];
#pragma unroll
            for (int e = 0; e < 4; ++e) { unsigned c = 0u;
#pragma unroll
                for (int k = 0; k < 16; ++k) c += (key[k] > mine[e]) ? 1u : 0u;
                rk[p][e] = c; }
        }
#pragma unroll
        for (int p = 0; p < 2; ++p)
#pragma unroll
            for (int e = 0; e < 4; ++e) {
                const float sv = g == 0 ? sAll[p][e] : g == 1 ? sAll[p][4 + e] : g == 2 ? sAll[p][8 + e] : sAll[p][12 + e];
                wl[p * 256 + j * 16 + rk[p][e]] = sv; wl[512 + p * 256 + j * 16 + rk[p][e]] = myi[p][e];
            }
        asm volatile("s_waitcnt lgkmcnt(0)" ::: "memory");
        const unsigned t0w = g == 0 ? 0x03020100u : g == 1 ? 0x13121110u : g == 2 ? 0x23222120u : 0xB0A09080u;
        const unsigned t1w = g == 0 ? 0x07060504u : g == 1 ? 0x17161514u : g == 2 ? 0x42414024u : 0xF0E0D0C0u;
        const unsigned t2w = g == 0 ? 0x0B0A0908u : g == 1 ? 0x33323130u : g == 2 ? 0x71705150u : 0xFFFFFFFFu;
        const unsigned t3w = g == 0 ? 0x0F0E0D0Cu : g == 1 ? 0xFFFF6160u : g == 2 ? 0xFFFFFFFFu : 0xFFFFFFFFu;
        unsigned kk[16]; float sm16[16];
#pragma unroll
        for (int k = 0; k < 16; ++k) {
            const unsigned tw = (k >> 2) == 0 ? t0w : (k >> 2) == 1 ? t1w : (k >> 2) == 2 ? t2w : t3w;
            const unsigned byte = (tw >> (8 * (k & 3))) & 255u;
            const bool valid = byte != 255u;
            const unsigned ci = valid ? (byte >> 4) : 0u, cj = valid ? (byte & 15u) : 0u;
            const float sum = wl[j * 16 + ci] + wl[256 + j * 16 + cj];
            sm16[k] = sum;
            kk[k] = valid ? ((ord_key(sum) & ~63u) | (unsigned)(63 - (16 * g + k))) : 0u;
        }
        const unsigned tau = bisect16<16>(kk);
        float mx = -INFINITY; unsigned cnt = 0u;
#pragma unroll
        for (int k = 0; k < 16; ++k) if (kk[k] >= tau && kk[k] != 0u) { mx = fmaxf(mx, sm16[k]); ++cnt; }
        mx = xg_max_f32(mx);
        float es = 0.f;
#pragma unroll
        for (int k = 0; k < 16; ++k) if (kk[k] >= tau && kk[k] != 0u) es += __expf(sm16[k] - mx);
        const float inv = 1.0f / xg_sum_f32(es);
        const unsigned c0 = (unsigned)__shfl((int)cnt, j), c1 = (unsigned)__shfl((int)cnt, j + 16), c2 = (unsigned)__shfl((int)cnt, j + 32);
        unsigned off = (g > 0 ? c0 : 0u) + (g > 1 ? c1 : 0u) + (g > 2 ? c2 : 0u);
        int* idp = ids + (t0 + j) * 128 + hd * 16;
        float* gtp = gates + (t0 + j) * 128 + hd * 16;
#pragma unroll
        for (int k = 0; k < 16; ++k) {
            if (kk[k] >= tau && kk[k] != 0u && off < 16u) {
                const unsigned tw = (k >> 2) == 0 ? t0w : (k >> 2) == 1 ? t1w : (k >> 2) == 2 ? t2w : t3w;
                const unsigned byte = (tw >> (8 * (k & 3))) & 255u;
                idp[off] = __float_as_int(wl[512 + j * 16 + (byte >> 4)]) * 128 + __float_as_int(wl[512 + 256 + j * 16 + (byte & 15u)]);
                gtp[off] = __expf(sm16[k] - mx) * inv;
                ++off;
            }
        }
        asm volatile("s_waitcnt lgkmcnt(0)" ::: "memory");
    }
}

__device__ __forceinline__ float wave_sum_dpp(float v) {
    v += __uint_as_float((unsigned)__builtin_amdgcn_update_dpp(0, (int)__float_as_uint(v), 0xB1, 0xF, 0xF, true));
    v += __uint_as_float((unsigned)__builtin_amdgcn_update_dpp(0, (int)__float_as_uint(v), 0x4E, 0xF, 0xF, true));
    v += __uint_as_float((unsigned)__builtin_amdgcn_update_dpp(0, (int)__float_as_uint(v), 0x141, 0xF, 0xF, true));
    v += __uint_as_float((unsigned)__builtin_amdgcn_update_dpp(0, (int)__float_as_uint(v), 0x140, 0xF, 0xF, true));
    const float a = __uint_as_float((unsigned)__builtin_amdgcn_readlane((int)__float_as_uint(v), 0)), b = __uint_as_float((unsigned)__builtin_amdgcn_readlane((int)__float_as_uint(v), 16)),
                c = __uint_as_float((unsigned)__builtin_amdgcn_readlane((int)__float_as_uint(v), 32)), d = __uint_as_float((unsigned)__builtin_amdgcn_readlane((int)__float_as_uint(v), 48));
    return (a + b) + (c + d);
}
typedef __bf16 bf16x2v_t __attribute__((ext_vector_type(2)));
__device__ __forceinline__ int wave_sum_all_i32(int v) {
    v += __builtin_amdgcn_update_dpp(0, v, 0xB1, 0xF, 0xF, true);
    v += __builtin_amdgcn_update_dpp(0, v, 0x4E, 0xF, 0xF, true);
    v += __builtin_amdgcn_update_dpp(0, v, 0x141, 0xF, 0xF, true);
    v += __builtin_amdgcn_update_dpp(0, v, 0x140, 0xF, 0xF, true);
    auto a = __builtin_amdgcn_permlane16_swap((unsigned)v, (unsigned)v, false, false); v = (int)(a[0] + a[1]);
    auto b = __builtin_amdgcn_permlane32_swap((unsigned)v, (unsigned)v, false, false); return (int)(b[0] + b[1]);
}
__device__ __forceinline__ float wave_sum_all(float v) {
    v += __uint_as_float((unsigned)__builtin_amdgcn_update_dpp(0, (int)__float_as_uint(v), 0xB1, 0xF, 0xF, true));
    v += __uint_as_float((unsigned)__builtin_amdgcn_update_dpp(0, (int)__float_as_uint(v), 0x4E, 0xF, 0xF, true));
    v += __uint_as_float((unsigned)__builtin_amdgcn_update_dpp(0, (int)__float_as_uint(v), 0x141, 0xF, 0xF, true));
    v += __uint_as_float((unsigned)__builtin_amdgcn_update_dpp(0, (int)__float_as_uint(v), 0x140, 0xF, 0xF, true));
    auto a = __builtin_amdgcn_permlane16_swap(__float_as_uint(v), __float_as_uint(v), false, false); v = __uint_as_float(a[0]) + __uint_as_float(a[1]);
    auto b = __builtin_amdgcn_permlane32_swap(__float_as_uint(v), __float_as_uint(v), false, false); return __uint_as_float(b[0]) + __uint_as_float(b[1]);
}
__device__ __forceinline__ float dot16_fp8_bf16(const uint4 q, const uint4 xa, const uint4 xb, float d) {
    const unsigned w[4] = {q.x, q.y, q.z, q.w};
    const unsigned xw[8] = {xa.x, xa.y, xa.z, xa.w, xb.x, xb.y, xb.z, xb.w};
#pragma unroll
    for (int k = 0; k < 4; ++k) {
        const bf16x2v_t lo = __builtin_amdgcn_cvt_scalef32_pk_bf16_fp8(w[k], 1.0f, false), hi = __builtin_amdgcn_cvt_scalef32_pk_bf16_fp8(w[k], 1.0f, true);
        d = __builtin_amdgcn_fdot2_f32_bf16(lo, __builtin_bit_cast(bf16x2v_t, xw[2 * k]), d, false);
        d = __builtin_amdgcn_fdot2_f32_bf16(hi, __builtin_bit_cast(bf16x2v_t, xw[2 * k + 1]), d, false);
    }
    return d;
}
__device__ __forceinline__ void axpy16_fp8_pk(const uint4 q, const f32x2_t c2, f32x2_t* acc) {
    const unsigned w[4] = {q.x, q.y, q.z, q.w};
#pragma unroll
    for (int k = 0; k < 4; ++k) {
        const f32x2_t lo = __builtin_amdgcn_cvt_pk_f32_fp8((int)w[k], false), hi = __builtin_amdgcn_cvt_pk_f32_fp8((int)w[k], true);
        acc[2 * k] = __builtin_elementwise_fma(c2, lo, acc[2 * k]); acc[2 * k + 1] = __builtin_elementwise_fma(c2, hi, acc[2 * k + 1]);
    }
}
__device__ __forceinline__ float gelu_as(float v) {
    const float av = fabsf(v), t = __builtin_amdgcn_rcpf(av * 0.2316418882f + 1.0f);
    float q = t * 0.5307027145f + (-0.7265760135f); q = q * t + 0.7107068705f; q = q * t + (-0.142248368f); q = q * t + 0.127414796f; q = q * t;
    const float e = __builtin_amdgcn_exp2f((v * v) * (-0.72134752044f));
    const float m = v * (q * e);
    return v < 0.f ? m : v - m;
}
__device__ __forceinline__ void peer_sweep_wave(int gw, int lane, LAS unsigned char* wl, const bf16_t* __restrict__ h3, const float* __restrict__ x2, const int* __restrict__ ids,
                                                const float* __restrict__ gates, const unsigned char* __restrict__ ut8, const unsigned char* __restrict__ vt8, const float* __restrict__ rsc,
                                                const float* __restrict__ rstd, const float* __restrict__ g_final, float* __restrict__ out) {
    typedef unsigned u32x4_t __attribute__((ext_vector_type(4)));
    typedef int i32x4_t __attribute__((ext_vector_type(4)));
    LAS unsigned char* x8 = wl;
    LAS unsigned* sorted = (LAS unsigned*)(wl + 8192);
    LAS unsigned* cnt = (LAS unsigned*)(wl + 8192 + 2048);
    LAS unsigned* base = (LAS unsigned*)(wl + 8192 + 2048 + 256);
    LAS unsigned short* gsv = (LAS unsigned short*)(wl + 8192 + 2048 + 512);
    const size_t t0 = (size_t)gw * 4;
    float fac = 0.f;
#pragma unroll
    for (int tok = 0; tok < 4; ++tok) {
        uint4 xv[4]; float am = 0.f;
#pragma unroll
        for (int c = 0; c < 4; ++c) {
            xv[c] = *(const uint4*)(h3 + (t0 + tok) * D + c * 512 + lane * 8);
            const unsigned w[4] = {xv[c].x, xv[c].y, xv[c].z, xv[c].w};
#pragma unroll
            for (int k = 0; k < 4; ++k) am = fmaxf(am, fmaxf(fabsf(__uint_as_float(w[k] << 16)), fabsf(__uint_as_float(w[k] & 0xFFFF0000u))));
        }
        am = wave_max(am);
        const float s = exp2f(fminf(floorf(log2f(127.0f / fmaxf(am, 1e-30f))), 100.0f));
        if ((lane & 3) == tok) fac = rstd[t0 + tok] / s;
#pragma unroll
        for (int c = 0; c < 4; ++c) {
            const unsigned w[4] = {xv[c].x, xv[c].y, xv[c].z, xv[c].w};
            unsigned o[2];
#pragma unroll
            for (int h = 0; h < 2; ++h) {
                const int q0 = __float2int_rn(__uint_as_float(w[2 * h] << 16) * s), q1 = __float2int_rn(__uint_as_float(w[2 * h] & 0xFFFF0000u) * s);
                const int q2 = __float2int_rn(__uint_as_float(w[2 * h + 1] << 16) * s), q3 = __float2int_rn(__uint_as_float(w[2 * h + 1] & 0xFFFF0000u) * s);
                o[h] = ((unsigned)q0 & 255u) | (((unsigned)q1 & 255u) << 8) | (((unsigned)q2 & 255u) << 16) | (((unsigned)q3 & 255u) << 24);
            }
            typedef unsigned u32x2_t __attribute__((ext_vector_type(2)));
            *(LAS u32x2_t*)(x8 + tok * 2048 + c * 512 + lane * 8) = (u32x2_t){o[0], o[1]};
        }
    }
    cnt[lane] = 0u;
    asm volatile("s_waitcnt lgkmcnt(0)" ::: "memory");
    unsigned key[8], rk[8]; unsigned short fv[8];
#pragma unroll
    for (int r = 0; r < 8; ++r) {
        const int n = r * 64 + lane;
        const unsigned e = (unsigned)ids[t0 * 128 + n];
        key[r] = (e << 9) | (unsigned)n | (__float_as_uint(rsc[e]) & 0x7F800000u);
        fv[r] = (unsigned short)f2bf(gates[t0 * 128 + n] * rsc[16384 + e]);
        rk[r] = __hip_atomic_fetch_add(&cnt[e >> 8], 1u, __ATOMIC_RELAXED, __HIP_MEMORY_SCOPE_WORKGROUP);
    }
    asm volatile("s_waitcnt lgkmcnt(0)" ::: "memory");
    {
        const unsigned c = cnt[lane];
        unsigned incl = c;
#pragma unroll
        for (int o = 1; o < 64; o <<= 1) { const unsigned t = (unsigned)__shfl_up((int)incl, o); if (lane >= o) incl += t; }
        base[lane] = incl - c;
    }
    asm volatile("s_waitcnt lgkmcnt(0)" ::: "memory");
#pragma unroll
    for (int r = 0; r < 8; ++r) { const unsigned pos = base[(key[r] >> 17) & 63u] + rk[r]; sorted[pos] = key[r]; gsv[pos] = fv[r]; }
    asm volatile("s_waitcnt lgkmcnt(0)" ::: "memory");
    float rs4[4];
#pragma unroll
    for (int tok = 0; tok < 4; ++tok) rs4[tok] = __uint_as_float((unsigned)__builtin_amdgcn_readlane((int)__float_as_uint(fac), tok));
#define P1_LOAD(ENT, UQ, I0) _Pragma("unroll") for (int q = 0; q < 8; ++q) { \
            ENT[q] = (unsigned)__builtin_amdgcn_readfirstlane((int)sorted[(I0) + q]); \
            const unsigned char* ur = ut8 + (size_t)((ENT[q] >> 9) & 16383u) * 2048 + lane * 16; \
            UQ[q][0] = *(const uint4*)ur; UQ[q][1] = *(const uint4*)(ur + 1024); }
#define P1_COMP(ENT, UQ, I0) _Pragma("unroll") for (int h4 = 0; h4 < 8; h4 += 4) { int d[4]; \
            _Pragma("unroll") for (int q = 0; q < 4; ++q) { \
                const int tok = (ENT[h4 + q] >> 7) & 3; \
                const LAS unsigned char* xr = x8 + tok * 2048 + lane * 16; \
                const u32x4_t a0 = *(const LAS u32x4_t*)xr, b0 = *(const LAS u32x4_t*)(xr + 1024); \
                int dd = 0; \
                dd = __builtin_amdgcn_sdot4((int)UQ[h4 + q][0].x, (int)a0[0], dd, false); dd = __builtin_amdgcn_sdot4((int)UQ[h4 + q][0].y, (int)a0[1], dd, false); \
                dd = __builtin_amdgcn_sdot4((int)UQ[h4 + q][0].z, (int)a0[2], dd, false); dd = __builtin_amdgcn_sdot4((int)UQ[h4 + q][0].w, (int)a0[3], dd, false); \
                dd = __builtin_amdgcn_sdot4((int)UQ[h4 + q][1].x, (int)b0[0], dd, false); dd = __builtin_amdgcn_sdot4((int)UQ[h4 + q][1].y, (int)b0[1], dd, false); \
                dd = __builtin_amdgcn_sdot4((int)UQ[h4 + q][1].z, (int)b0[2], dd, false); dd = __builtin_amdgcn_sdot4((int)UQ[h4 + q][1].w, (int)b0[3], dd, false); \
                d[q] = dd; } \
            _Pragma("unroll") for (int q = 0; q < 4; ++q) { \
                const int s = wave_sum_all_i32(d[q]); \
                const unsigned e = (ENT[h4 + q] >> 9) & 16383u; const int n = ENT[h4 + q] & 511, tok = n >> 7; \
                const float rsv = tok == 0 ? rs4[0] : tok == 1 ? rs4[1] : tok == 2 ? rs4[2] : rs4[3]; \
                const float a = (float)s * (__uint_as_float(ENT[h4 + q] & 0x7F800000u) * rsv); \
                const float cf = __uint_as_float((unsigned)gsv[(I0) + h4 + q] << 16) * gelu_as(a); \
                if (lane == 0) sorted[(I0) + h4 + q] = (e << 18) | ((unsigned)tok << 16) | f2bf(cf); } }
    {
        unsigned entA[8], entB[8]; uint4 uqA[8][2], uqB[8][2];
        P1_LOAD(entA, uqA, 0)
#pragma unroll 1
        for (int i = 0; i < 512; i += 16) {
            P1_LOAD(entB, uqB, i + 8)
            P1_COMP(entA, uqA, i)
            { const int nx = i + 16 < 512 ? i + 16 : 504; P1_LOAD(entA, uqA, nx) }
            P1_COMP(entB, uqB, i + 8)
        }
    }
#undef P1_LOAD
#undef P1_COMP
    asm volatile("s_waitcnt lgkmcnt(0)" ::: "memory");
    f32x2_t acc0[16], acc1[16], acc2[16], acc3[16];
#pragma unroll
    for (int k = 0; k < 16; ++k) { acc0[k] = (f32x2_t){0.f, 0.f}; acc1[k] = (f32x2_t){0.f, 0.f}; acc2[k] = (f32x2_t){0.f, 0.f}; acc3[k] = (f32x2_t){0.f, 0.f}; }
#ifndef P2N
#define P2N 2
#endif
#define P2_LOAD(ENT, VQ, I0) _Pragma("unroll") for (int q = 0; q < P2N; ++q) { \
            ENT[q] = (unsigned)__builtin_amdgcn_readfirstlane((int)sorted[(I0) + q]); \
            const unsigned char* vr = vt8 + (size_t)(ENT[q] >> 18) * 2048 + lane * 16; \
            VQ[q][0] = *(const uint4*)vr; VQ[q][1] = *(const uint4*)(vr + 1024); }
#define P2_COMP(ENT, VQ) _Pragma("unroll") for (int q = 0; q < P2N; ++q) { \
            const int tok = (ENT[q] >> 16) & 3; \
            const float cfs = __uint_as_float(ENT[q] << 16); \
            const f32x2_t c2 = (f32x2_t){cfs, cfs}; \
            if (tok == 0) { axpy16_fp8_pk(VQ[q][0], c2, acc0); axpy16_fp8_pk(VQ[q][1], c2, acc0 + 8); } \
            else if (tok == 1) { axpy16_fp8_pk(VQ[q][0], c2, acc1); axpy16_fp8_pk(VQ[q][1], c2, acc1 + 8); } \
            else if (tok == 2) { axpy16_fp8_pk(VQ[q][0], c2, acc2); axpy16_fp8_pk(VQ[q][1], c2, acc2 + 8); } \
            else { axpy16_fp8_pk(VQ[q][0], c2, acc3); axpy16_fp8_pk(VQ[q][1], c2, acc3 + 8); } }
    {
        unsigned entA[P2N], entB[P2N]; uint4 vqA[P2N][2], vqB[P2N][2];
        P2_LOAD(entA, vqA, 0)
#pragma unroll 1
        for (int i = 0; i < 512; i += 2 * P2N) {
            P2_LOAD(entB, vqB, i + P2N)
            P2_COMP(entA, vqA)
            { const int nx = i + 2 * P2N < 512 ? i + 2 * P2N : 512 - P2N; P2_LOAD(entA, vqA, nx) }
            P2_COMP(entB, vqB)
        }
    }
#undef P2_LOAD
#undef P2_COMP
    int l2 = lane; asm volatile("" : "+v"(l2));
#define PEER_EPI(tok, ACC) { \
        const bf16_t* xr = h3 + (t0 + tok) * D + l2 * 16; \
        float ss = 0.f; \
        _Pragma("unroll") for (int hh = 0; hh < 2; ++hh) _Pragma("unroll") for (int k = 0; k < 4; ++k) { \
            const uint2 xp = *(const uint2*)(xr + hh * 1024 + 4 * k); \
            const float4 xv = make_float4(__uint_as_float(xp.x << 16), __uint_as_float(xp.x & 0xFFFF0000u), __uint_as_float(xp.y << 16), __uint_as_float(xp.y & 0xFFFF0000u)); \
            f32x2_t a0 = ACC[hh * 8 + 2 * k], a1 = ACC[hh * 8 + 2 * k + 1]; \
            a0.x += xv.x; a0.y += xv.y; a1.x += xv.z; a1.y += xv.w; ACC[hh * 8 + 2 * k] = a0; ACC[hh * 8 + 2 * k + 1] = a1; \
            ss += (a0.x * a0.x + a0.y * a0.y) + (a1.x * a1.x + a1.y * a1.y); } \
        ss = wave_sum_dpp(ss); \
        const float r = rsqrtf(ss * (1.0f / D) + EPS); \
        float* orow = out + (t0 + tok) * D + l2 * 16; \
        _Pragma("unroll") for (int hh = 0; hh < 2; ++hh) _Pragma("unroll") for (int k = 0; k < 4; ++k) { \
            const float4 gv = *(const float4*)(g_final + hh * 1024 + l2 * 16 + 4 * k); \
            const f32x2_t a0 = ACC[hh * 8 + 2 * k], a1 = ACC[hh * 8 + 2 * k + 1]; \
            *(float4*)(orow + hh * 1024 + 4 * k) = make_float4(a0.x * r * gv.x, a0.y * r * gv.y, a1.x * r * gv.z, a1.y * r * gv.w); } }
    PEER_EPI(0, acc0) PEER_EPI(1, acc1) PEER_EPI(2, acc2) PEER_EPI(3, acc3)
#undef PEER_EPI
}

struct Params {
    const float *x, *mem, *g_mix, *w_in, *conv_w, *conv_b, *w_mq, *w_mk, *b_mi, *b_mf, *g_mhead, *g_ahead, *w_out, *g_cross, *g_mem,
                *w_xq, *w_xk, *w_xv, *w_xo, *g_ffn, *w_pq, *sub_keys, *u_tab, *v_tab, *g_final;
    float* out;
    unsigned* bar;
    float* ws;
};

#define PHASE_LOOP(nvb) for (int base_ = blockIdx.x * 2; base_ < (nvb); base_ += gridDim.x * 2)
#define VB (base_ + half)

__global__ void __launch_bounds__(NTHR) mega(Params P) {
    volatile LAS unsigned* st = (volatile LAS unsigned*)(LAS unsigned char*)(smem_raw + CTRL_OFF);
    if (threadIdx.x == 0) { st[0] = 0u; st[1] = 0u; st[2] = 0u; st[3] = 0u; }
    if (threadIdx.x < I_NPTR) ((LAS unsigned long long*)(LAS unsigned char*)(smem_raw + CTRL_OFF + 64))[threadIdx.x] = ((const unsigned long long*)&P)[threadIdx.x];
    __syncthreads();
    XcdBarrier xb = xcd_barrier_post((unsigned*)ldp_raw(I_BAR), st);

    constexpr size_t TD = (size_t)T * D;
    constexpr size_t O_HB = 6 * P6S * 2, O_CBUF = O_HB + (size_t)T * D * 2, O_MQ = O_CBUF + (size_t)T * 1024 * 2, O_MK = O_MQ + (size_t)T * 1024 * 2,
                     O_MIXB = O_MK + (size_t)T * 1024 * 2, O_WIN = O_MIXB + (size_t)T * D * 2, O_WOUT = O_WIN + (size_t)6144 * D * 2, O_WXQ = O_WOUT + (size_t)D * D * 2,
                     O_WXK = O_WXQ + (size_t)D * D * 2, O_WXV = O_WXK + (size_t)D * D * 2, O_WXO = O_WXV + (size_t)D * D * 2, O_WPQ = O_WXO + (size_t)D * D * 2,
                     O_WQK = O_WPQ + (size_t)D * D * 2, O_GPRE = O_WQK + (size_t)8 * 256 * 256 * 2, O_UT = O_GPRE + (size_t)T * 8 * 4, O_VT = O_UT + (size_t)16384 * D, O_RSC = O_VT + (size_t)16384 * D,
                     O_BH = O_RSC + (size_t)32768 * 4, O_GS = O_BH + (size_t)128 * 256 * 512 * 2, O_DENP = O_GS + (size_t)T * 4 * 8 * 4, O_QN = O_DENP + (size_t)T * 4 * 4 * 4,
                     O_DN = O_QN + (size_t)T * 4 * 4, O_DECAY = O_DN + (size_t)128 * 256 * 4, O_KB = O_DECAY + 4096, O_VB = O_KB + (size_t)12288 * 2048 * 2, O_CS = O_VB + (size_t)12288 * 2048 * 2, O_SKB = O_CS + (size_t)4096 * 64 * 8, O_RSSP = O_SKB + (size_t)262144 * 2, O_RSTD = O_RSSP + (size_t)T * 32 * 4, O_MN = O_RSTD + (size_t)T * 4, O_KVP = O_MN + (size_t)512 * D * 2, O_END = O_KVP + (size_t)2 * 512 * 4096 * 4;
    static_assert(O_END + 16384 <= (size_t)536870912, "workspace overflow");
#define W_P6    ((bf16_t*)wsb)
#define W_HB    ((bf16_t*)(wsb + O_HB))
#define W_CBUF  ((bf16_t*)(wsb + O_CBUF))
#define W_MQ    ((bf16_t*)(wsb + O_MQ))
#define W_MK    ((bf16_t*)(wsb + O_MK))
#define W_MIXB  ((bf16_t*)(wsb + O_MIXB))
#define W_GPRE  ((float*)(wsb + O_GPRE))
#define W_HRAW  ((float*)(wsb + O_HB))
#define W_XR    ((float*)wsb)
#define W_MN    ((bf16_t*)((float*)wsb + TD))
#define W_KM    ((bf16_t*)((float*)wsb + TD + (size_t)256 * D))
#define W_VMT   ((bf16_t*)((float*)wsb + TD + (size_t)768 * D))
#define W_PX    ((bf16_t*)(wsb + O_MK))
#define W_GATES ((float*)wsb + TD + (size_t)1280 * D)
#define W_IDS   ((int*)((float*)wsb + TD + (size_t)1280 * D + (size_t)T * 128))
#define W_QX    ((bf16_t*)(wsb + O_CBUF))
#define W_BH    ((bf16_t*)(wsb + O_BH))
#define W_KB    ((bf16_t*)(wsb + O_KB))
#define W_VB    ((bf16_t*)(wsb + O_VB))
#define W_CS    ((float2*)(wsb + O_CS))
#define W_SKB   ((bf16_t*)(wsb + O_SKB))
#define W_RSSP  ((float*)(wsb + O_RSSP))
#define W_RSTD  ((float*)(wsb + O_RSTD))
#define W_MN2   ((bf16_t*)(wsb + O_MN))
#define W_KVP   ((float*)(wsb + O_KVP))
#define W_GS    ((float*)(wsb + O_GS))
#define W_DENP  ((float*)(wsb + O_DENP))
#define W_QN    ((float*)(wsb + O_QN))
#define W_DN    ((float*)(wsb + O_DN))
#define W_DECAY ((float*)(wsb + O_DECAY))
#define W_PQ    ((bf16_t*)(wsb + O_HB))
#define W_KWT   ((bf16_t*)(wsb + O_CBUF))
#define W_DC    ((float*)(wsb + 3 * P6S * 2))
#define W_UT    ((unsigned char*)(wsb + O_UT))
#define W_VT    ((unsigned char*)(wsb + O_VT))
#define W_RSC   ((float*)(wsb + O_RSC))
#define PH_BEGIN() int tidx = threadIdx.x; asm volatile("" : "+v"(tidx)); const int half = tidx >> 8, tid = tidx & 255; float* sm = (float*)smem_raw + half * HALF_SM_FLOATS; \
                   char* wsb = (char*)ldp_raw(I_WS); (void)half; (void)tid; (void)sm; (void)wsb
#define GJOB_DEFAULT(g) pg8::GJob g; g.lda = D; g.ldb = D; g.K = D; g.nM = 32; g.nN = 8; g.a_pm_step = 256 * D; g.b_pn_mask = 0x7fffffff; g.b_pn_shift = 30; g.b_pn_step2 = 0; g.bid0 = 0; g.nblk = gridDim.x; g.a_pn_shift = 0; g.a_pn_mask = 0; g.a_pn_step = 0; g.b_pm_shift = 0; g.b_pm_step = 0; g.b_pn_step = 256 * D; \
                        g.ldc = D; g.R = nullptr; g.ldr = D; g.mode = 0; g.escale = 1.0f; g.gs = nullptr; g.denp = nullptr; g.qn = nullptr; g.gvec = nullptr; g.mo = nullptr; g.C2 = nullptr; g.rssp = nullptr; g.rstd = nullptr
#define GEMM_LDSP ((LAS unsigned char*)smem_raw)

    {
        PH_BEGIN();
        {
            LAS float* scr = (LAS float*)(LAS unsigned char*)(smem_raw) + (tidx >> 6) * (64 * 33);
            const int lane = tidx & 63;
            const int gw = blockIdx.x * 8 + (tidx >> 6), NGW = gridDim.x * 8;
            constexpr int I_IN = 32 * 192, I_SQ = 32 * 64, I_QK = 8 * 4 * 8;
            constexpr int NITEMS = I_IN + 6 * I_SQ + I_QK;
#pragma nounroll
            for (int it = gw; it < NITEMS; it += NGW) {
                const float* W; int ldw, K, csrc0, row0, kb; bf16_t* WT; float wscale = 1.0f; const float* kgain = nullptr;
                int r = it;
                if (r < I_IN) { const int nb = r % 192; kb = r / 192; W = PF(I_WIN); ldw = INC; K = D; csrc0 = nb * 32 + (nb >= 96 ? 8 : 0); WT = (bf16_t*)(wsb + O_WIN); row0 = nb * 32; }
                else if ((r -= I_IN) < 6 * I_SQ) {
                    const int wsel = r / I_SQ; r -= wsel * I_SQ; const int nb = r % 64; kb = r / 64; ldw = D; K = D; csrc0 = nb * 32; row0 = nb * 32;
                    W = PF(wsel == 0 ? I_WOUT : wsel == 1 ? I_WXQ : wsel == 2 ? I_WXK : wsel == 3 ? I_WXV : wsel == 4 ? I_WXO : I_WPQ);
                    WT = (bf16_t*)(wsb + O_WOUT + (size_t)wsel * ((size_t)D * D * 2));
                    if (wsel == 1) kgain = PF(I_GCROSS); else if (wsel == 5) kgain = PF(I_GFFN);
                } else {
                    r -= 6 * I_SQ; const int hq = r / 32; r -= hq * 32; const int nb = r % 8; kb = r / 8;
                    W = PF(hq < 4 ? I_WMQ : I_WMK) + (size_t)(hq & 3) * 65536; ldw = 256; K = 256; csrc0 = nb * 32; WT = (bf16_t*)(wsb + O_WQK); row0 = hq * 256 + nb * 32;
                    if (hq >= 4) wscale = 0.0625f;
                }
                p0_transpose_item(W, ldw, K, csrc0, WT, row0, scr, kb, lane, wscale, kgain);
            }
            rope_table_fill(W_CS, blockIdx.x * NTHR + tidx, gridDim.x * NTHR);
            {
                const float* sk = PF(I_SUBK);
#pragma nounroll
                for (int i = blockIdx.x * NTHR + tidx; i < 262144 / 8; i += gridDim.x * NTHR) {
                    const float4 a = *(const float4*)(sk + (size_t)i * 8), b = *(const float4*)(sk + (size_t)i * 8 + 4);
                    uint4 o; o.x = pk2(a.x, a.y); o.y = pk2(a.z, a.w); o.z = pk2(b.x, b.y); o.w = pk2(b.z, b.w);
                    *(uint4*)(W_SKB + (size_t)i * 8) = o;
                }
            }
            __syncthreads();
        }
        {
            const float* rin = PF(I_X); const float* rg = PF(I_GMIX); const float* win = PF(I_WIN);
            float* gwT = (float*)smem_raw;
            for (int k = tidx; k < 2048; k += NTHR) { const float4 a = *(const float4*)(win + (size_t)k * INC + C_MI), b = *(const float4*)(win + (size_t)k * INC + C_MI + 4);
                gwT[k] = a.x; gwT[2048 + k] = a.y; gwT[4096 + k] = a.z; gwT[6144 + k] = a.w; gwT[8192 + k] = b.x; gwT[10240 + k] = b.y; gwT[12288 + k] = b.z; gwT[14336 + k] = b.w; }
            __syncthreads();
            {
#pragma nounroll
                for (int row = blockIdx.x * 8 + (tidx >> 6); row < T; row += gridDim.x * 8) { int ln = tidx & 63; asm volatile("" : "+v"(ln)); rmsnorm_row_wave(row, ln, rin, rg, W_HB, gwT, W_GPRE); }
                const float* min_ = PF(I_MEM); const float* mg = PF(I_GMEM);
#pragma nounroll
                for (int row = blockIdx.x * 8 + (tidx >> 6); row < 512; row += gridDim.x * 8) { int ln = tidx & 63; asm volatile("" : "+v"(ln)); rmsnorm_row_wave(row, ln, min_, mg, W_MN2, nullptr, nullptr); }
            }
        }
    }
    xcd_barrier(xb);
    {
        PH_BEGIN();
        GJOB_DEFAULT(g); g.A = W_HB; g.Bt = (bf16_t*)(wsb + O_WIN); g.nN = 24; g.C = (float*)W_P6; g.ldc = 1024;
        pg8::gemm_phase<4>(GEMM_LDSP, g, tidx);
    }
    xcd_barrier(xb);
    {
        PH_BEGIN();
        const float* cw = PF(I_CONVW); const float* cb = PF(I_CONVB);
        const bool gates_wave = (blockIdx.x < 8) && ((tidx >> 6) == 7);
        {
            const int nconv = gridDim.x * NTHR;
#pragma nounroll
            for (int i = blockIdx.x * NTHR + tidx; i < 1024 * 128; i += nconv) conv_silu_run((i >> 7) * 8, i & 127, W_P6, cw, cb, W_CBUF);
        }
        if (gates_wave) mlstm_gates_wave(blockIdx.x >> 2, blockIdx.x & 3, tidx & 63, W_GPRE, PF(I_BMI), PF(I_BMF), W_GS, W_DECAY);
        else {
            LAS unsigned short* wl = (LAS unsigned short*)(LAS unsigned char*)smem_raw + (tidx >> 6) * (16 * 136);
            const int gwv = blockIdx.x * 8 + (tidx >> 6), rank = gwv - ((int)blockIdx.x < 8 ? (int)blockIdx.x : 8), nw = gridDim.x * 8 - 8;
#pragma nounroll
            for (int item = rank; item < 12288; item += nw) dil_tile_prep(item, tidx & 63, wl, W_P6 + 4 * P6S, W_P6 + 5 * P6S, W_CS, W_KB, W_VB);
        }
        __syncthreads();
#pragma nounroll
        PHASE_LOOP(2048) { const int it = VB, lt = it & 3, et = (it >> 2) & 3, h = (it >> 4) & 3, cg = it >> 6;
            transpose_tile64(tid, sm, W_P6 + P6S + (size_t)(cg * 256 + lt * 64) * 1024 + h * 256 + et * 64, 1024, W_BH + ((size_t)(cg * 4 + h) * 256 + et * 64) * 512 + lt * 64, 512, nullptr, 0); }
    }
    xcd_barrier(xb);
    {
        PH_BEGIN();
        {
            GJOB_DEFAULT(g); g.A = W_CBUF; g.lda = 1024; g.a_pm_step = 256 * 1024; g.Bt = (bf16_t*)(wsb + O_WQK); g.ldb = 256; g.b_pn_step = 256 * 256; g.K = 256; g.a_pn_mask = 3; g.a_pn_step = 256; g.C = (float*)W_MQ; g.ldc = 1024;
            pg8::gemm_phase<4>(GEMM_LDSP, g, tidx);
            __syncthreads();
        }
        const float* ga = PF(I_GAHEAD);
#pragma nounroll
        for (int qt = blockIdx.x * 8 + (tidx >> 6); qt < 2048; qt += gridDim.x * 8) dilated_wave_tile(qt, tidx & 63, W_P6 + 3 * P6S, W_CS, W_KB, W_VB, ga, W_MIXB);
    }
    xcd_barrier(xb);
    {
        PH_BEGIN();
#pragma nounroll
        PHASE_LOOP(2048) { const int it = VB, lt = it & 3, dt = (it >> 2) & 3, h = (it >> 4) & 3, cg = it >> 6;
            transpose_tile64(tid, sm, W_MK + (size_t)(cg * 256 + lt * 64) * 1024 + h * 256 + dt * 64, 1024, W_KWT + ((size_t)(cg * 4 + h) * 256 + dt * 64) * 256 + lt * 64, 256,
                             W_GS + ((size_t)(cg * 256 + lt * 64) * 4 + h) * 8 + 2, 32); }
        {
            const size_t nth = (size_t)gridDim.x * NTHR;
#pragma nounroll
            for (size_t i = (size_t)blockIdx.x * NTHR + tidx; i < (size_t)T * 128; i += nth) {
                const size_t t = i >> 7; const int c8 = (int)(i & 127) * 8, h = c8 >> 8, d = c8 & 255;
                const float sc = W_GS[(t * 4 + h) * 8 + 3];
                const uint4 v = *(const uint4*)(W_MQ + t * 1024 + c8);
                uint4 o;
                o.x = pk2(bf2f((unsigned short)(v.x & 0xFFFFu)) * sc, bf2f((unsigned short)(v.x >> 16)) * sc); o.y = pk2(bf2f((unsigned short)(v.y & 0xFFFFu)) * sc, bf2f((unsigned short)(v.y >> 16)) * sc);
                o.z = pk2(bf2f((unsigned short)(v.z & 0xFFFFu)) * sc, bf2f((unsigned short)(v.z >> 16)) * sc); o.w = pk2(bf2f((unsigned short)(v.w & 0xFFFFu)) * sc, bf2f((unsigned short)(v.w >> 16)) * sc);
                *(uint4*)(W_PQ + t * 2048 + h * 512 + 256 + d) = o;
            }
        }
#pragma nounroll
        PHASE_LOOP(128) { const int cgh = VB, cg = cgh >> 2, h = cgh & 3;
            float a = 0.f;
#pragma unroll 16
            for (int l = 0; l < 256; ++l) { const size_t t = (size_t)cg * 256 + l; a = fmaf(W_GS[(t * 4 + h) * 8 + 2], bf2f(W_MK[t * 1024 + h * 256 + tid]), a); }
            W_DN[(size_t)cgh * 256 + tid] = a; }
        __syncthreads();
        {
            GJOB_DEFAULT(g); g.A = W_MQ; g.lda = 1024; g.a_pm_step = 256 * 1024; g.a_pn_mask = 3; g.a_pn_step = 256; g.K = 256; g.nN = 4;
            g.Bt = W_MK; g.ldb = 1024; g.b_pn_step = 256; g.b_pm_step = 256 * 1024; g.C = (float*)W_PQ; g.gs = W_GS; g.denp = W_DENP;
            pg8::gemm_phase<6>(GEMM_LDSP, g, tidx);
        }
    }
    xcd_barrier(xb);
    {
        PH_BEGIN();
        GJOB_DEFAULT(g); g.A = W_BH; g.lda = 512; g.a_pm_step = 4 * 256 * 512; g.a_pn_mask = 3; g.a_pn_step = 256 * 512; g.K = 256; g.nN = 4;
        g.Bt = W_KWT; g.ldb = 256; g.b_pn_step = 65536; g.b_pm_step = 4 * 65536; g.C = W_DC;
        pg8::gemm_phase<7>(GEMM_LDSP, g, tidx);
    }
    xcd_barrier(xb);
    {
        PH_BEGIN();
        {
#pragma nounroll
            for (int gid = blockIdx.x * NTHR + tidx; gid < 131072; gid += gridDim.x * NTHR) {
                const int bh = gid >> 14, b = bh >> 2, h = bh & 3, e = (gid >> 6) & 255, d = (gid & 63) * 4;
                float4 C = make_float4(0.f, 0.f, 0.f, 0.f);
                float4 dcv[16]; float decv[16];
#pragma unroll
                for (int c = 0; c < 16; ++c) { const int cgh = (b * 16 + c) * 4 + h; decv[c] = W_DECAY[cgh]; dcv[c] = *(const float4*)(W_DC + ((size_t)cgh * 256 + e) * 256 + d); }
#pragma unroll
                for (int c = 0; c < 16; ++c) {
                    const int cgh = (b * 16 + c) * 4 + h;
                    uint2 o; o.x = pk2(C.x, C.y); o.y = pk2(C.z, C.w);
                    *(uint2*)(W_BH + ((size_t)cgh * 256 + e) * 512 + 256 + d) = o;
                    C.x = fmaf(decv[c], C.x, dcv[c].x); C.y = fmaf(decv[c], C.y, dcv[c].y); C.z = fmaf(decv[c], C.z, dcv[c].z); C.w = fmaf(decv[c], C.w, dcv[c].w);
                }
            }
        }
#pragma nounroll
        PHASE_LOOP(128) { const int cgh = VB, cg = cgh >> 2, h = cgh & 3, b = cg >> 4, c = cg & 15;
            float n = 0.f;
            for (int cc = 0; cc < c; ++cc) { const int j = (b * 16 + cc) * 4 + h; n = fmaf(W_DECAY[j], n, W_DN[(size_t)j * 256 + tid]); }
            __syncthreads();
            sm[tid] = n;
            __syncthreads();
            const int lane = tid & 63, w = tid >> 6;
            const float4 nv = *(const float4*)(sm + lane * 4);
#pragma unroll 1
            for (int i = 0; i < 64; i += 8) {
                float s[8];
#pragma unroll
                for (int k = 0; k < 8; ++k) {
                    const size_t t = (size_t)cg * 256 + w * 64 + i + k;
                    const ushort4 q4 = *(const ushort4*)(W_MQ + t * 1024 + h * 256 + lane * 4);
                    s[k] = bf2f(q4.x) * nv.x + bf2f(q4.y) * nv.y + bf2f(q4.z) * nv.z + bf2f(q4.w) * nv.w;
                }
#pragma unroll
                for (int k = 0; k < 8; ++k) { const float tot = wave_sum_dpp(s[k]); if (lane == 0) W_QN[((size_t)cg * 256 + w * 64 + i + k) * 4 + h] = tot; }
            }
        }
    }
    xcd_barrier(xb);
    {
        PH_BEGIN();
        GJOB_DEFAULT(g); g.A = W_PQ; g.a_pn_mask = 3; g.a_pn_step = 512; g.K = 512; g.nN = 4;
        g.Bt = W_BH; g.ldb = 512; g.b_pn_step = 256 * 512; g.b_pm_step = 4 * 256 * 512; g.C = (float*)W_MIXB;
        g.gs = W_GS; g.denp = W_DENP; g.qn = W_QN; g.gvec = PF(I_GMHEAD); g.mo = W_P6 + 2 * P6S; g.nblk = 128;
        if (blockIdx.x < 128) pg8::gemm_phase<8>(GEMM_LDSP, g, tidx);
        else {
            GJOB_DEFAULT(k); k.A = W_MN2; k.K = 1024; k.nM = 2; k.nN = 32; k.a_pn_shift = 4; k.a_pn_mask = 1; k.a_pn_step = 1024;
            k.Bt = (bf16_t*)(wsb + O_WXK); k.b_pn_mask = 15; k.b_pn_shift = 4; k.b_pn_step2 = 1024; k.C = W_KVP; k.bid0 = 128; k.nblk = 128;
            pg8::gemm_phase<12>(GEMM_LDSP, k, tidx);
        }
    }
    xcd_barrier(xb);
    {
        PH_BEGIN();
        for (int i = blockIdx.x * NTHR + tidx; i < 512 * 4096 / 4; i += gridDim.x * NTHR) {
            const int r = i >> 10, c = (i & 1023) * 4;
            const float4 a = *(const float4*)(W_KVP + (size_t)r * 4096 + c), b = *(const float4*)(W_KVP + (size_t)512 * 4096 + (size_t)r * 4096 + c);
            const float v0 = a.x + b.x, v1 = a.y + b.y, v2 = a.z + b.z, v3 = a.w + b.w;
            if (c < 2048) { uint2 o; o.x = pk2(v0, v1); o.y = pk2(v2, v3); *(uint2*)(W_KM + (size_t)r * 2048 + c) = o; }
            else { bf16_t* d = W_VMT + (size_t)(c - 2048) * 512 + r; d[0] = (bf16_t)f2bf(v0); d[512] = (bf16_t)f2bf(v1); d[1024] = (bf16_t)f2bf(v2); d[1536] = (bf16_t)f2bf(v3); }
        }
        GJOB_DEFAULT(g); g.A = W_MIXB; g.Bt = (bf16_t*)(wsb + O_WOUT); g.R = PF(I_X); g.C2 = W_HB; g.rssp = W_RSSP;
        pg8::gemm_phase<10>(GEMM_LDSP, g, tidx);
    }
    xcd_barrier(xb);
    {
        PH_BEGIN();
        {
            GJOB_DEFAULT(g); g.A = W_HB; g.Bt = (bf16_t*)(wsb + O_WXQ); g.C = (float*)W_QX;
            pg8::Unit u0;
            if (pg8::unit_next(g, 0, u0) && tidx < 256) { const size_t r = (size_t)u0.pm * 256 + tidx; float s = 0.f;
                { float4 pq[8];
#pragma unroll
                  for (int k = 0; k < 8; ++k) pq[k] = *(const float4*)(W_RSSP + r * 32 + 4 * k);
#pragma unroll
                  for (int k = 0; k < 8; ++k) s += (pq[k].x + pq[k].y) + (pq[k].z + pq[k].w); }
                ((LAS float*)(LAS unsigned char*)(smem_raw + GEMM_LDS + 1024 + 8192))[tidx] = rsqrtf(s * (1.0f / D) + EPS); }
            __syncthreads();
            pg8::gemm_phase<11>(GEMM_LDSP, g, tidx); __syncthreads();
        }

    }
    xcd_barrier(xb);
    {
        PH_BEGIN();
        GJOB_DEFAULT(g); g.A = W_QX; g.K = 512; g.a_pn_mask = 3; g.a_pn_step = 512; g.Bt = W_KM; g.b_pn_step = 512; g.b_pm_shift = 4; g.b_pm_step = 256 * D; g.nN = 4;
        g.C = (float*)W_PX; g.ldc = 1024; g.escale = 0.04419417382415922f * 1.4426950408889634f;
        pg8::gemm_phase<5>(GEMM_LDSP, g, tidx);
    }
    xcd_barrier(xb);
    {
        PH_BEGIN();
        GJOB_DEFAULT(g); g.A = W_PX; g.lda = 1024; g.a_pm_step = 256 * 1024; g.K = 256; g.a_pn_shift = 1; g.a_pn_mask = 3; g.a_pn_step = 256; g.Bt = W_VMT; g.ldb = 512; g.b_pn_step = 256 * 512; g.b_pm_shift = 4; g.b_pm_step = 256;
        g.C = (float*)W_MIXB;
        pg8::gemm_phase<3>(GEMM_LDSP, g, tidx);
    }
    xcd_barrier(xb);
    {
        PH_BEGIN();
        GJOB_DEFAULT(g); g.A = W_MIXB; g.Bt = (bf16_t*)(wsb + O_WXO); g.R = nullptr; g.C2 = W_HB; g.rssp = W_RSSP;
        pg8::gemm_phase<10>(GEMM_LDSP, g, tidx);
    }
    xcd_barrier(xb);
    {
        PH_BEGIN();
        GJOB_DEFAULT(g); g.A = W_HB; g.Bt = (bf16_t*)(wsb + O_WPQ); g.C = (float*)W_QX;
        pg8::Unit u0;
        if (pg8::unit_next(g, 0, u0) && tidx < 256) { const size_t r = (size_t)u0.pm * 256 + tidx; float s = 0.f;
                { float4 pq[8];
#pragma unroll
                  for (int k = 0; k < 8; ++k) pq[k] = *(const float4*)(W_RSSP + r * 32 + 4 * k);
#pragma unroll
                  for (int k = 0; k < 8; ++k) s += (pq[k].x + pq[k].y) + (pq[k].z + pq[k].w); }
            const float rs = rsqrtf(s * (1.0f / D) + EPS);
            ((LAS float*)(LAS unsigned char*)(smem_raw + GEMM_LDS + 1024 + 8192))[tidx] = rs; W_RSTD[r] = rs; }
        __syncthreads();
        pg8::gemm_phase<11>(GEMM_LDSP, g, tidx);
    }
    xcd_barrier(xb);
    {
        PH_BEGIN();
        LAS float* wl = (LAS float*)(LAS unsigned char*)smem_raw + (tidx >> 6) * 1024;
        const bool conv_first = ((tidx >> 6) & 1) != 0;
        if (!conv_first) {
#pragma nounroll
            for (int item = blockIdx.x * 8 + (tidx >> 6); item < 4096; item += gridDim.x * 8) peer_topk_wave2(item, tidx & 63, wl, W_QX, W_SKB, W_IDS, W_GATES);
        }
        {
            const int gw = blockIdx.x * 8 + (tidx >> 6), NGW = gridDim.x * 8; int lane = tidx & 63; asm volatile("" : "+v"(lane));
                const float* ut = PF(I_UTAB); const float* vt = PF(I_VTAB); const float* gffn = PF(I_GFFN);
#define TBL_LOAD(F, SRC, RR) _Pragma("unroll") for (int i = 0; i < 8; ++i) F[i] = *(const float4*)((SRC) + (size_t)(RR) * D + i * 256 + lane * 4);
                {
                    float4 fa[8], fb[8];
                    TBL_LOAD(fa, ut, gw)
#pragma nounroll
                    for (int rr = gw; rr < 16384; rr += 2 * NGW) {
                        TBL_LOAD(fb, ut, rr + NGW)
                        table_row_store<true>(fa, W_UT + (size_t)rr * D, W_RSC + rr, lane, gffn);
                        { const int nx = rr + 2 * NGW < 16384 ? rr + 2 * NGW : rr; TBL_LOAD(fa, ut, nx) }
                        table_row_store<true>(fb, W_UT + (size_t)(rr + NGW) * D, W_RSC + rr + NGW, lane, gffn);
                    }
                    TBL_LOAD(fa, vt, gw)
#pragma nounroll
                    for (int rr = gw; rr < 16384; rr += 2 * NGW) {
                        TBL_LOAD(fb, vt, rr + NGW)
                        table_row_store<false>(fa, W_VT + (size_t)rr * D, W_RSC + 16384 + rr, lane, nullptr);
                        { const int nx = rr + 2 * NGW < 16384 ? rr + 2 * NGW : rr; TBL_LOAD(fa, vt, nx) }
                        table_row_store<false>(fb, W_VT + (size_t)(rr + NGW) * D, W_RSC + 16384 + rr + NGW, lane, nullptr);
                    }
                }
#undef TBL_LOAD
            }
        if (conv_first) {
#pragma nounroll
            for (int item = blockIdx.x * 8 + (tidx >> 6); item < 4096; item += gridDim.x * 8) peer_topk_wave2(item, tidx & 63, wl, W_QX, W_SKB, W_IDS, W_GATES);
        }
    }
    xcd_barrier(xb);
    {
        PH_BEGIN();
        const float* gf = PF(I_GFINAL); float* outp = (float*)ldp_raw(I_OUT);
        LAS unsigned char* wl = (LAS unsigned char*)smem_raw + (tidx >> 6) * 11776;
#pragma nounroll
        for (int gw = blockIdx.x * 8 + (tidx >> 6); gw < T / 4; gw += gridDim.x * 8) { int ln = tidx & 63; asm volatile("" : "+v"(ln));
            peer_sweep_wave(gw, ln, wl, W_HB, W_XR, W_IDS, W_GATES, W_UT, W_VT, W_RSC, W_RSTD, gf, outp); }
    }
}
}

extern "C" void kernel_launch(void* const* d_in, const int* in_sizes, int n_in, void* d_out, int out_size, void* d_ws, size_t ws_size, hipStream_t stream) {
    static int grid_blocks = 0;
    if (!grid_blocks) {
        int dev = 0, cus = 0, per_cu = 0;
        hipGetDevice(&dev);
        hipDeviceGetAttribute(&cus, hipDeviceAttributeMultiprocessorCount, dev);
        hipFuncSetAttribute((const void*)mega, hipFuncAttributeMaxDynamicSharedMemorySize, SMEM_BYTES);
        hipOccupancyMaxActiveBlocksPerMultiprocessor(&per_cu, mega, NTHR, SMEM_BYTES);
        if (per_cu > 1) per_cu = 1;
        if (per_cu < 1) per_cu = 1;
        grid_blocks = cus * per_cu;
    }
    Params P{};
    const float** pp = (const float**)&P;
    for (int i = 0; i < 25; ++i) pp[i] = (const float*)d_in[i];
    P.out = (float*)d_out;
    P.bar = (unsigned*)d_ws;
    P.ws = (float*)((char*)d_ws + 16384);
    hipMemsetAsync(d_ws, 0, 16384, stream);
    void* args[] = {&P};
    hipError_t e = hipLaunchCooperativeKernel((const void*)mega, dim3(grid_blocks), dim3(NTHR), args, SMEM_BYTES, stream);
    if (e != hipSuccess) fprintf(stderr, "cooperative launch failed: %s (grid %d)\n", hipGetErrorString(e), grid_blocks);
}
```

```cpp
#include <hip/hip_runtime.h>
#include <stdint.h>
#include <math.h>
#include <cstdio>

#define LAS_ __attribute__((address_space(3)))
namespace {
constexpr int D = 2048, NB = 2, S = 4096, T = NB * S;
constexpr int INC = 6152;
constexpr int C_MIN = 0, C_MV = 1024, C_MO = 2048, C_MI = 3072, C_MF = 3076, C_AQ = 3080, C_AK = 4104, C_AV = 5128;
constexpr float EPS = 1e-6f;
constexpr size_t P6S = (size_t)8192 * 1024;
constexpr int NTHR = 512;
constexpr int HALF_SM_FLOATS = 8704;
constexpr int GEMM_LDS = 131072;
constexpr int SMEM_BYTES = 163840;
constexpr int CTRL_OFF = SMEM_BYTES - 1024;
typedef unsigned short bf16_t;
__device__ __forceinline__ unsigned f2bf(float f) { unsigned u = __float_as_uint(f); u += 0x7FFFu + ((u >> 16) & 1u); return u >> 16; }
__device__ __forceinline__ unsigned pk2(float lo, float hi) { return f2bf(lo) | (f2bf(hi) << 16); }
__device__ __forceinline__ float bf2f(unsigned short b) { return __uint_as_float(((unsigned)b) << 16); }
extern __shared__ __attribute__((aligned(16))) unsigned char smem_raw[];
enum { I_X = 0, I_MEM, I_GMIX, I_WIN, I_CONVW, I_CONVB, I_WMQ, I_WMK, I_BMI, I_BMF, I_GMHEAD, I_GAHEAD, I_WOUT, I_GCROSS, I_GMEM,
       I_WXQ, I_WXK, I_WXV, I_WXO, I_GFFN, I_WPQ, I_SUBK, I_UTAB, I_VTAB, I_GFINAL, I_OUT, I_BAR, I_WS, I_NPTR };
__device__ __forceinline__ unsigned long long ldp_raw(int i) {
    const LAS_ unsigned long long* tab = (const LAS_ unsigned long long*)(LAS_ unsigned char*)(smem_raw + CTRL_OFF + 64);
    const unsigned long long v = tab[i];
    const unsigned lo = __builtin_amdgcn_readfirstlane((unsigned)v), hi = __builtin_amdgcn_readfirstlane((unsigned)(v >> 32));
    return ((unsigned long long)hi << 32) | lo;
}
#define PF(i) ((const float*)ldp_raw(i))

#define XB_TMO      128
#define XB_XCNT(j)  (256  + 64 * (j))
#define XB_XSUB(j)  (1280 + 64 * (j))
#define XB_XGEN(j)  (2304 + 64 * (j))
#define XB_TOP      3328
#define XB_TOPGEN   3392
#define XCD_BAR_WORDS 3456
#define XB_SPIN_CAP (1u << 22)
#define LAS __attribute__((address_space(3)))

__device__ __forceinline__ unsigned xb_ld(unsigned* p)              { return __hip_atomic_load(p, __ATOMIC_RELAXED, __HIP_MEMORY_SCOPE_AGENT); }
__device__ __forceinline__ unsigned xb_add(unsigned* p, unsigned v) { return __hip_atomic_fetch_add(p, v, __ATOMIC_RELAXED, __HIP_MEMORY_SCOPE_AGENT); }
__device__ __forceinline__ unsigned xb_xcc_id() { return (unsigned)__builtin_amdgcn_s_getreg((3 << 11) | 20) & 0xFu; }
#define XB_SPIN(cond, bar) do { unsigned _sp = 0; while (cond) { __builtin_amdgcn_s_sleep(1); \
    if ((++_sp & 255u) == 0u) { if (xb_ld(&(bar)[XB_TMO])) break; if (_sp > XB_SPIN_CAP) { atomicAdd(&(bar)[XB_TMO], 1u); break; } } } } while (0)

struct XcdBarrier { unsigned* bar; unsigned x; volatile LAS unsigned* st; };

__device__ __forceinline__ XcdBarrier xcd_barrier_post(unsigned* bar, volatile LAS unsigned* st) {
    XcdBarrier b; b.bar = bar; b.x = xb_xcc_id(); b.st = st;
    if (threadIdx.x == 0) (void)xb_add(&bar[XB_XCNT(b.x)], 1u);
    return b;
}
__device__ __forceinline__ void xcd_barrier_complete(unsigned* bar, unsigned x, unsigned& nloc, unsigned& nx) {
    const unsigned G = gridDim.x * gridDim.y * gridDim.z;
    unsigned sum, cnt, mine, sp = 0u;
    for (;;) {
        sum = 0u; cnt = 0u; mine = 0u;
#pragma unroll
        for (unsigned j = 0; j < 16; ++j) { const unsigned c = xb_ld(&bar[XB_XCNT(j)]); sum += c; cnt += (c > 0u) ? 1u : 0u; mine = (j == x) ? c : mine; }
        if (sum == G) break;
        __builtin_amdgcn_s_sleep(1);
        if ((++sp & 255u) == 0u) { if (xb_ld(&bar[XB_TMO])) break; if (sp > XB_SPIN_CAP) { atomicAdd(&bar[XB_TMO], 1u); break; } }
    }
    nloc = mine > 0u ? mine : 1u; nx = cnt > 0u ? cnt : 1u;
}
__device__ __forceinline__ void xcd_barrier(const XcdBarrier& b) {
    asm volatile("s_waitcnt vmcnt(0)" ::: "memory");
    __syncthreads();
    if (threadIdx.x == 0) {
        unsigned* bar = b.bar;
        __builtin_amdgcn_s_waitcnt(0);
        unsigned nloc = b.st[0], nx = b.st[1];
        if (nloc == 0u) { xcd_barrier_complete(bar, b.x, nloc, nx); b.st[0] = nloc; b.st[1] = nx; }
        const unsigned old = xb_add(&bar[XB_XSUB(b.x)], 1u);
        const unsigned gen = old / nloc;
        if (old + 1u == (gen + 1u) * nloc) {
            __builtin_amdgcn_fence(__ATOMIC_RELEASE, "agent");
            asm volatile("s_waitcnt vmcnt(0)" ::: "memory");
            const unsigned og = xb_add(&bar[XB_TOP], 1u);
            const unsigned tg = og / nx;
            if (og + 1u == (tg + 1u) * nx) xb_add(&bar[XB_TOPGEN], 1u);
            else XB_SPIN(xb_ld(&bar[XB_TOPGEN]) == tg, bar);
            __builtin_amdgcn_fence(__ATOMIC_ACQUIRE, "agent");
            xb_add(&bar[XB_XGEN(b.x)], 1u);
            asm volatile("s_waitcnt vmcnt(0)" ::: "memory");
        } else {
            XB_SPIN(xb_ld(&bar[XB_XGEN(b.x)]) == gen, bar);
            __builtin_amdgcn_fence(__ATOMIC_ACQUIRE, "agent");
            asm volatile("s_waitcnt vmcnt(0)" ::: "memory");
        }
    }
    __syncthreads();
}

__device__ __forceinline__ float wave_sum(float v) {
#pragma unroll
    for (int o = 32; o >= 1; o >>= 1) v += __shfl_xor(v, o);
    return v;
}
__device__ __forceinline__ float wave_max(float v) {
#pragma unroll
    for (int o = 32; o >= 1; o >>= 1) v = fmaxf(v, __shfl_xor(v, o));
    return v;
}
__device__ __forceinline__ float log_sigmoid(float x) { return fminf(x, 0.f) - log1pf(expf(-fabsf(x))); }


__device__ __forceinline__ void d_rmsnorm(int vb, int t, float* sm, const float* __restrict__ in, const float* __restrict__ g, bf16_t* __restrict__ out,
                                          const float* gwl  , float* __restrict__ gpre) {
    float* red = sm;
    const int row = vb;
    const float4* p = (const float4*)(in + (size_t)row * D);
    float4 a = p[t], b = p[t + 256];
    float s = a.x * a.x + a.y * a.y + a.z * a.z + a.w * a.w + b.x * b.x + b.y * b.y + b.z * b.z + b.w * b.w;
    s = wave_sum(s);
    __syncthreads();
    if ((t & 63) == 0) red[t >> 6] = s;
    __syncthreads();
    const float tot = red[0] + red[1] + red[2] + red[3];
    const float r = rsqrtf(tot * (1.0f / D) + EPS);
    const float4* gp = (const float4*)g;
    float4 ga = gp[t], gb = gp[t + 256];
    float hv[8] = {a.x * r * ga.x, a.y * r * ga.y, a.z * r * ga.z, a.w * r * ga.w, b.x * r * gb.x, b.y * r * gb.y, b.z * r * gb.z, b.w * r * gb.w};
    uint2 o0, o1;
    o0.x = pk2(hv[0], hv[1]); o0.y = pk2(hv[2], hv[3]); o1.x = pk2(hv[4], hv[5]); o1.y = pk2(hv[6], hv[7]);
    *(uint2*)(out + (size_t)row * D + t * 4) = o0;
    *(uint2*)(out + (size_t)row * D + 1024 + t * 4) = o1;
    if (gpre) {
        float gs[8];
#pragma unroll
        for (int c = 0; c < 8; ++c) gs[c] = 0.f;
#pragma unroll
        for (int j = 0; j < 8; ++j) {
            const int k = (j < 4) ? (t * 4 + j) : (1024 + t * 4 + (j - 4));
            const float4 w0 = *(const float4*)(gwl + k * 8), w1 = *(const float4*)(gwl + k * 8 + 4);
            gs[0] = fmaf(hv[j], w0.x, gs[0]); gs[1] = fmaf(hv[j], w0.y, gs[1]); gs[2] = fmaf(hv[j], w0.z, gs[2]); gs[3] = fmaf(hv[j], w0.w, gs[3]);
            gs[4] = fmaf(hv[j], w1.x, gs[4]); gs[5] = fmaf(hv[j], w1.y, gs[5]); gs[6] = fmaf(hv[j], w1.z, gs[6]); gs[7] = fmaf(hv[j], w1.w, gs[7]);
        }
#pragma unroll
        for (int c = 0; c < 8; ++c) gs[c] = wave_sum(gs[c]);
        __syncthreads();
        if ((t & 63) == 0) {
#pragma unroll
            for (int c = 0; c < 8; ++c) red[8 + (t >> 6) * 8 + c] = gs[c];
        }
        __syncthreads();
        if (t < 8) gpre[(size_t)row * 8 + t] = red[8 + t] + red[16 + t] + red[24 + t] + red[32 + t];
    }
}

namespace pg8 {
typedef short bf16x8 __attribute__((ext_vector_type(8)));
typedef float f32x4 __attribute__((ext_vector_type(4)));
constexpr int BM = 256, BK = 64, HALF = 128, HTB = HALF * BK * 2, NXCD = 8, WGM = 8;
__device__ __forceinline__ int lds_byte(int r, int c) { const int st = (r >> 4) * 2 + (c >> 5), rr = r & 15, cc = c & 31, ob = rr * 64 + cc * 2; return st * 1024 + (ob ^ (((ob >> 9) & 1) << 5)); }
__device__ __forceinline__ void stage_rc(int b, int& R, int& C) { const int st = b / 1024, sb = b % 1024, swz = sb ^ (((sb >> 9) & 1) << 5); R = (st >> 1) * 16 + swz / 64; C = (st & 1) * 32 + (swz % 64) / 2; }
__device__ __forceinline__ int perm32(int rho) { const int n = rho >> 4, i = rho & 15; return 8 * (i >> 2) + 4 * n + (i & 3); }
template <int MODE> struct ModePerm { static constexpr bool value = (MODE == 3 || MODE == 4 || MODE == 11 || MODE == 10 || MODE == 5 || MODE == 6 || MODE == 8); };
struct Unit { int pm, pn; };
struct GJob {
    const bf16_t* A; const bf16_t* Bt;
    int lda, ldb, K, nM, nN;
    int a_pn_shift, a_pn_mask, a_pn_step;
    int b_pm_shift, b_pm_step, b_pn_step;
    int a_pm_step;
    int b_pn_mask, b_pn_shift, b_pn_step2;
    int bid0, nblk;
    float escale;
    const float* gs; float* denp; const float* qn; const float* gvec; const bf16_t* mo;
    bf16_t* C2; float* rssp; const float* rstd;
    float* C; int ldc; const float* R; int ldr;
    int mode;
};
__device__ __forceinline__ bool unit_next(const GJob& g, int i, Unit& u) {
    const int nwg = g.nM * g.nN;
    const int bid = (int)blockIdx.x - g.bid0; if (bid < 0 || bid >= g.nblk) return false;
    const long L = (long)i * g.nblk + bid; if (L >= nwg) return false;
    int wgid = (int)L; { const int q = nwg / NXCD, r = nwg % NXCD, xcd = wgid % NXCD, off = wgid / NXCD; wgid = (xcd < r ? xcd * (q + 1) : r * (q + 1) + (xcd - r) * q) + off; }
    const int nig = WGM * g.nN, gid = wgid / nig, fm = gid * WGM, gsz = (g.nM - fm) < WGM ? (g.nM - fm) : WGM;
    u.pm = fm + ((wgid % nig) % gsz); u.pn = (wgid % nig) / gsz; return true;
}
template <int MODE> __device__ __forceinline__ void epilogue(const GJob& g, f32x4 (&acc)[2][2][4][2], const Unit& u, int wr, int wc, int fr, int fq, LAS unsigned char* xlds) {
    const int row0 = u.pm * BM + wr * 64 + fr;
    if constexpr (MODE == 0) {
        const int col0 = u.pn * BM + wc * 32 + 4 * fq;
#pragma unroll
        for (int ai = 0; ai < 2; ++ai)
#pragma unroll
            for (int m = 0; m < 4; ++m) {
                const int row = row0 + ai * HALF + m * 16;
                float* rowp = g.C + (size_t)row * g.ldc + col0;
                const float* rp = g.R ? g.R + (size_t)row * g.ldr + col0 : nullptr;
#pragma unroll
                for (int bj = 0; bj < 2; ++bj)
#pragma unroll
                    for (int n = 0; n < 2; ++n) {
                        f32x4 v = acc[ai][bj][m][n];
                        if (rp) v = v + *(const f32x4*)(rp + bj * HALF + n * 16);
                        *(f32x4*)(rowp + bj * HALF + n * 16) = v;
                    }
            }
    } else if constexpr (MODE == 10) {
        const int col0 = u.pn * BM + wc * 32 + 8 * fq;
#pragma unroll
        for (int ai = 0; ai < 2; ++ai)
#pragma unroll
            for (int m = 0; m < 4; ++m) {
                const int row = row0 + ai * HALF + m * 16;
                bf16_t* r2 = g.C2 + (size_t)row * D + col0;
                float ss = 0.f;
#pragma unroll
                for (int bj = 0; bj < 2; ++bj) {
                    f32x4 v0 = acc[ai][bj][m][0], v1 = acc[ai][bj][m][1];
                    if (g.R) { const float* rp = g.R + (size_t)row * g.ldr + col0 + bj * HALF; v0 = v0 + *(const f32x4*)rp; v1 = v1 + *(const f32x4*)(rp + 4); }
                    else { const uint4 pr = *(const uint4*)(r2 + bj * HALF);
                           v0[0] += __uint_as_float(pr.x << 16); v0[1] += __uint_as_float(pr.x & 0xFFFF0000u); v0[2] += __uint_as_float(pr.y << 16); v0[3] += __uint_as_float(pr.y & 0xFFFF0000u);
                           v1[0] += __uint_as_float(pr.z << 16); v1[1] += __uint_as_float(pr.z & 0xFFFF0000u); v1[2] += __uint_as_float(pr.w << 16); v1[3] += __uint_as_float(pr.w & 0xFFFF0000u); }
                    uint4 o; o.x = pk2(v0[0], v0[1]); o.y = pk2(v0[2], v0[3]); o.z = pk2(v1[0], v1[1]); o.w = pk2(v1[2], v1[3]);
                    *(uint4*)(r2 + bj * HALF) = o;
                    ss += (v0[0] * v0[0] + v0[1] * v0[1]) + (v0[2] * v0[2] + v0[3] * v0[3]) + (v1[0] * v1[0] + v1[1] * v1[1]) + (v1[2] * v1[2] + v1[3] * v1[3]);
                }
                ss += __shfl_xor(ss, 16); ss += __shfl_xor(ss, 32);
                if (fq == 0) g.rssp[(size_t)row * 32 + u.pn * 4 + wc] = ss;
            }
    } else if constexpr (MODE == 11) {
        bf16_t* Cb = (bf16_t*)g.C;
        const int col0 = u.pn * BM + wc * 32 + 8 * fq;
#pragma unroll
        for (int ai = 0; ai < 2; ++ai)
#pragma unroll
            for (int m = 0; m < 4; ++m) {
                const int row = row0 + ai * HALF + m * 16;
                const float rs = ((const LAS float*)(xlds + 8192))[row - u.pm * BM];
                bf16_t* rowp = Cb + (size_t)row * g.ldc + col0;
#pragma unroll
                for (int bj = 0; bj < 2; ++bj) {
                    const f32x4 v0 = acc[ai][bj][m][0] * rs, v1 = acc[ai][bj][m][1] * rs;
                    uint4 o; o.x = pk2(v0[0], v0[1]); o.y = pk2(v0[2], v0[3]); o.z = pk2(v1[0], v1[1]); o.w = pk2(v1[2], v1[3]);
                    *(uint4*)(rowp + bj * HALF) = o;
                }
            }
    } else if constexpr (MODE == 6) {
        const int h = u.pn; const size_t t0 = (size_t)u.pm * BM;
        bf16_t* Cb = (bf16_t*)g.C;
#pragma unroll
        for (int ai = 0; ai < 2; ++ai)
#pragma unroll
            for (int m = 0; m < 4; ++m) {
                const int l = ai * HALF + wr * 64 + m * 16 + fr;
                const float M2 = g.gs[((t0 + l) * 4 + h) * 8 + 1];
                bf16_t* rowp = Cb + (t0 + l) * 2048 + h * 512 + wc * 32 + 8 * fq;
                float rs = 0.f;
#pragma unroll
                for (int bj = 0; bj < 2; ++bj) {
                    unsigned ow[4];
#pragma unroll
                    for (int n = 0; n < 2; ++n) {
                        const f32x4 a = acc[ai][bj][m][n];
                        const int s0 = bj * HALF + wc * 32 + 8 * fq + 4 * n;
                        float p[4];
#pragma unroll
                        for (int r = 0; r < 4; ++r) { const float u2 = g.gs[((t0 + s0 + r) * 4 + h) * 8 + 0]; p[r] = (s0 + r <= l) ? a[r] * __builtin_amdgcn_exp2f(u2 - M2) : 0.f; rs += p[r]; }
                        ow[2 * n] = pk2(p[0], p[1]); ow[2 * n + 1] = pk2(p[2], p[3]);
                    }
                    *(uint4*)(rowp + bj * HALF) = make_uint4(ow[0], ow[1], ow[2], ow[3]);
                }
                rs += __shfl_xor(rs, 16); rs += __shfl_xor(rs, 32);
                if (fq == 0) g.denp[((t0 + l) * 4 + h) * 4 + wc] = rs;
            }
    } else if constexpr (MODE == 12) {
        float* Ct = g.C + (size_t)(u.pn >> 4) * ((size_t)512 * 4096) + (size_t)(u.pn & 15) * 256;
        const int col0 = wc * 32 + 4 * fq;
#pragma unroll
        for (int ai = 0; ai < 2; ++ai)
#pragma unroll
            for (int m = 0; m < 4; ++m) {
                float* rowp = Ct + (size_t)(row0 + ai * HALF + m * 16) * 4096 + col0;
#pragma unroll
                for (int bj = 0; bj < 2; ++bj)
#pragma unroll
                    for (int n = 0; n < 2; ++n) *(f32x4*)(rowp + bj * HALF + n * 16) = acc[ai][bj][m][n];
            }
    } else if constexpr (MODE == 7) {
        float* Ct = g.C + (size_t)(u.pm * 4 + u.pn) * 65536;
        const int col0 = wc * 32 + 4 * fq;
#pragma unroll
        for (int ai = 0; ai < 2; ++ai)
#pragma unroll
            for (int m = 0; m < 4; ++m) {
                float* rowp = Ct + (size_t)(ai * HALF + wr * 64 + m * 16 + fr) * 256 + col0;
#pragma unroll
                for (int bj = 0; bj < 2; ++bj)
#pragma unroll
                    for (int n = 0; n < 2; ++n) *(f32x4*)(rowp + bj * HALF + n * 16) = acc[ai][bj][m][n];
            }
    } else if constexpr (MODE == 8) {
        const int h = u.pn; const size_t t0 = (size_t)u.pm * BM;
        LAS float* X0 = (LAS float*)xlds + wr * 512;
#pragma unroll
        for (int ai = 0; ai < 2; ++ai)
#pragma unroll
            for (int m = 0; m < 4; ++m) {
                const size_t th = (t0 + ai * HALF + wr * 64 + m * 16 + fr) * 4 + h;
                const f32x4 dp = *(const f32x4*)(g.denp + th * 4);
                const float den = (dp[0] + dp[1]) + (dp[2] + dp[3]) + g.gs[th * 8 + 3] * g.qn[th];
                const float rden = 1.0f / fmaxf(fabsf(den), g.gs[th * 8 + 4]);
                float ss = 0.f;
#pragma unroll
                for (int bj = 0; bj < 2; ++bj)
#pragma unroll
                    for (int n = 0; n < 2; ++n) { f32x4 a = acc[ai][bj][m][n] * rden; acc[ai][bj][m][n] = a; ss += (a[0] * a[0] + a[1] * a[1]) + (a[2] * a[2] + a[3] * a[3]); }
                ss += __shfl_xor(ss, 16); ss += __shfl_xor(ss, 32);
                if (fq == 0) X0[(ai * 64 + m * 16 + fr) * 4 + wc] = ss;
            }
        asm volatile("s_waitcnt lgkmcnt(0)" ::: "memory"); __builtin_amdgcn_s_barrier(); asm volatile("" ::: "memory");
        bf16_t* Cb = (bf16_t*)g.C;
        const int col0 = wc * 32 + 8 * fq;
#pragma unroll
        for (int ai = 0; ai < 2; ++ai)
#pragma unroll
            for (int m = 0; m < 4; ++m) {
                const f32x4 p4 = *(const LAS f32x4*)(X0 + (ai * 64 + m * 16 + fr) * 4);
                const float rsn = rsqrtf(((p4[0] + p4[1]) + (p4[2] + p4[3])) * (1.0f / 256.0f) + EPS);
                const size_t t = t0 + ai * HALF + wr * 64 + m * 16 + fr;
                bf16_t* rowp = Cb + t * 2048 + h * 256 + col0;
                const bf16_t* mop = g.mo + t * 1024 + h * 256 + col0;
#pragma unroll
                for (int bj = 0; bj < 2; ++bj) {
                    const uint4 mo8 = *(const uint4*)(mop + bj * HALF);
                    const unsigned mw[4] = {mo8.x, mo8.y, mo8.z, mo8.w};
                    unsigned ow[4];
#pragma unroll
                    for (int n = 0; n < 2; ++n) {
                        const f32x4 a = acc[ai][bj][m][n];
                        const f32x4 gv = *(const f32x4*)(g.gvec + h * 256 + col0 + bj * HALF + 4 * n);
                        const float o0 = a[0] * rsn * gv[0] / (1.0f + __expf(-__uint_as_float(mw[2 * n] << 16)));
                        const float o1 = a[1] * rsn * gv[1] / (1.0f + __expf(-__uint_as_float(mw[2 * n] & 0xFFFF0000u)));
                        const float o2 = a[2] * rsn * gv[2] / (1.0f + __expf(-__uint_as_float(mw[2 * n + 1] << 16)));
                        const float o3 = a[3] * rsn * gv[3] / (1.0f + __expf(-__uint_as_float(mw[2 * n + 1] & 0xFFFF0000u)));
                        ow[2 * n] = pk2(o0, o1); ow[2 * n + 1] = pk2(o2, o3);
                    }
                    *(uint4*)(rowp + bj * HALF) = make_uint4(ow[0], ow[1], ow[2], ow[3]);
                }
            }
    } else if constexpr (MODE == 5) {
        LAS float* X0 = (LAS float*)xlds + wr * 512;
        LAS float* X1 = (LAS float*)xlds + 1024 + wr * 512;
#pragma unroll
        for (int ai = 0; ai < 2; ++ai)
#pragma unroll
            for (int m = 0; m < 4; ++m) {
                float v = -INFINITY;
#pragma unroll
                for (int bj = 0; bj < 2; ++bj)
#pragma unroll
                    for (int n = 0; n < 2; ++n) { const f32x4 a = acc[ai][bj][m][n]; v = fmaxf(v, fmaxf(fmaxf(a[0], a[1]), fmaxf(a[2], a[3]))); }
                v = fmaxf(v, __shfl_xor(v, 16)); v = fmaxf(v, __shfl_xor(v, 32));
                if (fq == 0) X0[(ai * 64 + m * 16 + fr) * 4 + wc] = v;
            }
        asm volatile("s_waitcnt lgkmcnt(0)" ::: "memory"); __builtin_amdgcn_s_barrier(); asm volatile("" ::: "memory");
#pragma unroll
        for (int ai = 0; ai < 2; ++ai)
#pragma unroll
            for (int m = 0; m < 4; ++m) {
                const f32x4 p4 = *(const LAS f32x4*)(X0 + (ai * 64 + m * 16 + fr) * 4);
                const float mxr = fmaxf(fmaxf(p4[0], p4[1]), fmaxf(p4[2], p4[3])) * g.escale;
                float s = 0.f;
#pragma unroll
                for (int bj = 0; bj < 2; ++bj)
#pragma unroll
                    for (int n = 0; n < 2; ++n) { f32x4 a = acc[ai][bj][m][n];
                        a[0] = __builtin_amdgcn_exp2f(a[0] * g.escale - mxr); a[1] = __builtin_amdgcn_exp2f(a[1] * g.escale - mxr); a[2] = __builtin_amdgcn_exp2f(a[2] * g.escale - mxr); a[3] = __builtin_amdgcn_exp2f(a[3] * g.escale - mxr);
                        acc[ai][bj][m][n] = a; s += (a[0] + a[1]) + (a[2] + a[3]); }
                s += __shfl_xor(s, 16); s += __shfl_xor(s, 32);
                if (fq == 0) X1[(ai * 64 + m * 16 + fr) * 4 + wc] = s;
            }
        asm volatile("s_waitcnt lgkmcnt(0)" ::: "memory"); __builtin_amdgcn_s_barrier(); asm volatile("" ::: "memory");
        bf16_t* Cb = (bf16_t*)g.C;
        const int col0 = u.pn * BM + wc * 32 + 8 * fq;
#pragma unroll
        for (int ai = 0; ai < 2; ++ai)
#pragma unroll
            for (int m = 0; m < 4; ++m) {
                const f32x4 p4 = *(const LAS f32x4*)(X1 + (ai * 64 + m * 16 + fr) * 4);
                const float inv = 1.0f / ((p4[0] + p4[1]) + (p4[2] + p4[3]));
                bf16_t* rowp = Cb + (size_t)(row0 + ai * HALF + m * 16) * g.ldc + col0;
#pragma unroll
                for (int bj = 0; bj < 2; ++bj) {
                    const f32x4 a = acc[ai][bj][m][0], b = acc[ai][bj][m][1];
                    uint4 o; o.x = pk2(a[0] * inv, a[1] * inv); o.y = pk2(a[2] * inv, a[3] * inv); o.z = pk2(b[0] * inv, b[1] * inv); o.w = pk2(b[2] * inv, b[3] * inv);
                    *(uint4*)(rowp + bj * HALF) = o;
                }
            }
    } else {
        bf16_t* Cb = (bf16_t*)g.C; int ccol = u.pn * BM;
        if constexpr (MODE == 4) { Cb += (size_t)(u.pn >> 2) * P6S; ccol = (u.pn & 3) * 256; }
        const int col0 = ccol + wc * 32 + 8 * fq;
#pragma unroll
        for (int ai = 0; ai < 2; ++ai)
#pragma unroll
            for (int m = 0; m < 4; ++m) {
                bf16_t* rowp = Cb + (size_t)(row0 + ai * HALF + m * 16) * g.ldc + col0;
#pragma unroll
                for (int bj = 0; bj < 2; ++bj) {
                    const f32x4 v0 = acc[ai][bj][m][0], v1 = acc[ai][bj][m][1];
                    uint4 o; o.x = pk2(v0[0], v0[1]); o.y = pk2(v0[2], v0[3]); o.z = pk2(v1[0], v1[1]); o.w = pk2(v1[2], v1[3]);
                    *(uint4*)(rowp + bj * HALF) = o;
                }
            }
    }
}
template <int MODE> __device__ __forceinline__ void gemm_phase(LAS unsigned char* lds, const GJob& g, int tid) {
    const int wid = __builtin_amdgcn_readfirstlane(tid >> 6), lane = tid & 63, wr = wid >> 2, wc = wid & 3, fr = lane & 15, fq = lane >> 4;
    const int K = g.K, nt = K / BK;
    unsigned voffA[2], voffB[2];
#pragma unroll
    for (int i = 0; i < 2; ++i) { int R, C; stage_rc(tid * 16 + i * 8192, R, C);
        const int Rb = ModePerm<MODE>::value ? ((R & ~31) + perm32(R & 31)) : R;
        voffA[i] = (unsigned)(R * g.lda + C) * 2u; voffB[i] = (unsigned)(Rb * g.ldb + C) * 2u; }
    const size_t kstep = (size_t)(BK * 2);
    const size_t hstepA = (size_t)HALF * g.lda * 2, hstepB = (size_t)HALF * g.ldb * 2;
    const unsigned ldsw = (unsigned)wid * 1024u;
    const int aoff = lds_byte(wr * 64 + fr, fq * 8), boff = lds_byte(wc * 32 + fr, fq * 8);
#define PG8_SA(b, h) (((b) * 2 + (h)) * HTB)
#define PG8_SB(b, h) ((4 + (b) * 2 + (h)) * HTB)
#define PG8_STAGE(bufoff, gbase, voff) do { _Pragma("unroll") for (int _i = 0; _i < 2; ++_i) \
        __builtin_amdgcn_global_load_lds((const unsigned*)((const char*)(gbase) + (voff)[_i]), (LAS unsigned*)(lds + (bufoff) + ldsw + _i * 8192), 16, 0, 0); } while (0)
#define PG8_LDA(dst, b, h) do { _Pragma("unroll") for (int m = 0; m < 4; ++m) _Pragma("unroll") for (int k = 0; k < 2; ++k) dst[m][k] = *(const LAS bf16x8*)(lds + PG8_SA(b, h) + aoff + m * 2048 + k * 1024); } while (0)
#define PG8_LDB(dst, b, h) do { _Pragma("unroll") for (int n = 0; n < 2; ++n) _Pragma("unroll") for (int k = 0; k < 2; ++k) dst[n][k] = *(const LAS bf16x8*)(lds + PG8_SB(b, h) + boff + n * 2048 + k * 1024); } while (0)
#define PG8_MMA(ai, bj, At, Bt) do { __builtin_amdgcn_s_setprio(1); _Pragma("unroll") for (int m = 0; m < 4; ++m) _Pragma("unroll") for (int n = 0; n < 2; ++n) _Pragma("unroll") for (int k = 0; k < 2; ++k) \
        acc[ai][bj][m][n] = __builtin_amdgcn_mfma_f32_16x16x32_bf16(Bt[n][k], At[m][k], acc[ai][bj][m][n], 0, 0, 0); __builtin_amdgcn_s_setprio(0); } while (0)
#define PG8_WAIT_V(n) asm volatile("s_waitcnt vmcnt(" #n ")" ::: "memory")
#define PG8_WAIT_L(n) asm volatile("s_waitcnt lgkmcnt(" #n ")" ::: "memory")
#define PG8_BAR __builtin_amdgcn_s_barrier()
#define PG8_SCHED __builtin_amdgcn_sched_barrier(0)
#define PG8_ABASE(u) ((const char*)g.A + ((size_t)(u).pm * g.a_pm_step + (size_t)(((u).pn >> g.a_pn_shift) & g.a_pn_mask) * g.a_pn_step) * 2)
#define PG8_BBASE(u) ((const char*)g.Bt + ((size_t)((u).pn & g.b_pn_mask) * g.b_pn_step + (size_t)((u).pn >> g.b_pn_shift) * g.b_pn_step2 + (size_t)((u).pm >> g.b_pm_shift) * g.b_pm_step) * 2)
    Unit cur, nxt; int ui = 0;
    if (!unit_next(g, 0, cur)) return;
    f32x4 acc[2][2][4][2];
#pragma unroll
    for (int a = 0; a < 2; ++a)
#pragma unroll
        for (int b = 0; b < 2; ++b)
#pragma unroll
            for (int m = 0; m < 4; ++m)
#pragma unroll
                for (int n = 0; n < 2; ++n) acc[a][b][m][n] = (f32x4){0.f, 0.f, 0.f, 0.f};
    bf16x8 At[4][2], B0[2][2], B1[2][2];
    const char* cA = PG8_ABASE(cur); const char* cB = PG8_BBASE(cur);
    PG8_STAGE(PG8_SB(0, 0), cB, voffB); PG8_STAGE(PG8_SA(0, 0), cA, voffA); PG8_STAGE(PG8_SB(0, 1), cB + hstepB, voffB); PG8_STAGE(PG8_SA(0, 1), cA + hstepA, voffA);
    if (wr == 1) PG8_BAR;
    PG8_WAIT_V(4); PG8_BAR;
    PG8_STAGE(PG8_SB(1, 0), cB + kstep, voffB); PG8_STAGE(PG8_SA(1, 0), cA + kstep, voffA); PG8_STAGE(PG8_SB(1, 1), cB + hstepB + kstep, voffB);
    PG8_WAIT_V(6); PG8_BAR;
    for (;;) {
        const bool has_next = unit_next(g, ui + 1, nxt);
        const char* nA = has_next ? PG8_ABASE(nxt) : cA; const char* nB = has_next ? PG8_BBASE(nxt) : cB;
        for (int t = 0; t < nt; t += 2) {
            const bool last = (t == nt - 2);
            const char* a1 = cA + (size_t)(t + 1) * kstep;
            const char* a2 = last ? nA : cA + (size_t)(t + 2) * kstep; const char* b2 = last ? nB : cB + (size_t)(t + 2) * kstep;
            const char* a3 = a2 + kstep; const char* b3 = b2 + kstep;
            PG8_LDB(B0, 0, 0); PG8_SCHED; PG8_LDA(At, 0, 0); PG8_STAGE(PG8_SA(1, 1), a1 + hstepA, voffA);
            PG8_WAIT_L(8); PG8_BAR; PG8_WAIT_L(0); PG8_MMA(0, 0, At, B0); PG8_BAR; PG8_SCHED;
            PG8_LDB(B1, 0, 1); PG8_STAGE(PG8_SB(0, 0), b2, voffB);
            PG8_BAR; PG8_WAIT_L(0); PG8_MMA(0, 1, At, B1); PG8_BAR;
            PG8_LDA(At, 0, 1); PG8_STAGE(PG8_SA(0, 0), a2, voffA);
            PG8_BAR; PG8_WAIT_L(0); PG8_MMA(1, 0, At, B0); PG8_BAR; PG8_SCHED;
            PG8_STAGE(PG8_SB(0, 1), b2 + hstepB, voffB);
            PG8_WAIT_V(6); PG8_BAR; PG8_MMA(1, 1, At, B1); PG8_BAR;
            PG8_LDB(B0, 1, 0); PG8_SCHED; PG8_LDA(At, 1, 0); PG8_STAGE(PG8_SA(0, 1), a2 + hstepA, voffA);
            PG8_WAIT_L(8); PG8_BAR; PG8_WAIT_L(0); PG8_MMA(0, 0, At, B0); PG8_BAR; PG8_SCHED;
            PG8_LDB(B1, 1, 1); PG8_STAGE(PG8_SB(1, 0), b3, voffB);
            PG8_BAR; PG8_WAIT_L(0); PG8_MMA(0, 1, At, B1); PG8_BAR;
            PG8_LDA(At, 1, 1); PG8_STAGE(PG8_SA(1, 0), a3, voffA);
            PG8_BAR; PG8_WAIT_L(0); PG8_MMA(1, 0, At, B0); PG8_BAR; PG8_SCHED;
            PG8_STAGE(PG8_SB(1, 1), b3 + hstepB, voffB);
            PG8_WAIT_V(6); PG8_BAR; PG8_MMA(1, 1, At, B1); PG8_BAR;
        }
        epilogue<MODE>(g, acc, cur, wr, wc, fr, fq, lds + GEMM_LDS + 1024);
        if (!has_next) break;
#pragma unroll
        for (int a = 0; a < 2; ++a)
#pragma unroll
            for (int b = 0; b < 2; ++b)
#pragma unroll
                for (int m = 0; m < 4; ++m)
#pragma unroll
                    for (int n = 0; n < 2; ++n) acc[a][b][m][n] = (f32x4){0.f, 0.f, 0.f, 0.f};
        cur = nxt; cA = nA; cB = nB; ++ui;
    }
    PG8_WAIT_V(0);
    if (wr == 0) PG8_BAR;
    PG8_BAR;
#undef PG8_SA
#undef PG8_SB
#undef PG8_STAGE
#undef PG8_LDA
#undef PG8_LDB
#undef PG8_MMA
#undef PG8_WAIT_V
#undef PG8_WAIT_L
#undef PG8_BAR
#undef PG8_SCHED
#undef PG8_ABASE
#undef PG8_BBASE
}
}

__device__ __forceinline__ void p0_transpose_item(const float* W, int ldw, int K, int csrc0, bf16_t* WT, int row0, LAS float* scr, int kb, int lane, float wscale, const float* kgain) {
    const int k0 = 64 * kb;
#pragma unroll
    for (int i = 0; i < 8; ++i) { const int kk = 8 * i + (lane >> 3), n4 = (lane & 7) * 4;
        const float4 v = *(const float4*)(W + (size_t)(k0 + kk) * ldw + csrc0 + n4);
        const float ws = kgain ? kgain[k0 + kk] : wscale; (void)wscale;
        scr[kk * 33 + n4] = v.x * ws; scr[kk * 33 + n4 + 1] = v.y * ws; scr[kk * 33 + n4 + 2] = v.z * ws; scr[kk * 33 + n4 + 3] = v.w * ws; }
    asm volatile("s_waitcnt lgkmcnt(0)" ::: "memory");
    const int c = lane & 7;
#pragma unroll
    for (int j = 0; j < 4; ++j) { const int n = (lane >> 3) + 8 * j; const LAS float* s = scr + (8 * c) * 33 + n;
        uint4 o; o.x = pk2(s[0 * 33], s[1 * 33]); o.y = pk2(s[2 * 33], s[3 * 33]); o.z = pk2(s[4 * 33], s[5 * 33]); o.w = pk2(s[6 * 33], s[7 * 33]);
        *(uint4*)(WT + (size_t)(row0 + n) * K + k0 + 8 * c) = o; }
    asm volatile("s_waitcnt lgkmcnt(0)" ::: "memory");
}

__device__ __forceinline__ void d_conv_silu(int vb, int tid, const bf16_t* __restrict__ p6, const float* __restrict__ cw, const float* __restrict__ cb, bf16_t* __restrict__ c) {
    const int t = vb, s = t % S;
    for (int ch = tid; ch < 1024; ch += 256) {
        float y = cb[ch];
#pragma unroll
        for (int j = 0; j < 4; ++j) {
            const int ss = s - 3 + j;
            if (ss >= 0) y = fmaf(cw[j * 1024 + ch], bf2f(p6[(size_t)(t - 3 + j) * 1024 + ch]), y);
        }
        c[(size_t)t * 1024 + ch] = (bf16_t)f2bf(y / (1.0f + expf(-y)));
    }
}

__device__ __forceinline__ void d_mlstm(int vb, int tid, const bf16_t* __restrict__ mq, const bf16_t* __restrict__ mk, const bf16_t* __restrict__ p6,
                                        const float* __restrict__ gpre, const float* __restrict__ b_mi, const float* __restrict__ b_mf, float* __restrict__ hraw) {
    const int lane = tid & 63, w = tid >> 6;
    const int gid = vb * 4 + w;
    const int e = gid & 255, h = (gid >> 8) & 3, b = gid >> 10;
    const float bi = b_mi[h], bf = b_mf[h];
    float C0 = 0.f, C1 = 0.f, C2 = 0.f, C3 = 0.f, n0 = 0.f, n1 = 0.f, n2 = 0.f, n3 = 0.f, m = 0.f;
    const size_t tb = (size_t)b * S;
    const bf16_t* qp = mq + tb * 1024 + h * 256 + lane * 4;
    const bf16_t* kp = mk + tb * 1024 + h * 256 + lane * 4;
    const bf16_t* pp = p6 + P6S + tb * 1024 + h * 256 + e;
    ushort4 qn = *(const ushort4*)qp, kn = *(const ushort4*)kp;
    const float* gp = gpre + tb * 8;
    float vn = bf2f(pp[0]), in_ = gp[h], fn = gp[4 + h];
    for (int s = 0; s < S; ++s) {
        const float4 q = make_float4(bf2f(qn.x), bf2f(qn.y), bf2f(qn.z), bf2f(qn.w)), k = make_float4(bf2f(kn.x), bf2f(kn.y), bf2f(kn.z), bf2f(kn.w)); const float v = vn, ipre = in_ + bi, fpre = fn + bf;
        if (s + 1 < S) {
            qn = *(const ushort4*)(qp + (size_t)(s + 1) * 1024);
            kn = *(const ushort4*)(kp + (size_t)(s + 1) * 1024);
            vn = bf2f(pp[(size_t)(s + 1) * 1024]); in_ = gp[(size_t)(s + 1) * 8 + h]; fn = gp[(size_t)(s + 1) * 8 + 4 + h];
        }
        const float logf = log_sigmoid(fpre);
        const float mnew = fmaxf(logf + m, ipre);
        const float fd = expf(logf + m - mnew), ig = expf(ipre - mnew);
        m = mnew;
        const float sc = ig * 0.0625f;
        C0 = fd * C0 + sc * k.x * v; C1 = fd * C1 + sc * k.y * v; C2 = fd * C2 + sc * k.z * v; C3 = fd * C3 + sc * k.w * v;
        n0 = fd * n0 + sc * k.x; n1 = fd * n1 + sc * k.y; n2 = fd * n2 + sc * k.z; n3 = fd * n3 + sc * k.w;
        float num = q.x * C0 + q.y * C1 + q.z * C2 + q.w * C3;
        float den = q.x * n0 + q.y * n1 + q.z * n2 + q.w * n3;
        num = wave_sum(num); den = wave_sum(den);
        if (lane == 0) hraw[(tb + s) * 1024 + h * 256 + e] = num / fmaxf(fabsf(den), expf(-mnew));
    }
}

__device__ __forceinline__ void d_mhead_norm(int vb, int tid, const float* __restrict__ hraw, const bf16_t* __restrict__ p6, const float* __restrict__ g, bf16_t* __restrict__ mix) {
    const int t = vb, h = tid >> 6, lane = tid & 63;
    const float4 v = *(const float4*)(hraw + (size_t)t * 1024 + h * 256 + lane * 4);
    float s = v.x * v.x + v.y * v.y + v.z * v.z + v.w * v.w;
    s = wave_sum(s);
    const float r = rsqrtf(s * (1.0f / 256.0f) + EPS);
    const float4 gg = *(const float4*)(g + h * 256 + lane * 4);
    const ushort4 mo = *(const ushort4*)(p6 + 2 * P6S + (size_t)t * 1024 + h * 256 + lane * 4);
    float4 o;
    o.x = v.x * r * gg.x / (1.0f + expf(-bf2f(mo.x)));
    o.y = v.y * r * gg.y / (1.0f + expf(-bf2f(mo.y)));
    o.z = v.z * r * gg.z / (1.0f + expf(-bf2f(mo.z)));
    o.w = v.w * r * gg.w / (1.0f + expf(-bf2f(mo.w)));
    uint2 ob; ob.x = pk2(o.x, o.y); ob.y = pk2(o.z, o.w);
    *(uint2*)(mix + (size_t)t * D + h * 256 + lane * 4) = ob;
}

__device__ __forceinline__ void d_rope(int vb, int tid, bf16_t* __restrict__ p6) {
    const int t = vb, s = t % S;
    for (int idx = tid; idx < 2 * 8 * 64; idx += 256) {
        const int i = idx & 63, hd = (idx >> 6) & 7, qk = idx >> 9;
        const float inv = exp2f(-(float)i * 0.20762050593046014f);
        const float ang = (float)s * inv;
        float sn, cs; sincosf(ang, &sn, &cs);
        bf16_t* p = p6 + (size_t)(3 + qk) * P6S + (size_t)t * 1024 + hd * 128;
        const float x1 = bf2f(p[i]), x2 = bf2f(p[64 + i]);
        p[i] = (bf16_t)f2bf(x1 * cs - x2 * sn);
        p[64 + i] = (bf16_t)f2bf(x2 * cs + x1 * sn);
    }
}

__device__ __forceinline__ void d_dilated(int vb, int tid, float* sm, const bf16_t* __restrict__ p6, const float* __restrict__ g_ahead, bf16_t* __restrict__ mix) {
    float (*qs)[128] = (float (*)[128])sm;
    float (*ps)[576] = (float (*)[576])(sm + 512);
    const int lane = tid & 63, w = tid >> 6;
    const int gid = vb * 4 + w;
    const int s = gid % S, hd = (gid / S) & 7, b = gid / (S * 8);
    const size_t t = (size_t)b * S + s;
    const bf16_t* qrow = p6 + 3 * P6S + t * 1024 + hd * 128;
    __syncthreads();
    qs[w][lane] = bf2f(qrow[lane]); qs[w][lane + 64] = bf2f(qrow[lane + 64]);
    __syncthreads();
    const float scale = 0.08838834764831845f;
    float mloc = -INFINITY;
    for (int br = 0; br < 3; ++br) {
        const int dil = br == 0 ? 1 : (br == 1 ? 4 : 16);
        for (int jj = 0; jj < 192; jj += 64) {
            const int j = jj + lane;
            float sc = -INFINITY;
            if (j <= 128 && s - j * dil >= 0) {
                const bf16_t* krow = p6 + 4 * P6S + (t - (size_t)j * dil) * 1024 + hd * 128;
                float d = 0.f;
#pragma unroll 8
                for (int c = 0; c < 128; c += 4) {
                    const ushort4 kv = *(const ushort4*)(krow + c);
                    d = fmaf(qs[w][c], bf2f(kv.x), d); d = fmaf(qs[w][c + 1], bf2f(kv.y), d); d = fmaf(qs[w][c + 2], bf2f(kv.z), d); d = fmaf(qs[w][c + 3], bf2f(kv.w), d);
                }
                sc = d * scale;
            }
            ps[w][br * 192 + j] = sc;
            mloc = fmaxf(mloc, sc);
        }
    }
    const float mx = wave_max(mloc);
    __syncthreads();
    float lsum = 0.f;
    for (int i = lane; i < 3 * 192; i += 64) {
        const float sc = ps[w][i];
        const float pv = (sc == -INFINITY) ? 0.f : expf(sc - mx);
        ps[w][i] = pv; lsum += pv;
    }
    const float tot = wave_sum(lsum);
    __syncthreads();
    float o0 = 0.f, o1 = 0.f;
    for (int br = 0; br < 3; ++br) {
        const int dil = br == 0 ? 1 : (br == 1 ? 4 : 16);
        for (int j = 0; j <= 128; ++j) {
            if (s - j * dil < 0) break;
            const float pv = ps[w][br * 192 + j];
            const bf16_t* vrow = p6 + 5 * P6S + (t - (size_t)j * dil) * 1024 + hd * 128;
            o0 = fmaf(pv, bf2f(vrow[lane]), o0); o1 = fmaf(pv, bf2f(vrow[lane + 64]), o1);
        }
    }
    o0 /= tot; o1 /= tot;
    float ss = wave_sum(o0 * o0 + o1 * o1);
    const float r = rsqrtf(ss * (1.0f / 128.0f) + EPS);
    bf16_t* orow = mix + t * D + 1024 + hd * 128;
    orow[lane] = (bf16_t)f2bf(o0 * r * g_ahead[hd * 128 + lane]);
    orow[lane + 64] = (bf16_t)f2bf(o1 * r * g_ahead[hd * 128 + lane + 64]);
}

__device__ __forceinline__ void d_cross(int vb, int tid, float* sm, const bf16_t* __restrict__ q, const float* __restrict__ km, const float* __restrict__ vm, bf16_t* __restrict__ o) {
    float (*qs)[512] = (float (*)[512])sm;
    float (*ps)[256] = (float (*)[256])(sm + 2048);
    const int lane = tid & 63, w = tid >> 6;
    const int t = vb, hd = w, b = t / S;
    const bf16_t* qrow = q + (size_t)t * D + hd * 512;
    __syncthreads();
    for (int i = lane; i < 512; i += 64) qs[w][i] = bf2f(qrow[i]);
    __syncthreads();
    const float scale = 0.04419417382415922f;
    float sc[4]; float mloc = -INFINITY;
#pragma unroll
    for (int r = 0; r < 4; ++r) {
        const int mi = lane + 64 * r;
        const float* krow = km + ((size_t)b * 256 + mi) * D + hd * 512;
        float d = 0.f;
#pragma unroll 8
        for (int c = 0; c < 512; c += 4) {
            const float4 kv = *(const float4*)(krow + c);
            d = fmaf(qs[w][c], kv.x, d); d = fmaf(qs[w][c + 1], kv.y, d); d = fmaf(qs[w][c + 2], kv.z, d); d = fmaf(qs[w][c + 3], kv.w, d);
        }
        sc[r] = d * scale; mloc = fmaxf(mloc, sc[r]);
    }
    const float mx = wave_max(mloc);
    float lsum = 0.f;
#pragma unroll
    for (int r = 0; r < 4; ++r) { const float pv = expf(sc[r] - mx); ps[w][lane + 64 * r] = pv; lsum += pv; }
    const float tot = wave_sum(lsum);
    __syncthreads();
    float acc[8];
#pragma unroll
    for (int i = 0; i < 8; ++i) acc[i] = 0.f;
    for (int mi = 0; mi < 256; ++mi) {
        const float pv = ps[w][mi];
        const float* vrow = vm + ((size_t)b * 256 + mi) * D + hd * 512;
#pragma unroll
        for (int i = 0; i < 8; ++i) acc[i] = fmaf(pv, vrow[lane + 64 * i], acc[i]);
    }
    bf16_t* orow = o + (size_t)t * D + hd * 512;
#pragma unroll
    for (int i = 0; i < 8; ++i) orow[lane + 64 * i] = (bf16_t)f2bf(acc[i] / tot);
}

__device__ __forceinline__ void wave_argmax(float& best, int& bidx) {
#pragma unroll
    for (int o = 32; o >= 1; o >>= 1) {
        const float ob = __shfl_xor(best, o); const int oi = __shfl_xor(bidx, o);
        if (ob > best || (ob == best && oi < bidx)) { best = ob; bidx = oi; }
    }
}
__device__ __forceinline__ void d_peer_topk(int vb, int tid, float* sm, const bf16_t* __restrict__ qp, const float* __restrict__ sub_keys, int* __restrict__ ids, float* __restrict__ gates) {
    float (*qs)[256] = (float (*)[256])sm;
    const int lane = tid & 63, w = tid >> 6;
    const int gid = vb * 4 + w;
    const int hd = gid & 7, t = gid >> 3;
    const bf16_t* qrow = qp + (size_t)t * D + hd * 256;
    __syncthreads();
    for (int i = lane; i < 256; i += 64) qs[w][i] = bf2f(qrow[i]);
    __syncthreads();
    float tops[2]; int topi[2];
#pragma unroll
    for (int p = 0; p < 2; ++p) {
        float v0, v1;
        {
            const float* k0 = sub_keys + ((size_t)(hd * 2 + p) * 128 + lane) * 128;
            const float* k1 = k0 + 64 * 128;
            float d0 = 0.f, d1 = 0.f;
#pragma unroll 8
            for (int c = 0; c < 128; c += 4) {
                const float4 a = *(const float4*)(k0 + c), bb = *(const float4*)(k1 + c);
                const float q0 = qs[w][p * 128 + c], q1 = qs[w][p * 128 + c + 1], q2 = qs[w][p * 128 + c + 2], q3 = qs[w][p * 128 + c + 3];
                d0 = fmaf(q0, a.x, d0); d0 = fmaf(q1, a.y, d0); d0 = fmaf(q2, a.z, d0); d0 = fmaf(q3, a.w, d0);
                d1 = fmaf(q0, bb.x, d1); d1 = fmaf(q1, bb.y, d1); d1 = fmaf(q2, bb.z, d1); d1 = fmaf(q3, bb.w, d1);
            }
            v0 = d0; v1 = d1;
        }
        float ts = 0.f; int ti = 0;
        for (int it = 0; it < 16; ++it) {
            float best; int bidx;
            if (v0 >= v1) { best = v0; bidx = lane; } else { best = v1; bidx = lane + 64; }
            wave_argmax(best, bidx);
            if (lane == it) { ts = best; ti = bidx; }
            if (bidx == lane) v0 = -INFINITY;
            if (bidx == lane + 64) v1 = -INFINITY;
        }
        tops[p] = ts; topi[p] = ti;
    }
    float cv[4]; int ci[4];
#pragma unroll
    for (int r = 0; r < 4; ++r) {
        const int c = lane * 4 + r, i = c >> 4, j = c & 15;
        const float s0 = __shfl(tops[0], i), s1 = __shfl(tops[1], j);
        const int i0 = __shfl(topi[0], i), i1 = __shfl(topi[1], j);
        cv[r] = s0 + s1; ci[r] = i0 * 128 + i1;
    }
    float bs = 0.f; int bid = 0;
    for (int it = 0; it < 16; ++it) {
        float best = cv[0]; int bidx = lane * 4;
#pragma unroll
        for (int r = 1; r < 4; ++r) if (cv[r] > best) { best = cv[r]; bidx = lane * 4 + r; }
        wave_argmax(best, bidx);
        const int owner = bidx >> 2, rr = bidx & 3;
        int myid = ci[0];
        if (rr == 1) myid = ci[1]; else if (rr == 2) myid = ci[2]; else if (rr == 3) myid = ci[3];
        const int eid = __shfl(myid, owner);
        if (lane == it) { bs = best; bid = eid; }
        if (owner == lane) {
#pragma unroll
            for (int r = 0; r < 4; ++r) if (rr == r) cv[r] = -INFINITY;
        }
    }
    float v = lane < 16 ? bs : -INFINITY;
    const float mx = wave_max(v);
    const float ev = lane < 16 ? expf(bs - mx) : 0.f;
    const float tot = wave_sum(ev);
    if (lane < 16) {
        ids[(size_t)t * 128 + hd * 16 + lane] = bid;
        gates[(size_t)t * 128 + hd * 16 + lane] = ev / tot;
    }
}

__device__ __forceinline__ void d_peer_out(int vb, int tid, float* sm, const bf16_t* __restrict__ h3, const float* __restrict__ x2, const int* __restrict__ ids, const float* __restrict__ gates,
                                           const bf16_t* __restrict__ u_tab, const bf16_t* __restrict__ v_tab, const float* __restrict__ g_final, float* __restrict__ out) {
    float (*part)[2048] = (float (*)[2048])sm;
    float* red = sm + 4 * 2048;
    const int lane = tid & 63, w = tid >> 6, t = vb;
    float4 xr[8], acc[8];
    const bf16_t* hrow = h3 + (size_t)t * D;
#pragma unroll
    for (int i = 0; i < 8; ++i) { const ushort4 hv = *(const ushort4*)(hrow + i * 256 + lane * 4);
        xr[i] = make_float4(bf2f(hv.x), bf2f(hv.y), bf2f(hv.z), bf2f(hv.w)); acc[i] = make_float4(0.f, 0.f, 0.f, 0.f); }
    for (int j = 0; j < 32; ++j) {
        const int slot = w * 32 + j;
        const int e = ids[(size_t)t * 128 + slot];
        const float gt = gates[(size_t)t * 128 + slot];
        const bf16_t* ur = u_tab + (size_t)e * D;
        const bf16_t* vr = v_tab + (size_t)e * D;
        float d = 0.f;
#pragma unroll
        for (int i = 0; i < 8; ++i) {
            const ushort4 u = *(const ushort4*)(ur + i * 256 + lane * 4);
            d = fmaf(xr[i].x, bf2f(u.x), d); d = fmaf(xr[i].y, bf2f(u.y), d); d = fmaf(xr[i].z, bf2f(u.z), d); d = fmaf(xr[i].w, bf2f(u.w), d);
        }
        d = wave_sum(d);
        const float act = 0.5f * d * (1.0f + erff(d * 0.7071067811865476f));
        const float cf = gt * act;
#pragma unroll
        for (int i = 0; i < 8; ++i) {
            const ushort4 v = *(const ushort4*)(vr + i * 256 + lane * 4);
            acc[i].x = fmaf(cf, bf2f(v.x), acc[i].x); acc[i].y = fmaf(cf, bf2f(v.y), acc[i].y); acc[i].z = fmaf(cf, bf2f(v.z), acc[i].z); acc[i].w = fmaf(cf, bf2f(v.w), acc[i].w);
        }
    }
    __syncthreads();
#pragma unroll
    for (int i = 0; i < 8; ++i) *(float4*)&part[w][i * 256 + lane * 4] = acc[i];
    __syncthreads();
    float4 r0, r1;
    {
        const float4 a = *(const float4*)&part[0][tid * 4], b = *(const float4*)&part[1][tid * 4], c = *(const float4*)&part[2][tid * 4], d = *(const float4*)&part[3][tid * 4];
        const float4 x = *(const float4*)(x2 + (size_t)t * D + tid * 4);
        r0 = make_float4(x.x + a.x + b.x + c.x + d.x, x.y + a.y + b.y + c.y + d.y, x.z + a.z + b.z + c.z + d.z, x.w + a.w + b.w + c.w + d.w);
    }
    {
        const float4 a = *(const float4*)&part[0][1024 + tid * 4], b = *(const float4*)&part[1][1024 + tid * 4], c = *(const float4*)&part[2][1024 + tid * 4], d = *(const float4*)&part[3][1024 + tid * 4];
        const float4 x = *(const float4*)(x2 + (size_t)t * D + 1024 + tid * 4);
        r1 = make_float4(x.x + a.x + b.x + c.x + d.x, x.y + a.y + b.y + c.y + d.y, x.z + a.z + b.z + c.z + d.z, x.w + a.w + b.w + c.w + d.w);
    }
    float s = r0.x * r0.x + r0.y * r0.y + r0.z * r0.z + r0.w * r0.w + r1.x * r1.x + r1.y * r1.y + r1.z * r1.z + r1.w * r1.w;
    s = wave_sum(s);
    if (lane == 0) red[w] = s;
    __syncthreads();
    const float tot = red[0] + red[1] + red[2] + red[3];
    const float r = rsqrtf(tot * (1.0f / D) + EPS);
    const float4 g0 = *(const float4*)(g_final + tid * 4), g1 = *(const float4*)(g_final + 1024 + tid * 4);
    *(float4*)(out + (size_t)t * D + tid * 4) = make_float4(r0.x * r * g0.x, r0.y * r * g0.y, r0.z * r * g0.z, r0.w * r * g0.w);
    *(float4*)(out + (size_t)t * D + 1024 + tid * 4) = make_float4(r1.x * r * g1.x, r1.y * r * g1.y, r1.z * r * g1.z, r1.w * r * g1.w);
}


__device__ __forceinline__ float wave_sum_dpp(float v);
__device__ __forceinline__ void rmsnorm_row_wave(int row, int lane, const float* __restrict__ in, const float* __restrict__ g, bf16_t* __restrict__ out, const float* gwT, float* __restrict__ gpre) {
    float4 x[8];
    const float* p = in + (size_t)row * D + lane * 4;
#pragma unroll
    for (int i = 0; i < 8; ++i) x[i] = *(const float4*)(p + i * 256);
    float s = 0.f;
#pragma unroll
    for (int i = 0; i < 8; ++i) s += (x[i].x * x[i].x + x[i].y * x[i].y) + (x[i].z * x[i].z + x[i].w * x[i].w);
    s = wave_sum_dpp(s);
    const float r = rsqrtf(s * (1.0f / D) + EPS);
    bf16_t* o = out + (size_t)row * D + lane * 4;
#pragma unroll
    for (int i = 0; i < 8; ++i) {
        const float4 gv = *(const float4*)(g + i * 256 + lane * 4);
        x[i].x *= r * gv.x; x[i].y *= r * gv.y; x[i].z *= r * gv.z; x[i].w *= r * gv.w;
        uint2 w; w.x = pk2(x[i].x, x[i].y); w.y = pk2(x[i].z, x[i].w);
        *(uint2*)(o + i * 256) = w;
    }
    if (gpre) {
#pragma unroll 1
        for (int c = 0; c < 8; c += 2) {
            float a0 = 0.f, a1 = 0.f;
#pragma unroll
            for (int i = 0; i < 8; ++i) {
                const float4 w0 = *(const float4*)(gwT + c * 2048 + i * 256 + lane * 4), w1 = *(const float4*)(gwT + (c + 1) * 2048 + i * 256 + lane * 4);
                a0 = fmaf(x[i].x, w0.x, a0); a0 = fmaf(x[i].y, w0.y, a0); a0 = fmaf(x[i].z, w0.z, a0); a0 = fmaf(x[i].w, w0.w, a0);
                a1 = fmaf(x[i].x, w1.x, a1); a1 = fmaf(x[i].y, w1.y, a1); a1 = fmaf(x[i].z, w1.z, a1); a1 = fmaf(x[i].w, w1.w, a1);
            }
            const float t0_ = wave_sum_dpp(a0), t1_ = wave_sum_dpp(a1);
            if (lane == 0) { gpre[(size_t)row * 8 + c] = t0_; gpre[(size_t)row * 8 + c + 1] = t1_; }
        }
    }
}

__device__ __forceinline__ void conv_silu_run(int tokbase, int cg8, const bf16_t* __restrict__ min_, const float* __restrict__ cw, const float* __restrict__ cb, bf16_t* __restrict__ c) {
    float w[4][8], bias[8];
#pragma unroll
    for (int j = 0; j < 4; ++j) { const float4 a = *(const float4*)(cw + j * 1024 + cg8 * 8), b = *(const float4*)(cw + j * 1024 + cg8 * 8 + 4);
        w[j][0] = a.x; w[j][1] = a.y; w[j][2] = a.z; w[j][3] = a.w; w[j][4] = b.x; w[j][5] = b.y; w[j][6] = b.z; w[j][7] = b.w; }
    { const float4 a = *(const float4*)(cb + cg8 * 8), b = *(const float4*)(cb + cg8 * 8 + 4); bias[0] = a.x; bias[1] = a.y; bias[2] = a.z; bias[3] = a.w; bias[4] = b.x; bias[5] = b.y; bias[6] = b.z; bias[7] = b.w; }
    const int s0 = tokbase & (S - 1);
    uint4 rows[11];
#pragma unroll
    for (int i = 0; i < 11; ++i) { const int ss = s0 - 3 + i; rows[i] = ss >= 0 ? *(const uint4*)(min_ + (size_t)(tokbase - 3 + i) * 1024 + cg8 * 8) : make_uint4(0u, 0u, 0u, 0u); }
#pragma unroll
    for (int t = 0; t < 8; ++t) {
        float y[8];
#pragma unroll
        for (int k = 0; k < 8; ++k) y[k] = bias[k];
#pragma unroll
        for (int j = 0; j < 4; ++j) {
            const uint4 r = rows[t + j]; const unsigned rw[4] = {r.x, r.y, r.z, r.w};
#pragma unroll
            for (int k = 0; k < 4; ++k) { y[2 * k] = fmaf(w[j][2 * k], __uint_as_float(rw[k] << 16), y[2 * k]); y[2 * k + 1] = fmaf(w[j][2 * k + 1], __uint_as_float(rw[k] & 0xFFFF0000u), y[2 * k + 1]); }
        }
        uint4 o;
#pragma unroll
        for (int k = 0; k < 8; ++k) y[k] = y[k] / (1.0f + __expf(-y[k]));
        o.x = pk2(y[0], y[1]); o.y = pk2(y[2], y[3]); o.z = pk2(y[4], y[5]); o.w = pk2(y[6], y[7]);
        *(uint4*)(c + (size_t)(tokbase + t) * 1024 + cg8 * 8) = o;
    }
}

__device__ __forceinline__ float wave_incl_scan_add(float v, int lane) {
#pragma unroll
    for (int o = 1; o < 64; o <<= 1) { const float t = __shfl_up(v, o); if (lane >= o) v += t; }
    return v;
}
__device__ __forceinline__ float wave_incl_scan_max(float v, int lane) {
#pragma unroll
    for (int o = 1; o < 64; o <<= 1) { const float t = __shfl_up(v, o); if (lane >= o) v = fmaxf(v, t); }
    return v;
}
__device__ __forceinline__ void mlstm_gates_wave(int b, int h, int lane, const float* __restrict__ gpre, const float* __restrict__ b_mi, const float* __restrict__ b_mf,
                                                 float* __restrict__ gs, float* __restrict__ decay) {
    const float bi = b_mi[h], bf = b_mf[h];
    float mprev = 0.f;
    float gi_n[4], gf_n[4];
#pragma unroll
    for (int j = 0; j < 4; ++j) { const size_t t = (size_t)b * S + lane * 4 + j; gi_n[j] = gpre[t * 8 + h]; gf_n[j] = gpre[t * 8 + 4 + h]; }
#pragma unroll 1
    for (int c = 0; c < 16; ++c) {
        const size_t t0 = (size_t)b * S + c * 256 + lane * 4;
        float logi[4], lf[4], bb[4], gf_c[4];
#pragma unroll
        for (int j = 0; j < 4; ++j) { logi[j] = gi_n[j] + bi; gf_c[j] = gf_n[j]; }
        if (c < 15) {
#pragma unroll
            for (int j = 0; j < 4; ++j) { gi_n[j] = gpre[(t0 + 256 + j) * 8 + h]; gf_n[j] = gpre[(t0 + 256 + j) * 8 + 4 + h]; }
        }
#pragma unroll
        for (int j = 0; j < 4; ++j) lf[j] = log_sigmoid(gf_c[j] + bf);
        bb[0] = lf[0]; bb[1] = bb[0] + lf[1]; bb[2] = bb[1] + lf[2]; bb[3] = bb[2] + lf[3];
        const float incl = wave_incl_scan_add(bb[3], lane);
        const float excl = incl - bb[3];
#pragma unroll
        for (int j = 0; j < 4; ++j) bb[j] += excl;
        const float g = __shfl(incl, 63);
        float amax = -INFINITY, uu[4], cm[4];
#pragma unroll
        for (int j = 0; j < 4; ++j) { amax = fmaxf(amax, logi[j] + g - bb[j]); uu[j] = logi[j] - bb[j]; }
        amax = wave_max(amax);
        const float mnew = fmaxf(g + mprev, amax);
        cm[0] = uu[0]; cm[1] = fmaxf(cm[0], uu[1]); cm[2] = fmaxf(cm[1], uu[2]); cm[3] = fmaxf(cm[2], uu[3]);
        const float cincl = wave_incl_scan_max(cm[3], lane);
        float cexcl = __shfl_up(cincl, 1); if (lane == 0) cexcl = -INFINITY;
#pragma unroll
        for (int j = 0; j < 4; ++j) {
            const float M = fmaxf(mprev, fmaxf(cexcl, cm[j]));
            float* o = gs + ((t0 + j) * 4 + h) * 8;
            o[0] = uu[j] * 1.4426950408889634f; o[1] = M * 1.4426950408889634f; o[2] = expf(logi[j] + g - bb[j] - mnew); o[3] = expf(mprev - M); o[4] = expf(-(bb[j] + M));
        }
        if (lane == 0) decay[(b * 16 + c) * 4 + h] = expf(g + mprev - mnew);
        mprev = mnew;
    }
}
__device__ __forceinline__ void transpose_tile64(int tid, float* sm, const bf16_t* __restrict__ src, int src_ld, bf16_t* __restrict__ dst, int dst_ld, const float* __restrict__ scale, int sstride) {
    typedef unsigned u32x4_t __attribute__((ext_vector_type(4)));
    typedef short s16x4_t __attribute__((ext_vector_type(4)));
    LAS unsigned short* tl = (LAS unsigned short*)(LAS unsigned char*)sm;
    __syncthreads();
#pragma unroll
    for (int i = 0; i < 2; ++i) {
        const int ch = tid + i * 256, r = ch >> 3, c8 = (ch & 7) * 8;
        uint4 v = *(const uint4*)(src + (size_t)r * src_ld + c8);
        if (scale) {
            const float sc = scale[(size_t)r * sstride];
            unsigned w[4] = {v.x, v.y, v.z, v.w};
#pragma unroll
            for (int k = 0; k < 4; ++k) w[k] = pk2(__uint_as_float(w[k] << 16) * sc, __uint_as_float(w[k] & 0xFFFF0000u) * sc);
            v = make_uint4(w[0], w[1], w[2], w[3]);
        }
        *(LAS u32x4_t*)(tl + r * 72 + c8) = (u32x4_t){v.x, v.y, v.z, v.w};
    }
    __syncthreads();
    {
        const int G = tid >> 4, i = tid & 15, cb = G >> 2, rb = G & 3, q = i >> 2, p = i & 3;
        const int c0 = 16 * cb, r0 = 16 * rb;
        unsigned o[8];
#pragma unroll
        for (int m = 0; m < 4; ++m) {
            const s16x4_t t4 = __builtin_amdgcn_ds_read_tr16_b64_v4i16((LAS s16x4_t*)(tl + (r0 + 4 * m + q) * 72 + c0 + 4 * p));
            o[2 * m] = (unsigned)(unsigned short)t4[0] | ((unsigned)(unsigned short)t4[1] << 16);
            o[2 * m + 1] = (unsigned)(unsigned short)t4[2] | ((unsigned)(unsigned short)t4[3] << 16);
        }
        bf16_t* d = dst + (size_t)(c0 + i) * dst_ld + r0;
        *(uint4*)d = make_uint4(o[0], o[1], o[2], o[3]); *(uint4*)(d + 8) = make_uint4(o[4], o[5], o[6], o[7]);
    }
}

__device__ __forceinline__ void rope_table_fill(float2* __restrict__ cs, int gtid, int nth) {
    for (int idx = gtid; idx < 4096 * 64; idx += nth) {
        const int i = idx & 63, s = idx >> 6;
        const float inv = exp2f(-(float)i * 0.20762050593046014f);
        const float ang = (float)s * inv;
        float sn, c; sincosf(ang, &sn, &c);
        cs[idx] = make_float2(c, sn);
    }
}
__device__ __forceinline__ void rope_q_pass(bf16_t* __restrict__ aq, const float2* __restrict__ cs, size_t gtid, size_t nth) {
    for (size_t idx = gtid; idx < (size_t)T * 8 * 8; idx += nth) {
        const int c8 = (int)(idx & 7), hd = (int)((idx >> 3) & 7); const size_t t = idx >> 6; const int s = (int)(t & (S - 1));
        bf16_t* p = aq + t * 1024 + hd * 128 + c8 * 8;
        const uint4 a = *(const uint4*)p, b = *(const uint4*)(p + 64);
        const unsigned aw[4] = {a.x, a.y, a.z, a.w}, bw[4] = {b.x, b.y, b.z, b.w};
        unsigned ao[4], bo[4];
#pragma unroll
        for (int k = 0; k < 4; ++k) {
            const float4 cc = *(const float4*)(cs + (size_t)s * 64 + c8 * 8 + 2 * k);
            const float x10 = __uint_as_float(aw[k] << 16), x11 = __uint_as_float(aw[k] & 0xFFFF0000u), x20 = __uint_as_float(bw[k] << 16), x21 = __uint_as_float(bw[k] & 0xFFFF0000u);
            ao[k] = pk2(x10 * cc.x - x20 * cc.y, x11 * cc.z - x21 * cc.w);
            bo[k] = pk2(x20 * cc.x + x10 * cc.y, x21 * cc.z + x11 * cc.w);
        }
        *(uint4*)p = make_uint4(ao[0], ao[1], ao[2], ao[3]); *(uint4*)(p + 64) = make_uint4(bo[0], bo[1], bo[2], bo[3]);
    }
}
__device__ __forceinline__ void dil_tile_prep(int item, int lane, LAS unsigned short* wl, const bf16_t* __restrict__ ak, const bf16_t* __restrict__ av, const float2* __restrict__ cs,
                                              bf16_t* __restrict__ KB, bf16_t* __restrict__ VB) {
    const int TT = item & 255, hd = (item >> 8) & 7, b = (item >> 11) & 1, br = item >> 12;
    const int ld = 2 * br, tpr = 256 >> ld, rho = TT / tpr, tile = TT - rho * tpr;
    const int i = lane & 15, c = lane >> 4;
    const int s = rho + ((16 * tile + i) << ld);
    const size_t trow = (size_t)b * S + s;
    bf16_t* kdst = KB + (size_t)item * 2048;
    bf16_t* vdst = VB + (size_t)item * 2048;
    {
        const bf16_t* kr = ak + trow * 1024 + hd * 128 + 16 * c;
        const uint4 a0 = *(const uint4*)kr, a1 = *(const uint4*)(kr + 8), b0 = *(const uint4*)(kr + 64), b1 = *(const uint4*)(kr + 72);
        const unsigned aw[8] = {a0.x, a0.y, a0.z, a0.w, a1.x, a1.y, a1.z, a1.w}, bw[8] = {b0.x, b0.y, b0.z, b0.w, b1.x, b1.y, b1.z, b1.w};
        unsigned ao[8], bo[8];
#pragma unroll
        for (int k = 0; k < 8; ++k) {
            const float4 cc = *(const float4*)(cs + (size_t)s * 64 + 16 * c + 2 * k);
            const float x10 = __uint_as_float(aw[k] << 16), x11 = __uint_as_float(aw[k] & 0xFFFF0000u), x20 = __uint_as_float(bw[k] << 16), x21 = __uint_as_float(bw[k] & 0xFFFF0000u);
            ao[k] = pk2(x10 * cc.x - x20 * cc.y, x11 * cc.z - x21 * cc.w);
            bo[k] = pk2(x20 * cc.x + x10 * cc.y, x21 * cc.z + x11 * cc.w);
        }
        bf16_t* d0 = kdst + (c >> 1) * 512 + i * 32 + (c & 1) * 16;
        *(uint4*)d0 = make_uint4(ao[0], ao[1], ao[2], ao[3]); *(uint4*)(d0 + 8) = make_uint4(ao[4], ao[5], ao[6], ao[7]);
        bf16_t* d1 = d0 + 1024;
        *(uint4*)d1 = make_uint4(bo[0], bo[1], bo[2], bo[3]); *(uint4*)(d1 + 8) = make_uint4(bo[4], bo[5], bo[6], bo[7]);
    }
    {
        const bf16_t* vr = av + trow * 1024 + hd * 128 + 32 * c;
        const uint4 v0 = *(const uint4*)vr, v1 = *(const uint4*)(vr + 8), v2 = *(const uint4*)(vr + 16), v3 = *(const uint4*)(vr + 24);
        LAS unsigned short* wr = wl + i * 136 + 32 * c;
        typedef unsigned u32x4_t __attribute__((ext_vector_type(4)));
        *(LAS u32x4_t*)wr = (u32x4_t){v0.x, v0.y, v0.z, v0.w}; *(LAS u32x4_t*)(wr + 8) = (u32x4_t){v1.x, v1.y, v1.z, v1.w};
        *(LAS u32x4_t*)(wr + 16) = (u32x4_t){v2.x, v2.y, v2.z, v2.w}; *(LAS u32x4_t*)(wr + 24) = (u32x4_t){v3.x, v3.y, v3.z, v3.w};
        asm volatile("s_waitcnt lgkmcnt(0)" ::: "memory");
        unsigned o[16];
#pragma unroll
        for (int k = 0; k < 8; ++k) {
            const unsigned p0 = *(const LAS unsigned*)(wl + (2 * k) * 136 + 2 * lane), p1 = *(const LAS unsigned*)(wl + (2 * k + 1) * 136 + 2 * lane);
            o[k] = (p0 & 0xFFFFu) | (p1 << 16);
            o[8 + k] = (p0 >> 16) | (p1 & 0xFFFF0000u);
        }
        bf16_t* d = vdst + (2 * lane) * 16;
        *(uint4*)d = make_uint4(o[0], o[1], o[2], o[3]); *(uint4*)(d + 8) = make_uint4(o[4], o[5], o[6], o[7]);
        *(uint4*)(d + 16) = make_uint4(o[8], o[9], o[10], o[11]); *(uint4*)(d + 24) = make_uint4(o[12], o[13], o[14], o[15]);
        asm volatile("s_waitcnt lgkmcnt(0)" ::: "memory");
    }
}

typedef short bf16x8_t __attribute__((ext_vector_type(8)));
typedef short bf16x4_t __attribute__((ext_vector_type(4)));
typedef float f32x4_t __attribute__((ext_vector_type(4)));
__device__ __forceinline__ float xg_max_f32(float v);
__device__ __forceinline__ float xg_sum_f32(float v);
__device__ __forceinline__ void dilated_wave_tile(int qt2, int lane, const bf16_t* __restrict__ AQ, const float2* __restrict__ cs, const bf16_t* __restrict__ KB, const bf16_t* __restrict__ VB,
                                                  const float* __restrict__ g_ahead, bf16_t* __restrict__ mix) {
    const int r = qt2 & 7, blk = (qt2 >> 3) & 15, hd = (qt2 >> 7) & 7, b = qt2 >> 10;
    const int j = lane & 15, g = lane >> 4;
    const int t0 = blk * 256;
    bf16x8_t qf[2][4];
#pragma unroll
    for (int qi = 0; qi < 2; ++qi) {
        const int sq = t0 + r + 8 * qi + 16 * j;
        const bf16_t* qrow = AQ + ((size_t)b * S + sq) * 1024 + hd * 128 + 8 * g;
        const float sc = 0.08838834764831845f * 1.4426950408889634f;
#pragma unroll
        for (int ks = 0; ks < 2; ++ks) {
            const bf16x8_t lo = *(const bf16x8_t*)(qrow + 32 * ks), hi = *(const bf16x8_t*)(qrow + 32 * ks + 64);
            bf16x8_t olo, ohi;
#pragma unroll
            for (int e2 = 0; e2 < 4; ++e2) {
                const float4 cc = *(const float4*)(cs + (size_t)sq * 64 + 32 * ks + 8 * g + 2 * e2);
                const float x10 = bf2f((unsigned short)lo[2 * e2]), x11 = bf2f((unsigned short)lo[2 * e2 + 1]), x20 = bf2f((unsigned short)hi[2 * e2]), x21 = bf2f((unsigned short)hi[2 * e2 + 1]);
                const unsigned wl_ = pk2((x10 * cc.x - x20 * cc.y) * sc, (x11 * cc.z - x21 * cc.w) * sc), wh_ = pk2((x20 * cc.x + x10 * cc.y) * sc, (x21 * cc.z + x11 * cc.w) * sc);
                olo[2 * e2] = (short)(wl_ & 0xFFFF); olo[2 * e2 + 1] = (short)(wl_ >> 16); ohi[2 * e2] = (short)(wh_ & 0xFFFF); ohi[2 * e2 + 1] = (short)(wh_ >> 16);
            }
            qf[qi][ks] = olo; qf[qi][ks + 2] = ohi;
        }
    }
    float m_run[2] = {-1e30f, -1e30f}, l_run[2] = {0.f, 0.f};
    f32x4_t o[2][8];
#pragma unroll
    for (int qi = 0; qi < 2; ++qi)
#pragma unroll
        for (int dt = 0; dt < 8; ++dt) o[qi][dt] = (f32x4_t){0.f, 0.f, 0.f, 0.f};
#define DIL_STEP(QI, QJ, TP, KF, VF) { \
        f32x4_t su[2]; \
        _Pragma("unroll") for (int u = 0; u < 2; ++u) { f32x4_t a = (f32x4_t){0.f, 0.f, 0.f, 0.f}; \
            _Pragma("unroll") for (int ks = 0; ks < 4; ++ks) a = __builtin_amdgcn_mfma_f32_16x16x32_bf16(KF[u][ks], qf[QI][ks], a, 0, 0, 0); su[u] = a; } \
        float p[2][4]; float mx = -1e30f; \
        _Pragma("unroll") for (int u = 0; u < 2; ++u) _Pragma("unroll") for (int e = 0; e < 4; ++e) { \
            const int n = (QJ) - (16 * ((TP) + u) + 4 * g + e); const bool valid = (n >= 0) && (n <= 128); \
            p[u][e] = valid ? su[u][e] : -1e30f; mx = fmaxf(mx, p[u][e]); } \
        mx = xg_max_f32(mx); \
        const float m_new = fmaxf(m_run[QI], mx); const float alpha = __builtin_amdgcn_exp2f(m_run[QI] - m_new); m_run[QI] = m_new; \
        float ps = 0.f; \
        _Pragma("unroll") for (int u = 0; u < 2; ++u) _Pragma("unroll") for (int e = 0; e < 4; ++e) { p[u][e] = (p[u][e] > -1e29f) ? __builtin_amdgcn_exp2f(p[u][e] - m_new) : 0.f; ps += p[u][e]; } \
        l_run[QI] = l_run[QI] * alpha + ps; \
        bf16x8_t pb; { const unsigned w0 = pk2(p[0][0], p[0][1]), w1 = pk2(p[0][2], p[0][3]), w2 = pk2(p[1][0], p[1][1]), w3 = pk2(p[1][2], p[1][3]); \
            pb[0] = (short)(w0 & 0xFFFF); pb[1] = (short)(w0 >> 16); pb[2] = (short)(w1 & 0xFFFF); pb[3] = (short)(w1 >> 16); \
            pb[4] = (short)(w2 & 0xFFFF); pb[5] = (short)(w2 >> 16); pb[6] = (short)(w3 & 0xFFFF); pb[7] = (short)(w3 >> 16); } \
        _Pragma("unroll") for (int dt = 0; dt < 8; ++dt) { const bf16x4_t v0 = VF[dt][0], v1 = VF[dt][1]; \
            bf16x8_t va; va[0] = v0[0]; va[1] = v0[1]; va[2] = v0[2]; va[3] = v0[3]; va[4] = v1[0]; va[5] = v1[1]; va[6] = v1[2]; va[7] = v1[3]; \
            f32x4_t oo = o[QI][dt]; oo = oo * alpha; o[QI][dt] = __builtin_amdgcn_mfma_f32_16x16x32_bf16(va, pb, oo, 0, 0, 0); } }
#define DIL_LOADK(KF, TL) _Pragma("unroll") for (int u = 0; u < 2; ++u) { int tl_ = (TL) + u; if (tl_ > tile_max) tl_ = tile_max; \
            _Pragma("unroll") for (int ks = 0; ks < 4; ++ks) KF[u][ks] = *(const bf16x8_t*)(kbb + (size_t)tl_ * 2048 + 512 * ks); }
#define DIL_LOADV(VF, TP) { int tl0 = (TP), tl1 = (TP) + 1; if (tl0 > tile_max) tl0 = tile_max; if (tl1 > tile_max) tl1 = tile_max; \
            _Pragma("unroll") for (int dt = 0; dt < 8; ++dt) { VF[dt][0] = *(const bf16x4_t*)(vbb + dt * 256 + (size_t)tl0 * 2048); VF[dt][1] = *(const bf16x4_t*)(vbb + dt * 256 + (size_t)tl1 * 2048); } }
#pragma nounroll
    for (int br = 0; br < 2; ++br) {
        const int ld = 2 * br, d = 1 << ld;
        const int rho = r & (d - 1);
        const int qj0 = (t0 + r + 16 * j - rho) >> ld, qj1 = (t0 + r + 8 + 16 * j - rho) >> ld;
        const int q_lo = ((t0 + r - rho) >> ld) - 128, q_hi = (t0 + r + 8 + 240 - rho) >> ld;
        const int tile_lo = q_lo < 0 ? 0 : (q_lo >> 4), tile_hi = q_hi >> 4, tile_max = (256 >> ld) - 1;
        const size_t tbase = ((size_t)((br * 2 + b) * 8 + hd) * 256 + (size_t)rho * (256 >> ld)) * 2048;
        const bf16_t* kbb = KB + tbase + j * 32 + 8 * g;
        const bf16_t* vbb = VB + tbase + j * 16 + 4 * g;
        bf16x8_t kf[2][4];
        DIL_LOADK(kf, tile_lo)
#pragma nounroll
        for (int tp = tile_lo; tp <= tile_hi; tp += 2) {
            bf16x4_t vf[8][2];
            DIL_LOADV(vf, tp)
            bf16x8_t kc[2][4];
#pragma unroll
            for (int u = 0; u < 2; ++u)
#pragma unroll
                for (int ks = 0; ks < 4; ++ks) kc[u][ks] = kf[u][ks];
            DIL_LOADK(kf, tp + 2)
            DIL_STEP(0, qj0, tp, kc, vf)
            DIL_STEP(1, qj1, tp, kc, vf)
        }
    }
#pragma unroll
    for (int qi = 0; qi < 2; ++qi) {
        const int rho = r + 8 * qi;
        const int qj = (t0 + 16 * j) >> 4;
        const int q_lo = (t0 >> 4) - 128, q_hi = (t0 + 240) >> 4;
        const int tile_lo = q_lo < 0 ? 0 : (q_lo >> 4), tile_hi = q_hi >> 4, tile_max = 15;
        const size_t tbase = ((size_t)((2 * 2 + b) * 8 + hd) * 256 + (size_t)rho * 16) * 2048;
        const bf16_t* kbb = KB + tbase + j * 32 + 8 * g;
        const bf16_t* vbb = VB + tbase + j * 16 + 4 * g;
        bf16x8_t kf[2][4];
        DIL_LOADK(kf, tile_lo)
#pragma nounroll
        for (int tp = tile_lo; tp <= tile_hi; tp += 2) {
            bf16x4_t vf[8][2];
            DIL_LOADV(vf, tp)
            bf16x8_t kc[2][4];
#pragma unroll
            for (int u = 0; u < 2; ++u)
#pragma unroll
                for (int ks = 0; ks < 4; ++ks) kc[u][ks] = kf[u][ks];
            DIL_LOADK(kf, tp + 2)
            if (qi == 0) { DIL_STEP(0, qj, tp, kc, vf) } else { DIL_STEP(1, qj, tp, kc, vf) }
        }
    }
#undef DIL_STEP
#undef DIL_LOADK
#undef DIL_LOADV
#pragma unroll
    for (int qi = 0; qi < 2; ++qi) {
        const int sq = t0 + r + 8 * qi + 16 * j;
        const float inv = 1.0f / xg_sum_f32(l_run[qi]);
        float ss = 0.f;
#pragma unroll
        for (int dt = 0; dt < 8; ++dt) { o[qi][dt] = o[qi][dt] * inv; ss += (o[qi][dt][0] * o[qi][dt][0] + o[qi][dt][1] * o[qi][dt][1]) + (o[qi][dt][2] * o[qi][dt][2] + o[qi][dt][3] * o[qi][dt][3]); }
        ss = xg_sum_f32(ss);
        const float rn = rsqrtf(ss * (1.0f / 128.0f) + EPS);
        bf16_t* orow = mix + ((size_t)b * S + sq) * D + 1024 + hd * 128 + 4 * g;
#pragma unroll
        for (int dt = 0; dt < 8; ++dt) {
            const f32x4_t gv = *(const f32x4_t*)(g_ahead + hd * 128 + 16 * dt + 4 * g);
            uint2 w; w.x = pk2(o[qi][dt][0] * rn * gv[0], o[qi][dt][1] * rn * gv[1]); w.y = pk2(o[qi][dt][2] * rn * gv[2], o[qi][dt][3] * rn * gv[3]);
            *(uint2*)(orow + 16 * dt) = w;
        }
    }
}

__device__ __forceinline__ unsigned ord_key(float s) { const unsigned u = __float_as_uint(s); return u ^ ((unsigned)((int)u >> 31) | 0x80000000u); }
__device__ __forceinline__ unsigned wave_max_u32(unsigned v) {
    unsigned t;
    t = (unsigned)__builtin_amdgcn_update_dpp(0, (int)v, 0xB1, 0xF, 0xF, true); v = v > t ? v : t;
    t = (unsigned)__builtin_amdgcn_update_dpp(0, (int)v, 0x4E, 0xF, 0xF, true); v = v > t ? v : t;
    t = (unsigned)__builtin_amdgcn_update_dpp(0, (int)v, 0x141, 0xF, 0xF, true); v = v > t ? v : t;
    t = (unsigned)__builtin_amdgcn_update_dpp(0, (int)v, 0x140, 0xF, 0xF, true); v = v > t ? v : t;
    const unsigned a = (unsigned)__builtin_amdgcn_readlane((int)v, 0), b = (unsigned)__builtin_amdgcn_readlane((int)v, 16),
                   c = (unsigned)__builtin_amdgcn_readlane((int)v, 32), d = (unsigned)__builtin_amdgcn_readlane((int)v, 48);
    const unsigned ab = a > b ? a : b, cd = c > d ? c : d;
    return ab > cd ? ab : cd;
}
__device__ __forceinline__ void peer_topk_wave(int item, int lane, LAS float* wl, const bf16_t* __restrict__ qp, const bf16_t* __restrict__ skb, int* __restrict__ ids, float* __restrict__ gates) {
    const int hd = item & 7, tt = item >> 3, j = lane & 15, g = lane >> 4;
    const size_t t0 = (size_t)tt * 16;
    LAS float* sc = wl;
    LAS float* lst = wl + 2048;
#pragma unroll 1
    for (int p = 0; p < 2; ++p) {
        bf16x8_t qf[4];
        const bf16_t* qrow = qp + (t0 + j) * D + hd * 256 + p * 128 + 8 * g;
#pragma unroll
        for (int ks = 0; ks < 4; ++ks) qf[ks] = *(const bf16x8_t*)(qrow + 32 * ks);
        const bf16_t* kb = skb + ((size_t)(hd * 2 + p) * 128 + j) * 128 + 8 * g;
#pragma unroll
        for (int kt = 0; kt < 8; ++kt) {
            f32x4_t a = (f32x4_t){0.f, 0.f, 0.f, 0.f};
#pragma unroll
            for (int ks = 0; ks < 4; ++ks) a = __builtin_amdgcn_mfma_f32_16x16x32_bf16(*(const bf16x8_t*)(kb + (size_t)kt * (16 * 128) + 32 * ks), qf[ks], a, 0, 0, 0);
            *(LAS f32x4_t*)(sc + j * 128 + 16 * kt + 4 * g) = a;
        }
        asm volatile("s_waitcnt lgkmcnt(0)" ::: "memory");
#pragma unroll 1
        for (int tok = 0; tok < 16; ++tok) {
            const float s0 = sc[tok * 128 + lane], s1 = sc[tok * 128 + 64 + lane];
            unsigned k0 = (ord_key(s0) & ~127u) | (unsigned)(127 - lane), k1 = (ord_key(s1) & ~127u) | (unsigned)(63 - lane);
            unsigned sel = 0u;
#pragma unroll 4
            for (int it = 0; it < 16; ++it) {
                unsigned m = k0 > k1 ? k0 : k1;
                m = wave_max_u32(m);
                if (lane == it) sel = m;
                if (k0 == m) k0 = 0u;
                if (k1 == m) k1 = 0u;
            }
            if (lane < 16) {
                const int idx = 127 - (int)(sel & 127u);
                lst[((p * 16 + tok) * 16 + lane) * 2 + 0] = sc[tok * 128 + idx];
                lst[((p * 16 + tok) * 16 + lane) * 2 + 1] = __int_as_float(idx);
            }
        }
        asm volatile("s_waitcnt lgkmcnt(0)" ::: "memory");
    }
#pragma unroll 1
    for (int tok = 0; tok < 16; ++tok) {
        const int i = lane >> 2;
        const float sA = lst[((0 * 16 + tok) * 16 + i) * 2];
        unsigned kk[4];
#pragma unroll
        for (int r = 0; r < 4; ++r) {
            const int jb = (lane & 3) * 4 + r;
            const float sum = sA + lst[((1 * 16 + tok) * 16 + jb) * 2];
            kk[r] = (ord_key(sum) & ~255u) | (unsigned)(255 - (lane * 4 + r));
        }
        unsigned sel = 0u;
#pragma unroll 4
        for (int it = 0; it < 16; ++it) {
            unsigned m = kk[0] > kk[1] ? kk[0] : kk[1]; const unsigned m2 = kk[2] > kk[3] ? kk[2] : kk[3]; m = m > m2 ? m : m2;
            m = wave_max_u32(m);
            if (lane == it) sel = m;
#pragma unroll
            for (int r = 0; r < 4; ++r) if (kk[r] == m) kk[r] = 0u;
        }
        float bs = -INFINITY; int eid = 0;
        if (lane < 16) {
            const int c = 255 - (int)(sel & 255u), ia = c >> 4, ib = c & 15;
            bs = lst[((0 * 16 + tok) * 16 + ia) * 2] + lst[((1 * 16 + tok) * 16 + ib) * 2];
            eid = __float_as_int(lst[((0 * 16 + tok) * 16 + ia) * 2 + 1]) * 128 + __float_as_int(lst[((1 * 16 + tok) * 16 + ib) * 2 + 1]);
        }
        const float mx = wave_max(bs);
        const float ev = lane < 16 ? __expf(bs - mx) : 0.f;
        const float tot = wave_sum(ev);
        if (lane < 16) {
            ids[(t0 + tok) * 128 + hd * 16 + lane] = eid;
            gates[(t0 + tok) * 128 + hd * 16 + lane] = ev / tot;
        }
    }
}

typedef float f32x2_t __attribute__((ext_vector_type(2)));
__device__ __forceinline__ float wave_max_all(float v) {
    v = fmaxf(v, __uint_as_float((unsigned)__builtin_amdgcn_update_dpp(0, (int)__float_as_uint(v), 0xB1, 0xF, 0xF, true)));
    v = fmaxf(v, __uint_as_float((unsigned)__builtin_amdgcn_update_dpp(0, (int)__float_as_uint(v), 0x4E, 0xF, 0xF, true)));
    v = fmaxf(v, __uint_as_float((unsigned)__builtin_amdgcn_update_dpp(0, (int)__float_as_uint(v), 0x141, 0xF, 0xF, true)));
    v = fmaxf(v, __uint_as_float((unsigned)__builtin_amdgcn_update_dpp(0, (int)__float_as_uint(v), 0x140, 0xF, 0xF, true)));
    auto a = __builtin_amdgcn_permlane16_swap(__float_as_uint(v), __float_as_uint(v), false, false); v = fmaxf(__uint_as_float(a[0]), __uint_as_float(a[1]));
    auto b = __builtin_amdgcn_permlane32_swap(__float_as_uint(v), __float_as_uint(v), false, false); return fmaxf(__uint_as_float(b[0]), __uint_as_float(b[1]));
}
template <bool I8> __device__ __forceinline__ void table_row_store(float4 (&f)[8], unsigned char* __restrict__ drow, float* __restrict__ rscale, int lane, const float* __restrict__ dgain) {
    if (I8) {
#pragma unroll
        for (int i = 0; i < 8; ++i) { const float4 gq = *(const float4*)(dgain + i * 256 + lane * 4); f[i].x *= gq.x; f[i].y *= gq.y; f[i].z *= gq.z; f[i].w *= gq.w; }
    }
    float am = 0.f;
#pragma unroll
    for (int i = 0; i < 8; ++i) am = fmaxf(am, fmaxf(fmaxf(fabsf(f[i].x), fabsf(f[i].y)), fmaxf(fabsf(f[i].z), fabsf(f[i].w))));
    am = wave_max_all(am);
    const float s = exp2f(fminf(floorf(log2f((I8 ? 127.0f : 448.0f) / fmaxf(am, 1e-30f))), 100.0f));
#pragma unroll
    for (int i = 0; i < 8; ++i) {
        unsigned w;
        if (I8) { const int q0 = __float2int_rn(f[i].x * s), q1 = __float2int_rn(f[i].y * s), q2 = __float2int_rn(f[i].z * s), q3 = __float2int_rn(f[i].w * s);
                  w = ((unsigned)q0 & 255u) | (((unsigned)q1 & 255u) << 8) | (((unsigned)q2 & 255u) << 16) | (((unsigned)q3 & 255u) << 24); }
        else { int t = 0; t = __builtin_amdgcn_cvt_pk_fp8_f32(f[i].x * s, f[i].y * s, t, false); t = __builtin_amdgcn_cvt_pk_fp8_f32(f[i].z * s, f[i].w * s, t, true); w = (unsigned)t; }
        *(unsigned*)(drow + i * 256 + lane * 4) = w;
    }
    if (lane == 0) *rscale = 1.0f / s;
}
__device__ __forceinline__ void table_row_to_fp8(const float* __restrict__ srow, unsigned char* __restrict__ drow, float* __restrict__ rscale, int lane, const float* __restrict__ dgain) {
    float4 f[8];
#pragma unroll
    for (int i = 0; i < 8; ++i) f[i] = *(const float4*)(srow + i * 256 + lane * 4);
    if (dgain) {
#pragma unroll
        for (int i = 0; i < 8; ++i) { const float4 gq = *(const float4*)(dgain + i * 256 + lane * 4); f[i].x *= gq.x; f[i].y *= gq.y; f[i].z *= gq.z; f[i].w *= gq.w; }
    }
    float am = 0.f;
#pragma unroll
    for (int i = 0; i < 8; ++i) am = fmaxf(am, fmaxf(fmaxf(fabsf(f[i].x), fabsf(f[i].y)), fmaxf(fabsf(f[i].z), fabsf(f[i].w))));
    am = wave_max(am);
    const float e = floorf(log2f(448.0f / fmaxf(am, 1e-30f)));
    const float s = exp2f(fminf(e, 100.0f));
    unsigned w[8];
#pragma unroll
    for (int i = 0; i < 8; ++i) {
        int t = 0;
        t = __builtin_amdgcn_cvt_pk_fp8_f32(f[i].x * s, f[i].y * s, t, false);
        t = __builtin_amdgcn_cvt_pk_fp8_f32(f[i].z * s, f[i].w * s, t, true);
        w[i] = (unsigned)t;
    }
#pragma unroll
    for (int i = 0; i < 8; ++i) *(unsigned*)(drow + i * 256 + lane * 4) = w[i];
    if (lane == 0) *rscale = 1.0f / s;
}
__device__ __forceinline__ void table_row_to_i8(const float* __restrict__ srow, unsigned char* __restrict__ drow, float* __restrict__ rscale, int lane, const float* __restrict__ dgain) {
    float4 f[8];
#pragma unroll
    for (int i = 0; i < 8; ++i) { f[i] = *(const float4*)(srow + i * 256 + lane * 4); const float4 gq = *(const float4*)(dgain + i * 256 + lane * 4); f[i].x *= gq.x; f[i].y *= gq.y; f[i].z *= gq.z; f[i].w *= gq.w; }
    float am = 0.f;
#pragma unroll
    for (int i = 0; i < 8; ++i) am = fmaxf(am, fmaxf(fmaxf(fabsf(f[i].x), fabsf(f[i].y)), fmaxf(fabsf(f[i].z), fabsf(f[i].w))));
    am = wave_max(am);
    const float s = exp2f(fminf(floorf(log2f(127.0f / fmaxf(am, 1e-30f))), 100.0f));
#pragma unroll
    for (int i = 0; i < 8; ++i) {
        const int q0 = __float2int_rn(f[i].x * s), q1 = __float2int_rn(f[i].y * s), q2 = __float2int_rn(f[i].z * s), q3 = __float2int_rn(f[i].w * s);
        *(unsigned*)(drow + i * 256 + lane * 4) = ((unsigned)q0 & 255u) | (((unsigned)q1 & 255u) << 8) | (((unsigned)q2 & 255u) << 16) | (((unsigned)q3 & 255u) << 24);
    }
    if (lane == 0) *rscale = 1.0f / s;
}
__device__ __forceinline__ float dot16_fp8(const uint4 q, const float* x) {
    float d = 0.f;
    const unsigned w[4] = {q.x, q.y, q.z, q.w};
#pragma unroll
    for (int k = 0; k < 4; ++k) {
        const f32x2_t lo = __builtin_amdgcn_cvt_pk_f32_fp8((int)w[k], false), hi = __builtin_amdgcn_cvt_pk_f32_fp8((int)w[k], true);
        d = fmaf(lo.x, x[4 * k], d); d = fmaf(lo.y, x[4 * k + 1], d); d = fmaf(hi.x, x[4 * k + 2], d); d = fmaf(hi.y, x[4 * k + 3], d);
    }
    return d;
}
__device__ __forceinline__ void axpy16_fp8(const uint4 q, float c, float* acc) {
    const unsigned w[4] = {q.x, q.y, q.z, q.w};
#pragma unroll
    for (int k = 0; k < 4; ++k) {
        const f32x2_t lo = __builtin_amdgcn_cvt_pk_f32_fp8((int)w[k], false), hi = __builtin_amdgcn_cvt_pk_f32_fp8((int)w[k], true);
        acc[4 * k] = fmaf(c, lo.x, acc[4 * k]); acc[4 * k + 1] = fmaf(c, lo.y, acc[4 * k + 1]); acc[4 * k + 2] = fmaf(c, hi.x, acc[4 * k + 2]); acc[4 * k + 3] = fmaf(c, hi.y, acc[4 * k + 3]);
    }
}
__device__ __forceinline__ void d_peer_out8(int vb, int tid, float* sm, const bf16_t* __restrict__ h3, const float* __restrict__ x2, const int* __restrict__ ids, const float* __restrict__ gates,
                                            const unsigned char* __restrict__ ut8, const unsigned char* __restrict__ vt8, const float* __restrict__ rsc, const float* __restrict__ rstd, const float* __restrict__ g_final, float* __restrict__ out) {
    float (*part)[2048] = (float (*)[2048])sm;
    float* red = sm + 4 * 2048;
    const int lane = tid & 63, w = tid >> 6, t = vb;
    float x[32], acc[32];
    {
        const bf16_t* hrow = h3 + (size_t)t * D + lane * 16;
#pragma unroll
        for (int hh = 0; hh < 2; ++hh) {
            const uint4 a = *(const uint4*)(hrow + hh * 1024), b = *(const uint4*)(hrow + hh * 1024 + 8);
            const unsigned ww[8] = {a.x, a.y, a.z, a.w, b.x, b.y, b.z, b.w};
#pragma unroll
            for (int k = 0; k < 8; ++k) { x[hh * 16 + 2 * k] = __uint_as_float(ww[k] << 16); x[hh * 16 + 2 * k + 1] = __uint_as_float(ww[k] & 0xFFFF0000u); }
        }
#pragma unroll
        for (int i = 0; i < 32; ++i) acc[i] = 0.f;
    }
    const float xrs = rstd[t];
    const int myid = ids[(size_t)t * 128 + w * 32 + (lane & 31)];
    const float mygate = gates[(size_t)t * 128 + w * 32 + (lane & 31)];
#pragma unroll 1
    for (int j = 0; j < 32; j += 4) {
        int e[4]; uint4 uq[4][2], vq[4][2];
#pragma unroll
        for (int q = 0; q < 4; ++q) {
            e[q] = __builtin_amdgcn_readfirstlane(__shfl(myid, j + q));
            const unsigned char* ur = ut8 + (size_t)e[q] * 2048 + lane * 16;
            uq[q][0] = *(const uint4*)ur; uq[q][1] = *(const uint4*)(ur + 1024);
        }
#pragma unroll
        for (int q = 0; q < 4; ++q) {
            const unsigned char* vr = vt8 + (size_t)e[q] * 2048 + lane * 16;
            vq[q][0] = *(const uint4*)vr; vq[q][1] = *(const uint4*)(vr + 1024);
        }
        float d[4];
#pragma unroll
        for (int q = 0; q < 4; ++q) d[q] = dot16_fp8(uq[q][0], x) + dot16_fp8(uq[q][1], x + 16);
#pragma unroll
        for (int o = 32; o >= 1; o >>= 1) {
#pragma unroll
            for (int q = 0; q < 4; ++q) d[q] += __shfl_xor(d[q], o);
        }
#pragma unroll
        for (int q = 0; q < 4; ++q) {
            const float a = d[q] * rsc[e[q]] * xrs;
            const float act = 0.5f * a * (1.0f + erff(a * 0.7071067811865476f));
            const float cf = __shfl(mygate, j + q) * act * rsc[16384 + e[q]];
            axpy16_fp8(vq[q][0], cf, acc); axpy16_fp8(vq[q][1], cf, acc + 16);
        }
    }
    __syncthreads();
#pragma unroll
    for (int hh = 0; hh < 2; ++hh)
#pragma unroll
        for (int k = 0; k < 4; ++k) *(float4*)&part[w][hh * 1024 + lane * 16 + 4 * k] = make_float4(acc[hh * 16 + 4 * k], acc[hh * 16 + 4 * k + 1], acc[hh * 16 + 4 * k + 2], acc[hh * 16 + 4 * k + 3]);
    __syncthreads();
    float4 r0, r1;
    {
        const float4 a = *(const float4*)&part[0][tid * 4], b = *(const float4*)&part[1][tid * 4], c = *(const float4*)&part[2][tid * 4], dd = *(const float4*)&part[3][tid * 4];
        const float4 xx = *(const float4*)(x2 + (size_t)t * D + tid * 4);
        r0 = make_float4(xx.x + a.x + b.x + c.x + dd.x, xx.y + a.y + b.y + c.y + dd.y, xx.z + a.z + b.z + c.z + dd.z, xx.w + a.w + b.w + c.w + dd.w);
    }
    {
        const float4 a = *(const float4*)&part[0][1024 + tid * 4], b = *(const float4*)&part[1][1024 + tid * 4], c = *(const float4*)&part[2][1024 + tid * 4], dd = *(const float4*)&part[3][1024 + tid * 4];
        const float4 xx = *(const float4*)(x2 + (size_t)t * D + 1024 + tid * 4);
        r1 = make_float4(xx.x + a.x + b.x + c.x + dd.x, xx.y + a.y + b.y + c.y + dd.y, xx.z + a.z + b.z + c.z + dd.z, xx.w + a.w + b.w + c.w + dd.w);
    }
    float s = r0.x * r0.x + r0.y * r0.y + r0.z * r0.z + r0.w * r0.w + r1.x * r1.x + r1.y * r1.y + r1.z * r1.z + r1.w * r1.w;
    s = wave_sum(s);
    if (lane == 0) red[w] = s;
    __syncthreads();
    const float tot = red[0] + red[1] + red[2] + red[3];
    const float r = rsqrtf(tot * (1.0f / D) + EPS);
    const float4 g0 = *(const float4*)(g_final + tid * 4), g1 = *(const float4*)(g_final + 1024 + tid * 4);
    *(float4*)(out + (size_t)t * D + tid * 4) = make_float4(r0.x * r * g0.x, r0.y * r * g0.y, r0.z * r * g0.z, r0.w * r * g0.w);
    *(float4*)(out + (size_t)t * D + 1024 + tid * 4) = make_float4(r1.x * r * g1.x, r1.y * r * g1.y, r1.z * r * g1.z, r1.w * r * g1.w);
}

__device__ __forceinline__ unsigned xg_sum_u32(unsigned v) {
    auto a = __builtin_amdgcn_permlane16_swap(v, v, false, false); v = a[0] + a[1];
    auto b = __builtin_amdgcn_permlane32_swap(v, v, false, false); return b[0] + b[1];
}
__device__ __forceinline__ float xg_sum_f32(float v) {
    auto a = __builtin_amdgcn_permlane16_swap(__float_as_uint(v), __float_as_uint(v), false, false); v = __uint_as_float(a[0]) + __uint_as_float(a[1]);
    auto b = __builtin_amdgcn_permlane32_swap(__float_as_uint(v), __float_as_uint(v), false, false); return __uint_as_float(b[0]) + __uint_as_float(b[1]);
}
__device__ __forceinline__ float xg_max_f32(float v) {
    auto a = __builtin_amdgcn_permlane16_swap(__float_as_uint(v), __float_as_uint(v), false, false); v = fmaxf(__uint_as_float(a[0]), __uint_as_float(a[1]));
    auto b = __builtin_amdgcn_permlane32_swap(__float_as_uint(v), __float_as_uint(v), false, false); return fmaxf(__uint_as_float(b[0]), __uint_as_float(b[1]));
}
template <int N> __device__ __forceinline__ unsigned bisect16(const unsigned (&kk)[N]) {
    unsigned tau = 0u; bool done = false;
#pragma unroll 1
    for (int bit = 31; bit >= 0; --bit) {
        const unsigned cand = tau | (1u << bit);
        unsigned c0 = 0u, c1 = 0u, c2 = 0u, c3 = 0u;
#pragma unroll
        for (int i = 0; i < N; i += 4) { c0 += (kk[i] >= cand) ? 1u : 0u; c1 += (kk[i + 1] >= cand) ? 1u : 0u; c2 += (kk[i + 2] >= cand) ? 1u : 0u; c3 += (kk[i + 3] >= cand) ? 1u : 0u; }
        unsigned c = xg_sum_u32((c0 + c1) + (c2 + c3));
        if (!done && c >= 16u) { tau = cand; done = (c == 16u); }
        if (__all(done ? 1 : 0)) break;
    }
    return tau;
}
__device__ __forceinline__ void peer_topk_wave2(int item, int lane, LAS float* wl, const bf16_t* __restrict__ qp, const bf16_t* __restrict__ skb, int* __restrict__ ids, float* __restrict__ gates) {
    const int hd = item & 7, tt = item >> 3, j = lane & 15, g = lane >> 4;
    const size_t t0 = (size_t)tt * 16;
#pragma unroll 1
    for (int p = 0; p < 2; ++p) {
        bf16x8_t qf[4];
        const bf16_t* qrow = qp + (t0 + j) * D + hd * 256 + p * 128 + 8 * g;
#pragma unroll
        for (int ks = 0; ks < 4; ++ks) qf[ks] = *(const bf16x8_t*)(qrow + 32 * ks);
        const bf16_t* kb = skb + ((size_t)(hd * 2 + p) * 128 + j) * 128 + 8 * g;
        float sc[32]; unsigned kk[32];
#pragma unroll
        for (int kt = 0; kt < 8; ++kt) {
            f32x4_t a = (f32x4_t){0.f, 0.f, 0.f, 0.f};
#pragma unroll
            for (int ks = 0; ks < 4; ++ks) a = __builtin_amdgcn_mfma_f32_16x16x32_bf16(*(const bf16x8_t*)(kb + (size_t)kt * (16 * 128) + 32 * ks), qf[ks], a, 0, 0, 0);
#pragma unroll
            for (int r = 0; r < 4; ++r) { sc[kt * 4 + r] = a[r]; kk[kt * 4 + r] = (ord_key(a[r]) & ~127u) | (unsigned)(127 - (16 * kt + 4 * g + r)); }
        }
        const unsigned tau = bisect16<32>(kk);
        unsigned cnt = 0u;
#pragma unroll
        for (int i = 0; i < 32; ++i) cnt += (kk[i] >= tau) ? 1u : 0u;
        const unsigned c0 = (unsigned)__shfl((int)cnt, j), c1 = (unsigned)__shfl((int)cnt, j + 16), c2 = (unsigned)__shfl((int)cnt, j + 32);
        unsigned off = (g > 0 ? c0 : 0u) + (g > 1 ? c1 : 0u) + (g > 2 ? c2 : 0u);
        LAS float* ls = wl + p * 256 + j * 16;
        LAS float* li = wl + 512 + p * 256 + j * 16;
#pragma unroll
        for (int i = 0; i < 32; ++i) {
            if (kk[i] >= tau && off < 16u) { ls[off] = sc[i]; li[off] = __int_as_float(16 * (i >> 2) + 4 * g + (i & 3)); ++off; }
        }
    }
    asm volatile("s_waitcnt lgkmcnt(0)" ::: "memory");
    {
        float sAll[2][16];
#pragma unroll
        for (int p = 0; p < 2; ++p)
#pragma unroll
            for (int q = 0; q < 4; ++q) { const f32x4_t b = *(const LAS f32x4_t*)(wl + p * 256 + j * 16 + 4 * q); sAll[p][4 * q] = b[0]; sAll[p][4 * q + 1] = b[1]; sAll[p][4 * q + 2] = b[2]; sAll[p][4 * q + 3] = b[3]; }
        f32x4_t myi[2];
#pragma unroll
        for (int p = 0; p < 2; ++p) myi[p] = *(const LAS f32x4_t*)(wl + 512 + p * 256 + j * 16 + 4 * g);
        unsigned rk[2][4];
#pragma unroll
        for (int p = 0; p < 2; ++p) {
            unsigned key[16];
#pragma unroll
            for (int k = 0; k < 16; ++k) key[k] = (ord_key(sAll[p][k]) & ~15u) | (unsigned)(15 - k);
            unsigned mine[4];
#pragma unroll
            for (int e = 0; e < 4; ++e) mine[e] = g == 0 ? key[e] : g == 1 ? key[4 + e] : g == 2 ? key[8 + e] : key[12 + e];
#pragma unroll
            for (int e = 0; e < 4; ++e) { unsigned c = 0u;
#pragma unroll
                for (int k = 0; k < 16; ++k) c += (key[k] > mine[e]) ? 1u : 0u;
                rk[p][e] = c; }
        }
#pragma unroll
        for (int p = 0; p < 2; ++p)
#pragma unroll
            for (int e = 0; e < 4; ++e) {
                const float sv = g == 0 ? sAll[p][e] : g == 1 ? sAll[p][4 + e] : g == 2 ? sAll[p][8 + e] : sAll[p][12 + e];
                wl[p * 256 + j * 16 + rk[p][e]] = sv; wl[512 + p * 256 + j * 16 + rk[p][e]] = myi[p][e];
            }
        asm volatile("s_waitcnt lgkmcnt(0)" ::: "memory");
        const unsigned t0w = g == 0 ? 0x03020100u : g == 1 ? 0x13121110u : g == 2 ? 0x23222120u : 0xB0A09080u;
        const unsigned t1w = g == 0 ? 0x07060504u : g == 1 ? 0x17161514u : g == 2 ? 0x42414024u : 0xF0E0D0C0u;
        const unsigned t2w = g == 0 ? 0x0B0A0908u : g == 1 ? 0x33323130u : g == 2 ? 0x71705150u : 0xFFFFFFFFu;
        const unsigned t3w = g == 0 ? 0x0F0E0D0Cu : g == 1 ? 0xFFFF6160u : g == 2 ? 0xFFFFFFFFu : 0xFFFFFFFFu;
        unsigned kk[16]; float sm16[16];
#pragma unroll
        for (int k = 0; k < 16; ++k) {
            const unsigned tw = (k >> 2) == 0 ? t0w : (k >> 2) == 1 ? t1w : (k >> 2) == 2 ? t2w : t3w;
            const unsigned byte = (tw >> (8 * (k & 3))) & 255u;
            const bool valid = byte != 255u;
            const unsigned ci = valid ? (byte >> 4) : 0u, cj = valid ? (byte & 15u) : 0u;
            const float sum = wl[j * 16 + ci] + wl[256 + j * 16 + cj];
            sm16[k] = sum;
            kk[k] = valid ? ((ord_key(sum) & ~63u) | (unsigned)(63 - (16 * g + k))) : 0u;
        }
        const unsigned tau = bisect16<16>(kk);
        float mx = -INFINITY; unsigned cnt = 0u;
#pragma unroll
        for (int k = 0; k < 16; ++k) if (kk[k] >= tau && kk[k] != 0u) { mx = fmaxf(mx, sm16[k]); ++cnt; }
        mx = xg_max_f32(mx);
        float es = 0.f;
#pragma unroll
        for (int k = 0; k < 16; ++k) if (kk[k] >= tau && kk[k] != 0u) es += __expf(sm16[k] - mx);
        const float inv = 1.0f / xg_sum_f32(es);
        const unsigned c0 = (unsigned)__shfl((int)cnt, j), c1 = (unsigned)__shfl((int)cnt, j + 16), c2 = (unsigned)__shfl((int)cnt, j + 32);
        unsigned off = (g > 0 ? c0 : 0u) + (g > 1 ? c1 : 0u) + (g > 2 ? c2 : 0u);
        int* idp = ids + (t0 + j) * 128 + hd * 16;
        float* gtp = gates + (t0 + j) * 128 + hd * 16;
#pragma unroll
        for (int k = 0; k < 16; ++k) {
            if (kk[k] >= tau && kk[k] != 0u && off < 16u) {
                const unsigned tw = (k >> 2) == 0 ? t0w : (k >> 2) == 1 ? t1w : (k >> 2) == 2 ? t2w : t3w;
                const unsigned byte = (tw >> (8 * (k & 3))) & 255u;
                idp[off] = __float_as_int(wl[512 + j * 16 + (byte >> 4)]) * 128 + __float_as_int(wl[512 + 256 + j * 16 + (byte & 15u)]);
                gtp[off] = __expf(sm16[k] - mx) * inv;
                ++off;
            }
        }
        asm volatile("s_waitcnt lgkmcnt(0)" ::: "memory");
    }
}

__device__ __forceinline__ float wave_sum_dpp(float v) {
    v += __uint_as_float((unsigned)__builtin_amdgcn_update_dpp(0, (int)__float_as_uint(v), 0xB1, 0xF, 0xF, true));
    v += __uint_as_float((unsigned)__builtin_amdgcn_update_dpp(0, (int)__float_as_uint(v), 0x4E, 0xF, 0xF, true));
    v += __uint_as_float((unsigned)__builtin_amdgcn_update_dpp(0, (int)__float_as_uint(v), 0x141, 0xF, 0xF, true));
    v += __uint_as_float((unsigned)__builtin_amdgcn_update_dpp(0, (int)__float_as_uint(v), 0x140, 0xF, 0xF, true));
    const float a = __uint_as_float((unsigned)__builtin_amdgcn_readlane((int)__float_as_uint(v), 0)), b = __uint_as_float((unsigned)__builtin_amdgcn_readlane((int)__float_as_uint(v), 16)),
                c = __uint_as_float((unsigned)__builtin_amdgcn_readlane((int)__float_as_uint(v), 32)), d = __uint_as_float((unsigned)__builtin_amdgcn_readlane((int)__float_as_uint(v), 48));
    return (a + b) + (c + d);
}
typedef __bf16 bf16x2v_t __attribute__((ext_vector_type(2)));
__device__ __forceinline__ int wave_sum_all_i32(int v) {
    v += __builtin_amdgcn_update_dpp(0, v, 0xB1, 0xF, 0xF, true);
    v += __builtin_amdgcn_update_dpp(0, v, 0x4E, 0xF, 0xF, true);
    v += __builtin_amdgcn_update_dpp(0, v, 0x141, 0xF, 0xF, true);
    v += __builtin_amdgcn_update_dpp(0, v, 0x140, 0xF, 0xF, true);
    auto a = __builtin_amdgcn_permlane16_swap((unsigned)v, (unsigned)v, false, false); v = (int)(a[0] + a[1]);
    auto b = __builtin_amdgcn_permlane32_swap((unsigned)v, (unsigned)v, false, false); return (int)(b[0] + b[1]);
}
__device__ __forceinline__ float wave_sum_all(float v) {
    v += __uint_as_float((unsigned)__builtin_amdgcn_update_dpp(0, (int)__float_as_uint(v), 0xB1, 0xF, 0xF, true));
    v += __uint_as_float((unsigned)__builtin_amdgcn_update_dpp(0, (int)__float_as_uint(v), 0x4E, 0xF, 0xF, true));
    v += __uint_as_float((unsigned)__builtin_amdgcn_update_dpp(0, (int)__float_as_uint(v), 0x141, 0xF, 0xF, true));
    v += __uint_as_float((unsigned)__builtin_amdgcn_update_dpp(0, (int)__float_as_uint(v), 0x140, 0xF, 0xF, true));
    auto a = __builtin_amdgcn_permlane16_swap(__float_as_uint(v), __float_as_uint(v), false, false); v = __uint_as_float(a[0]) + __uint_as_float(a[1]);
    auto b = __builtin_amdgcn_permlane32_swap(__float_as_uint(v), __float_as_uint(v), false, false); return __uint_as_float(b[0]) + __uint_as_float(b[1]);
}
__device__ __forceinline__ float dot16_fp8_bf16(const uint4 q, const uint4 xa, const uint4 xb, float d) {
    const unsigned w[4] = {q.x, q.y, q.z, q.w};
    const unsigned xw[8] = {xa.x, xa.y, xa.z, xa.w, xb.x, xb.y, xb.z, xb.w};
#pragma unroll
    for (int k = 0; k < 4; ++k) {
        const bf16x2v_t lo = __builtin_amdgcn_cvt_scalef32_pk_bf16_fp8(w[k], 1.0f, false), hi = __builtin_amdgcn_cvt_scalef32_pk_bf16_fp8(w[k], 1.0f, true);
        d = __builtin_amdgcn_fdot2_f32_bf16(lo, __builtin_bit_cast(bf16x2v_t, xw[2 * k]), d, false);
        d = __builtin_amdgcn_fdot2_f32_bf16(hi, __builtin_bit_cast(bf16x2v_t, xw[2 * k + 1]), d, false);
    }
    return d;
}
__device__ __forceinline__ void axpy16_fp8_pk(const uint4 q, const f32x2_t c2, f32x2_t* acc) {
    const unsigned w[4] = {q.x, q.y, q.z, q.w};
#pragma unroll
    for (int k = 0; k < 4; ++k) {
        const f32x2_t lo = __builtin_amdgcn_cvt_pk_f32_fp8((int)w[k], false), hi = __builtin_amdgcn_cvt_pk_f32_fp8((int)w[k], true);
        acc[2 * k] = __builtin_elementwise_fma(c2, lo, acc[2 * k]); acc[2 * k + 1] = __builtin_elementwise_fma(c2, hi, acc[2 * k + 1]);
    }
}
__device__ __forceinline__ float gelu_as(float v) {
    const float av = fabsf(v), t = __builtin_amdgcn_rcpf(av * 0.2316418882f + 1.0f);
    float q = t * 0.5307027145f + (-0.7265760135f); q = q * t + 0.7107068705f; q = q * t + (-0.142248368f); q = q * t + 0.127414796f; q = q * t;
    const float e = __builtin_amdgcn_exp2f((v * v) * (-0.72134752044f));
    const float m = v * (q * e);
    return v < 0.f ? m : v - m;
}
__device__ __forceinline__ void peer_sweep_wave(int gw, int lane, LAS unsigned char* wl, const bf16_t* __restrict__ h3, const float* __restrict__ x2, const int* __restrict__ ids,
                                                const float* __restrict__ gates, const unsigned char* __restrict__ ut8, const unsigned char* __restrict__ vt8, const float* __restrict__ rsc,
                                                const float* __restrict__ rstd, const float* __restrict__ g_final, float* __restrict__ out) {
    typedef unsigned u32x4_t __attribute__((ext_vector_type(4)));
    typedef int i32x4_t __attribute__((ext_vector_type(4)));
    LAS unsigned char* x8 = wl;
    LAS unsigned* sorted = (LAS unsigned*)(wl + 8192);
    LAS unsigned* cnt = (LAS unsigned*)(wl + 8192 + 2048);
    LAS unsigned* base = (LAS unsigned*)(wl + 8192 + 2048 + 256);
    LAS unsigned short* gsv = (LAS unsigned short*)(wl + 8192 + 2048 + 512);
    const size_t t0 = (size_t)gw * 4;
    float fac = 0.f;
#pragma unroll
    for (int tok = 0; tok < 4; ++tok) {
        uint4 xv[4]; float am = 0.f;
#pragma unroll
        for (int c = 0; c < 4; ++c) {
            xv[c] = *(const uint4*)(h3 + (t0 + tok) * D + c * 512 + lane * 8);
            const unsigned w[4] = {xv[c].x, xv[c].y, xv[c].z, xv[c].w};
#pragma unroll
            for (int k = 0; k < 4; ++k) am = fmaxf(am, fmaxf(fabsf(__uint_as_float(w[k] << 16)), fabsf(__uint_as_float(w[k] & 0xFFFF0000u))));
        }
        am = wave_max(am);
        const float s = exp2f(fminf(floorf(log2f(127.0f / fmaxf(am, 1e-30f))), 100.0f));
        if ((lane & 3) == tok) fac = rstd[t0 + tok] / s;
#pragma unroll
        for (int c = 0; c < 4; ++c) {
            const unsigned w[4] = {xv[c].x, xv[c].y, xv[c].z, xv[c].w};
            unsigned o[2];
#pragma unroll
            for (int h = 0; h < 2; ++h) {
                const int q0 = __float2int_rn(__uint_as_float(w[2 * h] << 16) * s), q1 = __float2int_rn(__uint_as_float(w[2 * h] & 0xFFFF0000u) * s);
                const int q2 = __float2int_rn(__uint_as_float(w[2 * h + 1] << 16) * s), q3 = __float2int_rn(__uint_as_float(w[2 * h + 1] & 0xFFFF0000u) * s);
                o[h] = ((unsigned)q0 & 255u) | (((unsigned)q1 & 255u) << 8) | (((unsigned)q2 & 255u) << 16) | (((unsigned)q3 & 255u) << 24);
            }
            typedef unsigned u32x2_t __attribute__((ext_vector_type(2)));
            *(LAS u32x2_t*)(x8 + tok * 2048 + c * 512 + lane * 8) = (u32x2_t){o[0], o[1]};
        }
    }
    cnt[lane] = 0u;
    asm volatile("s_waitcnt lgkmcnt(0)" ::: "memory");
    unsigned key[8], rk[8]; unsigned short fv[8];
#pragma unroll
    for (int r = 0; r < 8; ++r) {
        const int n = r * 64 + lane;
        const unsigned e = (unsigned)ids[t0 * 128 + n];
        key[r] = (e << 9) | (unsigned)n | (__float_as_uint(rsc[e]) & 0x7F800000u);
        fv[r] = (unsigned short)f2bf(gates[t0 * 128 + n] * rsc[16384 + e]);
        rk[r] = __hip_atomic_fetch_add(&cnt[e >> 8], 1u, __ATOMIC_RELAXED, __HIP_MEMORY_SCOPE_WORKGROUP);
    }
    asm volatile("s_waitcnt lgkmcnt(0)" ::: "memory");
    {
        const unsigned c = cnt[lane];
        unsigned incl = c;
#pragma unroll
        for (int o = 1; o < 64; o <<= 1) { const unsigned t = (unsigned)__shfl_up((int)incl, o); if (lane >= o) incl += t; }
        base[lane] = incl - c;
    }
    asm volatile("s_waitcnt lgkmcnt(0)" ::: "memory");
#pragma unroll
    for (int r = 0; r < 8; ++r) { const unsigned pos = base[(key[r] >> 17) & 63u] + rk[r]; sorted[pos] = key[r]; gsv[pos] = fv[r]; }
    asm volatile("s_waitcnt lgkmcnt(0)" ::: "memory");
    float rs4[4];
#pragma unroll
    for (int tok = 0; tok < 4; ++tok) rs4[tok] = __uint_as_float((unsigned)__builtin_amdgcn_readlane((int)__float_as_uint(fac), tok));
#define P1_LOAD(ENT, UQ, I0) _Pragma("unroll") for (int q = 0; q < 8; ++q) { \
            ENT[q] = (unsigned)__builtin_amdgcn_readfirstlane((int)sorted[(I0) + q]); \
            const unsigned char* ur = ut8 + (size_t)((ENT[q] >> 9) & 16383u) * 2048 + lane * 16; \
            UQ[q][0] = *(const uint4*)ur; UQ[q][1] = *(const uint4*)(ur + 1024); }
#define P1_COMP(ENT, UQ, I0) _Pragma("unroll") for (int h4 = 0; h4 < 8; h4 += 4) { int d[4]; \
            _Pragma("unroll") for (int q = 0; q < 4; ++q) { \
                const int tok = (ENT[h4 + q] >> 7) & 3; \
                const LAS unsigned char* xr = x8 + tok * 2048 + lane * 16; \
                const u32x4_t a0 = *(const LAS u32x4_t*)xr, b0 = *(const LAS u32x4_t*)(xr + 1024); \
                int dd = 0; \
                dd = __builtin_amdgcn_sdot4((int)UQ[h4 + q][0].x, (int)a0[0], dd, false); dd = __builtin_amdgcn_sdot4((int)UQ[h4 + q][0].y, (int)a0[1], dd, false); \
                dd = __builtin_amdgcn_sdot4((int)UQ[h4 + q][0].z, (int)a0[2], dd, false); dd = __builtin_amdgcn_sdot4((int)UQ[h4 + q][0].w, (int)a0[3], dd, false); \
                dd = __builtin_amdgcn_sdot4((int)UQ[h4 + q][1].x, (int)b0[0], dd, false); dd = __builtin_amdgcn_sdot4((int)UQ[h4 + q][1].y, (int)b0[1], dd, false); \
                dd = __builtin_amdgcn_sdot4((int)UQ[h4 + q][1].z, (int)b0[2], dd, false); dd = __builtin_amdgcn_sdot4((int)UQ[h4 + q][1].w, (int)b0[3], dd, false); \
                d[q] = dd; } \
            _Pragma("unroll") for (int q = 0; q < 4; ++q) { \
                const int s = wave_sum_all_i32(d[q]); \
                const unsigned e = (ENT[h4 + q] >> 9) & 16383u; const int n = ENT[h4 + q] & 511, tok = n >> 7; \
                const float rsv = tok == 0 ? rs4[0] : tok == 1 ? rs4[1] : tok == 2 ? rs4[2] : rs4[3]; \
                const float a = (float)s * (__uint_as_float(ENT[h4 + q] & 0x7F800000u) * rsv); \
                const float cf = __uint_as_float((unsigned)gsv[(I0) + h4 + q] << 16) * gelu_as(a); \
                if (lane == 0) sorted[(I0) + h4 + q] = (e << 18) | ((unsigned)tok << 16) | f2bf(cf); } }
    {
        unsigned entA[8], entB[8]; uint4 uqA[8][2], uqB[8][2];
        P1_LOAD(entA, uqA, 0)
#pragma unroll 1
        for (int i = 0; i < 512; i += 16) {
            P1_LOAD(entB, uqB, i + 8)
            P1_COMP(entA, uqA, i)
            { const int nx = i + 16 < 512 ? i + 16 : 504; P1_LOAD(entA, uqA, nx) }
            P1_COMP(entB, uqB, i + 8)
        }
    }
#undef P1_LOAD
#undef P1_COMP
    asm volatile("s_waitcnt lgkmcnt(0)" ::: "memory");
    f32x2_t acc0[16], acc1[16], acc2[16], acc3[16];
#pragma unroll
    for (int k = 0; k < 16; ++k) { acc0[k] = (f32x2_t){0.f, 0.f}; acc1[k] = (f32x2_t){0.f, 0.f}; acc2[k] = (f32x2_t){0.f, 0.f}; acc3[k] = (f32x2_t){0.f, 0.f}; }
#ifndef P2N
#define P2N 2
#endif
#define P2_LOAD(ENT, VQ, I0) _Pragma("unroll") for (int q = 0; q < P2N; ++q) { \
            ENT[q] = (unsigned)__builtin_amdgcn_readfirstlane((int)sorted[(I0) + q]); \
            const unsigned char* vr = vt8 + (size_t)(ENT[q] >> 18) * 2048 + lane * 16; \
            VQ[q][0] = *(const uint4*)vr; VQ[q][1] = *(const uint4*)(vr + 1024); }
#define P2_COMP(ENT, VQ) _Pragma("unroll") for (int q = 0; q < P2N; ++q) { \
            const int tok = (ENT[q] >> 16) & 3; \
            const float cfs = __uint_as_float(ENT[q] << 16); \
            const f32x2_t c2 = (f32x2_t){cfs, cfs}; \
            if (tok == 0) { axpy16_fp8_pk(VQ[q][0], c2, acc0); axpy16_fp8_pk(VQ[q][1], c2, acc0 + 8); } \
            else if (tok == 1) { axpy16_fp8_pk(VQ[q][0], c2, acc1); axpy16_fp8_pk(VQ[q][1], c2, acc1 + 8); } \
            else if (tok == 2) { axpy16_fp8_pk(VQ[q][0], c2, acc2); axpy16_fp8_pk(VQ[q][1], c2, acc2 + 8); } \
            else { axpy16_fp8_pk(VQ[q][0], c2, acc3); axpy16_fp8_pk(VQ[q][1], c2, acc3 + 8); } }
    {
        unsigned entA[P2N], entB[P2N]; uint4 vqA[P2N][2], vqB[P2N][2];
        P2_LOAD(entA, vqA, 0)
#pragma unroll 1
        for (int i = 0; i < 512; i += 2 * P2N) {
            P2_LOAD(entB, vqB, i + P2N)
            P2_COMP(entA, vqA)
            { const int nx = i + 2 * P2N < 512 ? i + 2 * P2N : 512 - P2N; P2_LOAD(entA, vqA, nx) }
            P2_COMP(entB, vqB)
        }
    }
#undef P2_LOAD
#undef P2_COMP
    int l2 = lane; asm volatile("" : "+v"(l2));
#define PEER_EPI(tok, ACC) { \
        const bf16_t* xr = h3 + (t0 + tok) * D + l2 * 16; \
        float ss = 0.f; \
        _Pragma("unroll") for (int hh = 0; hh < 2; ++hh) _Pragma("unroll") for (int k = 0; k < 4; ++k) { \
            const uint2 xp = *(const uint2*)(xr + hh * 1024 + 4 * k); \
            const float4 xv = make_float4(__uint_as_float(xp.x << 16), __uint_as_float(xp.x & 0xFFFF0000u), __uint_as_float(xp.y << 16), __uint_as_float(xp.y & 0xFFFF0000u)); \
            f32x2_t a0 = ACC[hh * 8 + 2 * k], a1 = ACC[hh * 8 + 2 * k + 1]; \
            a0.x += xv.x; a0.y += xv.y; a1.x += xv.z; a1.y += xv.w; ACC[hh * 8 + 2 * k] = a0; ACC[hh * 8 + 2 * k + 1] = a1; \
            ss += (a0.x * a0.x + a0.y * a0.y) + (a1.x * a1.x + a1.y * a1.y); } \
        ss = wave_sum_dpp(ss); \
        const float r = rsqrtf(ss * (1.0f / D) + EPS); \
        float* orow = out + (t0 + tok) * D + l2 * 16; \
        _Pragma("unroll") for (int hh = 0; hh < 2; ++hh) _Pragma("unroll") for (int k = 0; k < 4; ++k) { \
            const float4 gv = *(const float4*)(g_final + hh * 1024 + l2 * 16 + 4 * k); \
            const f32x2_t a0 = ACC[hh * 8 + 2 * k], a1 = ACC[hh * 8 + 2 * k + 1]; \
            *(float4*)(orow + hh * 1024 + 4 * k) = make_float4(a0.x * r * gv.x, a0.y * r * gv.y, a1.x * r * gv.z, a1.y * r * gv.w); } }
    PEER_EPI(0, acc0) PEER_EPI(1, acc1) PEER_EPI(2, acc2) PEER_EPI(3, acc3)
#undef PEER_EPI
}

struct Params {
    const float *x, *mem, *g_mix, *w_in, *conv_w, *conv_b, *w_mq, *w_mk, *b_mi, *b_mf, *g_mhead, *g_ahead, *w_out, *g_cross, *g_mem,
                *w_xq, *w_xk, *w_xv, *w_xo, *g_ffn, *w_pq, *sub_keys, *u_tab, *v_tab, *g_final;
    float* out;
    unsigned* bar;
    float* ws;
};

#define PHASE_LOOP(nvb) for (int base_ = blockIdx.x * 2; base_ < (nvb); base_ += gridDim.x * 2)
#define VB (base_ + half)

__global__ void __launch_bounds__(NTHR) mega(Params P) {
    volatile LAS unsigned* st = (volatile LAS unsigned*)(LAS unsigned char*)(smem_raw + CTRL_OFF);
    if (threadIdx.x == 0) { st[0] = 0u; st[1] = 0u; st[2] = 0u; st[3] = 0u; }
    if (threadIdx.x < I_NPTR) ((LAS unsigned long long*)(LAS unsigned char*)(smem_raw + CTRL_OFF + 64))[threadIdx.x] = ((const unsigned long long*)&P)[threadIdx.x];
    __syncthreads();
    XcdBarrier xb = xcd_barrier_post((unsigned*)ldp_raw(I_BAR), st);

    constexpr size_t TD = (size_t)T * D;
    constexpr size_t O_HB = 6 * P6S * 2, O_CBUF = O_HB + (size_t)T * D * 2, O_MQ = O_CBUF + (size_t)T * 1024 * 2, O_MK = O_MQ + (size_t)T * 1024 * 2,
                     O_MIXB = O_MK + (size_t)T * 1024 * 2, O_WIN = O_MIXB + (size_t)T * D * 2, O_WOUT = O_WIN + (size_t)6144 * D * 2, O_WXQ = O_WOUT + (size_t)D * D * 2,
                     O_WXK = O_WXQ + (size_t)D * D * 2, O_WXV = O_WXK + (size_t)D * D * 2, O_WXO = O_WXV + (size_t)D * D * 2, O_WPQ = O_WXO + (size_t)D * D * 2,
                     O_WQK = O_WPQ + (size_t)D * D * 2, O_GPRE = O_WQK + (size_t)8 * 256 * 256 * 2, O_UT = O_GPRE + (size_t)T * 8 * 4, O_VT = O_UT + (size_t)16384 * D, O_RSC = O_VT + (size_t)16384 * D,
                     O_BH = O_RSC + (size_t)32768 * 4, O_GS = O_BH + (size_t)128 * 256 * 512 * 2, O_DENP = O_GS + (size_t)T * 4 * 8 * 4, O_QN = O_DENP + (size_t)T * 4 * 4 * 4,
                     O_DN = O_QN + (size_t)T * 4 * 4, O_DECAY = O_DN + (size_t)128 * 256 * 4, O_KB = O_DECAY + 4096, O_VB = O_KB + (size_t)12288 * 2048 * 2, O_CS = O_VB + (size_t)12288 * 2048 * 2, O_SKB = O_CS + (size_t)4096 * 64 * 8, O_RSSP = O_SKB + (size_t)262144 * 2, O_RSTD = O_RSSP + (size_t)T * 32 * 4, O_MN = O_RSTD + (size_t)T * 4, O_KVP = O_MN + (size_t)512 * D * 2, O_END = O_KVP + (size_t)2 * 512 * 4096 * 4;
    static_assert(O_END + 16384 <= (size_t)536870912, "workspace overflow");
#define W_P6    ((bf16_t*)wsb)
#define W_HB    ((bf16_t*)(wsb + O_HB))
#define W_CBUF  ((bf16_t*)(wsb + O_CBUF))
#define W_MQ    ((bf16_t*)(wsb + O_MQ))
#define W_MK    ((bf16_t*)(wsb + O_MK))
#define W_MIXB  ((bf16_t*)(wsb + O_MIXB))
#define W_GPRE  ((float*)(wsb + O_GPRE))
#define W_HRAW  ((float*)(wsb + O_HB))
#define W_XR    ((float*)wsb)
#define W_MN    ((bf16_t*)((float*)wsb + TD))
#define W_KM    ((bf16_t*)((float*)wsb + TD + (size_t)256 * D))
#define W_VMT   ((bf16_t*)((float*)wsb + TD + (size_t)768 * D))
#define W_PX    ((bf16_t*)(wsb + O_MK))
#define W_GATES ((float*)wsb + TD + (size_t)1280 * D)
#define W_IDS   ((int*)((float*)wsb + TD + (size_t)1280 * D + (size_t)T * 128))
#define W_QX    ((bf16_t*)(wsb + O_CBUF))
#define W_BH    ((bf16_t*)(wsb + O_BH))
#define W_KB    ((bf16_t*)(wsb + O_KB))
#define W_VB    ((bf16_t*)(wsb + O_VB))
#define W_CS    ((float2*)(wsb + O_CS))
#define W_SKB   ((bf16_t*)(wsb + O_SKB))
#define W_RSSP  ((float*)(wsb + O_RSSP))
#define W_RSTD  ((float*)(wsb + O_RSTD))
#define W_MN2   ((bf16_t*)(wsb + O_MN))
#define W_KVP   ((float*)(wsb + O_KVP))
#define W_GS    ((float*)(wsb + O_GS))
#define W_DENP  ((float*)(wsb + O_DENP))
#define W_QN    ((float*)(wsb + O_QN))
#define W_DN    ((float*)(wsb + O_DN))
#define W_DECAY ((float*)(wsb + O_DECAY))
#define W_PQ    ((bf16_t*)(wsb + O_HB))
#define W_KWT   ((bf16_t*)(wsb + O_CBUF))
#define W_DC    ((float*)(wsb + 3 * P6S * 2))
#define W_UT    ((unsigned char*)(wsb + O_UT))
#define W_VT    ((unsigned char*)(wsb + O_VT))
#define W_RSC   ((float*)(wsb + O_RSC))
#define PH_BEGIN() int tidx = threadIdx.x; asm volatile("" : "+v"(tidx)); const int half = tidx >> 8, tid = tidx & 255; float* sm = (float*)smem_raw + half * HALF_SM_FLOATS; \
                   char* wsb = (char*)ldp_raw(I_WS); (void)half; (void)tid; (void)sm; (void)wsb
#define GJOB_DEFAULT(g) pg8::GJob g; g.lda = D; g.ldb = D; g.K = D; g.nM = 32; g.nN = 8; g.a_pm_step = 256 * D; g.b_pn_mask = 0x7fffffff; g.b_pn_shift = 30; g.b_pn_step2 = 0; g.bid0 = 0; g.nblk = gridDim.x; g.a_pn_shift = 0; g.a_pn_mask = 0; g.a_pn_step = 0; g.b_pm_shift = 0; g.b_pm_step = 0; g.b_pn_step = 256 * D; \
                        g.ldc = D; g.R = nullptr; g.ldr = D; g.mode = 0; g.escale = 1.0f; g.gs = nullptr; g.denp = nullptr; g.qn = nullptr; g.gvec = nullptr; g.mo = nullptr; g.C2 = nullptr; g.rssp = nullptr; g.rstd = nullptr
#define GEMM_LDSP ((LAS unsigned char*)smem_raw)

    {
        PH_BEGIN();
        {
            LAS float* scr = (LAS float*)(LAS unsigned char*)(smem_raw) + (tidx >> 6) * (64 * 33);
            const int lane = tidx & 63;
            const int gw = blockIdx.x * 8 + (tidx >> 6), NGW = gridDim.x * 8;
            constexpr int I_IN = 32 * 192, I_SQ = 32 * 64, I_QK = 8 * 4 * 8;
            constexpr int NITEMS = I_IN + 6 * I_SQ + I_QK;
#pragma nounroll
            for (int it = gw; it < NITEMS; it += NGW) {
                const float* W; int ldw, K, csrc0, row0, kb; bf16_t* WT; float wscale = 1.0f; const float* kgain = nullptr;
                int r = it;
                if (r < I_IN) { const int nb = r % 192; kb = r / 192; W = PF(I_WIN); ldw = INC; K = D; csrc0 = nb * 32 + (nb >= 96 ? 8 : 0); WT = (bf16_t*)(wsb + O_WIN); row0 = nb * 32; }
                else if ((r -= I_IN) < 6 * I_SQ) {
                    const int wsel = r / I_SQ; r -= wsel * I_SQ; const int nb = r % 64; kb = r / 64; ldw = D; K = D; csrc0 = nb * 32; row0 = nb * 32;
                    W = PF(wsel == 0 ? I_WOUT : wsel == 1 ? I_WXQ : wsel == 2 ? I_WXK : wsel == 3 ? I_WXV : wsel == 4 ? I_WXO : I_WPQ);
                    WT = (bf16_t*)(wsb + O_WOUT + (size_t)wsel * ((size_t)D * D * 2));
                    if (wsel == 1) kgain = PF(I_GCROSS); else if (wsel == 5) kgain = PF(I_GFFN);
                } else {
                    r -= 6 * I_SQ; const int hq = r / 32; r -= hq * 32; const int nb = r % 8; kb = r / 8;
                    W = PF(hq < 4 ? I_WMQ : I_WMK) + (size_t)(hq & 3) * 65536; ldw = 256; K = 256; csrc0 = nb * 32; WT = (bf16_t*)(wsb + O_WQK); row0 = hq * 256 + nb * 32;
                    if (hq >= 4) wscale = 0.0625f;
                }
                p0_transpose_item(W, ldw, K, csrc0, WT, row0, scr, kb, lane, wscale, kgain);
            }
            rope_table_fill(W_CS, blockIdx.x * NTHR + tidx, gridDim.x * NTHR);
            {
                const float* sk = PF(I_SUBK);
#pragma nounroll
                for (int i = blockIdx.x * NTHR + tidx; i < 262144 / 8; i += gridDim.x * NTHR) {
                    const float4 a = *(const float4*)(sk + (size_t)i * 8), b = *(const float4*)(sk + (size_t)i * 8 + 4);
                    uint4 o; o.x = pk2(a.x, a.y); o.y = pk2(a.z, a.w); o.z = pk2(b.x, b.y); o.w = pk2(b.z, b.w);
                    *(uint4*)(W_SKB + (size_t)i * 8) = o;
                }
            }
            __syncthreads();
        }
        {
            const float* rin = PF(I_X); const float* rg = PF(I_GMIX); const float* win = PF(I_WIN);
            float* gwT = (float*)smem_raw;
            for (int k = tidx; k < 2048; k += NTHR) { const float4 a = *(const float4*)(win + (size_t)k * INC + C_MI), b = *(const float4*)(win + (size_t)k * INC + C_MI + 4);
                gwT[k] = a.x; gwT[2048 + k] = a.y; gwT[4096 + k] = a.z; gwT[6144 + k] = a.w; gwT[8192 + k] = b.x; gwT[10240 + k] = b.y; gwT[12288 + k] = b.z; gwT[14336 + k] = b.w; }
            __syncthreads();
            {
#pragma nounroll
                for (int row = blockIdx.x * 8 + (tidx >> 6); row < T; row += gridDim.x * 8) { int ln = tidx & 63; asm volatile("" : "+v"(ln)); rmsnorm_row_wave(row, ln, rin, rg, W_HB, gwT, W_GPRE); }
                const float* min_ = PF(I_MEM); const float* mg = PF(I_GMEM);
#pragma nounroll
                for (int row = blockIdx.x * 8 + (tidx >> 6); row < 512; row += gridDim.x * 8) { int ln = tidx & 63; asm volatile("" : "+v"(ln)); rmsnorm_row_wave(row, ln, min_, mg, W_MN2, nullptr, nullptr); }
            }
        }
    }
    xcd_barrier(xb);
    {
        PH_BEGIN();
        GJOB_DEFAULT(g); g.A = W_HB; g.Bt = (bf16_t*)(wsb + O_WIN); g.nN = 24; g.C = (float*)W_P6; g.ldc = 1024;
        pg8::gemm_phase<4>(GEMM_LDSP, g, tidx);
    }
    xcd_barrier(xb);
    {
        PH_BEGIN();
        const float* cw = PF(I_CONVW); const float* cb = PF(I_CONVB);
        const bool gates_wave = (blockIdx.x < 8) && ((tidx >> 6) == 7);
        {
            const int nconv = gridDim.x * NTHR;
#pragma nounroll
            for (int i = blockIdx.x * NTHR + tidx; i < 1024 * 128; i += nconv) conv_silu_run((i >> 7) * 8, i & 127, W_P6, cw, cb, W_CBUF);
        }
        if (gates_wave) mlstm_gates_wave(blockIdx.x >> 2, blockIdx.x & 3, tidx & 63, W_GPRE, PF(I_BMI), PF(I_BMF), W_GS, W_DECAY);
        else {
            LAS unsigned short* wl = (LAS unsigned short*)(LAS unsigned char*)smem_raw + (tidx >> 6) * (16 * 136);
            const int gwv = blockIdx.x * 8 + (tidx >> 6), rank = gwv - ((int)blockIdx.x < 8 ? (int)blockIdx.x : 8), nw = gridDim.x * 8 - 8;
#pragma nounroll
            for (int item = rank; item < 12288; item += nw) dil_tile_prep(item, tidx & 63, wl, W_P6 + 4 * P6S, W_P6 + 5 * P6S, W_CS, W_KB, W_VB);
        }
        __syncthreads();
#pragma nounroll
        PHASE_LOOP(2048) { const int it = VB, lt = it & 3, et = (it >> 2) & 3, h = (it >> 4) & 3, cg = it >> 6;
            transpose_tile64(tid, sm, W_P6 + P6S + (size_t)(cg * 256 + lt * 64) * 1024 + h * 256 + et * 64, 1024, W_BH + ((size_t)(cg * 4 + h) * 256 + et * 64) * 512 + lt * 64, 512, nullptr, 0); }
    }
    xcd_barrier(xb);
    {
        PH_BEGIN();
        {
            GJOB_DEFAULT(g); g.A = W_CBUF; g.lda = 1024; g.a_pm_step = 256 * 1024; g.Bt = (bf16_t*)(wsb + O_WQK); g.ldb = 256; g.b_pn_step = 256 * 256; g.K = 256; g.a_pn_mask = 3; g.a_pn_step = 256; g.C = (float*)W_MQ; g.ldc = 1024;
            pg8::gemm_phase<4>(GEMM_LDSP, g, tidx);
            __syncthreads();
        }
        const float* ga = PF(I_GAHEAD);
#pragma nounroll
        for (int qt = blockIdx.x * 8 + (tidx >> 6); qt < 2048; qt += gridDim.x * 8) dilated_wave_tile(qt, tidx & 63, W_P6 + 3 * P6S, W_CS, W_KB, W_VB, ga, W_MIXB);
    }
    xcd_barrier(xb);
    {
        PH_BEGIN();
#pragma nounroll
        PHASE_LOOP(2048) { const int it = VB, lt = it & 3, dt = (it >> 2) & 3, h = (it >> 4) & 3, cg = it >> 6;
            transpose_tile64(tid, sm, W_MK + (size_t)(cg * 256 + lt * 64) * 1024 + h * 256 + dt * 64, 1024, W_KWT + ((size_t)(cg * 4 + h) * 256 + dt * 64) * 256 + lt * 64, 256,
                             W_GS + ((size_t)(cg * 256 + lt * 64) * 4 + h) * 8 + 2, 32); }
        {
            const size_t nth = (size_t)gridDim.x * NTHR;
#pragma nounroll
            for (size_t i = (size_t)blockIdx.x * NTHR + tidx; i < (size_t)T * 128; i += nth) {
                const size_t t = i >> 7; const int c8 = (int)(i & 127) * 8, h = c8 >> 8, d = c8 & 255;
                const float sc = W_GS[(t * 4 + h) * 8 + 3];
                const uint4 v = *(const uint4*)(W_MQ + t * 1024 + c8);
                uint4 o;
                o.x = pk2(bf2f((unsigned short)(v.x & 0xFFFFu)) * sc, bf2f((unsigned short)(v.x >> 16)) * sc); o.y = pk2(bf2f((unsigned short)(v.y & 0xFFFFu)) * sc, bf2f((unsigned short)(v.y >> 16)) * sc);
                o.z = pk2(bf2f((unsigned short)(v.z & 0xFFFFu)) * sc, bf2f((unsigned short)(v.z >> 16)) * sc); o.w = pk2(bf2f((unsigned short)(v.w & 0xFFFFu)) * sc, bf2f((unsigned short)(v.w >> 16)) * sc);
                *(uint4*)(W_PQ + t * 2048 + h * 512 + 256 + d) = o;
            }
        }
#pragma nounroll
        PHASE_LOOP(128) { const int cgh = VB, cg = cgh >> 2, h = cgh & 3;
            float a = 0.f;
#pragma unroll 16
            for (int l = 0; l < 256; ++l) { const size_t t = (size_t)cg * 256 + l; a = fmaf(W_GS[(t * 4 + h) * 8 + 2], bf2f(W_MK[t * 1024 + h * 256 + tid]), a); }
            W_DN[(size_t)cgh * 256 + tid] = a; }
        __syncthreads();
        {
            GJOB_DEFAULT(g); g.A = W_MQ; g.lda = 1024; g.a_pm_step = 256 * 1024; g.a_pn_mask = 3; g.a_pn_step = 256; g.K = 256; g.nN = 4;
            g.Bt = W_MK; g.ldb = 1024; g.b_pn_step = 256; g.b_pm_step = 256 * 1024; g.C = (float*)W_PQ; g.gs = W_GS; g.denp = W_DENP;
            pg8::gemm_phase<6>(GEMM_LDSP, g, tidx);
        }
    }
    xcd_barrier(xb);
    {
        PH_BEGIN();
        GJOB_DEFAULT(g); g.A = W_BH; g.lda = 512; g.a_pm_step = 4 * 256 * 512; g.a_pn_mask = 3; g.a_pn_step = 256 * 512; g.K = 256; g.nN = 4;
        g.Bt = W_KWT; g.ldb = 256; g.b_pn_step = 65536; g.b_pm_step = 4 * 65536; g.C = W_DC;
        pg8::gemm_phase<7>(GEMM_LDSP, g, tidx);
    }
    xcd_barrier(xb);
    {
        PH_BEGIN();
        {
#pragma nounroll
            for (int gid = blockIdx.x * NTHR + tidx; gid < 131072; gid += gridDim.x * NTHR) {
                const int bh = gid >> 14, b = bh >> 2, h = bh & 3, e = (gid >> 6) & 255, d = (gid & 63) * 4;
                float4 C = make_float4(0.f, 0.f, 0.f, 0.f);
                float4 dcv[16]; float decv[16];
#pragma unroll
                for (int c = 0; c < 16; ++c) { const int cgh = (b * 16 + c) * 4 + h; decv[c] = W_DECAY[cgh]; dcv[c] = *(const float4*)(W_DC + ((size_t)cgh * 256 + e) * 256 + d); }
#pragma unroll
                for (int c = 0; c < 16; ++c) {
                    const int cgh = (b * 16 + c) * 4 + h;
                    uint2 o; o.x = pk2(C.x, C.y); o.y = pk2(C.z, C.w);
                    *(uint2*)(W_BH + ((size_t)cgh * 256 + e) * 512 + 256 + d) = o;
                    C.x = fmaf(decv[c], C.x, dcv[c].x); C.y = fmaf(decv[c], C.y, dcv[c].y); C.z = fmaf(decv[c], C.z, dcv[c].z); C.w = fmaf(decv[c], C.w, dcv[c].w);
                }
            }
        }
#pragma nounroll
        PHASE_LOOP(128) { const int cgh = VB, cg = cgh >> 2, h = cgh & 3, b = cg >> 4, c = cg & 15;
            float n = 0.f;
            for (int cc = 0; cc < c; ++cc) { const int j = (b * 16 + cc) * 4 + h; n = fmaf(W_DECAY[j], n, W_DN[(size_t)j * 256 + tid]); }
            __syncthreads();
            sm[tid] = n;
            __syncthreads();
            const int lane = tid & 63, w = tid >> 6;
            const float4 nv = *(const float4*)(sm + lane * 4);
#pragma unroll 1
            for (int i = 0; i < 64; i += 8) {
                float s[8];
#pragma unroll
                for (int k = 0; k < 8; ++k) {
                    const size_t t = (size_t)cg * 256 + w * 64 + i + k;
                    const ushort4 q4 = *(const ushort4*)(W_MQ + t * 1024 + h * 256 + lane * 4);
                    s[k] = bf2f(q4.x) * nv.x + bf2f(q4.y) * nv.y + bf2f(q4.z) * nv.z + bf2f(q4.w) * nv.w;
                }
#pragma unroll
                for (int k = 0; k < 8; ++k) { const float tot = wave_sum_dpp(s[k]); if (lane == 0) W_QN[((size_t)cg * 256 + w * 64 + i + k) * 4 + h] = tot; }
            }
        }
    }
    xcd_barrier(xb);
    {
        PH_BEGIN();
        GJOB_DEFAULT(g); g.A = W_PQ; g.a_pn_mask = 3; g.a_pn_step = 512; g.K = 512; g.nN = 4;
        g.Bt = W_BH; g.ldb = 512; g.b_pn_step = 256 * 512; g.b_pm_step = 4 * 256 * 512; g.C = (float*)W_MIXB;
        g.gs = W_GS; g.denp = W_DENP; g.qn = W_QN; g.gvec = PF(I_GMHEAD); g.mo = W_P6 + 2 * P6S; g.nblk = 128;
        if (blockIdx.x < 128) pg8::gemm_phase<8>(GEMM_LDSP, g, tidx);
        else {
            GJOB_DEFAULT(k); k.A = W_MN2; k.K = 1024; k.nM = 2; k.nN = 32; k.a_pn_shift = 4; k.a_pn_mask = 1; k.a_pn_step = 1024;
            k.Bt = (bf16_t*)(wsb + O_WXK); k.b_pn_mask = 15; k.b_pn_shift = 4; k.b_pn_step2 = 1024; k.C = W_KVP; k.bid0 = 128; k.nblk = 128;
            pg8::gemm_phase<12>(GEMM_LDSP, k, tidx);
        }
    }
    xcd_barrier(xb);
    {
        PH_BEGIN();
        for (int i = blockIdx.x * NTHR + tidx; i < 512 * 4096 / 4; i += gridDim.x * NTHR) {
            const int r = i >> 10, c = (i & 1023) * 4;
            const float4 a = *(const float4*)(W_KVP + (size_t)r * 4096 + c), b = *(const float4*)(W_KVP + (size_t)512 * 4096 + (size_t)r * 4096 + c);
            const float v0 = a.x + b.x, v1 = a.y + b.y, v2 = a.z + b.z, v3 = a.w + b.w;
            if (c < 2048) { uint2 o; o.x = pk2(v0, v1); o.y = pk2(v2, v3); *(uint2*)(W_KM + (size_t)r * 2048 + c) = o; }
            else { bf16_t* d = W_VMT + (size_t)(c - 2048) * 512 + r; d[0] = (bf16_t)f2bf(v0); d[512] = (bf16_t)f2bf(v1); d[1024] = (bf16_t)f2bf(v2); d[1536] = (bf16_t)f2bf(v3); }
        }
        GJOB_DEFAULT(g); g.A = W_MIXB; g.Bt = (bf16_t*)(wsb + O_WOUT); g.R = PF(I_X); g.C2 = W_HB; g.rssp = W_RSSP;
        pg8::gemm_phase<10>(GEMM_LDSP, g, tidx);
    }
    xcd_barrier(xb);
    {
        PH_BEGIN();
        {
            GJOB_DEFAULT(g); g.A = W_HB; g.Bt = (bf16_t*)(wsb + O_WXQ); g.C = (float*)W_QX;
            pg8::Unit u0;
            if (pg8::unit_next(g, 0, u0) && tidx < 256) { const size_t r = (size_t)u0.pm * 256 + tidx; float s = 0.f;
                { float4 pq[8];
#pragma unroll
                  for (int k = 0; k < 8; ++k) pq[k] = *(const float4*)(W_RSSP + r * 32 + 4 * k);
#pragma unroll
                  for (int k = 0; k < 8; ++k) s += (pq[k].x + pq[k].y) + (pq[k].z + pq[k].w); }
                ((LAS float*)(LAS unsigned char*)(smem_raw + GEMM_LDS + 1024 + 8192))[tidx] = rsqrtf(s * (1.0f / D) + EPS); }
            __syncthreads();
            pg8::gemm_phase<11>(GEMM_LDSP, g, tidx); __syncthreads();
        }

    }
    xcd_barrier(xb);
    {
        PH_BEGIN();
        GJOB_DEFAULT(g); g.A = W_QX; g.K = 512; g.a_pn_mask = 3; g.a_pn_step = 512; g.Bt = W_KM; g.b_pn_step = 512; g.b_pm_shift = 4; g.b_pm_step = 256 * D; g.nN = 4;
        g.C = (float*)W_PX; g.ldc = 1024; g.escale = 0.04419417382415922f * 1.4426950408889634f;
        pg8::gemm_phase<5>(GEMM_LDSP, g, tidx);
    }
    xcd_barrier(xb);
    {
        PH_BEGIN();
        GJOB_DEFAULT(g); g.A = W_PX; g.lda = 1024; g.a_pm_step = 256 * 1024; g.K = 256; g.a_pn_shift = 1; g.a_pn_mask = 3; g.a_pn_step = 256; g.Bt = W_VMT; g.ldb = 512; g.b_pn_step = 256 * 512; g.b_pm_shift = 4; g.b_pm_step = 256;
        g.C = (float*)W_MIXB;
        pg8::gemm_phase<3>(GEMM_LDSP, g, tidx);
    }
    xcd_barrier(xb);
    {
        PH_BEGIN();
        GJOB_DEFAULT(g); g.A = W_MIXB; g.Bt = (bf16_t*)(wsb + O_WXO); g.R = nullptr; g.C2 = W_HB; g.rssp = W_RSSP;
        pg8::gemm_phase<10>(GEMM_LDSP, g, tidx);
    }
    xcd_barrier(xb);
    {
        PH_BEGIN();
        GJOB_DEFAULT(g); g.A = W_HB; g.Bt = (bf16_t*)(wsb + O_WPQ); g.C = (float*)W_QX;
        pg8::Unit u0;
        if (pg8::unit_next(g, 0, u0) && tidx < 256) { const size_t r = (size_t)u0.pm * 256 + tidx; float s = 0.f;
                { float4 pq[8];
#pragma unroll
                  for (int k = 0; k < 8; ++k) pq[k] = *(const float4*)(W_RSSP + r * 32 + 4 * k);
#pragma unroll
                  for (int k = 0; k < 8; ++k) s += (pq[k].x + pq[k].y) + (pq[k].z + pq[k].w); }
            const float rs = rsqrtf(s * (1.0f / D) + EPS);
            ((LAS float*)(LAS unsigned char*)(smem_raw + GEMM_LDS + 1024 + 8192))[tidx] = rs; W_RSTD[r] = rs; }
        __syncthreads();
        pg8::gemm_phase<11>(GEMM_LDSP, g, tidx);
    }
    xcd_barrier(xb);
    {
        PH_BEGIN();
        LAS float* wl = (LAS float*)(LAS unsigned char*)smem_raw + (tidx >> 6) * 1024;
        const bool conv_first = ((tidx >> 6) & 1) != 0;
        if (!conv_first) {
#pragma nounroll
            for (int item = blockIdx.x * 8 + (tidx >> 6); item < 4096; item += gridDim.x * 8) peer_topk_wave2(item, tidx & 63, wl, W_QX, W_SKB, W_IDS, W_GATES);
        }
        {
            const int gw = blockIdx.x * 8 + (tidx >> 6), NGW = gridDim.x * 8; int lane = tidx & 63; asm volatile("" : "+v"(lane));
                const float* ut = PF(I_UTAB); const float* vt = PF(I_VTAB); const float* gffn = PF(I_GFFN);
#define TBL_LOAD(F, SRC, RR) _Pragma("unroll") for (int i = 0; i < 8; ++i) F[i] = *(const float4*)((SRC) + (size_t)(RR) * D + i * 256 + lane * 4);
                {
                    float4 fa[8], fb[8];
                    TBL_LOAD(fa, ut, gw)
#pragma nounroll
                    for (int rr = gw; rr < 16384; rr += 2 * NGW) {
                        TBL_LOAD(fb, ut, rr + NGW)
                        table_row_store<true>(fa, W_UT + (size_t)rr * D, W_RSC + rr, lane, gffn);
                        { const int nx = rr + 2 * NGW < 16384 ? rr + 2 * NGW : rr; TBL_LOAD(fa, ut, nx) }
                        table_row_store<true>(fb, W_UT + (size_t)(rr + NGW) * D, W_RSC + rr + NGW, lane, gffn);
                    }
                    TBL_LOAD(fa, vt, gw)
#pragma nounroll
                    for (int rr = gw; rr < 16384; rr += 2 * NGW) {
                        TBL_LOAD(fb, vt, rr + NGW)
                        table_row_store<false>(fa, W_VT + (size_t)rr * D, W_RSC + 16384 + rr, lane, nullptr);
                        { const int nx = rr + 2 * NGW < 16384 ? rr + 2 * NGW : rr; TBL_LOAD(fa, vt, nx) }
                        table_row_store<false>(fb, W_VT + (size_t)(rr + NGW) * D, W_RSC + 16384 + rr + NGW, lane, nullptr);
                    }
                }
#undef TBL_LOAD
            }
        if (conv_first) {
#pragma nounroll
            for (int item = blockIdx.x * 8 + (tidx >> 6); item < 4096; item += gridDim.x * 8) peer_topk_wave2(item, tidx & 63, wl, W_QX, W_SKB, W_IDS, W_GATES);
        }
    }
    xcd_barrier(xb);
    {
        PH_BEGIN();
        const float* gf = PF(I_GFINAL); float* outp = (float*)ldp_raw(I_OUT);
        LAS unsigned char* wl = (LAS unsigned char*)smem_raw + (tidx >> 6) * 11776;
#pragma nounroll
        for (int gw = blockIdx.x * 8 + (tidx >> 6); gw < T / 4; gw += gridDim.x * 8) { int ln = tidx & 63; asm volatile("" : "+v"(ln));
            peer_sweep_wave(gw, ln, wl, W_HB, W_XR, W_IDS, W_GATES, W_UT, W_VT, W_RSC, W_RSTD, gf, outp); }
    }
}
}

extern "C" void kernel_launch(void* const* d_in, const int* in_sizes, int n_in, void* d_out, int out_size, void* d_ws, size_t ws_size, hipStream_t stream) {
    static int grid_blocks = 0;
    if (!grid_blocks) {
        int dev = 0, cus = 0, per_cu = 0;
        hipGetDevice(&dev);
        hipDeviceGetAttribute(&cus, hipDeviceAttributeMultiprocessorCount, dev);
        hipFuncSetAttribute((const void*)mega, hipFuncAttributeMaxDynamicSharedMemorySize, SMEM_BYTES);
        hipOccupancyMaxActiveBlocksPerMultiprocessor(&per_cu, mega, NTHR, SMEM_BYTES);
        if (per_cu > 1) per_cu = 1;
        if (per_cu < 1) per_cu = 1;
        grid_blocks = cus * per_cu;
    }
    Params P{};
    const float** pp = (const float**)&P;
    for (int i = 0; i < 25; ++i) pp[i] = (const float*)d_in[i];
    P.out = (float*)d_out;
    P.bar = (unsigned*)d_ws;
    P.ws = (float*)((char*)d_ws + 16384);
    hipMemsetAsync(d_ws, 0, 16384, stream);
    void* args[] = {&P};
    hipError_t e = hipLaunchCooperativeKernel((const void*)mega, dim3(grid_blocks), dim3(NTHR), args, SMEM_BYTES, stream);
    if (e != hipSuccess) fprintf(stderr, "cooperative launch failed: %s (grid %d)\n", hipGetErrorString(e), grid_blocks);
}
```

```cpp
#include <hip/hip_runtime.h>
#include <stdint.h>
#include <math.h>
#include <cstdio>

#define LAS_ __attribute__((address_space(3)))
namespace {
constexpr int D = 2048, NB = 2, S = 4096, T = NB * S;
constexpr int INC = 6152;
constexpr int C_MIN = 0, C_MV = 1024, C_MO = 2048, C_MI = 3072, C_MF = 3076, C_AQ = 3080, C_AK = 4104, C_AV = 5128;
constexpr float EPS = 1e-6f;
constexpr size_t P6S = (size_t)8192 * 1024;
constexpr int NTHR = 512;
constexpr int HALF_SM_FLOATS = 8704;
constexpr int GEMM_LDS = 131072;
constexpr int SMEM_BYTES = 163840;
constexpr int CTRL_OFF = SMEM_BYTES - 1024;
typedef unsigned short bf16_t;
__device__ __forceinline__ unsigned f2bf(float f) { unsigned u = __float_as_uint(f); u += 0x7FFFu + ((u >> 16) & 1u); return u >> 16; }
__device__ __forceinline__ unsigned pk2(float lo, float hi) { return f2bf(lo) | (f2bf(hi) << 16); }
__device__ __forceinline__ float bf2f(unsigned short b) { return __uint_as_float(((unsigned)b) << 16); }
extern __shared__ __attribute__((aligned(16))) unsigned char smem_raw[];
enum { I_X = 0, I_MEM, I_GMIX, I_WIN, I_CONVW, I_CONVB, I_WMQ, I_WMK, I_BMI, I_BMF, I_GMHEAD, I_GAHEAD, I_WOUT, I_GCROSS, I_GMEM,
       I_WXQ, I_WXK, I_WXV, I_WXO, I_GFFN, I_WPQ, I_SUBK, I_UTAB, I_VTAB, I_GFINAL, I_OUT, I_BAR, I_WS, I_NPTR };
__device__ __forceinline__ unsigned long long ldp_raw(int i) {
    const LAS_ unsigned long long* tab = (const LAS_ unsigned long long*)(LAS_ unsigned char*)(smem_raw + CTRL_OFF + 64);
    const unsigned long long v = tab[i];
    const unsigned lo = __builtin_amdgcn_readfirstlane((unsigned)v), hi = __builtin_amdgcn_readfirstlane((unsigned)(v >> 32));
    return ((unsigned long long)hi << 32) | lo;
}
#define PF(i) ((const float*)ldp_raw(i))

#define XB_TMO      128
#define XB_XCNT(j)  (256  + 64 * (j))
#define XB_XSUB(j)  (1280 + 64 * (j))
#define XB_XGEN(j)  (2304 + 64 * (j))
#define XB_TOP      3328
#define XB_TOPGEN   3392
#define XCD_BAR_WORDS 3456
#define XB_SPIN_CAP (1u << 22)
#define LAS __attribute__((address_space(3)))

__device__ __forceinline__ unsigned xb_ld(unsigned* p)              { return __hip_atomic_load(p, __ATOMIC_RELAXED, __HIP_MEMORY_SCOPE_AGENT); }
__device__ __forceinline__ unsigned xb_add(unsigned* p, unsigned v) { return __hip_atomic_fetch_add(p, v, __ATOMIC_RELAXED, __HIP_MEMORY_SCOPE_AGENT); }
__device__ __forceinline__ unsigned xb_xcc_id() { return (unsigned)__builtin_amdgcn_s_getreg((3 << 11) | 20) & 0xFu; }
#define XB_SPIN(cond, bar) do { unsigned _sp = 0; while (cond) { __builtin_amdgcn_s_sleep(1); \
    if ((++_sp & 255u) == 0u) { if (xb_ld(&(bar)[XB_TMO])) break; if (_sp > XB_SPIN_CAP) { atomicAdd(&(bar)[XB_TMO], 1u); break; } } } } while (0)

struct XcdBarrier { unsigned* bar; unsigned x; volatile LAS unsigned* st; };

__device__ __forceinline__ XcdBarrier xcd_barrier_post(unsigned* bar, volatile LAS unsigned* st) {
    XcdBarrier b; b.bar = bar; b.x = xb_xcc_id(); b.st = st;
    if (threadIdx.x == 0) (void)xb_add(&bar[XB_XCNT(b.x)], 1u);
    return b;
}
__device__ __forceinline__ void xcd_barrier_complete(unsigned* bar, unsigned x, unsigned& nloc, unsigned& nx) {
    const unsigned G = gridDim.x * gridDim.y * gridDim.z;
    unsigned sum, cnt, mine, sp = 0u;
    for (;;) {
        sum = 0u; cnt = 0u; mine = 0u;
#pragma unroll
        for (unsigned j = 0; j < 16; ++j) { const unsigned c = xb_ld(&bar[XB_XCNT(j)]); sum += c; cnt += (c > 0u) ? 1u : 0u; mine = (j == x) ? c : mine; }
        if (sum == G) break;
        __builtin_amdgcn_s_sleep(1);
        if ((++sp & 255u) == 0u) { if (xb_ld(&bar[XB_TMO])) break; if (sp > XB_SPIN_CAP) { atomicAdd(&bar[XB_TMO], 1u); break; } }
    }
    nloc = mine > 0u ? mine : 1u; nx = cnt > 0u ? cnt : 1u;
}
__device__ __forceinline__ void xcd_barrier(const XcdBarrier& b) {
    asm volatile("s_waitcnt vmcnt(0)" ::: "memory");
    __syncthreads();
    if (threadIdx.x == 0) {
        unsigned* bar = b.bar;
        __builtin_amdgcn_s_waitcnt(0);
        unsigned nloc = b.st[0], nx = b.st[1];
        if (nloc == 0u) { xcd_barrier_complete(bar, b.x, nloc, nx); b.st[0] = nloc; b.st[1] = nx; }
        const unsigned old = xb_add(&bar[XB_XSUB(b.x)], 1u);
        const unsigned gen = old / nloc;
        if (old + 1u == (gen + 1u) * nloc) {
            __builtin_amdgcn_fence(__ATOMIC_RELEASE, "agent");
            asm volatile("s_waitcnt vmcnt(0)" ::: "memory");
            const unsigned og = xb_add(&bar[XB_TOP], 1u);
            const unsigned tg = og / nx;
            if (og + 1u == (tg + 1u) * nx) xb_add(&bar[XB_TOPGEN], 1u);
            else XB_SPIN(xb_ld(&bar[XB_TOPGEN]) == tg, bar);
            __builtin_amdgcn_fence(__ATOMIC_ACQUIRE, "agent");
            xb_add(&bar[XB_XGEN(b.x)], 1u);
            asm volatile("s_waitcnt vmcnt(0)" ::: "memory");
        } else {
            XB_SPIN(xb_ld(&bar[XB_XGEN(b.x)]) == gen, bar);
            __builtin_amdgcn_fence(__ATOMIC_ACQUIRE, "agent");
            asm volatile("s_waitcnt vmcnt(0)" ::: "memory");
        }
    }
    __syncthreads();
}

__device__ __forceinline__ float wave_sum(float v) {
#pragma unroll
    for (int o = 32; o >= 1; o >>= 1) v += __shfl_xor(v, o);
    return v;
}
__device__ __forceinline__ float wave_max(float v) {
#pragma unroll
    for (int o = 32; o >= 1; o >>= 1) v = fmaxf(v, __shfl_xor(v, o));
    return v;
}
__device__ __forceinline__ float log_sigmoid(float x) { return fminf(x, 0.f) - log1pf(expf(-fabsf(x))); }


__device__ __forceinline__ void d_rmsnorm(int vb, int t, float* sm, const float* __restrict__ in, const float* __restrict__ g, bf16_t* __restrict__ out,
                                          const float* gwl  , float* __restrict__ gpre) {
    float* red = sm;
    const int row = vb;
    const float4* p = (const float4*)(in + (size_t)row * D);
    float4 a = p[t], b = p[t + 256];
    float s = a.x * a.x + a.y * a.y + a.z * a.z + a.w * a.w + b.x * b.x + b.y * b.y + b.z * b.z + b.w * b.w;
    s = wave_sum(s);
    __syncthreads();
    if ((t & 63) == 0) red[t >> 6] = s;
    __syncthreads();
    const float tot = red[0] + red[1] + red[2] + red[3];
    const float r = rsqrtf(tot * (1.0f / D) + EPS);
    const float4* gp = (const float4*)g;
    float4 ga = gp[t], gb = gp[t + 256];
    float hv[8] = {a.x * r * ga.x, a.y * r * ga.y, a.z * r * ga.z, a.w * r * ga.w, b.x * r * gb.x, b.y * r * gb.y, b.z * r * gb.z, b.w * r * gb.w};
    uint2 o0, o1;
    o0.x = pk2(hv[0], hv[1]); o0.y = pk2(hv[2], hv[3]); o1.x = pk2(hv[4], hv[5]); o1.y = pk2(hv[6], hv[7]);
    *(uint2*)(out + (size_t)row * D + t * 4) = o0;
    *(uint2*)(out + (size_t)row * D + 1024 + t * 4) = o1;
    if (gpre) {
        float gs[8];
#pragma unroll
        for (int c = 0; c < 8; ++c) gs[c] = 0.f;
#pragma unroll
        for (int j = 0; j < 8; ++j) {
            const int k = (j < 4) ? (t * 4 + j) : (1024 + t * 4 + (j - 4));
            const float4 w0 = *(const float4*)(gwl + k * 8), w1 = *(const float4*)(gwl + k * 8 + 4);
            gs[0] = fmaf(hv[j], w0.x, gs[0]); gs[1] = fmaf(hv[j], w0.y, gs[1]); gs[2] = fmaf(hv[j], w0.z, gs[2]); gs[3] = fmaf(hv[j], w0.w, gs[3]);
            gs[4] = fmaf(hv[j], w1.x, gs[4]); gs[5] = fmaf(hv[j], w1.y, gs[5]); gs[6] = fmaf(hv[j], w1.z, gs[6]); gs[7] = fmaf(hv[j], w1.w, gs[7]);
        }
#pragma unroll
        for (int c = 0; c < 8; ++c) gs[c] = wave_sum(gs[c]);
        __syncthreads();
        if ((t & 63) == 0) {
#pragma unroll
            for (int c = 0; c < 8; ++c) red[8 + (t >> 6) * 8 + c] = gs[c];
        }
        __syncthreads();
        if (t < 8) gpre[(size_t)row * 8 + t] = red[8 + t] + red[16 + t] + red[24 + t] + red[32 + t];
    }
}

namespace pg8 {
typedef short bf16x8 __attribute__((ext_vector_type(8)));
typedef float f32x4 __attribute__((ext_vector_type(4)));
constexpr int BM = 256, BK = 64, HALF = 128, HTB = HALF * BK * 2, NXCD = 8, WGM = 8;
__device__ __forceinline__ int lds_byte(int r, int c) { const int st = (r >> 4) * 2 + (c >> 5), rr = r & 15, cc = c & 31, ob = rr * 64 + cc * 2; return st * 1024 + (ob ^ (((ob >> 9) & 1) << 5)); }
__device__ __forceinline__ void stage_rc(int b, int& R, int& C) { const int st = b / 1024, sb = b % 1024, swz = sb ^ (((sb >> 9) & 1) << 5); R = (st >> 1) * 16 + swz / 64; C = (st & 1) * 32 + (swz % 64) / 2; }
__device__ __forceinline__ int perm32(int rho) { const int n = rho >> 4, i = rho & 15; return 8 * (i >> 2) + 4 * n + (i & 3); }
template <int MODE> struct ModePerm { static constexpr bool value = (MODE == 3 || MODE == 4 || MODE == 11 || MODE == 10 || MODE == 5 || MODE == 6 || MODE == 8); };
struct Unit { int pm, pn; };
struct GJob {
    const bf16_t* A; const bf16_t* Bt;
    int lda, ldb, K, nM, nN;
    int a_pn_shift, a_pn_mask, a_pn_step;
    int b_pm_shift, b_pm_step, b_pn_step;
    int a_pm_step;
    int b_pn_mask, b_pn_shift, b_pn_step2;
    int bid0, nblk;
    float escale;
    const float* gs; float* denp; const float* qn; const float* gvec; const bf16_t* mo;
    bf16_t* C2; float* rssp; const float* rstd;
    float* C; int ldc; const float* R; int ldr;
    int mode;
};
__device__ __forceinline__ bool unit_next(const GJob& g, int i, Unit& u) {
    const int nwg = g.nM * g.nN;
    const int bid = (int)blockIdx.x - g.bid0; if (bid < 0 || bid >= g.nblk) return false;
    const long L = (long)i * g.nblk + bid; if (L >= nwg) return false;
    int wgid = (int)L; { const int q = nwg / NXCD, r = nwg % NXCD, xcd = wgid % NXCD, off = wgid / NXCD; wgid = (xcd < r ? xcd * (q + 1) : r * (q + 1) + (xcd - r) * q) + off; }
    const int nig = WGM * g.nN, gid = wgid / nig, fm = gid * WGM, gsz = (g.nM - fm) < WGM ? (g.nM - fm) : WGM;
    u.pm = fm + ((wgid % nig) % gsz); u.pn = (wgid % nig) / gsz; return true;
}
template <int MODE> __device__ __forceinline__ void epilogue(const GJob& g, f32x4 (&acc)[2][2][4][2], const Unit& u, int wr, int wc, int fr, int fq, LAS unsigned char* xlds) {
    const int row0 = u.pm * BM + wr * 64 + fr;
    if constexpr (MODE == 0) {
        const int col0 = u.pn * BM + wc * 32 + 4 * fq;
#pragma unroll
        for (int ai = 0; ai < 2; ++ai)
#pragma unroll
            for (int m = 0; m < 4; ++m) {
                const int row = row0 + ai * HALF + m * 16;
                float* rowp = g.C + (size_t)row * g.ldc + col0;
                const float* rp = g.R ? g.R + (size_t)row * g.ldr + col0 : nullptr;
#pragma unroll
                for (int bj = 0; bj < 2; ++bj)
#pragma unroll
                    for (int n = 0; n < 2; ++n) {
                        f32x4 v = acc[ai][bj][m][n];
                        if (rp) v = v + *(const f32x4*)(rp + bj * HALF + n * 16);
                        *(f32x4*)(rowp + bj * HALF + n * 16) = v;
                    }
            }
    } else if constexpr (MODE == 10) {
        const int col0 = u.pn * BM + wc * 32 + 8 * fq;
#pragma unroll
        for (int ai = 0; ai < 2; ++ai)
#pragma unroll
            for (int m = 0; m < 4; ++m) {
                const int row = row0 + ai * HALF + m * 16;
                bf16_t* r2 = g.C2 + (size_t)row * D + col0;
                float ss = 0.f;
#pragma unroll
                for (int bj = 0; bj < 2; ++bj) {
                    f32x4 v0 = acc[ai][bj][m][0], v1 = acc[ai][bj][m][1];
                    if (g.R) { const float* rp = g.R + (size_t)row * g.ldr + col0 + bj * HALF; v0 = v0 + *(const f32x4*)rp; v1 = v1 + *(const f32x4*)(rp + 4); }
                    else { const uint4 pr = *(const uint4*)(r2 + bj * HALF);
                           v0[0] += __uint_as_float(pr.x << 16); v0[1] += __uint_as_float(pr.x & 0xFFFF0000u); v0[2] += __uint_as_float(pr.y << 16); v0[3] += __uint_as_float(pr.y & 0xFFFF0000u);
                           v1[0] += __uint_as_float(pr.z << 16); v1[1] += __uint_as_float(pr.z & 0xFFFF0000u); v1[2] += __uint_as_float(pr.w << 16); v1[3] += __uint_as_float(pr.w & 0xFFFF0000u); }
                    uint4 o; o.x = pk2(v0[0], v0[1]); o.y = pk2(v0[2], v0[3]); o.z = pk2(v1[0], v1[1]); o.w = pk2(v1[2], v1[3]);
                    *(uint4*)(r2 + bj * HALF) = o;
                    ss += (v0[0] * v0[0] + v0[1] * v0[1]) + (v0[2] * v0[2] + v0[3] * v0[3]) + (v1[0] * v1[0] + v1[1] * v1[1]) + (v1[2] * v1[2] + v1[3] * v1[3]);
                }
                ss += __shfl_xor(ss, 16); ss += __shfl_xor(ss, 32);
                if (fq == 0) g.rssp[(size_t)row * 32 + u.pn * 4 + wc] = ss;
            }
    } else if constexpr (MODE == 11) {
        bf16_t* Cb = (bf16_t*)g.C;
        const int col0 = u.pn * BM + wc * 32 + 8 * fq;
#pragma unroll
        for (int ai = 0; ai < 2; ++ai)
#pragma unroll
            for (int m = 0; m < 4; ++m) {
                const int row = row0 + ai * HALF + m * 16;
                const float rs = ((const LAS float*)(xlds + 8192))[row - u.pm * BM];
                bf16_t* rowp = Cb + (size_t)row * g.ldc + col0;
#pragma unroll
                for (int bj = 0; bj < 2; ++bj) {
                    const f32x4 v0 = acc[ai][bj][m][0] * rs, v1 = acc[ai][bj][m][1] * rs;
                    uint4 o; o.x = pk2(v0[0], v0[1]); o.y = pk2(v0[2], v0[3]); o.z = pk2(v1[0], v1[1]); o.w = pk2(v1[2], v1[3]);
                    *(uint4*)(rowp + bj * HALF) = o;
                }
            }
    } else if constexpr (MODE == 6) {
        const int h = u.pn; const size_t t0 = (size_t)u.pm * BM;
        bf16_t* Cb = (bf16_t*)g.C;
#pragma unroll
        for (int ai = 0; ai < 2; ++ai)
#pragma unroll
            for (int m = 0; m < 4; ++m) {
                const int l = ai * HALF + wr * 64 + m * 16 + fr;
                const float M2 = g.gs[((t0 + l) * 4 + h) * 8 + 1];
                bf16_t* rowp = Cb + (t0 + l) * 2048 + h * 512 + wc * 32 + 8 * fq;
                float rs = 0.f;
#pragma unroll
                for (int bj = 0; bj < 2; ++bj) {
                    unsigned ow[4];
#pragma unroll
                    for (int n = 0; n < 2; ++n) {
                        const f32x4 a = acc[ai][bj][m][n];
                        const int s0 = bj * HALF + wc * 32 + 8 * fq + 4 * n;
                        float p[4];
#pragma unroll
                        for (int r = 0; r < 4; ++r) { const float u2 = g.gs[((t0 + s0 + r) * 4 + h) * 8 + 0]; p[r] = (s0 + r <= l) ? a[r] * __builtin_amdgcn_exp2f(u2 - M2) : 0.f; rs += p[r]; }
                        ow[2 * n] = pk2(p[0], p[1]); ow[2 * n + 1] = pk2(p[2], p[3]);
                    }
                    *(uint4*)(rowp + bj * HALF) = make_uint4(ow[0], ow[1], ow[2], ow[3]);
                }
                rs += __shfl_xor(rs, 16); rs += __shfl_xor(rs, 32);
                if (fq == 0) g.denp[((t0 + l) * 4 + h) * 4 + wc] = rs;
            }
    } else if constexpr (MODE == 12) {
        float* Ct = g.C + (size_t)(u.pn >> 4) * ((size_t)512 * 4096) + (size_t)(u.pn & 15) * 256;
        const int col0 = wc * 32 + 4 * fq;
#pragma unroll
        for (int ai = 0; ai < 2; ++ai)
#pragma unroll
            for (int m = 0; m < 4; ++m) {
                float* rowp = Ct + (size_t)(row0 + ai * HALF + m * 16) * 4096 + col0;
#pragma unroll
                for (int bj = 0; bj < 2; ++bj)
#pragma unroll
                    for (int n = 0; n < 2; ++n) *(f32x4*)(rowp + bj * HALF + n * 16) = acc[ai][bj][m][n];
            }
    } else if constexpr (MODE == 7) {
        float* Ct = g.C + (size_t)(u.pm * 4 + u.pn) * 65536;
        const int col0 = wc * 32 + 4 * fq;
#pragma unroll
        for (int ai = 0; ai < 2; ++ai)
#pragma unroll
            for (int m = 0; m < 4; ++m) {
                float* rowp = Ct + (size_t)(ai * HALF + wr * 64 + m * 16 + fr) * 256 + col0;
#pragma unroll
                for (int bj = 0; bj < 2; ++bj)
#pragma unroll
                    for (int n = 0; n < 2; ++n) *(f32x4*)(rowp + bj * HALF + n * 16) = acc[ai][bj][m][n];
            }
    } else if constexpr (MODE == 8) {
        const int h = u.pn; const size_t t0 = (size_t)u.pm * BM;
        LAS float* X0 = (LAS float*)xlds + wr * 512;
#pragma unroll
        for (int ai = 0; ai < 2; ++ai)
#pragma unroll
            for (int m = 0; m < 4; ++m) {
                const size_t th = (t0 + ai * HALF + wr * 64 + m * 16 + fr) * 4 + h;
                const f32x4 dp = *(const f32x4*)(g.denp + th * 4);
                const float den = (dp[0] + dp[1]) + (dp[2] + dp[3]) + g.gs[th * 8 + 3] * g.qn[th];
                const float rden = 1.0f / fmaxf(fabsf(den), g.gs[th * 8 + 4]);
                float ss = 0.f;
#pragma unroll
                for (int bj = 0; bj < 2; ++bj)
#pragma unroll
                    for (int n = 0; n < 2; ++n) { f32x4 a = acc[ai][bj][m][n] * rden; acc[ai][bj][m][n] = a; ss += (a[0] * a[0] + a[1] * a[1]) + (a[2] * a[2] + a[3] * a[3]); }
                ss += __shfl_xor(ss, 16); ss += __shfl_xor(ss, 32);
                if (fq == 0) X0[(ai * 64 + m * 16 + fr) * 4 + wc] = ss;
            }
        asm volatile("s_waitcnt lgkmcnt(0)" ::: "memory"); __builtin_amdgcn_s_barrier(); asm volatile("" ::: "memory");
        bf16_t* Cb = (bf16_t*)g.C;
        const int col0 = wc * 32 + 8 * fq;
#pragma unroll
        for (int ai = 0; ai < 2; ++ai)
#pragma unroll
            for (int m = 0; m < 4; ++m) {
                const f32x4 p4 = *(const LAS f32x4*)(X0 + (ai * 64 + m * 16 + fr) * 4);
                const float rsn = rsqrtf(((p4[0] + p4[1]) + (p4[2] + p4[3])) * (1.0f / 256.0f) + EPS);
                const size_t t = t0 + ai * HALF + wr * 64 + m * 16 + fr;
                bf16_t* rowp = Cb + t * 2048 + h * 256 + col0;
                const bf16_t* mop = g.mo + t * 1024 + h * 256 + col0;
#pragma unroll
                for (int bj = 0; bj < 2; ++bj) {
                    const uint4 mo8 = *(const uint4*)(mop + bj * HALF);
                    const unsigned mw[4] = {mo8.x, mo8.y, mo8.z, mo8.w};
                    unsigned ow[4];
#pragma unroll
                    for (int n = 0; n < 2; ++n) {
                        const f32x4 a = acc[ai][bj][m][n];
                        const f32x4 gv = *(const f32x4*)(g.gvec + h * 256 + col0 + bj * HALF + 4 * n);
                        const float o0 = a[0] * rsn * gv[0] / (1.0f + __expf(-__uint_as_float(mw[2 * n] << 16)));
                        const float o1 = a[1] * rsn * gv[1] / (1.0f + __expf(-__uint_as_float(mw[2 * n] & 0xFFFF0000u)));
                        const float o2 = a[2] * rsn * gv[2] / (1.0f + __expf(-__uint_as_float(mw[2 * n + 1] << 16)));
                        const float o3 = a[3] * rsn * gv[3] / (1.0f + __expf(-__uint_as_float(mw[2 * n + 1] & 0xFFFF0000u)));
                        ow[2 * n] = pk2(o0, o1); ow[2 * n + 1] = pk2(o2, o3);
                    }
                    *(uint4*)(rowp + bj * HALF) = make_uint4(ow[0], ow[1], ow[2], ow[3]);
                }
            }
    } else if constexpr (MODE == 5) {
        LAS float* X0 = (LAS float*)xlds + wr * 512;
        LAS float* X1 = (LAS float*)xlds + 1024 + wr * 512;
#pragma unroll
        for (int ai = 0; ai < 2; ++ai)
#pragma unroll
            for (int m = 0; m < 4; ++m) {
                float v = -INFINITY;
#pragma unroll
                for (int bj = 0; bj < 2; ++bj)
#pragma unroll
                    for (int n = 0; n < 2; ++n) { const f32x4 a = acc[ai][bj][m][n]; v = fmaxf(v, fmaxf(fmaxf(a[0], a[1]), fmaxf(a[2], a[3]))); }
                v = fmaxf(v, __shfl_xor(v, 16)); v = fmaxf(v, __shfl_xor(v, 32));
                if (fq == 0) X0[(ai * 64 + m * 16 + fr) * 4 + wc] = v;
            }
        asm volatile("s_waitcnt lgkmcnt(0)" ::: "memory"); __builtin_amdgcn_s_barrier(); asm volatile("" ::: "memory");
#pragma unroll
        for (int ai = 0; ai < 2; ++ai)
#pragma unroll
            for (int m = 0; m < 4; ++m) {
                const f32x4 p4 = *(const LAS f32x4*)(X0 + (ai * 64 + m * 16 + fr) * 4);
                const float mxr = fmaxf(fmaxf(p4[0], p4[1]), fmaxf(p4[2], p4[3])) * g.escale;
                float s = 0.f;
#pragma unroll
                for (int bj = 0; bj < 2; ++bj)
#pragma unroll
                    for (int n = 0; n < 2; ++n) { f32x4 a = acc[ai][bj][m][n];
                        a[0] = __builtin_amdgcn_exp2f(a[0] * g.escale - mxr); a[1] = __builtin_amdgcn_exp2f(a[1] * g.escale - mxr); a[2] = __builtin_amdgcn_exp2f(a[2] * g.escale - mxr); a[3] = __builtin_amdgcn_exp2f(a[3] * g.escale - mxr);
                        acc[ai][bj][m][n] = a; s += (a[0] + a[1]) + (a[2] + a[3]); }
                s += __shfl_xor(s, 16); s += __shfl_xor(s, 32);
                if (fq == 0) X1[(ai * 64 + m * 16 + fr) * 4 + wc] = s;
            }
        asm volatile("s_waitcnt lgkmcnt(0)" ::: "memory"); __builtin_amdgcn_s_barrier(); asm volatile("" ::: "memory");
        bf16_t* Cb = (bf16_t*)g.C;
        const int col0 = u.pn * BM + wc * 32 + 8 * fq;
#pragma unroll
        for (int ai = 0; ai < 2; ++ai)
#pragma unroll
            for (int m = 0; m < 4; ++m) {
                const f32x4 p4 = *(const LAS f32x4*)(X1 + (ai * 64 + m * 16 + fr) * 4);
                const float inv = 1.0f / ((p4[0] + p4[1]) + (p4[2] + p4[3]));
                bf16_t* rowp = Cb + (size_t)(row0 + ai * HALF + m * 16) * g.ldc + col0;
#pragma unroll
                for (int bj = 0; bj < 2; ++bj) {
                    const f32x4 a = acc[ai][bj][m][0], b = acc[ai][bj][m][1];
                    uint4 o; o.x = pk2(a[0] * inv, a[1] * inv); o.y = pk2(a[2] * inv, a[3] * inv); o.z = pk2(b[0] * inv, b[1] * inv); o.w = pk2(b[2] * inv, b[3] * inv);
                    *(uint4*)(rowp + bj * HALF) = o;
                }
            }
    } else {
        bf16_t* Cb = (bf16_t*)g.C; int ccol = u.pn * BM;
        if constexpr (MODE == 4) { Cb += (size_t)(u.pn >> 2) * P6S; ccol = (u.pn & 3) * 256; }
        const int col0 = ccol + wc * 32 + 8 * fq;
#pragma unroll
        for (int ai = 0; ai < 2; ++ai)
#pragma unroll
            for (int m = 0; m < 4; ++m) {
                bf16_t* rowp = Cb + (size_t)(row0 + ai * HALF + m * 16) * g.ldc + col0;
#pragma unroll
                for (int bj = 0; bj < 2; ++bj) {
                    const f32x4 v0 = acc[ai][bj][m][0], v1 = acc[ai][bj][m][1];
                    uint4 o; o.x = pk2(v0[0], v0[1]); o.y = pk2(v0[2], v0[3]); o.z = pk2(v1[0], v1[1]); o.w = pk2(v1[2], v1[3]);
                    *(uint4*)(rowp + bj * HALF) = o;
                }
            }
    }
}
template <int MODE> __device__ __forceinline__ void gemm_phase(LAS unsigned char* lds, const GJob& g, int tid) {
    const int wid = __builtin_amdgcn_readfirstlane(tid >> 6), lane = tid & 63, wr = wid >> 2, wc = wid & 3, fr = lane & 15, fq = lane >> 4;
    const int K = g.K, nt = K / BK;
    unsigned voffA[2], voffB[2];
#pragma unroll
    for (int i = 0; i < 2; ++i) { int R, C; stage_rc(tid * 16 + i * 8192, R, C);
        const int Rb = ModePerm<MODE>::value ? ((R & ~31) + perm32(R & 31)) : R;
        voffA[i] = (unsigned)(R * g.lda + C) * 2u; voffB[i] = (unsigned)(Rb * g.ldb + C) * 2u; }
    const size_t kstep = (size_t)(BK * 2);
    const size_t hstepA = (size_t)HALF * g.lda * 2, hstepB = (size_t)HALF * g.ldb * 2;
    const unsigned ldsw = (unsigned)wid * 1024u;
    const int aoff = lds_byte(wr * 64 + fr, fq * 8), boff = lds_byte(wc * 32 + fr, fq * 8);
#define PG8_SA(b, h) (((b) * 2 + (h)) * HTB)
#define PG8_SB(b, h) ((4 + (b) * 2 + (h)) * HTB)
#define PG8_STAGE(bufoff, gbase, voff) do { _Pragma("unroll") for (int _i = 0; _i < 2; ++_i) \
        __builtin_amdgcn_global_load_lds((const unsigned*)((const char*)(gbase) + (voff)[_i]), (LAS unsigned*)(lds + (bufoff) + ldsw + _i * 8192), 16, 0, 0); } while (0)
#define PG8_LDA(dst, b, h) do { _Pragma("unroll") for (int m = 0; m < 4; ++m) _Pragma("unroll") for (int k = 0; k < 2; ++k) dst[m][k] = *(const LAS bf16x8*)(lds + PG8_SA(b, h) + aoff + m * 2048 + k * 1024); } while (0)
#define PG8_LDB(dst, b, h) do { _Pragma("unroll") for (int n = 0; n < 2; ++n) _Pragma("unroll") for (int k = 0; k < 2; ++k) dst[n][k] = *(const LAS bf16x8*)(lds + PG8_SB(b, h) + boff + n * 2048 + k * 1024); } while (0)
#define PG8_MMA(ai, bj, At, Bt) do { __builtin_amdgcn_s_setprio(1); _Pragma("unroll") for (int m = 0; m < 4; ++m) _Pragma("unroll") for (int n = 0; n < 2; ++n) _Pragma("unroll") for (int k = 0; k < 2; ++k) \
        acc[ai][bj][m][n] = __builtin_amdgcn_mfma_f32_16x16x32_bf16(Bt[n][k], At[m][k], acc[ai][bj][m][n], 0, 0, 0); __builtin_amdgcn_s_setprio(0); } while (0)
#define PG8_WAIT_V(n) asm volatile("s_waitcnt vmcnt(" #n ")" ::: "memory")
#define PG8_WAIT_L(n) asm volatile("s_waitcnt lgkmcnt(" #n ")" ::: "memory")
#define PG8_BAR __builtin_amdgcn_s_barrier()
#define PG8_SCHED __builtin_amdgcn_sched_barrier(0)
#define PG8_ABASE(u) ((const char*)g.A + ((size_t)(u).pm * g.a_pm_step + (size_t)(((u).pn >> g.a_pn_shift) & g.a_pn_mask) * g.a_pn_step) * 2)
#define PG8_BBASE(u) ((const char*)g.Bt + ((size_t)((u).pn & g.b_pn_mask) * g.b_pn_step + (size_t)((u).pn >> g.b_pn_shift) * g.b_pn_step2 + (size_t)((u).pm >> g.b_pm_shift) * g.b_pm_step) * 2)
    Unit cur, nxt; int ui = 0;
    if (!unit_next(g, 0, cur)) return;
    f32x4 acc[2][2][4][2];
#pragma unroll
    for (int a = 0; a < 2; ++a)
#pragma unroll
        for (int b = 0; b < 2; ++b)
#pragma unroll
            for (int m = 0; m < 4; ++m)
#pragma unroll
                for (int n = 0; n < 2; ++n) acc[a][b][m][n] = (f32x4){0.f, 0.f, 0.f, 0.f};
    bf16x8 At[4][2], B0[2][2], B1[2][2];
    const char* cA = PG8_ABASE(cur); const char* cB = PG8_BBASE(cur);
    PG8_STAGE(PG8_SB(0, 0), cB, voffB); PG8_STAGE(PG8_SA(0, 0), cA, voffA); PG8_STAGE(PG8_SB(0, 1), cB + hstepB, voffB); PG8_STAGE(PG8_SA(0, 1), cA + hstepA, voffA);
    if (wr == 1) PG8_BAR;
    PG8_WAIT_V(4); PG8_BAR;
    PG8_STAGE(PG8_SB(1, 0), cB + kstep, voffB); PG8_STAGE(PG8_SA(1, 0), cA + kstep, voffA); PG8_STAGE(PG8_SB(1, 1), cB + hstepB + kstep, voffB);
    PG8_WAIT_V(6); PG8_BAR;
    for (;;) {
        const bool has_next = unit_next(g, ui + 1, nxt);
        const char* nA = has_next ? PG8_ABASE(nxt) : cA; const char* nB = has_next ? PG8_BBASE(nxt) : cB;
        for (int t = 0; t < nt; t += 2) {
            const bool last = (t == nt - 2);
            const char* a1 = cA + (size_t)(t + 1) * kstep;
            const char* a2 = last ? nA : cA + (size_t)(t + 2) * kstep; const char* b2 = last ? nB : cB + (size_t)(t + 2) * kstep;
            const char* a3 = a2 + kstep; const char* b3 = b2 + kstep;
            PG8_LDB(B0, 0, 0); PG8_SCHED; PG8_LDA(At, 0, 0); PG8_STAGE(PG8_SA(1, 1), a1 + hstepA, voffA);
            PG8_WAIT_L(8); PG8_BAR; PG8_WAIT_L(0); PG8_MMA(0, 0, At, B0); PG8_BAR; PG8_SCHED;
            PG8_LDB(B1, 0, 1); PG8_STAGE(PG8_SB(0, 0), b2, voffB);
            PG8_BAR; PG8_WAIT_L(0); PG8_MMA(0, 1, At, B1); PG8_BAR;
            PG8_LDA(At, 0, 1); PG8_STAGE(PG8_SA(0, 0), a2, voffA);
            PG8_BAR; PG8_WAIT_L(0); PG8_MMA(1, 0, At, B0); PG8_BAR; PG8_SCHED;
            PG8_STAGE(PG8_SB(0, 1), b2 + hstepB, voffB);
            PG8_WAIT_V(6); PG8_BAR; PG8_MMA(1, 1, At, B1); PG8_BAR;
            PG8_LDB(B0, 1, 0); PG8_SCHED; PG8_LDA(At, 1, 0); PG8_STAGE(PG8_SA(0, 1), a2 + hstepA, voffA);
            PG8_WAIT_L(8); PG8_BAR; PG8_WAIT_L(0); PG8_MMA(0, 0, At, B0); PG8_BAR; PG8_SCHED;
            PG8_LDB(B1, 1, 1); PG8_STAGE(PG8_SB(1, 0), b3, voffB);
            PG8_BAR; PG8_WAIT_L(0); PG8_MMA(0, 1, At, B1); PG8_BAR;
            PG8_LDA(At, 1, 1); PG8_STAGE(PG8_SA(1, 0), a3, voffA);
            PG8_BAR; PG8_WAIT_L(0); PG8_MMA(1, 0, At, B0); PG8_BAR; PG8_SCHED;
            PG8_STAGE(PG8_SB(1, 1), b3 + hstepB, voffB);
            PG8_WAIT_V(6); PG8_BAR; PG8_MMA(1, 1, At, B1); PG8_BAR;
        }
        epilogue<MODE>(g, acc, cur, wr, wc, fr, fq, lds + GEMM_LDS + 1024);
        if (!has_next) break;
#pragma unroll
        for (int a = 0; a < 2; ++a)
#pragma unroll
            for (int b = 0; b < 2; ++b)
#pragma unroll
                for (int m = 0; m < 4; ++m)
#pragma unroll
                    for (int n = 0; n < 2; ++n) acc[a][b][m][n] = (f32x4){0.f, 0.f, 0.f, 0.f};
        cur = nxt; cA = nA; cB = nB; ++ui;
    }
    PG8_WAIT_V(0);
    if (wr == 0) PG8_BAR;
    PG8_BAR;
#undef PG8_SA
#undef PG8_SB
#undef PG8_STAGE
#undef PG8_LDA
#undef PG8_LDB
#undef PG8_MMA
#undef PG8_WAIT_V
#undef PG8_WAIT_L
#undef PG8_BAR
#undef PG8_SCHED
#undef PG8_ABASE
#undef PG8_BBASE
}
}

__device__ __forceinline__ void p0_transpose_item(const float* W, int ldw, int K, int csrc0, bf16_t* WT, int row0, LAS float* scr, int kb, int lane, float wscale, const float* kgain) {
    const int k0 = 64 * kb;
#pragma unroll
    for (int i = 0; i < 8; ++i) { const int kk = 8 * i + (lane >> 3), n4 = (lane & 7) * 4;
        const float4 v = *(const float4*)(W + (size_t)(k0 + kk) * ldw + csrc0 + n4);
        const float ws = kgain ? kgain[k0 + kk] : wscale; (void)wscale;
        scr[kk * 33 + n4] = v.x * ws; scr[kk * 33 + n4 + 1] = v.y * ws; scr[kk * 33 + n4 + 2] = v.z * ws; scr[kk * 33 + n4 + 3] = v.w * ws; }
    asm volatile("s_waitcnt lgkmcnt(0)" ::: "memory");
    const int c = lane & 7;
#pragma unroll
    for (int j = 0; j < 4; ++j) { const int n = (lane >> 3) + 8 * j; const LAS float* s = scr + (8 * c) * 33 + n;
        uint4 o; o.x = pk2(s[0 * 33], s[1 * 33]); o.y = pk2(s[2 * 33], s[3 * 33]); o.z = pk2(s[4 * 33], s[5 * 33]); o.w = pk2(s[6 * 33], s[7 * 33]);
        *(uint4*)(WT + (size_t)(row0 + n) * K + k0 + 8 * c) = o; }
    asm volatile("s_waitcnt lgkmcnt(0)" ::: "memory");
}

__device__ __forceinline__ void d_conv_silu(int vb, int tid, const bf16_t* __restrict__ p6, const float* __restrict__ cw, const float* __restrict__ cb, bf16_t* __restrict__ c) {
    const int t = vb, s = t % S;
    for (int ch = tid; ch < 1024; ch += 256) {
        float y = cb[ch];
#pragma unroll
        for (int j = 0; j < 4; ++j) {
            const int ss = s - 3 + j;
            if (ss >= 0) y = fmaf(cw[j * 1024 + ch], bf2f(p6[(size_t)(t - 3 + j) * 1024 + ch]), y);
        }
        c[(size_t)t * 1024 + ch] = (bf16_t)f2bf(y / (1.0f + expf(-y)));
    }
}

__device__ __forceinline__ void d_mlstm(int vb, int tid, const bf16_t* __restrict__ mq, const bf16_t* __restrict__ mk, const bf16_t* __restrict__ p6,
                                        const float* __restrict__ gpre, const float* __restrict__ b_mi, const float* __restrict__ b_mf, float* __restrict__ hraw) {
    const int lane = tid & 63, w = tid >> 6;
    const int gid = vb * 4 + w;
    const int e = gid & 255, h = (gid >> 8) & 3, b = gid >> 10;
    const float bi = b_mi[h], bf = b_mf[h];
    float C0 = 0.f, C1 = 0.f, C2 = 0.f, C3 = 0.f, n0 = 0.f, n1 = 0.f, n2 = 0.f, n3 = 0.f, m = 0.f;
    const size_t tb = (size_t)b * S;
    const bf16_t* qp = mq + tb * 1024 + h * 256 + lane * 4;
    const bf16_t* kp = mk + tb * 1024 + h * 256 + lane * 4;
    const bf16_t* pp = p6 + P6S + tb * 1024 + h * 256 + e;
    ushort4 qn = *(const ushort4*)qp, kn = *(const ushort4*)kp;
    const float* gp = gpre + tb * 8;
    float vn = bf2f(pp[0]), in_ = gp[h], fn = gp[4 + h];
    for (int s = 0; s < S; ++s) {
        const float4 q = make_float4(bf2f(qn.x), bf2f(qn.y), bf2f(qn.z), bf2f(qn.w)), k = make_float4(bf2f(kn.x), bf2f(kn.y), bf2f(kn.z), bf2f(kn.w)); const float v = vn, ipre = in_ + bi, fpre = fn + bf;
        if (s + 1 < S) {
            qn = *(const ushort4*)(qp + (size_t)(s + 1) * 1024);
            kn = *(const ushort4*)(kp + (size_t)(s + 1) * 1024);
            vn = bf2f(pp[(size_t)(s + 1) * 1024]); in_ = gp[(size_t)(s + 1) * 8 + h]; fn = gp[(size_t)(s + 1) * 8 + 4 + h];
        }
        const float logf = log_sigmoid(fpre);
        const float mnew = fmaxf(logf + m, ipre);
        const float fd = expf(logf + m - mnew), ig = expf(ipre - mnew);
        m = mnew;
        const float sc = ig * 0.0625f;
        C0 = fd * C0 + sc * k.x * v; C1 = fd * C1 + sc * k.y * v; C2 = fd * C2 + sc * k.z * v; C3 = fd * C3 + sc * k.w * v;
        n0 = fd * n0 + sc * k.x; n1 = fd * n1 + sc * k.y; n2 = fd * n2 + sc * k.z; n3 = fd * n3 + sc * k.w;
        float num = q.x * C0 + q.y * C1 + q.z * C2 + q.w * C3;
        float den = q.x * n0 + q.y * n1 + q.z * n2 + q.w * n3;
        num = wave_sum(num); den = wave_sum(den);
        if (lane == 0) hraw[(tb + s) * 1024 + h * 256 + e] = num / fmaxf(fabsf(den), expf(-mnew));
    }
}

__device__ __forceinline__ void d_mhead_norm(int vb, int tid, const float* __restrict__ hraw, const bf16_t* __restrict__ p6, const float* __restrict__ g, bf16_t* __restrict__ mix) {
    const int t = vb, h = tid >> 6, lane = tid & 63;
    const float4 v = *(const float4*)(hraw + (size_t)t * 1024 + h * 256 + lane * 4);
    float s = v.x * v.x + v.y * v.y + v.z * v.z + v.w * v.w;
    s = wave_sum(s);
    const float r = rsqrtf(s * (1.0f / 256.0f) + EPS);
    const float4 gg = *(const float4*)(g + h * 256 + lane * 4);
    const ushort4 mo = *(const ushort4*)(p6 + 2 * P6S + (size_t)t * 1024 + h * 256 + lane * 4);
    float4 o;
    o.x = v.x * r * gg.x / (1.0f + expf(-bf2f(mo.x)));
    o.y = v.y * r * gg.y / (1.0f + expf(-bf2f(mo.y)));
    o.z = v.z * r * gg.z / (1.0f + expf(-bf2f(mo.z)));
    o.w = v.w * r * gg.w / (1.0f + expf(-bf2f(mo.w)));
    uint2 ob; ob.x = pk2(o.x, o.y); ob.y = pk2(o.z, o.w);
    *(uint2*)(mix + (size_t)t * D + h * 256 + lane * 4) = ob;
}

__device__ __forceinline__ void d_rope(int vb, int tid, bf16_t* __restrict__ p6) {
    const int t = vb, s = t % S;
    for (int idx = tid; idx < 2 * 8 * 64; idx += 256) {
        const int i = idx & 63, hd = (idx >> 6) & 7, qk = idx >> 9;
        const float inv = exp2f(-(float)i * 0.20762050593046014f);
        const float ang = (float)s * inv;
        float sn, cs; sincosf(ang, &sn, &cs);
        bf16_t* p = p6 + (size_t)(3 + qk) * P6S + (size_t)t * 1024 + hd * 128;
        const float x1 = bf2f(p[i]), x2 = bf2f(p[64 + i]);
        p[i] = (bf16_t)f2bf(x1 * cs - x2 * sn);
        p[64 + i] = (bf16_t)f2bf(x2 * cs + x1 * sn);
    }
}

__device__ __forceinline__ void d_dilated(int vb, int tid, float* sm, const bf16_t* __restrict__ p6, const float* __restrict__ g_ahead, bf16_t* __restrict__ mix) {
    float (*qs)[128] = (float (*)[128])sm;
    float (*ps)[576] = (float (*)[576])(sm + 512);
    const int lane = tid & 63, w = tid >> 6;
    const int gid = vb * 4 + w;
    const int s = gid % S, hd = (gid / S) & 7, b = gid / (S * 8);
    const size_t t = (size_t)b * S + s;
    const bf16_t* qrow = p6 + 3 * P6S + t * 1024 + hd * 128;
    __syncthreads();
    qs[w][lane] = bf2f(qrow[lane]); qs[w][lane + 64] = bf2f(qrow[lane + 64]);
    __syncthreads();
    const float scale = 0.08838834764831845f;
    float mloc = -INFINITY;
    for (int br = 0; br < 3; ++br) {
        const int dil = br == 0 ? 1 : (br == 1 ? 4 : 16);
        for (int jj = 0; jj < 192; jj += 64) {
            const int j = jj + lane;
            float sc = -INFINITY;
            if (j <= 128 && s - j * dil >= 0) {
                const bf16_t* krow = p6 + 4 * P6S + (t - (size_t)j * dil) * 1024 + hd * 128;
                float d = 0.f;
#pragma unroll 8
                for (int c = 0; c < 128; c += 4) {
                    const ushort4 kv = *(const ushort4*)(krow + c);
                    d = fmaf(qs[w][c], bf2f(kv.x), d); d = fmaf(qs[w][c + 1], bf2f(kv.y), d); d = fmaf(qs[w][c + 2], bf2f(kv.z), d); d = fmaf(qs[w][c + 3], bf2f(kv.w), d);
                }
                sc = d * scale;
            }
            ps[w][br * 192 + j] = sc;
            mloc = fmaxf(mloc, sc);
        }
    }
    const float mx = wave_max(mloc);
    __syncthreads();
    float lsum = 0.f;
    for (int i = lane; i < 3 * 192; i += 64) {
        const float sc = ps[w][i];
        const float pv = (sc == -INFINITY) ? 0.f : expf(sc - mx);
        ps[w][i] = pv; lsum += pv;
    }
    const float tot = wave_sum(lsum);
    __syncthreads();
    float o0 = 0.f, o1 = 0.f;
    for (int br = 0; br < 3; ++br) {
        const int dil = br == 0 ? 1 : (br == 1 ? 4 : 16);
        for (int j = 0; j <= 128; ++j) {
            if (s - j * dil < 0) break;
            const float pv = ps[w][br * 192 + j];
            const bf16_t* vrow = p6 + 5 * P6S + (t - (size_t)j * dil) * 1024 + hd * 128;
            o0 = fmaf(pv, bf2f(vrow[lane]), o0); o1 = fmaf(pv, bf2f(vrow[lane + 64]), o1);
        }
    }
    o0 /= tot; o1 /= tot;
    float ss = wave_sum(o0 * o0 + o1 * o1);
    const float r = rsqrtf(ss * (1.0f / 128.0f) + EPS);
    bf16_t* orow = mix + t * D + 1024 + hd * 128;
    orow[lane] = (bf16_t)f2bf(o0 * r * g_ahead[hd * 128 + lane]);
    orow[lane + 64] = (bf16_t)f2bf(o1 * r * g_ahead[hd * 128 + lane + 64]);
}

__device__ __forceinline__ void d_cross(int vb, int tid, float* sm, const bf16_t* __restrict__ q, const float* __restrict__ km, const float* __restrict__ vm, bf16_t* __restrict__ o) {
    float (*qs)[512] = (float (*)[512])sm;
    float (*ps)[256] = (float (*)[256])(sm + 2048);
    const int lane = tid & 63, w = tid >> 6;
    const int t = vb, hd = w, b = t / S;
    const bf16_t* qrow = q + (size_t)t * D + hd * 512;
    __syncthreads();
    for (int i = lane; i < 512; i += 64) qs[w][i] = bf2f(qrow[i]);
    __syncthreads();
    const float scale = 0.04419417382415922f;
    float sc[4]; float mloc = -INFINITY;
#pragma unroll
    for (int r = 0; r < 4; ++r) {
        const int mi = lane + 64 * r;
        const float* krow = km + ((size_t)b * 256 + mi) * D + hd * 512;
        float d = 0.f;
#pragma unroll 8
        for (int c = 0; c < 512; c += 4) {
            const float4 kv = *(const float4*)(krow + c);
            d = fmaf(qs[w][c], kv.x, d); d = fmaf(qs[w][c + 1], kv.y, d); d = fmaf(qs[w][c + 2], kv.z, d); d = fmaf(qs[w][c + 3], kv.w, d);
        }
        sc[r] = d * scale; mloc = fmaxf(mloc, sc[r]);
    }
    const float mx = wave_max(mloc);
    float lsum = 0.f;
#pragma unroll
    for (int r = 0; r < 4; ++r) { const float pv = expf(sc[r] - mx); ps[w][lane + 64 * r] = pv; lsum += pv; }
    const float tot = wave_sum(lsum);
    __syncthreads();
    float acc[8];
#pragma unroll
    for (int i = 0; i < 8; ++i) acc[i] = 0.f;
    for (int mi = 0; mi < 256; ++mi) {
        const float pv = ps[w][mi];
        const float* vrow = vm + ((size_t)b * 256 + mi) * D + hd * 512;
#pragma unroll
        for (int i = 0; i < 8; ++i) acc[i] = fmaf(pv, vrow[lane + 64 * i], acc[i]);
    }
    bf16_t* orow = o + (size_t)t * D + hd * 512;
#pragma unroll
    for (int i = 0; i < 8; ++i) orow[lane + 64 * i] = (bf16_t)f2bf(acc[i] / tot);
}

__device__ __forceinline__ void wave_argmax(float& best, int& bidx) {
#pragma unroll
    for (int o = 32; o >= 1; o >>= 1) {
        const float ob = __shfl_xor(best, o); const int oi = __shfl_xor(bidx, o);
        if (ob > best || (ob == best && oi < bidx)) { best = ob; bidx = oi; }
    }
}
__device__ __forceinline__ void d_peer_topk(int vb, int tid, float* sm, const bf16_t* __restrict__ qp, const float* __restrict__ sub_keys, int* __restrict__ ids, float* __restrict__ gates) {
    float (*qs)[256] = (float (*)[256])sm;
    const int lane = tid & 63, w = tid >> 6;
    const int gid = vb * 4 + w;
    const int hd = gid & 7, t = gid >> 3;
    const bf16_t* qrow = qp + (size_t)t * D + hd * 256;
    __syncthreads();
    for (int i = lane; i < 256; i += 64) qs[w][i] = bf2f(qrow[i]);
    __syncthreads();
    float tops[2]; int topi[2];
#pragma unroll
    for (int p = 0; p < 2; ++p) {
        float v0, v1;
        {
            const float* k0 = sub_keys + ((size_t)(hd * 2 + p) * 128 + lane) * 128;
            const float* k1 = k0 + 64 * 128;
            float d0 = 0.f, d1 = 0.f;
#pragma unroll 8
            for (int c = 0; c < 128; c += 4) {
                const float4 a = *(const float4*)(k0 + c), bb = *(const float4*)(k1 + c);
                const float q0 = qs[w][p * 128 + c], q1 = qs[w][p * 128 + c + 1], q2 = qs[w][p * 128 + c + 2], q3 = qs[w][p * 128 + c + 3];
                d0 = fmaf(q0, a.x, d0); d0 = fmaf(q1, a.y, d0); d0 = fmaf(q2, a.z, d0); d0 = fmaf(q3, a.w, d0);
                d1 = fmaf(q0, bb.x, d1); d1 = fmaf(q1, bb.y, d1); d1 = fmaf(q2, bb.z, d1); d1 = fmaf(q3, bb.w, d1);
            }
            v0 = d0; v1 = d1;
        }
        float ts = 0.f; int ti = 0;
        for (int it = 0; it < 16; ++it) {
            float best; int bidx;
            if (v0 >= v1) { best = v0; bidx = lane; } else { best = v1; bidx = lane + 64; }
            wave_argmax(best, bidx);
            if (lane == it) { ts = best; ti = bidx; }
            if (bidx == lane) v0 = -INFINITY;
            if (bidx == lane + 64) v1 = -INFINITY;
        }
        tops[p] = ts; topi[p] = ti;
    }
    float cv[4]; int ci[4];
#pragma unroll
    for (int r = 0; r < 4; ++r) {
        const int c = lane * 4 + r, i = c >> 4, j = c & 15;
        const float s0 = __shfl(tops[0], i), s1 = __shfl(tops[1], j);
        const int i0 = __shfl(topi[0], i), i1 = __shfl(topi[1], j);
        cv[r] = s0 + s1; ci[r] = i0 * 128 + i1;
    }
    float bs = 0.f; int bid = 0;
    for (int it = 0; it < 16; ++it) {
        float best = cv[0]; int bidx = lane * 4;
#pragma unroll
        for (int r = 1; r < 4; ++r) if (cv[r] > best) { best = cv[r]; bidx = lane * 4 + r; }
        wave_argmax(best, bidx);
        const int owner = bidx >> 2, rr = bidx & 3;
        int myid = ci[0];
        if (rr == 1) myid = ci[1]; else if (rr == 2) myid = ci[2]; else if (rr == 3) myid = ci[3];
        const int eid = __shfl(myid, owner);
        if (lane == it) { bs = best; bid = eid; }
        if (owner == lane) {
#pragma unroll
            for (int r = 0; r < 4; ++r) if (rr == r) cv[r] = -INFINITY;
        }
    }
    float v = lane < 16 ? bs : -INFINITY;
    const float mx = wave_max(v);
    const float ev = lane < 16 ? expf(bs - mx) : 0.f;
    const float tot = wave_sum(ev);
    if (lane < 16) {
        ids[(size_t)t * 128 + hd * 16 + lane] = bid;
        gates[(size_t)t * 128 + hd * 16 + lane] = ev / tot;
    }
}

__device__ __forceinline__ void d_peer_out(int vb, int tid, float* sm, const bf16_t* __restrict__ h3, const float* __restrict__ x2, const int* __restrict__ ids, const float* __restrict__ gates,
                                           const bf16_t* __restrict__ u_tab, const bf16_t* __restrict__ v_tab, const float* __restrict__ g_final, float* __restrict__ out) {
    float (*part)[2048] = (float (*)[2048])sm;
    float* red = sm + 4 * 2048;
    const int lane = tid & 63, w = tid >> 6, t = vb;
    float4 xr[8], acc[8];
    const bf16_t* hrow = h3 + (size_t)t * D;
#pragma unroll
    for (int i = 0; i < 8; ++i) { const ushort4 hv = *(const ushort4*)(hrow + i * 256 + lane * 4);
        xr[i] = make_float4(bf2f(hv.x), bf2f(hv.y), bf2f(hv.z), bf2f(hv.w)); acc[i] = make_float4(0.f, 0.f, 0.f, 0.f); }
    for (int j = 0; j < 32; ++j) {
        const int slot = w * 32 + j;
        const int e = ids[(size_t)t * 128 + slot];
        const float gt = gates[(size_t)t * 128 + slot];
        const bf16_t* ur = u_tab + (size_t)e * D;
        const bf16_t* vr = v_tab + (size_t)e * D;
        float d = 0.f;
#pragma unroll
        for (int i = 0; i < 8; ++i) {
            const ushort4 u = *(const ushort4*)(ur + i * 256 + lane * 4);
            d = fmaf(xr[i].x, bf2f(u.x), d); d = fmaf(xr[i].y, bf2f(u.y), d); d = fmaf(xr[i].z, bf2f(u.z), d); d = fmaf(xr[i].w, bf2f(u.w), d);
        }
        d = wave_sum(d);
        const float act = 0.5f * d * (1.0f + erff(d * 0.7071067811865476f));
        const float cf = gt * act;
#pragma unroll
        for (int i = 0; i < 8; ++i) {
            const ushort4 v = *(const ushort4*)(vr + i * 256 + lane * 4);
            acc[i].x = fmaf(cf, bf2f(v.x), acc[i].x); acc[i].y = fmaf(cf, bf2f(v.y), acc[i].y); acc[i].z = fmaf(cf, bf2f(v.z), acc[i].z); acc[i].w = fmaf(cf, bf2f(v.w), acc[i].w);
        }
    }
    __syncthreads();
#pragma unroll
    for (int i = 0; i < 8; ++i) *(float4*)&part[w][i * 256 + lane * 4] = acc[i];
    __syncthreads();
    float4 r0, r1;
    {
        const float4 a = *(const float4*)&part[0][tid * 4], b = *(const float4*)&part[1][tid * 4], c = *(const float4*)&part[2][tid * 4], d = *(const float4*)&part[3][tid * 4];
        const float4 x = *(const float4*)(x2 + (size_t)t * D + tid * 4);
        r0 = make_float4(x.x + a.x + b.x + c.x + d.x, x.y + a.y + b.y + c.y + d.y, x.z + a.z + b.z + c.z + d.z, x.w + a.w + b.w + c.w + d.w);
    }
    {
        const float4 a = *(const float4*)&part[0][1024 + tid * 4], b = *(const float4*)&part[1][1024 + tid * 4], c = *(const float4*)&part[2][1024 + tid * 4], d = *(const float4*)&part[3][1024 + tid * 4];
        const float4 x = *(const float4*)(x2 + (size_t)t * D + 1024 + tid * 4);
        r1 = make_float4(x.x + a.x + b.x + c.x + d.x, x.y + a.y + b.y + c.y + d.y, x.z + a.z + b.z + c.z + d.z, x.w + a.w + b.w + c.w + d.w);
    }
    float s = r0.x * r0.x + r0.y * r0.y + r0.z * r0.z + r0.w * r0.w + r1.x * r1.x + r1.y * r1.y + r1.z * r1.z + r1.w * r1.w;
    s = wave_sum(s);
    if (lane == 0) red[w] = s;
    __syncthreads();
    const float tot = red[0] + red[1] + red[2] + red[3];
    const float r = rsqrtf(tot * (1.0f / D) + EPS);
    const float4 g0 = *(const float4*)(g_final + tid * 4), g1 = *(const float4*)(g_final + 1024 + tid * 4);
    *(float4*)(out + (size_t)t * D + tid * 4) = make_float4(r0.x * r * g0.x, r0.y * r * g0.y, r0.z * r * g0.z, r0.w * r * g0.w);
    *(float4*)(out + (size_t)t * D + 1024 + tid * 4) = make_float4(r1.x * r * g1.x, r1.y * r * g1.y, r1.z * r * g1.z, r1.w * r * g1.w);
}


__device__ __forceinline__ float wave_sum_dpp(float v);
__device__ __forceinline__ void rmsnorm_row_wave(int row, int lane, const float* __restrict__ in, const float* __restrict__ g, bf16_t* __restrict__ out, const float* gwT, float* __restrict__ gpre) {
    float4 x[8];
    const float* p = in + (size_t)row * D + lane * 4;
#pragma unroll
    for (int i = 0; i < 8; ++i) x[i] = *(const float4*)(p + i * 256);
    float s = 0.f;
#pragma unroll
    for (int i = 0; i < 8; ++i) s += (x[i].x * x[i].x + x[i].y * x[i].y) + (x[i].z * x[i].z + x[i].w * x[i].w);
    s = wave_sum_dpp(s);
    const float r = rsqrtf(s * (1.0f / D) + EPS);
    bf16_t* o = out + (size_t)row * D + lane * 4;
#pragma unroll
    for (int i = 0; i < 8; ++i) {
        const float4 gv = *(const float4*)(g + i * 256 + lane * 4);
        x[i].x *= r * gv.x; x[i].y *= r * gv.y; x[i].z *= r * gv.z; x[i].w *= r * gv.w;
        uint2 w; w.x = pk2(x[i].x, x[i].y); w.y = pk2(x[i].z, x[i].w);
        *(uint2*)(o + i * 256) = w;
    }
    if (gpre) {
#pragma unroll 1
        for (int c = 0; c < 8; c += 2) {
            float a0 = 0.f, a1 = 0.f;
#pragma unroll
            for (int i = 0; i < 8; ++i) {
                const float4 w0 = *(const float4*)(gwT + c * 2048 + i * 256 + lane * 4), w1 = *(const float4*)(gwT + (c + 1) * 2048 + i * 256 + lane * 4);
                a0 = fmaf(x[i].x, w0.x, a0); a0 = fmaf(x[i].y, w0.y, a0); a0 = fmaf(x[i].z, w0.z, a0); a0 = fmaf(x[i].w, w0.w, a0);
                a1 = fmaf(x[i].x, w1.x, a1); a1 = fmaf(x[i].y, w1.y, a1); a1 = fmaf(x[i].z, w1.z, a1); a1 = fmaf(x[i].w, w1.w, a1);
            }
            const float t0_ = wave_sum_dpp(a0), t1_ = wave_sum_dpp(a1);
            if (lane == 0) { gpre[(size_t)row * 8 + c] = t0_; gpre[(size_t)row * 8 + c + 1] = t1_; }
        }
    }
}

__device__ __forceinline__ void conv_silu_run(int tokbase, int cg8, const bf16_t* __restrict__ min_, const float* __restrict__ cw, const float* __restrict__ cb, bf16_t* __restrict__ c) {
    float w[4][8], bias[8];
#pragma unroll
    for (int j = 0; j < 4; ++j) { const float4 a = *(const float4*)(cw + j * 1024 + cg8 * 8), b = *(const float4*)(cw + j * 1024 + cg8 * 8 + 4);
        w[j][0] = a.x; w[j][1] = a.y; w[j][2] = a.z; w[j][3] = a.w; w[j][4] = b.x; w[j][5] = b.y; w[j][6] = b.z; w[j][7] = b.w; }
    { const float4 a = *(const float4*)(cb + cg8 * 8), b = *(const float4*)(cb + cg8 * 8 + 4); bias[0] = a.x; bias[1] = a.y; bias[2] = a.z; bias[3] = a.w; bias[4] = b.x; bias[5] = b.y; bias[6] = b.z; bias[7] = b.w; }
    const int s0 = tokbase & (S - 1);
    uint4 rows[11];
#pragma unroll
    for (int i = 0; i < 11; ++i) { const int ss = s0 - 3 + i; rows[i] = ss >= 0 ? *(const uint4*)(min_ + (size_t)(tokbase - 3 + i) * 1024 + cg8 * 8) : make_uint4(0u, 0u, 0u, 0u); }
#pragma unroll
    for (int t = 0; t < 8; ++t) {
        float y[8];
#pragma unroll
        for (int k = 0; k < 8; ++k) y[k] = bias[k];
#pragma unroll
        for (int j = 0; j < 4; ++j) {
            const uint4 r = rows[t + j]; const unsigned rw[4] = {r.x, r.y, r.z, r.w};
#pragma unroll
            for (int k = 0; k < 4; ++k) { y[2 * k] = fmaf(w[j][2 * k], __uint_as_float(rw[k] << 16), y[2 * k]); y[2 * k + 1] = fmaf(w[j][2 * k + 1], __uint_as_float(rw[k] & 0xFFFF0000u), y[2 * k + 1]); }
        }
        uint4 o;
#pragma unroll
        for (int k = 0; k < 8; ++k) y[k] = y[k] / (1.0f + __expf(-y[k]));
        o.x = pk2(y[0], y[1]); o.y = pk2(y[2], y[3]); o.z = pk2(y[4], y[5]); o.w = pk2(y[6], y[7]);
        *(uint4*)(c + (size_t)(tokbase + t) * 1024 + cg8 * 8) = o;
    }
}

__device__ __forceinline__ float wave_incl_scan_add(float v, int lane) {
#pragma unroll
    for (int o = 1; o < 64; o <<= 1) { const float t = __shfl_up(v, o); if (lane >= o) v += t; }
    return v;
}
__device__ __forceinline__ float wave_incl_scan_max(float v, int lane) {
#pragma unroll
    for (int o = 1; o < 64; o <<= 1) { const float t = __shfl_up(v, o); if (lane >= o) v = fmaxf(v, t); }
    return v;
}
__device__ __forceinline__ void mlstm_gates_wave(int b, int h, int lane, const float* __restrict__ gpre, const float* __restrict__ b_mi, const float* __restrict__ b_mf,
                                                 float* __restrict__ gs, float* __restrict__ decay) {
    const float bi = b_mi[h], bf = b_mf[h];
    float mprev = 0.f;
    float gi_n[4], gf_n[4];
#pragma unroll
    for (int j = 0; j < 4; ++j) { const size_t t = (size_t)b * S + lane * 4 + j; gi_n[j] = gpre[t * 8 + h]; gf_n[j] = gpre[t * 8 + 4 + h]; }
#pragma unroll 1
    for (int c = 0; c < 16; ++c) {
        const size_t t0 = (size_t)b * S + c * 256 + lane * 4;
        float logi[4], lf[4], bb[4], gf_c[4];
#pragma unroll
        for (int j = 0; j < 4; ++j) { logi[j] = gi_n[j] + bi; gf_c[j] = gf_n[j]; }
        if (c < 15) {
#pragma unroll
            for (int j = 0; j < 4; ++j) { gi_n[j] = gpre[(t0 + 256 + j) * 8 + h]; gf_n[j] = gpre[(t0 + 256 + j) * 8 + 4 + h]; }
        }
#pragma unroll
        for (int j = 0; j < 4; ++j) lf[j] = log_sigmoid(gf_c[j] + bf);
        bb[0] = lf[0]; bb[1] = bb[0] + lf[1]; bb[2] = bb[1] + lf[2]; bb[3] = bb[2] + lf[3];
        const float incl = wave_incl_scan_add(bb[3], lane);
        const float excl = incl - bb[3];
#pragma unroll
        for (int j = 0; j < 4; ++j) bb[j] += excl;
        const float g = __shfl(incl, 63);
        float amax = -INFINITY, uu[4], cm[4];
#pragma unroll
        for (int j = 0; j < 4; ++j) { amax = fmaxf(amax, logi[j] + g - bb[j]); uu[j] = logi[j] - bb[j]; }
        amax = wave_max(amax);
        const float mnew = fmaxf(g + mprev, amax);
        cm[0] = uu[0]; cm[1] = fmaxf(cm[0], uu[1]); cm[2] = fmaxf(cm[1], uu[2]); cm[3] = fmaxf(cm[2], uu[3]);
        const float cincl = wave_incl_scan_max(cm[3], lane);
        float cexcl = __shfl_up(cincl, 1); if (lane == 0) cexcl = -INFINITY;
#pragma unroll
        for (int j = 0; j < 4; ++j) {
            const float M = fmaxf(mprev, fmaxf(cexcl, cm[j]));
            float* o = gs + ((t0 + j) * 4 + h) * 8;
            o[0] = uu[j] * 1.4426950408889634f; o[1] = M * 1.4426950408889634f; o[2] = expf(logi[j] + g - bb[j] - mnew); o[3] = expf(mprev - M); o[4] = expf(-(bb[j] + M));
        }
        if (lane == 0) decay[(b * 16 + c) * 4 + h] = expf(g + mprev - mnew);
        mprev = mnew;
    }
}
__device__ __forceinline__ void transpose_tile64(int tid, float* sm, const bf16_t* __restrict__ src, int src_ld, bf16_t* __restrict__ dst, int dst_ld, const float* __restrict__ scale, int sstride) {
    typedef unsigned u32x4_t __attribute__((ext_vector_type(4)));
    typedef short s16x4_t __attribute__((ext_vector_type(4)));
    LAS unsigned short* tl = (LAS unsigned short*)(LAS unsigned char*)sm;
    __syncthreads();
#pragma unroll
    for (int i = 0; i < 2; ++i) {
        const int ch = tid + i * 256, r = ch >> 3, c8 = (ch & 7) * 8;
        uint4 v = *(const uint4*)(src + (size_t)r * src_ld + c8);
        if (scale) {
            const float sc = scale[(size_t)r * sstride];
            unsigned w[4] = {v.x, v.y, v.z, v.w};
#pragma unroll
            for (int k = 0; k < 4; ++k) w[k] = pk2(__uint_as_float(w[k] << 16) * sc, __uint_as_float(w[k] & 0xFFFF0000u) * sc);
            v = make_uint4(w[0], w[1], w[2], w[3]);
        }
        *(LAS u32x4_t*)(tl + r * 72 + c8) = (u32x4_t){v.x, v.y, v.z, v.w};
    }
    __syncthreads();
    {
        const int G = tid >> 4, i = tid & 15, cb = G >> 2, rb = G & 3, q = i >> 2, p = i & 3;
        const int c0 = 16 * cb, r0 = 16 * rb;
        unsigned o[8];
#pragma unroll
        for (int m = 0; m < 4; ++m) {
            const s16x4_t t4 = __builtin_amdgcn_ds_read_tr16_b64_v4i16((LAS s16x4_t*)(tl + (r0 + 4 * m + q) * 72 + c0 + 4 * p));
            o[2 * m] = (unsigned)(unsigned short)t4[0] | ((unsigned)(unsigned short)t4[1] << 16);
            o[2 * m + 1] = (unsigned)(unsigned short)t4[2] | ((unsigned)(unsigned short)t4[3] << 16);
        }
        bf16_t* d = dst + (size_t)(c0 + i) * dst_ld + r0;
        *(uint4*)d = make_uint4(o[0], o[1], o[2], o[3]); *(uint4*)(d + 8) = make_uint4(o[4], o[5], o[6], o[7]);
    }
}

__device__ __forceinline__ void rope_table_fill(float2* __restrict__ cs, int gtid, int nth) {
    for (int idx = gtid; idx < 4096 * 64; idx += nth) {
        const int i = idx & 63, s = idx >> 6;
        const float inv = exp2f(-(float)i * 0.20762050593046014f);
        const float ang = (float)s * inv;
        float sn, c; sincosf(ang, &sn, &c);
        cs[idx] = make_float2(c, sn);
    }
}
__device__ __forceinline__ void rope_q_pass(bf16_t* __restrict__ aq, const float2* __restrict__ cs, size_t gtid, size_t nth) {
    for (size_t idx = gtid; idx < (size_t)T * 8 * 8; idx += nth) {
        const int c8 = (int)(idx & 7), hd = (int)((idx >> 3) & 7); const size_t t = idx >> 6; const int s = (int)(t & (S - 1));
        bf16_t* p = aq + t * 1024 + hd * 128 + c8 * 8;
        const uint4 a = *(const uint4*)p, b = *(const uint4*)(p + 64);
        const unsigned aw[4] = {a.x, a.y, a.z, a.w}, bw[4] = {b.x, b.y, b.z, b.w};
        unsigned ao[4], bo[4];
#pragma unroll
        for (int k = 0; k < 4; ++k) {
            const float4 cc = *(const float4*)(cs + (size_t)s * 64 + c8 * 8 + 2 * k);
            const float x10 = __uint_as_float(aw[k] << 16), x11 = __uint_as_float(aw[k] & 0xFFFF0000u), x20 = __uint_as_float(bw[k] << 16), x21 = __uint_as_float(bw[k] & 0xFFFF0000u);
            ao[k] = pk2(x10 * cc.x - x20 * cc.y, x11 * cc.z - x21 * cc.w);
            bo[k] = pk2(x20 * cc.x + x10 * cc.y, x21 * cc.z + x11 * cc.w);
        }
        *(uint4*)p = make_uint4(ao[0], ao[1], ao[2], ao[3]); *(uint4*)(p + 64) = make_uint4(bo[0], bo[1], bo[2], bo[3]);
    }
}
__device__ __forceinline__ void dil_tile_prep(int item, int lane, LAS unsigned short* wl, const bf16_t* __restrict__ ak, const bf16_t* __restrict__ av, const float2* __restrict__ cs,
                                              bf16_t* __restrict__ KB, bf16_t* __restrict__ VB) {
    const int TT = item & 255, hd = (item >> 8) & 7, b = (item >> 11) & 1, br = item >> 12;
    const int ld = 2 * br, tpr = 256 >> ld, rho = TT / tpr, tile = TT - rho * tpr;
    const int i = lane & 15, c = lane >> 4;
    const int s = rho + ((16 * tile + i) << ld);
    const size_t trow = (size_t)b * S + s;
    bf16_t* kdst = KB + (size_t)item * 2048;
    bf16_t* vdst = VB + (size_t)item * 2048;
    {
        const bf16_t* kr = ak + trow * 1024 + hd * 128 + 16 * c;
        const uint4 a0 = *(const uint4*)kr, a1 = *(const uint4*)(kr + 8), b0 = *(const uint4*)(kr + 64), b1 = *(const uint4*)(kr + 72);
        const unsigned aw[8] = {a0.x, a0.y, a0.z, a0.w, a1.x, a1.y, a1.z, a1.w}, bw[8] = {b0.x, b0.y, b0.z, b0.w, b1.x, b1.y, b1.z, b1.w};
        unsigned ao[8], bo[8];
#pragma unroll
        for (int k = 0; k < 8; ++k) {
            const float4 cc = *(const float4*)(cs + (size_t)s * 64 + 16 * c + 2 * k);
            const float x10 = __uint_as_float(aw[k] << 16), x11 = __uint_as_float(aw[k] & 0xFFFF0000u), x20 = __uint_as_float(bw[k] << 16), x21 = __uint_as_float(bw[k] & 0xFFFF0000u);
            ao[k] = pk2(x10 * cc.x - x20 * cc.y, x11 * cc.z - x21 * cc.w);
            bo[k] = pk2(x20 * cc.x + x10 * cc.y, x21 * cc.z + x11 * cc.w);
        }
        bf16_t* d0 = kdst + (c >> 1) * 512 + i * 32 + (c & 1) * 16;
        *(uint4*)d0 = make_uint4(ao[0], ao[1], ao[2], ao[3]); *(uint4*)(d0 + 8) = make_uint4(ao[4], ao[5], ao[6], ao[7]);
        bf16_t* d1 = d0 + 1024;
        *(uint4*)d1 = make_uint4(bo[0], bo[1], bo[2], bo[3]); *(uint4*)(d1 + 8) = make_uint4(bo[4], bo[5], bo[6], bo[7]);
    }
    {
        const bf16_t* vr = av + trow * 1024 + hd * 128 + 32 * c;
        const uint4 v0 = *(const uint4*)vr, v1 = *(const uint4*)(vr + 8), v2 = *(const uint4*)(vr + 16), v3 = *(const uint4*)(vr + 24);
        LAS unsigned short* wr = wl + i * 136 + 32 * c;
        typedef unsigned u32x4_t __attribute__((ext_vector_type(4)));
        *(LAS u32x4_t*)wr = (u32x4_t){v0.x, v0.y, v0.z, v0.w}; *(LAS u32x4_t*)(wr + 8) = (u32x4_t){v1.x, v1.y, v1.z, v1.w};
        *(LAS u32x4_t*)(wr + 16) = (u32x4_t){v2.x, v2.y, v2.z, v2.w}; *(LAS u32x4_t*)(wr + 24) = (u32x4_t){v3.x, v3.y, v3.z, v3.w};
        asm volatile("s_waitcnt lgkmcnt(0)" ::: "memory");
        unsigned o[16];
#pragma unroll
        for (int k = 0; k < 8; ++k) {
            const unsigned p0 = *(const LAS unsigned*)(wl + (2 * k) * 136 + 2 * lane), p1 = *(const LAS unsigned*)(wl + (2 * k + 1) * 136 + 2 * lane);
            o[k] = (p0 & 0xFFFFu) | (p1 << 16);
            o[8 + k] = (p0 >> 16) | (p1 & 0xFFFF0000u);
        }
        bf16_t* d = vdst + (2 * lane) * 16;
        *(uint4*)d = make_uint4(o[0], o[1], o[2], o[3]); *(uint4*)(d + 8) = make_uint4(o[4], o[5], o[6], o[7]);
        *(uint4*)(d + 16) = make_uint4(o[8], o[9], o[10], o[11]); *(uint4*)(d + 24) = make_uint4(o[12], o[13], o[14], o[15]);
        asm volatile("s_waitcnt lgkmcnt(0)" ::: "memory");
    }
}

typedef short bf16x8_t __attribute__((ext_vector_type(8)));
typedef short bf16x4_t __attribute__((ext_vector_type(4)));
typedef float f32x4_t __attribute__((ext_vector_type(4)));
__device__ __forceinline__ float xg_max_f32(float v);
__device__ __forceinline__ float xg_sum_f32(float v);
__device__ __forceinline__ void dilated_wave_tile(int qt2, int lane, const bf16_t* __restrict__ AQ, const float2* __restrict__ cs, const bf16_t* __restrict__ KB, const bf16_t* __restrict__ VB,
                                                  const float* __restrict__ g_ahead, bf16_t* __restrict__ mix) {
    const int r = qt2 & 7, blk = (qt2 >> 3) & 15, hd = (qt2 >> 7) & 7, b = qt2 >> 10;
    const int j = lane & 15, g = lane >> 4;
    const int t0 = blk * 256;
    bf16x8_t qf[2][4];
#pragma unroll
    for (int qi = 0; qi < 2; ++qi) {
        const int sq = t0 + r + 8 * qi + 16 * j;
        const bf16_t* qrow = AQ + ((size_t)b * S + sq) * 1024 + hd * 128 + 8 * g;
        const float sc = 0.08838834764831845f * 1.4426950408889634f;
#pragma unroll
        for (int ks = 0; ks < 2; ++ks) {
            const bf16x8_t lo = *(const bf16x8_t*)(qrow + 32 * ks), hi = *(const bf16x8_t*)(qrow + 32 * ks + 64);
            bf16x8_t olo, ohi;
#pragma unroll
            for (int e2 = 0; e2 < 4; ++e2) {
                const float4 cc = *(const float4*)(cs + (size_t)sq * 64 + 32 * ks + 8 * g + 2 * e2);
                const float x10 = bf2f((unsigned short)lo[2 * e2]), x11 = bf2f((unsigned short)lo[2 * e2 + 1]), x20 = bf2f((unsigned short)hi[2 * e2]), x21 = bf2f((unsigned short)hi[2 * e2 + 1]);
                const unsigned wl_ = pk2((x10 * cc.x - x20 * cc.y) * sc, (x11 * cc.z - x21 * cc.w) * sc), wh_ = pk2((x20 * cc.x + x10 * cc.y) * sc, (x21 * cc.z + x11 * cc.w) * sc);
                olo[2 * e2] = (short)(wl_ & 0xFFFF); olo[2 * e2 + 1] = (short)(wl_ >> 16); ohi[2 * e2] = (short)(wh_ & 0xFFFF); ohi[2 * e2 + 1] = (short)(wh_ >> 16);
            }
            qf[qi][ks] = olo; qf[qi][ks + 2] = ohi;
        }
    }
    float m_run[2] = {-1e30f, -1e30f}, l_run[2] = {0.f, 0.f};
    f32x4_t o[2][8];
#pragma unroll
    for (int qi = 0; qi < 2; ++qi)
#pragma unroll
        for (int dt = 0; dt < 8; ++dt) o[qi][dt] = (f32x4_t){0.f, 0.f, 0.f, 0.f};
#define DIL_STEP(QI, QJ, TP, KF, VF) { \
        f32x4_t su[2]; \
        _Pragma("unroll") for (int u = 0; u < 2; ++u) { f32x4_t a = (f32x4_t){0.f, 0.f, 0.f, 0.f}; \
            _Pragma("unroll") for (int ks = 0; ks < 4; ++ks) a = __builtin_amdgcn_mfma_f32_16x16x32_bf16(KF[u][ks], qf[QI][ks], a, 0, 0, 0); su[u] = a; } \
        float p[2][4]; float mx = -1e30f; \
        _Pragma("unroll") for (int u = 0; u < 2; ++u) _Pragma("unroll") for (int e = 0; e < 4; ++e) { \
            const int n = (QJ) - (16 * ((TP) + u) + 4 * g + e); const bool valid = (n >= 0) && (n <= 128); \
            p[u][e] = valid ? su[u][e] : -1e30f; mx = fmaxf(mx, p[u][e]); } \
        mx = xg_max_f32(mx); \
        const float m_new = fmaxf(m_run[QI], mx); const float alpha = __builtin_amdgcn_exp2f(m_run[QI] - m_new); m_run[QI] = m_new; \
        float ps = 0.f; \
        _Pragma("unroll") for (int u = 0; u < 2; ++u) _Pragma("unroll") for (int e = 0; e < 4; ++e) { p[u][e] = (p[u][e] > -1e29f) ? __builtin_amdgcn_exp2f(p[u][e] - m_new) : 0.f; ps += p[u][e]; } \
        l_run[QI] = l_run[QI] * alpha + ps; \
        bf16x8_t pb; { const unsigned w0 = pk2(p[0][0], p[0][1]), w1 = pk2(p[0][2], p[0][3]), w2 = pk2(p[1][0], p[1][1]), w3 = pk2(p[1][2], p[1][3]); \
            pb[0] = (short)(w0 & 0xFFFF); pb[1] = (short)(w0 >> 16); pb[2] = (short)(w1 & 0xFFFF); pb[3] = (short)(w1 >> 16); \
            pb[4] = (short)(w2 & 0xFFFF); pb[5] = (short)(w2 >> 16); pb[6] = (short)(w3 & 0xFFFF); pb[7] = (short)(w3 >> 16); } \
        _Pragma("unroll") for (int dt = 0; dt < 8; ++dt) { const bf16x4_t v0 = VF[dt][0], v1 = VF[dt][1]; \
            bf16x8_t va; va[0] = v0[0]; va[1] = v0[1]; va[2] = v0[2]; va[3] = v0[3]; va[4] = v1[0]; va[5] = v1[1]; va[6] = v1[2]; va[7] = v1[3]; \
            f32x4_t oo = o[QI][dt]; oo = oo * alpha; o[QI][dt] = __builtin_amdgcn_mfma_f32_16x16x32_bf16(va, pb, oo, 0, 0, 0); } }
#define DIL_LOADK(KF, TL) _Pragma("unroll") for (int u = 0; u < 2; ++u) { int tl_ = (TL) + u; if (tl_ > tile_max) tl_ = tile_max; \
            _Pragma("unroll") for (int ks = 0; ks < 4; ++ks) KF[u][ks] = *(const bf16x8_t*)(kbb + (size_t)tl_ * 2048 + 512 * ks); }
#define DIL_LOADV(VF, TP) { int tl0 = (TP), tl1 = (TP) + 1; if (tl0 > tile_max) tl0 = tile_max; if (tl1 > tile_max) tl1 = tile_max; \
            _Pragma("unroll") for (int dt = 0; dt < 8; ++dt) { VF[dt][0] = *(const bf16x4_t*)(vbb + dt * 256 + (size_t)tl0 * 2048); VF[dt][1] = *(const bf16x4_t*)(vbb + dt * 256 + (size_t)tl1 * 2048); } }
#pragma nounroll
    for (int br = 0; br < 2; ++br) {
        const int ld = 2 * br, d = 1 << ld;
        const int rho = r & (d - 1);
        const int qj0 = (t0 + r + 16 * j - rho) >> ld, qj1 = (t0 + r + 8 + 16 * j - rho) >> ld;
        const int q_lo = ((t0 + r - rho) >> ld) - 128, q_hi = (t0 + r + 8 + 240 - rho) >> ld;
        const int tile_lo = q_lo < 0 ? 0 : (q_lo >> 4), tile_hi = q_hi >> 4, tile_max = (256 >> ld) - 1;
        const size_t tbase = ((size_t)((br * 2 + b) * 8 + hd) * 256 + (size_t)rho * (256 >> ld)) * 2048;
        const bf16_t* kbb = KB + tbase + j * 32 + 8 * g;
        const bf16_t* vbb = VB + tbase + j * 16 + 4 * g;
        bf16x8_t kf[2][4];
        DIL_LOADK(kf, tile_lo)
#pragma nounroll
        for (int tp = tile_lo; tp <= tile_hi; tp += 2) {
            bf16x4_t vf[8][2];
            DIL_LOADV(vf, tp)
            bf16x8_t kc[2][4];
#pragma unroll
            for (int u = 0; u < 2; ++u)
#pragma unroll
                for (int ks = 0; ks < 4; ++ks) kc[u][ks] = kf[u][ks];
            DIL_LOADK(kf, tp + 2)
            DIL_STEP(0, qj0, tp, kc, vf)
            DIL_STEP(1, qj1, tp, kc, vf)
        }
    }
#pragma unroll
    for (int qi = 0; qi < 2; ++qi) {
        const int rho = r + 8 * qi;
        const int qj = (t0 + 16 * j) >> 4;
        const int q_lo = (t0 >> 4) - 128, q_hi = (t0 + 240) >> 4;
        const int tile_lo = q_lo < 0 ? 0 : (q_lo >> 4), tile_hi = q_hi >> 4, tile_max = 15;
        const size_t tbase = ((size_t)((2 * 2 + b) * 8 + hd) * 256 + (size_t)rho * 16) * 2048;
        const bf16_t* kbb = KB + tbase + j * 32 + 8 * g;
        const bf16_t* vbb = VB + tbase + j * 16 + 4 * g;
        bf16x8_t kf[2][4];
        DIL_LOADK(kf, tile_lo)
#pragma nounroll
        for (int tp = tile_lo; tp <= tile_hi; tp += 2) {
            bf16x4_t vf[8][2];
            DIL_LOADV(vf, tp)
            bf16x8_t kc[2][4];
#pragma unroll
            for (int u = 0; u < 2; ++u)
#pragma unroll
                for (int ks = 0; ks < 4; ++ks) kc[u][ks] = kf[u][ks];
            DIL_LOADK(kf, tp + 2)
            if (qi == 0) { DIL_STEP(0, qj, tp, kc, vf) } else { DIL_STEP(1, qj, tp, kc, vf) }
        }
    }
#undef DIL_STEP
#undef DIL_LOADK
#undef DIL_LOADV
#pragma unroll
    for (int qi = 0; qi < 2; ++qi) {
        const int sq = t0 + r + 8 * qi + 16 * j;
        const float inv = 1.0f / xg_sum_f32(l_run[qi]);
        float ss = 0.f;
#pragma unroll
        for (int dt = 0; dt < 8; ++dt) { o[qi][dt] = o[qi][dt] * inv; ss += (o[qi][dt][0] * o[qi][dt][0] + o[qi][dt][1] * o[qi][dt][1]) + (o[qi][dt][2] * o[qi][dt][2] + o[qi][dt][3] * o[qi][dt][3]); }
        ss = xg_sum_f32(ss);
        const float rn = rsqrtf(ss * (1.0f / 128.0f) + EPS);
        bf16_t* orow = mix + ((size_t)b * S + sq) * D + 1024 + hd * 128 + 4 * g;
#pragma unroll
        for (int dt = 0; dt < 8; ++dt) {
            const f32x4_t gv = *(const f32x4_t*)(g_ahead + hd * 128 + 16 * dt + 4 * g);
            uint2 w; w.x = pk2(o[qi][dt][0] * rn * gv[0], o[qi][dt][1] * rn * gv[1]); w.y = pk2(o[qi][dt][2] * rn * gv[2], o[qi][dt][3] * rn * gv[3]);
            *(uint2*)(orow + 16 * dt) = w;
        }
    }
}

__device__ __forceinline__ unsigned ord_key(float s) { const unsigned u = __float_as_uint(s); return u ^ ((unsigned)((int)u >> 31) | 0x80000000u); }
__device__ __forceinline__ unsigned wave_max_u32(unsigned v) {
    unsigned t;
    t = (unsigned)__builtin_amdgcn_update_dpp(0, (int)v, 0xB1, 0xF, 0xF, true); v = v > t ? v : t;
    t = (unsigned)__builtin_amdgcn_update_dpp(0, (int)v, 0x4E, 0xF, 0xF, true); v = v > t ? v : t;
    t = (unsigned)__builtin_amdgcn_update_dpp(0, (int)v, 0x141, 0xF, 0xF, true); v = v > t ? v : t;
    t = (unsigned)__builtin_amdgcn_update_dpp(0, (int)v, 0x140, 0xF, 0xF, true); v = v > t ? v : t;
    const unsigned a = (unsigned)__builtin_amdgcn_readlane((int)v, 0), b = (unsigned)__builtin_amdgcn_readlane((int)v, 16),
                   c = (unsigned)__builtin_amdgcn_readlane((int)v, 32), d = (unsigned)__builtin_amdgcn_readlane((int)v, 48);
    const unsigned ab = a > b ? a : b, cd = c > d ? c : d;
    return ab > cd ? ab : cd;
}
__device__ __forceinline__ void peer_topk_wave(int item, int lane, LAS float* wl, const bf16_t* __restrict__ qp, const bf16_t* __restrict__ skb, int* __restrict__ ids, float* __restrict__ gates) {
    const int hd = item & 7, tt = item >> 3, j = lane & 15, g = lane >> 4;
    const size_t t0 = (size_t)tt * 16;
    LAS float* sc = wl;
    LAS float* lst = wl + 2048;
#pragma unroll 1
    for (int p = 0; p < 2; ++p) {
        bf16x8_t qf[4];
        const bf16_t* qrow = qp + (t0 + j) * D + hd * 256 + p * 128 + 8 * g;
#pragma unroll
        for (int ks = 0; ks < 4; ++ks) qf[ks] = *(const bf16x8_t*)(qrow + 32 * ks);
        const bf16_t* kb = skb + ((size_t)(hd * 2 + p) * 128 + j) * 128 + 8 * g;
#pragma unroll
        for (int kt = 0; kt < 8; ++kt) {
            f32x4_t a = (f32x4_t){0.f, 0.f, 0.f, 0.f};
#pragma unroll
            for (int ks = 0; ks < 4; ++ks) a = __builtin_amdgcn_mfma_f32_16x16x32_bf16(*(const bf16x8_t*)(kb + (size_t)kt * (16 * 128) + 32 * ks), qf[ks], a, 0, 0, 0);
            *(LAS f32x4_t*)(sc + j * 128 + 16 * kt + 4 * g) = a;
        }
        asm volatile("s_waitcnt lgkmcnt(0)" ::: "memory");
#pragma unroll 1
        for (int tok = 0; tok < 16; ++tok) {
            const float s0 = sc[tok * 128 + lane], s1 = sc[tok * 128 + 64 + lane];
            unsigned k0 = (ord_key(s0) & ~127u) | (unsigned)(127 - lane), k1 = (ord_key(s1) & ~127u) | (unsigned)(63 - lane);
            unsigned sel = 0u;
#pragma unroll 4
            for (int it = 0; it < 16; ++it) {
                unsigned m = k0 > k1 ? k0 : k1;
                m = wave_max_u32(m);
                if (lane == it) sel = m;
                if (k0 == m) k0 = 0u;
                if (k1 == m) k1 = 0u;
            }
            if (lane < 16) {
                const int idx = 127 - (int)(sel & 127u);
                lst[((p * 16 + tok) * 16 + lane) * 2 + 0] = sc[tok * 128 + idx];
                lst[((p * 16 + tok) * 16 + lane) * 2 + 1] = __int_as_float(idx);
            }
        }
        asm volatile("s_waitcnt lgkmcnt(0)" ::: "memory");
    }
#pragma unroll 1
    for (int tok = 0; tok < 16; ++tok) {
        const int i = lane >> 2;
        const float sA = lst[((0 * 16 + tok) * 16 + i) * 2];
        unsigned kk[4];
#pragma unroll
        for (int r = 0; r < 4; ++r) {
            const int jb = (lane & 3) * 4 + r;
            const float sum = sA + lst[((1 * 16 + tok) * 16 + jb) * 2];
            kk[r] = (ord_key(sum) & ~255u) | (unsigned)(255 - (lane * 4 + r));
        }
        unsigned sel = 0u;
#pragma unroll 4
        for (int it = 0; it < 16; ++it) {
            unsigned m = kk[0] > kk[1] ? kk[0] : kk[1]; const unsigned m2 = kk[2] > kk[3] ? kk[2] : kk[3]; m = m > m2 ? m : m2;
            m = wave_max_u32(m);
            if (lane == it) sel = m;
#pragma unroll
            for (int r = 0; r < 4; ++r) if (kk[r] == m) kk[r] = 0u;
        }
        float bs = -INFINITY; int eid = 0;
        if (lane < 16) {
            const int c = 255 - (int)(sel & 255u), ia = c >> 4, ib = c & 15;
            bs = lst[((0 * 16 + tok) * 16 + ia) * 2] + lst[((1 * 16 + tok) * 16 + ib) * 2];
            eid = __float_as_int(lst[((0 * 16 + tok) * 16 + ia) * 2 + 1]) * 128 + __float_as_int(lst[((1 * 16 + tok) * 16 + ib) * 2 + 1]);
        }
        const float mx = wave_max(bs);
        const float ev = lane < 16 ? __expf(bs - mx) : 0.f;
        const float tot = wave_sum(ev);
        if (lane < 16) {
            ids[(t0 + tok) * 128 + hd * 16 + lane] = eid;
            gates[(t0 + tok) * 128 + hd * 16 + lane] = ev / tot;
        }
    }
}

typedef float f32x2_t __attribute__((ext_vector_type(2)));
__device__ __forceinline__ float wave_max_all(float v) {
    v = fmaxf(v, __uint_as_float((unsigned)__builtin_amdgcn_update_dpp(0, (int)__float_as_uint(v), 0xB1, 0xF, 0xF, true)));
    v = fmaxf(v, __uint_as_float((unsigned)__builtin_amdgcn_update_dpp(0, (int)__float_as_uint(v), 0x4E, 0xF, 0xF, true)));
    v = fmaxf(v, __uint_as_float((unsigned)__builtin_amdgcn_update_dpp(0, (int)__float_as_uint(v), 0x141, 0xF, 0xF, true)));
    v = fmaxf(v, __uint_as_float((unsigned)__builtin_amdgcn_update_dpp(0, (int)__float_as_uint(v), 0x140, 0xF, 0xF, true)));
    auto a = __builtin_amdgcn_permlane16_swap(__float_as_uint(v), __float_as_uint(v), false, false); v = fmaxf(__uint_as_float(a[0]), __uint_as_float(a[1]));
    auto b = __builtin_amdgcn_permlane32_swap(__float_as_uint(v), __float_as_uint(v), false, false); return fmaxf(__uint_as_float(b[0]), __uint_as_float(b[1]));
}
template <bool I8> __device__ __forceinline__ void table_row_store(float4 (&f)[8], unsigned char* __restrict__ drow, float* __restrict__ rscale, int lane, const float* __restrict__ dgain) {
    if (I8) {
#pragma unroll
        for (int i = 0; i < 8; ++i) { const float4 gq = *(const float4*)(dgain + i * 256 + lane * 4); f[i].x *= gq.x; f[i].y *= gq.y; f[i].z *= gq.z; f[i].w *= gq.w; }
    }
    float am = 0.f;
#pragma unroll
    for (int i = 0; i < 8; ++i) am = fmaxf(am, fmaxf(fmaxf(fabsf(f[i].x), fabsf(f[i].y)), fmaxf(fabsf(f[i].z), fabsf(f[i].w))));
    am = wave_max_all(am);
    const float s = exp2f(fminf(floorf(log2f((I8 ? 127.0f : 448.0f) / fmaxf(am, 1e-30f))), 100.0f));
#pragma unroll
    for (int i = 0; i < 8; ++i) {
        unsigned w;
        if (I8) { const int q0 = __float2int_rn(f[i].x * s), q1 = __float2int_rn(f[i].y * s), q2 = __float2int_rn(f[i].z * s), q3 = __float2int_rn(f[i].w * s);
                  w = ((unsigned)q0 & 255u) | (((unsigned)q1 & 255u) << 8) | (((unsigned)q2 & 255u) << 16) | (((unsigned)q3 & 255u) << 24); }
        else { int t = 0; t = __builtin_amdgcn_cvt_pk_fp8_f32(f[i].x * s, f[i].y * s, t, false); t = __builtin_amdgcn_cvt_pk_fp8_f32(f[i].z * s, f[i].w * s, t, true); w = (unsigned)t; }
        *(unsigned*)(drow + i * 256 + lane * 4) = w;
    }
    if (lane == 0) *rscale = 1.0f / s;
}
__device__ __forceinline__ void table_row_to_fp8(const float* __restrict__ srow, unsigned char* __restrict__ drow, float* __restrict__ rscale, int lane, const float* __restrict__ dgain) {
    float4 f[8];
#pragma unroll
    for (int i = 0; i < 8; ++i) f[i] = *(const float4*)(srow + i * 256 + lane * 4);
    if (dgain) {
#pragma unroll
        for (int i = 0; i < 8; ++i) { const float4 gq = *(const float4*)(dgain + i * 256 + lane * 4); f[i].x *= gq.x; f[i].y *= gq.y; f[i].z *= gq.z; f[i].w *= gq.w; }
    }
    float am = 0.f;
#pragma unroll
    for (int i = 0; i < 8; ++i) am = fmaxf(am, fmaxf(fmaxf(fabsf(f[i].x), fabsf(f[i].y)), fmaxf(fabsf(f[i].z), fabsf(f[i].w))));
    am = wave_max(am);
    const float e = floorf(log2f(448.0f / fmaxf(am, 1e-30f)));
    const float s = exp2f(fminf(e, 100.0f));
    unsigned w[8];
#pragma unroll
    for (int i = 0; i < 8; ++i) {
        int t = 0;
        t = __builtin_amdgcn_cvt_pk_fp8_f32(f[i].x * s, f[i].y * s, t, false);
        t = __builtin_amdgcn_cvt_pk_fp8_f32(f[i].z * s, f[i].w * s, t, true);
        w[i] = (unsigned)t;
    }
#pragma unroll
    for (int i = 0; i < 8; ++i) *(unsigned*)(drow + i * 256 + lane * 4) = w[i];
    if (lane == 0) *rscale = 1.0f / s;
}
__device__ __forceinline__ void table_row_to_i8(const float* __restrict__ srow, unsigned char* __restrict__ drow, float* __restrict__ rscale, int lane, const float* __restrict__ dgain) {
    float4 f[8];
#pragma unroll
    for (int i = 0; i < 8; ++i) { f[i] = *(const float4*)(srow + i * 256 + lane * 4); const float4 gq = *(const float4*)(dgain + i * 256 + lane * 4); f[i].x *= gq.x; f[i].y *= gq.y; f[i].z *= gq.z; f[i].w *= gq.w; }
    float am = 0.f;
#pragma unroll
    for (int i = 0; i < 8; ++i) am = fmaxf(am, fmaxf(fmaxf(fabsf(f[i].x), fabsf(f[i].y)), fmaxf(fabsf(f[i].z), fabsf(f[i].w))));
    am = wave_max(am);
    const float s = exp2f(fminf(floorf(log2f(127.0f / fmaxf(am, 1e-30f))), 100.0f));
#pragma unroll
    for (int i = 0; i < 8; ++i) {
        const int q0 = __float2int_rn(f[i].x * s), q1 = __float2int_rn(f[i].y * s), q2 = __float2int_rn(f[i].z * s), q3 = __float2int_rn(f[i].w * s);
        *(unsigned*)(drow + i * 256 + lane * 4) = ((unsigned)q0 & 255u) | (((unsigned)q1 & 255u) << 8) | (((unsigned)q2 & 255u) << 16) | (((unsigned)q3 & 255u) << 24);
    }
    if (lane == 0) *rscale = 1.0f / s;
}
__device__ __forceinline__ float dot16_fp8(const uint4 q, const float* x) {
    float d = 0.f;
    const unsigned w[4] = {q.x, q.y, q.z, q.w};
#pragma unroll
    for (int k = 0; k < 4; ++k) {
        const f32x2_t lo = __builtin_amdgcn_cvt_pk_f32_fp8((int)w[k], false), hi = __builtin_amdgcn_cvt_pk_f32_fp8((int)w[k], true);
        d = fmaf(lo.x, x[4 * k], d); d = fmaf(lo.y, x[4 * k + 1], d); d = fmaf(hi.x, x[4 * k + 2], d); d = fmaf(hi.y, x[4 * k + 3], d);
    }
    return d;
}
__device__ __forceinline__ void axpy16_fp8(const uint4 q, float c, float* acc) {
    const unsigned w[4] = {q.x, q.y, q.z, q.w};
#pragma unroll
    for (int k = 0; k < 4; ++k) {
        const f32x2_t lo = __builtin_amdgcn_cvt_pk_f32_fp8((int)w[k], false), hi = __builtin_amdgcn_cvt_pk_f32_fp8((int)w[k], true);
        acc[4 * k] = fmaf(c, lo.x, acc[4 * k]); acc[4 * k + 1] = fmaf(c, lo.y, acc[4 * k + 1]); acc[4 * k + 2] = fmaf(c, hi.x, acc[4 * k + 2]); acc[4 * k + 3] = fmaf(c, hi.y, acc[4 * k + 3]);
    }
}
__device__ __forceinline__ void d_peer_out8(int vb, int tid, float* sm, const bf16_t* __restrict__ h3, const float* __restrict__ x2, const int* __restrict__ ids, const float* __restrict__ gates,
                                            const unsigned char* __restrict__ ut8, const unsigned char* __restrict__ vt8, const float* __restrict__ rsc, const float* __restrict__ rstd, const float* __restrict__ g_final, float* __restrict__ out) {
    float (*part)[2048] = (float (*)[2048])sm;
    float* red = sm + 4 * 2048;
    const int lane = tid & 63, w = tid >> 6, t = vb;
    float x[32], acc[32];
    {
        const bf16_t* hrow = h3 + (size_t)t * D + lane * 16;
#pragma unroll
        for (int hh = 0; hh < 2; ++hh) {
            const uint4 a = *(const uint4*)(hrow + hh * 1024), b = *(const uint4*)(hrow + hh * 1024 + 8);
            const unsigned ww[8] = {a.x, a.y, a.z, a.w, b.x, b.y, b.z, b.w};
#pragma unroll
            for (int k = 0; k < 8; ++k) { x[hh * 16 + 2 * k] = __uint_as_float(ww[k] << 16); x[hh * 16 + 2 * k + 1] = __uint_as_float(ww[k] & 0xFFFF0000u); }
        }
#pragma unroll
        for (int i = 0; i < 32; ++i) acc[i] = 0.f;
    }
    const float xrs = rstd[t];
    const int myid = ids[(size_t)t * 128 + w * 32 + (lane & 31)];
    const float mygate = gates[(size_t)t * 128 + w * 32 + (lane & 31)];
#pragma unroll 1
    for (int j = 0; j < 32; j += 4) {
        int e[4]; uint4 uq[4][2], vq[4][2];
#pragma unroll
        for (int q = 0; q < 4; ++q) {
            e[q] = __builtin_amdgcn_readfirstlane(__shfl(myid, j + q));
            const unsigned char* ur = ut8 + (size_t)e[q] * 2048 + lane * 16;
            uq[q][0] = *(const uint4*)ur; uq[q][1] = *(const uint4*)(ur + 1024);
        }
#pragma unroll
        for (int q = 0; q < 4; ++q) {
            const unsigned char* vr = vt8 + (size_t)e[q] * 2048 + lane * 16;
            vq[q][0] = *(const uint4*)vr; vq[q][1] = *(const uint4*)(vr + 1024);
        }
        float d[4];
#pragma unroll
        for (int q = 0; q < 4; ++q) d[q] = dot16_fp8(uq[q][0], x) + dot16_fp8(uq[q][1], x + 16);
#pragma unroll
        for (int o = 32; o >= 1; o >>= 1) {
#pragma unroll
            for (int q = 0; q < 4; ++q) d[q] += __shfl_xor(d[q], o);
        }
#pragma unroll
        for (int q = 0; q < 4; ++q) {
            const float a = d[q] * rsc[e[q]] * xrs;
            const float act = 0.5f * a * (1.0f + erff(a * 0.7071067811865476f));
            const float cf = __shfl(mygate, j + q) * act * rsc[16384 + e[q]];
            axpy16_fp8(vq[q][0], cf, acc); axpy16_fp8(vq[q][1], cf, acc + 16);
        }
    }
    __syncthreads();
#pragma unroll
    for (int hh = 0; hh < 2; ++hh)
#pragma unroll
        for (int k = 0; k < 4; ++k) *(float4*)&part[w][hh * 1024 + lane * 16 + 4 * k] = make_float4(acc[hh * 16 + 4 * k], acc[hh * 16 + 4 * k + 1], acc[hh * 16 + 4 * k + 2], acc[hh * 16 + 4 * k + 3]);
    __syncthreads();
    float4 r0, r1;
    {
        const float4 a = *(const float4*)&part[0][tid * 4], b = *(const float4*)&part[1][tid * 4], c = *(const float4*)&part[2][tid * 4], dd = *(const float4*)&part[3][tid * 4];
        const float4 xx = *(const float4*)(x2 + (size_t)t * D + tid * 4);
        r0 = make_float4(xx.x + a.x + b.x + c.x + dd.x, xx.y + a.y + b.y + c.y + dd.y, xx.z + a.z + b.z + c.z + dd.z, xx.w + a.w + b.w + c.w + dd.w);
    }
    {
        const float4 a = *(const float4*)&part[0][1024 + tid * 4], b = *(const float4*)&part[1][1024 + tid * 4], c = *(const float4*)&part[2][1024 + tid * 4], dd = *(const float4*)&part[3][1024 + tid * 4];
        const float4 xx = *(const float4*)(x2 + (size_t)t * D + 1024 + tid * 4);
        r1 = make_float4(xx.x + a.x + b.x + c.x + dd.x, xx.y + a.y + b.y + c.y + dd.y, xx.z + a.z + b.z + c.z + dd.z, xx.w + a.w + b.w + c.w + dd.w);
    }
    float s = r0.x * r0.x + r0.y * r0.y + r0.z * r0.z + r0.w * r0.w + r1.x * r1.x + r1.y * r1.y + r1.z * r1.z + r1.w * r1.w;
    s = wave_sum(s);
    if (lane == 0) red[w] = s;
    __syncthreads();
    const float tot = red[0] + red[1] + red[2] + red[3];
    const float r = rsqrtf(tot * (1.0f / D) + EPS);
    const float4 g0 = *(const float4*)(g_final + tid * 4), g1 = *(const float4*)(g_final + 1024 + tid * 4);
    *(float4*)(out + (size_t)t * D + tid * 4) = make_float4(r0.x * r * g0.x, r0.y * r * g0.y, r0.z * r * g0.z, r0.w * r * g0.w);
    *(float4*)(out + (size_t)t * D + 1024 + tid * 4) = make_float4(r1.x * r * g1.x, r1.y * r * g1.y, r1.z * r * g1.z, r1.w * r * g1.w);
}

__device__ __forceinline__ unsigned xg_sum_u32(unsigned v) {
    auto a = __builtin_amdgcn_permlane16_swap(v, v, false, false); v = a[0] + a[1];
    auto b = __builtin_amdgcn_permlane32_swap(v, v, false, false); return b[0] + b[1];
}
__device__ __forceinline__ float xg_sum_f32(float v) {
    auto a = __builtin_amdgcn_permlane16_swap(__float_as_uint(v), __float_as_uint(v), false, false); v = __uint_as_float(a[0]) + __uint_as_float(a[1]);
    auto b = __builtin_amdgcn_permlane32_swap(__float_as_uint(v), __float_as_uint(v), false, false); return __uint_as_float(b[0]) + __uint_as_float(b[1]);
}
__device__ __forceinline__ float xg_max_f32(float v) {
    auto a = __builtin_amdgcn_permlane16_swap(__float_as_uint(v), __float_as_uint(v), false, false); v = fmaxf(__uint_as_float(a[0]), __uint_as_float(a[1]));
    auto b = __builtin_amdgcn_permlane32_swap(__float_as_uint(v), __float_as_uint(v), false, false); return fmaxf(__uint_as_float(b[0]), __uint_as_float(b[1]));
}
template <int N> __device__ __forceinline__ unsigned bisect16(const unsigned (&kk)[N]) {
    unsigned tau = 0u; bool done = false;
#pragma unroll 1
    for (int bit = 31; bit >= 0; --bit) {
        const unsigned cand = tau | (1u << bit);
        unsigned c0 = 0u, c1 = 0u, c2 = 0u, c3 = 0u;
#pragma unroll
        for (int i = 0; i < N; i += 4) { c0 += (kk[i] >= cand) ? 1u : 0u; c1 += (kk[i + 1] >= cand) ? 1u : 0u; c2 += (kk[i + 2] >= cand) ? 1u : 0u; c3 += (kk[i + 3] >= cand) ? 1u : 0u; }
        unsigned c = xg_sum_u32((c0 + c1) + (c2 + c3));
        if (!done && c >= 16u) { tau = cand; done = (c == 16u); }
        if (__all(done ? 1 : 0)) break;
    }
    return tau;
}
__device__ __forceinline__ void peer_topk_wave2(int item, int lane, LAS float* wl, const bf16_t* __restrict__ qp, const bf16_t* __restrict__ skb, int* __restrict__ ids, float* __restrict__ gates) {
    const int hd = item & 7, tt = item >> 3, j = lane & 15, g = lane >> 4;
    const size_t t0 = (size_t)tt * 16;
#pragma unroll 1
    for (int p = 0; p < 2; ++p) {
        bf16x8_t qf[4];
        const bf16_t* qrow = qp + (t0 + j) * D + hd * 256 + p * 128 + 8 * g;
#pragma unroll
        for (int ks = 0; ks < 4; ++ks) qf[ks] = *(const bf16x8_t*)(qrow + 32 * ks);
        const bf16_t* kb = skb + ((size_t)(hd * 2 + p) * 128 + j) * 128 + 8 * g;
        float sc[32]; unsigned kk[32];
#pragma unroll
        for (int kt = 0; kt < 8; ++kt) {
            f32x4_t a = (f32x4_t){0.f, 0.f, 0.f, 0.f};
#pragma unroll
            for (int ks = 0; ks < 4; ++ks) a = __builtin_amdgcn_mfma_f32_16x16x32_bf16(*(const bf16x8_t*)(kb + (size_t)kt * (16 * 128) + 32 * ks), qf[ks], a, 0, 0, 0);
#pragma unroll
            for (int r = 0; r < 4; ++r) { sc[kt * 4 + r] = a[r]; kk[kt * 4 + r] = (ord_key(a[r]) & ~127u) | (unsigned)(127 - (16 * kt + 4 * g + r)); }
        }
        const unsigned tau = bisect16<32>(kk);
        unsigned cnt = 0u;
#pragma unroll
        for (int i = 0; i < 32; ++i) cnt += (kk[i] >= tau) ? 1u : 0u;
        const unsigned c0 = (unsigned)__shfl((int)cnt, j), c1 = (unsigned)__shfl((int)cnt, j + 16), c2 = (unsigned)__shfl((int)cnt, j + 32);
        unsigned off = (g > 0 ? c0 : 0u) + (g > 1 ? c1 : 0u) + (g > 2 ? c2 : 0u);
        LAS float* ls = wl + p * 256 + j * 16;
        LAS float* li = wl + 512 + p * 256 + j * 16;
#pragma unroll
        for (int i = 0; i < 32; ++i) {
            if (kk[i] >= tau && off < 16u) { ls[off] = sc[i]; li[off] = __int_as_float(16 * (i >> 2) + 4 * g + (i & 3)); ++off; }
        }
    }
    asm volatile("s_waitcnt lgkmcnt(0)" ::: "memory");
    {
        float sAll[2][16];
#pragma unroll
        for (int p = 0; p < 2; ++p)
#pragma unroll
            for (int q = 0; q < 4; ++q) { const f32x4_t b = *(const LAS f32x4_t*)(wl + p * 256 + j * 16 + 4 * q); sAll[p][4 * q] = b[0]; sAll[p][4 * q + 1] = b[1]; sAll[p][4 * q + 2] = b[2]; sAll[p][4 * q + 3] = b[3]; }
        f32x4_t myi[2];
#pragma unroll
        for (int p = 0; p < 2; ++p) myi[p] = *(const LAS f32x4_t*)(wl + 512 + p * 256 + j * 16 + 4 * g);
        unsigned rk[2][4];
#pragma unroll
        for (int p = 0; p < 2; ++p) {
            unsigned key[16];
#pragma unroll
            for (int k = 0; k < 16; ++k) key[k] = (ord_key(sAll[p][k]) & ~15u) | (unsigned)(15 - k);
            unsigned mine[4];
#pragma unroll
            for (int e = 0; e < 4; ++e) mine[e] = g == 0 ? key[e] : g == 1 ? key[4 + e] : g == 2 ? key[8 + e] : key[12 + e];
#pragma unroll
            for (int e = 0; e < 4; ++e) { unsigned c = 0u;
#pragma unroll
                for (int k = 0; k < 16; ++k) c += (key[k] > mine[e]) ? 1u : 0u;
                rk[p][e] = c; }
        }
#pragma unroll
        for (int p = 0; p < 2; ++p)
#pragma unroll
            for (int e = 0; e < 4; ++e) {
                const float sv = g == 0 ? sAll[p][e] : g == 1 ? sAll[p][4 + e] : g == 2 ? sAll[p][8 + e] : sAll[p][12 + e];
                wl[p * 256 + j * 16 + rk[p][e]] = sv; wl[512 + p * 256 + j * 16 + rk[p][e]] = myi[p][e];
            }
        asm volatile("s_waitcnt lgkmcnt(0)" ::: "memory");
        const unsigned t0w = g == 0 ? 0x03020100u : g == 1 ? 0x13121110u : g == 2 ? 0x23222120u : 0xB0A09080u;
        const unsigned t1w = g == 0 ? 0x07060504u : g == 1 ? 0x17161514u : g == 2 ? 0x42414024u : 0xF0E0D0C0u;
        const unsigned t2w = g == 0 ? 0x0B0A0908u : g == 1 ? 0x33323130u : g == 2 ? 0x71705150u : 0xFFFFFFFFu;
        const unsigned t3w = g == 0 ? 0x0F0E0D0Cu : g == 1 ? 0xFFFF6160u : g == 2 ? 0xFFFFFFFFu : 0xFFFFFFFFu;
        unsigned kk[16]; float sm16[16];
#pragma unroll
        for (int k = 0; k < 16; ++k) {
            const unsigned tw = (k >> 2) == 0 ? t0w : (k >> 2) == 1 ? t1w : (k >> 2) == 2 ? t2w : t3w;
            const unsigned byte = (tw >> (8 * (k & 3))) & 255u;
            const bool valid = byte != 255u;
            const unsigned ci = valid ? (byte >> 4) : 0u, cj = valid ? (byte & 15u) : 0u;
            const float sum = wl[j * 16 + ci] + wl[256 + j * 16 + cj];
            sm16[k] = sum;
            kk[k] = valid ? ((ord_key(sum) & ~63u) | (unsigned)(63 - (16 * g + k))) : 0u;
        }
        const unsigned tau = bisect16<16>(kk);
        float mx = -INFINITY; unsigned cnt = 0u;
#pragma unroll
        for (int k = 0; k < 16; ++k) if (kk[k] >= tau && kk[k] != 0u) { mx = fmaxf(mx, sm16[k]); ++cnt; }
        mx = xg_max_f32(mx);
        float es = 0.f;
#pragma unroll
        for (int k = 0; k < 16; ++k) if (kk[k] >= tau && kk[k] != 0u) es += __expf(sm16[k] - mx);
        const float inv = 1.0f / xg_sum_f32(es);
        const unsigned c0 = (unsigned)__shfl((int)cnt, j), c1 = (unsigned)__shfl((int)cnt, j + 16), c2 = (unsigned)__shfl((int)cnt, j + 32);
        unsigned off = (g > 0 ? c0 : 0u) + (g > 1 ? c1 : 0u) + (g > 2 ? c2 : 0u);
        int* idp = ids + (t0 + j) * 128 + hd * 16;
        float* gtp = gates + (t0 + j) * 128 + hd * 16;
#pragma unroll
        for (int k = 0; k < 16; ++k) {
            if (kk[k] >= tau && kk[k] != 0u && off < 16u) {
                const unsigned tw = (k >> 2) == 0 ? t0w : (k >> 2) == 1 ? t1w : (k >> 2) == 2 ? t2w : t3w;
                const unsigned byte = (tw >> (8 * (k & 3))) & 255u;
                idp[off] = __float_as_int(wl[512 + j * 16 + (byte >> 4)]) * 128 + __float_as_int(wl[512 + 256 + j * 16 + (byte & 15u)]);
                gtp[off] = __expf(sm16[k] - mx) * inv;
                ++off;
            }
        }
        asm volatile("s_waitcnt lgkmcnt(0)" ::: "memory");
    }
}

__device__ __forceinline__ float wave_sum_dpp(float v) {
    v += __uint_as_float((unsigned)__builtin_amdgcn_update_dpp(0, (int)__float_as_uint(v), 0xB1, 0xF, 0xF, true));
    v += __uint_as_float((unsigned)__builtin_amdgcn_update_dpp(0, (int)__float_as_uint(v), 0x4E, 0xF, 0xF, true));
    v += __uint_as_float((unsigned)__builtin_amdgcn_update_dpp(0, (int)__float_as_uint(v), 0x141, 0xF, 0xF, true));
    v += __uint_as_float((unsigned)__builtin_amdgcn_update_dpp(0, (int)__float_as_uint(v), 0x140, 0xF, 0xF, true));
    const float a = __uint_as_float((unsigned)__builtin_amdgcn_readlane((int)__float_as_uint(v), 0)), b = __uint_as_float((unsigned)__builtin_amdgcn_readlane((int)__float_as_uint(v), 16)),
                c = __uint_as_float((unsigned)__builtin_amdgcn_readlane((int)__float_as_uint(v), 32)), d = __uint_as_float((unsigned)__builtin_amdgcn_readlane((int)__float_as_uint(v), 48));
    return (a + b) + (c + d);
}
typedef __bf16 bf16x2v_t __attribute__((ext_vector_type(2)));
__device__ __forceinline__ int wave_sum_all_i32(int v) {
    v += __builtin_amdgcn_update_dpp(0, v, 0xB1, 0xF, 0xF, true);
    v += __builtin_amdgcn_update_dpp(0, v, 0x4E, 0xF, 0xF, true);
    v += __builtin_amdgcn_update_dpp(0, v, 0x141, 0xF, 0xF, true);
    v += __builtin_amdgcn_update_dpp(0, v, 0x140, 0xF, 0xF, true);
    auto a = __builtin_amdgcn_permlane16_swap((unsigned)v, (unsigned)v, false, false); v = (int)(a[0] + a[1]);
    auto b = __builtin_amdgcn_permlane32_swap((unsigned)v, (unsigned)v, false, false); return (int)(b[0] + b[1]);
}
__device__ __forceinline__ float wave_sum_all(float v) {
    v += __uint_as_float((unsigned)__builtin_amdgcn_update_dpp(0, (int)__float_as_uint(v), 0xB1, 0xF, 0xF, true));
    v += __uint_as_float((unsigned)__builtin_amdgcn_update_dpp(0, (int)__float_as_uint(v), 0x4E, 0xF, 0xF, true));
    v += __uint_as_float((unsigned)__builtin_amdgcn_update_dpp(0, (int)__float_as_uint(v), 0x141, 0xF, 0xF, true));
    v += __uint_as_float((unsigned)__builtin_amdgcn_update_dpp(0, (int)__float_as_uint(v), 0x140, 0xF, 0xF, true));
    auto a = __builtin_amdgcn_permlane16_swap(__float_as_uint(v), __float_as_uint(v), false, false); v = __uint_as_float(a[0]) + __uint_as_float(a[1]);
    auto b = __builtin_amdgcn_permlane32_swap(__float_as_uint(v), __float_as_uint(v), false, false); return __uint_as_float(b[0]) + __uint_as_float(b[1]);
}
__device__ __forceinline__ float dot16_fp8_bf16(const uint4 q, const uint4 xa, const uint4 xb, float d) {
    const unsigned w[4] = {q.x, q.y, q.z, q.w};
    const unsigned xw[8] = {xa.x, xa.y, xa.z, xa.w, xb.x, xb.y, xb.z, xb.w};
#pragma unroll
    for (int k = 0; k < 4; ++k) {
        const bf16x2v_t lo = __builtin_amdgcn_cvt_scalef32_pk_bf16_fp8(w[k], 1.0f, false), hi = __builtin_amdgcn_cvt_scalef32_pk_bf16_fp8(w[k], 1.0f, true);
        d = __builtin_amdgcn_fdot2_f32_bf16(lo, __builtin_bit_cast(bf16x2v_t, xw[2 * k]), d, false);
        d = __builtin_amdgcn_fdot2_f32_bf16(hi, __builtin_bit_cast(bf16x2v_t, xw[2 * k + 1]), d, false);
    }
    return d;
}
__device__ __forceinline__ void axpy16_fp8_pk(const uint4 q, const f32x2_t c2, f32x2_t* acc) {
    const unsigned w[4] = {q.x, q.y, q.z, q.w};
#pragma unroll
    for (int k = 0; k < 4; ++k) {
        const f32x2_t lo = __builtin_amdgcn_cvt_pk_f32_fp8((int)w[k], false), hi = __builtin_amdgcn_cvt_pk_f32_fp8((int)w[k], true);
        acc[2 * k] = __builtin_elementwise_fma(c2, lo, acc[2 * k]); acc[2 * k + 1] = __builtin_elementwise_fma(c2, hi, acc[2 * k + 1]);
    }
}
typedef _Float16 f16x2_t __attribute__((ext_vector_type(2)));
__device__ __forceinline__ void axpy16_fp8_h(const uint4 q, const f16x2_t c2, f16x2_t* acc) {
    const unsigned w[4] = {q.x, q.y, q.z, q.w};
#pragma unroll
    for (int k = 0; k < 4; ++k) {
        const f16x2_t lo = __builtin_amdgcn_cvt_scalef32_pk_f16_fp8(w[k], 0.00390625f, false), hi = __builtin_amdgcn_cvt_scalef32_pk_f16_fp8(w[k], 0.00390625f, true);
        acc[2 * k] = __builtin_elementwise_fma(c2, lo, acc[2 * k]); acc[2 * k + 1] = __builtin_elementwise_fma(c2, hi, acc[2 * k + 1]);
    }
}
__device__ __forceinline__ float gelu_as(float v) {
    const float av = fabsf(v), t = __builtin_amdgcn_rcpf(av * 0.2316418882f + 1.0f);
    float q = t * 0.5307027145f + (-0.7265760135f); q = q * t + 0.7107068705f; q = q * t + (-0.142248368f); q = q * t + 0.127414796f; q = q * t;
    const float e = __builtin_amdgcn_exp2f((v * v) * (-0.72134752044f));
    const float m = v * (q * e);
    return v < 0.f ? m : v - m;
}
__device__ __forceinline__ void peer_sweep_wave(int gw, int lane, LAS unsigned char* wl, const bf16_t* __restrict__ h3, const float* __restrict__ x2, const int* __restrict__ ids,
                                                const float* __restrict__ gates, const unsigned char* __restrict__ ut8, const unsigned char* __restrict__ vt8, const float* __restrict__ rsc,
                                                const float* __restrict__ rstd, const float* __restrict__ g_final, float* __restrict__ out) {
    typedef unsigned u32x4_t __attribute__((ext_vector_type(4)));
    typedef int i32x4_t __attribute__((ext_vector_type(4)));
    LAS unsigned char* x8 = wl;
    LAS unsigned* sorted = (LAS unsigned*)(wl + 8192);
    LAS unsigned* cnt = (LAS unsigned*)(wl + 8192 + 2048);
    LAS unsigned* base = (LAS unsigned*)(wl + 8192 + 2048 + 256);
    LAS unsigned short* gsv = (LAS unsigned short*)(wl + 8192 + 2048 + 512);
    const size_t t0 = (size_t)gw * 4;
    float fac = 0.f;
#pragma unroll
    for (int tok = 0; tok < 4; ++tok) {
        uint4 xv[4]; float am = 0.f;
#pragma unroll
        for (int c = 0; c < 4; ++c) {
            xv[c] = *(const uint4*)(h3 + (t0 + tok) * D + c * 512 + lane * 8);
            const unsigned w[4] = {xv[c].x, xv[c].y, xv[c].z, xv[c].w};
#pragma unroll
            for (int k = 0; k < 4; ++k) am = fmaxf(am, fmaxf(fabsf(__uint_as_float(w[k] << 16)), fabsf(__uint_as_float(w[k] & 0xFFFF0000u))));
        }
        am = wave_max(am);
        const float s = exp2f(fminf(floorf(log2f(127.0f / fmaxf(am, 1e-30f))), 100.0f));
        if ((lane & 3) == tok) fac = rstd[t0 + tok] / s;
#pragma unroll
        for (int c = 0; c < 4; ++c) {
            const unsigned w[4] = {xv[c].x, xv[c].y, xv[c].z, xv[c].w};
            unsigned o[2];
#pragma unroll
            for (int h = 0; h < 2; ++h) {
                const int q0 = __float2int_rn(__uint_as_float(w[2 * h] << 16) * s), q1 = __float2int_rn(__uint_as_float(w[2 * h] & 0xFFFF0000u) * s);
                const int q2 = __float2int_rn(__uint_as_float(w[2 * h + 1] << 16) * s), q3 = __float2int_rn(__uint_as_float(w[2 * h + 1] & 0xFFFF0000u) * s);
                o[h] = ((unsigned)q0 & 255u) | (((unsigned)q1 & 255u) << 8) | (((unsigned)q2 & 255u) << 16) | (((unsigned)q3 & 255u) << 24);
            }
            typedef unsigned u32x2_t __attribute__((ext_vector_type(2)));
            *(LAS u32x2_t*)(x8 + tok * 2048 + c * 512 + lane * 8) = (u32x2_t){o[0], o[1]};
        }
    }
    cnt[lane] = 0u;
    asm volatile("s_waitcnt lgkmcnt(0)" ::: "memory");
    unsigned key[8], rk[8]; unsigned short fv[8];
#pragma unroll
    for (int r = 0; r < 8; ++r) {
        const int n = r * 64 + lane;
        const unsigned e = (unsigned)ids[t0 * 128 + n];
        key[r] = (e << 9) | (unsigned)n | (__float_as_uint(rsc[e]) & 0x7F800000u);
        fv[r] = (unsigned short)f2bf(gates[t0 * 128 + n] * rsc[16384 + e]);
        rk[r] = __hip_atomic_fetch_add(&cnt[e >> 8], 1u, __ATOMIC_RELAXED, __HIP_MEMORY_SCOPE_WORKGROUP);
    }
    asm volatile("s_waitcnt lgkmcnt(0)" ::: "memory");
    {
        const unsigned c = cnt[lane];
        unsigned incl = c;
#pragma unroll
        for (int o = 1; o < 64; o <<= 1) { const unsigned t = (unsigned)__shfl_up((int)incl, o); if (lane >= o) incl += t; }
        base[lane] = incl - c;
    }
    asm volatile("s_waitcnt lgkmcnt(0)" ::: "memory");
#pragma unroll
    for (int r = 0; r < 8; ++r) { const unsigned pos = base[(key[r] >> 17) & 63u] + rk[r]; sorted[pos] = key[r]; gsv[pos] = fv[r]; }
    asm volatile("s_waitcnt lgkmcnt(0)" ::: "memory");
    float rs4[4];
#pragma unroll
    for (int tok = 0; tok < 4; ++tok) rs4[tok] = __uint_as_float((unsigned)__builtin_amdgcn_readlane((int)__float_as_uint(fac), tok));
#define P1_LOAD(ENT, UQ, I0) _Pragma("unroll") for (int q = 0; q < 8; ++q) { \
            ENT[q] = (unsigned)__builtin_amdgcn_readfirstlane((int)sorted[(I0) + q]); \
            const unsigned char* ur = ut8 + (size_t)((ENT[q] >> 9) & 16383u) * 2048 + lane * 16; \
            UQ[q][0] = *(const uint4*)ur; UQ[q][1] = *(const uint4*)(ur + 1024); }
#define P1_COMP(ENT, UQ, I0) { int d[8]; \
            _Pragma("unroll") for (int q = 0; q < 8; ++q) { \
                const int tok = (ENT[q] >> 7) & 3; \
                const LAS unsigned char* xr = x8 + tok * 2048 + lane * 16; \
                const u32x4_t a0 = *(const LAS u32x4_t*)xr, b0 = *(const LAS u32x4_t*)(xr + 1024); \
                int dd = 0; \
                dd = __builtin_amdgcn_sdot4((int)UQ[q][0].x, (int)a0[0], dd, false); dd = __builtin_amdgcn_sdot4((int)UQ[q][0].y, (int)a0[1], dd, false); \
                dd = __builtin_amdgcn_sdot4((int)UQ[q][0].z, (int)a0[2], dd, false); dd = __builtin_amdgcn_sdot4((int)UQ[q][0].w, (int)a0[3], dd, false); \
                dd = __builtin_amdgcn_sdot4((int)UQ[q][1].x, (int)b0[0], dd, false); dd = __builtin_amdgcn_sdot4((int)UQ[q][1].y, (int)b0[1], dd, false); \
                dd = __builtin_amdgcn_sdot4((int)UQ[q][1].z, (int)b0[2], dd, false); dd = __builtin_amdgcn_sdot4((int)UQ[q][1].w, (int)b0[3], dd, false); \
                d[q] = dd; } \
              \
            int c4[4]; \
            _Pragma("unroll") for (int q = 0; q < 4; ++q) { auto t_ = __builtin_amdgcn_permlane32_swap((unsigned)d[q], (unsigned)d[q + 4], false, false); c4[q] = (int)(t_[0] + t_[1]); } \
            int e2[2]; \
            _Pragma("unroll") for (int q = 0; q < 2; ++q) { auto t_ = __builtin_amdgcn_permlane16_swap((unsigned)c4[q], (unsigned)c4[q + 2], false, false); e2[q] = (int)(t_[0] + t_[1]); } \
            const int g0_ = e2[0] + __builtin_amdgcn_update_dpp(0, e2[0], 0x128, 0xF, 0xF, true), g1_ = e2[1] + __builtin_amdgcn_update_dpp(0, e2[1], 0x128, 0xF, 0xF, true); \
            int f_ = (lane & 8) ? g1_ : g0_; \
            f_ += __builtin_amdgcn_update_dpp(0, f_, 0x141, 0xF, 0xF, true); \
            f_ += __builtin_amdgcn_update_dpp(0, f_, 0xB1, 0xF, 0xF, true); \
            f_ += __builtin_amdgcn_update_dpp(0, f_, 0x4E, 0xF, 0xF, true); \
            { const int pidx = (I0) + 2 * (lane >> 4) + ((lane >> 3) & 1); \
              const unsigned ent_ = sorted[pidx]; \
              const unsigned e = (ent_ >> 9) & 16383u; const int tok = (ent_ >> 7) & 3; \
              const float rsv = tok == 0 ? rs4[0] : tok == 1 ? rs4[1] : tok == 2 ? rs4[2] : rs4[3]; \
              const float a = (float)f_ * (__uint_as_float(ent_ & 0x7F800000u) * rsv); \
              const float cf = __uint_as_float((unsigned)gsv[pidx] << 16) * gelu_as(a); \
              if ((lane & 7) == 0) sorted[pidx] = (e << 18) | ((unsigned)tok << 16) | f2bf(cf); } }
    {
        unsigned entA[8], entB[8]; uint4 uqA[8][2], uqB[8][2];
        P1_LOAD(entA, uqA, 0)
#pragma unroll 1
        for (int i = 0; i < 512; i += 16) {
            P1_LOAD(entB, uqB, i + 8)
            P1_COMP(entA, uqA, i)
            { const int nx = i + 16 < 512 ? i + 16 : 504; P1_LOAD(entA, uqA, nx) }
            P1_COMP(entB, uqB, i + 8)
        }
    }
#undef P1_LOAD
#undef P1_COMP
    asm volatile("s_waitcnt lgkmcnt(0)" ::: "memory");
    f16x2_t acc0[16], acc1[16], acc2[16], acc3[16];
#pragma unroll
    for (int k = 0; k < 16; ++k) { const f16x2_t z = {(_Float16)0.f, (_Float16)0.f}; acc0[k] = z; acc1[k] = z; acc2[k] = z; acc3[k] = z; }
#ifndef P2N
#define P2N 4
#endif
#define P2_LOAD(ENT, VQ, I0) _Pragma("unroll") for (int q = 0; q < P2N; ++q) { \
            ENT[q] = (unsigned)__builtin_amdgcn_readfirstlane((int)sorted[(I0) + q]); \
            const unsigned char* vr = vt8 + (size_t)(ENT[q] >> 18) * 2048 + lane * 16; \
            VQ[q][0] = *(const uint4*)vr; VQ[q][1] = *(const uint4*)(vr + 1024); }
#define P2_COMP(ENT, VQ) _Pragma("unroll") for (int q = 0; q < P2N; ++q) { \
            const int tok = (ENT[q] >> 16) & 3; \
            const _Float16 cfh = (_Float16)(__uint_as_float(ENT[q] << 16) * 256.0f); \
            const f16x2_t c2 = {cfh, cfh}; \
            if (tok == 0) { axpy16_fp8_h(VQ[q][0], c2, acc0); axpy16_fp8_h(VQ[q][1], c2, acc0 + 8); } \
            else if (tok == 1) { axpy16_fp8_h(VQ[q][0], c2, acc1); axpy16_fp8_h(VQ[q][1], c2, acc1 + 8); } \
            else if (tok == 2) { axpy16_fp8_h(VQ[q][0], c2, acc2); axpy16_fp8_h(VQ[q][1], c2, acc2 + 8); } \
            else { axpy16_fp8_h(VQ[q][0], c2, acc3); axpy16_fp8_h(VQ[q][1], c2, acc3 + 8); } }
    {
        unsigned entA[P2N], entB[P2N]; uint4 vqA[P2N][2], vqB[P2N][2];
        P2_LOAD(entA, vqA, 0)
#pragma unroll 1
        for (int i = 0; i < 512; i += 2 * P2N) {
            P2_LOAD(entB, vqB, i + P2N)
            P2_COMP(entA, vqA)
            { const int nx = i + 2 * P2N < 512 ? i + 2 * P2N : 512 - P2N; P2_LOAD(entA, vqA, nx) }
            P2_COMP(entB, vqB)
        }
    }
#undef P2_LOAD
#undef P2_COMP
    int l2 = lane; asm volatile("" : "+v"(l2));
#define PEER_EPI(tok, ACC) { f32x2_t res[16]; \
        const bf16_t* xr = h3 + (t0 + tok) * D + l2 * 16; \
        float ss = 0.f; \
        _Pragma("unroll") for (int hh = 0; hh < 2; ++hh) _Pragma("unroll") for (int k = 0; k < 4; ++k) { \
            const uint2 xp = *(const uint2*)(xr + hh * 1024 + 4 * k); \
            const float4 xv = make_float4(__uint_as_float(xp.x << 16), __uint_as_float(xp.x & 0xFFFF0000u), __uint_as_float(xp.y << 16), __uint_as_float(xp.y & 0xFFFF0000u)); \
            f32x2_t a0 = {(float)ACC[hh * 8 + 2 * k].x, (float)ACC[hh * 8 + 2 * k].y}, a1 = {(float)ACC[hh * 8 + 2 * k + 1].x, (float)ACC[hh * 8 + 2 * k + 1].y}; \
            a0.x += xv.x; a0.y += xv.y; a1.x += xv.z; a1.y += xv.w; res[hh * 8 + 2 * k] = a0; res[hh * 8 + 2 * k + 1] = a1; \
            ss += (a0.x * a0.x + a0.y * a0.y) + (a1.x * a1.x + a1.y * a1.y); } \
        ss = wave_sum_dpp(ss); \
        const float r = rsqrtf(ss * (1.0f / D) + EPS); \
        float* orow = out + (t0 + tok) * D + l2 * 16; \
        _Pragma("unroll") for (int hh = 0; hh < 2; ++hh) _Pragma("unroll") for (int k = 0; k < 4; ++k) { \
            const float4 gv = *(const float4*)(g_final + hh * 1024 + l2 * 16 + 4 * k); \
            const f32x2_t a0 = res[hh * 8 + 2 * k], a1 = res[hh * 8 + 2 * k + 1]; \
            *(float4*)(orow + hh * 1024 + 4 * k) = make_float4(a0.x * r * gv.x, a0.y * r * gv.y, a1.x * r * gv.z, a1.y * r * gv.w); } }
    PEER_EPI(0, acc0) PEER_EPI(1, acc1) PEER_EPI(2, acc2) PEER_EPI(3, acc3)
#undef PEER_EPI
}

struct Params {
    const float *x, *mem, *g_mix, *w_in, *conv_w, *conv_b, *w_mq, *w_mk, *b_mi, *b_mf, *g_mhead, *g_ahead, *w_out, *g_cross, *g_mem,
                *w_xq, *w_xk, *w_xv, *w_xo, *g_ffn, *w_pq, *sub_keys, *u_tab, *v_tab, *g_final;
    float* out;
    unsigned* bar;
    float* ws;
};

#define PHASE_LOOP(nvb) for (int base_ = blockIdx.x * 2; base_ < (nvb); base_ += gridDim.x * 2)
#define VB (base_ + half)

__global__ void __launch_bounds__(NTHR) mega(Params P) {
    volatile LAS unsigned* st = (volatile LAS unsigned*)(LAS unsigned char*)(smem_raw + CTRL_OFF);
    if (threadIdx.x == 0) { st[0] = 0u; st[1] = 0u; st[2] = 0u; st[3] = 0u; }
    if (threadIdx.x < I_NPTR) ((LAS unsigned long long*)(LAS unsigned char*)(smem_raw + CTRL_OFF + 64))[threadIdx.x] = ((const unsigned long long*)&P)[threadIdx.x];
    __syncthreads();
    XcdBarrier xb = xcd_barrier_post((unsigned*)ldp_raw(I_BAR), st);

    constexpr size_t TD = (size_t)T * D;
    constexpr size_t O_HB = 6 * P6S * 2, O_CBUF = O_HB + (size_t)T * D * 2, O_MQ = O_CBUF + (size_t)T * 1024 * 2, O_MK = O_MQ + (size_t)T * 1024 * 2,
                     O_MIXB = O_MK + (size_t)T * 1024 * 2, O_WIN = O_MIXB + (size_t)T * D * 2, O_WOUT = O_WIN + (size_t)6144 * D * 2, O_WXQ = O_WOUT + (size_t)D * D * 2,
                     O_WXK = O_WXQ + (size_t)D * D * 2, O_WXV = O_WXK + (size_t)D * D * 2, O_WXO = O_WXV + (size_t)D * D * 2, O_WPQ = O_WXO + (size_t)D * D * 2,
                     O_WQK = O_WPQ + (size_t)D * D * 2, O_GPRE = O_WQK + (size_t)8 * 256 * 256 * 2, O_UT = O_GPRE + (size_t)T * 8 * 4, O_VT = O_UT + (size_t)16384 * D, O_RSC = O_VT + (size_t)16384 * D,
                     O_BH = O_RSC + (size_t)32768 * 4, O_GS = O_BH + (size_t)128 * 256 * 512 * 2, O_DENP = O_GS + (size_t)T * 4 * 8 * 4, O_QN = O_DENP + (size_t)T * 4 * 4 * 4,
                     O_DN = O_QN + (size_t)T * 4 * 4, O_DECAY = O_DN + (size_t)128 * 256 * 4, O_KB = O_DECAY + 4096, O_VB = O_KB + (size_t)12288 * 2048 * 2, O_CS = O_VB + (size_t)12288 * 2048 * 2, O_SKB = O_CS + (size_t)4096 * 64 * 8, O_RSSP = O_SKB + (size_t)262144 * 2, O_RSTD = O_RSSP + (size_t)T * 32 * 4, O_MN = O_RSTD + (size_t)T * 4, O_KVP = O_MN + (size_t)512 * D * 2, O_END = O_KVP + (size_t)2 * 512 * 4096 * 4;
    static_assert(O_END + 16384 <= (size_t)536870912, "workspace overflow");
#define W_P6    ((bf16_t*)wsb)
#define W_HB    ((bf16_t*)(wsb + O_HB))
#define W_CBUF  ((bf16_t*)(wsb + O_CBUF))
#define W_MQ    ((bf16_t*)(wsb + O_MQ))
#define W_MK    ((bf16_t*)(wsb + O_MK))
#define W_MIXB  ((bf16_t*)(wsb + O_MIXB))
#define W_GPRE  ((float*)(wsb + O_GPRE))
#define W_HRAW  ((float*)(wsb + O_HB))
#define W_XR    ((float*)wsb)
#define W_MN    ((bf16_t*)((float*)wsb + TD))
#define W_KM    ((bf16_t*)((float*)wsb + TD + (size_t)256 * D))
#define W_VMT   ((bf16_t*)((float*)wsb + TD + (size_t)768 * D))
#define W_PX    ((bf16_t*)(wsb + O_MK))
#define W_GATES ((float*)wsb + TD + (size_t)1280 * D)
#define W_IDS   ((int*)((float*)wsb + TD + (size_t)1280 * D + (size_t)T * 128))
#define W_QX    ((bf16_t*)(wsb + O_CBUF))
#define W_BH    ((bf16_t*)(wsb + O_BH))
#define W_KB    ((bf16_t*)(wsb + O_KB))
#define W_VB    ((bf16_t*)(wsb + O_VB))
#define W_CS    ((float2*)(wsb + O_CS))
#define W_SKB   ((bf16_t*)(wsb + O_SKB))
#define W_RSSP  ((float*)(wsb + O_RSSP))
#define W_RSTD  ((float*)(wsb + O_RSTD))
#define W_MN2   ((bf16_t*)(wsb + O_MN))
#define W_KVP   ((float*)(wsb + O_KVP))
#define W_GS    ((float*)(wsb + O_GS))
#define W_DENP  ((float*)(wsb + O_DENP))
#define W_QN    ((float*)(wsb + O_QN))
#define W_DN    ((float*)(wsb + O_DN))
#define W_DECAY ((float*)(wsb + O_DECAY))
#define W_PQ    ((bf16_t*)(wsb + O_HB))
#define W_KWT   ((bf16_t*)(wsb + O_CBUF))
#define W_DC    ((float*)(wsb + 3 * P6S * 2))
#define W_UT    ((unsigned char*)(wsb + O_UT))
#define W_VT    ((unsigned char*)(wsb + O_VT))
#define W_RSC   ((float*)(wsb + O_RSC))
#define PH_BEGIN() int tidx = threadIdx.x; asm volatile("" : "+v"(tidx)); const int half = tidx >> 8, tid = tidx & 255; float* sm = (float*)smem_raw + half * HALF_SM_FLOATS; \
                   char* wsb = (char*)ldp_raw(I_WS); (void)half; (void)tid; (void)sm; (void)wsb
#define GJOB_DEFAULT(g) pg8::GJob g; g.lda = D; g.ldb = D; g.K = D; g.nM = 32; g.nN = 8; g.a_pm_step = 256 * D; g.b_pn_mask = 0x7fffffff; g.b_pn_shift = 30; g.b_pn_step2 = 0; g.bid0 = 0; g.nblk = gridDim.x; g.a_pn_shift = 0; g.a_pn_mask = 0; g.a_pn_step = 0; g.b_pm_shift = 0; g.b_pm_step = 0; g.b_pn_step = 256 * D; \
                        g.ldc = D; g.R = nullptr; g.ldr = D; g.mode = 0; g.escale = 1.0f; g.gs = nullptr; g.denp = nullptr; g.qn = nullptr; g.gvec = nullptr; g.mo = nullptr; g.C2 = nullptr; g.rssp = nullptr; g.rstd = nullptr
#define GEMM_LDSP ((LAS unsigned char*)smem_raw)

    {
        PH_BEGIN();
        {
            LAS float* scr = (LAS float*)(LAS unsigned char*)(smem_raw) + (tidx >> 6) * (64 * 33);
            const int lane = tidx & 63;
            const int gw = blockIdx.x * 8 + (tidx >> 6), NGW = gridDim.x * 8;
            constexpr int I_IN = 32 * 192, I_SQ = 32 * 64, I_QK = 8 * 4 * 8;
            constexpr int NITEMS = I_IN + 6 * I_SQ + I_QK;
#pragma nounroll
            for (int it = gw; it < NITEMS; it += NGW) {
                const float* W; int ldw, K, csrc0, row0, kb; bf16_t* WT; float wscale = 1.0f; const float* kgain = nullptr;
                int r = it;
                if (r < I_IN) { const int nb = r % 192; kb = r / 192; W = PF(I_WIN); ldw = INC; K = D; csrc0 = nb * 32 + (nb >= 96 ? 8 : 0); WT = (bf16_t*)(wsb + O_WIN); row0 = nb * 32; }
                else if ((r -= I_IN) < 6 * I_SQ) {
                    const int wsel = r / I_SQ; r -= wsel * I_SQ; const int nb = r % 64; kb = r / 64; ldw = D; K = D; csrc0 = nb * 32; row0 = nb * 32;
                    W = PF(wsel == 0 ? I_WOUT : wsel == 1 ? I_WXQ : wsel == 2 ? I_WXK : wsel == 3 ? I_WXV : wsel == 4 ? I_WXO : I_WPQ);
                    WT = (bf16_t*)(wsb + O_WOUT + (size_t)wsel * ((size_t)D * D * 2));
                    if (wsel == 1) kgain = PF(I_GCROSS); else if (wsel == 5) kgain = PF(I_GFFN);
                } else {
                    r -= 6 * I_SQ; const int hq = r / 32; r -= hq * 32; const int nb = r % 8; kb = r / 8;
                    W = PF(hq < 4 ? I_WMQ : I_WMK) + (size_t)(hq & 3) * 65536; ldw = 256; K = 256; csrc0 = nb * 32; WT = (bf16_t*)(wsb + O_WQK); row0 = hq * 256 + nb * 32;
                    if (hq >= 4) wscale = 0.0625f;
                }
                p0_transpose_item(W, ldw, K, csrc0, WT, row0, scr, kb, lane, wscale, kgain);
            }
            rope_table_fill(W_CS, blockIdx.x * NTHR + tidx, gridDim.x * NTHR);
            {
                const float* sk = PF(I_SUBK);
#pragma nounroll
                for (int i = blockIdx.x * NTHR + tidx; i < 262144 / 8; i += gridDim.x * NTHR) {
                    const float4 a = *(const float4*)(sk + (size_t)i * 8), b = *(const float4*)(sk + (size_t)i * 8 + 4);
                    uint4 o; o.x = pk2(a.x, a.y); o.y = pk2(a.z, a.w); o.z = pk2(b.x, b.y); o.w = pk2(b.z, b.w);
                    *(uint4*)(W_SKB + (size_t)i * 8) = o;
                }
            }
            __syncthreads();
        }
        {
            const float* rin = PF(I_X); const float* rg = PF(I_GMIX); const float* win = PF(I_WIN);
            float* gwT = (float*)smem_raw;
            for (int k = tidx; k < 2048; k += NTHR) { const float4 a = *(const float4*)(win + (size_t)k * INC + C_MI), b = *(const float4*)(win + (size_t)k * INC + C_MI + 4);
                gwT[k] = a.x; gwT[2048 + k] = a.y; gwT[4096 + k] = a.z; gwT[6144 + k] = a.w; gwT[8192 + k] = b.x; gwT[10240 + k] = b.y; gwT[12288 + k] = b.z; gwT[14336 + k] = b.w; }
            __syncthreads();
            {
#pragma nounroll
                for (int row = blockIdx.x * 8 + (tidx >> 6); row < T; row += gridDim.x * 8) { int ln = tidx & 63; asm volatile("" : "+v"(ln)); rmsnorm_row_wave(row, ln, rin, rg, W_HB, gwT, W_GPRE); }
                const float* min_ = PF(I_MEM); const float* mg = PF(I_GMEM);
#pragma nounroll
                for (int row = blockIdx.x * 8 + (tidx >> 6); row < 512; row += gridDim.x * 8) { int ln = tidx & 63; asm volatile("" : "+v"(ln)); rmsnorm_row_wave(row, ln, min_, mg, W_MN2, nullptr, nullptr); }
            }
        }
    }
    xcd_barrier(xb);
    {
        PH_BEGIN();
        GJOB_DEFAULT(g); g.A = W_HB; g.Bt = (bf16_t*)(wsb + O_WIN); g.nN = 24; g.C = (float*)W_P6; g.ldc = 1024;
        pg8::gemm_phase<4>(GEMM_LDSP, g, tidx);
    }
    xcd_barrier(xb);
    {
        PH_BEGIN();
        const float* cw = PF(I_CONVW); const float* cb = PF(I_CONVB);
        const bool gates_wave = (blockIdx.x < 8) && ((tidx >> 6) == 7);
        {
            const int nconv = gridDim.x * NTHR;
#pragma nounroll
            for (int i = blockIdx.x * NTHR + tidx; i < 1024 * 128; i += nconv) conv_silu_run((i >> 7) * 8, i & 127, W_P6, cw, cb, W_CBUF);
        }
        if (gates_wave) mlstm_gates_wave(blockIdx.x >> 2, blockIdx.x & 3, tidx & 63, W_GPRE, PF(I_BMI), PF(I_BMF), W_GS, W_DECAY);
        else {
            LAS unsigned short* wl = (LAS unsigned short*)(LAS unsigned char*)smem_raw + (tidx >> 6) * (16 * 136);
            const int gwv = blockIdx.x * 8 + (tidx >> 6), rank = gwv - ((int)blockIdx.x < 8 ? (int)blockIdx.x : 8), nw = gridDim.x * 8 - 8;
#pragma nounroll
            for (int item = rank; item < 12288; item += nw) dil_tile_prep(item, tidx & 63, wl, W_P6 + 4 * P6S, W_P6 + 5 * P6S, W_CS, W_KB, W_VB);
        }
        __syncthreads();
#pragma nounroll
        PHASE_LOOP(2048) { const int it = VB, lt = it & 3, et = (it >> 2) & 3, h = (it >> 4) & 3, cg = it >> 6;
            transpose_tile64(tid, sm, W_P6 + P6S + (size_t)(cg * 256 + lt * 64) * 1024 + h * 256 + et * 64, 1024, W_BH + ((size_t)(cg * 4 + h) * 256 + et * 64) * 512 + lt * 64, 512, nullptr, 0); }
    }
    xcd_barrier(xb);
    {
        PH_BEGIN();
        {
            GJOB_DEFAULT(g); g.A = W_CBUF; g.lda = 1024; g.a_pm_step = 256 * 1024; g.Bt = (bf16_t*)(wsb + O_WQK); g.ldb = 256; g.b_pn_step = 256 * 256; g.K = 256; g.a_pn_mask = 3; g.a_pn_step = 256; g.C = (float*)W_MQ; g.ldc = 1024;
            pg8::gemm_phase<4>(GEMM_LDSP, g, tidx);
            __syncthreads();
        }
        const float* ga = PF(I_GAHEAD);
#pragma nounroll
        for (int qt = blockIdx.x * 8 + (tidx >> 6); qt < 2048; qt += gridDim.x * 8) dilated_wave_tile(qt, tidx & 63, W_P6 + 3 * P6S, W_CS, W_KB, W_VB, ga, W_MIXB);
    }
    xcd_barrier(xb);
    {
        PH_BEGIN();
#pragma nounroll
        PHASE_LOOP(2048) { const int it = VB, lt = it & 3, dt = (it >> 2) & 3, h = (it >> 4) & 3, cg = it >> 6;
            transpose_tile64(tid, sm, W_MK + (size_t)(cg * 256 + lt * 64) * 1024 + h * 256 + dt * 64, 1024, W_KWT + ((size_t)(cg * 4 + h) * 256 + dt * 64) * 256 + lt * 64, 256,
                             W_GS + ((size_t)(cg * 256 + lt * 64) * 4 + h) * 8 + 2, 32); }
        {
            const size_t nth = (size_t)gridDim.x * NTHR;
#pragma nounroll
            for (size_t i = (size_t)blockIdx.x * NTHR + tidx; i < (size_t)T * 128; i += nth) {
                const size_t t = i >> 7; const int c8 = (int)(i & 127) * 8, h = c8 >> 8, d = c8 & 255;
                const float sc = W_GS[(t * 4 + h) * 8 + 3];
                const uint4 v = *(const uint4*)(W_MQ + t * 1024 + c8);
                uint4 o;
                o.x = pk2(bf2f((unsigned short)(v.x & 0xFFFFu)) * sc, bf2f((unsigned short)(v.x >> 16)) * sc); o.y = pk2(bf2f((unsigned short)(v.y & 0xFFFFu)) * sc, bf2f((unsigned short)(v.y >> 16)) * sc);
                o.z = pk2(bf2f((unsigned short)(v.z & 0xFFFFu)) * sc, bf2f((unsigned short)(v.z >> 16)) * sc); o.w = pk2(bf2f((unsigned short)(v.w & 0xFFFFu)) * sc, bf2f((unsigned short)(v.w >> 16)) * sc);
                *(uint4*)(W_PQ + t * 2048 + h * 512 + 256 + d) = o;
            }
        }
#pragma nounroll
        PHASE_LOOP(128) { const int cgh = VB, cg = cgh >> 2, h = cgh & 3;
            float a = 0.f;
#pragma unroll 16
            for (int l = 0; l < 256; ++l) { const size_t t = (size_t)cg * 256 + l; a = fmaf(W_GS[(t * 4 + h) * 8 + 2], bf2f(W_MK[t * 1024 + h * 256 + tid]), a); }
            W_DN[(size_t)cgh * 256 + tid] = a; }
        __syncthreads();
        {
            GJOB_DEFAULT(g); g.A = W_MQ; g.lda = 1024; g.a_pm_step = 256 * 1024; g.a_pn_mask = 3; g.a_pn_step = 256; g.K = 256; g.nN = 4;
            g.Bt = W_MK; g.ldb = 1024; g.b_pn_step = 256; g.b_pm_step = 256 * 1024; g.C = (float*)W_PQ; g.gs = W_GS; g.denp = W_DENP;
            pg8::gemm_phase<6>(GEMM_LDSP, g, tidx);
        }
    }
    xcd_barrier(xb);
    {
        PH_BEGIN();
        GJOB_DEFAULT(g); g.A = W_BH; g.lda = 512; g.a_pm_step = 4 * 256 * 512; g.a_pn_mask = 3; g.a_pn_step = 256 * 512; g.K = 256; g.nN = 4;
        g.Bt = W_KWT; g.ldb = 256; g.b_pn_step = 65536; g.b_pm_step = 4 * 65536; g.C = W_DC;
        pg8::gemm_phase<7>(GEMM_LDSP, g, tidx);
    }
    xcd_barrier(xb);
    {
        PH_BEGIN();
        {
#pragma nounroll
            for (int gid = blockIdx.x * NTHR + tidx; gid < 131072; gid += gridDim.x * NTHR) {
                const int bh = gid >> 14, b = bh >> 2, h = bh & 3, e = (gid >> 6) & 255, d = (gid & 63) * 4;
                float4 C = make_float4(0.f, 0.f, 0.f, 0.f);
                float4 dcv[16]; float decv[16];
#pragma unroll
                for (int c = 0; c < 16; ++c) { const int cgh = (b * 16 + c) * 4 + h; decv[c] = W_DECAY[cgh]; dcv[c] = *(const float4*)(W_DC + ((size_t)cgh * 256 + e) * 256 + d); }
#pragma unroll
                for (int c = 0; c < 16; ++c) {
                    const int cgh = (b * 16 + c) * 4 + h;
                    uint2 o; o.x = pk2(C.x, C.y); o.y = pk2(C.z, C.w);
                    *(uint2*)(W_BH + ((size_t)cgh * 256 + e) * 512 + 256 + d) = o;
                    C.x = fmaf(decv[c], C.x, dcv[c].x); C.y = fmaf(decv[c], C.y, dcv[c].y); C.z = fmaf(decv[c], C.z, dcv[c].z); C.w = fmaf(decv[c], C.w, dcv[c].w);
                }
            }
        }
#pragma nounroll
        PHASE_LOOP(128) { const int cgh = VB, cg = cgh >> 2, h = cgh & 3, b = cg >> 4, c = cg & 15;
            float n = 0.f;
            for (int cc = 0; cc < c; ++cc) { const int j = (b * 16 + cc) * 4 + h; n = fmaf(W_DECAY[j], n, W_DN[(size_t)j * 256 + tid]); }
            __syncthreads();
            sm[tid] = n;
            __syncthreads();
            const int lane = tid & 63, w = tid >> 6;
            const float4 nv = *(const float4*)(sm + lane * 4);
#pragma unroll 1
            for (int i = 0; i < 64; i += 8) {
                float s[8];
#pragma unroll
                for (int k = 0; k < 8; ++k) {
                    const size_t t = (size_t)cg * 256 + w * 64 + i + k;
                    const ushort4 q4 = *(const ushort4*)(W_MQ + t * 1024 + h * 256 + lane * 4);
                    s[k] = bf2f(q4.x) * nv.x + bf2f(q4.y) * nv.y + bf2f(q4.z) * nv.z + bf2f(q4.w) * nv.w;
                }
#pragma unroll
                for (int k = 0; k < 8; ++k) { const float tot = wave_sum_dpp(s[k]); if (lane == 0) W_QN[((size_t)cg * 256 + w * 64 + i + k) * 4 + h] = tot; }
            }
        }
    }
    xcd_barrier(xb);
    {
        PH_BEGIN();
        GJOB_DEFAULT(g); g.A = W_PQ; g.a_pn_mask = 3; g.a_pn_step = 512; g.K = 512; g.nN = 4;
        g.Bt = W_BH; g.ldb = 512; g.b_pn_step = 256 * 512; g.b_pm_step = 4 * 256 * 512; g.C = (float*)W_MIXB;
        g.gs = W_GS; g.denp = W_DENP; g.qn = W_QN; g.gvec = PF(I_GMHEAD); g.mo = W_P6 + 2 * P6S; g.nblk = 128;
        if (blockIdx.x < 128) pg8::gemm_phase<8>(GEMM_LDSP, g, tidx);
        else {
            GJOB_DEFAULT(k); k.A = W_MN2; k.K = 1024; k.nM = 2; k.nN = 32; k.a_pn_shift = 4; k.a_pn_mask = 1; k.a_pn_step = 1024;
            k.Bt = (bf16_t*)(wsb + O_WXK); k.b_pn_mask = 15; k.b_pn_shift = 4; k.b_pn_step2 = 1024; k.C = W_KVP; k.bid0 = 128; k.nblk = 128;
            pg8::gemm_phase<12>(GEMM_LDSP, k, tidx);
        }
    }
    xcd_barrier(xb);
    {
        PH_BEGIN();
        for (int i = blockIdx.x * NTHR + tidx; i < 512 * 4096 / 4; i += gridDim.x * NTHR) {
            const int r = i >> 10, c = (i & 1023) * 4;
            const float4 a = *(const float4*)(W_KVP + (size_t)r * 4096 + c), b = *(const float4*)(W_KVP + (size_t)512 * 4096 + (size_t)r * 4096 + c);
            const float v0 = a.x + b.x, v1 = a.y + b.y, v2 = a.z + b.z, v3 = a.w + b.w;
            if (c < 2048) { uint2 o; o.x = pk2(v0, v1); o.y = pk2(v2, v3); *(uint2*)(W_KM + (size_t)r * 2048 + c) = o; }
            else { bf16_t* d = W_VMT + (size_t)(c - 2048) * 512 + r; d[0] = (bf16_t)f2bf(v0); d[512] = (bf16_t)f2bf(v1); d[1024] = (bf16_t)f2bf(v2); d[1536] = (bf16_t)f2bf(v3); }
        }
        GJOB_DEFAULT(g); g.A = W_MIXB; g.Bt = (bf16_t*)(wsb + O_WOUT); g.R = PF(I_X); g.C2 = W_HB; g.rssp = W_RSSP;
        pg8::gemm_phase<10>(GEMM_LDSP, g, tidx);
    }
    xcd_barrier(xb);
    {
        PH_BEGIN();
        {
            GJOB_DEFAULT(g); g.A = W_HB; g.Bt = (bf16_t*)(wsb + O_WXQ); g.C = (float*)W_QX;
            pg8::Unit u0;
            if (pg8::unit_next(g, 0, u0) && tidx < 256) { const size_t r = (size_t)u0.pm * 256 + tidx; float s = 0.f;
                { float4 pq[8];
#pragma unroll
                  for (int k = 0; k < 8; ++k) pq[k] = *(const float4*)(W_RSSP + r * 32 + 4 * k);
#pragma unroll
                  for (int k = 0; k < 8; ++k) s += (pq[k].x + pq[k].y) + (pq[k].z + pq[k].w); }
                ((LAS float*)(LAS unsigned char*)(smem_raw + GEMM_LDS + 1024 + 8192))[tidx] = rsqrtf(s * (1.0f / D) + EPS); }
            __syncthreads();
            pg8::gemm_phase<11>(GEMM_LDSP, g, tidx); __syncthreads();
        }

    }
    xcd_barrier(xb);
    {
        PH_BEGIN();
        GJOB_DEFAULT(g); g.A = W_QX; g.K = 512; g.a_pn_mask = 3; g.a_pn_step = 512; g.Bt = W_KM; g.b_pn_step = 512; g.b_pm_shift = 4; g.b_pm_step = 256 * D; g.nN = 4;
        g.C = (float*)W_PX; g.ldc = 1024; g.escale = 0.04419417382415922f * 1.4426950408889634f;
        pg8::gemm_phase<5>(GEMM_LDSP, g, tidx);
    }
    xcd_barrier(xb);
    {
        PH_BEGIN();
        GJOB_DEFAULT(g); g.A = W_PX; g.lda = 1024; g.a_pm_step = 256 * 1024; g.K = 256; g.a_pn_shift = 1; g.a_pn_mask = 3; g.a_pn_step = 256; g.Bt = W_VMT; g.ldb = 512; g.b_pn_step = 256 * 512; g.b_pm_shift = 4; g.b_pm_step = 256;
        g.C = (float*)W_MIXB;
        pg8::gemm_phase<3>(GEMM_LDSP, g, tidx);
    }
    xcd_barrier(xb);
    {
        PH_BEGIN();
        GJOB_DEFAULT(g); g.A = W_MIXB; g.Bt = (bf16_t*)(wsb + O_WXO); g.R = nullptr; g.C2 = W_HB; g.rssp = W_RSSP;
        pg8::gemm_phase<10>(GEMM_LDSP, g, tidx);
    }
    xcd_barrier(xb);
    {
        PH_BEGIN();
        GJOB_DEFAULT(g); g.A = W_HB; g.Bt = (bf16_t*)(wsb + O_WPQ); g.C = (float*)W_QX;
        pg8::Unit u0;
        if (pg8::unit_next(g, 0, u0) && tidx < 256) { const size_t r = (size_t)u0.pm * 256 + tidx; float s = 0.f;
                { float4 pq[8];
#pragma unroll
                  for (int k = 0; k < 8; ++k) pq[k] = *(const float4*)(W_RSSP + r * 32 + 4 * k);
#pragma unroll
                  for (int k = 0; k < 8; ++k) s += (pq[k].x + pq[k].y) + (pq[k].z + pq[k].w); }
            const float rs = rsqrtf(s * (1.0f / D) + EPS);
            ((LAS float*)(LAS unsigned char*)(smem_raw + GEMM_LDS + 1024 + 8192))[tidx] = rs; W_RSTD[r] = rs; }
        __syncthreads();
        pg8::gemm_phase<11>(GEMM_LDSP, g, tidx);
    }
    xcd_barrier(xb);
    {
        PH_BEGIN();
        LAS float* wl = (LAS float*)(LAS unsigned char*)smem_raw + (tidx >> 6) * 1024;
        const bool conv_first = ((tidx >> 6) & 1) != 0;
        if (!conv_first) {
#pragma nounroll
            for (int item = blockIdx.x * 8 + (tidx >> 6); item < 4096; item += gridDim.x * 8) peer_topk_wave2(item, tidx & 63, wl, W_QX, W_SKB, W_IDS, W_GATES);
        }
        {
            const int gw = blockIdx.x * 8 + (tidx >> 6), NGW = gridDim.x * 8; int lane = tidx & 63; asm volatile("" : "+v"(lane));
                const float* ut = PF(I_UTAB); const float* vt = PF(I_VTAB); const float* gffn = PF(I_GFFN);
#define TBL_LOAD(F, SRC, RR) _Pragma("unroll") for (int i = 0; i < 8; ++i) F[i] = *(const float4*)((SRC) + (size_t)(RR) * D + i * 256 + lane * 4);
                {
                    float4 fa[8], fb[8];
                    TBL_LOAD(fa, ut, gw)
#pragma nounroll
                    for (int rr = gw; rr < 16384; rr += 2 * NGW) {
                        TBL_LOAD(fb, ut, rr + NGW)
                        table_row_store<true>(fa, W_UT + (size_t)rr * D, W_RSC + rr, lane, gffn);
                        { const int nx = rr + 2 * NGW < 16384 ? rr + 2 * NGW : rr; TBL_LOAD(fa, ut, nx) }
                        table_row_store<true>(fb, W_UT + (size_t)(rr + NGW) * D, W_RSC + rr + NGW, lane, gffn);
                    }
                    TBL_LOAD(fa, vt, gw)
#pragma nounroll
                    for (int rr = gw; rr < 16384; rr += 2 * NGW) {
                        TBL_LOAD(fb, vt, rr + NGW)
                        table_row_store<false>(fa, W_VT + (size_t)rr * D, W_RSC + 16384 + rr, lane, nullptr);
                        { const int nx = rr + 2 * NGW < 16384 ? rr + 2 * NGW : rr; TBL_LOAD(fa, vt, nx) }
                        table_row_store<false>(fb, W_VT + (size_t)(rr + NGW) * D, W_RSC + 16384 + rr + NGW, lane, nullptr);
                    }
                }
#undef TBL_LOAD
            }
        if (conv_first) {
#pragma nounroll
            for (int item = blockIdx.x * 8 + (tidx >> 6); item < 4096; item += gridDim.x * 8) peer_topk_wave2(item, tidx & 63, wl, W_QX, W_SKB, W_IDS, W_GATES);
        }
    }
    xcd_barrier(xb);
    {
        PH_BEGIN();
        const float* gf = PF(I_GFINAL); float* outp = (float*)ldp_raw(I_OUT);
        LAS unsigned char* wl = (LAS unsigned char*)smem_raw + (tidx >> 6) * 11776;
#pragma nounroll
        for (int gw = blockIdx.x * 8 + (tidx >> 6); gw < T / 4; gw += gridDim.x * 8) { int ln = tidx & 63; asm volatile("" : "+v"(ln));
            peer_sweep_wave(gw, ln, wl, W_HB, W_XR, W_IDS, W_GATES, W_UT, W_VT, W_RSC, W_RSTD, gf, outp); }
    }
}
}

extern "C" void kernel_launch(void* const* d_in, const int* in_sizes, int n_in, void* d_out, int out_size, void* d_ws, size_t ws_size, hipStream_t stream) {
    static int grid_blocks = 0;
    if (!grid_blocks) {
        int dev = 0, cus = 0, per_cu = 0;
        hipGetDevice(&dev);
        hipDeviceGetAttribute(&cus, hipDeviceAttributeMultiprocessorCount, dev);
        hipFuncSetAttribute((const void*)mega, hipFuncAttributeMaxDynamicSharedMemorySize, SMEM_BYTES);
        hipOccupancyMaxActiveBlocksPerMultiprocessor(&per_cu, mega, NTHR, SMEM_BYTES);
        if (per_cu > 1) per_cu = 1;
        if (per_cu < 1) per_cu = 1;
        grid_blocks = cus * per_cu;
    }
    Params P{};
    const float** pp = (const float**)&P;
    for (int i = 0; i < 25; ++i) pp[i] = (const float*)d_in[i];
    P.out = (float*)d_out;
    P.bar = (unsigned*)d_ws;
    P.ws = (float*)((char*)d_ws + 16384);
    hipMemsetAsync(d_ws, 0, 16384, stream);
    void* args[] = {&P};
    hipError_t e = hipLaunchCooperativeKernel((const void*)mega, dim3(grid_blocks), dim3(NTHR), args, SMEM_BYTES, stream);
    if (e != hipSuccess) fprintf(stderr, "cooperative launch failed: %s (grid %d)\n", hipGetErrorString(e), grid_blocks);
}
```
